# Optimizing an MI355X kernel written in HIP

```python
import math
import jax, jax.numpy as jnp
from jax import lax
import numpy as np

D_MODEL = 1024
BATCH = 4
SEQ = 4096
DEPTH = 4

GRID_W = 64
CTX_LEN = 256
N_MIXERS = 3
LAYER_KINDS = tuple(i % N_MIXERS for i in range(DEPTH))
KIND_SLOT = tuple(LAYER_KINDS[:i].count(LAYER_KINDS[i]) for i in range(DEPTH))
N_HYENA = LAYER_KINDS.count(0)
N_ATTN = LAYER_KINDS.count(1)
N_CHUNK = LAYER_KINDS.count(2)
LAST_CTX_LAYER = max([i for i, k in enumerate(LAYER_KINDS) if k == 1], default=-1)

HY_ORDER = 2
HY_SHORT = 3
HY_BANDS = 16
HY_EMB_DIM = 1 + 2 * HY_BANDS
HY_FILTER_HIDDEN = 64
HY_DECAY_TARGET = 1e-2
HY_FAST_DECAY_PCT = 0.3
HY_SLOW_DECAY_PCT = 1.5
HY_MIN_DECAY = math.log(HY_DECAY_TARGET) / HY_SLOW_DECAY_PCT
HY_MAX_DECAY = math.log(HY_DECAY_TARGET) / HY_FAST_DECAY_PCT
HY_PROJ = (HY_ORDER + 1) * D_MODEL

HEAD_DIM = 64
N_Q_HEADS = D_MODEL // HEAD_DIM
N_KV_HEADS = 4
GQA_GROUP = N_Q_HEADS // N_KV_HEADS
Q_BLOCK = 128
ROPE_THETA = 10000.0
ATTN_SCALE = HEAD_DIM ** -0.5
Q_COLS = N_Q_HEADS * HEAD_DIM
QKV_COLS = (N_Q_HEADS + 2 * N_KV_HEADS) * HEAD_DIM

CHUNK = 128
GMLP_HALF = 2 * D_MODEL
GMLP_GROUPS = 16
GMLP_GROUP_W = GMLP_HALF // GMLP_GROUPS

N_EXPERTS = 16
EXPERT_FF = 2 * D_MODEL
CAPACITY_FACTOR = 2

RMS_EPS = 1e-6
LN_EPS = 1e-5
DEEPNORM_ALPHA = (2 * DEPTH) ** 0.25
DEEPNORM_BETA = (8 * DEPTH) ** -0.25

kernel_name = 'hybrid_hyena_gqa_gmlp_ecmoe_diffusion'

F32 = jnp.float32


def layer_norm(x, g, b):
    xf = x.astype(F32)
    mu = jnp.mean(xf, axis=-1, keepdims=True)
    var = jnp.mean(jnp.square(xf - mu), axis=-1, keepdims=True)
    return ((xf - mu) * lax.rsqrt(var + LN_EPS) * g.astype(F32) + b.astype(F32)).astype(x.dtype)


def rms_norm(x, g):
    xf = x.astype(F32)
    return (xf * lax.rsqrt(jnp.mean(jnp.square(xf), axis=-1, keepdims=True) + RMS_EPS) * g.astype(F32)).astype(x.dtype)


def adaln(cond, w_mod, b_mod):
    m = jax.nn.silu(cond) @ w_mod + b_mod
    return jnp.split(m, 6, axis=-1)


def modulate(x, shift, scale):
    return x * (1.0 + scale) + shift


def post_norm(x, y, g, b):
    return layer_norm(DEEPNORM_ALPHA * x + y, g, b)


def centred_depthwise_conv(x, w, b):
    k = w.shape[0]
    y = lax.conv_general_dilated(x, w[:, None, :].astype(x.dtype), window_strides=(1,),
                                 padding=[(k // 2, k // 2)], dimension_numbers=('NWC', 'WIO', 'NWC'),
                                 feature_group_count=x.shape[-1])
    return y + b


def hyena_filters(L, f_w1, f_b1, f_w2, f_b2, f_w3, f_freq):
    t = jnp.linspace(0.0, 1.0, L, dtype=F32)[:, None]
    w = (2.0 * math.pi / L) * jnp.arange(L, dtype=F32)[:, None]
    f = jnp.linspace(1e-4, HY_BANDS - 1, HY_BANDS, dtype=F32)[None, :]
    z = jnp.concatenate([t, jnp.cos(f * w), -jnp.sin(f * w)], axis=-1)
    freq = f_freq.astype(F32)
    h = jnp.sin(freq[0] * (z @ f_w1.astype(F32) + f_b1.astype(F32)))
    h = jnp.sin(freq[1] * (h @ f_w2.astype(F32) + f_b2.astype(F32)))
    h = (h @ f_w3.astype(F32)).reshape(L, HY_ORDER, 2, D_MODEL)
    deltas = jnp.abs(jnp.linspace(HY_MIN_DECAY, HY_MAX_DECAY, D_MODEL, dtype=F32))
    h = h * jnp.exp(-t * deltas)[:, None, None, :]
    fwd, bwd = h[:, :, 0], h[:, :, 1]
    k2 = jnp.concatenate([fwd, jnp.zeros((1, HY_ORDER, D_MODEL), F32), bwd[:0:-1]], axis=0)
    k2 = k2 / (jnp.sum(jnp.abs(k2), axis=0, keepdims=True) + RMS_EPS)
    return jnp.fft.rfft(k2, axis=0)


def long_conv(v, k_f, bias):
    L = v.shape[1]
    vf32 = v.astype(F32)
    y = jnp.fft.irfft(jnp.fft.rfft(vf32, n=2 * L, axis=1) * k_f[None], n=2 * L, axis=1)[:, :L]
    return (y + vf32 * bias.astype(F32)).astype(v.dtype)


def hyena_mixer(h, w_in, conv_w, conv_b, f_w1, f_b1, f_w2, f_b2, f_w3, f_freq, f_bias, w_out):
    L = h.shape[1]
    p = centred_depthwise_conv(h @ w_in, conv_w, conv_b)
    v, x1, x2 = jnp.split(p, 3, axis=-1)
    k_f = hyena_filters(L, f_w1, f_b1, f_w2, f_b2, f_w3, f_freq)
    z = v
    for n, gate in enumerate((x1, x2)):
        z = gate * long_conv(z, k_f[:, n], f_bias[n])
    return z @ w_out


def axial_rope_tables(L):
    rows = L // GRID_W
    row = jnp.broadcast_to(jnp.arange(rows, dtype=F32)[:, None], (rows, GRID_W)).reshape(L)
    col = jnp.broadcast_to(jnp.arange(GRID_W, dtype=F32)[None, :], (rows, GRID_W)).reshape(L)
    n_freq = HEAD_DIM // 4
    inv_freq = ROPE_THETA ** (-jnp.arange(n_freq, dtype=F32) / n_freq)
    ang = jnp.concatenate([row[:, None] * inv_freq, col[:, None] * inv_freq], axis=-1)
    return jnp.cos(ang), jnp.sin(ang)


def apply_rope(x, cos, sin):
    shape = (1, x.shape[1]) + (1,) * (x.ndim - 3) + (HEAD_DIM // 2,)
    cos, sin = cos.reshape(shape), sin.reshape(shape)
    xf = x.astype(F32)
    x1, x2 = xf[..., :HEAD_DIM // 2], xf[..., HEAD_DIM // 2:]
    return jnp.concatenate([x1 * cos - x2 * sin, x1 * sin + x2 * cos], axis=-1).astype(x.dtype)


def q_heads(h, w_qkv, q_gain):
    B, L, _ = h.shape
    q = (h @ w_qkv[:, :Q_COLS]).reshape(B, L, N_KV_HEADS, GQA_GROUP, HEAD_DIM)
    return rms_norm(q, q_gain)


def kv_heads(h, w_qkv, k_gain):
    B, L, _ = h.shape
    k, v = jnp.split(h @ w_qkv[:, Q_COLS:], 2, axis=-1)
    return rms_norm(k.reshape(B, L, N_KV_HEADS, HEAD_DIM), k_gain), v.reshape(B, L, N_KV_HEADS, HEAD_DIM)


def block_attention(q, keys, vals):
    B, Lq = q.shape[:2]
    qb = jnp.moveaxis(q.reshape((B, Lq // Q_BLOCK, Q_BLOCK) + q.shape[2:]), 1, 0)

    def one_block(qi):
        s = jnp.einsum('bqkgd,bskd->bkgqs', qi, keys, preferred_element_type=F32) * ATTN_SCALE
        p = jax.nn.softmax(s, axis=-1).astype(vals.dtype)
        return jnp.einsum('bkgqs,bskd->bqkgd', p, vals)

    o = lax.map(one_block, qb)
    return jnp.moveaxis(o, 0, 1).reshape(B, Lq, Q_COLS)


def chunk_gmlp_mixer(h, w_in, ln_g, ln_b, w_s, b_s, w_out):
    B, L, _ = h.shape
    z = jax.nn.gelu(h @ w_in, approximate=False)
    u, v = jnp.split(z, 2, axis=-1)
    v = layer_norm(v, ln_g, ln_b).reshape(B, L // CHUNK, CHUNK, GMLP_GROUPS, GMLP_GROUP_W)
    v = jnp.einsum('gts,bnsgc->bntgc', w_s, v) + b_s.T[None, None, :, :, None]
    return (u * v.reshape(B, L, GMLP_HALF)) @ w_out


def expert_choice_ffn(h, w_router, w_gate, w_up, w_down):
    B, n, _ = h.shape
    cap = CAPACITY_FACTOR * n // N_EXPERTS
    aff = jax.nn.softmax((h @ w_router).astype(F32), axis=-1)
    gate, idx = lax.top_k(jnp.swapaxes(aff, 1, 2), cap)
    bidx = jnp.arange(B)[:, None, None]
    xg = h[bidx, idx]
    a = jnp.einsum('becd,edf->becf', xg, w_gate)
    u = jnp.einsum('becd,edf->becf', xg, w_up)
    y = jnp.einsum('becf,efd->becd', jax.nn.silu(a) * u, w_down) * gate[..., None].astype(h.dtype)
    return jnp.zeros_like(h).at[bidx, idx].add(y)


def setup_inputs(seed: int = 0) -> dict:
    key = jax.random.key(seed)
    ks = jax.random.split(key, 33)
    D = D_MODEL

    def nrm(i, shape, scale):
        return scale * jax.random.normal(ks[i], shape, F32)

    return {
        'x': nrm(0, (BATCH, SEQ, D), 1.0),
        'c': nrm(1, (BATCH, D), 1.0),
        'ctx': nrm(2, (BATCH, CTX_LEN, D), 1.0),
        'c_ctx': nrm(3, (D,), 1.0),
        'mod_w': nrm(4, (DEPTH, D, 6 * D), D ** -0.5),
        'mod_b': nrm(5, (DEPTH, 6 * D), 0.02),
        'ln_g': 1.0 + nrm(6, (DEPTH, 2, D), 0.02),
        'ln_b': nrm(7, (DEPTH, 2, D), 0.02),
        'hy_w_in': nrm(8, (N_HYENA, D, HY_PROJ), D ** -0.5),
        'hy_conv_w': nrm(9, (N_HYENA, HY_SHORT, HY_PROJ), HY_SHORT ** -0.5),
        'hy_conv_b': nrm(10, (N_HYENA, HY_PROJ), 0.02),
        'hy_f_w1': nrm(11, (N_HYENA, HY_EMB_DIM, HY_FILTER_HIDDEN), HY_EMB_DIM ** -0.5),
        'hy_f_b1': nrm(12, (N_HYENA, HY_FILTER_HIDDEN), 0.02),
        'hy_f_w2': nrm(13, (N_HYENA, HY_FILTER_HIDDEN, HY_FILTER_HIDDEN), HY_FILTER_HIDDEN ** -0.5),
        'hy_f_b2': nrm(14, (N_HYENA, HY_FILTER_HIDDEN), 0.02),
        'hy_f_w3': nrm(15, (N_HYENA, HY_FILTER_HIDDEN, HY_ORDER * 2 * D), HY_FILTER_HIDDEN ** -0.5),
        'hy_f_freq': 1.0 + nrm(16, (N_HYENA, 2, HY_FILTER_HIDDEN), 0.02),
        'hy_f_bias': nrm(17, (N_HYENA, HY_ORDER, D), 0.02),
        'hy_w_out': nrm(18, (N_HYENA, D, D), DEEPNORM_BETA * D ** -0.5),
        'at_w_qkv': nrm(19, (N_ATTN, D, QKV_COLS), D ** -0.5),
        'at_q_gain': 1.0 + nrm(20, (N_ATTN, HEAD_DIM), 0.02),
        'at_k_gain': 1.0 + nrm(21, (N_ATTN, HEAD_DIM), 0.02),
        'at_w_out': nrm(22, (N_ATTN, Q_COLS, D), DEEPNORM_BETA * Q_COLS ** -0.5),
        'cm_w_in': nrm(23, (N_CHUNK, D, 2 * GMLP_HALF), D ** -0.5),
        'cm_ln_g': 1.0 + nrm(24, (N_CHUNK, GMLP_HALF), 0.02),
        'cm_ln_b': nrm(25, (N_CHUNK, GMLP_HALF), 0.02),
        'cm_w_s': nrm(26, (N_CHUNK, GMLP_GROUPS, CHUNK, CHUNK), CHUNK ** -0.5),
        'cm_b_s': 1.0 + nrm(27, (N_CHUNK, GMLP_GROUPS, CHUNK), 0.02),
        'cm_w_out': nrm(28, (N_CHUNK, GMLP_HALF, D), DEEPNORM_BETA * GMLP_HALF ** -0.5),
        'moe_router': nrm(29, (DEPTH, D, N_EXPERTS), D ** -0.5),
        'moe_w_gate': nrm(30, (DEPTH, N_EXPERTS, D, EXPERT_FF), D ** -0.5),
        'moe_w_up': nrm(31, (DEPTH, N_EXPERTS, D, EXPERT_FF), D ** -0.5),
        'moe_w_down': nrm(32, (DEPTH, N_EXPERTS, EXPERT_FF, D), DEEPNORM_BETA * EXPERT_FF ** -0.5),
    }


def reference(x, c, ctx, c_ctx, mod_w, mod_b, ln_g, ln_b,
              hy_w_in, hy_conv_w, hy_conv_b, hy_f_w1, hy_f_b1, hy_f_w2, hy_f_b2, hy_f_w3, hy_f_freq, hy_f_bias, hy_w_out,
              at_w_qkv, at_q_gain, at_k_gain, at_w_out,
              cm_w_in, cm_ln_g, cm_ln_b, cm_w_s, cm_b_s, cm_w_out,
              moe_router, moe_w_gate, moe_w_up, moe_w_down):
    x_lat, x_ctx = x, ctx
    for i in range(DEPTH):
        kind, slot = LAYER_KINDS[i], KIND_SLOT[i]
        ctx_read = i <= LAST_CTX_LAYER
        ctx_update = i < LAST_CTX_LAYER
        sh1, sc1, g1, sh2, sc2, g2 = adaln(c[:, None, :], mod_w[i], mod_b[i])
        h = modulate(x_lat, sh1, sc1)
        if ctx_read:
            cmod = adaln(c_ctx, mod_w[i], mod_b[i])
            hc = modulate(x_ctx, cmod[0], cmod[1])

        if kind == 0:
            hy = (hy_w_in[slot], hy_conv_w[slot], hy_conv_b[slot], hy_f_w1[slot], hy_f_b1[slot], hy_f_w2[slot],
                  hy_f_b2[slot], hy_f_w3[slot], hy_f_freq[slot], hy_f_bias[slot], hy_w_out[slot])
            y = hyena_mixer(h, *hy)
            if ctx_update:
                yc = hyena_mixer(hc, *hy)
        elif kind == 1:
            w_qkv = at_w_qkv[slot]
            ck, cv = kv_heads(hc, w_qkv, at_k_gain[slot])
            cos, sin = axial_rope_tables(h.shape[1])
            q = apply_rope(q_heads(h, w_qkv, at_q_gain[slot]), cos, sin)
            k, v = kv_heads(h, w_qkv, at_k_gain[slot])
            k = apply_rope(k, cos, sin)
            o = block_attention(q, jnp.concatenate([ck, k], axis=1), jnp.concatenate([cv, v], axis=1))
            y = o @ at_w_out[slot]
            if ctx_update:
                yc = block_attention(q_heads(hc, w_qkv, at_q_gain[slot]), ck, cv) @ at_w_out[slot]
        else:
            cm = (cm_w_in[slot], cm_ln_g[slot], cm_ln_b[slot], cm_w_s[slot], cm_b_s[slot], cm_w_out[slot])
            y = chunk_gmlp_mixer(h, *cm)
            if ctx_update:
                yc = chunk_gmlp_mixer(hc, *cm)

        moe = (moe_router[i], moe_w_gate[i], moe_w_up[i], moe_w_down[i])
        x_lat = post_norm(x_lat, g1 * y, ln_g[i, 0], ln_b[i, 0])
        x_lat = post_norm(x_lat, g2 * expert_choice_ffn(modulate(x_lat, sh2, sc2), *moe), ln_g[i, 1], ln_b[i, 1])
        if ctx_update:
            x_ctx = post_norm(x_ctx, cmod[2] * yc, ln_g[i, 0], ln_b[i, 0])
            x_ctx = post_norm(x_ctx, cmod[5] * expert_choice_ffn(modulate(x_ctx, cmod[3], cmod[4]), *moe),
                              ln_g[i, 1], ln_b[i, 1])
    return x_lat
```

```cpp
#define MK_N_LAUNCHES 1
#define MK_FAST_ATTN 1
#define MK_FAST_CONV 1
#define MK_GATHER 1
#define MK_FAST_SP 1
#include <hip/hip_runtime.h>
#include <cstdio>
#include <cstdint>
#include <cmath>
namespace pg8 {
#define PG8_LAS __attribute__((address_space(3)))
typedef unsigned short bf16_t;
typedef short bf16x8 __attribute__((ext_vector_type(8)));
typedef float f32x4 __attribute__((ext_vector_type(4)));
typedef unsigned u32x4 __attribute__((ext_vector_type(4)));
constexpr int BM = 256, BK = 64, HALF = 128, HTB = HALF * BK * 2  , STAGE_BYTES = 8 * HTB, NXCD = 8, WGM = 8;

__host__ __device__ __forceinline__ int lds_byte(int r, int c) { const int st = (r >> 4) * 2 + (c >> 5), rr = r & 15, cc = c & 31, ob = rr * 64 + cc * 2; return st * 1024 + (ob ^ (((ob >> 9) & 1) << 5)); }
__host__ __device__ __forceinline__ void stage_rc(int b, int& R, int& C) { const int st = b / 1024, sb = b % 1024, swz = sb ^ (((sb >> 9) & 1) << 5); R = (st >> 1) * 16 + swz / 64; C = (st & 1) * 32 + (swz % 64) / 2; }
__host__ __device__ __forceinline__ int perm32(int rho) { const int n = rho >> 4, i = rho & 15; return 8 * (i >> 2) + 4 * n + (i & 3); }

struct Unit { int pm, pn; };
struct Gemm { const bf16_t* A; const bf16_t* Bt; int M, N, K; const int* rows; };

struct StaticOrder {
    int nM, nN, nwg, G, c;
    __host__ __device__ void init(int M, int N, int G_, int c_) { nM = M / BM; nN = N / BM; nwg = nM * nN; G = G_; c = c_; }
    __host__ __device__ bool next(int i, Unit& u) const {
        const long L = (long)i * G + c; if (L >= nwg) return false;
        int wgid = (int)L; { const int q = nwg / NXCD, r = nwg % NXCD, xcd = wgid % NXCD, off = wgid / NXCD; wgid = (xcd < r ? xcd * (q + 1) : r * (q + 1) + (xcd - r) * q) + off; }
        const int nig = WGM * nN, gid = wgid / nig, fm = gid * WGM, gsz = (nM - fm) < WGM ? (nM - fm) : WGM;
        u.pm = fm + ((wgid % nig) % gsz); u.pn = (wgid % nig) / gsz; return true;
    }
    __device__ __forceinline__ void a_ready(const Unit&) const {}
    __device__ __forceinline__ void done(const Unit&) const {}
};

__device__ __forceinline__ unsigned cvt_pk_bf16(float lo, float hi) { unsigned r; asm volatile("v_cvt_pk_bf16_f32 %0, %1, %2" : "=v"(r) : "v"(lo), "v"(hi)); return r; }
typedef float f32x2 __attribute__((ext_vector_type(2)));
__device__ __forceinline__ f32x2 gelu_pk(f32x2 v) {
    const f32x2 av = __builtin_elementwise_abs(v), d = av * 0.2316418882f + 1.0f;
    f32x2 t; t.x = __builtin_amdgcn_rcpf(d.x); t.y = __builtin_amdgcn_rcpf(d.y);
    f32x2 q = t * 0.5307027145f + (-0.7265760135f); q = q * t + 0.7107068705f; q = q * t + (-0.142248368f); q = q * t + 0.127414796f; q = q * t;
    const f32x2 s = (v * v) * (-0.72134752044f);
    f32x2 e; e.x = __builtin_amdgcn_exp2f(s.x); e.y = __builtin_amdgcn_exp2f(s.y);
    const f32x2 m = v * (q * e), r = v - m;
    f32x2 o; o.x = v.x < 0.f ? m.x : r.x; o.y = v.y < 0.f ? m.y : r.y; return o;
}

template <int ACT  > struct EpiBf16 {
    static constexpr bool PERM = true, AFTER_DRAIN = false; static_assert(ACT == 0 || ACT == 1, "EpiBf16: ACT is 0 (none) or 1 (gelu_pk)");
    bf16_t* O; int ldc; const float* bias; int split_cols; size_t split_stride; float scale0;
    __device__ __forceinline__ void operator()(const f32x4 (&acc)[2][2][4][2], const Unit& u, int wr, int wc, int fr, int fq) const {
        const int row0 = u.pm * BM + wr * 64 + fr; int colt = u.pn * BM; bf16_t* base = O;
        float sc = 1.f; if (split_cols) { const int t = colt / split_cols; base += (size_t)t * split_stride; colt -= t * split_cols; if (t == 0) sc = scale0; }
        const int col0 = colt + wc * 32 + 8 * fq, bcol0 = u.pn * BM + wc * 32 + 8 * fq;
        f32x4 bv[2][2];
#pragma unroll
        for (int bj = 0; bj < 2; ++bj)
#pragma unroll
            for (int n = 0; n < 2; ++n) bv[bj][n] = bias ? *(const f32x4*)(bias + bcol0 + bj * HALF + 4 * n) : (f32x4){0.f, 0.f, 0.f, 0.f};
#pragma unroll
        for (int ai = 0; ai < 2; ++ai)
#pragma unroll
            for (int m = 0; m < 4; ++m) { bf16_t* rowp = base + (size_t)(row0 + ai * HALF + m * 16) * ldc + col0;
#pragma unroll
                for (int bj = 0; bj < 2; ++bj) { f32x4 v0 = acc[ai][bj][m][0] + bv[bj][0], v1 = acc[ai][bj][m][1] + bv[bj][1];
                    if (ACT == 1) { f32x2 a = gelu_pk((f32x2){v0[0], v0[1]}), b = gelu_pk((f32x2){v0[2], v0[3]}), c = gelu_pk((f32x2){v1[0], v1[1]}), d = gelu_pk((f32x2){v1[2], v1[3]});
                        v0 = (f32x4){a.x, a.y, b.x, b.y}; v1 = (f32x4){c.x, c.y, d.x, d.y}; }
                    v0 = v0 * sc; v1 = v1 * sc; u32x4 w; w.x = cvt_pk_bf16(v0[0], v0[1]); w.y = cvt_pk_bf16(v0[2], v0[3]); w.z = cvt_pk_bf16(v1[0], v1[1]); w.w = cvt_pk_bf16(v1[2], v1[3]);
                    *(u32x4*)(rowp + bj * HALF) = w; } }
    }
};

struct EpiF32 {
    static constexpr bool PERM = false, AFTER_DRAIN = false;
    float* C; int ldc;
    __device__ __forceinline__ void operator()(const f32x4 (&acc)[2][2][4][2], const Unit& u, int wr, int wc, int fr, int fq) const {
        const int row0 = u.pm * BM + wr * 64 + fr, col0 = u.pn * BM + wc * 32 + 4 * fq;
#pragma unroll
        for (int ai = 0; ai < 2; ++ai)
#pragma unroll
            for (int m = 0; m < 4; ++m) { float* rowp = C + (size_t)(row0 + ai * HALF + m * 16) * ldc + col0;
#pragma unroll
                for (int bj = 0; bj < 2; ++bj)
#pragma unroll
                    for (int n = 0; n < 2; ++n) *(f32x4*)(rowp + bj * HALF + n * 16) = acc[ai][bj][m][n]; }
    }
};
struct EpiRes {
    static constexpr bool PERM = false, AFTER_DRAIN = false;
    const float* X; float* U; const float* g; int gstride; float alpha;
    __device__ __forceinline__ void operator()(const f32x4 (&acc)[2][2][4][2], const Unit& u, int wr, int wc, int fr, int fq) const {
        const int row0 = u.pm * BM + wr * 64 + fr, col0 = u.pn * BM + wc * 32 + 4 * fq;
        const int rb = u.pm * BM; const int bidx = rb < 16384 ? (rb >> 12) : 4;
        const float* gp = g + (size_t)bidx * gstride + col0;
        f32x4 gv[2][2];
#pragma unroll
        for (int bj = 0; bj < 2; ++bj)
#pragma unroll
            for (int n = 0; n < 2; ++n) gv[bj][n] = *(const f32x4*)(gp + bj * HALF + n * 16);
#pragma unroll
        for (int ai = 0; ai < 2; ++ai)
#pragma unroll
            for (int m = 0; m < 4; ++m) { const size_t off = (size_t)(row0 + ai * HALF + m * 16) * 1024 + col0;
#pragma unroll
                for (int bj = 0; bj < 2; ++bj)
#pragma unroll
                    for (int n = 0; n < 2; ++n) { const f32x4 xv = *(const f32x4*)(X + off + bj * HALF + n * 16);
                        *(f32x4*)(U + off + bj * HALF + n * 16) = xv * alpha + gv[bj][n] * acc[ai][bj][m][n]; }
                asm volatile("" ::: "memory"); }
    }
};
struct EpiGU {
    static constexpr bool PERM = true, AFTER_DRAIN = false;
    bf16_t* ACT; int npn;
    __device__ __forceinline__ void operator()(const f32x4 (&acc)[2][2][4][2], const Unit& u, int wr, int wc, int fr, int fq) const {
        const int row0 = u.pm * BM + wr * 64 + fr; const int col0 = (u.pn % npn) * 128 + wc * 32 + 8 * fq;
#pragma unroll
        for (int ai = 0; ai < 2; ++ai)
#pragma unroll
            for (int m = 0; m < 4; ++m) { bf16_t* rowp = ACT + (size_t)(row0 + ai * HALF + m * 16) * 2048 + col0;
                float o[8];
#pragma unroll
                for (int n = 0; n < 2; ++n)
#pragma unroll
                    for (int j = 0; j < 4; ++j) { const float a = acc[ai][0][m][n][j], b = acc[ai][1][m][n][j];
                        const float s = a * __builtin_amdgcn_rcpf(1.0f + __builtin_amdgcn_exp2f(-1.4426950408889634f * a)); o[n * 4 + j] = s * b; }
                u32x4 w; w.x = cvt_pk_bf16(o[0], o[1]); w.y = cvt_pk_bf16(o[2], o[3]); w.z = cvt_pk_bf16(o[4], o[5]); w.w = cvt_pk_bf16(o[6], o[7]);
                *(u32x4*)rowp = w; }
    }
};
struct EpiDN {
    static constexpr bool PERM = true, AFTER_DRAIN = false;
    bf16_t* Y; const float* gate; int npn;
    __device__ __forceinline__ void operator()(const f32x4 (&acc)[2][2][4][2], const Unit& u, int wr, int wc, int fr, int fq) const {
        const int row0 = u.pm * BM + wr * 64 + fr, col0 = (u.pn % npn) * BM + wc * 32 + 8 * fq;
#pragma unroll
        for (int ai = 0; ai < 2; ++ai)
#pragma unroll
            for (int m = 0; m < 4; ++m) { const int row = row0 + ai * HALF + m * 16; const float gt = gate[row]; bf16_t* rowp = Y + (size_t)row * 1024 + col0;
#pragma unroll
                for (int bj = 0; bj < 2; ++bj) { const f32x4 v0 = acc[ai][bj][m][0] * gt, v1 = acc[ai][bj][m][1] * gt;
                    u32x4 w; w.x = cvt_pk_bf16(v0[0], v0[1]); w.y = cvt_pk_bf16(v0[2], v0[3]); w.z = cvt_pk_bf16(v1[0], v1[1]); w.w = cvt_pk_bf16(v1[2], v1[3]);
                    *(u32x4*)(rowp + bj * HALF) = w; } }
    }
};
struct EpiVT {
    static constexpr bool PERM = false, AFTER_DRAIN = false;
    float* VT; int ldc; f32x2* VST; int ntok;
    __device__ __forceinline__ void operator()(const f32x4 (&acc)[2][2][4][2], const Unit& u, int wr, int wc, int fr, int fq) const {
        const int row0 = u.pm * BM + wr * 64 + fr, col0 = u.pn * BM + wc * 32 + 4 * fq;
        f32x4 s1[2][2], s2[2][2];
#pragma unroll
        for (int bj = 0; bj < 2; ++bj)
#pragma unroll
            for (int n = 0; n < 2; ++n) { s1[bj][n] = (f32x4){0.f, 0.f, 0.f, 0.f}; s2[bj][n] = (f32x4){0.f, 0.f, 0.f, 0.f}; }
#pragma unroll
        for (int ai = 0; ai < 2; ++ai)
#pragma unroll
            for (int m = 0; m < 4; ++m) { float* rowp = VT + (size_t)(row0 + ai * HALF + m * 16) * ldc + col0;
#pragma unroll
                for (int bj = 0; bj < 2; ++bj)
#pragma unroll
                    for (int n = 0; n < 2; ++n) { const f32x4 v = acc[ai][bj][m][n]; const f32x2 a = gelu_pk((f32x2){v[0], v[1]}), b = gelu_pk((f32x2){v[2], v[3]});
                        const f32x4 gl = (f32x4){a.x, a.y, b.x, b.y}; *(f32x4*)(rowp + bj * HALF + n * 16) = gl; s1[bj][n] += gl; s2[bj][n] += gl * gl; } }
#pragma unroll
        for (int bj = 0; bj < 2; ++bj)
#pragma unroll
            for (int n = 0; n < 2; ++n)
#pragma unroll
                for (int j = 0; j < 4; ++j) { float a = s1[bj][n][j], b = s2[bj][n][j];
#pragma unroll
                    for (int o = 1; o < 16; o <<= 1) { a += __shfl_xor(a, o); b += __shfl_xor(b, o); }
                    s1[bj][n][j] = a; s2[bj][n][j] = b; }
        if (fr == 0) {
            f32x2* dst = VST + (size_t)(u.pm * 2 + wr) * ntok + col0;
#pragma unroll
            for (int bj = 0; bj < 2; ++bj)
#pragma unroll
                for (int n = 0; n < 2; ++n)
#pragma unroll
                    for (int j = 0; j < 4; ++j) dst[bj * HALF + n * 16 + j] = (f32x2){s1[bj][n][j], s2[bj][n][j]};
        }
    }
};
struct MoeOrder {
    int nPM, nPN, G, vcu;
    __device__ __forceinline__ bool next(int i, Unit& u) const {
        const int L = i * G + vcu; if (L >= 16 * nPM * nPN) return false;
        const int pm = L % nPM, r = L / nPM, pn = r % nPN, e = r / nPN; u.pm = e * 9 + pm; u.pn = e * nPN + pn; return true;
    }
    __device__ __forceinline__ void a_ready(const Unit&) const {}
    __device__ __forceinline__ void done(const Unit&) const {}
};

template <class Epi, class Sched, bool ALIGN_EPI = false, bool GATHER = false>
__device__ __forceinline__ void gemm_phase(PG8_LAS unsigned char* lds, const Gemm g, const Sched& S, const Epi& E) {
    int tid_ = threadIdx.x; asm volatile("" : "+v"(tid_));
    const int tid = tid_, wid = __builtin_amdgcn_readfirstlane(tid >> 6), lane = tid & 63, wr = wid >> 2, wc = wid & 3, fr = lane & 15, fq = lane >> 4;
    const int K = g.K, nt = K / BK;
    unsigned voffA[2], voffB[2];
#pragma unroll
    for (int i = 0; i < 2; ++i) { int R, C; stage_rc(tid * 16 + i * 8192, R, C); const int Rb = Epi::PERM ? ((R & ~31) + perm32(R & 31)) : R;
        voffA[i] = (unsigned)(R * K + C) * 2u; voffB[i] = (unsigned)(Rb * K + C) * 2u; }
    const size_t kstep = (size_t)(BK * 2);
    const size_t hstep = (size_t)HALF * K * 2;
    const size_t tstep = 2 * hstep;
    const unsigned ldsw = (unsigned)wid * 1024u;
    const int aoff = lds_byte(wr * 64 + fr, fq * 8), boff = lds_byte(wc * 32 + fr, fq * 8);
#define PG8_SA(b, h) (((b) * 2 + (h)) * HTB)
#define PG8_SB(b, h) ((4 + (b) * 2 + (h)) * HTB)
#define PG8_STAGE(bufoff, gbase, voff) do { _Pragma("unroll") for (int _i = 0; _i < 2; ++_i) \
        __builtin_amdgcn_global_load_lds((const unsigned*)((const char*)(gbase) + (voff)[_i]), (PG8_LAS unsigned*)(lds + (bufoff) + ldsw + _i * 8192), 16, 0, 0); } while (0)
#define PG8_STGA(b, h, ubase, koff, gofs) do { if constexpr (GATHER) { PG8_STAGE(PG8_SA(b, h), (const char*)g.A + (koff), gofs[h]); } \
        else { PG8_STAGE(PG8_SA(b, h), (ubase) + (koff) + (size_t)(h) * hstep, voffA); } } while (0)
#define PG8_GLOAD(dst, u) do { if constexpr (GATHER) { _Pragma("unroll") for (int _i = 0; _i < 2; ++_i) { int _R, _C; stage_rc(tid * 16 + _i * 8192, _R, _C); \
        _Pragma("unroll") for (int _h = 0; _h < 2; ++_h) dst[_h][_i] = (unsigned)g.rows[(u).pm * BM + _h * HALF + _R] * (unsigned)(K * 2) + (unsigned)_C * 2u; } } } while (0)
#define PG8_LDA(dst, b, h) do { _Pragma("unroll") for (int m = 0; m < 4; ++m) _Pragma("unroll") for (int k = 0; k < 2; ++k) dst[m][k] = *(const PG8_LAS bf16x8*)(lds + PG8_SA(b, h) + aoff + m * 2048 + k * 1024); } while (0)
#define PG8_LDB(dst, b, h) do { _Pragma("unroll") for (int n = 0; n < 2; ++n) _Pragma("unroll") for (int k = 0; k < 2; ++k) dst[n][k] = *(const PG8_LAS bf16x8*)(lds + PG8_SB(b, h) + boff + n * 2048 + k * 1024); } while (0)
#define PG8_MMA(ai, bj, At, Bt) do { __builtin_amdgcn_s_setprio(1); _Pragma("unroll") for (int m = 0; m < 4; ++m) _Pragma("unroll") for (int n = 0; n < 2; ++n) _Pragma("unroll") for (int k = 0; k < 2; ++k) \
        acc[ai][bj][m][n] = __builtin_amdgcn_mfma_f32_16x16x32_bf16(Bt[n][k], At[m][k], acc[ai][bj][m][n], 0, 0, 0); __builtin_amdgcn_s_setprio(0); } while (0)
#define PG8_WAIT_V(n) asm volatile("s_waitcnt vmcnt(" #n ")" ::: "memory")
#define PG8_WAIT_L(n) asm volatile("s_waitcnt lgkmcnt(" #n ")" ::: "memory")
#define PG8_BAR __builtin_amdgcn_s_barrier()
#define PG8_SCHED __builtin_amdgcn_sched_barrier(0)
    Unit cur, nxt; int ui = 0;
    if (!S.next(0, cur)) return;
    f32x4 acc[2][2][4][2];
#pragma unroll
    for (int a = 0; a < 2; ++a)
#pragma unroll
        for (int b = 0; b < 2; ++b)
#pragma unroll
            for (int m = 0; m < 4; ++m)
#pragma unroll
                for (int n = 0; n < 2; ++n) acc[a][b][m][n] = (f32x4){0.f, 0.f, 0.f, 0.f};
    bf16x8 At[4][2], B0[2][2], B1[2][2];
    unsigned gc[2][2] = {{0u, 0u}, {0u, 0u}}, gn[2][2] = {{0u, 0u}, {0u, 0u}};
    const char* cA = GATHER ? (const char*)g.A : (const char*)g.A + (size_t)cur.pm * tstep; const char* cB = (const char*)g.Bt + (size_t)cur.pn * tstep;
    S.a_ready(cur);
    PG8_GLOAD(gc, cur);
    PG8_STAGE(PG8_SB(0, 0), cB, voffB); PG8_STAGE(PG8_SB(0, 1), cB + hstep, voffB); PG8_STGA(0, 0, cA, 0, gc); PG8_STGA(0, 1, cA, 0, gc);
    if (wr == 1) PG8_BAR;
    PG8_WAIT_V(2); PG8_BAR;
    PG8_STAGE(PG8_SB(1, 0), cB + kstep, voffB); PG8_STGA(1, 0, cA, kstep, gc); PG8_STAGE(PG8_SB(1, 1), cB + hstep + kstep, voffB);
    PG8_WAIT_V(6); PG8_BAR;
    for (;;) {
        const bool has_next = S.next(ui + 1, nxt);
        const char* nA = GATHER ? (const char*)g.A : (has_next ? (const char*)g.A + (size_t)nxt.pm * tstep : cA); const char* nB = has_next ? (const char*)g.Bt + (size_t)nxt.pn * tstep : cB;
        for (int t = 0; t < nt; t += 2) {
            const bool last = (t == nt - 2);
            const size_t k1 = (size_t)(t + 1) * kstep;
            const char* b2 = last ? nB : cB + (size_t)(t + 2) * kstep; const char* b3 = b2 + kstep;
            if (last && has_next) S.a_ready(nxt);
            if (last) { if (has_next) { PG8_GLOAD(gn, nxt); } else {
#pragma unroll
                    for (int h = 0; h < 2; ++h)
#pragma unroll
                        for (int i = 0; i < 2; ++i) gn[h][i] = gc[h][i]; } }
            PG8_LDB(B0, 0, 0); PG8_LDB(B1, 0, 1); PG8_SCHED; PG8_LDA(At, 0, 0); PG8_STGA(1, 1, cA, k1, gc);
            PG8_WAIT_V(8); PG8_WAIT_L(0); PG8_BAR; PG8_MMA(0, 0, At, B0); PG8_MMA(0, 1, At, B1); PG8_BAR; PG8_SCHED;
            PG8_LDA(At, 0, 1); PG8_STAGE(PG8_SB(0, 0), b2, voffB); PG8_STAGE(PG8_SB(0, 1), b2 + hstep, voffB);
            if (last) { PG8_STGA(0, 0, nA, 0, gn); } else { PG8_STGA(0, 0, cA, (size_t)(t + 2) * kstep, gc); }
            PG8_WAIT_V(8); PG8_WAIT_L(0); PG8_BAR; PG8_MMA(1, 0, At, B0); PG8_MMA(1, 1, At, B1); PG8_BAR; PG8_SCHED;
            PG8_LDB(B0, 1, 0); PG8_LDB(B1, 1, 1); PG8_SCHED; PG8_LDA(At, 1, 0);
            if (last) { PG8_STGA(0, 1, nA, 0, gn); } else { PG8_STGA(0, 1, cA, (size_t)(t + 2) * kstep, gc); }
            PG8_WAIT_V(8); PG8_WAIT_L(0); PG8_BAR; PG8_MMA(0, 0, At, B0); PG8_MMA(0, 1, At, B1); PG8_BAR; PG8_SCHED;
            PG8_LDA(At, 1, 1); PG8_STAGE(PG8_SB(1, 0), b3, voffB); PG8_STAGE(PG8_SB(1, 1), b3 + hstep, voffB);
            if (last) { PG8_STGA(1, 0, nA, kstep, gn); } else { PG8_STGA(1, 0, cA, (size_t)(t + 3) * kstep, gc); }
            PG8_WAIT_V(8); PG8_WAIT_L(0); PG8_BAR; PG8_MMA(1, 0, At, B0); PG8_MMA(1, 1, At, B1); PG8_BAR; PG8_SCHED;
        }
        if constexpr (ALIGN_EPI) { if (wr == 0) PG8_BAR; }
        if constexpr (!Epi::AFTER_DRAIN) { E(acc, cur, wr, wc, fr, fq); S.done(cur); }
        if (!has_next) break;
#pragma unroll
        for (int a = 0; a < 2; ++a)
#pragma unroll
            for (int b = 0; b < 2; ++b)
#pragma unroll
                for (int m = 0; m < 4; ++m)
#pragma unroll
                    for (int n = 0; n < 2; ++n) acc[a][b][m][n] = (f32x4){0.f, 0.f, 0.f, 0.f};
        cur = nxt; cA = nA; cB = nB; ++ui;
#pragma unroll
        for (int h = 0; h < 2; ++h)
#pragma unroll
            for (int i = 0; i < 2; ++i) gc[h][i] = gn[h][i];
        if constexpr (ALIGN_EPI) { if (wr == 1) PG8_BAR; }
    }
    PG8_WAIT_V(0);
    if constexpr (!ALIGN_EPI) { if (wr == 0) PG8_BAR; }
    PG8_BAR;
    if constexpr (Epi::AFTER_DRAIN) { E.fused(acc, cur, wr, wc, fr, fq, lds, wid, lane); S.done(cur); }
#undef PG8_SA
#undef PG8_SB
#undef PG8_STAGE
#undef PG8_STGA
#undef PG8_GLOAD
#undef PG8_LDA
#undef PG8_LDB
#undef PG8_MMA
#undef PG8_WAIT_V
#undef PG8_WAIT_L
#undef PG8_BAR
#undef PG8_SCHED
}
}
constexpr int NB = 4, SEQ = 4096, T = NB * SEQ, LC = 256, TC = NB * LC, TA = T + TC, D = 1024;
constexpr int NE = 16, FF = 2048, ESTR = 2304;
constexpr int LK = LC + SEQ, KVP = 256;
constexpr float ALPHA = 1.6817928305074290f;
constexpr float LN_EPS = 1e-5f, RMS_EPS = 1e-6f;
constexpr float ATT_C2 = 0.125f * 1.4426950408889634f;
constexpr int NWAVES = 8, NTHR = 512;
constexpr size_t MiB = 1u << 20;
constexpr size_t WS_CTL = 0, WS_MOD = 1 * MiB, WS_MODP = 2 * MiB, WS_TW = 6 * MiB;
constexpr size_t WS_WHYIN = 8 * MiB, WS_WHYOUT = 20 * MiB, WS_WQKV = 24 * MiB, WS_WATO = 27 * MiB, WS_WCMIN = 29 * MiB, WS_WCMOUT = 37 * MiB, WS_WCMS = 41 * MiB;
constexpr size_t WS_WGU = 42 * MiB, WS_WDN = 554 * MiB, WS_HF = 810 * MiB;
constexpr size_t WS_XL = 942 * MiB, WS_U = 1010 * MiB, WS_HB = 1078 * MiB, WS_AFF = 1112 * MiB, WS_ROWS = 1114 * MiB, WS_GATE = WS_ROWS + 256 * 1024, WS_INV = 1115 * MiB;
constexpr size_t WS_ACT = 1117 * MiB, WS_Y = 1261 * MiB, WS_SCR = 1405 * MiB, WS_XC = 1677 * MiB, WS_END = 1745 * MiB;
constexpr size_t WS_XG = WS_Y;
constexpr size_t SC_PT = WS_SCR, SC_Z2T = WS_SCR + 204 * MiB, SC_Z2 = WS_SCR + 238 * MiB;
constexpr size_t SC_QKV = WS_SCR, SC_Q = WS_SCR + 102 * MiB, SC_K = WS_SCR + 134 * MiB, SC_V = WS_SCR + 143 * MiB, SC_O = WS_SCR + 152 * MiB;
constexpr size_t SC_UB = WS_SCR, SC_VT = WS_SCR + 64 * MiB, SC_VST = WS_SCR + 192 * MiB, SC_UV = WS_SCR + 194 * MiB;
constexpr size_t HF_SLOT = (size_t)4 * 1024 * 4096 * 4, HF_CTX = 2 * HF_SLOT;
constexpr int LDS_BYTES = 147456;
constexpr int RING_BYTES = 131072, MISC_OFF = LDS_BYTES - 256;

#define GAS __attribute__((address_space(1)))
#define LAS __attribute__((address_space(3)))
typedef unsigned short bf16;
typedef unsigned v4u __attribute__((ext_vector_type(4)));
typedef unsigned v2u __attribute__((ext_vector_type(2)));
typedef float f32x4 __attribute__((ext_vector_type(4)));
typedef float f32x2 __attribute__((ext_vector_type(2)));
#define LDS_WAIT() asm volatile("s_waitcnt lgkmcnt(0)" ::: "memory")
__device__ __forceinline__ unsigned f2bf(float f) { unsigned u = __builtin_bit_cast(unsigned, f); return (u + 0x7fffu + ((u >> 16) & 1u)) >> 16; }
__device__ __forceinline__ unsigned pk2(float lo, float hi) { return f2bf(lo) | (f2bf(hi) << 16); }
__device__ __forceinline__ float bf2f(unsigned short b) { return __builtin_bit_cast(float, (unsigned)b << 16); }
__device__ __forceinline__ float wave_sum(float v) {
#pragma unroll
    for (int o = 1; o < 64; o <<= 1) v += __shfl_xor(v, o);
    return v;
}

#define XB_TMO      128
#define XB_XCNT(j)  (256  + 64 * (j))
#define XB_XSUB(j)  (1280 + 64 * (j))
#define XB_XGEN(j)  (2304 + 64 * (j))
#define XB_TOP      3328
#define XB_TOPGEN   3392
#define XCD_BAR_WORDS 3456
#define XB_SPIN_CAP (1u << 18)
__device__ __forceinline__ unsigned xb_ld(unsigned* p)              { return __hip_atomic_load(p, __ATOMIC_RELAXED, __HIP_MEMORY_SCOPE_AGENT); }
__device__ __forceinline__ unsigned xb_add(unsigned* p, unsigned v) { return __hip_atomic_fetch_add(p, v, __ATOMIC_RELAXED, __HIP_MEMORY_SCOPE_AGENT); }
__device__ __forceinline__ unsigned xb_xcc_id() { return (unsigned)__builtin_amdgcn_s_getreg((3 << 11) | 20) & 0xFu; }
#define XB_SPIN(cond, bar) do { unsigned _sp = 0; while (cond) { __builtin_amdgcn_s_sleep(1); \
    if ((++_sp & 255u) == 0u) { if (xb_ld(&(bar)[XB_TMO])) break; if (_sp > XB_SPIN_CAP) { atomicAdd(&(bar)[XB_TMO], 1u); break; } } } } while (0)
struct XcdBarrier { unsigned* bar; unsigned x; volatile LAS unsigned* st; };
__device__ __forceinline__ XcdBarrier xcd_barrier_post(unsigned* bar, volatile LAS unsigned* st) {
    XcdBarrier b; b.bar = bar; b.x = xb_xcc_id(); b.st = st;
    if (threadIdx.x == 0) (void)xb_add(&bar[XB_XCNT(b.x)], 1u);
    return b;
}
__device__ __forceinline__ void xcd_barrier_complete(unsigned* bar, unsigned x, unsigned& nloc, unsigned& nx) {
    const unsigned G = gridDim.x * gridDim.y * gridDim.z;
    unsigned sum, cnt, mine, sp = 0u;
    for (;;) {
        sum = 0u; cnt = 0u; mine = 0u;
#pragma unroll
        for (unsigned j = 0; j < 16; ++j) { const unsigned c = xb_ld(&bar[XB_XCNT(j)]); sum += c; cnt += (c > 0u) ? 1u : 0u; mine = (j == x) ? c : mine; }
        if (sum == G) break;
        __builtin_amdgcn_s_sleep(1);
        if ((++sp & 255u) == 0u) { if (xb_ld(&bar[XB_TMO])) break; if (sp > XB_SPIN_CAP) { atomicAdd(&bar[XB_TMO], 1u); break; } }
    }
    nloc = mine > 0u ? mine : 1u; nx = cnt > 0u ? cnt : 1u;
}
__device__ __forceinline__ void xcd_barrier(const XcdBarrier& b) {
    asm volatile("s_waitcnt vmcnt(0)" ::: "memory");
    __syncthreads();
    if (threadIdx.x == 0) {
        unsigned* bar = b.bar; asm volatile("" : "+s"(bar));
        __builtin_amdgcn_s_waitcnt(0);
        unsigned bx_ = b.x; asm volatile("" : "+s"(bx_));
        unsigned nloc = b.st[0], nx = b.st[1];
        if (nloc == 0u) { xcd_barrier_complete(bar, bx_, nloc, nx); b.st[0] = nloc; b.st[1] = nx; }
        const unsigned old = xb_add(&bar[XB_XSUB(bx_)], 1u);
        const unsigned gen = old / nloc;
        if (old + 1u == (gen + 1u) * nloc) {
            __builtin_amdgcn_fence(__ATOMIC_RELEASE, "agent");
            asm volatile("s_waitcnt vmcnt(0)" ::: "memory");
            const unsigned og = xb_add(&bar[XB_TOP], 1u);
            const unsigned tg = og / nx;
            if (og + 1u == (tg + 1u) * nx) xb_add(&bar[XB_TOPGEN], 1u);
            else XB_SPIN(xb_ld(&bar[XB_TOPGEN]) == tg, bar);
            __builtin_amdgcn_fence(__ATOMIC_ACQUIRE, "agent");
            xb_add(&bar[XB_XGEN(bx_)], 1u);
            asm volatile("s_waitcnt vmcnt(0)" ::: "memory");
        } else {
            XB_SPIN(xb_ld(&bar[XB_XGEN(bx_)]) == gen, bar);
            __builtin_amdgcn_fence(__ATOMIC_ACQUIRE, "agent");
            asm volatile("s_waitcnt vmcnt(0)" ::: "memory");
        }
    }
    __syncthreads();
}

struct Args { const float* in[33]; float* out; unsigned char* ws; int ph_lo, ph_hi; };
enum { I_X = 0, I_C, I_CTX, I_CCTX, I_MODW, I_MODB, I_LNG, I_LNB, I_HYWIN, I_HYCW, I_HYCB, I_FW1, I_FB1, I_FW2, I_FB2, I_FW3, I_FFREQ, I_FBIAS, I_HYWOUT,
       I_WQKV, I_QGAIN, I_KGAIN, I_WATO, I_CMWIN, I_CMLNG, I_CMLNB, I_CMWS, I_CMBS, I_CMWOUT, I_ROUTER, I_WGATE, I_WUP, I_WDOWN };
typedef const __attribute__((address_space(4))) Args* ArgsP;
__device__ __forceinline__ ArgsP get_args() { auto p = __builtin_amdgcn_kernarg_segment_ptr(); asm volatile("" : "+s"(p)); return (ArgsP)p; }
struct Fr { LAS unsigned char* lds; int tid, lane, wave, vcu, G, bx; };
__device__ __forceinline__ Fr mkfr(unsigned char* lds_raw) {
    Fr F; int tid = threadIdx.x; asm volatile("" : "+v"(tid)); int bx = blockIdx.x, G = gridDim.x; asm volatile("" : "+s"(bx), "+s"(G));
    F.lds = (LAS unsigned char*)lds_raw; F.tid = tid; F.lane = tid & 63; F.wave = __builtin_amdgcn_readfirstlane(tid >> 6);
    F.G = G; F.bx = bx; F.vcu = (G % 8 == 0) ? (bx % 8) * (G / 8) + bx / 8 : bx; return F; }
__device__ __forceinline__ void proA_adaln_item(ArgsP a, const Fr& F, int it) {
    LAS float* sc = (LAS float*)F.lds;
    const int i = it / 96, ks = (it / 12) % 8, cc = it % 12;
    __syncthreads();
    for (int u = F.tid; u < 5 * 128; u += NTHR) { const int r = u / 128, k = ks * 128 + (u % 128);
        const float x = r < 4 ? a->in[I_C][r * D + k] : a->in[I_CCTX][k]; sc[u] = x / (1.0f + expf(-x)); }
    __syncthreads();
    const int col = cc * 512 + F.tid;
    const float* w = a->in[I_MODW] + ((size_t)i * D + (size_t)ks * 128) * 6144 + col;
    float acc[5] = {0.f, 0.f, 0.f, 0.f, 0.f};
#pragma unroll 8
    for (int k = 0; k < 128; ++k) { const float wv = w[(size_t)k * 6144];
#pragma unroll
        for (int r = 0; r < 5; ++r) acc[r] += sc[r * 128 + k] * wv; }
    float* mp = (float*)(a->ws + WS_MODP) + (size_t)((i * 8 + ks) * 5) * 6144 + col;
#pragma unroll
    for (int r = 0; r < 5; ++r) mp[(size_t)r * 6144] = acc[r];
}
__device__ __forceinline__ void proA_filter_item(ArgsP a, const Fr& F, int it) {
    int slot, L, t0; float* HF;
    if (it < 512) { slot = it >> 8; L = SEQ; t0 = (it & 255) * 16; HF = (float*)(a->ws + WS_HF + (size_t)slot * HF_SLOT); }
    else { slot = 0; L = LC; t0 = (it - 512) * 16; HF = (float*)(a->ws + WS_HF + HF_CTX); }
    LAS float* z = (LAS float*)F.lds;
    LAS float* h1 = z + 16 * 33;
    LAS float* h2 = h1 + 16 * 64;
    __syncthreads();
    for (int u = F.tid; u < 16 * 33; u += NTHR) { const int tt = u / 33, j = u % 33; const float tf = (float)(t0 + tt);
        float v;
        if (j == 0) v = tf / (float)(L - 1);
        else { const int jj = (j - 1) & 15; const float f = 1e-4f + (float)jj * ((15.0f - 1e-4f) / 15.0f); const float w = (float)(6.283185307179586 / (double)L) * tf;
            v = j <= 16 ? cosf(f * w) : -sinf(f * w); }
        z[u] = v; }
    __syncthreads();
    const float* w1 = a->in[I_FW1] + (size_t)slot * 33 * 64; const float* b1 = a->in[I_FB1] + slot * 64;
    const float* w2 = a->in[I_FW2] + (size_t)slot * 64 * 64; const float* b2 = a->in[I_FB2] + slot * 64;
    const float* fq = a->in[I_FFREQ] + slot * 128;
    for (int u = F.tid; u < 16 * 64; u += NTHR) { const int tt = u >> 6, j = u & 63; float s = b1[j];
        for (int i = 0; i < 33; ++i) s += z[tt * 33 + i] * w1[i * 64 + j];
        h1[u] = sinf(fq[j] * s); }
    __syncthreads();
    for (int u = F.tid; u < 16 * 64; u += NTHR) { const int tt = u >> 6, j = u & 63; float s = b2[j];
        for (int i = 0; i < 64; ++i) s += h1[tt * 64 + i] * w2[i * 64 + j];
        h2[u] = sinf(fq[64 + j] * s); }
    __syncthreads();
    const float* w3 = a->in[I_FW3] + (size_t)slot * 64 * 4096;
    const float dmin = -3.0701134573253940f, dmax = -15.350567286626973f;
    for (int cb = 0; cb < 8; ++cb) { const int col = cb * 512 + F.tid;
        float acc[16];
#pragma unroll
        for (int tt = 0; tt < 16; ++tt) acc[tt] = 0.f;
        for (int k4 = 0; k4 < 16; ++k4) { const float wa = w3[(size_t)(4 * k4) * 4096 + col], wb = w3[(size_t)(4 * k4 + 1) * 4096 + col], wc = w3[(size_t)(4 * k4 + 2) * 4096 + col], wd = w3[(size_t)(4 * k4 + 3) * 4096 + col];
#pragma unroll
            for (int tt = 0; tt < 16; ++tt) { const f32x4 hv = *(const LAS f32x4*)(h2 + tt * 64 + 4 * k4); acc[tt] += (hv[0] * wa + hv[1] * wb) + (hv[2] * wc + hv[3] * wd); } }
        const int d = col & 1023; const float delta = fabsf(dmin + (float)d * ((dmax - dmin) / 1023.0f));
        float* dst = HF + (size_t)col * L + t0;
#pragma unroll
        for (int q = 0; q < 4; ++q) { f32x4 o;
#pragma unroll
            for (int j = 0; j < 4; ++j) { const int tt = q * 4 + j; const float tl = (float)(t0 + tt) / (float)(L - 1); o[j] = acc[tt] * expf(-tl * delta); }
            *(f32x4*)(dst + q * 4) = o; } }
}
__device__ __forceinline__ void conv_tile(const float* W, int K, int N, int k0, int n0, bf16* WT, int drow0, LAS float* scr, int lane) {
    float rv[64];
#pragma unroll
    for (int i = 0; i < 64; ++i) rv[i] = W[(size_t)(k0 + i) * N + n0 + lane];
#pragma unroll
    for (int i = 0; i < 64; ++i) scr[i * 65 + lane] = rv[i];
    LDS_WAIT(); asm volatile("" ::: "memory");
    const int c = lane & 7;
#pragma unroll
    for (int j = 0; j < 8; ++j) { const int n = (lane >> 3) + 8 * j; const LAS float* s = scr + (8 * c) * 65 + n;
        v4u o; o.x = pk2(s[0 * 65], s[1 * 65]); o.y = pk2(s[2 * 65], s[3 * 65]); o.z = pk2(s[4 * 65], s[5 * 65]); o.w = pk2(s[6 * 65], s[7 * 65]);
        *(v4u*)(WT + (size_t)(drow0 + n) * K + k0 + 8 * c) = o; }
    LDS_WAIT(); asm volatile("" ::: "memory");
}
constexpr int CV_SMALL = 768 * 2 + 256 * 2 + 384 + 256 + 1024 + 512;
constexpr int CV_MOE = 4 * 16 * 3 * 512;
__device__ __forceinline__ void proA_conv_item(ArgsP a, int it, LAS float* scr, int lane) {
    unsigned char* ws = a->ws;
    if (it < CV_SMALL) {
        int r = it;
        if (r < 1536) { const int s = r / 768, q = r % 768, kb = q / 48, nb = q % 48;
            conv_tile(a->in[I_HYWIN] + (size_t)s * 1024 * 3072, 1024, 3072, kb * 64, nb * 64, (bf16*)(ws + WS_WHYIN) + (size_t)s * 3072 * 1024, nb * 64, scr, lane); return; } r -= 1536;
        if (r < 512) { const int s = r / 256, q = r % 256, kb = q / 16, nb = q % 16;
            conv_tile(a->in[I_HYWOUT] + (size_t)s * 1024 * 1024, 1024, 1024, kb * 64, nb * 64, (bf16*)(ws + WS_WHYOUT) + (size_t)s * 1024 * 1024, nb * 64, scr, lane); return; } r -= 512;
        if (r < 384) { const int kb = r / 24, nb = r % 24;
            conv_tile(a->in[I_WQKV], 1024, 1536, kb * 64, nb * 64, (bf16*)(ws + WS_WQKV), nb * 64, scr, lane); return; } r -= 384;
        if (r < 256) { const int kb = r / 16, nb = r % 16;
            conv_tile(a->in[I_WATO], 1024, 1024, kb * 64, nb * 64, (bf16*)(ws + WS_WATO), nb * 64, scr, lane); return; } r -= 256;
        if (r < 1024) { const int kb = r / 64, nb = r % 64;
            conv_tile(a->in[I_CMWIN], 1024, 4096, kb * 64, nb * 64, (bf16*)(ws + WS_WCMIN), nb * 64, scr, lane); return; } r -= 1024;
        { const int kb = r / 16, nb = r % 16;
            conv_tile(a->in[I_CMWOUT], 2048, 1024, kb * 64, nb * 64, (bf16*)(ws + WS_WCMOUT), nb * 64, scr, lane); return; }
    }
    const int r = it - CV_SMALL, mat = r / 512, q = r % 512, le = mat / 3, which = mat % 3;
    if (which < 2) { const int kb = q / 32, nb = q % 32, n0 = nb * 64;
        const float* src = a->in[which == 0 ? I_WGATE : I_WUP] + (size_t)le * 1024 * 2048;
        conv_tile(src, 1024, 2048, kb * 64, n0, (bf16*)(ws + WS_WGU) + (size_t)le * 4096 * 1024, (n0 >> 7) * 256 + (n0 & 127) + which * 128, scr, lane); }
    else { const int kb = q / 16, nb = q % 16;
        conv_tile(a->in[I_WDOWN] + (size_t)le * 2048 * 1024, 2048, 1024, kb * 64, nb * 64, (bf16*)(ws + WS_WDN) + (size_t)le * 1024 * 2048, nb * 64, scr, lane); }
}
__device__ __forceinline__ void phase_proA(ArgsP a, const Fr& F) {
    for (int it = F.vcu; it < 384 + 528; it += F.G) { if (it < 384) proA_adaln_item(a, F, it); else proA_filter_item(a, F, it - 384); }
    __syncthreads();
    const int gt = F.vcu * NTHR + F.tid, NGT = F.G * NTHR;
    for (int k = gt; k < 8192; k += NGT) { float s, c; sincospif((float)k * (1.0f / 4096.0f), &s, &c); ((f32x2*)(a->ws + WS_TW))[k] = (f32x2){c, s}; }
    for (int k = gt; k < 16 * 128 * 128; k += NGT) ((bf16*)(a->ws + WS_WCMS))[k] = (bf16)f2bf(a->in[I_CMWS][k]);
    LAS float* scr = (LAS float*)(F.lds + F.wave * 16640);
    const int gw = F.vcu * NWAVES + F.wave, NGW = F.G * NWAVES;
    for (int it = gw; it < CV_SMALL + CV_MOE; it += NGW) proA_conv_item(a, it, scr, F.lane);
}
__device__ __forceinline__ void phase_proB(ArgsP a, const Fr& F) {
    LAS float* m0 = (LAS float*)F.lds;
    const float* mp = (const float*)(a->ws + WS_MODP);
    for (int u = F.tid; u < 5 * 2048; u += NTHR) { const int r = u / 2048, c = u % 2048; float s = a->in[I_MODB][c];
        for (int ks = 0; ks < 8; ++ks) s += mp[(size_t)(ks * 5 + r) * 6144 + c];
        m0[u] = s; }
    __syncthreads();
    const int gw = F.vcu * NWAVES + F.wave, NGW = F.G * NWAVES;
    for (int row = gw; row < TA; row += NGW) {
        const int r = row < T ? (row >> 12) : 4;
        const float* src = row < T ? a->in[I_X] + (size_t)row * D : a->in[I_CTX] + (size_t)(row - T) * D;
        float* xl = (float*)(a->ws + WS_XC) + (size_t)row * D; bf16* hb = (bf16*)(a->ws + WS_HB) + (size_t)row * D;
#pragma unroll
        for (int j = 0; j < 4; ++j) { const int c = 4 * F.lane + 256 * j; const f32x4 v = *(const f32x4*)(src + c); *(f32x4*)(xl + c) = v;
            const f32x4 sh = *(const LAS f32x4*)(m0 + r * 2048 + c), sc = *(const LAS f32x4*)(m0 + r * 2048 + 1024 + c);
            const f32x4 h = v * (sc + 1.0f) + sh; v2u o; o.x = pk2(h[0], h[1]); o.y = pk2(h[2], h[3]); *(v2u*)(hb + c) = o; }
    }
    const int gt = F.vcu * NTHR + F.tid, NGT = F.G * NTHR;
    float* mod = (float*)(a->ws + WS_MOD);
    for (int u = gt; u < 4 * 5 * 6144; u += NGT) { const int i = u / 30720, r = (u / 6144) % 5, c = u % 6144; float s = a->in[I_MODB][i * 6144 + c];
        for (int ks = 0; ks < 8; ++ks) s += mp[(size_t)((i * 8 + ks) * 5 + r) * 6144 + c];
        mod[u] = s; }
}
template <int L>
__device__ __forceinline__ float sconv(const bf16* p, int t, float w0, float w1, float w2, float cb) {
    const float a = t > 0 ? bf2f(p[t - 1]) : 0.f, b = bf2f(p[t]), c = t < L - 1 ? bf2f(p[t + 1]) : 0.f; return w0 * a + w1 * b + w2 * c + cb;
}
template <int L>
__device__ __forceinline__ void hy_direct_item(ArgsP a, const Fr& F, int slot, int d, int tok0, const float* HF) {
    LAS float* kk = (LAS float*)F.lds;
    LAS float* vb = kk + 4 * L;
    LAS float* red = vb + 4 * L;
    const bf16* PT = (const bf16*)(a->ws + SC_PT);
    bf16* Z2T = (bf16*)(a->ws + SC_Z2T);
    __syncthreads();
    for (int o = 0; o < 2; ++o) {
        const float* fw = HF + (size_t)((o * 2 + 0) * 1024 + d) * L; const float* bw = HF + (size_t)((o * 2 + 1) * 1024 + d) * L;
        float s = 0.f;
        for (int t = F.tid; t < L; t += NTHR) { const float f = fw[t], b = bw[t]; kk[o * 2 * L + (L - 1) + t] = f; if (t >= 1) kk[o * 2 * L + (L - 1) - t] = b; s += fabsf(f) + (t >= 1 ? fabsf(b) : 0.f); }
        s = wave_sum(s); if (F.lane == 0) red[o * 8 + F.wave] = s;
    }
    __syncthreads();
    float nrm[2];
#pragma unroll
    for (int o = 0; o < 2; ++o) { float s = 0.f; for (int w = 0; w < 8; ++w) s += red[o * 8 + w]; nrm[o] = 1.0f / (s + 1e-6f); }
    const float* cw = a->in[I_HYCW] + (size_t)slot * 3 * 3072; const float* cbp = a->in[I_HYCB] + (size_t)slot * 3072;
    float w0[3], w1[3], w2[3], cb[3];
#pragma unroll
    for (int g = 0; g < 3; ++g) { const int c = g * 1024 + d; w0[g] = cw[c]; w1[g] = cw[3072 + c]; w2[g] = cw[2 * 3072 + c]; cb[g] = cbp[c]; }
    const float fb0 = a->in[I_FBIAS][(slot * 2 + 0) * 1024 + d], fb1 = a->in[I_FBIAS][(slot * 2 + 1) * 1024 + d];
    for (int u = F.tid; u < 4 * L; u += NTHR) { const int b = u / L, t = u % L; vb[u] = sconv<L>(PT + (size_t)d * TA + tok0 + b * L, t, w0[0], w1[0], w2[0], cb[0]); }
    __syncthreads();
    constexpr int NBLK = 4 * L / 8, PER = (NBLK + NTHR - 1) / NTHR;
    float res[PER][8];
#pragma unroll 1
    for (int o = 0; o < 2; ++o) {
        const LAS float* ko = kk + o * 2 * L;
#pragma unroll
        for (int pi = 0; pi < PER; ++pi) {
            const int q = F.tid + pi * NTHR;
            float acc[8];
#pragma unroll
            for (int j = 0; j < 8; ++j) acc[j] = 0.f;
            if (q < NBLK) {
                const int b = q / (L / 8), t0 = (q % (L / 8)) * 8;
                const LAS float* vv = vb + b * L;
#pragma unroll 1
                for (int s8 = 0; s8 < L; s8 += 8) {
                    const LAS float* kw = ko + (t0 - s8 - 7 + L - 1);
                    float w[15], x[8];
#pragma unroll
                    for (int i = 0; i < 15; ++i) w[i] = kw[i];
#pragma unroll
                    for (int i = 0; i < 8; ++i) x[i] = vv[s8 + i];
#pragma unroll
                    for (int j = 0; j < 8; ++j)
#pragma unroll
                        for (int i = 0; i < 8; ++i) acc[j] += w[j - i + 7] * x[i];
                }
            }
#pragma unroll
            for (int j = 0; j < 8; ++j) res[pi][j] = acc[j];
        }
        __syncthreads();
#pragma unroll
        for (int pi = 0; pi < PER; ++pi) {
            const int q = F.tid + pi * NTHR;
            if (q < NBLK) {
                const int b = q / (L / 8), t0 = (q % (L / 8)) * 8;
                const bf16* pg = PT + (size_t)((o + 1) * 1024 + d) * TA + tok0 + b * L;
#pragma unroll
                for (int j = 0; j < 8; ++j) { const int t = t0 + j; const float vin = vb[b * L + t];
                    const float y = res[pi][j] * nrm[o] + vin * (o == 0 ? fb0 : fb1);
                    const float xg = sconv<L>(pg, t, w0[o + 1], w1[o + 1], w2[o + 1], cb[o + 1]);
                    res[pi][j] = xg * y; }
            }
        }
        __syncthreads();
        if (o == 0) {
#pragma unroll
            for (int pi = 0; pi < PER; ++pi) { const int q = F.tid + pi * NTHR;
                if (q < NBLK) { const int b = q / (L / 8), t0 = (q % (L / 8)) * 8;
#pragma unroll
                    for (int j = 0; j < 8; ++j) vb[b * L + t0 + j] = res[pi][j]; } }
            __syncthreads();
        } else {
#pragma unroll
            for (int pi = 0; pi < PER; ++pi) { const int q = F.tid + pi * NTHR;
                if (q < NBLK) { const int b = q / (L / 8), t0 = (q % (L / 8)) * 8;
                    v4u ov; ov.x = pk2(res[pi][0], res[pi][1]); ov.y = pk2(res[pi][2], res[pi][3]); ov.z = pk2(res[pi][4], res[pi][5]); ov.w = pk2(res[pi][6], res[pi][7]);
                    *(v4u*)(Z2T + (size_t)d * TA + tok0 + b * L + t0) = ov; } }
        }
    }
}
__device__ __forceinline__ void phase_hy_tr(ArgsP a, const Fr& F, int ntok) {
    LAS unsigned short* tile = (LAS unsigned short*)(F.lds + F.wave * 9216);
    const bf16* Z2T = (const bf16*)(a->ws + SC_Z2T); bf16* Z2 = (bf16*)(a->ws + SC_Z2);
    const int gw = F.vcu * NWAVES + F.wave, NGW = F.G * NWAVES, ntt = ntok / 64;
    for (int it = gw; it < 16 * ntt; it += NGW) {
        const int c0 = (it / ntt) * 64, t0 = (it % ntt) * 64;
#pragma unroll
        for (int i = 0; i < 8; ++i) { const int ch = i * 8 + (F.lane >> 3), ck = F.lane & 7;
            const v4u v = *(const v4u*)(Z2T + (size_t)(c0 + ch) * TA + t0 + ck * 8); *(LAS v4u*)(tile + ch * 72 + ck * 8) = v; }
        LDS_WAIT(); asm volatile("" ::: "memory");
        bf16* dst = Z2 + (size_t)(t0 + F.lane) * D + c0;
#pragma unroll
        for (int q = 0; q < 8; ++q) { unsigned w[4];
#pragma unroll
            for (int j = 0; j < 4; ++j) { const unsigned lo = tile[(q * 8 + 2 * j) * 72 + F.lane], hi = tile[(q * 8 + 2 * j + 1) * 72 + F.lane]; w[j] = lo | (hi << 16); }
            v4u o; o.x = w[0]; o.y = w[1]; o.z = w[2]; o.w = w[3]; *(v4u*)(dst + q * 8) = o; }
        LDS_WAIT(); asm volatile("" ::: "memory");
    }
}
__device__ __forceinline__ void phase_hy_conv_direct(ArgsP a, const Fr& F, int layer) {
    const int slot = layer == 0 ? 0 : 1; const int nitems = layer == 0 ? 2048 : 1024;
    for (int it = F.vcu; it < nitems; it += F.G) {
        if (it < 1024) hy_direct_item<SEQ>(a, F, slot, it, 0, (const float*)(a->ws + WS_HF + (size_t)slot * HF_SLOT));
        else hy_direct_item<LC>(a, F, slot, it - 1024, T, (const float*)(a->ws + WS_HF + HF_CTX));
    }
}

__device__ __forceinline__ void phase_lnr(ArgsP a, const Fr& F, int layer, int nrows) {
    LAS float* wr = (LAS float*)F.lds;
    __syncthreads();
    for (int u = F.tid; u < 1024 * 16; u += NTHR) wr[u] = a->in[I_ROUTER][(size_t)layer * 1024 * 16 + (u & 1023) * 16 + (u >> 10)];
    __syncthreads();
    const float* U = (const float*)(a->ws + WS_U); float* XL = (float*)(a->ws + WS_XL); bf16* HB = (bf16*)(a->ws + WS_HB); float* AFF = (float*)(a->ws + WS_AFF);
    const float* mod = (const float*)(a->ws + WS_MOD) + (size_t)layer * 5 * 6144;
    const float* lg = a->in[I_LNG] + (size_t)(layer * 2 + 0) * D; const float* lb = a->in[I_LNB] + (size_t)(layer * 2 + 0) * D;
    const int gw = F.vcu * NWAVES + F.wave, NGW = F.G * NWAVES;
    for (int row = gw; row < nrows; row += NGW) {
        const int r = row < T ? (row >> 12) : 4;
        const float* up = U + (size_t)row * D; f32x4 v[4]; float s = 0.f;
#pragma unroll
        for (int j = 0; j < 4; ++j) { v[j] = *(const f32x4*)(up + 4 * F.lane + 256 * j); s += (v[j][0] + v[j][1]) + (v[j][2] + v[j][3]); }
        const float mean = wave_sum(s) * (1.0f / D); float s2 = 0.f;
#pragma unroll
        for (int j = 0; j < 4; ++j) { v[j] = v[j] - mean; s2 += (v[j][0] * v[j][0] + v[j][1] * v[j][1]) + (v[j][2] * v[j][2] + v[j][3] * v[j][3]); }
        const float rstd = 1.0f / sqrtf(wave_sum(s2) * (1.0f / D) + LN_EPS);
        float part[16];
#pragma unroll
        for (int e = 0; e < 16; ++e) part[e] = 0.f;
#pragma unroll
        for (int j = 0; j < 4; ++j) { const int c = 4 * F.lane + 256 * j;
            const f32x4 x = v[j] * rstd * *(const f32x4*)(lg + c) + *(const f32x4*)(lb + c);
            *(f32x4*)(XL + (size_t)row * D + c) = x;
            const f32x4 h = x * (*(const f32x4*)(mod + r * 6144 + 4096 + c) + 1.0f) + *(const f32x4*)(mod + r * 6144 + 3072 + c);
            v2u o; o.x = pk2(h[0], h[1]); o.y = pk2(h[2], h[3]); *(v2u*)(HB + (size_t)row * D + c) = o;
#pragma unroll
            for (int e = 0; e < 16; ++e) { const f32x4 w = *(const LAS f32x4*)(wr + e * 1024 + c);
                part[e] += (h[0] * w[0] + h[1] * w[1]) + (h[2] * w[2] + h[3] * w[3]); }
            asm volatile("" ::: "memory"); }
        float mx = -3.0e38f;
#pragma unroll
        for (int e = 0; e < 16; ++e) { part[e] = wave_sum(part[e]); mx = fmaxf(mx, part[e]); }
        float den = 0.f;
#pragma unroll
        for (int e = 0; e < 16; ++e) { part[e] = expf(part[e] - mx); den += part[e]; }
        float mine = 0.f;
#pragma unroll
        for (int e = 0; e < 16; ++e) mine = (F.lane == e) ? part[e] / den : mine;
        if (F.lane < 16) AFF[(size_t)row * 16 + F.lane] = mine;
    }
}

template <int N, int CAPN>
__device__ __forceinline__ void topk_item(ArgsP a, const Fr& F, int b, int e, int rowbase, int slotbase, bool pad) {
    LAS unsigned long long* key = (LAS unsigned long long*)F.lds;
    const float* AFF = (const float*)(a->ws + WS_AFF); int* ROWS = (int*)(a->ws + WS_ROWS); float* GATE = (float*)(a->ws + WS_GATE); int* INV = (int*)(a->ws + WS_INV);
    __syncthreads();
    for (int t = F.tid; t < N; t += NTHR) { const float v = AFF[(size_t)(rowbase + t) * 16 + e]; key[t] = ((unsigned long long)__float_as_uint(v) << 32) | (unsigned long long)(0xFFFFFFFFu - (unsigned)t); }
    __syncthreads();
    for (int k = 2; k <= N; k <<= 1)
        for (int j = k >> 1; j > 0; j >>= 1) {
            for (int q = F.tid; q < N / 2; q += NTHR) { const int i = ((q & ~(j - 1)) << 1) | (q & (j - 1)), l = i | j; const bool up = (i & k) == 0;
                const unsigned long long x = key[i], y = key[l]; if ((x < y) == up) { key[i] = y; key[l] = x; } }
            __syncthreads();
        }
    for (int p = F.tid; p < N; p += NTHR) { const unsigned long long kv = key[p]; const int t = (int)(0xFFFFFFFFu - (unsigned)(kv & 0xFFFFFFFFull)); const int row = rowbase + t;
        int slot = -1;
        if (p < CAPN) { slot = e * ESTR + slotbase + p; ROWS[slot] = row; GATE[slot] = __uint_as_float((unsigned)(kv >> 32)); }
        INV[(size_t)row * 16 + e] = slot; }
    if (pad) for (int p = F.tid; p < 128; p += NTHR) { ROWS[e * ESTR + 2176 + p] = 0; GATE[e * ESTR + 2176 + p] = 0.f; }
}
__device__ __forceinline__ void phase_topk(ArgsP a, const Fr& F, int layer) {
    const int nitems = layer == 0 ? 128 : 64;
    for (int it = F.vcu; it < nitems; it += F.G) {
        if (it < 64) { const int b = it >> 4, e = it & 15; topk_item<SEQ, 512>(a, F, b, e, b * SEQ, b * 512, false); }
        else { const int b = (it - 64) >> 4, e = it & 15; topk_item<LC, 32>(a, F, b, e, T + b * LC, 2048 + b * 32, b == 0); }
    }
}
__device__ __forceinline__ void phase_gather(ArgsP a, const Fr& F, int layer) {
    const int me = layer == 0 ? 2304 : 2048;
    const int* ROWS = (const int*)(a->ws + WS_ROWS); const bf16* HB = (const bf16*)(a->ws + WS_HB); bf16* XG = (bf16*)(a->ws + WS_XG);
    const int gw = F.vcu * NWAVES + F.wave, NGW = F.G * NWAVES;
    for (int it = gw; it < 16 * me; it += NGW) { const int e = it / me, s = it % me, dr = e * ESTR + s; const int sr = ROWS[dr];
        const v4u* src = (const v4u*)(HB + (size_t)sr * D); v4u* dst = (v4u*)(XG + (size_t)dr * D);
        dst[F.lane] = src[F.lane]; dst[64 + F.lane] = src[64 + F.lane]; }
}
__device__ __forceinline__ void phase_comb(ArgsP a, const Fr& F, int layer, int nrows) {
    const bf16* Y = (const bf16*)(a->ws + WS_Y); const float* XL = (const float*)(a->ws + WS_XL); float* XC = (float*)(a->ws + WS_XC); bf16* HB = (bf16*)(a->ws + WS_HB); const int* INV = (const int*)(a->ws + WS_INV);
    const float* mod = (const float*)(a->ws + WS_MOD) + (size_t)layer * 5 * 6144;
    const float* modn = (const float*)(a->ws + WS_MOD) + (size_t)(layer < 3 ? layer + 1 : 3) * 5 * 6144;
    const float* lg = a->in[I_LNG] + (size_t)(layer * 2 + 1) * D; const float* lb = a->in[I_LNB] + (size_t)(layer * 2 + 1) * D;
    const int gw = F.vcu * NWAVES + F.wave, NGW = F.G * NWAVES;
    for (int row = gw; row < nrows; row += NGW) {
        const int r = row < T ? (row >> 12) : 4;
        const int myinv = INV[(size_t)row * 16 + (F.lane & 15)];
        f32x4 m[4];
#pragma unroll
        for (int j = 0; j < 4; ++j) m[j] = (f32x4){0.f, 0.f, 0.f, 0.f};
        unsigned msk = (unsigned)(__ballot(myinv >= 0) & 0xFFFFull);
        while (msk) {
            int sl[4];
#pragma unroll
            for (int q = 0; q < 4; ++q) { if (msk) { const int e = __builtin_ctz(msk); msk &= msk - 1; sl[q] = __shfl(myinv, e); } else sl[q] = -1; }
            v2u yv[4][4];
#pragma unroll
            for (int q = 0; q < 4; ++q) if (sl[q] >= 0) { const bf16* yp = Y + (size_t)sl[q] * D;
#pragma unroll
                for (int j = 0; j < 4; ++j) yv[q][j] = *(const v2u*)(yp + 4 * F.lane + 256 * j); }
#pragma unroll
            for (int q = 0; q < 4; ++q) if (sl[q] >= 0) {
#pragma unroll
                for (int j = 0; j < 4; ++j) { const v2u w = yv[q][j];
                    m[j] += (f32x4){__builtin_bit_cast(float, w.x << 16), __builtin_bit_cast(float, w.x & 0xffff0000u), __builtin_bit_cast(float, w.y << 16), __builtin_bit_cast(float, w.y & 0xffff0000u)}; } }
        }
        f32x4 v[4]; float s = 0.f;
#pragma unroll
        for (int j = 0; j < 4; ++j) { const int c = 4 * F.lane + 256 * j;
            v[j] = *(const f32x4*)(XL + (size_t)row * D + c) * ALPHA + *(const f32x4*)(mod + r * 6144 + 5120 + c) * m[j]; s += (v[j][0] + v[j][1]) + (v[j][2] + v[j][3]); }
        const float mean = wave_sum(s) * (1.0f / D); float s2 = 0.f;
#pragma unroll
        for (int j = 0; j < 4; ++j) { v[j] = v[j] - mean; s2 += (v[j][0] * v[j][0] + v[j][1] * v[j][1]) + (v[j][2] * v[j][2] + v[j][3] * v[j][3]); }
        const float rstd = 1.0f / sqrtf(wave_sum(s2) * (1.0f / D) + LN_EPS);
#pragma unroll
        for (int j = 0; j < 4; ++j) { const int c = 4 * F.lane + 256 * j;
            const f32x4 x = v[j] * rstd * *(const f32x4*)(lg + c) + *(const f32x4*)(lb + c);
            if (layer == 3) { *(f32x4*)(a->out + (size_t)row * D + c) = x; }
            else { *(f32x4*)(XC + (size_t)row * D + c) = x;
                const f32x4 h = x * (*(const f32x4*)(modn + r * 6144 + 1024 + c) + 1.0f) + *(const f32x4*)(modn + r * 6144 + c);
                v2u o; o.x = pk2(h[0], h[1]); o.y = pk2(h[2], h[3]); *(v2u*)(HB + (size_t)row * D + c) = o; } }
    }
}
#ifndef FFT_HD
#define FFT_HD __device__ __forceinline__
#endif
typedef float cf2 __attribute__((ext_vector_type(2)));
FFT_HD cf2 cmul(cf2 a, cf2 b) { return (cf2){a.x * b.x - a.y * b.y, a.x * b.y + a.y * b.x}; }
FFT_HD int fpad(int p) { return p + (p >> 5); }
constexpr int FFT_N = 8192, FFT_BUF = 8192 + 256;
template <bool INV> FFT_HD void dft4(cf2& a, cf2& b, cf2& c, cf2& d) {
    const cf2 s0 = a + c, s1 = a - c, s2 = b + d, s3 = b - d;
    const cf2 js3 = INV ? (cf2){-s3.y, s3.x} : (cf2){s3.y, -s3.x};
    a = s0 + s2; b = s1 + js3; c = s0 - s2; d = s1 - js3;
}
template <bool INV> FFT_HD void dft16(cf2 (&x)[16]) {
#pragma unroll
    for (int n0 = 0; n0 < 4; ++n0) dft4<INV>(x[n0], x[n0 + 4], x[n0 + 8], x[n0 + 12]);
    constexpr float C1 = 0.92387953251128674f, S1 = 0.38268343236508977f, R2 = 0.70710678118654752f;
    const float sg = INV ? 1.f : -1.f;
    const cf2 w1 = {C1, sg * S1}, w2 = {R2, sg * R2}, w3 = {S1, sg * C1}, w4 = {0.f, sg * 1.f}, w6 = {-R2, sg * R2}, w9 = {-C1, -sg * S1};
    x[1 + 4 * 1] = cmul(x[1 + 4 * 1], w1); x[1 + 4 * 2] = cmul(x[1 + 4 * 2], w2); x[1 + 4 * 3] = cmul(x[1 + 4 * 3], w3);
    x[2 + 4 * 1] = cmul(x[2 + 4 * 1], w2); x[2 + 4 * 2] = cmul(x[2 + 4 * 2], w4); x[2 + 4 * 3] = cmul(x[2 + 4 * 3], w6);
    x[3 + 4 * 1] = cmul(x[3 + 4 * 1], w3); x[3 + 4 * 2] = cmul(x[3 + 4 * 2], w6); x[3 + 4 * 3] = cmul(x[3 + 4 * 3], w9);
#pragma unroll
    for (int k0 = 0; k0 < 4; ++k0) dft4<INV>(x[0 + 4 * k0], x[1 + 4 * k0], x[2 + 4 * k0], x[3 + 4 * k0]);
#pragma unroll
    for (int i = 0; i < 4; ++i)
#pragma unroll
        for (int j = i + 1; j < 4; ++j) { const cf2 t = x[i + 4 * j]; x[i + 4 * j] = x[j + 4 * i]; x[j + 4 * i] = t; }
}
template <bool INV, class BP, class TP> FFT_HD void stage_r16(BP buf, TP TW, int base, int stride, int tidx) {
    cf2 x[16];
#pragma unroll
    for (int i = 0; i < 16; ++i) x[i] = buf[fpad(base + i * stride)];
    cf2 w = TW[tidx]; w.y = INV ? w.y : -w.y;
    if (!INV) dft16<false>(x);
    cf2 wk = w;
#pragma unroll
    for (int k = 1; k < 16; ++k) { x[k] = cmul(x[k], wk); if (k < 15) wk = cmul(wk, w); }
    if (INV) dft16<true>(x);
#pragma unroll
    for (int i = 0; i < 16; ++i) buf[fpad(base + i * stride)] = x[i];
}
template <bool INV, class BP> FFT_HD void stage_r32_load(BP buf, int blk, int r, cf2 (&u)[16]) {
    constexpr float CS[16] = {1.f, 0.98078528040323043f, 0.92387953251128674f, 0.83146961230254524f, 0.70710678118654752f, 0.55557023301960218f, 0.38268343236508977f, 0.19509032201612825f,
                              0.f, -0.19509032201612825f, -0.38268343236508977f, -0.55557023301960218f, -0.70710678118654752f, -0.83146961230254524f, -0.92387953251128674f, -0.98078528040323043f};
    constexpr float SN[16] = {0.f, 0.19509032201612825f, 0.38268343236508977f, 0.55557023301960218f, 0.70710678118654752f, 0.83146961230254524f, 0.92387953251128674f, 0.98078528040323043f,
                              1.f, 0.98078528040323043f, 0.92387953251128674f, 0.83146961230254524f, 0.70710678118654752f, 0.55557023301960218f, 0.38268343236508977f, 0.19509032201612825f};
    const int base = blk * 33;
#pragma unroll
    for (int n = 0; n < 16; ++n) { const cf2 lo = buf[base + n], hi = buf[base + n + 16];
        const cf2 s = lo + hi, d = lo - hi; const cf2 w = {CS[n], INV ? SN[n] : -SN[n]}; const cf2 dw = cmul(d, w);
        u[n] = r ? dw : s; }
    dft16<INV>(u);
}
template <class BP> FFT_HD void stage_r32_store(BP buf, int blk, int r, const cf2 (&u)[16]) {
    const int base = blk * 33;
#pragma unroll
    for (int g = 0; g < 16; ++g) buf[base + 2 * g + r] = u[g];
}
template <class BP> FFT_HD void fft_mul(BP Z, BP W, int tid, int o, float scale) {
    const int f2 = tid >> 5, f3 = tid & 31;
#pragma unroll 4
    for (int j = 0; j < 16; ++j) { const int p = tid + 512 * j; const int f = j + 16 * f2 + 256 * f3; const int fm = (FFT_N - f) & (FFT_N - 1);
        const int pm = (fm & 15) * 512 + ((fm >> 4) & 15) * 32 + (fm >> 8);
        const cf2 a = W[fpad(p)], b = W[fpad(pm)];
        const cf2 k = o == 0 ? (cf2){0.5f * (a.x + b.x), 0.5f * (a.y - b.y)} : (cf2){0.5f * (a.y + b.y), 0.5f * (b.x - a.x)};
        const cf2 z = Z[fpad(p)]; Z[fpad(p)] = cmul(z, k) * scale; }
}
#ifndef FFT_HOST_ONLY
__device__ __forceinline__ void fft_fwd(LAS cf2* buf, const cf2* TW, int tid) {
    stage_r16<false>(buf, TW, tid, 512, tid); __syncthreads();
    stage_r16<false>(buf, TW, (tid >> 5) * 512 + (tid & 31), 32, 16 * (tid & 31)); __syncthreads();
    { cf2 u[16]; stage_r32_load<false>(buf, tid >> 1, tid & 1, u); stage_r32_store(buf, tid >> 1, tid & 1, u); } __syncthreads();
}
__device__ __forceinline__ void fft_inv(LAS cf2* buf, const cf2* TW, int tid) {
    { cf2 u[16]; stage_r32_load<true>(buf, tid >> 1, tid & 1, u); stage_r32_store(buf, tid >> 1, tid & 1, u); } __syncthreads();
    stage_r16<true>(buf, TW, (tid >> 5) * 512 + (tid & 31), 32, 16 * (tid & 31)); __syncthreads();
    stage_r16<true>(buf, TW, tid, 512, tid); __syncthreads();
}
__device__ __forceinline__ void hy_fft_item(ArgsP a, const Fr& F, int slot, int d) {
    LAS cf2* Zb = (LAS cf2*)F.lds;
    LAS cf2* Wb = Zb + FFT_BUF;
    LAS float* red = (LAS float*)(Wb + FFT_BUF);
    const bf16* PT = (const bf16*)(a->ws + SC_PT); bf16* Z2T = (bf16*)(a->ws + SC_Z2T); const cf2* TW = (const cf2*)(a->ws + WS_TW);
    const float* HF = (const float*)(a->ws + WS_HF + (size_t)slot * HF_SLOT);
    const int tid = F.tid;
    __syncthreads();
    { const float* f0 = HF + (size_t)(0 * 1024 + d) * SEQ; const float* b0 = HF + (size_t)(1 * 1024 + d) * SEQ;
      const float* f1 = HF + (size_t)(2 * 1024 + d) * SEQ; const float* b1 = HF + (size_t)(3 * 1024 + d) * SEQ;
      float s0 = 0.f, s1 = 0.f;
      for (int t = tid; t < SEQ; t += NTHR) { const float a0 = f0[t], a1 = f1[t]; Wb[fpad(t)] = (cf2){a0, a1}; s0 += fabsf(a0); s1 += fabsf(a1);
          if (t >= 1) { const float c0 = b0[t], c1 = b1[t]; Wb[fpad(FFT_N - t)] = (cf2){c0, c1}; s0 += fabsf(c0); s1 += fabsf(c1); } }
      if (tid == 0) Wb[fpad(SEQ)] = (cf2){0.f, 0.f};
      s0 = wave_sum(s0); s1 = wave_sum(s1); if (F.lane == 0) { red[F.wave] = s0; red[8 + F.wave] = s1; } }
    __syncthreads();
    float nrm0, nrm1; { float s0 = 0.f, s1 = 0.f; for (int w = 0; w < 8; ++w) { s0 += red[w]; s1 += red[8 + w]; } nrm0 = 1.0f / (s0 + 1e-6f); nrm1 = 1.0f / (s1 + 1e-6f); }
    fft_fwd(Wb, TW, tid);
    const float* cw = a->in[I_HYCW] + (size_t)slot * 3 * 3072; const float* cbp = a->in[I_HYCB] + (size_t)slot * 3072;
    float w0[3], w1[3], w2[3], cb[3];
#pragma unroll
    for (int g = 0; g < 3; ++g) { const int c = g * 1024 + d; w0[g] = cw[c]; w1[g] = cw[3072 + c]; w2[g] = cw[2 * 3072 + c]; cb[g] = cbp[c]; }
    const float fb0 = a->in[I_FBIAS][(slot * 2 + 0) * 1024 + d], fb1 = a->in[I_FBIAS][(slot * 2 + 1) * 1024 + d];
    const float sc0 = nrm0 * (1.0f / FFT_N), sc1 = nrm1 * (1.0f / FFT_N);
#pragma unroll 1
    for (int pr = 0; pr < 2; ++pr) {
        const bf16* pv0 = PT + (size_t)d * TA + (2 * pr) * SEQ; const bf16* pv1 = pv0 + SEQ;
        cf2 vin[8];
#pragma unroll
        for (int j = 0; j < 8; ++j) { const int t = tid + 512 * j; vin[j] = (cf2){sconv<SEQ>(pv0, t, w0[0], w1[0], w2[0], cb[0]), sconv<SEQ>(pv1, t, w0[0], w1[0], w2[0], cb[0])};
            Zb[fpad(t)] = vin[j]; Zb[fpad(t + SEQ)] = (cf2){0.f, 0.f}; }
        __syncthreads();
        fft_fwd(Zb, TW, tid); fft_mul(Zb, Wb, tid, 0, sc0); __syncthreads(); fft_inv(Zb, TW, tid);
        const bf16* px0 = PT + (size_t)(1024 + d) * TA + (2 * pr) * SEQ; const bf16* px1 = px0 + SEQ;
#pragma unroll
        for (int j = 0; j < 8; ++j) { const int t = tid + 512 * j; const cf2 y = Zb[fpad(t)];
            const cf2 xg = {sconv<SEQ>(px0, t, w0[1], w1[1], w2[1], cb[1]), sconv<SEQ>(px1, t, w0[1], w1[1], w2[1], cb[1])};
            vin[j] = xg * (y + vin[j] * fb0); }
        __syncthreads();
#pragma unroll
        for (int j = 0; j < 8; ++j) { const int t = tid + 512 * j; Zb[fpad(t)] = vin[j]; Zb[fpad(t + SEQ)] = (cf2){0.f, 0.f}; }
        __syncthreads();
        fft_fwd(Zb, TW, tid); fft_mul(Zb, Wb, tid, 1, sc1); __syncthreads(); fft_inv(Zb, TW, tid);
        const bf16* pz0 = PT + (size_t)(2048 + d) * TA + (2 * pr) * SEQ; const bf16* pz1 = pz0 + SEQ;
        bf16* o0 = Z2T + (size_t)d * TA + (2 * pr) * SEQ; bf16* o1 = o0 + SEQ;
#pragma unroll
        for (int j = 0; j < 8; ++j) { const int t = tid + 512 * j; const cf2 y = Zb[fpad(t)];
            const cf2 xg = {sconv<SEQ>(pz0, t, w0[2], w1[2], w2[2], cb[2]), sconv<SEQ>(pz1, t, w0[2], w1[2], w2[2], cb[2])};
            const cf2 z = xg * (y + vin[j] * fb1); o0[t] = (bf16)f2bf(z.x); o1[t] = (bf16)f2bf(z.y); }
        __syncthreads();
    }
}
__device__ __forceinline__ void phase_hy_conv_fft(ArgsP a, const Fr& F, int layer) {
    const int slot = layer == 0 ? 0 : 1; const int nitems = layer == 0 ? 2048 : 1024;
    for (int it = F.vcu; it < nitems; it += F.G) {
        if (it < 1024) hy_fft_item(a, F, slot, it);
        else hy_direct_item<LC>(a, F, slot, it - 1024, T, (const float*)(a->ws + WS_HF + HF_CTX));
    }
}
#endif
#include <hip/hip_bf16.h>
namespace attn_body {
using bf16=__hip_bfloat16;
using bf16x8=__attribute__((ext_vector_type(8)))short;
using s16x4=__attribute__((ext_vector_type(4)))short;
using f32x16=__attribute__((ext_vector_type(16)))float;
using u32x4=__attribute__((ext_vector_type(4)))unsigned;
constexpr int BATCH=4,NHEAD=16,SEQ=4096,D=64,DM=NHEAD*D,KP=256,LKEYS=4352;
constexpr int NW=8,QBLK=32,QB=QBLK*NW,KVBLK=64,NQB=SEQ/QB;
constexpr int ATTN_PITCH=DM, ATTN_UNIT_ROWS=QB;
__device__ __forceinline__ int crow(int r,int hi){return (r&3)+8*(r>>2)+4*hi;}
#define SBAR() __builtin_amdgcn_sched_barrier(0)
__device__ __forceinline__ void cmask(f32x16&p0,f32x16&p1,int jb,int qrel,int hi){
  const float NEG=-INFINITY; int kb=64*jb+4*hi;
  #pragma unroll
  for(int r=0;r<16;++r){int kv=kb+(r&3)+8*(r>>2); if(kv>qrel)p0[r]=NEG; if(kv+32>qrel)p1[r]=NEG;}
}

constexpr int NSLOT=3, SLOTB=8192;
constexpr int LDS_K=0, LDS_V=NSLOT*SLOTB, LDS_WS=2*NSLOT*SLOTB, LDS_OST=LDS_WS+NW*64*4, LDS_BYTES=LDS_OST+NW*4096;
constexpr float C2=0.125f*1.4426950408889634f;
__device__ __forceinline__ void glds16(const void*gsrc,unsigned lds_dst){unsigned keep;
  asm volatile("s_mov_b32 %0, m0\n\ts_mov_b32 m0, %2\n\ts_nop 0\n\tglobal_load_lds_dwordx4 %1, off\n\ts_mov_b32 m0, %0":"=&s"(keep):"v"(gsrc),"s"(lds_dst):"memory");}
__device__ __forceinline__ float max3f(float a,float b,float c){float r;asm("v_max3_f32 %0, %1, %2, %3":"=v"(r):"v"(a),"v"(b),"v"(c));return r;}
__device__ __forceinline__ float max2f(float a,float b){float r;asm("v_max_f32_e32 %0, %1, %2":"=v"(r):"v"(a),"v"(b));return r;}
__device__ __forceinline__ float fadd_s(float a,float b){float r;asm("v_add_f32_e32 %0, %1, %2":"=v"(r):"v"(a),"v"(b));return r;}
__device__ __forceinline__ float fsub_s(float a,float b){float r;asm("v_sub_f32_e32 %0, %1, %2":"=v"(r):"v"(a),"v"(b));return r;}
typedef float f32x2_t __attribute__((ext_vector_type(2))); typedef __bf16 bf16x2_t __attribute__((ext_vector_type(2)));
__device__ __forceinline__ unsigned cvtpk_s(float lo,float hi){f32x2_t v={lo,hi};bf16x2_t b=__builtin_convertvector(v,bf16x2_t);return __builtin_bit_cast(unsigned,b);}
#define WAIT_BAR(N) asm volatile("s_waitcnt vmcnt(" #N ") lgkmcnt(0)\n\ts_barrier":::"memory")

__device__ __forceinline__ void qkt(f32x16&p0,f32x16&p1,const char*Kslot,const bf16x8*qr,const f32x16&negm,int r32,int hi){
  const char*kb=Kslot+hi*1024+r32*16;
  #pragma unroll
  for(int d0=0;d0<4;++d0){
    const bf16x8 b0=*reinterpret_cast<const bf16x8*>(kb+d0*2048);
    const bf16x8 b1=*reinterpret_cast<const bf16x8*>(kb+d0*2048+512);
    if(d0==0){p0=__builtin_amdgcn_mfma_f32_32x32x16_bf16(b0,qr[0],negm,0,0,0);p1=__builtin_amdgcn_mfma_f32_32x32x16_bf16(b1,qr[0],negm,0,0,0);}
    else{p0=__builtin_amdgcn_mfma_f32_32x32x16_bf16(b0,qr[d0],p0,0,0,0);p1=__builtin_amdgcn_mfma_f32_32x32x16_bf16(b1,qr[d0],p1,0,0,0);}}
}
typedef __attribute__((address_space(3))) const char* lds_cptr;
typedef short v4i16_t __attribute__((ext_vector_type(4)));
__device__ __forceinline__ void kload8(bf16x8*kf,lds_cptr kp){
  kf[0]=*(const __attribute__((address_space(3))) bf16x8*)(kp);      kf[1]=*(const __attribute__((address_space(3))) bf16x8*)(kp+512);
  kf[2]=*(const __attribute__((address_space(3))) bf16x8*)(kp+2048); kf[3]=*(const __attribute__((address_space(3))) bf16x8*)(kp+2560);
  kf[4]=*(const __attribute__((address_space(3))) bf16x8*)(kp+4096); kf[5]=*(const __attribute__((address_space(3))) bf16x8*)(kp+4608);
  kf[6]=*(const __attribute__((address_space(3))) bf16x8*)(kp+6144); kf[7]=*(const __attribute__((address_space(3))) bf16x8*)(kp+6656);
}
__device__ __forceinline__ void kload2(bf16x8*kf,lds_cptr kp,int j){ kf[2*j]=*(const __attribute__((address_space(3))) bf16x8*)(kp+j*2048); kf[2*j+1]=*(const __attribute__((address_space(3))) bf16x8*)(kp+j*2048+512); }
__device__ __forceinline__ s16x4 vtr(lds_cptr p){ return __builtin_bit_cast(s16x4,__builtin_amdgcn_ds_read_tr16_b64_v4i16((__attribute__((address_space(3))) v4i16_t*)p)); }
__device__ __forceinline__ float rowmax(const f32x16&p0,const f32x16&p1){
  float a=max3f(p0[0],p0[1],p1[0]),b=max3f(p0[2],p0[3],p1[1]);a=max3f(a,p1[2],p1[3]);
  #pragma unroll
  for(int r=4;r<16;r+=4){a=max3f(a,p0[r],p0[r+1]);b=max3f(b,p0[r+2],p0[r+3]);a=max3f(a,p1[r],p1[r+1]);b=max3f(b,p1[r+2],p1[r+3]);}
  const float m=max2f(a,b);
  auto rr=__builtin_amdgcn_permlane32_swap(__float_as_uint(m),__float_as_uint(m),false,false);
  return max2f(__uint_as_float(rr[0]),__uint_as_float(rr[1]));
}
__device__ __forceinline__ void pv(f32x16*o,int vb,bf16x8 pa0,bf16x8 pa1,bf16x8 pa2,bf16x8 pa3){
  #pragma unroll
  for(int d0=0;d0<2;++d0){s16x4 lo[4],hi[4];
    #pragma unroll
    for(int ks=0;ks<4;++ks){
      asm volatile("ds_read_b64_tr_b16 %0,%1 offset:%c2":"=&v"(lo[ks]):"v"(vb),"i"(d0*4096+ks*1024):"memory");
      asm volatile("ds_read_b64_tr_b16 %0,%1 offset:%c2":"=&v"(hi[ks]):"v"(vb),"i"(d0*4096+ks*1024+512):"memory");}
    asm volatile("s_waitcnt lgkmcnt(0)":::"memory");SBAR();
    #define PK(k) (bf16x8){lo[k][0],lo[k][1],lo[k][2],lo[k][3],hi[k][0],hi[k][1],hi[k][2],hi[k][3]}
    o[d0]=__builtin_amdgcn_mfma_f32_32x32x16_bf16(pa0,PK(0),o[d0],0,0,0);
    o[d0]=__builtin_amdgcn_mfma_f32_32x32x16_bf16(pa1,PK(1),o[d0],0,0,0);
    o[d0]=__builtin_amdgcn_mfma_f32_32x32x16_bf16(pa2,PK(2),o[d0],0,0,0);
    o[d0]=__builtin_amdgcn_mfma_f32_32x32x16_bf16(pa3,PK(3),o[d0],0,0,0);
    #undef PK
  }
}

#ifndef ATTN_STORE16
#define ATTN_STORE16(p,v) (*(u32x4*)(p)=(v))
#endif
template<int THRL> __device__ __forceinline__ void attn_unit(int b,int h,int qb,const bf16*Q,const bf16*__restrict__ K,const bf16*__restrict__ V,bf16*O,char*shm){
  int tid_=threadIdx.x; asm volatile("":"+v"(tid_)); const int tid=tid_,lane=tid&63,r32=lane&31,hi=lane>>5; const int wid=__builtin_amdgcn_readfirstlane(tid>>6);
  const long rowbase=(long)b*SEQ; const int q0=qb*QB;
  const bf16*Qw=Q+(rowbase+q0+wid*QBLK)*DM+h*D;
  const bf16*Kh=K+(long)b*LKEYS*KP+(h>>2)*D,*Vh=V+(long)b*LKEYS*KP+(h>>2)*D;
  const unsigned lds0=(unsigned)(uintptr_t)shm;
  float*wsf=(float*)(shm+LDS_WS)+wid*64;
  const bf16*ksrc=Kh+(long)lane*KP+wid*8;
  const bf16*vsrc=Vh+(long)(16*(wid&3)+(lane>>2))*KP+(wid>>2)*32+(lane&3)*8;
  const unsigned kdst=lds0+LDS_K+wid*1024, vdst=lds0+LDS_V+wid*1024;
  #define DMA_K(t,slot) glds16(ksrc+(long)(t)*KVBLK*KP,(unsigned)__builtin_amdgcn_readfirstlane(kdst+(slot)))
  #define DMA_V(t,slot) glds16(vsrc+(long)(t)*KVBLK*KP,(unsigned)__builtin_amdgcn_readfirstlane(vdst+(slot)))
  const int vb0=(int)(lds0+LDS_V)+((lane>>4)&1)*32+(lane&3)*8+(4*hi+((lane&15)>>2))*64;
  const char*Kbase=shm+LDS_K; bf16x8 kf[8];
  const lds_cptr shm3=(lds_cptr)shm; const lds_cptr kp0=shm3+LDS_K+hi*1024+r32*16; const lds_cptr vp0=shm3+LDS_V+((lane>>4)&1)*32+(lane&3)*8+(4*hi+((lane&15)>>2))*64;
  const int NT=LKEYS/KVBLK;
  DMA_K(0,0);DMA_V(0,0);DMA_K(1,SLOTB);
  bf16x8 qr[4];
  #pragma unroll
  for(int d0=0;d0<4;++d0)qr[d0]=*reinterpret_cast<const bf16x8*>(&Qw[(long)r32*DM+d0*16+hi*8]);
  float mhat=0.f,l_reg=0.f;f32x16 o[2];o[0]=f32x16{};o[1]=f32x16{};f32x16 negm=f32x16{};asm volatile("":"+v"(negm));

  #define CMASK(P0,P1,t) do{}while(0)
  bool resc=false;
  #define START(P0,P1) do{ const float rm=rowmax(P0,P1); resc=false; \
    { const float dl=rm; mhat=fadd_s(mhat,dl); \
      _Pragma("unroll") for(int r=0;r<16;++r){P0[r]=fsub_s(P0[r],dl);P1[r]=fsub_s(P1[r],dl);} \
      _Pragma("unroll") for(int r=0;r<16;++r)negm[r]=-mhat; asm volatile("":"+v"(negm)); } \
    _Pragma("unroll") for(int r=0;r<16;++r)P0[r]=__builtin_amdgcn_exp2f(P0[r]); }while(0)
  #define RESC() do{ if(resc){ asm volatile("s_waitcnt lgkmcnt(0)":::"memory"); \
      _Pragma("unroll") for(int d_=0;d_<2;++d_) _Pragma("unroll") for(int r=0;r<16;++r)o[d_][r]*=wsf[crow(r,hi)]; } }while(0)
  f32x16 pA0,pA1,pB0,pB1;
  int sl_prev=0,sl_cur=0,sl_next=SLOTB;
  #define ROT() do{sl_prev=sl_cur;sl_cur=sl_next;sl_next=(sl_next==(NSLOT-1)*SLOTB)?0:sl_next+SLOTB;}while(0)
  DMA_K(2,2*SLOTB);
  WAIT_BAR(3);
  qkt(pA0,pA1,Kbase,qr,negm,r32,hi);asm volatile("s_nop 15\n\ts_nop 7":"+v"(pA0),"+v"(pA1));CMASK(pA0,pA1,0);
  START(pA0,pA1);
  _Pragma("unroll") for(int r=0;r<16;++r)pA1[r]=__builtin_amdgcn_exp2f(pA1[r]);
  WAIT_BAR(0);
  DMA_K(3,0);DMA_V(1,SLOTB);
  ROT();
  kload8(kf,kp0+sl_cur);
  WAIT_BAR(2);
  s16x4 vlo[8],vhi[8]; u32x4 pw0,pw1,pw2,pw3;
  #define PKW(P,B) cvtpk_s(P[B],P[B+1])
  #define PAF(k) __builtin_bit_cast(bf16x8,pw##k)
  #define VFR(i) (bf16x8){vlo[i][0],vlo[i][1],vlo[i][2],vlo[i][3],vhi[i][0],vhi[i][1],vhi[i][2],vhi[i][3]}
  #define PIN(x) asm volatile("":"+v"(x))
  #define MX3(a,b,c) __builtin_fmaxf(__builtin_fmaxf((a),(b)),(c))
  #define GAPA(MF,A0,A1,A2,A3,W0,W1,PW) do{ MF; sacc+=A0; sacc+=A1; sacc+=A2; sacc+=A3; PIN(sacc); W0; W1; PIN(PW); SBAR(); }while(0)
  #define EX(v) __builtin_amdgcn_exp2f(v)
  #define GAPB(MF,X,B) do{ MF; X[B]=EX(X[B]); X[B+1]=EX(X[B+1]); X[B+2]=EX(X[B+2]); X[B+3]=EX(X[B+3]); PIN(X); SBAR(); }while(0)
  #define VRD(i) do{ vlo[i]=vtr(vp_+(((i)>>2)*4096+((i)&3)*1024)); vhi[i]=vtr(vp_+(((i)>>2)*4096+((i)&3)*1024+512)); }while(0)
  #define KRD(G,j) do{ if(G){ kload2(kf,kp0+sl_next,j); SBAR(); } }while(0)
  #define STEP(C0,C1,P0,P1,t,GK,GV,GL) do{ SBAR(); \
    const lds_cptr vp_=vp0+sl_prev; \
    VRD(0); SBAR(); float sacc=(P0[0]+P0[1]); \
    GAPA(C0=__builtin_amdgcn_mfma_f32_32x32x16_bf16(kf[0],qr[0],negm,0,0,0), P0[2],P0[3],P0[4],P0[5],     pw0[0]=PKW(P0,0), pw0[1]=PKW(P0,2), pw0); \
    VRD(4); SBAR(); GAPA(C1=__builtin_amdgcn_mfma_f32_32x32x16_bf16(kf[1],qr[0],negm,0,0,0), P0[6],P0[7],P0[8],P0[9],     pw0[2]=PKW(P0,4), pw0[3]=PKW(P0,6), pw0); \
    VRD(1); SBAR(); GAPA(C0=__builtin_amdgcn_mfma_f32_32x32x16_bf16(kf[2],qr[1],C0,0,0,0),   P0[10],P0[11],P0[12],P0[13], pw1[0]=PKW(P0,8), pw1[1]=PKW(P0,10), pw1); \
    VRD(5); SBAR(); GAPA(C1=__builtin_amdgcn_mfma_f32_32x32x16_bf16(kf[3],qr[1],C1,0,0,0),   P0[14],P0[15],P1[0],P1[1],   pw1[2]=PKW(P0,12),pw1[3]=PKW(P0,14), pw1); \
    VRD(2); SBAR(); GAPA(C0=__builtin_amdgcn_mfma_f32_32x32x16_bf16(kf[4],qr[2],C0,0,0,0),   P1[2],P1[3],P1[4],P1[5],     pw2[0]=PKW(P1,0), pw2[1]=PKW(P1,2), pw2); \
    VRD(6); SBAR(); GAPA(C1=__builtin_amdgcn_mfma_f32_32x32x16_bf16(kf[5],qr[2],C1,0,0,0),   P1[6],P1[7],P1[8],P1[9],     pw2[2]=PKW(P1,4), pw2[3]=PKW(P1,6), pw2); \
    VRD(3); SBAR(); GAPA(C0=__builtin_amdgcn_mfma_f32_32x32x16_bf16(kf[6],qr[3],C0,0,0,0),   P1[10],P1[11],P1[12],P1[13], pw3[0]=PKW(P1,8), pw3[1]=PKW(P1,10), pw3); \
    VRD(7); SBAR(); GAPA(C1=__builtin_amdgcn_mfma_f32_32x32x16_bf16(kf[7],qr[3],C1,0,0,0),   P1[14],P1[15],0.f,0.f,       pw3[2]=PKW(P1,12),pw3[3]=PKW(P1,14), pw3); \
    l_reg+=sacc; \
    if(GK){DMA_K((t)+3,sl_cur);} if(GV){DMA_V((t)+1,sl_next);} \
    CMASK(C0,C1,t); \
    { float a=MX3(C0[0],C0[1],C1[0]),b=MX3(C0[2],C0[3],C1[1]); a=MX3(a,C1[2],C1[3]); \
      _Pragma("unroll") for(int r=4;r<16;r+=4){a=MX3(a,C0[r],C0[r+1]);b=MX3(b,C0[r+2],C0[r+3]);a=MX3(a,C1[r],C1[r+1]);b=MX3(b,C1[r+2],C1[r+3]);} \
      float rm=__builtin_fmaxf(a,b); { auto rr=__builtin_amdgcn_permlane32_swap(__float_as_uint(rm),__float_as_uint(rm),false,false); rm=__builtin_fmaxf(__uint_as_float(rr[0]),__uint_as_float(rr[1])); } \
      resc=false; \
      if(__builtin_expect(__any(rm>(float)THRL),0)){ const float dl=__builtin_fmaxf(rm,0.f); mhat+=dl; \
        _Pragma("unroll") for(int r=0;r<16;++r){C0[r]-=dl;C1[r]-=dl;} \
        _Pragma("unroll") for(int r=0;r<16;++r)negm[r]=-mhat; asm volatile("":"+v"(negm)); \
        const float f=__builtin_amdgcn_exp2f(-dl); l_reg*=f; if(hi==0)wsf[r32]=f; resc=true; } } \
    SBAR(); \
    GAPB(o[0]=__builtin_amdgcn_mfma_f32_32x32x16_bf16(PAF(0),VFR(0),o[0],0,0,0), C0,0); \
    GAPB(o[1]=__builtin_amdgcn_mfma_f32_32x32x16_bf16(PAF(0),VFR(4),o[1],0,0,0), C0,4); \
    KRD(GL,0); GAPB(o[0]=__builtin_amdgcn_mfma_f32_32x32x16_bf16(PAF(1),VFR(1),o[0],0,0,0), C0,8); \
    KRD(GL,1); GAPB(o[1]=__builtin_amdgcn_mfma_f32_32x32x16_bf16(PAF(1),VFR(5),o[1],0,0,0), C0,12); \
    KRD(GL,2); GAPB(o[0]=__builtin_amdgcn_mfma_f32_32x32x16_bf16(PAF(2),VFR(2),o[0],0,0,0), C1,0); \
    KRD(GL,3); GAPB(o[1]=__builtin_amdgcn_mfma_f32_32x32x16_bf16(PAF(2),VFR(6),o[1],0,0,0), C1,4); \
    GAPB(o[0]=__builtin_amdgcn_mfma_f32_32x32x16_bf16(PAF(3),VFR(3),o[0],0,0,0), C1,8); \
    GAPB(o[1]=__builtin_amdgcn_mfma_f32_32x32x16_bf16(PAF(3),VFR(7),o[1],0,0,0), C1,12); \
    }while(0)
  int t=1;
  #undef CMASK
  #define CMASK(P0,P1,t) do{}while(0)
  for(;t+5<NT;t+=2){
    STEP(pB0,pB1,pA0,pA1,t,true,true,true);     WAIT_BAR(2); RESC(); ROT();
    STEP(pA0,pA1,pB0,pB1,t+1,true,true,true);   WAIT_BAR(2); RESC(); ROT();
  }
  #undef CMASK
  #define CMASK(P0,P1,t) do{}while(0)
  #define ENDW(tt) do{ if((tt)+3<NT){WAIT_BAR(2);} else if((tt)+2<NT){WAIT_BAR(1);} else {WAIT_BAR(0);} }while(0)
  for(;t+1<NT;t+=2){
    STEP(pB0,pB1,pA0,pA1,t,(t+3<NT),(t+1<NT),(t+1<NT));       ENDW(t);   RESC(); ROT();
    STEP(pA0,pA1,pB0,pB1,t+1,(t+4<NT),(t+2<NT),(t+2<NT));     ENDW(t+1); RESC(); ROT();
  }
  STEP(pB0,pB1,pA0,pA1,NT-1,false,false,false); RESC();
  { float sacc=pB0[0]+pB0[1]; _Pragma("unroll") for(int r=2;r<16;++r)sacc+=pB0[r]; _Pragma("unroll") for(int r=0;r<16;++r)sacc+=pB1[r]; l_reg+=sacc;
    pw0=(u32x4){PKW(pB0,0),PKW(pB0,2),PKW(pB0,4),PKW(pB0,6)};pw1=(u32x4){PKW(pB0,8),PKW(pB0,10),PKW(pB0,12),PKW(pB0,14)};pw2=(u32x4){PKW(pB1,0),PKW(pB1,2),PKW(pB1,4),PKW(pB1,6)};pw3=(u32x4){PKW(pB1,8),PKW(pB1,10),PKW(pB1,12),PKW(pB1,14)};
    SBAR(); pv(o,vb0+sl_cur,PAF(0),PAF(1),PAF(2),PAF(3)); }
  #undef PKW
  #undef PAF
  #undef VFR
  #undef PIN
  #undef MX3
  #undef GAPA
  #undef GAPB
  #undef EX
  #undef VRD
  #undef KRD
  #undef STEP
  #undef ENDW
  {auto rr=__builtin_amdgcn_permlane32_swap(__float_as_uint(l_reg),__float_as_uint(l_reg),false,false);l_reg=__uint_as_float(rr[0])+__uint_as_float(rr[1]);}
  if(hi==0)wsf[32+r32]=l_reg;asm volatile("s_waitcnt lgkmcnt(0)":::"memory");
  float rli[16];
  #pragma unroll
  for(int r=0;r<16;++r)rli[r]=__builtin_amdgcn_rcpf(wsf[32+crow(r,hi)]);
  bf16*Ow=O+(rowbase+q0+wid*QBLK)*DM+h*D;
  { bf16*stg=(bf16*)(shm+LDS_OST)+wid*2048;
    #pragma unroll
    for(int r=0;r<16;++r){const int orow=crow(r,hi);
      #pragma unroll
      for(int d0=0;d0<2;++d0)stg[orow*64+d0*32+r32]=__float2bfloat16(o[d0][r]*rli[r]);}
    asm volatile("s_waitcnt lgkmcnt(0)":::"memory");
    #pragma unroll
    for(int i=0;i<4;++i){const int row=i*8+(lane>>3),ch=lane&7; const u32x4 v=*(const u32x4*)(stg+row*64+ch*8); ATTN_STORE16(Ow+(long)row*DM+ch*8,v);} }
  asm volatile("s_waitcnt lgkmcnt(0)\n\ts_barrier":::"memory");
  #undef DMA_K
  #undef DMA_V
  #undef CMASK
  #undef START
  #undef RESC
  #undef ROT
}
constexpr int ATTN_LDS_BYTES=LDS_BYTES;
struct AttnTensors { const bf16* Q; const bf16* K; const bf16* V; bf16* O; };
struct AttnUnit { int bh; int qb; };
struct StaticOrder {
  int vcu, per;
  __device__ __forceinline__ explicit StaticOrder(int grid,int vcu_):vcu(vcu_),per((BATCH*NHEAD*(SEQ/QB)+grid-1)/grid){}
  __device__ __forceinline__ bool next(int i,AttnUnit&u)const{ if(i>=per)return false; const int idx=vcu*per+i; if(idx>=BATCH*NHEAD*(SEQ/QB))return false; u.bh=idx/(SEQ/QB); u.qb=idx%(SEQ/QB); return true; }
  __device__ __forceinline__ void a_ready(const AttnUnit&)const{}
  __device__ __forceinline__ void done(const AttnUnit&)const{}
};
template<class Sched,int THRL=8> __device__ __forceinline__ void attn_phase(char*lds,const AttnTensors&T,const Sched&S){
  AttnUnit u;
  for(int i=0;S.next(i,u);++i){ S.a_ready(u); attn_unit<THRL>(u.bh/NHEAD,u.bh%NHEAD,u.qb,T.Q,T.K,T.V,T.O,lds); S.done(u); }
}
#undef SBAR
#undef WAIT_BAR
}

__device__ __forceinline__ void phase_attn_fast(ArgsP a, const Fr& F) {
    const attn_body::AttnTensors AT{(const attn_body::bf16*)(a->ws + SC_Q), (const attn_body::bf16*)(a->ws + SC_K), (const attn_body::bf16*)(a->ws + SC_V), (attn_body::bf16*)(a->ws + SC_O)};
    const attn_body::StaticOrder S(F.G, F.vcu);
    __syncthreads();
    attn_body::attn_phase<attn_body::StaticOrder>((char*)F.lds, AT, S);
    __syncthreads();
}
__device__ __forceinline__ void phase_sp_fast(ArgsP a, const Fr& F) {
    typedef short bf16x8 __attribute__((ext_vector_type(8)));
    constexpr int PITCH = 136;
    LAS unsigned short* As = (LAS unsigned short*)F.lds;
    LAS unsigned short* Bs = As + 128 * PITCH;
    LAS float* st = (LAS float*)(Bs + 128 * PITCH);
    const float* VT = (const float*)(a->ws + SC_VT); const f32x2* VST = (const f32x2*)(a->ws + SC_VST); const bf16* UB = (const bf16*)(a->ws + SC_UB); bf16* UV = (bf16*)(a->ws + SC_UV);
    const bf16* WS = (const bf16*)(a->ws + WS_WCMS);
    const float* lng = a->in[I_CMLNG]; const float* lnb = a->in[I_CMLNB]; const float* bs = a->in[I_CMBS];
    const int tid = F.tid, lane = F.lane, wid = F.wave, wr = wid >> 2, wc = wid & 3, fr = lane & 15, fq = lane >> 4;
    const int per = (2048 + F.G - 1) / F.G; int gl = -1;
    for (int it = F.vcu * per; it < (F.vcu + 1) * per && it < 2048; ++it) {
        const int g = it >> 7, n = it & 127;
        __syncthreads();
        if (g != gl) { gl = g;
#pragma unroll
            for (int q = 0; q < 4; ++q) { const int idx = tid + q * NTHR, t = idx >> 4, ck = idx & 15;
                *(LAS v4u*)(As + t * PITCH + ck * 8) = *(const v4u*)(WS + (size_t)g * 16384 + t * 128 + ck * 8); } }
        if (tid < 128) { float s1 = 0.f, s2 = 0.f;
#pragma unroll
            for (int p = 0; p < 16; ++p) { const f32x2 v = VST[(size_t)p * T + n * 128 + tid]; s1 += v.x; s2 += v.y; }
            const float mean = s1 * (1.0f / 2048.0f); const float var = s2 * (1.0f / 2048.0f) - mean * mean; st[tid * 2] = mean; st[tid * 2 + 1] = 1.0f / sqrtf(var + LN_EPS); }
        __syncthreads();
        { const int s4 = (lane & 31) * 4; const int ch = lane >> 5;
          const f32x4 mu = {st[(s4 + 0) * 2], st[(s4 + 1) * 2], st[(s4 + 2) * 2], st[(s4 + 3) * 2]};
          const f32x4 rs = {st[(s4 + 0) * 2 + 1], st[(s4 + 1) * 2 + 1], st[(s4 + 2) * 2 + 1], st[(s4 + 3) * 2 + 1]};
#pragma unroll
          for (int q = 0; q < 8; ++q) { const int c = q * 16 + wid * 2 + ch; const int chn = g * 128 + c;
              const f32x4 v = *(const f32x4*)(VT + (size_t)chn * T + n * 128 + s4);
              const float lg = lng[chn], lb = lnb[chn];
              const f32x4 y = (v - mu) * rs * lg + lb;
              v2u o; o.x = pk2(y[0], y[1]); o.y = pk2(y[2], y[3]); *(LAS v2u*)(Bs + c * PITCH + s4) = o; } }
        __syncthreads();
        f32x4 acc[4][2];
#pragma unroll
        for (int m = 0; m < 4; ++m)
#pragma unroll
            for (int nn = 0; nn < 2; ++nn) acc[m][nn] = (f32x4){0.f, 0.f, 0.f, 0.f};
#pragma unroll
        for (int k = 0; k < 4; ++k) {
            bf16x8 af[4], bfr[2];
#pragma unroll
            for (int m = 0; m < 4; ++m) af[m] = *(const LAS bf16x8*)(As + (wr * 64 + m * 16 + fr) * PITCH + k * 32 + fq * 8);
#pragma unroll
            for (int nn = 0; nn < 2; ++nn) bfr[nn] = *(const LAS bf16x8*)(Bs + (wc * 32 + nn * 16 + fr) * PITCH + k * 32 + fq * 8);
#pragma unroll
            for (int m = 0; m < 4; ++m)
#pragma unroll
                for (int nn = 0; nn < 2; ++nn) acc[m][nn] = __builtin_amdgcn_mfma_f32_16x16x32_bf16(bfr[nn], af[m], acc[m][nn], 0, 0, 0);
        }
#pragma unroll
        for (int m = 0; m < 4; ++m) { const int t = wr * 64 + m * 16 + fr; const float bt = bs[g * 128 + t];
#pragma unroll
            for (int nn = 0; nn < 2; ++nn) { const size_t idx = (size_t)(n * 128 + t) * 2048 + g * 128 + wc * 32 + nn * 16 + 4 * fq;
                const v2u ub = *(const v2u*)(UB + idx); const f32x4 o = acc[m][nn] + bt;
                v2u w; w.x = pk2(__builtin_bit_cast(float, ub.x << 16) * o[0], __builtin_bit_cast(float, ub.x & 0xffff0000u) * o[1]);
                w.y = pk2(__builtin_bit_cast(float, ub.y << 16) * o[2], __builtin_bit_cast(float, ub.y & 0xffff0000u) * o[3]);
                *(v2u*)(UV + idx) = w; } }
    }
}
__device__ __forceinline__ void phase_rope(ArgsP a, const Fr& F) {
    const float* QKV = (const float*)(a->ws + SC_QKV); bf16* Q = (bf16*)(a->ws + SC_Q); bf16* K = (bf16*)(a->ws + SC_K); bf16* V = (bf16*)(a->ws + SC_V);
    const int gw = F.vcu * NWAVES + F.wave, NGW = F.G * NWAVES;
    const int i = F.lane & 31, hs = F.lane >> 5;
    const float qg0 = a->in[I_QGAIN][i], qg1 = a->in[I_QGAIN][i + 32], kg0 = a->in[I_KGAIN][i], kg1 = a->in[I_KGAIN][i + 32];
    const float invf = powf(10000.0f, -(float)(i & 15) / 16.0f);
    for (int row = gw; row < TA; row += NGW) {
        const bool lat = row < T; const int b = lat ? (row >> 12) : ((row - T) >> 8); const int t = lat ? (row & 4095) : ((row - T) & 255);
        float cs = 1.f, sn = 0.f;
        if (lat) { const float pos = (i < 16) ? (float)(t >> 6) : (float)(t & 63); sincosf(pos * invf, &sn, &cs); }
        const float* src = QKV + (size_t)row * 1536;
        const size_t krow = (size_t)b * LK + (lat ? LC + t : t);
#pragma unroll
        for (int j = 0; j < 12; ++j) { const int hh = 2 * j + hs;
            if (!lat && hh < 16) continue;
            const float x1 = src[hh * 64 + i], x2 = src[hh * 64 + 32 + i];
            if (hh < 20) {
                float ss = x1 * x1 + x2 * x2;
#pragma unroll
                for (int o = 1; o < 32; o <<= 1) ss += __shfl_xor(ss, o);
                const float rs = 1.0f / sqrtf(ss * (1.0f / 64.0f) + RMS_EPS);
                const bool isq = hh < 16;
                const float n1 = x1 * rs * (isq ? qg0 : kg0), n2 = x2 * rs * (isq ? qg1 : kg1);
                float o1 = n1 * cs - n2 * sn, o2 = n1 * sn + n2 * cs;
                if (isq) { o1 *= ATT_C2; o2 *= ATT_C2; bf16* d = Q + (size_t)row * 1024 + hh * 64; d[i] = (bf16)f2bf(o1); d[i + 32] = (bf16)f2bf(o2); }
                else { bf16* d = K + krow * KVP + (hh - 16) * 64; d[i] = (bf16)f2bf(o1); d[i + 32] = (bf16)f2bf(o2); }
            } else { bf16* d = V + krow * KVP + (hh - 20) * 64; d[i] = (bf16)f2bf(x1); d[i + 32] = (bf16)f2bf(x2); }
        }
    }
}
__device__ __forceinline__ void phase_attn_simple(ArgsP a, const Fr& F) {
    const bf16* Q = (const bf16*)(a->ws + SC_Q); const bf16* K = (const bf16*)(a->ws + SC_K); const bf16* V = (const bf16*)(a->ws + SC_V); bf16* O = (bf16*)(a->ws + SC_O);
    for (int it = F.vcu; it < 512; it += F.G) {
        const int b = it >> 7, h = (it >> 3) & 15, q = (it & 7) * 512 + F.tid;
        const bf16* qp = Q + (size_t)(b * SEQ + q) * 1024 + h * 64;
        float qv[64], o[64];
#pragma unroll
        for (int d = 0; d < 64; ++d) { qv[d] = bf2f(qp[d]); o[d] = 0.f; }
        float m = -3.0e38f, l = 0.f;
        const bf16* kb = K + (size_t)b * LK * KVP + (h >> 2) * 64; const bf16* vb = V + (size_t)b * LK * KVP + (h >> 2) * 64;
        for (int s = 0; s < LK; ++s) {
            const v4u* kr = (const v4u*)(kb + (size_t)s * KVP); float sc = 0.f;
#pragma unroll
            for (int c = 0; c < 8; ++c) { const v4u kv = kr[c]; const unsigned w[4] = {kv.x, kv.y, kv.z, kv.w};
#pragma unroll
                for (int j = 0; j < 4; ++j) { sc += qv[c * 8 + 2 * j] * __builtin_bit_cast(float, w[j] << 16) + qv[c * 8 + 2 * j + 1] * __builtin_bit_cast(float, w[j] & 0xffff0000u); } }
            const float mn = fmaxf(m, sc); const float al = exp2f(m - mn), p = exp2f(sc - mn); l = l * al + p; m = mn;
            const v4u* vr = (const v4u*)(vb + (size_t)s * KVP);
#pragma unroll
            for (int c = 0; c < 8; ++c) { const v4u vv = vr[c]; const unsigned w[4] = {vv.x, vv.y, vv.z, vv.w};
#pragma unroll
                for (int j = 0; j < 4; ++j) { o[c * 8 + 2 * j] = o[c * 8 + 2 * j] * al + p * __builtin_bit_cast(float, w[j] << 16); o[c * 8 + 2 * j + 1] = o[c * 8 + 2 * j + 1] * al + p * __builtin_bit_cast(float, w[j] & 0xffff0000u); } }
        }
        const float il = 1.0f / l; bf16* op = O + (size_t)(b * SEQ + q) * 1024 + h * 64;
#pragma unroll
        for (int c = 0; c < 8; ++c) { v4u w; w.x = pk2(o[c * 8] * il, o[c * 8 + 1] * il); w.y = pk2(o[c * 8 + 2] * il, o[c * 8 + 3] * il); w.z = pk2(o[c * 8 + 4] * il, o[c * 8 + 5] * il); w.w = pk2(o[c * 8 + 6] * il, o[c * 8 + 7] * il);
            *(v4u*)(op + c * 8) = w; }
    }
}
__device__ __forceinline__ void phase_sp_simple(ArgsP a, const Fr& F) {
    LAS float* wsL = (LAS float*)F.lds;
    LAS float* vl = wsL + 128 * 128;
    LAS float* st = vl + 128 * 128;
    const float* VT = (const float*)(a->ws + SC_VT); const f32x2* VST = (const f32x2*)(a->ws + SC_VST); const bf16* UB = (const bf16*)(a->ws + SC_UB); bf16* UV = (bf16*)(a->ws + SC_UV);
    const int per = (2048 + F.G - 1) / F.G; int gl = -1;
    for (int it = F.vcu * per; it < (F.vcu + 1) * per && it < 2048; ++it) {
        const int g = it >> 7, n = it & 127;
        __syncthreads();
        if (g != gl) { for (int u = F.tid; u < 128 * 128; u += NTHR) wsL[u] = a->in[I_CMWS][(size_t)g * 16384 + u]; gl = g; }
        if (F.tid < 128) { float s1 = 0.f, s2 = 0.f; for (int p = 0; p < 16; ++p) { const f32x2 v = VST[(size_t)p * T + n * 128 + F.tid]; s1 += v.x; s2 += v.y; }
            const float mean = s1 * (1.0f / 2048.0f); const float var = s2 * (1.0f / 2048.0f) - mean * mean; st[F.tid * 2] = mean; st[F.tid * 2 + 1] = 1.0f / sqrtf(var + LN_EPS); }
        __syncthreads();
        for (int u = F.tid; u < 128 * 128; u += NTHR) { const int c = u >> 7, s = u & 127; const int ch = g * 128 + c;
            const float v = VT[(size_t)ch * T + n * 128 + s]; vl[s * 128 + c] = (v - st[s * 2]) * st[s * 2 + 1] * a->in[I_CMLNG][ch] + a->in[I_CMLNB][ch]; }
        __syncthreads();
        const int c = F.tid & 127, tq = F.tid >> 7;
        for (int jj = 0; jj < 32; ++jj) { const int t = tq + 4 * jj; float acc = 0.f;
            for (int s = 0; s < 128; ++s) acc += wsL[t * 128 + s] * vl[s * 128 + c];
            acc += a->in[I_CMBS][g * 128 + t];
            const size_t idx = (size_t)(n * 128 + t) * 2048 + g * 128 + c;
            UV[idx] = (bf16)f2bf(bf2f(UB[idx]) * acc); }
    }
}
#ifndef MK_FAST_CONV
#define MK_FAST_CONV 0
#endif
#ifndef MK_FAST_ATTN
#define MK_FAST_ATTN 0
#endif
#ifndef MK_FAST_SP
#define MK_FAST_SP 0
#endif
#ifndef MK_GATHER
#define MK_GATHER 0
#endif
constexpr int MOE_PH = MK_GATHER ? 5 : 6;
constexpr int N_PHASES = 2 + (4 + MOE_PH) + (4 + MOE_PH) + (3 + MOE_PH) + (4 + MOE_PH);

#ifndef MK_REPMASK
#define MK_REPMASK 0ull
#endif
#ifndef MK_REPN
#define MK_REPN 3
#endif
#define REPS for (int rep_ = 0; rep_ < (((MK_REPMASK >> p) & 1ull) ? MK_REPN : 1); ++rep_)
#define IN() (get_args()->ph_lo <= p && p < get_args()->ph_hi)
#define PHB ArgsP a = get_args(); unsigned char* ws = a->ws; (void)ws; const Fr F = mkfr(lds_raw);
#define SEAM() do { { ArgsP a__ = get_args(); if (a__->ph_lo <= p && p + 1 < a__->ph_hi) { XcdBarrier bb; bb.bar = (unsigned*)(a__->ws + WS_CTL) + 4096; bb.x = xb_xcc_id(); \
        bb.st = (volatile LAS unsigned*)((LAS unsigned char*)lds_raw + MISC_OFF) + 8; xcd_barrier(bb); } } ++p; } while (0)
template <int layer> __device__ __forceinline__ void layer_body(int& p, unsigned char* lds_raw) {
    PG8_LAS unsigned char* ring = (PG8_LAS unsigned char*)lds_raw;
        constexpr int kind = layer % 3;
        const int nrows = layer == 0 ? TA : T;
#define G1PTR ((const float*)(ws + WS_MOD) + (size_t)layer * 5 * 6144 + 2048)
        if constexpr (kind == 0) {
            const int slot = layer == 0 ? 0 : 1;
            REPS if (IN()) { PHB pg8::Gemm g{(const pg8::bf16_t*)(ws + WS_WHYIN) + (size_t)slot * 3072 * 1024, (const pg8::bf16_t*)(ws + WS_HB), 3072, nrows, 1024, nullptr};
                pg8::StaticOrder S; S.init(3072, nrows, F.G, F.bx); pg8::EpiBf16<0> E{(pg8::bf16_t*)(ws + SC_PT), TA, nullptr, 0, 0, 1.f};
                pg8::gemm_phase<pg8::EpiBf16<0>, pg8::StaticOrder, true, false>(ring, g, S, E); }
            SEAM();
            REPS if (IN()) { PHB
#if MK_FAST_CONV
                phase_hy_conv_fft(a, F, layer);
#else
                phase_hy_conv_direct(a, F, layer);
#endif
            }
            SEAM();
            REPS if (IN()) { PHB phase_hy_tr(a, F, nrows); }
            SEAM();
            REPS if (IN()) { PHB pg8::Gemm g{(const pg8::bf16_t*)(ws + SC_Z2), (const pg8::bf16_t*)(ws + WS_WHYOUT) + (size_t)slot * 1024 * 1024, nrows, 1024, 1024, nullptr};
                pg8::StaticOrder S; S.init(nrows, 1024, F.G, F.bx); pg8::EpiRes E{(const float*)(ws + WS_XC), (float*)(ws + WS_U), G1PTR, 6144, ALPHA};
                pg8::gemm_phase<pg8::EpiRes, pg8::StaticOrder, true, false>(ring, g, S, E); }
            SEAM();
        } else if constexpr (kind == 1) {
            REPS if (IN()) { PHB pg8::Gemm g{(const pg8::bf16_t*)(ws + WS_HB), (const pg8::bf16_t*)(ws + WS_WQKV), TA, 1536, 1024, nullptr};
                pg8::StaticOrder S; S.init(TA, 1536, F.G, F.bx); pg8::EpiF32 E{(float*)(ws + SC_QKV), 1536};
                pg8::gemm_phase<pg8::EpiF32, pg8::StaticOrder, true, false>(ring, g, S, E); }
            SEAM();
            REPS if (IN()) { PHB phase_rope(a, F); }
            SEAM();
            REPS if (IN()) { PHB
#if MK_FAST_ATTN
                phase_attn_fast(a, F);
#else
                phase_attn_simple(a, F);
#endif
            }
            SEAM();
            REPS if (IN()) { PHB pg8::Gemm g{(const pg8::bf16_t*)(ws + SC_O), (const pg8::bf16_t*)(ws + WS_WATO), T, 1024, 1024, nullptr};
                pg8::StaticOrder S; S.init(T, 1024, F.G, F.bx); pg8::EpiRes E{(const float*)(ws + WS_XC), (float*)(ws + WS_U), G1PTR, 6144, ALPHA};
                pg8::gemm_phase<pg8::EpiRes, pg8::StaticOrder, true, false>(ring, g, S, E); }
            SEAM();
        } else {
            REPS if (IN()) {
                { PHB pg8::Gemm g{(const pg8::bf16_t*)(ws + WS_HB), (const pg8::bf16_t*)(ws + WS_WCMIN), T, 2048, 1024, nullptr};
                  pg8::StaticOrder S; S.init(T, 2048, F.G, F.bx); pg8::EpiBf16<1> E{(pg8::bf16_t*)(ws + SC_UB), 2048, nullptr, 0, 0, 1.f};
                  pg8::gemm_phase<pg8::EpiBf16<1>, pg8::StaticOrder, true, false>(ring, g, S, E); }
                { PHB pg8::Gemm g{(const pg8::bf16_t*)(ws + WS_WCMIN) + (size_t)2048 * 1024, (const pg8::bf16_t*)(ws + WS_HB), 2048, T, 1024, nullptr};
                  pg8::StaticOrder S; S.init(2048, T, F.G, F.bx); pg8::EpiVT E{(float*)(ws + SC_VT), T, (pg8::f32x2*)(ws + SC_VST), T};
                  pg8::gemm_phase<pg8::EpiVT, pg8::StaticOrder, true, false>(ring, g, S, E); }
            }
            SEAM();
            REPS if (IN()) { PHB
#if MK_FAST_SP
                phase_sp_fast(a, F);
#else
                phase_sp_simple(a, F);
#endif
            }
            SEAM();
            REPS if (IN()) { PHB pg8::Gemm g{(const pg8::bf16_t*)(ws + SC_UV), (const pg8::bf16_t*)(ws + WS_WCMOUT), T, 1024, 2048, nullptr};
                pg8::StaticOrder S; S.init(T, 1024, F.G, F.bx); pg8::EpiRes E{(const float*)(ws + WS_XC), (float*)(ws + WS_U), G1PTR, 6144, ALPHA};
                pg8::gemm_phase<pg8::EpiRes, pg8::StaticOrder, true, false>(ring, g, S, E); }
            SEAM();
        }
        REPS if (IN()) { PHB phase_lnr(a, F, layer, nrows); }
        SEAM();
        REPS if (IN()) { PHB phase_topk(a, F, layer); }
        SEAM();
        const int npm = layer == 0 ? 9 : 8;
#if MK_GATHER
        REPS if (IN()) { PHB pg8::Gemm g{(const pg8::bf16_t*)(ws + WS_HB), (const pg8::bf16_t*)(ws + WS_WGU) + (size_t)layer * 16 * 4096 * 1024, 0, 0, 1024, (const int*)(ws + WS_ROWS)};
            pg8::MoeOrder S{npm, 16, F.G, F.vcu}; pg8::EpiGU E{(pg8::bf16_t*)(ws + WS_ACT), 16};
            pg8::gemm_phase<pg8::EpiGU, pg8::MoeOrder, true, true>(ring, g, S, E); }
        SEAM();
#else
        REPS if (IN()) { PHB phase_gather(a, F, layer); }
        SEAM();
        REPS if (IN()) { PHB pg8::Gemm g{(const pg8::bf16_t*)(ws + WS_XG), (const pg8::bf16_t*)(ws + WS_WGU) + (size_t)layer * 16 * 4096 * 1024, 0, 0, 1024, nullptr};
            pg8::MoeOrder S{npm, 16, F.G, F.vcu}; pg8::EpiGU E{(pg8::bf16_t*)(ws + WS_ACT), 16};
            pg8::gemm_phase<pg8::EpiGU, pg8::MoeOrder, true, false>(ring, g, S, E); }
        SEAM();
#endif
        REPS if (IN()) { PHB pg8::Gemm g{(const pg8::bf16_t*)(ws + WS_ACT), (const pg8::bf16_t*)(ws + WS_WDN) + (size_t)layer * 16 * 1024 * 2048, 0, 0, 2048, nullptr};
            pg8::MoeOrder S{npm, 4, F.G, F.vcu}; pg8::EpiDN E{(pg8::bf16_t*)(ws + WS_Y), (const float*)(ws + WS_GATE), 4};
            pg8::gemm_phase<pg8::EpiDN, pg8::MoeOrder, true, false>(ring, g, S, E); }
        SEAM();
        REPS if (IN()) { PHB phase_comb(a, F, layer, nrows); }
        SEAM();
    }
__global__ void __launch_bounds__(NTHR, 2) mk_fwd(Args a_) {
    extern __shared__ __attribute__((aligned(16))) unsigned char lds_raw[];
    Fr F0 = mkfr(lds_raw);
    volatile LAS unsigned* MISC = (volatile LAS unsigned*)(F0.lds + MISC_OFF);
    if (F0.tid < 32) MISC[F0.tid] = 0u;
    __syncthreads();
    if (a_.ph_hi - a_.ph_lo > 1) (void)xcd_barrier_post((unsigned*)(a_.ws + WS_CTL) + 4096, MISC + 8);
    int p = 0;
    PG8_LAS unsigned char* ring = (PG8_LAS unsigned char*)lds_raw;

    REPS if (IN()) { PHB phase_proA(a, F); }
    SEAM();
    REPS if (IN()) { PHB phase_proB(a, F); }
    SEAM();
    layer_body<0>(p, lds_raw); layer_body<1>(p, lds_raw); layer_body<2>(p, lds_raw); layer_body<3>(p, lds_raw);
#undef IN
#undef PHB
#undef G1PTR
#undef SEAM
}

#ifndef MK_N_LAUNCHES
#define MK_N_LAUNCHES 0
#endif
extern "C" void kernel_launch(void* const* d_in, const int* in_sizes, int n_in, void* d_out, int out_size, void* d_ws, size_t ws_size, hipStream_t stream) {
    static int grid = 0;
    if (grid == 0) {
        if (n_in != 33 || out_size != T * D || ws_size < WS_END) { fprintf(stderr, "kernel_launch: expected 33 inputs, %d outputs, >= %zu bytes of workspace; got %d, %d, %zu\n", T * D, (size_t)WS_END, n_in, out_size, ws_size); grid = -1; return; }
        int dev = 0, cus = 0, per_cu = 0;
        if (hipGetDevice(&dev) != hipSuccess || hipDeviceGetAttribute(&cus, hipDeviceAttributeMultiprocessorCount, dev) != hipSuccess) { grid = -1; return; }
        if (hipFuncSetAttribute((const void*)mk_fwd, hipFuncAttributeMaxDynamicSharedMemorySize, LDS_BYTES) != hipSuccess) { fprintf(stderr, "kernel_launch: hipFuncSetAttribute failed\n"); grid = -1; return; }
        if (hipOccupancyMaxActiveBlocksPerMultiprocessor(&per_cu, (const void*)mk_fwd, NTHR, LDS_BYTES) != hipSuccess || per_cu < 1)
            fprintf(stderr, "kernel_launch: note: occupancy query reports %d workgroups per CU\n", per_cu);
        (void)hipGetLastError();
        grid = cus;
    }
    if (grid < 0) return;
    (void)hipMemsetAsync((char*)d_ws + WS_CTL, 0, 1 * MiB, stream);
    Args a{};
    for (int i = 0; i < 33; ++i) a.in[i] = (const float*)d_in[i];
    a.out = (float*)d_out; a.ws = (unsigned char*)d_ws;
#if MK_N_LAUNCHES == 1
    a.ph_lo = 0; a.ph_hi = N_PHASES;
    hipLaunchKernelGGL(mk_fwd, dim3(grid), dim3(NTHR), LDS_BYTES, stream, a);
#else
    for (int p = 0; p < N_PHASES; ++p) { a.ph_lo = p; a.ph_hi = p + 1; hipLaunchKernelGGL(mk_fwd, dim3(grid), dim3(NTHR), LDS_BYTES, stream, a); }
#endif
    const hipError_t le = hipPeekAtLastError();
    if (le != hipSuccess) fprintf(stderr, "kernel_launch: launch failed: %s\n", hipGetErrorName(le));
}
```

```cpp
#define MK_N_LAUNCHES 1
#define MK_FAST_ATTN 1
#define MK_FAST_CONV 1
#define MK_GATHER 1
#define MK_FAST_SP 1
#include <hip/hip_runtime.h>
#include <cstdio>
#include <cstdint>
#include <cmath>
namespace pg8 {
#define PG8_LAS __attribute__((address_space(3)))
typedef unsigned short bf16_t;
typedef short bf16x8 __attribute__((ext_vector_type(8)));
typedef float f32x4 __attribute__((ext_vector_type(4)));
typedef unsigned u32x4 __attribute__((ext_vector_type(4)));
constexpr int BM = 256, BK = 64, HALF = 128, HTB = HALF * BK * 2  , STAGE_BYTES = 8 * HTB, NXCD = 8, WGM = 8;

__host__ __device__ __forceinline__ int lds_byte(int r, int c) { const int st = (r >> 4) * 2 + (c >> 5), rr = r & 15, cc = c & 31, ob = rr * 64 + cc * 2; return st * 1024 + (ob ^ (((ob >> 9) & 1) << 5)); }
__host__ __device__ __forceinline__ void stage_rc(int b, int& R, int& C) { const int st = b / 1024, sb = b % 1024, swz = sb ^ (((sb >> 9) & 1) << 5); R = (st >> 1) * 16 + swz / 64; C = (st & 1) * 32 + (swz % 64) / 2; }
__host__ __device__ __forceinline__ int perm32(int rho) { const int n = rho >> 4, i = rho & 15; return 8 * (i >> 2) + 4 * n + (i & 3); }

struct Unit { int pm, pn; };
struct Gemm { const bf16_t* A; const bf16_t* Bt; int M, N, K; const int* rows; };

struct StaticOrder {
    int nM, nN, nwg, G, c;
    __host__ __device__ void init(int M, int N, int G_, int c_) { nM = M / BM; nN = N / BM; nwg = nM * nN; G = G_; c = c_; }
    __host__ __device__ bool next(int i, Unit& u) const {
        const long L = (long)i * G + c; if (L >= nwg) return false;
        int wgid = (int)L; { const int q = nwg / NXCD, r = nwg % NXCD, xcd = wgid % NXCD, off = wgid / NXCD; wgid = (xcd < r ? xcd * (q + 1) : r * (q + 1) + (xcd - r) * q) + off; }
        const int nig = WGM * nN, gid = wgid / nig, fm = gid * WGM, gsz = (nM - fm) < WGM ? (nM - fm) : WGM;
        u.pm = fm + ((wgid % nig) % gsz); u.pn = (wgid % nig) / gsz; return true;
    }
    __device__ __forceinline__ void a_ready(const Unit&) const {}
    __device__ __forceinline__ void done(const Unit&) const {}
};

__device__ __forceinline__ unsigned cvt_pk_bf16(float lo, float hi) { unsigned r; asm volatile("v_cvt_pk_bf16_f32 %0, %1, %2" : "=v"(r) : "v"(lo), "v"(hi)); return r; }
typedef float f32x2 __attribute__((ext_vector_type(2)));
__device__ __forceinline__ f32x2 gelu_pk(f32x2 v) {
    const f32x2 av = __builtin_elementwise_abs(v), d = av * 0.2316418882f + 1.0f;
    f32x2 t; t.x = __builtin_amdgcn_rcpf(d.x); t.y = __builtin_amdgcn_rcpf(d.y);
    f32x2 q = t * 0.5307027145f + (-0.7265760135f); q = q * t + 0.7107068705f; q = q * t + (-0.142248368f); q = q * t + 0.127414796f; q = q * t;
    const f32x2 s = (v * v) * (-0.72134752044f);
    f32x2 e; e.x = __builtin_amdgcn_exp2f(s.x); e.y = __builtin_amdgcn_exp2f(s.y);
    const f32x2 m = v * (q * e), r = v - m;
    f32x2 o; o.x = v.x < 0.f ? m.x : r.x; o.y = v.y < 0.f ? m.y : r.y; return o;
}

template <int ACT  > struct EpiBf16 {
    static constexpr bool PERM = true, AFTER_DRAIN = false; static_assert(ACT == 0 || ACT == 1, "EpiBf16: ACT is 0 (none) or 1 (gelu_pk)");
    bf16_t* O; int ldc; const float* bias; int split_cols; size_t split_stride; float scale0;
    __device__ __forceinline__ void operator()(const f32x4 (&acc)[2][2][4][2], const Unit& u, int wr, int wc, int fr, int fq) const {
        const int row0 = u.pm * BM + wr * 64 + fr; int colt = u.pn * BM; bf16_t* base = O;
        float sc = 1.f; if (split_cols) { const int t = colt / split_cols; base += (size_t)t * split_stride; colt -= t * split_cols; if (t == 0) sc = scale0; }
        const int col0 = colt + wc * 32 + 8 * fq, bcol0 = u.pn * BM + wc * 32 + 8 * fq;
        f32x4 bv[2][2];
#pragma unroll
        for (int bj = 0; bj < 2; ++bj)
#pragma unroll
            for (int n = 0; n < 2; ++n) bv[bj][n] = bias ? *(const f32x4*)(bias + bcol0 + bj * HALF + 4 * n) : (f32x4){0.f, 0.f, 0.f, 0.f};
#pragma unroll
        for (int ai = 0; ai < 2; ++ai)
#pragma unroll
            for (int m = 0; m < 4; ++m) { bf16_t* rowp = base + (size_t)(row0 + ai * HALF + m * 16) * ldc + col0;
#pragma unroll
                for (int bj = 0; bj < 2; ++bj) { f32x4 v0 = acc[ai][bj][m][0] + bv[bj][0], v1 = acc[ai][bj][m][1] + bv[bj][1];
                    if (ACT == 1) { f32x2 a = gelu_pk((f32x2){v0[0], v0[1]}), b = gelu_pk((f32x2){v0[2], v0[3]}), c = gelu_pk((f32x2){v1[0], v1[1]}), d = gelu_pk((f32x2){v1[2], v1[3]});
                        v0 = (f32x4){a.x, a.y, b.x, b.y}; v1 = (f32x4){c.x, c.y, d.x, d.y}; }
                    v0 = v0 * sc; v1 = v1 * sc; u32x4 w; w.x = cvt_pk_bf16(v0[0], v0[1]); w.y = cvt_pk_bf16(v0[2], v0[3]); w.z = cvt_pk_bf16(v1[0], v1[1]); w.w = cvt_pk_bf16(v1[2], v1[3]);
                    *(u32x4*)(rowp + bj * HALF) = w; } }
    }
};

struct EpiF32 {
    static constexpr bool PERM = false, AFTER_DRAIN = false;
    float* C; int ldc;
    __device__ __forceinline__ void operator()(const f32x4 (&acc)[2][2][4][2], const Unit& u, int wr, int wc, int fr, int fq) const {
        const int row0 = u.pm * BM + wr * 64 + fr, col0 = u.pn * BM + wc * 32 + 4 * fq;
#pragma unroll
        for (int ai = 0; ai < 2; ++ai)
#pragma unroll
            for (int m = 0; m < 4; ++m) { float* rowp = C + (size_t)(row0 + ai * HALF + m * 16) * ldc + col0;
#pragma unroll
                for (int bj = 0; bj < 2; ++bj)
#pragma unroll
                    for (int n = 0; n < 2; ++n) *(f32x4*)(rowp + bj * HALF + n * 16) = acc[ai][bj][m][n]; }
    }
};
struct EpiRes {
    static constexpr bool PERM = false, AFTER_DRAIN = false;
    const float* X; float* U; const float* g; int gstride; float alpha;
    __device__ __forceinline__ void operator()(const f32x4 (&acc)[2][2][4][2], const Unit& u, int wr, int wc, int fr, int fq) const {
        const int row0 = u.pm * BM + wr * 64 + fr, col0 = u.pn * BM + wc * 32 + 4 * fq;
        const int rb = u.pm * BM; const int bidx = rb < 16384 ? (rb >> 12) : 4;
        const float* gp = g + (size_t)bidx * gstride + col0;
        f32x4 gv[2][2];
#pragma unroll
        for (int bj = 0; bj < 2; ++bj)
#pragma unroll
            for (int n = 0; n < 2; ++n) gv[bj][n] = *(const f32x4*)(gp + bj * HALF + n * 16);
#pragma unroll
        for (int ai = 0; ai < 2; ++ai)
#pragma unroll
            for (int m = 0; m < 4; ++m) { const size_t off = (size_t)(row0 + ai * HALF + m * 16) * 1024 + col0;
#pragma unroll
                for (int bj = 0; bj < 2; ++bj)
#pragma unroll
                    for (int n = 0; n < 2; ++n) { const f32x4 xv = *(const f32x4*)(X + off + bj * HALF + n * 16);
                        *(f32x4*)(U + off + bj * HALF + n * 16) = xv * alpha + gv[bj][n] * acc[ai][bj][m][n]; }
                asm volatile("" ::: "memory"); }
    }
};
struct EpiGU {
    static constexpr bool PERM = true, AFTER_DRAIN = false;
    bf16_t* ACT; int npn;
    __device__ __forceinline__ void operator()(const f32x4 (&acc)[2][2][4][2], const Unit& u, int wr, int wc, int fr, int fq) const {
        const int row0 = u.pm * BM + wr * 64 + fr; const int col0 = (u.pn % npn) * 128 + wc * 32 + 8 * fq;
#pragma unroll
        for (int ai = 0; ai < 2; ++ai)
#pragma unroll
            for (int m = 0; m < 4; ++m) { bf16_t* rowp = ACT + (size_t)(row0 + ai * HALF + m * 16) * 2048 + col0;
                float o[8];
#pragma unroll
                for (int n = 0; n < 2; ++n)
#pragma unroll
                    for (int j = 0; j < 4; ++j) { const float a = acc[ai][0][m][n][j], b = acc[ai][1][m][n][j];
                        const float s = a * __builtin_amdgcn_rcpf(1.0f + __builtin_amdgcn_exp2f(-1.4426950408889634f * a)); o[n * 4 + j] = s * b; }
                u32x4 w; w.x = cvt_pk_bf16(o[0], o[1]); w.y = cvt_pk_bf16(o[2], o[3]); w.z = cvt_pk_bf16(o[4], o[5]); w.w = cvt_pk_bf16(o[6], o[7]);
                *(u32x4*)rowp = w; }
    }
};
struct EpiDN {
    static constexpr bool PERM = true, AFTER_DRAIN = false;
    bf16_t* Y; const float* gate; int npn;
    __device__ __forceinline__ void operator()(const f32x4 (&acc)[2][2][4][2], const Unit& u, int wr, int wc, int fr, int fq) const {
        const int row0 = u.pm * BM + wr * 64 + fr, col0 = (u.pn % npn) * BM + wc * 32 + 8 * fq;
#pragma unroll
        for (int ai = 0; ai < 2; ++ai)
#pragma unroll
            for (int m = 0; m < 4; ++m) { const int row = row0 + ai * HALF + m * 16; const float gt = gate[row]; bf16_t* rowp = Y + (size_t)row * 1024 + col0;
#pragma unroll
                for (int bj = 0; bj < 2; ++bj) { const f32x4 v0 = acc[ai][bj][m][0] * gt, v1 = acc[ai][bj][m][1] * gt;
                    u32x4 w; w.x = cvt_pk_bf16(v0[0], v0[1]); w.y = cvt_pk_bf16(v0[2], v0[3]); w.z = cvt_pk_bf16(v1[0], v1[1]); w.w = cvt_pk_bf16(v1[2], v1[3]);
                    *(u32x4*)(rowp + bj * HALF) = w; } }
    }
};
struct EpiVT {
    static constexpr bool PERM = false, AFTER_DRAIN = false;
    float* VT; int ldc; f32x2* VST; int ntok;
    __device__ __forceinline__ void operator()(const f32x4 (&acc)[2][2][4][2], const Unit& u, int wr, int wc, int fr, int fq) const {
        const int row0 = u.pm * BM + wr * 64 + fr, col0 = u.pn * BM + wc * 32 + 4 * fq;
        f32x4 s1[2][2], s2[2][2];
#pragma unroll
        for (int bj = 0; bj < 2; ++bj)
#pragma unroll
            for (int n = 0; n < 2; ++n) { s1[bj][n] = (f32x4){0.f, 0.f, 0.f, 0.f}; s2[bj][n] = (f32x4){0.f, 0.f, 0.f, 0.f}; }
#pragma unroll
        for (int ai = 0; ai < 2; ++ai)
#pragma unroll
            for (int m = 0; m < 4; ++m) { float* rowp = VT + (size_t)(row0 + ai * HALF + m * 16) * ldc + col0;
#pragma unroll
                for (int bj = 0; bj < 2; ++bj)
#pragma unroll
                    for (int n = 0; n < 2; ++n) { const f32x4 v = acc[ai][bj][m][n]; const f32x2 a = gelu_pk((f32x2){v[0], v[1]}), b = gelu_pk((f32x2){v[2], v[3]});
                        const f32x4 gl = (f32x4){a.x, a.y, b.x, b.y}; *(f32x4*)(rowp + bj * HALF + n * 16) = gl; s1[bj][n] += gl; s2[bj][n] += gl * gl; } }
#pragma unroll
        for (int bj = 0; bj < 2; ++bj)
#pragma unroll
            for (int n = 0; n < 2; ++n)
#pragma unroll
                for (int j = 0; j < 4; ++j) { float a = s1[bj][n][j], b = s2[bj][n][j];
#pragma unroll
                    for (int o = 1; o < 16; o <<= 1) { a += __shfl_xor(a, o); b += __shfl_xor(b, o); }
                    s1[bj][n][j] = a; s2[bj][n][j] = b; }
        if (fr == 0) {
            f32x2* dst = VST + (size_t)(u.pm * 2 + wr) * ntok + col0;
#pragma unroll
            for (int bj = 0; bj < 2; ++bj)
#pragma unroll
                for (int n = 0; n < 2; ++n)
#pragma unroll
                    for (int j = 0; j < 4; ++j) dst[bj * HALF + n * 16 + j] = (f32x2){s1[bj][n][j], s2[bj][n][j]};
        }
    }
};
struct MoeOrder {
    int nPM, nPN, G, vcu;
    __device__ __forceinline__ bool next(int i, Unit& u) const {
        const int L = i * G + vcu; if (L >= 16 * nPM * nPN) return false;
        const int pm = L % nPM, r = L / nPM, pn = r % nPN, e = r / nPN; u.pm = e * 9 + pm; u.pn = e * nPN + pn; return true;
    }
    __device__ __forceinline__ void a_ready(const Unit&) const {}
    __device__ __forceinline__ void done(const Unit&) const {}
};

template <class Epi, class Sched, bool ALIGN_EPI = false, bool GATHER = false>
__device__ __forceinline__ void gemm_phase(PG8_LAS unsigned char* lds, const Gemm g, const Sched& S, const Epi& E) {
    int tid_ = threadIdx.x; asm volatile("" : "+v"(tid_));
    const int tid = tid_, wid = __builtin_amdgcn_readfirstlane(tid >> 6), lane = tid & 63, wr = wid >> 2, wc = wid & 3, fr = lane & 15, fq = lane >> 4;
    const int K = g.K, nt = K / BK;
    unsigned voffA[2], voffB[2];
#pragma unroll
    for (int i = 0; i < 2; ++i) { int R, C; stage_rc(tid * 16 + i * 8192, R, C); const int Rb = Epi::PERM ? ((R & ~31) + perm32(R & 31)) : R;
        voffA[i] = (unsigned)(R * K + C) * 2u; voffB[i] = (unsigned)(Rb * K + C) * 2u; }
    const size_t kstep = (size_t)(BK * 2);
    const size_t hstep = (size_t)HALF * K * 2;
    const size_t tstep = 2 * hstep;
    const unsigned ldsw = (unsigned)wid * 1024u;
    const int aoff = lds_byte(wr * 64 + fr, fq * 8), boff = lds_byte(wc * 32 + fr, fq * 8);
#define PG8_SA(b, h) (((b) * 2 + (h)) * HTB)
#define PG8_SB(b, h) ((4 + (b) * 2 + (h)) * HTB)
#define PG8_STAGE(bufoff, gbase, voff) do { _Pragma("unroll") for (int _i = 0; _i < 2; ++_i) \
        __builtin_amdgcn_global_load_lds((const unsigned*)((const char*)(gbase) + (voff)[_i]), (PG8_LAS unsigned*)(lds + (bufoff) + ldsw + _i * 8192), 16, 0, 0); } while (0)
#define PG8_STGA(b, h, ubase, koff, gofs) do { if constexpr (GATHER) { PG8_STAGE(PG8_SA(b, h), (const char*)g.A + (koff), gofs[h]); } \
        else { PG8_STAGE(PG8_SA(b, h), (ubase) + (koff) + (size_t)(h) * hstep, voffA); } } while (0)
#define PG8_GLOAD(dst, u) do { if constexpr (GATHER) { _Pragma("unroll") for (int _i = 0; _i < 2; ++_i) { int _R, _C; stage_rc(tid * 16 + _i * 8192, _R, _C); \
        _Pragma("unroll") for (int _h = 0; _h < 2; ++_h) dst[_h][_i] = (unsigned)g.rows[(u).pm * BM + _h * HALF + _R] * (unsigned)(K * 2) + (unsigned)_C * 2u; } } } while (0)
#define PG8_LDA(dst, b, h) do { _Pragma("unroll") for (int m = 0; m < 4; ++m) _Pragma("unroll") for (int k = 0; k < 2; ++k) dst[m][k] = *(const PG8_LAS bf16x8*)(lds + PG8_SA(b, h) + aoff + m * 2048 + k * 1024); } while (0)
#define PG8_LDB(dst, b, h) do { _Pragma("unroll") for (int n = 0; n < 2; ++n) _Pragma("unroll") for (int k = 0; k < 2; ++k) dst[n][k] = *(const PG8_LAS bf16x8*)(lds + PG8_SB(b, h) + boff + n * 2048 + k * 1024); } while (0)
#define PG8_MMA(ai, bj, At, Bt) do { __builtin_amdgcn_s_setprio(1); _Pragma("unroll") for (int m = 0; m < 4; ++m) _Pragma("unroll") for (int n = 0; n < 2; ++n) _Pragma("unroll") for (int k = 0; k < 2; ++k) \
        acc[ai][bj][m][n] = __builtin_amdgcn_mfma_f32_16x16x32_bf16(Bt[n][k], At[m][k], acc[ai][bj][m][n], 0, 0, 0); __builtin_amdgcn_s_setprio(0); } while (0)
#define PG8_WAIT_V(n) asm volatile("s_waitcnt vmcnt(" #n ")" ::: "memory")
#define PG8_WAIT_L(n) asm volatile("s_waitcnt lgkmcnt(" #n ")" ::: "memory")
#define PG8_BAR __builtin_amdgcn_s_barrier()
#define PG8_SCHED __builtin_amdgcn_sched_barrier(0)
    Unit cur, nxt; int ui = 0;
    if (!S.next(0, cur)) return;
    f32x4 acc[2][2][4][2];
#pragma unroll
    for (int a = 0; a < 2; ++a)
#pragma unroll
        for (int b = 0; b < 2; ++b)
#pragma unroll
            for (int m = 0; m < 4; ++m)
#pragma unroll
                for (int n = 0; n < 2; ++n) acc[a][b][m][n] = (f32x4){0.f, 0.f, 0.f, 0.f};
    bf16x8 At[4][2], B0[2][2], B1[2][2];
    unsigned gc[2][2] = {{0u, 0u}, {0u, 0u}}, gn[2][2] = {{0u, 0u}, {0u, 0u}};
    const char* cA = GATHER ? (const char*)g.A : (const char*)g.A + (size_t)cur.pm * tstep; const char* cB = (const char*)g.Bt + (size_t)cur.pn * tstep;
    S.a_ready(cur);
    PG8_GLOAD(gc, cur);
    PG8_STAGE(PG8_SB(0, 0), cB, voffB); PG8_STAGE(PG8_SB(0, 1), cB + hstep, voffB); PG8_STGA(0, 0, cA, 0, gc); PG8_STGA(0, 1, cA, 0, gc);
    if (wr == 1) PG8_BAR;
    PG8_WAIT_V(2); PG8_BAR;
    PG8_STAGE(PG8_SB(1, 0), cB + kstep, voffB); PG8_STGA(1, 0, cA, kstep, gc); PG8_STAGE(PG8_SB(1, 1), cB + hstep + kstep, voffB);
    PG8_WAIT_V(6); PG8_BAR;
    for (;;) {
        const bool has_next = S.next(ui + 1, nxt);
        const char* nA = GATHER ? (const char*)g.A : (has_next ? (const char*)g.A + (size_t)nxt.pm * tstep : cA); const char* nB = has_next ? (const char*)g.Bt + (size_t)nxt.pn * tstep : cB;
        for (int t = 0; t < nt; t += 2) {
            const bool last = (t == nt - 2);
            const size_t k1 = (size_t)(t + 1) * kstep;
            const char* b2 = last ? nB : cB + (size_t)(t + 2) * kstep; const char* b3 = b2 + kstep;
            if (last && has_next) S.a_ready(nxt);
            if (last) { if (has_next) { PG8_GLOAD(gn, nxt); } else {
#pragma unroll
                    for (int h = 0; h < 2; ++h)
#pragma unroll
                        for (int i = 0; i < 2; ++i) gn[h][i] = gc[h][i]; } }
            PG8_LDB(B0, 0, 0); PG8_LDB(B1, 0, 1); PG8_SCHED; PG8_LDA(At, 0, 0); PG8_STGA(1, 1, cA, k1, gc);
            PG8_WAIT_V(8); PG8_WAIT_L(0); PG8_BAR; PG8_MMA(0, 0, At, B0); PG8_MMA(0, 1, At, B1); PG8_BAR; PG8_SCHED;
            PG8_LDA(At, 0, 1); PG8_STAGE(PG8_SB(0, 0), b2, voffB); PG8_STAGE(PG8_SB(0, 1), b2 + hstep, voffB);
            if (last) { PG8_STGA(0, 0, nA, 0, gn); } else { PG8_STGA(0, 0, cA, (size_t)(t + 2) * kstep, gc); }
            PG8_WAIT_V(8); PG8_WAIT_L(0); PG8_BAR; PG8_MMA(1, 0, At, B0); PG8_MMA(1, 1, At, B1); PG8_BAR; PG8_SCHED;
            PG8_LDB(B0, 1, 0); PG8_LDB(B1, 1, 1); PG8_SCHED; PG8_LDA(At, 1, 0);
            if (last) { PG8_STGA(0, 1, nA, 0, gn); } else { PG8_STGA(0, 1, cA, (size_t)(t + 2) * kstep, gc); }
            PG8_WAIT_V(8); PG8_WAIT_L(0); PG8_BAR; PG8_MMA(0, 0, At, B0); PG8_MMA(0, 1, At, B1); PG8_BAR; PG8_SCHED;
            PG8_LDA(At, 1, 1); PG8_STAGE(PG8_SB(1, 0), b3, voffB); PG8_STAGE(PG8_SB(1, 1), b3 + hstep, voffB);
            if (last) { PG8_STGA(1, 0, nA, kstep, gn); } else { PG8_STGA(1, 0, cA, (size_t)(t + 3) * kstep, gc); }
            PG8_WAIT_V(8); PG8_WAIT_L(0); PG8_BAR; PG8_MMA(1, 0, At, B0); PG8_MMA(1, 1, At, B1); PG8_BAR; PG8_SCHED;
        }
        if constexpr (ALIGN_EPI) { if (wr == 0) PG8_BAR; }
        if constexpr (!Epi::AFTER_DRAIN) { E(acc, cur, wr, wc, fr, fq); S.done(cur); }
        if (!has_next) break;
#pragma unroll
        for (int a = 0; a < 2; ++a)
#pragma unroll
            for (int b = 0; b < 2; ++b)
#pragma unroll
                for (int m = 0; m < 4; ++m)
#pragma unroll
                    for (int n = 0; n < 2; ++n) acc[a][b][m][n] = (f32x4){0.f, 0.f, 0.f, 0.f};
        cur = nxt; cA = nA; cB = nB; ++ui;
#pragma unroll
        for (int h = 0; h < 2; ++h)
#pragma unroll
            for (int i = 0; i < 2; ++i) gc[h][i] = gn[h][i];
        if constexpr (ALIGN_EPI) { if (wr == 1) PG8_BAR; }
    }
    PG8_WAIT_V(0);
    if constexpr (!ALIGN_EPI) { if (wr == 0) PG8_BAR; }
    PG8_BAR;
    if constexpr (Epi::AFTER_DRAIN) { E.fused(acc, cur, wr, wc, fr, fq, lds, wid, lane); S.done(cur); }
#undef PG8_SA
#undef PG8_SB
#undef PG8_STAGE
#undef PG8_STGA
#undef PG8_GLOAD
#undef PG8_LDA
#undef PG8_LDB
#undef PG8_MMA
#undef PG8_WAIT_V
#undef PG8_WAIT_L
#undef PG8_BAR
#undef PG8_SCHED
}
}
constexpr int NB = 4, SEQ = 4096, T = NB * SEQ, LC = 256, TC = NB * LC, TA = T + TC, D = 1024;
constexpr int NE = 16, FF = 2048, ESTR = 2304;
constexpr int LK = LC + SEQ, KVP = 256;
constexpr float ALPHA = 1.6817928305074290f;
constexpr float LN_EPS = 1e-5f, RMS_EPS = 1e-6f;
constexpr float ATT_C2 = 0.125f * 1.4426950408889634f;
constexpr int NWAVES = 8, NTHR = 512;
constexpr size_t MiB = 1u << 20;
constexpr size_t WS_CTL = 0, WS_MOD = 1 * MiB, WS_MODP = 2 * MiB, WS_TW = 6 * MiB;
constexpr size_t WS_WHYIN = 8 * MiB, WS_WHYOUT = 20 * MiB, WS_WQKV = 24 * MiB, WS_WATO = 27 * MiB, WS_WCMIN = 29 * MiB, WS_WCMOUT = 37 * MiB, WS_WCMS = 41 * MiB;
constexpr size_t WS_WGU = 42 * MiB, WS_WDN = 554 * MiB, WS_HF = 810 * MiB;
constexpr size_t WS_XL = 942 * MiB, WS_U = 1010 * MiB, WS_HB = 1078 * MiB, WS_AFF = 1112 * MiB, WS_ROWS = 1114 * MiB, WS_GATE = WS_ROWS + 256 * 1024, WS_INV = 1115 * MiB;
constexpr size_t WS_ACT = 1117 * MiB, WS_Y = 1261 * MiB, WS_SCR = 1405 * MiB, WS_XC = 1677 * MiB, WS_END = 1745 * MiB;
constexpr size_t WS_XG = WS_Y;
constexpr size_t SC_PT = WS_SCR, SC_Z2T = WS_SCR + 204 * MiB, SC_Z2 = WS_SCR + 238 * MiB;
constexpr size_t SC_QKV = WS_SCR, SC_Q = WS_SCR + 102 * MiB, SC_K = WS_SCR + 134 * MiB, SC_V = WS_SCR + 143 * MiB, SC_O = WS_SCR + 152 * MiB;
constexpr size_t SC_UB = WS_SCR, SC_VT = WS_SCR + 64 * MiB, SC_VST = WS_SCR + 192 * MiB, SC_UV = WS_SCR + 194 * MiB;
constexpr size_t HF_SLOT = (size_t)4 * 1024 * 4096 * 4, HF_CTX = 2 * HF_SLOT;
constexpr int LDS_BYTES = 147456;
constexpr int RING_BYTES = 131072, MISC_OFF = LDS_BYTES - 256;

#define GAS __attribute__((address_space(1)))
#define LAS __attribute__((address_space(3)))
typedef unsigned short bf16;
typedef unsigned v4u __attribute__((ext_vector_type(4)));
typedef unsigned v2u __attribute__((ext_vector_type(2)));
typedef float f32x4 __attribute__((ext_vector_type(4)));
typedef float f32x2 __attribute__((ext_vector_type(2)));
#define LDS_WAIT() asm volatile("s_waitcnt lgkmcnt(0)" ::: "memory")
__device__ __forceinline__ unsigned f2bf(float f) { unsigned u = __builtin_bit_cast(unsigned, f); return (u + 0x7fffu + ((u >> 16) & 1u)) >> 16; }
__device__ __forceinline__ unsigned pk2(float lo, float hi) { return f2bf(lo) | (f2bf(hi) << 16); }
__device__ __forceinline__ float bf2f(unsigned short b) { return __builtin_bit_cast(float, (unsigned)b << 16); }
__device__ __forceinline__ float wave_sum(float v) {
#pragma unroll
    for (int o = 1; o < 64; o <<= 1) v += __shfl_xor(v, o);
    return v;
}

#define XB_TMO      128
#define XB_XCNT(j)  (256  + 64 * (j))
#define XB_XSUB(j)  (1280 + 64 * (j))
#define XB_XGEN(j)  (2304 + 64 * (j))
#define XB_TOP      3328
#define XB_TOPGEN   3392
#define XCD_BAR_WORDS 3456
#define XB_SPIN_CAP (1u << 18)
__device__ __forceinline__ unsigned xb_ld(unsigned* p)              { return __hip_atomic_load(p, __ATOMIC_RELAXED, __HIP_MEMORY_SCOPE_AGENT); }
__device__ __forceinline__ unsigned xb_add(unsigned* p, unsigned v) { return __hip_atomic_fetch_add(p, v, __ATOMIC_RELAXED, __HIP_MEMORY_SCOPE_AGENT); }
__device__ __forceinline__ unsigned xb_xcc_id() { return (unsigned)__builtin_amdgcn_s_getreg((3 << 11) | 20) & 0xFu; }
#define XB_SPIN(cond, bar) do { unsigned _sp = 0; while (cond) { __builtin_amdgcn_s_sleep(1); \
    if ((++_sp & 255u) == 0u) { if (xb_ld(&(bar)[XB_TMO])) break; if (_sp > XB_SPIN_CAP) { atomicAdd(&(bar)[XB_TMO], 1u); break; } } } } while (0)
struct XcdBarrier { unsigned* bar; unsigned x; volatile LAS unsigned* st; };
__device__ __forceinline__ XcdBarrier xcd_barrier_post(unsigned* bar, volatile LAS unsigned* st) {
    XcdBarrier b; b.bar = bar; b.x = xb_xcc_id(); b.st = st;
    if (threadIdx.x == 0) (void)xb_add(&bar[XB_XCNT(b.x)], 1u);
    return b;
}
__device__ __forceinline__ void xcd_barrier_complete(unsigned* bar, unsigned x, unsigned& nloc, unsigned& nx) {
    const unsigned G = gridDim.x * gridDim.y * gridDim.z;
    unsigned sum, cnt, mine, sp = 0u;
    for (;;) {
        sum = 0u; cnt = 0u; mine = 0u;
#pragma unroll
        for (unsigned j = 0; j < 16; ++j) { const unsigned c = xb_ld(&bar[XB_XCNT(j)]); sum += c; cnt += (c > 0u) ? 1u : 0u; mine = (j == x) ? c : mine; }
        if (sum == G) break;
        __builtin_amdgcn_s_sleep(1);
        if ((++sp & 255u) == 0u) { if (xb_ld(&bar[XB_TMO])) break; if (sp > XB_SPIN_CAP) { atomicAdd(&bar[XB_TMO], 1u); break; } }
    }
    nloc = mine > 0u ? mine : 1u; nx = cnt > 0u ? cnt : 1u;
}
__device__ __forceinline__ void xcd_barrier(const XcdBarrier& b) {
    asm volatile("s_waitcnt vmcnt(0)" ::: "memory");
    __syncthreads();
    if (threadIdx.x == 0) {
        unsigned* bar = b.bar; asm volatile("" : "+s"(bar));
        __builtin_amdgcn_s_waitcnt(0);
        unsigned bx_ = b.x; asm volatile("" : "+s"(bx_));
        unsigned nloc = b.st[0], nx = b.st[1];
        if (nloc == 0u) { xcd_barrier_complete(bar, bx_, nloc, nx); b.st[0] = nloc; b.st[1] = nx; }
        const unsigned old = xb_add(&bar[XB_XSUB(bx_)], 1u);
        const unsigned gen = old / nloc;
        if (old + 1u == (gen + 1u) * nloc) {
            __builtin_amdgcn_fence(__ATOMIC_RELEASE, "agent");
            asm volatile("s_waitcnt vmcnt(0)" ::: "memory");
            const unsigned og = xb_add(&bar[XB_TOP], 1u);
            const unsigned tg = og / nx;
            if (og + 1u == (tg + 1u) * nx) xb_add(&bar[XB_TOPGEN], 1u);
            else XB_SPIN(xb_ld(&bar[XB_TOPGEN]) == tg, bar);
            __builtin_amdgcn_fence(__ATOMIC_ACQUIRE, "agent");
            xb_add(&bar[XB_XGEN(bx_)], 1u);
            asm volatile("s_waitcnt vmcnt(0)" ::: "memory");
        } else {
            XB_SPIN(xb_ld(&bar[XB_XGEN(bx_)]) == gen, bar);
            __builtin_amdgcn_fence(__ATOMIC_ACQUIRE, "agent");
            asm volatile("s_waitcnt vmcnt(0)" ::: "memory");
        }
    }
    __syncthreads();
}

struct Args { const float* in[33]; float* out; unsigned char* ws; int ph_lo, ph_hi; };
enum { I_X = 0, I_C, I_CTX, I_CCTX, I_MODW, I_MODB, I_LNG, I_LNB, I_HYWIN, I_HYCW, I_HYCB, I_FW1, I_FB1, I_FW2, I_FB2, I_FW3, I_FFREQ, I_FBIAS, I_HYWOUT,
       I_WQKV, I_QGAIN, I_KGAIN, I_WATO, I_CMWIN, I_CMLNG, I_CMLNB, I_CMWS, I_CMBS, I_CMWOUT, I_ROUTER, I_WGATE, I_WUP, I_WDOWN };
typedef const __attribute__((address_space(4))) Args* ArgsP;
__device__ __forceinline__ ArgsP get_args() { auto p = __builtin_amdgcn_kernarg_segment_ptr(); asm volatile("" : "+s"(p)); return (ArgsP)p; }
struct Fr { LAS unsigned char* lds; int tid, lane, wave, vcu, G, bx; };
__device__ __forceinline__ Fr mkfr(unsigned char* lds_raw) {
    Fr F; int tid = threadIdx.x; asm volatile("" : "+v"(tid)); int bx = blockIdx.x, G = gridDim.x; asm volatile("" : "+s"(bx), "+s"(G));
    F.lds = (LAS unsigned char*)lds_raw; F.tid = tid; F.lane = tid & 63; F.wave = __builtin_amdgcn_readfirstlane(tid >> 6);
    F.G = G; F.bx = bx; F.vcu = (G % 8 == 0) ? (bx % 8) * (G / 8) + bx / 8 : bx; return F; }
__device__ __forceinline__ void proA_adaln_item(ArgsP a, const Fr& F, int it) {
    LAS float* sc = (LAS float*)F.lds;
    const int i = it / 96, ks = (it / 12) % 8, cc = it % 12;
    __syncthreads();
    for (int u = F.tid; u < 5 * 128; u += NTHR) { const int r = u / 128, k = ks * 128 + (u % 128);
        const float x = r < 4 ? a->in[I_C][r * D + k] : a->in[I_CCTX][k]; sc[u] = x / (1.0f + expf(-x)); }
    __syncthreads();
    const int col = cc * 512 + F.tid;
    const float* w = a->in[I_MODW] + ((size_t)i * D + (size_t)ks * 128) * 6144 + col;
    float acc[5] = {0.f, 0.f, 0.f, 0.f, 0.f};
#pragma unroll 8
    for (int k = 0; k < 128; ++k) { const float wv = w[(size_t)k * 6144];
#pragma unroll
        for (int r = 0; r < 5; ++r) acc[r] += sc[r * 128 + k] * wv; }
    float* mp = (float*)(a->ws + WS_MODP) + (size_t)((i * 8 + ks) * 5) * 6144 + col;
#pragma unroll
    for (int r = 0; r < 5; ++r) mp[(size_t)r * 6144] = acc[r];
}
__device__ __forceinline__ void proA_filter_item(ArgsP a, const Fr& F, int it) {
    int slot, L, t0; float* HF;
    if (it < 512) { slot = it >> 8; L = SEQ; t0 = (it & 255) * 16; HF = (float*)(a->ws + WS_HF + (size_t)slot * HF_SLOT); }
    else { slot = 0; L = LC; t0 = (it - 512) * 16; HF = (float*)(a->ws + WS_HF + HF_CTX); }
    LAS float* z = (LAS float*)F.lds;
    LAS float* h1 = z + 16 * 33;
    LAS float* h2 = h1 + 16 * 64;
    __syncthreads();
    for (int u = F.tid; u < 16 * 33; u += NTHR) { const int tt = u / 33, j = u % 33; const float tf = (float)(t0 + tt);
        float v;
        if (j == 0) v = tf / (float)(L - 1);
        else { const int jj = (j - 1) & 15; const float f = 1e-4f + (float)jj * ((15.0f - 1e-4f) / 15.0f); const float w = (float)(6.283185307179586 / (double)L) * tf;
            v = j <= 16 ? cosf(f * w) : -sinf(f * w); }
        z[u] = v; }
    __syncthreads();
    const float* w1 = a->in[I_FW1] + (size_t)slot * 33 * 64; const float* b1 = a->in[I_FB1] + slot * 64;
    const float* w2 = a->in[I_FW2] + (size_t)slot * 64 * 64; const float* b2 = a->in[I_FB2] + slot * 64;
    const float* fq = a->in[I_FFREQ] + slot * 128;
    for (int u = F.tid; u < 16 * 64; u += NTHR) { const int tt = u >> 6, j = u & 63; float s = b1[j];
        for (int i = 0; i < 33; ++i) s += z[tt * 33 + i] * w1[i * 64 + j];
        h1[u] = sinf(fq[j] * s); }
    __syncthreads();
    for (int u = F.tid; u < 16 * 64; u += NTHR) { const int tt = u >> 6, j = u & 63; float s = b2[j];
        for (int i = 0; i < 64; ++i) s += h1[tt * 64 + i] * w2[i * 64 + j];
        h2[u] = sinf(fq[64 + j] * s); }
    __syncthreads();
    const float* w3 = a->in[I_FW3] + (size_t)slot * 64 * 4096;
    const float dmin = -3.0701134573253940f, dmax = -15.350567286626973f;
    for (int cb = 0; cb < 8; ++cb) { const int col = cb * 512 + F.tid;
        float acc[16];
#pragma unroll
        for (int tt = 0; tt < 16; ++tt) acc[tt] = 0.f;
        for (int k4 = 0; k4 < 16; ++k4) { const float wa = w3[(size_t)(4 * k4) * 4096 + col], wb = w3[(size_t)(4 * k4 + 1) * 4096 + col], wc = w3[(size_t)(4 * k4 + 2) * 4096 + col], wd = w3[(size_t)(4 * k4 + 3) * 4096 + col];
#pragma unroll
            for (int tt = 0; tt < 16; ++tt) { const f32x4 hv = *(const LAS f32x4*)(h2 + tt * 64 + 4 * k4); acc[tt] += (hv[0] * wa + hv[1] * wb) + (hv[2] * wc + hv[3] * wd); } }
        const int d = col & 1023; const float delta = fabsf(dmin + (float)d * ((dmax - dmin) / 1023.0f));
        float* dst = HF + (size_t)col * L + t0;
#pragma unroll
        for (int q = 0; q < 4; ++q) { f32x4 o;
#pragma unroll
            for (int j = 0; j < 4; ++j) { const int tt = q * 4 + j; const float tl = (float)(t0 + tt) / (float)(L - 1); o[j] = acc[tt] * expf(-tl * delta); }
            *(f32x4*)(dst + q * 4) = o; } }
}
__device__ __forceinline__ void conv_tile(const float* W, int K, int N, int k0, int n0, bf16* WT, int drow0, LAS float* scr, int lane) {
    float rv[64];
#pragma unroll
    for (int i = 0; i < 64; ++i) rv[i] = W[(size_t)(k0 + i) * N + n0 + lane];
#pragma unroll
    for (int i = 0; i < 64; ++i) scr[i * 65 + lane] = rv[i];
    LDS_WAIT(); asm volatile("" ::: "memory");
    const int c = lane & 7;
#pragma unroll
    for (int j = 0; j < 8; ++j) { const int n = (lane >> 3) + 8 * j; const LAS float* s = scr + (8 * c) * 65 + n;
        v4u o; o.x = pk2(s[0 * 65], s[1 * 65]); o.y = pk2(s[2 * 65], s[3 * 65]); o.z = pk2(s[4 * 65], s[5 * 65]); o.w = pk2(s[6 * 65], s[7 * 65]);
        *(v4u*)(WT + (size_t)(drow0 + n) * K + k0 + 8 * c) = o; }
    LDS_WAIT(); asm volatile("" ::: "memory");
}
constexpr int CV_SMALL = 768 * 2 + 256 * 2 + 384 + 256 + 1024 + 512;
constexpr int CV_MOE = 4 * 16 * 3 * 512;
__device__ __forceinline__ void proA_conv_item(ArgsP a, int it, LAS float* scr, int lane) {
    unsigned char* ws = a->ws;
    if (it < CV_SMALL) {
        int r = it;
        if (r < 1536) { const int s = r / 768, q = r % 768, kb = q / 48, nb = q % 48;
            conv_tile(a->in[I_HYWIN] + (size_t)s * 1024 * 3072, 1024, 3072, kb * 64, nb * 64, (bf16*)(ws + WS_WHYIN) + (size_t)s * 3072 * 1024, nb * 64, scr, lane); return; } r -= 1536;
        if (r < 512) { const int s = r / 256, q = r % 256, kb = q / 16, nb = q % 16;
            conv_tile(a->in[I_HYWOUT] + (size_t)s * 1024 * 1024, 1024, 1024, kb * 64, nb * 64, (bf16*)(ws + WS_WHYOUT) + (size_t)s * 1024 * 1024, nb * 64, scr, lane); return; } r -= 512;
        if (r < 384) { const int kb = r / 24, nb = r % 24;
            conv_tile(a->in[I_WQKV], 1024, 1536, kb * 64, nb * 64, (bf16*)(ws + WS_WQKV), nb * 64, scr, lane); return; } r -= 384;
        if (r < 256) { const int kb = r / 16, nb = r % 16;
            conv_tile(a->in[I_WATO], 1024, 1024, kb * 64, nb * 64, (bf16*)(ws + WS_WATO), nb * 64, scr, lane); return; } r -= 256;
        if (r < 1024) { const int kb = r / 64, nb = r % 64;
            conv_tile(a->in[I_CMWIN], 1024, 4096, kb * 64, nb * 64, (bf16*)(ws + WS_WCMIN), nb * 64, scr, lane); return; } r -= 1024;
        { const int kb = r / 16, nb = r % 16;
            conv_tile(a->in[I_CMWOUT], 2048, 1024, kb * 64, nb * 64, (bf16*)(ws + WS_WCMOUT), nb * 64, scr, lane); return; }
    }
    const int r = it - CV_SMALL, mat = r / 512, q = r % 512, le = mat / 3, which = mat % 3;
    if (which < 2) { const int kb = q / 32, nb = q % 32, n0 = nb * 64;
        const float* src = a->in[which == 0 ? I_WGATE : I_WUP] + (size_t)le * 1024 * 2048;
        conv_tile(src, 1024, 2048, kb * 64, n0, (bf16*)(ws + WS_WGU) + (size_t)le * 4096 * 1024, (n0 >> 7) * 256 + (n0 & 127) + which * 128, scr, lane); }
    else { const int kb = q / 16, nb = q % 16;
        conv_tile(a->in[I_WDOWN] + (size_t)le * 2048 * 1024, 2048, 1024, kb * 64, nb * 64, (bf16*)(ws + WS_WDN) + (size_t)le * 1024 * 2048, nb * 64, scr, lane); }
}
__device__ __forceinline__ void phase_proA(ArgsP a, const Fr& F) {
    for (int it = F.vcu; it < 384 + 528; it += F.G) { if (it < 384) proA_adaln_item(a, F, it); else proA_filter_item(a, F, it - 384); }
    __syncthreads();
    const int gt = F.vcu * NTHR + F.tid, NGT = F.G * NTHR;
    for (int k = gt; k < 8192; k += NGT) { float s, c; sincospif((float)k * (1.0f / 4096.0f), &s, &c); ((f32x2*)(a->ws + WS_TW))[k] = (f32x2){c, s}; }
    for (int k = gt; k < 16 * 128 * 128; k += NGT) ((bf16*)(a->ws + WS_WCMS))[k] = (bf16)f2bf(a->in[I_CMWS][k]);
    LAS float* scr = (LAS float*)(F.lds + F.wave * 16640);
    const int gw = F.vcu * NWAVES + F.wave, NGW = F.G * NWAVES;
    for (int it = gw; it < CV_SMALL + CV_MOE; it += NGW) proA_conv_item(a, it, scr, F.lane);
}
__device__ __forceinline__ void phase_proB(ArgsP a, const Fr& F) {
    LAS float* m0 = (LAS float*)F.lds;
    const float* mp = (const float*)(a->ws + WS_MODP);
    for (int u = F.tid; u < 5 * 2048; u += NTHR) { const int r = u / 2048, c = u % 2048; float s = a->in[I_MODB][c];
        for (int ks = 0; ks < 8; ++ks) s += mp[(size_t)(ks * 5 + r) * 6144 + c];
        m0[u] = s; }
    __syncthreads();
    const int gw = F.vcu * NWAVES + F.wave, NGW = F.G * NWAVES;
    for (int row = gw; row < TA; row += NGW) {
        const int r = row < T ? (row >> 12) : 4;
        const float* src = row < T ? a->in[I_X] + (size_t)row * D : a->in[I_CTX] + (size_t)(row - T) * D;
        float* xl = (float*)(a->ws + WS_XC) + (size_t)row * D; bf16* hb = (bf16*)(a->ws + WS_HB) + (size_t)row * D;
#pragma unroll
        for (int j = 0; j < 4; ++j) { const int c = 4 * F.lane + 256 * j; const f32x4 v = *(const f32x4*)(src + c); *(f32x4*)(xl + c) = v;
            const f32x4 sh = *(const LAS f32x4*)(m0 + r * 2048 + c), sc = *(const LAS f32x4*)(m0 + r * 2048 + 1024 + c);
            const f32x4 h = v * (sc + 1.0f) + sh; v2u o; o.x = pk2(h[0], h[1]); o.y = pk2(h[2], h[3]); *(v2u*)(hb + c) = o; }
    }
    const int gt = F.vcu * NTHR + F.tid, NGT = F.G * NTHR;
    float* mod = (float*)(a->ws + WS_MOD);
    for (int u = gt; u < 4 * 5 * 6144; u += NGT) { const int i = u / 30720, r = (u / 6144) % 5, c = u % 6144; float s = a->in[I_MODB][i * 6144 + c];
        for (int ks = 0; ks < 8; ++ks) s += mp[(size_t)((i * 8 + ks) * 5 + r) * 6144 + c];
        mod[u] = s; }
}
template <int L>
__device__ __forceinline__ float sconv(const bf16* p, int t, float w0, float w1, float w2, float cb) {
    const float a = t > 0 ? bf2f(p[t - 1]) : 0.f, b = bf2f(p[t]), c = t < L - 1 ? bf2f(p[t + 1]) : 0.f; return w0 * a + w1 * b + w2 * c + cb;
}
template <int L>
__device__ __forceinline__ void hy_direct_item(ArgsP a, const Fr& F, int slot, int d, int tok0, const float* HF) {
    LAS float* kk = (LAS float*)F.lds;
    LAS float* vb = kk + 4 * L;
    LAS float* red = vb + 4 * L;
    const bf16* PT = (const bf16*)(a->ws + SC_PT);
    bf16* Z2T = (bf16*)(a->ws + SC_Z2T);
    __syncthreads();
    for (int o = 0; o < 2; ++o) {
        const float* fw = HF + (size_t)((o * 2 + 0) * 1024 + d) * L; const float* bw = HF + (size_t)((o * 2 + 1) * 1024 + d) * L;
        float s = 0.f;
        for (int t = F.tid; t < L; t += NTHR) { const float f = fw[t], b = bw[t]; kk[o * 2 * L + (L - 1) + t] = f; if (t >= 1) kk[o * 2 * L + (L - 1) - t] = b; s += fabsf(f) + (t >= 1 ? fabsf(b) : 0.f); }
        s = wave_sum(s); if (F.lane == 0) red[o * 8 + F.wave] = s;
    }
    __syncthreads();
    float nrm[2];
#pragma unroll
    for (int o = 0; o < 2; ++o) { float s = 0.f; for (int w = 0; w < 8; ++w) s += red[o * 8 + w]; nrm[o] = 1.0f / (s + 1e-6f); }
    const float* cw = a->in[I_HYCW] + (size_t)slot * 3 * 3072; const float* cbp = a->in[I_HYCB] + (size_t)slot * 3072;
    float w0[3], w1[3], w2[3], cb[3];
#pragma unroll
    for (int g = 0; g < 3; ++g) { const int c = g * 1024 + d; w0[g] = cw[c]; w1[g] = cw[3072 + c]; w2[g] = cw[2 * 3072 + c]; cb[g] = cbp[c]; }
    const float fb0 = a->in[I_FBIAS][(slot * 2 + 0) * 1024 + d], fb1 = a->in[I_FBIAS][(slot * 2 + 1) * 1024 + d];
    for (int u = F.tid; u < 4 * L; u += NTHR) { const int b = u / L, t = u % L; vb[u] = sconv<L>(PT + (size_t)d * TA + tok0 + b * L, t, w0[0], w1[0], w2[0], cb[0]); }
    __syncthreads();
    constexpr int NBLK = 4 * L / 8, PER = (NBLK + NTHR - 1) / NTHR;
    float res[PER][8];
#pragma unroll 1
    for (int o = 0; o < 2; ++o) {
        const LAS float* ko = kk + o * 2 * L;
#pragma unroll
        for (int pi = 0; pi < PER; ++pi) {
            const int q = F.tid + pi * NTHR;
            float acc[8];
#pragma unroll
            for (int j = 0; j < 8; ++j) acc[j] = 0.f;
            if (q < NBLK) {
                const int b = q / (L / 8), t0 = (q % (L / 8)) * 8;
                const LAS float* vv = vb + b * L;
#pragma unroll 1
                for (int s8 = 0; s8 < L; s8 += 8) {
                    const LAS float* kw = ko + (t0 - s8 - 7 + L - 1);
                    float w[15], x[8];
#pragma unroll
                    for (int i = 0; i < 15; ++i) w[i] = kw[i];
#pragma unroll
                    for (int i = 0; i < 8; ++i) x[i] = vv[s8 + i];
#pragma unroll
                    for (int j = 0; j < 8; ++j)
#pragma unroll
                        for (int i = 0; i < 8; ++i) acc[j] += w[j - i + 7] * x[i];
                }
            }
#pragma unroll
            for (int j = 0; j < 8; ++j) res[pi][j] = acc[j];
        }
        __syncthreads();
#pragma unroll
        for (int pi = 0; pi < PER; ++pi) {
            const int q = F.tid + pi * NTHR;
            if (q < NBLK) {
                const int b = q / (L / 8), t0 = (q % (L / 8)) * 8;
                const bf16* pg = PT + (size_t)((o + 1) * 1024 + d) * TA + tok0 + b * L;
#pragma unroll
                for (int j = 0; j < 8; ++j) { const int t = t0 + j; const float vin = vb[b * L + t];
                    const float y = res[pi][j] * nrm[o] + vin * (o == 0 ? fb0 : fb1);
                    const float xg = sconv<L>(pg, t, w0[o + 1], w1[o + 1], w2[o + 1], cb[o + 1]);
                    res[pi][j] = xg * y; }
            }
        }
        __syncthreads();
        if (o == 0) {
#pragma unroll
            for (int pi = 0; pi < PER; ++pi) { const int q = F.tid + pi * NTHR;
                if (q < NBLK) { const int b = q / (L / 8), t0 = (q % (L / 8)) * 8;
#pragma unroll
                    for (int j = 0; j < 8; ++j) vb[b * L + t0 + j] = res[pi][j]; } }
            __syncthreads();
        } else {
#pragma unroll
            for (int pi = 0; pi < PER; ++pi) { const int q = F.tid + pi * NTHR;
                if (q < NBLK) { const int b = q / (L / 8), t0 = (q % (L / 8)) * 8;
                    v4u ov; ov.x = pk2(res[pi][0], res[pi][1]); ov.y = pk2(res[pi][2], res[pi][3]); ov.z = pk2(res[pi][4], res[pi][5]); ov.w = pk2(res[pi][6], res[pi][7]);
                    *(v4u*)(Z2T + (size_t)d * TA + tok0 + b * L + t0) = ov; } }
        }
    }
}
__device__ __forceinline__ void phase_hy_tr(ArgsP a, const Fr& F, int ntok) {
    LAS unsigned short* tile = (LAS unsigned short*)(F.lds + F.wave * 9216);
    const bf16* Z2T = (const bf16*)(a->ws + SC_Z2T); bf16* Z2 = (bf16*)(a->ws + SC_Z2);
    const int gw = F.vcu * NWAVES + F.wave, NGW = F.G * NWAVES, ntt = ntok / 64;
    for (int it = gw; it < 16 * ntt; it += NGW) {
        const int c0 = (it / ntt) * 64, t0 = (it % ntt) * 64;
#pragma unroll
        for (int i = 0; i < 8; ++i) { const int ch = i * 8 + (F.lane >> 3), ck = F.lane & 7;
            const v4u v = *(const v4u*)(Z2T + (size_t)(c0 + ch) * TA + t0 + ck * 8); *(LAS v4u*)(tile + ch * 72 + ck * 8) = v; }
        LDS_WAIT(); asm volatile("" ::: "memory");
        bf16* dst = Z2 + (size_t)(t0 + F.lane) * D + c0;
#pragma unroll
        for (int q = 0; q < 8; ++q) { unsigned w[4];
#pragma unroll
            for (int j = 0; j < 4; ++j) { const unsigned lo = tile[(q * 8 + 2 * j) * 72 + F.lane], hi = tile[(q * 8 + 2 * j + 1) * 72 + F.lane]; w[j] = lo | (hi << 16); }
            v4u o; o.x = w[0]; o.y = w[1]; o.z = w[2]; o.w = w[3]; *(v4u*)(dst + q * 8) = o; }
        LDS_WAIT(); asm volatile("" ::: "memory");
    }
}
__device__ __forceinline__ void phase_hy_conv_direct(ArgsP a, const Fr& F, int layer) {
    const int slot = layer == 0 ? 0 : 1; const int nitems = layer == 0 ? 2048 : 1024;
    for (int it = F.vcu; it < nitems; it += F.G) {
        if (it < 1024) hy_direct_item<SEQ>(a, F, slot, it, 0, (const float*)(a->ws + WS_HF + (size_t)slot * HF_SLOT));
        else hy_direct_item<LC>(a, F, slot, it - 1024, T, (const float*)(a->ws + WS_HF + HF_CTX));
    }
}

__device__ __forceinline__ void phase_lnr(ArgsP a, const Fr& F, int layer, int nrows) {
    LAS float* wr = (LAS float*)F.lds;
    __syncthreads();
    for (int u = F.tid; u < 1024 * 16; u += NTHR) wr[u] = a->in[I_ROUTER][(size_t)layer * 1024 * 16 + (u & 1023) * 16 + (u >> 10)];
    __syncthreads();
    const float* U = (const float*)(a->ws + WS_U); float* XL = (float*)(a->ws + WS_XL); bf16* HB = (bf16*)(a->ws + WS_HB); float* AFF = (float*)(a->ws + WS_AFF);
    const float* mod = (const float*)(a->ws + WS_MOD) + (size_t)layer * 5 * 6144;
    const float* lg = a->in[I_LNG] + (size_t)(layer * 2 + 0) * D; const float* lb = a->in[I_LNB] + (size_t)(layer * 2 + 0) * D;
    const int gw = F.vcu * NWAVES + F.wave, NGW = F.G * NWAVES;
    for (int row = gw; row < nrows; row += NGW) {
        const int r = row < T ? (row >> 12) : 4;
        const float* up = U + (size_t)row * D; f32x4 v[4]; float s = 0.f;
#pragma unroll
        for (int j = 0; j < 4; ++j) { v[j] = *(const f32x4*)(up + 4 * F.lane + 256 * j); s += (v[j][0] + v[j][1]) + (v[j][2] + v[j][3]); }
        const float mean = wave_sum(s) * (1.0f / D); float s2 = 0.f;
#pragma unroll
        for (int j = 0; j < 4; ++j) { v[j] = v[j] - mean; s2 += (v[j][0] * v[j][0] + v[j][1] * v[j][1]) + (v[j][2] * v[j][2] + v[j][3] * v[j][3]); }
        const float rstd = 1.0f / sqrtf(wave_sum(s2) * (1.0f / D) + LN_EPS);
        float part[16];
#pragma unroll
        for (int e = 0; e < 16; ++e) part[e] = 0.f;
#pragma unroll
        for (int j = 0; j < 4; ++j) { const int c = 4 * F.lane + 256 * j;
            const f32x4 x = v[j] * rstd * *(const f32x4*)(lg + c) + *(const f32x4*)(lb + c);
            *(f32x4*)(XL + (size_t)row * D + c) = x;
            const f32x4 h = x * (*(const f32x4*)(mod + r * 6144 + 4096 + c) + 1.0f) + *(const f32x4*)(mod + r * 6144 + 3072 + c);
            v2u o; o.x = pk2(h[0], h[1]); o.y = pk2(h[2], h[3]); *(v2u*)(HB + (size_t)row * D + c) = o;
#pragma unroll
            for (int e = 0; e < 16; ++e) { const f32x4 w = *(const LAS f32x4*)(wr + e * 1024 + c);
                part[e] += (h[0] * w[0] + h[1] * w[1]) + (h[2] * w[2] + h[3] * w[3]); }
            asm volatile("" ::: "memory"); }
        float mx = -3.0e38f;
#pragma unroll
        for (int e = 0; e < 16; ++e) { part[e] = wave_sum(part[e]); mx = fmaxf(mx, part[e]); }
        float den = 0.f;
#pragma unroll
        for (int e = 0; e < 16; ++e) { part[e] = expf(part[e] - mx); den += part[e]; }
        float mine = 0.f;
#pragma unroll
        for (int e = 0; e < 16; ++e) mine = (F.lane == e) ? part[e] / den : mine;
        if (F.lane < 16) AFF[(size_t)row * 16 + F.lane] = mine;
    }
}

template <int N, int CAPN>
__device__ __forceinline__ void topk_item(ArgsP a, const Fr& F, int b, int e, int rowbase, int slotbase, bool pad) {
    LAS unsigned* hist = (LAS unsigned*)F.lds;
    LAS unsigned* sel = hist + 256;
    LAS unsigned* wtot = hist + 264;
    const float* AFF = (const float*)(a->ws + WS_AFF); int* ROWS = (int*)(a->ws + WS_ROWS); float* GATE = (float*)(a->ws + WS_GATE); int* INV = (int*)(a->ws + WS_INV);
    const int tid = F.tid, lane = F.lane; const bool act = tid * 8 < N;
    unsigned key[8];
#pragma unroll
    for (int j = 0; j < 8; ++j) key[j] = act ? __float_as_uint(AFF[(size_t)(rowbase + tid * 8 + j) * 16 + e]) : 0u;
    unsigned prefix = 0u, need = CAPN;
#pragma unroll 1
    for (int pass = 0; pass < 4; ++pass) {
        const int shift = 24 - 8 * pass; const unsigned himask = pass == 0 ? 0u : (0xFFFFFFFFu << (shift + 8));
        __syncthreads();
        if (tid < 256) hist[tid] = 0u;
        __syncthreads();
        if (act) {
#pragma unroll
            for (int j = 0; j < 8; ++j) if ((key[j] & himask) == prefix) __hip_atomic_fetch_add(&hist[(key[j] >> shift) & 255u], 1u, __ATOMIC_RELAXED, __HIP_MEMORY_SCOPE_WORKGROUP);
        }
        __syncthreads();
        if (tid < 64) {
            const unsigned v0 = hist[4 * lane], v1 = hist[4 * lane + 1], v2 = hist[4 * lane + 2], v3 = hist[4 * lane + 3]; const unsigned tot = v0 + v1 + v2 + v3;
            unsigned x = tot;
#pragma unroll
            for (int o = 1; o < 64; o <<= 1) { const unsigned t = __shfl_down(x, o); if (lane + o < 64) x += t; }
            const unsigned a3 = x - tot, a2 = a3 + v3, a1 = a2 + v2, a0 = a1 + v1;
            if (a3 < need && need <= a3 + v3) { sel[0] = 4 * lane + 3; sel[1] = a3; }
            if (a2 < need && need <= a2 + v2) { sel[0] = 4 * lane + 2; sel[1] = a2; }
            if (a1 < need && need <= a1 + v1) { sel[0] = 4 * lane + 1; sel[1] = a1; }
            if (a0 < need && need <= a0 + v0) { sel[0] = 4 * lane + 0; sel[1] = a0; }
        }
        __syncthreads();
        prefix |= sel[0] << shift; need -= sel[1];
    }
    const unsigned tau = prefix;
    unsigned ceq = 0u;
#pragma unroll
    for (int j = 0; j < 8; ++j) ceq += (act && key[j] == tau) ? 1u : 0u;
    unsigned xe = ceq;
#pragma unroll
    for (int o = 1; o < 64; o <<= 1) { const unsigned t = __shfl_up(xe, o); if (lane >= o) xe += t; }
    __syncthreads();
    if (lane == 63) wtot[F.wave * 2] = xe;
    __syncthreads();
    unsigned eqbase = xe - ceq; for (int w = 0; w < F.wave; ++w) eqbase += wtot[w * 2];
    unsigned flags = 0u, csel = 0u;
#pragma unroll
    for (int j = 0; j < 8; ++j) { bool s = false; if (act) { if (key[j] > tau) s = true; else if (key[j] == tau) { s = eqbase < need; ++eqbase; } } if (s) { flags |= 1u << j; ++csel; } }
    unsigned xs = csel;
#pragma unroll
    for (int o = 1; o < 64; o <<= 1) { const unsigned t = __shfl_up(xs, o); if (lane >= o) xs += t; }
    if (lane == 63) wtot[F.wave * 2 + 1] = xs;
    __syncthreads();
    unsigned pos = xs - csel; for (int w = 0; w < F.wave; ++w) pos += wtot[w * 2 + 1];
    if (act) {
#pragma unroll
        for (int j = 0; j < 8; ++j) { const int row = rowbase + tid * 8 + j; int slot = -1;
            if (flags & (1u << j)) { slot = e * ESTR + slotbase + (int)pos; ++pos; ROWS[slot] = row; GATE[slot] = __uint_as_float(key[j]); }
            INV[(size_t)row * 16 + e] = slot; }
    }
    if (pad) for (int p = tid; p < 128; p += NTHR) { ROWS[e * ESTR + 2176 + p] = 0; GATE[e * ESTR + 2176 + p] = 0.f; }
}
__device__ __forceinline__ void phase_topk(ArgsP a, const Fr& F, int layer) {
    const int nitems = layer == 0 ? 128 : 64;
    for (int it = F.vcu; it < nitems; it += F.G) {
        if (it < 64) { const int b = it >> 4, e = it & 15; topk_item<SEQ, 512>(a, F, b, e, b * SEQ, b * 512, false); }
        else { const int b = (it - 64) >> 4, e = it & 15; topk_item<LC, 32>(a, F, b, e, T + b * LC, 2048 + b * 32, b == 0); }
    }
}
__device__ __forceinline__ void phase_gather(ArgsP a, const Fr& F, int layer) {
    const int me = layer == 0 ? 2304 : 2048;
    const int* ROWS = (const int*)(a->ws + WS_ROWS); const bf16* HB = (const bf16*)(a->ws + WS_HB); bf16* XG = (bf16*)(a->ws + WS_XG);
    const int gw = F.vcu * NWAVES + F.wave, NGW = F.G * NWAVES;
    for (int it = gw; it < 16 * me; it += NGW) { const int e = it / me, s = it % me, dr = e * ESTR + s; const int sr = ROWS[dr];
        const v4u* src = (const v4u*)(HB + (size_t)sr * D); v4u* dst = (v4u*)(XG + (size_t)dr * D);
        dst[F.lane] = src[F.lane]; dst[64 + F.lane] = src[64 + F.lane]; }
}
__device__ __forceinline__ void phase_comb(ArgsP a, const Fr& F, int layer, int nrows) {
    const bf16* Y = (const bf16*)(a->ws + WS_Y); const float* XL = (const float*)(a->ws + WS_XL); float* XC = (float*)(a->ws + WS_XC); bf16* HB = (bf16*)(a->ws + WS_HB); const int* INV = (const int*)(a->ws + WS_INV);
    const float* mod = (const float*)(a->ws + WS_MOD) + (size_t)layer * 5 * 6144;
    const float* modn = (const float*)(a->ws + WS_MOD) + (size_t)(layer < 3 ? layer + 1 : 3) * 5 * 6144;
    const float* lg = a->in[I_LNG] + (size_t)(layer * 2 + 1) * D; const float* lb = a->in[I_LNB] + (size_t)(layer * 2 + 1) * D;
    const int gw = F.vcu * NWAVES + F.wave, NGW = F.G * NWAVES;
    for (int row = gw; row < nrows; row += NGW) {
        const int r = row < T ? (row >> 12) : 4;
        const int myinv = INV[(size_t)row * 16 + (F.lane & 15)];
        f32x4 m[4];
#pragma unroll
        for (int j = 0; j < 4; ++j) m[j] = (f32x4){0.f, 0.f, 0.f, 0.f};
        unsigned msk = (unsigned)(__ballot(myinv >= 0) & 0xFFFFull);
        while (msk) {
            int sl[4];
#pragma unroll
            for (int q = 0; q < 4; ++q) { if (msk) { const int e = __builtin_ctz(msk); msk &= msk - 1; sl[q] = __shfl(myinv, e); } else sl[q] = -1; }
            v2u yv[4][4];
#pragma unroll
            for (int q = 0; q < 4; ++q) if (sl[q] >= 0) { const bf16* yp = Y + (size_t)sl[q] * D;
#pragma unroll
                for (int j = 0; j < 4; ++j) yv[q][j] = *(const v2u*)(yp + 4 * F.lane + 256 * j); }
#pragma unroll
            for (int q = 0; q < 4; ++q) if (sl[q] >= 0) {
#pragma unroll
                for (int j = 0; j < 4; ++j) { const v2u w = yv[q][j];
                    m[j] += (f32x4){__builtin_bit_cast(float, w.x << 16), __builtin_bit_cast(float, w.x & 0xffff0000u), __builtin_bit_cast(float, w.y << 16), __builtin_bit_cast(float, w.y & 0xffff0000u)}; } }
        }
        f32x4 v[4]; float s = 0.f;
#pragma unroll
        for (int j = 0; j < 4; ++j) { const int c = 4 * F.lane + 256 * j;
            v[j] = *(const f32x4*)(XL + (size_t)row * D + c) * ALPHA + *(const f32x4*)(mod + r * 6144 + 5120 + c) * m[j]; s += (v[j][0] + v[j][1]) + (v[j][2] + v[j][3]); }
        const float mean = wave_sum(s) * (1.0f / D); float s2 = 0.f;
#pragma unroll
        for (int j = 0; j < 4; ++j) { v[j] = v[j] - mean; s2 += (v[j][0] * v[j][0] + v[j][1] * v[j][1]) + (v[j][2] * v[j][2] + v[j][3] * v[j][3]); }
        const float rstd = 1.0f / sqrtf(wave_sum(s2) * (1.0f / D) + LN_EPS);
#pragma unroll
        for (int j = 0; j < 4; ++j) { const int c = 4 * F.lane + 256 * j;
            const f32x4 x = v[j] * rstd * *(const f32x4*)(lg + c) + *(const f32x4*)(lb + c);
            if (layer == 3) { *(f32x4*)(a->out + (size_t)row * D + c) = x; }
            else { *(f32x4*)(XC + (size_t)row * D + c) = x;
                const f32x4 h = x * (*(const f32x4*)(modn + r * 6144 + 1024 + c) + 1.0f) + *(const f32x4*)(modn + r * 6144 + c);
                v2u o; o.x = pk2(h[0], h[1]); o.y = pk2(h[2], h[3]); *(v2u*)(HB + (size_t)row * D + c) = o; } }
    }
}
#ifndef FFT_HD
#define FFT_HD __device__ __forceinline__
#endif
typedef float cf2 __attribute__((ext_vector_type(2)));
FFT_HD cf2 cmul(cf2 a, cf2 b) { return (cf2){a.x * b.x - a.y * b.y, a.x * b.y + a.y * b.x}; }
FFT_HD int fpad(int p) { return p + (p >> 5); }
constexpr int FFT_N = 8192, FFT_BUF = 8192 + 256;
template <bool INV> FFT_HD void dft4(cf2& a, cf2& b, cf2& c, cf2& d) {
    const cf2 s0 = a + c, s1 = a - c, s2 = b + d, s3 = b - d;
    const cf2 js3 = INV ? (cf2){-s3.y, s3.x} : (cf2){s3.y, -s3.x};
    a = s0 + s2; b = s1 + js3; c = s0 - s2; d = s1 - js3;
}
template <bool INV> FFT_HD void dft16(cf2 (&x)[16]) {
#pragma unroll
    for (int n0 = 0; n0 < 4; ++n0) dft4<INV>(x[n0], x[n0 + 4], x[n0 + 8], x[n0 + 12]);
    constexpr float C1 = 0.92387953251128674f, S1 = 0.38268343236508977f, R2 = 0.70710678118654752f;
    const float sg = INV ? 1.f : -1.f;
    const cf2 w1 = {C1, sg * S1}, w2 = {R2, sg * R2}, w3 = {S1, sg * C1}, w4 = {0.f, sg * 1.f}, w6 = {-R2, sg * R2}, w9 = {-C1, -sg * S1};
    x[1 + 4 * 1] = cmul(x[1 + 4 * 1], w1); x[1 + 4 * 2] = cmul(x[1 + 4 * 2], w2); x[1 + 4 * 3] = cmul(x[1 + 4 * 3], w3);
    x[2 + 4 * 1] = cmul(x[2 + 4 * 1], w2); x[2 + 4 * 2] = cmul(x[2 + 4 * 2], w4); x[2 + 4 * 3] = cmul(x[2 + 4 * 3], w6);
    x[3 + 4 * 1] = cmul(x[3 + 4 * 1], w3); x[3 + 4 * 2] = cmul(x[3 + 4 * 2], w6); x[3 + 4 * 3] = cmul(x[3 + 4 * 3], w9);
#pragma unroll
    for (int k0 = 0; k0 < 4; ++k0) dft4<INV>(x[0 + 4 * k0], x[1 + 4 * k0], x[2 + 4 * k0], x[3 + 4 * k0]);
#pragma unroll
    for (int i = 0; i < 4; ++i)
#pragma unroll
        for (int j = i + 1; j < 4; ++j) { const cf2 t = x[i + 4 * j]; x[i + 4 * j] = x[j + 4 * i]; x[j + 4 * i] = t; }
}
template <bool INV, class BP, class TP> FFT_HD void stage_r16(BP buf, TP TW, int base, int stride, int tidx) {
    cf2 x[16];
#pragma unroll
    for (int i = 0; i < 16; ++i) x[i] = buf[fpad(base + i * stride)];
    cf2 w = TW[tidx]; w.y = INV ? w.y : -w.y;
    if (!INV) dft16<false>(x);
    cf2 wk = w;
#pragma unroll
    for (int k = 1; k < 16; ++k) { x[k] = cmul(x[k], wk); if (k < 15) wk = cmul(wk, w); }
    if (INV) dft16<true>(x);
#pragma unroll
    for (int i = 0; i < 16; ++i) buf[fpad(base + i * stride)] = x[i];
}
template <bool INV, class BP> FFT_HD void stage_r32_load(BP buf, int blk, int r, cf2 (&u)[16]) {
    constexpr float CS[16] = {1.f, 0.98078528040323043f, 0.92387953251128674f, 0.83146961230254524f, 0.70710678118654752f, 0.55557023301960218f, 0.38268343236508977f, 0.19509032201612825f,
                              0.f, -0.19509032201612825f, -0.38268343236508977f, -0.55557023301960218f, -0.70710678118654752f, -0.83146961230254524f, -0.92387953251128674f, -0.98078528040323043f};
    constexpr float SN[16] = {0.f, 0.19509032201612825f, 0.38268343236508977f, 0.55557023301960218f, 0.70710678118654752f, 0.83146961230254524f, 0.92387953251128674f, 0.98078528040323043f,
                              1.f, 0.98078528040323043f, 0.92387953251128674f, 0.83146961230254524f, 0.70710678118654752f, 0.55557023301960218f, 0.38268343236508977f, 0.19509032201612825f};
    const int base = blk * 33;
#pragma unroll
    for (int n = 0; n < 16; ++n) { const cf2 lo = buf[base + n], hi = buf[base + n + 16];
        const cf2 s = lo + hi, d = lo - hi; const cf2 w = {CS[n], INV ? SN[n] : -SN[n]}; const cf2 dw = cmul(d, w);
        u[n] = r ? dw : s; }
    dft16<INV>(u);
}
template <class BP> FFT_HD void stage_r32_store(BP buf, int blk, int r, const cf2 (&u)[16]) {
    const int base = blk * 33;
#pragma unroll
    for (int g = 0; g < 16; ++g) buf[base + 2 * g + r] = u[g];
}
template <class BP> FFT_HD void fft_mul(BP Z, BP W, int tid, int o, float scale) {
    const int f2 = tid >> 5, f3 = tid & 31;
#pragma unroll 4
    for (int j = 0; j < 16; ++j) { const int p = tid + 512 * j; const int f = j + 16 * f2 + 256 * f3; const int fm = (FFT_N - f) & (FFT_N - 1);
        const int pm = (fm & 15) * 512 + ((fm >> 4) & 15) * 32 + (fm >> 8);
        const cf2 a = W[fpad(p)], b = W[fpad(pm)];
        const cf2 k = o == 0 ? (cf2){0.5f * (a.x + b.x), 0.5f * (a.y - b.y)} : (cf2){0.5f * (a.y + b.y), 0.5f * (b.x - a.x)};
        const cf2 z = Z[fpad(p)]; Z[fpad(p)] = cmul(z, k) * scale; }
}
#ifndef FFT_HOST_ONLY
__device__ __forceinline__ void fft_fwd(LAS cf2* buf, const cf2* TW, int tid) {
    stage_r16<false>(buf, TW, tid, 512, tid); __syncthreads();
    stage_r16<false>(buf, TW, (tid >> 5) * 512 + (tid & 31), 32, 16 * (tid & 31)); __syncthreads();
    { cf2 u[16]; stage_r32_load<false>(buf, tid >> 1, tid & 1, u); stage_r32_store(buf, tid >> 1, tid & 1, u); } __syncthreads();
}
__device__ __forceinline__ void fft_inv(LAS cf2* buf, const cf2* TW, int tid) {
    { cf2 u[16]; stage_r32_load<true>(buf, tid >> 1, tid & 1, u); stage_r32_store(buf, tid >> 1, tid & 1, u); } __syncthreads();
    stage_r16<true>(buf, TW, (tid >> 5) * 512 + (tid & 31), 32, 16 * (tid & 31)); __syncthreads();
    stage_r16<true>(buf, TW, tid, 512, tid); __syncthreads();
}
__device__ __forceinline__ void hy_fft_item(ArgsP a, const Fr& F, int slot, int d) {
    LAS cf2* Zb = (LAS cf2*)F.lds;
    LAS cf2* Wb = Zb + FFT_BUF;
    LAS float* red = (LAS float*)(Wb + FFT_BUF);
    const bf16* PT = (const bf16*)(a->ws + SC_PT); bf16* Z2T = (bf16*)(a->ws + SC_Z2T); const cf2* TW = (const cf2*)(a->ws + WS_TW);
    const float* HF = (const float*)(a->ws + WS_HF + (size_t)slot * HF_SLOT);
    const int tid = F.tid;
    __syncthreads();
    { const float* f0 = HF + (size_t)(0 * 1024 + d) * SEQ; const float* b0 = HF + (size_t)(1 * 1024 + d) * SEQ;
      const float* f1 = HF + (size_t)(2 * 1024 + d) * SEQ; const float* b1 = HF + (size_t)(3 * 1024 + d) * SEQ;
      float s0 = 0.f, s1 = 0.f;
      for (int t = tid; t < SEQ; t += NTHR) { const float a0 = f0[t], a1 = f1[t]; Wb[fpad(t)] = (cf2){a0, a1}; s0 += fabsf(a0); s1 += fabsf(a1);
          if (t >= 1) { const float c0 = b0[t], c1 = b1[t]; Wb[fpad(FFT_N - t)] = (cf2){c0, c1}; s0 += fabsf(c0); s1 += fabsf(c1); } }
      if (tid == 0) Wb[fpad(SEQ)] = (cf2){0.f, 0.f};
      s0 = wave_sum(s0); s1 = wave_sum(s1); if (F.lane == 0) { red[F.wave] = s0; red[8 + F.wave] = s1; } }
    __syncthreads();
    float nrm0, nrm1; { float s0 = 0.f, s1 = 0.f; for (int w = 0; w < 8; ++w) { s0 += red[w]; s1 += red[8 + w]; } nrm0 = 1.0f / (s0 + 1e-6f); nrm1 = 1.0f / (s1 + 1e-6f); }
    fft_fwd(Wb, TW, tid);
    const float* cw = a->in[I_HYCW] + (size_t)slot * 3 * 3072; const float* cbp = a->in[I_HYCB] + (size_t)slot * 3072;
    float w0[3], w1[3], w2[3], cb[3];
#pragma unroll
    for (int g = 0; g < 3; ++g) { const int c = g * 1024 + d; w0[g] = cw[c]; w1[g] = cw[3072 + c]; w2[g] = cw[2 * 3072 + c]; cb[g] = cbp[c]; }
    const float fb0 = a->in[I_FBIAS][(slot * 2 + 0) * 1024 + d], fb1 = a->in[I_FBIAS][(slot * 2 + 1) * 1024 + d];
    const float sc0 = nrm0 * (1.0f / FFT_N), sc1 = nrm1 * (1.0f / FFT_N);
#pragma unroll 1
    for (int pr = 0; pr < 2; ++pr) {
        const bf16* pv0 = PT + (size_t)d * TA + (2 * pr) * SEQ; const bf16* pv1 = pv0 + SEQ;
        cf2 vin[8];
#pragma unroll
        for (int j = 0; j < 8; ++j) { const int t = tid + 512 * j; vin[j] = (cf2){sconv<SEQ>(pv0, t, w0[0], w1[0], w2[0], cb[0]), sconv<SEQ>(pv1, t, w0[0], w1[0], w2[0], cb[0])};
            Zb[fpad(t)] = vin[j]; Zb[fpad(t + SEQ)] = (cf2){0.f, 0.f}; }
        __syncthreads();
        fft_fwd(Zb, TW, tid); fft_mul(Zb, Wb, tid, 0, sc0); __syncthreads(); fft_inv(Zb, TW, tid);
        const bf16* px0 = PT + (size_t)(1024 + d) * TA + (2 * pr) * SEQ; const bf16* px1 = px0 + SEQ;
#pragma unroll
        for (int j = 0; j < 8; ++j) { const int t = tid + 512 * j; const cf2 y = Zb[fpad(t)];
            const cf2 xg = {sconv<SEQ>(px0, t, w0[1], w1[1], w2[1], cb[1]), sconv<SEQ>(px1, t, w0[1], w1[1], w2[1], cb[1])};
            vin[j] = xg * (y + vin[j] * fb0); }
        __syncthreads();
#pragma unroll
        for (int j = 0; j < 8; ++j) { const int t = tid + 512 * j; Zb[fpad(t)] = vin[j]; Zb[fpad(t + SEQ)] = (cf2){0.f, 0.f}; }
        __syncthreads();
        fft_fwd(Zb, TW, tid); fft_mul(Zb, Wb, tid, 1, sc1); __syncthreads(); fft_inv(Zb, TW, tid);
        const bf16* pz0 = PT + (size_t)(2048 + d) * TA + (2 * pr) * SEQ; const bf16* pz1 = pz0 + SEQ;
        bf16* o0 = Z2T + (size_t)d * TA + (2 * pr) * SEQ; bf16* o1 = o0 + SEQ;
#pragma unroll
        for (int j = 0; j < 8; ++j) { const int t = tid + 512 * j; const cf2 y = Zb[fpad(t)];
            const cf2 xg = {sconv<SEQ>(pz0, t, w0[2], w1[2], w2[2], cb[2]), sconv<SEQ>(pz1, t, w0[2], w1[2], w2[2], cb[2])};
            const cf2 z = xg * (y + vin[j] * fb1); o0[t] = (bf16)f2bf(z.x); o1[t] = (bf16)f2bf(z.y); }
        __syncthreads();
    }
}
__device__ __forceinline__ void phase_hy_conv_fft(ArgsP a, const Fr& F, int layer) {
    const int slot = layer == 0 ? 0 : 1; const int nitems = layer == 0 ? 2048 : 1024;
    for (int it = F.vcu; it < nitems; it += F.G) {
        if (it < 1024) hy_fft_item(a, F, slot, it);
        else hy_direct_item<LC>(a, F, slot, it - 1024, T, (const float*)(a->ws + WS_HF + HF_CTX));
    }
}
#endif
#include <hip/hip_bf16.h>
namespace attn_body {
using bf16=__hip_bfloat16;
using bf16x8=__attribute__((ext_vector_type(8)))short;
using s16x4=__attribute__((ext_vector_type(4)))short;
using f32x16=__attribute__((ext_vector_type(16)))float;
using u32x4=__attribute__((ext_vector_type(4)))unsigned;
constexpr int BATCH=4,NHEAD=16,SEQ=4096,D=64,DM=NHEAD*D,KP=256,LKEYS=4352;
constexpr int NW=8,QBLK=32,QB=QBLK*NW,KVBLK=64,NQB=SEQ/QB;
constexpr int ATTN_PITCH=DM, ATTN_UNIT_ROWS=QB;
__device__ __forceinline__ int crow(int r,int hi){return (r&3)+8*(r>>2)+4*hi;}
#define SBAR() __builtin_amdgcn_sched_barrier(0)
__device__ __forceinline__ void cmask(f32x16&p0,f32x16&p1,int jb,int qrel,int hi){
  const float NEG=-INFINITY; int kb=64*jb+4*hi;
  #pragma unroll
  for(int r=0;r<16;++r){int kv=kb+(r&3)+8*(r>>2); if(kv>qrel)p0[r]=NEG; if(kv+32>qrel)p1[r]=NEG;}
}

constexpr int NSLOT=3, SLOTB=8192;
constexpr int LDS_K=0, LDS_V=NSLOT*SLOTB, LDS_WS=2*NSLOT*SLOTB, LDS_OST=LDS_WS+NW*64*4, LDS_BYTES=LDS_OST+NW*4096;
constexpr float C2=0.125f*1.4426950408889634f;
__device__ __forceinline__ void glds16(const void*gsrc,unsigned lds_dst){unsigned keep;
  asm volatile("s_mov_b32 %0, m0\n\ts_mov_b32 m0, %2\n\ts_nop 0\n\tglobal_load_lds_dwordx4 %1, off\n\ts_mov_b32 m0, %0":"=&s"(keep):"v"(gsrc),"s"(lds_dst):"memory");}
__device__ __forceinline__ float max3f(float a,float b,float c){float r;asm("v_max3_f32 %0, %1, %2, %3":"=v"(r):"v"(a),"v"(b),"v"(c));return r;}
__device__ __forceinline__ float max2f(float a,float b){float r;asm("v_max_f32_e32 %0, %1, %2":"=v"(r):"v"(a),"v"(b));return r;}
__device__ __forceinline__ float fadd_s(float a,float b){float r;asm("v_add_f32_e32 %0, %1, %2":"=v"(r):"v"(a),"v"(b));return r;}
__device__ __forceinline__ float fsub_s(float a,float b){float r;asm("v_sub_f32_e32 %0, %1, %2":"=v"(r):"v"(a),"v"(b));return r;}
typedef float f32x2_t __attribute__((ext_vector_type(2))); typedef __bf16 bf16x2_t __attribute__((ext_vector_type(2)));
__device__ __forceinline__ unsigned cvtpk_s(float lo,float hi){f32x2_t v={lo,hi};bf16x2_t b=__builtin_convertvector(v,bf16x2_t);return __builtin_bit_cast(unsigned,b);}
#define WAIT_BAR(N) asm volatile("s_waitcnt vmcnt(" #N ") lgkmcnt(0)\n\ts_barrier":::"memory")

__device__ __forceinline__ void qkt(f32x16&p0,f32x16&p1,const char*Kslot,const bf16x8*qr,const f32x16&negm,int r32,int hi){
  const char*kb=Kslot+hi*1024+r32*16;
  #pragma unroll
  for(int d0=0;d0<4;++d0){
    const bf16x8 b0=*reinterpret_cast<const bf16x8*>(kb+d0*2048);
    const bf16x8 b1=*reinterpret_cast<const bf16x8*>(kb+d0*2048+512);
    if(d0==0){p0=__builtin_amdgcn_mfma_f32_32x32x16_bf16(b0,qr[0],negm,0,0,0);p1=__builtin_amdgcn_mfma_f32_32x32x16_bf16(b1,qr[0],negm,0,0,0);}
    else{p0=__builtin_amdgcn_mfma_f32_32x32x16_bf16(b0,qr[d0],p0,0,0,0);p1=__builtin_amdgcn_mfma_f32_32x32x16_bf16(b1,qr[d0],p1,0,0,0);}}
}
typedef __attribute__((address_space(3))) const char* lds_cptr;
typedef short v4i16_t __attribute__((ext_vector_type(4)));
__device__ __forceinline__ void kload8(bf16x8*kf,lds_cptr kp){
  kf[0]=*(const __attribute__((address_space(3))) bf16x8*)(kp);      kf[1]=*(const __attribute__((address_space(3))) bf16x8*)(kp+512);
  kf[2]=*(const __attribute__((address_space(3))) bf16x8*)(kp+2048); kf[3]=*(const __attribute__((address_space(3))) bf16x8*)(kp+2560);
  kf[4]=*(const __attribute__((address_space(3))) bf16x8*)(kp+4096); kf[5]=*(const __attribute__((address_space(3))) bf16x8*)(kp+4608);
  kf[6]=*(const __attribute__((address_space(3))) bf16x8*)(kp+6144); kf[7]=*(const __attribute__((address_space(3))) bf16x8*)(kp+6656);
}
__device__ __forceinline__ void kload2(bf16x8*kf,lds_cptr kp,int j){ kf[2*j]=*(const __attribute__((address_space(3))) bf16x8*)(kp+j*2048); kf[2*j+1]=*(const __attribute__((address_space(3))) bf16x8*)(kp+j*2048+512); }
__device__ __forceinline__ s16x4 vtr(lds_cptr p){ return __builtin_bit_cast(s16x4,__builtin_amdgcn_ds_read_tr16_b64_v4i16((__attribute__((address_space(3))) v4i16_t*)p)); }
__device__ __forceinline__ float rowmax(const f32x16&p0,const f32x16&p1){
  float a=max3f(p0[0],p0[1],p1[0]),b=max3f(p0[2],p0[3],p1[1]);a=max3f(a,p1[2],p1[3]);
  #pragma unroll
  for(int r=4;r<16;r+=4){a=max3f(a,p0[r],p0[r+1]);b=max3f(b,p0[r+2],p0[r+3]);a=max3f(a,p1[r],p1[r+1]);b=max3f(b,p1[r+2],p1[r+3]);}
  const float m=max2f(a,b);
  auto rr=__builtin_amdgcn_permlane32_swap(__float_as_uint(m),__float_as_uint(m),false,false);
  return max2f(__uint_as_float(rr[0]),__uint_as_float(rr[1]));
}
__device__ __forceinline__ void pv(f32x16*o,int vb,bf16x8 pa0,bf16x8 pa1,bf16x8 pa2,bf16x8 pa3){
  #pragma unroll
  for(int d0=0;d0<2;++d0){s16x4 lo[4],hi[4];
    #pragma unroll
    for(int ks=0;ks<4;++ks){
      asm volatile("ds_read_b64_tr_b16 %0,%1 offset:%c2":"=&v"(lo[ks]):"v"(vb),"i"(d0*4096+ks*1024):"memory");
      asm volatile("ds_read_b64_tr_b16 %0,%1 offset:%c2":"=&v"(hi[ks]):"v"(vb),"i"(d0*4096+ks*1024+512):"memory");}
    asm volatile("s_waitcnt lgkmcnt(0)":::"memory");SBAR();
    #define PK(k) (bf16x8){lo[k][0],lo[k][1],lo[k][2],lo[k][3],hi[k][0],hi[k][1],hi[k][2],hi[k][3]}
    o[d0]=__builtin_amdgcn_mfma_f32_32x32x16_bf16(pa0,PK(0),o[d0],0,0,0);
    o[d0]=__builtin_amdgcn_mfma_f32_32x32x16_bf16(pa1,PK(1),o[d0],0,0,0);
    o[d0]=__builtin_amdgcn_mfma_f32_32x32x16_bf16(pa2,PK(2),o[d0],0,0,0);
    o[d0]=__builtin_amdgcn_mfma_f32_32x32x16_bf16(pa3,PK(3),o[d0],0,0,0);
    #undef PK
  }
}

#ifndef ATTN_STORE16
#define ATTN_STORE16(p,v) (*(u32x4*)(p)=(v))
#endif
template<int THRL> __device__ __forceinline__ void attn_unit(int b,int h,int qb,const bf16*Q,const bf16*__restrict__ K,const bf16*__restrict__ V,bf16*O,char*shm){
  int tid_=threadIdx.x; asm volatile("":"+v"(tid_)); const int tid=tid_,lane=tid&63,r32=lane&31,hi=lane>>5; const int wid=__builtin_amdgcn_readfirstlane(tid>>6);
  const long rowbase=(long)b*SEQ; const int q0=qb*QB;
  const bf16*Qw=Q+(rowbase+q0+wid*QBLK)*DM+h*D;
  const bf16*Kh=K+(long)b*LKEYS*KP+(h>>2)*D,*Vh=V+(long)b*LKEYS*KP+(h>>2)*D;
  const unsigned lds0=(unsigned)(uintptr_t)shm;
  float*wsf=(float*)(shm+LDS_WS)+wid*64;
  const bf16*ksrc=Kh+(long)lane*KP+wid*8;
  const bf16*vsrc=Vh+(long)(16*(wid&3)+(lane>>2))*KP+(wid>>2)*32+(lane&3)*8;
  const unsigned kdst=lds0+LDS_K+wid*1024, vdst=lds0+LDS_V+wid*1024;
  #define DMA_K(t,slot) glds16(ksrc+(long)(t)*KVBLK*KP,(unsigned)__builtin_amdgcn_readfirstlane(kdst+(slot)))
  #define DMA_V(t,slot) glds16(vsrc+(long)(t)*KVBLK*KP,(unsigned)__builtin_amdgcn_readfirstlane(vdst+(slot)))
  const int vb0=(int)(lds0+LDS_V)+((lane>>4)&1)*32+(lane&3)*8+(4*hi+((lane&15)>>2))*64;
  const char*Kbase=shm+LDS_K; bf16x8 kf[8];
  const lds_cptr shm3=(lds_cptr)shm; const lds_cptr kp0=shm3+LDS_K+hi*1024+r32*16; const lds_cptr vp0=shm3+LDS_V+((lane>>4)&1)*32+(lane&3)*8+(4*hi+((lane&15)>>2))*64;
  const int NT=LKEYS/KVBLK;
  DMA_K(0,0);DMA_V(0,0);DMA_K(1,SLOTB);
  bf16x8 qr[4];
  #pragma unroll
  for(int d0=0;d0<4;++d0)qr[d0]=*reinterpret_cast<const bf16x8*>(&Qw[(long)r32*DM+d0*16+hi*8]);
  float mhat=0.f,l_reg=0.f;f32x16 o[2];o[0]=f32x16{};o[1]=f32x16{};f32x16 negm=f32x16{};asm volatile("":"+v"(negm));

  #define CMASK(P0,P1,t) do{}while(0)
  bool resc=false;
  #define START(P0,P1) do{ const float rm=rowmax(P0,P1); resc=false; \
    { const float dl=rm; mhat=fadd_s(mhat,dl); \
      _Pragma("unroll") for(int r=0;r<16;++r){P0[r]=fsub_s(P0[r],dl);P1[r]=fsub_s(P1[r],dl);} \
      _Pragma("unroll") for(int r=0;r<16;++r)negm[r]=-mhat; asm volatile("":"+v"(negm)); } \
    _Pragma("unroll") for(int r=0;r<16;++r)P0[r]=__builtin_amdgcn_exp2f(P0[r]); }while(0)
  #define RESC() do{ if(resc){ asm volatile("s_waitcnt lgkmcnt(0)":::"memory"); \
      _Pragma("unroll") for(int d_=0;d_<2;++d_) _Pragma("unroll") for(int r=0;r<16;++r)o[d_][r]*=wsf[crow(r,hi)]; } }while(0)
  f32x16 pA0,pA1,pB0,pB1;
  int sl_prev=0,sl_cur=0,sl_next=SLOTB;
  #define ROT() do{sl_prev=sl_cur;sl_cur=sl_next;sl_next=(sl_next==(NSLOT-1)*SLOTB)?0:sl_next+SLOTB;}while(0)
  DMA_K(2,2*SLOTB);
  WAIT_BAR(3);
  qkt(pA0,pA1,Kbase,qr,negm,r32,hi);asm volatile("s_nop 15\n\ts_nop 7":"+v"(pA0),"+v"(pA1));CMASK(pA0,pA1,0);
  START(pA0,pA1);
  _Pragma("unroll") for(int r=0;r<16;++r)pA1[r]=__builtin_amdgcn_exp2f(pA1[r]);
  WAIT_BAR(0);
  DMA_K(3,0);DMA_V(1,SLOTB);
  ROT();
  kload8(kf,kp0+sl_cur);
  WAIT_BAR(2);
  s16x4 vlo[8],vhi[8]; u32x4 pw0,pw1,pw2,pw3;
  #define PKW(P,B) cvtpk_s(P[B],P[B+1])
  #define PAF(k) __builtin_bit_cast(bf16x8,pw##k)
  #define VFR(i) (bf16x8){vlo[i][0],vlo[i][1],vlo[i][2],vlo[i][3],vhi[i][0],vhi[i][1],vhi[i][2],vhi[i][3]}
  #define PIN(x) asm volatile("":"+v"(x))
  #define MX3(a,b,c) __builtin_fmaxf(__builtin_fmaxf((a),(b)),(c))
  #define GAPA(MF,A0,A1,A2,A3,W0,W1,PW) do{ MF; sacc+=A0; sacc+=A1; sacc+=A2; sacc+=A3; PIN(sacc); W0; W1; PIN(PW); SBAR(); }while(0)
  #define EX(v) __builtin_amdgcn_exp2f(v)
  #define GAPB(MF,X,B) do{ MF; X[B]=EX(X[B]); X[B+1]=EX(X[B+1]); X[B+2]=EX(X[B+2]); X[B+3]=EX(X[B+3]); PIN(X); SBAR(); }while(0)
  #define VRD(i) do{ vlo[i]=vtr(vp_+(((i)>>2)*4096+((i)&3)*1024)); vhi[i]=vtr(vp_+(((i)>>2)*4096+((i)&3)*1024+512)); }while(0)
  #define KRD(G,j) do{ if(G){ kload2(kf,kp0+sl_next,j); SBAR(); } }while(0)
  #define STEP(C0,C1,P0,P1,t,GK,GV,GL) do{ SBAR(); \
    const lds_cptr vp_=vp0+sl_prev; \
    VRD(0); SBAR(); float sacc=(P0[0]+P0[1]); \
    GAPA(C0=__builtin_amdgcn_mfma_f32_32x32x16_bf16(kf[0],qr[0],negm,0,0,0), P0[2],P0[3],P0[4],P0[5],     pw0[0]=PKW(P0,0), pw0[1]=PKW(P0,2), pw0); \
    VRD(4); SBAR(); GAPA(C1=__builtin_amdgcn_mfma_f32_32x32x16_bf16(kf[1],qr[0],negm,0,0,0), P0[6],P0[7],P0[8],P0[9],     pw0[2]=PKW(P0,4), pw0[3]=PKW(P0,6), pw0); \
    VRD(1); SBAR(); GAPA(C0=__builtin_amdgcn_mfma_f32_32x32x16_bf16(kf[2],qr[1],C0,0,0,0),   P0[10],P0[11],P0[12],P0[13], pw1[0]=PKW(P0,8), pw1[1]=PKW(P0,10), pw1); \
    VRD(5); SBAR(); GAPA(C1=__builtin_amdgcn_mfma_f32_32x32x16_bf16(kf[3],qr[1],C1,0,0,0),   P0[14],P0[15],P1[0],P1[1],   pw1[2]=PKW(P0,12),pw1[3]=PKW(P0,14), pw1); \
    VRD(2); SBAR(); GAPA(C0=__builtin_amdgcn_mfma_f32_32x32x16_bf16(kf[4],qr[2],C0,0,0,0),   P1[2],P1[3],P1[4],P1[5],     pw2[0]=PKW(P1,0), pw2[1]=PKW(P1,2), pw2); \
    VRD(6); SBAR(); GAPA(C1=__builtin_amdgcn_mfma_f32_32x32x16_bf16(kf[5],qr[2],C1,0,0,0),   P1[6],P1[7],P1[8],P1[9],     pw2[2]=PKW(P1,4), pw2[3]=PKW(P1,6), pw2); \
    VRD(3); SBAR(); GAPA(C0=__builtin_amdgcn_mfma_f32_32x32x16_bf16(kf[6],qr[3],C0,0,0,0),   P1[10],P1[11],P1[12],P1[13], pw3[0]=PKW(P1,8), pw3[1]=PKW(P1,10), pw3); \
    VRD(7); SBAR(); GAPA(C1=__builtin_amdgcn_mfma_f32_32x32x16_bf16(kf[7],qr[3],C1,0,0,0),   P1[14],P1[15],0.f,0.f,       pw3[2]=PKW(P1,12),pw3[3]=PKW(P1,14), pw3); \
    l_reg+=sacc; \
    if(GK){DMA_K((t)+3,sl_cur);} if(GV){DMA_V((t)+1,sl_next);} \
    CMASK(C0,C1,t); \
    { float a=MX3(C0[0],C0[1],C1[0]),b=MX3(C0[2],C0[3],C1[1]); a=MX3(a,C1[2],C1[3]); \
      _Pragma("unroll") for(int r=4;r<16;r+=4){a=MX3(a,C0[r],C0[r+1]);b=MX3(b,C0[r+2],C0[r+3]);a=MX3(a,C1[r],C1[r+1]);b=MX3(b,C1[r+2],C1[r+3]);} \
      float rm=__builtin_fmaxf(a,b); { auto rr=__builtin_amdgcn_permlane32_swap(__float_as_uint(rm),__float_as_uint(rm),false,false); rm=__builtin_fmaxf(__uint_as_float(rr[0]),__uint_as_float(rr[1])); } \
      resc=false; \
      if(__builtin_expect(__any(rm>(float)THRL),0)){ const float dl=__builtin_fmaxf(rm,0.f); mhat+=dl; \
        _Pragma("unroll") for(int r=0;r<16;++r){C0[r]-=dl;C1[r]-=dl;} \
        _Pragma("unroll") for(int r=0;r<16;++r)negm[r]=-mhat; asm volatile("":"+v"(negm)); \
        const float f=__builtin_amdgcn_exp2f(-dl); l_reg*=f; if(hi==0)wsf[r32]=f; resc=true; } } \
    SBAR(); \
    GAPB(o[0]=__builtin_amdgcn_mfma_f32_32x32x16_bf16(PAF(0),VFR(0),o[0],0,0,0), C0,0); \
    GAPB(o[1]=__builtin_amdgcn_mfma_f32_32x32x16_bf16(PAF(0),VFR(4),o[1],0,0,0), C0,4); \
    KRD(GL,0); GAPB(o[0]=__builtin_amdgcn_mfma_f32_32x32x16_bf16(PAF(1),VFR(1),o[0],0,0,0), C0,8); \
    KRD(GL,1); GAPB(o[1]=__builtin_amdgcn_mfma_f32_32x32x16_bf16(PAF(1),VFR(5),o[1],0,0,0), C0,12); \
    KRD(GL,2); GAPB(o[0]=__builtin_amdgcn_mfma_f32_32x32x16_bf16(PAF(2),VFR(2),o[0],0,0,0), C1,0); \
    KRD(GL,3); GAPB(o[1]=__builtin_amdgcn_mfma_f32_32x32x16_bf16(PAF(2),VFR(6),o[1],0,0,0), C1,4); \
    GAPB(o[0]=__builtin_amdgcn_mfma_f32_32x32x16_bf16(PAF(3),VFR(3),o[0],0,0,0), C1,8); \
    GAPB(o[1]=__builtin_amdgcn_mfma_f32_32x32x16_bf16(PAF(3),VFR(7),o[1],0,0,0), C1,12); \
    }while(0)
  int t=1;
  #undef CMASK
  #define CMASK(P0,P1,t) do{}while(0)
  for(;t+5<NT;t+=2){
    STEP(pB0,pB1,pA0,pA1,t,true,true,true);     WAIT_BAR(2); RESC(); ROT();
    STEP(pA0,pA1,pB0,pB1,t+1,true,true,true);   WAIT_BAR(2); RESC(); ROT();
  }
  #undef CMASK
  #define CMASK(P0,P1,t) do{}while(0)
  #define ENDW(tt) do{ if((tt)+3<NT){WAIT_BAR(2);} else if((tt)+2<NT){WAIT_BAR(1);} else {WAIT_BAR(0);} }while(0)
  for(;t+1<NT;t+=2){
    STEP(pB0,pB1,pA0,pA1,t,(t+3<NT),(t+1<NT),(t+1<NT));       ENDW(t);   RESC(); ROT();
    STEP(pA0,pA1,pB0,pB1,t+1,(t+4<NT),(t+2<NT),(t+2<NT));     ENDW(t+1); RESC(); ROT();
  }
  STEP(pB0,pB1,pA0,pA1,NT-1,false,false,false); RESC();
  { float sacc=pB0[0]+pB0[1]; _Pragma("unroll") for(int r=2;r<16;++r)sacc+=pB0[r]; _Pragma("unroll") for(int r=0;r<16;++r)sacc+=pB1[r]; l_reg+=sacc;
    pw0=(u32x4){PKW(pB0,0),PKW(pB0,2),PKW(pB0,4),PKW(pB0,6)};pw1=(u32x4){PKW(pB0,8),PKW(pB0,10),PKW(pB0,12),PKW(pB0,14)};pw2=(u32x4){PKW(pB1,0),PKW(pB1,2),PKW(pB1,4),PKW(pB1,6)};pw3=(u32x4){PKW(pB1,8),PKW(pB1,10),PKW(pB1,12),PKW(pB1,14)};
    SBAR(); pv(o,vb0+sl_cur,PAF(0),PAF(1),PAF(2),PAF(3)); }
  #undef PKW
  #undef PAF
  #undef VFR
  #undef PIN
  #undef MX3
  #undef GAPA
  #undef GAPB
  #undef EX
  #undef VRD
  #undef KRD
  #undef STEP
  #undef ENDW
  {auto rr=__builtin_amdgcn_permlane32_swap(__float_as_uint(l_reg),__float_as_uint(l_reg),false,false);l_reg=__uint_as_float(rr[0])+__uint_as_float(rr[1]);}
  if(hi==0)wsf[32+r32]=l_reg;asm volatile("s_waitcnt lgkmcnt(0)":::"memory");
  float rli[16];
  #pragma unroll
  for(int r=0;r<16;++r)rli[r]=__builtin_amdgcn_rcpf(wsf[32+crow(r,hi)]);
  bf16*Ow=O+(rowbase+q0+wid*QBLK)*DM+h*D;
  { bf16*stg=(bf16*)(shm+LDS_OST)+wid*2048;
    #pragma unroll
    for(int r=0;r<16;++r){const int orow=crow(r,hi);
      #pragma unroll
      for(int d0=0;d0<2;++d0)stg[orow*64+d0*32+r32]=__float2bfloat16(o[d0][r]*rli[r]);}
    asm volatile("s_waitcnt lgkmcnt(0)":::"memory");
    #pragma unroll
    for(int i=0;i<4;++i){const int row=i*8+(lane>>3),ch=lane&7; const u32x4 v=*(const u32x4*)(stg+row*64+ch*8); ATTN_STORE16(Ow+(long)row*DM+ch*8,v);} }
  asm volatile("s_waitcnt lgkmcnt(0)\n\ts_barrier":::"memory");
  #undef DMA_K
  #undef DMA_V
  #undef CMASK
  #undef START
  #undef RESC
  #undef ROT
}
constexpr int ATTN_LDS_BYTES=LDS_BYTES;
struct AttnTensors { const bf16* Q; const bf16* K; const bf16* V; bf16* O; };
struct AttnUnit { int bh; int qb; };
struct StaticOrder {
  int vcu, per;
  __device__ __forceinline__ explicit StaticOrder(int grid,int vcu_):vcu(vcu_),per((BATCH*NHEAD*(SEQ/QB)+grid-1)/grid){}
  __device__ __forceinline__ bool next(int i,AttnUnit&u)const{ if(i>=per)return false; const int idx=vcu*per+i; if(idx>=BATCH*NHEAD*(SEQ/QB))return false; u.bh=idx/(SEQ/QB); u.qb=idx%(SEQ/QB); return true; }
  __device__ __forceinline__ void a_ready(const AttnUnit&)const{}
  __device__ __forceinline__ void done(const AttnUnit&)const{}
};
template<class Sched,int THRL=8> __device__ __forceinline__ void attn_phase(char*lds,const AttnTensors&T,const Sched&S){
  AttnUnit u;
  for(int i=0;S.next(i,u);++i){ S.a_ready(u); attn_unit<THRL>(u.bh/NHEAD,u.bh%NHEAD,u.qb,T.Q,T.K,T.V,T.O,lds); S.done(u); }
}
#undef SBAR
#undef WAIT_BAR
}

__device__ __forceinline__ void phase_attn_fast(ArgsP a, const Fr& F) {
    const attn_body::AttnTensors AT{(const attn_body::bf16*)(a->ws + SC_Q), (const attn_body::bf16*)(a->ws + SC_K), (const attn_body::bf16*)(a->ws + SC_V), (attn_body::bf16*)(a->ws + SC_O)};
    const attn_body::StaticOrder S(F.G, F.vcu);
    __syncthreads();
    attn_body::attn_phase<attn_body::StaticOrder>((char*)F.lds, AT, S);
    __syncthreads();
}
__device__ __forceinline__ void phase_sp_fast(ArgsP a, const Fr& F) {
    typedef short bf16x8 __attribute__((ext_vector_type(8)));
    constexpr int PITCH = 136;
    LAS unsigned short* As = (LAS unsigned short*)F.lds;
    LAS unsigned short* Bs = As + 128 * PITCH;
    LAS float* st = (LAS float*)(Bs + 128 * PITCH);
    const float* VT = (const float*)(a->ws + SC_VT); const f32x2* VST = (const f32x2*)(a->ws + SC_VST); const bf16* UB = (const bf16*)(a->ws + SC_UB); bf16* UV = (bf16*)(a->ws + SC_UV);
    const bf16* WS = (const bf16*)(a->ws + WS_WCMS);
    const float* lng = a->in[I_CMLNG]; const float* lnb = a->in[I_CMLNB]; const float* bs = a->in[I_CMBS];
    const int tid = F.tid, lane = F.lane, wid = F.wave, wr = wid >> 2, wc = wid & 3, fr = lane & 15, fq = lane >> 4;
    const int per = (2048 + F.G - 1) / F.G; int gl = -1;
    for (int it = F.vcu * per; it < (F.vcu + 1) * per && it < 2048; ++it) {
        const int g = it >> 7, n = it & 127;
        __syncthreads();
        if (g != gl) { gl = g;
#pragma unroll
            for (int q = 0; q < 4; ++q) { const int idx = tid + q * NTHR, t = idx >> 4, ck = idx & 15;
                *(LAS v4u*)(As + t * PITCH + ck * 8) = *(const v4u*)(WS + (size_t)g * 16384 + t * 128 + ck * 8); } }
        if (tid < 128) { float s1 = 0.f, s2 = 0.f;
#pragma unroll
            for (int p = 0; p < 16; ++p) { const f32x2 v = VST[(size_t)p * T + n * 128 + tid]; s1 += v.x; s2 += v.y; }
            const float mean = s1 * (1.0f / 2048.0f); const float var = s2 * (1.0f / 2048.0f) - mean * mean; st[tid * 2] = mean; st[tid * 2 + 1] = 1.0f / sqrtf(var + LN_EPS); }
        __syncthreads();
        { const int s4 = (lane & 31) * 4; const int ch = lane >> 5;
          const f32x4 mu = {st[(s4 + 0) * 2], st[(s4 + 1) * 2], st[(s4 + 2) * 2], st[(s4 + 3) * 2]};
          const f32x4 rs = {st[(s4 + 0) * 2 + 1], st[(s4 + 1) * 2 + 1], st[(s4 + 2) * 2 + 1], st[(s4 + 3) * 2 + 1]};
#pragma unroll
          for (int q = 0; q < 8; ++q) { const int c = q * 16 + wid * 2 + ch; const int chn = g * 128 + c;
              const f32x4 v = *(const f32x4*)(VT + (size_t)chn * T + n * 128 + s4);
              const float lg = lng[chn], lb = lnb[chn];
              const f32x4 y = (v - mu) * rs * lg + lb;
              v2u o; o.x = pk2(y[0], y[1]); o.y = pk2(y[2], y[3]); *(LAS v2u*)(Bs + c * PITCH + s4) = o; } }
        __syncthreads();
        f32x4 acc[4][2];
#pragma unroll
        for (int m = 0; m < 4; ++m)
#pragma unroll
            for (int nn = 0; nn < 2; ++nn) acc[m][nn] = (f32x4){0.f, 0.f, 0.f, 0.f};
#pragma unroll
        for (int k = 0; k < 4; ++k) {
            bf16x8 af[4], bfr[2];
#pragma unroll
            for (int m = 0; m < 4; ++m) af[m] = *(const LAS bf16x8*)(As + (wr * 64 + m * 16 + fr) * PITCH + k * 32 + fq * 8);
#pragma unroll
            for (int nn = 0; nn < 2; ++nn) bfr[nn] = *(const LAS bf16x8*)(Bs + (wc * 32 + nn * 16 + fr) * PITCH + k * 32 + fq * 8);
#pragma unroll
            for (int m = 0; m < 4; ++m)
#pragma unroll
                for (int nn = 0; nn < 2; ++nn) acc[m][nn] = __builtin_amdgcn_mfma_f32_16x16x32_bf16(bfr[nn], af[m], acc[m][nn], 0, 0, 0);
        }
#pragma unroll
        for (int m = 0; m < 4; ++m) { const int t = wr * 64 + m * 16 + fr; const float bt = bs[g * 128 + t];
#pragma unroll
            for (int nn = 0; nn < 2; ++nn) { const size_t idx = (size_t)(n * 128 + t) * 2048 + g * 128 + wc * 32 + nn * 16 + 4 * fq;
                const v2u ub = *(const v2u*)(UB + idx); const f32x4 o = acc[m][nn] + bt;
                v2u w; w.x = pk2(__builtin_bit_cast(float, ub.x << 16) * o[0], __builtin_bit_cast(float, ub.x & 0xffff0000u) * o[1]);
                w.y = pk2(__builtin_bit_cast(float, ub.y << 16) * o[2], __builtin_bit_cast(float, ub.y & 0xffff0000u) * o[3]);
                *(v2u*)(UV + idx) = w; } }
    }
}
__device__ __forceinline__ void phase_rope(ArgsP a, const Fr& F) {
    const float* QKV = (const float*)(a->ws + SC_QKV); bf16* Q = (bf16*)(a->ws + SC_Q); bf16* K = (bf16*)(a->ws + SC_K); bf16* V = (bf16*)(a->ws + SC_V);
    const int gw = F.vcu * NWAVES + F.wave, NGW = F.G * NWAVES;
    const int i = F.lane & 31, hs = F.lane >> 5;
    const float qg0 = a->in[I_QGAIN][i], qg1 = a->in[I_QGAIN][i + 32], kg0 = a->in[I_KGAIN][i], kg1 = a->in[I_KGAIN][i + 32];
    const float invf = powf(10000.0f, -(float)(i & 15) / 16.0f);
    for (int row = gw; row < TA; row += NGW) {
        const bool lat = row < T; const int b = lat ? (row >> 12) : ((row - T) >> 8); const int t = lat ? (row & 4095) : ((row - T) & 255);
        float cs = 1.f, sn = 0.f;
        if (lat) { const float pos = (i < 16) ? (float)(t >> 6) : (float)(t & 63); sincosf(pos * invf, &sn, &cs); }
        const float* src = QKV + (size_t)row * 1536;
        const size_t krow = (size_t)b * LK + (lat ? LC + t : t);
#pragma unroll
        for (int j = 0; j < 12; ++j) { const int hh = 2 * j + hs;
            if (!lat && hh < 16) continue;
            const float x1 = src[hh * 64 + i], x2 = src[hh * 64 + 32 + i];
            if (hh < 20) {
                float ss = x1 * x1 + x2 * x2;
#pragma unroll
                for (int o = 1; o < 32; o <<= 1) ss += __shfl_xor(ss, o);
                const float rs = 1.0f / sqrtf(ss * (1.0f / 64.0f) + RMS_EPS);
                const bool isq = hh < 16;
                const float n1 = x1 * rs * (isq ? qg0 : kg0), n2 = x2 * rs * (isq ? qg1 : kg1);
                float o1 = n1 * cs - n2 * sn, o2 = n1 * sn + n2 * cs;
                if (isq) { o1 *= ATT_C2; o2 *= ATT_C2; bf16* d = Q + (size_t)row * 1024 + hh * 64; d[i] = (bf16)f2bf(o1); d[i + 32] = (bf16)f2bf(o2); }
                else { bf16* d = K + krow * KVP + (hh - 16) * 64; d[i] = (bf16)f2bf(o1); d[i + 32] = (bf16)f2bf(o2); }
            } else { bf16* d = V + krow * KVP + (hh - 20) * 64; d[i] = (bf16)f2bf(x1); d[i + 32] = (bf16)f2bf(x2); }
        }
    }
}
__device__ __forceinline__ void phase_attn_simple(ArgsP a, const Fr& F) {
    const bf16* Q = (const bf16*)(a->ws + SC_Q); const bf16* K = (const bf16*)(a->ws + SC_K); const bf16* V = (const bf16*)(a->ws + SC_V); bf16* O = (bf16*)(a->ws + SC_O);
    for (int it = F.vcu; it < 512; it += F.G) {
        const int b = it >> 7, h = (it >> 3) & 15, q = (it & 7) * 512 + F.tid;
        const bf16* qp = Q + (size_t)(b * SEQ + q) * 1024 + h * 64;
        float qv[64], o[64];
#pragma unroll
        for (int d = 0; d < 64; ++d) { qv[d] = bf2f(qp[d]); o[d] = 0.f; }
        float m = -3.0e38f, l = 0.f;
        const bf16* kb = K + (size_t)b * LK * KVP + (h >> 2) * 64; const bf16* vb = V + (size_t)b * LK * KVP + (h >> 2) * 64;
        for (int s = 0; s < LK; ++s) {
            const v4u* kr = (const v4u*)(kb + (size_t)s * KVP); float sc = 0.f;
#pragma unroll
            for (int c = 0; c < 8; ++c) { const v4u kv = kr[c]; const unsigned w[4] = {kv.x, kv.y, kv.z, kv.w};
#pragma unroll
                for (int j = 0; j < 4; ++j) { sc += qv[c * 8 + 2 * j] * __builtin_bit_cast(float, w[j] << 16) + qv[c * 8 + 2 * j + 1] * __builtin_bit_cast(float, w[j] & 0xffff0000u); } }
            const float mn = fmaxf(m, sc); const float al = exp2f(m - mn), p = exp2f(sc - mn); l = l * al + p; m = mn;
            const v4u* vr = (const v4u*)(vb + (size_t)s * KVP);
#pragma unroll
            for (int c = 0; c < 8; ++c) { const v4u vv = vr[c]; const unsigned w[4] = {vv.x, vv.y, vv.z, vv.w};
#pragma unroll
                for (int j = 0; j < 4; ++j) { o[c * 8 + 2 * j] = o[c * 8 + 2 * j] * al + p * __builtin_bit_cast(float, w[j] << 16); o[c * 8 + 2 * j + 1] = o[c * 8 + 2 * j + 1] * al + p * __builtin_bit_cast(float, w[j] & 0xffff0000u); } }
        }
        const float il = 1.0f / l; bf16* op = O + (size_t)(b * SEQ + q) * 1024 + h * 64;
#pragma unroll
        for (int c = 0; c < 8; ++c) { v4u w; w.x = pk2(o[c * 8] * il, o[c * 8 + 1] * il); w.y = pk2(o[c * 8 + 2] * il, o[c * 8 + 3] * il); w.z = pk2(o[c * 8 + 4] * il, o[c * 8 + 5] * il); w.w = pk2(o[c * 8 + 6] * il, o[c * 8 + 7] * il);
            *(v4u*)(op + c * 8) = w; }
    }
}
__device__ __forceinline__ void phase_sp_simple(ArgsP a, const Fr& F) {
    LAS float* wsL = (LAS float*)F.lds;
    LAS float* vl = wsL + 128 * 128;
    LAS float* st = vl + 128 * 128;
    const float* VT = (const float*)(a->ws + SC_VT); const f32x2* VST = (const f32x2*)(a->ws + SC_VST); const bf16* UB = (const bf16*)(a->ws + SC_UB); bf16* UV = (bf16*)(a->ws + SC_UV);
    const int per = (2048 + F.G - 1) / F.G; int gl = -1;
    for (int it = F.vcu * per; it < (F.vcu + 1) * per && it < 2048; ++it) {
        const int g = it >> 7, n = it & 127;
        __syncthreads();
        if (g != gl) { for (int u = F.tid; u < 128 * 128; u += NTHR) wsL[u] = a->in[I_CMWS][(size_t)g * 16384 + u]; gl = g; }
        if (F.tid < 128) { float s1 = 0.f, s2 = 0.f; for (int p = 0; p < 16; ++p) { const f32x2 v = VST[(size_t)p * T + n * 128 + F.tid]; s1 += v.x; s2 += v.y; }
            const float mean = s1 * (1.0f / 2048.0f); const float var = s2 * (1.0f / 2048.0f) - mean * mean; st[F.tid * 2] = mean; st[F.tid * 2 + 1] = 1.0f / sqrtf(var + LN_EPS); }
        __syncthreads();
        for (int u = F.tid; u < 128 * 128; u += NTHR) { const int c = u >> 7, s = u & 127; const int ch = g * 128 + c;
            const float v = VT[(size_t)ch * T + n * 128 + s]; vl[s * 128 + c] = (v - st[s * 2]) * st[s * 2 + 1] * a->in[I_CMLNG][ch] + a->in[I_CMLNB][ch]; }
        __syncthreads();
        const int c = F.tid & 127, tq = F.tid >> 7;
        for (int jj = 0; jj < 32; ++jj) { const int t = tq + 4 * jj; float acc = 0.f;
            for (int s = 0; s < 128; ++s) acc += wsL[t * 128 + s] * vl[s * 128 + c];
            acc += a->in[I_CMBS][g * 128 + t];
            const size_t idx = (size_t)(n * 128 + t) * 2048 + g * 128 + c;
            UV[idx] = (bf16)f2bf(bf2f(UB[idx]) * acc); }
    }
}
#ifndef MK_FAST_CONV
#define MK_FAST_CONV 0
#endif
#ifndef MK_FAST_ATTN
#define MK_FAST_ATTN 0
#endif
#ifndef MK_FAST_SP
#define MK_FAST_SP 0
#endif
#ifndef MK_GATHER
#define MK_GATHER 0
#endif
constexpr int MOE_PH = MK_GATHER ? 5 : 6;
constexpr int N_PHASES = 2 + (4 + MOE_PH) + (4 + MOE_PH) + (3 + MOE_PH) + (4 + MOE_PH);

#ifndef MK_REPMASK
#define MK_REPMASK 0ull
#endif
#ifndef MK_REPN
#define MK_REPN 3
#endif
#define REPS for (int rep_ = 0; rep_ < (((MK_REPMASK >> p) & 1ull) ? MK_REPN : 1); ++rep_)
#define IN() (get_args()->ph_lo <= p && p < get_args()->ph_hi)
#define PHB ArgsP a = get_args(); unsigned char* ws = a->ws; (void)ws; const Fr F = mkfr(lds_raw);
#define SEAM() do { { ArgsP a__ = get_args(); if (a__->ph_lo <= p && p + 1 < a__->ph_hi) { XcdBarrier bb; bb.bar = (unsigned*)(a__->ws + WS_CTL) + 4096; bb.x = xb_xcc_id(); \
        bb.st = (volatile LAS unsigned*)((LAS unsigned char*)lds_raw + MISC_OFF) + 8; xcd_barrier(bb); } } ++p; } while (0)
template <int layer> __device__ __forceinline__ void layer_body(int& p, unsigned char* lds_raw) {
    PG8_LAS unsigned char* ring = (PG8_LAS unsigned char*)lds_raw;
        constexpr int kind = layer % 3;
        const int nrows = layer == 0 ? TA : T;
#define G1PTR ((const float*)(ws + WS_MOD) + (size_t)layer * 5 * 6144 + 2048)
        if constexpr (kind == 0) {
            const int slot = layer == 0 ? 0 : 1;
            REPS if (IN()) { PHB pg8::Gemm g{(const pg8::bf16_t*)(ws + WS_WHYIN) + (size_t)slot * 3072 * 1024, (const pg8::bf16_t*)(ws + WS_HB), 3072, nrows, 1024, nullptr};
                pg8::StaticOrder S; S.init(3072, nrows, F.G, F.bx); pg8::EpiBf16<0> E{(pg8::bf16_t*)(ws + SC_PT), TA, nullptr, 0, 0, 1.f};
                pg8::gemm_phase<pg8::EpiBf16<0>, pg8::StaticOrder, true, false>(ring, g, S, E); }
            SEAM();
            REPS if (IN()) { PHB
#if MK_FAST_CONV
                phase_hy_conv_fft(a, F, layer);
#else
                phase_hy_conv_direct(a, F, layer);
#endif
            }
            SEAM();
            REPS if (IN()) { PHB phase_hy_tr(a, F, nrows); }
            SEAM();
            REPS if (IN()) { PHB pg8::Gemm g{(const pg8::bf16_t*)(ws + SC_Z2), (const pg8::bf16_t*)(ws + WS_WHYOUT) + (size_t)slot * 1024 * 1024, nrows, 1024, 1024, nullptr};
                pg8::StaticOrder S; S.init(nrows, 1024, F.G, F.bx); pg8::EpiRes E{(const float*)(ws + WS_XC), (float*)(ws + WS_U), G1PTR, 6144, ALPHA};
                pg8::gemm_phase<pg8::EpiRes, pg8::StaticOrder, true, false>(ring, g, S, E); }
            SEAM();
        } else if constexpr (kind == 1) {
            REPS if (IN()) { PHB pg8::Gemm g{(const pg8::bf16_t*)(ws + WS_HB), (const pg8::bf16_t*)(ws + WS_WQKV), TA, 1536, 1024, nullptr};
                pg8::StaticOrder S; S.init(TA, 1536, F.G, F.bx); pg8::EpiF32 E{(float*)(ws + SC_QKV), 1536};
                pg8::gemm_phase<pg8::EpiF32, pg8::StaticOrder, true, false>(ring, g, S, E); }
            SEAM();
            REPS if (IN()) { PHB phase_rope(a, F); }
            SEAM();
            REPS if (IN()) { PHB
#if MK_FAST_ATTN
                phase_attn_fast(a, F);
#else
                phase_attn_simple(a, F);
#endif
            }
            SEAM();
            REPS if (IN()) { PHB pg8::Gemm g{(const pg8::bf16_t*)(ws + SC_O), (const pg8::bf16_t*)(ws + WS_WATO), T, 1024, 1024, nullptr};
                pg8::StaticOrder S; S.init(T, 1024, F.G, F.bx); pg8::EpiRes E{(const float*)(ws + WS_XC), (float*)(ws + WS_U), G1PTR, 6144, ALPHA};
                pg8::gemm_phase<pg8::EpiRes, pg8::StaticOrder, true, false>(ring, g, S, E); }
            SEAM();
        } else {
            REPS if (IN()) {
                { PHB pg8::Gemm g{(const pg8::bf16_t*)(ws + WS_HB), (const pg8::bf16_t*)(ws + WS_WCMIN), T, 2048, 1024, nullptr};
                  pg8::StaticOrder S; S.init(T, 2048, F.G, F.bx); pg8::EpiBf16<1> E{(pg8::bf16_t*)(ws + SC_UB), 2048, nullptr, 0, 0, 1.f};
                  pg8::gemm_phase<pg8::EpiBf16<1>, pg8::StaticOrder, true, false>(ring, g, S, E); }
                { PHB pg8::Gemm g{(const pg8::bf16_t*)(ws + WS_WCMIN) + (size_t)2048 * 1024, (const pg8::bf16_t*)(ws + WS_HB), 2048, T, 1024, nullptr};
                  pg8::StaticOrder S; S.init(2048, T, F.G, F.bx); pg8::EpiVT E{(float*)(ws + SC_VT), T, (pg8::f32x2*)(ws + SC_VST), T};
                  pg8::gemm_phase<pg8::EpiVT, pg8::StaticOrder, true, false>(ring, g, S, E); }
            }
            SEAM();
            REPS if (IN()) { PHB
#if MK_FAST_SP
                phase_sp_fast(a, F);
#else
                phase_sp_simple(a, F);
#endif
            }
            SEAM();
            REPS if (IN()) { PHB pg8::Gemm g{(const pg8::bf16_t*)(ws + SC_UV), (const pg8::bf16_t*)(ws + WS_WCMOUT), T, 1024, 2048, nullptr};
                pg8::StaticOrder S; S.init(T, 1024, F.G, F.bx); pg8::EpiRes E{(const float*)(ws + WS_XC), (float*)(ws + WS_U), G1PTR, 6144, ALPHA};
                pg8::gemm_phase<pg8::EpiRes, pg8::StaticOrder, true, false>(ring, g, S, E); }
            SEAM();
        }
        REPS if (IN()) { PHB phase_lnr(a, F, layer, nrows); }
        SEAM();
        REPS if (IN()) { PHB phase_topk(a, F, layer); }
        SEAM();
        const int npm = layer == 0 ? 9 : 8;
#if MK_GATHER
        REPS if (IN()) { PHB pg8::Gemm g{(const pg8::bf16_t*)(ws + WS_HB), (const pg8::bf16_t*)(ws + WS_WGU) + (size_t)layer * 16 * 4096 * 1024, 0, 0, 1024, (const int*)(ws + WS_ROWS)};
            pg8::MoeOrder S{npm, 16, F.G, F.vcu}; pg8::EpiGU E{(pg8::bf16_t*)(ws + WS_ACT), 16};
            pg8::gemm_phase<pg8::EpiGU, pg8::MoeOrder, true, true>(ring, g, S, E); }
        SEAM();
#else
        REPS if (IN()) { PHB phase_gather(a, F, layer); }
        SEAM();
        REPS if (IN()) { PHB pg8::Gemm g{(const pg8::bf16_t*)(ws + WS_XG), (const pg8::bf16_t*)(ws + WS_WGU) + (size_t)layer * 16 * 4096 * 1024, 0, 0, 1024, nullptr};
            pg8::MoeOrder S{npm, 16, F.G, F.vcu}; pg8::EpiGU E{(pg8::bf16_t*)(ws + WS_ACT), 16};
            pg8::gemm_phase<pg8::EpiGU, pg8::MoeOrder, true, false>(ring, g, S, E); }
        SEAM();
#endif
        REPS if (IN()) { PHB pg8::Gemm g{(const pg8::bf16_t*)(ws + WS_ACT), (const pg8::bf16_t*)(ws + WS_WDN) + (size_t)layer * 16 * 1024 * 2048, 0, 0, 2048, nullptr};
            pg8::MoeOrder S{npm, 4, F.G, F.vcu}; pg8::EpiDN E{(pg8::bf16_t*)(ws + WS_Y), (const float*)(ws + WS_GATE), 4};
            pg8::gemm_phase<pg8::EpiDN, pg8::MoeOrder, true, false>(ring, g, S, E); }
        SEAM();
        REPS if (IN()) { PHB phase_comb(a, F, layer, nrows); }
        SEAM();
    }
__global__ void __launch_bounds__(NTHR, 2) mk_fwd(Args a_) {
    extern __shared__ __attribute__((aligned(16))) unsigned char lds_raw[];
    Fr F0 = mkfr(lds_raw);
    volatile LAS unsigned* MISC = (volatile LAS unsigned*)(F0.lds + MISC_OFF);
    if (F0.tid < 32) MISC[F0.tid] = 0u;
    __syncthreads();
    if (a_.ph_hi - a_.ph_lo > 1) (void)xcd_barrier_post((unsigned*)(a_.ws + WS_CTL) + 4096, MISC + 8);
    int p = 0;
    PG8_LAS unsigned char* ring = (PG8_LAS unsigned char*)lds_raw;

    REPS if (IN()) { PHB phase_proA(a, F); }
    SEAM();
    REPS if (IN()) { PHB phase_proB(a, F); }
    SEAM();
    layer_body<0>(p, lds_raw); layer_body<1>(p, lds_raw); layer_body<2>(p, lds_raw); layer_body<3>(p, lds_raw);
#undef IN
#undef PHB
#undef G1PTR
#undef SEAM
}

#ifndef MK_N_LAUNCHES
#define MK_N_LAUNCHES 0
#endif
extern "C" void kernel_launch(void* const* d_in, const int* in_sizes, int n_in, void* d_out, int out_size, void* d_ws, size_t ws_size, hipStream_t stream) {
    static int grid = 0;
    if (grid == 0) {
        if (n_in != 33 || out_size != T * D || ws_size < WS_END) { fprintf(stderr, "kernel_launch: expected 33 inputs, %d outputs, >= %zu bytes of workspace; got %d, %d, %zu\n", T * D, (size_t)WS_END, n_in, out_size, ws_size); grid = -1; return; }
        int dev = 0, cus = 0, per_cu = 0;
        if (hipGetDevice(&dev) != hipSuccess || hipDeviceGetAttribute(&cus, hipDeviceAttributeMultiprocessorCount, dev) != hipSuccess) { grid = -1; return; }
        if (hipFuncSetAttribute((const void*)mk_fwd, hipFuncAttributeMaxDynamicSharedMemorySize, LDS_BYTES) != hipSuccess) { fprintf(stderr, "kernel_launch: hipFuncSetAttribute failed\n"); grid = -1; return; }
        if (hipOccupancyMaxActiveBlocksPerMultiprocessor(&per_cu, (const void*)mk_fwd, NTHR, LDS_BYTES) != hipSuccess || per_cu < 1)
            fprintf(stderr, "kernel_launch: note: occupancy query reports %d workgroups per CU\n", per_cu);
        (void)hipGetLastError();
        grid = cus;
    }
    if (grid < 0) return;
    (void)hipMemsetAsync((char*)d_ws + WS_CTL, 0, 1 * MiB, stream);
    Args a{};
    for (int i = 0; i < 33; ++i) a.in[i] = (const float*)d_in[i];
    a.out = (float*)d_out; a.ws = (unsigned char*)d_ws;
#if MK_N_LAUNCHES == 1
    a.ph_lo = 0; a.ph_hi = N_PHASES;
    hipLaunchKernelGGL(mk_fwd, dim3(grid), dim3(NTHR), LDS_BYTES, stream, a);
#else
    for (int p = 0; p < N_PHASES; ++p) { a.ph_lo = p; a.ph_hi = p + 1; hipLaunchKernelGGL(mk_fwd, dim3(grid), dim3(NTHR), LDS_BYTES, stream, a); }
#endif
    const hipError_t le = hipPeekAtLastError();
    if (le != hipSuccess) fprintf(stderr, "kernel_launch: launch failed: %s\n", hipGetErrorName(le));
}
```

```cpp
#define MK_N_LAUNCHES 1
#define MK_FAST_ATTN 1
#define MK_FAST_CONV 1
#define MK_GATHER 1
#define MK_FAST_SP 1
#include <hip/hip_runtime.h>
#include <cstdio>
#include <cstdint>
#include <cmath>
namespace pg8 {
#define PG8_LAS __attribute__((address_space(3)))
typedef unsigned short bf16_t;
typedef short bf16x8 __attribute__((ext_vector_type(8)));
typedef float f32x4 __attribute__((ext_vector_type(4)));
typedef unsigned u32x4 __attribute__((ext_vector_type(4)));
constexpr int BM = 256, BK = 64, HALF = 128, HTB = HALF * BK * 2  , STAGE_BYTES = 8 * HTB, NXCD = 8, WGM = 8;

__host__ __device__ __forceinline__ int lds_byte(int r, int c) { const int st = (r >> 4) * 2 + (c >> 5), rr = r & 15, cc = c & 31, ob = rr * 64 + cc * 2; return st * 1024 + (ob ^ (((ob >> 9) & 1) << 5)); }
__host__ __device__ __forceinline__ void stage_rc(int b, int& R, int& C) { const int st = b / 1024, sb = b % 1024, swz = sb ^ (((sb >> 9) & 1) << 5); R = (st >> 1) * 16 + swz / 64; C = (st & 1) * 32 + (swz % 64) / 2; }
__host__ __device__ __forceinline__ int perm32(int rho) { const int n = rho >> 4, i = rho & 15; return 8 * (i >> 2) + 4 * n + (i & 3); }

struct Unit { int pm, pn; };
struct Gemm { const bf16_t* A; const bf16_t* Bt; int M, N, K; const int* rows; };

struct StaticOrder {
    int nM, nN, nwg, G, c;
    __host__ __device__ void init(int M, int N, int G_, int c_) { nM = M / BM; nN = N / BM; nwg = nM * nN; G = G_; c = c_; }
    __host__ __device__ bool next(int i, Unit& u) const {
        const long L = (long)i * G + c; if (L >= nwg) return false;
        int wgid = (int)L; { const int q = nwg / NXCD, r = nwg % NXCD, xcd = wgid % NXCD, off = wgid / NXCD; wgid = (xcd < r ? xcd * (q + 1) : r * (q + 1) + (xcd - r) * q) + off; }
        const int nig = WGM * nN, gid = wgid / nig, fm = gid * WGM, gsz = (nM - fm) < WGM ? (nM - fm) : WGM;
        u.pm = fm + ((wgid % nig) % gsz); u.pn = (wgid % nig) / gsz; return true;
    }
    __device__ __forceinline__ void a_ready(const Unit&) const {}
    __device__ __forceinline__ void done(const Unit&) const {}
};

__device__ __forceinline__ unsigned cvt_pk_bf16(float lo, float hi) { unsigned r; asm volatile("v_cvt_pk_bf16_f32 %0, %1, %2" : "=v"(r) : "v"(lo), "v"(hi)); return r; }
typedef float f32x2 __attribute__((ext_vector_type(2)));
__device__ __forceinline__ f32x2 gelu_pk(f32x2 v) {
    const f32x2 av = __builtin_elementwise_abs(v), d = av * 0.2316418882f + 1.0f;
    f32x2 t; t.x = __builtin_amdgcn_rcpf(d.x); t.y = __builtin_amdgcn_rcpf(d.y);
    f32x2 q = t * 0.5307027145f + (-0.7265760135f); q = q * t + 0.7107068705f; q = q * t + (-0.142248368f); q = q * t + 0.127414796f; q = q * t;
    const f32x2 s = (v * v) * (-0.72134752044f);
    f32x2 e; e.x = __builtin_amdgcn_exp2f(s.x); e.y = __builtin_amdgcn_exp2f(s.y);
    const f32x2 m = v * (q * e), r = v - m;
    f32x2 o; o.x = v.x < 0.f ? m.x : r.x; o.y = v.y < 0.f ? m.y : r.y; return o;
}

template <int ACT  > struct EpiBf16 {
    static constexpr bool PERM = true, AFTER_DRAIN = false; static_assert(ACT == 0 || ACT == 1, "EpiBf16: ACT is 0 (none) or 1 (gelu_pk)");
    bf16_t* O; int ldc; const float* bias; int split_cols; size_t split_stride; float scale0;
    __device__ __forceinline__ void operator()(const f32x4 (&acc)[2][2][4][2], const Unit& u, int wr, int wc, int fr, int fq) const {
        const int row0 = u.pm * BM + wr * 64 + fr; int colt = u.pn * BM; bf16_t* base = O;
        float sc = 1.f; if (split_cols) { const int t = colt / split_cols; base += (size_t)t * split_stride; colt -= t * split_cols; if (t == 0) sc = scale0; }
        const int col0 = colt + wc * 32 + 8 * fq, bcol0 = u.pn * BM + wc * 32 + 8 * fq;
        f32x4 bv[2][2];
#pragma unroll
        for (int bj = 0; bj < 2; ++bj)
#pragma unroll
            for (int n = 0; n < 2; ++n) bv[bj][n] = bias ? *(const f32x4*)(bias + bcol0 + bj * HALF + 4 * n) : (f32x4){0.f, 0.f, 0.f, 0.f};
#pragma unroll
        for (int ai = 0; ai < 2; ++ai)
#pragma unroll
            for (int m = 0; m < 4; ++m) { bf16_t* rowp = base + (size_t)(row0 + ai * HALF + m * 16) * ldc + col0;
#pragma unroll
                for (int bj = 0; bj < 2; ++bj) { f32x4 v0 = acc[ai][bj][m][0] + bv[bj][0], v1 = acc[ai][bj][m][1] + bv[bj][1];
                    if (ACT == 1) { f32x2 a = gelu_pk((f32x2){v0[0], v0[1]}), b = gelu_pk((f32x2){v0[2], v0[3]}), c = gelu_pk((f32x2){v1[0], v1[1]}), d = gelu_pk((f32x2){v1[2], v1[3]});
                        v0 = (f32x4){a.x, a.y, b.x, b.y}; v1 = (f32x4){c.x, c.y, d.x, d.y}; }
                    v0 = v0 * sc; v1 = v1 * sc; u32x4 w; w.x = cvt_pk_bf16(v0[0], v0[1]); w.y = cvt_pk_bf16(v0[2], v0[3]); w.z = cvt_pk_bf16(v1[0], v1[1]); w.w = cvt_pk_bf16(v1[2], v1[3]);
                    *(u32x4*)(rowp + bj * HALF) = w; } }
    }
};

struct EpiF32 {
    static constexpr bool PERM = false, AFTER_DRAIN = false;
    float* C; int ldc;
    __device__ __forceinline__ void operator()(const f32x4 (&acc)[2][2][4][2], const Unit& u, int wr, int wc, int fr, int fq) const {
        const int row0 = u.pm * BM + wr * 64 + fr, col0 = u.pn * BM + wc * 32 + 4 * fq;
#pragma unroll
        for (int ai = 0; ai < 2; ++ai)
#pragma unroll
            for (int m = 0; m < 4; ++m) { float* rowp = C + (size_t)(row0 + ai * HALF + m * 16) * ldc + col0;
#pragma unroll
                for (int bj = 0; bj < 2; ++bj)
#pragma unroll
                    for (int n = 0; n < 2; ++n) *(f32x4*)(rowp + bj * HALF + n * 16) = acc[ai][bj][m][n]; }
    }
};
struct EpiRes {
    static constexpr bool PERM = false, AFTER_DRAIN = false;
    const float* X; float* U; const float* g; int gstride; float alpha;
    __device__ __forceinline__ void operator()(const f32x4 (&acc)[2][2][4][2], const Unit& u, int wr, int wc, int fr, int fq) const {
        const int row0 = u.pm * BM + wr * 64 + fr, col0 = u.pn * BM + wc * 32 + 4 * fq;
        const int rb = u.pm * BM; const int bidx = rb < 16384 ? (rb >> 12) : 4;
        const float* gp = g + (size_t)bidx * gstride + col0;
        f32x4 gv[2][2];
#pragma unroll
        for (int bj = 0; bj < 2; ++bj)
#pragma unroll
            for (int n = 0; n < 2; ++n) gv[bj][n] = *(const f32x4*)(gp + bj * HALF + n * 16);
#pragma unroll
        for (int ai = 0; ai < 2; ++ai)
#pragma unroll
            for (int m = 0; m < 4; ++m) { const size_t off = (size_t)(row0 + ai * HALF + m * 16) * 1024 + col0;
#pragma unroll
                for (int bj = 0; bj < 2; ++bj)
#pragma unroll
                    for (int n = 0; n < 2; ++n) { const f32x4 xv = *(const f32x4*)(X + off + bj * HALF + n * 16);
                        *(f32x4*)(U + off + bj * HALF + n * 16) = xv * alpha + gv[bj][n] * acc[ai][bj][m][n]; }
                asm volatile("" ::: "memory"); }
    }
};
struct EpiGU {
    static constexpr bool PERM = true, AFTER_DRAIN = false;
    bf16_t* ACT; int npn;
    __device__ __forceinline__ void operator()(const f32x4 (&acc)[2][2][4][2], const Unit& u, int wr, int wc, int fr, int fq) const {
        const int row0 = u.pm * BM + wr * 64 + fr; const int col0 = (u.pn % npn) * 128 + wc * 32 + 8 * fq;
#pragma unroll
        for (int ai = 0; ai < 2; ++ai)
#pragma unroll
            for (int m = 0; m < 4; ++m) { bf16_t* rowp = ACT + (size_t)(row0 + ai * HALF + m * 16) * 2048 + col0;
                float o[8];
#pragma unroll
                for (int n = 0; n < 2; ++n)
#pragma unroll
                    for (int j = 0; j < 4; ++j) { const float a = acc[ai][0][m][n][j], b = acc[ai][1][m][n][j];
                        const float s = a * __builtin_amdgcn_rcpf(1.0f + __builtin_amdgcn_exp2f(-1.4426950408889634f * a)); o[n * 4 + j] = s * b; }
                u32x4 w; w.x = cvt_pk_bf16(o[0], o[1]); w.y = cvt_pk_bf16(o[2], o[3]); w.z = cvt_pk_bf16(o[4], o[5]); w.w = cvt_pk_bf16(o[6], o[7]);
                *(u32x4*)rowp = w; }
    }
};
struct EpiDN {
    static constexpr bool PERM = true, AFTER_DRAIN = false;
    bf16_t* Y; const float* gate; int npn;
    __device__ __forceinline__ void operator()(const f32x4 (&acc)[2][2][4][2], const Unit& u, int wr, int wc, int fr, int fq) const {
        const int row0 = u.pm * BM + wr * 64 + fr, col0 = (u.pn % npn) * BM + wc * 32 + 8 * fq;
#pragma unroll
        for (int ai = 0; ai < 2; ++ai)
#pragma unroll
            for (int m = 0; m < 4; ++m) { const int row = row0 + ai * HALF + m * 16; const float gt = gate[row]; bf16_t* rowp = Y + (size_t)row * 1024 + col0;
#pragma unroll
                for (int bj = 0; bj < 2; ++bj) { const f32x4 v0 = acc[ai][bj][m][0] * gt, v1 = acc[ai][bj][m][1] * gt;
                    u32x4 w; w.x = cvt_pk_bf16(v0[0], v0[1]); w.y = cvt_pk_bf16(v0[2], v0[3]); w.z = cvt_pk_bf16(v1[0], v1[1]); w.w = cvt_pk_bf16(v1[2], v1[3]);
                    *(u32x4*)(rowp + bj * HALF) = w; } }
    }
};
struct EpiVT {
    static constexpr bool PERM = false, AFTER_DRAIN = false;
    float* VT; int ldc; f32x2* VST; int ntok;
    __device__ __forceinline__ void operator()(const f32x4 (&acc)[2][2][4][2], const Unit& u, int wr, int wc, int fr, int fq) const {
        const int row0 = u.pm * BM + wr * 64 + fr, col0 = u.pn * BM + wc * 32 + 4 * fq;
        f32x4 s1[2][2], s2[2][2];
#pragma unroll
        for (int bj = 0; bj < 2; ++bj)
#pragma unroll
            for (int n = 0; n < 2; ++n) { s1[bj][n] = (f32x4){0.f, 0.f, 0.f, 0.f}; s2[bj][n] = (f32x4){0.f, 0.f, 0.f, 0.f}; }
#pragma unroll
        for (int ai = 0; ai < 2; ++ai)
#pragma unroll
            for (int m = 0; m < 4; ++m) { float* rowp = VT + (size_t)(row0 + ai * HALF + m * 16) * ldc + col0;
#pragma unroll
                for (int bj = 0; bj < 2; ++bj)
#pragma unroll
                    for (int n = 0; n < 2; ++n) { const f32x4 v = acc[ai][bj][m][n]; const f32x2 a = gelu_pk((f32x2){v[0], v[1]}), b = gelu_pk((f32x2){v[2], v[3]});
                        const f32x4 gl = (f32x4){a.x, a.y, b.x, b.y}; *(f32x4*)(rowp + bj * HALF + n * 16) = gl; s1[bj][n] += gl; s2[bj][n] += gl * gl; } }
#pragma unroll
        for (int bj = 0; bj < 2; ++bj)
#pragma unroll
            for (int n = 0; n < 2; ++n)
#pragma unroll
                for (int j = 0; j < 4; ++j) { float a = s1[bj][n][j], b = s2[bj][n][j];
#pragma unroll
                    for (int o = 1; o < 16; o <<= 1) { a += __shfl_xor(a, o); b += __shfl_xor(b, o); }
                    s1[bj][n][j] = a; s2[bj][n][j] = b; }
        if (fr == 0) {
            f32x2* dst = VST + (size_t)(u.pm * 2 + wr) * ntok + col0;
#pragma unroll
            for (int bj = 0; bj < 2; ++bj)
#pragma unroll
                for (int n = 0; n < 2; ++n)
#pragma unroll
                    for (int j = 0; j < 4; ++j) dst[bj * HALF + n * 16 + j] = (f32x2){s1[bj][n][j], s2[bj][n][j]};
        }
    }
};
struct MoeOrder {
    int nPM, nPN, G, vcu;
    __device__ __forceinline__ bool next(int i, Unit& u) const {
        const int L = i * G + vcu; if (L >= 16 * nPM * nPN) return false;
        const int pm = L % nPM, r = L / nPM, pn = r % nPN, e = r / nPN; u.pm = e * 9 + pm; u.pn = e * nPN + pn; return true;
    }
    __device__ __forceinline__ void a_ready(const Unit&) const {}
    __device__ __forceinline__ void done(const Unit&) const {}
};

template <class Epi, class Sched, bool ALIGN_EPI = false, bool GATHER = false>
__device__ __forceinline__ void gemm_phase(PG8_LAS unsigned char* lds, const Gemm g, const Sched& S, const Epi& E) {
    int tid_ = threadIdx.x; asm volatile("" : "+v"(tid_));
    const int tid = tid_, wid = __builtin_amdgcn_readfirstlane(tid >> 6), lane = tid & 63, wr = wid >> 2, wc = wid & 3, fr = lane & 15, fq = lane >> 4;
    const int K = g.K, nt = K / BK;
    unsigned voffA[2], voffB[2];
#pragma unroll
    for (int i = 0; i < 2; ++i) { int R, C; stage_rc(tid * 16 + i * 8192, R, C); const int Rb = Epi::PERM ? ((R & ~31) + perm32(R & 31)) : R;
        voffA[i] = (unsigned)(R * K + C) * 2u; voffB[i] = (unsigned)(Rb * K + C) * 2u; }
    const size_t kstep = (size_t)(BK * 2);
    const size_t hstep = (size_t)HALF * K * 2;
    const size_t tstep = 2 * hstep;
    const unsigned ldsw = (unsigned)wid * 1024u;
    const int aoff = lds_byte(wr * 64 + fr, fq * 8), boff = lds_byte(wc * 32 + fr, fq * 8);
#define PG8_SA(b, h) (((b) * 2 + (h)) * HTB)
#define PG8_SB(b, h) ((4 + (b) * 2 + (h)) * HTB)
#define PG8_STAGE(bufoff, gbase, voff) do { _Pragma("unroll") for (int _i = 0; _i < 2; ++_i) \
        __builtin_amdgcn_global_load_lds((const unsigned*)((const char*)(gbase) + (voff)[_i]), (PG8_LAS unsigned*)(lds + (bufoff) + ldsw + _i * 8192), 16, 0, 0); } while (0)
#define PG8_STGA(b, h, ubase, koff, gofs) do { if constexpr (GATHER) { PG8_STAGE(PG8_SA(b, h), (const char*)g.A + (koff), gofs[h]); } \
        else { PG8_STAGE(PG8_SA(b, h), (ubase) + (koff) + (size_t)(h) * hstep, voffA); } } while (0)
#define PG8_GLOAD(dst, u) do { if constexpr (GATHER) { _Pragma("unroll") for (int _i = 0; _i < 2; ++_i) { int _R, _C; stage_rc(tid * 16 + _i * 8192, _R, _C); \
        _Pragma("unroll") for (int _h = 0; _h < 2; ++_h) dst[_h][_i] = (unsigned)g.rows[(u).pm * BM + _h * HALF + _R] * (unsigned)(K * 2) + (unsigned)_C * 2u; } } } while (0)
#define PG8_LDA(dst, b, h) do { _Pragma("unroll") for (int m = 0; m < 4; ++m) _Pragma("unroll") for (int k = 0; k < 2; ++k) dst[m][k] = *(const PG8_LAS bf16x8*)(lds + PG8_SA(b, h) + aoff + m * 2048 + k * 1024); } while (0)
#define PG8_LDB(dst, b, h) do { _Pragma("unroll") for (int n = 0; n < 2; ++n) _Pragma("unroll") for (int k = 0; k < 2; ++k) dst[n][k] = *(const PG8_LAS bf16x8*)(lds + PG8_SB(b, h) + boff + n * 2048 + k * 1024); } while (0)
#define PG8_MMA(ai, bj, At, Bt) do { __builtin_amdgcn_s_setprio(1); _Pragma("unroll") for (int m = 0; m < 4; ++m) _Pragma("unroll") for (int n = 0; n < 2; ++n) _Pragma("unroll") for (int k = 0; k < 2; ++k) \
        acc[ai][bj][m][n] = __builtin_amdgcn_mfma_f32_16x16x32_bf16(Bt[n][k], At[m][k], acc[ai][bj][m][n], 0, 0, 0); __builtin_amdgcn_s_setprio(0); } while (0)
#define PG8_WAIT_V(n) asm volatile("s_waitcnt vmcnt(" #n ")" ::: "memory")
#define PG8_WAIT_L(n) asm volatile("s_waitcnt lgkmcnt(" #n ")" ::: "memory")
#define PG8_BAR __builtin_amdgcn_s_barrier()
#define PG8_SCHED __builtin_amdgcn_sched_barrier(0)
    Unit cur, nxt; int ui = 0;
    if (!S.next(0, cur)) return;
    f32x4 acc[2][2][4][2];
#pragma unroll
    for (int a = 0; a < 2; ++a)
#pragma unroll
        for (int b = 0; b < 2; ++b)
#pragma unroll
            for (int m = 0; m < 4; ++m)
#pragma unroll
                for (int n = 0; n < 2; ++n) acc[a][b][m][n] = (f32x4){0.f, 0.f, 0.f, 0.f};
    bf16x8 At[4][2], B0[2][2], B1[2][2];
    unsigned gc[2][2] = {{0u, 0u}, {0u, 0u}}, gn[2][2] = {{0u, 0u}, {0u, 0u}};
    const char* cA = GATHER ? (const char*)g.A : (const char*)g.A + (size_t)cur.pm * tstep; const char* cB = (const char*)g.Bt + (size_t)cur.pn * tstep;
    S.a_ready(cur);
    PG8_GLOAD(gc, cur);
    PG8_STAGE(PG8_SB(0, 0), cB, voffB); PG8_STAGE(PG8_SB(0, 1), cB + hstep, voffB); PG8_STGA(0, 0, cA, 0, gc); PG8_STGA(0, 1, cA, 0, gc);
    if (wr == 1) PG8_BAR;
    PG8_WAIT_V(2); PG8_BAR;
    PG8_STAGE(PG8_SB(1, 0), cB + kstep, voffB); PG8_STGA(1, 0, cA, kstep, gc); PG8_STAGE(PG8_SB(1, 1), cB + hstep + kstep, voffB);
    PG8_WAIT_V(6); PG8_BAR;
    for (;;) {
        const bool has_next = S.next(ui + 1, nxt);
        const char* nA = GATHER ? (const char*)g.A : (has_next ? (const char*)g.A + (size_t)nxt.pm * tstep : cA); const char* nB = has_next ? (const char*)g.Bt + (size_t)nxt.pn * tstep : cB;
        for (int t = 0; t < nt; t += 2) {
            const bool last = (t == nt - 2);
            const size_t k1 = (size_t)(t + 1) * kstep;
            const char* b2 = last ? nB : cB + (size_t)(t + 2) * kstep; const char* b3 = b2 + kstep;
            if (last && has_next) S.a_ready(nxt);
            if (last) { if (has_next) { PG8_GLOAD(gn, nxt); } else {
#pragma unroll
                    for (int h = 0; h < 2; ++h)
#pragma unroll
                        for (int i = 0; i < 2; ++i) gn[h][i] = gc[h][i]; } }
            PG8_LDB(B0, 0, 0); PG8_LDB(B1, 0, 1); PG8_SCHED; PG8_LDA(At, 0, 0); PG8_STGA(1, 1, cA, k1, gc);
            PG8_WAIT_V(8); PG8_WAIT_L(0); PG8_BAR; PG8_MMA(0, 0, At, B0); PG8_MMA(0, 1, At, B1); PG8_BAR; PG8_SCHED;
            PG8_LDA(At, 0, 1); PG8_STAGE(PG8_SB(0, 0), b2, voffB); PG8_STAGE(PG8_SB(0, 1), b2 + hstep, voffB);
            if (last) { PG8_STGA(0, 0, nA, 0, gn); } else { PG8_STGA(0, 0, cA, (size_t)(t + 2) * kstep, gc); }
            PG8_WAIT_V(8); PG8_WAIT_L(0); PG8_BAR; PG8_MMA(1, 0, At, B0); PG8_MMA(1, 1, At, B1); PG8_BAR; PG8_SCHED;
            PG8_LDB(B0, 1, 0); PG8_LDB(B1, 1, 1); PG8_SCHED; PG8_LDA(At, 1, 0);
            if (last) { PG8_STGA(0, 1, nA, 0, gn); } else { PG8_STGA(0, 1, cA, (size_t)(t + 2) * kstep, gc); }
            PG8_WAIT_V(8); PG8_WAIT_L(0); PG8_BAR; PG8_MMA(0, 0, At, B0); PG8_MMA(0, 1, At, B1); PG8_BAR; PG8_SCHED;
            PG8_LDA(At, 1, 1); PG8_STAGE(PG8_SB(1, 0), b3, voffB); PG8_STAGE(PG8_SB(1, 1), b3 + hstep, voffB);
            if (last) { PG8_STGA(1, 0, nA, kstep, gn); } else { PG8_STGA(1, 0, cA, (size_t)(t + 3) * kstep, gc); }
            PG8_WAIT_V(8); PG8_WAIT_L(0); PG8_BAR; PG8_MMA(1, 0, At, B0); PG8_MMA(1, 1, At, B1); PG8_BAR; PG8_SCHED;
        }
        if constexpr (ALIGN_EPI) { if (wr == 0) PG8_BAR; }
        if constexpr (!Epi::AFTER_DRAIN) { E(acc, cur, wr, wc, fr, fq); S.done(cur); }
        if (!has_next) break;
#pragma unroll
        for (int a = 0; a < 2; ++a)
#pragma unroll
            for (int b = 0; b < 2; ++b)
#pragma unroll
                for (int m = 0; m < 4; ++m)
#pragma unroll
                    for (int n = 0; n < 2; ++n) acc[a][b][m][n] = (f32x4){0.f, 0.f, 0.f, 0.f};
        cur = nxt; cA = nA; cB = nB; ++ui;
#pragma unroll
        for (int h = 0; h < 2; ++h)
#pragma unroll
            for (int i = 0; i < 2; ++i) gc[h][i] = gn[h][i];
        if constexpr (ALIGN_EPI) { if (wr == 1) PG8_BAR; }
    }
    PG8_WAIT_V(0);
    if constexpr (!ALIGN_EPI) { if (wr == 0) PG8_BAR; }
    PG8_BAR;
    if constexpr (Epi::AFTER_DRAIN) { E.fused(acc, cur, wr, wc, fr, fq, lds, wid, lane); S.done(cur); }
#undef PG8_SA
#undef PG8_SB
#undef PG8_STAGE
#undef PG8_STGA
#undef PG8_GLOAD
#undef PG8_LDA
#undef PG8_LDB
#undef PG8_MMA
#undef PG8_WAIT_V
#undef PG8_WAIT_L
#undef PG8_BAR
#undef PG8_SCHED
}
}
constexpr int NB = 4, SEQ = 4096, T = NB * SEQ, LC = 256, TC = NB * LC, TA = T + TC, D = 1024;
constexpr int NE = 16, FF = 2048, ESTR = 2304;
constexpr int LK = LC + SEQ, KVP = 256;
constexpr float ALPHA = 1.6817928305074290f;
constexpr float LN_EPS = 1e-5f, RMS_EPS = 1e-6f;
constexpr float ATT_C2 = 0.125f * 1.4426950408889634f;
constexpr int NWAVES = 8, NTHR = 512;
constexpr size_t MiB = 1u << 20;
constexpr size_t WS_CTL = 0, WS_MOD = 1 * MiB, WS_MODP = 2 * MiB, WS_TW = 6 * MiB;
constexpr size_t WS_WHYIN = 8 * MiB, WS_WHYOUT = 20 * MiB, WS_WQKV = 24 * MiB, WS_WATO = 27 * MiB, WS_WCMIN = 29 * MiB, WS_WCMOUT = 37 * MiB, WS_WCMS = 41 * MiB;
constexpr size_t WS_WGU = 42 * MiB, WS_WDN = 554 * MiB, WS_HF = 810 * MiB;
constexpr size_t WS_XL = 942 * MiB, WS_U = 1010 * MiB, WS_HB = 1078 * MiB, WS_AFF = 1112 * MiB, WS_ROWS = 1114 * MiB, WS_GATE = WS_ROWS + 256 * 1024, WS_INV = 1115 * MiB;
constexpr size_t WS_ACT = 1117 * MiB, WS_Y = 1261 * MiB, WS_SCR = 1405 * MiB, WS_XC = 1677 * MiB, WS_END = 1745 * MiB;
constexpr size_t WS_XG = WS_Y;
constexpr size_t SC_PT = WS_SCR, SC_Z2T = WS_SCR + 204 * MiB, SC_Z2 = WS_SCR + 238 * MiB;
constexpr size_t SC_QKV = WS_SCR, SC_Q = WS_SCR + 102 * MiB, SC_K = WS_SCR + 134 * MiB, SC_V = WS_SCR + 143 * MiB, SC_O = WS_SCR + 152 * MiB;
constexpr size_t SC_UB = WS_SCR, SC_VT = WS_SCR + 64 * MiB, SC_VST = WS_SCR + 192 * MiB, SC_UV = WS_SCR + 194 * MiB;
constexpr size_t HF_SLOT = (size_t)4 * 1024 * 4096 * 4, HF_CTX = 2 * HF_SLOT;
constexpr int LDS_BYTES = 147456;
constexpr int RING_BYTES = 131072, MISC_OFF = LDS_BYTES - 256;

#define GAS __attribute__((address_space(1)))
#define LAS __attribute__((address_space(3)))
typedef unsigned short bf16;
typedef unsigned v4u __attribute__((ext_vector_type(4)));
typedef unsigned v2u __attribute__((ext_vector_type(2)));
typedef float f32x4 __attribute__((ext_vector_type(4)));
typedef float f32x2 __attribute__((ext_vector_type(2)));
#define LDS_WAIT() asm volatile("s_waitcnt lgkmcnt(0)" ::: "memory")
__device__ __forceinline__ unsigned f2bf(float f) { unsigned u = __builtin_bit_cast(unsigned, f); return (u + 0x7fffu + ((u >> 16) & 1u)) >> 16; }
__device__ __forceinline__ unsigned pk2(float lo, float hi) { return f2bf(lo) | (f2bf(hi) << 16); }
__device__ __forceinline__ float bf2f(unsigned short b) { return __builtin_bit_cast(float, (unsigned)b << 16); }
__device__ __forceinline__ float wave_sum(float v) {
#pragma unroll
    for (int o = 1; o < 64; o <<= 1) v += __shfl_xor(v, o);
    return v;
}

#define XB_TMO      128
#define XB_XCNT(j)  (256  + 64 * (j))
#define XB_XSUB(j)  (1280 + 64 * (j))
#define XB_XGEN(j)  (2304 + 64 * (j))
#define XB_TOP      3328
#define XB_TOPGEN   3392
#define XCD_BAR_WORDS 3456
#define XB_SPIN_CAP (1u << 18)
__device__ __forceinline__ unsigned xb_ld(unsigned* p)              { return __hip_atomic_load(p, __ATOMIC_RELAXED, __HIP_MEMORY_SCOPE_AGENT); }
__device__ __forceinline__ unsigned xb_add(unsigned* p, unsigned v) { return __hip_atomic_fetch_add(p, v, __ATOMIC_RELAXED, __HIP_MEMORY_SCOPE_AGENT); }
__device__ __forceinline__ unsigned xb_xcc_id() { return (unsigned)__builtin_amdgcn_s_getreg((3 << 11) | 20) & 0xFu; }
#define XB_SPIN(cond, bar) do { unsigned _sp = 0; while (cond) { __builtin_amdgcn_s_sleep(1); \
    if ((++_sp & 255u) == 0u) { if (xb_ld(&(bar)[XB_TMO])) break; if (_sp > XB_SPIN_CAP) { atomicAdd(&(bar)[XB_TMO], 1u); break; } } } } while (0)
struct XcdBarrier { unsigned* bar; unsigned x; volatile LAS unsigned* st; };
__device__ __forceinline__ XcdBarrier xcd_barrier_post(unsigned* bar, volatile LAS unsigned* st) {
    XcdBarrier b; b.bar = bar; b.x = xb_xcc_id(); b.st = st;
    if (threadIdx.x == 0) (void)xb_add(&bar[XB_XCNT(b.x)], 1u);
    return b;
}
__device__ __forceinline__ void xcd_barrier_complete(unsigned* bar, unsigned x, unsigned& nloc, unsigned& nx) {
    const unsigned G = gridDim.x * gridDim.y * gridDim.z;
    unsigned sum, cnt, mine, sp = 0u;
    for (;;) {
        sum = 0u; cnt = 0u; mine = 0u;
#pragma unroll
        for (unsigned j = 0; j < 16; ++j) { const unsigned c = xb_ld(&bar[XB_XCNT(j)]); sum += c; cnt += (c > 0u) ? 1u : 0u; mine = (j == x) ? c : mine; }
        if (sum == G) break;
        __builtin_amdgcn_s_sleep(1);
        if ((++sp & 255u) == 0u) { if (xb_ld(&bar[XB_TMO])) break; if (sp > XB_SPIN_CAP) { atomicAdd(&bar[XB_TMO], 1u); break; } }
    }
    nloc = mine > 0u ? mine : 1u; nx = cnt > 0u ? cnt : 1u;
}
__device__ __forceinline__ void xcd_barrier(const XcdBarrier& b) {
    asm volatile("s_waitcnt vmcnt(0)" ::: "memory");
    __syncthreads();
    if (threadIdx.x == 0) {
        unsigned* bar = b.bar; asm volatile("" : "+s"(bar));
        __builtin_amdgcn_s_waitcnt(0);
        unsigned bx_ = b.x; asm volatile("" : "+s"(bx_));
        unsigned nloc = b.st[0], nx = b.st[1];
        if (nloc == 0u) { xcd_barrier_complete(bar, bx_, nloc, nx); b.st[0] = nloc; b.st[1] = nx; }
        const unsigned old = xb_add(&bar[XB_XSUB(bx_)], 1u);
        const unsigned gen = old / nloc;
        if (old + 1u == (gen + 1u) * nloc) {
            __builtin_amdgcn_fence(__ATOMIC_RELEASE, "agent");
            asm volatile("s_waitcnt vmcnt(0)" ::: "memory");
            const unsigned og = xb_add(&bar[XB_TOP], 1u);
            const unsigned tg = og / nx;
            if (og + 1u == (tg + 1u) * nx) xb_add(&bar[XB_TOPGEN], 1u);
            else XB_SPIN(xb_ld(&bar[XB_TOPGEN]) == tg, bar);
            __builtin_amdgcn_fence(__ATOMIC_ACQUIRE, "agent");
            xb_add(&bar[XB_XGEN(bx_)], 1u);
            asm volatile("s_waitcnt vmcnt(0)" ::: "memory");
        } else {
            XB_SPIN(xb_ld(&bar[XB_XGEN(bx_)]) == gen, bar);
            __builtin_amdgcn_fence(__ATOMIC_ACQUIRE, "agent");
            asm volatile("s_waitcnt vmcnt(0)" ::: "memory");
        }
    }
    __syncthreads();
}

struct Args { const float* in[33]; float* out; unsigned char* ws; int ph_lo, ph_hi; };
enum { I_X = 0, I_C, I_CTX, I_CCTX, I_MODW, I_MODB, I_LNG, I_LNB, I_HYWIN, I_HYCW, I_HYCB, I_FW1, I_FB1, I_FW2, I_FB2, I_FW3, I_FFREQ, I_FBIAS, I_HYWOUT,
       I_WQKV, I_QGAIN, I_KGAIN, I_WATO, I_CMWIN, I_CMLNG, I_CMLNB, I_CMWS, I_CMBS, I_CMWOUT, I_ROUTER, I_WGATE, I_WUP, I_WDOWN };
typedef const __attribute__((address_space(4))) Args* ArgsP;
__device__ __forceinline__ ArgsP get_args() { auto p = __builtin_amdgcn_kernarg_segment_ptr(); asm volatile("" : "+s"(p)); return (ArgsP)p; }
struct Fr { LAS unsigned char* lds; int tid, lane, wave, vcu, G, bx; };
__device__ __forceinline__ Fr mkfr(unsigned char* lds_raw) {
    Fr F; int tid = threadIdx.x; asm volatile("" : "+v"(tid)); int bx = blockIdx.x, G = gridDim.x; asm volatile("" : "+s"(bx), "+s"(G));
    F.lds = (LAS unsigned char*)lds_raw; F.tid = tid; F.lane = tid & 63; F.wave = __builtin_amdgcn_readfirstlane(tid >> 6);
    F.G = G; F.bx = bx; F.vcu = (G % 8 == 0) ? (bx % 8) * (G / 8) + bx / 8 : bx; return F; }
__device__ __forceinline__ void proA_adaln_item(ArgsP a, const Fr& F, int it) {
    LAS float* sc = (LAS float*)F.lds;
    const int i = it / 96, ks = (it / 12) % 8, cc = it % 12;
    __syncthreads();
    for (int u = F.tid; u < 5 * 128; u += NTHR) { const int r = u / 128, k = ks * 128 + (u % 128);
        const float x = r < 4 ? a->in[I_C][r * D + k] : a->in[I_CCTX][k]; sc[u] = x / (1.0f + expf(-x)); }
    __syncthreads();
    const int col = cc * 512 + F.tid;
    const float* w = a->in[I_MODW] + ((size_t)i * D + (size_t)ks * 128) * 6144 + col;
    float acc[5] = {0.f, 0.f, 0.f, 0.f, 0.f};
#pragma unroll 8
    for (int k = 0; k < 128; ++k) { const float wv = w[(size_t)k * 6144];
#pragma unroll
        for (int r = 0; r < 5; ++r) acc[r] += sc[r * 128 + k] * wv; }
    float* mp = (float*)(a->ws + WS_MODP) + (size_t)((i * 8 + ks) * 5) * 6144 + col;
#pragma unroll
    for (int r = 0; r < 5; ++r) mp[(size_t)r * 6144] = acc[r];
}
__device__ __forceinline__ void proA_filter_item(ArgsP a, const Fr& F, int it) {
    int slot, L, t0; float* HF;
    if (it < 512) { slot = it >> 8; L = SEQ; t0 = (it & 255) * 16; HF = (float*)(a->ws + WS_HF + (size_t)slot * HF_SLOT); }
    else { slot = 0; L = LC; t0 = (it - 512) * 16; HF = (float*)(a->ws + WS_HF + HF_CTX); }
    LAS float* z = (LAS float*)F.lds;
    LAS float* h1 = z + 16 * 33;
    LAS float* h2 = h1 + 16 * 64;
    __syncthreads();
    for (int u = F.tid; u < 16 * 33; u += NTHR) { const int tt = u / 33, j = u % 33; const float tf = (float)(t0 + tt);
        float v;
        if (j == 0) v = tf / (float)(L - 1);
        else { const int jj = (j - 1) & 15; const float f = 1e-4f + (float)jj * ((15.0f - 1e-4f) / 15.0f); const float w = (float)(6.283185307179586 / (double)L) * tf;
            v = j <= 16 ? cosf(f * w) : -sinf(f * w); }
        z[u] = v; }
    __syncthreads();
    const float* w1 = a->in[I_FW1] + (size_t)slot * 33 * 64; const float* b1 = a->in[I_FB1] + slot * 64;
    const float* w2 = a->in[I_FW2] + (size_t)slot * 64 * 64; const float* b2 = a->in[I_FB2] + slot * 64;
    const float* fq = a->in[I_FFREQ] + slot * 128;
    for (int u = F.tid; u < 16 * 64; u += NTHR) { const int tt = u >> 6, j = u & 63; float s = b1[j];
        for (int i = 0; i < 33; ++i) s += z[tt * 33 + i] * w1[i * 64 + j];
        h1[u] = sinf(fq[j] * s); }
    __syncthreads();
    for (int u = F.tid; u < 16 * 64; u += NTHR) { const int tt = u >> 6, j = u & 63; float s = b2[j];
        for (int i = 0; i < 64; ++i) s += h1[tt * 64 + i] * w2[i * 64 + j];
        h2[u] = sinf(fq[64 + j] * s); }
    __syncthreads();
    const float* w3 = a->in[I_FW3] + (size_t)slot * 64 * 4096;
    const float dmin = -3.0701134573253940f, dmax = -15.350567286626973f;
    for (int cb = 0; cb < 8; ++cb) { const int col = cb * 512 + F.tid;
        float acc[16];
#pragma unroll
        for (int tt = 0; tt < 16; ++tt) acc[tt] = 0.f;
        for (int k4 = 0; k4 < 16; ++k4) { const float wa = w3[(size_t)(4 * k4) * 4096 + col], wb = w3[(size_t)(4 * k4 + 1) * 4096 + col], wc = w3[(size_t)(4 * k4 + 2) * 4096 + col], wd = w3[(size_t)(4 * k4 + 3) * 4096 + col];
#pragma unroll
            for (int tt = 0; tt < 16; ++tt) { const f32x4 hv = *(const LAS f32x4*)(h2 + tt * 64 + 4 * k4); acc[tt] += (hv[0] * wa + hv[1] * wb) + (hv[2] * wc + hv[3] * wd); } }
        const int d = col & 1023; const float delta = fabsf(dmin + (float)d * ((dmax - dmin) / 1023.0f));
        float* dst = HF + (size_t)col * L + t0;
#pragma unroll
        for (int q = 0; q < 4; ++q) { f32x4 o;
#pragma unroll
            for (int j = 0; j < 4; ++j) { const int tt = q * 4 + j; const float tl = (float)(t0 + tt) / (float)(L - 1); o[j] = acc[tt] * expf(-tl * delta); }
            *(f32x4*)(dst + q * 4) = o; } }
}
__device__ __forceinline__ void conv_tile(const float* W, int K, int N, int k0, int n0, bf16* WT, int drow0, LAS float* scr, int lane) {
    float rv[64];
#pragma unroll
    for (int i = 0; i < 64; ++i) rv[i] = W[(size_t)(k0 + i) * N + n0 + lane];
#pragma unroll
    for (int i = 0; i < 64; ++i) scr[i * 65 + lane] = rv[i];
    LDS_WAIT(); asm volatile("" ::: "memory");
    const int c = lane & 7;
#pragma unroll
    for (int j = 0; j < 8; ++j) { const int n = (lane >> 3) + 8 * j; const LAS float* s = scr + (8 * c) * 65 + n;
        v4u o; o.x = pk2(s[0 * 65], s[1 * 65]); o.y = pk2(s[2 * 65], s[3 * 65]); o.z = pk2(s[4 * 65], s[5 * 65]); o.w = pk2(s[6 * 65], s[7 * 65]);
        *(v4u*)(WT + (size_t)(drow0 + n) * K + k0 + 8 * c) = o; }
    LDS_WAIT(); asm volatile("" ::: "memory");
}
constexpr int CV_SMALL = 768 * 2 + 256 * 2 + 384 + 256 + 1024 + 512;
constexpr int CV_MOE = 4 * 16 * 3 * 512;
__device__ __forceinline__ void proA_conv_item(ArgsP a, int it, LAS float* scr, int lane) {
    unsigned char* ws = a->ws;
    if (it < CV_SMALL) {
        int r = it;
        if (r < 1536) { const int s = r / 768, q = r % 768, kb = q / 48, nb = q % 48;
            conv_tile(a->in[I_HYWIN] + (size_t)s * 1024 * 3072, 1024, 3072, kb * 64, nb * 64, (bf16*)(ws + WS_WHYIN) + (size_t)s * 3072 * 1024, nb * 64, scr, lane); return; } r -= 1536;
        if (r < 512) { const int s = r / 256, q = r % 256, kb = q / 16, nb = q % 16;
            conv_tile(a->in[I_HYWOUT] + (size_t)s * 1024 * 1024, 1024, 1024, kb * 64, nb * 64, (bf16*)(ws + WS_WHYOUT) + (size_t)s * 1024 * 1024, nb * 64, scr, lane); return; } r -= 512;
        if (r < 384) { const int kb = r / 24, nb = r % 24;
            conv_tile(a->in[I_WQKV], 1024, 1536, kb * 64, nb * 64, (bf16*)(ws + WS_WQKV), nb * 64, scr, lane); return; } r -= 384;
        if (r < 256) { const int kb = r / 16, nb = r % 16;
            conv_tile(a->in[I_WATO], 1024, 1024, kb * 64, nb * 64, (bf16*)(ws + WS_WATO), nb * 64, scr, lane); return; } r -= 256;
        if (r < 1024) { const int kb = r / 64, nb = r % 64;
            conv_tile(a->in[I_CMWIN], 1024, 4096, kb * 64, nb * 64, (bf16*)(ws + WS_WCMIN), nb * 64, scr, lane); return; } r -= 1024;
        { const int kb = r / 16, nb = r % 16;
            conv_tile(a->in[I_CMWOUT], 2048, 1024, kb * 64, nb * 64, (bf16*)(ws + WS_WCMOUT), nb * 64, scr, lane); return; }
    }
    const int r = it - CV_SMALL, mat = r / 512, q = r % 512, le = mat / 3, which = mat % 3;
    if (which < 2) { const int kb = q / 32, nb = q % 32, n0 = nb * 64;
        const float* src = a->in[which == 0 ? I_WGATE : I_WUP] + (size_t)le * 1024 * 2048;
        conv_tile(src, 1024, 2048, kb * 64, n0, (bf16*)(ws + WS_WGU) + (size_t)le * 4096 * 1024, (n0 >> 7) * 256 + (n0 & 127) + which * 128, scr, lane); }
    else { const int kb = q / 16, nb = q % 16;
        conv_tile(a->in[I_WDOWN] + (size_t)le * 2048 * 1024, 2048, 1024, kb * 64, nb * 64, (bf16*)(ws + WS_WDN) + (size_t)le * 1024 * 2048, nb * 64, scr, lane); }
}
__device__ __forceinline__ void phase_proA(ArgsP a, const Fr& F) {
    for (int it = F.vcu; it < 384 + 528; it += F.G) { if (it < 384) proA_adaln_item(a, F, it); else proA_filter_item(a, F, it - 384); }
    __syncthreads();
    const int gt = F.vcu * NTHR + F.tid, NGT = F.G * NTHR;
    for (int k = gt; k < 8192; k += NGT) { float s, c; sincospif((float)k * (1.0f / 4096.0f), &s, &c); ((f32x2*)(a->ws + WS_TW))[k] = (f32x2){c, s}; }
    for (int k = gt; k < 16 * 128 * 128; k += NGT) ((bf16*)(a->ws + WS_WCMS))[k] = (bf16)f2bf(a->in[I_CMWS][k]);
    LAS float* scr = (LAS float*)(F.lds + F.wave * 16640);
    const int gw = F.vcu * NWAVES + F.wave, NGW = F.G * NWAVES;
    for (int it = gw; it < CV_SMALL + CV_MOE; it += NGW) proA_conv_item(a, it, scr, F.lane);
}
__device__ __forceinline__ void phase_proB(ArgsP a, const Fr& F) {
    LAS float* m0 = (LAS float*)F.lds;
    const float* mp = (const float*)(a->ws + WS_MODP);
    for (int u = F.tid; u < 5 * 2048; u += NTHR) { const int r = u / 2048, c = u % 2048; float s = a->in[I_MODB][c];
        for (int ks = 0; ks < 8; ++ks) s += mp[(size_t)(ks * 5 + r) * 6144 + c];
        m0[u] = s; }
    __syncthreads();
    const int gw = F.vcu * NWAVES + F.wave, NGW = F.G * NWAVES;
    for (int row = gw; row < TA; row += NGW) {
        const int r = row < T ? (row >> 12) : 4;
        const float* src = row < T ? a->in[I_X] + (size_t)row * D : a->in[I_CTX] + (size_t)(row - T) * D;
        float* xl = (float*)(a->ws + WS_XC) + (size_t)row * D; bf16* hb = (bf16*)(a->ws + WS_HB) + (size_t)row * D;
#pragma unroll
        for (int j = 0; j < 4; ++j) { const int c = 4 * F.lane + 256 * j; const f32x4 v = *(const f32x4*)(src + c); *(f32x4*)(xl + c) = v;
            const f32x4 sh = *(const LAS f32x4*)(m0 + r * 2048 + c), sc = *(const LAS f32x4*)(m0 + r * 2048 + 1024 + c);
            const f32x4 h = v * (sc + 1.0f) + sh; v2u o; o.x = pk2(h[0], h[1]); o.y = pk2(h[2], h[3]); *(v2u*)(hb + c) = o; }
    }
    const int gt = F.vcu * NTHR + F.tid, NGT = F.G * NTHR;
    float* mod = (float*)(a->ws + WS_MOD);
    for (int u = gt; u < 4 * 5 * 6144; u += NGT) { const int i = u / 30720, r = (u / 6144) % 5, c = u % 6144; float s = a->in[I_MODB][i * 6144 + c];
        for (int ks = 0; ks < 8; ++ks) s += mp[(size_t)((i * 8 + ks) * 5 + r) * 6144 + c];
        mod[u] = s; }
}
template <int L>
__device__ __forceinline__ float sconv(const bf16* p, int t, float w0, float w1, float w2, float cb) {
    const float a = t > 0 ? bf2f(p[t - 1]) : 0.f, b = bf2f(p[t]), c = t < L - 1 ? bf2f(p[t + 1]) : 0.f; return w0 * a + w1 * b + w2 * c + cb;
}
template <int L>
__device__ __forceinline__ void hy_direct_item(ArgsP a, const Fr& F, int slot, int d, int tok0, const float* HF) {
    LAS float* kk = (LAS float*)F.lds;
    LAS float* vb = kk + 4 * L;
    LAS float* red = vb + 4 * L;
    const bf16* PT = (const bf16*)(a->ws + SC_PT);
    bf16* Z2T = (bf16*)(a->ws + SC_Z2T);
    __syncthreads();
    for (int o = 0; o < 2; ++o) {
        const float* fw = HF + (size_t)((o * 2 + 0) * 1024 + d) * L; const float* bw = HF + (size_t)((o * 2 + 1) * 1024 + d) * L;
        float s = 0.f;
        for (int t = F.tid; t < L; t += NTHR) { const float f = fw[t], b = bw[t]; kk[o * 2 * L + (L - 1) + t] = f; if (t >= 1) kk[o * 2 * L + (L - 1) - t] = b; s += fabsf(f) + (t >= 1 ? fabsf(b) : 0.f); }
        s = wave_sum(s); if (F.lane == 0) red[o * 8 + F.wave] = s;
    }
    __syncthreads();
    float nrm[2];
#pragma unroll
    for (int o = 0; o < 2; ++o) { float s = 0.f; for (int w = 0; w < 8; ++w) s += red[o * 8 + w]; nrm[o] = 1.0f / (s + 1e-6f); }
    const float* cw = a->in[I_HYCW] + (size_t)slot * 3 * 3072; const float* cbp = a->in[I_HYCB] + (size_t)slot * 3072;
    float w0[3], w1[3], w2[3], cb[3];
#pragma unroll
    for (int g = 0; g < 3; ++g) { const int c = g * 1024 + d; w0[g] = cw[c]; w1[g] = cw[3072 + c]; w2[g] = cw[2 * 3072 + c]; cb[g] = cbp[c]; }
    const float fb0 = a->in[I_FBIAS][(slot * 2 + 0) * 1024 + d], fb1 = a->in[I_FBIAS][(slot * 2 + 1) * 1024 + d];
    for (int u = F.tid; u < 4 * L; u += NTHR) { const int b = u / L, t = u % L; vb[u] = sconv<L>(PT + (size_t)d * TA + tok0 + b * L, t, w0[0], w1[0], w2[0], cb[0]); }
    __syncthreads();
    constexpr int NBLK = 4 * L / 8, PER = (NBLK + NTHR - 1) / NTHR;
    float res[PER][8];
#pragma unroll 1
    for (int o = 0; o < 2; ++o) {
        const LAS float* ko = kk + o * 2 * L;
#pragma unroll
        for (int pi = 0; pi < PER; ++pi) {
            const int q = F.tid + pi * NTHR;
            float acc[8];
#pragma unroll
            for (int j = 0; j < 8; ++j) acc[j] = 0.f;
            if (q < NBLK) {
                const int b = q / (L / 8), t0 = (q % (L / 8)) * 8;
                const LAS float* vv = vb + b * L;
#pragma unroll 1
                for (int s8 = 0; s8 < L; s8 += 8) {
                    const LAS float* kw = ko + (t0 - s8 - 7 + L - 1);
                    float w[15], x[8];
#pragma unroll
                    for (int i = 0; i < 15; ++i) w[i] = kw[i];
#pragma unroll
                    for (int i = 0; i < 8; ++i) x[i] = vv[s8 + i];
#pragma unroll
                    for (int j = 0; j < 8; ++j)
#pragma unroll
                        for (int i = 0; i < 8; ++i) acc[j] += w[j - i + 7] * x[i];
                }
            }
#pragma unroll
            for (int j = 0; j < 8; ++j) res[pi][j] = acc[j];
        }
        __syncthreads();
#pragma unroll
        for (int pi = 0; pi < PER; ++pi) {
            const int q = F.tid + pi * NTHR;
            if (q < NBLK) {
                const int b = q / (L / 8), t0 = (q % (L / 8)) * 8;
                const bf16* pg = PT + (size_t)((o + 1) * 1024 + d) * TA + tok0 + b * L;
#pragma unroll
                for (int j = 0; j < 8; ++j) { const int t = t0 + j; const float vin = vb[b * L + t];
                    const float y = res[pi][j] * nrm[o] + vin * (o == 0 ? fb0 : fb1);
                    const float xg = sconv<L>(pg, t, w0[o + 1], w1[o + 1], w2[o + 1], cb[o + 1]);
                    res[pi][j] = xg * y; }
            }
        }
        __syncthreads();
        if (o == 0) {
#pragma unroll
            for (int pi = 0; pi < PER; ++pi) { const int q = F.tid + pi * NTHR;
                if (q < NBLK) { const int b = q / (L / 8), t0 = (q % (L / 8)) * 8;
#pragma unroll
                    for (int j = 0; j < 8; ++j) vb[b * L + t0 + j] = res[pi][j]; } }
            __syncthreads();
        } else {
#pragma unroll
            for (int pi = 0; pi < PER; ++pi) { const int q = F.tid + pi * NTHR;
                if (q < NBLK) { const int b = q / (L / 8), t0 = (q % (L / 8)) * 8;
                    v4u ov; ov.x = pk2(res[pi][0], res[pi][1]); ov.y = pk2(res[pi][2], res[pi][3]); ov.z = pk2(res[pi][4], res[pi][5]); ov.w = pk2(res[pi][6], res[pi][7]);
                    *(v4u*)(Z2T + (size_t)d * TA + tok0 + b * L + t0) = ov; } }
        }
    }
}
__device__ __forceinline__ void phase_hy_tr(ArgsP a, const Fr& F, int ntok) {
    LAS unsigned short* tile = (LAS unsigned short*)(F.lds + F.wave * 9216);
    const bf16* Z2T = (const bf16*)(a->ws + SC_Z2T); bf16* Z2 = (bf16*)(a->ws + SC_Z2);
    const int gw = F.vcu * NWAVES + F.wave, NGW = F.G * NWAVES, ntt = ntok / 64;
    for (int it = gw; it < 16 * ntt; it += NGW) {
        const int c0 = (it / ntt) * 64, t0 = (it % ntt) * 64;
#pragma unroll
        for (int i = 0; i < 8; ++i) { const int ch = i * 8 + (F.lane >> 3), ck = F.lane & 7;
            const v4u v = *(const v4u*)(Z2T + (size_t)(c0 + ch) * TA + t0 + ck * 8); *(LAS v4u*)(tile + ch * 72 + ck * 8) = v; }
        LDS_WAIT(); asm volatile("" ::: "memory");
        bf16* dst = Z2 + (size_t)(t0 + F.lane) * D + c0;
#pragma unroll
        for (int q = 0; q < 8; ++q) { unsigned w[4];
#pragma unroll
            for (int j = 0; j < 4; ++j) { const unsigned lo = tile[(q * 8 + 2 * j) * 72 + F.lane], hi = tile[(q * 8 + 2 * j + 1) * 72 + F.lane]; w[j] = lo | (hi << 16); }
            v4u o; o.x = w[0]; o.y = w[1]; o.z = w[2]; o.w = w[3]; *(v4u*)(dst + q * 8) = o; }
        LDS_WAIT(); asm volatile("" ::: "memory");
    }
}
__device__ __forceinline__ void phase_hy_conv_direct(ArgsP a, const Fr& F, int layer) {
    const int slot = layer == 0 ? 0 : 1; const int nitems = layer == 0 ? 2048 : 1024;
    for (int it = F.vcu; it < nitems; it += F.G) {
        if (it < 1024) hy_direct_item<SEQ>(a, F, slot, it, 0, (const float*)(a->ws + WS_HF + (size_t)slot * HF_SLOT));
        else hy_direct_item<LC>(a, F, slot, it - 1024, T, (const float*)(a->ws + WS_HF + HF_CTX));
    }
}

__device__ __forceinline__ void phase_lnr(ArgsP a, const Fr& F, int layer, int nrows) {
    LAS float* wr = (LAS float*)F.lds;
    __syncthreads();
    for (int u = F.tid; u < 1024 * 16; u += NTHR) wr[u] = a->in[I_ROUTER][(size_t)layer * 1024 * 16 + (u & 1023) * 16 + (u >> 10)];
    __syncthreads();
    const float* U = (const float*)(a->ws + WS_U); float* XL = (float*)(a->ws + WS_XL); bf16* HB = (bf16*)(a->ws + WS_HB); float* AFF = (float*)(a->ws + WS_AFF);
    const float* mod = (const float*)(a->ws + WS_MOD) + (size_t)layer * 5 * 6144;
    const float* lg = a->in[I_LNG] + (size_t)(layer * 2 + 0) * D; const float* lb = a->in[I_LNB] + (size_t)(layer * 2 + 0) * D;
    const int gw = F.vcu * NWAVES + F.wave, NGW = F.G * NWAVES;
    for (int row = gw; row < nrows; row += NGW) {
        const int r = row < T ? (row >> 12) : 4;
        const float* up = U + (size_t)row * D; f32x4 v[4]; float s = 0.f;
#pragma unroll
        for (int j = 0; j < 4; ++j) { v[j] = *(const f32x4*)(up + 4 * F.lane + 256 * j); s += (v[j][0] + v[j][1]) + (v[j][2] + v[j][3]); }
        const float mean = wave_sum(s) * (1.0f / D); float s2 = 0.f;
#pragma unroll
        for (int j = 0; j < 4; ++j) { v[j] = v[j] - mean; s2 += (v[j][0] * v[j][0] + v[j][1] * v[j][1]) + (v[j][2] * v[j][2] + v[j][3] * v[j][3]); }
        const float rstd = 1.0f / sqrtf(wave_sum(s2) * (1.0f / D) + LN_EPS);
        float part[16];
#pragma unroll
        for (int e = 0; e < 16; ++e) part[e] = 0.f;
#pragma unroll
        for (int j = 0; j < 4; ++j) { const int c = 4 * F.lane + 256 * j;
            const f32x4 x = v[j] * rstd * *(const f32x4*)(lg + c) + *(const f32x4*)(lb + c);
            *(f32x4*)(XL + (size_t)row * D + c) = x;
            const f32x4 h = x * (*(const f32x4*)(mod + r * 6144 + 4096 + c) + 1.0f) + *(const f32x4*)(mod + r * 6144 + 3072 + c);
            v2u o; o.x = pk2(h[0], h[1]); o.y = pk2(h[2], h[3]); *(v2u*)(HB + (size_t)row * D + c) = o;
#pragma unroll
            for (int e = 0; e < 16; ++e) { const f32x4 w = *(const LAS f32x4*)(wr + e * 1024 + c);
                part[e] += (h[0] * w[0] + h[1] * w[1]) + (h[2] * w[2] + h[3] * w[3]); }
            asm volatile("" ::: "memory"); }
        float mx = -3.0e38f;
#pragma unroll
        for (int e = 0; e < 16; ++e) { part[e] = wave_sum(part[e]); mx = fmaxf(mx, part[e]); }
        float den = 0.f;
#pragma unroll
        for (int e = 0; e < 16; ++e) { part[e] = expf(part[e] - mx); den += part[e]; }
        float mine = 0.f;
#pragma unroll
        for (int e = 0; e < 16; ++e) mine = (F.lane == e) ? part[e] / den : mine;
        if (F.lane < 16) AFF[(size_t)row * 16 + F.lane] = mine;
    }
}

template <int N, int CAPN>
__device__ __forceinline__ void topk_item(ArgsP a, const Fr& F, int b, int e, int rowbase, int slotbase, bool pad) {
    LAS unsigned* hist = (LAS unsigned*)F.lds;
    LAS unsigned* sel = hist + 256;
    LAS unsigned* wtot = hist + 264;
    const float* AFF = (const float*)(a->ws + WS_AFF); int* ROWS = (int*)(a->ws + WS_ROWS); float* GATE = (float*)(a->ws + WS_GATE); int* INV = (int*)(a->ws + WS_INV);
    const int tid = F.tid, lane = F.lane; const bool act = tid * 8 < N;
    unsigned key[8];
#pragma unroll
    for (int j = 0; j < 8; ++j) key[j] = act ? __float_as_uint(AFF[(size_t)(rowbase + tid * 8 + j) * 16 + e]) : 0u;
    unsigned prefix = 0u, need = CAPN;
#pragma unroll 1
    for (int pass = 0; pass < 4; ++pass) {
        const int shift = 24 - 8 * pass; const unsigned himask = pass == 0 ? 0u : (0xFFFFFFFFu << (shift + 8));
        __syncthreads();
        if (tid < 256) hist[tid] = 0u;
        __syncthreads();
        if (act) {
#pragma unroll
            for (int j = 0; j < 8; ++j) if ((key[j] & himask) == prefix) __hip_atomic_fetch_add(&hist[(key[j] >> shift) & 255u], 1u, __ATOMIC_RELAXED, __HIP_MEMORY_SCOPE_WORKGROUP);
        }
        __syncthreads();
        if (tid < 64) {
            const unsigned v0 = hist[4 * lane], v1 = hist[4 * lane + 1], v2 = hist[4 * lane + 2], v3 = hist[4 * lane + 3]; const unsigned tot = v0 + v1 + v2 + v3;
            unsigned x = tot;
#pragma unroll
            for (int o = 1; o < 64; o <<= 1) { const unsigned t = __shfl_down(x, o); if (lane + o < 64) x += t; }
            const unsigned a3 = x - tot, a2 = a3 + v3, a1 = a2 + v2, a0 = a1 + v1;
            if (a3 < need && need <= a3 + v3) { sel[0] = 4 * lane + 3; sel[1] = a3; }
            if (a2 < need && need <= a2 + v2) { sel[0] = 4 * lane + 2; sel[1] = a2; }
            if (a1 < need && need <= a1 + v1) { sel[0] = 4 * lane + 1; sel[1] = a1; }
            if (a0 < need && need <= a0 + v0) { sel[0] = 4 * lane + 0; sel[1] = a0; }
        }
        __syncthreads();
        prefix |= sel[0] << shift; need -= sel[1];
    }
    const unsigned tau = prefix;
    unsigned ceq = 0u;
#pragma unroll
    for (int j = 0; j < 8; ++j) ceq += (act && key[j] == tau) ? 1u : 0u;
    unsigned xe = ceq;
#pragma unroll
    for (int o = 1; o < 64; o <<= 1) { const unsigned t = __shfl_up(xe, o); if (lane >= o) xe += t; }
    __syncthreads();
    if (lane == 63) wtot[F.wave * 2] = xe;
    __syncthreads();
    unsigned eqbase = xe - ceq; for (int w = 0; w < F.wave; ++w) eqbase += wtot[w * 2];
    unsigned flags = 0u, csel = 0u;
#pragma unroll
    for (int j = 0; j < 8; ++j) { bool s = false; if (act) { if (key[j] > tau) s = true; else if (key[j] == tau) { s = eqbase < need; ++eqbase; } } if (s) { flags |= 1u << j; ++csel; } }
    unsigned xs = csel;
#pragma unroll
    for (int o = 1; o < 64; o <<= 1) { const unsigned t = __shfl_up(xs, o); if (lane >= o) xs += t; }
    if (lane == 63) wtot[F.wave * 2 + 1] = xs;
    __syncthreads();
    unsigned pos = xs - csel; for (int w = 0; w < F.wave; ++w) pos += wtot[w * 2 + 1];
    if (act) {
#pragma unroll
        for (int j = 0; j < 8; ++j) { const int row = rowbase + tid * 8 + j; int slot = -1;
            if (flags & (1u << j)) { slot = e * ESTR + slotbase + (int)pos; ++pos; ROWS[slot] = row; GATE[slot] = __uint_as_float(key[j]); }
            INV[(size_t)row * 16 + e] = slot; }
    }
    if (pad) for (int p = tid; p < 128; p += NTHR) { ROWS[e * ESTR + 2176 + p] = 0; GATE[e * ESTR + 2176 + p] = 0.f; }
}
__device__ __forceinline__ void phase_topk(ArgsP a, const Fr& F, int layer) {
    const int nitems = layer == 0 ? 128 : 64;
    for (int it = F.vcu; it < nitems; it += F.G) {
        if (it < 64) { const int b = it >> 4, e = it & 15; topk_item<SEQ, 512>(a, F, b, e, b * SEQ, b * 512, false); }
        else { const int b = (it - 64) >> 4, e = it & 15; topk_item<LC, 32>(a, F, b, e, T + b * LC, 2048 + b * 32, b == 0); }
    }
}
__device__ __forceinline__ void phase_gather(ArgsP a, const Fr& F, int layer) {
    const int me = layer == 0 ? 2304 : 2048;
    const int* ROWS = (const int*)(a->ws + WS_ROWS); const bf16* HB = (const bf16*)(a->ws + WS_HB); bf16* XG = (bf16*)(a->ws + WS_XG);
    const int gw = F.vcu * NWAVES + F.wave, NGW = F.G * NWAVES;
    for (int it = gw; it < 16 * me; it += NGW) { const int e = it / me, s = it % me, dr = e * ESTR + s; const int sr = ROWS[dr];
        const v4u* src = (const v4u*)(HB + (size_t)sr * D); v4u* dst = (v4u*)(XG + (size_t)dr * D);
        dst[F.lane] = src[F.lane]; dst[64 + F.lane] = src[64 + F.lane]; }
}
__device__ __forceinline__ void phase_comb(ArgsP a, const Fr& F, int layer, int nrows) {
    const bf16* Y = (const bf16*)(a->ws + WS_Y); const float* XL = (const float*)(a->ws + WS_XL); float* XC = (float*)(a->ws + WS_XC); bf16* HB = (bf16*)(a->ws + WS_HB); const int* INV = (const int*)(a->ws + WS_INV);
    const float* mod = (const float*)(a->ws + WS_MOD) + (size_t)layer * 5 * 6144;
    const float* modn = (const float*)(a->ws + WS_MOD) + (size_t)(layer < 3 ? layer + 1 : 3) * 5 * 6144;
    const float* lg = a->in[I_LNG] + (size_t)(layer * 2 + 1) * D; const float* lb = a->in[I_LNB] + (size_t)(layer * 2 + 1) * D;
    const int gw = F.vcu * NWAVES + F.wave, NGW = F.G * NWAVES;
    for (int row = gw; row < nrows; row += NGW) {
        const int r = row < T ? (row >> 12) : 4;
        const int myinv = INV[(size_t)row * 16 + (F.lane & 15)];
        f32x4 m[4];
#pragma unroll
        for (int j = 0; j < 4; ++j) m[j] = (f32x4){0.f, 0.f, 0.f, 0.f};
        unsigned msk = (unsigned)(__ballot(myinv >= 0) & 0xFFFFull);
        while (msk) {
            int sl[4];
#pragma unroll
            for (int q = 0; q < 4; ++q) { if (msk) { const int e = __builtin_ctz(msk); msk &= msk - 1; sl[q] = __shfl(myinv, e); } else sl[q] = -1; }
            v2u yv[4][4];
#pragma unroll
            for (int q = 0; q < 4; ++q) if (sl[q] >= 0) { const bf16* yp = Y + (size_t)sl[q] * D;
#pragma unroll
                for (int j = 0; j < 4; ++j) yv[q][j] = *(const v2u*)(yp + 4 * F.lane + 256 * j); }
#pragma unroll
            for (int q = 0; q < 4; ++q) if (sl[q] >= 0) {
#pragma unroll
                for (int j = 0; j < 4; ++j) { const v2u w = yv[q][j];
                    m[j] += (f32x4){__builtin_bit_cast(float, w.x << 16), __builtin_bit_cast(float, w.x & 0xffff0000u), __builtin_bit_cast(float, w.y << 16), __builtin_bit_cast(float, w.y & 0xffff0000u)}; } }
        }
        f32x4 v[4]; float s = 0.f;
#pragma unroll
        for (int j = 0; j < 4; ++j) { const int c = 4 * F.lane + 256 * j;
            v[j] = *(const f32x4*)(XL + (size_t)row * D + c) * ALPHA + *(const f32x4*)(mod + r * 6144 + 5120 + c) * m[j]; s += (v[j][0] + v[j][1]) + (v[j][2] + v[j][3]); }
        const float mean = wave_sum(s) * (1.0f / D); float s2 = 0.f;
#pragma unroll
        for (int j = 0; j < 4; ++j) { v[j] = v[j] - mean; s2 += (v[j][0] * v[j][0] + v[j][1] * v[j][1]) + (v[j][2] * v[j][2] + v[j][3] * v[j][3]); }
        const float rstd = 1.0f / sqrtf(wave_sum(s2) * (1.0f / D) + LN_EPS);
#pragma unroll
        for (int j = 0; j < 4; ++j) { const int c = 4 * F.lane + 256 * j;
            const f32x4 x = v[j] * rstd * *(const f32x4*)(lg + c) + *(const f32x4*)(lb + c);
            if (layer == 3) { *(f32x4*)(a->out + (size_t)row * D + c) = x; }
            else { *(f32x4*)(XC + (size_t)row * D + c) = x;
                const f32x4 h = x * (*(const f32x4*)(modn + r * 6144 + 1024 + c) + 1.0f) + *(const f32x4*)(modn + r * 6144 + c);
                v2u o; o.x = pk2(h[0], h[1]); o.y = pk2(h[2], h[3]); *(v2u*)(HB + (size_t)row * D + c) = o; } }
    }
}
#ifndef FFT_HD
#define FFT_HD __device__ __forceinline__
#endif
typedef float cf2 __attribute__((ext_vector_type(2)));
FFT_HD cf2 cmul(cf2 a, cf2 b) { return (cf2){a.x * b.x - a.y * b.y, a.x * b.y + a.y * b.x}; }
FFT_HD int fpad(int p) { return p + (p >> 5); }
constexpr int FFT_N = 8192, FFT_BUF = 8192 + 256;
template <bool INV> FFT_HD void dft4(cf2& a, cf2& b, cf2& c, cf2& d) {
    const cf2 s0 = a + c, s1 = a - c, s2 = b + d, s3 = b - d;
    const cf2 js3 = INV ? (cf2){-s3.y, s3.x} : (cf2){s3.y, -s3.x};
    a = s0 + s2; b = s1 + js3; c = s0 - s2; d = s1 - js3;
}
template <bool INV> FFT_HD void dft16(cf2 (&x)[16]) {
#pragma unroll
    for (int n0 = 0; n0 < 4; ++n0) dft4<INV>(x[n0], x[n0 + 4], x[n0 + 8], x[n0 + 12]);
    constexpr float C1 = 0.92387953251128674f, S1 = 0.38268343236508977f, R2 = 0.70710678118654752f;
    const float sg = INV ? 1.f : -1.f;
    const cf2 w1 = {C1, sg * S1}, w2 = {R2, sg * R2}, w3 = {S1, sg * C1}, w4 = {0.f, sg * 1.f}, w6 = {-R2, sg * R2}, w9 = {-C1, -sg * S1};
    x[1 + 4 * 1] = cmul(x[1 + 4 * 1], w1); x[1 + 4 * 2] = cmul(x[1 + 4 * 2], w2); x[1 + 4 * 3] = cmul(x[1 + 4 * 3], w3);
    x[2 + 4 * 1] = cmul(x[2 + 4 * 1], w2); x[2 + 4 * 2] = cmul(x[2 + 4 * 2], w4); x[2 + 4 * 3] = cmul(x[2 + 4 * 3], w6);
    x[3 + 4 * 1] = cmul(x[3 + 4 * 1], w3); x[3 + 4 * 2] = cmul(x[3 + 4 * 2], w6); x[3 + 4 * 3] = cmul(x[3 + 4 * 3], w9);
#pragma unroll
    for (int k0 = 0; k0 < 4; ++k0) dft4<INV>(x[0 + 4 * k0], x[1 + 4 * k0], x[2 + 4 * k0], x[3 + 4 * k0]);
#pragma unroll
    for (int i = 0; i < 4; ++i)
#pragma unroll
        for (int j = i + 1; j < 4; ++j) { const cf2 t = x[i + 4 * j]; x[i + 4 * j] = x[j + 4 * i]; x[j + 4 * i] = t; }
}
FFT_HD cf2 cmulc(cf2 a, cf2 b) { return (cf2){a.x * b.x + a.y * b.y, a.y * b.x - a.x * b.y}; }
template <bool INV, class BP> FFT_HD void stage_r16(BP buf, const cf2 (&tw)[15], int base, int stride) {
    cf2 x[16];
#pragma unroll
    for (int i = 0; i < 16; ++i) x[i] = buf[fpad(base + i * stride)];
    if (!INV) { dft16<false>(x);
#pragma unroll
        for (int k = 1; k < 16; ++k) x[k] = cmulc(x[k], tw[k - 1]); }
    else {
#pragma unroll
        for (int k = 1; k < 16; ++k) x[k] = cmul(x[k], tw[k - 1]);
        dft16<true>(x); }
#pragma unroll
    for (int i = 0; i < 16; ++i) buf[fpad(base + i * stride)] = x[i];
}
template <class TP> FFT_HD void load_tw(TP TW, int tidx, cf2 (&tw)[15]) {
#ifndef FFT_HOST_ONLY
    asm volatile("" : "+v"(tidx));
#endif
#pragma unroll
    for (int k = 1; k < 16; ++k) tw[k - 1] = TW[(tidx * k) & (FFT_N - 1)];
}
template <bool INV, class BP> FFT_HD void stage_r32_load(BP buf, int blk, int r, cf2 (&u)[16]) {
    constexpr float CS[16] = {1.f, 0.98078528040323043f, 0.92387953251128674f, 0.83146961230254524f, 0.70710678118654752f, 0.55557023301960218f, 0.38268343236508977f, 0.19509032201612825f,
                              0.f, -0.19509032201612825f, -0.38268343236508977f, -0.55557023301960218f, -0.70710678118654752f, -0.83146961230254524f, -0.92387953251128674f, -0.98078528040323043f};
    constexpr float SN[16] = {0.f, 0.19509032201612825f, 0.38268343236508977f, 0.55557023301960218f, 0.70710678118654752f, 0.83146961230254524f, 0.92387953251128674f, 0.98078528040323043f,
                              1.f, 0.98078528040323043f, 0.92387953251128674f, 0.83146961230254524f, 0.70710678118654752f, 0.55557023301960218f, 0.38268343236508977f, 0.19509032201612825f};
    const int base = blk * 33;
#pragma unroll
    for (int n = 0; n < 16; ++n) { const cf2 lo = buf[base + n], hi = buf[base + n + 16];
        const cf2 s = lo + hi, d = lo - hi; const cf2 w = {CS[n], INV ? SN[n] : -SN[n]}; const cf2 dw = cmul(d, w);
        u[n] = r ? dw : s; }
    dft16<INV>(u);
}
template <class BP> FFT_HD void stage_r32_store(BP buf, int blk, int r, const cf2 (&u)[16]) {
    const int base = blk * 33;
#pragma unroll
    for (int g = 0; g < 16; ++g) buf[base + 2 * g + r] = u[g];
}
template <class BP> FFT_HD void fft_mul(BP Z, BP W, int tid, int o, float scale) {
    const int f2 = tid >> 5, f3 = tid & 31;
#pragma unroll 4
    for (int j = 0; j < 16; ++j) { const int p = tid + 512 * j; const int f = j + 16 * f2 + 256 * f3; const int fm = (FFT_N - f) & (FFT_N - 1);
        const int pm = (fm & 15) * 512 + ((fm >> 4) & 15) * 32 + (fm >> 8);
        const cf2 a = W[fpad(p)], b = W[fpad(pm)];
        const cf2 k = o == 0 ? (cf2){0.5f * (a.x + b.x), 0.5f * (a.y - b.y)} : (cf2){0.5f * (a.y + b.y), 0.5f * (b.x - a.x)};
        const cf2 z = Z[fpad(p)]; Z[fpad(p)] = cmul(z, k) * scale; }
}
#ifndef FFT_HOST_ONLY
__device__ __forceinline__ void fft_fwd(LAS cf2* buf, const cf2* TW, int tid) {
    { cf2 tw[15]; load_tw(TW, tid, tw); stage_r16<false>(buf, tw, tid, 512); } __syncthreads();
    { cf2 tw[15]; load_tw(TW, 16 * (tid & 31), tw); stage_r16<false>(buf, tw, (tid >> 5) * 512 + (tid & 31), 32); } __syncthreads();
    { cf2 u[16]; stage_r32_load<false>(buf, tid >> 1, tid & 1, u); stage_r32_store(buf, tid >> 1, tid & 1, u); } __syncthreads();
}
__device__ __forceinline__ void fft_inv(LAS cf2* buf, const cf2* TW, int tid) {
    { cf2 u[16]; stage_r32_load<true>(buf, tid >> 1, tid & 1, u); stage_r32_store(buf, tid >> 1, tid & 1, u); } __syncthreads();
    { cf2 tw[15]; load_tw(TW, 16 * (tid & 31), tw); stage_r16<true>(buf, tw, (tid >> 5) * 512 + (tid & 31), 32); } __syncthreads();
    { cf2 tw[15]; load_tw(TW, tid, tw); stage_r16<true>(buf, tw, tid, 512); } __syncthreads();
}
struct Raw8 { v4u mid; unsigned lo, hi; };
__device__ __forceinline__ Raw8 raw8_load(const bf16* p, int t0) { Raw8 r; r.mid = *(const v4u*)(p + t0); r.lo = t0 > 0 ? (unsigned)p[t0 - 1] : 0u; r.hi = t0 + 8 < SEQ ? (unsigned)p[t0 + 8] : 0u; return r; }
__device__ __forceinline__ void raw8_conv(const Raw8& r, float w0, float w1, float w2, float cb, float (&o)[8]) {
    float x[10]; x[0] = bf2f((unsigned short)r.lo); x[9] = bf2f((unsigned short)r.hi);
    const unsigned w[4] = {r.mid.x, r.mid.y, r.mid.z, r.mid.w};
#pragma unroll
    for (int j = 0; j < 4; ++j) { x[1 + 2 * j] = __builtin_bit_cast(float, w[j] << 16); x[2 + 2 * j] = __builtin_bit_cast(float, w[j] & 0xffff0000u); }
#pragma unroll
    for (int j = 0; j < 8; ++j) o[j] = w0 * x[j] + w1 * x[j + 1] + w2 * x[j + 2] + cb;
}
__device__ __forceinline__ void hy_fft_item(ArgsP a, const Fr& F, int slot, int d) {
    LAS cf2* Zb = (LAS cf2*)F.lds;
    LAS cf2* Wb = Zb + FFT_BUF;
    LAS float* red = (LAS float*)(Wb + FFT_BUF);
    const bf16* PT = (const bf16*)(a->ws + SC_PT); bf16* Z2T = (bf16*)(a->ws + SC_Z2T); const cf2* TW = (const cf2*)(a->ws + WS_TW);
    const float* HF = (const float*)(a->ws + WS_HF + (size_t)slot * HF_SLOT);
    const int tid = F.tid, t0 = 8 * tid;
    const int zb0 = t0 + (tid >> 2);
    __syncthreads();
    { const float* f0 = HF + (size_t)(0 * 1024 + d) * SEQ; const float* b0 = HF + (size_t)(1 * 1024 + d) * SEQ;
      const float* f1 = HF + (size_t)(2 * 1024 + d) * SEQ; const float* b1 = HF + (size_t)(3 * 1024 + d) * SEQ;
      float s0 = 0.f, s1 = 0.f;
      for (int t = tid; t < SEQ; t += NTHR) { const float a0 = f0[t], a1 = f1[t]; Wb[fpad(t)] = (cf2){a0, a1}; s0 += fabsf(a0); s1 += fabsf(a1);
          if (t >= 1) { const float c0 = b0[t], c1 = b1[t]; Wb[fpad(FFT_N - t)] = (cf2){c0, c1}; s0 += fabsf(c0); s1 += fabsf(c1); } }
      if (tid == 0) Wb[fpad(SEQ)] = (cf2){0.f, 0.f};
      s0 = wave_sum(s0); s1 = wave_sum(s1); if (F.lane == 0) { red[F.wave] = s0; red[8 + F.wave] = s1; } }
    __syncthreads();
    float nrm0, nrm1; { float s0 = 0.f, s1 = 0.f; for (int w = 0; w < 8; ++w) { s0 += red[w]; s1 += red[8 + w]; } nrm0 = 1.0f / (s0 + 1e-6f); nrm1 = 1.0f / (s1 + 1e-6f); }
    fft_fwd(Wb, TW, tid);
    const float* cw = a->in[I_HYCW] + (size_t)slot * 3 * 3072; const float* cbp = a->in[I_HYCB] + (size_t)slot * 3072;
    float w0[3], w1[3], w2[3], cb[3];
#pragma unroll
    for (int g = 0; g < 3; ++g) { const int c = g * 1024 + d; w0[g] = cw[c]; w1[g] = cw[3072 + c]; w2[g] = cw[2 * 3072 + c]; cb[g] = cbp[c]; }
    const float fb0 = a->in[I_FBIAS][(slot * 2 + 0) * 1024 + d], fb1 = a->in[I_FBIAS][(slot * 2 + 1) * 1024 + d];
    const float sc0 = nrm0 * (1.0f / FFT_N), sc1 = nrm1 * (1.0f / FFT_N);
#pragma unroll 1
    for (int pr = 0; pr < 2; ++pr) {
        const bf16* pb = PT + (size_t)d * TA + (2 * pr) * SEQ;
        const Raw8 rv0 = raw8_load(pb, t0), rv1 = raw8_load(pb + SEQ, t0);
        float va[8], vb2[8];
        raw8_conv(rv0, w0[0], w1[0], w2[0], cb[0], va); raw8_conv(rv1, w0[0], w1[0], w2[0], cb[0], vb2);
        cf2 vin[8];
#pragma unroll
        for (int j = 0; j < 8; ++j) { vin[j] = (cf2){va[j], vb2[j]}; Zb[zb0 + j] = vin[j]; Zb[zb0 + j + SEQ + 128] = (cf2){0.f, 0.f}; }
        __syncthreads();
        fft_fwd(Zb, TW, tid); fft_mul(Zb, Wb, tid, 0, sc0); __syncthreads(); fft_inv(Zb, TW, tid);
        { const Raw8 rx0 = raw8_load(pb + (size_t)1024 * TA, t0), rx1 = raw8_load(pb + (size_t)1024 * TA + SEQ, t0);
          raw8_conv(rx0, w0[1], w1[1], w2[1], cb[1], va); raw8_conv(rx1, w0[1], w1[1], w2[1], cb[1], vb2); }
#pragma unroll
        for (int j = 0; j < 8; ++j) { const cf2 y = Zb[zb0 + j]; const cf2 xg = {va[j], vb2[j]}; vin[j] = xg * (y + vin[j] * fb0); }
        __syncthreads();
#pragma unroll
        for (int j = 0; j < 8; ++j) { Zb[zb0 + j] = vin[j]; Zb[zb0 + j + SEQ + 128] = (cf2){0.f, 0.f}; }
        __syncthreads();
        fft_fwd(Zb, TW, tid); fft_mul(Zb, Wb, tid, 1, sc1); __syncthreads(); fft_inv(Zb, TW, tid);
        { const Raw8 rz0 = raw8_load(pb + (size_t)2048 * TA, t0), rz1 = raw8_load(pb + (size_t)2048 * TA + SEQ, t0);
          raw8_conv(rz0, w0[2], w1[2], w2[2], cb[2], va); raw8_conv(rz1, w0[2], w1[2], w2[2], cb[2], vb2); }
        float z0[8], z1[8];
#pragma unroll
        for (int j = 0; j < 8; ++j) { const cf2 y = Zb[zb0 + j]; const cf2 xg = {va[j], vb2[j]}; const cf2 z = xg * (y + vin[j] * fb1); z0[j] = z.x; z1[j] = z.y; }
        bf16* o0 = Z2T + (size_t)d * TA + (2 * pr) * SEQ + t0;
        v4u q0, q1; q0.x = pk2(z0[0], z0[1]); q0.y = pk2(z0[2], z0[3]); q0.z = pk2(z0[4], z0[5]); q0.w = pk2(z0[6], z0[7]);
        q1.x = pk2(z1[0], z1[1]); q1.y = pk2(z1[2], z1[3]); q1.z = pk2(z1[4], z1[5]); q1.w = pk2(z1[6], z1[7]);
        *(v4u*)o0 = q0; *(v4u*)(o0 + SEQ) = q1;
        __syncthreads();
    }
}
__device__ __forceinline__ void phase_hy_conv_fft(ArgsP a, const Fr& F, int layer) {
    const int slot = layer == 0 ? 0 : 1; const int nitems = layer == 0 ? 2048 : 1024;
    for (int it = F.vcu; it < 1024; it += F.G) hy_fft_item(a, F, slot, it);
    for (int it = 1024 + F.vcu; it < nitems; it += F.G) hy_direct_item<LC>(a, F, slot, it - 1024, T, (const float*)(a->ws + WS_HF + HF_CTX));
}
#endif
#include <hip/hip_bf16.h>
namespace attn_body {
using bf16=__hip_bfloat16;
using bf16x8=__attribute__((ext_vector_type(8)))short;
using s16x4=__attribute__((ext_vector_type(4)))short;
using f32x16=__attribute__((ext_vector_type(16)))float;
using u32x4=__attribute__((ext_vector_type(4)))unsigned;
constexpr int BATCH=4,NHEAD=16,SEQ=4096,D=64,DM=NHEAD*D,KP=256,LKEYS=4352;
constexpr int NW=8,QBLK=32,QB=QBLK*NW,KVBLK=64,NQB=SEQ/QB;
constexpr int ATTN_PITCH=DM, ATTN_UNIT_ROWS=QB;
__device__ __forceinline__ int crow(int r,int hi){return (r&3)+8*(r>>2)+4*hi;}
#define SBAR() __builtin_amdgcn_sched_barrier(0)
__device__ __forceinline__ void cmask(f32x16&p0,f32x16&p1,int jb,int qrel,int hi){
  const float NEG=-INFINITY; int kb=64*jb+4*hi;
  #pragma unroll
  for(int r=0;r<16;++r){int kv=kb+(r&3)+8*(r>>2); if(kv>qrel)p0[r]=NEG; if(kv+32>qrel)p1[r]=NEG;}
}

constexpr int NSLOT=3, SLOTB=8192;
constexpr int LDS_K=0, LDS_V=NSLOT*SLOTB, LDS_WS=2*NSLOT*SLOTB, LDS_OST=LDS_WS+NW*64*4, LDS_BYTES=LDS_OST+NW*4096;
constexpr float C2=0.125f*1.4426950408889634f;
__device__ __forceinline__ void glds16(const void*gsrc,unsigned lds_dst){unsigned keep;
  asm volatile("s_mov_b32 %0, m0\n\ts_mov_b32 m0, %2\n\ts_nop 0\n\tglobal_load_lds_dwordx4 %1, off\n\ts_mov_b32 m0, %0":"=&s"(keep):"v"(gsrc),"s"(lds_dst):"memory");}
__device__ __forceinline__ float max3f(float a,float b,float c){float r;asm("v_max3_f32 %0, %1, %2, %3":"=v"(r):"v"(a),"v"(b),"v"(c));return r;}
__device__ __forceinline__ float max2f(float a,float b){float r;asm("v_max_f32_e32 %0, %1, %2":"=v"(r):"v"(a),"v"(b));return r;}
__device__ __forceinline__ float fadd_s(float a,float b){float r;asm("v_add_f32_e32 %0, %1, %2":"=v"(r):"v"(a),"v"(b));return r;}
__device__ __forceinline__ float fsub_s(float a,float b){float r;asm("v_sub_f32_e32 %0, %1, %2":"=v"(r):"v"(a),"v"(b));return r;}
typedef float f32x2_t __attribute__((ext_vector_type(2))); typedef __bf16 bf16x2_t __attribute__((ext_vector_type(2)));
__device__ __forceinline__ unsigned cvtpk_s(float lo,float hi){f32x2_t v={lo,hi};bf16x2_t b=__builtin_convertvector(v,bf16x2_t);return __builtin_bit_cast(unsigned,b);}
#define WAIT_BAR(N) asm volatile("s_waitcnt vmcnt(" #N ") lgkmcnt(0)\n\ts_barrier":::"memory")

__device__ __forceinline__ void qkt(f32x16&p0,f32x16&p1,const char*Kslot,const bf16x8*qr,const f32x16&negm,int r32,int hi){
  const char*kb=Kslot+hi*1024+r32*16;
  #pragma unroll
  for(int d0=0;d0<4;++d0){
    const bf16x8 b0=*reinterpret_cast<const bf16x8*>(kb+d0*2048);
    const bf16x8 b1=*reinterpret_cast<const bf16x8*>(kb+d0*2048+512);
    if(d0==0){p0=__builtin_amdgcn_mfma_f32_32x32x16_bf16(b0,qr[0],negm,0,0,0);p1=__builtin_amdgcn_mfma_f32_32x32x16_bf16(b1,qr[0],negm,0,0,0);}
    else{p0=__builtin_amdgcn_mfma_f32_32x32x16_bf16(b0,qr[d0],p0,0,0,0);p1=__builtin_amdgcn_mfma_f32_32x32x16_bf16(b1,qr[d0],p1,0,0,0);}}
}
typedef __attribute__((address_space(3))) const char* lds_cptr;
typedef short v4i16_t __attribute__((ext_vector_type(4)));
__device__ __forceinline__ void kload8(bf16x8*kf,lds_cptr kp){
  kf[0]=*(const __attribute__((address_space(3))) bf16x8*)(kp);      kf[1]=*(const __attribute__((address_space(3))) bf16x8*)(kp+512);
  kf[2]=*(const __attribute__((address_space(3))) bf16x8*)(kp+2048); kf[3]=*(const __attribute__((address_space(3))) bf16x8*)(kp+2560);
  kf[4]=*(const __attribute__((address_space(3))) bf16x8*)(kp+4096); kf[5]=*(const __attribute__((address_space(3))) bf16x8*)(kp+4608);
  kf[6]=*(const __attribute__((address_space(3))) bf16x8*)(kp+6144); kf[7]=*(const __attribute__((address_space(3))) bf16x8*)(kp+6656);
}
__device__ __forceinline__ void kload2(bf16x8*kf,lds_cptr kp,int j){ kf[2*j]=*(const __attribute__((address_space(3))) bf16x8*)(kp+j*2048); kf[2*j+1]=*(const __attribute__((address_space(3))) bf16x8*)(kp+j*2048+512); }
__device__ __forceinline__ s16x4 vtr(lds_cptr p){ return __builtin_bit_cast(s16x4,__builtin_amdgcn_ds_read_tr16_b64_v4i16((__attribute__((address_space(3))) v4i16_t*)p)); }
__device__ __forceinline__ float rowmax(const f32x16&p0,const f32x16&p1){
  float a=max3f(p0[0],p0[1],p1[0]),b=max3f(p0[2],p0[3],p1[1]);a=max3f(a,p1[2],p1[3]);
  #pragma unroll
  for(int r=4;r<16;r+=4){a=max3f(a,p0[r],p0[r+1]);b=max3f(b,p0[r+2],p0[r+3]);a=max3f(a,p1[r],p1[r+1]);b=max3f(b,p1[r+2],p1[r+3]);}
  const float m=max2f(a,b);
  auto rr=__builtin_amdgcn_permlane32_swap(__float_as_uint(m),__float_as_uint(m),false,false);
  return max2f(__uint_as_float(rr[0]),__uint_as_float(rr[1]));
}
__device__ __forceinline__ void pv(f32x16*o,int vb,bf16x8 pa0,bf16x8 pa1,bf16x8 pa2,bf16x8 pa3){
  #pragma unroll
  for(int d0=0;d0<2;++d0){s16x4 lo[4],hi[4];
    #pragma unroll
    for(int ks=0;ks<4;++ks){
      asm volatile("ds_read_b64_tr_b16 %0,%1 offset:%c2":"=&v"(lo[ks]):"v"(vb),"i"(d0*4096+ks*1024):"memory");
      asm volatile("ds_read_b64_tr_b16 %0,%1 offset:%c2":"=&v"(hi[ks]):"v"(vb),"i"(d0*4096+ks*1024+512):"memory");}
    asm volatile("s_waitcnt lgkmcnt(0)":::"memory");SBAR();
    #define PK(k) (bf16x8){lo[k][0],lo[k][1],lo[k][2],lo[k][3],hi[k][0],hi[k][1],hi[k][2],hi[k][3]}
    o[d0]=__builtin_amdgcn_mfma_f32_32x32x16_bf16(pa0,PK(0),o[d0],0,0,0);
    o[d0]=__builtin_amdgcn_mfma_f32_32x32x16_bf16(pa1,PK(1),o[d0],0,0,0);
    o[d0]=__builtin_amdgcn_mfma_f32_32x32x16_bf16(pa2,PK(2),o[d0],0,0,0);
    o[d0]=__builtin_amdgcn_mfma_f32_32x32x16_bf16(pa3,PK(3),o[d0],0,0,0);
    #undef PK
  }
}

#ifndef ATTN_STORE16
#define ATTN_STORE16(p,v) (*(u32x4*)(p)=(v))
#endif
template<int THRL> __device__ __forceinline__ void attn_unit(int b,int h,int qb,const bf16*Q,const bf16*__restrict__ K,const bf16*__restrict__ V,bf16*O,char*shm){
  int tid_=threadIdx.x; asm volatile("":"+v"(tid_)); const int tid=tid_,lane=tid&63,r32=lane&31,hi=lane>>5; const int wid=__builtin_amdgcn_readfirstlane(tid>>6);
  const long rowbase=(long)b*SEQ; const int q0=qb*QB;
  const bf16*Qw=Q+(rowbase+q0+wid*QBLK)*DM+h*D;
  const bf16*Kh=K+(long)b*LKEYS*KP+(h>>2)*D,*Vh=V+(long)b*LKEYS*KP+(h>>2)*D;
  const unsigned lds0=(unsigned)(uintptr_t)shm;
  float*wsf=(float*)(shm+LDS_WS)+wid*64;
  const bf16*ksrc=Kh+(long)lane*KP+wid*8;
  const bf16*vsrc=Vh+(long)(16*(wid&3)+(lane>>2))*KP+(wid>>2)*32+(lane&3)*8;
  const unsigned kdst=lds0+LDS_K+wid*1024, vdst=lds0+LDS_V+wid*1024;
  #define DMA_K(t,slot) glds16(ksrc+(long)(t)*KVBLK*KP,(unsigned)__builtin_amdgcn_readfirstlane(kdst+(slot)))
  #define DMA_V(t,slot) glds16(vsrc+(long)(t)*KVBLK*KP,(unsigned)__builtin_amdgcn_readfirstlane(vdst+(slot)))
  const int vb0=(int)(lds0+LDS_V)+((lane>>4)&1)*32+(lane&3)*8+(4*hi+((lane&15)>>2))*64;
  const char*Kbase=shm+LDS_K; bf16x8 kf[8];
  const lds_cptr shm3=(lds_cptr)shm; const lds_cptr kp0=shm3+LDS_K+hi*1024+r32*16; const lds_cptr vp0=shm3+LDS_V+((lane>>4)&1)*32+(lane&3)*8+(4*hi+((lane&15)>>2))*64;
  const int NT=LKEYS/KVBLK;
  DMA_K(0,0);DMA_V(0,0);DMA_K(1,SLOTB);
  bf16x8 qr[4];
  #pragma unroll
  for(int d0=0;d0<4;++d0)qr[d0]=*reinterpret_cast<const bf16x8*>(&Qw[(long)r32*DM+d0*16+hi*8]);
  float mhat=0.f,l_reg=0.f;f32x16 o[2];o[0]=f32x16{};o[1]=f32x16{};f32x16 negm=f32x16{};asm volatile("":"+v"(negm));

  #define CMASK(P0,P1,t) do{}while(0)
  bool resc=false;
  #define START(P0,P1) do{ const float rm=rowmax(P0,P1); resc=false; \
    { const float dl=rm; mhat=fadd_s(mhat,dl); \
      _Pragma("unroll") for(int r=0;r<16;++r){P0[r]=fsub_s(P0[r],dl);P1[r]=fsub_s(P1[r],dl);} \
      _Pragma("unroll") for(int r=0;r<16;++r)negm[r]=-mhat; asm volatile("":"+v"(negm)); } \
    _Pragma("unroll") for(int r=0;r<16;++r)P0[r]=__builtin_amdgcn_exp2f(P0[r]); }while(0)
  #define RESC() do{ if(resc){ asm volatile("s_waitcnt lgkmcnt(0)":::"memory"); \
      _Pragma("unroll") for(int d_=0;d_<2;++d_) _Pragma("unroll") for(int r=0;r<16;++r)o[d_][r]*=wsf[crow(r,hi)]; } }while(0)
  f32x16 pA0,pA1,pB0,pB1;
  int sl_prev=0,sl_cur=0,sl_next=SLOTB;
  #define ROT() do{sl_prev=sl_cur;sl_cur=sl_next;sl_next=(sl_next==(NSLOT-1)*SLOTB)?0:sl_next+SLOTB;}while(0)
  DMA_K(2,2*SLOTB);
  WAIT_BAR(3);
  qkt(pA0,pA1,Kbase,qr,negm,r32,hi);asm volatile("s_nop 15\n\ts_nop 7":"+v"(pA0),"+v"(pA1));CMASK(pA0,pA1,0);
  START(pA0,pA1);
  _Pragma("unroll") for(int r=0;r<16;++r)pA1[r]=__builtin_amdgcn_exp2f(pA1[r]);
  WAIT_BAR(0);
  DMA_K(3,0);DMA_V(1,SLOTB);
  ROT();
  kload8(kf,kp0+sl_cur);
  WAIT_BAR(2);
  s16x4 vlo[8],vhi[8]; u32x4 pw0,pw1,pw2,pw3;
  #define PKW(P,B) cvtpk_s(P[B],P[B+1])
  #define PAF(k) __builtin_bit_cast(bf16x8,pw##k)
  #define VFR(i) (bf16x8){vlo[i][0],vlo[i][1],vlo[i][2],vlo[i][3],vhi[i][0],vhi[i][1],vhi[i][2],vhi[i][3]}
  #define PIN(x) asm volatile("":"+v"(x))
  #define MX3(a,b,c) __builtin_fmaxf(__builtin_fmaxf((a),(b)),(c))
  #define GAPA(MF,A0,A1,A2,A3,W0,W1,PW) do{ MF; sacc+=A0; sacc+=A1; sacc+=A2; sacc+=A3; PIN(sacc); W0; W1; PIN(PW); SBAR(); }while(0)
  #define EX(v) __builtin_amdgcn_exp2f(v)
  #define GAPB(MF,X,B) do{ MF; X[B]=EX(X[B]); X[B+1]=EX(X[B+1]); X[B+2]=EX(X[B+2]); X[B+3]=EX(X[B+3]); PIN(X); SBAR(); }while(0)
  #define VRD(i) do{ vlo[i]=vtr(vp_+(((i)>>2)*4096+((i)&3)*1024)); vhi[i]=vtr(vp_+(((i)>>2)*4096+((i)&3)*1024+512)); }while(0)
  #define KRD(G,j) do{ if(G){ kload2(kf,kp0+sl_next,j); SBAR(); } }while(0)
  #define STEP(C0,C1,P0,P1,t,GK,GV,GL) do{ SBAR(); \
    const lds_cptr vp_=vp0+sl_prev; \
    VRD(0); SBAR(); float sacc=(P0[0]+P0[1]); \
    GAPA(C0=__builtin_amdgcn_mfma_f32_32x32x16_bf16(kf[0],qr[0],negm,0,0,0), P0[2],P0[3],P0[4],P0[5],     pw0[0]=PKW(P0,0), pw0[1]=PKW(P0,2), pw0); \
    VRD(4); SBAR(); GAPA(C1=__builtin_amdgcn_mfma_f32_32x32x16_bf16(kf[1],qr[0],negm,0,0,0), P0[6],P0[7],P0[8],P0[9],     pw0[2]=PKW(P0,4), pw0[3]=PKW(P0,6), pw0); \
    VRD(1); SBAR(); GAPA(C0=__builtin_amdgcn_mfma_f32_32x32x16_bf16(kf[2],qr[1],C0,0,0,0),   P0[10],P0[11],P0[12],P0[13], pw1[0]=PKW(P0,8), pw1[1]=PKW(P0,10), pw1); \
    VRD(5); SBAR(); GAPA(C1=__builtin_amdgcn_mfma_f32_32x32x16_bf16(kf[3],qr[1],C1,0,0,0),   P0[14],P0[15],P1[0],P1[1],   pw1[2]=PKW(P0,12),pw1[3]=PKW(P0,14), pw1); \
    VRD(2); SBAR(); GAPA(C0=__builtin_amdgcn_mfma_f32_32x32x16_bf16(kf[4],qr[2],C0,0,0,0),   P1[2],P1[3],P1[4],P1[5],     pw2[0]=PKW(P1,0), pw2[1]=PKW(P1,2), pw2); \
    VRD(6); SBAR(); GAPA(C1=__builtin_amdgcn_mfma_f32_32x32x16_bf16(kf[5],qr[2],C1,0,0,0),   P1[6],P1[7],P1[8],P1[9],     pw2[2]=PKW(P1,4), pw2[3]=PKW(P1,6), pw2); \
    VRD(3); SBAR(); GAPA(C0=__builtin_amdgcn_mfma_f32_32x32x16_bf16(kf[6],qr[3],C0,0,0,0),   P1[10],P1[11],P1[12],P1[13], pw3[0]=PKW(P1,8), pw3[1]=PKW(P1,10), pw3); \
    VRD(7); SBAR(); GAPA(C1=__builtin_amdgcn_mfma_f32_32x32x16_bf16(kf[7],qr[3],C1,0,0,0),   P1[14],P1[15],0.f,0.f,       pw3[2]=PKW(P1,12),pw3[3]=PKW(P1,14), pw3); \
    l_reg+=sacc; \
    if(GK){DMA_K((t)+3,sl_cur);} if(GV){DMA_V((t)+1,sl_next);} \
    CMASK(C0,C1,t); \
    { float a=MX3(C0[0],C0[1],C1[0]),b=MX3(C0[2],C0[3],C1[1]); a=MX3(a,C1[2],C1[3]); \
      _Pragma("unroll") for(int r=4;r<16;r+=4){a=MX3(a,C0[r],C0[r+1]);b=MX3(b,C0[r+2],C0[r+3]);a=MX3(a,C1[r],C1[r+1]);b=MX3(b,C1[r+2],C1[r+3]);} \
      float rm=__builtin_fmaxf(a,b); { auto rr=__builtin_amdgcn_permlane32_swap(__float_as_uint(rm),__float_as_uint(rm),false,false); rm=__builtin_fmaxf(__uint_as_float(rr[0]),__uint_as_float(rr[1])); } \
      resc=false; \
      if(__builtin_expect(__any(rm>(float)THRL),0)){ const float dl=__builtin_fmaxf(rm,0.f); mhat+=dl; \
        _Pragma("unroll") for(int r=0;r<16;++r){C0[r]-=dl;C1[r]-=dl;} \
        _Pragma("unroll") for(int r=0;r<16;++r)negm[r]=-mhat; asm volatile("":"+v"(negm)); \
        const float f=__builtin_amdgcn_exp2f(-dl); l_reg*=f; if(hi==0)wsf[r32]=f; resc=true; } } \
    SBAR(); \
    GAPB(o[0]=__builtin_amdgcn_mfma_f32_32x32x16_bf16(PAF(0),VFR(0),o[0],0,0,0), C0,0); \
    GAPB(o[1]=__builtin_amdgcn_mfma_f32_32x32x16_bf16(PAF(0),VFR(4),o[1],0,0,0), C0,4); \
    KRD(GL,0); GAPB(o[0]=__builtin_amdgcn_mfma_f32_32x32x16_bf16(PAF(1),VFR(1),o[0],0,0,0), C0,8); \
    KRD(GL,1); GAPB(o[1]=__builtin_amdgcn_mfma_f32_32x32x16_bf16(PAF(1),VFR(5),o[1],0,0,0), C0,12); \
    KRD(GL,2); GAPB(o[0]=__builtin_amdgcn_mfma_f32_32x32x16_bf16(PAF(2),VFR(2),o[0],0,0,0), C1,0); \
    KRD(GL,3); GAPB(o[1]=__builtin_amdgcn_mfma_f32_32x32x16_bf16(PAF(2),VFR(6),o[1],0,0,0), C1,4); \
    GAPB(o[0]=__builtin_amdgcn_mfma_f32_32x32x16_bf16(PAF(3),VFR(3),o[0],0,0,0), C1,8); \
    GAPB(o[1]=__builtin_amdgcn_mfma_f32_32x32x16_bf16(PAF(3),VFR(7),o[1],0,0,0), C1,12); \
    }while(0)
  int t=1;
  #undef CMASK
  #define CMASK(P0,P1,t) do{}while(0)
  for(;t+5<NT;t+=2){
    STEP(pB0,pB1,pA0,pA1,t,true,true,true);     WAIT_BAR(2); RESC(); ROT();
    STEP(pA0,pA1,pB0,pB1,t+1,true,true,true);   WAIT_BAR(2); RESC(); ROT();
  }
  #undef CMASK
  #define CMASK(P0,P1,t) do{}while(0)
  #define ENDW(tt) do{ if((tt)+3<NT){WAIT_BAR(2);} else if((tt)+2<NT){WAIT_BAR(1);} else {WAIT_BAR(0);} }while(0)
  for(;t+1<NT;t+=2){
    STEP(pB0,pB1,pA0,pA1,t,(t+3<NT),(t+1<NT),(t+1<NT));       ENDW(t);   RESC(); ROT();
    STEP(pA0,pA1,pB0,pB1,t+1,(t+4<NT),(t+2<NT),(t+2<NT));     ENDW(t+1); RESC(); ROT();
  }
  STEP(pB0,pB1,pA0,pA1,NT-1,false,false,false); RESC();
  { float sacc=pB0[0]+pB0[1]; _Pragma("unroll") for(int r=2;r<16;++r)sacc+=pB0[r]; _Pragma("unroll") for(int r=0;r<16;++r)sacc+=pB1[r]; l_reg+=sacc;
    pw0=(u32x4){PKW(pB0,0),PKW(pB0,2),PKW(pB0,4),PKW(pB0,6)};pw1=(u32x4){PKW(pB0,8),PKW(pB0,10),PKW(pB0,12),PKW(pB0,14)};pw2=(u32x4){PKW(pB1,0),PKW(pB1,2),PKW(pB1,4),PKW(pB1,6)};pw3=(u32x4){PKW(pB1,8),PKW(pB1,10),PKW(pB1,12),PKW(pB1,14)};
    SBAR(); pv(o,vb0+sl_cur,PAF(0),PAF(1),PAF(2),PAF(3)); }
  #undef PKW
  #undef PAF
  #undef VFR
  #undef PIN
  #undef MX3
  #undef GAPA
  #undef GAPB
  #undef EX
  #undef VRD
  #undef KRD
  #undef STEP
  #undef ENDW
  {auto rr=__builtin_amdgcn_permlane32_swap(__float_as_uint(l_reg),__float_as_uint(l_reg),false,false);l_reg=__uint_as_float(rr[0])+__uint_as_float(rr[1]);}
  if(hi==0)wsf[32+r32]=l_reg;asm volatile("s_waitcnt lgkmcnt(0)":::"memory");
  float rli[16];
  #pragma unroll
  for(int r=0;r<16;++r)rli[r]=__builtin_amdgcn_rcpf(wsf[32+crow(r,hi)]);
  bf16*Ow=O+(rowbase+q0+wid*QBLK)*DM+h*D;
  { bf16*stg=(bf16*)(shm+LDS_OST)+wid*2048;
    #pragma unroll
    for(int r=0;r<16;++r){const int orow=crow(r,hi);
      #pragma unroll
      for(int d0=0;d0<2;++d0)stg[orow*64+d0*32+r32]=__float2bfloat16(o[d0][r]*rli[r]);}
    asm volatile("s_waitcnt lgkmcnt(0)":::"memory");
    #pragma unroll
    for(int i=0;i<4;++i){const int row=i*8+(lane>>3),ch=lane&7; const u32x4 v=*(const u32x4*)(stg+row*64+ch*8); ATTN_STORE16(Ow+(long)row*DM+ch*8,v);} }
  asm volatile("s_waitcnt lgkmcnt(0)\n\ts_barrier":::"memory");
  #undef DMA_K
  #undef DMA_V
  #undef CMASK
  #undef START
  #undef RESC
  #undef ROT
}
constexpr int ATTN_LDS_BYTES=LDS_BYTES;
struct AttnTensors { const bf16* Q; const bf16* K; const bf16* V; bf16* O; };
struct AttnUnit { int bh; int qb; };
struct StaticOrder {
  int vcu, per;
  __device__ __forceinline__ explicit StaticOrder(int grid,int vcu_):vcu(vcu_),per((BATCH*NHEAD*(SEQ/QB)+grid-1)/grid){}
  __device__ __forceinline__ bool next(int i,AttnUnit&u)const{ if(i>=per)return false; const int idx=vcu*per+i; if(idx>=BATCH*NHEAD*(SEQ/QB))return false; u.bh=idx/(SEQ/QB); u.qb=idx%(SEQ/QB); return true; }
  __device__ __forceinline__ void a_ready(const AttnUnit&)const{}
  __device__ __forceinline__ void done(const AttnUnit&)const{}
};
template<class Sched,int THRL=8> __device__ __forceinline__ void attn_phase(char*lds,const AttnTensors&T,const Sched&S){
  AttnUnit u;
  for(int i=0;S.next(i,u);++i){ S.a_ready(u); attn_unit<THRL>(u.bh/NHEAD,u.bh%NHEAD,u.qb,T.Q,T.K,T.V,T.O,lds); S.done(u); }
}
#undef SBAR
#undef WAIT_BAR
}

__device__ __forceinline__ void phase_attn_fast(ArgsP a, const Fr& F) {
    const attn_body::AttnTensors AT{(const attn_body::bf16*)(a->ws + SC_Q), (const attn_body::bf16*)(a->ws + SC_K), (const attn_body::bf16*)(a->ws + SC_V), (attn_body::bf16*)(a->ws + SC_O)};
    const attn_body::StaticOrder S(F.G, F.vcu);
    __syncthreads();
    attn_body::attn_phase<attn_body::StaticOrder>((char*)F.lds, AT, S);
    __syncthreads();
}
__device__ __forceinline__ void phase_sp_fast(ArgsP a, const Fr& F) {
    typedef short bf16x8 __attribute__((ext_vector_type(8)));
    constexpr int PITCH = 136;
    LAS unsigned short* As = (LAS unsigned short*)F.lds;
    LAS unsigned short* Bs = As + 128 * PITCH;
    LAS float* st = (LAS float*)(Bs + 128 * PITCH);
    const float* VT = (const float*)(a->ws + SC_VT); const f32x2* VST = (const f32x2*)(a->ws + SC_VST); const bf16* UB = (const bf16*)(a->ws + SC_UB); bf16* UV = (bf16*)(a->ws + SC_UV);
    const bf16* WS = (const bf16*)(a->ws + WS_WCMS);
    const float* lng = a->in[I_CMLNG]; const float* lnb = a->in[I_CMLNB]; const float* bs = a->in[I_CMBS];
    const int tid = F.tid, lane = F.lane, wid = F.wave, wr = wid >> 2, wc = wid & 3, fr = lane & 15, fq = lane >> 4;
    const int per = (2048 + F.G - 1) / F.G; int gl = -1;
    for (int it = F.vcu * per; it < (F.vcu + 1) * per && it < 2048; ++it) {
        const int g = it >> 7, n = it & 127;
        __syncthreads();
        if (g != gl) { gl = g;
#pragma unroll
            for (int q = 0; q < 4; ++q) { const int idx = tid + q * NTHR, t = idx >> 4, ck = idx & 15;
                *(LAS v4u*)(As + t * PITCH + ck * 8) = *(const v4u*)(WS + (size_t)g * 16384 + t * 128 + ck * 8); } }
        if (tid < 128) { float s1 = 0.f, s2 = 0.f;
#pragma unroll
            for (int p = 0; p < 16; ++p) { const f32x2 v = VST[(size_t)p * T + n * 128 + tid]; s1 += v.x; s2 += v.y; }
            const float mean = s1 * (1.0f / 2048.0f); const float var = s2 * (1.0f / 2048.0f) - mean * mean; st[tid * 2] = mean; st[tid * 2 + 1] = 1.0f / sqrtf(var + LN_EPS); }
        __syncthreads();
        { const int s4 = (lane & 31) * 4; const int ch = lane >> 5;
          const f32x4 mu = {st[(s4 + 0) * 2], st[(s4 + 1) * 2], st[(s4 + 2) * 2], st[(s4 + 3) * 2]};
          const f32x4 rs = {st[(s4 + 0) * 2 + 1], st[(s4 + 1) * 2 + 1], st[(s4 + 2) * 2 + 1], st[(s4 + 3) * 2 + 1]};
#pragma unroll
          for (int q = 0; q < 8; ++q) { const int c = q * 16 + wid * 2 + ch; const int chn = g * 128 + c;
              const f32x4 v = *(const f32x4*)(VT + (size_t)chn * T + n * 128 + s4);
              const float lg = lng[chn], lb = lnb[chn];
              const f32x4 y = (v - mu) * rs * lg + lb;
              v2u o; o.x = pk2(y[0], y[1]); o.y = pk2(y[2], y[3]); *(LAS v2u*)(Bs + c * PITCH + s4) = o; } }
        __syncthreads();
        f32x4 acc[4][2];
#pragma unroll
        for (int m = 0; m < 4; ++m)
#pragma unroll
            for (int nn = 0; nn < 2; ++nn) acc[m][nn] = (f32x4){0.f, 0.f, 0.f, 0.f};
#pragma unroll
        for (int k = 0; k < 4; ++k) {
            bf16x8 af[4], bfr[2];
#pragma unroll
            for (int m = 0; m < 4; ++m) af[m] = *(const LAS bf16x8*)(As + (wr * 64 + m * 16 + fr) * PITCH + k * 32 + fq * 8);
#pragma unroll
            for (int nn = 0; nn < 2; ++nn) bfr[nn] = *(const LAS bf16x8*)(Bs + (wc * 32 + nn * 16 + fr) * PITCH + k * 32 + fq * 8);
#pragma unroll
            for (int m = 0; m < 4; ++m)
#pragma unroll
                for (int nn = 0; nn < 2; ++nn) acc[m][nn] = __builtin_amdgcn_mfma_f32_16x16x32_bf16(bfr[nn], af[m], acc[m][nn], 0, 0, 0);
        }
#pragma unroll
        for (int m = 0; m < 4; ++m) { const int t = wr * 64 + m * 16 + fr; const float bt = bs[g * 128 + t];
#pragma unroll
            for (int nn = 0; nn < 2; ++nn) { const size_t idx = (size_t)(n * 128 + t) * 2048 + g * 128 + wc * 32 + nn * 16 + 4 * fq;
                const v2u ub = *(const v2u*)(UB + idx); const f32x4 o = acc[m][nn] + bt;
                v2u w; w.x = pk2(__builtin_bit_cast(float, ub.x << 16) * o[0], __builtin_bit_cast(float, ub.x & 0xffff0000u) * o[1]);
                w.y = pk2(__builtin_bit_cast(float, ub.y << 16) * o[2], __builtin_bit_cast(float, ub.y & 0xffff0000u) * o[3]);
                *(v2u*)(UV + idx) = w; } }
    }
}
__device__ __forceinline__ void phase_rope(ArgsP a, const Fr& F) {
    const float* QKV = (const float*)(a->ws + SC_QKV); bf16* Q = (bf16*)(a->ws + SC_Q); bf16* K = (bf16*)(a->ws + SC_K); bf16* V = (bf16*)(a->ws + SC_V);
    const int gw = F.vcu * NWAVES + F.wave, NGW = F.G * NWAVES;
    const int i = F.lane & 31, hs = F.lane >> 5;
    const float qg0 = a->in[I_QGAIN][i], qg1 = a->in[I_QGAIN][i + 32], kg0 = a->in[I_KGAIN][i], kg1 = a->in[I_KGAIN][i + 32];
    const float invf = powf(10000.0f, -(float)(i & 15) / 16.0f);
    for (int row = gw; row < TA; row += NGW) {
        const bool lat = row < T; const int b = lat ? (row >> 12) : ((row - T) >> 8); const int t = lat ? (row & 4095) : ((row - T) & 255);
        float cs = 1.f, sn = 0.f;
        if (lat) { const float pos = (i < 16) ? (float)(t >> 6) : (float)(t & 63); sincosf(pos * invf, &sn, &cs); }
        const float* src = QKV + (size_t)row * 1536;
        const size_t krow = (size_t)b * LK + (lat ? LC + t : t);
#pragma unroll
        for (int j = 0; j < 12; ++j) { const int hh = 2 * j + hs;
            if (!lat && hh < 16) continue;
            const float x1 = src[hh * 64 + i], x2 = src[hh * 64 + 32 + i];
            if (hh < 20) {
                float ss = x1 * x1 + x2 * x2;
#pragma unroll
                for (int o = 1; o < 32; o <<= 1) ss += __shfl_xor(ss, o);
                const float rs = 1.0f / sqrtf(ss * (1.0f / 64.0f) + RMS_EPS);
                const bool isq = hh < 16;
                const float n1 = x1 * rs * (isq ? qg0 : kg0), n2 = x2 * rs * (isq ? qg1 : kg1);
                float o1 = n1 * cs - n2 * sn, o2 = n1 * sn + n2 * cs;
                if (isq) { o1 *= ATT_C2; o2 *= ATT_C2; bf16* d = Q + (size_t)row * 1024 + hh * 64; d[i] = (bf16)f2bf(o1); d[i + 32] = (bf16)f2bf(o2); }
                else { bf16* d = K + krow * KVP + (hh - 16) * 64; d[i] = (bf16)f2bf(o1); d[i + 32] = (bf16)f2bf(o2); }
            } else { bf16* d = V + krow * KVP + (hh - 20) * 64; d[i] = (bf16)f2bf(x1); d[i + 32] = (bf16)f2bf(x2); }
        }
    }
}
__device__ __forceinline__ void phase_attn_simple(ArgsP a, const Fr& F) {
    const bf16* Q = (const bf16*)(a->ws + SC_Q); const bf16* K = (const bf16*)(a->ws + SC_K); const bf16* V = (const bf16*)(a->ws + SC_V); bf16* O = (bf16*)(a->ws + SC_O);
    for (int it = F.vcu; it < 512; it += F.G) {
        const int b = it >> 7, h = (it >> 3) & 15, q = (it & 7) * 512 + F.tid;
        const bf16* qp = Q + (size_t)(b * SEQ + q) * 1024 + h * 64;
        float qv[64], o[64];
#pragma unroll
        for (int d = 0; d < 64; ++d) { qv[d] = bf2f(qp[d]); o[d] = 0.f; }
        float m = -3.0e38f, l = 0.f;
        const bf16* kb = K + (size_t)b * LK * KVP + (h >> 2) * 64; const bf16* vb = V + (size_t)b * LK * KVP + (h >> 2) * 64;
        for (int s = 0; s < LK; ++s) {
            const v4u* kr = (const v4u*)(kb + (size_t)s * KVP); float sc = 0.f;
#pragma unroll
            for (int c = 0; c < 8; ++c) { const v4u kv = kr[c]; const unsigned w[4] = {kv.x, kv.y, kv.z, kv.w};
#pragma unroll
                for (int j = 0; j < 4; ++j) { sc += qv[c * 8 + 2 * j] * __builtin_bit_cast(float, w[j] << 16) + qv[c * 8 + 2 * j + 1] * __builtin_bit_cast(float, w[j] & 0xffff0000u); } }
            const float mn = fmaxf(m, sc); const float al = exp2f(m - mn), p = exp2f(sc - mn); l = l * al + p; m = mn;
            const v4u* vr = (const v4u*)(vb + (size_t)s * KVP);
#pragma unroll
            for (int c = 0; c < 8; ++c) { const v4u vv = vr[c]; const unsigned w[4] = {vv.x, vv.y, vv.z, vv.w};
#pragma unroll
                for (int j = 0; j < 4; ++j) { o[c * 8 + 2 * j] = o[c * 8 + 2 * j] * al + p * __builtin_bit_cast(float, w[j] << 16); o[c * 8 + 2 * j + 1] = o[c * 8 + 2 * j + 1] * al + p * __builtin_bit_cast(float, w[j] & 0xffff0000u); } }
        }
        const float il = 1.0f / l; bf16* op = O + (size_t)(b * SEQ + q) * 1024 + h * 64;
#pragma unroll
        for (int c = 0; c < 8; ++c) { v4u w; w.x = pk2(o[c * 8] * il, o[c * 8 + 1] * il); w.y = pk2(o[c * 8 + 2] * il, o[c * 8 + 3] * il); w.z = pk2(o[c * 8 + 4] * il, o[c * 8 + 5] * il); w.w = pk2(o[c * 8 + 6] * il, o[c * 8 + 7] * il);
            *(v4u*)(op + c * 8) = w; }
    }
}
__device__ __forceinline__ void phase_sp_simple(ArgsP a, const Fr& F) {
    LAS float* wsL = (LAS float*)F.lds;
    LAS float* vl = wsL + 128 * 128;
    LAS float* st = vl + 128 * 128;
    const float* VT = (const float*)(a->ws + SC_VT); const f32x2* VST = (const f32x2*)(a->ws + SC_VST); const bf16* UB = (const bf16*)(a->ws + SC_UB); bf16* UV = (bf16*)(a->ws + SC_UV);
    const int per = (2048 + F.G - 1) / F.G; int gl = -1;
    for (int it = F.vcu * per; it < (F.vcu + 1) * per && it < 2048; ++it) {
        const int g = it >> 7, n = it & 127;
        __syncthreads();
        if (g != gl) { for (int u = F.tid; u < 128 * 128; u += NTHR) wsL[u] = a->in[I_CMWS][(size_t)g * 16384 + u]; gl = g; }
        if (F.tid < 128) { float s1 = 0.f, s2 = 0.f; for (int p = 0; p < 16; ++p) { const f32x2 v = VST[(size_t)p * T + n * 128 + F.tid]; s1 += v.x; s2 += v.y; }
            const float mean = s1 * (1.0f / 2048.0f); const float var = s2 * (1.0f / 2048.0f) - mean * mean; st[F.tid * 2] = mean; st[F.tid * 2 + 1] = 1.0f / sqrtf(var + LN_EPS); }
        __syncthreads();
        for (int u = F.tid; u < 128 * 128; u += NTHR) { const int c = u >> 7, s = u & 127; const int ch = g * 128 + c;
            const float v = VT[(size_t)ch * T + n * 128 + s]; vl[s * 128 + c] = (v - st[s * 2]) * st[s * 2 + 1] * a->in[I_CMLNG][ch] + a->in[I_CMLNB][ch]; }
        __syncthreads();
        const int c = F.tid & 127, tq = F.tid >> 7;
        for (int jj = 0; jj < 32; ++jj) { const int t = tq + 4 * jj; float acc = 0.f;
            for (int s = 0; s < 128; ++s) acc += wsL[t * 128 + s] * vl[s * 128 + c];
            acc += a->in[I_CMBS][g * 128 + t];
            const size_t idx = (size_t)(n * 128 + t) * 2048 + g * 128 + c;
            UV[idx] = (bf16)f2bf(bf2f(UB[idx]) * acc); }
    }
}
#ifndef MK_FAST_CONV
#define MK_FAST_CONV 0
#endif
#ifndef MK_FAST_ATTN
#define MK_FAST_ATTN 0
#endif
#ifndef MK_FAST_SP
#define MK_FAST_SP 0
#endif
#ifndef MK_GATHER
#define MK_GATHER 0
#endif
constexpr int MOE_PH = MK_GATHER ? 5 : 6;
constexpr int N_PHASES = 2 + (4 + MOE_PH) + (4 + MOE_PH) + (3 + MOE_PH) + (4 + MOE_PH);

#ifndef MK_REPMASK
#define MK_REPMASK 0ull
#endif
#ifndef MK_REPN
#define MK_REPN 3
#endif
#define REPS for (int rep_ = 0; rep_ < (((MK_REPMASK >> p) & 1ull) ? MK_REPN : 1); ++rep_)
#define IN() (get_args()->ph_lo <= p && p < get_args()->ph_hi)
#define PHB ArgsP a = get_args(); unsigned char* ws = a->ws; (void)ws; const Fr F = mkfr(lds_raw);
#define SEAM() do { { ArgsP a__ = get_args(); if (a__->ph_lo <= p && p + 1 < a__->ph_hi) { XcdBarrier bb; bb.bar = (unsigned*)(a__->ws + WS_CTL) + 4096; bb.x = xb_xcc_id(); \
        bb.st = (volatile LAS unsigned*)((LAS unsigned char*)lds_raw + MISC_OFF) + 8; xcd_barrier(bb); } } ++p; } while (0)
template <int layer> __device__ __forceinline__ void layer_body(int& p, unsigned char* lds_raw) {
    PG8_LAS unsigned char* ring = (PG8_LAS unsigned char*)lds_raw;
        constexpr int kind = layer % 3;
        const int nrows = layer == 0 ? TA : T;
#define G1PTR ((const float*)(ws + WS_MOD) + (size_t)layer * 5 * 6144 + 2048)
        if constexpr (kind == 0) {
            const int slot = layer == 0 ? 0 : 1;
            REPS if (IN()) { PHB pg8::Gemm g{(const pg8::bf16_t*)(ws + WS_WHYIN) + (size_t)slot * 3072 * 1024, (const pg8::bf16_t*)(ws + WS_HB), 3072, nrows, 1024, nullptr};
                pg8::StaticOrder S; S.init(3072, nrows, F.G, F.bx); pg8::EpiBf16<0> E{(pg8::bf16_t*)(ws + SC_PT), TA, nullptr, 0, 0, 1.f};
                pg8::gemm_phase<pg8::EpiBf16<0>, pg8::StaticOrder, true, false>(ring, g, S, E); }
            SEAM();
            REPS if (IN()) { PHB
#if MK_FAST_CONV
                phase_hy_conv_fft(a, F, layer);
#else
                phase_hy_conv_direct(a, F, layer);
#endif
            }
            SEAM();
            REPS if (IN()) { PHB phase_hy_tr(a, F, nrows); }
            SEAM();
            REPS if (IN()) { PHB pg8::Gemm g{(const pg8::bf16_t*)(ws + SC_Z2), (const pg8::bf16_t*)(ws + WS_WHYOUT) + (size_t)slot * 1024 * 1024, nrows, 1024, 1024, nullptr};
                pg8::StaticOrder S; S.init(nrows, 1024, F.G, F.bx); pg8::EpiRes E{(const float*)(ws + WS_XC), (float*)(ws + WS_U), G1PTR, 6144, ALPHA};
                pg8::gemm_phase<pg8::EpiRes, pg8::StaticOrder, true, false>(ring, g, S, E); }
            SEAM();
        } else if constexpr (kind == 1) {
            REPS if (IN()) { PHB pg8::Gemm g{(const pg8::bf16_t*)(ws + WS_HB), (const pg8::bf16_t*)(ws + WS_WQKV), TA, 1536, 1024, nullptr};
                pg8::StaticOrder S; S.init(TA, 1536, F.G, F.bx); pg8::EpiF32 E{(float*)(ws + SC_QKV), 1536};
                pg8::gemm_phase<pg8::EpiF32, pg8::StaticOrder, true, false>(ring, g, S, E); }
            SEAM();
            REPS if (IN()) { PHB phase_rope(a, F); }
            SEAM();
            REPS if (IN()) { PHB
#if MK_FAST_ATTN
                phase_attn_fast(a, F);
#else
                phase_attn_simple(a, F);
#endif
            }
            SEAM();
            REPS if (IN()) { PHB pg8::Gemm g{(const pg8::bf16_t*)(ws + SC_O), (const pg8::bf16_t*)(ws + WS_WATO), T, 1024, 1024, nullptr};
                pg8::StaticOrder S; S.init(T, 1024, F.G, F.bx); pg8::EpiRes E{(const float*)(ws + WS_XC), (float*)(ws + WS_U), G1PTR, 6144, ALPHA};
                pg8::gemm_phase<pg8::EpiRes, pg8::StaticOrder, true, false>(ring, g, S, E); }
            SEAM();
        } else {
            REPS if (IN()) {
                { PHB pg8::Gemm g{(const pg8::bf16_t*)(ws + WS_HB), (const pg8::bf16_t*)(ws + WS_WCMIN), T, 2048, 1024, nullptr};
                  pg8::StaticOrder S; S.init(T, 2048, F.G, F.bx); pg8::EpiBf16<1> E{(pg8::bf16_t*)(ws + SC_UB), 2048, nullptr, 0, 0, 1.f};
                  pg8::gemm_phase<pg8::EpiBf16<1>, pg8::StaticOrder, true, false>(ring, g, S, E); }
                { PHB pg8::Gemm g{(const pg8::bf16_t*)(ws + WS_WCMIN) + (size_t)2048 * 1024, (const pg8::bf16_t*)(ws + WS_HB), 2048, T, 1024, nullptr};
                  pg8::StaticOrder S; S.init(2048, T, F.G, F.bx); pg8::EpiVT E{(float*)(ws + SC_VT), T, (pg8::f32x2*)(ws + SC_VST), T};
                  pg8::gemm_phase<pg8::EpiVT, pg8::StaticOrder, true, false>(ring, g, S, E); }
            }
            SEAM();
            REPS if (IN()) { PHB
#if MK_FAST_SP
                phase_sp_fast(a, F);
#else
                phase_sp_simple(a, F);
#endif
            }
            SEAM();
            REPS if (IN()) { PHB pg8::Gemm g{(const pg8::bf16_t*)(ws + SC_UV), (const pg8::bf16_t*)(ws + WS_WCMOUT), T, 1024, 2048, nullptr};
                pg8::StaticOrder S; S.init(T, 1024, F.G, F.bx); pg8::EpiRes E{(const float*)(ws + WS_XC), (float*)(ws + WS_U), G1PTR, 6144, ALPHA};
                pg8::gemm_phase<pg8::EpiRes, pg8::StaticOrder, true, false>(ring, g, S, E); }
            SEAM();
        }
        REPS if (IN()) { PHB phase_lnr(a, F, layer, nrows); }
        SEAM();
        REPS if (IN()) { PHB phase_topk(a, F, layer); }
        SEAM();
        const int npm = layer == 0 ? 9 : 8;
#if MK_GATHER
        REPS if (IN()) { PHB pg8::Gemm g{(const pg8::bf16_t*)(ws + WS_HB), (const pg8::bf16_t*)(ws + WS_WGU) + (size_t)layer * 16 * 4096 * 1024, 0, 0, 1024, (const int*)(ws + WS_ROWS)};
            pg8::MoeOrder S{npm, 16, F.G, F.vcu}; pg8::EpiGU E{(pg8::bf16_t*)(ws + WS_ACT), 16};
            pg8::gemm_phase<pg8::EpiGU, pg8::MoeOrder, true, true>(ring, g, S, E); }
        SEAM();
#else
        REPS if (IN()) { PHB phase_gather(a, F, layer); }
        SEAM();
        REPS if (IN()) { PHB pg8::Gemm g{(const pg8::bf16_t*)(ws + WS_XG), (const pg8::bf16_t*)(ws + WS_WGU) + (size_t)layer * 16 * 4096 * 1024, 0, 0, 1024, nullptr};
            pg8::MoeOrder S{npm, 16, F.G, F.vcu}; pg8::EpiGU E{(pg8::bf16_t*)(ws + WS_ACT), 16};
            pg8::gemm_phase<pg8::EpiGU, pg8::MoeOrder, true, false>(ring, g, S, E); }
        SEAM();
#endif
        REPS if (IN()) { PHB pg8::Gemm g{(const pg8::bf16_t*)(ws + WS_ACT), (const pg8::bf16_t*)(ws + WS_WDN) + (size_t)layer * 16 * 1024 * 2048, 0, 0, 2048, nullptr};
            pg8::MoeOrder S{npm, 4, F.G, F.vcu}; pg8::EpiDN E{(pg8::bf16_t*)(ws + WS_Y), (const float*)(ws + WS_GATE), 4};
            pg8::gemm_phase<pg8::EpiDN, pg8::MoeOrder, true, false>(ring, g, S, E); }
        SEAM();
        REPS if (IN()) { PHB phase_comb(a, F, layer, nrows); }
        SEAM();
    }
__global__ void __launch_bounds__(NTHR, 2) mk_fwd(Args a_) {
    extern __shared__ __attribute__((aligned(16))) unsigned char lds_raw[];
    Fr F0 = mkfr(lds_raw);
    volatile LAS unsigned* MISC = (volatile LAS unsigned*)(F0.lds + MISC_OFF);
    if (F0.tid < 32) MISC[F0.tid] = 0u;
    __syncthreads();
    if (a_.ph_hi - a_.ph_lo > 1) (void)xcd_barrier_post((unsigned*)(a_.ws + WS_CTL) + 4096, MISC + 8);
    int p = 0;
    PG8_LAS unsigned char* ring = (PG8_LAS unsigned char*)lds_raw;

    REPS if (IN()) { PHB phase_proA(a, F); }
    SEAM();
    REPS if (IN()) { PHB phase_proB(a, F); }
    SEAM();
    layer_body<0>(p, lds_raw); layer_body<1>(p, lds_raw); layer_body<2>(p, lds_raw); layer_body<3>(p, lds_raw);
#undef IN
#undef PHB
#undef G1PTR
#undef SEAM
}

#ifndef MK_N_LAUNCHES
#define MK_N_LAUNCHES 0
#endif
extern "C" void kernel_launch(void* const* d_in, const int* in_sizes, int n_in, void* d_out, int out_size, void* d_ws, size_t ws_size, hipStream_t stream) {
    static int grid = 0;
    if (grid == 0) {
        if (n_in != 33 || out_size != T * D || ws_size < WS_END) { fprintf(stderr, "kernel_launch: expected 33 inputs, %d outputs, >= %zu bytes of workspace; got %d, %d, %zu\n", T * D, (size_t)WS_END, n_in, out_size, ws_size); grid = -1; return; }
        int dev = 0, cus = 0, per_cu = 0;
        if (hipGetDevice(&dev) != hipSuccess || hipDeviceGetAttribute(&cus, hipDeviceAttributeMultiprocessorCount, dev) != hipSuccess) { grid = -1; return; }
        if (hipFuncSetAttribute((const void*)mk_fwd, hipFuncAttributeMaxDynamicSharedMemorySize, LDS_BYTES) != hipSuccess) { fprintf(stderr, "kernel_launch: hipFuncSetAttribute failed\n"); grid = -1; return; }
        if (hipOccupancyMaxActiveBlocksPerMultiprocessor(&per_cu, (const void*)mk_fwd, NTHR, LDS_BYTES) != hipSuccess || per_cu < 1)
            fprintf(stderr, "kernel_launch: note: occupancy query reports %d workgroups per CU\n", per_cu);
        (void)hipGetLastError();
        grid = cus;
    }
    if (grid < 0) return;
    (void)hipMemsetAsync((char*)d_ws + WS_CTL, 0, 1 * MiB, stream);
    Args a{};
    for (int i = 0; i < 33; ++i) a.in[i] = (const float*)d_in[i];
    a.out = (float*)d_out; a.ws = (unsigned char*)d_ws;
#if MK_N_LAUNCHES == 1
    a.ph_lo = 0; a.ph_hi = N_PHASES;
    hipLaunchKernelGGL(mk_fwd, dim3(grid), dim3(NTHR), LDS_BYTES, stream, a);
#else
    for (int p = 0; p < N_PHASES; ++p) { a.ph_lo = p; a.ph_hi = p + 1; hipLaunchKernelGGL(mk_fwd, dim3(grid), dim3(NTHR), LDS_BYTES, stream, a); }
#endif
    const hipError_t le = hipPeekAtLastError();
    if (le != hipSuccess) fprintf(stderr, "kernel_launch: launch failed: %s\n", hipGetErrorName(le));
}
```

```cpp
#define MK_N_LAUNCHES 1
#define MK_FAST_ATTN 1
#define MK_FAST_CONV 1
#define MK_GATHER 1
#define MK_FAST_SP 1
#include <hip/hip_runtime.h>
#include <cstdio>
#include <cstdint>
#include <cmath>
namespace pg8 {
#define PG8_LAS __attribute__((address_space(3)))
typedef unsigned short bf16_t;
typedef short bf16x8 __attribute__((ext_vector_type(8)));
typedef float f32x4 __attribute__((ext_vector_type(4)));
typedef unsigned u32x4 __attribute__((ext_vector_type(4)));
constexpr int BM = 256, BK = 64, HALF = 128, HTB = HALF * BK * 2  , STAGE_BYTES = 8 * HTB, NXCD = 8, WGM = 8;

__host__ __device__ __forceinline__ int lds_byte(int r, int c) { const int st = (r >> 4) * 2 + (c >> 5), rr = r & 15, cc = c & 31, ob = rr * 64 + cc * 2; return st * 1024 + (ob ^ (((ob >> 9) & 1) << 5)); }
__host__ __device__ __forceinline__ void stage_rc(int b, int& R, int& C) { const int st = b / 1024, sb = b % 1024, swz = sb ^ (((sb >> 9) & 1) << 5); R = (st >> 1) * 16 + swz / 64; C = (st & 1) * 32 + (swz % 64) / 2; }
__host__ __device__ __forceinline__ int perm32(int rho) { const int n = rho >> 4, i = rho & 15; return 8 * (i >> 2) + 4 * n + (i & 3); }

struct Unit { int pm, pn; };
struct Gemm { const bf16_t* A; const bf16_t* Bt; int M, N, K; const int* rows; };

struct StaticOrder {
    int nM, nN, nwg, G, c;
    __host__ __device__ void init(int M, int N, int G_, int c_) { nM = M / BM; nN = N / BM; nwg = nM * nN; G = G_; c = c_; }
    __host__ __device__ bool next(int i, Unit& u) const {
        const long L = (long)i * G + c; if (L >= nwg) return false;
        int wgid = (int)L; { const int q = nwg / NXCD, r = nwg % NXCD, xcd = wgid % NXCD, off = wgid / NXCD; wgid = (xcd < r ? xcd * (q + 1) : r * (q + 1) + (xcd - r) * q) + off; }
        const int nig = WGM * nN, gid = wgid / nig, fm = gid * WGM, gsz = (nM - fm) < WGM ? (nM - fm) : WGM;
        u.pm = fm + ((wgid % nig) % gsz); u.pn = (wgid % nig) / gsz; return true;
    }
    __device__ __forceinline__ void a_ready(const Unit&) const {}
    __device__ __forceinline__ void done(const Unit&) const {}
};

__device__ __forceinline__ unsigned cvt_pk_bf16(float lo, float hi) { unsigned r; asm volatile("v_cvt_pk_bf16_f32 %0, %1, %2" : "=v"(r) : "v"(lo), "v"(hi)); return r; }
typedef float f32x2 __attribute__((ext_vector_type(2)));
__device__ __forceinline__ f32x2 gelu_pk(f32x2 v) {
    const f32x2 av = __builtin_elementwise_abs(v), d = av * 0.2316418882f + 1.0f;
    f32x2 t; t.x = __builtin_amdgcn_rcpf(d.x); t.y = __builtin_amdgcn_rcpf(d.y);
    f32x2 q = t * 0.5307027145f + (-0.7265760135f); q = q * t + 0.7107068705f; q = q * t + (-0.142248368f); q = q * t + 0.127414796f; q = q * t;
    const f32x2 s = (v * v) * (-0.72134752044f);
    f32x2 e; e.x = __builtin_amdgcn_exp2f(s.x); e.y = __builtin_amdgcn_exp2f(s.y);
    const f32x2 m = v * (q * e), r = v - m;
    f32x2 o; o.x = v.x < 0.f ? m.x : r.x; o.y = v.y < 0.f ? m.y : r.y; return o;
}

template <int ACT  > struct EpiBf16 {
    static constexpr bool PERM = true, AFTER_DRAIN = false; static_assert(ACT == 0 || ACT == 1, "EpiBf16: ACT is 0 (none) or 1 (gelu_pk)");
    bf16_t* O; int ldc; const float* bias; int split_cols; size_t split_stride; float scale0;
    __device__ __forceinline__ void operator()(const f32x4 (&acc)[2][2][4][2], const Unit& u, int wr, int wc, int fr, int fq) const {
        const int row0 = u.pm * BM + wr * 64 + fr; int colt = u.pn * BM; bf16_t* base = O;
        float sc = 1.f; if (split_cols) { const int t = colt / split_cols; base += (size_t)t * split_stride; colt -= t * split_cols; if (t == 0) sc = scale0; }
        const int col0 = colt + wc * 32 + 8 * fq, bcol0 = u.pn * BM + wc * 32 + 8 * fq;
        f32x4 bv[2][2];
#pragma unroll
        for (int bj = 0; bj < 2; ++bj)
#pragma unroll
            for (int n = 0; n < 2; ++n) bv[bj][n] = bias ? *(const f32x4*)(bias + bcol0 + bj * HALF + 4 * n) : (f32x4){0.f, 0.f, 0.f, 0.f};
#pragma unroll
        for (int ai = 0; ai < 2; ++ai)
#pragma unroll
            for (int m = 0; m < 4; ++m) { bf16_t* rowp = base + (size_t)(row0 + ai * HALF + m * 16) * ldc + col0;
#pragma unroll
                for (int bj = 0; bj < 2; ++bj) { f32x4 v0 = acc[ai][bj][m][0] + bv[bj][0], v1 = acc[ai][bj][m][1] + bv[bj][1];
                    if (ACT == 1) { f32x2 a = gelu_pk((f32x2){v0[0], v0[1]}), b = gelu_pk((f32x2){v0[2], v0[3]}), c = gelu_pk((f32x2){v1[0], v1[1]}), d = gelu_pk((f32x2){v1[2], v1[3]});
                        v0 = (f32x4){a.x, a.y, b.x, b.y}; v1 = (f32x4){c.x, c.y, d.x, d.y}; }
                    v0 = v0 * sc; v1 = v1 * sc; u32x4 w; w.x = cvt_pk_bf16(v0[0], v0[1]); w.y = cvt_pk_bf16(v0[2], v0[3]); w.z = cvt_pk_bf16(v1[0], v1[1]); w.w = cvt_pk_bf16(v1[2], v1[3]);
                    *(u32x4*)(rowp + bj * HALF) = w; } }
    }
};

struct EpiF32 {
    static constexpr bool PERM = false, AFTER_DRAIN = false;
    float* C; int ldc;
    __device__ __forceinline__ void operator()(const f32x4 (&acc)[2][2][4][2], const Unit& u, int wr, int wc, int fr, int fq) const {
        const int row0 = u.pm * BM + wr * 64 + fr, col0 = u.pn * BM + wc * 32 + 4 * fq;
#pragma unroll
        for (int ai = 0; ai < 2; ++ai)
#pragma unroll
            for (int m = 0; m < 4; ++m) { float* rowp = C + (size_t)(row0 + ai * HALF + m * 16) * ldc + col0;
#pragma unroll
                for (int bj = 0; bj < 2; ++bj)
#pragma unroll
                    for (int n = 0; n < 2; ++n) *(f32x4*)(rowp + bj * HALF + n * 16) = acc[ai][bj][m][n]; }
    }
};
struct EpiRes {
    static constexpr bool PERM = false, AFTER_DRAIN = false;
    const float* X; float* U; const float* g; int gstride; float alpha;
    __device__ __forceinline__ void operator()(const f32x4 (&acc)[2][2][4][2], const Unit& u, int wr, int wc, int fr, int fq) const {
        const int row0 = u.pm * BM + wr * 64 + fr, col0 = u.pn * BM + wc * 32 + 4 * fq;
        const int rb = u.pm * BM; const int bidx = rb < 16384 ? (rb >> 12) : 4;
        const float* gp = g + (size_t)bidx * gstride + col0;
        f32x4 gv[2][2];
#pragma unroll
        for (int bj = 0; bj < 2; ++bj)
#pragma unroll
            for (int n = 0; n < 2; ++n) gv[bj][n] = *(const f32x4*)(gp + bj * HALF + n * 16);
#pragma unroll
        for (int ai = 0; ai < 2; ++ai)
#pragma unroll
            for (int m = 0; m < 4; ++m) { const size_t off = (size_t)(row0 + ai * HALF + m * 16) * 1024 + col0;
#pragma unroll
                for (int bj = 0; bj < 2; ++bj)
#pragma unroll
                    for (int n = 0; n < 2; ++n) { const f32x4 xv = *(const f32x4*)(X + off + bj * HALF + n * 16);
                        *(f32x4*)(U + off + bj * HALF + n * 16) = xv * alpha + gv[bj][n] * acc[ai][bj][m][n]; }
                asm volatile("" ::: "memory"); }
    }
};
struct EpiGU {
    static constexpr bool PERM = true, AFTER_DRAIN = false;
    bf16_t* ACT; int npn;
    __device__ __forceinline__ void operator()(const f32x4 (&acc)[2][2][4][2], const Unit& u, int wr, int wc, int fr, int fq) const {
        const int row0 = u.pm * BM + wr * 64 + fr; const int col0 = (u.pn % npn) * 128 + wc * 32 + 8 * fq;
#pragma unroll
        for (int ai = 0; ai < 2; ++ai)
#pragma unroll
            for (int m = 0; m < 4; ++m) { bf16_t* rowp = ACT + (size_t)(row0 + ai * HALF + m * 16) * 2048 + col0;
                float o[8];
#pragma unroll
                for (int n = 0; n < 2; ++n)
#pragma unroll
                    for (int j = 0; j < 4; ++j) { const float a = acc[ai][0][m][n][j], b = acc[ai][1][m][n][j];
                        const float s = a * __builtin_amdgcn_rcpf(1.0f + __builtin_amdgcn_exp2f(-1.4426950408889634f * a)); o[n * 4 + j] = s * b; }
                u32x4 w; w.x = cvt_pk_bf16(o[0], o[1]); w.y = cvt_pk_bf16(o[2], o[3]); w.z = cvt_pk_bf16(o[4], o[5]); w.w = cvt_pk_bf16(o[6], o[7]);
                *(u32x4*)rowp = w; }
    }
};
struct EpiDN {
    static constexpr bool PERM = true, AFTER_DRAIN = false;
    bf16_t* Y; const float* gate; int npn;
    __device__ __forceinline__ void operator()(const f32x4 (&acc)[2][2][4][2], const Unit& u, int wr, int wc, int fr, int fq) const {
        const int row0 = u.pm * BM + wr * 64 + fr, col0 = (u.pn % npn) * BM + wc * 32 + 8 * fq;
#pragma unroll
        for (int ai = 0; ai < 2; ++ai)
#pragma unroll
            for (int m = 0; m < 4; ++m) { const int row = row0 + ai * HALF + m * 16; const float gt = gate[row]; bf16_t* rowp = Y + (size_t)row * 1024 + col0;
#pragma unroll
                for (int bj = 0; bj < 2; ++bj) { const f32x4 v0 = acc[ai][bj][m][0] * gt, v1 = acc[ai][bj][m][1] * gt;
                    u32x4 w; w.x = cvt_pk_bf16(v0[0], v0[1]); w.y = cvt_pk_bf16(v0[2], v0[3]); w.z = cvt_pk_bf16(v1[0], v1[1]); w.w = cvt_pk_bf16(v1[2], v1[3]);
                    *(u32x4*)(rowp + bj * HALF) = w; } }
    }
};
struct EpiVT {
    static constexpr bool PERM = false, AFTER_DRAIN = false;
    float* VT; int ldc; f32x2* VST; int ntok;
    __device__ __forceinline__ void operator()(const f32x4 (&acc)[2][2][4][2], const Unit& u, int wr, int wc, int fr, int fq) const {
        const int row0 = u.pm * BM + wr * 64 + fr, col0 = u.pn * BM + wc * 32 + 4 * fq;
        f32x4 s1[2][2], s2[2][2];
#pragma unroll
        for (int bj = 0; bj < 2; ++bj)
#pragma unroll
            for (int n = 0; n < 2; ++n) { s1[bj][n] = (f32x4){0.f, 0.f, 0.f, 0.f}; s2[bj][n] = (f32x4){0.f, 0.f, 0.f, 0.f}; }
#pragma unroll
        for (int ai = 0; ai < 2; ++ai)
#pragma unroll
            for (int m = 0; m < 4; ++m) { float* rowp = VT + (size_t)(row0 + ai * HALF + m * 16) * ldc + col0;
#pragma unroll
                for (int bj = 0; bj < 2; ++bj)
#pragma unroll
                    for (int n = 0; n < 2; ++n) { const f32x4 v = acc[ai][bj][m][n]; const f32x2 a = gelu_pk((f32x2){v[0], v[1]}), b = gelu_pk((f32x2){v[2], v[3]});
                        const f32x4 gl = (f32x4){a.x, a.y, b.x, b.y}; *(f32x4*)(rowp + bj * HALF + n * 16) = gl; s1[bj][n] += gl; s2[bj][n] += gl * gl; } }
#pragma unroll
        for (int bj = 0; bj < 2; ++bj)
#pragma unroll
            for (int n = 0; n < 2; ++n)
#pragma unroll
                for (int j = 0; j < 4; ++j) { float a = s1[bj][n][j], b = s2[bj][n][j];
#pragma unroll
                    for (int o = 1; o < 16; o <<= 1) { a += __shfl_xor(a, o); b += __shfl_xor(b, o); }
                    s1[bj][n][j] = a; s2[bj][n][j] = b; }
        if (fr == 0) {
            f32x2* dst = VST + (size_t)(u.pm * 2 + wr) * ntok + col0;
#pragma unroll
            for (int bj = 0; bj < 2; ++bj)
#pragma unroll
                for (int n = 0; n < 2; ++n)
#pragma unroll
                    for (int j = 0; j < 4; ++j) dst[bj * HALF + n * 16 + j] = (f32x2){s1[bj][n][j], s2[bj][n][j]};
        }
    }
};
struct MoeOrder {
    int nPM, nPN, G, vcu;
    __device__ __forceinline__ bool next(int i, Unit& u) const {
        const int L = i * G + vcu; if (L >= 16 * nPM * nPN) return false;
        const int pm = L % nPM, r = L / nPM, pn = r % nPN, e = r / nPN; u.pm = e * 9 + pm; u.pn = e * nPN + pn; return true;
    }
    __device__ __forceinline__ void a_ready(const Unit&) const {}
    __device__ __forceinline__ void done(const Unit&) const {}
};

template <class Epi, class Sched, bool ALIGN_EPI = false, bool GATHER = false>
__device__ __forceinline__ void gemm_phase(PG8_LAS unsigned char* lds, const Gemm g, const Sched& S, const Epi& E) {
    int tid_ = threadIdx.x; asm volatile("" : "+v"(tid_));
    const int tid = tid_, wid = __builtin_amdgcn_readfirstlane(tid >> 6), lane = tid & 63, wr = wid >> 2, wc = wid & 3, fr = lane & 15, fq = lane >> 4;
    const int K = g.K, nt = K / BK;
    unsigned voffA[2], voffB[2];
#pragma unroll
    for (int i = 0; i < 2; ++i) { int R, C; stage_rc(tid * 16 + i * 8192, R, C); const int Rb = Epi::PERM ? ((R & ~31) + perm32(R & 31)) : R;
        voffA[i] = (unsigned)(R * K + C) * 2u; voffB[i] = (unsigned)(Rb * K + C) * 2u; }
    const size_t kstep = (size_t)(BK * 2);
    const size_t hstep = (size_t)HALF * K * 2;
    const size_t tstep = 2 * hstep;
    const unsigned ldsw = (unsigned)wid * 1024u;
    const int aoff = lds_byte(wr * 64 + fr, fq * 8), boff = lds_byte(wc * 32 + fr, fq * 8);
#define PG8_SA(b, h) (((b) * 2 + (h)) * HTB)
#define PG8_SB(b, h) ((4 + (b) * 2 + (h)) * HTB)
#define PG8_STAGE(bufoff, gbase, voff) do { _Pragma("unroll") for (int _i = 0; _i < 2; ++_i) \
        __builtin_amdgcn_global_load_lds((const unsigned*)((const char*)(gbase) + (voff)[_i]), (PG8_LAS unsigned*)(lds + (bufoff) + ldsw + _i * 8192), 16, 0, 0); } while (0)
#define PG8_STGA(b, h, ubase, koff, gofs) do { if constexpr (GATHER) { PG8_STAGE(PG8_SA(b, h), (const char*)g.A + (koff), gofs[h]); } \
        else { PG8_STAGE(PG8_SA(b, h), (ubase) + (koff) + (size_t)(h) * hstep, voffA); } } while (0)
#define PG8_GLOAD(dst, u) do { if constexpr (GATHER) { _Pragma("unroll") for (int _i = 0; _i < 2; ++_i) { int _R, _C; stage_rc(tid * 16 + _i * 8192, _R, _C); \
        _Pragma("unroll") for (int _h = 0; _h < 2; ++_h) dst[_h][_i] = (unsigned)g.rows[(u).pm * BM + _h * HALF + _R] * (unsigned)(K * 2) + (unsigned)_C * 2u; } } } while (0)
#define PG8_LDA(dst, b, h) do { _Pragma("unroll") for (int m = 0; m < 4; ++m) _Pragma("unroll") for (int k = 0; k < 2; ++k) dst[m][k] = *(const PG8_LAS bf16x8*)(lds + PG8_SA(b, h) + aoff + m * 2048 + k * 1024); } while (0)
#define PG8_LDB(dst, b, h) do { _Pragma("unroll") for (int n = 0; n < 2; ++n) _Pragma("unroll") for (int k = 0; k < 2; ++k) dst[n][k] = *(const PG8_LAS bf16x8*)(lds + PG8_SB(b, h) + boff + n * 2048 + k * 1024); } while (0)
#define PG8_MMA(ai, bj, At, Bt) do { __builtin_amdgcn_s_setprio(1); _Pragma("unroll") for (int m = 0; m < 4; ++m) _Pragma("unroll") for (int n = 0; n < 2; ++n) _Pragma("unroll") for (int k = 0; k < 2; ++k) \
        acc[ai][bj][m][n] = __builtin_amdgcn_mfma_f32_16x16x32_bf16(Bt[n][k], At[m][k], acc[ai][bj][m][n], 0, 0, 0); __builtin_amdgcn_s_setprio(0); } while (0)
#define PG8_WAIT_V(n) asm volatile("s_waitcnt vmcnt(" #n ")" ::: "memory")
#define PG8_WAIT_L(n) asm volatile("s_waitcnt lgkmcnt(" #n ")" ::: "memory")
#define PG8_BAR __builtin_amdgcn_s_barrier()
#define PG8_SCHED __builtin_amdgcn_sched_barrier(0)
    Unit cur, nxt; int ui = 0;
    if (!S.next(0, cur)) return;
    f32x4 acc[2][2][4][2];
#pragma unroll
    for (int a = 0; a < 2; ++a)
#pragma unroll
        for (int b = 0; b < 2; ++b)
#pragma unroll
            for (int m = 0; m < 4; ++m)
#pragma unroll
                for (int n = 0; n < 2; ++n) acc[a][b][m][n] = (f32x4){0.f, 0.f, 0.f, 0.f};
    bf16x8 At[4][2], B0[2][2], B1[2][2];
    unsigned gc[2][2] = {{0u, 0u}, {0u, 0u}}, gn[2][2] = {{0u, 0u}, {0u, 0u}};
    const char* cA = GATHER ? (const char*)g.A : (const char*)g.A + (size_t)cur.pm * tstep; const char* cB = (const char*)g.Bt + (size_t)cur.pn * tstep;
    S.a_ready(cur);
    PG8_GLOAD(gc, cur);
    PG8_STAGE(PG8_SB(0, 0), cB, voffB); PG8_STAGE(PG8_SB(0, 1), cB + hstep, voffB); PG8_STGA(0, 0, cA, 0, gc); PG8_STGA(0, 1, cA, 0, gc);
    if (wr == 1) PG8_BAR;
    PG8_WAIT_V(2); PG8_BAR;
    PG8_STAGE(PG8_SB(1, 0), cB + kstep, voffB); PG8_STGA(1, 0, cA, kstep, gc); PG8_STAGE(PG8_SB(1, 1), cB + hstep + kstep, voffB);
    PG8_WAIT_V(6); PG8_BAR;
    for (;;) {
        const bool has_next = S.next(ui + 1, nxt);
        const char* nA = GATHER ? (const char*)g.A : (has_next ? (const char*)g.A + (size_t)nxt.pm * tstep : cA); const char* nB = has_next ? (const char*)g.Bt + (size_t)nxt.pn * tstep : cB;
        for (int t = 0; t < nt; t += 2) {
            const bool last = (t == nt - 2);
            const size_t k1 = (size_t)(t + 1) * kstep;
            const char* b2 = last ? nB : cB + (size_t)(t + 2) * kstep; const char* b3 = b2 + kstep;
            if (last && has_next) S.a_ready(nxt);
            if (last) { if (has_next) { PG8_GLOAD(gn, nxt); } else {
#pragma unroll
                    for (int h = 0; h < 2; ++h)
#pragma unroll
                        for (int i = 0; i < 2; ++i) gn[h][i] = gc[h][i]; } }
            PG8_LDB(B0, 0, 0); PG8_LDB(B1, 0, 1); PG8_SCHED; PG8_LDA(At, 0, 0); PG8_STGA(1, 1, cA, k1, gc);
            PG8_WAIT_V(8); PG8_WAIT_L(0); PG8_BAR; PG8_MMA(0, 0, At, B0); PG8_MMA(0, 1, At, B1); PG8_BAR; PG8_SCHED;
            PG8_LDA(At, 0, 1); PG8_STAGE(PG8_SB(0, 0), b2, voffB); PG8_STAGE(PG8_SB(0, 1), b2 + hstep, voffB);
            if (last) { PG8_STGA(0, 0, nA, 0, gn); } else { PG8_STGA(0, 0, cA, (size_t)(t + 2) * kstep, gc); }
            PG8_WAIT_V(8); PG8_WAIT_L(0); PG8_BAR; PG8_MMA(1, 0, At, B0); PG8_MMA(1, 1, At, B1); PG8_BAR; PG8_SCHED;
            PG8_LDB(B0, 1, 0); PG8_LDB(B1, 1, 1); PG8_SCHED; PG8_LDA(At, 1, 0);
            if (last) { PG8_STGA(0, 1, nA, 0, gn); } else { PG8_STGA(0, 1, cA, (size_t)(t + 2) * kstep, gc); }
            PG8_WAIT_V(8); PG8_WAIT_L(0); PG8_BAR; PG8_MMA(0, 0, At, B0); PG8_MMA(0, 1, At, B1); PG8_BAR; PG8_SCHED;
            PG8_LDA(At, 1, 1); PG8_STAGE(PG8_SB(1, 0), b3, voffB); PG8_STAGE(PG8_SB(1, 1), b3 + hstep, voffB);
            if (last) { PG8_STGA(1, 0, nA, kstep, gn); } else { PG8_STGA(1, 0, cA, (size_t)(t + 3) * kstep, gc); }
            PG8_WAIT_V(8); PG8_WAIT_L(0); PG8_BAR; PG8_MMA(1, 0, At, B0); PG8_MMA(1, 1, At, B1); PG8_BAR; PG8_SCHED;
        }
        if constexpr (ALIGN_EPI) { if (wr == 0) PG8_BAR; }
        if constexpr (!Epi::AFTER_DRAIN) { E(acc, cur, wr, wc, fr, fq); S.done(cur); }
        if (!has_next) break;
#pragma unroll
        for (int a = 0; a < 2; ++a)
#pragma unroll
            for (int b = 0; b < 2; ++b)
#pragma unroll
                for (int m = 0; m < 4; ++m)
#pragma unroll
                    for (int n = 0; n < 2; ++n) acc[a][b][m][n] = (f32x4){0.f, 0.f, 0.f, 0.f};
        cur = nxt; cA = nA; cB = nB; ++ui;
#pragma unroll
        for (int h = 0; h < 2; ++h)
#pragma unroll
            for (int i = 0; i < 2; ++i) gc[h][i] = gn[h][i];
        if constexpr (ALIGN_EPI) { if (wr == 1) PG8_BAR; }
    }
    PG8_WAIT_V(0);
    if constexpr (!ALIGN_EPI) { if (wr == 0) PG8_BAR; }
    PG8_BAR;
    if constexpr (Epi::AFTER_DRAIN) { E.fused(acc, cur, wr, wc, fr, fq, lds, wid, lane); S.done(cur); }
#undef PG8_SA
#undef PG8_SB
#undef PG8_STAGE
#undef PG8_STGA
#undef PG8_GLOAD
#undef PG8_LDA
#undef PG8_LDB
#undef PG8_MMA
#undef PG8_WAIT_V
#undef PG8_WAIT_L
#undef PG8_BAR
#undef PG8_SCHED
}
}
constexpr int NB = 4, SEQ = 4096, T = NB * SEQ, LC = 256, TC = NB * LC, TA = T + TC, D = 1024;
constexpr int NE = 16, FF = 2048, ESTR = 2304;
constexpr int LK = LC + SEQ, KVP = 256;
constexpr float ALPHA = 1.6817928305074290f;
constexpr float LN_EPS = 1e-5f, RMS_EPS = 1e-6f;
constexpr float ATT_C2 = 0.125f * 1.4426950408889634f;
constexpr int NWAVES = 8, NTHR = 512;
constexpr size_t MiB = 1u << 20;
constexpr size_t WS_CTL = 0, WS_MOD = 1 * MiB, WS_MODP = 2 * MiB, WS_TW = 6 * MiB;
constexpr size_t WS_WHYIN = 8 * MiB, WS_WHYOUT = 20 * MiB, WS_WQKV = 24 * MiB, WS_WATO = 27 * MiB, WS_WCMIN = 29 * MiB, WS_WCMOUT = 37 * MiB, WS_WCMS = 41 * MiB;
constexpr size_t WS_WGU = 42 * MiB, WS_WDN = 554 * MiB, WS_HF = 810 * MiB;
constexpr size_t WS_XL = 942 * MiB, WS_U = 1010 * MiB, WS_HB = 1078 * MiB, WS_AFF = 1112 * MiB, WS_ROWS = 1114 * MiB, WS_GATE = WS_ROWS + 256 * 1024, WS_INV = 1115 * MiB;
constexpr size_t WS_ACT = 1117 * MiB, WS_Y = 1261 * MiB, WS_SCR = 1405 * MiB, WS_XC = 1677 * MiB, WS_END = 1745 * MiB;
constexpr size_t WS_XG = WS_Y;
constexpr size_t SC_PT = WS_SCR, SC_Z2T = WS_SCR + 204 * MiB, SC_Z2 = WS_SCR + 238 * MiB;
constexpr size_t SC_QKV = WS_SCR, SC_Q = WS_SCR + 102 * MiB, SC_K = WS_SCR + 134 * MiB, SC_V = WS_SCR + 143 * MiB, SC_O = WS_SCR + 152 * MiB;
constexpr size_t SC_UB = WS_SCR, SC_VT = WS_SCR + 64 * MiB, SC_VST = WS_SCR + 192 * MiB, SC_UV = WS_SCR + 194 * MiB;
constexpr size_t HF_SLOT = (size_t)4 * 1024 * 4096 * 4, HF_CTX = 2 * HF_SLOT;
constexpr int LDS_BYTES = 147456;
constexpr int RING_BYTES = 131072, MISC_OFF = LDS_BYTES - 256;

#define GAS __attribute__((address_space(1)))
#define LAS __attribute__((address_space(3)))
typedef unsigned short bf16;
typedef unsigned v4u __attribute__((ext_vector_type(4)));
typedef unsigned v2u __attribute__((ext_vector_type(2)));
typedef float f32x4 __attribute__((ext_vector_type(4)));
typedef float f32x2 __attribute__((ext_vector_type(2)));
#define LDS_WAIT() asm volatile("s_waitcnt lgkmcnt(0)" ::: "memory")
__device__ __forceinline__ unsigned f2bf(float f) { unsigned u = __builtin_bit_cast(unsigned, f); return (u + 0x7fffu + ((u >> 16) & 1u)) >> 16; }
__device__ __forceinline__ unsigned pk2(float lo, float hi) { return f2bf(lo) | (f2bf(hi) << 16); }
__device__ __forceinline__ float bf2f(unsigned short b) { return __builtin_bit_cast(float, (unsigned)b << 16); }
__device__ __forceinline__ float wave_sum(float v) {
#pragma unroll
    for (int o = 1; o < 64; o <<= 1) v += __shfl_xor(v, o);
    return v;
}

#define XB_TMO      128
#define XB_XCNT(j)  (256  + 64 * (j))
#define XB_XSUB(j)  (1280 + 64 * (j))
#define XB_XGEN(j)  (2304 + 64 * (j))
#define XB_TOP      3328
#define XB_TOPGEN   3392
#define XCD_BAR_WORDS 3456
#define XB_SPIN_CAP (1u << 18)
__device__ __forceinline__ unsigned xb_ld(unsigned* p)              { return __hip_atomic_load(p, __ATOMIC_RELAXED, __HIP_MEMORY_SCOPE_AGENT); }
__device__ __forceinline__ unsigned xb_add(unsigned* p, unsigned v) { return __hip_atomic_fetch_add(p, v, __ATOMIC_RELAXED, __HIP_MEMORY_SCOPE_AGENT); }
__device__ __forceinline__ unsigned xb_xcc_id() { return (unsigned)__builtin_amdgcn_s_getreg((3 << 11) | 20) & 0xFu; }
#define XB_SPIN(cond, bar) do { unsigned _sp = 0; while (cond) { __builtin_amdgcn_s_sleep(1); \
    if ((++_sp & 255u) == 0u) { if (xb_ld(&(bar)[XB_TMO])) break; if (_sp > XB_SPIN_CAP) { atomicAdd(&(bar)[XB_TMO], 1u); break; } } } } while (0)
struct XcdBarrier { unsigned* bar; unsigned x; volatile LAS unsigned* st; };
__device__ __forceinline__ XcdBarrier xcd_barrier_post(unsigned* bar, volatile LAS unsigned* st) {
    XcdBarrier b; b.bar = bar; b.x = xb_xcc_id(); b.st = st;
    if (threadIdx.x == 0) (void)xb_add(&bar[XB_XCNT(b.x)], 1u);
    return b;
}
__device__ __forceinline__ void xcd_barrier_complete(unsigned* bar, unsigned x, unsigned& nloc, unsigned& nx) {
    const unsigned G = gridDim.x * gridDim.y * gridDim.z;
    unsigned sum, cnt, mine, sp = 0u;
    for (;;) {
        sum = 0u; cnt = 0u; mine = 0u;
#pragma unroll
        for (unsigned j = 0; j < 16; ++j) { const unsigned c = xb_ld(&bar[XB_XCNT(j)]); sum += c; cnt += (c > 0u) ? 1u : 0u; mine = (j == x) ? c : mine; }
        if (sum == G) break;
        __builtin_amdgcn_s_sleep(1);
        if ((++sp & 255u) == 0u) { if (xb_ld(&bar[XB_TMO])) break; if (sp > XB_SPIN_CAP) { atomicAdd(&bar[XB_TMO], 1u); break; } }
    }
    nloc = mine > 0u ? mine : 1u; nx = cnt > 0u ? cnt : 1u;
}
__device__ __forceinline__ void xcd_barrier(const XcdBarrier& b) {
    asm volatile("s_waitcnt vmcnt(0)" ::: "memory");
    __syncthreads();
    if (threadIdx.x == 0) {
        unsigned* bar = b.bar; asm volatile("" : "+s"(bar));
        __builtin_amdgcn_s_waitcnt(0);
        unsigned bx_ = b.x; asm volatile("" : "+s"(bx_));
        unsigned nloc = b.st[0], nx = b.st[1];
        if (nloc == 0u) { xcd_barrier_complete(bar, bx_, nloc, nx); b.st[0] = nloc; b.st[1] = nx; }
        const unsigned old = xb_add(&bar[XB_XSUB(bx_)], 1u);
        const unsigned gen = old / nloc;
        if (old + 1u == (gen + 1u) * nloc) {
            __builtin_amdgcn_fence(__ATOMIC_RELEASE, "agent");
            asm volatile("s_waitcnt vmcnt(0)" ::: "memory");
            const unsigned og = xb_add(&bar[XB_TOP], 1u);
            const unsigned tg = og / nx;
            if (og + 1u == (tg + 1u) * nx) xb_add(&bar[XB_TOPGEN], 1u);
            else XB_SPIN(xb_ld(&bar[XB_TOPGEN]) == tg, bar);
            __builtin_amdgcn_fence(__ATOMIC_ACQUIRE, "agent");
            xb_add(&bar[XB_XGEN(bx_)], 1u);
            asm volatile("s_waitcnt vmcnt(0)" ::: "memory");
        } else {
            XB_SPIN(xb_ld(&bar[XB_XGEN(bx_)]) == gen, bar);
            __builtin_amdgcn_fence(__ATOMIC_ACQUIRE, "agent");
            asm volatile("s_waitcnt vmcnt(0)" ::: "memory");
        }
    }
    __syncthreads();
}

struct Args { const float* in[33]; float* out; unsigned char* ws; int ph_lo, ph_hi; };
enum { I_X = 0, I_C, I_CTX, I_CCTX, I_MODW, I_MODB, I_LNG, I_LNB, I_HYWIN, I_HYCW, I_HYCB, I_FW1, I_FB1, I_FW2, I_FB2, I_FW3, I_FFREQ, I_FBIAS, I_HYWOUT,
       I_WQKV, I_QGAIN, I_KGAIN, I_WATO, I_CMWIN, I_CMLNG, I_CMLNB, I_CMWS, I_CMBS, I_CMWOUT, I_ROUTER, I_WGATE, I_WUP, I_WDOWN };
typedef const __attribute__((address_space(4))) Args* ArgsP;
__device__ __forceinline__ ArgsP get_args() { auto p = __builtin_amdgcn_kernarg_segment_ptr(); asm volatile("" : "+s"(p)); return (ArgsP)p; }
struct Fr { LAS unsigned char* lds; int tid, lane, wave, vcu, G, bx; };
__device__ __forceinline__ Fr mkfr(unsigned char* lds_raw) {
    Fr F; int tid = threadIdx.x; asm volatile("" : "+v"(tid)); int bx = blockIdx.x, G = gridDim.x; asm volatile("" : "+s"(bx), "+s"(G));
    F.lds = (LAS unsigned char*)lds_raw; F.tid = tid; F.lane = tid & 63; F.wave = __builtin_amdgcn_readfirstlane(tid >> 6);
    F.G = G; F.bx = bx; F.vcu = (G % 8 == 0) ? (bx % 8) * (G / 8) + bx / 8 : bx; return F; }
__device__ __forceinline__ void proA_adaln_item(ArgsP a, const Fr& F, int it) {
    LAS float* sc = (LAS float*)F.lds;
    const int i = it / 96, ks = (it / 12) % 8, cc = it % 12;
    __syncthreads();
    for (int u = F.tid; u < 5 * 128; u += NTHR) { const int r = u / 128, k = ks * 128 + (u % 128);
        const float x = r < 4 ? a->in[I_C][r * D + k] : a->in[I_CCTX][k]; sc[u] = x / (1.0f + expf(-x)); }
    __syncthreads();
    const int col = cc * 512 + F.tid;
    const float* w = a->in[I_MODW] + ((size_t)i * D + (size_t)ks * 128) * 6144 + col;
    float acc[5] = {0.f, 0.f, 0.f, 0.f, 0.f};
#pragma unroll 8
    for (int k = 0; k < 128; ++k) { const float wv = w[(size_t)k * 6144];
#pragma unroll
        for (int r = 0; r < 5; ++r) acc[r] += sc[r * 128 + k] * wv; }
    float* mp = (float*)(a->ws + WS_MODP) + (size_t)((i * 8 + ks) * 5) * 6144 + col;
#pragma unroll
    for (int r = 0; r < 5; ++r) mp[(size_t)r * 6144] = acc[r];
}
__device__ __forceinline__ void proA_filter_item(ArgsP a, const Fr& F, int it) {
    int slot, L, t0; float* HF;
    if (it < 512) { slot = it >> 8; L = SEQ; t0 = (it & 255) * 16; HF = (float*)(a->ws + WS_HF + (size_t)slot * HF_SLOT); }
    else { slot = 0; L = LC; t0 = (it - 512) * 16; HF = (float*)(a->ws + WS_HF + HF_CTX); }
    LAS float* z = (LAS float*)F.lds;
    LAS float* h1 = z + 16 * 33;
    LAS float* h2 = h1 + 16 * 64;
    __syncthreads();
    for (int u = F.tid; u < 16 * 33; u += NTHR) { const int tt = u / 33, j = u % 33; const float tf = (float)(t0 + tt);
        float v;
        if (j == 0) v = tf / (float)(L - 1);
        else { const int jj = (j - 1) & 15; const float f = 1e-4f + (float)jj * ((15.0f - 1e-4f) / 15.0f); const float w = (float)(6.283185307179586 / (double)L) * tf;
            v = j <= 16 ? cosf(f * w) : -sinf(f * w); }
        z[u] = v; }
    __syncthreads();
    const float* w1 = a->in[I_FW1] + (size_t)slot * 33 * 64; const float* b1 = a->in[I_FB1] + slot * 64;
    const float* w2 = a->in[I_FW2] + (size_t)slot * 64 * 64; const float* b2 = a->in[I_FB2] + slot * 64;
    const float* fq = a->in[I_FFREQ] + slot * 128;
    for (int u = F.tid; u < 16 * 64; u += NTHR) { const int tt = u >> 6, j = u & 63; float s = b1[j];
        for (int i = 0; i < 33; ++i) s += z[tt * 33 + i] * w1[i * 64 + j];
        h1[u] = sinf(fq[j] * s); }
    __syncthreads();
    for (int u = F.tid; u < 16 * 64; u += NTHR) { const int tt = u >> 6, j = u & 63; float s = b2[j];
        for (int i = 0; i < 64; ++i) s += h1[tt * 64 + i] * w2[i * 64 + j];
        h2[u] = sinf(fq[64 + j] * s); }
    __syncthreads();
    const float* w3 = a->in[I_FW3] + (size_t)slot * 64 * 4096;
    const float dmin = -3.0701134573253940f, dmax = -15.350567286626973f;
    for (int cb = 0; cb < 8; ++cb) { const int col = cb * 512 + F.tid;
        float acc[16];
#pragma unroll
        for (int tt = 0; tt < 16; ++tt) acc[tt] = 0.f;
        for (int k4 = 0; k4 < 16; ++k4) { const float wa = w3[(size_t)(4 * k4) * 4096 + col], wb = w3[(size_t)(4 * k4 + 1) * 4096 + col], wc = w3[(size_t)(4 * k4 + 2) * 4096 + col], wd = w3[(size_t)(4 * k4 + 3) * 4096 + col];
#pragma unroll
            for (int tt = 0; tt < 16; ++tt) { const f32x4 hv = *(const LAS f32x4*)(h2 + tt * 64 + 4 * k4); acc[tt] += (hv[0] * wa + hv[1] * wb) + (hv[2] * wc + hv[3] * wd); } }
        const int d = col & 1023; const float delta = fabsf(dmin + (float)d * ((dmax - dmin) / 1023.0f));
        float* dst = HF + (size_t)col * L + t0;
#pragma unroll
        for (int q = 0; q < 4; ++q) { f32x4 o;
#pragma unroll
            for (int j = 0; j < 4; ++j) { const int tt = q * 4 + j; const float tl = (float)(t0 + tt) / (float)(L - 1); o[j] = acc[tt] * expf(-tl * delta); }
            *(f32x4*)(dst + q * 4) = o; } }
}
__device__ __forceinline__ void conv_tile(const float* W, int K, int N, int k0, int n0, bf16* WT, int drow0, LAS float* scr, int lane) {
    float rv[64];
#pragma unroll
    for (int i = 0; i < 64; ++i) rv[i] = W[(size_t)(k0 + i) * N + n0 + lane];
#pragma unroll
    for (int i = 0; i < 64; ++i) scr[i * 65 + lane] = rv[i];
    LDS_WAIT(); asm volatile("" ::: "memory");
    const int c = lane & 7;
#pragma unroll
    for (int j = 0; j < 8; ++j) { const int n = (lane >> 3) + 8 * j; const LAS float* s = scr + (8 * c) * 65 + n;
        v4u o; o.x = pk2(s[0 * 65], s[1 * 65]); o.y = pk2(s[2 * 65], s[3 * 65]); o.z = pk2(s[4 * 65], s[5 * 65]); o.w = pk2(s[6 * 65], s[7 * 65]);
        *(v4u*)(WT + (size_t)(drow0 + n) * K + k0 + 8 * c) = o; }
    LDS_WAIT(); asm volatile("" ::: "memory");
}
constexpr int CV_SMALL = 768 * 2 + 256 * 2 + 384 + 256 + 1024 + 512;
constexpr int CV_MOE = 4 * 16 * 3 * 512;
__device__ __forceinline__ void proA_conv_item(ArgsP a, int it, LAS float* scr, int lane) {
    unsigned char* ws = a->ws;
    if (it < CV_SMALL) {
        int r = it;
        if (r < 1536) { const int s = r / 768, q = r % 768, kb = q / 48, nb = q % 48;
            conv_tile(a->in[I_HYWIN] + (size_t)s * 1024 * 3072, 1024, 3072, kb * 64, nb * 64, (bf16*)(ws + WS_WHYIN) + (size_t)s * 3072 * 1024, nb * 64, scr, lane); return; } r -= 1536;
        if (r < 512) { const int s = r / 256, q = r % 256, kb = q / 16, nb = q % 16;
            conv_tile(a->in[I_HYWOUT] + (size_t)s * 1024 * 1024, 1024, 1024, kb * 64, nb * 64, (bf16*)(ws + WS_WHYOUT) + (size_t)s * 1024 * 1024, nb * 64, scr, lane); return; } r -= 512;
        if (r < 384) { const int kb = r / 24, nb = r % 24;
            conv_tile(a->in[I_WQKV], 1024, 1536, kb * 64, nb * 64, (bf16*)(ws + WS_WQKV), nb * 64, scr, lane); return; } r -= 384;
        if (r < 256) { const int kb = r / 16, nb = r % 16;
            conv_tile(a->in[I_WATO], 1024, 1024, kb * 64, nb * 64, (bf16*)(ws + WS_WATO), nb * 64, scr, lane); return; } r -= 256;
        if (r < 1024) { const int kb = r / 64, nb = r % 64;
            conv_tile(a->in[I_CMWIN], 1024, 4096, kb * 64, nb * 64, (bf16*)(ws + WS_WCMIN), nb * 64, scr, lane); return; } r -= 1024;
        { const int kb = r / 16, nb = r % 16;
            conv_tile(a->in[I_CMWOUT], 2048, 1024, kb * 64, nb * 64, (bf16*)(ws + WS_WCMOUT), nb * 64, scr, lane); return; }
    }
    const int r = it - CV_SMALL, mat = r / 512, q = r % 512, le = mat / 3, which = mat % 3;
    if (which < 2) { const int kb = q / 32, nb = q % 32, n0 = nb * 64;
        const float* src = a->in[which == 0 ? I_WGATE : I_WUP] + (size_t)le * 1024 * 2048;
        conv_tile(src, 1024, 2048, kb * 64, n0, (bf16*)(ws + WS_WGU) + (size_t)le * 4096 * 1024, (n0 >> 7) * 256 + (n0 & 127) + which * 128, scr, lane); }
    else { const int kb = q / 16, nb = q % 16;
        conv_tile(a->in[I_WDOWN] + (size_t)le * 2048 * 1024, 2048, 1024, kb * 64, nb * 64, (bf16*)(ws + WS_WDN) + (size_t)le * 1024 * 2048, nb * 64, scr, lane); }
}
__device__ __forceinline__ void phase_proA(ArgsP a, const Fr& F) {
    for (int it = F.vcu; it < 384 + 528; it += F.G) { if (it < 384) proA_adaln_item(a, F, it); else proA_filter_item(a, F, it - 384); }
    __syncthreads();
    const int gt = F.vcu * NTHR + F.tid, NGT = F.G * NTHR;
    for (int k = gt; k < 8192; k += NGT) { float s, c; sincospif((float)k * (1.0f / 4096.0f), &s, &c); ((f32x2*)(a->ws + WS_TW))[k] = (f32x2){c, s}; }
    for (int k = gt; k < 16 * 128 * 128; k += NGT) ((bf16*)(a->ws + WS_WCMS))[k] = (bf16)f2bf(a->in[I_CMWS][k]);
    LAS float* scr = (LAS float*)(F.lds + F.wave * 16640);
    const int gw = F.vcu * NWAVES + F.wave, NGW = F.G * NWAVES;
    for (int it = gw; it < CV_SMALL + CV_MOE; it += NGW) proA_conv_item(a, it, scr, F.lane);
}
__device__ __forceinline__ void phase_proB(ArgsP a, const Fr& F) {
    LAS float* m0 = (LAS float*)F.lds;
    const float* mp = (const float*)(a->ws + WS_MODP);
    for (int u = F.tid; u < 5 * 2048; u += NTHR) { const int r = u / 2048, c = u % 2048; float s = a->in[I_MODB][c];
        for (int ks = 0; ks < 8; ++ks) s += mp[(size_t)(ks * 5 + r) * 6144 + c];
        m0[u] = s; }
    __syncthreads();
    const int gw = F.vcu * NWAVES + F.wave, NGW = F.G * NWAVES;
    for (int row = gw; row < TA; row += NGW) {
        const int r = row < T ? (row >> 12) : 4;
        const float* src = row < T ? a->in[I_X] + (size_t)row * D : a->in[I_CTX] + (size_t)(row - T) * D;
        float* xl = (float*)(a->ws + WS_XC) + (size_t)row * D; bf16* hb = (bf16*)(a->ws + WS_HB) + (size_t)row * D;
#pragma unroll
        for (int j = 0; j < 4; ++j) { const int c = 4 * F.lane + 256 * j; const f32x4 v = *(const f32x4*)(src + c); *(f32x4*)(xl + c) = v;
            const f32x4 sh = *(const LAS f32x4*)(m0 + r * 2048 + c), sc = *(const LAS f32x4*)(m0 + r * 2048 + 1024 + c);
            const f32x4 h = v * (sc + 1.0f) + sh; v2u o; o.x = pk2(h[0], h[1]); o.y = pk2(h[2], h[3]); *(v2u*)(hb + c) = o; }
    }
    const int gt = F.vcu * NTHR + F.tid, NGT = F.G * NTHR;
    float* mod = (float*)(a->ws + WS_MOD);
    for (int u = gt; u < 4 * 5 * 6144; u += NGT) { const int i = u / 30720, r = (u / 6144) % 5, c = u % 6144; float s = a->in[I_MODB][i * 6144 + c];
        for (int ks = 0; ks < 8; ++ks) s += mp[(size_t)((i * 8 + ks) * 5 + r) * 6144 + c];
        mod[u] = s; }
}
template <int L>
__device__ __forceinline__ float sconv(const bf16* p, int t, float w0, float w1, float w2, float cb) {
    const float a = t > 0 ? bf2f(p[t - 1]) : 0.f, b = bf2f(p[t]), c = t < L - 1 ? bf2f(p[t + 1]) : 0.f; return w0 * a + w1 * b + w2 * c + cb;
}
template <int L>
__device__ __forceinline__ void hy_direct_item(ArgsP a, const Fr& F, int slot, int d, int tok0, const float* HF) {
    LAS float* kk = (LAS float*)F.lds;
    LAS float* vb = kk + 4 * L;
    LAS float* red = vb + 4 * L;
    const bf16* PT = (const bf16*)(a->ws + SC_PT);
    bf16* Z2T = (bf16*)(a->ws + SC_Z2T);
    __syncthreads();
    for (int o = 0; o < 2; ++o) {
        const float* fw = HF + (size_t)((o * 2 + 0) * 1024 + d) * L; const float* bw = HF + (size_t)((o * 2 + 1) * 1024 + d) * L;
        float s = 0.f;
        for (int t = F.tid; t < L; t += NTHR) { const float f = fw[t], b = bw[t]; kk[o * 2 * L + (L - 1) + t] = f; if (t >= 1) kk[o * 2 * L + (L - 1) - t] = b; s += fabsf(f) + (t >= 1 ? fabsf(b) : 0.f); }
        s = wave_sum(s); if (F.lane == 0) red[o * 8 + F.wave] = s;
    }
    __syncthreads();
    float nrm[2];
#pragma unroll
    for (int o = 0; o < 2; ++o) { float s = 0.f; for (int w = 0; w < 8; ++w) s += red[o * 8 + w]; nrm[o] = 1.0f / (s + 1e-6f); }
    const float* cw = a->in[I_HYCW] + (size_t)slot * 3 * 3072; const float* cbp = a->in[I_HYCB] + (size_t)slot * 3072;
    float w0[3], w1[3], w2[3], cb[3];
#pragma unroll
    for (int g = 0; g < 3; ++g) { const int c = g * 1024 + d; w0[g] = cw[c]; w1[g] = cw[3072 + c]; w2[g] = cw[2 * 3072 + c]; cb[g] = cbp[c]; }
    const float fb0 = a->in[I_FBIAS][(slot * 2 + 0) * 1024 + d], fb1 = a->in[I_FBIAS][(slot * 2 + 1) * 1024 + d];
    for (int u = F.tid; u < 4 * L; u += NTHR) { const int b = u / L, t = u % L; vb[u] = sconv<L>(PT + (size_t)d * TA + tok0 + b * L, t, w0[0], w1[0], w2[0], cb[0]); }
    __syncthreads();
    constexpr int NBLK = 4 * L / 8, PER = (NBLK + NTHR - 1) / NTHR;
    float res[PER][8];
#pragma unroll 1
    for (int o = 0; o < 2; ++o) {
        const LAS float* ko = kk + o * 2 * L;
#pragma unroll
        for (int pi = 0; pi < PER; ++pi) {
            const int q = F.tid + pi * NTHR;
            float acc[8];
#pragma unroll
            for (int j = 0; j < 8; ++j) acc[j] = 0.f;
            if (q < NBLK) {
                const int b = q / (L / 8), t0 = (q % (L / 8)) * 8;
                const LAS float* vv = vb + b * L;
#pragma unroll 1
                for (int s8 = 0; s8 < L; s8 += 8) {
                    const LAS float* kw = ko + (t0 - s8 - 7 + L - 1);
                    float w[15], x[8];
#pragma unroll
                    for (int i = 0; i < 15; ++i) w[i] = kw[i];
#pragma unroll
                    for (int i = 0; i < 8; ++i) x[i] = vv[s8 + i];
#pragma unroll
                    for (int j = 0; j < 8; ++j)
#pragma unroll
                        for (int i = 0; i < 8; ++i) acc[j] += w[j - i + 7] * x[i];
                }
            }
#pragma unroll
            for (int j = 0; j < 8; ++j) res[pi][j] = acc[j];
        }
        __syncthreads();
#pragma unroll
        for (int pi = 0; pi < PER; ++pi) {
            const int q = F.tid + pi * NTHR;
            if (q < NBLK) {
                const int b = q / (L / 8), t0 = (q % (L / 8)) * 8;
                const bf16* pg = PT + (size_t)((o + 1) * 1024 + d) * TA + tok0 + b * L;
#pragma unroll
                for (int j = 0; j < 8; ++j) { const int t = t0 + j; const float vin = vb[b * L + t];
                    const float y = res[pi][j] * nrm[o] + vin * (o == 0 ? fb0 : fb1);
                    const float xg = sconv<L>(pg, t, w0[o + 1], w1[o + 1], w2[o + 1], cb[o + 1]);
                    res[pi][j] = xg * y; }
            }
        }
        __syncthreads();
        if (o == 0) {
#pragma unroll
            for (int pi = 0; pi < PER; ++pi) { const int q = F.tid + pi * NTHR;
                if (q < NBLK) { const int b = q / (L / 8), t0 = (q % (L / 8)) * 8;
#pragma unroll
                    for (int j = 0; j < 8; ++j) vb[b * L + t0 + j] = res[pi][j]; } }
            __syncthreads();
        } else {
#pragma unroll
            for (int pi = 0; pi < PER; ++pi) { const int q = F.tid + pi * NTHR;
                if (q < NBLK) { const int b = q / (L / 8), t0 = (q % (L / 8)) * 8;
                    v4u ov; ov.x = pk2(res[pi][0], res[pi][1]); ov.y = pk2(res[pi][2], res[pi][3]); ov.z = pk2(res[pi][4], res[pi][5]); ov.w = pk2(res[pi][6], res[pi][7]);
                    *(v4u*)(Z2T + (size_t)d * TA + tok0 + b * L + t0) = ov; } }
        }
    }
}
__device__ __forceinline__ void phase_hy_tr(ArgsP a, const Fr& F, int ntok) {
    LAS unsigned short* tile = (LAS unsigned short*)(F.lds + F.wave * 9216);
    const bf16* Z2T = (const bf16*)(a->ws + SC_Z2T); bf16* Z2 = (bf16*)(a->ws + SC_Z2);
    const int gw = F.vcu * NWAVES + F.wave, NGW = F.G * NWAVES, ntt = ntok / 64;
    for (int it = gw; it < 16 * ntt; it += NGW) {
        const int c0 = (it / ntt) * 64, t0 = (it % ntt) * 64;
#pragma unroll
        for (int i = 0; i < 8; ++i) { const int ch = i * 8 + (F.lane >> 3), ck = F.lane & 7;
            const v4u v = *(const v4u*)(Z2T + (size_t)(c0 + ch) * TA + t0 + ck * 8); *(LAS v4u*)(tile + ch * 72 + ck * 8) = v; }
        LDS_WAIT(); asm volatile("" ::: "memory");
        bf16* dst = Z2 + (size_t)(t0 + F.lane) * D + c0;
#pragma unroll
        for (int q = 0; q < 8; ++q) { unsigned w[4];
#pragma unroll
            for (int j = 0; j < 4; ++j) { const unsigned lo = tile[(q * 8 + 2 * j) * 72 + F.lane], hi = tile[(q * 8 + 2 * j + 1) * 72 + F.lane]; w[j] = lo | (hi << 16); }
            v4u o; o.x = w[0]; o.y = w[1]; o.z = w[2]; o.w = w[3]; *(v4u*)(dst + q * 8) = o; }
        LDS_WAIT(); asm volatile("" ::: "memory");
    }
}
__device__ __forceinline__ void phase_hy_conv_direct(ArgsP a, const Fr& F, int layer) {
    const int slot = layer == 0 ? 0 : 1; const int nitems = layer == 0 ? 2048 : 1024;
    for (int it = F.vcu; it < nitems; it += F.G) {
        if (it < 1024) hy_direct_item<SEQ>(a, F, slot, it, 0, (const float*)(a->ws + WS_HF + (size_t)slot * HF_SLOT));
        else hy_direct_item<LC>(a, F, slot, it - 1024, T, (const float*)(a->ws + WS_HF + HF_CTX));
    }
}

__device__ __forceinline__ void phase_lnr(ArgsP a, const Fr& F, int layer, int nrows) {
    LAS float* wr = (LAS float*)F.lds;
    __syncthreads();
    for (int u = F.tid; u < 1024 * 16; u += NTHR) wr[u] = a->in[I_ROUTER][(size_t)layer * 1024 * 16 + (u & 1023) * 16 + (u >> 10)];
    __syncthreads();
    const float* U = (const float*)(a->ws + WS_U); float* XL = (float*)(a->ws + WS_XL); bf16* HB = (bf16*)(a->ws + WS_HB); float* AFF = (float*)(a->ws + WS_AFF);
    const float* mod = (const float*)(a->ws + WS_MOD) + (size_t)layer * 5 * 6144;
    const float* lg = a->in[I_LNG] + (size_t)(layer * 2 + 0) * D; const float* lb = a->in[I_LNB] + (size_t)(layer * 2 + 0) * D;
    const int gw = F.vcu * NWAVES + F.wave, NGW = F.G * NWAVES;
    for (int row = gw; row < nrows; row += NGW) {
        const int r = row < T ? (row >> 12) : 4;
        const float* up = U + (size_t)row * D; f32x4 v[4]; float s = 0.f;
#pragma unroll
        for (int j = 0; j < 4; ++j) { v[j] = *(const f32x4*)(up + 4 * F.lane + 256 * j); s += (v[j][0] + v[j][1]) + (v[j][2] + v[j][3]); }
        const float mean = wave_sum(s) * (1.0f / D); float s2 = 0.f;
#pragma unroll
        for (int j = 0; j < 4; ++j) { v[j] = v[j] - mean; s2 += (v[j][0] * v[j][0] + v[j][1] * v[j][1]) + (v[j][2] * v[j][2] + v[j][3] * v[j][3]); }
        const float rstd = 1.0f / sqrtf(wave_sum(s2) * (1.0f / D) + LN_EPS);
        float part[16];
#pragma unroll
        for (int e = 0; e < 16; ++e) part[e] = 0.f;
#pragma unroll
        for (int j = 0; j < 4; ++j) { const int c = 4 * F.lane + 256 * j;
            const f32x4 x = v[j] * rstd * *(const f32x4*)(lg + c) + *(const f32x4*)(lb + c);
            *(f32x4*)(XL + (size_t)row * D + c) = x;
            const f32x4 h = x * (*(const f32x4*)(mod + r * 6144 + 4096 + c) + 1.0f) + *(const f32x4*)(mod + r * 6144 + 3072 + c);
            v2u o; o.x = pk2(h[0], h[1]); o.y = pk2(h[2], h[3]); *(v2u*)(HB + (size_t)row * D + c) = o;
#pragma unroll
            for (int e = 0; e < 16; ++e) { const f32x4 w = *(const LAS f32x4*)(wr + e * 1024 + c);
                part[e] += (h[0] * w[0] + h[1] * w[1]) + (h[2] * w[2] + h[3] * w[3]); }
            asm volatile("" ::: "memory"); }
        float mx = -3.0e38f;
#pragma unroll
        for (int e = 0; e < 16; ++e) { part[e] = wave_sum(part[e]); mx = fmaxf(mx, part[e]); }
        float den = 0.f;
#pragma unroll
        for (int e = 0; e < 16; ++e) { part[e] = expf(part[e] - mx); den += part[e]; }
        float mine = 0.f;
#pragma unroll
        for (int e = 0; e < 16; ++e) mine = (F.lane == e) ? part[e] / den : mine;
        if (F.lane < 16) AFF[(size_t)row * 16 + F.lane] = mine;
    }
}

template <int N, int CAPN>
__device__ __forceinline__ void topk_item(ArgsP a, const Fr& F, int b, int e, int rowbase, int slotbase, bool pad) {
    LAS unsigned* hist = (LAS unsigned*)F.lds;
    LAS unsigned* sel = hist + 256;
    LAS unsigned* wtot = hist + 264;
    const float* AFF = (const float*)(a->ws + WS_AFF); int* ROWS = (int*)(a->ws + WS_ROWS); float* GATE = (float*)(a->ws + WS_GATE); int* INV = (int*)(a->ws + WS_INV);
    const int tid = F.tid, lane = F.lane; const bool act = tid * 8 < N;
    unsigned key[8];
#pragma unroll
    for (int j = 0; j < 8; ++j) key[j] = act ? __float_as_uint(AFF[(size_t)(rowbase + tid * 8 + j) * 16 + e]) : 0u;
    unsigned prefix = 0u, need = CAPN;
#pragma unroll 1
    for (int pass = 0; pass < 4; ++pass) {
        const int shift = 24 - 8 * pass; const unsigned himask = pass == 0 ? 0u : (0xFFFFFFFFu << (shift + 8));
        __syncthreads();
        if (tid < 256) hist[tid] = 0u;
        __syncthreads();
        if (act) {
#pragma unroll
            for (int j = 0; j < 8; ++j) if ((key[j] & himask) == prefix) __hip_atomic_fetch_add(&hist[(key[j] >> shift) & 255u], 1u, __ATOMIC_RELAXED, __HIP_MEMORY_SCOPE_WORKGROUP);
        }
        __syncthreads();
        if (tid < 64) {
            const unsigned v0 = hist[4 * lane], v1 = hist[4 * lane + 1], v2 = hist[4 * lane + 2], v3 = hist[4 * lane + 3]; const unsigned tot = v0 + v1 + v2 + v3;
            unsigned x = tot;
#pragma unroll
            for (int o = 1; o < 64; o <<= 1) { const unsigned t = __shfl_down(x, o); if (lane + o < 64) x += t; }
            const unsigned a3 = x - tot, a2 = a3 + v3, a1 = a2 + v2, a0 = a1 + v1;
            if (a3 < need && need <= a3 + v3) { sel[0] = 4 * lane + 3; sel[1] = a3; }
            if (a2 < need && need <= a2 + v2) { sel[0] = 4 * lane + 2; sel[1] = a2; }
            if (a1 < need && need <= a1 + v1) { sel[0] = 4 * lane + 1; sel[1] = a1; }
            if (a0 < need && need <= a0 + v0) { sel[0] = 4 * lane + 0; sel[1] = a0; }
        }
        __syncthreads();
        prefix |= sel[0] << shift; need -= sel[1];
    }
    const unsigned tau = prefix;
    unsigned ceq = 0u;
#pragma unroll
    for (int j = 0; j < 8; ++j) ceq += (act && key[j] == tau) ? 1u : 0u;
    unsigned xe = ceq;
#pragma unroll
    for (int o = 1; o < 64; o <<= 1) { const unsigned t = __shfl_up(xe, o); if (lane >= o) xe += t; }
    __syncthreads();
    if (lane == 63) wtot[F.wave * 2] = xe;
    __syncthreads();
    unsigned eqbase = xe - ceq; for (int w = 0; w < F.wave; ++w) eqbase += wtot[w * 2];
    unsigned flags = 0u, csel = 0u;
#pragma unroll
    for (int j = 0; j < 8; ++j) { bool s = false; if (act) { if (key[j] > tau) s = true; else if (key[j] == tau) { s = eqbase < need; ++eqbase; } } if (s) { flags |= 1u << j; ++csel; } }
    unsigned xs = csel;
#pragma unroll
    for (int o = 1; o < 64; o <<= 1) { const unsigned t = __shfl_up(xs, o); if (lane >= o) xs += t; }
    if (lane == 63) wtot[F.wave * 2 + 1] = xs;
    __syncthreads();
    unsigned pos = xs - csel; for (int w = 0; w < F.wave; ++w) pos += wtot[w * 2 + 1];
    if (act) {
#pragma unroll
        for (int j = 0; j < 8; ++j) { const int row = rowbase + tid * 8 + j; int slot = -1;
            if (flags & (1u << j)) { slot = e * ESTR + slotbase + (int)pos; ++pos; ROWS[slot] = row; GATE[slot] = __uint_as_float(key[j]); }
            INV[(size_t)row * 16 + e] = slot; }
    }
    if (pad) for (int p = tid; p < 128; p += NTHR) { ROWS[e * ESTR + 2176 + p] = 0; GATE[e * ESTR + 2176 + p] = 0.f; }
}
__device__ __forceinline__ void phase_topk(ArgsP a, const Fr& F, int layer) {
    const int nitems = layer == 0 ? 128 : 64;
    for (int it = F.vcu; it < nitems; it += F.G) {
        if (it < 64) { const int b = it >> 4, e = it & 15; topk_item<SEQ, 512>(a, F, b, e, b * SEQ, b * 512, false); }
        else { const int b = (it - 64) >> 4, e = it & 15; topk_item<LC, 32>(a, F, b, e, T + b * LC, 2048 + b * 32, b == 0); }
    }
}
__device__ __forceinline__ void phase_gather(ArgsP a, const Fr& F, int layer) {
    const int me = layer == 0 ? 2304 : 2048;
    const int* ROWS = (const int*)(a->ws + WS_ROWS); const bf16* HB = (const bf16*)(a->ws + WS_HB); bf16* XG = (bf16*)(a->ws + WS_XG);
    const int gw = F.vcu * NWAVES + F.wave, NGW = F.G * NWAVES;
    for (int it = gw; it < 16 * me; it += NGW) { const int e = it / me, s = it % me, dr = e * ESTR + s; const int sr = ROWS[dr];
        const v4u* src = (const v4u*)(HB + (size_t)sr * D); v4u* dst = (v4u*)(XG + (size_t)dr * D);
        dst[F.lane] = src[F.lane]; dst[64 + F.lane] = src[64 + F.lane]; }
}
__device__ __forceinline__ void phase_comb(ArgsP a, const Fr& F, int layer, int nrows) {
    const bf16* Y = (const bf16*)(a->ws + WS_Y); const float* XL = (const float*)(a->ws + WS_XL); float* XC = (float*)(a->ws + WS_XC); bf16* HB = (bf16*)(a->ws + WS_HB); const int* INV = (const int*)(a->ws + WS_INV);
    const float* mod = (const float*)(a->ws + WS_MOD) + (size_t)layer * 5 * 6144;
    const float* modn = (const float*)(a->ws + WS_MOD) + (size_t)(layer < 3 ? layer + 1 : 3) * 5 * 6144;
    const float* lg = a->in[I_LNG] + (size_t)(layer * 2 + 1) * D; const float* lb = a->in[I_LNB] + (size_t)(layer * 2 + 1) * D;
    const int gw = F.vcu * NWAVES + F.wave, NGW = F.G * NWAVES;
    for (int row = gw; row < nrows; row += NGW) {
        const int r = row < T ? (row >> 12) : 4;
        const int myinv = INV[(size_t)row * 16 + (F.lane & 15)];
        f32x4 m[4];
#pragma unroll
        for (int j = 0; j < 4; ++j) m[j] = (f32x4){0.f, 0.f, 0.f, 0.f};
        unsigned msk = (unsigned)(__ballot(myinv >= 0) & 0xFFFFull);
        while (msk) {
            int sl[4];
#pragma unroll
            for (int q = 0; q < 4; ++q) { if (msk) { const int e = __builtin_ctz(msk); msk &= msk - 1; sl[q] = __shfl(myinv, e); } else sl[q] = -1; }
            v2u yv[4][4];
#pragma unroll
            for (int q = 0; q < 4; ++q) if (sl[q] >= 0) { const bf16* yp = Y + (size_t)sl[q] * D;
#pragma unroll
                for (int j = 0; j < 4; ++j) yv[q][j] = *(const v2u*)(yp + 4 * F.lane + 256 * j); }
#pragma unroll
            for (int q = 0; q < 4; ++q) if (sl[q] >= 0) {
#pragma unroll
                for (int j = 0; j < 4; ++j) { const v2u w = yv[q][j];
                    m[j] += (f32x4){__builtin_bit_cast(float, w.x << 16), __builtin_bit_cast(float, w.x & 0xffff0000u), __builtin_bit_cast(float, w.y << 16), __builtin_bit_cast(float, w.y & 0xffff0000u)}; } }
        }
        f32x4 v[4]; float s = 0.f;
#pragma unroll
        for (int j = 0; j < 4; ++j) { const int c = 4 * F.lane + 256 * j;
            v[j] = *(const f32x4*)(XL + (size_t)row * D + c) * ALPHA + *(const f32x4*)(mod + r * 6144 + 5120 + c) * m[j]; s += (v[j][0] + v[j][1]) + (v[j][2] + v[j][3]); }
        const float mean = wave_sum(s) * (1.0f / D); float s2 = 0.f;
#pragma unroll
        for (int j = 0; j < 4; ++j) { v[j] = v[j] - mean; s2 += (v[j][0] * v[j][0] + v[j][1] * v[j][1]) + (v[j][2] * v[j][2] + v[j][3] * v[j][3]); }
        const float rstd = 1.0f / sqrtf(wave_sum(s2) * (1.0f / D) + LN_EPS);
#pragma unroll
        for (int j = 0; j < 4; ++j) { const int c = 4 * F.lane + 256 * j;
            const f32x4 x = v[j] * rstd * *(const f32x4*)(lg + c) + *(const f32x4*)(lb + c);
            if (layer == 3) { *(f32x4*)(a->out + (size_t)row * D + c) = x; }
            else { *(f32x4*)(XC + (size_t)row * D + c) = x;
                const f32x4 h = x * (*(const f32x4*)(modn + r * 6144 + 1024 + c) + 1.0f) + *(const f32x4*)(modn + r * 6144 + c);
                v2u o; o.x = pk2(h[0], h[1]); o.y = pk2(h[2], h[3]); *(v2u*)(HB + (size_t)row * D + c) = o; } }
    }
}
#ifndef FFT_HD
#define FFT_HD __device__ __forceinline__
#endif
typedef float cf2 __attribute__((ext_vector_type(2)));
FFT_HD cf2 cmul(cf2 a, cf2 b) { return (cf2){a.x * b.x - a.y * b.y, a.x * b.y + a.y * b.x}; }
FFT_HD int fpad(int p) { return p + (p >> 5); }
constexpr int FFT_N = 8192, FFT_BUF = 8192 + 256;
template <bool INV> FFT_HD void dft4(cf2& a, cf2& b, cf2& c, cf2& d) {
    const cf2 s0 = a + c, s1 = a - c, s2 = b + d, s3 = b - d;
    const cf2 js3 = INV ? (cf2){-s3.y, s3.x} : (cf2){s3.y, -s3.x};
    a = s0 + s2; b = s1 + js3; c = s0 - s2; d = s1 - js3;
}
template <bool INV> FFT_HD void dft16(cf2 (&x)[16]) {
#pragma unroll
    for (int n0 = 0; n0 < 4; ++n0) dft4<INV>(x[n0], x[n0 + 4], x[n0 + 8], x[n0 + 12]);
    constexpr float C1 = 0.92387953251128674f, S1 = 0.38268343236508977f, R2 = 0.70710678118654752f;
    const float sg = INV ? 1.f : -1.f;
    const cf2 w1 = {C1, sg * S1}, w2 = {R2, sg * R2}, w3 = {S1, sg * C1}, w4 = {0.f, sg * 1.f}, w6 = {-R2, sg * R2}, w9 = {-C1, -sg * S1};
    x[1 + 4 * 1] = cmul(x[1 + 4 * 1], w1); x[1 + 4 * 2] = cmul(x[1 + 4 * 2], w2); x[1 + 4 * 3] = cmul(x[1 + 4 * 3], w3);
    x[2 + 4 * 1] = cmul(x[2 + 4 * 1], w2); x[2 + 4 * 2] = cmul(x[2 + 4 * 2], w4); x[2 + 4 * 3] = cmul(x[2 + 4 * 3], w6);
    x[3 + 4 * 1] = cmul(x[3 + 4 * 1], w3); x[3 + 4 * 2] = cmul(x[3 + 4 * 2], w6); x[3 + 4 * 3] = cmul(x[3 + 4 * 3], w9);
#pragma unroll
    for (int k0 = 0; k0 < 4; ++k0) dft4<INV>(x[0 + 4 * k0], x[1 + 4 * k0], x[2 + 4 * k0], x[3 + 4 * k0]);
#pragma unroll
    for (int i = 0; i < 4; ++i)
#pragma unroll
        for (int j = i + 1; j < 4; ++j) { const cf2 t = x[i + 4 * j]; x[i + 4 * j] = x[j + 4 * i]; x[j + 4 * i] = t; }
}
FFT_HD cf2 cmulc(cf2 a, cf2 b) { return (cf2){a.x * b.x + a.y * b.y, a.y * b.x - a.x * b.y}; }
template <bool INV, class BP> FFT_HD void stage_r16(BP buf, const cf2 (&tw)[15], int base, int stride) {
    cf2 x[16];
    const int pb = fpad(base), ps = stride + (stride >> 5);
#pragma unroll
    for (int i = 0; i < 16; ++i) x[i] = buf[pb + i * ps];
    if (!INV) { dft16<false>(x);
#pragma unroll
        for (int k = 1; k < 16; ++k) x[k] = cmulc(x[k], tw[k - 1]); }
    else {
#pragma unroll
        for (int k = 1; k < 16; ++k) x[k] = cmul(x[k], tw[k - 1]);
        dft16<true>(x); }
#pragma unroll
    for (int i = 0; i < 16; ++i) buf[pb + i * ps] = x[i];
}
template <class TP> FFT_HD void load_tw(TP TW, int tidx, cf2 (&tw)[15]) {
#pragma unroll
    for (int k = 1; k < 16; ++k) tw[k - 1] = TW[(tidx * k) & (FFT_N - 1)];
}
template <bool INV, class BP> FFT_HD void stage_r16_chain(BP buf, cf2 w, int base, int stride) {
    cf2 tw[15]; tw[0] = w;
#pragma unroll
    for (int k = 1; k < 15; ++k) tw[k] = cmul(tw[k - 1], w);
    stage_r16<INV>(buf, tw, base, stride);
}
template <bool INV, class BP> FFT_HD void stage_r32_load(BP buf, int blk, int r, cf2 (&u)[16]) {
    constexpr float CS[16] = {1.f, 0.98078528040323043f, 0.92387953251128674f, 0.83146961230254524f, 0.70710678118654752f, 0.55557023301960218f, 0.38268343236508977f, 0.19509032201612825f,
                              0.f, -0.19509032201612825f, -0.38268343236508977f, -0.55557023301960218f, -0.70710678118654752f, -0.83146961230254524f, -0.92387953251128674f, -0.98078528040323043f};
    constexpr float SN[16] = {0.f, 0.19509032201612825f, 0.38268343236508977f, 0.55557023301960218f, 0.70710678118654752f, 0.83146961230254524f, 0.92387953251128674f, 0.98078528040323043f,
                              1.f, 0.98078528040323043f, 0.92387953251128674f, 0.83146961230254524f, 0.70710678118654752f, 0.55557023301960218f, 0.38268343236508977f, 0.19509032201612825f};
    const int base = blk * 33;
#pragma unroll
    for (int n = 0; n < 16; ++n) { const cf2 lo = buf[base + n], hi = buf[base + n + 16];
        const cf2 s = lo + hi, d = lo - hi; const cf2 w = {CS[n], INV ? SN[n] : -SN[n]}; const cf2 dw = cmul(d, w);
        u[n] = r ? dw : s; }
    dft16<INV>(u);
}
template <class BP> FFT_HD void stage_r32_store(BP buf, int blk, int r, const cf2 (&u)[16]) {
    const int base = blk * 33;
#pragma unroll
    for (int g = 0; g < 16; ++g) buf[base + 2 * g + r] = u[g];
}
template <class BP> FFT_HD void fft_mul(BP Z, BP W, int tid, int o, float scale) {
    const int f2 = tid >> 5, f3 = tid & 31; const int pp = fpad(tid);
#pragma unroll 4
    for (int j = 0; j < 16; ++j) { const int f = j + 16 * f2 + 256 * f3; const int fm = (FFT_N - f) & (FFT_N - 1);
        const int pm = (fm & 15) * 512 + ((fm >> 4) & 15) * 32 + (fm >> 8);
        const cf2 a = W[pp + 528 * j], b = W[fpad(pm)];
        const cf2 k = o == 0 ? (cf2){0.5f * (a.x + b.x), 0.5f * (a.y - b.y)} : (cf2){0.5f * (a.y + b.y), 0.5f * (b.x - a.x)};
        const cf2 z = Z[pp + 528 * j]; Z[pp + 528 * j] = cmul(z, k) * scale; }
}
#ifndef FFT_HOST_ONLY
__device__ __forceinline__ void ld_tw2(const LAS cf2* tw2l, int tid, cf2 (&tw)[15]) {
#pragma unroll
    for (int k = 0; k < 15; ++k) tw[k] = tw2l[(tid & 31) * 15 + k];
}
__device__ __forceinline__ void fft_fwd(LAS cf2* buf, cf2 w1, const LAS cf2* tw2l, int tid) {
    asm volatile("" : "+v"(tid));
    stage_r16_chain<false>(buf, w1, tid, 512); __syncthreads();
    { cf2 tw[15]; ld_tw2(tw2l, tid, tw); stage_r16<false>(buf, tw, (tid >> 5) * 512 + (tid & 31), 32); } __syncthreads();
    { cf2 u[16]; stage_r32_load<false>(buf, tid >> 1, tid & 1, u); stage_r32_store(buf, tid >> 1, tid & 1, u); } __syncthreads();
}
__device__ __forceinline__ void fft_inv(LAS cf2* buf, cf2 w1, const LAS cf2* tw2l, int tid) {
    asm volatile("" : "+v"(tid));
    { cf2 u[16]; stage_r32_load<true>(buf, tid >> 1, tid & 1, u); stage_r32_store(buf, tid >> 1, tid & 1, u); } __syncthreads();
    { cf2 tw[15]; ld_tw2(tw2l, tid, tw); stage_r16<true>(buf, tw, (tid >> 5) * 512 + (tid & 31), 32); } __syncthreads();
    stage_r16_chain<true>(buf, w1, tid, 512); __syncthreads();
}
struct Raw8 { v4u mid; unsigned lo, hi; };
__device__ __forceinline__ Raw8 raw8_load(const bf16* p, int t0) { Raw8 r; r.mid = *(const v4u*)(p + t0); r.lo = t0 > 0 ? (unsigned)p[t0 - 1] : 0u; r.hi = t0 + 8 < SEQ ? (unsigned)p[t0 + 8] : 0u; return r; }
__device__ __forceinline__ void raw8_conv(const Raw8& r, float w0, float w1, float w2, float cb, float (&o)[8]) {
    float x[10]; x[0] = bf2f((unsigned short)r.lo); x[9] = bf2f((unsigned short)r.hi);
    const unsigned w[4] = {r.mid.x, r.mid.y, r.mid.z, r.mid.w};
#pragma unroll
    for (int j = 0; j < 4; ++j) { x[1 + 2 * j] = __builtin_bit_cast(float, w[j] << 16); x[2 + 2 * j] = __builtin_bit_cast(float, w[j] & 0xffff0000u); }
#pragma unroll
    for (int j = 0; j < 8; ++j) o[j] = w0 * x[j] + w1 * x[j + 1] + w2 * x[j + 2] + cb;
}
__device__ __forceinline__ void hy_fft_item(ArgsP a, const Fr& F, int slot, int d, cf2 wtw) {
    LAS cf2* Zb = (LAS cf2*)F.lds;
    LAS cf2* Wb = Zb + FFT_BUF;
    LAS float* red = (LAS float*)(Wb + FFT_BUF);
    const LAS cf2* tw2l = (const LAS cf2*)(red + 16);
    const bf16* PT = (const bf16*)(a->ws + SC_PT); bf16* Z2T = (bf16*)(a->ws + SC_Z2T);
    const float* HF = (const float*)(a->ws + WS_HF + (size_t)slot * HF_SLOT);
    const int tid = F.tid, t0 = 8 * tid;
    const int zb0 = t0 + (tid >> 2);
    __syncthreads();
    { const float* f0 = HF + (size_t)(0 * 1024 + d) * SEQ; const float* b0 = HF + (size_t)(1 * 1024 + d) * SEQ;
      const float* f1 = HF + (size_t)(2 * 1024 + d) * SEQ; const float* b1 = HF + (size_t)(3 * 1024 + d) * SEQ;
      float s0 = 0.f, s1 = 0.f; float fa[8], fb[8], ba[8], bb[8];
#pragma unroll
      for (int j = 0; j < 8; ++j) { const int t = tid + 512 * j; fa[j] = f0[t]; fb[j] = f1[t]; ba[j] = b0[t]; bb[j] = b1[t]; }
#pragma unroll
      for (int j = 0; j < 8; ++j) { const int t = tid + 512 * j; Wb[fpad(t)] = (cf2){fa[j], fb[j]}; s0 += fabsf(fa[j]); s1 += fabsf(fb[j]);
          if (t >= 1) { Wb[fpad(FFT_N - t)] = (cf2){ba[j], bb[j]}; s0 += fabsf(ba[j]); s1 += fabsf(bb[j]); } }
      if (tid == 0) Wb[fpad(SEQ)] = (cf2){0.f, 0.f};
      s0 = wave_sum(s0); s1 = wave_sum(s1); if (F.lane == 0) { red[F.wave] = s0; red[8 + F.wave] = s1; } }
    __syncthreads();
    float nrm0, nrm1; { float s0 = 0.f, s1 = 0.f; for (int w = 0; w < 8; ++w) { s0 += red[w]; s1 += red[8 + w]; } nrm0 = 1.0f / (s0 + 1e-6f); nrm1 = 1.0f / (s1 + 1e-6f); }
    fft_fwd(Wb, wtw, tw2l, tid);
    const float* cw = a->in[I_HYCW] + (size_t)slot * 3 * 3072; const float* cbp = a->in[I_HYCB] + (size_t)slot * 3072;
    float w0[3], w1[3], w2[3], cb[3];
#pragma unroll
    for (int g = 0; g < 3; ++g) { const int c = g * 1024 + d; w0[g] = cw[c]; w1[g] = cw[3072 + c]; w2[g] = cw[2 * 3072 + c]; cb[g] = cbp[c]; }
    const float fb0 = a->in[I_FBIAS][(slot * 2 + 0) * 1024 + d], fb1 = a->in[I_FBIAS][(slot * 2 + 1) * 1024 + d];
    const float sc0 = nrm0 * (1.0f / FFT_N), sc1 = nrm1 * (1.0f / FFT_N);
#pragma unroll 1
    for (int pr = 0; pr < 2; ++pr) {
        const bf16* pb = PT + (size_t)d * TA + (2 * pr) * SEQ;
        const Raw8 rv0 = raw8_load(pb, t0), rv1 = raw8_load(pb + SEQ, t0);
        float va[8], vb2[8];
        raw8_conv(rv0, w0[0], w1[0], w2[0], cb[0], va); raw8_conv(rv1, w0[0], w1[0], w2[0], cb[0], vb2);
        cf2 vin[8];
#pragma unroll
        for (int j = 0; j < 8; ++j) { vin[j] = (cf2){va[j], vb2[j]}; Zb[zb0 + j] = vin[j]; Zb[zb0 + j + SEQ + 128] = (cf2){0.f, 0.f}; }
        __syncthreads();
        fft_fwd(Zb, wtw, tw2l, tid); { int tl = tid; asm volatile("" : "+v"(tl)); fft_mul(Zb, Wb, tl, 0, sc0); } __syncthreads(); fft_inv(Zb, wtw, tw2l, tid);
        { const Raw8 rx0 = raw8_load(pb + (size_t)1024 * TA, t0), rx1 = raw8_load(pb + (size_t)1024 * TA + SEQ, t0);
          raw8_conv(rx0, w0[1], w1[1], w2[1], cb[1], va); raw8_conv(rx1, w0[1], w1[1], w2[1], cb[1], vb2); }
#pragma unroll
        for (int j = 0; j < 8; ++j) { const cf2 y = Zb[zb0 + j]; const cf2 xg = {va[j], vb2[j]}; vin[j] = xg * (y + vin[j] * fb0); }
        __syncthreads();
#pragma unroll
        for (int j = 0; j < 8; ++j) { Zb[zb0 + j] = vin[j]; Zb[zb0 + j + SEQ + 128] = (cf2){0.f, 0.f}; }
        __syncthreads();
        fft_fwd(Zb, wtw, tw2l, tid); { int tl = tid; asm volatile("" : "+v"(tl)); fft_mul(Zb, Wb, tl, 1, sc1); } __syncthreads(); fft_inv(Zb, wtw, tw2l, tid);
        { const Raw8 rz0 = raw8_load(pb + (size_t)2048 * TA, t0), rz1 = raw8_load(pb + (size_t)2048 * TA + SEQ, t0);
          raw8_conv(rz0, w0[2], w1[2], w2[2], cb[2], va); raw8_conv(rz1, w0[2], w1[2], w2[2], cb[2], vb2); }
        float z0[8], z1[8];
#pragma unroll
        for (int j = 0; j < 8; ++j) { const cf2 y = Zb[zb0 + j]; const cf2 xg = {va[j], vb2[j]}; const cf2 z = xg * (y + vin[j] * fb1); z0[j] = z.x; z1[j] = z.y; }
        bf16* o0 = Z2T + (size_t)d * TA + (2 * pr) * SEQ + t0;
        v4u q0, q1; q0.x = pk2(z0[0], z0[1]); q0.y = pk2(z0[2], z0[3]); q0.z = pk2(z0[4], z0[5]); q0.w = pk2(z0[6], z0[7]);
        q1.x = pk2(z1[0], z1[1]); q1.y = pk2(z1[2], z1[3]); q1.z = pk2(z1[4], z1[5]); q1.w = pk2(z1[6], z1[7]);
        *(v4u*)o0 = q0; *(v4u*)(o0 + SEQ) = q1;
        __syncthreads();
    }
}
__device__ __forceinline__ void phase_hy_conv_fft(ArgsP a, const Fr& F, int layer) {
    const int slot = layer == 0 ? 0 : 1; const int nitems = layer == 0 ? 2048 : 1024;
    {   const cf2* TW = (const cf2*)(a->ws + WS_TW);
        LAS cf2* tw2l = (LAS cf2*)((LAS float*)((LAS cf2*)F.lds + 2 * FFT_BUF) + 16);
        __syncthreads();
        if (F.tid < 32 * 15) { const int n3 = F.tid / 15, k = F.tid % 15 + 1; tw2l[F.tid] = TW[(16 * n3 * k) & (FFT_N - 1)]; }
        const cf2 w1 = TW[F.tid];
        __syncthreads();
        for (int it = F.vcu; it < 1024; it += F.G) hy_fft_item(a, F, slot, it, w1);
    }
    for (int it = 1024 + F.vcu; it < nitems; it += F.G) hy_direct_item<LC>(a, F, slot, it - 1024, T, (const float*)(a->ws + WS_HF + HF_CTX));
}
#endif
#include <hip/hip_bf16.h>
namespace attn_body {
using bf16=__hip_bfloat16;
using bf16x8=__attribute__((ext_vector_type(8)))short;
using s16x4=__attribute__((ext_vector_type(4)))short;
using f32x16=__attribute__((ext_vector_type(16)))float;
using u32x4=__attribute__((ext_vector_type(4)))unsigned;
constexpr int BATCH=4,NHEAD=16,SEQ=4096,D=64,DM=NHEAD*D,KP=256,LKEYS=4352;
constexpr int NW=8,QBLK=32,QB=QBLK*NW,KVBLK=64,NQB=SEQ/QB;
constexpr int ATTN_PITCH=DM, ATTN_UNIT_ROWS=QB;
__device__ __forceinline__ int crow(int r,int hi){return (r&3)+8*(r>>2)+4*hi;}
#define SBAR() __builtin_amdgcn_sched_barrier(0)
__device__ __forceinline__ void cmask(f32x16&p0,f32x16&p1,int jb,int qrel,int hi){
  const float NEG=-INFINITY; int kb=64*jb+4*hi;
  #pragma unroll
  for(int r=0;r<16;++r){int kv=kb+(r&3)+8*(r>>2); if(kv>qrel)p0[r]=NEG; if(kv+32>qrel)p1[r]=NEG;}
}

constexpr int NSLOT=3, SLOTB=8192;
constexpr int LDS_K=0, LDS_V=NSLOT*SLOTB, LDS_WS=2*NSLOT*SLOTB, LDS_OST=LDS_WS+NW*64*4, LDS_BYTES=LDS_OST+NW*4096;
constexpr float C2=0.125f*1.4426950408889634f;
__device__ __forceinline__ void glds16(const void*gsrc,unsigned lds_dst){unsigned keep;
  asm volatile("s_mov_b32 %0, m0\n\ts_mov_b32 m0, %2\n\ts_nop 0\n\tglobal_load_lds_dwordx4 %1, off\n\ts_mov_b32 m0, %0":"=&s"(keep):"v"(gsrc),"s"(lds_dst):"memory");}
__device__ __forceinline__ float max3f(float a,float b,float c){float r;asm("v_max3_f32 %0, %1, %2, %3":"=v"(r):"v"(a),"v"(b),"v"(c));return r;}
__device__ __forceinline__ float max2f(float a,float b){float r;asm("v_max_f32_e32 %0, %1, %2":"=v"(r):"v"(a),"v"(b));return r;}
__device__ __forceinline__ float fadd_s(float a,float b){float r;asm("v_add_f32_e32 %0, %1, %2":"=v"(r):"v"(a),"v"(b));return r;}
__device__ __forceinline__ float fsub_s(float a,float b){float r;asm("v_sub_f32_e32 %0, %1, %2":"=v"(r):"v"(a),"v"(b));return r;}
typedef float f32x2_t __attribute__((ext_vector_type(2))); typedef __bf16 bf16x2_t __attribute__((ext_vector_type(2)));
__device__ __forceinline__ unsigned cvtpk_s(float lo,float hi){f32x2_t v={lo,hi};bf16x2_t b=__builtin_convertvector(v,bf16x2_t);return __builtin_bit_cast(unsigned,b);}
#define WAIT_BAR(N) asm volatile("s_waitcnt vmcnt(" #N ") lgkmcnt(0)\n\ts_barrier":::"memory")

__device__ __forceinline__ void qkt(f32x16&p0,f32x16&p1,const char*Kslot,const bf16x8*qr,const f32x16&negm,int r32,int hi){
  const char*kb=Kslot+hi*1024+r32*16;
  #pragma unroll
  for(int d0=0;d0<4;++d0){
    const bf16x8 b0=*reinterpret_cast<const bf16x8*>(kb+d0*2048);
    const bf16x8 b1=*reinterpret_cast<const bf16x8*>(kb+d0*2048+512);
    if(d0==0){p0=__builtin_amdgcn_mfma_f32_32x32x16_bf16(b0,qr[0],negm,0,0,0);p1=__builtin_amdgcn_mfma_f32_32x32x16_bf16(b1,qr[0],negm,0,0,0);}
    else{p0=__builtin_amdgcn_mfma_f32_32x32x16_bf16(b0,qr[d0],p0,0,0,0);p1=__builtin_amdgcn_mfma_f32_32x32x16_bf16(b1,qr[d0],p1,0,0,0);}}
}
typedef __attribute__((address_space(3))) const char* lds_cptr;
typedef short v4i16_t __attribute__((ext_vector_type(4)));
__device__ __forceinline__ void kload8(bf16x8*kf,lds_cptr kp){
  kf[0]=*(const __attribute__((address_space(3))) bf16x8*)(kp);      kf[1]=*(const __attribute__((address_space(3))) bf16x8*)(kp+512);
  kf[2]=*(const __attribute__((address_space(3))) bf16x8*)(kp+2048); kf[3]=*(const __attribute__((address_space(3))) bf16x8*)(kp+2560);
  kf[4]=*(const __attribute__((address_space(3))) bf16x8*)(kp+4096); kf[5]=*(const __attribute__((address_space(3))) bf16x8*)(kp+4608);
  kf[6]=*(const __attribute__((address_space(3))) bf16x8*)(kp+6144); kf[7]=*(const __attribute__((address_space(3))) bf16x8*)(kp+6656);
}
__device__ __forceinline__ void kload2(bf16x8*kf,lds_cptr kp,int j){ kf[2*j]=*(const __attribute__((address_space(3))) bf16x8*)(kp+j*2048); kf[2*j+1]=*(const __attribute__((address_space(3))) bf16x8*)(kp+j*2048+512); }
__device__ __forceinline__ s16x4 vtr(lds_cptr p){ return __builtin_bit_cast(s16x4,__builtin_amdgcn_ds_read_tr16_b64_v4i16((__attribute__((address_space(3))) v4i16_t*)p)); }
__device__ __forceinline__ float rowmax(const f32x16&p0,const f32x16&p1){
  float a=max3f(p0[0],p0[1],p1[0]),b=max3f(p0[2],p0[3],p1[1]);a=max3f(a,p1[2],p1[3]);
  #pragma unroll
  for(int r=4;r<16;r+=4){a=max3f(a,p0[r],p0[r+1]);b=max3f(b,p0[r+2],p0[r+3]);a=max3f(a,p1[r],p1[r+1]);b=max3f(b,p1[r+2],p1[r+3]);}
  const float m=max2f(a,b);
  auto rr=__builtin_amdgcn_permlane32_swap(__float_as_uint(m),__float_as_uint(m),false,false);
  return max2f(__uint_as_float(rr[0]),__uint_as_float(rr[1]));
}
__device__ __forceinline__ void pv(f32x16*o,int vb,bf16x8 pa0,bf16x8 pa1,bf16x8 pa2,bf16x8 pa3){
  #pragma unroll
  for(int d0=0;d0<2;++d0){s16x4 lo[4],hi[4];
    #pragma unroll
    for(int ks=0;ks<4;++ks){
      asm volatile("ds_read_b64_tr_b16 %0,%1 offset:%c2":"=&v"(lo[ks]):"v"(vb),"i"(d0*4096+ks*1024):"memory");
      asm volatile("ds_read_b64_tr_b16 %0,%1 offset:%c2":"=&v"(hi[ks]):"v"(vb),"i"(d0*4096+ks*1024+512):"memory");}
    asm volatile("s_waitcnt lgkmcnt(0)":::"memory");SBAR();
    #define PK(k) (bf16x8){lo[k][0],lo[k][1],lo[k][2],lo[k][3],hi[k][0],hi[k][1],hi[k][2],hi[k][3]}
    o[d0]=__builtin_amdgcn_mfma_f32_32x32x16_bf16(pa0,PK(0),o[d0],0,0,0);
    o[d0]=__builtin_amdgcn_mfma_f32_32x32x16_bf16(pa1,PK(1),o[d0],0,0,0);
    o[d0]=__builtin_amdgcn_mfma_f32_32x32x16_bf16(pa2,PK(2),o[d0],0,0,0);
    o[d0]=__builtin_amdgcn_mfma_f32_32x32x16_bf16(pa3,PK(3),o[d0],0,0,0);
    #undef PK
  }
}

#ifndef ATTN_STORE16
#define ATTN_STORE16(p,v) (*(u32x4*)(p)=(v))
#endif
template<int THRL> __device__ __forceinline__ void attn_unit(int b,int h,int qb,const bf16*Q,const bf16*__restrict__ K,const bf16*__restrict__ V,bf16*O,char*shm){
  int tid_=threadIdx.x; asm volatile("":"+v"(tid_)); const int tid=tid_,lane=tid&63,r32=lane&31,hi=lane>>5; const int wid=__builtin_amdgcn_readfirstlane(tid>>6);
  const long rowbase=(long)b*SEQ; const int q0=qb*QB;
  const bf16*Qw=Q+(rowbase+q0+wid*QBLK)*DM+h*D;
  const bf16*Kh=K+(long)b*LKEYS*KP+(h>>2)*D,*Vh=V+(long)b*LKEYS*KP+(h>>2)*D;
  const unsigned lds0=(unsigned)(uintptr_t)shm;
  float*wsf=(float*)(shm+LDS_WS)+wid*64;
  const bf16*ksrc=Kh+(long)lane*KP+wid*8;
  const bf16*vsrc=Vh+(long)(16*(wid&3)+(lane>>2))*KP+(wid>>2)*32+(lane&3)*8;
  const unsigned kdst=lds0+LDS_K+wid*1024, vdst=lds0+LDS_V+wid*1024;
  #define DMA_K(t,slot) glds16(ksrc+(long)(t)*KVBLK*KP,(unsigned)__builtin_amdgcn_readfirstlane(kdst+(slot)))
  #define DMA_V(t,slot) glds16(vsrc+(long)(t)*KVBLK*KP,(unsigned)__builtin_amdgcn_readfirstlane(vdst+(slot)))
  const int vb0=(int)(lds0+LDS_V)+((lane>>4)&1)*32+(lane&3)*8+(4*hi+((lane&15)>>2))*64;
  const char*Kbase=shm+LDS_K; bf16x8 kf[8];
  const lds_cptr shm3=(lds_cptr)shm; const lds_cptr kp0=shm3+LDS_K+hi*1024+r32*16; const lds_cptr vp0=shm3+LDS_V+((lane>>4)&1)*32+(lane&3)*8+(4*hi+((lane&15)>>2))*64;
  const int NT=LKEYS/KVBLK;
  DMA_K(0,0);DMA_V(0,0);DMA_K(1,SLOTB);
  bf16x8 qr[4];
  #pragma unroll
  for(int d0=0;d0<4;++d0)qr[d0]=*reinterpret_cast<const bf16x8*>(&Qw[(long)r32*DM+d0*16+hi*8]);
  float mhat=0.f,l_reg=0.f;f32x16 o[2];o[0]=f32x16{};o[1]=f32x16{};f32x16 negm=f32x16{};asm volatile("":"+v"(negm));

  #define CMASK(P0,P1,t) do{}while(0)
  bool resc=false;
  #define START(P0,P1) do{ const float rm=rowmax(P0,P1); resc=false; \
    { const float dl=rm; mhat=fadd_s(mhat,dl); \
      _Pragma("unroll") for(int r=0;r<16;++r){P0[r]=fsub_s(P0[r],dl);P1[r]=fsub_s(P1[r],dl);} \
      _Pragma("unroll") for(int r=0;r<16;++r)negm[r]=-mhat; asm volatile("":"+v"(negm)); } \
    _Pragma("unroll") for(int r=0;r<16;++r)P0[r]=__builtin_amdgcn_exp2f(P0[r]); }while(0)
  #define RESC() do{ if(resc){ asm volatile("s_waitcnt lgkmcnt(0)":::"memory"); \
      _Pragma("unroll") for(int d_=0;d_<2;++d_) _Pragma("unroll") for(int r=0;r<16;++r)o[d_][r]*=wsf[crow(r,hi)]; } }while(0)
  f32x16 pA0,pA1,pB0,pB1;
  int sl_prev=0,sl_cur=0,sl_next=SLOTB;
  #define ROT() do{sl_prev=sl_cur;sl_cur=sl_next;sl_next=(sl_next==(NSLOT-1)*SLOTB)?0:sl_next+SLOTB;}while(0)
  DMA_K(2,2*SLOTB);
  WAIT_BAR(3);
  qkt(pA0,pA1,Kbase,qr,negm,r32,hi);asm volatile("s_nop 15\n\ts_nop 7":"+v"(pA0),"+v"(pA1));CMASK(pA0,pA1,0);
  START(pA0,pA1);
  _Pragma("unroll") for(int r=0;r<16;++r)pA1[r]=__builtin_amdgcn_exp2f(pA1[r]);
  WAIT_BAR(0);
  DMA_K(3,0);DMA_V(1,SLOTB);
  ROT();
  kload8(kf,kp0+sl_cur);
  WAIT_BAR(2);
  s16x4 vlo[8],vhi[8]; u32x4 pw0,pw1,pw2,pw3;
  #define PKW(P,B) cvtpk_s(P[B],P[B+1])
  #define PAF(k) __builtin_bit_cast(bf16x8,pw##k)
  #define VFR(i) (bf16x8){vlo[i][0],vlo[i][1],vlo[i][2],vlo[i][3],vhi[i][0],vhi[i][1],vhi[i][2],vhi[i][3]}
  #define PIN(x) asm volatile("":"+v"(x))
  #define MX3(a,b,c) __builtin_fmaxf(__builtin_fmaxf((a),(b)),(c))
  #define GAPA(MF,A0,A1,A2,A3,W0,W1,PW) do{ MF; sacc+=A0; sacc+=A1; sacc+=A2; sacc+=A3; PIN(sacc); W0; W1; PIN(PW); SBAR(); }while(0)
  #define EX(v) __builtin_amdgcn_exp2f(v)
  #define GAPB(MF,X,B) do{ MF; X[B]=EX(X[B]); X[B+1]=EX(X[B+1]); X[B+2]=EX(X[B+2]); X[B+3]=EX(X[B+3]); PIN(X); SBAR(); }while(0)
  #define VRD(i) do{ vlo[i]=vtr(vp_+(((i)>>2)*4096+((i)&3)*1024)); vhi[i]=vtr(vp_+(((i)>>2)*4096+((i)&3)*1024+512)); }while(0)
  #define KRD(G,j) do{ if(G){ kload2(kf,kp0+sl_next,j); SBAR(); } }while(0)
  #define STEP(C0,C1,P0,P1,t,GK,GV,GL) do{ SBAR(); \
    const lds_cptr vp_=vp0+sl_prev; \
    VRD(0); SBAR(); float sacc=(P0[0]+P0[1]); \
    GAPA(C0=__builtin_amdgcn_mfma_f32_32x32x16_bf16(kf[0],qr[0],negm,0,0,0), P0[2],P0[3],P0[4],P0[5],     pw0[0]=PKW(P0,0), pw0[1]=PKW(P0,2), pw0); \
    VRD(4); SBAR(); GAPA(C1=__builtin_amdgcn_mfma_f32_32x32x16_bf16(kf[1],qr[0],negm,0,0,0), P0[6],P0[7],P0[8],P0[9],     pw0[2]=PKW(P0,4), pw0[3]=PKW(P0,6), pw0); \
    VRD(1); SBAR(); GAPA(C0=__builtin_amdgcn_mfma_f32_32x32x16_bf16(kf[2],qr[1],C0,0,0,0),   P0[10],P0[11],P0[12],P0[13], pw1[0]=PKW(P0,8), pw1[1]=PKW(P0,10), pw1); \
    VRD(5); SBAR(); GAPA(C1=__builtin_amdgcn_mfma_f32_32x32x16_bf16(kf[3],qr[1],C1,0,0,0),   P0[14],P0[15],P1[0],P1[1],   pw1[2]=PKW(P0,12),pw1[3]=PKW(P0,14), pw1); \
    VRD(2); SBAR(); GAPA(C0=__builtin_amdgcn_mfma_f32_32x32x16_bf16(kf[4],qr[2],C0,0,0,0),   P1[2],P1[3],P1[4],P1[5],     pw2[0]=PKW(P1,0), pw2[1]=PKW(P1,2), pw2); \
    VRD(6); SBAR(); GAPA(C1=__builtin_amdgcn_mfma_f32_32x32x16_bf16(kf[5],qr[2],C1,0,0,0),   P1[6],P1[7],P1[8],P1[9],     pw2[2]=PKW(P1,4), pw2[3]=PKW(P1,6), pw2); \
    VRD(3); SBAR(); GAPA(C0=__builtin_amdgcn_mfma_f32_32x32x16_bf16(kf[6],qr[3],C0,0,0,0),   P1[10],P1[11],P1[12],P1[13], pw3[0]=PKW(P1,8), pw3[1]=PKW(P1,10), pw3); \
    VRD(7); SBAR(); GAPA(C1=__builtin_amdgcn_mfma_f32_32x32x16_bf16(kf[7],qr[3],C1,0,0,0),   P1[14],P1[15],0.f,0.f,       pw3[2]=PKW(P1,12),pw3[3]=PKW(P1,14), pw3); \
    l_reg+=sacc; \
    if(GK){DMA_K((t)+3,sl_cur);} if(GV){DMA_V((t)+1,sl_next);} \
    CMASK(C0,C1,t); \
    { float a=MX3(C0[0],C0[1],C1[0]),b=MX3(C0[2],C0[3],C1[1]); a=MX3(a,C1[2],C1[3]); \
      _Pragma("unroll") for(int r=4;r<16;r+=4){a=MX3(a,C0[r],C0[r+1]);b=MX3(b,C0[r+2],C0[r+3]);a=MX3(a,C1[r],C1[r+1]);b=MX3(b,C1[r+2],C1[r+3]);} \
      float rm=__builtin_fmaxf(a,b); { auto rr=__builtin_amdgcn_permlane32_swap(__float_as_uint(rm),__float_as_uint(rm),false,false); rm=__builtin_fmaxf(__uint_as_float(rr[0]),__uint_as_float(rr[1])); } \
      resc=false; \
      if(__builtin_expect(__any(rm>(float)THRL),0)){ const float dl=__builtin_fmaxf(rm,0.f); mhat+=dl; \
        _Pragma("unroll") for(int r=0;r<16;++r){C0[r]-=dl;C1[r]-=dl;} \
        _Pragma("unroll") for(int r=0;r<16;++r)negm[r]=-mhat; asm volatile("":"+v"(negm)); \
        const float f=__builtin_amdgcn_exp2f(-dl); l_reg*=f; if(hi==0)wsf[r32]=f; resc=true; } } \
    SBAR(); \
    GAPB(o[0]=__builtin_amdgcn_mfma_f32_32x32x16_bf16(PAF(0),VFR(0),o[0],0,0,0), C0,0); \
    GAPB(o[1]=__builtin_amdgcn_mfma_f32_32x32x16_bf16(PAF(0),VFR(4),o[1],0,0,0), C0,4); \
    KRD(GL,0); GAPB(o[0]=__builtin_amdgcn_mfma_f32_32x32x16_bf16(PAF(1),VFR(1),o[0],0,0,0), C0,8); \
    KRD(GL,1); GAPB(o[1]=__builtin_amdgcn_mfma_f32_32x32x16_bf16(PAF(1),VFR(5),o[1],0,0,0), C0,12); \
    KRD(GL,2); GAPB(o[0]=__builtin_amdgcn_mfma_f32_32x32x16_bf16(PAF(2),VFR(2),o[0],0,0,0), C1,0); \
    KRD(GL,3); GAPB(o[1]=__builtin_amdgcn_mfma_f32_32x32x16_bf16(PAF(2),VFR(6),o[1],0,0,0), C1,4); \
    GAPB(o[0]=__builtin_amdgcn_mfma_f32_32x32x16_bf16(PAF(3),VFR(3),o[0],0,0,0), C1,8); \
    GAPB(o[1]=__builtin_amdgcn_mfma_f32_32x32x16_bf16(PAF(3),VFR(7),o[1],0,0,0), C1,12); \
    }while(0)
  int t=1;
  #undef CMASK
  #define CMASK(P0,P1,t) do{}while(0)
  for(;t+5<NT;t+=2){
    STEP(pB0,pB1,pA0,pA1,t,true,true,true);     WAIT_BAR(2); RESC(); ROT();
    STEP(pA0,pA1,pB0,pB1,t+1,true,true,true);   WAIT_BAR(2); RESC(); ROT();
  }
  #undef CMASK
  #define CMASK(P0,P1,t) do{}while(0)
  #define ENDW(tt) do{ if((tt)+3<NT){WAIT_BAR(2);} else if((tt)+2<NT){WAIT_BAR(1);} else {WAIT_BAR(0);} }while(0)
  for(;t+1<NT;t+=2){
    STEP(pB0,pB1,pA0,pA1,t,(t+3<NT),(t+1<NT),(t+1<NT));       ENDW(t);   RESC(); ROT();
    STEP(pA0,pA1,pB0,pB1,t+1,(t+4<NT),(t+2<NT),(t+2<NT));     ENDW(t+1); RESC(); ROT();
  }
  STEP(pB0,pB1,pA0,pA1,NT-1,false,false,false); RESC();
  { float sacc=pB0[0]+pB0[1]; _Pragma("unroll") for(int r=2;r<16;++r)sacc+=pB0[r]; _Pragma("unroll") for(int r=0;r<16;++r)sacc+=pB1[r]; l_reg+=sacc;
    pw0=(u32x4){PKW(pB0,0),PKW(pB0,2),PKW(pB0,4),PKW(pB0,6)};pw1=(u32x4){PKW(pB0,8),PKW(pB0,10),PKW(pB0,12),PKW(pB0,14)};pw2=(u32x4){PKW(pB1,0),PKW(pB1,2),PKW(pB1,4),PKW(pB1,6)};pw3=(u32x4){PKW(pB1,8),PKW(pB1,10),PKW(pB1,12),PKW(pB1,14)};
    SBAR(); pv(o,vb0+sl_cur,PAF(0),PAF(1),PAF(2),PAF(3)); }
  #undef PKW
  #undef PAF
  #undef VFR
  #undef PIN
  #undef MX3
  #undef GAPA
  #undef GAPB
  #undef EX
  #undef VRD
  #undef KRD
  #undef STEP
  #undef ENDW
  {auto rr=__builtin_amdgcn_permlane32_swap(__float_as_uint(l_reg),__float_as_uint(l_reg),false,false);l_reg=__uint_as_float(rr[0])+__uint_as_float(rr[1]);}
  if(hi==0)wsf[32+r32]=l_reg;asm volatile("s_waitcnt lgkmcnt(0)":::"memory");
  float rli[16];
  #pragma unroll
  for(int r=0;r<16;++r)rli[r]=__builtin_amdgcn_rcpf(wsf[32+crow(r,hi)]);
  bf16*Ow=O+(rowbase+q0+wid*QBLK)*DM+h*D;
  { bf16*stg=(bf16*)(shm+LDS_OST)+wid*2048;
    #pragma unroll
    for(int r=0;r<16;++r){const int orow=crow(r,hi);
      #pragma unroll
      for(int d0=0;d0<2;++d0)stg[orow*64+d0*32+r32]=__float2bfloat16(o[d0][r]*rli[r]);}
    asm volatile("s_waitcnt lgkmcnt(0)":::"memory");
    #pragma unroll
    for(int i=0;i<4;++i){const int row=i*8+(lane>>3),ch=lane&7; const u32x4 v=*(const u32x4*)(stg+row*64+ch*8); ATTN_STORE16(Ow+(long)row*DM+ch*8,v);} }
  asm volatile("s_waitcnt lgkmcnt(0)\n\ts_barrier":::"memory");
  #undef DMA_K
  #undef DMA_V
  #undef CMASK
  #undef START
  #undef RESC
  #undef ROT
}
constexpr int ATTN_LDS_BYTES=LDS_BYTES;
struct AttnTensors { const bf16* Q; const bf16* K; const bf16* V; bf16* O; };
struct AttnUnit { int bh; int qb; };
struct StaticOrder {
  int vcu, per;
  __device__ __forceinline__ explicit StaticOrder(int grid,int vcu_):vcu(vcu_),per((BATCH*NHEAD*(SEQ/QB)+grid-1)/grid){}
  __device__ __forceinline__ bool next(int i,AttnUnit&u)const{ if(i>=per)return false; const int idx=vcu*per+i; if(idx>=BATCH*NHEAD*(SEQ/QB))return false; u.bh=idx/(SEQ/QB); u.qb=idx%(SEQ/QB); return true; }
  __device__ __forceinline__ void a_ready(const AttnUnit&)const{}
  __device__ __forceinline__ void done(const AttnUnit&)const{}
};
template<class Sched,int THRL=8> __device__ __forceinline__ void attn_phase(char*lds,const AttnTensors&T,const Sched&S){
  AttnUnit u;
  for(int i=0;S.next(i,u);++i){ S.a_ready(u); attn_unit<THRL>(u.bh/NHEAD,u.bh%NHEAD,u.qb,T.Q,T.K,T.V,T.O,lds); S.done(u); }
}
#undef SBAR
#undef WAIT_BAR
}

__device__ __forceinline__ void phase_attn_fast(ArgsP a, const Fr& F) {
    const attn_body::AttnTensors AT{(const attn_body::bf16*)(a->ws + SC_Q), (const attn_body::bf16*)(a->ws + SC_K), (const attn_body::bf16*)(a->ws + SC_V), (attn_body::bf16*)(a->ws + SC_O)};
    const attn_body::StaticOrder S(F.G, F.vcu);
    __syncthreads();
    attn_body::attn_phase<attn_body::StaticOrder>((char*)F.lds, AT, S);
    __syncthreads();
}
__device__ __forceinline__ void phase_sp_fast(ArgsP a, const Fr& F) {
    typedef short bf16x8 __attribute__((ext_vector_type(8)));
    constexpr int PITCH = 136;
    LAS unsigned short* As = (LAS unsigned short*)F.lds;
    LAS unsigned short* Bs = As + 128 * PITCH;
    LAS float* st = (LAS float*)(Bs + 128 * PITCH);
    const float* VT = (const float*)(a->ws + SC_VT); const f32x2* VST = (const f32x2*)(a->ws + SC_VST); const bf16* UB = (const bf16*)(a->ws + SC_UB); bf16* UV = (bf16*)(a->ws + SC_UV);
    const bf16* WS = (const bf16*)(a->ws + WS_WCMS);
    const float* lng = a->in[I_CMLNG]; const float* lnb = a->in[I_CMLNB]; const float* bs = a->in[I_CMBS];
    const int tid = F.tid, lane = F.lane, wid = F.wave, wr = wid >> 2, wc = wid & 3, fr = lane & 15, fq = lane >> 4;
    const int per = (2048 + F.G - 1) / F.G; int gl = -1;
    for (int it = F.vcu * per; it < (F.vcu + 1) * per && it < 2048; ++it) {
        const int g = it >> 7, n = it & 127;
        __syncthreads();
        if (g != gl) { gl = g;
#pragma unroll
            for (int q = 0; q < 4; ++q) { const int idx = tid + q * NTHR, t = idx >> 4, ck = idx & 15;
                *(LAS v4u*)(As + t * PITCH + ck * 8) = *(const v4u*)(WS + (size_t)g * 16384 + t * 128 + ck * 8); } }
        if (tid < 128) { float s1 = 0.f, s2 = 0.f;
#pragma unroll
            for (int p = 0; p < 16; ++p) { const f32x2 v = VST[(size_t)p * T + n * 128 + tid]; s1 += v.x; s2 += v.y; }
            const float mean = s1 * (1.0f / 2048.0f); const float var = s2 * (1.0f / 2048.0f) - mean * mean; st[tid * 2] = mean; st[tid * 2 + 1] = 1.0f / sqrtf(var + LN_EPS); }
        __syncthreads();
        { const int s4 = (lane & 31) * 4; const int ch = lane >> 5;
          const f32x4 mu = {st[(s4 + 0) * 2], st[(s4 + 1) * 2], st[(s4 + 2) * 2], st[(s4 + 3) * 2]};
          const f32x4 rs = {st[(s4 + 0) * 2 + 1], st[(s4 + 1) * 2 + 1], st[(s4 + 2) * 2 + 1], st[(s4 + 3) * 2 + 1]};
#pragma unroll
          for (int q = 0; q < 8; ++q) { const int c = q * 16 + wid * 2 + ch; const int chn = g * 128 + c;
              const f32x4 v = *(const f32x4*)(VT + (size_t)chn * T + n * 128 + s4);
              const float lg = lng[chn], lb = lnb[chn];
              const f32x4 y = (v - mu) * rs * lg + lb;
              v2u o; o.x = pk2(y[0], y[1]); o.y = pk2(y[2], y[3]); *(LAS v2u*)(Bs + c * PITCH + s4) = o; } }
        __syncthreads();
        f32x4 acc[4][2];
#pragma unroll
        for (int m = 0; m < 4; ++m)
#pragma unroll
            for (int nn = 0; nn < 2; ++nn) acc[m][nn] = (f32x4){0.f, 0.f, 0.f, 0.f};
#pragma unroll
        for (int k = 0; k < 4; ++k) {
            bf16x8 af[4], bfr[2];
#pragma unroll
            for (int m = 0; m < 4; ++m) af[m] = *(const LAS bf16x8*)(As + (wr * 64 + m * 16 + fr) * PITCH + k * 32 + fq * 8);
#pragma unroll
            for (int nn = 0; nn < 2; ++nn) bfr[nn] = *(const LAS bf16x8*)(Bs + (wc * 32 + nn * 16 + fr) * PITCH + k * 32 + fq * 8);
#pragma unroll
            for (int m = 0; m < 4; ++m)
#pragma unroll
                for (int nn = 0; nn < 2; ++nn) acc[m][nn] = __builtin_amdgcn_mfma_f32_16x16x32_bf16(bfr[nn], af[m], acc[m][nn], 0, 0, 0);
        }
#pragma unroll
        for (int m = 0; m < 4; ++m) { const int t = wr * 64 + m * 16 + fr; const float bt = bs[g * 128 + t];
#pragma unroll
            for (int nn = 0; nn < 2; ++nn) { const size_t idx = (size_t)(n * 128 + t) * 2048 + g * 128 + wc * 32 + nn * 16 + 4 * fq;
                const v2u ub = *(const v2u*)(UB + idx); const f32x4 o = acc[m][nn] + bt;
                v2u w; w.x = pk2(__builtin_bit_cast(float, ub.x << 16) * o[0], __builtin_bit_cast(float, ub.x & 0xffff0000u) * o[1]);
                w.y = pk2(__builtin_bit_cast(float, ub.y << 16) * o[2], __builtin_bit_cast(float, ub.y & 0xffff0000u) * o[3]);
                *(v2u*)(UV + idx) = w; } }
    }
}
__device__ __forceinline__ void phase_rope(ArgsP a, const Fr& F) {
    const float* QKV = (const float*)(a->ws + SC_QKV); bf16* Q = (bf16*)(a->ws + SC_Q); bf16* K = (bf16*)(a->ws + SC_K); bf16* V = (bf16*)(a->ws + SC_V);
    const int gw = F.vcu * NWAVES + F.wave, NGW = F.G * NWAVES;
    const int i = F.lane & 31, hs = F.lane >> 5;
    const float qg0 = a->in[I_QGAIN][i], qg1 = a->in[I_QGAIN][i + 32], kg0 = a->in[I_KGAIN][i], kg1 = a->in[I_KGAIN][i + 32];
    const float invf = powf(10000.0f, -(float)(i & 15) / 16.0f);
    for (int row = gw; row < TA; row += NGW) {
        const bool lat = row < T; const int b = lat ? (row >> 12) : ((row - T) >> 8); const int t = lat ? (row & 4095) : ((row - T) & 255);
        float cs = 1.f, sn = 0.f;
        if (lat) { const float pos = (i < 16) ? (float)(t >> 6) : (float)(t & 63); sincosf(pos * invf, &sn, &cs); }
        const float* src = QKV + (size_t)row * 1536;
        const size_t krow = (size_t)b * LK + (lat ? LC + t : t);
#pragma unroll
        for (int j = 0; j < 12; ++j) { const int hh = 2 * j + hs;
            if (!lat && hh < 16) continue;
            const float x1 = src[hh * 64 + i], x2 = src[hh * 64 + 32 + i];
            if (hh < 20) {
                float ss = x1 * x1 + x2 * x2;
#pragma unroll
                for (int o = 1; o < 32; o <<= 1) ss += __shfl_xor(ss, o);
                const float rs = 1.0f / sqrtf(ss * (1.0f / 64.0f) + RMS_EPS);
                const bool isq = hh < 16;
                const float n1 = x1 * rs * (isq ? qg0 : kg0), n2 = x2 * rs * (isq ? qg1 : kg1);
                float o1 = n1 * cs - n2 * sn, o2 = n1 * sn + n2 * cs;
                if (isq) { o1 *= ATT_C2; o2 *= ATT_C2; bf16* d = Q + (size_t)row * 1024 + hh * 64; d[i] = (bf16)f2bf(o1); d[i + 32] = (bf16)f2bf(o2); }
                else { bf16* d = K + krow * KVP + (hh - 16) * 64; d[i] = (bf16)f2bf(o1); d[i + 32] = (bf16)f2bf(o2); }
            } else { bf16* d = V + krow * KVP + (hh - 20) * 64; d[i] = (bf16)f2bf(x1); d[i + 32] = (bf16)f2bf(x2); }
        }
    }
}
__device__ __forceinline__ void phase_attn_simple(ArgsP a, const Fr& F) {
    const bf16* Q = (const bf16*)(a->ws + SC_Q); const bf16* K = (const bf16*)(a->ws + SC_K); const bf16* V = (const bf16*)(a->ws + SC_V); bf16* O = (bf16*)(a->ws + SC_O);
    for (int it = F.vcu; it < 512; it += F.G) {
        const int b = it >> 7, h = (it >> 3) & 15, q = (it & 7) * 512 + F.tid;
        const bf16* qp = Q + (size_t)(b * SEQ + q) * 1024 + h * 64;
        float qv[64], o[64];
#pragma unroll
        for (int d = 0; d < 64; ++d) { qv[d] = bf2f(qp[d]); o[d] = 0.f; }
        float m = -3.0e38f, l = 0.f;
        const bf16* kb = K + (size_t)b * LK * KVP + (h >> 2) * 64; const bf16* vb = V + (size_t)b * LK * KVP + (h >> 2) * 64;
        for (int s = 0; s < LK; ++s) {
            const v4u* kr = (const v4u*)(kb + (size_t)s * KVP); float sc = 0.f;
#pragma unroll
            for (int c = 0; c < 8; ++c) { const v4u kv = kr[c]; const unsigned w[4] = {kv.x, kv.y, kv.z, kv.w};
#pragma unroll
                for (int j = 0; j < 4; ++j) { sc += qv[c * 8 + 2 * j] * __builtin_bit_cast(float, w[j] << 16) + qv[c * 8 + 2 * j + 1] * __builtin_bit_cast(float, w[j] & 0xffff0000u); } }
            const float mn = fmaxf(m, sc); const float al = exp2f(m - mn), p = exp2f(sc - mn); l = l * al + p; m = mn;
            const v4u* vr = (const v4u*)(vb + (size_t)s * KVP);
#pragma unroll
            for (int c = 0; c < 8; ++c) { const v4u vv = vr[c]; const unsigned w[4] = {vv.x, vv.y, vv.z, vv.w};
#pragma unroll
                for (int j = 0; j < 4; ++j) { o[c * 8 + 2 * j] = o[c * 8 + 2 * j] * al + p * __builtin_bit_cast(float, w[j] << 16); o[c * 8 + 2 * j + 1] = o[c * 8 + 2 * j + 1] * al + p * __builtin_bit_cast(float, w[j] & 0xffff0000u); } }
        }
        const float il = 1.0f / l; bf16* op = O + (size_t)(b * SEQ + q) * 1024 + h * 64;
#pragma unroll
        for (int c = 0; c < 8; ++c) { v4u w; w.x = pk2(o[c * 8] * il, o[c * 8 + 1] * il); w.y = pk2(o[c * 8 + 2] * il, o[c * 8 + 3] * il); w.z = pk2(o[c * 8 + 4] * il, o[c * 8 + 5] * il); w.w = pk2(o[c * 8 + 6] * il, o[c * 8 + 7] * il);
            *(v4u*)(op + c * 8) = w; }
    }
}
__device__ __forceinline__ void phase_sp_simple(ArgsP a, const Fr& F) {
    LAS float* wsL = (LAS float*)F.lds;
    LAS float* vl = wsL + 128 * 128;
    LAS float* st = vl + 128 * 128;
    const float* VT = (const float*)(a->ws + SC_VT); const f32x2* VST = (const f32x2*)(a->ws + SC_VST); const bf16* UB = (const bf16*)(a->ws + SC_UB); bf16* UV = (bf16*)(a->ws + SC_UV);
    const int per = (2048 + F.G - 1) / F.G; int gl = -1;
    for (int it = F.vcu * per; it < (F.vcu + 1) * per && it < 2048; ++it) {
        const int g = it >> 7, n = it & 127;
        __syncthreads();
        if (g != gl) { for (int u = F.tid; u < 128 * 128; u += NTHR) wsL[u] = a->in[I_CMWS][(size_t)g * 16384 + u]; gl = g; }
        if (F.tid < 128) { float s1 = 0.f, s2 = 0.f; for (int p = 0; p < 16; ++p) { const f32x2 v = VST[(size_t)p * T + n * 128 + F.tid]; s1 += v.x; s2 += v.y; }
            const float mean = s1 * (1.0f / 2048.0f); const float var = s2 * (1.0f / 2048.0f) - mean * mean; st[F.tid * 2] = mean; st[F.tid * 2 + 1] = 1.0f / sqrtf(var + LN_EPS); }
        __syncthreads();
        for (int u = F.tid; u < 128 * 128; u += NTHR) { const int c = u >> 7, s = u & 127; const int ch = g * 128 + c;
            const float v = VT[(size_t)ch * T + n * 128 + s]; vl[s * 128 + c] = (v - st[s * 2]) * st[s * 2 + 1] * a->in[I_CMLNG][ch] + a->in[I_CMLNB][ch]; }
        __syncthreads();
        const int c = F.tid & 127, tq = F.tid >> 7;
        for (int jj = 0; jj < 32; ++jj) { const int t = tq + 4 * jj; float acc = 0.f;
            for (int s = 0; s < 128; ++s) acc += wsL[t * 128 + s] * vl[s * 128 + c];
            acc += a->in[I_CMBS][g * 128 + t];
            const size_t idx = (size_t)(n * 128 + t) * 2048 + g * 128 + c;
            UV[idx] = (bf16)f2bf(bf2f(UB[idx]) * acc); }
    }
}
#ifndef MK_FAST_CONV
#define MK_FAST_CONV 0
#endif
#ifndef MK_FAST_ATTN
#define MK_FAST_ATTN 0
#endif
#ifndef MK_FAST_SP
#define MK_FAST_SP 0
#endif
#ifndef MK_GATHER
#define MK_GATHER 0
#endif
constexpr int MOE_PH = MK_GATHER ? 5 : 6;
constexpr int N_PHASES = 2 + (4 + MOE_PH) + (4 + MOE_PH) + (3 + MOE_PH) + (4 + MOE_PH);

#ifndef MK_REPMASK
#define MK_REPMASK 0ull
#endif
#ifndef MK_REPN
#define MK_REPN 3
#endif
#define REPS for (int rep_ = 0; rep_ < (((MK_REPMASK >> p) & 1ull) ? MK_REPN : 1); ++rep_)
#define IN() (get_args()->ph_lo <= p && p < get_args()->ph_hi)
#define PHB ArgsP a = get_args(); unsigned char* ws = a->ws; (void)ws; const Fr F = mkfr(lds_raw);
#define SEAM() do { { ArgsP a__ = get_args(); if (a__->ph_lo <= p && p + 1 < a__->ph_hi) { XcdBarrier bb; bb.bar = (unsigned*)(a__->ws + WS_CTL) + 4096; bb.x = xb_xcc_id(); \
        bb.st = (volatile LAS unsigned*)((LAS unsigned char*)lds_raw + MISC_OFF) + 8; xcd_barrier(bb); } } ++p; } while (0)
template <int layer> __device__ __forceinline__ void layer_body(int& p, unsigned char* lds_raw) {
    PG8_LAS unsigned char* ring = (PG8_LAS unsigned char*)lds_raw;
        constexpr int kind = layer % 3;
        const int nrows = layer == 0 ? TA : T;
#define G1PTR ((const float*)(ws + WS_MOD) + (size_t)layer * 5 * 6144 + 2048)
        if constexpr (kind == 0) {
            const int slot = layer == 0 ? 0 : 1;
            REPS if (IN()) { PHB pg8::Gemm g{(const pg8::bf16_t*)(ws + WS_WHYIN) + (size_t)slot * 3072 * 1024, (const pg8::bf16_t*)(ws + WS_HB), 3072, nrows, 1024, nullptr};
                pg8::StaticOrder S; S.init(3072, nrows, F.G, F.bx); pg8::EpiBf16<0> E{(pg8::bf16_t*)(ws + SC_PT), TA, nullptr, 0, 0, 1.f};
                pg8::gemm_phase<pg8::EpiBf16<0>, pg8::StaticOrder, true, false>(ring, g, S, E); }
            SEAM();
            REPS if (IN()) { PHB
#if MK_FAST_CONV
                phase_hy_conv_fft(a, F, layer);
#else
                phase_hy_conv_direct(a, F, layer);
#endif
            }
            SEAM();
            REPS if (IN()) { PHB phase_hy_tr(a, F, nrows); }
            SEAM();
            REPS if (IN()) { PHB pg8::Gemm g{(const pg8::bf16_t*)(ws + SC_Z2), (const pg8::bf16_t*)(ws + WS_WHYOUT) + (size_t)slot * 1024 * 1024, nrows, 1024, 1024, nullptr};
                pg8::StaticOrder S; S.init(nrows, 1024, F.G, F.bx); pg8::EpiRes E{(const float*)(ws + WS_XC), (float*)(ws + WS_U), G1PTR, 6144, ALPHA};
                pg8::gemm_phase<pg8::EpiRes, pg8::StaticOrder, true, false>(ring, g, S, E); }
            SEAM();
        } else if constexpr (kind == 1) {
            REPS if (IN()) { PHB pg8::Gemm g{(const pg8::bf16_t*)(ws + WS_HB), (const pg8::bf16_t*)(ws + WS_WQKV), TA, 1536, 1024, nullptr};
                pg8::StaticOrder S; S.init(TA, 1536, F.G, F.bx); pg8::EpiF32 E{(float*)(ws + SC_QKV), 1536};
                pg8::gemm_phase<pg8::EpiF32, pg8::StaticOrder, true, false>(ring, g, S, E); }
            SEAM();
            REPS if (IN()) { PHB phase_rope(a, F); }
            SEAM();
            REPS if (IN()) { PHB
#if MK_FAST_ATTN
                phase_attn_fast(a, F);
#else
                phase_attn_simple(a, F);
#endif
            }
            SEAM();
            REPS if (IN()) { PHB pg8::Gemm g{(const pg8::bf16_t*)(ws + SC_O), (const pg8::bf16_t*)(ws + WS_WATO), T, 1024, 1024, nullptr};
                pg8::StaticOrder S; S.init(T, 1024, F.G, F.bx); pg8::EpiRes E{(const float*)(ws + WS_XC), (float*)(ws + WS_U), G1PTR, 6144, ALPHA};
                pg8::gemm_phase<pg8::EpiRes, pg8::StaticOrder, true, false>(ring, g, S, E); }
            SEAM();
        } else {
            REPS if (IN()) {
                { PHB pg8::Gemm g{(const pg8::bf16_t*)(ws + WS_HB), (const pg8::bf16_t*)(ws + WS_WCMIN), T, 2048, 1024, nullptr};
                  pg8::StaticOrder S; S.init(T, 2048, F.G, F.bx); pg8::EpiBf16<1> E{(pg8::bf16_t*)(ws + SC_UB), 2048, nullptr, 0, 0, 1.f};
                  pg8::gemm_phase<pg8::EpiBf16<1>, pg8::StaticOrder, true, false>(ring, g, S, E); }
                { PHB pg8::Gemm g{(const pg8::bf16_t*)(ws + WS_WCMIN) + (size_t)2048 * 1024, (const pg8::bf16_t*)(ws + WS_HB), 2048, T, 1024, nullptr};
                  pg8::StaticOrder S; S.init(2048, T, F.G, F.bx); pg8::EpiVT E{(float*)(ws + SC_VT), T, (pg8::f32x2*)(ws + SC_VST), T};
                  pg8::gemm_phase<pg8::EpiVT, pg8::StaticOrder, true, false>(ring, g, S, E); }
            }
            SEAM();
            REPS if (IN()) { PHB
#if MK_FAST_SP
                phase_sp_fast(a, F);
#else
                phase_sp_simple(a, F);
#endif
            }
            SEAM();
            REPS if (IN()) { PHB pg8::Gemm g{(const pg8::bf16_t*)(ws + SC_UV), (const pg8::bf16_t*)(ws + WS_WCMOUT), T, 1024, 2048, nullptr};
                pg8::StaticOrder S; S.init(T, 1024, F.G, F.bx); pg8::EpiRes E{(const float*)(ws + WS_XC), (float*)(ws + WS_U), G1PTR, 6144, ALPHA};
                pg8::gemm_phase<pg8::EpiRes, pg8::StaticOrder, true, false>(ring, g, S, E); }
            SEAM();
        }
        REPS if (IN()) { PHB phase_lnr(a, F, layer, nrows); }
        SEAM();
        REPS if (IN()) { PHB phase_topk(a, F, layer); }
        SEAM();
        const int npm = layer == 0 ? 9 : 8;
#if MK_GATHER
        REPS if (IN()) { PHB pg8::Gemm g{(const pg8::bf16_t*)(ws + WS_HB), (const pg8::bf16_t*)(ws + WS_WGU) + (size_t)layer * 16 * 4096 * 1024, 0, 0, 1024, (const int*)(ws + WS_ROWS)};
            pg8::MoeOrder S{npm, 16, F.G, F.vcu}; pg8::EpiGU E{(pg8::bf16_t*)(ws + WS_ACT), 16};
            pg8::gemm_phase<pg8::EpiGU, pg8::MoeOrder, true, true>(ring, g, S, E); }
        SEAM();
#else
        REPS if (IN()) { PHB phase_gather(a, F, layer); }
        SEAM();
        REPS if (IN()) { PHB pg8::Gemm g{(const pg8::bf16_t*)(ws + WS_XG), (const pg8::bf16_t*)(ws + WS_WGU) + (size_t)layer * 16 * 4096 * 1024, 0, 0, 1024, nullptr};
            pg8::MoeOrder S{npm, 16, F.G, F.vcu}; pg8::EpiGU E{(pg8::bf16_t*)(ws + WS_ACT), 16};
            pg8::gemm_phase<pg8::EpiGU, pg8::MoeOrder, true, false>(ring, g, S, E); }
        SEAM();
#endif
        REPS if (IN()) { PHB pg8::Gemm g{(const pg8::bf16_t*)(ws + WS_ACT), (const pg8::bf16_t*)(ws + WS_WDN) + (size_t)layer * 16 * 1024 * 2048, 0, 0, 2048, nullptr};
            pg8::MoeOrder S{npm, 4, F.G, F.vcu}; pg8::EpiDN E{(pg8::bf16_t*)(ws + WS_Y), (const float*)(ws + WS_GATE), 4};
            pg8::gemm_phase<pg8::EpiDN, pg8::MoeOrder, true, false>(ring, g, S, E); }
        SEAM();
        REPS if (IN()) { PHB phase_comb(a, F, layer, nrows); }
        SEAM();
    }
__global__ void __launch_bounds__(NTHR, 2) mk_fwd(Args a_) {
    extern __shared__ __attribute__((aligned(16))) unsigned char lds_raw[];
    Fr F0 = mkfr(lds_raw);
    volatile LAS unsigned* MISC = (volatile LAS unsigned*)(F0.lds + MISC_OFF);
    if (F0.tid < 32) MISC[F0.tid] = 0u;
    __syncthreads();
    if (a_.ph_hi - a_.ph_lo > 1) (void)xcd_barrier_post((unsigned*)(a_.ws + WS_CTL) + 4096, MISC + 8);
    int p = 0;
    PG8_LAS unsigned char* ring = (PG8_LAS unsigned char*)lds_raw;

    REPS if (IN()) { PHB phase_proA(a, F); }
    SEAM();
    REPS if (IN()) { PHB phase_proB(a, F); }
    SEAM();
    layer_body<0>(p, lds_raw); layer_body<1>(p, lds_raw); layer_body<2>(p, lds_raw); layer_body<3>(p, lds_raw);
#undef IN
#undef PHB
#undef G1PTR
#undef SEAM
}

#ifndef MK_N_LAUNCHES
#define MK_N_LAUNCHES 0
#endif
extern "C" void kernel_launch(void* const* d_in, const int* in_sizes, int n_in, void* d_out, int out_size, void* d_ws, size_t ws_size, hipStream_t stream) {
    static int grid = 0;
    if (grid == 0) {
        if (n_in != 33 || out_size != T * D || ws_size < WS_END) { fprintf(stderr, "kernel_launch: expected 33 inputs, %d outputs, >= %zu bytes of workspace; got %d, %d, %zu\n", T * D, (size_t)WS_END, n_in, out_size, ws_size); grid = -1; return; }
        int dev = 0, cus = 0, per_cu = 0;
        if (hipGetDevice(&dev) != hipSuccess || hipDeviceGetAttribute(&cus, hipDeviceAttributeMultiprocessorCount, dev) != hipSuccess) { grid = -1; return; }
        if (hipFuncSetAttribute((const void*)mk_fwd, hipFuncAttributeMaxDynamicSharedMemorySize, LDS_BYTES) != hipSuccess) { fprintf(stderr, "kernel_launch: hipFuncSetAttribute failed\n"); grid = -1; return; }
        if (hipOccupancyMaxActiveBlocksPerMultiprocessor(&per_cu, (const void*)mk_fwd, NTHR, LDS_BYTES) != hipSuccess || per_cu < 1)
            fprintf(stderr, "kernel_launch: note: occupancy query reports %d workgroups per CU\n", per_cu);
        (void)hipGetLastError();
        grid = cus;
    }
    if (grid < 0) return;
    (void)hipMemsetAsync((char*)d_ws + WS_CTL, 0, 1 * MiB, stream);
    Args a{};
    for (int i = 0; i < 33; ++i) a.in[i] = (const float*)d_in[i];
    a.out = (float*)d_out; a.ws = (unsigned char*)d_ws;
#if MK_N_LAUNCHES == 1
    a.ph_lo = 0; a.ph_hi = N_PHASES;
    hipLaunchKernelGGL(mk_fwd, dim3(grid), dim3(NTHR), LDS_BYTES, stream, a);
#else
    for (int p = 0; p < N_PHASES; ++p) { a.ph_lo = p; a.ph_hi = p + 1; hipLaunchKernelGGL(mk_fwd, dim3(grid), dim3(NTHR), LDS_BYTES, stream, a); }
#endif
    const hipError_t le = hipPeekAtLastError();
    if (le != hipSuccess) fprintf(stderr, "kernel_launch: launch failed: %s\n", hipGetErrorName(le));
}
```

```cpp
#define MK_N_LAUNCHES 1
#define MK_FAST_ATTN 1
#define MK_FAST_CONV 1
#define MK_GATHER 1
#define MK_FAST_SP 1
#include <hip/hip_runtime.h>
#include <cstdio>
#include <cstdint>
#include <cmath>
namespace pg8 {
#define PG8_LAS __attribute__((address_space(3)))
typedef unsigned short bf16_t;
typedef short bf16x8 __attribute__((ext_vector_type(8)));
typedef float f32x4 __attribute__((ext_vector_type(4)));
typedef unsigned u32x4 __attribute__((ext_vector_type(4)));
constexpr int BM = 256, BK = 64, HALF = 128, HTB = HALF * BK * 2  , STAGE_BYTES = 8 * HTB, NXCD = 8, WGM = 8;

__host__ __device__ __forceinline__ int lds_byte(int r, int c) { const int st = (r >> 4) * 2 + (c >> 5), rr = r & 15, cc = c & 31, ob = rr * 64 + cc * 2; return st * 1024 + (ob ^ (((ob >> 9) & 1) << 5)); }
__host__ __device__ __forceinline__ void stage_rc(int b, int& R, int& C) { const int st = b / 1024, sb = b % 1024, swz = sb ^ (((sb >> 9) & 1) << 5); R = (st >> 1) * 16 + swz / 64; C = (st & 1) * 32 + (swz % 64) / 2; }
__host__ __device__ __forceinline__ int perm32(int rho) { const int n = rho >> 4, i = rho & 15; return 8 * (i >> 2) + 4 * n + (i & 3); }

struct Unit { int pm, pn; };
struct Gemm { const bf16_t* A; const bf16_t* Bt; int M, N, K; const int* rows; };

struct StaticOrder {
    int nM, nN, nwg, G, c;
    __host__ __device__ void init(int M, int N, int G_, int c_) { nM = M / BM; nN = N / BM; nwg = nM * nN; G = G_; c = c_; }
    __host__ __device__ bool next(int i, Unit& u) const {
        const long L = (long)i * G + c; if (L >= nwg) return false;
        int wgid = (int)L; { const int q = nwg / NXCD, r = nwg % NXCD, xcd = wgid % NXCD, off = wgid / NXCD; wgid = (xcd < r ? xcd * (q + 1) : r * (q + 1) + (xcd - r) * q) + off; }
        const int nig = WGM * nN, gid = wgid / nig, fm = gid * WGM, gsz = (nM - fm) < WGM ? (nM - fm) : WGM;
        u.pm = fm + ((wgid % nig) % gsz); u.pn = (wgid % nig) / gsz; return true;
    }
    __device__ __forceinline__ void a_ready(const Unit&) const {}
    __device__ __forceinline__ void done(const Unit&) const {}
};

__device__ __forceinline__ unsigned cvt_pk_bf16(float lo, float hi) { unsigned r; asm volatile("v_cvt_pk_bf16_f32 %0, %1, %2" : "=v"(r) : "v"(lo), "v"(hi)); return r; }
typedef float f32x2 __attribute__((ext_vector_type(2)));
__device__ __forceinline__ f32x2 gelu_pk(f32x2 v) {
    const f32x2 av = __builtin_elementwise_abs(v), d = av * 0.2316418882f + 1.0f;
    f32x2 t; t.x = __builtin_amdgcn_rcpf(d.x); t.y = __builtin_amdgcn_rcpf(d.y);
    f32x2 q = t * 0.5307027145f + (-0.7265760135f); q = q * t + 0.7107068705f; q = q * t + (-0.142248368f); q = q * t + 0.127414796f; q = q * t;
    const f32x2 s = (v * v) * (-0.72134752044f);
    f32x2 e; e.x = __builtin_amdgcn_exp2f(s.x); e.y = __builtin_amdgcn_exp2f(s.y);
    const f32x2 m = v * (q * e), r = v - m;
    f32x2 o; o.x = v.x < 0.f ? m.x : r.x; o.y = v.y < 0.f ? m.y : r.y; return o;
}

template <int ACT  > struct EpiBf16 {
    static constexpr bool PERM = true, AFTER_DRAIN = false; static_assert(ACT == 0 || ACT == 1, "EpiBf16: ACT is 0 (none) or 1 (gelu_pk)");
    bf16_t* O; int ldc; const float* bias; int split_cols; size_t split_stride; float scale0;
    __device__ __forceinline__ void operator()(const f32x4 (&acc)[2][2][4][2], const Unit& u, int wr, int wc, int fr, int fq) const {
        const int row0 = u.pm * BM + wr * 64 + fr; int colt = u.pn * BM; bf16_t* base = O;
        float sc = 1.f; if (split_cols) { const int t = colt / split_cols; base += (size_t)t * split_stride; colt -= t * split_cols; if (t == 0) sc = scale0; }
        const int col0 = colt + wc * 32 + 8 * fq, bcol0 = u.pn * BM + wc * 32 + 8 * fq;
        f32x4 bv[2][2];
#pragma unroll
        for (int bj = 0; bj < 2; ++bj)
#pragma unroll
            for (int n = 0; n < 2; ++n) bv[bj][n] = bias ? *(const f32x4*)(bias + bcol0 + bj * HALF + 4 * n) : (f32x4){0.f, 0.f, 0.f, 0.f};
#pragma unroll
        for (int ai = 0; ai < 2; ++ai)
#pragma unroll
            for (int m = 0; m < 4; ++m) { bf16_t* rowp = base + (size_t)(row0 + ai * HALF + m * 16) * ldc + col0;
#pragma unroll
                for (int bj = 0; bj < 2; ++bj) { f32x4 v0 = acc[ai][bj][m][0] + bv[bj][0], v1 = acc[ai][bj][m][1] + bv[bj][1];
                    if (ACT == 1) { f32x2 a = gelu_pk((f32x2){v0[0], v0[1]}), b = gelu_pk((f32x2){v0[2], v0[3]}), c = gelu_pk((f32x2){v1[0], v1[1]}), d = gelu_pk((f32x2){v1[2], v1[3]});
                        v0 = (f32x4){a.x, a.y, b.x, b.y}; v1 = (f32x4){c.x, c.y, d.x, d.y}; }
                    v0 = v0 * sc; v1 = v1 * sc; u32x4 w; w.x = cvt_pk_bf16(v0[0], v0[1]); w.y = cvt_pk_bf16(v0[2], v0[3]); w.z = cvt_pk_bf16(v1[0], v1[1]); w.w = cvt_pk_bf16(v1[2], v1[3]);
                    *(u32x4*)(rowp + bj * HALF) = w; } }
    }
};

struct EpiF32 {
    static constexpr bool PERM = false, AFTER_DRAIN = false;
    float* C; int ldc;
    __device__ __forceinline__ void operator()(const f32x4 (&acc)[2][2][4][2], const Unit& u, int wr, int wc, int fr, int fq) const {
        const int row0 = u.pm * BM + wr * 64 + fr, col0 = u.pn * BM + wc * 32 + 4 * fq;
#pragma unroll
        for (int ai = 0; ai < 2; ++ai)
#pragma unroll
            for (int m = 0; m < 4; ++m) { float* rowp = C + (size_t)(row0 + ai * HALF + m * 16) * ldc + col0;
#pragma unroll
                for (int bj = 0; bj < 2; ++bj)
#pragma unroll
                    for (int n = 0; n < 2; ++n) *(f32x4*)(rowp + bj * HALF + n * 16) = acc[ai][bj][m][n]; }
    }
};
struct EpiRes {
    static constexpr bool PERM = false, AFTER_DRAIN = false;
    const float* X; float* U; const float* g; int gstride; float alpha;
    __device__ __forceinline__ void operator()(const f32x4 (&acc)[2][2][4][2], const Unit& u, int wr, int wc, int fr, int fq) const {
        const int row0 = u.pm * BM + wr * 64 + fr, col0 = u.pn * BM + wc * 32 + 4 * fq;
        const int rb = u.pm * BM; const int bidx = rb < 16384 ? (rb >> 12) : 4;
        const float* gp = g + (size_t)bidx * gstride + col0;
        f32x4 gv[2][2];
#pragma unroll
        for (int bj = 0; bj < 2; ++bj)
#pragma unroll
            for (int n = 0; n < 2; ++n) gv[bj][n] = *(const f32x4*)(gp + bj * HALF + n * 16);
#pragma unroll
        for (int ai = 0; ai < 2; ++ai)
#pragma unroll
            for (int m = 0; m < 4; ++m) { const size_t off = (size_t)(row0 + ai * HALF + m * 16) * 1024 + col0;
#pragma unroll
                for (int bj = 0; bj < 2; ++bj)
#pragma unroll
                    for (int n = 0; n < 2; ++n) { const f32x4 xv = *(const f32x4*)(X + off + bj * HALF + n * 16);
                        *(f32x4*)(U + off + bj * HALF + n * 16) = xv * alpha + gv[bj][n] * acc[ai][bj][m][n]; }
                asm volatile("" ::: "memory"); }
    }
};
struct EpiGU {
    static constexpr bool PERM = true, AFTER_DRAIN = false;
    bf16_t* ACT; int npn;
    __device__ __forceinline__ void operator()(const f32x4 (&acc)[2][2][4][2], const Unit& u, int wr, int wc, int fr, int fq) const {
        const int row0 = u.pm * BM + wr * 64 + fr; const int col0 = (u.pn % npn) * 128 + wc * 32 + 8 * fq;
#pragma unroll
        for (int ai = 0; ai < 2; ++ai)
#pragma unroll
            for (int m = 0; m < 4; ++m) { bf16_t* rowp = ACT + (size_t)(row0 + ai * HALF + m * 16) * 2048 + col0;
                float o[8];
#pragma unroll
                for (int n = 0; n < 2; ++n)
#pragma unroll
                    for (int j = 0; j < 4; ++j) { const float a = acc[ai][0][m][n][j], b = acc[ai][1][m][n][j];
                        const float s = a * __builtin_amdgcn_rcpf(1.0f + __builtin_amdgcn_exp2f(-1.4426950408889634f * a)); o[n * 4 + j] = s * b; }
                u32x4 w; w.x = cvt_pk_bf16(o[0], o[1]); w.y = cvt_pk_bf16(o[2], o[3]); w.z = cvt_pk_bf16(o[4], o[5]); w.w = cvt_pk_bf16(o[6], o[7]);
                *(u32x4*)rowp = w; }
    }
};
struct EpiDN {
    static constexpr bool PERM = true, AFTER_DRAIN = false;
    bf16_t* Y; const float* gate; int npn;
    __device__ __forceinline__ void operator()(const f32x4 (&acc)[2][2][4][2], const Unit& u, int wr, int wc, int fr, int fq) const {
        const int row0 = u.pm * BM + wr * 64 + fr, col0 = (u.pn % npn) * BM + wc * 32 + 8 * fq;
#pragma unroll
        for (int ai = 0; ai < 2; ++ai)
#pragma unroll
            for (int m = 0; m < 4; ++m) { const int row = row0 + ai * HALF + m * 16; const float gt = gate[row]; bf16_t* rowp = Y + (size_t)row * 1024 + col0;
#pragma unroll
                for (int bj = 0; bj < 2; ++bj) { const f32x4 v0 = acc[ai][bj][m][0] * gt, v1 = acc[ai][bj][m][1] * gt;
                    u32x4 w; w.x = cvt_pk_bf16(v0[0], v0[1]); w.y = cvt_pk_bf16(v0[2], v0[3]); w.z = cvt_pk_bf16(v1[0], v1[1]); w.w = cvt_pk_bf16(v1[2], v1[3]);
                    *(u32x4*)(rowp + bj * HALF) = w; } }
    }
};
struct EpiVT {
    static constexpr bool PERM = false, AFTER_DRAIN = false;
    float* VT; int ldc; f32x2* VST; int ntok;
    __device__ __forceinline__ void operator()(const f32x4 (&acc)[2][2][4][2], const Unit& u, int wr, int wc, int fr, int fq) const {
        const int row0 = u.pm * BM + wr * 64 + fr, col0 = u.pn * BM + wc * 32 + 4 * fq;
        f32x4 s1[2][2], s2[2][2];
#pragma unroll
        for (int bj = 0; bj < 2; ++bj)
#pragma unroll
            for (int n = 0; n < 2; ++n) { s1[bj][n] = (f32x4){0.f, 0.f, 0.f, 0.f}; s2[bj][n] = (f32x4){0.f, 0.f, 0.f, 0.f}; }
#pragma unroll
        for (int ai = 0; ai < 2; ++ai)
#pragma unroll
            for (int m = 0; m < 4; ++m) { float* rowp = VT + (size_t)(row0 + ai * HALF + m * 16) * ldc + col0;
#pragma unroll
                for (int bj = 0; bj < 2; ++bj)
#pragma unroll
                    for (int n = 0; n < 2; ++n) { const f32x4 v = acc[ai][bj][m][n]; const f32x2 a = gelu_pk((f32x2){v[0], v[1]}), b = gelu_pk((f32x2){v[2], v[3]});
                        const f32x4 gl = (f32x4){a.x, a.y, b.x, b.y}; *(f32x4*)(rowp + bj * HALF + n * 16) = gl; s1[bj][n] += gl; s2[bj][n] += gl * gl; } }
#pragma unroll
        for (int bj = 0; bj < 2; ++bj)
#pragma unroll
            for (int n = 0; n < 2; ++n)
#pragma unroll
                for (int j = 0; j < 4; ++j) { float a = s1[bj][n][j], b = s2[bj][n][j];
#pragma unroll
                    for (int o = 1; o < 16; o <<= 1) { a += __shfl_xor(a, o); b += __shfl_xor(b, o); }
                    s1[bj][n][j] = a; s2[bj][n][j] = b; }
        if (fr == 0) {
            f32x2* dst = VST + (size_t)(u.pm * 2 + wr) * ntok + col0;
#pragma unroll
            for (int bj = 0; bj < 2; ++bj)
#pragma unroll
                for (int n = 0; n < 2; ++n)
#pragma unroll
                    for (int j = 0; j < 4; ++j) dst[bj * HALF + n * 16 + j] = (f32x2){s1[bj][n][j], s2[bj][n][j]};
        }
    }
};
struct MoeOrder {
    int nPM, nPN, G, vcu;
    __device__ __forceinline__ bool next(int i, Unit& u) const {
        const int L = i * G + vcu; if (L >= 16 * nPM * nPN) return false;
        const int pm = L % nPM, r = L / nPM, pn = r % nPN, e = r / nPN; u.pm = e * 9 + pm; u.pn = e * nPN + pn; return true;
    }
    __device__ __forceinline__ void a_ready(const Unit&) const {}
    __device__ __forceinline__ void done(const Unit&) const {}
};

template <class Epi, class Sched, bool ALIGN_EPI = false, bool GATHER = false>
__device__ __forceinline__ void gemm_phase(PG8_LAS unsigned char* lds, const Gemm g, const Sched& S, const Epi& E) {
    int tid_ = threadIdx.x; asm volatile("" : "+v"(tid_));
    const int tid = tid_, wid = __builtin_amdgcn_readfirstlane(tid >> 6), lane = tid & 63, wr = wid >> 2, wc = wid & 3, fr = lane & 15, fq = lane >> 4;
    const int K = g.K, nt = K / BK;
    unsigned voffA[2], voffB[2];
#pragma unroll
    for (int i = 0; i < 2; ++i) { int R, C; stage_rc(tid * 16 + i * 8192, R, C); const int Rb = Epi::PERM ? ((R & ~31) + perm32(R & 31)) : R;
        voffA[i] = (unsigned)(R * K + C) * 2u; voffB[i] = (unsigned)(Rb * K + C) * 2u; }
    const size_t kstep = (size_t)(BK * 2);
    const size_t hstep = (size_t)HALF * K * 2;
    const size_t tstep = 2 * hstep;
    const unsigned ldsw = (unsigned)wid * 1024u;
    const int aoff = lds_byte(wr * 64 + fr, fq * 8), boff = lds_byte(wc * 32 + fr, fq * 8);
#define PG8_SA(b, h) (((b) * 2 + (h)) * HTB)
#define PG8_SB(b, h) ((4 + (b) * 2 + (h)) * HTB)
#define PG8_STAGE(bufoff, gbase, voff) do { _Pragma("unroll") for (int _i = 0; _i < 2; ++_i) \
        __builtin_amdgcn_global_load_lds((const unsigned*)((const char*)(gbase) + (voff)[_i]), (PG8_LAS unsigned*)(lds + (bufoff) + ldsw + _i * 8192), 16, 0, 0); } while (0)
#define PG8_STGA(b, h, ubase, koff, gofs) do { if constexpr (GATHER) { PG8_STAGE(PG8_SA(b, h), (const char*)g.A + (koff), gofs[h]); } \
        else { PG8_STAGE(PG8_SA(b, h), (ubase) + (koff) + (size_t)(h) * hstep, voffA); } } while (0)
#define PG8_GLOAD(dst, u) do { if constexpr (GATHER) { _Pragma("unroll") for (int _i = 0; _i < 2; ++_i) { int _R, _C; stage_rc(tid * 16 + _i * 8192, _R, _C); \
        _Pragma("unroll") for (int _h = 0; _h < 2; ++_h) dst[_h][_i] = (unsigned)g.rows[(u).pm * BM + _h * HALF + _R] * (unsigned)(K * 2) + (unsigned)_C * 2u; } } } while (0)
#define PG8_LDA(dst, b, h) do { _Pragma("unroll") for (int m = 0; m < 4; ++m) _Pragma("unroll") for (int k = 0; k < 2; ++k) dst[m][k] = *(const PG8_LAS bf16x8*)(lds + PG8_SA(b, h) + aoff + m * 2048 + k * 1024); } while (0)
#define PG8_LDB(dst, b, h) do { _Pragma("unroll") for (int n = 0; n < 2; ++n) _Pragma("unroll") for (int k = 0; k < 2; ++k) dst[n][k] = *(const PG8_LAS bf16x8*)(lds + PG8_SB(b, h) + boff + n * 2048 + k * 1024); } while (0)
#define PG8_MMA(ai, bj, At, Bt) do { __builtin_amdgcn_s_setprio(1); _Pragma("unroll") for (int m = 0; m < 4; ++m) _Pragma("unroll") for (int n = 0; n < 2; ++n) _Pragma("unroll") for (int k = 0; k < 2; ++k) \
        acc[ai][bj][m][n] = __builtin_amdgcn_mfma_f32_16x16x32_bf16(Bt[n][k], At[m][k], acc[ai][bj][m][n], 0, 0, 0); __builtin_amdgcn_s_setprio(0); } while (0)
#define PG8_WAIT_V(n) asm volatile("s_waitcnt vmcnt(" #n ")" ::: "memory")
#define PG8_WAIT_L(n) asm volatile("s_waitcnt lgkmcnt(" #n ")" ::: "memory")
#define PG8_BAR __builtin_amdgcn_s_barrier()
#define PG8_SCHED __builtin_amdgcn_sched_barrier(0)
    Unit cur, nxt; int ui = 0;
    if (!S.next(0, cur)) return;
    f32x4 acc[2][2][4][2];
#pragma unroll
    for (int a = 0; a < 2; ++a)
#pragma unroll
        for (int b = 0; b < 2; ++b)
#pragma unroll
            for (int m = 0; m < 4; ++m)
#pragma unroll
                for (int n = 0; n < 2; ++n) acc[a][b][m][n] = (f32x4){0.f, 0.f, 0.f, 0.f};
    bf16x8 At[4][2], B0[2][2], B1[2][2];
    unsigned gc[2][2] = {{0u, 0u}, {0u, 0u}}, gn[2][2] = {{0u, 0u}, {0u, 0u}};
    const char* cA = GATHER ? (const char*)g.A : (const char*)g.A + (size_t)cur.pm * tstep; const char* cB = (const char*)g.Bt + (size_t)cur.pn * tstep;
    S.a_ready(cur);
    PG8_GLOAD(gc, cur);
    PG8_STAGE(PG8_SB(0, 0), cB, voffB); PG8_STAGE(PG8_SB(0, 1), cB + hstep, voffB); PG8_STGA(0, 0, cA, 0, gc); PG8_STGA(0, 1, cA, 0, gc);
    if (wr == 1) PG8_BAR;
    PG8_WAIT_V(2); PG8_BAR;
    PG8_STAGE(PG8_SB(1, 0), cB + kstep, voffB); PG8_STGA(1, 0, cA, kstep, gc); PG8_STAGE(PG8_SB(1, 1), cB + hstep + kstep, voffB);
    PG8_WAIT_V(6); PG8_BAR;
    for (;;) {
        const bool has_next = S.next(ui + 1, nxt);
        const char* nA = GATHER ? (const char*)g.A : (has_next ? (const char*)g.A + (size_t)nxt.pm * tstep : cA); const char* nB = has_next ? (const char*)g.Bt + (size_t)nxt.pn * tstep : cB;
        for (int t = 0; t < nt; t += 2) {
            const bool last = (t == nt - 2);
            const size_t k1 = (size_t)(t + 1) * kstep;
            const char* b2 = last ? nB : cB + (size_t)(t + 2) * kstep; const char* b3 = b2 + kstep;
            if (last && has_next) S.a_ready(nxt);
            if (last) { if (has_next) { PG8_GLOAD(gn, nxt); } else {
#pragma unroll
                    for (int h = 0; h < 2; ++h)
#pragma unroll
                        for (int i = 0; i < 2; ++i) gn[h][i] = gc[h][i]; } }
            PG8_LDB(B0, 0, 0); PG8_LDB(B1, 0, 1); PG8_SCHED; PG8_LDA(At, 0, 0); PG8_STGA(1, 1, cA, k1, gc);
            PG8_WAIT_V(8); PG8_WAIT_L(0); PG8_BAR; PG8_MMA(0, 0, At, B0); PG8_MMA(0, 1, At, B1); PG8_BAR; PG8_SCHED;
            PG8_LDA(At, 0, 1); PG8_STAGE(PG8_SB(0, 0), b2, voffB); PG8_STAGE(PG8_SB(0, 1), b2 + hstep, voffB);
            if (last) { PG8_STGA(0, 0, nA, 0, gn); } else { PG8_STGA(0, 0, cA, (size_t)(t + 2) * kstep, gc); }
            PG8_WAIT_V(8); PG8_WAIT_L(0); PG8_BAR; PG8_MMA(1, 0, At, B0); PG8_MMA(1, 1, At, B1); PG8_BAR; PG8_SCHED;
            PG8_LDB(B0, 1, 0); PG8_LDB(B1, 1, 1); PG8_SCHED; PG8_LDA(At, 1, 0);
            if (last) { PG8_STGA(0, 1, nA, 0, gn); } else { PG8_STGA(0, 1, cA, (size_t)(t + 2) * kstep, gc); }
            PG8_WAIT_V(8); PG8_WAIT_L(0); PG8_BAR; PG8_MMA(0, 0, At, B0); PG8_MMA(0, 1, At, B1); PG8_BAR; PG8_SCHED;
            PG8_LDA(At, 1, 1); PG8_STAGE(PG8_SB(1, 0), b3, voffB); PG8_STAGE(PG8_SB(1, 1), b3 + hstep, voffB);
            if (last) { PG8_STGA(1, 0, nA, kstep, gn); } else { PG8_STGA(1, 0, cA, (size_t)(t + 3) * kstep, gc); }
            PG8_WAIT_V(8); PG8_WAIT_L(0); PG8_BAR; PG8_MMA(1, 0, At, B0); PG8_MMA(1, 1, At, B1); PG8_BAR; PG8_SCHED;
        }
        if constexpr (ALIGN_EPI) { if (wr == 0) PG8_BAR; }
        if constexpr (!Epi::AFTER_DRAIN) { E(acc, cur, wr, wc, fr, fq); S.done(cur); }
        if (!has_next) break;
#pragma unroll
        for (int a = 0; a < 2; ++a)
#pragma unroll
            for (int b = 0; b < 2; ++b)
#pragma unroll
                for (int m = 0; m < 4; ++m)
#pragma unroll
                    for (int n = 0; n < 2; ++n) acc[a][b][m][n] = (f32x4){0.f, 0.f, 0.f, 0.f};
        cur = nxt; cA = nA; cB = nB; ++ui;
#pragma unroll
        for (int h = 0; h < 2; ++h)
#pragma unroll
            for (int i = 0; i < 2; ++i) gc[h][i] = gn[h][i];
        if constexpr (ALIGN_EPI) { if (wr == 1) PG8_BAR; }
    }
    PG8_WAIT_V(0);
    if constexpr (!ALIGN_EPI) { if (wr == 0) PG8_BAR; }
    PG8_BAR;
    if constexpr (Epi::AFTER_DRAIN) { E.fused(acc, cur, wr, wc, fr, fq, lds, wid, lane); S.done(cur); }
#undef PG8_SA
#undef PG8_SB
#undef PG8_STAGE
#undef PG8_STGA
#undef PG8_GLOAD
#undef PG8_LDA
#undef PG8_LDB
#undef PG8_MMA
#undef PG8_WAIT_V
#undef PG8_WAIT_L
#undef PG8_BAR
#undef PG8_SCHED
}
}
constexpr int NB = 4, SEQ = 4096, T = NB * SEQ, LC = 256, TC = NB * LC, TA = T + TC, D = 1024;
constexpr int NE = 16, FF = 2048, ESTR = 2304;
constexpr int LK = LC + SEQ, KVP = 256;
constexpr float ALPHA = 1.6817928305074290f;
constexpr float LN_EPS = 1e-5f, RMS_EPS = 1e-6f;
constexpr float ATT_C2 = 0.125f * 1.4426950408889634f;
constexpr int NWAVES = 8, NTHR = 512;
constexpr size_t MiB = 1u << 20;
constexpr size_t WS_CTL = 0, WS_MOD = 1 * MiB, WS_MODP = 2 * MiB, WS_TW = 6 * MiB;
constexpr size_t WS_WHYIN = 8 * MiB, WS_WHYOUT = 20 * MiB, WS_WQKV = 24 * MiB, WS_WATO = 27 * MiB, WS_WCMIN = 29 * MiB, WS_WCMOUT = 37 * MiB, WS_WCMS = 41 * MiB;
constexpr size_t WS_WGU = 42 * MiB, WS_WDN = 554 * MiB, WS_HF = 810 * MiB;
constexpr size_t WS_XL = 942 * MiB, WS_U = 1010 * MiB, WS_HB = 1078 * MiB, WS_AFF = 1112 * MiB, WS_ROWS = 1114 * MiB, WS_GATE = WS_ROWS + 256 * 1024, WS_INV = 1115 * MiB;
constexpr size_t WS_ACT = 1117 * MiB, WS_Y = 1261 * MiB, WS_SCR = 1405 * MiB, WS_XC = 1677 * MiB, WS_END = 1745 * MiB;
constexpr size_t WS_XG = WS_Y;
constexpr size_t SC_PT = WS_SCR, SC_Z2T = WS_SCR + 204 * MiB, SC_Z2 = WS_SCR + 238 * MiB;
constexpr size_t SC_QKV = WS_SCR, SC_Q = WS_SCR + 102 * MiB, SC_K = WS_SCR + 134 * MiB, SC_V = WS_SCR + 143 * MiB, SC_O = WS_SCR + 152 * MiB;
constexpr size_t SC_UB = WS_SCR, SC_VT = WS_SCR + 64 * MiB, SC_VST = WS_SCR + 192 * MiB, SC_UV = WS_SCR + 194 * MiB;
constexpr size_t HF_SLOT = (size_t)4 * 1024 * 4096 * 4, HF_CTX = 2 * HF_SLOT;
constexpr int LDS_BYTES = 147456;
constexpr int RING_BYTES = 131072, MISC_OFF = LDS_BYTES - 256;

#define GAS __attribute__((address_space(1)))
#define LAS __attribute__((address_space(3)))
typedef unsigned short bf16;
typedef unsigned v4u __attribute__((ext_vector_type(4)));
typedef unsigned v2u __attribute__((ext_vector_type(2)));
typedef float f32x4 __attribute__((ext_vector_type(4)));
typedef float f32x2 __attribute__((ext_vector_type(2)));
#define LDS_WAIT() asm volatile("s_waitcnt lgkmcnt(0)" ::: "memory")
__device__ __forceinline__ unsigned f2bf(float f) { unsigned u = __builtin_bit_cast(unsigned, f); return (u + 0x7fffu + ((u >> 16) & 1u)) >> 16; }
__device__ __forceinline__ unsigned pk2(float lo, float hi) { return f2bf(lo) | (f2bf(hi) << 16); }
__device__ __forceinline__ float bf2f(unsigned short b) { return __builtin_bit_cast(float, (unsigned)b << 16); }
__device__ __forceinline__ float wave_sum(float v) {
#pragma unroll
    for (int o = 1; o < 64; o <<= 1) v += __shfl_xor(v, o);
    return v;
}

#define XB_TMO      128
#define XB_XCNT(j)  (256  + 64 * (j))
#define XB_XSUB(j)  (1280 + 64 * (j))
#define XB_XGEN(j)  (2304 + 64 * (j))
#define XB_TOP      3328
#define XB_TOPGEN   3392
#define XCD_BAR_WORDS 3456
#define XB_SPIN_CAP (1u << 18)
__device__ __forceinline__ unsigned xb_ld(unsigned* p)              { return __hip_atomic_load(p, __ATOMIC_RELAXED, __HIP_MEMORY_SCOPE_AGENT); }
__device__ __forceinline__ unsigned xb_add(unsigned* p, unsigned v) { return __hip_atomic_fetch_add(p, v, __ATOMIC_RELAXED, __HIP_MEMORY_SCOPE_AGENT); }
__device__ __forceinline__ unsigned xb_xcc_id() { return (unsigned)__builtin_amdgcn_s_getreg((3 << 11) | 20) & 0xFu; }
#define XB_SPIN(cond, bar) do { unsigned _sp = 0; while (cond) { __builtin_amdgcn_s_sleep(1); \
    if ((++_sp & 255u) == 0u) { if (xb_ld(&(bar)[XB_TMO])) break; if (_sp > XB_SPIN_CAP) { atomicAdd(&(bar)[XB_TMO], 1u); break; } } } } while (0)
struct XcdBarrier { unsigned* bar; unsigned x; volatile LAS unsigned* st; };
__device__ __forceinline__ XcdBarrier xcd_barrier_post(unsigned* bar, volatile LAS unsigned* st) {
    XcdBarrier b; b.bar = bar; b.x = xb_xcc_id(); b.st = st;
    if (threadIdx.x == 0) (void)xb_add(&bar[XB_XCNT(b.x)], 1u);
    return b;
}
__device__ __forceinline__ void xcd_barrier_complete(unsigned* bar, unsigned x, unsigned& nloc, unsigned& nx) {
    const unsigned G = gridDim.x * gridDim.y * gridDim.z;
    unsigned sum, cnt, mine, sp = 0u;
    for (;;) {
        sum = 0u; cnt = 0u; mine = 0u;
#pragma unroll
        for (unsigned j = 0; j < 16; ++j) { const unsigned c = xb_ld(&bar[XB_XCNT(j)]); sum += c; cnt += (c > 0u) ? 1u : 0u; mine = (j == x) ? c : mine; }
        if (sum == G) break;
        __builtin_amdgcn_s_sleep(1);
        if ((++sp & 255u) == 0u) { if (xb_ld(&bar[XB_TMO])) break; if (sp > XB_SPIN_CAP) { atomicAdd(&bar[XB_TMO], 1u); break; } }
    }
    nloc = mine > 0u ? mine : 1u; nx = cnt > 0u ? cnt : 1u;
}
__device__ __forceinline__ void xcd_barrier(const XcdBarrier& b) {
    asm volatile("s_waitcnt vmcnt(0)" ::: "memory");
    __syncthreads();
    if (threadIdx.x == 0) {
        unsigned* bar = b.bar; asm volatile("" : "+s"(bar));
        __builtin_amdgcn_s_waitcnt(0);
        unsigned bx_ = b.x; asm volatile("" : "+s"(bx_));
        unsigned nloc = b.st[0], nx = b.st[1];
        if (nloc == 0u) { xcd_barrier_complete(bar, bx_, nloc, nx); b.st[0] = nloc; b.st[1] = nx; }
        const unsigned old = xb_add(&bar[XB_XSUB(bx_)], 1u);
        const unsigned gen = old / nloc;
        if (old + 1u == (gen + 1u) * nloc) {
            __builtin_amdgcn_fence(__ATOMIC_RELEASE, "agent");
            asm volatile("s_waitcnt vmcnt(0)" ::: "memory");
            const unsigned og = xb_add(&bar[XB_TOP], 1u);
            const unsigned tg = og / nx;
            if (og + 1u == (tg + 1u) * nx) xb_add(&bar[XB_TOPGEN], 1u);
            else XB_SPIN(xb_ld(&bar[XB_TOPGEN]) == tg, bar);
            __builtin_amdgcn_fence(__ATOMIC_ACQUIRE, "agent");
            xb_add(&bar[XB_XGEN(bx_)], 1u);
            asm volatile("s_waitcnt vmcnt(0)" ::: "memory");
        } else {
            XB_SPIN(xb_ld(&bar[XB_XGEN(bx_)]) == gen, bar);
            __builtin_amdgcn_fence(__ATOMIC_ACQUIRE, "agent");
            asm volatile("s_waitcnt vmcnt(0)" ::: "memory");
        }
    }
    __syncthreads();
}

struct Args { const float* in[33]; float* out; unsigned char* ws; int ph_lo, ph_hi; };
enum { I_X = 0, I_C, I_CTX, I_CCTX, I_MODW, I_MODB, I_LNG, I_LNB, I_HYWIN, I_HYCW, I_HYCB, I_FW1, I_FB1, I_FW2, I_FB2, I_FW3, I_FFREQ, I_FBIAS, I_HYWOUT,
       I_WQKV, I_QGAIN, I_KGAIN, I_WATO, I_CMWIN, I_CMLNG, I_CMLNB, I_CMWS, I_CMBS, I_CMWOUT, I_ROUTER, I_WGATE, I_WUP, I_WDOWN };
typedef const __attribute__((address_space(4))) Args* ArgsP;
__device__ __forceinline__ ArgsP get_args() { auto p = __builtin_amdgcn_kernarg_segment_ptr(); asm volatile("" : "+s"(p)); return (ArgsP)p; }
struct Fr { LAS unsigned char* lds; int tid, lane, wave, vcu, G, bx; };
__device__ __forceinline__ Fr mkfr(unsigned char* lds_raw) {
    Fr F; int tid = threadIdx.x; asm volatile("" : "+v"(tid)); int bx = blockIdx.x, G = gridDim.x; asm volatile("" : "+s"(bx), "+s"(G));
    F.lds = (LAS unsigned char*)lds_raw; F.tid = tid; F.lane = tid & 63; F.wave = __builtin_amdgcn_readfirstlane(tid >> 6);
    F.G = G; F.bx = bx; F.vcu = (G % 8 == 0) ? (bx % 8) * (G / 8) + bx / 8 : bx; return F; }
__device__ __forceinline__ void proA_adaln_item(ArgsP a, const Fr& F, int it) {
    LAS float* sc = (LAS float*)F.lds;
    const int i = it / 96, ks = (it / 12) % 8, cc = it % 12;
    __syncthreads();
    for (int u = F.tid; u < 5 * 128; u += NTHR) { const int r = u / 128, k = ks * 128 + (u % 128);
        const float x = r < 4 ? a->in[I_C][r * D + k] : a->in[I_CCTX][k]; sc[u] = x / (1.0f + expf(-x)); }
    __syncthreads();
    const int col = cc * 512 + F.tid;
    const float* w = a->in[I_MODW] + ((size_t)i * D + (size_t)ks * 128) * 6144 + col;
    float acc[5] = {0.f, 0.f, 0.f, 0.f, 0.f};
#pragma unroll 8
    for (int k = 0; k < 128; ++k) { const float wv = w[(size_t)k * 6144];
#pragma unroll
        for (int r = 0; r < 5; ++r) acc[r] += sc[r * 128 + k] * wv; }
    float* mp = (float*)(a->ws + WS_MODP) + (size_t)((i * 8 + ks) * 5) * 6144 + col;
#pragma unroll
    for (int r = 0; r < 5; ++r) mp[(size_t)r * 6144] = acc[r];
}
__device__ __forceinline__ void proA_filter_item(ArgsP a, const Fr& F, int it) {
    int slot, L, t0; float* HF;
    if (it < 512) { slot = it >> 8; L = SEQ; t0 = (it & 255) * 16; HF = (float*)(a->ws + WS_HF + (size_t)slot * HF_SLOT); }
    else { slot = 0; L = LC; t0 = (it - 512) * 16; HF = (float*)(a->ws + WS_HF + HF_CTX); }
    LAS float* z = (LAS float*)F.lds;
    LAS float* h1 = z + 16 * 33;
    LAS float* h2 = h1 + 16 * 64;
    __syncthreads();
    for (int u = F.tid; u < 16 * 33; u += NTHR) { const int tt = u / 33, j = u % 33; const float tf = (float)(t0 + tt);
        float v;
        if (j == 0) v = tf / (float)(L - 1);
        else { const int jj = (j - 1) & 15; const float f = 1e-4f + (float)jj * ((15.0f - 1e-4f) / 15.0f); const float w = (float)(6.283185307179586 / (double)L) * tf;
            v = j <= 16 ? cosf(f * w) : -sinf(f * w); }
        z[u] = v; }
    __syncthreads();
    const float* w1 = a->in[I_FW1] + (size_t)slot * 33 * 64; const float* b1 = a->in[I_FB1] + slot * 64;
    const float* w2 = a->in[I_FW2] + (size_t)slot * 64 * 64; const float* b2 = a->in[I_FB2] + slot * 64;
    const float* fq = a->in[I_FFREQ] + slot * 128;
    for (int u = F.tid; u < 16 * 64; u += NTHR) { const int tt = u >> 6, j = u & 63; float s = b1[j];
        for (int i = 0; i < 33; ++i) s += z[tt * 33 + i] * w1[i * 64 + j];
        h1[u] = sinf(fq[j] * s); }
    __syncthreads();
    for (int u = F.tid; u < 16 * 64; u += NTHR) { const int tt = u >> 6, j = u & 63; float s = b2[j];
        for (int i = 0; i < 64; ++i) s += h1[tt * 64 + i] * w2[i * 64 + j];
        h2[u] = sinf(fq[64 + j] * s); }
    __syncthreads();
    const float* w3 = a->in[I_FW3] + (size_t)slot * 64 * 4096;
    const float dmin = -3.0701134573253940f, dmax = -15.350567286626973f;
    for (int cb = 0; cb < 8; ++cb) { const int col = cb * 512 + F.tid;
        float acc[16];
#pragma unroll
        for (int tt = 0; tt < 16; ++tt) acc[tt] = 0.f;
        for (int k4 = 0; k4 < 16; ++k4) { const float wa = w3[(size_t)(4 * k4) * 4096 + col], wb = w3[(size_t)(4 * k4 + 1) * 4096 + col], wc = w3[(size_t)(4 * k4 + 2) * 4096 + col], wd = w3[(size_t)(4 * k4 + 3) * 4096 + col];
#pragma unroll
            for (int tt = 0; tt < 16; ++tt) { const f32x4 hv = *(const LAS f32x4*)(h2 + tt * 64 + 4 * k4); acc[tt] += (hv[0] * wa + hv[1] * wb) + (hv[2] * wc + hv[3] * wd); } }
        const int d = col & 1023; const float delta = fabsf(dmin + (float)d * ((dmax - dmin) / 1023.0f));
        float* dst = HF + (size_t)col * L + t0;
#pragma unroll
        for (int q = 0; q < 4; ++q) { f32x4 o;
#pragma unroll
            for (int j = 0; j < 4; ++j) { const int tt = q * 4 + j; const float tl = (float)(t0 + tt) / (float)(L - 1); o[j] = acc[tt] * expf(-tl * delta); }
            *(f32x4*)(dst + q * 4) = o; } }
}
__device__ __forceinline__ void conv_tile(const float* W, int K, int N, int k0, int n0, bf16* WT, int drow0, LAS float* scr, int lane) {
    float rv[64];
#pragma unroll
    for (int i = 0; i < 64; ++i) rv[i] = W[(size_t)(k0 + i) * N + n0 + lane];
#pragma unroll
    for (int i = 0; i < 64; ++i) scr[i * 65 + lane] = rv[i];
    LDS_WAIT(); asm volatile("" ::: "memory");
    const int c = lane & 7;
#pragma unroll
    for (int j = 0; j < 8; ++j) { const int n = (lane >> 3) + 8 * j; const LAS float* s = scr + (8 * c) * 65 + n;
        v4u o; o.x = pk2(s[0 * 65], s[1 * 65]); o.y = pk2(s[2 * 65], s[3 * 65]); o.z = pk2(s[4 * 65], s[5 * 65]); o.w = pk2(s[6 * 65], s[7 * 65]);
        *(v4u*)(WT + (size_t)(drow0 + n) * K + k0 + 8 * c) = o; }
    LDS_WAIT(); asm volatile("" ::: "memory");
}
constexpr int CV_SMALL = 768 * 2 + 256 * 2 + 384 + 256 + 1024 + 512;
constexpr int CV_MOE = 4 * 16 * 3 * 512;
__device__ __forceinline__ void proA_conv_item(ArgsP a, int it, LAS float* scr, int lane) {
    unsigned char* ws = a->ws;
    if (it < CV_SMALL) {
        int r = it;
        if (r < 1536) { const int s = r / 768, q = r % 768, kb = q / 48, nb = q % 48;
            conv_tile(a->in[I_HYWIN] + (size_t)s * 1024 * 3072, 1024, 3072, kb * 64, nb * 64, (bf16*)(ws + WS_WHYIN) + (size_t)s * 3072 * 1024, nb * 64, scr, lane); return; } r -= 1536;
        if (r < 512) { const int s = r / 256, q = r % 256, kb = q / 16, nb = q % 16;
            conv_tile(a->in[I_HYWOUT] + (size_t)s * 1024 * 1024, 1024, 1024, kb * 64, nb * 64, (bf16*)(ws + WS_WHYOUT) + (size_t)s * 1024 * 1024, nb * 64, scr, lane); return; } r -= 512;
        if (r < 384) { const int kb = r / 24, nb = r % 24;
            conv_tile(a->in[I_WQKV], 1024, 1536, kb * 64, nb * 64, (bf16*)(ws + WS_WQKV), nb * 64, scr, lane); return; } r -= 384;
        if (r < 256) { const int kb = r / 16, nb = r % 16;
            conv_tile(a->in[I_WATO], 1024, 1024, kb * 64, nb * 64, (bf16*)(ws + WS_WATO), nb * 64, scr, lane); return; } r -= 256;
        if (r < 1024) { const int kb = r / 64, nb = r % 64;
            conv_tile(a->in[I_CMWIN], 1024, 4096, kb * 64, nb * 64, (bf16*)(ws + WS_WCMIN), nb * 64, scr, lane); return; } r -= 1024;
        { const int kb = r / 16, nb = r % 16;
            conv_tile(a->in[I_CMWOUT], 2048, 1024, kb * 64, nb * 64, (bf16*)(ws + WS_WCMOUT), nb * 64, scr, lane); return; }
    }
    const int r = it - CV_SMALL, mat = r / 512, q = r % 512, le = mat / 3, which = mat % 3;
    if (which < 2) { const int kb = q / 32, nb = q % 32, n0 = nb * 64;
        const float* src = a->in[which == 0 ? I_WGATE : I_WUP] + (size_t)le * 1024 * 2048;
        conv_tile(src, 1024, 2048, kb * 64, n0, (bf16*)(ws + WS_WGU) + (size_t)le * 4096 * 1024, (n0 >> 7) * 256 + (n0 & 127) + which * 128, scr, lane); }
    else { const int kb = q / 16, nb = q % 16;
        conv_tile(a->in[I_WDOWN] + (size_t)le * 2048 * 1024, 2048, 1024, kb * 64, nb * 64, (bf16*)(ws + WS_WDN) + (size_t)le * 1024 * 2048, nb * 64, scr, lane); }
}
__device__ __forceinline__ void phase_proA(ArgsP a, const Fr& F) {
    const int gt = F.vcu * NTHR + F.tid, NGT = F.G * NTHR;
    for (int k = gt; k < 8192; k += NGT) { float s, c; sincospif((float)k * (1.0f / 4096.0f), &s, &c); ((f32x2*)(a->ws + WS_TW))[k] = (f32x2){c, s}; }
    for (int k = gt; k < 16 * 128 * 128; k += NGT) ((bf16*)(a->ws + WS_WCMS))[k] = (bf16)f2bf(a->in[I_CMWS][k]);
    const int nbl = F.G >= 2 ? F.G / 2 : 1;
    if (F.vcu < nbl) { for (int it = F.vcu; it < 384 + 528; it += nbl) { if (it < 384) proA_adaln_item(a, F, it); else proA_filter_item(a, F, it - 384); } }
    __syncthreads();
    LAS float* scr = (LAS float*)(F.lds + F.wave * 16640);
    unsigned* q = (unsigned*)(a->ws + WS_CTL) + 8192;
    for (;;) {
        unsigned i0 = 0u; if (F.lane == 0) i0 = __hip_atomic_fetch_add(q, 4u, __ATOMIC_RELAXED, __HIP_MEMORY_SCOPE_AGENT);
        i0 = (unsigned)__builtin_amdgcn_readfirstlane((int)i0);
        if (i0 >= (unsigned)(CV_SMALL + CV_MOE)) break;
        for (unsigned it = i0; it < i0 + 4u && it < (unsigned)(CV_SMALL + CV_MOE); ++it) proA_conv_item(a, (int)it, scr, F.lane);
    }
}
__device__ __forceinline__ void phase_proB(ArgsP a, const Fr& F) {
    LAS float* m0 = (LAS float*)F.lds;
    const float* mp = (const float*)(a->ws + WS_MODP);
    for (int u = F.tid; u < 5 * 2048; u += NTHR) { const int r = u / 2048, c = u % 2048; float s = a->in[I_MODB][c];
        for (int ks = 0; ks < 8; ++ks) s += mp[(size_t)(ks * 5 + r) * 6144 + c];
        m0[u] = s; }
    __syncthreads();
    const int gw = F.vcu * NWAVES + F.wave, NGW = F.G * NWAVES;
    for (int row = gw; row < TA; row += NGW) {
        const int r = row < T ? (row >> 12) : 4;
        const float* src = row < T ? a->in[I_X] + (size_t)row * D : a->in[I_CTX] + (size_t)(row - T) * D;
        float* xl = (float*)(a->ws + WS_XC) + (size_t)row * D; bf16* hb = (bf16*)(a->ws + WS_HB) + (size_t)row * D;
#pragma unroll
        for (int j = 0; j < 4; ++j) { const int c = 4 * F.lane + 256 * j; const f32x4 v = *(const f32x4*)(src + c); *(f32x4*)(xl + c) = v;
            const f32x4 sh = *(const LAS f32x4*)(m0 + r * 2048 + c), sc = *(const LAS f32x4*)(m0 + r * 2048 + 1024 + c);
            const f32x4 h = v * (sc + 1.0f) + sh; v2u o; o.x = pk2(h[0], h[1]); o.y = pk2(h[2], h[3]); *(v2u*)(hb + c) = o; }
    }
    const int gt = F.vcu * NTHR + F.tid, NGT = F.G * NTHR;
    float* mod = (float*)(a->ws + WS_MOD);
    for (int u = gt; u < 4 * 5 * 6144; u += NGT) { const int i = u / 30720, r = (u / 6144) % 5, c = u % 6144; float s = a->in[I_MODB][i * 6144 + c];
        for (int ks = 0; ks < 8; ++ks) s += mp[(size_t)((i * 8 + ks) * 5 + r) * 6144 + c];
        mod[u] = s; }
}
template <int L>
__device__ __forceinline__ float sconv(const bf16* p, int t, float w0, float w1, float w2, float cb) {
    const float a = t > 0 ? bf2f(p[t - 1]) : 0.f, b = bf2f(p[t]), c = t < L - 1 ? bf2f(p[t + 1]) : 0.f; return w0 * a + w1 * b + w2 * c + cb;
}
template <int L>
__device__ __forceinline__ void hy_direct_item(ArgsP a, const Fr& F, int slot, int d, int tok0, const float* HF) {
    LAS float* kk = (LAS float*)F.lds;
    LAS float* vb = kk + 4 * L;
    LAS float* red = vb + 4 * L;
    const bf16* PT = (const bf16*)(a->ws + SC_PT);
    bf16* Z2T = (bf16*)(a->ws + SC_Z2T);
    __syncthreads();
    for (int o = 0; o < 2; ++o) {
        const float* fw = HF + (size_t)((o * 2 + 0) * 1024 + d) * L; const float* bw = HF + (size_t)((o * 2 + 1) * 1024 + d) * L;
        float s = 0.f;
        for (int t = F.tid; t < L; t += NTHR) { const float f = fw[t], b = bw[t]; kk[o * 2 * L + (L - 1) + t] = f; if (t >= 1) kk[o * 2 * L + (L - 1) - t] = b; s += fabsf(f) + (t >= 1 ? fabsf(b) : 0.f); }
        s = wave_sum(s); if (F.lane == 0) red[o * 8 + F.wave] = s;
    }
    __syncthreads();
    float nrm[2];
#pragma unroll
    for (int o = 0; o < 2; ++o) { float s = 0.f; for (int w = 0; w < 8; ++w) s += red[o * 8 + w]; nrm[o] = 1.0f / (s + 1e-6f); }
    const float* cw = a->in[I_HYCW] + (size_t)slot * 3 * 3072; const float* cbp = a->in[I_HYCB] + (size_t)slot * 3072;
    float w0[3], w1[3], w2[3], cb[3];
#pragma unroll
    for (int g = 0; g < 3; ++g) { const int c = g * 1024 + d; w0[g] = cw[c]; w1[g] = cw[3072 + c]; w2[g] = cw[2 * 3072 + c]; cb[g] = cbp[c]; }
    const float fb0 = a->in[I_FBIAS][(slot * 2 + 0) * 1024 + d], fb1 = a->in[I_FBIAS][(slot * 2 + 1) * 1024 + d];
    for (int u = F.tid; u < 4 * L; u += NTHR) { const int b = u / L, t = u % L; vb[u] = sconv<L>(PT + (size_t)d * TA + tok0 + b * L, t, w0[0], w1[0], w2[0], cb[0]); }
    __syncthreads();
    constexpr int NBLK = 4 * L / 8, PER = (NBLK + NTHR - 1) / NTHR;
    float res[PER][8];
#pragma unroll 1
    for (int o = 0; o < 2; ++o) {
        const LAS float* ko = kk + o * 2 * L;
#pragma unroll
        for (int pi = 0; pi < PER; ++pi) {
            const int q = F.tid + pi * NTHR;
            float acc[8];
#pragma unroll
            for (int j = 0; j < 8; ++j) acc[j] = 0.f;
            if (q < NBLK) {
                const int b = q / (L / 8), t0 = (q % (L / 8)) * 8;
                const LAS float* vv = vb + b * L;
#pragma unroll 1
                for (int s8 = 0; s8 < L; s8 += 8) {
                    const LAS float* kw = ko + (t0 - s8 - 7 + L - 1);
                    float w[15], x[8];
#pragma unroll
                    for (int i = 0; i < 15; ++i) w[i] = kw[i];
#pragma unroll
                    for (int i = 0; i < 8; ++i) x[i] = vv[s8 + i];
#pragma unroll
                    for (int j = 0; j < 8; ++j)
#pragma unroll
                        for (int i = 0; i < 8; ++i) acc[j] += w[j - i + 7] * x[i];
                }
            }
#pragma unroll
            for (int j = 0; j < 8; ++j) res[pi][j] = acc[j];
        }
        __syncthreads();
#pragma unroll
        for (int pi = 0; pi < PER; ++pi) {
            const int q = F.tid + pi * NTHR;
            if (q < NBLK) {
                const int b = q / (L / 8), t0 = (q % (L / 8)) * 8;
                const bf16* pg = PT + (size_t)((o + 1) * 1024 + d) * TA + tok0 + b * L;
#pragma unroll
                for (int j = 0; j < 8; ++j) { const int t = t0 + j; const float vin = vb[b * L + t];
                    const float y = res[pi][j] * nrm[o] + vin * (o == 0 ? fb0 : fb1);
                    const float xg = sconv<L>(pg, t, w0[o + 1], w1[o + 1], w2[o + 1], cb[o + 1]);
                    res[pi][j] = xg * y; }
            }
        }
        __syncthreads();
        if (o == 0) {
#pragma unroll
            for (int pi = 0; pi < PER; ++pi) { const int q = F.tid + pi * NTHR;
                if (q < NBLK) { const int b = q / (L / 8), t0 = (q % (L / 8)) * 8;
#pragma unroll
                    for (int j = 0; j < 8; ++j) vb[b * L + t0 + j] = res[pi][j]; } }
            __syncthreads();
        } else {
#pragma unroll
            for (int pi = 0; pi < PER; ++pi) { const int q = F.tid + pi * NTHR;
                if (q < NBLK) { const int b = q / (L / 8), t0 = (q % (L / 8)) * 8;
                    v4u ov; ov.x = pk2(res[pi][0], res[pi][1]); ov.y = pk2(res[pi][2], res[pi][3]); ov.z = pk2(res[pi][4], res[pi][5]); ov.w = pk2(res[pi][6], res[pi][7]);
                    *(v4u*)(Z2T + (size_t)d * TA + tok0 + b * L + t0) = ov; } }
        }
    }
}
__device__ __forceinline__ void phase_hy_tr(ArgsP a, const Fr& F, int ntok) {
    LAS unsigned short* tile = (LAS unsigned short*)(F.lds + F.wave * 9216);
    const bf16* Z2T = (const bf16*)(a->ws + SC_Z2T); bf16* Z2 = (bf16*)(a->ws + SC_Z2);
    const int gw = F.vcu * NWAVES + F.wave, NGW = F.G * NWAVES, ntt = ntok / 64;
    for (int it = gw; it < 16 * ntt; it += NGW) {
        const int c0 = (it / ntt) * 64, t0 = (it % ntt) * 64;
#pragma unroll
        for (int i = 0; i < 8; ++i) { const int ch = i * 8 + (F.lane >> 3), ck = F.lane & 7;
            const v4u v = *(const v4u*)(Z2T + (size_t)(c0 + ch) * TA + t0 + ck * 8); *(LAS v4u*)(tile + ch * 72 + ck * 8) = v; }
        LDS_WAIT(); asm volatile("" ::: "memory");
        bf16* dst = Z2 + (size_t)(t0 + F.lane) * D + c0;
#pragma unroll
        for (int q = 0; q < 8; ++q) { unsigned w[4];
#pragma unroll
            for (int j = 0; j < 4; ++j) { const unsigned lo = tile[(q * 8 + 2 * j) * 72 + F.lane], hi = tile[(q * 8 + 2 * j + 1) * 72 + F.lane]; w[j] = lo | (hi << 16); }
            v4u o; o.x = w[0]; o.y = w[1]; o.z = w[2]; o.w = w[3]; *(v4u*)(dst + q * 8) = o; }
        LDS_WAIT(); asm volatile("" ::: "memory");
    }
}
__device__ __forceinline__ void phase_hy_conv_direct(ArgsP a, const Fr& F, int layer) {
    const int slot = layer == 0 ? 0 : 1; const int nitems = layer == 0 ? 2048 : 1024;
    for (int it = F.vcu; it < nitems; it += F.G) {
        if (it < 1024) hy_direct_item<SEQ>(a, F, slot, it, 0, (const float*)(a->ws + WS_HF + (size_t)slot * HF_SLOT));
        else hy_direct_item<LC>(a, F, slot, it - 1024, T, (const float*)(a->ws + WS_HF + HF_CTX));
    }
}

__device__ __forceinline__ void phase_lnr(ArgsP a, const Fr& F, int layer, int nrows) {
    LAS float* wr = (LAS float*)F.lds;
    __syncthreads();
    for (int u = F.tid; u < 1024 * 16; u += NTHR) wr[u] = a->in[I_ROUTER][(size_t)layer * 1024 * 16 + (u & 1023) * 16 + (u >> 10)];
    __syncthreads();
    const float* U = (const float*)(a->ws + WS_U); float* XL = (float*)(a->ws + WS_XL); bf16* HB = (bf16*)(a->ws + WS_HB); float* AFF = (float*)(a->ws + WS_AFF);
    const float* mod = (const float*)(a->ws + WS_MOD) + (size_t)layer * 5 * 6144;
    const float* lg = a->in[I_LNG] + (size_t)(layer * 2 + 0) * D; const float* lb = a->in[I_LNB] + (size_t)(layer * 2 + 0) * D;
    const int gw = F.vcu * NWAVES + F.wave, NGW = F.G * NWAVES;
    f32x4 vn[4];
    if (gw < nrows) {
#pragma unroll
        for (int j = 0; j < 4; ++j) vn[j] = *(const f32x4*)(U + (size_t)gw * D + 4 * F.lane + 256 * j); }
    for (int row = gw; row < nrows; row += NGW) {
        const int r = row < T ? (row >> 12) : 4;
        f32x4 v[4]; float s = 0.f;
#pragma unroll
        for (int j = 0; j < 4; ++j) { v[j] = vn[j]; s += (v[j][0] + v[j][1]) + (v[j][2] + v[j][3]); }
        if (row + NGW < nrows) {
#pragma unroll
            for (int j = 0; j < 4; ++j) vn[j] = *(const f32x4*)(U + (size_t)(row + NGW) * D + 4 * F.lane + 256 * j); }
        const float mean = wave_sum(s) * (1.0f / D); float s2 = 0.f;
#pragma unroll
        for (int j = 0; j < 4; ++j) { v[j] = v[j] - mean; s2 += (v[j][0] * v[j][0] + v[j][1] * v[j][1]) + (v[j][2] * v[j][2] + v[j][3] * v[j][3]); }
        const float rstd = 1.0f / sqrtf(wave_sum(s2) * (1.0f / D) + LN_EPS);
        float part[16];
#pragma unroll
        for (int e = 0; e < 16; ++e) part[e] = 0.f;
#pragma unroll
        for (int j = 0; j < 4; ++j) { const int c = 4 * F.lane + 256 * j;
            const f32x4 x = v[j] * rstd * *(const f32x4*)(lg + c) + *(const f32x4*)(lb + c);
            *(f32x4*)(XL + (size_t)row * D + c) = x;
            const f32x4 h = x * (*(const f32x4*)(mod + r * 6144 + 4096 + c) + 1.0f) + *(const f32x4*)(mod + r * 6144 + 3072 + c);
            v2u o; o.x = pk2(h[0], h[1]); o.y = pk2(h[2], h[3]); *(v2u*)(HB + (size_t)row * D + c) = o;
#pragma unroll
            for (int e = 0; e < 16; ++e) { const f32x4 w = *(const LAS f32x4*)(wr + e * 1024 + c);
                part[e] += (h[0] * w[0] + h[1] * w[1]) + (h[2] * w[2] + h[3] * w[3]); }
            asm volatile("" ::: "memory"); }
        float mx = -3.0e38f;
#pragma unroll
        for (int e = 0; e < 16; ++e) { part[e] = wave_sum(part[e]); mx = fmaxf(mx, part[e]); }
        float den = 0.f;
#pragma unroll
        for (int e = 0; e < 16; ++e) { part[e] = expf(part[e] - mx); den += part[e]; }
        float mine = 0.f;
#pragma unroll
        for (int e = 0; e < 16; ++e) mine = (F.lane == e) ? part[e] / den : mine;
        if (F.lane < 16) AFF[(size_t)row * 16 + F.lane] = mine;
    }
}

template <int N, int CAPN>
__device__ __forceinline__ void topk_item(ArgsP a, const Fr& F, int b, int e, int rowbase, int slotbase, bool pad) {
    LAS unsigned* hist = (LAS unsigned*)F.lds;
    LAS unsigned* sel = hist + 256;
    LAS unsigned* wtot = hist + 264;
    const float* AFF = (const float*)(a->ws + WS_AFF); int* ROWS = (int*)(a->ws + WS_ROWS); float* GATE = (float*)(a->ws + WS_GATE); int* INV = (int*)(a->ws + WS_INV);
    const int tid = F.tid, lane = F.lane; const bool act = tid * 8 < N;
    unsigned key[8];
#pragma unroll
    for (int j = 0; j < 8; ++j) key[j] = act ? __float_as_uint(AFF[(size_t)(rowbase + tid * 8 + j) * 16 + e]) : 0u;
    unsigned prefix = 0u, need = CAPN;
#pragma unroll 1
    for (int pass = 0; pass < 4; ++pass) {
        const int shift = 24 - 8 * pass; const unsigned himask = pass == 0 ? 0u : (0xFFFFFFFFu << (shift + 8));
        __syncthreads();
        if (tid < 256) hist[tid] = 0u;
        __syncthreads();
        if (act) {
#pragma unroll
            for (int j = 0; j < 8; ++j) if ((key[j] & himask) == prefix) __hip_atomic_fetch_add(&hist[(key[j] >> shift) & 255u], 1u, __ATOMIC_RELAXED, __HIP_MEMORY_SCOPE_WORKGROUP);
        }
        __syncthreads();
        if (tid < 64) {
            const unsigned v0 = hist[4 * lane], v1 = hist[4 * lane + 1], v2 = hist[4 * lane + 2], v3 = hist[4 * lane + 3]; const unsigned tot = v0 + v1 + v2 + v3;
            unsigned x = tot;
#pragma unroll
            for (int o = 1; o < 64; o <<= 1) { const unsigned t = __shfl_down(x, o); if (lane + o < 64) x += t; }
            const unsigned a3 = x - tot, a2 = a3 + v3, a1 = a2 + v2, a0 = a1 + v1;
            if (a3 < need && need <= a3 + v3) { sel[0] = 4 * lane + 3; sel[1] = a3; }
            if (a2 < need && need <= a2 + v2) { sel[0] = 4 * lane + 2; sel[1] = a2; }
            if (a1 < need && need <= a1 + v1) { sel[0] = 4 * lane + 1; sel[1] = a1; }
            if (a0 < need && need <= a0 + v0) { sel[0] = 4 * lane + 0; sel[1] = a0; }
        }
        __syncthreads();
        prefix |= sel[0] << shift; need -= sel[1];
    }
    const unsigned tau = prefix;
    unsigned ceq = 0u;
#pragma unroll
    for (int j = 0; j < 8; ++j) ceq += (act && key[j] == tau) ? 1u : 0u;
    unsigned xe = ceq;
#pragma unroll
    for (int o = 1; o < 64; o <<= 1) { const unsigned t = __shfl_up(xe, o); if (lane >= o) xe += t; }
    __syncthreads();
    if (lane == 63) wtot[F.wave * 2] = xe;
    __syncthreads();
    unsigned eqbase = xe - ceq; for (int w = 0; w < F.wave; ++w) eqbase += wtot[w * 2];
    unsigned flags = 0u, csel = 0u;
#pragma unroll
    for (int j = 0; j < 8; ++j) { bool s = false; if (act) { if (key[j] > tau) s = true; else if (key[j] == tau) { s = eqbase < need; ++eqbase; } } if (s) { flags |= 1u << j; ++csel; } }
    unsigned xs = csel;
#pragma unroll
    for (int o = 1; o < 64; o <<= 1) { const unsigned t = __shfl_up(xs, o); if (lane >= o) xs += t; }
    if (lane == 63) wtot[F.wave * 2 + 1] = xs;
    __syncthreads();
    unsigned pos = xs - csel; for (int w = 0; w < F.wave; ++w) pos += wtot[w * 2 + 1];
    if (act) {
#pragma unroll
        for (int j = 0; j < 8; ++j) { const int row = rowbase + tid * 8 + j; int slot = -1;
            if (flags & (1u << j)) { slot = e * ESTR + slotbase + (int)pos; ++pos; ROWS[slot] = row; GATE[slot] = __uint_as_float(key[j]); }
            INV[(size_t)row * 16 + e] = slot; }
    }
    if (pad) for (int p = tid; p < 128; p += NTHR) { ROWS[e * ESTR + 2176 + p] = 0; GATE[e * ESTR + 2176 + p] = 0.f; }
}
__device__ __forceinline__ void phase_topk(ArgsP a, const Fr& F, int layer) {
    const int nitems = layer == 0 ? 128 : 64;
    for (int it = F.vcu; it < nitems; it += F.G) {
        if (it < 64) { const int b = it >> 4, e = it & 15; topk_item<SEQ, 512>(a, F, b, e, b * SEQ, b * 512, false); }
        else { const int b = (it - 64) >> 4, e = it & 15; topk_item<LC, 32>(a, F, b, e, T + b * LC, 2048 + b * 32, b == 0); }
    }
}
__device__ __forceinline__ void phase_gather(ArgsP a, const Fr& F, int layer) {
    const int me = layer == 0 ? 2304 : 2048;
    const int* ROWS = (const int*)(a->ws + WS_ROWS); const bf16* HB = (const bf16*)(a->ws + WS_HB); bf16* XG = (bf16*)(a->ws + WS_XG);
    const int gw = F.vcu * NWAVES + F.wave, NGW = F.G * NWAVES;
    for (int it = gw; it < 16 * me; it += NGW) { const int e = it / me, s = it % me, dr = e * ESTR + s; const int sr = ROWS[dr];
        const v4u* src = (const v4u*)(HB + (size_t)sr * D); v4u* dst = (v4u*)(XG + (size_t)dr * D);
        dst[F.lane] = src[F.lane]; dst[64 + F.lane] = src[64 + F.lane]; }
}
__device__ __forceinline__ void phase_comb(ArgsP a, const Fr& F, int layer, int nrows) {
    const bf16* Y = (const bf16*)(a->ws + WS_Y); const float* XL = (const float*)(a->ws + WS_XL); float* XC = (float*)(a->ws + WS_XC); bf16* HB = (bf16*)(a->ws + WS_HB); const int* INV = (const int*)(a->ws + WS_INV);
    const float* mod = (const float*)(a->ws + WS_MOD) + (size_t)layer * 5 * 6144;
    const float* modn = (const float*)(a->ws + WS_MOD) + (size_t)(layer < 3 ? layer + 1 : 3) * 5 * 6144;
    const float* lg = a->in[I_LNG] + (size_t)(layer * 2 + 1) * D; const float* lb = a->in[I_LNB] + (size_t)(layer * 2 + 1) * D;
    const int gw = F.vcu * NWAVES + F.wave, NGW = F.G * NWAVES;
    int invn = gw < nrows ? INV[(size_t)gw * 16 + (F.lane & 15)] : -1;
    f32x4 xn[4];
    if (gw < nrows) {
#pragma unroll
        for (int j = 0; j < 4; ++j) xn[j] = *(const f32x4*)(XL + (size_t)gw * D + 4 * F.lane + 256 * j); }
    for (int row = gw; row < nrows; row += NGW) {
        const int r = row < T ? (row >> 12) : 4;
        const int myinv = invn;
        f32x4 xc[4];
#pragma unroll
        for (int j = 0; j < 4; ++j) xc[j] = xn[j];
        if (row + NGW < nrows) { invn = INV[(size_t)(row + NGW) * 16 + (F.lane & 15)];
#pragma unroll
            for (int j = 0; j < 4; ++j) xn[j] = *(const f32x4*)(XL + (size_t)(row + NGW) * D + 4 * F.lane + 256 * j); }
        f32x4 m[4];
#pragma unroll
        for (int j = 0; j < 4; ++j) m[j] = (f32x4){0.f, 0.f, 0.f, 0.f};
        unsigned msk = (unsigned)(__ballot(myinv >= 0) & 0xFFFFull);
        while (msk) {
            int sl[4];
#pragma unroll
            for (int q = 0; q < 4; ++q) { if (msk) { const int e = __builtin_ctz(msk); msk &= msk - 1; sl[q] = __shfl(myinv, e); } else sl[q] = -1; }
            v2u yv[4][4];
#pragma unroll
            for (int q = 0; q < 4; ++q) if (sl[q] >= 0) { const bf16* yp = Y + (size_t)sl[q] * D;
#pragma unroll
                for (int j = 0; j < 4; ++j) yv[q][j] = *(const v2u*)(yp + 4 * F.lane + 256 * j); }
#pragma unroll
            for (int q = 0; q < 4; ++q) if (sl[q] >= 0) {
#pragma unroll
                for (int j = 0; j < 4; ++j) { const v2u w = yv[q][j];
                    m[j] += (f32x4){__builtin_bit_cast(float, w.x << 16), __builtin_bit_cast(float, w.x & 0xffff0000u), __builtin_bit_cast(float, w.y << 16), __builtin_bit_cast(float, w.y & 0xffff0000u)}; } }
        }
        f32x4 v[4]; float s = 0.f;
#pragma unroll
        for (int j = 0; j < 4; ++j) { const int c = 4 * F.lane + 256 * j;
            v[j] = xc[j] * ALPHA + *(const f32x4*)(mod + r * 6144 + 5120 + c) * m[j]; s += (v[j][0] + v[j][1]) + (v[j][2] + v[j][3]); }
        const float mean = wave_sum(s) * (1.0f / D); float s2 = 0.f;
#pragma unroll
        for (int j = 0; j < 4; ++j) { v[j] = v[j] - mean; s2 += (v[j][0] * v[j][0] + v[j][1] * v[j][1]) + (v[j][2] * v[j][2] + v[j][3] * v[j][3]); }
        const float rstd = 1.0f / sqrtf(wave_sum(s2) * (1.0f / D) + LN_EPS);
#pragma unroll
        for (int j = 0; j < 4; ++j) { const int c = 4 * F.lane + 256 * j;
            const f32x4 x = v[j] * rstd * *(const f32x4*)(lg + c) + *(const f32x4*)(lb + c);
            if (layer == 3) { *(f32x4*)(a->out + (size_t)row * D + c) = x; }
            else { *(f32x4*)(XC + (size_t)row * D + c) = x;
                const f32x4 h = x * (*(const f32x4*)(modn + r * 6144 + 1024 + c) + 1.0f) + *(const f32x4*)(modn + r * 6144 + c);
                v2u o; o.x = pk2(h[0], h[1]); o.y = pk2(h[2], h[3]); *(v2u*)(HB + (size_t)row * D + c) = o; } }
    }
}
#ifndef FFT_HD
#define FFT_HD __device__ __forceinline__
#endif
typedef float cf2 __attribute__((ext_vector_type(2)));
FFT_HD cf2 cmul(cf2 a, cf2 b) { return (cf2){a.x * b.x - a.y * b.y, a.x * b.y + a.y * b.x}; }
FFT_HD int fpad(int p) { return p + (p >> 5); }
constexpr int FFT_N = 8192, FFT_BUF = 8192 + 256;
template <bool INV> FFT_HD void dft4(cf2& a, cf2& b, cf2& c, cf2& d) {
    const cf2 s0 = a + c, s1 = a - c, s2 = b + d, s3 = b - d;
    const cf2 js3 = INV ? (cf2){-s3.y, s3.x} : (cf2){s3.y, -s3.x};
    a = s0 + s2; b = s1 + js3; c = s0 - s2; d = s1 - js3;
}
template <bool INV> FFT_HD void dft16(cf2 (&x)[16]) {
#pragma unroll
    for (int n0 = 0; n0 < 4; ++n0) dft4<INV>(x[n0], x[n0 + 4], x[n0 + 8], x[n0 + 12]);
    constexpr float C1 = 0.92387953251128674f, S1 = 0.38268343236508977f, R2 = 0.70710678118654752f;
    const float sg = INV ? 1.f : -1.f;
    const cf2 w1 = {C1, sg * S1}, w2 = {R2, sg * R2}, w3 = {S1, sg * C1}, w4 = {0.f, sg * 1.f}, w6 = {-R2, sg * R2}, w9 = {-C1, -sg * S1};
    x[1 + 4 * 1] = cmul(x[1 + 4 * 1], w1); x[1 + 4 * 2] = cmul(x[1 + 4 * 2], w2); x[1 + 4 * 3] = cmul(x[1 + 4 * 3], w3);
    x[2 + 4 * 1] = cmul(x[2 + 4 * 1], w2); x[2 + 4 * 2] = cmul(x[2 + 4 * 2], w4); x[2 + 4 * 3] = cmul(x[2 + 4 * 3], w6);
    x[3 + 4 * 1] = cmul(x[3 + 4 * 1], w3); x[3 + 4 * 2] = cmul(x[3 + 4 * 2], w6); x[3 + 4 * 3] = cmul(x[3 + 4 * 3], w9);
#pragma unroll
    for (int k0 = 0; k0 < 4; ++k0) dft4<INV>(x[0 + 4 * k0], x[1 + 4 * k0], x[2 + 4 * k0], x[3 + 4 * k0]);
#pragma unroll
    for (int i = 0; i < 4; ++i)
#pragma unroll
        for (int j = i + 1; j < 4; ++j) { const cf2 t = x[i + 4 * j]; x[i + 4 * j] = x[j + 4 * i]; x[j + 4 * i] = t; }
}
FFT_HD cf2 cmulc(cf2 a, cf2 b) { return (cf2){a.x * b.x + a.y * b.y, a.y * b.x - a.x * b.y}; }
template <bool INV, class BP> FFT_HD void stage_r16(BP buf, const cf2 (&tw)[15], int base, int stride) {
    cf2 x[16];
    const int pb = fpad(base), ps = stride + (stride >> 5);
#pragma unroll
    for (int i = 0; i < 16; ++i) x[i] = buf[pb + i * ps];
    if (!INV) { dft16<false>(x);
#pragma unroll
        for (int k = 1; k < 16; ++k) x[k] = cmulc(x[k], tw[k - 1]); }
    else {
#pragma unroll
        for (int k = 1; k < 16; ++k) x[k] = cmul(x[k], tw[k - 1]);
        dft16<true>(x); }
#pragma unroll
    for (int i = 0; i < 16; ++i) buf[pb + i * ps] = x[i];
}
template <class TP> FFT_HD void load_tw(TP TW, int tidx, cf2 (&tw)[15]) {
#pragma unroll
    for (int k = 1; k < 16; ++k) tw[k - 1] = TW[(tidx * k) & (FFT_N - 1)];
}
template <bool INV, class BP> FFT_HD void stage_r16_chain(BP buf, cf2 w, int base, int stride) {
    cf2 tw[15]; tw[0] = w;
#pragma unroll
    for (int k = 1; k < 15; ++k) tw[k] = cmul(tw[k - 1], w);
    stage_r16<INV>(buf, tw, base, stride);
}
template <bool INV, class BP> FFT_HD void stage_r32_load(BP buf, int blk, int r, cf2 (&u)[16]) {
    constexpr float CS[16] = {1.f, 0.98078528040323043f, 0.92387953251128674f, 0.83146961230254524f, 0.70710678118654752f, 0.55557023301960218f, 0.38268343236508977f, 0.19509032201612825f,
                              0.f, -0.19509032201612825f, -0.38268343236508977f, -0.55557023301960218f, -0.70710678118654752f, -0.83146961230254524f, -0.92387953251128674f, -0.98078528040323043f};
    constexpr float SN[16] = {0.f, 0.19509032201612825f, 0.38268343236508977f, 0.55557023301960218f, 0.70710678118654752f, 0.83146961230254524f, 0.92387953251128674f, 0.98078528040323043f,
                              1.f, 0.98078528040323043f, 0.92387953251128674f, 0.83146961230254524f, 0.70710678118654752f, 0.55557023301960218f, 0.38268343236508977f, 0.19509032201612825f};
    const int base = blk * 33;
#pragma unroll
    for (int n = 0; n < 16; ++n) { const cf2 lo = buf[base + n], hi = buf[base + n + 16];
        const cf2 s = lo + hi, d = lo - hi; const cf2 w = {CS[n], INV ? SN[n] : -SN[n]}; const cf2 dw = cmul(d, w);
        u[n] = r ? dw : s; }
    dft16<INV>(u);
}
template <class BP> FFT_HD void stage_r32_store(BP buf, int blk, int r, const cf2 (&u)[16]) {
    const int base = blk * 33;
#pragma unroll
    for (int g = 0; g < 16; ++g) buf[base + 2 * g + r] = u[g];
}
template <class BP> FFT_HD void fft_mul(BP Z, BP W, int tid, int o, float scale) {
    const int f2 = tid >> 5, f3 = tid & 31; const int pp = fpad(tid);
#pragma unroll 4
    for (int j = 0; j < 16; ++j) { const int f = j + 16 * f2 + 256 * f3; const int fm = (FFT_N - f) & (FFT_N - 1);
        const int pm = (fm & 15) * 512 + ((fm >> 4) & 15) * 32 + (fm >> 8);
        const cf2 a = W[pp + 528 * j], b = W[fpad(pm)];
        const cf2 k = o == 0 ? (cf2){0.5f * (a.x + b.x), 0.5f * (a.y - b.y)} : (cf2){0.5f * (a.y + b.y), 0.5f * (b.x - a.x)};
        const cf2 z = Z[pp + 528 * j]; Z[pp + 528 * j] = cmul(z, k) * scale; }
}
#ifndef FFT_HOST_ONLY
__device__ __forceinline__ void ld_tw2(const LAS cf2* tw2l, int tid, cf2 (&tw)[15]) {
#pragma unroll
    for (int k = 0; k < 15; ++k) tw[k] = tw2l[(tid & 31) * 15 + k];
}
__device__ __forceinline__ void fft_fwd(LAS cf2* buf, cf2 w1, const LAS cf2* tw2l, int tid) {
    asm volatile("" : "+v"(tid));
    stage_r16_chain<false>(buf, w1, tid, 512); __syncthreads();
    { cf2 tw[15]; ld_tw2(tw2l, tid, tw); stage_r16<false>(buf, tw, (tid >> 5) * 512 + (tid & 31), 32); } __syncthreads();
    { cf2 u[16]; stage_r32_load<false>(buf, tid >> 1, tid & 1, u); stage_r32_store(buf, tid >> 1, tid & 1, u); } __syncthreads();
}
__device__ __forceinline__ void fft_inv(LAS cf2* buf, cf2 w1, const LAS cf2* tw2l, int tid) {
    asm volatile("" : "+v"(tid));
    { cf2 u[16]; stage_r32_load<true>(buf, tid >> 1, tid & 1, u); stage_r32_store(buf, tid >> 1, tid & 1, u); } __syncthreads();
    { cf2 tw[15]; ld_tw2(tw2l, tid, tw); stage_r16<true>(buf, tw, (tid >> 5) * 512 + (tid & 31), 32); } __syncthreads();
    stage_r16_chain<true>(buf, w1, tid, 512); __syncthreads();
}
struct Raw8 { v4u mid; unsigned lo, hi; };
__device__ __forceinline__ Raw8 raw8_load(const bf16* p, int t0) { Raw8 r; r.mid = *(const v4u*)(p + t0); r.lo = t0 > 0 ? (unsigned)p[t0 - 1] : 0u; r.hi = t0 + 8 < SEQ ? (unsigned)p[t0 + 8] : 0u; return r; }
__device__ __forceinline__ void raw8_conv(const Raw8& r, float w0, float w1, float w2, float cb, float (&o)[8]) {
    float x[10]; x[0] = bf2f((unsigned short)r.lo); x[9] = bf2f((unsigned short)r.hi);
    const unsigned w[4] = {r.mid.x, r.mid.y, r.mid.z, r.mid.w};
#pragma unroll
    for (int j = 0; j < 4; ++j) { x[1 + 2 * j] = __builtin_bit_cast(float, w[j] << 16); x[2 + 2 * j] = __builtin_bit_cast(float, w[j] & 0xffff0000u); }
#pragma unroll
    for (int j = 0; j < 8; ++j) o[j] = w0 * x[j] + w1 * x[j + 1] + w2 * x[j + 2] + cb;
}
__device__ __forceinline__ void hy_fft_item(ArgsP a, const Fr& F, int slot, int d, cf2 wtw) {
    LAS cf2* Zb = (LAS cf2*)F.lds;
    LAS cf2* Wb = Zb + FFT_BUF;
    LAS float* red = (LAS float*)(Wb + FFT_BUF);
    const LAS cf2* tw2l = (const LAS cf2*)(red + 16);
    const bf16* PT = (const bf16*)(a->ws + SC_PT); bf16* Z2T = (bf16*)(a->ws + SC_Z2T);
    const float* HF = (const float*)(a->ws + WS_HF + (size_t)slot * HF_SLOT);
    const int tid = F.tid, t0 = 8 * tid;
    const int zb0 = t0 + (tid >> 2);
    __syncthreads();
    { const float* f0 = HF + (size_t)(0 * 1024 + d) * SEQ; const float* b0 = HF + (size_t)(1 * 1024 + d) * SEQ;
      const float* f1 = HF + (size_t)(2 * 1024 + d) * SEQ; const float* b1 = HF + (size_t)(3 * 1024 + d) * SEQ;
      float s0 = 0.f, s1 = 0.f; float fa[8], fb[8], ba[8], bb[8];
#pragma unroll
      for (int j = 0; j < 8; ++j) { const int t = tid + 512 * j; fa[j] = f0[t]; fb[j] = f1[t]; ba[j] = b0[t]; bb[j] = b1[t]; }
#pragma unroll
      for (int j = 0; j < 8; ++j) { const int t = tid + 512 * j; Wb[fpad(t)] = (cf2){fa[j], fb[j]}; s0 += fabsf(fa[j]); s1 += fabsf(fb[j]);
          if (t >= 1) { Wb[fpad(FFT_N - t)] = (cf2){ba[j], bb[j]}; s0 += fabsf(ba[j]); s1 += fabsf(bb[j]); } }
      if (tid == 0) Wb[fpad(SEQ)] = (cf2){0.f, 0.f};
      s0 = wave_sum(s0); s1 = wave_sum(s1); if (F.lane == 0) { red[F.wave] = s0; red[8 + F.wave] = s1; } }
    __syncthreads();
    float nrm0, nrm1; { float s0 = 0.f, s1 = 0.f; for (int w = 0; w < 8; ++w) { s0 += red[w]; s1 += red[8 + w]; } nrm0 = 1.0f / (s0 + 1e-6f); nrm1 = 1.0f / (s1 + 1e-6f); }
    fft_fwd(Wb, wtw, tw2l, tid);
    const float* cw = a->in[I_HYCW] + (size_t)slot * 3 * 3072; const float* cbp = a->in[I_HYCB] + (size_t)slot * 3072;
    float w0[3], w1[3], w2[3], cb[3];
#pragma unroll
    for (int g = 0; g < 3; ++g) { const int c = g * 1024 + d; w0[g] = cw[c]; w1[g] = cw[3072 + c]; w2[g] = cw[2 * 3072 + c]; cb[g] = cbp[c]; }
    const float fb0 = a->in[I_FBIAS][(slot * 2 + 0) * 1024 + d], fb1 = a->in[I_FBIAS][(slot * 2 + 1) * 1024 + d];
    const float sc0 = nrm0 * (1.0f / FFT_N), sc1 = nrm1 * (1.0f / FFT_N);
#pragma unroll 1
    for (int pr = 0; pr < 2; ++pr) {
        const bf16* pb = PT + (size_t)d * TA + (2 * pr) * SEQ;
        const Raw8 rv0 = raw8_load(pb, t0), rv1 = raw8_load(pb + SEQ, t0);
        float va[8], vb2[8];
        raw8_conv(rv0, w0[0], w1[0], w2[0], cb[0], va); raw8_conv(rv1, w0[0], w1[0], w2[0], cb[0], vb2);
        cf2 vin[8];
#pragma unroll
        for (int j = 0; j < 8; ++j) { vin[j] = (cf2){va[j], vb2[j]}; Zb[zb0 + j] = vin[j]; Zb[zb0 + j + SEQ + 128] = (cf2){0.f, 0.f}; }
        const Raw8 rx0 = raw8_load(pb + (size_t)1024 * TA, t0), rx1 = raw8_load(pb + (size_t)1024 * TA + SEQ, t0);
        __syncthreads();
        fft_fwd(Zb, wtw, tw2l, tid); { int tl = tid; asm volatile("" : "+v"(tl)); fft_mul(Zb, Wb, tl, 0, sc0); } __syncthreads(); fft_inv(Zb, wtw, tw2l, tid);
        raw8_conv(rx0, w0[1], w1[1], w2[1], cb[1], va); raw8_conv(rx1, w0[1], w1[1], w2[1], cb[1], vb2);
#pragma unroll
        for (int j = 0; j < 8; ++j) { const cf2 y = Zb[zb0 + j]; const cf2 xg = {va[j], vb2[j]}; vin[j] = xg * (y + vin[j] * fb0); }
        __syncthreads();
#pragma unroll
        for (int j = 0; j < 8; ++j) { Zb[zb0 + j] = vin[j]; Zb[zb0 + j + SEQ + 128] = (cf2){0.f, 0.f}; }
        const Raw8 rz0 = raw8_load(pb + (size_t)2048 * TA, t0), rz1 = raw8_load(pb + (size_t)2048 * TA + SEQ, t0);
        __syncthreads();
        fft_fwd(Zb, wtw, tw2l, tid); { int tl = tid; asm volatile("" : "+v"(tl)); fft_mul(Zb, Wb, tl, 1, sc1); } __syncthreads(); fft_inv(Zb, wtw, tw2l, tid);
        raw8_conv(rz0, w0[2], w1[2], w2[2], cb[2], va); raw8_conv(rz1, w0[2], w1[2], w2[2], cb[2], vb2);
        float z0[8], z1[8];
#pragma unroll
        for (int j = 0; j < 8; ++j) { const cf2 y = Zb[zb0 + j]; const cf2 xg = {va[j], vb2[j]}; const cf2 z = xg * (y + vin[j] * fb1); z0[j] = z.x; z1[j] = z.y; }
        bf16* o0 = Z2T + (size_t)d * TA + (2 * pr) * SEQ + t0;
        v4u q0, q1; q0.x = pk2(z0[0], z0[1]); q0.y = pk2(z0[2], z0[3]); q0.z = pk2(z0[4], z0[5]); q0.w = pk2(z0[6], z0[7]);
        q1.x = pk2(z1[0], z1[1]); q1.y = pk2(z1[2], z1[3]); q1.z = pk2(z1[4], z1[5]); q1.w = pk2(z1[6], z1[7]);
        *(v4u*)o0 = q0; *(v4u*)(o0 + SEQ) = q1;
        __syncthreads();
    }
}
__device__ __forceinline__ void phase_hy_conv_fft(ArgsP a, const Fr& F, int layer) {
    const int slot = layer == 0 ? 0 : 1; const int nitems = layer == 0 ? 2048 : 1024;
    {   const cf2* TW = (const cf2*)(a->ws + WS_TW);
        LAS cf2* tw2l = (LAS cf2*)((LAS float*)((LAS cf2*)F.lds + 2 * FFT_BUF) + 16);
        __syncthreads();
        if (F.tid < 32 * 15) { const int n3 = F.tid / 15, k = F.tid % 15 + 1; tw2l[F.tid] = TW[(16 * n3 * k) & (FFT_N - 1)]; }
        const cf2 w1 = TW[F.tid];
        __syncthreads();
        for (int it = F.vcu; it < 1024; it += F.G) hy_fft_item(a, F, slot, it, w1);
    }
    for (int it = 1024 + F.vcu; it < nitems; it += F.G) hy_direct_item<LC>(a, F, slot, it - 1024, T, (const float*)(a->ws + WS_HF + HF_CTX));
}
#endif
#include <hip/hip_bf16.h>
namespace attn_body {
using bf16=__hip_bfloat16;
using bf16x8=__attribute__((ext_vector_type(8)))short;
using s16x4=__attribute__((ext_vector_type(4)))short;
using f32x16=__attribute__((ext_vector_type(16)))float;
using u32x4=__attribute__((ext_vector_type(4)))unsigned;
constexpr int BATCH=4,NHEAD=16,SEQ=4096,D=64,DM=NHEAD*D,KP=256,LKEYS=4352;
constexpr int NW=8,QBLK=32,QB=QBLK*NW,KVBLK=64,NQB=SEQ/QB;
constexpr int ATTN_PITCH=DM, ATTN_UNIT_ROWS=QB;
__device__ __forceinline__ int crow(int r,int hi){return (r&3)+8*(r>>2)+4*hi;}
#define SBAR() __builtin_amdgcn_sched_barrier(0)
__device__ __forceinline__ void cmask(f32x16&p0,f32x16&p1,int jb,int qrel,int hi){
  const float NEG=-INFINITY; int kb=64*jb+4*hi;
  #pragma unroll
  for(int r=0;r<16;++r){int kv=kb+(r&3)+8*(r>>2); if(kv>qrel)p0[r]=NEG; if(kv+32>qrel)p1[r]=NEG;}
}

constexpr int NSLOT=3, SLOTB=8192;
constexpr int LDS_K=0, LDS_V=NSLOT*SLOTB, LDS_WS=2*NSLOT*SLOTB, LDS_OST=LDS_WS+NW*64*4, LDS_BYTES=LDS_OST+NW*4096;
constexpr float C2=0.125f*1.4426950408889634f;
__device__ __forceinline__ void glds16(const void*gsrc,unsigned lds_dst){unsigned keep;
  asm volatile("s_mov_b32 %0, m0\n\ts_mov_b32 m0, %2\n\ts_nop 0\n\tglobal_load_lds_dwordx4 %1, off\n\ts_mov_b32 m0, %0":"=&s"(keep):"v"(gsrc),"s"(lds_dst):"memory");}
__device__ __forceinline__ float max3f(float a,float b,float c){float r;asm("v_max3_f32 %0, %1, %2, %3":"=v"(r):"v"(a),"v"(b),"v"(c));return r;}
__device__ __forceinline__ float max2f(float a,float b){float r;asm("v_max_f32_e32 %0, %1, %2":"=v"(r):"v"(a),"v"(b));return r;}
__device__ __forceinline__ float fadd_s(float a,float b){float r;asm("v_add_f32_e32 %0, %1, %2":"=v"(r):"v"(a),"v"(b));return r;}
__device__ __forceinline__ float fsub_s(float a,float b){float r;asm("v_sub_f32_e32 %0, %1, %2":"=v"(r):"v"(a),"v"(b));return r;}
typedef float f32x2_t __attribute__((ext_vector_type(2))); typedef __bf16 bf16x2_t __attribute__((ext_vector_type(2)));
__device__ __forceinline__ unsigned cvtpk_s(float lo,float hi){f32x2_t v={lo,hi};bf16x2_t b=__builtin_convertvector(v,bf16x2_t);return __builtin_bit_cast(unsigned,b);}
#define WAIT_BAR(N) asm volatile("s_waitcnt vmcnt(" #N ") lgkmcnt(0)\n\ts_barrier":::"memory")

__device__ __forceinline__ void qkt(f32x16&p0,f32x16&p1,const char*Kslot,const bf16x8*qr,const f32x16&negm,int r32,int hi){
  const char*kb=Kslot+hi*1024+r32*16;
  #pragma unroll
  for(int d0=0;d0<4;++d0){
    const bf16x8 b0=*reinterpret_cast<const bf16x8*>(kb+d0*2048);
    const bf16x8 b1=*reinterpret_cast<const bf16x8*>(kb+d0*2048+512);
    if(d0==0){p0=__builtin_amdgcn_mfma_f32_32x32x16_bf16(b0,qr[0],negm,0,0,0);p1=__builtin_amdgcn_mfma_f32_32x32x16_bf16(b1,qr[0],negm,0,0,0);}
    else{p0=__builtin_amdgcn_mfma_f32_32x32x16_bf16(b0,qr[d0],p0,0,0,0);p1=__builtin_amdgcn_mfma_f32_32x32x16_bf16(b1,qr[d0],p1,0,0,0);}}
}
typedef __attribute__((address_space(3))) const char* lds_cptr;
typedef short v4i16_t __attribute__((ext_vector_type(4)));
__device__ __forceinline__ void kload8(bf16x8*kf,lds_cptr kp){
  kf[0]=*(const __attribute__((address_space(3))) bf16x8*)(kp);      kf[1]=*(const __attribute__((address_space(3))) bf16x8*)(kp+512);
  kf[2]=*(const __attribute__((address_space(3))) bf16x8*)(kp+2048); kf[3]=*(const __attribute__((address_space(3))) bf16x8*)(kp+2560);
  kf[4]=*(const __attribute__((address_space(3))) bf16x8*)(kp+4096); kf[5]=*(const __attribute__((address_space(3))) bf16x8*)(kp+4608);
  kf[6]=*(const __attribute__((address_space(3))) bf16x8*)(kp+6144); kf[7]=*(const __attribute__((address_space(3))) bf16x8*)(kp+6656);
}
__device__ __forceinline__ void kload2(bf16x8*kf,lds_cptr kp,int j){ kf[2*j]=*(const __attribute__((address_space(3))) bf16x8*)(kp+j*2048); kf[2*j+1]=*(const __attribute__((address_space(3))) bf16x8*)(kp+j*2048+512); }
__device__ __forceinline__ s16x4 vtr(lds_cptr p){ return __builtin_bit_cast(s16x4,__builtin_amdgcn_ds_read_tr16_b64_v4i16((__attribute__((address_space(3))) v4i16_t*)p)); }
__device__ __forceinline__ float rowmax(const f32x16&p0,const f32x16&p1){
  float a=max3f(p0[0],p0[1],p1[0]),b=max3f(p0[2],p0[3],p1[1]);a=max3f(a,p1[2],p1[3]);
  #pragma unroll
  for(int r=4;r<16;r+=4){a=max3f(a,p0[r],p0[r+1]);b=max3f(b,p0[r+2],p0[r+3]);a=max3f(a,p1[r],p1[r+1]);b=max3f(b,p1[r+2],p1[r+3]);}
  const float m=max2f(a,b);
  auto rr=__builtin_amdgcn_permlane32_swap(__float_as_uint(m),__float_as_uint(m),false,false);
  return max2f(__uint_as_float(rr[0]),__uint_as_float(rr[1]));
}
__device__ __forceinline__ void pv(f32x16*o,int vb,bf16x8 pa0,bf16x8 pa1,bf16x8 pa2,bf16x8 pa3){
  #pragma unroll
  for(int d0=0;d0<2;++d0){s16x4 lo[4],hi[4];
    #pragma unroll
    for(int ks=0;ks<4;++ks){
      asm volatile("ds_read_b64_tr_b16 %0,%1 offset:%c2":"=&v"(lo[ks]):"v"(vb),"i"(d0*4096+ks*1024):"memory");
      asm volatile("ds_read_b64_tr_b16 %0,%1 offset:%c2":"=&v"(hi[ks]):"v"(vb),"i"(d0*4096+ks*1024+512):"memory");}
    asm volatile("s_waitcnt lgkmcnt(0)":::"memory");SBAR();
    #define PK(k) (bf16x8){lo[k][0],lo[k][1],lo[k][2],lo[k][3],hi[k][0],hi[k][1],hi[k][2],hi[k][3]}
    o[d0]=__builtin_amdgcn_mfma_f32_32x32x16_bf16(pa0,PK(0),o[d0],0,0,0);
    o[d0]=__builtin_amdgcn_mfma_f32_32x32x16_bf16(pa1,PK(1),o[d0],0,0,0);
    o[d0]=__builtin_amdgcn_mfma_f32_32x32x16_bf16(pa2,PK(2),o[d0],0,0,0);
    o[d0]=__builtin_amdgcn_mfma_f32_32x32x16_bf16(pa3,PK(3),o[d0],0,0,0);
    #undef PK
  }
}

#ifndef ATTN_STORE16
#define ATTN_STORE16(p,v) (*(u32x4*)(p)=(v))
#endif
template<int THRL> __device__ __forceinline__ void attn_unit(int b,int h,int qb,const bf16*Q,const bf16*__restrict__ K,const bf16*__restrict__ V,bf16*O,char*shm){
  int tid_=threadIdx.x; asm volatile("":"+v"(tid_)); const int tid=tid_,lane=tid&63,r32=lane&31,hi=lane>>5; const int wid=__builtin_amdgcn_readfirstlane(tid>>6);
  const long rowbase=(long)b*SEQ; const int q0=qb*QB;
  const bf16*Qw=Q+(rowbase+q0+wid*QBLK)*DM+h*D;
  const bf16*Kh=K+(long)b*LKEYS*KP+(h>>2)*D,*Vh=V+(long)b*LKEYS*KP+(h>>2)*D;
  const unsigned lds0=(unsigned)(uintptr_t)shm;
  float*wsf=(float*)(shm+LDS_WS)+wid*64;
  const bf16*ksrc=Kh+(long)lane*KP+wid*8;
  const bf16*vsrc=Vh+(long)(16*(wid&3)+(lane>>2))*KP+(wid>>2)*32+(lane&3)*8;
  const unsigned kdst=lds0+LDS_K+wid*1024, vdst=lds0+LDS_V+wid*1024;
  #define DMA_K(t,slot) glds16(ksrc+(long)(t)*KVBLK*KP,(unsigned)__builtin_amdgcn_readfirstlane(kdst+(slot)))
  #define DMA_V(t,slot) glds16(vsrc+(long)(t)*KVBLK*KP,(unsigned)__builtin_amdgcn_readfirstlane(vdst+(slot)))
  const int vb0=(int)(lds0+LDS_V)+((lane>>4)&1)*32+(lane&3)*8+(4*hi+((lane&15)>>2))*64;
  const char*Kbase=shm+LDS_K; bf16x8 kf[8];
  const lds_cptr shm3=(lds_cptr)shm; const lds_cptr kp0=shm3+LDS_K+hi*1024+r32*16; const lds_cptr vp0=shm3+LDS_V+((lane>>4)&1)*32+(lane&3)*8+(4*hi+((lane&15)>>2))*64;
  const int NT=LKEYS/KVBLK;
  DMA_K(0,0);DMA_V(0,0);DMA_K(1,SLOTB);
  bf16x8 qr[4];
  #pragma unroll
  for(int d0=0;d0<4;++d0)qr[d0]=*reinterpret_cast<const bf16x8*>(&Qw[(long)r32*DM+d0*16+hi*8]);
  float mhat=0.f,l_reg=0.f;f32x16 o[2];o[0]=f32x16{};o[1]=f32x16{};f32x16 negm=f32x16{};asm volatile("":"+v"(negm));

  #define CMASK(P0,P1,t) do{}while(0)
  bool resc=false;
  #define START(P0,P1) do{ const float rm=rowmax(P0,P1); resc=false; \
    { const float dl=rm; mhat=fadd_s(mhat,dl); \
      _Pragma("unroll") for(int r=0;r<16;++r){P0[r]=fsub_s(P0[r],dl);P1[r]=fsub_s(P1[r],dl);} \
      _Pragma("unroll") for(int r=0;r<16;++r)negm[r]=-mhat; asm volatile("":"+v"(negm)); } \
    _Pragma("unroll") for(int r=0;r<16;++r)P0[r]=__builtin_amdgcn_exp2f(P0[r]); }while(0)
  #define RESC() do{ if(resc){ asm volatile("s_waitcnt lgkmcnt(0)":::"memory"); \
      _Pragma("unroll") for(int d_=0;d_<2;++d_) _Pragma("unroll") for(int r=0;r<16;++r)o[d_][r]*=wsf[crow(r,hi)]; } }while(0)
  f32x16 pA0,pA1,pB0,pB1;
  int sl_prev=0,sl_cur=0,sl_next=SLOTB;
  #define ROT() do{sl_prev=sl_cur;sl_cur=sl_next;sl_next=(sl_next==(NSLOT-1)*SLOTB)?0:sl_next+SLOTB;}while(0)
  DMA_K(2,2*SLOTB);
  WAIT_BAR(3);
  qkt(pA0,pA1,Kbase,qr,negm,r32,hi);asm volatile("s_nop 15\n\ts_nop 7":"+v"(pA0),"+v"(pA1));CMASK(pA0,pA1,0);
  START(pA0,pA1);
  _Pragma("unroll") for(int r=0;r<16;++r)pA1[r]=__builtin_amdgcn_exp2f(pA1[r]);
  WAIT_BAR(0);
  DMA_K(3,0);DMA_V(1,SLOTB);
  ROT();
  kload8(kf,kp0+sl_cur);
  WAIT_BAR(2);
  s16x4 vlo[8],vhi[8]; u32x4 pw0,pw1,pw2,pw3;
  #define PKW(P,B) cvtpk_s(P[B],P[B+1])
  #define PAF(k) __builtin_bit_cast(bf16x8,pw##k)
  #define VFR(i) (bf16x8){vlo[i][0],vlo[i][1],vlo[i][2],vlo[i][3],vhi[i][0],vhi[i][1],vhi[i][2],vhi[i][3]}
  #define PIN(x) asm volatile("":"+v"(x))
  #define MX3(a,b,c) __builtin_fmaxf(__builtin_fmaxf((a),(b)),(c))
  #define GAPA(MF,A0,A1,A2,A3,W0,W1,PW) do{ MF; sacc+=A0; sacc+=A1; sacc+=A2; sacc+=A3; PIN(sacc); W0; W1; PIN(PW); SBAR(); }while(0)
  #define EX(v) __builtin_amdgcn_exp2f(v)
  #define GAPB(MF,X,B) do{ MF; X[B]=EX(X[B]); X[B+1]=EX(X[B+1]); X[B+2]=EX(X[B+2]); X[B+3]=EX(X[B+3]); PIN(X); SBAR(); }while(0)
  #define VRD(i) do{ vlo[i]=vtr(vp_+(((i)>>2)*4096+((i)&3)*1024)); vhi[i]=vtr(vp_+(((i)>>2)*4096+((i)&3)*1024+512)); }while(0)
  #define KRD(G,j) do{ if(G){ kload2(kf,kp0+sl_next,j); SBAR(); } }while(0)
  #define STEP(C0,C1,P0,P1,t,GK,GV,GL) do{ SBAR(); \
    const lds_cptr vp_=vp0+sl_prev; \
    VRD(0); SBAR(); float sacc=(P0[0]+P0[1]); \
    GAPA(C0=__builtin_amdgcn_mfma_f32_32x32x16_bf16(kf[0],qr[0],negm,0,0,0), P0[2],P0[3],P0[4],P0[5],     pw0[0]=PKW(P0,0), pw0[1]=PKW(P0,2), pw0); \
    VRD(4); SBAR(); GAPA(C1=__builtin_amdgcn_mfma_f32_32x32x16_bf16(kf[1],qr[0],negm,0,0,0), P0[6],P0[7],P0[8],P0[9],     pw0[2]=PKW(P0,4), pw0[3]=PKW(P0,6), pw0); \
    VRD(1); SBAR(); GAPA(C0=__builtin_amdgcn_mfma_f32_32x32x16_bf16(kf[2],qr[1],C0,0,0,0),   P0[10],P0[11],P0[12],P0[13], pw1[0]=PKW(P0,8), pw1[1]=PKW(P0,10), pw1); \
    VRD(5); SBAR(); GAPA(C1=__builtin_amdgcn_mfma_f32_32x32x16_bf16(kf[3],qr[1],C1,0,0,0),   P0[14],P0[15],P1[0],P1[1],   pw1[2]=PKW(P0,12),pw1[3]=PKW(P0,14), pw1); \
    VRD(2); SBAR(); GAPA(C0=__builtin_amdgcn_mfma_f32_32x32x16_bf16(kf[4],qr[2],C0,0,0,0),   P1[2],P1[3],P1[4],P1[5],     pw2[0]=PKW(P1,0), pw2[1]=PKW(P1,2), pw2); \
    VRD(6); SBAR(); GAPA(C1=__builtin_amdgcn_mfma_f32_32x32x16_bf16(kf[5],qr[2],C1,0,0,0),   P1[6],P1[7],P1[8],P1[9],     pw2[2]=PKW(P1,4), pw2[3]=PKW(P1,6), pw2); \
    VRD(3); SBAR(); GAPA(C0=__builtin_amdgcn_mfma_f32_32x32x16_bf16(kf[6],qr[3],C0,0,0,0),   P1[10],P1[11],P1[12],P1[13], pw3[0]=PKW(P1,8), pw3[1]=PKW(P1,10), pw3); \
    VRD(7); SBAR(); GAPA(C1=__builtin_amdgcn_mfma_f32_32x32x16_bf16(kf[7],qr[3],C1,0,0,0),   P1[14],P1[15],0.f,0.f,       pw3[2]=PKW(P1,12),pw3[3]=PKW(P1,14), pw3); \
    l_reg+=sacc; \
    if(GK){DMA_K((t)+3,sl_cur);} if(GV){DMA_V((t)+1,sl_next);} \
    CMASK(C0,C1,t); \
    { float a=MX3(C0[0],C0[1],C1[0]),b=MX3(C0[2],C0[3],C1[1]); a=MX3(a,C1[2],C1[3]); \
      _Pragma("unroll") for(int r=4;r<16;r+=4){a=MX3(a,C0[r],C0[r+1]);b=MX3(b,C0[r+2],C0[r+3]);a=MX3(a,C1[r],C1[r+1]);b=MX3(b,C1[r+2],C1[r+3]);} \
      float rm=__builtin_fmaxf(a,b); { auto rr=__builtin_amdgcn_permlane32_swap(__float_as_uint(rm),__float_as_uint(rm),false,false); rm=__builtin_fmaxf(__uint_as_float(rr[0]),__uint_as_float(rr[1])); } \
      resc=false; \
      if(__builtin_expect(__any(rm>(float)THRL),0)){ const float dl=__builtin_fmaxf(rm,0.f); mhat+=dl; \
        _Pragma("unroll") for(int r=0;r<16;++r){C0[r]-=dl;C1[r]-=dl;} \
        _Pragma("unroll") for(int r=0;r<16;++r)negm[r]=-mhat; asm volatile("":"+v"(negm)); \
        const float f=__builtin_amdgcn_exp2f(-dl); l_reg*=f; if(hi==0)wsf[r32]=f; resc=true; } } \
    SBAR(); \
    GAPB(o[0]=__builtin_amdgcn_mfma_f32_32x32x16_bf16(PAF(0),VFR(0),o[0],0,0,0), C0,0); \
    GAPB(o[1]=__builtin_amdgcn_mfma_f32_32x32x16_bf16(PAF(0),VFR(4),o[1],0,0,0), C0,4); \
    KRD(GL,0); GAPB(o[0]=__builtin_amdgcn_mfma_f32_32x32x16_bf16(PAF(1),VFR(1),o[0],0,0,0), C0,8); \
    KRD(GL,1); GAPB(o[1]=__builtin_amdgcn_mfma_f32_32x32x16_bf16(PAF(1),VFR(5),o[1],0,0,0), C0,12); \
    KRD(GL,2); GAPB(o[0]=__builtin_amdgcn_mfma_f32_32x32x16_bf16(PAF(2),VFR(2),o[0],0,0,0), C1,0); \
    KRD(GL,3); GAPB(o[1]=__builtin_amdgcn_mfma_f32_32x32x16_bf16(PAF(2),VFR(6),o[1],0,0,0), C1,4); \
    GAPB(o[0]=__builtin_amdgcn_mfma_f32_32x32x16_bf16(PAF(3),VFR(3),o[0],0,0,0), C1,8); \
    GAPB(o[1]=__builtin_amdgcn_mfma_f32_32x32x16_bf16(PAF(3),VFR(7),o[1],0,0,0), C1,12); \
    }while(0)
  int t=1;
  #undef CMASK
  #define CMASK(P0,P1,t) do{}while(0)
  for(;t+5<NT;t+=2){
    STEP(pB0,pB1,pA0,pA1,t,true,true,true);     WAIT_BAR(2); RESC(); ROT();
    STEP(pA0,pA1,pB0,pB1,t+1,true,true,true);   WAIT_BAR(2); RESC(); ROT();
  }
  #undef CMASK
  #define CMASK(P0,P1,t) do{}while(0)
  #define ENDW(tt) do{ if((tt)+3<NT){WAIT_BAR(2);} else if((tt)+2<NT){WAIT_BAR(1);} else {WAIT_BAR(0);} }while(0)
  for(;t+1<NT;t+=2){
    STEP(pB0,pB1,pA0,pA1,t,(t+3<NT),(t+1<NT),(t+1<NT));       ENDW(t);   RESC(); ROT();
    STEP(pA0,pA1,pB0,pB1,t+1,(t+4<NT),(t+2<NT),(t+2<NT));     ENDW(t+1); RESC(); ROT();
  }
  STEP(pB0,pB1,pA0,pA1,NT-1,false,false,false); RESC();
  { float sacc=pB0[0]+pB0[1]; _Pragma("unroll") for(int r=2;r<16;++r)sacc+=pB0[r]; _Pragma("unroll") for(int r=0;r<16;++r)sacc+=pB1[r]; l_reg+=sacc;
    pw0=(u32x4){PKW(pB0,0),PKW(pB0,2),PKW(pB0,4),PKW(pB0,6)};pw1=(u32x4){PKW(pB0,8),PKW(pB0,10),PKW(pB0,12),PKW(pB0,14)};pw2=(u32x4){PKW(pB1,0),PKW(pB1,2),PKW(pB1,4),PKW(pB1,6)};pw3=(u32x4){PKW(pB1,8),PKW(pB1,10),PKW(pB1,12),PKW(pB1,14)};
    SBAR(); pv(o,vb0+sl_cur,PAF(0),PAF(1),PAF(2),PAF(3)); }
  #undef PKW
  #undef PAF
  #undef VFR
  #undef PIN
  #undef MX3
  #undef GAPA
  #undef GAPB
  #undef EX
  #undef VRD
  #undef KRD
  #undef STEP
  #undef ENDW
  {auto rr=__builtin_amdgcn_permlane32_swap(__float_as_uint(l_reg),__float_as_uint(l_reg),false,false);l_reg=__uint_as_float(rr[0])+__uint_as_float(rr[1]);}
  if(hi==0)wsf[32+r32]=l_reg;asm volatile("s_waitcnt lgkmcnt(0)":::"memory");
  float rli[16];
  #pragma unroll
  for(int r=0;r<16;++r)rli[r]=__builtin_amdgcn_rcpf(wsf[32+crow(r,hi)]);
  bf16*Ow=O+(rowbase+q0+wid*QBLK)*DM+h*D;
  { bf16*stg=(bf16*)(shm+LDS_OST)+wid*2048;
    #pragma unroll
    for(int r=0;r<16;++r){const int orow=crow(r,hi);
      #pragma unroll
      for(int d0=0;d0<2;++d0)stg[orow*64+d0*32+r32]=__float2bfloat16(o[d0][r]*rli[r]);}
    asm volatile("s_waitcnt lgkmcnt(0)":::"memory");
    #pragma unroll
    for(int i=0;i<4;++i){const int row=i*8+(lane>>3),ch=lane&7; const u32x4 v=*(const u32x4*)(stg+row*64+ch*8); ATTN_STORE16(Ow+(long)row*DM+ch*8,v);} }
  asm volatile("s_waitcnt lgkmcnt(0)\n\ts_barrier":::"memory");
  #undef DMA_K
  #undef DMA_V
  #undef CMASK
  #undef START
  #undef RESC
  #undef ROT
}
constexpr int ATTN_LDS_BYTES=LDS_BYTES;
struct AttnTensors { const bf16* Q; const bf16* K; const bf16* V; bf16* O; };
struct AttnUnit { int bh; int qb; };
struct StaticOrder {
  int vcu, per;
  __device__ __forceinline__ explicit StaticOrder(int grid,int vcu_):vcu(vcu_),per((BATCH*NHEAD*(SEQ/QB)+grid-1)/grid){}
  __device__ __forceinline__ bool next(int i,AttnUnit&u)const{ if(i>=per)return false; const int idx=vcu*per+i; if(idx>=BATCH*NHEAD*(SEQ/QB))return false; u.bh=idx/(SEQ/QB); u.qb=idx%(SEQ/QB); return true; }
  __device__ __forceinline__ void a_ready(const AttnUnit&)const{}
  __device__ __forceinline__ void done(const AttnUnit&)const{}
};
template<class Sched,int THRL=8> __device__ __forceinline__ void attn_phase(char*lds,const AttnTensors&T,const Sched&S){
  AttnUnit u;
  for(int i=0;S.next(i,u);++i){ S.a_ready(u); attn_unit<THRL>(u.bh/NHEAD,u.bh%NHEAD,u.qb,T.Q,T.K,T.V,T.O,lds); S.done(u); }
}
#undef SBAR
#undef WAIT_BAR
}

__device__ __forceinline__ void phase_attn_fast(ArgsP a, const Fr& F) {
    const attn_body::AttnTensors AT{(const attn_body::bf16*)(a->ws + SC_Q), (const attn_body::bf16*)(a->ws + SC_K), (const attn_body::bf16*)(a->ws + SC_V), (attn_body::bf16*)(a->ws + SC_O)};
    const attn_body::StaticOrder S(F.G, F.vcu);
    __syncthreads();
    attn_body::attn_phase<attn_body::StaticOrder>((char*)F.lds, AT, S);
    __syncthreads();
}
__device__ __forceinline__ void phase_sp_fast(ArgsP a, const Fr& F) {
    typedef short bf16x8 __attribute__((ext_vector_type(8)));
    constexpr int PITCH = 136;
    LAS unsigned short* As = (LAS unsigned short*)F.lds;
    LAS unsigned short* Bs = As + 128 * PITCH;
    LAS float* st = (LAS float*)(Bs + 128 * PITCH);
    const float* VT = (const float*)(a->ws + SC_VT); const f32x2* VST = (const f32x2*)(a->ws + SC_VST); const bf16* UB = (const bf16*)(a->ws + SC_UB); bf16* UV = (bf16*)(a->ws + SC_UV);
    const bf16* WS = (const bf16*)(a->ws + WS_WCMS);
    const float* lng = a->in[I_CMLNG]; const float* lnb = a->in[I_CMLNB]; const float* bs = a->in[I_CMBS];
    const int tid = F.tid, lane = F.lane, wid = F.wave, wr = wid >> 2, wc = wid & 3, fr = lane & 15, fq = lane >> 4;
    const int per = (2048 + F.G - 1) / F.G; int gl = -1;
    for (int it = F.vcu * per; it < (F.vcu + 1) * per && it < 2048; ++it) {
        const int g = it >> 7, n = it & 127;
        __syncthreads();
        if (g != gl) { gl = g;
#pragma unroll
            for (int q = 0; q < 4; ++q) { const int idx = tid + q * NTHR, t = idx >> 4, ck = idx & 15;
                *(LAS v4u*)(As + t * PITCH + ck * 8) = *(const v4u*)(WS + (size_t)g * 16384 + t * 128 + ck * 8); } }
        if (tid < 128) { float s1 = 0.f, s2 = 0.f;
#pragma unroll
            for (int p = 0; p < 16; ++p) { const f32x2 v = VST[(size_t)p * T + n * 128 + tid]; s1 += v.x; s2 += v.y; }
            const float mean = s1 * (1.0f / 2048.0f); const float var = s2 * (1.0f / 2048.0f) - mean * mean; st[tid * 2] = mean; st[tid * 2 + 1] = 1.0f / sqrtf(var + LN_EPS); }
        __syncthreads();
        { const int s4 = (lane & 31) * 4; const int ch = lane >> 5;
          const f32x4 mu = {st[(s4 + 0) * 2], st[(s4 + 1) * 2], st[(s4 + 2) * 2], st[(s4 + 3) * 2]};
          const f32x4 rs = {st[(s4 + 0) * 2 + 1], st[(s4 + 1) * 2 + 1], st[(s4 + 2) * 2 + 1], st[(s4 + 3) * 2 + 1]};
#pragma unroll
          for (int q = 0; q < 8; ++q) { const int c = q * 16 + wid * 2 + ch; const int chn = g * 128 + c;
              const f32x4 v = *(const f32x4*)(VT + (size_t)chn * T + n * 128 + s4);
              const float lg = lng[chn], lb = lnb[chn];
              const f32x4 y = (v - mu) * rs * lg + lb;
              v2u o; o.x = pk2(y[0], y[1]); o.y = pk2(y[2], y[3]); *(LAS v2u*)(Bs + c * PITCH + s4) = o; } }
        __syncthreads();
        f32x4 acc[4][2];
#pragma unroll
        for (int m = 0; m < 4; ++m)
#pragma unroll
            for (int nn = 0; nn < 2; ++nn) acc[m][nn] = (f32x4){0.f, 0.f, 0.f, 0.f};
#pragma unroll
        for (int k = 0; k < 4; ++k) {
            bf16x8 af[4], bfr[2];
#pragma unroll
            for (int m = 0; m < 4; ++m) af[m] = *(const LAS bf16x8*)(As + (wr * 64 + m * 16 + fr) * PITCH + k * 32 + fq * 8);
#pragma unroll
            for (int nn = 0; nn < 2; ++nn) bfr[nn] = *(const LAS bf16x8*)(Bs + (wc * 32 + nn * 16 + fr) * PITCH + k * 32 + fq * 8);
#pragma unroll
            for (int m = 0; m < 4; ++m)
#pragma unroll
                for (int nn = 0; nn < 2; ++nn) acc[m][nn] = __builtin_amdgcn_mfma_f32_16x16x32_bf16(bfr[nn], af[m], acc[m][nn], 0, 0, 0);
        }
#pragma unroll
        for (int m = 0; m < 4; ++m) { const int t = wr * 64 + m * 16 + fr; const float bt = bs[g * 128 + t];
#pragma unroll
            for (int nn = 0; nn < 2; ++nn) { const size_t idx = (size_t)(n * 128 + t) * 2048 + g * 128 + wc * 32 + nn * 16 + 4 * fq;
                const v2u ub = *(const v2u*)(UB + idx); const f32x4 o = acc[m][nn] + bt;
                v2u w; w.x = pk2(__builtin_bit_cast(float, ub.x << 16) * o[0], __builtin_bit_cast(float, ub.x & 0xffff0000u) * o[1]);
                w.y = pk2(__builtin_bit_cast(float, ub.y << 16) * o[2], __builtin_bit_cast(float, ub.y & 0xffff0000u) * o[3]);
                *(v2u*)(UV + idx) = w; } }
    }
}
__device__ __forceinline__ void phase_rope(ArgsP a, const Fr& F) {
    const float* QKV = (const float*)(a->ws + SC_QKV); bf16* Q = (bf16*)(a->ws + SC_Q); bf16* K = (bf16*)(a->ws + SC_K); bf16* V = (bf16*)(a->ws + SC_V);
    const int gw = F.vcu * NWAVES + F.wave, NGW = F.G * NWAVES;
    const int i = F.lane & 31, hs = F.lane >> 5;
    const float qg0 = a->in[I_QGAIN][i], qg1 = a->in[I_QGAIN][i + 32], kg0 = a->in[I_KGAIN][i], kg1 = a->in[I_KGAIN][i + 32];
    const float invf = powf(10000.0f, -(float)(i & 15) / 16.0f);
    for (int row = gw; row < TA; row += NGW) {
        const bool lat = row < T; const int b = lat ? (row >> 12) : ((row - T) >> 8); const int t = lat ? (row & 4095) : ((row - T) & 255);
        float cs = 1.f, sn = 0.f;
        if (lat) { const float pos = (i < 16) ? (float)(t >> 6) : (float)(t & 63); sincosf(pos * invf, &sn, &cs); }
        const float* src = QKV + (size_t)row * 1536;
        const size_t krow = (size_t)b * LK + (lat ? LC + t : t);
#pragma unroll
        for (int j = 0; j < 12; ++j) { const int hh = 2 * j + hs;
            if (!lat && hh < 16) continue;
            const float x1 = src[hh * 64 + i], x2 = src[hh * 64 + 32 + i];
            if (hh < 20) {
                float ss = x1 * x1 + x2 * x2;
#pragma unroll
                for (int o = 1; o < 32; o <<= 1) ss += __shfl_xor(ss, o);
                const float rs = 1.0f / sqrtf(ss * (1.0f / 64.0f) + RMS_EPS);
                const bool isq = hh < 16;
                const float n1 = x1 * rs * (isq ? qg0 : kg0), n2 = x2 * rs * (isq ? qg1 : kg1);
                float o1 = n1 * cs - n2 * sn, o2 = n1 * sn + n2 * cs;
                if (isq) { o1 *= ATT_C2; o2 *= ATT_C2; bf16* d = Q + (size_t)row * 1024 + hh * 64; d[i] = (bf16)f2bf(o1); d[i + 32] = (bf16)f2bf(o2); }
                else { bf16* d = K + krow * KVP + (hh - 16) * 64; d[i] = (bf16)f2bf(o1); d[i + 32] = (bf16)f2bf(o2); }
            } else { bf16* d = V + krow * KVP + (hh - 20) * 64; d[i] = (bf16)f2bf(x1); d[i + 32] = (bf16)f2bf(x2); }
        }
    }
}
__device__ __forceinline__ void phase_attn_simple(ArgsP a, const Fr& F) {
    const bf16* Q = (const bf16*)(a->ws + SC_Q); const bf16* K = (const bf16*)(a->ws + SC_K); const bf16* V = (const bf16*)(a->ws + SC_V); bf16* O = (bf16*)(a->ws + SC_O);
    for (int it = F.vcu; it < 512; it += F.G) {
        const int b = it >> 7, h = (it >> 3) & 15, q = (it & 7) * 512 + F.tid;
        const bf16* qp = Q + (size_t)(b * SEQ + q) * 1024 + h * 64;
        float qv[64], o[64];
#pragma unroll
        for (int d = 0; d < 64; ++d) { qv[d] = bf2f(qp[d]); o[d] = 0.f; }
        float m = -3.0e38f, l = 0.f;
        const bf16* kb = K + (size_t)b * LK * KVP + (h >> 2) * 64; const bf16* vb = V + (size_t)b * LK * KVP + (h >> 2) * 64;
        for (int s = 0; s < LK; ++s) {
            const v4u* kr = (const v4u*)(kb + (size_t)s * KVP); float sc = 0.f;
#pragma unroll
            for (int c = 0; c < 8; ++c) { const v4u kv = kr[c]; const unsigned w[4] = {kv.x, kv.y, kv.z, kv.w};
#pragma unroll
                for (int j = 0; j < 4; ++j) { sc += qv[c * 8 + 2 * j] * __builtin_bit_cast(float, w[j] << 16) + qv[c * 8 + 2 * j + 1] * __builtin_bit_cast(float, w[j] & 0xffff0000u); } }
            const float mn = fmaxf(m, sc); const float al = exp2f(m - mn), p = exp2f(sc - mn); l = l * al + p; m = mn;
            const v4u* vr = (const v4u*)(vb + (size_t)s * KVP);
#pragma unroll
            for (int c = 0; c < 8; ++c) { const v4u vv = vr[c]; const unsigned w[4] = {vv.x, vv.y, vv.z, vv.w};
#pragma unroll
                for (int j = 0; j < 4; ++j) { o[c * 8 + 2 * j] = o[c * 8 + 2 * j] * al + p * __builtin_bit_cast(float, w[j] << 16); o[c * 8 + 2 * j + 1] = o[c * 8 + 2 * j + 1] * al + p * __builtin_bit_cast(float, w[j] & 0xffff0000u); } }
        }
        const float il = 1.0f / l; bf16* op = O + (size_t)(b * SEQ + q) * 1024 + h * 64;
#pragma unroll
        for (int c = 0; c < 8; ++c) { v4u w; w.x = pk2(o[c * 8] * il, o[c * 8 + 1] * il); w.y = pk2(o[c * 8 + 2] * il, o[c * 8 + 3] * il); w.z = pk2(o[c * 8 + 4] * il, o[c * 8 + 5] * il); w.w = pk2(o[c * 8 + 6] * il, o[c * 8 + 7] * il);
            *(v4u*)(op + c * 8) = w; }
    }
}
__device__ __forceinline__ void phase_sp_simple(ArgsP a, const Fr& F) {
    LAS float* wsL = (LAS float*)F.lds;
    LAS float* vl = wsL + 128 * 128;
    LAS float* st = vl + 128 * 128;
    const float* VT = (const float*)(a->ws + SC_VT); const f32x2* VST = (const f32x2*)(a->ws + SC_VST); const bf16* UB = (const bf16*)(a->ws + SC_UB); bf16* UV = (bf16*)(a->ws + SC_UV);
    const int per = (2048 + F.G - 1) / F.G; int gl = -1;
    for (int it = F.vcu * per; it < (F.vcu + 1) * per && it < 2048; ++it) {
        const int g = it >> 7, n = it & 127;
        __syncthreads();
        if (g != gl) { for (int u = F.tid; u < 128 * 128; u += NTHR) wsL[u] = a->in[I_CMWS][(size_t)g * 16384 + u]; gl = g; }
        if (F.tid < 128) { float s1 = 0.f, s2 = 0.f; for (int p = 0; p < 16; ++p) { const f32x2 v = VST[(size_t)p * T + n * 128 + F.tid]; s1 += v.x; s2 += v.y; }
            const float mean = s1 * (1.0f / 2048.0f); const float var = s2 * (1.0f / 2048.0f) - mean * mean; st[F.tid * 2] = mean; st[F.tid * 2 + 1] = 1.0f / sqrtf(var + LN_EPS); }
        __syncthreads();
        for (int u = F.tid; u < 128 * 128; u += NTHR) { const int c = u >> 7, s = u & 127; const int ch = g * 128 + c;
            const float v = VT[(size_t)ch * T + n * 128 + s]; vl[s * 128 + c] = (v - st[s * 2]) * st[s * 2 + 1] * a->in[I_CMLNG][ch] + a->in[I_CMLNB][ch]; }
        __syncthreads();
        const int c = F.tid & 127, tq = F.tid >> 7;
        for (int jj = 0; jj < 32; ++jj) { const int t = tq + 4 * jj; float acc = 0.f;
            for (int s = 0; s < 128; ++s) acc += wsL[t * 128 + s] * vl[s * 128 + c];
            acc += a->in[I_CMBS][g * 128 + t];
            const size_t idx = (size_t)(n * 128 + t) * 2048 + g * 128 + c;
            UV[idx] = (bf16)f2bf(bf2f(UB[idx]) * acc); }
    }
}
#ifndef MK_FAST_CONV
#define MK_FAST_CONV 0
#endif
#ifndef MK_FAST_ATTN
#define MK_FAST_ATTN 0
#endif
#ifndef MK_FAST_SP
#define MK_FAST_SP 0
#endif
#ifndef MK_GATHER
#define MK_GATHER 0
#endif
constexpr int MOE_PH = MK_GATHER ? 5 : 6;
constexpr int N_PHASES = 2 + (4 + MOE_PH) + (4 + MOE_PH) + (3 + MOE_PH) + (4 + MOE_PH);

#ifndef MK_REPMASK
#define MK_REPMASK 0ull
#endif
#ifndef MK_XBAR
#define MK_XBAR 0
#endif
#ifndef MK_REPN
#define MK_REPN 3
#endif
#define REPS for (int rep_ = 0; rep_ < (((MK_REPMASK >> p) & 1ull) ? MK_REPN : 1); ++rep_)
#define IN() (get_args()->ph_lo <= p && p < get_args()->ph_hi)
#define PHB ArgsP a = get_args(); unsigned char* ws = a->ws; (void)ws; const Fr F = mkfr(lds_raw);
#define SEAM() do { { ArgsP a__ = get_args(); if (a__->ph_lo <= p && p + 1 < a__->ph_hi) { XcdBarrier bb; bb.bar = (unsigned*)(a__->ws + WS_CTL) + 4096; bb.x = xb_xcc_id(); \
        bb.st = (volatile LAS unsigned*)((LAS unsigned char*)lds_raw + MISC_OFF) + 8; xcd_barrier(bb); for (int xb_ = 0; xb_ < MK_XBAR; ++xb_) xcd_barrier(bb); } } ++p; } while (0)
template <int layer> __device__ __forceinline__ void layer_body(int& p, unsigned char* lds_raw) {
    PG8_LAS unsigned char* ring = (PG8_LAS unsigned char*)lds_raw;
        constexpr int kind = layer % 3;
        const int nrows = layer == 0 ? TA : T;
#define G1PTR ((const float*)(ws + WS_MOD) + (size_t)layer * 5 * 6144 + 2048)
        if constexpr (kind == 0) {
            const int slot = layer == 0 ? 0 : 1;
            REPS if (IN()) { PHB pg8::Gemm g{(const pg8::bf16_t*)(ws + WS_WHYIN) + (size_t)slot * 3072 * 1024, (const pg8::bf16_t*)(ws + WS_HB), 3072, nrows, 1024, nullptr};
                pg8::StaticOrder S; S.init(3072, nrows, F.G, F.bx); pg8::EpiBf16<0> E{(pg8::bf16_t*)(ws + SC_PT), TA, nullptr, 0, 0, 1.f};
                pg8::gemm_phase<pg8::EpiBf16<0>, pg8::StaticOrder, true, false>(ring, g, S, E); }
            SEAM();
            REPS if (IN()) { PHB
#if MK_FAST_CONV
                phase_hy_conv_fft(a, F, layer);
#else
                phase_hy_conv_direct(a, F, layer);
#endif
            }
            SEAM();
            REPS if (IN()) { PHB phase_hy_tr(a, F, nrows); }
            SEAM();
            REPS if (IN()) { PHB pg8::Gemm g{(const pg8::bf16_t*)(ws + SC_Z2), (const pg8::bf16_t*)(ws + WS_WHYOUT) + (size_t)slot * 1024 * 1024, nrows, 1024, 1024, nullptr};
                pg8::StaticOrder S; S.init(nrows, 1024, F.G, F.bx); pg8::EpiRes E{(const float*)(ws + WS_XC), (float*)(ws + WS_U), G1PTR, 6144, ALPHA};
                pg8::gemm_phase<pg8::EpiRes, pg8::StaticOrder, true, false>(ring, g, S, E); }
            SEAM();
        } else if constexpr (kind == 1) {
            REPS if (IN()) { PHB pg8::Gemm g{(const pg8::bf16_t*)(ws + WS_HB), (const pg8::bf16_t*)(ws + WS_WQKV), TA, 1536, 1024, nullptr};
                pg8::StaticOrder S; S.init(TA, 1536, F.G, F.bx); pg8::EpiF32 E{(float*)(ws + SC_QKV), 1536};
                pg8::gemm_phase<pg8::EpiF32, pg8::StaticOrder, true, false>(ring, g, S, E); }
            SEAM();
            REPS if (IN()) { PHB phase_rope(a, F); }
            SEAM();
            REPS if (IN()) { PHB
#if MK_FAST_ATTN
                phase_attn_fast(a, F);
#else
                phase_attn_simple(a, F);
#endif
            }
            SEAM();
            REPS if (IN()) { PHB pg8::Gemm g{(const pg8::bf16_t*)(ws + SC_O), (const pg8::bf16_t*)(ws + WS_WATO), T, 1024, 1024, nullptr};
                pg8::StaticOrder S; S.init(T, 1024, F.G, F.bx); pg8::EpiRes E{(const float*)(ws + WS_XC), (float*)(ws + WS_U), G1PTR, 6144, ALPHA};
                pg8::gemm_phase<pg8::EpiRes, pg8::StaticOrder, true, false>(ring, g, S, E); }
            SEAM();
        } else {
            REPS if (IN()) {
                { PHB pg8::Gemm g{(const pg8::bf16_t*)(ws + WS_HB), (const pg8::bf16_t*)(ws + WS_WCMIN), T, 2048, 1024, nullptr};
                  pg8::StaticOrder S; S.init(T, 2048, F.G, F.bx); pg8::EpiBf16<1> E{(pg8::bf16_t*)(ws + SC_UB), 2048, nullptr, 0, 0, 1.f};
                  pg8::gemm_phase<pg8::EpiBf16<1>, pg8::StaticOrder, true, false>(ring, g, S, E); }
                { PHB pg8::Gemm g{(const pg8::bf16_t*)(ws + WS_WCMIN) + (size_t)2048 * 1024, (const pg8::bf16_t*)(ws + WS_HB), 2048, T, 1024, nullptr};
                  pg8::StaticOrder S; S.init(2048, T, F.G, F.bx); pg8::EpiVT E{(float*)(ws + SC_VT), T, (pg8::f32x2*)(ws + SC_VST), T};
                  pg8::gemm_phase<pg8::EpiVT, pg8::StaticOrder, true, false>(ring, g, S, E); }
            }
            SEAM();
            REPS if (IN()) { PHB
#if MK_FAST_SP
                phase_sp_fast(a, F);
#else
                phase_sp_simple(a, F);
#endif
            }
            SEAM();
            REPS if (IN()) { PHB pg8::Gemm g{(const pg8::bf16_t*)(ws + SC_UV), (const pg8::bf16_t*)(ws + WS_WCMOUT), T, 1024, 2048, nullptr};
                pg8::StaticOrder S; S.init(T, 1024, F.G, F.bx); pg8::EpiRes E{(const float*)(ws + WS_XC), (float*)(ws + WS_U), G1PTR, 6144, ALPHA};
                pg8::gemm_phase<pg8::EpiRes, pg8::StaticOrder, true, false>(ring, g, S, E); }
            SEAM();
        }
        REPS if (IN()) { PHB phase_lnr(a, F, layer, nrows); }
        SEAM();
        REPS if (IN()) { PHB phase_topk(a, F, layer); }
        SEAM();
        const int npm = layer == 0 ? 9 : 8;
#if MK_GATHER
        REPS if (IN()) { PHB pg8::Gemm g{(const pg8::bf16_t*)(ws + WS_HB), (const pg8::bf16_t*)(ws + WS_WGU) + (size_t)layer * 16 * 4096 * 1024, 0, 0, 1024, (const int*)(ws + WS_ROWS)};
            pg8::MoeOrder S{npm, 16, F.G, F.vcu}; pg8::EpiGU E{(pg8::bf16_t*)(ws + WS_ACT), 16};
            pg8::gemm_phase<pg8::EpiGU, pg8::MoeOrder, true, true>(ring, g, S, E); }
        SEAM();
#else
        REPS if (IN()) { PHB phase_gather(a, F, layer); }
        SEAM();
        REPS if (IN()) { PHB pg8::Gemm g{(const pg8::bf16_t*)(ws + WS_XG), (const pg8::bf16_t*)(ws + WS_WGU) + (size_t)layer * 16 * 4096 * 1024, 0, 0, 1024, nullptr};
            pg8::MoeOrder S{npm, 16, F.G, F.vcu}; pg8::EpiGU E{(pg8::bf16_t*)(ws + WS_ACT), 16};
            pg8::gemm_phase<pg8::EpiGU, pg8::MoeOrder, true, false>(ring, g, S, E); }
        SEAM();
#endif
        REPS if (IN()) { PHB pg8::Gemm g{(const pg8::bf16_t*)(ws + WS_ACT), (const pg8::bf16_t*)(ws + WS_WDN) + (size_t)layer * 16 * 1024 * 2048, 0, 0, 2048, nullptr};
            pg8::MoeOrder S{npm, 4, F.G, F.vcu}; pg8::EpiDN E{(pg8::bf16_t*)(ws + WS_Y), (const float*)(ws + WS_GATE), 4};
            pg8::gemm_phase<pg8::EpiDN, pg8::MoeOrder, true, false>(ring, g, S, E); }
        SEAM();
        REPS if (IN()) { PHB phase_comb(a, F, layer, nrows); }
        SEAM();
    }
__global__ void __launch_bounds__(NTHR, 2) mk_fwd(Args a_) {
    extern __shared__ __attribute__((aligned(16))) unsigned char lds_raw[];
    Fr F0 = mkfr(lds_raw);
    volatile LAS unsigned* MISC = (volatile LAS unsigned*)(F0.lds + MISC_OFF);
    if (F0.tid < 32) MISC[F0.tid] = 0u;
    __syncthreads();
    if (a_.ph_hi - a_.ph_lo > 1) (void)xcd_barrier_post((unsigned*)(a_.ws + WS_CTL) + 4096, MISC + 8);
    int p = 0;
    PG8_LAS unsigned char* ring = (PG8_LAS unsigned char*)lds_raw;

    REPS if (IN()) { PHB phase_proA(a, F); }
    SEAM();
    REPS if (IN()) { PHB phase_proB(a, F); }
    SEAM();
    layer_body<0>(p, lds_raw); layer_body<1>(p, lds_raw); layer_body<2>(p, lds_raw); layer_body<3>(p, lds_raw);
#undef IN
#undef PHB
#undef G1PTR
#undef SEAM
}

#ifndef MK_N_LAUNCHES
#define MK_N_LAUNCHES 0
#endif
extern "C" void kernel_launch(void* const* d_in, const int* in_sizes, int n_in, void* d_out, int out_size, void* d_ws, size_t ws_size, hipStream_t stream) {
    static int grid = 0;
    if (grid == 0) {
        if (n_in != 33 || out_size != T * D || ws_size < WS_END) { fprintf(stderr, "kernel_launch: expected 33 inputs, %d outputs, >= %zu bytes of workspace; got %d, %d, %zu\n", T * D, (size_t)WS_END, n_in, out_size, ws_size); grid = -1; return; }
        int dev = 0, cus = 0, per_cu = 0;
        if (hipGetDevice(&dev) != hipSuccess || hipDeviceGetAttribute(&cus, hipDeviceAttributeMultiprocessorCount, dev) != hipSuccess) { grid = -1; return; }
        if (hipFuncSetAttribute((const void*)mk_fwd, hipFuncAttributeMaxDynamicSharedMemorySize, LDS_BYTES) != hipSuccess) { fprintf(stderr, "kernel_launch: hipFuncSetAttribute failed\n"); grid = -1; return; }
        if (hipOccupancyMaxActiveBlocksPerMultiprocessor(&per_cu, (const void*)mk_fwd, NTHR, LDS_BYTES) != hipSuccess || per_cu < 1)
            fprintf(stderr, "kernel_launch: note: occupancy query reports %d workgroups per CU\n", per_cu);
        (void)hipGetLastError();
        grid = cus;
    }
    if (grid < 0) return;
    (void)hipMemsetAsync((char*)d_ws + WS_CTL, 0, 1 * MiB, stream);
    Args a{};
    for (int i = 0; i < 33; ++i) a.in[i] = (const float*)d_in[i];
    a.out = (float*)d_out; a.ws = (unsigned char*)d_ws;
#if MK_N_LAUNCHES == 1
    a.ph_lo = 0; a.ph_hi = N_PHASES;
    hipLaunchKernelGGL(mk_fwd, dim3(grid), dim3(NTHR), LDS_BYTES, stream, a);
#else
    for (int p = 0; p < N_PHASES; ++p) { a.ph_lo = p; a.ph_hi = p + 1; hipLaunchKernelGGL(mk_fwd, dim3(grid), dim3(NTHR), LDS_BYTES, stream, a); }
#endif
    const hipError_t le = hipPeekAtLastError();
    if (le != hipSuccess) fprintf(stderr, "kernel_launch: launch failed: %s\n", hipGetErrorName(le));
}
```

```cpp
#define MK_N_LAUNCHES 1
#define MK_FAST_ATTN 1
#define MK_FAST_CONV 1
#define MK_GATHER 1
#define MK_FAST_SP 1
#include <hip/hip_runtime.h>
#include <cstdio>
#include <cstdint>
#include <cmath>
namespace pg8 {
#define PG8_LAS __attribute__((address_space(3)))
typedef unsigned short bf16_t;
typedef short bf16x8 __attribute__((ext_vector_type(8)));
typedef float f32x4 __attribute__((ext_vector_type(4)));
typedef unsigned u32x4 __attribute__((ext_vector_type(4)));
typedef unsigned u32x2 __attribute__((ext_vector_type(2)));
constexpr int BM = 256, BK = 64, HALF = 128, HTB = HALF * BK * 2  , STAGE_BYTES = 8 * HTB, NXCD = 8, WGM = 8;

__host__ __device__ __forceinline__ int lds_byte(int r, int c) { const int st = (r >> 4) * 2 + (c >> 5), rr = r & 15, cc = c & 31, ob = rr * 64 + cc * 2; return st * 1024 + (ob ^ (((ob >> 9) & 1) << 5)); }
__host__ __device__ __forceinline__ void stage_rc(int b, int& R, int& C) { const int st = b / 1024, sb = b % 1024, swz = sb ^ (((sb >> 9) & 1) << 5); R = (st >> 1) * 16 + swz / 64; C = (st & 1) * 32 + (swz % 64) / 2; }
__host__ __device__ __forceinline__ int perm32(int rho) { const int n = rho >> 4, i = rho & 15; return 8 * (i >> 2) + 4 * n + (i & 3); }

struct Unit { int pm, pn; };
struct Gemm { const bf16_t* A; const bf16_t* Bt; int M, N, K; const int* rows; };

struct StaticOrder {
    int nM, nN, nwg, G, c;
    __host__ __device__ void init(int M, int N, int G_, int c_) { nM = M / BM; nN = N / BM; nwg = nM * nN; G = G_; c = c_; }
    __host__ __device__ bool next(int i, Unit& u) const {
        const long L = (long)i * G + c; if (L >= nwg) return false;
        int wgid = (int)L; { const int q = nwg / NXCD, r = nwg % NXCD, xcd = wgid % NXCD, off = wgid / NXCD; wgid = (xcd < r ? xcd * (q + 1) : r * (q + 1) + (xcd - r) * q) + off; }
        const int nig = WGM * nN, gid = wgid / nig, fm = gid * WGM, gsz = (nM - fm) < WGM ? (nM - fm) : WGM;
        u.pm = fm + ((wgid % nig) % gsz); u.pn = (wgid % nig) / gsz; return true;
    }
    __device__ __forceinline__ void a_ready(const Unit&) const {}
    __device__ __forceinline__ void done(const Unit&) const {}
};

__device__ __forceinline__ unsigned cvt_pk_bf16(float lo, float hi) { unsigned r; asm volatile("v_cvt_pk_bf16_f32 %0, %1, %2" : "=v"(r) : "v"(lo), "v"(hi)); return r; }
typedef float f32x2 __attribute__((ext_vector_type(2)));
__device__ __forceinline__ f32x2 gelu_pk(f32x2 v) {
    const f32x2 av = __builtin_elementwise_abs(v), d = av * 0.2316418882f + 1.0f;
    f32x2 t; t.x = __builtin_amdgcn_rcpf(d.x); t.y = __builtin_amdgcn_rcpf(d.y);
    f32x2 q = t * 0.5307027145f + (-0.7265760135f); q = q * t + 0.7107068705f; q = q * t + (-0.142248368f); q = q * t + 0.127414796f; q = q * t;
    const f32x2 s = (v * v) * (-0.72134752044f);
    f32x2 e; e.x = __builtin_amdgcn_exp2f(s.x); e.y = __builtin_amdgcn_exp2f(s.y);
    const f32x2 m = v * (q * e), r = v - m;
    f32x2 o; o.x = v.x < 0.f ? m.x : r.x; o.y = v.y < 0.f ? m.y : r.y; return o;
}

template <int ACT  > struct EpiBf16 {
    static constexpr bool PERM = true, AFTER_DRAIN = false; static_assert(ACT == 0 || ACT == 1, "EpiBf16: ACT is 0 (none) or 1 (gelu_pk)");
    bf16_t* O; int ldc; const float* bias; int split_cols; size_t split_stride; float scale0; float pre = 1.f;
    __device__ __forceinline__ void operator()(const f32x4 (&acc)[2][2][4][2], const Unit& u, int wr, int wc, int fr, int fq) const {
        const int row0 = u.pm * BM + wr * 64 + fr; int colt = u.pn * BM; bf16_t* base = O;
        float sc = 1.f; if (split_cols) { const int t = colt / split_cols; base += (size_t)t * split_stride; colt -= t * split_cols; if (t == 0) sc = scale0; }
        const int col0 = colt + wc * 32 + 8 * fq, bcol0 = u.pn * BM + wc * 32 + 8 * fq;
        f32x4 bv[2][2];
#pragma unroll
        for (int bj = 0; bj < 2; ++bj)
#pragma unroll
            for (int n = 0; n < 2; ++n) bv[bj][n] = bias ? *(const f32x4*)(bias + bcol0 + bj * HALF + 4 * n) : (f32x4){0.f, 0.f, 0.f, 0.f};
#pragma unroll
        for (int ai = 0; ai < 2; ++ai)
#pragma unroll
            for (int m = 0; m < 4; ++m) { bf16_t* rowp = base + (size_t)(row0 + ai * HALF + m * 16) * ldc + col0;
#pragma unroll
                for (int bj = 0; bj < 2; ++bj) { f32x4 v0 = acc[ai][bj][m][0] * pre + bv[bj][0], v1 = acc[ai][bj][m][1] * pre + bv[bj][1];
                    if (ACT == 1) { f32x2 a = gelu_pk((f32x2){v0[0], v0[1]}), b = gelu_pk((f32x2){v0[2], v0[3]}), c = gelu_pk((f32x2){v1[0], v1[1]}), d = gelu_pk((f32x2){v1[2], v1[3]});
                        v0 = (f32x4){a.x, a.y, b.x, b.y}; v1 = (f32x4){c.x, c.y, d.x, d.y}; }
                    v0 = v0 * sc; v1 = v1 * sc; u32x4 w; w.x = cvt_pk_bf16(v0[0], v0[1]); w.y = cvt_pk_bf16(v0[2], v0[3]); w.z = cvt_pk_bf16(v1[0], v1[1]); w.w = cvt_pk_bf16(v1[2], v1[3]);
                    *(u32x4*)(rowp + bj * HALF) = w; } }
    }
};

#ifndef MK_FP8_Y
#define MK_FP8_Y 1
#endif
struct EpiF32 {
    static constexpr bool PERM = false, AFTER_DRAIN = false;
    float* C; int ldc;
    __device__ __forceinline__ void operator()(const f32x4 (&acc)[2][2][4][2], const Unit& u, int wr, int wc, int fr, int fq) const {
        const int row0 = u.pm * BM + wr * 64 + fr, col0 = u.pn * BM + wc * 32 + 4 * fq;
#pragma unroll
        for (int ai = 0; ai < 2; ++ai)
#pragma unroll
            for (int m = 0; m < 4; ++m) { float* rowp = C + (size_t)(row0 + ai * HALF + m * 16) * ldc + col0;
#pragma unroll
                for (int bj = 0; bj < 2; ++bj)
#pragma unroll
                    for (int n = 0; n < 2; ++n) *(f32x4*)(rowp + bj * HALF + n * 16) = acc[ai][bj][m][n]; }
    }
};
struct EpiRes {
    static constexpr bool PERM = false, AFTER_DRAIN = false;
    const bf16_t* X; bf16_t* U; const float* g; int gstride; float alpha; float accs = 1.f;
    __device__ __forceinline__ void operator()(const f32x4 (&acc)[2][2][4][2], const Unit& u, int wr, int wc, int fr, int fq) const {
        const int row0 = u.pm * BM + wr * 64 + fr, col0 = u.pn * BM + wc * 32 + 4 * fq;
        const int rb = u.pm * BM; const int bidx = rb < 16384 ? (rb >> 12) : 4;
        const float* gp = g + (size_t)bidx * gstride + col0;
        f32x4 gv[2][2];
#pragma unroll
        for (int bj = 0; bj < 2; ++bj)
#pragma unroll
            for (int n = 0; n < 2; ++n) gv[bj][n] = *(const f32x4*)(gp + bj * HALF + n * 16) * accs;
#pragma unroll
        for (int ai = 0; ai < 2; ++ai)
#pragma unroll
            for (int m = 0; m < 4; ++m) { const size_t off = (size_t)(row0 + ai * HALF + m * 16) * 1024 + col0;
#pragma unroll
                for (int bj = 0; bj < 2; ++bj)
#pragma unroll
                    for (int n = 0; n < 2; ++n) { const u32x2 xw = *(const u32x2*)(X + off + bj * HALF + n * 16);
                        const f32x4 xv = (f32x4){__builtin_bit_cast(float, xw.x << 16), __builtin_bit_cast(float, xw.x & 0xffff0000u), __builtin_bit_cast(float, xw.y << 16), __builtin_bit_cast(float, xw.y & 0xffff0000u)};
                        const f32x4 uo = xv * alpha + gv[bj][n] * acc[ai][bj][m][n]; u32x2 uw; uw.x = cvt_pk_bf16(uo[0], uo[1]); uw.y = cvt_pk_bf16(uo[2], uo[3]);
                        *(u32x2*)(U + off + bj * HALF + n * 16) = uw; }
                asm volatile("" ::: "memory"); }
    }
};
struct EpiNull {
    static constexpr bool PERM = true, AFTER_DRAIN = false;
    __device__ __forceinline__ void operator()(const f32x4 (&acc)[2][2][4][2], const Unit& u, int wr, int wc, int fr, int fq) const {
        f32x4 s = (f32x4){0.f, 0.f, 0.f, 0.f};
#pragma unroll
        for (int ai = 0; ai < 2; ++ai)
#pragma unroll
            for (int bj = 0; bj < 2; ++bj)
#pragma unroll
                for (int m = 0; m < 4; ++m)
#pragma unroll
                    for (int n = 0; n < 2; ++n) s += acc[ai][bj][m][n];
        asm volatile("" :: "v"(s));
    }
};
struct EpiGUnostore {
    static constexpr bool PERM = true, AFTER_DRAIN = false;
    __device__ __forceinline__ void operator()(const f32x4 (&acc)[2][2][4][2], const Unit& u, int wr, int wc, int fr, int fq) const {
#pragma unroll
        for (int ai = 0; ai < 2; ++ai)
#pragma unroll
            for (int m = 0; m < 4; ++m) { float o[8];
#pragma unroll
                for (int n = 0; n < 2; ++n)
#pragma unroll
                    for (int j = 0; j < 4; ++j) { const float a = acc[ai][0][m][n][j], b = acc[ai][1][m][n][j];
                        const float s = a * __builtin_amdgcn_rcpf(1.0f + __builtin_amdgcn_exp2f(-1.4426950408889634f * a)); o[n * 4 + j] = s * b; }
                u32x4 w; w.x = cvt_pk_bf16(o[0], o[1]); w.y = cvt_pk_bf16(o[2], o[3]); w.z = cvt_pk_bf16(o[4], o[5]); w.w = cvt_pk_bf16(o[6], o[7]);
                asm volatile("" :: "v"(w)); }
    }
};
struct EpiGU {
    static constexpr bool PERM = true, AFTER_DRAIN = false;
    bf16_t* ACT; int npn;
    __device__ __forceinline__ void operator()(const f32x4 (&acc)[2][2][4][2], const Unit& u, int wr, int wc, int fr, int fq) const {
        const int row0 = u.pm * BM + wr * 64 + fr; const int col0 = (u.pn % npn) * 128 + wc * 32 + 8 * fq;
#pragma unroll
        for (int ai = 0; ai < 2; ++ai)
#pragma unroll
            for (int m = 0; m < 4; ++m) { bf16_t* rowp = ACT + (size_t)(row0 + ai * HALF + m * 16) * 2048 + col0;
                float o[8];
#pragma unroll
                for (int n = 0; n < 2; ++n)
#pragma unroll
                    for (int j = 0; j < 4; ++j) { const float a = acc[ai][0][m][n][j], b = acc[ai][1][m][n][j];
                        const float s = a * __builtin_amdgcn_rcpf(1.0f + __builtin_amdgcn_exp2f(-1.4426950408889634f * a)); o[n * 4 + j] = s * b; }
                u32x4 w; w.x = cvt_pk_bf16(o[0], o[1]); w.y = cvt_pk_bf16(o[2], o[3]); w.z = cvt_pk_bf16(o[4], o[5]); w.w = cvt_pk_bf16(o[6], o[7]);
                *(u32x4*)rowp = w; }
    }
};
template <bool OUT8> struct EpiGU8 {
    static constexpr bool PERM = true, AFTER_DRAIN = false;
    unsigned char* ACT; int npn; float inscale, outscale;
    __device__ __forceinline__ void operator()(const f32x4 (&acc)[2][2][4][2], const Unit& u, int wr, int wc, int fr, int fq) const {
        const int row0 = u.pm * BM + wr * 64 + fr; const int col0 = (u.pn % npn) * 128 + wc * 32 + 8 * fq;
        const float ka = -1.4426950408889634f * inscale, kb = inscale * inscale * outscale;
#pragma unroll
        for (int ai = 0; ai < 2; ++ai)
#pragma unroll
            for (int m = 0; m < 4; ++m) { unsigned char* rowp = ACT + ((size_t)(row0 + ai * HALF + m * 16) * 2048 + col0) * (OUT8 ? 1 : 2);
                float o[8];
#pragma unroll
                for (int n = 0; n < 2; ++n)
#pragma unroll
                    for (int j = 0; j < 4; ++j) { const float a = acc[ai][0][m][n][j], b = acc[ai][1][m][n][j];
                        o[n * 4 + j] = a * __builtin_amdgcn_rcpf(1.0f + __builtin_amdgcn_exp2f(ka * a)) * (b * kb); }
                if constexpr (OUT8) {
#pragma unroll
                    for (int q = 0; q < 8; ++q) o[q] = __builtin_amdgcn_fmed3f(o[q], -448.0f, 448.0f);
                    unsigned w0 = 0u, w1 = 0u;
                    w0 = __builtin_amdgcn_cvt_pk_fp8_f32(o[0], o[1], w0, false); w0 = __builtin_amdgcn_cvt_pk_fp8_f32(o[2], o[3], w0, true);
                    w1 = __builtin_amdgcn_cvt_pk_fp8_f32(o[4], o[5], w1, false); w1 = __builtin_amdgcn_cvt_pk_fp8_f32(o[6], o[7], w1, true);
                    typedef unsigned u32x2_ __attribute__((ext_vector_type(2)));
                    *(u32x2_*)rowp = (u32x2_){w0, w1}; }
                else { u32x4 w; w.x = cvt_pk_bf16(o[0], o[1]); w.y = cvt_pk_bf16(o[2], o[3]); w.z = cvt_pk_bf16(o[4], o[5]); w.w = cvt_pk_bf16(o[6], o[7]); *(u32x4*)rowp = w; } }
    }
};
struct EpiDN {
    static constexpr bool PERM = true, AFTER_DRAIN = false;
    bf16_t* Y; const float* gate; int npn; float scale;
    __device__ __forceinline__ void operator()(const f32x4 (&acc)[2][2][4][2], const Unit& u, int wr, int wc, int fr, int fq) const {
        const int row0 = u.pm * BM + wr * 64 + fr, col0 = (u.pn % npn) * BM + wc * 32 + 8 * fq;
#pragma unroll
        for (int ai = 0; ai < 2; ++ai)
#pragma unroll
            for (int m = 0; m < 4; ++m) { const int row = row0 + ai * HALF + m * 16; const float gt = gate[row] * scale; bf16_t* rowp = Y + (size_t)row * 1024 + col0;
#pragma unroll
                for (int bj = 0; bj < 2; ++bj) { const f32x4 v0 = acc[ai][bj][m][0] * gt, v1 = acc[ai][bj][m][1] * gt;
#if MK_FP8_Y
                    unsigned w0 = 0u, w1 = 0u;
                    w0 = __builtin_amdgcn_cvt_pk_fp8_f32(__builtin_amdgcn_fmed3f(v0[0], -448.0f, 448.0f), __builtin_amdgcn_fmed3f(v0[1], -448.0f, 448.0f), w0, false);
                    w0 = __builtin_amdgcn_cvt_pk_fp8_f32(__builtin_amdgcn_fmed3f(v0[2], -448.0f, 448.0f), __builtin_amdgcn_fmed3f(v0[3], -448.0f, 448.0f), w0, true);
                    w1 = __builtin_amdgcn_cvt_pk_fp8_f32(__builtin_amdgcn_fmed3f(v1[0], -448.0f, 448.0f), __builtin_amdgcn_fmed3f(v1[1], -448.0f, 448.0f), w1, false);
                    w1 = __builtin_amdgcn_cvt_pk_fp8_f32(__builtin_amdgcn_fmed3f(v1[2], -448.0f, 448.0f), __builtin_amdgcn_fmed3f(v1[3], -448.0f, 448.0f), w1, true);
                    *(u32x2*)((unsigned char*)Y + (size_t)row * 1024 + col0 + bj * HALF) = (u32x2){w0, w1}; } }
#else
                    u32x4 w; w.x = cvt_pk_bf16(v0[0], v0[1]); w.y = cvt_pk_bf16(v0[2], v0[3]); w.z = cvt_pk_bf16(v1[0], v1[1]); w.w = cvt_pk_bf16(v1[2], v1[3]);
                    *(u32x4*)(rowp + bj * HALF) = w; } }
#endif
    }
};
struct EpiVT {
    static constexpr bool PERM = false, AFTER_DRAIN = false;
    bf16_t* VT; int ldc; f32x2* VST; int ntok; float pre = 1.f;
    __device__ __forceinline__ void operator()(const f32x4 (&acc)[2][2][4][2], const Unit& u, int wr, int wc, int fr, int fq) const {
        const int row0 = u.pm * BM + wr * 64 + fr, col0 = u.pn * BM + wc * 32 + 4 * fq;
        f32x4 s1[2][2], s2[2][2];
#pragma unroll
        for (int bj = 0; bj < 2; ++bj)
#pragma unroll
            for (int n = 0; n < 2; ++n) { s1[bj][n] = (f32x4){0.f, 0.f, 0.f, 0.f}; s2[bj][n] = (f32x4){0.f, 0.f, 0.f, 0.f}; }
#pragma unroll
        for (int ai = 0; ai < 2; ++ai)
#pragma unroll
            for (int m = 0; m < 4; ++m) { bf16_t* rowp = VT + (size_t)(row0 + ai * HALF + m * 16) * ldc + col0;
#pragma unroll
                for (int bj = 0; bj < 2; ++bj)
#pragma unroll
                    for (int n = 0; n < 2; ++n) { const f32x4 v = acc[ai][bj][m][n] * pre; const f32x2 a = gelu_pk((f32x2){v[0], v[1]}), b = gelu_pk((f32x2){v[2], v[3]});
                        const f32x4 gl = (f32x4){a.x, a.y, b.x, b.y}; { u32x2 gw; gw.x = cvt_pk_bf16(gl[0], gl[1]); gw.y = cvt_pk_bf16(gl[2], gl[3]); *(u32x2*)(rowp + bj * HALF + n * 16) = gw; } s1[bj][n] += gl; s2[bj][n] += gl * gl; } }
#pragma unroll
        for (int bj = 0; bj < 2; ++bj)
#pragma unroll
            for (int n = 0; n < 2; ++n)
#pragma unroll
                for (int j = 0; j < 4; ++j) { float a = s1[bj][n][j], b = s2[bj][n][j];
#pragma unroll
                    for (int o = 1; o < 16; o <<= 1) { a += __shfl_xor(a, o); b += __shfl_xor(b, o); }
                    s1[bj][n][j] = a; s2[bj][n][j] = b; }
        if (fr == 0) {
            f32x2* dst = VST + (size_t)(u.pm * 2 + wr) * ntok + col0;
#pragma unroll
            for (int bj = 0; bj < 2; ++bj)
#pragma unroll
                for (int n = 0; n < 2; ++n)
#pragma unroll
                    for (int j = 0; j < 4; ++j) dst[bj * HALF + n * 16 + j] = (f32x2){s1[bj][n][j], s2[bj][n][j]};
        }
    }
};
struct MoeOrder {
    int nPM, nPN, G, vcu; int fixed = 0;
    __device__ __forceinline__ bool next(int i, Unit& u) const {
        const int L = i * G + vcu; if (L >= 16 * nPM * nPN) return false;
        const int pm = L % nPM, r = L / nPM, pn = r % nPN, e = r / nPN; u.pm = e * 9 + pm; u.pn = e * nPN + pn;
#if defined(MK_FIXEDUNIT)
        if (fixed) { u.pm = 0; u.pn = 0; }
#endif
        return true;
    }
    __device__ __forceinline__ void a_ready(const Unit&) const {}
    __device__ __forceinline__ void done(const Unit&) const {}
};

template <class Epi, class Sched, bool ALIGN_EPI = false, bool GATHER = false, bool FP8 = false>
__device__ __forceinline__ void gemm_phase(PG8_LAS unsigned char* lds, const Gemm g, const Sched& S, const Epi& E) {
    int tid_ = threadIdx.x; asm volatile("" : "+v"(tid_));
    const int tid = tid_, wid = __builtin_amdgcn_readfirstlane(tid >> 6), lane = tid & 63, wr = wid >> 2, wc = wid & 3, fr = lane & 15, fq = lane >> 4;
    const int K = g.K, nt = K / BK;
    unsigned voffA[2], voffB[2];
#pragma unroll
    for (int i = 0; i < 2; ++i) { int R, C; stage_rc(tid * 16 + i * 8192, R, C); const int Rb = Epi::PERM ? ((R & ~31) + perm32(R & 31)) : R;
        voffA[i] = (unsigned)(R * K + C) * 2u; voffB[i] = (unsigned)(Rb * K + C) * 2u; }
    const size_t kstep = (size_t)(BK * 2);
    const size_t hstep = (size_t)HALF * K * 2;
    const size_t tstep = 2 * hstep;
    const unsigned ldsw = (unsigned)wid * 1024u;
    const int aoff = lds_byte(wr * 64 + fr, fq * 8), boff = lds_byte(wc * 32 + fr, fq * 8);
#define PG8_SA(b, h) (((b) * 2 + (h)) * HTB)
#define PG8_SB(b, h) ((4 + (b) * 2 + (h)) * HTB)
#define PG8_STAGE(bufoff, gbase, voff) do { _Pragma("unroll") for (int _i = 0; _i < 2; ++_i) \
        __builtin_amdgcn_global_load_lds((const unsigned*)((const char*)(gbase) + (voff)[_i]), (PG8_LAS unsigned*)(lds + (bufoff) + ldsw + _i * 8192), 16, 0, 0); } while (0)
#define PG8_STGA(b, h, ubase, koff, gofs) do { if constexpr (GATHER) { PG8_STAGE(PG8_SA(b, h), (const char*)g.A + (koff), gofs[h]); } \
        else { PG8_STAGE(PG8_SA(b, h), (ubase) + (koff) + (size_t)(h) * hstep, voffA); } } while (0)
#define PG8_GLOAD(dst, u) do { if constexpr (GATHER) { _Pragma("unroll") for (int _i = 0; _i < 2; ++_i) { int _R, _C; stage_rc(tid * 16 + _i * 8192, _R, _C); \
        _Pragma("unroll") for (int _h = 0; _h < 2; ++_h) dst[_h][_i] = (unsigned)g.rows[(u).pm * BM + _h * HALF + _R] * (unsigned)(K * 2) + (unsigned)_C * 2u; } } } while (0)
#define PG8_LDA(dst, b, h) do { _Pragma("unroll") for (int m = 0; m < 4; ++m) _Pragma("unroll") for (int k = 0; k < 2; ++k) dst[m][k] = *(const PG8_LAS bf16x8*)(lds + PG8_SA(b, h) + aoff + m * 2048 + k * 1024); } while (0)
#define PG8_LDB(dst, b, h) do { _Pragma("unroll") for (int n = 0; n < 2; ++n) _Pragma("unroll") for (int k = 0; k < 2; ++k) dst[n][k] = *(const PG8_LAS bf16x8*)(lds + PG8_SB(b, h) + boff + n * 2048 + k * 1024); } while (0)
#define PG8_CAT8(x0, x1) __builtin_shufflevector(__builtin_bit_cast(v4i_t, x0), __builtin_bit_cast(v4i_t, x1), 0, 1, 2, 3, 4, 5, 6, 7)
#define PG8_MMA(ai, bj, At, Bt) do { __builtin_amdgcn_s_setprio(1); _Pragma("unroll") for (int m = 0; m < 4; ++m) _Pragma("unroll") for (int n = 0; n < 2; ++n) { \
        if constexpr (FP8) { asm volatile("v_mfma_scale_f32_16x16x128_f8f6f4 %0, %1, %2, %0, %3, %3 op_sel_hi:[0,0,0]" : "+v"(acc[ai][bj][m][n]) : "v"(PG8_CAT8(Bt[n][0], Bt[n][1])), "v"(PG8_CAT8(At[m][0], At[m][1])), "v"(0x7F7F7F7F)); } \
        else { _Pragma("unroll") for (int k = 0; k < 2; ++k) acc[ai][bj][m][n] = __builtin_amdgcn_mfma_f32_16x16x32_bf16(Bt[n][k], At[m][k], acc[ai][bj][m][n], 0, 0, 0); } } \
        __builtin_amdgcn_s_setprio(0); } while (0)
#define PG8_WAIT_V(n) asm volatile("s_waitcnt vmcnt(" #n ")" ::: "memory")
#define PG8_WAIT_L(n) asm volatile("s_waitcnt lgkmcnt(" #n ")" ::: "memory")
#define PG8_BAR __builtin_amdgcn_s_barrier()
#define PG8_SCHED __builtin_amdgcn_sched_barrier(0)
    Unit cur, nxt; int ui = 0;
    if (!S.next(0, cur)) return;
    f32x4 acc[2][2][4][2];
#pragma unroll
    for (int a = 0; a < 2; ++a)
#pragma unroll
        for (int b = 0; b < 2; ++b)
#pragma unroll
            for (int m = 0; m < 4; ++m)
#pragma unroll
                for (int n = 0; n < 2; ++n) acc[a][b][m][n] = (f32x4){0.f, 0.f, 0.f, 0.f};
    bf16x8 At[4][2], B0[2][2], B1[2][2];
    typedef int v8i_t __attribute__((ext_vector_type(8))); typedef int v4i_t __attribute__((ext_vector_type(4)));
    unsigned gc[2][2] = {{0u, 0u}, {0u, 0u}}, gn[2][2] = {{0u, 0u}, {0u, 0u}};
    const char* cA = GATHER ? (const char*)g.A : (const char*)g.A + (size_t)cur.pm * tstep; const char* cB = (const char*)g.Bt + (size_t)cur.pn * tstep;
    S.a_ready(cur);
    PG8_GLOAD(gc, cur);
    PG8_STAGE(PG8_SB(0, 0), cB, voffB); PG8_STAGE(PG8_SB(0, 1), cB + hstep, voffB); PG8_STGA(0, 0, cA, 0, gc); PG8_STGA(0, 1, cA, 0, gc);
    if (wr == 1) PG8_BAR;
    PG8_WAIT_V(2); PG8_BAR;
    PG8_STAGE(PG8_SB(1, 0), cB + kstep, voffB); PG8_STGA(1, 0, cA, kstep, gc); PG8_STAGE(PG8_SB(1, 1), cB + hstep + kstep, voffB);
    PG8_WAIT_V(6); PG8_BAR;
    for (;;) {
        const bool has_next = S.next(ui + 1, nxt);
        const char* nA = GATHER ? (const char*)g.A : (has_next ? (const char*)g.A + (size_t)nxt.pm * tstep : cA); const char* nB = has_next ? (const char*)g.Bt + (size_t)nxt.pn * tstep : cB;
#pragma unroll 1
        for (int t = 0; t < nt; t += 2) {
            const bool last = (t == nt - 2);
            const size_t k1 = (size_t)(t + 1) * kstep;
            const char* b2 = last ? nB : cB + (size_t)(t + 2) * kstep; const char* b3 = b2 + kstep;
            if (last && has_next) S.a_ready(nxt);
            if (last) { if (has_next) { PG8_GLOAD(gn, nxt); } else {
#pragma unroll
                    for (int h = 0; h < 2; ++h)
#pragma unroll
                        for (int i = 0; i < 2; ++i) gn[h][i] = gc[h][i]; } }
            PG8_LDB(B0, 0, 0); PG8_LDB(B1, 0, 1); PG8_SCHED; PG8_LDA(At, 0, 0); PG8_STGA(1, 1, cA, k1, gc);
            PG8_WAIT_V(8); PG8_WAIT_L(0); PG8_BAR; PG8_MMA(0, 0, At, B0); PG8_MMA(0, 1, At, B1); PG8_BAR; PG8_SCHED;
            PG8_LDA(At, 0, 1); PG8_STAGE(PG8_SB(0, 0), b2, voffB); PG8_STAGE(PG8_SB(0, 1), b2 + hstep, voffB);
            if (last) { PG8_STGA(0, 0, nA, 0, gn); } else { PG8_STGA(0, 0, cA, (size_t)(t + 2) * kstep, gc); }
            PG8_WAIT_V(8); PG8_WAIT_L(0); PG8_BAR; PG8_MMA(1, 0, At, B0); PG8_MMA(1, 1, At, B1); PG8_BAR; PG8_SCHED;
            PG8_LDB(B0, 1, 0); PG8_LDB(B1, 1, 1); PG8_SCHED; PG8_LDA(At, 1, 0);
            if (last) { PG8_STGA(0, 1, nA, 0, gn); } else { PG8_STGA(0, 1, cA, (size_t)(t + 2) * kstep, gc); }
            PG8_WAIT_V(8); PG8_WAIT_L(0); PG8_BAR; PG8_MMA(0, 0, At, B0); PG8_MMA(0, 1, At, B1); PG8_BAR; PG8_SCHED;
            PG8_LDA(At, 1, 1); PG8_STAGE(PG8_SB(1, 0), b3, voffB); PG8_STAGE(PG8_SB(1, 1), b3 + hstep, voffB);
            if (last) { PG8_STGA(1, 0, nA, kstep, gn); } else { PG8_STGA(1, 0, cA, (size_t)(t + 3) * kstep, gc); }
            PG8_WAIT_V(8); PG8_WAIT_L(0); PG8_BAR; PG8_MMA(1, 0, At, B0); PG8_MMA(1, 1, At, B1); PG8_BAR; PG8_SCHED;
        }
        if constexpr (ALIGN_EPI) { if (wr == 0) PG8_BAR; }
        if constexpr (FP8) asm volatile("s_nop 15\n\ts_nop 15" ::: "memory");
        if constexpr (!Epi::AFTER_DRAIN) { E(acc, cur, wr, wc, fr, fq); S.done(cur); }
        if (!has_next) break;
#pragma unroll
        for (int a = 0; a < 2; ++a)
#pragma unroll
            for (int b = 0; b < 2; ++b)
#pragma unroll
                for (int m = 0; m < 4; ++m)
#pragma unroll
                    for (int n = 0; n < 2; ++n) acc[a][b][m][n] = (f32x4){0.f, 0.f, 0.f, 0.f};
        if constexpr (FP8) asm volatile("s_nop 7" ::: "memory");
        cur = nxt; cA = nA; cB = nB; ++ui;
#pragma unroll
        for (int h = 0; h < 2; ++h)
#pragma unroll
            for (int i = 0; i < 2; ++i) gc[h][i] = gn[h][i];
        if constexpr (ALIGN_EPI) { if (wr == 1) PG8_BAR; }
    }
    PG8_WAIT_V(0);
    if constexpr (!ALIGN_EPI) { if (wr == 0) PG8_BAR; }
    PG8_BAR;
    if constexpr (Epi::AFTER_DRAIN) { E.fused(acc, cur, wr, wc, fr, fq, lds, wid, lane); S.done(cur); }
#undef PG8_SA
#undef PG8_SB
#undef PG8_STAGE
#undef PG8_STGA
#undef PG8_GLOAD
#undef PG8_LDA
#undef PG8_LDB
#undef PG8_MMA
#undef PG8_CAT8
#undef PG8_WAIT_V
#undef PG8_WAIT_L
#undef PG8_BAR
#undef PG8_SCHED
}
}
constexpr int NB = 4, SEQ = 4096, T = NB * SEQ, LC = 256, TC = NB * LC, TA = T + TC, D = 1024;
constexpr int NE = 16, FF = 2048, ESTR = 2304;
constexpr int LK = LC + SEQ, KVP = 256;
constexpr float ALPHA = 1.6817928305074290f;
constexpr float LN_EPS = 1e-5f, RMS_EPS = 1e-6f;
constexpr float ATT_C2 = 0.125f * 1.4426950408889634f;
constexpr int NWAVES = 8, NTHR = 512;
constexpr size_t MiB = 1u << 20;
constexpr size_t WS_CTL = 0, WS_MOD = 1 * MiB, WS_MODP = 2 * MiB, WS_TW = 6 * MiB;
constexpr size_t WS_WHYIN = 8 * MiB, WS_WHYOUT = 20 * MiB, WS_WQKV = 24 * MiB, WS_WATO = 27 * MiB, WS_WCMIN = 29 * MiB, WS_WCMOUT = 37 * MiB, WS_WCMS = 41 * MiB;
constexpr size_t WS_WGU = 42 * MiB, WS_WDN = 554 * MiB, WS_HF = 810 * MiB;
constexpr size_t WS_XL = 942 * MiB, WS_U = 1010 * MiB, WS_HB = 1078 * MiB, WS_AFF = 1112 * MiB, WS_ROWS = 1114 * MiB, WS_GATE = WS_ROWS + 256 * 1024, WS_INV = 1115 * MiB;
constexpr size_t WS_ACT = 1117 * MiB, WS_Y = 1261 * MiB, WS_SCR = 1405 * MiB, WS_XC = 1677 * MiB, WS_END = 1745 * MiB;
constexpr size_t WS_XG = WS_Y;
constexpr size_t SC_PT = WS_SCR, SC_Z2T = WS_SCR + 204 * MiB, SC_Z2 = WS_SCR + 238 * MiB;
constexpr size_t SC_QKV = WS_SCR, SC_Q = WS_SCR + 102 * MiB, SC_K = WS_SCR + 134 * MiB, SC_V = WS_SCR + 143 * MiB, SC_O = WS_SCR + 152 * MiB;
constexpr size_t SC_UB = WS_SCR, SC_VT = WS_SCR + 64 * MiB, SC_VST = WS_SCR + 192 * MiB, SC_UV = WS_SCR + 194 * MiB;
constexpr size_t HF_SLOT = (size_t)4 * 1024 * 4096 * 4, HF_CTX = 2 * HF_SLOT;
constexpr int LDS_BYTES = 147456;
constexpr int RING_BYTES = 131072, MISC_OFF = LDS_BYTES - 256;

#define GAS __attribute__((address_space(1)))
#define LAS __attribute__((address_space(3)))
typedef unsigned short bf16;
typedef unsigned v4u __attribute__((ext_vector_type(4)));
typedef unsigned v2u __attribute__((ext_vector_type(2)));
typedef float f32x4 __attribute__((ext_vector_type(4)));
typedef float f32x2 __attribute__((ext_vector_type(2)));
#define LDS_WAIT() asm volatile("s_waitcnt lgkmcnt(0)" ::: "memory")
__device__ __forceinline__ unsigned f2bf(float f) { unsigned u = __builtin_bit_cast(unsigned, f); return (u + 0x7fffu + ((u >> 16) & 1u)) >> 16; }
__device__ __forceinline__ unsigned pk2(float lo, float hi) { unsigned r; asm("v_cvt_pk_bf16_f32 %0, %1, %2" : "=v"(r) : "v"(lo), "v"(hi)); return r; }
__device__ __forceinline__ unsigned pk4_e4m3(f32x4 h) { unsigned o8 = 0u;
    o8 = __builtin_amdgcn_cvt_pk_fp8_f32(__builtin_amdgcn_fmed3f(h[0], -448.0f, 448.0f), __builtin_amdgcn_fmed3f(h[1], -448.0f, 448.0f), o8, false);
    o8 = __builtin_amdgcn_cvt_pk_fp8_f32(__builtin_amdgcn_fmed3f(h[2], -448.0f, 448.0f), __builtin_amdgcn_fmed3f(h[3], -448.0f, 448.0f), o8, true); return o8; }
__device__ __forceinline__ f32x4 up4(v2u w) { return (f32x4){__builtin_bit_cast(float, w.x << 16), __builtin_bit_cast(float, w.x & 0xffff0000u), __builtin_bit_cast(float, w.y << 16), __builtin_bit_cast(float, w.y & 0xffff0000u)}; }
__device__ __forceinline__ float bf2f(unsigned short b) { return __builtin_bit_cast(float, (unsigned)b << 16); }
__device__ __forceinline__ float wave_sum(float v) {
#pragma unroll
    for (int o = 1; o < 64; o <<= 1) v += __shfl_xor(v, o);
    return v;
}

#ifndef MK_FP8_HYIN
#define MK_FP8_HYIN 1
#endif
constexpr float WH_SCALE = 64.0f;
#ifndef MK_FP8_CMIN
#define MK_FP8_CMIN 0
#endif
#ifndef MK_FP8_CMV
#define MK_FP8_CMV 0
#endif
constexpr size_t WS_HB8B = 943 * (1ull << 20);
#ifndef MK_FP8_HYOUT
#define MK_FP8_HYOUT 1
#endif
constexpr float Z_SCALE = 8.0f;
#ifndef MK_FP8_AOUT
#define MK_FP8_AOUT 1
#endif
constexpr float O_SCALE = 16.0f;
#ifndef MK_FP8_CMOUT
#define MK_FP8_CMOUT 0
#endif
constexpr float Y_SCALE = 64.0f;
#ifndef MK_FP8_QKV
#define MK_FP8_QKV 1
#endif
#ifndef MK_LNR_WREG
#define MK_LNR_WREG 0
#endif
#ifndef MK_MERGE_PRO
#define MK_MERGE_PRO 0
#endif
#ifndef MK_FOLLOW_L1INV
#define MK_FOLLOW_L1INV 0
#endif
#ifndef MK_EARLY_WB
#define MK_EARLY_WB 0
#endif
#define XB_TMO      128
#define XB_XCNT(j)  (256  + 64 * (j))
#define XB_XSUB(j)  (1280 + 64 * (j))
#define XB_XGEN(j)  (2304 + 64 * (j))
#define XB_TOP      3328
#define XB_TOPGEN   3392
#define XCD_BAR_WORDS 3456
#define XB_SPIN_CAP (1u << 18)
__device__ __forceinline__ unsigned xb_ld(unsigned* p)              { return __hip_atomic_load(p, __ATOMIC_RELAXED, __HIP_MEMORY_SCOPE_AGENT); }
__device__ __forceinline__ unsigned xb_add(unsigned* p, unsigned v) { return __hip_atomic_fetch_add(p, v, __ATOMIC_RELAXED, __HIP_MEMORY_SCOPE_AGENT); }
__device__ __forceinline__ unsigned xb_xcc_id() { return (unsigned)__builtin_amdgcn_s_getreg((3 << 11) | 20) & 0xFu; }
#define XB_SPIN(cond, bar) do { unsigned _sp = 0; while (cond) { __builtin_amdgcn_s_sleep(1); \
    if ((++_sp & 255u) == 0u) { if (xb_ld(&(bar)[XB_TMO])) break; if (_sp > XB_SPIN_CAP) { atomicAdd(&(bar)[XB_TMO], 1u); break; } } } } while (0)
struct XcdBarrier { unsigned* bar; unsigned x; volatile LAS unsigned* st; };
__device__ __forceinline__ XcdBarrier xcd_barrier_post(unsigned* bar, volatile LAS unsigned* st) {
    XcdBarrier b; b.bar = bar; b.x = xb_xcc_id(); b.st = st;
    if (threadIdx.x == 0) (void)xb_add(&bar[XB_XCNT(b.x)], 1u);
    return b;
}
__device__ __forceinline__ void xcd_barrier_complete(unsigned* bar, unsigned x, unsigned& nloc, unsigned& nx) {
    const unsigned G = gridDim.x * gridDim.y * gridDim.z;
    unsigned sum, cnt, mine, sp = 0u;
    for (;;) {
        sum = 0u; cnt = 0u; mine = 0u;
#pragma unroll
        for (unsigned j = 0; j < 16; ++j) { const unsigned c = xb_ld(&bar[XB_XCNT(j)]); sum += c; cnt += (c > 0u) ? 1u : 0u; mine = (j == x) ? c : mine; }
        if (sum == G) break;
        __builtin_amdgcn_s_sleep(1);
        if ((++sp & 255u) == 0u) { if (xb_ld(&bar[XB_TMO])) break; if (sp > XB_SPIN_CAP) { atomicAdd(&bar[XB_TMO], 1u); break; } }
    }
    nloc = mine > 0u ? mine : 1u; nx = cnt > 0u ? cnt : 1u;
}
__device__ __forceinline__ void xcd_barrier(const XcdBarrier& b) {
    asm volatile("s_waitcnt vmcnt(0)" ::: "memory");
    __syncthreads();
    if (threadIdx.x == 0) {
        unsigned* bar = b.bar; asm volatile("" : "+s"(bar));
        __builtin_amdgcn_s_waitcnt(0);
        unsigned bx_ = b.x; asm volatile("" : "+s"(bx_));
        unsigned nloc = b.st[0], nx = b.st[1];
        if (nloc == 0u) { xcd_barrier_complete(bar, bx_, nloc, nx); b.st[0] = nloc; b.st[1] = nx; }
#if MK_EARLY_WB
        asm volatile("buffer_wbl2 sc1" ::: "memory");
#endif
        const unsigned old = xb_add(&bar[XB_XSUB(bx_)], 1u);
        const unsigned gen = old / nloc;
        if (old + 1u == (gen + 1u) * nloc) {
            __builtin_amdgcn_fence(__ATOMIC_RELEASE, "agent");
            asm volatile("s_waitcnt vmcnt(0)" ::: "memory");
            const unsigned og = xb_add(&bar[XB_TOP], 1u);
            const unsigned tg = og / nx;
            if (og + 1u == (tg + 1u) * nx) xb_add(&bar[XB_TOPGEN], 1u);
            else XB_SPIN(xb_ld(&bar[XB_TOPGEN]) == tg, bar);
            __builtin_amdgcn_fence(__ATOMIC_ACQUIRE, "agent");
            xb_add(&bar[XB_XGEN(bx_)], 1u);
            asm volatile("s_waitcnt vmcnt(0)" ::: "memory");
        } else {
            XB_SPIN(xb_ld(&bar[XB_XGEN(bx_)]) == gen, bar);
#if MK_FOLLOW_L1INV
            asm volatile("buffer_inv sc0" ::: "memory");
#else
            __builtin_amdgcn_fence(__ATOMIC_ACQUIRE, "agent");
#endif
            asm volatile("s_waitcnt vmcnt(0)" ::: "memory");
        }
    }
    __syncthreads();
}

struct Args { const float* in[33]; float* out; unsigned char* ws; int ph_lo, ph_hi; };
enum { I_X = 0, I_C, I_CTX, I_CCTX, I_MODW, I_MODB, I_LNG, I_LNB, I_HYWIN, I_HYCW, I_HYCB, I_FW1, I_FB1, I_FW2, I_FB2, I_FW3, I_FFREQ, I_FBIAS, I_HYWOUT,
       I_WQKV, I_QGAIN, I_KGAIN, I_WATO, I_CMWIN, I_CMLNG, I_CMLNB, I_CMWS, I_CMBS, I_CMWOUT, I_ROUTER, I_WGATE, I_WUP, I_WDOWN };
typedef const __attribute__((address_space(4))) Args* ArgsP;
__device__ __forceinline__ ArgsP get_args() { auto p = __builtin_amdgcn_kernarg_segment_ptr(); asm volatile("" : "+s"(p)); return (ArgsP)p; }
struct Fr { LAS unsigned char* lds; int tid, lane, wave, vcu, G, bx; };
__device__ __forceinline__ Fr mkfr(unsigned char* lds_raw) {
    Fr F; int tid = threadIdx.x; asm volatile("" : "+v"(tid)); int bx = blockIdx.x, G = gridDim.x; asm volatile("" : "+s"(bx), "+s"(G));
    F.lds = (LAS unsigned char*)lds_raw; F.tid = tid; F.lane = tid & 63; F.wave = __builtin_amdgcn_readfirstlane(tid >> 6);
    F.G = G; F.bx = bx; F.vcu = (G % 8 == 0) ? (bx % 8) * (G / 8) + bx / 8 : bx; return F; }
__device__ __forceinline__ void proA_adaln_item(ArgsP a, const Fr& F, int it) {
    LAS float* sc = (LAS float*)F.lds;
    const int i = it / 96, ks = (it / 12) % 8, cc = it % 12;
    __syncthreads();
    for (int u = F.tid; u < 5 * 128; u += NTHR) { const int r = u / 128, k = ks * 128 + (u % 128);
        const float x = r < 4 ? a->in[I_C][r * D + k] : a->in[I_CCTX][k]; sc[u] = x / (1.0f + expf(-x)); }
    __syncthreads();
    const int col = cc * 512 + F.tid;
    const float* w = a->in[I_MODW] + ((size_t)i * D + (size_t)ks * 128) * 6144 + col;
    float acc[5] = {0.f, 0.f, 0.f, 0.f, 0.f};
#pragma unroll 8
    for (int k = 0; k < 128; ++k) { const float wv = w[(size_t)k * 6144];
#pragma unroll
        for (int r = 0; r < 5; ++r) acc[r] += sc[r * 128 + k] * wv; }
    float* mp = (float*)(a->ws + WS_MODP) + (size_t)((i * 8 + ks) * 5) * 6144 + col;
#pragma unroll
    for (int r = 0; r < 5; ++r) {
#if MK_MERGE_PRO
        asm volatile("global_store_dword %0, %1, off sc0 sc1" :: "v"(mp + (size_t)r * 6144), "v"(acc[r]) : "memory");
#else
        mp[(size_t)r * 6144] = acc[r];
#endif
    }
}
__device__ __forceinline__ void proA_filter_item(ArgsP a, const Fr& F, int it) {
    int slot, L, t0; float* HF;
    if (it < 512) { slot = it >> 8; L = SEQ; t0 = (it & 255) * 16; HF = (float*)(a->ws + WS_HF + (size_t)slot * HF_SLOT); }
    else { slot = 0; L = LC; t0 = (it - 512) * 16; HF = (float*)(a->ws + WS_HF + HF_CTX); }
    LAS float* z = (LAS float*)F.lds;
    LAS float* h1 = z + 16 * 33;
    LAS float* h2 = h1 + 16 * 64;
    LAS float* w1s = h2 + 16 * 64;
    LAS float* w2s = w1s + 33 * 64;
    __syncthreads();
    for (int u = F.tid; u < 33 * 64; u += NTHR) w1s[u] = a->in[I_FW1][(size_t)slot * 33 * 64 + u];
    for (int u = F.tid; u < 64 * 64; u += NTHR) w2s[u] = a->in[I_FW2][(size_t)slot * 64 * 64 + u];
    for (int u = F.tid; u < 16 * 33; u += NTHR) { const int tt = u / 33, j = u % 33; const float tf = (float)(t0 + tt);
        float v;
        if (j == 0) v = tf / (float)(L - 1);
        else { const int jj = (j - 1) & 15; const float f = 1e-4f + (float)jj * ((15.0f - 1e-4f) / 15.0f); const float w = (float)(6.283185307179586 / (double)L) * tf;
            v = j <= 16 ? cosf(f * w) : -sinf(f * w); }
        z[u] = v; }
    __syncthreads();
    const LAS float* w1 = w1s; const float* b1 = a->in[I_FB1] + slot * 64;
    const LAS float* w2 = w2s; const float* b2 = a->in[I_FB2] + slot * 64;
    const float* fq = a->in[I_FFREQ] + slot * 128;
    for (int u = F.tid; u < 16 * 64; u += NTHR) { const int tt = u >> 6, j = u & 63; float s = b1[j];
        for (int i = 0; i < 33; ++i) s += z[tt * 33 + i] * w1[i * 64 + j];
        h1[u] = sinf(fq[j] * s); }
    __syncthreads();
    for (int u = F.tid; u < 16 * 64; u += NTHR) { const int tt = u >> 6, j = u & 63; float s = b2[j];
        for (int i = 0; i < 64; ++i) s += h1[tt * 64 + i] * w2[i * 64 + j];
        h2[u] = sinf(fq[64 + j] * s); }
    __syncthreads();
    const float* w3 = a->in[I_FW3] + (size_t)slot * 64 * 4096;
    const float dmin = -3.0701134573253940f, dmax = -15.350567286626973f;
    const int lane = F.lane, lm = lane & 15, lk = lane >> 4;
    float af[16];
#pragma unroll
    for (int s = 0; s < 16; ++s) af[s] = h2[lm * 64 + 4 * s + lk];
    float tl[4];
#pragma unroll
    for (int j = 0; j < 4; ++j) tl[j] = (float)(t0 + 4 * lk + j) / (float)(L - 1);
#define FILT_LOAD(bA, bB, ct_) do { const int c0_ = (F.wave * 32 + (ct_)) * 16 + lm; _Pragma("unroll") for (int s = 0; s < 16; ++s) { bA[s] = w3[(size_t)(4 * s + lk) * 4096 + c0_]; bB[s] = w3[(size_t)(4 * s + lk) * 4096 + c0_ + 16]; } } while (0)
#define FILT_STEP(bA, bB, ct_) do { const int c0 = (F.wave * 32 + (ct_)) * 16 + lm, c1 = c0 + 16; f32x4 acc0 = {0.f, 0.f, 0.f, 0.f}, acc1 = {0.f, 0.f, 0.f, 0.f}; \
        _Pragma("unroll") for (int s = 0; s < 16; ++s) { acc0 = __builtin_amdgcn_mfma_f32_16x16x4f32(af[s], bA[s], acc0, 0, 0, 0); acc1 = __builtin_amdgcn_mfma_f32_16x16x4f32(af[s], bB[s], acc1, 0, 0, 0); } \
        { const float delta = fabsf(dmin + (float)(c0 & 1023) * ((dmax - dmin) / 1023.0f)); f32x4 o; _Pragma("unroll") for (int j = 0; j < 4; ++j) o[j] = acc0[j] * expf(-tl[j] * delta); *(f32x4*)(HF + (size_t)c0 * L + t0 + 4 * lk) = o; } \
        { const float delta = fabsf(dmin + (float)(c1 & 1023) * ((dmax - dmin) / 1023.0f)); f32x4 o; _Pragma("unroll") for (int j = 0; j < 4; ++j) o[j] = acc1[j] * expf(-tl[j] * delta); *(f32x4*)(HF + (size_t)c1 * L + t0 + 4 * lk) = o; } } while (0)
    float p0[16], p1[16], q0[16], q1[16];
    FILT_LOAD(p0, p1, 0);
    for (int ct = 0; ct < 32; ct += 4) {
        FILT_LOAD(q0, q1, ct + 2);
        FILT_STEP(p0, p1, ct);
        if (ct + 4 < 32) FILT_LOAD(p0, p1, ct + 4);
        FILT_STEP(q0, q1, ct + 2);
    }
#undef FILT_LOAD
#undef FILT_STEP
}
__device__ __forceinline__ void conv_tile(const float* W, int K, int N, int k0, int n0, bf16* WT, int drow0, LAS float* scr, int lane) {
    float rv[64];
#pragma unroll
    for (int i = 0; i < 64; ++i) rv[i] = W[(size_t)(k0 + i) * N + n0 + lane];
#pragma unroll
    for (int i = 0; i < 64; ++i) scr[i * 65 + lane] = rv[i];
    LDS_WAIT(); asm volatile("" ::: "memory");
    const int c = lane & 7;
#pragma unroll
    for (int j = 0; j < 8; ++j) { const int n = (lane >> 3) + 8 * j; const LAS float* s = scr + (8 * c) * 65 + n;
        v4u o; o.x = pk2(s[0 * 65], s[1 * 65]); o.y = pk2(s[2 * 65], s[3 * 65]); o.z = pk2(s[4 * 65], s[5 * 65]); o.w = pk2(s[6 * 65], s[7 * 65]);
        *(v4u*)(WT + (size_t)(drow0 + n) * K + k0 + 8 * c) = o; }
    LDS_WAIT(); asm volatile("" ::: "memory");
}
__device__ __forceinline__ void conv_tile8(const float* W, int K, int N, int k0, int n0, unsigned char* WT, int drow0, float scale, LAS float* scr, int lane) {
    float rv[64];
#pragma unroll
    for (int i = 0; i < 64; ++i) rv[i] = W[(size_t)(k0 + i) * N + n0 + lane];
#pragma unroll
    for (int i = 0; i < 64; ++i) scr[i * 65 + lane] = __builtin_amdgcn_fmed3f(rv[i] * scale, -448.0f, 448.0f);
    LDS_WAIT(); asm volatile("" ::: "memory");
    const int c = lane & 3;
#pragma unroll
    for (int j = 0; j < 4; ++j) { const int n = (lane >> 2) + 16 * j; const LAS float* s = scr + (16 * c) * 65 + n;
        unsigned w[4];
#pragma unroll
        for (int q = 0; q < 4; ++q) { unsigned x = 0u; x = __builtin_amdgcn_cvt_pk_fp8_f32(s[(4 * q) * 65], s[(4 * q + 1) * 65], x, false); x = __builtin_amdgcn_cvt_pk_fp8_f32(s[(4 * q + 2) * 65], s[(4 * q + 3) * 65], x, true); w[q] = x; }
        v4u o; o.x = w[0]; o.y = w[1]; o.z = w[2]; o.w = w[3];
        *(v4u*)(WT + (size_t)(drow0 + n) * K + k0 + 16 * c) = o; }
    LDS_WAIT(); asm volatile("" ::: "memory");
}
struct Cv8 { const float* src; unsigned char* dst; int N, K; float scale; };
__device__ __forceinline__ void conv8_load(const Cv8& d, float (&rv)[64], int lane) {
#pragma unroll
    for (int i = 0; i < 64; ++i) rv[i] = d.src[(size_t)i * d.N + lane];
}
__device__ __forceinline__ void conv8_store(const Cv8& d, const float (&rv)[64], LAS float* scr, int lane) {
#pragma unroll
    for (int i = 0; i < 64; ++i) scr[i * 65 + lane] = __builtin_amdgcn_fmed3f(rv[i] * d.scale, -448.0f, 448.0f);
    LDS_WAIT(); asm volatile("" ::: "memory");
    const int c = lane & 3;
#pragma unroll
    for (int j = 0; j < 4; ++j) { const int n = (lane >> 2) + 16 * j; const LAS float* s = scr + (16 * c) * 65 + n;
        unsigned w[4];
#pragma unroll
        for (int q = 0; q < 4; ++q) { unsigned x = 0u; x = __builtin_amdgcn_cvt_pk_fp8_f32(s[(4 * q) * 65], s[(4 * q + 1) * 65], x, false); x = __builtin_amdgcn_cvt_pk_fp8_f32(s[(4 * q + 2) * 65], s[(4 * q + 3) * 65], x, true); w[q] = x; }
        v4u o; o.x = w[0]; o.y = w[1]; o.z = w[2]; o.w = w[3];
        *(v4u*)(d.dst + (size_t)n * d.K + 16 * c) = o; }
    LDS_WAIT(); asm volatile("" ::: "memory");
}
#ifndef MK_CV_CHUNK
#define MK_CV_CHUNK 4
#endif
#ifndef MK_CV_ORDER
#define MK_CV_ORDER 0
#endif
#ifndef MK_CV_PIPE
#define MK_CV_PIPE 0
#endif
#ifndef MK_FP8_DN
#define MK_FP8_DN 1
#endif
constexpr float WGU_SCALE = 64.0f, WDN_SCALE = 128.0f, ACT_SCALE = 2.0f;
constexpr int CV_SMALL = 768 * 2 + 256 * 2 + 384 + 256 + 1024 + 512;
constexpr int CV_MOE = 4 * 16 * 3 * 512;
__device__ __forceinline__ void proA_conv_item(ArgsP a, int it, LAS float* scr, int lane) {
    unsigned char* ws = a->ws;
    if (it < CV_SMALL) {
        int r = it;
        if (r < 1536) { const int s = r / 768, q = r % 768, kb = q / 48, nb = q % 48;
#if MK_FP8_HYIN
            conv_tile8(a->in[I_HYWIN] + (size_t)s * 1024 * 3072, 1024, 3072, kb * 64, nb * 64, (unsigned char*)(ws + WS_WHYIN) + (size_t)s * 3072 * 1024, nb * 64, WH_SCALE, scr, lane); return; } r -= 1536;
#else
            conv_tile(a->in[I_HYWIN] + (size_t)s * 1024 * 3072, 1024, 3072, kb * 64, nb * 64, (bf16*)(ws + WS_WHYIN) + (size_t)s * 3072 * 1024, nb * 64, scr, lane); return; } r -= 1536;
#endif
        if (r < 512) { const int s = r / 256, q = r % 256, kb = q / 16, nb = q % 16;
#if MK_FP8_HYOUT
            conv_tile8(a->in[I_HYWOUT] + (size_t)s * 1024 * 1024, 1024, 1024, kb * 64, nb * 64, (unsigned char*)(ws + WS_WHYOUT) + (size_t)s * 1024 * 1024, nb * 64, WH_SCALE, scr, lane); return; } r -= 512;
#else
            conv_tile(a->in[I_HYWOUT] + (size_t)s * 1024 * 1024, 1024, 1024, kb * 64, nb * 64, (bf16*)(ws + WS_WHYOUT) + (size_t)s * 1024 * 1024, nb * 64, scr, lane); return; } r -= 512;
#endif
        if (r < 384) { const int kb = r / 24, nb = r % 24;
#if MK_FP8_QKV
            conv_tile8(a->in[I_WQKV], 1024, 1536, kb * 64, nb * 64, (unsigned char*)(ws + WS_WQKV), nb * 64, WH_SCALE, scr, lane); return; } r -= 384;
#else
            conv_tile(a->in[I_WQKV], 1024, 1536, kb * 64, nb * 64, (bf16*)(ws + WS_WQKV), nb * 64, scr, lane); return; } r -= 384;
#endif
        if (r < 256) { const int kb = r / 16, nb = r % 16;
#if MK_FP8_AOUT
            conv_tile8(a->in[I_WATO], 1024, 1024, kb * 64, nb * 64, (unsigned char*)(ws + WS_WATO), nb * 64, WH_SCALE, scr, lane); return; } r -= 256;
#else
            conv_tile(a->in[I_WATO], 1024, 1024, kb * 64, nb * 64, (bf16*)(ws + WS_WATO), nb * 64, scr, lane); return; } r -= 256;
#endif
        if (r < 1024) { const int kb = r / 64, nb = r % 64;
#if MK_FP8_CMIN
            conv_tile8(a->in[I_CMWIN], 1024, 4096, kb * 64, nb * 64, (unsigned char*)(ws + WS_WCMIN), nb * 64, WH_SCALE, scr, lane); return; } r -= 1024;
#elif MK_FP8_CMV
            if (nb >= 32) { conv_tile8(a->in[I_CMWIN], 1024, 4096, kb * 64, nb * 64, (unsigned char*)(ws + WS_WCMIN) + (size_t)2048 * 1024 * 2, (nb - 32) * 64, WH_SCALE, scr, lane); return; }
            conv_tile(a->in[I_CMWIN], 1024, 4096, kb * 64, nb * 64, (bf16*)(ws + WS_WCMIN), nb * 64, scr, lane); return; } r -= 1024;
#else
            conv_tile(a->in[I_CMWIN], 1024, 4096, kb * 64, nb * 64, (bf16*)(ws + WS_WCMIN), nb * 64, scr, lane); return; } r -= 1024;
#endif
        { const int kb = r / 16, nb = r % 16;
#if MK_FP8_CMOUT
            conv_tile8(a->in[I_CMWOUT], 2048, 1024, kb * 64, nb * 64, (unsigned char*)(ws + WS_WCMOUT), nb * 64, WH_SCALE, scr, lane); return; }
#else
            conv_tile(a->in[I_CMWOUT], 2048, 1024, kb * 64, nb * 64, (bf16*)(ws + WS_WCMOUT), nb * 64, scr, lane); return; }
#endif
    }
    const int r = it - CV_SMALL, mat = r / 512, q = r % 512, le = mat / 3, which = mat % 3;
    if (which < 2) { const int kb = MK_CV_ORDER ? (q >> 7) * 4 + (q & 3) : q / 32, nb = MK_CV_ORDER ? (q >> 2) & 31 : q % 32, n0 = nb * 64;
        const float* src = a->in[which == 0 ? I_WGATE : I_WUP] + (size_t)le * 1024 * 2048;
        conv_tile8(src, 1024, 2048, kb * 64, n0, (unsigned char*)(ws + WS_WGU) + (size_t)le * 4096 * 1024, (n0 >> 7) * 256 + (n0 & 127) + which * 128, WGU_SCALE, scr, lane); }
    else { const int kb = MK_CV_ORDER ? (q >> 6) * 4 + (q & 3) : q / 16, nb = MK_CV_ORDER ? (q >> 2) & 15 : q % 16;
#if MK_FP8_DN
        conv_tile8(a->in[I_WDOWN] + (size_t)le * 2048 * 1024, 2048, 1024, kb * 64, nb * 64, (unsigned char*)(ws + WS_WDN) + (size_t)le * 1024 * 2048, nb * 64, WDN_SCALE, scr, lane); }
#else
        conv_tile(a->in[I_WDOWN] + (size_t)le * 2048 * 1024, 2048, 1024, kb * 64, nb * 64, (bf16*)(ws + WS_WDN) + (size_t)le * 1024 * 2048, nb * 64, scr, lane); }
#endif
}
#if MK_FP8_DN
__device__ __forceinline__ Cv8 cv8_desc(ArgsP a, int it) {
    unsigned char* ws = a->ws;
    const int r = it - CV_SMALL, mat = r / 512, q = r % 512, le = mat / 3, which = mat % 3;
    Cv8 d;
    if (which < 2) { const int kb = MK_CV_ORDER ? (q >> 7) * 4 + (q & 3) : q / 32, nb = MK_CV_ORDER ? (q >> 2) & 31 : q % 32, n0 = nb * 64;
        d.src = a->in[which == 0 ? I_WGATE : I_WUP] + (size_t)le * 1024 * 2048 + (size_t)(kb * 64) * 2048 + n0; d.N = 2048; d.K = 1024; d.scale = WGU_SCALE;
        d.dst = (unsigned char*)(ws + WS_WGU) + (size_t)le * 4096 * 1024 + (size_t)((n0 >> 7) * 256 + (n0 & 127) + which * 128) * 1024 + kb * 64; }
    else { const int kb = MK_CV_ORDER ? (q >> 6) * 4 + (q & 3) : q / 16, nb = MK_CV_ORDER ? (q >> 2) & 15 : q % 16;
        d.src = a->in[I_WDOWN] + (size_t)le * 2048 * 1024 + (size_t)(kb * 64) * 1024 + nb * 64; d.N = 1024; d.K = 2048; d.scale = WDN_SCALE;
        d.dst = (unsigned char*)(ws + WS_WDN) + (size_t)le * 1024 * 2048 + (size_t)(nb * 64) * 2048 + kb * 64; }
    return d;
}
#endif
constexpr int CV_TOTAL = CV_SMALL + CV_MOE;
constexpr int BG_IDLE[7] = {208, 240, 128, 192, 104, 192, 192};
#ifndef MK_BG_TPW
#define MK_BG_TPW {4, 4, 2, 3, 3, 2, 2}
#endif
constexpr int BG_TPW[7] = MK_BG_TPW;
constexpr int bg_base(int w) { int s = 0; for (int i = 0; i < w; ++i) s += BG_IDLE[i] * 8 * BG_TPW[i]; return s; }
constexpr int CV_DEFER = bg_base(7);
static_assert(CV_DEFER <= 2 * 24576, "the deferred tiles must all belong to layers 2 and 3 (first needed by the layer-2 expert GEMMs; every window runs before that)");
template <int W> __device__ __forceinline__ void bg_convert(ArgsP a, const Fr& F, int rank) {
    if (F.G != 256 || rank < 0 || rank >= BG_IDLE[W]) return;
    LAS float* scr = (LAS float*)(F.lds + F.wave * 16640);
    constexpr int nw = BG_IDLE[W] * 8; const int widx = rank * 8 + F.wave;
#pragma unroll 1
    for (int k = 0; k < BG_TPW[W]; ++k) proA_conv_item(a, CV_TOTAL - CV_DEFER + bg_base(W) + k * nw + widx, scr, F.lane);
}
__device__ __forceinline__ void phase_proB(ArgsP a, const Fr& F);
__device__ __forceinline__ void phase_proA(ArgsP a, const Fr& F) {
    const int gt = F.vcu * NTHR + F.tid, NGT = F.G * NTHR;
    for (int k = gt; k < 8192; k += NGT) { float s, c; sincospif((float)k * (1.0f / 4096.0f), &s, &c); ((f32x2*)(a->ws + WS_TW))[k] = (f32x2){c, s}; }
    for (int k = gt; k < 16 * 128 * 128; k += NGT) ((bf16*)(a->ws + WS_WCMS))[k] = (bf16)f2bf(a->in[I_CMWS][k]);
    const int nbl = F.G >= 2 ? F.G / 2 : 1;
    if (F.vcu < nbl) { for (int it = F.vcu; it < 384 + 528; it += nbl) {
        if (it < 384) { proA_adaln_item(a, F, it);
#if MK_MERGE_PRO
            asm volatile("s_waitcnt vmcnt(0)" ::: "memory"); __syncthreads();
            if (F.tid == 0) (void)xb_add((unsigned*)(a->ws + WS_CTL) + 8256, 1u);
#endif
        } else proA_filter_item(a, F, it - 384); } }
    __syncthreads();
    LAS float* scr = (LAS float*)(F.lds + F.wave * 16640);
    unsigned* q = (unsigned*)(a->ws + WS_CTL) + 8192;
    const unsigned lim = (unsigned)(F.G == 256 ? CV_TOTAL - CV_DEFER : CV_TOTAL);
    for (;;) {
        unsigned i0 = 0u; if (F.lane == 0) i0 = __hip_atomic_fetch_add(q, (unsigned)MK_CV_CHUNK, __ATOMIC_RELAXED, __HIP_MEMORY_SCOPE_AGENT);
        i0 = (unsigned)__builtin_amdgcn_readfirstlane((int)i0);
        if (i0 >= lim) break;
#if MK_FP8_DN && MK_CV_PIPE
        if (MK_CV_CHUNK == 4 && i0 >= (unsigned)CV_SMALL && i0 + 4u <= lim) {
            float rv[64]; Cv8 dn = cv8_desc(a, (int)i0); conv8_load(dn, rv, F.lane);
#pragma unroll 1
            for (int k = 0; k < 4; ++k) { float cur[64]; const Cv8 dc = dn;
#pragma unroll
                for (int i = 0; i < 64; ++i) cur[i] = rv[i];
                if (k < 3) { dn = cv8_desc(a, (int)i0 + k + 1); conv8_load(dn, rv, F.lane); }
                conv8_store(dc, cur, scr, F.lane); }
            continue; }
#endif
        for (unsigned it = i0; it < i0 + (unsigned)MK_CV_CHUNK && it < lim; ++it) proA_conv_item(a, (int)it, scr, F.lane);
    }
#if MK_MERGE_PRO
    __syncthreads();
    if (F.tid == 0) { unsigned* ctl = (unsigned*)(a->ws + WS_CTL); XB_SPIN(xb_ld(ctl + 8256) < 384u, ctl + 4096); }
    __syncthreads();
    __builtin_amdgcn_fence(__ATOMIC_ACQUIRE, "agent");
    phase_proB(a, F);
#endif
}
__device__ __forceinline__ void phase_proB(ArgsP a, const Fr& F) {
    LAS float* m0 = (LAS float*)F.lds;
    const float* mp = (const float*)(a->ws + WS_MODP);
    for (int u = F.tid; u < 5 * 2048; u += NTHR) { const int r = u / 2048, c = u % 2048; float s = a->in[I_MODB][c];
        for (int ks = 0; ks < 8; ++ks) s += mp[(size_t)(ks * 5 + r) * 6144 + c];
        m0[u] = s; }
    __syncthreads();
    const int gw = F.vcu * NWAVES + F.wave, NGW = F.G * NWAVES;
    for (int row = gw; row < TA; row += NGW) {
        const int r = row < T ? (row >> 12) : 4;
        const float* src = row < T ? a->in[I_X] + (size_t)row * D : a->in[I_CTX] + (size_t)(row - T) * D;
        bf16* xl = (bf16*)(a->ws + WS_XC) + (size_t)row * D; const int hrow = row < T ? (row & ~4095) + ((row & 511) << 3) + ((row & 4095) >> 9) : row;
        bf16* hb = (bf16*)(a->ws + WS_HB) + (size_t)hrow * D;
#pragma unroll
        for (int j = 0; j < 4; ++j) { const int c = 4 * F.lane + 256 * j; const f32x4 v = *(const f32x4*)(src + c); { v2u xo; xo.x = pk2(v[0], v[1]); xo.y = pk2(v[2], v[3]); *(v2u*)(xl + c) = xo; }
            const f32x4 sh = *(const LAS f32x4*)(m0 + r * 2048 + c), sc = *(const LAS f32x4*)(m0 + r * 2048 + 1024 + c);
            const f32x4 h = v * (sc + 1.0f) + sh;
#if MK_FP8_HYIN
            *(unsigned*)((unsigned char*)(a->ws + WS_HB) + (size_t)hrow * D + c) = pk4_e4m3(h); }
#else
            v2u o; o.x = pk2(h[0], h[1]); o.y = pk2(h[2], h[3]); *(v2u*)(hb + c) = o; }
#endif
    }
    const int gt = F.vcu * NTHR + F.tid, NGT = F.G * NTHR;
    float* mod = (float*)(a->ws + WS_MOD);
    for (int u = gt; u < 4 * 5 * 6144; u += NGT) { const int i = u / 30720, r = (u / 6144) % 5, c = u % 6144; float s = a->in[I_MODB][i * 6144 + c];
        for (int ks = 0; ks < 8; ++ks) s += mp[(size_t)((i * 8 + ks) * 5 + r) * 6144 + c];
        mod[u] = s; }
}
template <int L>
__device__ __forceinline__ float sconv(const bf16* p, int t, float w0, float w1, float w2, float cb) {
    const float a = t > 0 ? bf2f(p[t - 1]) : 0.f, b = bf2f(p[t]), c = t < L - 1 ? bf2f(p[t + 1]) : 0.f; return w0 * a + w1 * b + w2 * c + cb;
}
template <int L>
__device__ __forceinline__ void hy_direct_item(ArgsP a, const Fr& F, int slot, int d, int tok0, const float* HF) {
    LAS float* kk = (LAS float*)F.lds;
    LAS float* vb = kk + 4 * L;
    LAS float* red = vb + 4 * L;
    const bf16* PT = (const bf16*)(a->ws + SC_PT);
    bf16* Z2T = (bf16*)(a->ws + SC_Z2T);
    __syncthreads();
    for (int o = 0; o < 2; ++o) {
        const float* fw = HF + (size_t)((o * 2 + 0) * 1024 + d) * L; const float* bw = HF + (size_t)((o * 2 + 1) * 1024 + d) * L;
        float s = 0.f;
        for (int t = F.tid; t < L; t += NTHR) { const float f = fw[t], b = bw[t]; kk[o * 2 * L + (L - 1) + t] = f; if (t >= 1) kk[o * 2 * L + (L - 1) - t] = b; s += fabsf(f) + (t >= 1 ? fabsf(b) : 0.f); }
        s = wave_sum(s); if (F.lane == 0) red[o * 8 + F.wave] = s;
    }
    __syncthreads();
    float nrm[2];
#pragma unroll
    for (int o = 0; o < 2; ++o) { float s = 0.f; for (int w = 0; w < 8; ++w) s += red[o * 8 + w]; nrm[o] = 1.0f / (s + 1e-6f); }
    const float* cw = a->in[I_HYCW] + (size_t)slot * 3 * 3072; const float* cbp = a->in[I_HYCB] + (size_t)slot * 3072;
    float w0[3], w1[3], w2[3], cb[3];
#pragma unroll
    for (int g = 0; g < 3; ++g) { const int c = g * 1024 + d; w0[g] = cw[c]; w1[g] = cw[3072 + c]; w2[g] = cw[2 * 3072 + c]; cb[g] = cbp[c]; }
    const float fb0 = a->in[I_FBIAS][(slot * 2 + 0) * 1024 + d], fb1 = a->in[I_FBIAS][(slot * 2 + 1) * 1024 + d];
    for (int u = F.tid; u < 4 * L; u += NTHR) { const int b = u / L, t = u % L; vb[u] = sconv<L>(PT + (size_t)d * TA + tok0 + b * L, t, w0[0], w1[0], w2[0], cb[0]); }
    __syncthreads();
    constexpr int NBLK = 4 * L / 8, PER = (NBLK + NTHR - 1) / NTHR;
    float res[PER][8];
#pragma unroll 1
    for (int o = 0; o < 2; ++o) {
        const LAS float* ko = kk + o * 2 * L;
#pragma unroll
        for (int pi = 0; pi < PER; ++pi) {
            const int q = F.tid + pi * NTHR;
            float acc[8];
#pragma unroll
            for (int j = 0; j < 8; ++j) acc[j] = 0.f;
            if (q < NBLK) {
                const int b = q / (L / 8), t0 = (q % (L / 8)) * 8;
                const LAS float* vv = vb + b * L;
#pragma unroll 1
                for (int s8 = 0; s8 < L; s8 += 8) {
                    const LAS float* kw = ko + (t0 - s8 - 7 + L - 1);
                    float w[15], x[8];
#pragma unroll
                    for (int i = 0; i < 15; ++i) w[i] = kw[i];
#pragma unroll
                    for (int i = 0; i < 8; ++i) x[i] = vv[s8 + i];
#pragma unroll
                    for (int j = 0; j < 8; ++j)
#pragma unroll
                        for (int i = 0; i < 8; ++i) acc[j] += w[j - i + 7] * x[i];
                }
            }
#pragma unroll
            for (int j = 0; j < 8; ++j) res[pi][j] = acc[j];
        }
        __syncthreads();
#pragma unroll
        for (int pi = 0; pi < PER; ++pi) {
            const int q = F.tid + pi * NTHR;
            if (q < NBLK) {
                const int b = q / (L / 8), t0 = (q % (L / 8)) * 8;
                const bf16* pg = PT + (size_t)((o + 1) * 1024 + d) * TA + tok0 + b * L;
#pragma unroll
                for (int j = 0; j < 8; ++j) { const int t = t0 + j; const float vin = vb[b * L + t];
                    const float y = res[pi][j] * nrm[o] + vin * (o == 0 ? fb0 : fb1);
                    const float xg = sconv<L>(pg, t, w0[o + 1], w1[o + 1], w2[o + 1], cb[o + 1]);
                    res[pi][j] = xg * y; }
            }
        }
        __syncthreads();
        if (o == 0) {
#pragma unroll
            for (int pi = 0; pi < PER; ++pi) { const int q = F.tid + pi * NTHR;
                if (q < NBLK) { const int b = q / (L / 8), t0 = (q % (L / 8)) * 8;
#pragma unroll
                    for (int j = 0; j < 8; ++j) vb[b * L + t0 + j] = res[pi][j]; } }
            __syncthreads();
        } else {
#pragma unroll
            for (int pi = 0; pi < PER; ++pi) { const int q = F.tid + pi * NTHR;
                if (q < NBLK) { const int b = q / (L / 8), t0 = (q % (L / 8)) * 8;
                    v4u ov; ov.x = pk2(res[pi][0], res[pi][1]); ov.y = pk2(res[pi][2], res[pi][3]); ov.z = pk2(res[pi][4], res[pi][5]); ov.w = pk2(res[pi][6], res[pi][7]);
                    *(v4u*)(Z2T + (size_t)d * TA + tok0 + b * L + t0) = ov; } }
        }
    }
}
__device__ __forceinline__ void hy_ctx_item(ArgsP a, const Fr& F, int slot, int d) {
    constexpr int L = LC;
    LAS float* kk = (LAS float*)F.lds;
    LAS float* vb = kk + 4 * L;
    LAS float* red = vb + 4 * L;
    LAS float* ps = red + 16;
    const bf16* PT = (const bf16*)(a->ws + SC_PT); bf16* Z2T = (bf16*)(a->ws + SC_Z2T);
    const float* HF = (const float*)(a->ws + WS_HF + HF_CTX); const int tok0 = T;
    __syncthreads();
    for (int o = 0; o < 2; ++o) {
        const float* fw = HF + (size_t)((o * 2 + 0) * 1024 + d) * L; const float* bw = HF + (size_t)((o * 2 + 1) * 1024 + d) * L;
        float s = 0.f;
        for (int t = F.tid; t < L; t += NTHR) { const float f = fw[t], b = bw[t]; kk[o * 2 * L + (L - 1) + t] = f; if (t >= 1) kk[o * 2 * L + (L - 1) - t] = b; s += fabsf(f) + (t >= 1 ? fabsf(b) : 0.f); }
        s = wave_sum(s); if (F.lane == 0) red[o * 8 + F.wave] = s;
    }
    __syncthreads();
    float nrm[2];
#pragma unroll
    for (int o = 0; o < 2; ++o) { float s = 0.f; for (int w = 0; w < 8; ++w) s += red[o * 8 + w]; nrm[o] = 1.0f / (s + 1e-6f); }
    const float* cw = a->in[I_HYCW] + (size_t)slot * 3 * 3072; const float* cbp = a->in[I_HYCB] + (size_t)slot * 3072;
    float w0[3], w1[3], w2[3], cb[3];
#pragma unroll
    for (int g = 0; g < 3; ++g) { const int c = g * 1024 + d; w0[g] = cw[c]; w1[g] = cw[3072 + c]; w2[g] = cw[2 * 3072 + c]; cb[g] = cbp[c]; }
    const float fb0 = a->in[I_FBIAS][(slot * 2 + 0) * 1024 + d], fb1 = a->in[I_FBIAS][(slot * 2 + 1) * 1024 + d];
    for (int u = F.tid; u < 4 * L; u += NTHR) { const int b = u / L, t = u % L; vb[u] = sconv<L>(PT + (size_t)d * TA + tok0 + b * L, t, w0[0], w1[0], w2[0], cb[0]); }
    __syncthreads();
    const int sq = F.tid >> 7, q = F.tid & 127, b = q >> 5, t0 = (q & 31) * 8;
#pragma unroll 1
    for (int o = 0; o < 2; ++o) {
        const LAS float* ko = kk + o * 2 * L; const LAS float* vv = vb + b * L;
        float acc[8];
#pragma unroll
        for (int j = 0; j < 8; ++j) acc[j] = 0.f;
#pragma unroll 1
        for (int s8 = sq * 64; s8 < sq * 64 + 64; s8 += 8) {
            const LAS float* kw = ko + (t0 - s8 - 7 + L - 1);
            float w[15], x[8];
#pragma unroll
            for (int i = 0; i < 15; ++i) w[i] = kw[i];
#pragma unroll
            for (int i = 0; i < 8; ++i) x[i] = vv[s8 + i];
#pragma unroll
            for (int j = 0; j < 8; ++j)
#pragma unroll
                for (int i = 0; i < 8; ++i) acc[j] += w[j - i + 7] * x[i];
        }
#pragma unroll
        for (int j = 0; j < 8; ++j) ps[(sq * 128 + q) * 8 + j] = acc[j];
        __syncthreads();
        float res[8];
        if (F.tid < 128) {
            const bf16* pg = PT + (size_t)((o + 1) * 1024 + d) * TA + tok0 + b * L;
#pragma unroll
            for (int j = 0; j < 8; ++j) { const float cv = ((ps[q * 8 + j] + ps[(128 + q) * 8 + j]) + ps[(256 + q) * 8 + j]) + ps[(384 + q) * 8 + j];
                const int t = t0 + j; const float vin = vb[b * L + t];
                const float y = cv * nrm[o] + vin * (o == 0 ? fb0 : fb1);
                res[j] = sconv<L>(pg, t, w0[o + 1], w1[o + 1], w2[o + 1], cb[o + 1]) * y; }
        }
        __syncthreads();
        if (F.tid < 128) {
            if (o == 0) {
#pragma unroll
                for (int j = 0; j < 8; ++j) vb[b * L + t0 + j] = res[j]; }
            else { v4u ov; ov.x = pk2(res[0], res[1]); ov.y = pk2(res[2], res[3]); ov.z = pk2(res[4], res[5]); ov.w = pk2(res[6], res[7]);
                *(v4u*)(Z2T + (size_t)d * TA + tok0 + b * L + t0) = ov; }
        }
        __syncthreads();
    }
}
__device__ __forceinline__ void phase_hy_tr(ArgsP a, const Fr& F, int ntok) {
    LAS unsigned short* tile = (LAS unsigned short*)(F.lds + F.wave * 9216);
    const bf16* Z2T = (const bf16*)(a->ws + SC_Z2T); bf16* Z2 = (bf16*)(a->ws + SC_Z2);
    const int gw = F.vcu * NWAVES + F.wave, NGW = F.G * NWAVES, ntt = ntok / 64;
    for (int it = gw; it < 16 * ntt; it += NGW) {
        const int c0 = (it / ntt) * 64, t0 = (it % ntt) * 64;
#pragma unroll
        for (int i = 0; i < 8; ++i) { const int ch = i * 8 + (F.lane >> 3), ck = F.lane & 7;
            const v4u v = *(const v4u*)(Z2T + (size_t)(c0 + ch) * TA + t0 + ck * 8); *(LAS v4u*)(tile + ch * 72 + ck * 8) = v; }
        LDS_WAIT(); asm volatile("" ::: "memory");
        int trow = t0 + F.lane;
        if (trow < T) { const int pi = trow & 4095; trow = (trow & ~4095) + (pi >> 3) + 512 * (pi & 7); }
        bf16* dst = Z2 + (size_t)trow * D + c0;
#pragma unroll
        for (int q = 0; q < 8; ++q) { unsigned w[4];
#pragma unroll
            for (int j = 0; j < 4; ++j) { const unsigned lo = tile[(q * 8 + 2 * j) * 72 + F.lane], hi = tile[(q * 8 + 2 * j + 1) * 72 + F.lane]; w[j] = lo | (hi << 16); }
#if MK_FP8_HYOUT
            v2u o8; o8.x = pk4_e4m3((f32x4){__builtin_bit_cast(float, w[0] << 16), __builtin_bit_cast(float, w[0] & 0xffff0000u), __builtin_bit_cast(float, w[1] << 16), __builtin_bit_cast(float, w[1] & 0xffff0000u)} * Z_SCALE);
            o8.y = pk4_e4m3((f32x4){__builtin_bit_cast(float, w[2] << 16), __builtin_bit_cast(float, w[2] & 0xffff0000u), __builtin_bit_cast(float, w[3] << 16), __builtin_bit_cast(float, w[3] & 0xffff0000u)} * Z_SCALE);
            *(v2u*)((unsigned char*)Z2 + (size_t)trow * D + c0 + q * 8) = o8; }
#else
            v4u o; o.x = w[0]; o.y = w[1]; o.z = w[2]; o.w = w[3]; *(v4u*)(dst + q * 8) = o; }
#endif
        LDS_WAIT(); asm volatile("" ::: "memory");
    }
}
__device__ __forceinline__ void phase_hy_conv_direct(ArgsP a, const Fr& F, int layer) {
    const int slot = layer == 0 ? 0 : 1; const int nitems = layer == 0 ? 2048 : 1024;
    for (int it = F.vcu; it < nitems; it += F.G) {
        if (it < 1024) hy_direct_item<SEQ>(a, F, slot, it, 0, (const float*)(a->ws + WS_HF + (size_t)slot * HF_SLOT));
        else hy_direct_item<LC>(a, F, slot, it - 1024, T, (const float*)(a->ws + WS_HF + HF_CTX));
    }
}

__device__ __forceinline__ void lnr_softmax_store(const float (&part)[16], int lane, float* affrow) {
    const bool h5 = (lane & 32) != 0, h4 = (lane & 16) != 0, h3 = (lane & 8) != 0, h2 = (lane & 4) != 0;
    float q8[8], q4[4], q2[2];
#pragma unroll
    for (int k = 0; k < 8; ++k) { const float keep = h5 ? part[8 + k] : part[k], send = h5 ? part[k] : part[8 + k]; q8[k] = keep + __shfl_xor(send, 32); }
#pragma unroll
    for (int k = 0; k < 4; ++k) { const float keep = h4 ? q8[4 + k] : q8[k], send = h4 ? q8[k] : q8[4 + k]; q4[k] = keep + __shfl_xor(send, 16); }
#pragma unroll
    for (int k = 0; k < 2; ++k) { const float keep = h3 ? q4[2 + k] : q4[k], send = h3 ? q4[k] : q4[2 + k]; q2[k] = keep + __shfl_xor(send, 8); }
    float lg; { const float keep = h2 ? q2[1] : q2[0], send = h2 ? q2[0] : q2[1]; lg = keep + __shfl_xor(send, 4); }
    lg += __shfl_xor(lg, 1); lg += __shfl_xor(lg, 2);
    float mx = lg;
#pragma unroll
    for (int o = 4; o < 64; o <<= 1) mx = fmaxf(mx, __shfl_xor(mx, o));
    const float ex = expf(lg - mx); float den = ex;
#pragma unroll
    for (int o = 4; o < 64; o <<= 1) den += __shfl_xor(den, o);
    const int eidx = (h5 ? 8 : 0) + (h4 ? 4 : 0) + (h3 ? 2 : 0) + (h2 ? 1 : 0);
    if ((lane & 3) == 0) affrow[eidx] = ex / den;
}
__device__ __forceinline__ void phase_lnr2(ArgsP a, const Fr& F, int layer, int nrows) {
    LAS float* wr = (LAS float*)F.lds;
    __syncthreads();
    for (int u = F.tid; u < 1024 * 16; u += NTHR) wr[u] = a->in[I_ROUTER][(size_t)layer * 1024 * 16 + (u & 1023) * 16 + (u >> 10)];
    __syncthreads();
    const bf16* U = (const bf16*)(a->ws + WS_U); f32x2* ST = (f32x2*)(a->ws + WS_XL); unsigned char* HB8 = (unsigned char*)(a->ws + WS_HB); float* AFF = (float*)(a->ws + WS_AFF);
    const float* mod = (const float*)(a->ws + WS_MOD) + (size_t)layer * 5 * 6144;
    const float* lg = a->in[I_LNG] + (size_t)(layer * 2 + 0) * D; const float* lb = a->in[I_LNB] + (size_t)(layer * 2 + 0) * D;
    const int gw = F.vcu * NWAVES + F.wave, NGW = F.G * NWAVES, npair = nrows >> 1;
    v2u vn[2][4];
    if (gw < npair) {
#pragma unroll
        for (int q = 0; q < 2; ++q)
#pragma unroll
            for (int j = 0; j < 4; ++j) vn[q][j] = *(const v2u*)(U + (size_t)(2 * gw + q) * D + 4 * F.lane + 256 * j); }
    for (int pi = gw; pi < npair; pi += NGW) {
        int lane = F.lane; asm volatile("" : "+v"(lane));
        const int row = 2 * pi; const int r = row < T ? (row >> 12) : 4;
        f32x4 v[2][4]; float s[2] = {0.f, 0.f};
#pragma unroll
        for (int q = 0; q < 2; ++q)
#pragma unroll
            for (int j = 0; j < 4; ++j) { v[q][j] = up4(vn[q][j]); s[q] += (v[q][j][0] + v[q][j][1]) + (v[q][j][2] + v[q][j][3]); }
        if (pi + NGW < npair) {
#pragma unroll
            for (int q = 0; q < 2; ++q)
#pragma unroll
                for (int j = 0; j < 4; ++j) vn[q][j] = *(const v2u*)(U + (size_t)(2 * (pi + NGW) + q) * D + 4 * lane + 256 * j); }
        float rstd[2];
#pragma unroll
        for (int q = 0; q < 2; ++q) { const float mean = wave_sum(s[q]) * (1.0f / D); float s2 = 0.f;
#pragma unroll
            for (int j = 0; j < 4; ++j) { v[q][j] = v[q][j] - mean; s2 += (v[q][j][0] * v[q][j][0] + v[q][j][1] * v[q][j][1]) + (v[q][j][2] * v[q][j][2] + v[q][j][3] * v[q][j][3]); }
            rstd[q] = 1.0f / sqrtf(wave_sum(s2) * (1.0f / D) + LN_EPS);
            if (lane == 0) ST[row + q] = (f32x2){mean, rstd[q]}; }
        float pa[16], pb[16];
#pragma unroll
        for (int e = 0; e < 16; ++e) { pa[e] = 0.f; pb[e] = 0.f; }
#pragma unroll 1
        for (int j = 0; j < 4; ++j) { const int c = 4 * lane + 256 * j;
            const f32x4 g4 = *(const f32x4*)(lg + c), b4 = *(const f32x4*)(lb + c), sc = *(const f32x4*)(mod + r * 6144 + 4096 + c) + 1.0f, sh = *(const f32x4*)(mod + r * 6144 + 3072 + c);
            f32x4 vA, vB;
            switch (j) { case 0: vA = v[0][0]; vB = v[1][0]; break; case 1: vA = v[0][1]; vB = v[1][1]; break; case 2: vA = v[0][2]; vB = v[1][2]; break; default: vA = v[0][3]; vB = v[1][3]; break; }
            const f32x4 hA = (vA * rstd[0] * g4 + b4) * sc + sh, hB = (vB * rstd[1] * g4 + b4) * sc + sh;
            { unsigned o8 = 0u; o8 = __builtin_amdgcn_cvt_pk_fp8_f32(__builtin_amdgcn_fmed3f(hA[0], -448.0f, 448.0f), __builtin_amdgcn_fmed3f(hA[1], -448.0f, 448.0f), o8, false);
              o8 = __builtin_amdgcn_cvt_pk_fp8_f32(__builtin_amdgcn_fmed3f(hA[2], -448.0f, 448.0f), __builtin_amdgcn_fmed3f(hA[3], -448.0f, 448.0f), o8, true); *(unsigned*)(HB8 + (size_t)row * D + c) = o8; }
            { unsigned o8 = 0u; o8 = __builtin_amdgcn_cvt_pk_fp8_f32(__builtin_amdgcn_fmed3f(hB[0], -448.0f, 448.0f), __builtin_amdgcn_fmed3f(hB[1], -448.0f, 448.0f), o8, false);
              o8 = __builtin_amdgcn_cvt_pk_fp8_f32(__builtin_amdgcn_fmed3f(hB[2], -448.0f, 448.0f), __builtin_amdgcn_fmed3f(hB[3], -448.0f, 448.0f), o8, true); *(unsigned*)(HB8 + (size_t)(row + 1) * D + c) = o8; }
#pragma unroll
            for (int e = 0; e < 16; ++e) { const f32x4 w = *(const LAS f32x4*)(wr + e * 1024 + c);
                pa[e] += (hA[0] * w[0] + hA[1] * w[1]) + (hA[2] * w[2] + hA[3] * w[3]);
                pb[e] += (hB[0] * w[0] + hB[1] * w[1]) + (hB[2] * w[2] + hB[3] * w[3]); }
            asm volatile("" ::: "memory"); }
        lnr_softmax_store(pa, lane, AFF + (size_t)row * 16);
        lnr_softmax_store(pb, lane, AFF + (size_t)(row + 1) * 16);
    }
}
__device__ __forceinline__ void phase_lnr(ArgsP a, const Fr& F, int layer, int nrows) {
    LAS float* wr = (LAS float*)F.lds;
    __syncthreads();
    for (int u = F.tid; u < 1024 * 16; u += NTHR) wr[u] = a->in[I_ROUTER][(size_t)layer * 1024 * 16 + (u & 1023) * 16 + (u >> 10)];
    __syncthreads();
    const bf16* U = (const bf16*)(a->ws + WS_U); f32x2* ST = (f32x2*)(a->ws + WS_XL); unsigned char* HB8 = (unsigned char*)(a->ws + WS_HB); float* AFF = (float*)(a->ws + WS_AFF);
    const float* mod = (const float*)(a->ws + WS_MOD) + (size_t)layer * 5 * 6144;
    const float* lg = a->in[I_LNG] + (size_t)(layer * 2 + 0) * D; const float* lb = a->in[I_LNB] + (size_t)(layer * 2 + 0) * D;
    const int gw = F.vcu * NWAVES + F.wave, NGW = F.G * NWAVES;
    f32x4 wreg[MK_LNR_WREG > 0 ? MK_LNR_WREG : 1][4];
#pragma unroll
    for (int e = 0; e < MK_LNR_WREG; ++e)
#pragma unroll
        for (int j = 0; j < 4; ++j) wreg[e][j] = *(const LAS f32x4*)(wr + e * 1024 + 4 * F.lane + 256 * j);
    v2u vn[4];
    if (gw < nrows) {
#pragma unroll
        for (int j = 0; j < 4; ++j) vn[j] = *(const v2u*)(U + (size_t)gw * D + 4 * F.lane + 256 * j); }
    for (int row = gw; row < nrows; row += NGW) {
        const int r = row < T ? (row >> 12) : 4;
        f32x4 v[4]; float s = 0.f;
#pragma unroll
        for (int j = 0; j < 4; ++j) { v[j] = up4(vn[j]); s += (v[j][0] + v[j][1]) + (v[j][2] + v[j][3]); }
        if (row + NGW < nrows) {
#pragma unroll
            for (int j = 0; j < 4; ++j) vn[j] = *(const v2u*)(U + (size_t)(row + NGW) * D + 4 * F.lane + 256 * j); }
        const float mean = wave_sum(s) * (1.0f / D); float s2 = 0.f;
#pragma unroll
        for (int j = 0; j < 4; ++j) { v[j] = v[j] - mean; s2 += (v[j][0] * v[j][0] + v[j][1] * v[j][1]) + (v[j][2] * v[j][2] + v[j][3] * v[j][3]); }
        const float rstd = 1.0f / sqrtf(wave_sum(s2) * (1.0f / D) + LN_EPS);
        if (F.lane == 0) ST[row] = (f32x2){mean, rstd};
        float part[16];
#pragma unroll
        for (int e = 0; e < 16; ++e) part[e] = 0.f;
#pragma unroll
        for (int j = 0; j < 4; ++j) { const int c = 4 * F.lane + 256 * j;
            const f32x4 x = v[j] * rstd * *(const f32x4*)(lg + c) + *(const f32x4*)(lb + c);
            const f32x4 h = x * (*(const f32x4*)(mod + r * 6144 + 4096 + c) + 1.0f) + *(const f32x4*)(mod + r * 6144 + 3072 + c);
            { unsigned o8 = 0u; const f32x4 hc = {__builtin_amdgcn_fmed3f(h[0], -448.0f, 448.0f), __builtin_amdgcn_fmed3f(h[1], -448.0f, 448.0f), __builtin_amdgcn_fmed3f(h[2], -448.0f, 448.0f), __builtin_amdgcn_fmed3f(h[3], -448.0f, 448.0f)};
              o8 = __builtin_amdgcn_cvt_pk_fp8_f32(hc[0], hc[1], o8, false); o8 = __builtin_amdgcn_cvt_pk_fp8_f32(hc[2], hc[3], o8, true); *(unsigned*)(HB8 + (size_t)row * D + c) = o8; }
#pragma unroll
            for (int e = 0; e < 16; ++e) { const f32x4 w = e < MK_LNR_WREG ? wreg[e < MK_LNR_WREG ? e : 0][j] : *(const LAS f32x4*)(wr + e * 1024 + c);
                part[e] += (h[0] * w[0] + h[1] * w[1]) + (h[2] * w[2] + h[3] * w[3]); }
            asm volatile("" ::: "memory"); }
        const bool h5 = (F.lane & 32) != 0, h4 = (F.lane & 16) != 0, h3 = (F.lane & 8) != 0, h2 = (F.lane & 4) != 0;
        float q8[8], q4[4], q2[2];
#pragma unroll
        for (int k = 0; k < 8; ++k) { const float keep = h5 ? part[8 + k] : part[k], send = h5 ? part[k] : part[8 + k]; q8[k] = keep + __shfl_xor(send, 32); }
#pragma unroll
        for (int k = 0; k < 4; ++k) { const float keep = h4 ? q8[4 + k] : q8[k], send = h4 ? q8[k] : q8[4 + k]; q4[k] = keep + __shfl_xor(send, 16); }
#pragma unroll
        for (int k = 0; k < 2; ++k) { const float keep = h3 ? q4[2 + k] : q4[k], send = h3 ? q4[k] : q4[2 + k]; q2[k] = keep + __shfl_xor(send, 8); }
        float lg; { const float keep = h2 ? q2[1] : q2[0], send = h2 ? q2[0] : q2[1]; lg = keep + __shfl_xor(send, 4); }
        lg += __shfl_xor(lg, 1); lg += __shfl_xor(lg, 2);
        float mx = lg;
#pragma unroll
        for (int o = 4; o < 64; o <<= 1) mx = fmaxf(mx, __shfl_xor(mx, o));
        const float ex = expf(lg - mx); float den = ex;
#pragma unroll
        for (int o = 4; o < 64; o <<= 1) den += __shfl_xor(den, o);
        const int eidx = (h5 ? 8 : 0) + (h4 ? 4 : 0) + (h3 ? 2 : 0) + (h2 ? 1 : 0);
        if ((F.lane & 3) == 0) AFF[(size_t)row * 16 + eidx] = ex / den;
    }
}

template <int N, int CAPN>
__device__ __forceinline__ void topk_item(ArgsP a, const Fr& F, int b, int e, int rowbase, int slotbase, bool pad) {
    LAS unsigned* hist = (LAS unsigned*)F.lds;
    LAS unsigned* sel = hist + 256;
    LAS unsigned* wtot = hist + 264;
    const float* AFF = (const float*)(a->ws + WS_AFF); int* ROWS = (int*)(a->ws + WS_ROWS); float* GATE = (float*)(a->ws + WS_GATE); int* INV = (int*)(a->ws + WS_INV);
    const int tid = F.tid, lane = F.lane; const bool act = tid * 8 < N;
    unsigned key[8];
#pragma unroll
    for (int j = 0; j < 8; ++j) key[j] = act ? __float_as_uint(AFF[(size_t)(rowbase + tid * 8 + j) * 16 + e]) : 0u;
    unsigned prefix = 0u, need = CAPN;
#pragma unroll 1
    for (int pass = 0; pass < 4; ++pass) {
        const int shift = 24 - 8 * pass; const unsigned himask = pass == 0 ? 0u : (0xFFFFFFFFu << (shift + 8));
        __syncthreads();
        if (tid < 256) hist[tid] = 0u;
        __syncthreads();
        if (act) {
#pragma unroll
            for (int j = 0; j < 8; ++j) if ((key[j] & himask) == prefix) __hip_atomic_fetch_add(&hist[(key[j] >> shift) & 255u], 1u, __ATOMIC_RELAXED, __HIP_MEMORY_SCOPE_WORKGROUP);
        }
        __syncthreads();
        if (tid < 64) {
            const unsigned v0 = hist[4 * lane], v1 = hist[4 * lane + 1], v2 = hist[4 * lane + 2], v3 = hist[4 * lane + 3]; const unsigned tot = v0 + v1 + v2 + v3;
            unsigned x = tot;
#pragma unroll
            for (int o = 1; o < 64; o <<= 1) { const unsigned t = __shfl_down(x, o); if (lane + o < 64) x += t; }
            const unsigned a3 = x - tot, a2 = a3 + v3, a1 = a2 + v2, a0 = a1 + v1;
            if (a3 < need && need <= a3 + v3) { sel[0] = 4 * lane + 3; sel[1] = a3; }
            if (a2 < need && need <= a2 + v2) { sel[0] = 4 * lane + 2; sel[1] = a2; }
            if (a1 < need && need <= a1 + v1) { sel[0] = 4 * lane + 1; sel[1] = a1; }
            if (a0 < need && need <= a0 + v0) { sel[0] = 4 * lane + 0; sel[1] = a0; }
        }
        __syncthreads();
        prefix |= sel[0] << shift; need -= sel[1];
    }
    const unsigned tau = prefix;
    unsigned ceq = 0u;
#pragma unroll
    for (int j = 0; j < 8; ++j) ceq += (act && key[j] == tau) ? 1u : 0u;
    unsigned xe = ceq;
#pragma unroll
    for (int o = 1; o < 64; o <<= 1) { const unsigned t = __shfl_up(xe, o); if (lane >= o) xe += t; }
    __syncthreads();
    if (lane == 63) wtot[F.wave * 2] = xe;
    __syncthreads();
    unsigned eqbase = xe - ceq; for (int w = 0; w < F.wave; ++w) eqbase += wtot[w * 2];
    unsigned flags = 0u, csel = 0u;
#pragma unroll
    for (int j = 0; j < 8; ++j) { bool s = false; if (act) { if (key[j] > tau) s = true; else if (key[j] == tau) { s = eqbase < need; ++eqbase; } } if (s) { flags |= 1u << j; ++csel; } }
    unsigned xs = csel;
#pragma unroll
    for (int o = 1; o < 64; o <<= 1) { const unsigned t = __shfl_up(xs, o); if (lane >= o) xs += t; }
    if (lane == 63) wtot[F.wave * 2 + 1] = xs;
    __syncthreads();
    unsigned pos = xs - csel; for (int w = 0; w < F.wave; ++w) pos += wtot[w * 2 + 1];
    if (act) {
#pragma unroll
        for (int j = 0; j < 8; ++j) { const int row = rowbase + tid * 8 + j; int slot = -1;
            if (flags & (1u << j)) { slot = e * ESTR + slotbase + (int)pos; ++pos; ROWS[slot] = row; GATE[slot] = __uint_as_float(key[j]); }
            INV[(size_t)row * 16 + e] = slot; }
    }
    if (pad) for (int p = tid; p < 128; p += NTHR) { ROWS[e * ESTR + 2176 + p] = 0; GATE[e * ESTR + 2176 + p] = 0.f; }
}
__device__ __forceinline__ void phase_topk(ArgsP a, const Fr& F, int layer) {
    const int nitems = layer == 0 ? 128 : 64;
    for (int it = F.vcu; it < nitems; it += F.G) {
        if (it < 64) { const int b = it >> 4, e = it & 15; topk_item<SEQ, 512>(a, F, b, e, b * SEQ, b * 512, false); }
        else { const int b = (it - 64) >> 4, e = it & 15; topk_item<LC, 32>(a, F, b, e, T + b * LC, 2048 + b * 32, b == 0); }
    }
}
__device__ __forceinline__ void phase_gather(ArgsP a, const Fr& F, int layer) {
    const int me = layer == 0 ? 2304 : 2048;
    const int* ROWS = (const int*)(a->ws + WS_ROWS); const bf16* HB = (const bf16*)(a->ws + WS_HB); bf16* XG = (bf16*)(a->ws + WS_XG);
    const int gw = F.vcu * NWAVES + F.wave, NGW = F.G * NWAVES;
    for (int it = gw; it < 16 * me; it += NGW) { const int e = it / me, s = it % me, dr = e * ESTR + s; const int sr = ROWS[dr];
        const v4u* src = (const v4u*)(HB + (size_t)sr * D); v4u* dst = (v4u*)(XG + (size_t)dr * D);
        dst[F.lane] = src[F.lane]; dst[64 + F.lane] = src[64 + F.lane]; }
}
#if MK_FP8_Y
typedef unsigned comb_y_t;
#define COMB_YLOAD(p, off) (*(const unsigned*)((const unsigned char*)(p) + (off)))
#define COMB_YS (1.0f / Y_SCALE)
#define COMB_YROW(s) ((const bf16*)((const unsigned char*)Y + (size_t)(s) * D))
__device__ __forceinline__ f32x4 comb_y_up(unsigned w) { const auto lo = __builtin_amdgcn_cvt_pk_f32_fp8(w, false), hi = __builtin_amdgcn_cvt_pk_f32_fp8(w, true); return (f32x4){lo[0], lo[1], hi[0], hi[1]}; }
#else
typedef v2u comb_y_t;
#define COMB_YLOAD(p, off) (*(const v2u*)((p) + (off)))
#define COMB_YS 1.0f
#define COMB_YROW(s) (Y + (size_t)(s) * D)
__device__ __forceinline__ f32x4 comb_y_up(v2u w) { return up4(w); }
#endif
__device__ __forceinline__ void phase_comb(ArgsP a, const Fr& F, int layer, int nrows) {
    const bf16* Y = (const bf16*)(a->ws + WS_Y); const bf16* XL = (const bf16*)(a->ws + WS_U); const f32x2* ST = (const f32x2*)(a->ws + WS_XL); bf16* XC = (bf16*)(a->ws + WS_XC); bf16* HB = (bf16*)(a->ws + WS_HB); const int* INV = (const int*)(a->ws + WS_INV);
    const float* lg1 = a->in[I_LNG] + (size_t)(layer * 2 + 0) * D; const float* lb1 = a->in[I_LNB] + (size_t)(layer * 2 + 0) * D;
    const float* mod = (const float*)(a->ws + WS_MOD) + (size_t)layer * 5 * 6144;
    const float* modn = (const float*)(a->ws + WS_MOD) + (size_t)(layer < 3 ? layer + 1 : 3) * 5 * 6144;
    const float* lg = a->in[I_LNG] + (size_t)(layer * 2 + 1) * D; const float* lb = a->in[I_LNB] + (size_t)(layer * 2 + 1) * D;
    const int gw = F.vcu * NWAVES + F.wave, NGW = F.G * NWAVES;
#define COMB_ISSUE(inv_, row_, sl_, rest_, yv_, xl_, st_) do { unsigned mk_ = (unsigned)(__ballot((inv_) >= 0) & 0xFFFFull); \
        _Pragma("unroll") for (int q = 0; q < 4; ++q) { if (mk_) { const int e_ = __builtin_ctz(mk_); mk_ &= mk_ - 1; sl_[q] = __shfl((inv_), e_); } else sl_[q] = -1; } \
        rest_ = mk_; \
        _Pragma("unroll") for (int q = 0; q < 4; ++q) if (sl_[q] >= 0) { const bf16* yp_ = COMB_YROW(sl_[q]); _Pragma("unroll") for (int j = 0; j < 4; ++j) yv_[q][j] = COMB_YLOAD(yp_, 4 * F.lane + 256 * j); } \
        _Pragma("unroll") for (int j = 0; j < 4; ++j) xl_[j] = *(const v2u*)(XL + (size_t)(row_) * D + 4 * F.lane + 256 * j); st_ = ST[(row_)]; } while (0)
    int inv_c = gw < nrows ? INV[(size_t)gw * 16 + (F.lane & 15)] : -1;
    int inv_n = gw + NGW < nrows ? INV[(size_t)(gw + NGW) * 16 + (F.lane & 15)] : -1;
    int sl_c[4] = {-1, -1, -1, -1}; unsigned rest_c = 0u; comb_y_t yv_c[4][4]; v2u xl_c[4]; f32x2 st_c = {0.f, 1.f};
    if (gw < nrows) COMB_ISSUE(inv_c, gw, sl_c, rest_c, yv_c, xl_c, st_c);
    for (int row = gw; row < nrows; row += NGW) {
        const int r = row < T ? (row >> 12) : 4;
        const int hrow = (layer == 2 && row < T) ? (row & ~4095) + ((row & 511) << 3) + ((row & 4095) >> 9) : row;
        const int myinv = inv_c;
        int sl_n[4] = {-1, -1, -1, -1}; unsigned rest_n = 0u; comb_y_t yv_n[4][4]; v2u xl_n[4]; f32x2 st_n = {0.f, 1.f};
        const bool has_n = row + NGW < nrows;
        if (has_n) COMB_ISSUE(inv_n, row + NGW, sl_n, rest_n, yv_n, xl_n, st_n);
        const int inv_nn = (row + 2 * NGW < nrows) ? INV[(size_t)(row + 2 * NGW) * 16 + (F.lane & 15)] : -1;
        f32x4 m[4];
#pragma unroll
        for (int j = 0; j < 4; ++j) m[j] = (f32x4){0.f, 0.f, 0.f, 0.f};
#pragma unroll
        for (int q = 0; q < 4; ++q) if (sl_c[q] >= 0) {
#pragma unroll
            for (int j = 0; j < 4; ++j) m[j] += comb_y_up(yv_c[q][j]); }
        unsigned msk = rest_c;
        while (msk) { const int e = __builtin_ctz(msk); msk &= msk - 1; const int slot = __shfl(myinv, e); const bf16* yp = COMB_YROW(slot);
#pragma unroll
            for (int j = 0; j < 4; ++j) m[j] += comb_y_up(COMB_YLOAD(yp, 4 * F.lane + 256 * j)); }
        f32x4 xc[4];
#pragma unroll
        for (int j = 0; j < 4; ++j) { const int c = 4 * F.lane + 256 * j; xc[j] = (up4(xl_c[j]) - st_c.x) * st_c.y * *(const f32x4*)(lg1 + c) + *(const f32x4*)(lb1 + c); }
        inv_c = inv_n; inv_n = inv_nn; rest_c = rest_n; st_c = st_n;
#pragma unroll
        for (int q = 0; q < 4; ++q) { sl_c[q] = sl_n[q];
#pragma unroll
            for (int j = 0; j < 4; ++j) yv_c[q][j] = yv_n[q][j]; }
#pragma unroll
        for (int j = 0; j < 4; ++j) xl_c[j] = xl_n[j];
        f32x4 v[4]; float s = 0.f;
#pragma unroll
        for (int j = 0; j < 4; ++j) { const int c = 4 * F.lane + 256 * j;
            v[j] = xc[j] * ALPHA + *(const f32x4*)(mod + r * 6144 + 5120 + c) * (m[j] * COMB_YS); s += (v[j][0] + v[j][1]) + (v[j][2] + v[j][3]); }
        const float mean = wave_sum(s) * (1.0f / D); float s2 = 0.f;
#pragma unroll
        for (int j = 0; j < 4; ++j) { v[j] = v[j] - mean; s2 += (v[j][0] * v[j][0] + v[j][1] * v[j][1]) + (v[j][2] * v[j][2] + v[j][3] * v[j][3]); }
        const float rstd = 1.0f / sqrtf(wave_sum(s2) * (1.0f / D) + LN_EPS);
#pragma unroll
        for (int j = 0; j < 4; ++j) { const int c = 4 * F.lane + 256 * j;
            const f32x4 x = v[j] * rstd * *(const f32x4*)(lg + c) + *(const f32x4*)(lb + c);
            if (layer == 3) { *(f32x4*)(a->out + (size_t)row * D + c) = x; }
            else { { v2u xo; xo.x = pk2(x[0], x[1]); xo.y = pk2(x[2], x[3]); *(v2u*)(XC + (size_t)row * D + c) = xo; }
                const f32x4 h = x * (*(const f32x4*)(modn + r * 6144 + 1024 + c) + 1.0f) + *(const f32x4*)(modn + r * 6144 + c);
                if ((MK_FP8_HYIN && layer == 2) || (MK_FP8_CMIN && layer == 1) || (MK_FP8_QKV && layer == 0)) *(unsigned*)((unsigned char*)HB + (size_t)hrow * D + c) = pk4_e4m3(h);
                else { v2u o; o.x = pk2(h[0], h[1]); o.y = pk2(h[2], h[3]); *(v2u*)(HB + (size_t)hrow * D + c) = o;
                    if (MK_FP8_CMV && !MK_FP8_CMIN && layer == 1) *(unsigned*)((unsigned char*)(a->ws + WS_HB8B) + (size_t)row * D + c) = pk4_e4m3(h); } } }
    }
#undef COMB_ISSUE
}
#ifndef FFT_HD
#define FFT_HD __device__ __forceinline__
#endif
typedef float cf2 __attribute__((ext_vector_type(2)));
FFT_HD cf2 cmul(cf2 a, cf2 b) { return (cf2){a.x * b.x - a.y * b.y, a.x * b.y + a.y * b.x}; }
FFT_HD int fpad(int p) { return p + (p >> 5); }
constexpr int FFT_N = 8192, FFT_BUF = 8192 + 256;
template <bool INV> FFT_HD void dft4(cf2& a, cf2& b, cf2& c, cf2& d) {
    const cf2 s0 = a + c, s1 = a - c, s2 = b + d, s3 = b - d;
    const cf2 js3 = INV ? (cf2){-s3.y, s3.x} : (cf2){s3.y, -s3.x};
    a = s0 + s2; b = s1 + js3; c = s0 - s2; d = s1 - js3;
}
template <bool INV> FFT_HD void dft16(cf2 (&x)[16]) {
#pragma unroll
    for (int n0 = 0; n0 < 4; ++n0) dft4<INV>(x[n0], x[n0 + 4], x[n0 + 8], x[n0 + 12]);
    constexpr float C1 = 0.92387953251128674f, S1 = 0.38268343236508977f, R2 = 0.70710678118654752f;
    const float sg = INV ? 1.f : -1.f;
    const cf2 w1 = {C1, sg * S1}, w2 = {R2, sg * R2}, w3 = {S1, sg * C1}, w4 = {0.f, sg * 1.f}, w6 = {-R2, sg * R2}, w9 = {-C1, -sg * S1};
    x[1 + 4 * 1] = cmul(x[1 + 4 * 1], w1); x[1 + 4 * 2] = cmul(x[1 + 4 * 2], w2); x[1 + 4 * 3] = cmul(x[1 + 4 * 3], w3);
    x[2 + 4 * 1] = cmul(x[2 + 4 * 1], w2); x[2 + 4 * 2] = cmul(x[2 + 4 * 2], w4); x[2 + 4 * 3] = cmul(x[2 + 4 * 3], w6);
    x[3 + 4 * 1] = cmul(x[3 + 4 * 1], w3); x[3 + 4 * 2] = cmul(x[3 + 4 * 2], w6); x[3 + 4 * 3] = cmul(x[3 + 4 * 3], w9);
#pragma unroll
    for (int k0 = 0; k0 < 4; ++k0) dft4<INV>(x[0 + 4 * k0], x[1 + 4 * k0], x[2 + 4 * k0], x[3 + 4 * k0]);
#pragma unroll
    for (int i = 0; i < 4; ++i)
#pragma unroll
        for (int j = i + 1; j < 4; ++j) { const cf2 t = x[i + 4 * j]; x[i + 4 * j] = x[j + 4 * i]; x[j + 4 * i] = t; }
}
FFT_HD cf2 cmulc(cf2 a, cf2 b) { return (cf2){a.x * b.x + a.y * b.y, a.y * b.x - a.x * b.y}; }
template <bool INV, class BP> FFT_HD void stage_r16(BP buf, const cf2 (&tw)[15], int base, int stride) {
    cf2 x[16];
    const int pb = fpad(base), ps = stride + (stride >> 5);
#pragma unroll
    for (int i = 0; i < 16; ++i) x[i] = buf[pb + i * ps];
    if (!INV) { dft16<false>(x);
#pragma unroll
        for (int k = 1; k < 16; ++k) x[k] = cmulc(x[k], tw[k - 1]); }
    else {
#pragma unroll
        for (int k = 1; k < 16; ++k) x[k] = cmul(x[k], tw[k - 1]);
        dft16<true>(x); }
#pragma unroll
    for (int i = 0; i < 16; ++i) buf[pb + i * ps] = x[i];
}
template <class TP> FFT_HD void load_tw(TP TW, int tidx, cf2 (&tw)[15]) {
#pragma unroll
    for (int k = 1; k < 16; ++k) tw[k - 1] = TW[(tidx * k) & (FFT_N - 1)];
}
template <bool INV, class BP> FFT_HD void stage_r16_chain(BP buf, cf2 w, int base, int stride) {
    cf2 tw[15]; tw[0] = w;
#pragma unroll
    for (int k = 1; k < 15; ++k) tw[k] = cmul(tw[k - 1], w);
    stage_r16<INV>(buf, tw, base, stride);
}
template <class BP> FFT_HD void stage1_fwd_regs(BP buf, cf2 (&x)[16], cf2 w, int m) {
    dft16<false>(x);
    cf2 wk = w; const int pb = fpad(m);
    buf[pb] = x[0];
#pragma unroll
    for (int k = 1; k < 16; ++k) { buf[pb + 528 * k] = cmulc(x[k], wk); if (k < 15) wk = cmul(wk, w); }
}
template <class BP> FFT_HD void stage1_inv_regs(BP buf, cf2 (&x)[16], cf2 w, int m) {
    cf2 wk = w; const int pb = fpad(m);
    x[0] = buf[pb];
#pragma unroll
    for (int k = 1; k < 16; ++k) { x[k] = cmul(buf[pb + 528 * k], wk); if (k < 15) wk = cmul(wk, w); }
    dft16<true>(x);
}
template <bool INV, class BP> FFT_HD void stage_r32_load(BP buf, int blk, int r, cf2 (&u)[16]) {
    constexpr float CS[16] = {1.f, 0.98078528040323043f, 0.92387953251128674f, 0.83146961230254524f, 0.70710678118654752f, 0.55557023301960218f, 0.38268343236508977f, 0.19509032201612825f,
                              0.f, -0.19509032201612825f, -0.38268343236508977f, -0.55557023301960218f, -0.70710678118654752f, -0.83146961230254524f, -0.92387953251128674f, -0.98078528040323043f};
    constexpr float SN[16] = {0.f, 0.19509032201612825f, 0.38268343236508977f, 0.55557023301960218f, 0.70710678118654752f, 0.83146961230254524f, 0.92387953251128674f, 0.98078528040323043f,
                              1.f, 0.98078528040323043f, 0.92387953251128674f, 0.83146961230254524f, 0.70710678118654752f, 0.55557023301960218f, 0.38268343236508977f, 0.19509032201612825f};
    const int base = blk * 33;
#pragma unroll
    for (int n = 0; n < 16; ++n) { const cf2 lo = buf[base + n], hi = buf[base + n + 16];
        const cf2 s = lo + hi, d = lo - hi; const cf2 w = {CS[n], INV ? SN[n] : -SN[n]}; const cf2 dw = cmul(d, w);
        u[n] = r ? dw : s; }
    dft16<INV>(u);
}
template <class BP> FFT_HD void stage_r32_store(BP buf, int blk, int r, const cf2 (&u)[16]) {
    const int base = blk * 33;
#pragma unroll
    for (int g = 0; g < 16; ++g) buf[base + 2 * g + r] = u[g];
}
template <class BP> FFT_HD void stage_r32_store_mul(BP buf, BP W, int blk, int r, const cf2 (&u)[16], int o, float scale) {
    const int base = blk * 33; const int f1 = blk >> 4, f2 = blk & 15;
#pragma unroll
    for (int g = 0; g < 16; ++g) { const int f3 = 2 * g + r; const int f = f1 + 16 * f2 + 256 * f3; const int fm = (FFT_N - f) & (FFT_N - 1);
        const int pm = (fm & 15) * 512 + ((fm >> 4) & 15) * 32 + (fm >> 8);
        const cf2 a = W[base + f3], b = W[fpad(pm)];
        const cf2 k = o == 0 ? (cf2){0.5f * (a.x + b.x), 0.5f * (a.y - b.y)} : (cf2){0.5f * (a.y + b.y), 0.5f * (b.x - a.x)};
        buf[base + f3] = cmul(u[g], k) * scale; }
}
template <class BP> FFT_HD void fft_mul(BP Z, BP W, int tid, int o, float scale) {
    const int f2 = tid >> 5, f3 = tid & 31; const int pp = fpad(tid);
#pragma unroll 4
    for (int j = 0; j < 16; ++j) { const int f = j + 16 * f2 + 256 * f3; const int fm = (FFT_N - f) & (FFT_N - 1);
        const int pm = (fm & 15) * 512 + ((fm >> 4) & 15) * 32 + (fm >> 8);
        const cf2 a = W[pp + 528 * j], b = W[fpad(pm)];
        const cf2 k = o == 0 ? (cf2){0.5f * (a.x + b.x), 0.5f * (a.y - b.y)} : (cf2){0.5f * (a.y + b.y), 0.5f * (b.x - a.x)};
        const cf2 z = Z[pp + 528 * j]; Z[pp + 528 * j] = cmul(z, k) * scale; }
}
#ifndef FFT_HOST_ONLY
__device__ __forceinline__ void ld_tw2(const LAS cf2* tw2l, int tid, cf2 (&tw)[15]) {
#pragma unroll
    for (int k = 0; k < 15; ++k) tw[k] = tw2l[(tid & 31) * 15 + k];
}
__device__ __forceinline__ void fft_fwd(LAS cf2* buf, cf2 w1, const LAS cf2* tw2l, int tid) {
    asm volatile("" : "+v"(tid));
    stage_r16_chain<false>(buf, w1, tid, 512); __syncthreads();
    { cf2 tw[15]; ld_tw2(tw2l, tid, tw); stage_r16<false>(buf, tw, (tid >> 5) * 512 + (tid & 31), 32); } __syncthreads();
    { cf2 u[16]; stage_r32_load<false>(buf, tid >> 1, tid & 1, u); stage_r32_store(buf, tid >> 1, tid & 1, u); } __syncthreads();
}
__device__ __forceinline__ void fft_inv(LAS cf2* buf, cf2 w1, const LAS cf2* tw2l, int tid) {
    asm volatile("" : "+v"(tid));
    { cf2 u[16]; stage_r32_load<true>(buf, tid >> 1, tid & 1, u); stage_r32_store(buf, tid >> 1, tid & 1, u); } __syncthreads();
    { cf2 tw[15]; ld_tw2(tw2l, tid, tw); stage_r16<true>(buf, tw, (tid >> 5) * 512 + (tid & 31), 32); } __syncthreads();
    stage_r16_chain<true>(buf, w1, tid, 512); __syncthreads();
}
struct P8 { v4u own, prv, nxt; };
__device__ __forceinline__ P8 p8_load(const bf16* p, int m) { P8 r; r.own = *(const v4u*)(p + 8 * m); r.prv = *(const v4u*)(p + 8 * (m == 0 ? 511 : m - 1)); r.nxt = *(const v4u*)(p + 8 * (m == 511 ? 0 : m + 1)); return r; }
__device__ __forceinline__ void unpk8(const v4u& v, float (&o)[8]) { const unsigned w[4] = {v.x, v.y, v.z, v.w};
#pragma unroll
    for (int j = 0; j < 4; ++j) { o[2 * j] = __builtin_bit_cast(float, w[j] << 16); o[2 * j + 1] = __builtin_bit_cast(float, w[j] & 0xffff0000u); } }
__device__ __forceinline__ void p8_conv(const P8& r, int m, float w0, float w1, float w2, float cb, float (&o)[8]) {
    float a[8], b[8], c[8]; unpk8(r.own, a); unpk8(r.prv, b); unpk8(r.nxt, c);
#pragma unroll
    for (int j = 0; j < 8; ++j) { const float pv = m == 0 ? (j ? b[j - 1] : 0.f) : b[j]; const float nx = m == 511 ? (j < 7 ? c[j + 1] : 0.f) : c[j];
        o[j] = w0 * pv + w1 * a[j] + w2 * nx + cb; }
}
__device__ __forceinline__ void fft_mid_a(LAS cf2* Zb, LAS cf2* Wb, const LAS cf2* tw2l, int tid, int o, float sc) {
    asm volatile("" : "+v"(tid));
    __syncthreads();
    { cf2 tw[15]; ld_tw2(tw2l, tid, tw); stage_r16<false>(Zb, tw, (tid >> 5) * 512 + (tid & 31), 32); } __syncthreads();
    { cf2 u[16]; stage_r32_load<false>(Zb, tid >> 1, tid & 1, u); stage_r32_store_mul(Zb, Wb, tid >> 1, tid & 1, u, o, sc); } __syncthreads();
    { cf2 u[16]; stage_r32_load<true>(Zb, tid >> 1, tid & 1, u); stage_r32_store(Zb, tid >> 1, tid & 1, u); } __syncthreads();
}
__device__ __forceinline__ void fft_mid_b(LAS cf2* Zb, const LAS cf2* tw2l, int tid) {
    asm volatile("" : "+v"(tid));
    { cf2 tw[15]; ld_tw2(tw2l, tid, tw); stage_r16<true>(Zb, tw, (tid >> 5) * 512 + (tid & 31), 32); } __syncthreads();
}
__device__ __forceinline__ void hy_fft_item(ArgsP a, const Fr& F, int slot, int d, cf2 wtw) {
    LAS cf2* Zb = (LAS cf2*)F.lds;
    LAS cf2* Wb = Zb + FFT_BUF;
    LAS float* red = (LAS float*)(Wb + FFT_BUF);
    const LAS cf2* tw2l = (const LAS cf2*)(red + 16);
    const bf16* PT = (const bf16*)(a->ws + SC_PT); bf16* Z2T = (bf16*)(a->ws + SC_Z2T);
    const float* HF = (const float*)(a->ws + WS_HF + (size_t)slot * HF_SLOT);
    const int tid = F.tid;
    __syncthreads();
    { const float* f0 = HF + (size_t)(0 * 1024 + d) * SEQ; const float* b0 = HF + (size_t)(1 * 1024 + d) * SEQ;
      const float* f1 = HF + (size_t)(2 * 1024 + d) * SEQ; const float* b1 = HF + (size_t)(3 * 1024 + d) * SEQ;
      float s0 = 0.f, s1 = 0.f; float fa[8], fb[8], ba[8], bb[8];
#pragma unroll
      for (int j = 0; j < 8; ++j) { const int t = tid + 512 * j; fa[j] = f0[t]; fb[j] = f1[t]; ba[j] = b0[t]; bb[j] = b1[t]; }
#pragma unroll
      for (int j = 0; j < 8; ++j) { const int t = tid + 512 * j; Wb[fpad(t)] = (cf2){fa[j], fb[j]}; s0 += fabsf(fa[j]); s1 += fabsf(fb[j]);
          if (t >= 1) { Wb[fpad(FFT_N - t)] = (cf2){ba[j], bb[j]}; s0 += fabsf(ba[j]); s1 += fabsf(bb[j]); } }
      if (tid == 0) Wb[fpad(SEQ)] = (cf2){0.f, 0.f};
      s0 = wave_sum(s0); s1 = wave_sum(s1); if (F.lane == 0) { red[F.wave] = s0; red[8 + F.wave] = s1; } }
    __syncthreads();
    float nrm0, nrm1; { float s0 = 0.f, s1 = 0.f; for (int w = 0; w < 8; ++w) { s0 += red[w]; s1 += red[8 + w]; } nrm0 = 1.0f / (s0 + 1e-6f); nrm1 = 1.0f / (s1 + 1e-6f); }
    fft_fwd(Wb, wtw, tw2l, tid);
    const float* cw = a->in[I_HYCW] + (size_t)slot * 3 * 3072; const float* cbp = a->in[I_HYCB] + (size_t)slot * 3072;
    float w0[3], w1[3], w2[3], cb[3];
#pragma unroll
    for (int g = 0; g < 3; ++g) { const int c = g * 1024 + d; w0[g] = cw[c]; w1[g] = cw[3072 + c]; w2[g] = cw[2 * 3072 + c]; cb[g] = cbp[c]; }
    const float fb0 = a->in[I_FBIAS][(slot * 2 + 0) * 1024 + d], fb1 = a->in[I_FBIAS][(slot * 2 + 1) * 1024 + d];
    const float sc0 = nrm0 * (1.0f / FFT_N), sc1 = nrm1 * (1.0f / FFT_N);
#pragma unroll 1
    for (int pr = 0; pr < 2; ++pr) {
        int m = tid; asm volatile("" : "+v"(m));
        const bf16* pb = PT + (size_t)d * TA + (2 * pr) * SEQ;
        const P8 rv0 = p8_load(pb, m), rv1 = p8_load(pb + SEQ, m);
        float va[8], vb2[8];
        p8_conv(rv0, m, w0[0], w1[0], w2[0], cb[0], va); p8_conv(rv1, m, w0[0], w1[0], w2[0], cb[0], vb2);
        cf2 vin[8], x[16];
#pragma unroll
        for (int j = 0; j < 8; ++j) { vin[j] = (cf2){va[j], vb2[j]}; x[j] = vin[j]; x[j + 8] = (cf2){0.f, 0.f}; }
        stage1_fwd_regs(Zb, x, wtw, m);
        fft_mid_a(Zb, Wb, tw2l, tid, 0, sc0);
        const P8 rx0 = p8_load(pb + (size_t)1024 * TA, m), rx1 = p8_load(pb + (size_t)1024 * TA + SEQ, m);
        fft_mid_b(Zb, tw2l, tid);
        stage1_inv_regs(Zb, x, wtw, m);
        p8_conv(rx0, m, w0[1], w1[1], w2[1], cb[1], va); p8_conv(rx1, m, w0[1], w1[1], w2[1], cb[1], vb2);
#pragma unroll
        for (int j = 0; j < 8; ++j) { const cf2 xg = {va[j], vb2[j]}; vin[j] = xg * (x[j] + vin[j] * fb0); x[j] = vin[j]; x[j + 8] = (cf2){0.f, 0.f}; }
        stage1_fwd_regs(Zb, x, wtw, m);
        fft_mid_a(Zb, Wb, tw2l, tid, 1, sc1);
        const P8 rz0 = p8_load(pb + (size_t)2048 * TA, m), rz1 = p8_load(pb + (size_t)2048 * TA + SEQ, m);
        fft_mid_b(Zb, tw2l, tid);
        stage1_inv_regs(Zb, x, wtw, m);
        p8_conv(rz0, m, w0[2], w1[2], w2[2], cb[2], va); p8_conv(rz1, m, w0[2], w1[2], w2[2], cb[2], vb2);
        float z0[8], z1[8];
#pragma unroll
        for (int j = 0; j < 8; ++j) { const cf2 xg = {va[j], vb2[j]}; const cf2 z = xg * (x[j] + vin[j] * fb1); z0[j] = z.x; z1[j] = z.y; }
        bf16* o0 = Z2T + (size_t)d * TA + (2 * pr) * SEQ + 8 * m;
        v4u q0, q1; q0.x = pk2(z0[0], z0[1]); q0.y = pk2(z0[2], z0[3]); q0.z = pk2(z0[4], z0[5]); q0.w = pk2(z0[6], z0[7]);
        q1.x = pk2(z1[0], z1[1]); q1.y = pk2(z1[2], z1[3]); q1.z = pk2(z1[4], z1[5]); q1.w = pk2(z1[6], z1[7]);
        *(v4u*)o0 = q0; *(v4u*)(o0 + SEQ) = q1;
    }
}
__device__ __forceinline__ void phase_hy_conv_fft(ArgsP a, const Fr& F, int layer) {
    const int slot = layer == 0 ? 0 : 1; const int nitems = layer == 0 ? 2048 : 1024;
    {   const cf2* TW = (const cf2*)(a->ws + WS_TW);
        LAS cf2* tw2l = (LAS cf2*)((LAS float*)((LAS cf2*)F.lds + 2 * FFT_BUF) + 16);
        __syncthreads();
        if (F.tid < 32 * 15) { const int n3 = F.tid / 15, k = F.tid % 15 + 1; tw2l[F.tid] = TW[(16 * n3 * k) & (FFT_N - 1)]; }
        const cf2 w1 = TW[F.tid];
        __syncthreads();
        for (int it = F.vcu; it < 1024; it += F.G) hy_fft_item(a, F, slot, it, w1);
    }
    for (int it = 1024 + F.vcu; it < nitems; it += F.G) hy_ctx_item(a, F, slot, it - 1024);
}
#endif
#include <hip/hip_bf16.h>
namespace attn_body {
using bf16=__hip_bfloat16;
using bf16x8=__attribute__((ext_vector_type(8)))short;
using s16x4=__attribute__((ext_vector_type(4)))short;
using f32x16=__attribute__((ext_vector_type(16)))float;
using u32x4=__attribute__((ext_vector_type(4)))unsigned;
constexpr int BATCH=4,NHEAD=16,SEQ=4096,D=64,DM=NHEAD*D,KP=256,LKEYS=4352;
constexpr int NW=8,QBLK=32,QB=QBLK*NW,KVBLK=64,NQB=SEQ/QB;
constexpr int ATTN_PITCH=DM, ATTN_UNIT_ROWS=QB;
__device__ __forceinline__ int crow(int r,int hi){return (r&3)+8*(r>>2)+4*hi;}
#define SBAR() __builtin_amdgcn_sched_barrier(0)
__device__ __forceinline__ void cmask(f32x16&p0,f32x16&p1,int jb,int qrel,int hi){
  const float NEG=-INFINITY; int kb=64*jb+4*hi;
  #pragma unroll
  for(int r=0;r<16;++r){int kv=kb+(r&3)+8*(r>>2); if(kv>qrel)p0[r]=NEG; if(kv+32>qrel)p1[r]=NEG;}
}

constexpr int NSLOT=3, SLOTB=8192;
constexpr int LDS_K=0, LDS_V=NSLOT*SLOTB, LDS_WS=2*NSLOT*SLOTB, LDS_OST=LDS_WS+NW*64*4, LDS_BYTES=LDS_OST+NW*4096;
constexpr float C2=0.125f*1.4426950408889634f;
__device__ __forceinline__ void glds16(const void*gsrc,unsigned lds_dst){unsigned keep;
  asm volatile("s_mov_b32 %0, m0\n\ts_mov_b32 m0, %2\n\ts_nop 0\n\tglobal_load_lds_dwordx4 %1, off\n\ts_mov_b32 m0, %0":"=&s"(keep):"v"(gsrc),"s"(lds_dst):"memory");}
__device__ __forceinline__ float max3f(float a,float b,float c){float r;asm("v_max3_f32 %0, %1, %2, %3":"=v"(r):"v"(a),"v"(b),"v"(c));return r;}
__device__ __forceinline__ float max2f(float a,float b){float r;asm("v_max_f32_e32 %0, %1, %2":"=v"(r):"v"(a),"v"(b));return r;}
__device__ __forceinline__ float fadd_s(float a,float b){float r;asm("v_add_f32_e32 %0, %1, %2":"=v"(r):"v"(a),"v"(b));return r;}
__device__ __forceinline__ float fsub_s(float a,float b){float r;asm("v_sub_f32_e32 %0, %1, %2":"=v"(r):"v"(a),"v"(b));return r;}
typedef float f32x2_t __attribute__((ext_vector_type(2))); typedef __bf16 bf16x2_t __attribute__((ext_vector_type(2)));
__device__ __forceinline__ unsigned cvtpk_s(float lo,float hi){f32x2_t v={lo,hi};bf16x2_t b=__builtin_convertvector(v,bf16x2_t);return __builtin_bit_cast(unsigned,b);}
#define WAIT_BAR(N) asm volatile("s_waitcnt vmcnt(" #N ") lgkmcnt(0)\n\ts_barrier":::"memory")

__device__ __forceinline__ void qkt(f32x16&p0,f32x16&p1,const char*Kslot,const bf16x8*qr,const f32x16&negm,int r32,int hi){
  const char*kb=Kslot+hi*1024+r32*16;
  #pragma unroll
  for(int d0=0;d0<4;++d0){
    const bf16x8 b0=*reinterpret_cast<const bf16x8*>(kb+d0*2048);
    const bf16x8 b1=*reinterpret_cast<const bf16x8*>(kb+d0*2048+512);
    if(d0==0){p0=__builtin_amdgcn_mfma_f32_32x32x16_bf16(b0,qr[0],negm,0,0,0);p1=__builtin_amdgcn_mfma_f32_32x32x16_bf16(b1,qr[0],negm,0,0,0);}
    else{p0=__builtin_amdgcn_mfma_f32_32x32x16_bf16(b0,qr[d0],p0,0,0,0);p1=__builtin_amdgcn_mfma_f32_32x32x16_bf16(b1,qr[d0],p1,0,0,0);}}
}
typedef __attribute__((address_space(3))) const char* lds_cptr;
typedef short v4i16_t __attribute__((ext_vector_type(4)));
__device__ __forceinline__ void kload8(bf16x8*kf,lds_cptr kp){
  kf[0]=*(const __attribute__((address_space(3))) bf16x8*)(kp);      kf[1]=*(const __attribute__((address_space(3))) bf16x8*)(kp+512);
  kf[2]=*(const __attribute__((address_space(3))) bf16x8*)(kp+2048); kf[3]=*(const __attribute__((address_space(3))) bf16x8*)(kp+2560);
  kf[4]=*(const __attribute__((address_space(3))) bf16x8*)(kp+4096); kf[5]=*(const __attribute__((address_space(3))) bf16x8*)(kp+4608);
  kf[6]=*(const __attribute__((address_space(3))) bf16x8*)(kp+6144); kf[7]=*(const __attribute__((address_space(3))) bf16x8*)(kp+6656);
}
__device__ __forceinline__ void kload2(bf16x8*kf,lds_cptr kp,int j){ kf[2*j]=*(const __attribute__((address_space(3))) bf16x8*)(kp+j*2048); kf[2*j+1]=*(const __attribute__((address_space(3))) bf16x8*)(kp+j*2048+512); }
__device__ __forceinline__ s16x4 vtr(lds_cptr p){ return __builtin_bit_cast(s16x4,__builtin_amdgcn_ds_read_tr16_b64_v4i16((__attribute__((address_space(3))) v4i16_t*)p)); }
__device__ __forceinline__ float rowmax(const f32x16&p0,const f32x16&p1){
  float a=max3f(p0[0],p0[1],p1[0]),b=max3f(p0[2],p0[3],p1[1]);a=max3f(a,p1[2],p1[3]);
  #pragma unroll
  for(int r=4;r<16;r+=4){a=max3f(a,p0[r],p0[r+1]);b=max3f(b,p0[r+2],p0[r+3]);a=max3f(a,p1[r],p1[r+1]);b=max3f(b,p1[r+2],p1[r+3]);}
  const float m=max2f(a,b);
  auto rr=__builtin_amdgcn_permlane32_swap(__float_as_uint(m),__float_as_uint(m),false,false);
  return max2f(__uint_as_float(rr[0]),__uint_as_float(rr[1]));
}
__device__ __forceinline__ void pv(f32x16*o,int vb,bf16x8 pa0,bf16x8 pa1,bf16x8 pa2,bf16x8 pa3){
  #pragma unroll
  for(int d0=0;d0<2;++d0){s16x4 lo[4],hi[4];
    #pragma unroll
    for(int ks=0;ks<4;++ks){
      asm volatile("ds_read_b64_tr_b16 %0,%1 offset:%c2":"=&v"(lo[ks]):"v"(vb),"i"(d0*4096+ks*1024):"memory");
      asm volatile("ds_read_b64_tr_b16 %0,%1 offset:%c2":"=&v"(hi[ks]):"v"(vb),"i"(d0*4096+ks*1024+512):"memory");}
    asm volatile("s_waitcnt lgkmcnt(0)":::"memory");SBAR();
    #define PK(k) (bf16x8){lo[k][0],lo[k][1],lo[k][2],lo[k][3],hi[k][0],hi[k][1],hi[k][2],hi[k][3]}
    o[d0]=__builtin_amdgcn_mfma_f32_32x32x16_bf16(pa0,PK(0),o[d0],0,0,0);
    o[d0]=__builtin_amdgcn_mfma_f32_32x32x16_bf16(pa1,PK(1),o[d0],0,0,0);
    o[d0]=__builtin_amdgcn_mfma_f32_32x32x16_bf16(pa2,PK(2),o[d0],0,0,0);
    o[d0]=__builtin_amdgcn_mfma_f32_32x32x16_bf16(pa3,PK(3),o[d0],0,0,0);
    #undef PK
  }
}

#ifndef ATTN_STORE16
#if MK_FP8_AOUT
#define ATTN_STORE16(p,v) do { const long off_ = (const bf16*)(p) - (const bf16*)O; const u32x4 v_ = (v); ::v2u o8_; \
    o8_.x = ::pk4_e4m3((::f32x4){__builtin_bit_cast(float, v_.x << 16), __builtin_bit_cast(float, v_.x & 0xffff0000u), __builtin_bit_cast(float, v_.y << 16), __builtin_bit_cast(float, v_.y & 0xffff0000u)} * O_SCALE); \
    o8_.y = ::pk4_e4m3((::f32x4){__builtin_bit_cast(float, v_.z << 16), __builtin_bit_cast(float, v_.z & 0xffff0000u), __builtin_bit_cast(float, v_.w << 16), __builtin_bit_cast(float, v_.w & 0xffff0000u)} * O_SCALE); \
    *(::v2u*)((unsigned char*)O + off_) = o8_; } while (0)
#else
#define ATTN_STORE16(p,v) (*(u32x4*)(p)=(v))
#endif
#endif
template<int THRL> __device__ __forceinline__ void attn_unit(int b,int h,int qb,const bf16*Q,const bf16*__restrict__ K,const bf16*__restrict__ V,bf16*O,char*shm){
  int tid_=threadIdx.x; asm volatile("":"+v"(tid_)); const int tid=tid_,lane=tid&63,r32=lane&31,hi=lane>>5; const int wid=__builtin_amdgcn_readfirstlane(tid>>6);
  const long rowbase=(long)b*SEQ; const int q0=qb*QB;
  const bf16*Qw=Q+(rowbase+q0+wid*QBLK)*DM+h*D;
  const bf16*Kh=K+(long)b*LKEYS*KP+(h>>2)*D,*Vh=V+(long)b*LKEYS*KP+(h>>2)*D;
  const unsigned lds0=(unsigned)(uintptr_t)shm;
  float*wsf=(float*)(shm+LDS_WS)+wid*64;
  const bf16*ksrc=Kh+(long)lane*KP+wid*8;
  const bf16*vsrc=Vh+(long)(16*(wid&3)+(lane>>2))*KP+(wid>>2)*32+(lane&3)*8;
  const unsigned kdst=lds0+LDS_K+wid*1024, vdst=lds0+LDS_V+wid*1024;
  #define DMA_K(t,slot) glds16(ksrc+(long)(t)*KVBLK*KP,(unsigned)__builtin_amdgcn_readfirstlane(kdst+(slot)))
  #define DMA_V(t,slot) glds16(vsrc+(long)(t)*KVBLK*KP,(unsigned)__builtin_amdgcn_readfirstlane(vdst+(slot)))
  const int vb0=(int)(lds0+LDS_V)+((lane>>4)&1)*32+(lane&3)*8+(4*hi+((lane&15)>>2))*64;
  const char*Kbase=shm+LDS_K; bf16x8 kf[8];
  const lds_cptr shm3=(lds_cptr)shm; const lds_cptr kp0=shm3+LDS_K+hi*1024+r32*16; const lds_cptr vp0=shm3+LDS_V+((lane>>4)&1)*32+(lane&3)*8+(4*hi+((lane&15)>>2))*64;
  const int NT=LKEYS/KVBLK;
  DMA_K(0,0);DMA_V(0,0);DMA_K(1,SLOTB);
  bf16x8 qr[4];
  #pragma unroll
  for(int d0=0;d0<4;++d0)qr[d0]=*reinterpret_cast<const bf16x8*>(&Qw[(long)r32*DM+d0*16+hi*8]);
  float mhat=0.f,l_reg=0.f;f32x16 o[2];o[0]=f32x16{};o[1]=f32x16{};f32x16 negm=f32x16{};asm volatile("":"+v"(negm));

  #define CMASK(P0,P1,t) do{}while(0)
  bool resc=false;
  #define START(P0,P1) do{ const float rm=rowmax(P0,P1); resc=false; \
    { const float dl=rm; mhat=fadd_s(mhat,dl); \
      _Pragma("unroll") for(int r=0;r<16;++r){P0[r]=fsub_s(P0[r],dl);P1[r]=fsub_s(P1[r],dl);} \
      _Pragma("unroll") for(int r=0;r<16;++r)negm[r]=-mhat; asm volatile("":"+v"(negm)); } \
    _Pragma("unroll") for(int r=0;r<16;++r)P0[r]=__builtin_amdgcn_exp2f(P0[r]); }while(0)
  #define RESC() do{ if(resc){ asm volatile("s_waitcnt lgkmcnt(0)":::"memory"); \
      _Pragma("unroll") for(int d_=0;d_<2;++d_) _Pragma("unroll") for(int r=0;r<16;++r)o[d_][r]*=wsf[crow(r,hi)]; } }while(0)
  f32x16 pA0,pA1,pB0,pB1;
  int sl_prev=0,sl_cur=0,sl_next=SLOTB;
  #define ROT() do{sl_prev=sl_cur;sl_cur=sl_next;sl_next=(sl_next==(NSLOT-1)*SLOTB)?0:sl_next+SLOTB;}while(0)
  DMA_K(2,2*SLOTB);
  WAIT_BAR(3);
  qkt(pA0,pA1,Kbase,qr,negm,r32,hi);asm volatile("s_nop 15\n\ts_nop 7":"+v"(pA0),"+v"(pA1));CMASK(pA0,pA1,0);
  START(pA0,pA1);
  _Pragma("unroll") for(int r=0;r<16;++r)pA1[r]=__builtin_amdgcn_exp2f(pA1[r]);
  WAIT_BAR(0);
  DMA_K(3,0);DMA_V(1,SLOTB);
  ROT();
  kload8(kf,kp0+sl_cur);
  WAIT_BAR(2);
  s16x4 vlo[8],vhi[8]; u32x4 pw0,pw1,pw2,pw3;
  #define PKW(P,B) cvtpk_s(P[B],P[B+1])
  #define PAF(k) __builtin_bit_cast(bf16x8,pw##k)
  #define VFR(i) (bf16x8){vlo[i][0],vlo[i][1],vlo[i][2],vlo[i][3],vhi[i][0],vhi[i][1],vhi[i][2],vhi[i][3]}
  #define PIN(x) asm volatile("":"+v"(x))
  #define MX3(a,b,c) __builtin_fmaxf(__builtin_fmaxf((a),(b)),(c))
  #define GAPA(MF,A0,A1,A2,A3,W0,W1,PW) do{ MF; sacc+=A0; sacc+=A1; sacc+=A2; sacc+=A3; PIN(sacc); W0; W1; PIN(PW); SBAR(); }while(0)
  #define EX(v) __builtin_amdgcn_exp2f(v)
  #define GAPB(MF,X,B) do{ MF; X[B]=EX(X[B]); X[B+1]=EX(X[B+1]); X[B+2]=EX(X[B+2]); X[B+3]=EX(X[B+3]); PIN(X); SBAR(); }while(0)
  #define VRD(i) do{ vlo[i]=vtr(vp_+(((i)>>2)*4096+((i)&3)*1024)); vhi[i]=vtr(vp_+(((i)>>2)*4096+((i)&3)*1024+512)); }while(0)
  #define KRD(G,j) do{ if(G){ kload2(kf,kp0+sl_next,j); SBAR(); } }while(0)
  #define STEP(C0,C1,P0,P1,t,GK,GV,GL) do{ SBAR(); \
    const lds_cptr vp_=vp0+sl_prev; \
    VRD(0); SBAR(); float sacc=(P0[0]+P0[1]); \
    GAPA(C0=__builtin_amdgcn_mfma_f32_32x32x16_bf16(kf[0],qr[0],negm,0,0,0), P0[2],P0[3],P0[4],P0[5],     pw0[0]=PKW(P0,0), pw0[1]=PKW(P0,2), pw0); \
    VRD(4); SBAR(); GAPA(C1=__builtin_amdgcn_mfma_f32_32x32x16_bf16(kf[1],qr[0],negm,0,0,0), P0[6],P0[7],P0[8],P0[9],     pw0[2]=PKW(P0,4), pw0[3]=PKW(P0,6), pw0); \
    VRD(1); SBAR(); GAPA(C0=__builtin_amdgcn_mfma_f32_32x32x16_bf16(kf[2],qr[1],C0,0,0,0),   P0[10],P0[11],P0[12],P0[13], pw1[0]=PKW(P0,8), pw1[1]=PKW(P0,10), pw1); \
    VRD(5); SBAR(); GAPA(C1=__builtin_amdgcn_mfma_f32_32x32x16_bf16(kf[3],qr[1],C1,0,0,0),   P0[14],P0[15],P1[0],P1[1],   pw1[2]=PKW(P0,12),pw1[3]=PKW(P0,14), pw1); \
    VRD(2); SBAR(); GAPA(C0=__builtin_amdgcn_mfma_f32_32x32x16_bf16(kf[4],qr[2],C0,0,0,0),   P1[2],P1[3],P1[4],P1[5],     pw2[0]=PKW(P1,0), pw2[1]=PKW(P1,2), pw2); \
    VRD(6); SBAR(); GAPA(C1=__builtin_amdgcn_mfma_f32_32x32x16_bf16(kf[5],qr[2],C1,0,0,0),   P1[6],P1[7],P1[8],P1[9],     pw2[2]=PKW(P1,4), pw2[3]=PKW(P1,6), pw2); \
    VRD(3); SBAR(); GAPA(C0=__builtin_amdgcn_mfma_f32_32x32x16_bf16(kf[6],qr[3],C0,0,0,0),   P1[10],P1[11],P1[12],P1[13], pw3[0]=PKW(P1,8), pw3[1]=PKW(P1,10), pw3); \
    VRD(7); SBAR(); GAPA(C1=__builtin_amdgcn_mfma_f32_32x32x16_bf16(kf[7],qr[3],C1,0,0,0),   P1[14],P1[15],0.f,0.f,       pw3[2]=PKW(P1,12),pw3[3]=PKW(P1,14), pw3); \
    l_reg+=sacc; \
    if(GK){DMA_K((t)+3,sl_cur);} if(GV){DMA_V((t)+1,sl_next);} \
    CMASK(C0,C1,t); \
    { float a=MX3(C0[0],C0[1],C1[0]),b=MX3(C0[2],C0[3],C1[1]); a=MX3(a,C1[2],C1[3]); \
      _Pragma("unroll") for(int r=4;r<16;r+=4){a=MX3(a,C0[r],C0[r+1]);b=MX3(b,C0[r+2],C0[r+3]);a=MX3(a,C1[r],C1[r+1]);b=MX3(b,C1[r+2],C1[r+3]);} \
      float rm=__builtin_fmaxf(a,b); { auto rr=__builtin_amdgcn_permlane32_swap(__float_as_uint(rm),__float_as_uint(rm),false,false); rm=__builtin_fmaxf(__uint_as_float(rr[0]),__uint_as_float(rr[1])); } \
      resc=false; \
      if(__builtin_expect(__any(rm>(float)THRL),0)){ const float dl=__builtin_fmaxf(rm,0.f); mhat+=dl; \
        _Pragma("unroll") for(int r=0;r<16;++r){C0[r]-=dl;C1[r]-=dl;} \
        _Pragma("unroll") for(int r=0;r<16;++r)negm[r]=-mhat; asm volatile("":"+v"(negm)); \
        const float f=__builtin_amdgcn_exp2f(-dl); l_reg*=f; if(hi==0)wsf[r32]=f; resc=true; } } \
    SBAR(); \
    GAPB(o[0]=__builtin_amdgcn_mfma_f32_32x32x16_bf16(PAF(0),VFR(0),o[0],0,0,0), C0,0); \
    GAPB(o[1]=__builtin_amdgcn_mfma_f32_32x32x16_bf16(PAF(0),VFR(4),o[1],0,0,0), C0,4); \
    KRD(GL,0); GAPB(o[0]=__builtin_amdgcn_mfma_f32_32x32x16_bf16(PAF(1),VFR(1),o[0],0,0,0), C0,8); \
    KRD(GL,1); GAPB(o[1]=__builtin_amdgcn_mfma_f32_32x32x16_bf16(PAF(1),VFR(5),o[1],0,0,0), C0,12); \
    KRD(GL,2); GAPB(o[0]=__builtin_amdgcn_mfma_f32_32x32x16_bf16(PAF(2),VFR(2),o[0],0,0,0), C1,0); \
    KRD(GL,3); GAPB(o[1]=__builtin_amdgcn_mfma_f32_32x32x16_bf16(PAF(2),VFR(6),o[1],0,0,0), C1,4); \
    GAPB(o[0]=__builtin_amdgcn_mfma_f32_32x32x16_bf16(PAF(3),VFR(3),o[0],0,0,0), C1,8); \
    GAPB(o[1]=__builtin_amdgcn_mfma_f32_32x32x16_bf16(PAF(3),VFR(7),o[1],0,0,0), C1,12); \
    }while(0)
  int t=1;
  #undef CMASK
  #define CMASK(P0,P1,t) do{}while(0)
  for(;t+5<NT;t+=2){
    STEP(pB0,pB1,pA0,pA1,t,true,true,true);     WAIT_BAR(2); RESC(); ROT();
    STEP(pA0,pA1,pB0,pB1,t+1,true,true,true);   WAIT_BAR(2); RESC(); ROT();
  }
  #undef CMASK
  #define CMASK(P0,P1,t) do{}while(0)
  #define ENDW(tt) do{ if((tt)+3<NT){WAIT_BAR(2);} else if((tt)+2<NT){WAIT_BAR(1);} else {WAIT_BAR(0);} }while(0)
  for(;t+1<NT;t+=2){
    STEP(pB0,pB1,pA0,pA1,t,(t+3<NT),(t+1<NT),(t+1<NT));       ENDW(t);   RESC(); ROT();
    STEP(pA0,pA1,pB0,pB1,t+1,(t+4<NT),(t+2<NT),(t+2<NT));     ENDW(t+1); RESC(); ROT();
  }
  STEP(pB0,pB1,pA0,pA1,NT-1,false,false,false); RESC();
  { float sacc=pB0[0]+pB0[1]; _Pragma("unroll") for(int r=2;r<16;++r)sacc+=pB0[r]; _Pragma("unroll") for(int r=0;r<16;++r)sacc+=pB1[r]; l_reg+=sacc;
    pw0=(u32x4){PKW(pB0,0),PKW(pB0,2),PKW(pB0,4),PKW(pB0,6)};pw1=(u32x4){PKW(pB0,8),PKW(pB0,10),PKW(pB0,12),PKW(pB0,14)};pw2=(u32x4){PKW(pB1,0),PKW(pB1,2),PKW(pB1,4),PKW(pB1,6)};pw3=(u32x4){PKW(pB1,8),PKW(pB1,10),PKW(pB1,12),PKW(pB1,14)};
    SBAR(); pv(o,vb0+sl_cur,PAF(0),PAF(1),PAF(2),PAF(3)); }
  #undef PKW
  #undef PAF
  #undef VFR
  #undef PIN
  #undef MX3
  #undef GAPA
  #undef GAPB
  #undef EX
  #undef VRD
  #undef KRD
  #undef STEP
  #undef ENDW
  {auto rr=__builtin_amdgcn_permlane32_swap(__float_as_uint(l_reg),__float_as_uint(l_reg),false,false);l_reg=__uint_as_float(rr[0])+__uint_as_float(rr[1]);}
  if(hi==0)wsf[32+r32]=l_reg;asm volatile("s_waitcnt lgkmcnt(0)":::"memory");
  float rli[16];
  #pragma unroll
  for(int r=0;r<16;++r)rli[r]=__builtin_amdgcn_rcpf(wsf[32+crow(r,hi)]);
  bf16*Ow=O+(rowbase+q0+wid*QBLK)*DM+h*D;
  { bf16*stg=(bf16*)(shm+LDS_OST)+wid*2048;
    #pragma unroll
    for(int r=0;r<16;++r){const int orow=crow(r,hi);
      #pragma unroll
      for(int d0=0;d0<2;++d0)stg[orow*64+d0*32+r32]=__float2bfloat16(o[d0][r]*rli[r]);}
    asm volatile("s_waitcnt lgkmcnt(0)":::"memory");
    #pragma unroll
    for(int i=0;i<4;++i){const int row=i*8+(lane>>3),ch=lane&7; const u32x4 v=*(const u32x4*)(stg+row*64+ch*8); ATTN_STORE16(Ow+(long)row*DM+ch*8,v);} }
  asm volatile("s_waitcnt lgkmcnt(0)\n\ts_barrier":::"memory");
  #undef DMA_K
  #undef DMA_V
  #undef CMASK
  #undef START
  #undef RESC
  #undef ROT
}
constexpr int ATTN_LDS_BYTES=LDS_BYTES;
struct AttnTensors { const bf16* Q; const bf16* K; const bf16* V; bf16* O; };
struct AttnUnit { int bh; int qb; };
struct StaticOrder {
  int vcu, per;
  __device__ __forceinline__ explicit StaticOrder(int grid,int vcu_):vcu(vcu_),per((BATCH*NHEAD*(SEQ/QB)+grid-1)/grid){}
  __device__ __forceinline__ bool next(int i,AttnUnit&u)const{ if(i>=per)return false; const int idx=vcu*per+i; if(idx>=BATCH*NHEAD*(SEQ/QB))return false; u.bh=idx/(SEQ/QB); u.qb=idx%(SEQ/QB); return true; }
  __device__ __forceinline__ void a_ready(const AttnUnit&)const{}
  __device__ __forceinline__ void done(const AttnUnit&)const{}
};
template<class Sched,int THRL=8> __device__ __forceinline__ void attn_phase(char*lds,const AttnTensors&T,const Sched&S){
  AttnUnit u;
  for(int i=0;S.next(i,u);++i){ S.a_ready(u); attn_unit<THRL>(u.bh/NHEAD,u.bh%NHEAD,u.qb,T.Q,T.K,T.V,T.O,lds); S.done(u); }
}
#undef SBAR
#undef WAIT_BAR
}

__device__ __forceinline__ void phase_attn_fast(ArgsP a, const Fr& F) {
    const attn_body::AttnTensors AT{(const attn_body::bf16*)(a->ws + SC_Q), (const attn_body::bf16*)(a->ws + SC_K), (const attn_body::bf16*)(a->ws + SC_V), (attn_body::bf16*)(a->ws + SC_O)};
    const attn_body::StaticOrder S(F.G, F.vcu);
    __syncthreads();
    attn_body::attn_phase<attn_body::StaticOrder>((char*)F.lds, AT, S);
    __syncthreads();
}
__device__ __forceinline__ void phase_sp_fast(ArgsP a, const Fr& F) {
    typedef short bf16x8 __attribute__((ext_vector_type(8)));
    constexpr int PITCH = 136;
    LAS unsigned short* As = (LAS unsigned short*)F.lds;
    LAS unsigned short* Bs = As + 128 * PITCH;
    LAS float* st = (LAS float*)(Bs + 128 * PITCH);
    const bf16* VT = (const bf16*)(a->ws + SC_VT); const f32x2* VST = (const f32x2*)(a->ws + SC_VST); const bf16* UB = (const bf16*)(a->ws + SC_UB); bf16* UV = (bf16*)(a->ws + SC_UV);
    const bf16* WS = (const bf16*)(a->ws + WS_WCMS);
    const float* lng = a->in[I_CMLNG]; const float* lnb = a->in[I_CMLNB]; const float* bs = a->in[I_CMBS];
    const int tid = F.tid, lane = F.lane, wid = F.wave, wr = wid >> 2, wc = wid & 3, fr = lane & 15, fq = lane >> 4;
    const int per = (2048 + F.G - 1) / F.G; int gl = -1;
    const int s4 = (lane & 31) * 4, ch = lane >> 5;
    const int it_lo = F.vcu * per, it_hi = ((F.vcu + 1) * per < 2048) ? (F.vcu + 1) * per : 2048;
#define SP_BAR() asm volatile("s_waitcnt lgkmcnt(0)\n\ts_barrier" ::: "memory")
#define SP_PREFETCH(it_) do { const int g_ = (it_) >> 7, n_ = (it_) & 127; \
        _Pragma("unroll") for (int q = 0; q < 8; ++q) vt_n[q] = *(const v2u*)(VT + (size_t)(g_ * 128 + q * 16 + wid * 2 + ch) * T + n_ * 128 + s4); \
        if (tid < 128) { _Pragma("unroll") for (int p = 0; p < 16; ++p) vst_n[p] = VST[(size_t)p * T + n_ * 128 + tid]; } } while (0)
    v2u vt_n[8]; f32x2 vst_n[16];
#pragma unroll
    for (int p = 0; p < 16; ++p) vst_n[p] = (f32x2){0.f, 0.f};
    if (it_lo < it_hi) SP_PREFETCH(it_lo);
    for (int it = it_lo; it < it_hi; ++it) {
        const int g = it >> 7, n = it & 127;
        v2u vt[8];
#pragma unroll
        for (int q = 0; q < 8; ++q) vt[q] = vt_n[q];
        float s1 = 0.f, s2 = 0.f;
#pragma unroll
        for (int p = 0; p < 16; ++p) { s1 += vst_n[p].x; s2 += vst_n[p].y; }
        v2u ub[4][2];
#pragma unroll
        for (int m = 0; m < 4; ++m)
#pragma unroll
            for (int nn = 0; nn < 2; ++nn) ub[m][nn] = *(const v2u*)(UB + (size_t)(n * 128 + wr * 64 + m * 16 + fr) * 2048 + g * 128 + wc * 32 + nn * 16 + 4 * fq);
        SP_BAR();
        if (g != gl) { gl = g;
#pragma unroll
            for (int q = 0; q < 4; ++q) { const int idx = tid + q * NTHR, t = idx >> 4, ck = idx & 15;
                *(LAS v4u*)(As + t * PITCH + ck * 8) = *(const v4u*)(WS + (size_t)g * 16384 + t * 128 + ck * 8); } }
        if (tid < 128) { const float mean = s1 * (1.0f / 2048.0f); const float var = s2 * (1.0f / 2048.0f) - mean * mean; st[tid * 2] = mean; st[tid * 2 + 1] = 1.0f / sqrtf(var + LN_EPS); }
        if (it + 1 < it_hi) SP_PREFETCH(it + 1);
        SP_BAR();
        { const f32x4 mu = {st[(s4 + 0) * 2], st[(s4 + 1) * 2], st[(s4 + 2) * 2], st[(s4 + 3) * 2]};
          const f32x4 rs = {st[(s4 + 0) * 2 + 1], st[(s4 + 1) * 2 + 1], st[(s4 + 2) * 2 + 1], st[(s4 + 3) * 2 + 1]};
#pragma unroll
          for (int q = 0; q < 8; ++q) { const int c = q * 16 + wid * 2 + ch; const int chn = g * 128 + c;
              const f32x4 v = up4(vt[q]);
              const float lg = lng[chn], lb = lnb[chn];
              const f32x4 y = (v - mu) * rs * lg + lb;
              v2u o; o.x = pk2(y[0], y[1]); o.y = pk2(y[2], y[3]); *(LAS v2u*)(Bs + c * PITCH + s4) = o; } }
        SP_BAR();
        f32x4 acc[4][2];
#pragma unroll
        for (int m = 0; m < 4; ++m)
#pragma unroll
            for (int nn = 0; nn < 2; ++nn) acc[m][nn] = (f32x4){0.f, 0.f, 0.f, 0.f};
#pragma unroll
        for (int k = 0; k < 4; ++k) {
            bf16x8 af[4], bfr[2];
#pragma unroll
            for (int m = 0; m < 4; ++m) af[m] = *(const LAS bf16x8*)(As + (wr * 64 + m * 16 + fr) * PITCH + k * 32 + fq * 8);
#pragma unroll
            for (int nn = 0; nn < 2; ++nn) bfr[nn] = *(const LAS bf16x8*)(Bs + (wc * 32 + nn * 16 + fr) * PITCH + k * 32 + fq * 8);
#pragma unroll
            for (int m = 0; m < 4; ++m)
#pragma unroll
                for (int nn = 0; nn < 2; ++nn) acc[m][nn] = __builtin_amdgcn_mfma_f32_16x16x32_bf16(bfr[nn], af[m], acc[m][nn], 0, 0, 0);
        }
#pragma unroll
        for (int m = 0; m < 4; ++m) { const int t = wr * 64 + m * 16 + fr; const float bt = bs[g * 128 + t];
#pragma unroll
            for (int nn = 0; nn < 2; ++nn) { const size_t idx = (size_t)(n * 128 + t) * 2048 + g * 128 + wc * 32 + nn * 16 + 4 * fq;
                const v2u ubv = ub[m][nn]; const f32x4 o = acc[m][nn] + bt;
#if MK_FP8_CMOUT
                const f32x4 uvv = {__builtin_bit_cast(float, ubv.x << 16) * o[0], __builtin_bit_cast(float, ubv.x & 0xffff0000u) * o[1], __builtin_bit_cast(float, ubv.y << 16) * o[2], __builtin_bit_cast(float, ubv.y & 0xffff0000u) * o[3]};
                *(unsigned*)((unsigned char*)UV + idx) = pk4_e4m3(uvv * O_SCALE); } }
#else
                v2u w; w.x = pk2(__builtin_bit_cast(float, ubv.x << 16) * o[0], __builtin_bit_cast(float, ubv.x & 0xffff0000u) * o[1]);
                w.y = pk2(__builtin_bit_cast(float, ubv.y << 16) * o[2], __builtin_bit_cast(float, ubv.y & 0xffff0000u) * o[3]);
                *(v2u*)(UV + idx) = w; } }
#endif
    }
#undef SP_BAR
#undef SP_PREFETCH
}
__device__ __forceinline__ void phase_rope(ArgsP a, const Fr& F) {
    LAS f32x2* tab = (LAS f32x2*)F.lds;
    __syncthreads();
    for (int u = F.tid; u < 1024; u += NTHR) { const int pos = u >> 4, f = u & 15; const float invf = powf(10000.0f, -(float)f / 16.0f); float sn, cs; sincosf((float)pos * invf, &sn, &cs); tab[u] = (f32x2){cs, sn}; }
    __syncthreads();
    const bf16* QKV = (const bf16*)(a->ws + SC_QKV); bf16* Q = (bf16*)(a->ws + SC_Q); bf16* K = (bf16*)(a->ws + SC_K); bf16* V = (bf16*)(a->ws + SC_V);
    const int gw = F.vcu * NWAVES + F.wave, NGW = F.G * NWAVES;
    const int l8 = F.lane & 7, hl = F.lane >> 3;
    const f32x4 qg0 = *(const f32x4*)(a->in[I_QGAIN] + 4 * l8), qg1 = *(const f32x4*)(a->in[I_QGAIN] + 32 + 4 * l8);
    const f32x4 kg0 = *(const f32x4*)(a->in[I_KGAIN] + 4 * l8), kg1 = *(const f32x4*)(a->in[I_KGAIN] + 32 + 4 * l8);
    for (int row0 = gw; row0 < TA; row0 += 4 * NGW) {
        v2u xa[4][3], xb[4][3];
#pragma unroll
        for (int rr = 0; rr < 4; ++rr) { const int row = row0 + rr * NGW < TA ? row0 + rr * NGW : row0; const bf16* src = QKV + (size_t)row * 1536 + hl * 64 + 4 * l8;
#pragma unroll
            for (int p = 0; p < 3; ++p) { xa[rr][p] = *(const v2u*)(src + p * 512); xb[rr][p] = *(const v2u*)(src + p * 512 + 32); } }
#pragma unroll
        for (int rr = 0; rr < 4; ++rr) { const int row = row0 + rr * NGW; if (row >= TA) break;
            const bool lat = row < T; const int b = lat ? (row >> 12) : ((row - T) >> 8); const int t = lat ? (row & 4095) : ((row - T) & 255);
            f32x4 cs = {1.f, 1.f, 1.f, 1.f}, sn = {0.f, 0.f, 0.f, 0.f};
            if (lat) { const int pos = (l8 < 4) ? (t >> 6) : (t & 63); const LAS f32x4* tp = (const LAS f32x4*)(tab + pos * 16 + 4 * (l8 & 3));
                const f32x4 c01 = tp[0], c23 = tp[1]; cs = (f32x4){c01[0], c01[2], c23[0], c23[2]}; sn = (f32x4){c01[1], c01[3], c23[1], c23[3]}; }
            const size_t krow = (size_t)b * LK + (lat ? LC + t : t);
#pragma unroll
            for (int p = 0; p < 3; ++p) {
                if (p < 2 && !lat) continue;
                if (p == 2 && hl >= 4) { bf16* d = V + krow * KVP + (hl - 4) * 64 + 4 * l8; *(v2u*)d = xa[rr][p]; *(v2u*)(d + 32) = xb[rr][p]; }
                else {
                    const f32x4 x1 = up4(xa[rr][p]), x2 = up4(xb[rr][p]);
                    float ss = ((x1[0] * x1[0] + x1[1] * x1[1]) + (x1[2] * x1[2] + x1[3] * x1[3])) + ((x2[0] * x2[0] + x2[1] * x2[1]) + (x2[2] * x2[2] + x2[3] * x2[3]));
                    ss += __shfl_xor(ss, 1); ss += __shfl_xor(ss, 2); ss += __shfl_xor(ss, 4);
                    const float rs = 1.0f / sqrtf(ss * (1.0f / 64.0f) + RMS_EPS);
                    const bool isq = p < 2;
                    const f32x4 n1 = x1 * rs * (isq ? qg0 : kg0), n2 = x2 * rs * (isq ? qg1 : kg1);
                    f32x4 o1 = n1 * cs - n2 * sn, o2 = n1 * sn + n2 * cs;
                    bf16* d;
                    if (isq) { o1 *= ATT_C2; o2 *= ATT_C2; d = Q + (size_t)row * 1024 + (p * 8 + hl) * 64 + 4 * l8; }
                    else d = K + krow * KVP + hl * 64 + 4 * l8;
                    v2u w1, w2; w1.x = pk2(o1[0], o1[1]); w1.y = pk2(o1[2], o1[3]); w2.x = pk2(o2[0], o2[1]); w2.y = pk2(o2[2], o2[3]);
                    *(v2u*)d = w1; *(v2u*)(d + 32) = w2; }
            }
        }
    }
}
__device__ __forceinline__ void phase_attn_simple(ArgsP a, const Fr& F) {
    const bf16* Q = (const bf16*)(a->ws + SC_Q); const bf16* K = (const bf16*)(a->ws + SC_K); const bf16* V = (const bf16*)(a->ws + SC_V); bf16* O = (bf16*)(a->ws + SC_O);
    for (int it = F.vcu; it < 512; it += F.G) {
        const int b = it >> 7, h = (it >> 3) & 15, q = (it & 7) * 512 + F.tid;
        const bf16* qp = Q + (size_t)(b * SEQ + q) * 1024 + h * 64;
        float qv[64], o[64];
#pragma unroll
        for (int d = 0; d < 64; ++d) { qv[d] = bf2f(qp[d]); o[d] = 0.f; }
        float m = -3.0e38f, l = 0.f;
        const bf16* kb = K + (size_t)b * LK * KVP + (h >> 2) * 64; const bf16* vb = V + (size_t)b * LK * KVP + (h >> 2) * 64;
        for (int s = 0; s < LK; ++s) {
            const v4u* kr = (const v4u*)(kb + (size_t)s * KVP); float sc = 0.f;
#pragma unroll
            for (int c = 0; c < 8; ++c) { const v4u kv = kr[c]; const unsigned w[4] = {kv.x, kv.y, kv.z, kv.w};
#pragma unroll
                for (int j = 0; j < 4; ++j) { sc += qv[c * 8 + 2 * j] * __builtin_bit_cast(float, w[j] << 16) + qv[c * 8 + 2 * j + 1] * __builtin_bit_cast(float, w[j] & 0xffff0000u); } }
            const float mn = fmaxf(m, sc); const float al = exp2f(m - mn), p = exp2f(sc - mn); l = l * al + p; m = mn;
            const v4u* vr = (const v4u*)(vb + (size_t)s * KVP);
#pragma unroll
            for (int c = 0; c < 8; ++c) { const v4u vv = vr[c]; const unsigned w[4] = {vv.x, vv.y, vv.z, vv.w};
#pragma unroll
                for (int j = 0; j < 4; ++j) { o[c * 8 + 2 * j] = o[c * 8 + 2 * j] * al + p * __builtin_bit_cast(float, w[j] << 16); o[c * 8 + 2 * j + 1] = o[c * 8 + 2 * j + 1] * al + p * __builtin_bit_cast(float, w[j] & 0xffff0000u); } }
        }
        const float il = 1.0f / l; bf16* op = O + (size_t)(b * SEQ + q) * 1024 + h * 64;
#pragma unroll
        for (int c = 0; c < 8; ++c) { v4u w; w.x = pk2(o[c * 8] * il, o[c * 8 + 1] * il); w.y = pk2(o[c * 8 + 2] * il, o[c * 8 + 3] * il); w.z = pk2(o[c * 8 + 4] * il, o[c * 8 + 5] * il); w.w = pk2(o[c * 8 + 6] * il, o[c * 8 + 7] * il);
            *(v4u*)(op + c * 8) = w; }
    }
}
__device__ __forceinline__ void phase_sp_simple(ArgsP a, const Fr& F) {
    LAS float* wsL = (LAS float*)F.lds;
    LAS float* vl = wsL + 128 * 128;
    LAS float* st = vl + 128 * 128;
    const float* VT = (const float*)(a->ws + SC_VT); const f32x2* VST = (const f32x2*)(a->ws + SC_VST); const bf16* UB = (const bf16*)(a->ws + SC_UB); bf16* UV = (bf16*)(a->ws + SC_UV);
    const int per = (2048 + F.G - 1) / F.G; int gl = -1;
    for (int it = F.vcu * per; it < (F.vcu + 1) * per && it < 2048; ++it) {
        const int g = it >> 7, n = it & 127;
        __syncthreads();
        if (g != gl) { for (int u = F.tid; u < 128 * 128; u += NTHR) wsL[u] = a->in[I_CMWS][(size_t)g * 16384 + u]; gl = g; }
        if (F.tid < 128) { float s1 = 0.f, s2 = 0.f; for (int p = 0; p < 16; ++p) { const f32x2 v = VST[(size_t)p * T + n * 128 + F.tid]; s1 += v.x; s2 += v.y; }
            const float mean = s1 * (1.0f / 2048.0f); const float var = s2 * (1.0f / 2048.0f) - mean * mean; st[F.tid * 2] = mean; st[F.tid * 2 + 1] = 1.0f / sqrtf(var + LN_EPS); }
        __syncthreads();
        for (int u = F.tid; u < 128 * 128; u += NTHR) { const int c = u >> 7, s = u & 127; const int ch = g * 128 + c;
            const float v = VT[(size_t)ch * T + n * 128 + s]; vl[s * 128 + c] = (v - st[s * 2]) * st[s * 2 + 1] * a->in[I_CMLNG][ch] + a->in[I_CMLNB][ch]; }
        __syncthreads();
        const int c = F.tid & 127, tq = F.tid >> 7;
        for (int jj = 0; jj < 32; ++jj) { const int t = tq + 4 * jj; float acc = 0.f;
            for (int s = 0; s < 128; ++s) acc += wsL[t * 128 + s] * vl[s * 128 + c];
            acc += a->in[I_CMBS][g * 128 + t];
            const size_t idx = (size_t)(n * 128 + t) * 2048 + g * 128 + c;
            UV[idx] = (bf16)f2bf(bf2f(UB[idx]) * acc); }
    }
}
#ifndef MK_FAST_CONV
#define MK_FAST_CONV 0
#endif
#ifndef MK_FAST_ATTN
#define MK_FAST_ATTN 0
#endif
#ifndef MK_FAST_SP
#define MK_FAST_SP 0
#endif
#ifndef MK_GATHER
#define MK_GATHER 0
#endif
constexpr int MOE_PH = MK_GATHER ? 5 : 6;
constexpr int N_PHASES = (MK_MERGE_PRO ? 1 : 2) + (4 + MOE_PH) + (4 + MOE_PH) + (3 + MOE_PH) + (4 + MOE_PH);

#ifndef MK_STAG_GU
#define MK_STAG_GU 0
#endif
#define STAGGER(ticks) do { if ((ticks) > 0 && (F.vcu & 1)) { const unsigned long long t0_ = __builtin_amdgcn_s_memrealtime(); while (__builtin_amdgcn_s_memrealtime() - t0_ < (unsigned long long)(ticks)) __builtin_amdgcn_s_sleep(8); } } while (0)
#ifndef MK_REPMASK
#define MK_REPMASK 0ull
#endif
#ifndef MK_CODEPROBE_N
#define MK_CODEPROBE_N 0
#endif
#if MK_CODEPROBE_N > 0
#define MK_CODEPROBE { _Pragma("unroll 1") for (int cp_ = 0; cp_ < MK_CODEPROBE_N; ++cp_) asm volatile(".rept 2048\n\ts_nop 0\n\t.endr" ::: "memory"); }
#else
#define MK_CODEPROBE
#endif
#ifndef MK_LNR2
#define MK_LNR2 0
#endif
#ifndef MK_XBAR
#define MK_XBAR 0
#endif
#ifndef MK_REPN
#define MK_REPN 3
#endif
#ifndef MK_REPBAR
#define MK_REPBAR 0
#endif
__device__ __forceinline__ bool probe_bar(unsigned char* lds_raw) { ArgsP a__ = get_args(); XcdBarrier bb; bb.bar = (unsigned*)(a__->ws + WS_CTL) + 4096; bb.x = xb_xcc_id();
    bb.st = (volatile LAS unsigned*)((LAS unsigned char*)lds_raw + MISC_OFF) + 8; xcd_barrier(bb); return false; }
#define REPS for (int rep_ = 0; rep_ < (((MK_REPMASK >> p) & 1ull) ? MK_REPN : 1); ++rep_) if (MK_REPBAR && rep_ > 0 && probe_bar(lds_raw)) {} else
#define IN() (get_args()->ph_lo <= p && p < get_args()->ph_hi)
#define PHB ArgsP a = get_args(); unsigned char* ws = a->ws; (void)ws; const Fr F = mkfr(lds_raw);
#define SEAM() do { { ArgsP a__ = get_args(); if (a__->ph_lo <= p && p + 1 < a__->ph_hi) { XcdBarrier bb; bb.bar = (unsigned*)(a__->ws + WS_CTL) + 4096; bb.x = xb_xcc_id(); \
        bb.st = (volatile LAS unsigned*)((LAS unsigned char*)lds_raw + MISC_OFF) + 8; xcd_barrier(bb); for (int xb_ = 0; xb_ < MK_XBAR; ++xb_) xcd_barrier(bb); MK_CODEPROBE } } ++p; } while (0)
template <int layer> __device__ __forceinline__ void layer_body(int& p, unsigned char* lds_raw) {
    PG8_LAS unsigned char* ring = (PG8_LAS unsigned char*)lds_raw;
        constexpr int kind = layer % 3;
        const int nrows = layer == 0 ? TA : T;
#define G1PTR ((const float*)(ws + WS_MOD) + (size_t)layer * 5 * 6144 + 2048)
        if constexpr (kind == 0) {
            const int slot = layer == 0 ? 0 : 1;
#if MK_FP8_HYIN
            REPS if (IN()) { PHB pg8::Gemm g{(const pg8::bf16_t*)(ws + WS_WHYIN + (size_t)slot * 3072 * 1024), (const pg8::bf16_t*)(ws + WS_HB), 3072, nrows, 512, nullptr};
                pg8::StaticOrder S; S.init(3072, nrows, F.G, F.bx); pg8::EpiBf16<0> E{(pg8::bf16_t*)(ws + SC_PT), TA, nullptr, 1 << 30, 0, 1.0f / WH_SCALE};
                pg8::gemm_phase<pg8::EpiBf16<0>, pg8::StaticOrder, true, false, true>(ring, g, S, E);
#else
            REPS if (IN()) { PHB pg8::Gemm g{(const pg8::bf16_t*)(ws + WS_WHYIN) + (size_t)slot * 3072 * 1024, (const pg8::bf16_t*)(ws + WS_HB), 3072, nrows, 1024, nullptr};
                pg8::StaticOrder S; S.init(3072, nrows, F.G, F.bx); pg8::EpiBf16<0> E{(pg8::bf16_t*)(ws + SC_PT), TA, nullptr, 0, 0, 1.f};
                pg8::gemm_phase<pg8::EpiBf16<0>, pg8::StaticOrder, true, false>(ring, g, S, E);
#endif
                if constexpr (layer == 0) { __syncthreads(); bg_convert<0>(a, F, F.bx - (12 * 68) % 256); } }
            SEAM();
            REPS if (IN()) { PHB
#if MK_FAST_CONV
                phase_hy_conv_fft(a, F, layer);
#else
                phase_hy_conv_direct(a, F, layer);
#endif
            }
            SEAM();
            REPS if (IN()) { PHB phase_hy_tr(a, F, nrows); }
            SEAM();
#if MK_FP8_HYOUT
            REPS if (IN()) { PHB pg8::Gemm g{(const pg8::bf16_t*)(ws + SC_Z2), (const pg8::bf16_t*)(ws + WS_WHYOUT + (size_t)slot * 1024 * 1024), nrows, 1024, 512, nullptr};
                pg8::StaticOrder S; S.init(nrows, 1024, F.G, F.bx); pg8::EpiRes E{(const pg8::bf16_t*)(ws + WS_XC), (pg8::bf16_t*)(ws + WS_U), G1PTR, 6144, ALPHA, 1.0f / (WH_SCALE * Z_SCALE)};
                pg8::gemm_phase<pg8::EpiRes, pg8::StaticOrder, true, false, true>(ring, g, S, E);
#else
            REPS if (IN()) { PHB pg8::Gemm g{(const pg8::bf16_t*)(ws + SC_Z2), (const pg8::bf16_t*)(ws + WS_WHYOUT) + (size_t)slot * 1024 * 1024, nrows, 1024, 1024, nullptr};
                pg8::StaticOrder S; S.init(nrows, 1024, F.G, F.bx); pg8::EpiRes E{(const pg8::bf16_t*)(ws + WS_XC), (pg8::bf16_t*)(ws + WS_U), G1PTR, 6144, ALPHA};
                pg8::gemm_phase<pg8::EpiRes, pg8::StaticOrder, true, false>(ring, g, S, E);
#endif
                if constexpr (layer == 0) { __syncthreads(); bg_convert<1>(a, F, F.bx - (68 * 4) % 256); } }
            SEAM();
        } else if constexpr (kind == 1) {
#if MK_FP8_QKV
            REPS if (IN()) { PHB pg8::Gemm g{(const pg8::bf16_t*)(ws + WS_HB), (const pg8::bf16_t*)(ws + WS_WQKV), TA, 1536, 512, nullptr};
                pg8::StaticOrder S; S.init(TA, 1536, F.G, F.bx); pg8::EpiBf16<0> E{(pg8::bf16_t*)(ws + SC_QKV), 1536, nullptr, 0, 0, 1.f, 1.0f / WH_SCALE};
                pg8::gemm_phase<pg8::EpiBf16<0>, pg8::StaticOrder, true, false, true>(ring, g, S, E);
#else
            REPS if (IN()) { PHB pg8::Gemm g{(const pg8::bf16_t*)(ws + WS_HB), (const pg8::bf16_t*)(ws + WS_WQKV), TA, 1536, 1024, nullptr};
                pg8::StaticOrder S; S.init(TA, 1536, F.G, F.bx); pg8::EpiBf16<0> E{(pg8::bf16_t*)(ws + SC_QKV), 1536, nullptr, 0, 0, 1.f};
                pg8::gemm_phase<pg8::EpiBf16<0>, pg8::StaticOrder, true, false>(ring, g, S, E);
#endif
                __syncthreads(); bg_convert<4>(a, F, F.bx - (68 * 6) % 256); }
            SEAM();
            REPS if (IN()) { PHB phase_rope(a, F); }
            SEAM();
            REPS if (IN()) { PHB
#if MK_FAST_ATTN
                phase_attn_fast(a, F);
#else
                phase_attn_simple(a, F);
#endif
            }
            SEAM();
#if MK_FP8_AOUT
            REPS if (IN()) { PHB pg8::Gemm g{(const pg8::bf16_t*)(ws + SC_O), (const pg8::bf16_t*)(ws + WS_WATO), T, 1024, 512, nullptr};
                pg8::StaticOrder S; S.init(T, 1024, F.G, F.bx); pg8::EpiRes E{(const pg8::bf16_t*)(ws + WS_XC), (pg8::bf16_t*)(ws + WS_U), G1PTR, 6144, ALPHA, 1.0f / (WH_SCALE * O_SCALE)};
                pg8::gemm_phase<pg8::EpiRes, pg8::StaticOrder, true, false, true>(ring, g, S, E); }
#else
            REPS if (IN()) { PHB pg8::Gemm g{(const pg8::bf16_t*)(ws + SC_O), (const pg8::bf16_t*)(ws + WS_WATO), T, 1024, 1024, nullptr};
                pg8::StaticOrder S; S.init(T, 1024, F.G, F.bx); pg8::EpiRes E{(const pg8::bf16_t*)(ws + WS_XC), (pg8::bf16_t*)(ws + WS_U), G1PTR, 6144, ALPHA};
                pg8::gemm_phase<pg8::EpiRes, pg8::StaticOrder, true, false>(ring, g, S, E); }
#endif
            SEAM();
        } else {
            REPS if (IN()) {
#if MK_FP8_CMIN
                { PHB pg8::Gemm g{(const pg8::bf16_t*)(ws + WS_HB), (const pg8::bf16_t*)(ws + WS_WCMIN), T, 2048, 512, nullptr};
                  pg8::StaticOrder S; S.init(T, 2048, F.G, F.bx); pg8::EpiBf16<1> E{(pg8::bf16_t*)(ws + SC_UB), 2048, nullptr, 0, 0, 1.f, 1.0f / WH_SCALE};
                  pg8::gemm_phase<pg8::EpiBf16<1>, pg8::StaticOrder, true, false, true>(ring, g, S, E); }
                { PHB pg8::Gemm g{(const pg8::bf16_t*)(ws + WS_WCMIN + (size_t)2048 * 1024), (const pg8::bf16_t*)(ws + WS_HB), 2048, T, 512, nullptr};
                  pg8::StaticOrder S; S.init(2048, T, F.G, F.bx); pg8::EpiVT E{(pg8::bf16_t*)(ws + SC_VT), T, (pg8::f32x2*)(ws + SC_VST), T, 1.0f / WH_SCALE};
                  pg8::gemm_phase<pg8::EpiVT, pg8::StaticOrder, true, false, true>(ring, g, S, E); }
#else
                { PHB pg8::Gemm g{(const pg8::bf16_t*)(ws + WS_HB), (const pg8::bf16_t*)(ws + WS_WCMIN), T, 2048, 1024, nullptr};
                  pg8::StaticOrder S; S.init(T, 2048, F.G, F.bx); pg8::EpiBf16<1> E{(pg8::bf16_t*)(ws + SC_UB), 2048, nullptr, 0, 0, 1.f};
                  pg8::gemm_phase<pg8::EpiBf16<1>, pg8::StaticOrder, true, false>(ring, g, S, E); }
#if MK_FP8_CMV
                { PHB pg8::Gemm g{(const pg8::bf16_t*)(ws + WS_WCMIN + (size_t)2048 * 1024 * 2), (const pg8::bf16_t*)(ws + WS_HB8B), 2048, T, 512, nullptr};
                  pg8::StaticOrder S; S.init(2048, T, F.G, F.bx); pg8::EpiVT E{(pg8::bf16_t*)(ws + SC_VT), T, (pg8::f32x2*)(ws + SC_VST), T, 1.0f / WH_SCALE};
                  pg8::gemm_phase<pg8::EpiVT, pg8::StaticOrder, true, false, true>(ring, g, S, E); }
#else
                { PHB pg8::Gemm g{(const pg8::bf16_t*)(ws + WS_WCMIN) + (size_t)2048 * 1024, (const pg8::bf16_t*)(ws + WS_HB), 2048, T, 1024, nullptr};
                  pg8::StaticOrder S; S.init(2048, T, F.G, F.bx); pg8::EpiVT E{(pg8::bf16_t*)(ws + SC_VT), T, (pg8::f32x2*)(ws + SC_VST), T};
                  pg8::gemm_phase<pg8::EpiVT, pg8::StaticOrder, true, false>(ring, g, S, E); }
#endif
#endif
            }
            SEAM();
            REPS if (IN()) { PHB
#if MK_FAST_SP
                phase_sp_fast(a, F);
#else
                phase_sp_simple(a, F);
#endif
            }
            SEAM();
#if MK_FP8_CMOUT
            REPS if (IN()) { PHB pg8::Gemm g{(const pg8::bf16_t*)(ws + SC_UV), (const pg8::bf16_t*)(ws + WS_WCMOUT), T, 1024, 1024, nullptr};
                pg8::StaticOrder S; S.init(T, 1024, F.G, F.bx); pg8::EpiRes E{(const pg8::bf16_t*)(ws + WS_XC), (pg8::bf16_t*)(ws + WS_U), G1PTR, 6144, ALPHA, 1.0f / (WH_SCALE * O_SCALE)};
                pg8::gemm_phase<pg8::EpiRes, pg8::StaticOrder, true, false, true>(ring, g, S, E); }
#else
            REPS if (IN()) { PHB pg8::Gemm g{(const pg8::bf16_t*)(ws + SC_UV), (const pg8::bf16_t*)(ws + WS_WCMOUT), T, 1024, 2048, nullptr};
                pg8::StaticOrder S; S.init(T, 1024, F.G, F.bx); pg8::EpiRes E{(const pg8::bf16_t*)(ws + WS_XC), (pg8::bf16_t*)(ws + WS_U), G1PTR, 6144, ALPHA};
                pg8::gemm_phase<pg8::EpiRes, pg8::StaticOrder, true, false>(ring, g, S, E); }
#endif
            SEAM();
        }
#if MK_LNR2
        REPS if (IN()) { PHB phase_lnr2(a, F, layer, nrows); }
#else
        REPS if (IN()) { PHB phase_lnr(a, F, layer, nrows); }
#endif
        SEAM();
        REPS if (IN()) { PHB phase_topk(a, F, layer);
            if constexpr (layer == 0) { __syncthreads(); bg_convert<2>(a, F, F.vcu - 128); }
            if constexpr (layer == 1) { __syncthreads(); bg_convert<5>(a, F, F.vcu - 64); }
            if constexpr (layer == 2) { __syncthreads(); bg_convert<6>(a, F, F.vcu - 64); } }
        SEAM();
        const int npm = layer == 0 ? 9 : 8;
#if MK_GATHER
        REPS if (IN()) { PHB pg8::Gemm g{(const pg8::bf16_t*)(ws + WS_HB), (const pg8::bf16_t*)(ws + WS_WGU + (size_t)layer * 16 * 4096 * 1024), 0, 0, 512, (const int*)(ws + WS_ROWS)};
            pg8::MoeOrder S{npm, 16, F.G, F.vcu}; pg8::EpiGU8<MK_FP8_DN != 0> E{(unsigned char*)(ws + WS_ACT), 16, 1.0f / WGU_SCALE, MK_FP8_DN ? ACT_SCALE : 1.0f};
            STAGGER(MK_STAG_GU);
#if defined(MK_NULLEPI)
            if (rep_ > 0) { pg8::MK_NULLEPI EN; pg8::MoeOrder S2 = S; S2.fixed = 1; pg8::gemm_phase<pg8::MK_NULLEPI, pg8::MoeOrder, true, true, true>(ring, g, S2, EN); } else
#endif
            pg8::gemm_phase<pg8::EpiGU8<MK_FP8_DN != 0>, pg8::MoeOrder, true, true, true>(ring, g, S, E); }
        SEAM();
#else
        REPS if (IN()) { PHB phase_gather(a, F, layer); }
        SEAM();
#error "the materialised-gather build (MK_GATHER 0) predates the e4m3 expert GEMMs and is no longer supported"
        SEAM();
#endif
#if MK_FP8_DN
        REPS if (IN()) { PHB pg8::Gemm g{(const pg8::bf16_t*)(ws + WS_ACT), (const pg8::bf16_t*)(ws + WS_WDN + (size_t)layer * 16 * 1024 * 2048), 0, 0, 1024, nullptr};
            pg8::MoeOrder S{npm, 4, F.G, F.vcu}; pg8::EpiDN E{(pg8::bf16_t*)(ws + WS_Y), (const float*)(ws + WS_GATE), 4, (MK_FP8_Y ? Y_SCALE : 1.0f) / (WDN_SCALE * ACT_SCALE)};
            pg8::gemm_phase<pg8::EpiDN, pg8::MoeOrder, true, false, true>(ring, g, S, E);
            if constexpr (layer == 0) { __syncthreads(); bg_convert<3>(a, F, F.vcu - (16 * 9 * 4) % 256); } }
#else
        REPS if (IN()) { PHB pg8::Gemm g{(const pg8::bf16_t*)(ws + WS_ACT), (const pg8::bf16_t*)(ws + WS_WDN) + (size_t)layer * 16 * 1024 * 2048, 0, 0, 2048, nullptr};
            pg8::MoeOrder S{npm, 4, F.G, F.vcu}; pg8::EpiDN E{(pg8::bf16_t*)(ws + WS_Y), (const float*)(ws + WS_GATE), 4, 1.0f};
            pg8::gemm_phase<pg8::EpiDN, pg8::MoeOrder, true, false, false>(ring, g, S, E); }
#endif
        SEAM();
        REPS if (IN()) { PHB phase_comb(a, F, layer, nrows); }
        SEAM();
    }
__global__ void __launch_bounds__(NTHR, 2) mk_fwd(Args a_) {
    extern __shared__ __attribute__((aligned(16))) unsigned char lds_raw[];
    Fr F0 = mkfr(lds_raw);
    volatile LAS unsigned* MISC = (volatile LAS unsigned*)(F0.lds + MISC_OFF);
    if (F0.tid < 32) MISC[F0.tid] = 0u;
    __syncthreads();
    if (a_.ph_hi - a_.ph_lo > 1) (void)xcd_barrier_post((unsigned*)(a_.ws + WS_CTL) + 4096, MISC + 8);
    int p = 0;
    PG8_LAS unsigned char* ring = (PG8_LAS unsigned char*)lds_raw;

    REPS if (IN()) { PHB phase_proA(a, F); }
    SEAM();
#if !MK_MERGE_PRO
    REPS if (IN()) { PHB phase_proB(a, F); }
    SEAM();
#endif
    layer_body<0>(p, lds_raw); layer_body<1>(p, lds_raw); layer_body<2>(p, lds_raw); layer_body<3>(p, lds_raw);
#undef IN
#undef PHB
#undef G1PTR
#undef SEAM
}

#ifndef MK_N_LAUNCHES
#define MK_N_LAUNCHES 0
#endif
extern "C" void kernel_launch(void* const* d_in, const int* in_sizes, int n_in, void* d_out, int out_size, void* d_ws, size_t ws_size, hipStream_t stream) {
    static int grid = 0;
    if (grid == 0) {
        if (n_in != 33 || out_size != T * D || ws_size < WS_END) { fprintf(stderr, "kernel_launch: expected 33 inputs, %d outputs, >= %zu bytes of workspace; got %d, %d, %zu\n", T * D, (size_t)WS_END, n_in, out_size, ws_size); grid = -1; return; }
        int dev = 0, cus = 0, per_cu = 0;
        if (hipGetDevice(&dev) != hipSuccess || hipDeviceGetAttribute(&cus, hipDeviceAttributeMultiprocessorCount, dev) != hipSuccess) { grid = -1; return; }
        if (hipFuncSetAttribute((const void*)mk_fwd, hipFuncAttributeMaxDynamicSharedMemorySize, LDS_BYTES) != hipSuccess) { fprintf(stderr, "kernel_launch: hipFuncSetAttribute failed\n"); grid = -1; return; }
        if (hipOccupancyMaxActiveBlocksPerMultiprocessor(&per_cu, (const void*)mk_fwd, NTHR, LDS_BYTES) != hipSuccess || per_cu < 1)
            fprintf(stderr, "kernel_launch: note: occupancy query reports %d workgroups per CU\n", per_cu);
        (void)hipGetLastError();
        grid = cus;
    }
    if (grid < 0) return;
    (void)hipMemsetAsync((char*)d_ws + WS_CTL, 0, 64 * 1024, stream);
    Args a{};
    for (int i = 0; i < 33; ++i) a.in[i] = (const float*)d_in[i];
    a.out = (float*)d_out; a.ws = (unsigned char*)d_ws;
#if MK_N_LAUNCHES == 1
    a.ph_lo = 0; a.ph_hi = N_PHASES;
    hipLaunchKernelGGL(mk_fwd, dim3(grid), dim3(NTHR), LDS_BYTES, stream, a);
#else
    for (int p = 0; p < N_PHASES; ++p) { a.ph_lo = p; a.ph_hi = p + 1; hipLaunchKernelGGL(mk_fwd, dim3(grid), dim3(NTHR), LDS_BYTES, stream, a); }
#endif
    const hipError_t le = hipPeekAtLastError();
    if (le != hipSuccess) fprintf(stderr, "kernel_launch: launch failed: %s\n", hipGetErrorName(le));
}
```

```cpp
#define MK_N_LAUNCHES 1
#define MK_FAST_ATTN 1
#define MK_FAST_CONV 1
#define MK_GATHER 1
#define MK_FAST_SP 1
#include <hip/hip_runtime.h>
#include <cstdio>
#include <cstdint>
#include <cmath>
namespace pg8 {
#define PG8_LAS __attribute__((address_space(3)))
typedef unsigned short bf16_t;
typedef short bf16x8 __attribute__((ext_vector_type(8)));
typedef float f32x4 __attribute__((ext_vector_type(4)));
typedef unsigned u32x4 __attribute__((ext_vector_type(4)));
typedef unsigned u32x2 __attribute__((ext_vector_type(2)));
constexpr int BM = 256, BK = 64, HALF = 128, HTB = HALF * BK * 2  , STAGE_BYTES = 8 * HTB, NXCD = 8, WGM = 8;

__host__ __device__ __forceinline__ int lds_byte(int r, int c) { const int st = (r >> 4) * 2 + (c >> 5), rr = r & 15, cc = c & 31, ob = rr * 64 + cc * 2; return st * 1024 + (ob ^ (((ob >> 9) & 1) << 5)); }
__host__ __device__ __forceinline__ void stage_rc(int b, int& R, int& C) { const int st = b / 1024, sb = b % 1024, swz = sb ^ (((sb >> 9) & 1) << 5); R = (st >> 1) * 16 + swz / 64; C = (st & 1) * 32 + (swz % 64) / 2; }
__host__ __device__ __forceinline__ int perm32(int rho) { const int n = rho >> 4, i = rho & 15; return 8 * (i >> 2) + 4 * n + (i & 3); }

struct Unit { int pm, pn; };
struct Gemm { const bf16_t* A; const bf16_t* Bt; int M, N, K; const int* rows; };

struct StaticOrder {
    int nM, nN, nwg, G, c;
    __host__ __device__ void init(int M, int N, int G_, int c_) { nM = M / BM; nN = N / BM; nwg = nM * nN; G = G_; c = c_; }
    __host__ __device__ bool next(int i, Unit& u) const {
        const long L = (long)i * G + c; if (L >= nwg) return false;
        int wgid = (int)L; { const int q = nwg / NXCD, r = nwg % NXCD, xcd = wgid % NXCD, off = wgid / NXCD; wgid = (xcd < r ? xcd * (q + 1) : r * (q + 1) + (xcd - r) * q) + off; }
        const int nig = WGM * nN, gid = wgid / nig, fm = gid * WGM, gsz = (nM - fm) < WGM ? (nM - fm) : WGM;
        u.pm = fm + ((wgid % nig) % gsz); u.pn = (wgid % nig) / gsz; return true;
    }
    __device__ __forceinline__ void a_ready(const Unit&) const {}
    __device__ __forceinline__ void done(const Unit&) const {}
};

__device__ __forceinline__ unsigned cvt_pk_bf16(float lo, float hi) { unsigned r; asm volatile("v_cvt_pk_bf16_f32 %0, %1, %2" : "=v"(r) : "v"(lo), "v"(hi)); return r; }
typedef float f32x2 __attribute__((ext_vector_type(2)));
__device__ __forceinline__ f32x2 gelu_pk(f32x2 v) {
    const f32x2 av = __builtin_elementwise_abs(v), d = av * 0.2316418882f + 1.0f;
    f32x2 t; t.x = __builtin_amdgcn_rcpf(d.x); t.y = __builtin_amdgcn_rcpf(d.y);
    f32x2 q = t * 0.5307027145f + (-0.7265760135f); q = q * t + 0.7107068705f; q = q * t + (-0.142248368f); q = q * t + 0.127414796f; q = q * t;
    const f32x2 s = (v * v) * (-0.72134752044f);
    f32x2 e; e.x = __builtin_amdgcn_exp2f(s.x); e.y = __builtin_amdgcn_exp2f(s.y);
    const f32x2 m = v * (q * e), r = v - m;
    f32x2 o; o.x = v.x < 0.f ? m.x : r.x; o.y = v.y < 0.f ? m.y : r.y; return o;
}

template <int ACT  > struct EpiBf16 {
    static constexpr bool PERM = true, AFTER_DRAIN = false; static_assert(ACT == 0 || ACT == 1, "EpiBf16: ACT is 0 (none) or 1 (gelu_pk)");
    bf16_t* O; int ldc; const float* bias; int split_cols; size_t split_stride; float scale0; float pre = 1.f;
    __device__ __forceinline__ void operator()(const f32x4 (&acc)[2][2][4][2], const Unit& u, int wr, int wc, int fr, int fq) const {
        const int row0 = u.pm * BM + wr * 64 + fr; int colt = u.pn * BM; bf16_t* base = O;
        float sc = 1.f; if (split_cols) { const int t = colt / split_cols; base += (size_t)t * split_stride; colt -= t * split_cols; if (t == 0) sc = scale0; }
        const int col0 = colt + wc * 32 + 8 * fq, bcol0 = u.pn * BM + wc * 32 + 8 * fq;
        f32x4 bv[2][2];
#pragma unroll
        for (int bj = 0; bj < 2; ++bj)
#pragma unroll
            for (int n = 0; n < 2; ++n) bv[bj][n] = bias ? *(const f32x4*)(bias + bcol0 + bj * HALF + 4 * n) : (f32x4){0.f, 0.f, 0.f, 0.f};
#pragma unroll
        for (int ai = 0; ai < 2; ++ai)
#pragma unroll
            for (int m = 0; m < 4; ++m) { bf16_t* rowp = base + (size_t)(row0 + ai * HALF + m * 16) * ldc + col0;
#pragma unroll
                for (int bj = 0; bj < 2; ++bj) { f32x4 v0 = acc[ai][bj][m][0] * pre + bv[bj][0], v1 = acc[ai][bj][m][1] * pre + bv[bj][1];
                    if (ACT == 1) { f32x2 a = gelu_pk((f32x2){v0[0], v0[1]}), b = gelu_pk((f32x2){v0[2], v0[3]}), c = gelu_pk((f32x2){v1[0], v1[1]}), d = gelu_pk((f32x2){v1[2], v1[3]});
                        v0 = (f32x4){a.x, a.y, b.x, b.y}; v1 = (f32x4){c.x, c.y, d.x, d.y}; }
                    v0 = v0 * sc; v1 = v1 * sc; u32x4 w; w.x = cvt_pk_bf16(v0[0], v0[1]); w.y = cvt_pk_bf16(v0[2], v0[3]); w.z = cvt_pk_bf16(v1[0], v1[1]); w.w = cvt_pk_bf16(v1[2], v1[3]);
                    *(u32x4*)(rowp + bj * HALF) = w; } }
    }
};

#ifndef MK_FP8_Y
#define MK_FP8_Y 1
#endif
struct EpiF32 {
    static constexpr bool PERM = false, AFTER_DRAIN = false;
    float* C; int ldc;
    __device__ __forceinline__ void operator()(const f32x4 (&acc)[2][2][4][2], const Unit& u, int wr, int wc, int fr, int fq) const {
        const int row0 = u.pm * BM + wr * 64 + fr, col0 = u.pn * BM + wc * 32 + 4 * fq;
#pragma unroll
        for (int ai = 0; ai < 2; ++ai)
#pragma unroll
            for (int m = 0; m < 4; ++m) { float* rowp = C + (size_t)(row0 + ai * HALF + m * 16) * ldc + col0;
#pragma unroll
                for (int bj = 0; bj < 2; ++bj)
#pragma unroll
                    for (int n = 0; n < 2; ++n) *(f32x4*)(rowp + bj * HALF + n * 16) = acc[ai][bj][m][n]; }
    }
};
struct EpiRes {
    static constexpr bool PERM = true, AFTER_DRAIN = false;
    const bf16_t* X; bf16_t* U; const float* g; int gstride; float alpha; float accs = 1.f;
    __device__ __forceinline__ void operator()(const f32x4 (&acc)[2][2][4][2], const Unit& u, int wr, int wc, int fr, int fq) const {
        const int row0 = u.pm * BM + wr * 64 + fr, col0 = u.pn * BM + wc * 32 + 8 * fq;
        const int rb = u.pm * BM; const int bidx = rb < 16384 ? (rb >> 12) : 4;
        const float* gp = g + (size_t)bidx * gstride + col0;
        f32x4 gv[2][2];
#pragma unroll
        for (int bj = 0; bj < 2; ++bj)
#pragma unroll
            for (int n = 0; n < 2; ++n) gv[bj][n] = *(const f32x4*)(gp + bj * HALF + 4 * n) * accs;
#pragma unroll
        for (int ai = 0; ai < 2; ++ai)
#pragma unroll
            for (int m = 0; m < 4; ++m) { const size_t off = (size_t)(row0 + ai * HALF + m * 16) * 1024 + col0;
#pragma unroll
                for (int bj = 0; bj < 2; ++bj) { const u32x4 xw = *(const u32x4*)(X + off + bj * HALF);
                    const f32x4 x0 = (f32x4){__builtin_bit_cast(float, xw.x << 16), __builtin_bit_cast(float, xw.x & 0xffff0000u), __builtin_bit_cast(float, xw.y << 16), __builtin_bit_cast(float, xw.y & 0xffff0000u)};
                    const f32x4 x1 = (f32x4){__builtin_bit_cast(float, xw.z << 16), __builtin_bit_cast(float, xw.z & 0xffff0000u), __builtin_bit_cast(float, xw.w << 16), __builtin_bit_cast(float, xw.w & 0xffff0000u)};
                    const f32x4 u0 = x0 * alpha + gv[bj][0] * acc[ai][bj][m][0], u1 = x1 * alpha + gv[bj][1] * acc[ai][bj][m][1];
                    u32x4 uw; uw.x = cvt_pk_bf16(u0[0], u0[1]); uw.y = cvt_pk_bf16(u0[2], u0[3]); uw.z = cvt_pk_bf16(u1[0], u1[1]); uw.w = cvt_pk_bf16(u1[2], u1[3]);
                    *(u32x4*)(U + off + bj * HALF) = uw; }
                asm volatile("" ::: "memory"); }
    }
};
struct EpiNull {
    static constexpr bool PERM = true, AFTER_DRAIN = false;
    __device__ __forceinline__ void operator()(const f32x4 (&acc)[2][2][4][2], const Unit& u, int wr, int wc, int fr, int fq) const {
        f32x4 s = (f32x4){0.f, 0.f, 0.f, 0.f};
#pragma unroll
        for (int ai = 0; ai < 2; ++ai)
#pragma unroll
            for (int bj = 0; bj < 2; ++bj)
#pragma unroll
                for (int m = 0; m < 4; ++m)
#pragma unroll
                    for (int n = 0; n < 2; ++n) s += acc[ai][bj][m][n];
        asm volatile("" :: "v"(s));
    }
};
struct EpiGUnostore {
    static constexpr bool PERM = true, AFTER_DRAIN = false;
    __device__ __forceinline__ void operator()(const f32x4 (&acc)[2][2][4][2], const Unit& u, int wr, int wc, int fr, int fq) const {
#pragma unroll
        for (int ai = 0; ai < 2; ++ai)
#pragma unroll
            for (int m = 0; m < 4; ++m) { float o[8];
#pragma unroll
                for (int n = 0; n < 2; ++n)
#pragma unroll
                    for (int j = 0; j < 4; ++j) { const float a = acc[ai][0][m][n][j], b = acc[ai][1][m][n][j];
                        const float s = a * __builtin_amdgcn_rcpf(1.0f + __builtin_amdgcn_exp2f(-1.4426950408889634f * a)); o[n * 4 + j] = s * b; }
                u32x4 w; w.x = cvt_pk_bf16(o[0], o[1]); w.y = cvt_pk_bf16(o[2], o[3]); w.z = cvt_pk_bf16(o[4], o[5]); w.w = cvt_pk_bf16(o[6], o[7]);
                asm volatile("" :: "v"(w)); }
    }
};
struct EpiGU {
    static constexpr bool PERM = true, AFTER_DRAIN = false;
    bf16_t* ACT; int npn;
    __device__ __forceinline__ void operator()(const f32x4 (&acc)[2][2][4][2], const Unit& u, int wr, int wc, int fr, int fq) const {
        const int row0 = u.pm * BM + wr * 64 + fr; const int col0 = (u.pn % npn) * 128 + wc * 32 + 8 * fq;
#pragma unroll
        for (int ai = 0; ai < 2; ++ai)
#pragma unroll
            for (int m = 0; m < 4; ++m) { bf16_t* rowp = ACT + (size_t)(row0 + ai * HALF + m * 16) * 2048 + col0;
                float o[8];
#pragma unroll
                for (int n = 0; n < 2; ++n)
#pragma unroll
                    for (int j = 0; j < 4; ++j) { const float a = acc[ai][0][m][n][j], b = acc[ai][1][m][n][j];
                        const float s = a * __builtin_amdgcn_rcpf(1.0f + __builtin_amdgcn_exp2f(-1.4426950408889634f * a)); o[n * 4 + j] = s * b; }
                u32x4 w; w.x = cvt_pk_bf16(o[0], o[1]); w.y = cvt_pk_bf16(o[2], o[3]); w.z = cvt_pk_bf16(o[4], o[5]); w.w = cvt_pk_bf16(o[6], o[7]);
                *(u32x4*)rowp = w; }
    }
};
template <bool OUT8> struct EpiGU8 {
    static constexpr bool PERM = true, AFTER_DRAIN = false;
    unsigned char* ACT; int npn; float inscale, outscale;
    __device__ __forceinline__ void operator()(const f32x4 (&acc)[2][2][4][2], const Unit& u, int wr, int wc, int fr, int fq) const {
        const int row0 = u.pm * BM + wr * 64 + fr; const int col0 = (u.pn % npn) * 128 + wc * 32 + 8 * fq;
        const float ka = -1.4426950408889634f * inscale, kb = inscale * inscale * outscale;
#pragma unroll
        for (int ai = 0; ai < 2; ++ai)
#pragma unroll
            for (int m = 0; m < 4; ++m) { unsigned char* rowp = ACT + ((size_t)(row0 + ai * HALF + m * 16) * 2048 + col0) * (OUT8 ? 1 : 2);
                float o[8];
#pragma unroll
                for (int n = 0; n < 2; ++n)
#pragma unroll
                    for (int j = 0; j < 4; ++j) { const float a = acc[ai][0][m][n][j], b = acc[ai][1][m][n][j];
                        o[n * 4 + j] = a * __builtin_amdgcn_rcpf(1.0f + __builtin_amdgcn_exp2f(ka * a)) * (b * kb); }
                if constexpr (OUT8) {
#pragma unroll
                    for (int q = 0; q < 8; ++q) o[q] = __builtin_amdgcn_fmed3f(o[q], -448.0f, 448.0f);
                    unsigned w0 = 0u, w1 = 0u;
                    w0 = __builtin_amdgcn_cvt_pk_fp8_f32(o[0], o[1], w0, false); w0 = __builtin_amdgcn_cvt_pk_fp8_f32(o[2], o[3], w0, true);
                    w1 = __builtin_amdgcn_cvt_pk_fp8_f32(o[4], o[5], w1, false); w1 = __builtin_amdgcn_cvt_pk_fp8_f32(o[6], o[7], w1, true);
                    typedef unsigned u32x2_ __attribute__((ext_vector_type(2)));
                    *(u32x2_*)rowp = (u32x2_){w0, w1}; }
                else { u32x4 w; w.x = cvt_pk_bf16(o[0], o[1]); w.y = cvt_pk_bf16(o[2], o[3]); w.z = cvt_pk_bf16(o[4], o[5]); w.w = cvt_pk_bf16(o[6], o[7]); *(u32x4*)rowp = w; } }
    }
};
struct EpiDN {
    static constexpr bool PERM = true, AFTER_DRAIN = false;
    bf16_t* Y; const float* gate; int npn; float scale;
    __device__ __forceinline__ void operator()(const f32x4 (&acc)[2][2][4][2], const Unit& u, int wr, int wc, int fr, int fq) const {
        const int row0 = u.pm * BM + wr * 64 + fr, col0 = (u.pn % npn) * BM + wc * 32 + 8 * fq;
#pragma unroll
        for (int ai = 0; ai < 2; ++ai)
#pragma unroll
            for (int m = 0; m < 4; ++m) { const int row = row0 + ai * HALF + m * 16; const float gt = gate[row] * scale; bf16_t* rowp = Y + (size_t)row * 1024 + col0;
#pragma unroll
                for (int bj = 0; bj < 2; ++bj) { const f32x4 v0 = acc[ai][bj][m][0] * gt, v1 = acc[ai][bj][m][1] * gt;
#if MK_FP8_Y
                    unsigned w0 = 0u, w1 = 0u;
                    w0 = __builtin_amdgcn_cvt_pk_fp8_f32(__builtin_amdgcn_fmed3f(v0[0], -448.0f, 448.0f), __builtin_amdgcn_fmed3f(v0[1], -448.0f, 448.0f), w0, false);
                    w0 = __builtin_amdgcn_cvt_pk_fp8_f32(__builtin_amdgcn_fmed3f(v0[2], -448.0f, 448.0f), __builtin_amdgcn_fmed3f(v0[3], -448.0f, 448.0f), w0, true);
                    w1 = __builtin_amdgcn_cvt_pk_fp8_f32(__builtin_amdgcn_fmed3f(v1[0], -448.0f, 448.0f), __builtin_amdgcn_fmed3f(v1[1], -448.0f, 448.0f), w1, false);
                    w1 = __builtin_amdgcn_cvt_pk_fp8_f32(__builtin_amdgcn_fmed3f(v1[2], -448.0f, 448.0f), __builtin_amdgcn_fmed3f(v1[3], -448.0f, 448.0f), w1, true);
                    *(u32x2*)((unsigned char*)Y + (size_t)row * 1024 + col0 + bj * HALF) = (u32x2){w0, w1}; } }
#else
                    u32x4 w; w.x = cvt_pk_bf16(v0[0], v0[1]); w.y = cvt_pk_bf16(v0[2], v0[3]); w.z = cvt_pk_bf16(v1[0], v1[1]); w.w = cvt_pk_bf16(v1[2], v1[3]);
                    *(u32x4*)(rowp + bj * HALF) = w; } }
#endif
    }
};
struct EpiVT {
    static constexpr bool PERM = false, AFTER_DRAIN = false;
    bf16_t* VT; int ldc; f32x2* VST; int ntok; float pre = 1.f;
    __device__ __forceinline__ void operator()(const f32x4 (&acc)[2][2][4][2], const Unit& u, int wr, int wc, int fr, int fq) const {
        const int row0 = u.pm * BM + wr * 64 + fr, col0 = u.pn * BM + wc * 32 + 4 * fq;
        f32x4 s1[2][2], s2[2][2];
#pragma unroll
        for (int bj = 0; bj < 2; ++bj)
#pragma unroll
            for (int n = 0; n < 2; ++n) { s1[bj][n] = (f32x4){0.f, 0.f, 0.f, 0.f}; s2[bj][n] = (f32x4){0.f, 0.f, 0.f, 0.f}; }
#pragma unroll
        for (int ai = 0; ai < 2; ++ai)
#pragma unroll
            for (int m = 0; m < 4; ++m) { bf16_t* rowp = VT + (size_t)(row0 + ai * HALF + m * 16) * ldc + col0;
#pragma unroll
                for (int bj = 0; bj < 2; ++bj)
#pragma unroll
                    for (int n = 0; n < 2; ++n) { const f32x4 v = acc[ai][bj][m][n] * pre; const f32x2 a = gelu_pk((f32x2){v[0], v[1]}), b = gelu_pk((f32x2){v[2], v[3]});
                        const f32x4 gl = (f32x4){a.x, a.y, b.x, b.y}; { u32x2 gw; gw.x = cvt_pk_bf16(gl[0], gl[1]); gw.y = cvt_pk_bf16(gl[2], gl[3]); *(u32x2*)(rowp + bj * HALF + n * 16) = gw; } s1[bj][n] += gl; s2[bj][n] += gl * gl; } }
#pragma unroll
        for (int bj = 0; bj < 2; ++bj)
#pragma unroll
            for (int n = 0; n < 2; ++n)
#pragma unroll
                for (int j = 0; j < 4; ++j) { float a = s1[bj][n][j], b = s2[bj][n][j];
#pragma unroll
                    for (int o = 1; o < 16; o <<= 1) { a += __shfl_xor(a, o); b += __shfl_xor(b, o); }
                    s1[bj][n][j] = a; s2[bj][n][j] = b; }
        if (fr == 0) {
            f32x2* dst = VST + (size_t)(u.pm * 2 + wr) * ntok + col0;
#pragma unroll
            for (int bj = 0; bj < 2; ++bj)
#pragma unroll
                for (int n = 0; n < 2; ++n)
#pragma unroll
                    for (int j = 0; j < 4; ++j) dst[bj * HALF + n * 16 + j] = (f32x2){s1[bj][n][j], s2[bj][n][j]};
        }
    }
};
struct MoeOrder {
    int nPM, nPN, G, vcu; int fixed = 0;
    __device__ __forceinline__ bool next(int i, Unit& u) const {
        const int L = i * G + vcu; if (L >= 16 * nPM * nPN) return false;
        const int pm = L % nPM, r = L / nPM, pn = r % nPN, e = r / nPN; u.pm = e * 9 + pm; u.pn = e * nPN + pn;
#if defined(MK_FIXEDUNIT)
        if (fixed) { u.pm = 0; u.pn = 0; }
#endif
        return true;
    }
    __device__ __forceinline__ void a_ready(const Unit&) const {}
    __device__ __forceinline__ void done(const Unit&) const {}
};

template <class Epi, class Sched, bool ALIGN_EPI = false, bool GATHER = false, bool FP8 = false>
__device__ __forceinline__ void gemm_phase(PG8_LAS unsigned char* lds, const Gemm g, const Sched& S, const Epi& E) {
    int tid_ = threadIdx.x; asm volatile("" : "+v"(tid_));
    const int tid = tid_, wid = __builtin_amdgcn_readfirstlane(tid >> 6), lane = tid & 63, wr = wid >> 2, wc = wid & 3, fr = lane & 15, fq = lane >> 4;
    const int K = g.K, nt = K / BK;
    unsigned voffA[2], voffB[2];
#pragma unroll
    for (int i = 0; i < 2; ++i) { int R, C; stage_rc(tid * 16 + i * 8192, R, C); const int Rb = Epi::PERM ? ((R & ~31) + perm32(R & 31)) : R;
        voffA[i] = (unsigned)(R * K + C) * 2u; voffB[i] = (unsigned)(Rb * K + C) * 2u; }
    const size_t kstep = (size_t)(BK * 2);
    const size_t hstep = (size_t)HALF * K * 2;
    const size_t tstep = 2 * hstep;
    const unsigned ldsw = (unsigned)wid * 1024u;
    const int aoff = lds_byte(wr * 64 + fr, fq * 8), boff = lds_byte(wc * 32 + fr, fq * 8);
#define PG8_SA(b, h) (((b) * 2 + (h)) * HTB)
#define PG8_SB(b, h) ((4 + (b) * 2 + (h)) * HTB)
#define PG8_STAGE(bufoff, gbase, voff) do { _Pragma("unroll") for (int _i = 0; _i < 2; ++_i) \
        __builtin_amdgcn_global_load_lds((const unsigned*)((const char*)(gbase) + (voff)[_i]), (PG8_LAS unsigned*)(lds + (bufoff) + ldsw + _i * 8192), 16, 0, 0); } while (0)
#define PG8_STGA(b, h, ubase, koff, gofs) do { if constexpr (GATHER) { PG8_STAGE(PG8_SA(b, h), (const char*)g.A + (koff), gofs[h]); } \
        else { PG8_STAGE(PG8_SA(b, h), (ubase) + (koff) + (size_t)(h) * hstep, voffA); } } while (0)
#define PG8_GLOAD(dst, u) do { if constexpr (GATHER) { _Pragma("unroll") for (int _i = 0; _i < 2; ++_i) { int _R, _C; stage_rc(tid * 16 + _i * 8192, _R, _C); \
        _Pragma("unroll") for (int _h = 0; _h < 2; ++_h) dst[_h][_i] = (unsigned)g.rows[(u).pm * BM + _h * HALF + _R] * (unsigned)(K * 2) + (unsigned)_C * 2u; } } } while (0)
#define PG8_LDA(dst, b, h) do { _Pragma("unroll") for (int m = 0; m < 4; ++m) _Pragma("unroll") for (int k = 0; k < 2; ++k) dst[m][k] = *(const PG8_LAS bf16x8*)(lds + PG8_SA(b, h) + aoff + m * 2048 + k * 1024); } while (0)
#define PG8_LDB(dst, b, h) do { _Pragma("unroll") for (int n = 0; n < 2; ++n) _Pragma("unroll") for (int k = 0; k < 2; ++k) dst[n][k] = *(const PG8_LAS bf16x8*)(lds + PG8_SB(b, h) + boff + n * 2048 + k * 1024); } while (0)
#define PG8_CAT8(x0, x1) __builtin_shufflevector(__builtin_bit_cast(v4i_t, x0), __builtin_bit_cast(v4i_t, x1), 0, 1, 2, 3, 4, 5, 6, 7)
#define PG8_MMA(ai, bj, At, Bt) do { __builtin_amdgcn_s_setprio(1); _Pragma("unroll") for (int m = 0; m < 4; ++m) _Pragma("unroll") for (int n = 0; n < 2; ++n) { \
        if constexpr (FP8) { asm volatile("v_mfma_scale_f32_16x16x128_f8f6f4 %0, %1, %2, %0, %3, %3 op_sel_hi:[0,0,0]" : "+v"(acc[ai][bj][m][n]) : "v"(PG8_CAT8(Bt[n][0], Bt[n][1])), "v"(PG8_CAT8(At[m][0], At[m][1])), "v"(0x7F7F7F7F)); } \
        else { _Pragma("unroll") for (int k = 0; k < 2; ++k) acc[ai][bj][m][n] = __builtin_amdgcn_mfma_f32_16x16x32_bf16(Bt[n][k], At[m][k], acc[ai][bj][m][n], 0, 0, 0); } } \
        __builtin_amdgcn_s_setprio(0); } while (0)
#define PG8_WAIT_V(n) asm volatile("s_waitcnt vmcnt(" #n ")" ::: "memory")
#define PG8_WAIT_L(n) asm volatile("s_waitcnt lgkmcnt(" #n ")" ::: "memory")
#define PG8_BAR __builtin_amdgcn_s_barrier()
#define PG8_SCHED __builtin_amdgcn_sched_barrier(0)
    Unit cur, nxt; int ui = 0;
    if (!S.next(0, cur)) return;
    f32x4 acc[2][2][4][2];
#pragma unroll
    for (int a = 0; a < 2; ++a)
#pragma unroll
        for (int b = 0; b < 2; ++b)
#pragma unroll
            for (int m = 0; m < 4; ++m)
#pragma unroll
                for (int n = 0; n < 2; ++n) acc[a][b][m][n] = (f32x4){0.f, 0.f, 0.f, 0.f};
    bf16x8 At[4][2], B0[2][2], B1[2][2];
    typedef int v8i_t __attribute__((ext_vector_type(8))); typedef int v4i_t __attribute__((ext_vector_type(4)));
    unsigned gc[2][2] = {{0u, 0u}, {0u, 0u}}, gn[2][2] = {{0u, 0u}, {0u, 0u}};
    const char* cA = GATHER ? (const char*)g.A : (const char*)g.A + (size_t)cur.pm * tstep; const char* cB = (const char*)g.Bt + (size_t)cur.pn * tstep;
    S.a_ready(cur);
    PG8_GLOAD(gc, cur);
    PG8_STAGE(PG8_SB(0, 0), cB, voffB); PG8_STAGE(PG8_SB(0, 1), cB + hstep, voffB); PG8_STGA(0, 0, cA, 0, gc); PG8_STGA(0, 1, cA, 0, gc);
    if (wr == 1) PG8_BAR;
    PG8_WAIT_V(2); PG8_BAR;
    PG8_STAGE(PG8_SB(1, 0), cB + kstep, voffB); PG8_STGA(1, 0, cA, kstep, gc); PG8_STAGE(PG8_SB(1, 1), cB + hstep + kstep, voffB);
    PG8_WAIT_V(6); PG8_BAR;
    for (;;) {
        const bool has_next = S.next(ui + 1, nxt);
        const char* nA = GATHER ? (const char*)g.A : (has_next ? (const char*)g.A + (size_t)nxt.pm * tstep : cA); const char* nB = has_next ? (const char*)g.Bt + (size_t)nxt.pn * tstep : cB;
#pragma unroll 1
        for (int t = 0; t < nt; t += 2) {
            const bool last = (t == nt - 2);
            const size_t k1 = (size_t)(t + 1) * kstep;
            const char* b2 = last ? nB : cB + (size_t)(t + 2) * kstep; const char* b3 = b2 + kstep;
            if (last && has_next) S.a_ready(nxt);
            if (last) { if (has_next) { PG8_GLOAD(gn, nxt); } else {
#pragma unroll
                    for (int h = 0; h < 2; ++h)
#pragma unroll
                        for (int i = 0; i < 2; ++i) gn[h][i] = gc[h][i]; } }
            PG8_LDB(B0, 0, 0); PG8_LDB(B1, 0, 1); PG8_SCHED; PG8_LDA(At, 0, 0); PG8_STGA(1, 1, cA, k1, gc);
            PG8_WAIT_V(8); PG8_WAIT_L(0); PG8_BAR; PG8_MMA(0, 0, At, B0); PG8_MMA(0, 1, At, B1); PG8_BAR; PG8_SCHED;
            PG8_LDA(At, 0, 1); PG8_STAGE(PG8_SB(0, 0), b2, voffB); PG8_STAGE(PG8_SB(0, 1), b2 + hstep, voffB);
            if (last) { PG8_STGA(0, 0, nA, 0, gn); } else { PG8_STGA(0, 0, cA, (size_t)(t + 2) * kstep, gc); }
            PG8_WAIT_V(8); PG8_WAIT_L(0); PG8_BAR; PG8_MMA(1, 0, At, B0); PG8_MMA(1, 1, At, B1); PG8_BAR; PG8_SCHED;
            PG8_LDB(B0, 1, 0); PG8_LDB(B1, 1, 1); PG8_SCHED; PG8_LDA(At, 1, 0);
            if (last) { PG8_STGA(0, 1, nA, 0, gn); } else { PG8_STGA(0, 1, cA, (size_t)(t + 2) * kstep, gc); }
            PG8_WAIT_V(8); PG8_WAIT_L(0); PG8_BAR; PG8_MMA(0, 0, At, B0); PG8_MMA(0, 1, At, B1); PG8_BAR; PG8_SCHED;
            PG8_LDA(At, 1, 1); PG8_STAGE(PG8_SB(1, 0), b3, voffB); PG8_STAGE(PG8_SB(1, 1), b3 + hstep, voffB);
            if (last) { PG8_STGA(1, 0, nA, kstep, gn); } else { PG8_STGA(1, 0, cA, (size_t)(t + 3) * kstep, gc); }
            PG8_WAIT_V(8); PG8_WAIT_L(0); PG8_BAR; PG8_MMA(1, 0, At, B0); PG8_MMA(1, 1, At, B1); PG8_BAR; PG8_SCHED;
        }
        if constexpr (ALIGN_EPI) { if (wr == 0) PG8_BAR; }
        if constexpr (FP8) asm volatile("s_nop 15\n\ts_nop 15" ::: "memory");
        if constexpr (!Epi::AFTER_DRAIN) { E(acc, cur, wr, wc, fr, fq); S.done(cur); }
        if (!has_next) break;
#pragma unroll
        for (int a = 0; a < 2; ++a)
#pragma unroll
            for (int b = 0; b < 2; ++b)
#pragma unroll
                for (int m = 0; m < 4; ++m)
#pragma unroll
                    for (int n = 0; n < 2; ++n) acc[a][b][m][n] = (f32x4){0.f, 0.f, 0.f, 0.f};
        if constexpr (FP8) asm volatile("s_nop 7" ::: "memory");
        cur = nxt; cA = nA; cB = nB; ++ui;
#pragma unroll
        for (int h = 0; h < 2; ++h)
#pragma unroll
            for (int i = 0; i < 2; ++i) gc[h][i] = gn[h][i];
        if constexpr (ALIGN_EPI) { if (wr == 1) PG8_BAR; }
    }
    PG8_WAIT_V(0);
    if constexpr (!ALIGN_EPI) { if (wr == 0) PG8_BAR; }
    PG8_BAR;
    if constexpr (Epi::AFTER_DRAIN) { E.fused(acc, cur, wr, wc, fr, fq, lds, wid, lane); S.done(cur); }
#undef PG8_SA
#undef PG8_SB
#undef PG8_STAGE
#undef PG8_STGA
#undef PG8_GLOAD
#undef PG8_LDA
#undef PG8_LDB
#undef PG8_MMA
#undef PG8_CAT8
#undef PG8_WAIT_V
#undef PG8_WAIT_L
#undef PG8_BAR
#undef PG8_SCHED
}
}
constexpr int NB = 4, SEQ = 4096, T = NB * SEQ, LC = 256, TC = NB * LC, TA = T + TC, D = 1024;
constexpr int NE = 16, FF = 2048, ESTR = 2304;
constexpr int LK = LC + SEQ, KVP = 256;
constexpr float ALPHA = 1.6817928305074290f;
constexpr float LN_EPS = 1e-5f, RMS_EPS = 1e-6f;
constexpr float ATT_C2 = 0.125f * 1.4426950408889634f;
constexpr int NWAVES = 8, NTHR = 512;
constexpr size_t MiB = 1u << 20;
constexpr size_t WS_CTL = 0, WS_MOD = 1 * MiB, WS_MODP = 2 * MiB, WS_TW = 6 * MiB;
constexpr size_t WS_WHYIN = 8 * MiB, WS_WHYOUT = 20 * MiB, WS_WQKV = 24 * MiB, WS_WATO = 27 * MiB, WS_WCMIN = 29 * MiB, WS_WCMOUT = 37 * MiB, WS_WCMS = 41 * MiB;
constexpr size_t WS_WGU = 42 * MiB, WS_WDN = 554 * MiB, WS_HF = 810 * MiB;
constexpr size_t WS_XL = 942 * MiB, WS_U = 1010 * MiB, WS_HB = 1078 * MiB, WS_AFF = 1112 * MiB, WS_ROWS = 1114 * MiB, WS_GATE = WS_ROWS + 256 * 1024, WS_INV = 1115 * MiB;
constexpr size_t WS_ACT = 1117 * MiB, WS_Y = 1261 * MiB, WS_SCR = 1405 * MiB, WS_XC = 1677 * MiB, WS_END = 1745 * MiB;
constexpr size_t WS_XG = WS_Y;
constexpr size_t SC_PT = WS_SCR, SC_Z2T = WS_SCR + 204 * MiB, SC_Z2 = WS_SCR + 238 * MiB;
constexpr size_t SC_QKV = WS_SCR, SC_Q = WS_SCR + 102 * MiB, SC_K = WS_SCR + 134 * MiB, SC_V = WS_SCR + 143 * MiB, SC_O = WS_SCR + 152 * MiB;
constexpr size_t SC_UB = WS_SCR, SC_VT = WS_SCR + 64 * MiB, SC_VST = WS_SCR + 192 * MiB, SC_UV = WS_SCR + 194 * MiB;
constexpr size_t HF_SLOT = (size_t)4 * 1024 * 4096 * 4, HF_CTX = 2 * HF_SLOT;
constexpr int LDS_BYTES = 147456;
constexpr int RING_BYTES = 131072, MISC_OFF = LDS_BYTES - 256;

#define GAS __attribute__((address_space(1)))
#define LAS __attribute__((address_space(3)))
typedef unsigned short bf16;
typedef unsigned v4u __attribute__((ext_vector_type(4)));
typedef unsigned v2u __attribute__((ext_vector_type(2)));
typedef float f32x4 __attribute__((ext_vector_type(4)));
typedef float f32x2 __attribute__((ext_vector_type(2)));
#define LDS_WAIT() asm volatile("s_waitcnt lgkmcnt(0)" ::: "memory")
__device__ __forceinline__ unsigned f2bf(float f) { unsigned u = __builtin_bit_cast(unsigned, f); return (u + 0x7fffu + ((u >> 16) & 1u)) >> 16; }
__device__ __forceinline__ unsigned pk2(float lo, float hi) { unsigned r; asm("v_cvt_pk_bf16_f32 %0, %1, %2" : "=v"(r) : "v"(lo), "v"(hi)); return r; }
__device__ __forceinline__ unsigned pk4_e4m3(f32x4 h) { unsigned o8 = 0u;
    o8 = __builtin_amdgcn_cvt_pk_fp8_f32(__builtin_amdgcn_fmed3f(h[0], -448.0f, 448.0f), __builtin_amdgcn_fmed3f(h[1], -448.0f, 448.0f), o8, false);
    o8 = __builtin_amdgcn_cvt_pk_fp8_f32(__builtin_amdgcn_fmed3f(h[2], -448.0f, 448.0f), __builtin_amdgcn_fmed3f(h[3], -448.0f, 448.0f), o8, true); return o8; }
__device__ __forceinline__ f32x4 up4(v2u w) { return (f32x4){__builtin_bit_cast(float, w.x << 16), __builtin_bit_cast(float, w.x & 0xffff0000u), __builtin_bit_cast(float, w.y << 16), __builtin_bit_cast(float, w.y & 0xffff0000u)}; }
__device__ __forceinline__ float bf2f(unsigned short b) { return __builtin_bit_cast(float, (unsigned)b << 16); }
__device__ __forceinline__ float wave_sum(float v) {
#pragma unroll
    for (int o = 1; o < 64; o <<= 1) v += __shfl_xor(v, o);
    return v;
}

#ifndef MK_FP8_HYIN
#define MK_FP8_HYIN 1
#endif
constexpr float WH_SCALE = 64.0f;
#ifndef MK_FP8_CMIN
#define MK_FP8_CMIN 0
#endif
#ifndef MK_FP8_CMV
#define MK_FP8_CMV 0
#endif
constexpr size_t WS_HB8B = 943 * (1ull << 20);
#ifndef MK_FP8_HYOUT
#define MK_FP8_HYOUT 1
#endif
constexpr float Z_SCALE = 8.0f;
#ifndef MK_FP8_AOUT
#define MK_FP8_AOUT 1
#endif
constexpr float O_SCALE = 16.0f;
#ifndef MK_FP8_CMOUT
#define MK_FP8_CMOUT 0
#endif
constexpr float Y_SCALE = 64.0f;
#ifndef MK_FP8_QKV
#define MK_FP8_QKV 1
#endif
#ifndef MK_LNR_WREG
#define MK_LNR_WREG 0
#endif
#ifndef MK_MERGE_PRO
#define MK_MERGE_PRO 0
#endif
#ifndef MK_FOLLOW_L1INV
#define MK_FOLLOW_L1INV 0
#endif
#ifndef MK_EARLY_WB
#define MK_EARLY_WB 0
#endif
#define XB_TMO      128
#define XB_XCNT(j)  (256  + 64 * (j))
#define XB_XSUB(j)  (1280 + 64 * (j))
#define XB_XGEN(j)  (2304 + 64 * (j))
#define XB_TOP      3328
#define XB_TOPGEN   3392
#define XCD_BAR_WORDS 3456
#define XB_SPIN_CAP (1u << 18)
__device__ __forceinline__ unsigned xb_ld(unsigned* p)              { return __hip_atomic_load(p, __ATOMIC_RELAXED, __HIP_MEMORY_SCOPE_AGENT); }
__device__ __forceinline__ unsigned xb_add(unsigned* p, unsigned v) { return __hip_atomic_fetch_add(p, v, __ATOMIC_RELAXED, __HIP_MEMORY_SCOPE_AGENT); }
__device__ __forceinline__ unsigned xb_xcc_id() { return (unsigned)__builtin_amdgcn_s_getreg((3 << 11) | 20) & 0xFu; }
#define XB_SPIN(cond, bar) do { unsigned _sp = 0; while (cond) { __builtin_amdgcn_s_sleep(1); \
    if ((++_sp & 255u) == 0u) { if (xb_ld(&(bar)[XB_TMO])) break; if (_sp > XB_SPIN_CAP) { atomicAdd(&(bar)[XB_TMO], 1u); break; } } } } while (0)
struct XcdBarrier { unsigned* bar; unsigned x; volatile LAS unsigned* st; };
__device__ __forceinline__ XcdBarrier xcd_barrier_post(unsigned* bar, volatile LAS unsigned* st) {
    XcdBarrier b; b.bar = bar; b.x = xb_xcc_id(); b.st = st;
    if (threadIdx.x == 0) (void)xb_add(&bar[XB_XCNT(b.x)], 1u);
    return b;
}
__device__ __forceinline__ void xcd_barrier_complete(unsigned* bar, unsigned x, unsigned& nloc, unsigned& nx) {
    const unsigned G = gridDim.x * gridDim.y * gridDim.z;
    unsigned sum, cnt, mine, sp = 0u;
    for (;;) {
        sum = 0u; cnt = 0u; mine = 0u;
#pragma unroll
        for (unsigned j = 0; j < 16; ++j) { const unsigned c = xb_ld(&bar[XB_XCNT(j)]); sum += c; cnt += (c > 0u) ? 1u : 0u; mine = (j == x) ? c : mine; }
        if (sum == G) break;
        __builtin_amdgcn_s_sleep(1);
        if ((++sp & 255u) == 0u) { if (xb_ld(&bar[XB_TMO])) break; if (sp > XB_SPIN_CAP) { atomicAdd(&bar[XB_TMO], 1u); break; } }
    }
    nloc = mine > 0u ? mine : 1u; nx = cnt > 0u ? cnt : 1u;
}
__device__ __forceinline__ void xcd_barrier(const XcdBarrier& b) {
    asm volatile("s_waitcnt vmcnt(0)" ::: "memory");
    __syncthreads();
    if (threadIdx.x == 0) {
        unsigned* bar = b.bar; asm volatile("" : "+s"(bar));
        __builtin_amdgcn_s_waitcnt(0);
        unsigned bx_ = b.x; asm volatile("" : "+s"(bx_));
        unsigned nloc = b.st[0], nx = b.st[1];
        if (nloc == 0u) { xcd_barrier_complete(bar, bx_, nloc, nx); b.st[0] = nloc; b.st[1] = nx; }
#if MK_EARLY_WB
        asm volatile("buffer_wbl2 sc1" ::: "memory");
#endif
        const unsigned old = xb_add(&bar[XB_XSUB(bx_)], 1u);
        const unsigned gen = old / nloc;
        if (old + 1u == (gen + 1u) * nloc) {
            __builtin_amdgcn_fence(__ATOMIC_RELEASE, "agent");
            asm volatile("s_waitcnt vmcnt(0)" ::: "memory");
            const unsigned og = xb_add(&bar[XB_TOP], 1u);
            const unsigned tg = og / nx;
            if (og + 1u == (tg + 1u) * nx) xb_add(&bar[XB_TOPGEN], 1u);
            else XB_SPIN(xb_ld(&bar[XB_TOPGEN]) == tg, bar);
            __builtin_amdgcn_fence(__ATOMIC_ACQUIRE, "agent");
            xb_add(&bar[XB_XGEN(bx_)], 1u);
            asm volatile("s_waitcnt vmcnt(0)" ::: "memory");
        } else {
            XB_SPIN(xb_ld(&bar[XB_XGEN(bx_)]) == gen, bar);
#if MK_FOLLOW_L1INV
            asm volatile("buffer_inv sc0" ::: "memory");
#else
            __builtin_amdgcn_fence(__ATOMIC_ACQUIRE, "agent");
#endif
            asm volatile("s_waitcnt vmcnt(0)" ::: "memory");
        }
    }
    __syncthreads();
}

struct Args { const float* in[33]; float* out; unsigned char* ws; int ph_lo, ph_hi; };
enum { I_X = 0, I_C, I_CTX, I_CCTX, I_MODW, I_MODB, I_LNG, I_LNB, I_HYWIN, I_HYCW, I_HYCB, I_FW1, I_FB1, I_FW2, I_FB2, I_FW3, I_FFREQ, I_FBIAS, I_HYWOUT,
       I_WQKV, I_QGAIN, I_KGAIN, I_WATO, I_CMWIN, I_CMLNG, I_CMLNB, I_CMWS, I_CMBS, I_CMWOUT, I_ROUTER, I_WGATE, I_WUP, I_WDOWN };
typedef const __attribute__((address_space(4))) Args* ArgsP;
__device__ __forceinline__ ArgsP get_args() { auto p = __builtin_amdgcn_kernarg_segment_ptr(); asm volatile("" : "+s"(p)); return (ArgsP)p; }
struct Fr { LAS unsigned char* lds; int tid, lane, wave, vcu, G, bx; };
__device__ __forceinline__ Fr mkfr(unsigned char* lds_raw) {
    Fr F; int tid = threadIdx.x; asm volatile("" : "+v"(tid)); int bx = blockIdx.x, G = gridDim.x; asm volatile("" : "+s"(bx), "+s"(G));
    F.lds = (LAS unsigned char*)lds_raw; F.tid = tid; F.lane = tid & 63; F.wave = __builtin_amdgcn_readfirstlane(tid >> 6);
    F.G = G; F.bx = bx; F.vcu = (G % 8 == 0) ? (bx % 8) * (G / 8) + bx / 8 : bx; return F; }
__device__ __forceinline__ void proA_adaln_item(ArgsP a, const Fr& F, int it) {
    LAS float* sc = (LAS float*)F.lds;
    const int i = it / 96, ks = (it / 12) % 8, cc = it % 12;
    __syncthreads();
    for (int u = F.tid; u < 5 * 128; u += NTHR) { const int r = u / 128, k = ks * 128 + (u % 128);
        const float x = r < 4 ? a->in[I_C][r * D + k] : a->in[I_CCTX][k]; sc[u] = x / (1.0f + expf(-x)); }
    __syncthreads();
    const int col = cc * 512 + F.tid;
    const float* w = a->in[I_MODW] + ((size_t)i * D + (size_t)ks * 128) * 6144 + col;
    float acc[5] = {0.f, 0.f, 0.f, 0.f, 0.f};
#pragma unroll 8
    for (int k = 0; k < 128; ++k) { const float wv = w[(size_t)k * 6144];
#pragma unroll
        for (int r = 0; r < 5; ++r) acc[r] += sc[r * 128 + k] * wv; }
    float* mp = (float*)(a->ws + WS_MODP) + (size_t)((i * 8 + ks) * 5) * 6144 + col;
#pragma unroll
    for (int r = 0; r < 5; ++r) {
#if MK_MERGE_PRO
        asm volatile("global_store_dword %0, %1, off sc0 sc1" :: "v"(mp + (size_t)r * 6144), "v"(acc[r]) : "memory");
#else
        mp[(size_t)r * 6144] = acc[r];
#endif
    }
}
__device__ __forceinline__ void proA_filter_item(ArgsP a, const Fr& F, int it) {
    int slot, L, t0; float* HF;
    if (it < 512) { slot = it >> 8; L = SEQ; t0 = (it & 255) * 16; HF = (float*)(a->ws + WS_HF + (size_t)slot * HF_SLOT); }
    else { slot = 0; L = LC; t0 = (it - 512) * 16; HF = (float*)(a->ws + WS_HF + HF_CTX); }
    LAS float* z = (LAS float*)F.lds;
    LAS float* h1 = z + 16 * 33;
    LAS float* h2 = h1 + 16 * 64;
    LAS float* w1s = h2 + 16 * 64;
    LAS float* w2s = w1s + 33 * 64;
    __syncthreads();
    for (int u = F.tid; u < 33 * 64; u += NTHR) w1s[u] = a->in[I_FW1][(size_t)slot * 33 * 64 + u];
    for (int u = F.tid; u < 64 * 64; u += NTHR) w2s[u] = a->in[I_FW2][(size_t)slot * 64 * 64 + u];
    for (int u = F.tid; u < 16 * 33; u += NTHR) { const int tt = u / 33, j = u % 33; const float tf = (float)(t0 + tt);
        float v;
        if (j == 0) v = tf / (float)(L - 1);
        else { const int jj = (j - 1) & 15; const float f = 1e-4f + (float)jj * ((15.0f - 1e-4f) / 15.0f); const float w = (float)(6.283185307179586 / (double)L) * tf;
            v = j <= 16 ? cosf(f * w) : -sinf(f * w); }
        z[u] = v; }
    __syncthreads();
    const LAS float* w1 = w1s; const float* b1 = a->in[I_FB1] + slot * 64;
    const LAS float* w2 = w2s; const float* b2 = a->in[I_FB2] + slot * 64;
    const float* fq = a->in[I_FFREQ] + slot * 128;
    for (int u = F.tid; u < 16 * 64; u += NTHR) { const int tt = u >> 6, j = u & 63; float s = b1[j];
        for (int i = 0; i < 33; ++i) s += z[tt * 33 + i] * w1[i * 64 + j];
        h1[u] = sinf(fq[j] * s); }
    __syncthreads();
    for (int u = F.tid; u < 16 * 64; u += NTHR) { const int tt = u >> 6, j = u & 63; float s = b2[j];
        for (int i = 0; i < 64; ++i) s += h1[tt * 64 + i] * w2[i * 64 + j];
        h2[u] = sinf(fq[64 + j] * s); }
    __syncthreads();
    const float* w3 = a->in[I_FW3] + (size_t)slot * 64 * 4096;
    const float dmin = -3.0701134573253940f, dmax = -15.350567286626973f;
    const int lane = F.lane, lm = lane & 15, lk = lane >> 4;
    float af[16];
#pragma unroll
    for (int s = 0; s < 16; ++s) af[s] = h2[lm * 64 + 4 * s + lk];
    float tl[4];
#pragma unroll
    for (int j = 0; j < 4; ++j) tl[j] = (float)(t0 + 4 * lk + j) / (float)(L - 1);
#define FILT_LOAD(bA, bB, ct_) do { const int c0_ = (F.wave * 32 + (ct_)) * 16 + lm; _Pragma("unroll") for (int s = 0; s < 16; ++s) { bA[s] = w3[(size_t)(4 * s + lk) * 4096 + c0_]; bB[s] = w3[(size_t)(4 * s + lk) * 4096 + c0_ + 16]; } } while (0)
#define FILT_STEP(bA, bB, ct_) do { const int c0 = (F.wave * 32 + (ct_)) * 16 + lm, c1 = c0 + 16; f32x4 acc0 = {0.f, 0.f, 0.f, 0.f}, acc1 = {0.f, 0.f, 0.f, 0.f}; \
        _Pragma("unroll") for (int s = 0; s < 16; ++s) { acc0 = __builtin_amdgcn_mfma_f32_16x16x4f32(af[s], bA[s], acc0, 0, 0, 0); acc1 = __builtin_amdgcn_mfma_f32_16x16x4f32(af[s], bB[s], acc1, 0, 0, 0); } \
        { const float delta = fabsf(dmin + (float)(c0 & 1023) * ((dmax - dmin) / 1023.0f)); f32x4 o; _Pragma("unroll") for (int j = 0; j < 4; ++j) o[j] = acc0[j] * expf(-tl[j] * delta); *(f32x4*)(HF + (size_t)c0 * L + t0 + 4 * lk) = o; } \
        { const float delta = fabsf(dmin + (float)(c1 & 1023) * ((dmax - dmin) / 1023.0f)); f32x4 o; _Pragma("unroll") for (int j = 0; j < 4; ++j) o[j] = acc1[j] * expf(-tl[j] * delta); *(f32x4*)(HF + (size_t)c1 * L + t0 + 4 * lk) = o; } } while (0)
    float p0[16], p1[16], q0[16], q1[16];
    FILT_LOAD(p0, p1, 0);
    for (int ct = 0; ct < 32; ct += 4) {
        FILT_LOAD(q0, q1, ct + 2);
        FILT_STEP(p0, p1, ct);
        if (ct + 4 < 32) FILT_LOAD(p0, p1, ct + 4);
        FILT_STEP(q0, q1, ct + 2);
    }
#undef FILT_LOAD
#undef FILT_STEP
}
__device__ __forceinline__ void conv_tile(const float* W, int K, int N, int k0, int n0, bf16* WT, int drow0, LAS float* scr, int lane) {
    float rv[64];
#pragma unroll
    for (int i = 0; i < 64; ++i) rv[i] = W[(size_t)(k0 + i) * N + n0 + lane];
#pragma unroll
    for (int i = 0; i < 64; ++i) scr[i * 65 + lane] = rv[i];
    LDS_WAIT(); asm volatile("" ::: "memory");
    const int c = lane & 7;
#pragma unroll
    for (int j = 0; j < 8; ++j) { const int n = (lane >> 3) + 8 * j; const LAS float* s = scr + (8 * c) * 65 + n;
        v4u o; o.x = pk2(s[0 * 65], s[1 * 65]); o.y = pk2(s[2 * 65], s[3 * 65]); o.z = pk2(s[4 * 65], s[5 * 65]); o.w = pk2(s[6 * 65], s[7 * 65]);
        *(v4u*)(WT + (size_t)(drow0 + n) * K + k0 + 8 * c) = o; }
    LDS_WAIT(); asm volatile("" ::: "memory");
}
__device__ __forceinline__ void conv_tile8(const float* W, int K, int N, int k0, int n0, unsigned char* WT, int drow0, float scale, LAS float* scr, int lane) {
    float rv[64];
#pragma unroll
    for (int i = 0; i < 64; ++i) rv[i] = W[(size_t)(k0 + i) * N + n0 + lane];
#pragma unroll
    for (int i = 0; i < 64; ++i) scr[i * 65 + lane] = __builtin_amdgcn_fmed3f(rv[i] * scale, -448.0f, 448.0f);
    LDS_WAIT(); asm volatile("" ::: "memory");
    const int c = lane & 3;
#pragma unroll
    for (int j = 0; j < 4; ++j) { const int n = (lane >> 2) + 16 * j; const LAS float* s = scr + (16 * c) * 65 + n;
        unsigned w[4];
#pragma unroll
        for (int q = 0; q < 4; ++q) { unsigned x = 0u; x = __builtin_amdgcn_cvt_pk_fp8_f32(s[(4 * q) * 65], s[(4 * q + 1) * 65], x, false); x = __builtin_amdgcn_cvt_pk_fp8_f32(s[(4 * q + 2) * 65], s[(4 * q + 3) * 65], x, true); w[q] = x; }
        v4u o; o.x = w[0]; o.y = w[1]; o.z = w[2]; o.w = w[3];
        *(v4u*)(WT + (size_t)(drow0 + n) * K + k0 + 16 * c) = o; }
    LDS_WAIT(); asm volatile("" ::: "memory");
}
struct Cv8 { const float* src; unsigned char* dst; int N, K; float scale; };
__device__ __forceinline__ void conv8_load(const Cv8& d, float (&rv)[64], int lane) {
#pragma unroll
    for (int i = 0; i < 64; ++i) rv[i] = d.src[(size_t)i * d.N + lane];
}
__device__ __forceinline__ void conv8_store(const Cv8& d, const float (&rv)[64], LAS float* scr, int lane) {
#pragma unroll
    for (int i = 0; i < 64; ++i) scr[i * 65 + lane] = __builtin_amdgcn_fmed3f(rv[i] * d.scale, -448.0f, 448.0f);
    LDS_WAIT(); asm volatile("" ::: "memory");
    const int c = lane & 3;
#pragma unroll
    for (int j = 0; j < 4; ++j) { const int n = (lane >> 2) + 16 * j; const LAS float* s = scr + (16 * c) * 65 + n;
        unsigned w[4];
#pragma unroll
        for (int q = 0; q < 4; ++q) { unsigned x = 0u; x = __builtin_amdgcn_cvt_pk_fp8_f32(s[(4 * q) * 65], s[(4 * q + 1) * 65], x, false); x = __builtin_amdgcn_cvt_pk_fp8_f32(s[(4 * q + 2) * 65], s[(4 * q + 3) * 65], x, true); w[q] = x; }
        v4u o; o.x = w[0]; o.y = w[1]; o.z = w[2]; o.w = w[3];
        *(v4u*)(d.dst + (size_t)n * d.K + 16 * c) = o; }
    LDS_WAIT(); asm volatile("" ::: "memory");
}
#ifndef MK_CV_CHUNK
#define MK_CV_CHUNK 4
#endif
#ifndef MK_CV_ORDER
#define MK_CV_ORDER 0
#endif
#ifndef MK_CV_PIPE
#define MK_CV_PIPE 0
#endif
#ifndef MK_FP8_DN
#define MK_FP8_DN 1
#endif
constexpr float WGU_SCALE = 64.0f, WDN_SCALE = 128.0f, ACT_SCALE = 2.0f;
constexpr int CV_SMALL = 768 * 2 + 256 * 2 + 384 + 256 + 1024 + 512;
constexpr int CV_MOE = 4 * 16 * 3 * 512;
__device__ __forceinline__ void proA_conv_item(ArgsP a, int it, LAS float* scr, int lane) {
    unsigned char* ws = a->ws;
    if (it < CV_SMALL) {
        int r = it;
        if (r < 1536) { const int s = r / 768, q = r % 768, kb = q / 48, nb = q % 48;
#if MK_FP8_HYIN
            conv_tile8(a->in[I_HYWIN] + (size_t)s * 1024 * 3072, 1024, 3072, kb * 64, nb * 64, (unsigned char*)(ws + WS_WHYIN) + (size_t)s * 3072 * 1024, nb * 64, WH_SCALE, scr, lane); return; } r -= 1536;
#else
            conv_tile(a->in[I_HYWIN] + (size_t)s * 1024 * 3072, 1024, 3072, kb * 64, nb * 64, (bf16*)(ws + WS_WHYIN) + (size_t)s * 3072 * 1024, nb * 64, scr, lane); return; } r -= 1536;
#endif
        if (r < 512) { const int s = r / 256, q = r % 256, kb = q / 16, nb = q % 16;
#if MK_FP8_HYOUT
            conv_tile8(a->in[I_HYWOUT] + (size_t)s * 1024 * 1024, 1024, 1024, kb * 64, nb * 64, (unsigned char*)(ws + WS_WHYOUT) + (size_t)s * 1024 * 1024, nb * 64, WH_SCALE, scr, lane); return; } r -= 512;
#else
            conv_tile(a->in[I_HYWOUT] + (size_t)s * 1024 * 1024, 1024, 1024, kb * 64, nb * 64, (bf16*)(ws + WS_WHYOUT) + (size_t)s * 1024 * 1024, nb * 64, scr, lane); return; } r -= 512;
#endif
        if (r < 384) { const int kb = r / 24, nb = r % 24;
#if MK_FP8_QKV
            conv_tile8(a->in[I_WQKV], 1024, 1536, kb * 64, nb * 64, (unsigned char*)(ws + WS_WQKV), nb * 64, WH_SCALE, scr, lane); return; } r -= 384;
#else
            conv_tile(a->in[I_WQKV], 1024, 1536, kb * 64, nb * 64, (bf16*)(ws + WS_WQKV), nb * 64, scr, lane); return; } r -= 384;
#endif
        if (r < 256) { const int kb = r / 16, nb = r % 16;
#if MK_FP8_AOUT
            conv_tile8(a->in[I_WATO], 1024, 1024, kb * 64, nb * 64, (unsigned char*)(ws + WS_WATO), nb * 64, WH_SCALE, scr, lane); return; } r -= 256;
#else
            conv_tile(a->in[I_WATO], 1024, 1024, kb * 64, nb * 64, (bf16*)(ws + WS_WATO), nb * 64, scr, lane); return; } r -= 256;
#endif
        if (r < 1024) { const int kb = r / 64, nb = r % 64;
#if MK_FP8_CMIN
            conv_tile8(a->in[I_CMWIN], 1024, 4096, kb * 64, nb * 64, (unsigned char*)(ws + WS_WCMIN), nb * 64, WH_SCALE, scr, lane); return; } r -= 1024;
#elif MK_FP8_CMV
            if (nb >= 32) { conv_tile8(a->in[I_CMWIN], 1024, 4096, kb * 64, nb * 64, (unsigned char*)(ws + WS_WCMIN) + (size_t)2048 * 1024 * 2, (nb - 32) * 64, WH_SCALE, scr, lane); return; }
            conv_tile(a->in[I_CMWIN], 1024, 4096, kb * 64, nb * 64, (bf16*)(ws + WS_WCMIN), nb * 64, scr, lane); return; } r -= 1024;
#else
            conv_tile(a->in[I_CMWIN], 1024, 4096, kb * 64, nb * 64, (bf16*)(ws + WS_WCMIN), nb * 64, scr, lane); return; } r -= 1024;
#endif
        { const int kb = r / 16, nb = r % 16;
#if MK_FP8_CMOUT
            conv_tile8(a->in[I_CMWOUT], 2048, 1024, kb * 64, nb * 64, (unsigned char*)(ws + WS_WCMOUT), nb * 64, WH_SCALE, scr, lane); return; }
#else
            conv_tile(a->in[I_CMWOUT], 2048, 1024, kb * 64, nb * 64, (bf16*)(ws + WS_WCMOUT), nb * 64, scr, lane); return; }
#endif
    }
    const int r = it - CV_SMALL, mat = r / 512, q = r % 512, le = mat / 3, which = mat % 3;
    if (which < 2) { const int kb = MK_CV_ORDER ? (q >> 7) * 4 + (q & 3) : q / 32, nb = MK_CV_ORDER ? (q >> 2) & 31 : q % 32, n0 = nb * 64;
        const float* src = a->in[which == 0 ? I_WGATE : I_WUP] + (size_t)le * 1024 * 2048;
        conv_tile8(src, 1024, 2048, kb * 64, n0, (unsigned char*)(ws + WS_WGU) + (size_t)le * 4096 * 1024, (n0 >> 7) * 256 + (n0 & 127) + which * 128, WGU_SCALE, scr, lane); }
    else { const int kb = MK_CV_ORDER ? (q >> 6) * 4 + (q & 3) : q / 16, nb = MK_CV_ORDER ? (q >> 2) & 15 : q % 16;
#if MK_FP8_DN
        conv_tile8(a->in[I_WDOWN] + (size_t)le * 2048 * 1024, 2048, 1024, kb * 64, nb * 64, (unsigned char*)(ws + WS_WDN) + (size_t)le * 1024 * 2048, nb * 64, WDN_SCALE, scr, lane); }
#else
        conv_tile(a->in[I_WDOWN] + (size_t)le * 2048 * 1024, 2048, 1024, kb * 64, nb * 64, (bf16*)(ws + WS_WDN) + (size_t)le * 1024 * 2048, nb * 64, scr, lane); }
#endif
}
#if MK_FP8_DN
__device__ __forceinline__ Cv8 cv8_desc(ArgsP a, int it) {
    unsigned char* ws = a->ws;
    const int r = it - CV_SMALL, mat = r / 512, q = r % 512, le = mat / 3, which = mat % 3;
    Cv8 d;
    if (which < 2) { const int kb = MK_CV_ORDER ? (q >> 7) * 4 + (q & 3) : q / 32, nb = MK_CV_ORDER ? (q >> 2) & 31 : q % 32, n0 = nb * 64;
        d.src = a->in[which == 0 ? I_WGATE : I_WUP] + (size_t)le * 1024 * 2048 + (size_t)(kb * 64) * 2048 + n0; d.N = 2048; d.K = 1024; d.scale = WGU_SCALE;
        d.dst = (unsigned char*)(ws + WS_WGU) + (size_t)le * 4096 * 1024 + (size_t)((n0 >> 7) * 256 + (n0 & 127) + which * 128) * 1024 + kb * 64; }
    else { const int kb = MK_CV_ORDER ? (q >> 6) * 4 + (q & 3) : q / 16, nb = MK_CV_ORDER ? (q >> 2) & 15 : q % 16;
        d.src = a->in[I_WDOWN] + (size_t)le * 2048 * 1024 + (size_t)(kb * 64) * 1024 + nb * 64; d.N = 1024; d.K = 2048; d.scale = WDN_SCALE;
        d.dst = (unsigned char*)(ws + WS_WDN) + (size_t)le * 1024 * 2048 + (size_t)(nb * 64) * 2048 + kb * 64; }
    return d;
}
#endif
constexpr int CV_TOTAL = CV_SMALL + CV_MOE;
constexpr int BG_IDLE[7] = {208, 240, 128, 192, 104, 192, 192};
#ifndef MK_BG_TPW
#define MK_BG_TPW {4, 4, 2, 3, 3, 2, 2}
#endif
constexpr int BG_TPW[7] = MK_BG_TPW;
constexpr int bg_base(int w) { int s = 0; for (int i = 0; i < w; ++i) s += BG_IDLE[i] * 8 * BG_TPW[i]; return s; }
constexpr int CV_DEFER = bg_base(7);
static_assert(CV_DEFER <= 2 * 24576, "the deferred tiles must all belong to layers 2 and 3 (first needed by the layer-2 expert GEMMs; every window runs before that)");
template <int W> __device__ __forceinline__ void bg_convert(ArgsP a, const Fr& F, int rank) {
    if (F.G != 256 || rank < 0 || rank >= BG_IDLE[W]) return;
    LAS float* scr = (LAS float*)(F.lds + F.wave * 16640);
    constexpr int nw = BG_IDLE[W] * 8; const int widx = rank * 8 + F.wave;
#pragma unroll 1
    for (int k = 0; k < BG_TPW[W]; ++k) proA_conv_item(a, CV_TOTAL - CV_DEFER + bg_base(W) + k * nw + widx, scr, F.lane);
}
__device__ __forceinline__ void phase_proB(ArgsP a, const Fr& F);
__device__ __forceinline__ void phase_proA(ArgsP a, const Fr& F) {
    const int gt = F.vcu * NTHR + F.tid, NGT = F.G * NTHR;
    for (int k = gt; k < 8192; k += NGT) { float s, c; sincospif((float)k * (1.0f / 4096.0f), &s, &c); ((f32x2*)(a->ws + WS_TW))[k] = (f32x2){c, s}; }
    for (int k = gt; k < 16 * 128 * 128; k += NGT) ((bf16*)(a->ws + WS_WCMS))[k] = (bf16)f2bf(a->in[I_CMWS][k]);
    const int nbl = F.G >= 2 ? F.G / 2 : 1;
    if (F.vcu < nbl) { for (int it = F.vcu; it < 384 + 528; it += nbl) {
        if (it < 384) { proA_adaln_item(a, F, it);
#if MK_MERGE_PRO
            asm volatile("s_waitcnt vmcnt(0)" ::: "memory"); __syncthreads();
            if (F.tid == 0) (void)xb_add((unsigned*)(a->ws + WS_CTL) + 8256, 1u);
#endif
        } else proA_filter_item(a, F, it - 384); } }
    __syncthreads();
    LAS float* scr = (LAS float*)(F.lds + F.wave * 16640);
    unsigned* q = (unsigned*)(a->ws + WS_CTL) + 8192;
    const unsigned lim = (unsigned)(F.G == 256 ? CV_TOTAL - CV_DEFER : CV_TOTAL);
    for (;;) {
        unsigned i0 = 0u; if (F.lane == 0) i0 = __hip_atomic_fetch_add(q, (unsigned)MK_CV_CHUNK, __ATOMIC_RELAXED, __HIP_MEMORY_SCOPE_AGENT);
        i0 = (unsigned)__builtin_amdgcn_readfirstlane((int)i0);
        if (i0 >= lim) break;
#if MK_FP8_DN && MK_CV_PIPE
        if (MK_CV_CHUNK == 4 && i0 >= (unsigned)CV_SMALL && i0 + 4u <= lim) {
            float rv[64]; Cv8 dn = cv8_desc(a, (int)i0); conv8_load(dn, rv, F.lane);
#pragma unroll 1
            for (int k = 0; k < 4; ++k) { float cur[64]; const Cv8 dc = dn;
#pragma unroll
                for (int i = 0; i < 64; ++i) cur[i] = rv[i];
                if (k < 3) { dn = cv8_desc(a, (int)i0 + k + 1); conv8_load(dn, rv, F.lane); }
                conv8_store(dc, cur, scr, F.lane); }
            continue; }
#endif
        for (unsigned it = i0; it < i0 + (unsigned)MK_CV_CHUNK && it < lim; ++it) proA_conv_item(a, (int)it, scr, F.lane);
    }
#if MK_MERGE_PRO
    __syncthreads();
    if (F.tid == 0) { unsigned* ctl = (unsigned*)(a->ws + WS_CTL); XB_SPIN(xb_ld(ctl + 8256) < 384u, ctl + 4096); }
    __syncthreads();
    __builtin_amdgcn_fence(__ATOMIC_ACQUIRE, "agent");
    phase_proB(a, F);
#endif
}
__device__ __forceinline__ void phase_proB(ArgsP a, const Fr& F) {
    LAS float* m0 = (LAS float*)F.lds;
    const float* mp = (const float*)(a->ws + WS_MODP);
    for (int u = F.tid; u < 5 * 2048; u += NTHR) { const int r = u / 2048, c = u % 2048; float s = a->in[I_MODB][c];
        for (int ks = 0; ks < 8; ++ks) s += mp[(size_t)(ks * 5 + r) * 6144 + c];
        m0[u] = s; }
    __syncthreads();
    const int gw = F.vcu * NWAVES + F.wave, NGW = F.G * NWAVES;
    for (int row = gw; row < TA; row += NGW) {
        const int r = row < T ? (row >> 12) : 4;
        const float* src = row < T ? a->in[I_X] + (size_t)row * D : a->in[I_CTX] + (size_t)(row - T) * D;
        bf16* xl = (bf16*)(a->ws + WS_XC) + (size_t)row * D; const int hrow = row < T ? (row & ~4095) + ((row & 511) << 3) + ((row & 4095) >> 9) : row;
        bf16* hb = (bf16*)(a->ws + WS_HB) + (size_t)hrow * D;
#pragma unroll
        for (int j = 0; j < 4; ++j) { const int c = 4 * F.lane + 256 * j; const f32x4 v = *(const f32x4*)(src + c); { v2u xo; xo.x = pk2(v[0], v[1]); xo.y = pk2(v[2], v[3]); *(v2u*)(xl + c) = xo; }
            const f32x4 sh = *(const LAS f32x4*)(m0 + r * 2048 + c), sc = *(const LAS f32x4*)(m0 + r * 2048 + 1024 + c);
            const f32x4 h = v * (sc + 1.0f) + sh;
#if MK_FP8_HYIN
            *(unsigned*)((unsigned char*)(a->ws + WS_HB) + (size_t)hrow * D + c) = pk4_e4m3(h); }
#else
            v2u o; o.x = pk2(h[0], h[1]); o.y = pk2(h[2], h[3]); *(v2u*)(hb + c) = o; }
#endif
    }
    const int gt = F.vcu * NTHR + F.tid, NGT = F.G * NTHR;
    float* mod = (float*)(a->ws + WS_MOD);
    for (int u = gt; u < 4 * 5 * 6144; u += NGT) { const int i = u / 30720, r = (u / 6144) % 5, c = u % 6144; float s = a->in[I_MODB][i * 6144 + c];
        for (int ks = 0; ks < 8; ++ks) s += mp[(size_t)((i * 8 + ks) * 5 + r) * 6144 + c];
        mod[u] = s; }
}
template <int L>
__device__ __forceinline__ float sconv(const bf16* p, int t, float w0, float w1, float w2, float cb) {
    const float a = t > 0 ? bf2f(p[t - 1]) : 0.f, b = bf2f(p[t]), c = t < L - 1 ? bf2f(p[t + 1]) : 0.f; return w0 * a + w1 * b + w2 * c + cb;
}
template <int L>
__device__ __forceinline__ void hy_direct_item(ArgsP a, const Fr& F, int slot, int d, int tok0, const float* HF) {
    LAS float* kk = (LAS float*)F.lds;
    LAS float* vb = kk + 4 * L;
    LAS float* red = vb + 4 * L;
    const bf16* PT = (const bf16*)(a->ws + SC_PT);
    bf16* Z2T = (bf16*)(a->ws + SC_Z2T);
    __syncthreads();
    for (int o = 0; o < 2; ++o) {
        const float* fw = HF + (size_t)((o * 2 + 0) * 1024 + d) * L; const float* bw = HF + (size_t)((o * 2 + 1) * 1024 + d) * L;
        float s = 0.f;
        for (int t = F.tid; t < L; t += NTHR) { const float f = fw[t], b = bw[t]; kk[o * 2 * L + (L - 1) + t] = f; if (t >= 1) kk[o * 2 * L + (L - 1) - t] = b; s += fabsf(f) + (t >= 1 ? fabsf(b) : 0.f); }
        s = wave_sum(s); if (F.lane == 0) red[o * 8 + F.wave] = s;
    }
    __syncthreads();
    float nrm[2];
#pragma unroll
    for (int o = 0; o < 2; ++o) { float s = 0.f; for (int w = 0; w < 8; ++w) s += red[o * 8 + w]; nrm[o] = 1.0f / (s + 1e-6f); }
    const float* cw = a->in[I_HYCW] + (size_t)slot * 3 * 3072; const float* cbp = a->in[I_HYCB] + (size_t)slot * 3072;
    float w0[3], w1[3], w2[3], cb[3];
#pragma unroll
    for (int g = 0; g < 3; ++g) { const int c = g * 1024 + d; w0[g] = cw[c]; w1[g] = cw[3072 + c]; w2[g] = cw[2 * 3072 + c]; cb[g] = cbp[c]; }
    const float fb0 = a->in[I_FBIAS][(slot * 2 + 0) * 1024 + d], fb1 = a->in[I_FBIAS][(slot * 2 + 1) * 1024 + d];
    for (int u = F.tid; u < 4 * L; u += NTHR) { const int b = u / L, t = u % L; vb[u] = sconv<L>(PT + (size_t)d * TA + tok0 + b * L, t, w0[0], w1[0], w2[0], cb[0]); }
    __syncthreads();
    constexpr int NBLK = 4 * L / 8, PER = (NBLK + NTHR - 1) / NTHR;
    float res[PER][8];
#pragma unroll 1
    for (int o = 0; o < 2; ++o) {
        const LAS float* ko = kk + o * 2 * L;
#pragma unroll
        for (int pi = 0; pi < PER; ++pi) {
            const int q = F.tid + pi * NTHR;
            float acc[8];
#pragma unroll
            for (int j = 0; j < 8; ++j) acc[j] = 0.f;
            if (q < NBLK) {
                const int b = q / (L / 8), t0 = (q % (L / 8)) * 8;
                const LAS float* vv = vb + b * L;
#pragma unroll 1
                for (int s8 = 0; s8 < L; s8 += 8) {
                    const LAS float* kw = ko + (t0 - s8 - 7 + L - 1);
                    float w[15], x[8];
#pragma unroll
                    for (int i = 0; i < 15; ++i) w[i] = kw[i];
#pragma unroll
                    for (int i = 0; i < 8; ++i) x[i] = vv[s8 + i];
#pragma unroll
                    for (int j = 0; j < 8; ++j)
#pragma unroll
                        for (int i = 0; i < 8; ++i) acc[j] += w[j - i + 7] * x[i];
                }
            }
#pragma unroll
            for (int j = 0; j < 8; ++j) res[pi][j] = acc[j];
        }
        __syncthreads();
#pragma unroll
        for (int pi = 0; pi < PER; ++pi) {
            const int q = F.tid + pi * NTHR;
            if (q < NBLK) {
                const int b = q / (L / 8), t0 = (q % (L / 8)) * 8;
                const bf16* pg = PT + (size_t)((o + 1) * 1024 + d) * TA + tok0 + b * L;
#pragma unroll
                for (int j = 0; j < 8; ++j) { const int t = t0 + j; const float vin = vb[b * L + t];
                    const float y = res[pi][j] * nrm[o] + vin * (o == 0 ? fb0 : fb1);
                    const float xg = sconv<L>(pg, t, w0[o + 1], w1[o + 1], w2[o + 1], cb[o + 1]);
                    res[pi][j] = xg * y; }
            }
        }
        __syncthreads();
        if (o == 0) {
#pragma unroll
            for (int pi = 0; pi < PER; ++pi) { const int q = F.tid + pi * NTHR;
                if (q < NBLK) { const int b = q / (L / 8), t0 = (q % (L / 8)) * 8;
#pragma unroll
                    for (int j = 0; j < 8; ++j) vb[b * L + t0 + j] = res[pi][j]; } }
            __syncthreads();
        } else {
#pragma unroll
            for (int pi = 0; pi < PER; ++pi) { const int q = F.tid + pi * NTHR;
                if (q < NBLK) { const int b = q / (L / 8), t0 = (q % (L / 8)) * 8;
                    v4u ov; ov.x = pk2(res[pi][0], res[pi][1]); ov.y = pk2(res[pi][2], res[pi][3]); ov.z = pk2(res[pi][4], res[pi][5]); ov.w = pk2(res[pi][6], res[pi][7]);
                    *(v4u*)(Z2T + (size_t)d * TA + tok0 + b * L + t0) = ov; } }
        }
    }
}
__device__ __forceinline__ void hy_ctx_item(ArgsP a, const Fr& F, int slot, int d) {
    constexpr int L = LC;
    LAS float* kk = (LAS float*)F.lds;
    LAS float* vb = kk + 4 * L;
    LAS float* red = vb + 4 * L;
    LAS float* ps = red + 16;
    const bf16* PT = (const bf16*)(a->ws + SC_PT); bf16* Z2T = (bf16*)(a->ws + SC_Z2T);
    const float* HF = (const float*)(a->ws + WS_HF + HF_CTX); const int tok0 = T;
    __syncthreads();
    for (int o = 0; o < 2; ++o) {
        const float* fw = HF + (size_t)((o * 2 + 0) * 1024 + d) * L; const float* bw = HF + (size_t)((o * 2 + 1) * 1024 + d) * L;
        float s = 0.f;
        for (int t = F.tid; t < L; t += NTHR) { const float f = fw[t], b = bw[t]; kk[o * 2 * L + (L - 1) + t] = f; if (t >= 1) kk[o * 2 * L + (L - 1) - t] = b; s += fabsf(f) + (t >= 1 ? fabsf(b) : 0.f); }
        s = wave_sum(s); if (F.lane == 0) red[o * 8 + F.wave] = s;
    }
    __syncthreads();
    float nrm[2];
#pragma unroll
    for (int o = 0; o < 2; ++o) { float s = 0.f; for (int w = 0; w < 8; ++w) s += red[o * 8 + w]; nrm[o] = 1.0f / (s + 1e-6f); }
    const float* cw = a->in[I_HYCW] + (size_t)slot * 3 * 3072; const float* cbp = a->in[I_HYCB] + (size_t)slot * 3072;
    float w0[3], w1[3], w2[3], cb[3];
#pragma unroll
    for (int g = 0; g < 3; ++g) { const int c = g * 1024 + d; w0[g] = cw[c]; w1[g] = cw[3072 + c]; w2[g] = cw[2 * 3072 + c]; cb[g] = cbp[c]; }
    const float fb0 = a->in[I_FBIAS][(slot * 2 + 0) * 1024 + d], fb1 = a->in[I_FBIAS][(slot * 2 + 1) * 1024 + d];
    for (int u = F.tid; u < 4 * L; u += NTHR) { const int b = u / L, t = u % L; vb[u] = sconv<L>(PT + (size_t)d * TA + tok0 + b * L, t, w0[0], w1[0], w2[0], cb[0]); }
    __syncthreads();
    const int sq = F.tid >> 7, q = F.tid & 127, b = q >> 5, t0 = (q & 31) * 8;
#pragma unroll 1
    for (int o = 0; o < 2; ++o) {
        const LAS float* ko = kk + o * 2 * L; const LAS float* vv = vb + b * L;
        float acc[8];
#pragma unroll
        for (int j = 0; j < 8; ++j) acc[j] = 0.f;
#pragma unroll 1
        for (int s8 = sq * 64; s8 < sq * 64 + 64; s8 += 8) {
            const LAS float* kw = ko + (t0 - s8 - 7 + L - 1);
            float w[15], x[8];
#pragma unroll
            for (int i = 0; i < 15; ++i) w[i] = kw[i];
#pragma unroll
            for (int i = 0; i < 8; ++i) x[i] = vv[s8 + i];
#pragma unroll
            for (int j = 0; j < 8; ++j)
#pragma unroll
                for (int i = 0; i < 8; ++i) acc[j] += w[j - i + 7] * x[i];
        }
#pragma unroll
        for (int j = 0; j < 8; ++j) ps[(sq * 128 + q) * 8 + j] = acc[j];
        __syncthreads();
        float res[8];
        if (F.tid < 128) {
            const bf16* pg = PT + (size_t)((o + 1) * 1024 + d) * TA + tok0 + b * L;
#pragma unroll
            for (int j = 0; j < 8; ++j) { const float cv = ((ps[q * 8 + j] + ps[(128 + q) * 8 + j]) + ps[(256 + q) * 8 + j]) + ps[(384 + q) * 8 + j];
                const int t = t0 + j; const float vin = vb[b * L + t];
                const float y = cv * nrm[o] + vin * (o == 0 ? fb0 : fb1);
                res[j] = sconv<L>(pg, t, w0[o + 1], w1[o + 1], w2[o + 1], cb[o + 1]) * y; }
        }
        __syncthreads();
        if (F.tid < 128) {
            if (o == 0) {
#pragma unroll
                for (int j = 0; j < 8; ++j) vb[b * L + t0 + j] = res[j]; }
            else { v4u ov; ov.x = pk2(res[0], res[1]); ov.y = pk2(res[2], res[3]); ov.z = pk2(res[4], res[5]); ov.w = pk2(res[6], res[7]);
                *(v4u*)(Z2T + (size_t)d * TA + tok0 + b * L + t0) = ov; }
        }
        __syncthreads();
    }
}
__device__ __forceinline__ void phase_hy_tr(ArgsP a, const Fr& F, int ntok) {
    LAS unsigned short* tile = (LAS unsigned short*)(F.lds + F.wave * 9216);
    const bf16* Z2T = (const bf16*)(a->ws + SC_Z2T); bf16* Z2 = (bf16*)(a->ws + SC_Z2);
    const int gw = F.vcu * NWAVES + F.wave, NGW = F.G * NWAVES, ntt = ntok / 64;
    for (int it = gw; it < 16 * ntt; it += NGW) {
        const int c0 = (it / ntt) * 64, t0 = (it % ntt) * 64;
#pragma unroll
        for (int i = 0; i < 8; ++i) { const int ch = i * 8 + (F.lane >> 3), ck = F.lane & 7;
            const v4u v = *(const v4u*)(Z2T + (size_t)(c0 + ch) * TA + t0 + ck * 8); *(LAS v4u*)(tile + ch * 72 + ck * 8) = v; }
        LDS_WAIT(); asm volatile("" ::: "memory");
        int trow = t0 + F.lane;
        if (trow < T) { const int pi = trow & 4095; trow = (trow & ~4095) + (pi >> 3) + 512 * (pi & 7); }
        bf16* dst = Z2 + (size_t)trow * D + c0;
#pragma unroll
        for (int q = 0; q < 8; ++q) { unsigned w[4];
#pragma unroll
            for (int j = 0; j < 4; ++j) { const unsigned lo = tile[(q * 8 + 2 * j) * 72 + F.lane], hi = tile[(q * 8 + 2 * j + 1) * 72 + F.lane]; w[j] = lo | (hi << 16); }
#if MK_FP8_HYOUT
            v2u o8; o8.x = pk4_e4m3((f32x4){__builtin_bit_cast(float, w[0] << 16), __builtin_bit_cast(float, w[0] & 0xffff0000u), __builtin_bit_cast(float, w[1] << 16), __builtin_bit_cast(float, w[1] & 0xffff0000u)} * Z_SCALE);
            o8.y = pk4_e4m3((f32x4){__builtin_bit_cast(float, w[2] << 16), __builtin_bit_cast(float, w[2] & 0xffff0000u), __builtin_bit_cast(float, w[3] << 16), __builtin_bit_cast(float, w[3] & 0xffff0000u)} * Z_SCALE);
            *(v2u*)((unsigned char*)Z2 + (size_t)trow * D + c0 + q * 8) = o8; }
#else
            v4u o; o.x = w[0]; o.y = w[1]; o.z = w[2]; o.w = w[3]; *(v4u*)(dst + q * 8) = o; }
#endif
        LDS_WAIT(); asm volatile("" ::: "memory");
    }
}
__device__ __forceinline__ void phase_hy_conv_direct(ArgsP a, const Fr& F, int layer) {
    const int slot = layer == 0 ? 0 : 1; const int nitems = layer == 0 ? 2048 : 1024;
    for (int it = F.vcu; it < nitems; it += F.G) {
        if (it < 1024) hy_direct_item<SEQ>(a, F, slot, it, 0, (const float*)(a->ws + WS_HF + (size_t)slot * HF_SLOT));
        else hy_direct_item<LC>(a, F, slot, it - 1024, T, (const float*)(a->ws + WS_HF + HF_CTX));
    }
}

__device__ __forceinline__ void lnr_softmax_store(const float (&part)[16], int lane, float* affrow) {
    const bool h5 = (lane & 32) != 0, h4 = (lane & 16) != 0, h3 = (lane & 8) != 0, h2 = (lane & 4) != 0;
    float q8[8], q4[4], q2[2];
#pragma unroll
    for (int k = 0; k < 8; ++k) { const float keep = h5 ? part[8 + k] : part[k], send = h5 ? part[k] : part[8 + k]; q8[k] = keep + __shfl_xor(send, 32); }
#pragma unroll
    for (int k = 0; k < 4; ++k) { const float keep = h4 ? q8[4 + k] : q8[k], send = h4 ? q8[k] : q8[4 + k]; q4[k] = keep + __shfl_xor(send, 16); }
#pragma unroll
    for (int k = 0; k < 2; ++k) { const float keep = h3 ? q4[2 + k] : q4[k], send = h3 ? q4[k] : q4[2 + k]; q2[k] = keep + __shfl_xor(send, 8); }
    float lg; { const float keep = h2 ? q2[1] : q2[0], send = h2 ? q2[0] : q2[1]; lg = keep + __shfl_xor(send, 4); }
    lg += __shfl_xor(lg, 1); lg += __shfl_xor(lg, 2);
    float mx = lg;
#pragma unroll
    for (int o = 4; o < 64; o <<= 1) mx = fmaxf(mx, __shfl_xor(mx, o));
    const float ex = expf(lg - mx); float den = ex;
#pragma unroll
    for (int o = 4; o < 64; o <<= 1) den += __shfl_xor(den, o);
    const int eidx = (h5 ? 8 : 0) + (h4 ? 4 : 0) + (h3 ? 2 : 0) + (h2 ? 1 : 0);
    if ((lane & 3) == 0) affrow[eidx] = ex / den;
}
__device__ __forceinline__ void phase_lnr2(ArgsP a, const Fr& F, int layer, int nrows) {
    LAS float* wr = (LAS float*)F.lds;
    __syncthreads();
    for (int u = F.tid; u < 1024 * 16; u += NTHR) wr[u] = a->in[I_ROUTER][(size_t)layer * 1024 * 16 + (u & 1023) * 16 + (u >> 10)];
    __syncthreads();
    const bf16* U = (const bf16*)(a->ws + WS_U); f32x2* ST = (f32x2*)(a->ws + WS_XL); unsigned char* HB8 = (unsigned char*)(a->ws + WS_HB); float* AFF = (float*)(a->ws + WS_AFF);
    const float* mod = (const float*)(a->ws + WS_MOD) + (size_t)layer * 5 * 6144;
    const float* lg = a->in[I_LNG] + (size_t)(layer * 2 + 0) * D; const float* lb = a->in[I_LNB] + (size_t)(layer * 2 + 0) * D;
    const int gw = F.vcu * NWAVES + F.wave, NGW = F.G * NWAVES, npair = nrows >> 1;
    v2u vn[2][4];
    if (gw < npair) {
#pragma unroll
        for (int q = 0; q < 2; ++q)
#pragma unroll
            for (int j = 0; j < 4; ++j) vn[q][j] = *(const v2u*)(U + (size_t)(2 * gw + q) * D + 4 * F.lane + 256 * j); }
    for (int pi = gw; pi < npair; pi += NGW) {
        int lane = F.lane; asm volatile("" : "+v"(lane));
        const int row = 2 * pi; const int r = row < T ? (row >> 12) : 4;
        f32x4 v[2][4]; float s[2] = {0.f, 0.f};
#pragma unroll
        for (int q = 0; q < 2; ++q)
#pragma unroll
            for (int j = 0; j < 4; ++j) { v[q][j] = up4(vn[q][j]); s[q] += (v[q][j][0] + v[q][j][1]) + (v[q][j][2] + v[q][j][3]); }
        if (pi + NGW < npair) {
#pragma unroll
            for (int q = 0; q < 2; ++q)
#pragma unroll
                for (int j = 0; j < 4; ++j) vn[q][j] = *(const v2u*)(U + (size_t)(2 * (pi + NGW) + q) * D + 4 * lane + 256 * j); }
        float rstd[2];
#pragma unroll
        for (int q = 0; q < 2; ++q) { const float mean = wave_sum(s[q]) * (1.0f / D); float s2 = 0.f;
#pragma unroll
            for (int j = 0; j < 4; ++j) { v[q][j] = v[q][j] - mean; s2 += (v[q][j][0] * v[q][j][0] + v[q][j][1] * v[q][j][1]) + (v[q][j][2] * v[q][j][2] + v[q][j][3] * v[q][j][3]); }
            rstd[q] = 1.0f / sqrtf(wave_sum(s2) * (1.0f / D) + LN_EPS);
            if (lane == 0) ST[row + q] = (f32x2){mean, rstd[q]}; }
        float pa[16], pb[16];
#pragma unroll
        for (int e = 0; e < 16; ++e) { pa[e] = 0.f; pb[e] = 0.f; }
#pragma unroll 1
        for (int j = 0; j < 4; ++j) { const int c = 4 * lane + 256 * j;
            const f32x4 g4 = *(const f32x4*)(lg + c), b4 = *(const f32x4*)(lb + c), sc = *(const f32x4*)(mod + r * 6144 + 4096 + c) + 1.0f, sh = *(const f32x4*)(mod + r * 6144 + 3072 + c);
            f32x4 vA, vB;
            switch (j) { case 0: vA = v[0][0]; vB = v[1][0]; break; case 1: vA = v[0][1]; vB = v[1][1]; break; case 2: vA = v[0][2]; vB = v[1][2]; break; default: vA = v[0][3]; vB = v[1][3]; break; }
            const f32x4 hA = (vA * rstd[0] * g4 + b4) * sc + sh, hB = (vB * rstd[1] * g4 + b4) * sc + sh;
            { unsigned o8 = 0u; o8 = __builtin_amdgcn_cvt_pk_fp8_f32(__builtin_amdgcn_fmed3f(hA[0], -448.0f, 448.0f), __builtin_amdgcn_fmed3f(hA[1], -448.0f, 448.0f), o8, false);
              o8 = __builtin_amdgcn_cvt_pk_fp8_f32(__builtin_amdgcn_fmed3f(hA[2], -448.0f, 448.0f), __builtin_amdgcn_fmed3f(hA[3], -448.0f, 448.0f), o8, true); *(unsigned*)(HB8 + (size_t)row * D + c) = o8; }
            { unsigned o8 = 0u; o8 = __builtin_amdgcn_cvt_pk_fp8_f32(__builtin_amdgcn_fmed3f(hB[0], -448.0f, 448.0f), __builtin_amdgcn_fmed3f(hB[1], -448.0f, 448.0f), o8, false);
              o8 = __builtin_amdgcn_cvt_pk_fp8_f32(__builtin_amdgcn_fmed3f(hB[2], -448.0f, 448.0f), __builtin_amdgcn_fmed3f(hB[3], -448.0f, 448.0f), o8, true); *(unsigned*)(HB8 + (size_t)(row + 1) * D + c) = o8; }
#pragma unroll
            for (int e = 0; e < 16; ++e) { const f32x4 w = *(const LAS f32x4*)(wr + e * 1024 + c);
                pa[e] += (hA[0] * w[0] + hA[1] * w[1]) + (hA[2] * w[2] + hA[3] * w[3]);
                pb[e] += (hB[0] * w[0] + hB[1] * w[1]) + (hB[2] * w[2] + hB[3] * w[3]); }
            asm volatile("" ::: "memory"); }
        lnr_softmax_store(pa, lane, AFF + (size_t)row * 16);
        lnr_softmax_store(pb, lane, AFF + (size_t)(row + 1) * 16);
    }
}
__device__ __forceinline__ void phase_lnr(ArgsP a, const Fr& F, int layer, int nrows) {
    LAS float* wr = (LAS float*)F.lds;
    __syncthreads();
    for (int u = F.tid; u < 1024 * 16; u += NTHR) wr[u] = a->in[I_ROUTER][(size_t)layer * 1024 * 16 + (u & 1023) * 16 + (u >> 10)];
    __syncthreads();
    const bf16* U = (const bf16*)(a->ws + WS_U); f32x2* ST = (f32x2*)(a->ws + WS_XL); unsigned char* HB8 = (unsigned char*)(a->ws + WS_HB); float* AFF = (float*)(a->ws + WS_AFF);
    const float* mod = (const float*)(a->ws + WS_MOD) + (size_t)layer * 5 * 6144;
    const float* lg = a->in[I_LNG] + (size_t)(layer * 2 + 0) * D; const float* lb = a->in[I_LNB] + (size_t)(layer * 2 + 0) * D;
    const int gw = F.vcu * NWAVES + F.wave, NGW = F.G * NWAVES;
    f32x4 wreg[MK_LNR_WREG > 0 ? MK_LNR_WREG : 1][4];
#pragma unroll
    for (int e = 0; e < MK_LNR_WREG; ++e)
#pragma unroll
        for (int j = 0; j < 4; ++j) wreg[e][j] = *(const LAS f32x4*)(wr + e * 1024 + 4 * F.lane + 256 * j);
    v2u vn[4];
    if (gw < nrows) {
#pragma unroll
        for (int j = 0; j < 4; ++j) vn[j] = *(const v2u*)(U + (size_t)gw * D + 4 * F.lane + 256 * j); }
    for (int row = gw; row < nrows; row += NGW) {
        const int r = row < T ? (row >> 12) : 4;
        f32x4 v[4]; float s = 0.f;
#pragma unroll
        for (int j = 0; j < 4; ++j) { v[j] = up4(vn[j]); s += (v[j][0] + v[j][1]) + (v[j][2] + v[j][3]); }
        if (row + NGW < nrows) {
#pragma unroll
            for (int j = 0; j < 4; ++j) vn[j] = *(const v2u*)(U + (size_t)(row + NGW) * D + 4 * F.lane + 256 * j); }
        const float mean = wave_sum(s) * (1.0f / D); float s2 = 0.f;
#pragma unroll
        for (int j = 0; j < 4; ++j) { v[j] = v[j] - mean; s2 += (v[j][0] * v[j][0] + v[j][1] * v[j][1]) + (v[j][2] * v[j][2] + v[j][3] * v[j][3]); }
        const float rstd = 1.0f / sqrtf(wave_sum(s2) * (1.0f / D) + LN_EPS);
        if (F.lane == 0) ST[row] = (f32x2){mean, rstd};
        float part[16];
#pragma unroll
        for (int e = 0; e < 16; ++e) part[e] = 0.f;
#pragma unroll
        for (int j = 0; j < 4; ++j) { const int c = 4 * F.lane + 256 * j;
            const f32x4 x = v[j] * rstd * *(const f32x4*)(lg + c) + *(const f32x4*)(lb + c);
            const f32x4 h = x * (*(const f32x4*)(mod + r * 6144 + 4096 + c) + 1.0f) + *(const f32x4*)(mod + r * 6144 + 3072 + c);
            { unsigned o8 = 0u; const f32x4 hc = {__builtin_amdgcn_fmed3f(h[0], -448.0f, 448.0f), __builtin_amdgcn_fmed3f(h[1], -448.0f, 448.0f), __builtin_amdgcn_fmed3f(h[2], -448.0f, 448.0f), __builtin_amdgcn_fmed3f(h[3], -448.0f, 448.0f)};
              o8 = __builtin_amdgcn_cvt_pk_fp8_f32(hc[0], hc[1], o8, false); o8 = __builtin_amdgcn_cvt_pk_fp8_f32(hc[2], hc[3], o8, true); *(unsigned*)(HB8 + (size_t)row * D + c) = o8; }
#pragma unroll
            for (int e = 0; e < 16; ++e) { const f32x4 w = e < MK_LNR_WREG ? wreg[e < MK_LNR_WREG ? e : 0][j] : *(const LAS f32x4*)(wr + e * 1024 + c);
                part[e] += (h[0] * w[0] + h[1] * w[1]) + (h[2] * w[2] + h[3] * w[3]); }
            asm volatile("" ::: "memory"); }
        const bool h5 = (F.lane & 32) != 0, h4 = (F.lane & 16) != 0, h3 = (F.lane & 8) != 0, h2 = (F.lane & 4) != 0;
        float q8[8], q4[4], q2[2];
#pragma unroll
        for (int k = 0; k < 8; ++k) { const float keep = h5 ? part[8 + k] : part[k], send = h5 ? part[k] : part[8 + k]; q8[k] = keep + __shfl_xor(send, 32); }
#pragma unroll
        for (int k = 0; k < 4; ++k) { const float keep = h4 ? q8[4 + k] : q8[k], send = h4 ? q8[k] : q8[4 + k]; q4[k] = keep + __shfl_xor(send, 16); }
#pragma unroll
        for (int k = 0; k < 2; ++k) { const float keep = h3 ? q4[2 + k] : q4[k], send = h3 ? q4[k] : q4[2 + k]; q2[k] = keep + __shfl_xor(send, 8); }
        float lg; { const float keep = h2 ? q2[1] : q2[0], send = h2 ? q2[0] : q2[1]; lg = keep + __shfl_xor(send, 4); }
        lg += __shfl_xor(lg, 1); lg += __shfl_xor(lg, 2);
        float mx = lg;
#pragma unroll
        for (int o = 4; o < 64; o <<= 1) mx = fmaxf(mx, __shfl_xor(mx, o));
        const float ex = expf(lg - mx); float den = ex;
#pragma unroll
        for (int o = 4; o < 64; o <<= 1) den += __shfl_xor(den, o);
        const int eidx = (h5 ? 8 : 0) + (h4 ? 4 : 0) + (h3 ? 2 : 0) + (h2 ? 1 : 0);
        if ((F.lane & 3) == 0) AFF[(size_t)row * 16 + eidx] = ex / den;
    }
}

template <int N, int CAPN>
__device__ __forceinline__ void topk_item(ArgsP a, const Fr& F, int b, int e, int rowbase, int slotbase, bool pad) {
    LAS unsigned* hist = (LAS unsigned*)F.lds;
    LAS unsigned* sel = hist + 256;
    LAS unsigned* wtot = hist + 264;
    const float* AFF = (const float*)(a->ws + WS_AFF); int* ROWS = (int*)(a->ws + WS_ROWS); float* GATE = (float*)(a->ws + WS_GATE); int* INV = (int*)(a->ws + WS_INV);
    const int tid = F.tid, lane = F.lane; const bool act = tid * 8 < N;
    unsigned key[8];
#pragma unroll
    for (int j = 0; j < 8; ++j) key[j] = act ? __float_as_uint(AFF[(size_t)(rowbase + tid * 8 + j) * 16 + e]) : 0u;
    unsigned prefix = 0u, need = CAPN;
#pragma unroll 1
    for (int pass = 0; pass < 4; ++pass) {
        const int shift = 24 - 8 * pass; const unsigned himask = pass == 0 ? 0u : (0xFFFFFFFFu << (shift + 8));
        __syncthreads();
        if (tid < 256) hist[tid] = 0u;
        __syncthreads();
        if (act) {
#pragma unroll
            for (int j = 0; j < 8; ++j) if ((key[j] & himask) == prefix) __hip_atomic_fetch_add(&hist[(key[j] >> shift) & 255u], 1u, __ATOMIC_RELAXED, __HIP_MEMORY_SCOPE_WORKGROUP);
        }
        __syncthreads();
        if (tid < 64) {
            const unsigned v0 = hist[4 * lane], v1 = hist[4 * lane + 1], v2 = hist[4 * lane + 2], v3 = hist[4 * lane + 3]; const unsigned tot = v0 + v1 + v2 + v3;
            unsigned x = tot;
#pragma unroll
            for (int o = 1; o < 64; o <<= 1) { const unsigned t = __shfl_down(x, o); if (lane + o < 64) x += t; }
            const unsigned a3 = x - tot, a2 = a3 + v3, a1 = a2 + v2, a0 = a1 + v1;
            if (a3 < need && need <= a3 + v3) { sel[0] = 4 * lane + 3; sel[1] = a3; }
            if (a2 < need && need <= a2 + v2) { sel[0] = 4 * lane + 2; sel[1] = a2; }
            if (a1 < need && need <= a1 + v1) { sel[0] = 4 * lane + 1; sel[1] = a1; }
            if (a0 < need && need <= a0 + v0) { sel[0] = 4 * lane + 0; sel[1] = a0; }
        }
        __syncthreads();
        prefix |= sel[0] << shift; need -= sel[1];
    }
    const unsigned tau = prefix;
    unsigned ceq = 0u;
#pragma unroll
    for (int j = 0; j < 8; ++j) ceq += (act && key[j] == tau) ? 1u : 0u;
    unsigned xe = ceq;
#pragma unroll
    for (int o = 1; o < 64; o <<= 1) { const unsigned t = __shfl_up(xe, o); if (lane >= o) xe += t; }
    __syncthreads();
    if (lane == 63) wtot[F.wave * 2] = xe;
    __syncthreads();
    unsigned eqbase = xe - ceq; for (int w = 0; w < F.wave; ++w) eqbase += wtot[w * 2];
    unsigned flags = 0u, csel = 0u;
#pragma unroll
    for (int j = 0; j < 8; ++j) { bool s = false; if (act) { if (key[j] > tau) s = true; else if (key[j] == tau) { s = eqbase < need; ++eqbase; } } if (s) { flags |= 1u << j; ++csel; } }
    unsigned xs = csel;
#pragma unroll
    for (int o = 1; o < 64; o <<= 1) { const unsigned t = __shfl_up(xs, o); if (lane >= o) xs += t; }
    if (lane == 63) wtot[F.wave * 2 + 1] = xs;
    __syncthreads();
    unsigned pos = xs - csel; for (int w = 0; w < F.wave; ++w) pos += wtot[w * 2 + 1];
    if (act) {
#pragma unroll
        for (int j = 0; j < 8; ++j) { const int row = rowbase + tid * 8 + j; int slot = -1;
            if (flags & (1u << j)) { slot = e * ESTR + slotbase + (int)pos; ++pos; ROWS[slot] = row; GATE[slot] = __uint_as_float(key[j]); }
            INV[(size_t)row * 16 + e] = slot; }
    }
    if (pad) for (int p = tid; p < 128; p += NTHR) { ROWS[e * ESTR + 2176 + p] = 0; GATE[e * ESTR + 2176 + p] = 0.f; }
}
__device__ __forceinline__ void phase_topk(ArgsP a, const Fr& F, int layer) {
    const int nitems = layer == 0 ? 128 : 64;
    for (int it = F.vcu; it < nitems; it += F.G) {
        if (it < 64) { const int b = it >> 4, e = it & 15; topk_item<SEQ, 512>(a, F, b, e, b * SEQ, b * 512, false); }
        else { const int b = (it - 64) >> 4, e = it & 15; topk_item<LC, 32>(a, F, b, e, T + b * LC, 2048 + b * 32, b == 0); }
    }
}
__device__ __forceinline__ void phase_gather(ArgsP a, const Fr& F, int layer) {
    const int me = layer == 0 ? 2304 : 2048;
    const int* ROWS = (const int*)(a->ws + WS_ROWS); const bf16* HB = (const bf16*)(a->ws + WS_HB); bf16* XG = (bf16*)(a->ws + WS_XG);
    const int gw = F.vcu * NWAVES + F.wave, NGW = F.G * NWAVES;
    for (int it = gw; it < 16 * me; it += NGW) { const int e = it / me, s = it % me, dr = e * ESTR + s; const int sr = ROWS[dr];
        const v4u* src = (const v4u*)(HB + (size_t)sr * D); v4u* dst = (v4u*)(XG + (size_t)dr * D);
        dst[F.lane] = src[F.lane]; dst[64 + F.lane] = src[64 + F.lane]; }
}
#if MK_FP8_Y
typedef unsigned comb_y_t;
#define COMB_YLOAD(p, off) (*(const unsigned*)((const unsigned char*)(p) + (off)))
#define COMB_YS (1.0f / Y_SCALE)
#define COMB_YROW(s) ((const bf16*)((const unsigned char*)Y + (size_t)(s) * D))
__device__ __forceinline__ f32x4 comb_y_up(unsigned w) { const auto lo = __builtin_amdgcn_cvt_pk_f32_fp8(w, false), hi = __builtin_amdgcn_cvt_pk_f32_fp8(w, true); return (f32x4){lo[0], lo[1], hi[0], hi[1]}; }
#else
typedef v2u comb_y_t;
#define COMB_YLOAD(p, off) (*(const v2u*)((p) + (off)))
#define COMB_YS 1.0f
#define COMB_YROW(s) (Y + (size_t)(s) * D)
__device__ __forceinline__ f32x4 comb_y_up(v2u w) { return up4(w); }
#endif
__device__ __forceinline__ void phase_comb(ArgsP a, const Fr& F, int layer, int nrows) {
    const bf16* Y = (const bf16*)(a->ws + WS_Y); const bf16* XL = (const bf16*)(a->ws + WS_U); const f32x2* ST = (const f32x2*)(a->ws + WS_XL); bf16* XC = (bf16*)(a->ws + WS_XC); bf16* HB = (bf16*)(a->ws + WS_HB); const int* INV = (const int*)(a->ws + WS_INV);
    const float* lg1 = a->in[I_LNG] + (size_t)(layer * 2 + 0) * D; const float* lb1 = a->in[I_LNB] + (size_t)(layer * 2 + 0) * D;
    const float* mod = (const float*)(a->ws + WS_MOD) + (size_t)layer * 5 * 6144;
    const float* modn = (const float*)(a->ws + WS_MOD) + (size_t)(layer < 3 ? layer + 1 : 3) * 5 * 6144;
    const float* lg = a->in[I_LNG] + (size_t)(layer * 2 + 1) * D; const float* lb = a->in[I_LNB] + (size_t)(layer * 2 + 1) * D;
    const int gw = F.vcu * NWAVES + F.wave, NGW = F.G * NWAVES;
#define COMB_ISSUE(inv_, row_, sl_, rest_, yv_, xl_, st_) do { unsigned mk_ = (unsigned)(__ballot((inv_) >= 0) & 0xFFFFull); \
        _Pragma("unroll") for (int q = 0; q < 4; ++q) { if (mk_) { const int e_ = __builtin_ctz(mk_); mk_ &= mk_ - 1; sl_[q] = __shfl((inv_), e_); } else sl_[q] = -1; } \
        rest_ = mk_; \
        _Pragma("unroll") for (int q = 0; q < 4; ++q) if (sl_[q] >= 0) { const bf16* yp_ = COMB_YROW(sl_[q]); _Pragma("unroll") for (int j = 0; j < 4; ++j) yv_[q][j] = COMB_YLOAD(yp_, 4 * F.lane + 256 * j); } \
        _Pragma("unroll") for (int j = 0; j < 4; ++j) xl_[j] = *(const v2u*)(XL + (size_t)(row_) * D + 4 * F.lane + 256 * j); st_ = ST[(row_)]; } while (0)
    int inv_c = gw < nrows ? INV[(size_t)gw * 16 + (F.lane & 15)] : -1;
    int inv_n = gw + NGW < nrows ? INV[(size_t)(gw + NGW) * 16 + (F.lane & 15)] : -1;
    int sl_c[4] = {-1, -1, -1, -1}; unsigned rest_c = 0u; comb_y_t yv_c[4][4]; v2u xl_c[4]; f32x2 st_c = {0.f, 1.f};
    if (gw < nrows) COMB_ISSUE(inv_c, gw, sl_c, rest_c, yv_c, xl_c, st_c);
    for (int row = gw; row < nrows; row += NGW) {
        const int r = row < T ? (row >> 12) : 4;
        const int hrow = (layer == 2 && row < T) ? (row & ~4095) + ((row & 511) << 3) + ((row & 4095) >> 9) : row;
        const int myinv = inv_c;
        int sl_n[4] = {-1, -1, -1, -1}; unsigned rest_n = 0u; comb_y_t yv_n[4][4]; v2u xl_n[4]; f32x2 st_n = {0.f, 1.f};
        const bool has_n = row + NGW < nrows;
        if (has_n) COMB_ISSUE(inv_n, row + NGW, sl_n, rest_n, yv_n, xl_n, st_n);
        const int inv_nn = (row + 2 * NGW < nrows) ? INV[(size_t)(row + 2 * NGW) * 16 + (F.lane & 15)] : -1;
        f32x4 m[4];
#pragma unroll
        for (int j = 0; j < 4; ++j) m[j] = (f32x4){0.f, 0.f, 0.f, 0.f};
#pragma unroll
        for (int q = 0; q < 4; ++q) if (sl_c[q] >= 0) {
#pragma unroll
            for (int j = 0; j < 4; ++j) m[j] += comb_y_up(yv_c[q][j]); }
        unsigned msk = rest_c;
        while (msk) { const int e = __builtin_ctz(msk); msk &= msk - 1; const int slot = __shfl(myinv, e); const bf16* yp = COMB_YROW(slot);
#pragma unroll
            for (int j = 0; j < 4; ++j) m[j] += comb_y_up(COMB_YLOAD(yp, 4 * F.lane + 256 * j)); }
        f32x4 xc[4];
#pragma unroll
        for (int j = 0; j < 4; ++j) { const int c = 4 * F.lane + 256 * j; xc[j] = (up4(xl_c[j]) - st_c.x) * st_c.y * *(const f32x4*)(lg1 + c) + *(const f32x4*)(lb1 + c); }
        inv_c = inv_n; inv_n = inv_nn; rest_c = rest_n; st_c = st_n;
#pragma unroll
        for (int q = 0; q < 4; ++q) { sl_c[q] = sl_n[q];
#pragma unroll
            for (int j = 0; j < 4; ++j) yv_c[q][j] = yv_n[q][j]; }
#pragma unroll
        for (int j = 0; j < 4; ++j) xl_c[j] = xl_n[j];
        f32x4 v[4]; float s = 0.f;
#pragma unroll
        for (int j = 0; j < 4; ++j) { const int c = 4 * F.lane + 256 * j;
            v[j] = xc[j] * ALPHA + *(const f32x4*)(mod + r * 6144 + 5120 + c) * (m[j] * COMB_YS); s += (v[j][0] + v[j][1]) + (v[j][2] + v[j][3]); }
        const float mean = wave_sum(s) * (1.0f / D); float s2 = 0.f;
#pragma unroll
        for (int j = 0; j < 4; ++j) { v[j] = v[j] - mean; s2 += (v[j][0] * v[j][0] + v[j][1] * v[j][1]) + (v[j][2] * v[j][2] + v[j][3] * v[j][3]); }
        const float rstd = 1.0f / sqrtf(wave_sum(s2) * (1.0f / D) + LN_EPS);
#pragma unroll
        for (int j = 0; j < 4; ++j) { const int c = 4 * F.lane + 256 * j;
            const f32x4 x = v[j] * rstd * *(const f32x4*)(lg + c) + *(const f32x4*)(lb + c);
            if (layer == 3) { *(f32x4*)(a->out + (size_t)row * D + c) = x; }
            else { { v2u xo; xo.x = pk2(x[0], x[1]); xo.y = pk2(x[2], x[3]); *(v2u*)(XC + (size_t)row * D + c) = xo; }
                const f32x4 h = x * (*(const f32x4*)(modn + r * 6144 + 1024 + c) + 1.0f) + *(const f32x4*)(modn + r * 6144 + c);
                if ((MK_FP8_HYIN && layer == 2) || (MK_FP8_CMIN && layer == 1) || (MK_FP8_QKV && layer == 0)) *(unsigned*)((unsigned char*)HB + (size_t)hrow * D + c) = pk4_e4m3(h);
                else { v2u o; o.x = pk2(h[0], h[1]); o.y = pk2(h[2], h[3]); *(v2u*)(HB + (size_t)hrow * D + c) = o;
                    if (MK_FP8_CMV && !MK_FP8_CMIN && layer == 1) *(unsigned*)((unsigned char*)(a->ws + WS_HB8B) + (size_t)row * D + c) = pk4_e4m3(h); } } }
    }
#undef COMB_ISSUE
}
#ifndef FFT_HD
#define FFT_HD __device__ __forceinline__
#endif
typedef float cf2 __attribute__((ext_vector_type(2)));
FFT_HD cf2 cmul(cf2 a, cf2 b) { return (cf2){a.x * b.x - a.y * b.y, a.x * b.y + a.y * b.x}; }
FFT_HD int fpad(int p) { return p + (p >> 5); }
constexpr int FFT_N = 8192, FFT_BUF = 8192 + 256;
template <bool INV> FFT_HD void dft4(cf2& a, cf2& b, cf2& c, cf2& d) {
    const cf2 s0 = a + c, s1 = a - c, s2 = b + d, s3 = b - d;
    const cf2 js3 = INV ? (cf2){-s3.y, s3.x} : (cf2){s3.y, -s3.x};
    a = s0 + s2; b = s1 + js3; c = s0 - s2; d = s1 - js3;
}
template <bool INV> FFT_HD void dft16(cf2 (&x)[16]) {
#pragma unroll
    for (int n0 = 0; n0 < 4; ++n0) dft4<INV>(x[n0], x[n0 + 4], x[n0 + 8], x[n0 + 12]);
    constexpr float C1 = 0.92387953251128674f, S1 = 0.38268343236508977f, R2 = 0.70710678118654752f;
    const float sg = INV ? 1.f : -1.f;
    const cf2 w1 = {C1, sg * S1}, w2 = {R2, sg * R2}, w3 = {S1, sg * C1}, w4 = {0.f, sg * 1.f}, w6 = {-R2, sg * R2}, w9 = {-C1, -sg * S1};
    x[1 + 4 * 1] = cmul(x[1 + 4 * 1], w1); x[1 + 4 * 2] = cmul(x[1 + 4 * 2], w2); x[1 + 4 * 3] = cmul(x[1 + 4 * 3], w3);
    x[2 + 4 * 1] = cmul(x[2 + 4 * 1], w2); x[2 + 4 * 2] = cmul(x[2 + 4 * 2], w4); x[2 + 4 * 3] = cmul(x[2 + 4 * 3], w6);
    x[3 + 4 * 1] = cmul(x[3 + 4 * 1], w3); x[3 + 4 * 2] = cmul(x[3 + 4 * 2], w6); x[3 + 4 * 3] = cmul(x[3 + 4 * 3], w9);
#pragma unroll
    for (int k0 = 0; k0 < 4; ++k0) dft4<INV>(x[0 + 4 * k0], x[1 + 4 * k0], x[2 + 4 * k0], x[3 + 4 * k0]);
#pragma unroll
    for (int i = 0; i < 4; ++i)
#pragma unroll
        for (int j = i + 1; j < 4; ++j) { const cf2 t = x[i + 4 * j]; x[i + 4 * j] = x[j + 4 * i]; x[j + 4 * i] = t; }
}
FFT_HD cf2 cmulc(cf2 a, cf2 b) { return (cf2){a.x * b.x + a.y * b.y, a.y * b.x - a.x * b.y}; }
template <bool INV, class BP> FFT_HD void stage_r16(BP buf, const cf2 (&tw)[15], int base, int stride) {
    cf2 x[16];
    const int pb = fpad(base), ps = stride + (stride >> 5);
#pragma unroll
    for (int i = 0; i < 16; ++i) x[i] = buf[pb + i * ps];
    if (!INV) { dft16<false>(x);
#pragma unroll
        for (int k = 1; k < 16; ++k) x[k] = cmulc(x[k], tw[k - 1]); }
    else {
#pragma unroll
        for (int k = 1; k < 16; ++k) x[k] = cmul(x[k], tw[k - 1]);
        dft16<true>(x); }
#pragma unroll
    for (int i = 0; i < 16; ++i) buf[pb + i * ps] = x[i];
}
template <class TP> FFT_HD void load_tw(TP TW, int tidx, cf2 (&tw)[15]) {
#pragma unroll
    for (int k = 1; k < 16; ++k) tw[k - 1] = TW[(tidx * k) & (FFT_N - 1)];
}
template <bool INV, class BP> FFT_HD void stage_r16_chain(BP buf, cf2 w, int base, int stride) {
    cf2 tw[15]; tw[0] = w;
#pragma unroll
    for (int k = 1; k < 15; ++k) tw[k] = cmul(tw[k - 1], w);
    stage_r16<INV>(buf, tw, base, stride);
}
template <class BP> FFT_HD void stage1_fwd_regs(BP buf, cf2 (&x)[16], cf2 w, int m) {
    dft16<false>(x);
    cf2 wk = w; const int pb = fpad(m);
    buf[pb] = x[0];
#pragma unroll
    for (int k = 1; k < 16; ++k) { buf[pb + 528 * k] = cmulc(x[k], wk); if (k < 15) wk = cmul(wk, w); }
}
template <class BP> FFT_HD void stage1_inv_regs(BP buf, cf2 (&x)[16], cf2 w, int m) {
    cf2 wk = w; const int pb = fpad(m);
    x[0] = buf[pb];
#pragma unroll
    for (int k = 1; k < 16; ++k) { x[k] = cmul(buf[pb + 528 * k], wk); if (k < 15) wk = cmul(wk, w); }
    dft16<true>(x);
}
template <bool INV, class BP> FFT_HD void stage_r32_load(BP buf, int blk, int r, cf2 (&u)[16]) {
    constexpr float CS[16] = {1.f, 0.98078528040323043f, 0.92387953251128674f, 0.83146961230254524f, 0.70710678118654752f, 0.55557023301960218f, 0.38268343236508977f, 0.19509032201612825f,
                              0.f, -0.19509032201612825f, -0.38268343236508977f, -0.55557023301960218f, -0.70710678118654752f, -0.83146961230254524f, -0.92387953251128674f, -0.98078528040323043f};
    constexpr float SN[16] = {0.f, 0.19509032201612825f, 0.38268343236508977f, 0.55557023301960218f, 0.70710678118654752f, 0.83146961230254524f, 0.92387953251128674f, 0.98078528040323043f,
                              1.f, 0.98078528040323043f, 0.92387953251128674f, 0.83146961230254524f, 0.70710678118654752f, 0.55557023301960218f, 0.38268343236508977f, 0.19509032201612825f};
    const int base = blk * 33;
#pragma unroll
    for (int n = 0; n < 16; ++n) { const cf2 lo = buf[base + n], hi = buf[base + n + 16];
        const cf2 s = lo + hi, d = lo - hi; const cf2 w = {CS[n], INV ? SN[n] : -SN[n]}; const cf2 dw = cmul(d, w);
        u[n] = r ? dw : s; }
    dft16<INV>(u);
}
template <class BP> FFT_HD void stage_r32_store(BP buf, int blk, int r, const cf2 (&u)[16]) {
    const int base = blk * 33;
#pragma unroll
    for (int g = 0; g < 16; ++g) buf[base + 2 * g + r] = u[g];
}
template <class BP> FFT_HD void stage_r32_store_mul(BP buf, BP W, int blk, int r, const cf2 (&u)[16], int o, float scale) {
    const int base = blk * 33; const int f1 = blk >> 4, f2 = blk & 15;
#pragma unroll
    for (int g = 0; g < 16; ++g) { const int f3 = 2 * g + r; const int f = f1 + 16 * f2 + 256 * f3; const int fm = (FFT_N - f) & (FFT_N - 1);
        const int pm = (fm & 15) * 512 + ((fm >> 4) & 15) * 32 + (fm >> 8);
        const cf2 a = W[base + f3], b = W[fpad(pm)];
        const cf2 k = o == 0 ? (cf2){0.5f * (a.x + b.x), 0.5f * (a.y - b.y)} : (cf2){0.5f * (a.y + b.y), 0.5f * (b.x - a.x)};
        buf[base + f3] = cmul(u[g], k) * scale; }
}
template <class BP> FFT_HD void fft_mul(BP Z, BP W, int tid, int o, float scale) {
    const int f2 = tid >> 5, f3 = tid & 31; const int pp = fpad(tid);
#pragma unroll 4
    for (int j = 0; j < 16; ++j) { const int f = j + 16 * f2 + 256 * f3; const int fm = (FFT_N - f) & (FFT_N - 1);
        const int pm = (fm & 15) * 512 + ((fm >> 4) & 15) * 32 + (fm >> 8);
        const cf2 a = W[pp + 528 * j], b = W[fpad(pm)];
        const cf2 k = o == 0 ? (cf2){0.5f * (a.x + b.x), 0.5f * (a.y - b.y)} : (cf2){0.5f * (a.y + b.y), 0.5f * (b.x - a.x)};
        const cf2 z = Z[pp + 528 * j]; Z[pp + 528 * j] = cmul(z, k) * scale; }
}
#ifndef FFT_HOST_ONLY
__device__ __forceinline__ void ld_tw2(const LAS cf2* tw2l, int tid, cf2 (&tw)[15]) {
#pragma unroll
    for (int k = 0; k < 15; ++k) tw[k] = tw2l[(tid & 31) * 15 + k];
}
__device__ __forceinline__ void fft_fwd(LAS cf2* buf, cf2 w1, const LAS cf2* tw2l, int tid) {
    asm volatile("" : "+v"(tid));
    stage_r16_chain<false>(buf, w1, tid, 512); __syncthreads();
    { cf2 tw[15]; ld_tw2(tw2l, tid, tw); stage_r16<false>(buf, tw, (tid >> 5) * 512 + (tid & 31), 32); } __syncthreads();
    { cf2 u[16]; stage_r32_load<false>(buf, tid >> 1, tid & 1, u); stage_r32_store(buf, tid >> 1, tid & 1, u); } __syncthreads();
}
__device__ __forceinline__ void fft_inv(LAS cf2* buf, cf2 w1, const LAS cf2* tw2l, int tid) {
    asm volatile("" : "+v"(tid));
    { cf2 u[16]; stage_r32_load<true>(buf, tid >> 1, tid & 1, u); stage_r32_store(buf, tid >> 1, tid & 1, u); } __syncthreads();
    { cf2 tw[15]; ld_tw2(tw2l, tid, tw); stage_r16<true>(buf, tw, (tid >> 5) * 512 + (tid & 31), 32); } __syncthreads();
    stage_r16_chain<true>(buf, w1, tid, 512); __syncthreads();
}
struct P8 { v4u own, prv, nxt; };
__device__ __forceinline__ P8 p8_load(const bf16* p, int m) { P8 r; r.own = *(const v4u*)(p + 8 * m); r.prv = *(const v4u*)(p + 8 * (m == 0 ? 511 : m - 1)); r.nxt = *(const v4u*)(p + 8 * (m == 511 ? 0 : m + 1)); return r; }
__device__ __forceinline__ void unpk8(const v4u& v, float (&o)[8]) { const unsigned w[4] = {v.x, v.y, v.z, v.w};
#pragma unroll
    for (int j = 0; j < 4; ++j) { o[2 * j] = __builtin_bit_cast(float, w[j] << 16); o[2 * j + 1] = __builtin_bit_cast(float, w[j] & 0xffff0000u); } }
__device__ __forceinline__ void p8_conv(const P8& r, int m, float w0, float w1, float w2, float cb, float (&o)[8]) {
    float a[8], b[8], c[8]; unpk8(r.own, a); unpk8(r.prv, b); unpk8(r.nxt, c);
#pragma unroll
    for (int j = 0; j < 8; ++j) { const float pv = m == 0 ? (j ? b[j - 1] : 0.f) : b[j]; const float nx = m == 511 ? (j < 7 ? c[j + 1] : 0.f) : c[j];
        o[j] = w0 * pv + w1 * a[j] + w2 * nx + cb; }
}
__device__ __forceinline__ void fft_mid_a(LAS cf2* Zb, LAS cf2* Wb, const LAS cf2* tw2l, int tid, int o, float sc) {
    asm volatile("" : "+v"(tid));
    __syncthreads();
    { cf2 tw[15]; ld_tw2(tw2l, tid, tw); stage_r16<false>(Zb, tw, (tid >> 5) * 512 + (tid & 31), 32); } __syncthreads();
    { cf2 u[16]; stage_r32_load<false>(Zb, tid >> 1, tid & 1, u); stage_r32_store_mul(Zb, Wb, tid >> 1, tid & 1, u, o, sc); } __syncthreads();
    { cf2 u[16]; stage_r32_load<true>(Zb, tid >> 1, tid & 1, u); stage_r32_store(Zb, tid >> 1, tid & 1, u); } __syncthreads();
}
__device__ __forceinline__ void fft_mid_b(LAS cf2* Zb, const LAS cf2* tw2l, int tid) {
    asm volatile("" : "+v"(tid));
    { cf2 tw[15]; ld_tw2(tw2l, tid, tw); stage_r16<true>(Zb, tw, (tid >> 5) * 512 + (tid & 31), 32); } __syncthreads();
}
__device__ __forceinline__ void hy_fft_item(ArgsP a, const Fr& F, int slot, int d, cf2 wtw) {
    LAS cf2* Zb = (LAS cf2*)F.lds;
    LAS cf2* Wb = Zb + FFT_BUF;
    LAS float* red = (LAS float*)(Wb + FFT_BUF);
    const LAS cf2* tw2l = (const LAS cf2*)(red + 16);
    const bf16* PT = (const bf16*)(a->ws + SC_PT); bf16* Z2T = (bf16*)(a->ws + SC_Z2T);
    const float* HF = (const float*)(a->ws + WS_HF + (size_t)slot * HF_SLOT);
    const int tid = F.tid;
    __syncthreads();
    { const float* f0 = HF + (size_t)(0 * 1024 + d) * SEQ; const float* b0 = HF + (size_t)(1 * 1024 + d) * SEQ;
      const float* f1 = HF + (size_t)(2 * 1024 + d) * SEQ; const float* b1 = HF + (size_t)(3 * 1024 + d) * SEQ;
      float s0 = 0.f, s1 = 0.f; float fa[8], fb[8], ba[8], bb[8];
#pragma unroll
      for (int j = 0; j < 8; ++j) { const int t = tid + 512 * j; fa[j] = f0[t]; fb[j] = f1[t]; ba[j] = b0[t]; bb[j] = b1[t]; }
#pragma unroll
      for (int j = 0; j < 8; ++j) { const int t = tid + 512 * j; Wb[fpad(t)] = (cf2){fa[j], fb[j]}; s0 += fabsf(fa[j]); s1 += fabsf(fb[j]);
          if (t >= 1) { Wb[fpad(FFT_N - t)] = (cf2){ba[j], bb[j]}; s0 += fabsf(ba[j]); s1 += fabsf(bb[j]); } }
      if (tid == 0) Wb[fpad(SEQ)] = (cf2){0.f, 0.f};
      s0 = wave_sum(s0); s1 = wave_sum(s1); if (F.lane == 0) { red[F.wave] = s0; red[8 + F.wave] = s1; } }
    __syncthreads();
    float nrm0, nrm1; { float s0 = 0.f, s1 = 0.f; for (int w = 0; w < 8; ++w) { s0 += red[w]; s1 += red[8 + w]; } nrm0 = 1.0f / (s0 + 1e-6f); nrm1 = 1.0f / (s1 + 1e-6f); }
    fft_fwd(Wb, wtw, tw2l, tid);
    const float* cw = a->in[I_HYCW] + (size_t)slot * 3 * 3072; const float* cbp = a->in[I_HYCB] + (size_t)slot * 3072;
    float w0[3], w1[3], w2[3], cb[3];
#pragma unroll
    for (int g = 0; g < 3; ++g) { const int c = g * 1024 + d; w0[g] = cw[c]; w1[g] = cw[3072 + c]; w2[g] = cw[2 * 3072 + c]; cb[g] = cbp[c]; }
    const float fb0 = a->in[I_FBIAS][(slot * 2 + 0) * 1024 + d], fb1 = a->in[I_FBIAS][(slot * 2 + 1) * 1024 + d];
    const float sc0 = nrm0 * (1.0f / FFT_N), sc1 = nrm1 * (1.0f / FFT_N);
#pragma unroll 1
    for (int pr = 0; pr < 2; ++pr) {
        int m = tid; asm volatile("" : "+v"(m));
        const bf16* pb = PT + (size_t)d * TA + (2 * pr) * SEQ;
        const P8 rv0 = p8_load(pb, m), rv1 = p8_load(pb + SEQ, m);
        float va[8], vb2[8];
        p8_conv(rv0, m, w0[0], w1[0], w2[0], cb[0], va); p8_conv(rv1, m, w0[0], w1[0], w2[0], cb[0], vb2);
        cf2 vin[8], x[16];
#pragma unroll
        for (int j = 0; j < 8; ++j) { vin[j] = (cf2){va[j], vb2[j]}; x[j] = vin[j]; x[j + 8] = (cf2){0.f, 0.f}; }
        stage1_fwd_regs(Zb, x, wtw, m);
        fft_mid_a(Zb, Wb, tw2l, tid, 0, sc0);
        const P8 rx0 = p8_load(pb + (size_t)1024 * TA, m), rx1 = p8_load(pb + (size_t)1024 * TA + SEQ, m);
        fft_mid_b(Zb, tw2l, tid);
        stage1_inv_regs(Zb, x, wtw, m);
        p8_conv(rx0, m, w0[1], w1[1], w2[1], cb[1], va); p8_conv(rx1, m, w0[1], w1[1], w2[1], cb[1], vb2);
#pragma unroll
        for (int j = 0; j < 8; ++j) { const cf2 xg = {va[j], vb2[j]}; vin[j] = xg * (x[j] + vin[j] * fb0); x[j] = vin[j]; x[j + 8] = (cf2){0.f, 0.f}; }
        stage1_fwd_regs(Zb, x, wtw, m);
        fft_mid_a(Zb, Wb, tw2l, tid, 1, sc1);
        const P8 rz0 = p8_load(pb + (size_t)2048 * TA, m), rz1 = p8_load(pb + (size_t)2048 * TA + SEQ, m);
        fft_mid_b(Zb, tw2l, tid);
        stage1_inv_regs(Zb, x, wtw, m);
        p8_conv(rz0, m, w0[2], w1[2], w2[2], cb[2], va); p8_conv(rz1, m, w0[2], w1[2], w2[2], cb[2], vb2);
        float z0[8], z1[8];
#pragma unroll
        for (int j = 0; j < 8; ++j) { const cf2 xg = {va[j], vb2[j]}; const cf2 z = xg * (x[j] + vin[j] * fb1); z0[j] = z.x; z1[j] = z.y; }
        bf16* o0 = Z2T + (size_t)d * TA + (2 * pr) * SEQ + 8 * m;
        v4u q0, q1; q0.x = pk2(z0[0], z0[1]); q0.y = pk2(z0[2], z0[3]); q0.z = pk2(z0[4], z0[5]); q0.w = pk2(z0[6], z0[7]);
        q1.x = pk2(z1[0], z1[1]); q1.y = pk2(z1[2], z1[3]); q1.z = pk2(z1[4], z1[5]); q1.w = pk2(z1[6], z1[7]);
        *(v4u*)o0 = q0; *(v4u*)(o0 + SEQ) = q1;
    }
}
__device__ __forceinline__ void phase_hy_conv_fft(ArgsP a, const Fr& F, int layer) {
    const int slot = layer == 0 ? 0 : 1; const int nitems = layer == 0 ? 2048 : 1024;
    {   const cf2* TW = (const cf2*)(a->ws + WS_TW);
        LAS cf2* tw2l = (LAS cf2*)((LAS float*)((LAS cf2*)F.lds + 2 * FFT_BUF) + 16);
        __syncthreads();
        if (F.tid < 32 * 15) { const int n3 = F.tid / 15, k = F.tid % 15 + 1; tw2l[F.tid] = TW[(16 * n3 * k) & (FFT_N - 1)]; }
        const cf2 w1 = TW[F.tid];
        __syncthreads();
        for (int it = F.vcu; it < 1024; it += F.G) hy_fft_item(a, F, slot, it, w1);
    }
    for (int it = 1024 + F.vcu; it < nitems; it += F.G) hy_ctx_item(a, F, slot, it - 1024);
}
#endif
#include <hip/hip_bf16.h>
namespace attn_body {
using bf16=__hip_bfloat16;
using bf16x8=__attribute__((ext_vector_type(8)))short;
using s16x4=__attribute__((ext_vector_type(4)))short;
using f32x16=__attribute__((ext_vector_type(16)))float;
using u32x4=__attribute__((ext_vector_type(4)))unsigned;
constexpr int BATCH=4,NHEAD=16,SEQ=4096,D=64,DM=NHEAD*D,KP=256,LKEYS=4352;
constexpr int NW=8,QBLK=32,QB=QBLK*NW,KVBLK=64,NQB=SEQ/QB;
constexpr int ATTN_PITCH=DM, ATTN_UNIT_ROWS=QB;
__device__ __forceinline__ int crow(int r,int hi){return (r&3)+8*(r>>2)+4*hi;}
#define SBAR() __builtin_amdgcn_sched_barrier(0)
__device__ __forceinline__ void cmask(f32x16&p0,f32x16&p1,int jb,int qrel,int hi){
  const float NEG=-INFINITY; int kb=64*jb+4*hi;
  #pragma unroll
  for(int r=0;r<16;++r){int kv=kb+(r&3)+8*(r>>2); if(kv>qrel)p0[r]=NEG; if(kv+32>qrel)p1[r]=NEG;}
}

constexpr int NSLOT=3, SLOTB=8192;
constexpr int LDS_K=0, LDS_V=NSLOT*SLOTB, LDS_WS=2*NSLOT*SLOTB, LDS_OST=LDS_WS+NW*64*4, LDS_BYTES=LDS_OST+NW*4096;
constexpr float C2=0.125f*1.4426950408889634f;
__device__ __forceinline__ void glds16(const void*gsrc,unsigned lds_dst){unsigned keep;
  asm volatile("s_mov_b32 %0, m0\n\ts_mov_b32 m0, %2\n\ts_nop 0\n\tglobal_load_lds_dwordx4 %1, off\n\ts_mov_b32 m0, %0":"=&s"(keep):"v"(gsrc),"s"(lds_dst):"memory");}
__device__ __forceinline__ float max3f(float a,float b,float c){float r;asm("v_max3_f32 %0, %1, %2, %3":"=v"(r):"v"(a),"v"(b),"v"(c));return r;}
__device__ __forceinline__ float max2f(float a,float b){float r;asm("v_max_f32_e32 %0, %1, %2":"=v"(r):"v"(a),"v"(b));return r;}
__device__ __forceinline__ float fadd_s(float a,float b){float r;asm("v_add_f32_e32 %0, %1, %2":"=v"(r):"v"(a),"v"(b));return r;}
__device__ __forceinline__ float fsub_s(float a,float b){float r;asm("v_sub_f32_e32 %0, %1, %2":"=v"(r):"v"(a),"v"(b));return r;}
typedef float f32x2_t __attribute__((ext_vector_type(2))); typedef __bf16 bf16x2_t __attribute__((ext_vector_type(2)));
__device__ __forceinline__ unsigned cvtpk_s(float lo,float hi){f32x2_t v={lo,hi};bf16x2_t b=__builtin_convertvector(v,bf16x2_t);return __builtin_bit_cast(unsigned,b);}
#define WAIT_BAR(N) asm volatile("s_waitcnt vmcnt(" #N ") lgkmcnt(0)\n\ts_barrier":::"memory")

__device__ __forceinline__ void qkt(f32x16&p0,f32x16&p1,const char*Kslot,const bf16x8*qr,const f32x16&negm,int r32,int hi){
  const char*kb=Kslot+hi*1024+r32*16;
  #pragma unroll
  for(int d0=0;d0<4;++d0){
    const bf16x8 b0=*reinterpret_cast<const bf16x8*>(kb+d0*2048);
    const bf16x8 b1=*reinterpret_cast<const bf16x8*>(kb+d0*2048+512);
    if(d0==0){p0=__builtin_amdgcn_mfma_f32_32x32x16_bf16(b0,qr[0],negm,0,0,0);p1=__builtin_amdgcn_mfma_f32_32x32x16_bf16(b1,qr[0],negm,0,0,0);}
    else{p0=__builtin_amdgcn_mfma_f32_32x32x16_bf16(b0,qr[d0],p0,0,0,0);p1=__builtin_amdgcn_mfma_f32_32x32x16_bf16(b1,qr[d0],p1,0,0,0);}}
}
typedef __attribute__((address_space(3))) const char* lds_cptr;
typedef short v4i16_t __attribute__((ext_vector_type(4)));
__device__ __forceinline__ void kload8(bf16x8*kf,lds_cptr kp){
  kf[0]=*(const __attribute__((address_space(3))) bf16x8*)(kp);      kf[1]=*(const __attribute__((address_space(3))) bf16x8*)(kp+512);
  kf[2]=*(const __attribute__((address_space(3))) bf16x8*)(kp+2048); kf[3]=*(const __attribute__((address_space(3))) bf16x8*)(kp+2560);
  kf[4]=*(const __attribute__((address_space(3))) bf16x8*)(kp+4096); kf[5]=*(const __attribute__((address_space(3))) bf16x8*)(kp+4608);
  kf[6]=*(const __attribute__((address_space(3))) bf16x8*)(kp+6144); kf[7]=*(const __attribute__((address_space(3))) bf16x8*)(kp+6656);
}
__device__ __forceinline__ void kload2(bf16x8*kf,lds_cptr kp,int j){ kf[2*j]=*(const __attribute__((address_space(3))) bf16x8*)(kp+j*2048); kf[2*j+1]=*(const __attribute__((address_space(3))) bf16x8*)(kp+j*2048+512); }
__device__ __forceinline__ s16x4 vtr(lds_cptr p){ return __builtin_bit_cast(s16x4,__builtin_amdgcn_ds_read_tr16_b64_v4i16((__attribute__((address_space(3))) v4i16_t*)p)); }
__device__ __forceinline__ float rowmax(const f32x16&p0,const f32x16&p1){
  float a=max3f(p0[0],p0[1],p1[0]),b=max3f(p0[2],p0[3],p1[1]);a=max3f(a,p1[2],p1[3]);
  #pragma unroll
  for(int r=4;r<16;r+=4){a=max3f(a,p0[r],p0[r+1]);b=max3f(b,p0[r+2],p0[r+3]);a=max3f(a,p1[r],p1[r+1]);b=max3f(b,p1[r+2],p1[r+3]);}
  const float m=max2f(a,b);
  auto rr=__builtin_amdgcn_permlane32_swap(__float_as_uint(m),__float_as_uint(m),false,false);
  return max2f(__uint_as_float(rr[0]),__uint_as_float(rr[1]));
}
__device__ __forceinline__ void pv(f32x16*o,int vb,bf16x8 pa0,bf16x8 pa1,bf16x8 pa2,bf16x8 pa3){
  #pragma unroll
  for(int d0=0;d0<2;++d0){s16x4 lo[4],hi[4];
    #pragma unroll
    for(int ks=0;ks<4;++ks){
      asm volatile("ds_read_b64_tr_b16 %0,%1 offset:%c2":"=&v"(lo[ks]):"v"(vb),"i"(d0*4096+ks*1024):"memory");
      asm volatile("ds_read_b64_tr_b16 %0,%1 offset:%c2":"=&v"(hi[ks]):"v"(vb),"i"(d0*4096+ks*1024+512):"memory");}
    asm volatile("s_waitcnt lgkmcnt(0)":::"memory");SBAR();
    #define PK(k) (bf16x8){lo[k][0],lo[k][1],lo[k][2],lo[k][3],hi[k][0],hi[k][1],hi[k][2],hi[k][3]}
    o[d0]=__builtin_amdgcn_mfma_f32_32x32x16_bf16(pa0,PK(0),o[d0],0,0,0);
    o[d0]=__builtin_amdgcn_mfma_f32_32x32x16_bf16(pa1,PK(1),o[d0],0,0,0);
    o[d0]=__builtin_amdgcn_mfma_f32_32x32x16_bf16(pa2,PK(2),o[d0],0,0,0);
    o[d0]=__builtin_amdgcn_mfma_f32_32x32x16_bf16(pa3,PK(3),o[d0],0,0,0);
    #undef PK
  }
}

#ifndef ATTN_STORE16
#if MK_FP8_AOUT
#define ATTN_STORE16(p,v) do { const long off_ = (const bf16*)(p) - (const bf16*)O; const u32x4 v_ = (v); ::v2u o8_; \
    o8_.x = ::pk4_e4m3((::f32x4){__builtin_bit_cast(float, v_.x << 16), __builtin_bit_cast(float, v_.x & 0xffff0000u), __builtin_bit_cast(float, v_.y << 16), __builtin_bit_cast(float, v_.y & 0xffff0000u)} * O_SCALE); \
    o8_.y = ::pk4_e4m3((::f32x4){__builtin_bit_cast(float, v_.z << 16), __builtin_bit_cast(float, v_.z & 0xffff0000u), __builtin_bit_cast(float, v_.w << 16), __builtin_bit_cast(float, v_.w & 0xffff0000u)} * O_SCALE); \
    *(::v2u*)((unsigned char*)O + off_) = o8_; } while (0)
#else
#define ATTN_STORE16(p,v) (*(u32x4*)(p)=(v))
#endif
#endif
template<int THRL> __device__ __forceinline__ void attn_unit(int b,int h,int qb,const bf16*Q,const bf16*__restrict__ K,const bf16*__restrict__ V,bf16*O,char*shm){
  int tid_=threadIdx.x; asm volatile("":"+v"(tid_)); const int tid=tid_,lane=tid&63,r32=lane&31,hi=lane>>5; const int wid=__builtin_amdgcn_readfirstlane(tid>>6);
  const long rowbase=(long)b*SEQ; const int q0=qb*QB;
  const bf16*Qw=Q+(rowbase+q0+wid*QBLK)*DM+h*D;
  const bf16*Kh=K+(long)b*LKEYS*KP+(h>>2)*D,*Vh=V+(long)b*LKEYS*KP+(h>>2)*D;
  const unsigned lds0=(unsigned)(uintptr_t)shm;
  float*wsf=(float*)(shm+LDS_WS)+wid*64;
  const bf16*ksrc=Kh+(long)lane*KP+wid*8;
  const bf16*vsrc=Vh+(long)(16*(wid&3)+(lane>>2))*KP+(wid>>2)*32+(lane&3)*8;
  const unsigned kdst=lds0+LDS_K+wid*1024, vdst=lds0+LDS_V+wid*1024;
  #define DMA_K(t,slot) glds16(ksrc+(long)(t)*KVBLK*KP,(unsigned)__builtin_amdgcn_readfirstlane(kdst+(slot)))
  #define DMA_V(t,slot) glds16(vsrc+(long)(t)*KVBLK*KP,(unsigned)__builtin_amdgcn_readfirstlane(vdst+(slot)))
  const int vb0=(int)(lds0+LDS_V)+((lane>>4)&1)*32+(lane&3)*8+(4*hi+((lane&15)>>2))*64;
  const char*Kbase=shm+LDS_K; bf16x8 kf[8];
  const lds_cptr shm3=(lds_cptr)shm; const lds_cptr kp0=shm3+LDS_K+hi*1024+r32*16; const lds_cptr vp0=shm3+LDS_V+((lane>>4)&1)*32+(lane&3)*8+(4*hi+((lane&15)>>2))*64;
  const int NT=LKEYS/KVBLK;
  DMA_K(0,0);DMA_V(0,0);DMA_K(1,SLOTB);
  bf16x8 qr[4];
  #pragma unroll
  for(int d0=0;d0<4;++d0)qr[d0]=*reinterpret_cast<const bf16x8*>(&Qw[(long)r32*DM+d0*16+hi*8]);
  float mhat=0.f,l_reg=0.f;f32x16 o[2];o[0]=f32x16{};o[1]=f32x16{};f32x16 negm=f32x16{};asm volatile("":"+v"(negm));

  #define CMASK(P0,P1,t) do{}while(0)
  bool resc=false;
  #define START(P0,P1) do{ const float rm=rowmax(P0,P1); resc=false; \
    { const float dl=rm; mhat=fadd_s(mhat,dl); \
      _Pragma("unroll") for(int r=0;r<16;++r){P0[r]=fsub_s(P0[r],dl);P1[r]=fsub_s(P1[r],dl);} \
      _Pragma("unroll") for(int r=0;r<16;++r)negm[r]=-mhat; asm volatile("":"+v"(negm)); } \
    _Pragma("unroll") for(int r=0;r<16;++r)P0[r]=__builtin_amdgcn_exp2f(P0[r]); }while(0)
  #define RESC() do{ if(resc){ asm volatile("s_waitcnt lgkmcnt(0)":::"memory"); \
      _Pragma("unroll") for(int d_=0;d_<2;++d_) _Pragma("unroll") for(int r=0;r<16;++r)o[d_][r]*=wsf[crow(r,hi)]; } }while(0)
  f32x16 pA0,pA1,pB0,pB1;
  int sl_prev=0,sl_cur=0,sl_next=SLOTB;
  #define ROT() do{sl_prev=sl_cur;sl_cur=sl_next;sl_next=(sl_next==(NSLOT-1)*SLOTB)?0:sl_next+SLOTB;}while(0)
  DMA_K(2,2*SLOTB);
  WAIT_BAR(3);
  qkt(pA0,pA1,Kbase,qr,negm,r32,hi);asm volatile("s_nop 15\n\ts_nop 7":"+v"(pA0),"+v"(pA1));CMASK(pA0,pA1,0);
  START(pA0,pA1);
  _Pragma("unroll") for(int r=0;r<16;++r)pA1[r]=__builtin_amdgcn_exp2f(pA1[r]);
  WAIT_BAR(0);
  DMA_K(3,0);DMA_V(1,SLOTB);
  ROT();
  kload8(kf,kp0+sl_cur);
  WAIT_BAR(2);
  s16x4 vlo[8],vhi[8]; u32x4 pw0,pw1,pw2,pw3;
  #define PKW(P,B) cvtpk_s(P[B],P[B+1])
  #define PAF(k) __builtin_bit_cast(bf16x8,pw##k)
  #define VFR(i) (bf16x8){vlo[i][0],vlo[i][1],vlo[i][2],vlo[i][3],vhi[i][0],vhi[i][1],vhi[i][2],vhi[i][3]}
  #define PIN(x) asm volatile("":"+v"(x))
  #define MX3(a,b,c) __builtin_fmaxf(__builtin_fmaxf((a),(b)),(c))
  #define GAPA(MF,A0,A1,A2,A3,W0,W1,PW) do{ MF; sacc+=A0; sacc+=A1; sacc+=A2; sacc+=A3; PIN(sacc); W0; W1; PIN(PW); SBAR(); }while(0)
  #define EX(v) __builtin_amdgcn_exp2f(v)
  #define GAPB(MF,X,B) do{ MF; X[B]=EX(X[B]); X[B+1]=EX(X[B+1]); X[B+2]=EX(X[B+2]); X[B+3]=EX(X[B+3]); PIN(X); SBAR(); }while(0)
  #define VRD(i) do{ vlo[i]=vtr(vp_+(((i)>>2)*4096+((i)&3)*1024)); vhi[i]=vtr(vp_+(((i)>>2)*4096+((i)&3)*1024+512)); }while(0)
  #define KRD(G,j) do{ if(G){ kload2(kf,kp0+sl_next,j); SBAR(); } }while(0)
  #define STEP(C0,C1,P0,P1,t,GK,GV,GL) do{ SBAR(); \
    const lds_cptr vp_=vp0+sl_prev; \
    VRD(0); SBAR(); float sacc=(P0[0]+P0[1]); \
    GAPA(C0=__builtin_amdgcn_mfma_f32_32x32x16_bf16(kf[0],qr[0],negm,0,0,0), P0[2],P0[3],P0[4],P0[5],     pw0[0]=PKW(P0,0), pw0[1]=PKW(P0,2), pw0); \
    VRD(4); SBAR(); GAPA(C1=__builtin_amdgcn_mfma_f32_32x32x16_bf16(kf[1],qr[0],negm,0,0,0), P0[6],P0[7],P0[8],P0[9],     pw0[2]=PKW(P0,4), pw0[3]=PKW(P0,6), pw0); \
    VRD(1); SBAR(); GAPA(C0=__builtin_amdgcn_mfma_f32_32x32x16_bf16(kf[2],qr[1],C0,0,0,0),   P0[10],P0[11],P0[12],P0[13], pw1[0]=PKW(P0,8), pw1[1]=PKW(P0,10), pw1); \
    VRD(5); SBAR(); GAPA(C1=__builtin_amdgcn_mfma_f32_32x32x16_bf16(kf[3],qr[1],C1,0,0,0),   P0[14],P0[15],P1[0],P1[1],   pw1[2]=PKW(P0,12),pw1[3]=PKW(P0,14), pw1); \
    VRD(2); SBAR(); GAPA(C0=__builtin_amdgcn_mfma_f32_32x32x16_bf16(kf[4],qr[2],C0,0,0,0),   P1[2],P1[3],P1[4],P1[5],     pw2[0]=PKW(P1,0), pw2[1]=PKW(P1,2), pw2); \
    VRD(6); SBAR(); GAPA(C1=__builtin_amdgcn_mfma_f32_32x32x16_bf16(kf[5],qr[2],C1,0,0,0),   P1[6],P1[7],P1[8],P1[9],     pw2[2]=PKW(P1,4), pw2[3]=PKW(P1,6), pw2); \
    VRD(3); SBAR(); GAPA(C0=__builtin_amdgcn_mfma_f32_32x32x16_bf16(kf[6],qr[3],C0,0,0,0),   P1[10],P1[11],P1[12],P1[13], pw3[0]=PKW(P1,8), pw3[1]=PKW(P1,10), pw3); \
    VRD(7); SBAR(); GAPA(C1=__builtin_amdgcn_mfma_f32_32x32x16_bf16(kf[7],qr[3],C1,0,0,0),   P1[14],P1[15],0.f,0.f,       pw3[2]=PKW(P1,12),pw3[3]=PKW(P1,14), pw3); \
    l_reg+=sacc; \
    if(GK){DMA_K((t)+3,sl_cur);} if(GV){DMA_V((t)+1,sl_next);} \
    CMASK(C0,C1,t); \
    { float a=MX3(C0[0],C0[1],C1[0]),b=MX3(C0[2],C0[3],C1[1]); a=MX3(a,C1[2],C1[3]); \
      _Pragma("unroll") for(int r=4;r<16;r+=4){a=MX3(a,C0[r],C0[r+1]);b=MX3(b,C0[r+2],C0[r+3]);a=MX3(a,C1[r],C1[r+1]);b=MX3(b,C1[r+2],C1[r+3]);} \
      float rm=__builtin_fmaxf(a,b); { auto rr=__builtin_amdgcn_permlane32_swap(__float_as_uint(rm),__float_as_uint(rm),false,false); rm=__builtin_fmaxf(__uint_as_float(rr[0]),__uint_as_float(rr[1])); } \
      resc=false; \
      if(__builtin_expect(__any(rm>(float)THRL),0)){ const float dl=__builtin_fmaxf(rm,0.f); mhat+=dl; \
        _Pragma("unroll") for(int r=0;r<16;++r){C0[r]-=dl;C1[r]-=dl;} \
        _Pragma("unroll") for(int r=0;r<16;++r)negm[r]=-mhat; asm volatile("":"+v"(negm)); \
        const float f=__builtin_amdgcn_exp2f(-dl); l_reg*=f; if(hi==0)wsf[r32]=f; resc=true; } } \
    SBAR(); \
    GAPB(o[0]=__builtin_amdgcn_mfma_f32_32x32x16_bf16(PAF(0),VFR(0),o[0],0,0,0), C0,0); \
    GAPB(o[1]=__builtin_amdgcn_mfma_f32_32x32x16_bf16(PAF(0),VFR(4),o[1],0,0,0), C0,4); \
    KRD(GL,0); GAPB(o[0]=__builtin_amdgcn_mfma_f32_32x32x16_bf16(PAF(1),VFR(1),o[0],0,0,0), C0,8); \
    KRD(GL,1); GAPB(o[1]=__builtin_amdgcn_mfma_f32_32x32x16_bf16(PAF(1),VFR(5),o[1],0,0,0), C0,12); \
    KRD(GL,2); GAPB(o[0]=__builtin_amdgcn_mfma_f32_32x32x16_bf16(PAF(2),VFR(2),o[0],0,0,0), C1,0); \
    KRD(GL,3); GAPB(o[1]=__builtin_amdgcn_mfma_f32_32x32x16_bf16(PAF(2),VFR(6),o[1],0,0,0), C1,4); \
    GAPB(o[0]=__builtin_amdgcn_mfma_f32_32x32x16_bf16(PAF(3),VFR(3),o[0],0,0,0), C1,8); \
    GAPB(o[1]=__builtin_amdgcn_mfma_f32_32x32x16_bf16(PAF(3),VFR(7),o[1],0,0,0), C1,12); \
    }while(0)
  int t=1;
  #undef CMASK
  #define CMASK(P0,P1,t) do{}while(0)
  for(;t+5<NT;t+=2){
    STEP(pB0,pB1,pA0,pA1,t,true,true,true);     WAIT_BAR(2); RESC(); ROT();
    STEP(pA0,pA1,pB0,pB1,t+1,true,true,true);   WAIT_BAR(2); RESC(); ROT();
  }
  #undef CMASK
  #define CMASK(P0,P1,t) do{}while(0)
  #define ENDW(tt) do{ if((tt)+3<NT){WAIT_BAR(2);} else if((tt)+2<NT){WAIT_BAR(1);} else {WAIT_BAR(0);} }while(0)
  for(;t+1<NT;t+=2){
    STEP(pB0,pB1,pA0,pA1,t,(t+3<NT),(t+1<NT),(t+1<NT));       ENDW(t);   RESC(); ROT();
    STEP(pA0,pA1,pB0,pB1,t+1,(t+4<NT),(t+2<NT),(t+2<NT));     ENDW(t+1); RESC(); ROT();
  }
  STEP(pB0,pB1,pA0,pA1,NT-1,false,false,false); RESC();
  { float sacc=pB0[0]+pB0[1]; _Pragma("unroll") for(int r=2;r<16;++r)sacc+=pB0[r]; _Pragma("unroll") for(int r=0;r<16;++r)sacc+=pB1[r]; l_reg+=sacc;
    pw0=(u32x4){PKW(pB0,0),PKW(pB0,2),PKW(pB0,4),PKW(pB0,6)};pw1=(u32x4){PKW(pB0,8),PKW(pB0,10),PKW(pB0,12),PKW(pB0,14)};pw2=(u32x4){PKW(pB1,0),PKW(pB1,2),PKW(pB1,4),PKW(pB1,6)};pw3=(u32x4){PKW(pB1,8),PKW(pB1,10),PKW(pB1,12),PKW(pB1,14)};
    SBAR(); pv(o,vb0+sl_cur,PAF(0),PAF(1),PAF(2),PAF(3)); }
  #undef PKW
  #undef PAF
  #undef VFR
  #undef PIN
  #undef MX3
  #undef GAPA
  #undef GAPB
  #undef EX
  #undef VRD
  #undef KRD
  #undef STEP
  #undef ENDW
  {auto rr=__builtin_amdgcn_permlane32_swap(__float_as_uint(l_reg),__float_as_uint(l_reg),false,false);l_reg=__uint_as_float(rr[0])+__uint_as_float(rr[1]);}
  if(hi==0)wsf[32+r32]=l_reg;asm volatile("s_waitcnt lgkmcnt(0)":::"memory");
  float rli[16];
  #pragma unroll
  for(int r=0;r<16;++r)rli[r]=__builtin_amdgcn_rcpf(wsf[32+crow(r,hi)]);
  bf16*Ow=O+(rowbase+q0+wid*QBLK)*DM+h*D;
  { bf16*stg=(bf16*)(shm+LDS_OST)+wid*2048;
    #pragma unroll
    for(int r=0;r<16;++r){const int orow=crow(r,hi);
      #pragma unroll
      for(int d0=0;d0<2;++d0)stg[orow*64+d0*32+r32]=__float2bfloat16(o[d0][r]*rli[r]);}
    asm volatile("s_waitcnt lgkmcnt(0)":::"memory");
    #pragma unroll
    for(int i=0;i<4;++i){const int row=i*8+(lane>>3),ch=lane&7; const u32x4 v=*(const u32x4*)(stg+row*64+ch*8); ATTN_STORE16(Ow+(long)row*DM+ch*8,v);} }
  asm volatile("s_waitcnt lgkmcnt(0)\n\ts_barrier":::"memory");
  #undef DMA_K
  #undef DMA_V
  #undef CMASK
  #undef START
  #undef RESC
  #undef ROT
}
constexpr int ATTN_LDS_BYTES=LDS_BYTES;
struct AttnTensors { const bf16* Q; const bf16* K; const bf16* V; bf16* O; };
struct AttnUnit { int bh; int qb; };
struct StaticOrder {
  int vcu, per;
  __device__ __forceinline__ explicit StaticOrder(int grid,int vcu_):vcu(vcu_),per((BATCH*NHEAD*(SEQ/QB)+grid-1)/grid){}
  __device__ __forceinline__ bool next(int i,AttnUnit&u)const{ if(i>=per)return false; const int idx=vcu*per+i; if(idx>=BATCH*NHEAD*(SEQ/QB))return false; u.bh=idx/(SEQ/QB); u.qb=idx%(SEQ/QB); return true; }
  __device__ __forceinline__ void a_ready(const AttnUnit&)const{}
  __device__ __forceinline__ void done(const AttnUnit&)const{}
};
template<class Sched,int THRL=8> __device__ __forceinline__ void attn_phase(char*lds,const AttnTensors&T,const Sched&S){
  AttnUnit u;
  for(int i=0;S.next(i,u);++i){ S.a_ready(u); attn_unit<THRL>(u.bh/NHEAD,u.bh%NHEAD,u.qb,T.Q,T.K,T.V,T.O,lds); S.done(u); }
}
#undef SBAR
#undef WAIT_BAR
}

__device__ __forceinline__ void phase_attn_fast(ArgsP a, const Fr& F) {
    const attn_body::AttnTensors AT{(const attn_body::bf16*)(a->ws + SC_Q), (const attn_body::bf16*)(a->ws + SC_K), (const attn_body::bf16*)(a->ws + SC_V), (attn_body::bf16*)(a->ws + SC_O)};
    const attn_body::StaticOrder S(F.G, F.vcu);
    __syncthreads();
    attn_body::attn_phase<attn_body::StaticOrder>((char*)F.lds, AT, S);
    __syncthreads();
}
__device__ __forceinline__ void phase_sp_fast(ArgsP a, const Fr& F) {
    typedef short bf16x8 __attribute__((ext_vector_type(8)));
    constexpr int PITCH = 136;
    LAS unsigned short* As = (LAS unsigned short*)F.lds;
    LAS unsigned short* Bs = As + 128 * PITCH;
    LAS float* st = (LAS float*)(Bs + 128 * PITCH);
    const bf16* VT = (const bf16*)(a->ws + SC_VT); const f32x2* VST = (const f32x2*)(a->ws + SC_VST); const bf16* UB = (const bf16*)(a->ws + SC_UB); bf16* UV = (bf16*)(a->ws + SC_UV);
    const bf16* WS = (const bf16*)(a->ws + WS_WCMS);
    const float* lng = a->in[I_CMLNG]; const float* lnb = a->in[I_CMLNB]; const float* bs = a->in[I_CMBS];
    const int tid = F.tid, lane = F.lane, wid = F.wave, wr = wid >> 2, wc = wid & 3, fr = lane & 15, fq = lane >> 4;
    const int per = (2048 + F.G - 1) / F.G; int gl = -1;
    const int s4 = (lane & 31) * 4, ch = lane >> 5;
    const int it_lo = F.vcu * per, it_hi = ((F.vcu + 1) * per < 2048) ? (F.vcu + 1) * per : 2048;
#define SP_BAR() asm volatile("s_waitcnt lgkmcnt(0)\n\ts_barrier" ::: "memory")
#define SP_PREFETCH(it_) do { const int g_ = (it_) >> 7, n_ = (it_) & 127; \
        _Pragma("unroll") for (int q = 0; q < 8; ++q) vt_n[q] = *(const v2u*)(VT + (size_t)(g_ * 128 + q * 16 + wid * 2 + ch) * T + n_ * 128 + s4); \
        if (tid < 128) { _Pragma("unroll") for (int p = 0; p < 16; ++p) vst_n[p] = VST[(size_t)p * T + n_ * 128 + tid]; } } while (0)
    v2u vt_n[8]; f32x2 vst_n[16];
#pragma unroll
    for (int p = 0; p < 16; ++p) vst_n[p] = (f32x2){0.f, 0.f};
    if (it_lo < it_hi) SP_PREFETCH(it_lo);
    for (int it = it_lo; it < it_hi; ++it) {
        const int g = it >> 7, n = it & 127;
        v2u vt[8];
#pragma unroll
        for (int q = 0; q < 8; ++q) vt[q] = vt_n[q];
        float s1 = 0.f, s2 = 0.f;
#pragma unroll
        for (int p = 0; p < 16; ++p) { s1 += vst_n[p].x; s2 += vst_n[p].y; }
        v2u ub[4][2];
#pragma unroll
        for (int m = 0; m < 4; ++m)
#pragma unroll
            for (int nn = 0; nn < 2; ++nn) ub[m][nn] = *(const v2u*)(UB + (size_t)(n * 128 + wr * 64 + m * 16 + fr) * 2048 + g * 128 + wc * 32 + nn * 16 + 4 * fq);
        SP_BAR();
        if (g != gl) { gl = g;
#pragma unroll
            for (int q = 0; q < 4; ++q) { const int idx = tid + q * NTHR, t = idx >> 4, ck = idx & 15;
                *(LAS v4u*)(As + t * PITCH + ck * 8) = *(const v4u*)(WS + (size_t)g * 16384 + t * 128 + ck * 8); } }
        if (tid < 128) { const float mean = s1 * (1.0f / 2048.0f); const float var = s2 * (1.0f / 2048.0f) - mean * mean; st[tid * 2] = mean; st[tid * 2 + 1] = 1.0f / sqrtf(var + LN_EPS); }
        if (it + 1 < it_hi) SP_PREFETCH(it + 1);
        SP_BAR();
        { const f32x4 mu = {st[(s4 + 0) * 2], st[(s4 + 1) * 2], st[(s4 + 2) * 2], st[(s4 + 3) * 2]};
          const f32x4 rs = {st[(s4 + 0) * 2 + 1], st[(s4 + 1) * 2 + 1], st[(s4 + 2) * 2 + 1], st[(s4 + 3) * 2 + 1]};
#pragma unroll
          for (int q = 0; q < 8; ++q) { const int c = q * 16 + wid * 2 + ch; const int chn = g * 128 + c;
              const f32x4 v = up4(vt[q]);
              const float lg = lng[chn], lb = lnb[chn];
              const f32x4 y = (v - mu) * rs * lg + lb;
              v2u o; o.x = pk2(y[0], y[1]); o.y = pk2(y[2], y[3]); *(LAS v2u*)(Bs + c * PITCH + s4) = o; } }
        SP_BAR();
        f32x4 acc[4][2];
#pragma unroll
        for (int m = 0; m < 4; ++m)
#pragma unroll
            for (int nn = 0; nn < 2; ++nn) acc[m][nn] = (f32x4){0.f, 0.f, 0.f, 0.f};
#pragma unroll
        for (int k = 0; k < 4; ++k) {
            bf16x8 af[4], bfr[2];
#pragma unroll
            for (int m = 0; m < 4; ++m) af[m] = *(const LAS bf16x8*)(As + (wr * 64 + m * 16 + fr) * PITCH + k * 32 + fq * 8);
#pragma unroll
            for (int nn = 0; nn < 2; ++nn) bfr[nn] = *(const LAS bf16x8*)(Bs + (wc * 32 + nn * 16 + fr) * PITCH + k * 32 + fq * 8);
#pragma unroll
            for (int m = 0; m < 4; ++m)
#pragma unroll
                for (int nn = 0; nn < 2; ++nn) acc[m][nn] = __builtin_amdgcn_mfma_f32_16x16x32_bf16(bfr[nn], af[m], acc[m][nn], 0, 0, 0);
        }
#pragma unroll
        for (int m = 0; m < 4; ++m) { const int t = wr * 64 + m * 16 + fr; const float bt = bs[g * 128 + t];
#pragma unroll
            for (int nn = 0; nn < 2; ++nn) { const size_t idx = (size_t)(n * 128 + t) * 2048 + g * 128 + wc * 32 + nn * 16 + 4 * fq;
                const v2u ubv = ub[m][nn]; const f32x4 o = acc[m][nn] + bt;
#if MK_FP8_CMOUT
                const f32x4 uvv = {__builtin_bit_cast(float, ubv.x << 16) * o[0], __builtin_bit_cast(float, ubv.x & 0xffff0000u) * o[1], __builtin_bit_cast(float, ubv.y << 16) * o[2], __builtin_bit_cast(float, ubv.y & 0xffff0000u) * o[3]};
                *(unsigned*)((unsigned char*)UV + idx) = pk4_e4m3(uvv * O_SCALE); } }
#else
                v2u w; w.x = pk2(__builtin_bit_cast(float, ubv.x << 16) * o[0], __builtin_bit_cast(float, ubv.x & 0xffff0000u) * o[1]);
                w.y = pk2(__builtin_bit_cast(float, ubv.y << 16) * o[2], __builtin_bit_cast(float, ubv.y & 0xffff0000u) * o[3]);
                *(v2u*)(UV + idx) = w; } }
#endif
    }
#undef SP_BAR
#undef SP_PREFETCH
}
__device__ __forceinline__ void phase_rope(ArgsP a, const Fr& F) {
    LAS f32x2* tab = (LAS f32x2*)F.lds;
    __syncthreads();
    for (int u = F.tid; u < 1024; u += NTHR) { const int pos = u >> 4, f = u & 15; const float invf = powf(10000.0f, -(float)f / 16.0f); float sn, cs; sincosf((float)pos * invf, &sn, &cs); tab[u] = (f32x2){cs, sn}; }
    __syncthreads();
    const bf16* QKV = (const bf16*)(a->ws + SC_QKV); bf16* Q = (bf16*)(a->ws + SC_Q); bf16* K = (bf16*)(a->ws + SC_K); bf16* V = (bf16*)(a->ws + SC_V);
    const int gw = F.vcu * NWAVES + F.wave, NGW = F.G * NWAVES;
    const int l8 = F.lane & 7, hl = F.lane >> 3;
    const f32x4 qg0 = *(const f32x4*)(a->in[I_QGAIN] + 4 * l8), qg1 = *(const f32x4*)(a->in[I_QGAIN] + 32 + 4 * l8);
    const f32x4 kg0 = *(const f32x4*)(a->in[I_KGAIN] + 4 * l8), kg1 = *(const f32x4*)(a->in[I_KGAIN] + 32 + 4 * l8);
    for (int row0 = gw; row0 < TA; row0 += 4 * NGW) {
        v2u xa[4][3], xb[4][3];
#pragma unroll
        for (int rr = 0; rr < 4; ++rr) { const int row = row0 + rr * NGW < TA ? row0 + rr * NGW : row0; const bf16* src = QKV + (size_t)row * 1536 + hl * 64 + 4 * l8;
#pragma unroll
            for (int p = 0; p < 3; ++p) { xa[rr][p] = *(const v2u*)(src + p * 512); xb[rr][p] = *(const v2u*)(src + p * 512 + 32); } }
#pragma unroll
        for (int rr = 0; rr < 4; ++rr) { const int row = row0 + rr * NGW; if (row >= TA) break;
            const bool lat = row < T; const int b = lat ? (row >> 12) : ((row - T) >> 8); const int t = lat ? (row & 4095) : ((row - T) & 255);
            f32x4 cs = {1.f, 1.f, 1.f, 1.f}, sn = {0.f, 0.f, 0.f, 0.f};
            if (lat) { const int pos = (l8 < 4) ? (t >> 6) : (t & 63); const LAS f32x4* tp = (const LAS f32x4*)(tab + pos * 16 + 4 * (l8 & 3));
                const f32x4 c01 = tp[0], c23 = tp[1]; cs = (f32x4){c01[0], c01[2], c23[0], c23[2]}; sn = (f32x4){c01[1], c01[3], c23[1], c23[3]}; }
            const size_t krow = (size_t)b * LK + (lat ? LC + t : t);
#pragma unroll
            for (int p = 0; p < 3; ++p) {
                if (p < 2 && !lat) continue;
                if (p == 2 && hl >= 4) { bf16* d = V + krow * KVP + (hl - 4) * 64 + 4 * l8; *(v2u*)d = xa[rr][p]; *(v2u*)(d + 32) = xb[rr][p]; }
                else {
                    const f32x4 x1 = up4(xa[rr][p]), x2 = up4(xb[rr][p]);
                    float ss = ((x1[0] * x1[0] + x1[1] * x1[1]) + (x1[2] * x1[2] + x1[3] * x1[3])) + ((x2[0] * x2[0] + x2[1] * x2[1]) + (x2[2] * x2[2] + x2[3] * x2[3]));
                    ss += __shfl_xor(ss, 1); ss += __shfl_xor(ss, 2); ss += __shfl_xor(ss, 4);
                    const float rs = 1.0f / sqrtf(ss * (1.0f / 64.0f) + RMS_EPS);
                    const bool isq = p < 2;
                    const f32x4 n1 = x1 * rs * (isq ? qg0 : kg0), n2 = x2 * rs * (isq ? qg1 : kg1);
                    f32x4 o1 = n1 * cs - n2 * sn, o2 = n1 * sn + n2 * cs;
                    bf16* d;
                    if (isq) { o1 *= ATT_C2; o2 *= ATT_C2; d = Q + (size_t)row * 1024 + (p * 8 + hl) * 64 + 4 * l8; }
                    else d = K + krow * KVP + hl * 64 + 4 * l8;
                    v2u w1, w2; w1.x = pk2(o1[0], o1[1]); w1.y = pk2(o1[2], o1[3]); w2.x = pk2(o2[0], o2[1]); w2.y = pk2(o2[2], o2[3]);
                    *(v2u*)d = w1; *(v2u*)(d + 32) = w2; }
            }
        }
    }
}
__device__ __forceinline__ void phase_attn_simple(ArgsP a, const Fr& F) {
    const bf16* Q = (const bf16*)(a->ws + SC_Q); const bf16* K = (const bf16*)(a->ws + SC_K); const bf16* V = (const bf16*)(a->ws + SC_V); bf16* O = (bf16*)(a->ws + SC_O);
    for (int it = F.vcu; it < 512; it += F.G) {
        const int b = it >> 7, h = (it >> 3) & 15, q = (it & 7) * 512 + F.tid;
        const bf16* qp = Q + (size_t)(b * SEQ + q) * 1024 + h * 64;
        float qv[64], o[64];
#pragma unroll
        for (int d = 0; d < 64; ++d) { qv[d] = bf2f(qp[d]); o[d] = 0.f; }
        float m = -3.0e38f, l = 0.f;
        const bf16* kb = K + (size_t)b * LK * KVP + (h >> 2) * 64; const bf16* vb = V + (size_t)b * LK * KVP + (h >> 2) * 64;
        for (int s = 0; s < LK; ++s) {
            const v4u* kr = (const v4u*)(kb + (size_t)s * KVP); float sc = 0.f;
#pragma unroll
            for (int c = 0; c < 8; ++c) { const v4u kv = kr[c]; const unsigned w[4] = {kv.x, kv.y, kv.z, kv.w};
#pragma unroll
                for (int j = 0; j < 4; ++j) { sc += qv[c * 8 + 2 * j] * __builtin_bit_cast(float, w[j] << 16) + qv[c * 8 + 2 * j + 1] * __builtin_bit_cast(float, w[j] & 0xffff0000u); } }
            const float mn = fmaxf(m, sc); const float al = exp2f(m - mn), p = exp2f(sc - mn); l = l * al + p; m = mn;
            const v4u* vr = (const v4u*)(vb + (size_t)s * KVP);
#pragma unroll
            for (int c = 0; c < 8; ++c) { const v4u vv = vr[c]; const unsigned w[4] = {vv.x, vv.y, vv.z, vv.w};
#pragma unroll
                for (int j = 0; j < 4; ++j) { o[c * 8 + 2 * j] = o[c * 8 + 2 * j] * al + p * __builtin_bit_cast(float, w[j] << 16); o[c * 8 + 2 * j + 1] = o[c * 8 + 2 * j + 1] * al + p * __builtin_bit_cast(float, w[j] & 0xffff0000u); } }
        }
        const float il = 1.0f / l; bf16* op = O + (size_t)(b * SEQ + q) * 1024 + h * 64;
#pragma unroll
        for (int c = 0; c < 8; ++c) { v4u w; w.x = pk2(o[c * 8] * il, o[c * 8 + 1] * il); w.y = pk2(o[c * 8 + 2] * il, o[c * 8 + 3] * il); w.z = pk2(o[c * 8 + 4] * il, o[c * 8 + 5] * il); w.w = pk2(o[c * 8 + 6] * il, o[c * 8 + 7] * il);
            *(v4u*)(op + c * 8) = w; }
    }
}
__device__ __forceinline__ void phase_sp_simple(ArgsP a, const Fr& F) {
    LAS float* wsL = (LAS float*)F.lds;
    LAS float* vl = wsL + 128 * 128;
    LAS float* st = vl + 128 * 128;
    const float* VT = (const float*)(a->ws + SC_VT); const f32x2* VST = (const f32x2*)(a->ws + SC_VST); const bf16* UB = (const bf16*)(a->ws + SC_UB); bf16* UV = (bf16*)(a->ws + SC_UV);
    const int per = (2048 + F.G - 1) / F.G; int gl = -1;
    for (int it = F.vcu * per; it < (F.vcu + 1) * per && it < 2048; ++it) {
        const int g = it >> 7, n = it & 127;
        __syncthreads();
        if (g != gl) { for (int u = F.tid; u < 128 * 128; u += NTHR) wsL[u] = a->in[I_CMWS][(size_t)g * 16384 + u]; gl = g; }
        if (F.tid < 128) { float s1 = 0.f, s2 = 0.f; for (int p = 0; p < 16; ++p) { const f32x2 v = VST[(size_t)p * T + n * 128 + F.tid]; s1 += v.x; s2 += v.y; }
            const float mean = s1 * (1.0f / 2048.0f); const float var = s2 * (1.0f / 2048.0f) - mean * mean; st[F.tid * 2] = mean; st[F.tid * 2 + 1] = 1.0f / sqrtf(var + LN_EPS); }
        __syncthreads();
        for (int u = F.tid; u < 128 * 128; u += NTHR) { const int c = u >> 7, s = u & 127; const int ch = g * 128 + c;
            const float v = VT[(size_t)ch * T + n * 128 + s]; vl[s * 128 + c] = (v - st[s * 2]) * st[s * 2 + 1] * a->in[I_CMLNG][ch] + a->in[I_CMLNB][ch]; }
        __syncthreads();
        const int c = F.tid & 127, tq = F.tid >> 7;
        for (int jj = 0; jj < 32; ++jj) { const int t = tq + 4 * jj; float acc = 0.f;
            for (int s = 0; s < 128; ++s) acc += wsL[t * 128 + s] * vl[s * 128 + c];
            acc += a->in[I_CMBS][g * 128 + t];
            const size_t idx = (size_t)(n * 128 + t) * 2048 + g * 128 + c;
            UV[idx] = (bf16)f2bf(bf2f(UB[idx]) * acc); }
    }
}
#ifndef MK_FAST_CONV
#define MK_FAST_CONV 0
#endif
#ifndef MK_FAST_ATTN
#define MK_FAST_ATTN 0
#endif
#ifndef MK_FAST_SP
#define MK_FAST_SP 0
#endif
#ifndef MK_GATHER
#define MK_GATHER 0
#endif
constexpr int MOE_PH = MK_GATHER ? 5 : 6;
constexpr int N_PHASES = (MK_MERGE_PRO ? 1 : 2) + (4 + MOE_PH) + (4 + MOE_PH) + (3 + MOE_PH) + (4 + MOE_PH);

#ifndef MK_STAG_GU
#define MK_STAG_GU 0
#endif
#define STAGGER(ticks) do { if ((ticks) > 0 && (F.vcu & 1)) { const unsigned long long t0_ = __builtin_amdgcn_s_memrealtime(); while (__builtin_amdgcn_s_memrealtime() - t0_ < (unsigned long long)(ticks)) __builtin_amdgcn_s_sleep(8); } } while (0)
#ifndef MK_REPMASK
#define MK_REPMASK 0ull
#endif
#ifndef MK_CODEPROBE_N
#define MK_CODEPROBE_N 0
#endif
#if MK_CODEPROBE_N > 0
#define MK_CODEPROBE { _Pragma("unroll 1") for (int cp_ = 0; cp_ < MK_CODEPROBE_N; ++cp_) asm volatile(".rept 2048\n\ts_nop 0\n\t.endr" ::: "memory"); }
#else
#define MK_CODEPROBE
#endif
#ifndef MK_LNR2
#define MK_LNR2 0
#endif
#ifndef MK_XBAR
#define MK_XBAR 0
#endif
#ifndef MK_REPN
#define MK_REPN 3
#endif
#ifndef MK_REPBAR
#define MK_REPBAR 0
#endif
__device__ __forceinline__ bool probe_bar(unsigned char* lds_raw) { ArgsP a__ = get_args(); XcdBarrier bb; bb.bar = (unsigned*)(a__->ws + WS_CTL) + 4096; bb.x = xb_xcc_id();
    bb.st = (volatile LAS unsigned*)((LAS unsigned char*)lds_raw + MISC_OFF) + 8; xcd_barrier(bb); return false; }
#define REPS for (int rep_ = 0; rep_ < (((MK_REPMASK >> p) & 1ull) ? MK_REPN : 1); ++rep_) if (MK_REPBAR && rep_ > 0 && probe_bar(lds_raw)) {} else
#define IN() (get_args()->ph_lo <= p && p < get_args()->ph_hi)
#define PHB ArgsP a = get_args(); unsigned char* ws = a->ws; (void)ws; const Fr F = mkfr(lds_raw);
#define SEAM() do { { ArgsP a__ = get_args(); if (a__->ph_lo <= p && p + 1 < a__->ph_hi) { XcdBarrier bb; bb.bar = (unsigned*)(a__->ws + WS_CTL) + 4096; bb.x = xb_xcc_id(); \
        bb.st = (volatile LAS unsigned*)((LAS unsigned char*)lds_raw + MISC_OFF) + 8; xcd_barrier(bb); for (int xb_ = 0; xb_ < MK_XBAR; ++xb_) xcd_barrier(bb); MK_CODEPROBE } } ++p; } while (0)
template <int layer> __device__ __forceinline__ void layer_body(int& p, unsigned char* lds_raw) {
    PG8_LAS unsigned char* ring = (PG8_LAS unsigned char*)lds_raw;
        constexpr int kind = layer % 3;
        const int nrows = layer == 0 ? TA : T;
#define G1PTR ((const float*)(ws + WS_MOD) + (size_t)layer * 5 * 6144 + 2048)
        if constexpr (kind == 0) {
            const int slot = layer == 0 ? 0 : 1;
#if MK_FP8_HYIN
            REPS if (IN()) { PHB pg8::Gemm g{(const pg8::bf16_t*)(ws + WS_WHYIN + (size_t)slot * 3072 * 1024), (const pg8::bf16_t*)(ws + WS_HB), 3072, nrows, 512, nullptr};
                pg8::StaticOrder S; S.init(3072, nrows, F.G, F.bx); pg8::EpiBf16<0> E{(pg8::bf16_t*)(ws + SC_PT), TA, nullptr, 1 << 30, 0, 1.0f / WH_SCALE};
                pg8::gemm_phase<pg8::EpiBf16<0>, pg8::StaticOrder, true, false, true>(ring, g, S, E);
#else
            REPS if (IN()) { PHB pg8::Gemm g{(const pg8::bf16_t*)(ws + WS_WHYIN) + (size_t)slot * 3072 * 1024, (const pg8::bf16_t*)(ws + WS_HB), 3072, nrows, 1024, nullptr};
                pg8::StaticOrder S; S.init(3072, nrows, F.G, F.bx); pg8::EpiBf16<0> E{(pg8::bf16_t*)(ws + SC_PT), TA, nullptr, 0, 0, 1.f};
                pg8::gemm_phase<pg8::EpiBf16<0>, pg8::StaticOrder, true, false>(ring, g, S, E);
#endif
                if constexpr (layer == 0) { __syncthreads(); bg_convert<0>(a, F, F.bx - (12 * 68) % 256); } }
            SEAM();
            REPS if (IN()) { PHB
#if MK_FAST_CONV
                phase_hy_conv_fft(a, F, layer);
#else
                phase_hy_conv_direct(a, F, layer);
#endif
            }
            SEAM();
            REPS if (IN()) { PHB phase_hy_tr(a, F, nrows); }
            SEAM();
#if MK_FP8_HYOUT
            REPS if (IN()) { PHB pg8::Gemm g{(const pg8::bf16_t*)(ws + SC_Z2), (const pg8::bf16_t*)(ws + WS_WHYOUT + (size_t)slot * 1024 * 1024), nrows, 1024, 512, nullptr};
                pg8::StaticOrder S; S.init(nrows, 1024, F.G, F.bx); pg8::EpiRes E{(const pg8::bf16_t*)(ws + WS_XC), (pg8::bf16_t*)(ws + WS_U), G1PTR, 6144, ALPHA, 1.0f / (WH_SCALE * Z_SCALE)};
                pg8::gemm_phase<pg8::EpiRes, pg8::StaticOrder, true, false, true>(ring, g, S, E);
#else
            REPS if (IN()) { PHB pg8::Gemm g{(const pg8::bf16_t*)(ws + SC_Z2), (const pg8::bf16_t*)(ws + WS_WHYOUT) + (size_t)slot * 1024 * 1024, nrows, 1024, 1024, nullptr};
                pg8::StaticOrder S; S.init(nrows, 1024, F.G, F.bx); pg8::EpiRes E{(const pg8::bf16_t*)(ws + WS_XC), (pg8::bf16_t*)(ws + WS_U), G1PTR, 6144, ALPHA};
                pg8::gemm_phase<pg8::EpiRes, pg8::StaticOrder, true, false>(ring, g, S, E);
#endif
                if constexpr (layer == 0) { __syncthreads(); bg_convert<1>(a, F, F.bx - (68 * 4) % 256); } }
            SEAM();
        } else if constexpr (kind == 1) {
#if MK_FP8_QKV
            REPS if (IN()) { PHB pg8::Gemm g{(const pg8::bf16_t*)(ws + WS_HB), (const pg8::bf16_t*)(ws + WS_WQKV), TA, 1536, 512, nullptr};
                pg8::StaticOrder S; S.init(TA, 1536, F.G, F.bx); pg8::EpiBf16<0> E{(pg8::bf16_t*)(ws + SC_QKV), 1536, nullptr, 0, 0, 1.f, 1.0f / WH_SCALE};
                pg8::gemm_phase<pg8::EpiBf16<0>, pg8::StaticOrder, true, false, true>(ring, g, S, E);
#else
            REPS if (IN()) { PHB pg8::Gemm g{(const pg8::bf16_t*)(ws + WS_HB), (const pg8::bf16_t*)(ws + WS_WQKV), TA, 1536, 1024, nullptr};
                pg8::StaticOrder S; S.init(TA, 1536, F.G, F.bx); pg8::EpiBf16<0> E{(pg8::bf16_t*)(ws + SC_QKV), 1536, nullptr, 0, 0, 1.f};
                pg8::gemm_phase<pg8::EpiBf16<0>, pg8::StaticOrder, true, false>(ring, g, S, E);
#endif
                __syncthreads(); bg_convert<4>(a, F, F.bx - (68 * 6) % 256); }
            SEAM();
            REPS if (IN()) { PHB phase_rope(a, F); }
            SEAM();
            REPS if (IN()) { PHB
#if MK_FAST_ATTN
                phase_attn_fast(a, F);
#else
                phase_attn_simple(a, F);
#endif
            }
            SEAM();
#if MK_FP8_AOUT
            REPS if (IN()) { PHB pg8::Gemm g{(const pg8::bf16_t*)(ws + SC_O), (const pg8::bf16_t*)(ws + WS_WATO), T, 1024, 512, nullptr};
                pg8::StaticOrder S; S.init(T, 1024, F.G, F.bx); pg8::EpiRes E{(const pg8::bf16_t*)(ws + WS_XC), (pg8::bf16_t*)(ws + WS_U), G1PTR, 6144, ALPHA, 1.0f / (WH_SCALE * O_SCALE)};
                pg8::gemm_phase<pg8::EpiRes, pg8::StaticOrder, true, false, true>(ring, g, S, E); }
#else
            REPS if (IN()) { PHB pg8::Gemm g{(const pg8::bf16_t*)(ws + SC_O), (const pg8::bf16_t*)(ws + WS_WATO), T, 1024, 1024, nullptr};
                pg8::StaticOrder S; S.init(T, 1024, F.G, F.bx); pg8::EpiRes E{(const pg8::bf16_t*)(ws + WS_XC), (pg8::bf16_t*)(ws + WS_U), G1PTR, 6144, ALPHA};
                pg8::gemm_phase<pg8::EpiRes, pg8::StaticOrder, true, false>(ring, g, S, E); }
#endif
            SEAM();
        } else {
            REPS if (IN()) {
#if MK_FP8_CMIN
                { PHB pg8::Gemm g{(const pg8::bf16_t*)(ws + WS_HB), (const pg8::bf16_t*)(ws + WS_WCMIN), T, 2048, 512, nullptr};
                  pg8::StaticOrder S; S.init(T, 2048, F.G, F.bx); pg8::EpiBf16<1> E{(pg8::bf16_t*)(ws + SC_UB), 2048, nullptr, 0, 0, 1.f, 1.0f / WH_SCALE};
                  pg8::gemm_phase<pg8::EpiBf16<1>, pg8::StaticOrder, true, false, true>(ring, g, S, E); }
                { PHB pg8::Gemm g{(const pg8::bf16_t*)(ws + WS_WCMIN + (size_t)2048 * 1024), (const pg8::bf16_t*)(ws + WS_HB), 2048, T, 512, nullptr};
                  pg8::StaticOrder S; S.init(2048, T, F.G, F.bx); pg8::EpiVT E{(pg8::bf16_t*)(ws + SC_VT), T, (pg8::f32x2*)(ws + SC_VST), T, 1.0f / WH_SCALE};
                  pg8::gemm_phase<pg8::EpiVT, pg8::StaticOrder, true, false, true>(ring, g, S, E); }
#else
                { PHB pg8::Gemm g{(const pg8::bf16_t*)(ws + WS_HB), (const pg8::bf16_t*)(ws + WS_WCMIN), T, 2048, 1024, nullptr};
                  pg8::StaticOrder S; S.init(T, 2048, F.G, F.bx); pg8::EpiBf16<1> E{(pg8::bf16_t*)(ws + SC_UB), 2048, nullptr, 0, 0, 1.f};
                  pg8::gemm_phase<pg8::EpiBf16<1>, pg8::StaticOrder, true, false>(ring, g, S, E); }
#if MK_FP8_CMV
                { PHB pg8::Gemm g{(const pg8::bf16_t*)(ws + WS_WCMIN + (size_t)2048 * 1024 * 2), (const pg8::bf16_t*)(ws + WS_HB8B), 2048, T, 512, nullptr};
                  pg8::StaticOrder S; S.init(2048, T, F.G, F.bx); pg8::EpiVT E{(pg8::bf16_t*)(ws + SC_VT), T, (pg8::f32x2*)(ws + SC_VST), T, 1.0f / WH_SCALE};
                  pg8::gemm_phase<pg8::EpiVT, pg8::StaticOrder, true, false, true>(ring, g, S, E); }
#else
                { PHB pg8::Gemm g{(const pg8::bf16_t*)(ws + WS_WCMIN) + (size_t)2048 * 1024, (const pg8::bf16_t*)(ws + WS_HB), 2048, T, 1024, nullptr};
                  pg8::StaticOrder S; S.init(2048, T, F.G, F.bx); pg8::EpiVT E{(pg8::bf16_t*)(ws + SC_VT), T, (pg8::f32x2*)(ws + SC_VST), T};
                  pg8::gemm_phase<pg8::EpiVT, pg8::StaticOrder, true, false>(ring, g, S, E); }
#endif
#endif
            }
            SEAM();
            REPS if (IN()) { PHB
#if MK_FAST_SP
                phase_sp_fast(a, F);
#else
                phase_sp_simple(a, F);
#endif
            }
            SEAM();
#if MK_FP8_CMOUT
            REPS if (IN()) { PHB pg8::Gemm g{(const pg8::bf16_t*)(ws + SC_UV), (const pg8::bf16_t*)(ws + WS_WCMOUT), T, 1024, 1024, nullptr};
                pg8::StaticOrder S; S.init(T, 1024, F.G, F.bx); pg8::EpiRes E{(const pg8::bf16_t*)(ws + WS_XC), (pg8::bf16_t*)(ws + WS_U), G1PTR, 6144, ALPHA, 1.0f / (WH_SCALE * O_SCALE)};
                pg8::gemm_phase<pg8::EpiRes, pg8::StaticOrder, true, false, true>(ring, g, S, E); }
#else
            REPS if (IN()) { PHB pg8::Gemm g{(const pg8::bf16_t*)(ws + SC_UV), (const pg8::bf16_t*)(ws + WS_WCMOUT), T, 1024, 2048, nullptr};
                pg8::StaticOrder S; S.init(T, 1024, F.G, F.bx); pg8::EpiRes E{(const pg8::bf16_t*)(ws + WS_XC), (pg8::bf16_t*)(ws + WS_U), G1PTR, 6144, ALPHA};
                pg8::gemm_phase<pg8::EpiRes, pg8::StaticOrder, true, false>(ring, g, S, E); }
#endif
            SEAM();
        }
#if MK_LNR2
        REPS if (IN()) { PHB phase_lnr2(a, F, layer, nrows); }
#else
        REPS if (IN()) { PHB phase_lnr(a, F, layer, nrows); }
#endif
        SEAM();
        REPS if (IN()) { PHB phase_topk(a, F, layer);
            if constexpr (layer == 0) { __syncthreads(); bg_convert<2>(a, F, F.vcu - 128); }
            if constexpr (layer == 1) { __syncthreads(); bg_convert<5>(a, F, F.vcu - 64); }
            if constexpr (layer == 2) { __syncthreads(); bg_convert<6>(a, F, F.vcu - 64); } }
        SEAM();
        const int npm = layer == 0 ? 9 : 8;
#if MK_GATHER
        REPS if (IN()) { PHB pg8::Gemm g{(const pg8::bf16_t*)(ws + WS_HB), (const pg8::bf16_t*)(ws + WS_WGU + (size_t)layer * 16 * 4096 * 1024), 0, 0, 512, (const int*)(ws + WS_ROWS)};
            pg8::MoeOrder S{npm, 16, F.G, F.vcu}; pg8::EpiGU8<MK_FP8_DN != 0> E{(unsigned char*)(ws + WS_ACT), 16, 1.0f / WGU_SCALE, MK_FP8_DN ? ACT_SCALE : 1.0f};
            STAGGER(MK_STAG_GU);
#if defined(MK_NULLEPI)
            if (rep_ > 0) { pg8::MK_NULLEPI EN; pg8::MoeOrder S2 = S; S2.fixed = 1; pg8::gemm_phase<pg8::MK_NULLEPI, pg8::MoeOrder, true, true, true>(ring, g, S2, EN); } else
#endif
            pg8::gemm_phase<pg8::EpiGU8<MK_FP8_DN != 0>, pg8::MoeOrder, true, true, true>(ring, g, S, E); }
        SEAM();
#else
        REPS if (IN()) { PHB phase_gather(a, F, layer); }
        SEAM();
#error "the materialised-gather build (MK_GATHER 0) predates the e4m3 expert GEMMs and is no longer supported"
        SEAM();
#endif
#if MK_FP8_DN
        REPS if (IN()) { PHB pg8::Gemm g{(const pg8::bf16_t*)(ws + WS_ACT), (const pg8::bf16_t*)(ws + WS_WDN + (size_t)layer * 16 * 1024 * 2048), 0, 0, 1024, nullptr};
            pg8::MoeOrder S{npm, 4, F.G, F.vcu}; pg8::EpiDN E{(pg8::bf16_t*)(ws + WS_Y), (const float*)(ws + WS_GATE), 4, (MK_FP8_Y ? Y_SCALE : 1.0f) / (WDN_SCALE * ACT_SCALE)};
            pg8::gemm_phase<pg8::EpiDN, pg8::MoeOrder, true, false, true>(ring, g, S, E);
            if constexpr (layer == 0) { __syncthreads(); bg_convert<3>(a, F, F.vcu - (16 * 9 * 4) % 256); } }
#else
        REPS if (IN()) { PHB pg8::Gemm g{(const pg8::bf16_t*)(ws + WS_ACT), (const pg8::bf16_t*)(ws + WS_WDN) + (size_t)layer * 16 * 1024 * 2048, 0, 0, 2048, nullptr};
            pg8::MoeOrder S{npm, 4, F.G, F.vcu}; pg8::EpiDN E{(pg8::bf16_t*)(ws + WS_Y), (const float*)(ws + WS_GATE), 4, 1.0f};
            pg8::gemm_phase<pg8::EpiDN, pg8::MoeOrder, true, false, false>(ring, g, S, E); }
#endif
        SEAM();
        REPS if (IN()) { PHB phase_comb(a, F, layer, nrows); }
        SEAM();
    }
__global__ void __launch_bounds__(NTHR, 2) mk_fwd(Args a_) {
    extern __shared__ __attribute__((aligned(16))) unsigned char lds_raw[];
    Fr F0 = mkfr(lds_raw);
    volatile LAS unsigned* MISC = (volatile LAS unsigned*)(F0.lds + MISC_OFF);
    if (F0.tid < 32) MISC[F0.tid] = 0u;
    __syncthreads();
    if (a_.ph_hi - a_.ph_lo > 1) (void)xcd_barrier_post((unsigned*)(a_.ws + WS_CTL) + 4096, MISC + 8);
    int p = 0;
    PG8_LAS unsigned char* ring = (PG8_LAS unsigned char*)lds_raw;

    REPS if (IN()) { PHB phase_proA(a, F); }
    SEAM();
#if !MK_MERGE_PRO
    REPS if (IN()) { PHB phase_proB(a, F); }
    SEAM();
#endif
    layer_body<0>(p, lds_raw); layer_body<1>(p, lds_raw); layer_body<2>(p, lds_raw); layer_body<3>(p, lds_raw);
#undef IN
#undef PHB
#undef G1PTR
#undef SEAM
}

#ifndef MK_N_LAUNCHES
#define MK_N_LAUNCHES 0
#endif
extern "C" void kernel_launch(void* const* d_in, const int* in_sizes, int n_in, void* d_out, int out_size, void* d_ws, size_t ws_size, hipStream_t stream) {
    static int grid = 0;
    if (grid == 0) {
        if (n_in != 33 || out_size != T * D || ws_size < WS_END) { fprintf(stderr, "kernel_launch: expected 33 inputs, %d outputs, >= %zu bytes of workspace; got %d, %d, %zu\n", T * D, (size_t)WS_END, n_in, out_size, ws_size); grid = -1; return; }
        int dev = 0, cus = 0, per_cu = 0;
        if (hipGetDevice(&dev) != hipSuccess || hipDeviceGetAttribute(&cus, hipDeviceAttributeMultiprocessorCount, dev) != hipSuccess) { grid = -1; return; }
        if (hipFuncSetAttribute((const void*)mk_fwd, hipFuncAttributeMaxDynamicSharedMemorySize, LDS_BYTES) != hipSuccess) { fprintf(stderr, "kernel_launch: hipFuncSetAttribute failed\n"); grid = -1; return; }
        if (hipOccupancyMaxActiveBlocksPerMultiprocessor(&per_cu, (const void*)mk_fwd, NTHR, LDS_BYTES) != hipSuccess || per_cu < 1)
            fprintf(stderr, "kernel_launch: note: occupancy query reports %d workgroups per CU\n", per_cu);
        (void)hipGetLastError();
        grid = cus;
    }
    if (grid < 0) return;
    (void)hipMemsetAsync((char*)d_ws + WS_CTL, 0, 64 * 1024, stream);
    Args a{};
    for (int i = 0; i < 33; ++i) a.in[i] = (const float*)d_in[i];
    a.out = (float*)d_out; a.ws = (unsigned char*)d_ws;
#if MK_N_LAUNCHES == 1
    a.ph_lo = 0; a.ph_hi = N_PHASES;
    hipLaunchKernelGGL(mk_fwd, dim3(grid), dim3(NTHR), LDS_BYTES, stream, a);
#else
    for (int p = 0; p < N_PHASES; ++p) { a.ph_lo = p; a.ph_hi = p + 1; hipLaunchKernelGGL(mk_fwd, dim3(grid), dim3(NTHR), LDS_BYTES, stream, a); }
#endif
    const hipError_t le = hipPeekAtLastError();
    if (le != hipSuccess) fprintf(stderr, "kernel_launch: launch failed: %s\n", hipGetErrorName(le));
}
```

```cpp
#define MK_N_LAUNCHES 1
#define MK_FAST_ATTN 1
#define MK_FAST_CONV 1
#define MK_GATHER 1
#define MK_FAST_SP 1
#include <hip/hip_runtime.h>
#include <cstdio>
#include <cstdint>
#include <cmath>
namespace pg8 {
#define PG8_LAS __attribute__((address_space(3)))
typedef unsigned short bf16_t;
typedef short bf16x8 __attribute__((ext_vector_type(8)));
typedef float f32x4 __attribute__((ext_vector_type(4)));
typedef unsigned u32x4 __attribute__((ext_vector_type(4)));
typedef unsigned u32x2 __attribute__((ext_vector_type(2)));
constexpr int BM = 256, BK = 64, HALF = 128, HTB = HALF * BK * 2  , STAGE_BYTES = 8 * HTB, NXCD = 8, WGM = 8;

__host__ __device__ __forceinline__ int lds_byte(int r, int c) { const int st = (r >> 4) * 2 + (c >> 5), rr = r & 15, cc = c & 31, ob = rr * 64 + cc * 2; return st * 1024 + (ob ^ (((ob >> 9) & 1) << 5)); }
__host__ __device__ __forceinline__ void stage_rc(int b, int& R, int& C) { const int st = b / 1024, sb = b % 1024, swz = sb ^ (((sb >> 9) & 1) << 5); R = (st >> 1) * 16 + swz / 64; C = (st & 1) * 32 + (swz % 64) / 2; }
__host__ __device__ __forceinline__ int perm32(int rho) { const int n = rho >> 4, i = rho & 15; return 8 * (i >> 2) + 4 * n + (i & 3); }

struct Unit { int pm, pn; };
struct Gemm { const bf16_t* A; const bf16_t* Bt; int M, N, K; const int* rows; };

struct StaticOrder {
    int nM, nN, nwg, G, c;
    __host__ __device__ void init(int M, int N, int G_, int c_) { nM = M / BM; nN = N / BM; nwg = nM * nN; G = G_; c = c_; }
    __host__ __device__ bool next(int i, Unit& u) const {
        const long L = (long)i * G + c; if (L >= nwg) return false;
        int wgid = (int)L; { const int q = nwg / NXCD, r = nwg % NXCD, xcd = wgid % NXCD, off = wgid / NXCD; wgid = (xcd < r ? xcd * (q + 1) : r * (q + 1) + (xcd - r) * q) + off; }
        const int nig = WGM * nN, gid = wgid / nig, fm = gid * WGM, gsz = (nM - fm) < WGM ? (nM - fm) : WGM;
        u.pm = fm + ((wgid % nig) % gsz); u.pn = (wgid % nig) / gsz; return true;
    }
    __device__ __forceinline__ void a_ready(const Unit&) const {}
    __device__ __forceinline__ void done(const Unit&) const {}
};

__device__ __forceinline__ unsigned cvt_pk_bf16(float lo, float hi) { unsigned r; asm volatile("v_cvt_pk_bf16_f32 %0, %1, %2" : "=v"(r) : "v"(lo), "v"(hi)); return r; }
typedef float f32x2 __attribute__((ext_vector_type(2)));
__device__ __forceinline__ f32x2 gelu_pk(f32x2 v) {
    const f32x2 av = __builtin_elementwise_abs(v), d = av * 0.2316418882f + 1.0f;
    f32x2 t; t.x = __builtin_amdgcn_rcpf(d.x); t.y = __builtin_amdgcn_rcpf(d.y);
    f32x2 q = t * 0.5307027145f + (-0.7265760135f); q = q * t + 0.7107068705f; q = q * t + (-0.142248368f); q = q * t + 0.127414796f; q = q * t;
    const f32x2 s = (v * v) * (-0.72134752044f);
    f32x2 e; e.x = __builtin_amdgcn_exp2f(s.x); e.y = __builtin_amdgcn_exp2f(s.y);
    const f32x2 m = v * (q * e), r = v - m;
    f32x2 o; o.x = v.x < 0.f ? m.x : r.x; o.y = v.y < 0.f ? m.y : r.y; return o;
}

template <int ACT  > struct EpiBf16 {
    static constexpr bool PERM = true, AFTER_DRAIN = false; static_assert(ACT == 0 || ACT == 1, "EpiBf16: ACT is 0 (none) or 1 (gelu_pk)");
    bf16_t* O; int ldc; const float* bias; int split_cols; size_t split_stride; float scale0; float pre = 1.f;
    __device__ __forceinline__ void operator()(const f32x4 (&acc)[2][2][4][2], const Unit& u, int wr, int wc, int fr, int fq) const {
        const int row0 = u.pm * BM + wr * 64 + fr; int colt = u.pn * BM; bf16_t* base = O;
        float sc = 1.f; if (split_cols) { const int t = colt / split_cols; base += (size_t)t * split_stride; colt -= t * split_cols; if (t == 0) sc = scale0; }
        const int col0 = colt + wc * 32 + 8 * fq, bcol0 = u.pn * BM + wc * 32 + 8 * fq;
        f32x4 bv[2][2];
#pragma unroll
        for (int bj = 0; bj < 2; ++bj)
#pragma unroll
            for (int n = 0; n < 2; ++n) bv[bj][n] = bias ? *(const f32x4*)(bias + bcol0 + bj * HALF + 4 * n) : (f32x4){0.f, 0.f, 0.f, 0.f};
#pragma unroll
        for (int ai = 0; ai < 2; ++ai)
#pragma unroll
            for (int m = 0; m < 4; ++m) { bf16_t* rowp = base + (size_t)(row0 + ai * HALF + m * 16) * ldc + col0;
#pragma unroll
                for (int bj = 0; bj < 2; ++bj) { f32x4 v0 = acc[ai][bj][m][0] * pre + bv[bj][0], v1 = acc[ai][bj][m][1] * pre + bv[bj][1];
                    if (ACT == 1) { f32x2 a = gelu_pk((f32x2){v0[0], v0[1]}), b = gelu_pk((f32x2){v0[2], v0[3]}), c = gelu_pk((f32x2){v1[0], v1[1]}), d = gelu_pk((f32x2){v1[2], v1[3]});
                        v0 = (f32x4){a.x, a.y, b.x, b.y}; v1 = (f32x4){c.x, c.y, d.x, d.y}; }
                    v0 = v0 * sc; v1 = v1 * sc; u32x4 w; w.x = cvt_pk_bf16(v0[0], v0[1]); w.y = cvt_pk_bf16(v0[2], v0[3]); w.z = cvt_pk_bf16(v1[0], v1[1]); w.w = cvt_pk_bf16(v1[2], v1[3]);
                    *(u32x4*)(rowp + bj * HALF) = w; } }
    }
};

#ifndef MK_FP8_Y
#define MK_FP8_Y 1
#endif
struct EpiF32 {
    static constexpr bool PERM = false, AFTER_DRAIN = false;
    float* C; int ldc;
    __device__ __forceinline__ void operator()(const f32x4 (&acc)[2][2][4][2], const Unit& u, int wr, int wc, int fr, int fq) const {
        const int row0 = u.pm * BM + wr * 64 + fr, col0 = u.pn * BM + wc * 32 + 4 * fq;
#pragma unroll
        for (int ai = 0; ai < 2; ++ai)
#pragma unroll
            for (int m = 0; m < 4; ++m) { float* rowp = C + (size_t)(row0 + ai * HALF + m * 16) * ldc + col0;
#pragma unroll
                for (int bj = 0; bj < 2; ++bj)
#pragma unroll
                    for (int n = 0; n < 2; ++n) *(f32x4*)(rowp + bj * HALF + n * 16) = acc[ai][bj][m][n]; }
    }
};
struct EpiRes {
    static constexpr bool PERM = true, AFTER_DRAIN = false;
    const bf16_t* X; bf16_t* U; const float* g; int gstride; float alpha; float accs = 1.f;
    __device__ __forceinline__ void operator()(const f32x4 (&acc)[2][2][4][2], const Unit& u, int wr, int wc, int fr, int fq) const {
        const int row0 = u.pm * BM + wr * 64 + fr, col0 = u.pn * BM + wc * 32 + 8 * fq;
        const int rb = u.pm * BM; const int bidx = rb < 16384 ? (rb >> 12) : 4;
        const float* gp = g + (size_t)bidx * gstride + col0;
        f32x4 gv[2][2];
#pragma unroll
        for (int bj = 0; bj < 2; ++bj)
#pragma unroll
            for (int n = 0; n < 2; ++n) gv[bj][n] = *(const f32x4*)(gp + bj * HALF + 4 * n) * accs;
#pragma unroll
        for (int ai = 0; ai < 2; ++ai)
#pragma unroll
            for (int m = 0; m < 4; ++m) { const size_t off = (size_t)(row0 + ai * HALF + m * 16) * 1024 + col0;
#pragma unroll
                for (int bj = 0; bj < 2; ++bj) { const u32x4 xw = *(const u32x4*)(X + off + bj * HALF);
                    const f32x4 x0 = (f32x4){__builtin_bit_cast(float, xw.x << 16), __builtin_bit_cast(float, xw.x & 0xffff0000u), __builtin_bit_cast(float, xw.y << 16), __builtin_bit_cast(float, xw.y & 0xffff0000u)};
                    const f32x4 x1 = (f32x4){__builtin_bit_cast(float, xw.z << 16), __builtin_bit_cast(float, xw.z & 0xffff0000u), __builtin_bit_cast(float, xw.w << 16), __builtin_bit_cast(float, xw.w & 0xffff0000u)};
                    const f32x4 u0 = x0 * alpha + gv[bj][0] * acc[ai][bj][m][0], u1 = x1 * alpha + gv[bj][1] * acc[ai][bj][m][1];
                    u32x4 uw; uw.x = cvt_pk_bf16(u0[0], u0[1]); uw.y = cvt_pk_bf16(u0[2], u0[3]); uw.z = cvt_pk_bf16(u1[0], u1[1]); uw.w = cvt_pk_bf16(u1[2], u1[3]);
                    *(u32x4*)(U + off + bj * HALF) = uw; }
                asm volatile("" ::: "memory"); }
    }
};
struct EpiNull {
    static constexpr bool PERM = true, AFTER_DRAIN = false;
    __device__ __forceinline__ void operator()(const f32x4 (&acc)[2][2][4][2], const Unit& u, int wr, int wc, int fr, int fq) const {
        f32x4 s = (f32x4){0.f, 0.f, 0.f, 0.f};
#pragma unroll
        for (int ai = 0; ai < 2; ++ai)
#pragma unroll
            for (int bj = 0; bj < 2; ++bj)
#pragma unroll
                for (int m = 0; m < 4; ++m)
#pragma unroll
                    for (int n = 0; n < 2; ++n) s += acc[ai][bj][m][n];
        asm volatile("" :: "v"(s));
    }
};
struct EpiGUnostore {
    static constexpr bool PERM = true, AFTER_DRAIN = false;
    __device__ __forceinline__ void operator()(const f32x4 (&acc)[2][2][4][2], const Unit& u, int wr, int wc, int fr, int fq) const {
#pragma unroll
        for (int ai = 0; ai < 2; ++ai)
#pragma unroll
            for (int m = 0; m < 4; ++m) { float o[8];
#pragma unroll
                for (int n = 0; n < 2; ++n)
#pragma unroll
                    for (int j = 0; j < 4; ++j) { const float a = acc[ai][0][m][n][j], b = acc[ai][1][m][n][j];
                        const float s = a * __builtin_amdgcn_rcpf(1.0f + __builtin_amdgcn_exp2f(-1.4426950408889634f * a)); o[n * 4 + j] = s * b; }
                u32x4 w; w.x = cvt_pk_bf16(o[0], o[1]); w.y = cvt_pk_bf16(o[2], o[3]); w.z = cvt_pk_bf16(o[4], o[5]); w.w = cvt_pk_bf16(o[6], o[7]);
                asm volatile("" :: "v"(w)); }
    }
};
struct EpiGU {
    static constexpr bool PERM = true, AFTER_DRAIN = false;
    bf16_t* ACT; int npn;
    __device__ __forceinline__ void operator()(const f32x4 (&acc)[2][2][4][2], const Unit& u, int wr, int wc, int fr, int fq) const {
        const int row0 = u.pm * BM + wr * 64 + fr; const int col0 = (u.pn % npn) * 128 + wc * 32 + 8 * fq;
#pragma unroll
        for (int ai = 0; ai < 2; ++ai)
#pragma unroll
            for (int m = 0; m < 4; ++m) { bf16_t* rowp = ACT + (size_t)(row0 + ai * HALF + m * 16) * 2048 + col0;
                float o[8];
#pragma unroll
                for (int n = 0; n < 2; ++n)
#pragma unroll
                    for (int j = 0; j < 4; ++j) { const float a = acc[ai][0][m][n][j], b = acc[ai][1][m][n][j];
                        const float s = a * __builtin_amdgcn_rcpf(1.0f + __builtin_amdgcn_exp2f(-1.4426950408889634f * a)); o[n * 4 + j] = s * b; }
                u32x4 w; w.x = cvt_pk_bf16(o[0], o[1]); w.y = cvt_pk_bf16(o[2], o[3]); w.z = cvt_pk_bf16(o[4], o[5]); w.w = cvt_pk_bf16(o[6], o[7]);
                *(u32x4*)rowp = w; }
    }
};
template <bool OUT8> struct EpiGU8 {
    static constexpr bool PERM = true, AFTER_DRAIN = false;
    unsigned char* ACT; int npn; float inscale, outscale;
    __device__ __forceinline__ void operator()(const f32x4 (&acc)[2][2][4][2], const Unit& u, int wr, int wc, int fr, int fq) const {
        const int row0 = u.pm * BM + wr * 64 + fr; const int col0 = (u.pn % npn) * 128 + wc * 32 + 8 * fq;
        const float ka = -1.4426950408889634f * inscale, kb = inscale * inscale * outscale;
#pragma unroll
        for (int ai = 0; ai < 2; ++ai)
#pragma unroll
            for (int m = 0; m < 4; ++m) { unsigned char* rowp = ACT + ((size_t)(row0 + ai * HALF + m * 16) * 2048 + col0) * (OUT8 ? 1 : 2);
                float o[8];
#pragma unroll
                for (int n = 0; n < 2; ++n)
#pragma unroll
                    for (int j = 0; j < 4; ++j) { const float a = acc[ai][0][m][n][j], b = acc[ai][1][m][n][j];
                        o[n * 4 + j] = a * __builtin_amdgcn_rcpf(1.0f + __builtin_amdgcn_exp2f(ka * a)) * (b * kb); }
                if constexpr (OUT8) {
#pragma unroll
                    for (int q = 0; q < 8; ++q) o[q] = __builtin_amdgcn_fmed3f(o[q], -448.0f, 448.0f);
                    unsigned w0 = 0u, w1 = 0u;
                    w0 = __builtin_amdgcn_cvt_pk_fp8_f32(o[0], o[1], w0, false); w0 = __builtin_amdgcn_cvt_pk_fp8_f32(o[2], o[3], w0, true);
                    w1 = __builtin_amdgcn_cvt_pk_fp8_f32(o[4], o[5], w1, false); w1 = __builtin_amdgcn_cvt_pk_fp8_f32(o[6], o[7], w1, true);
                    typedef unsigned u32x2_ __attribute__((ext_vector_type(2)));
                    *(u32x2_*)rowp = (u32x2_){w0, w1}; }
                else { u32x4 w; w.x = cvt_pk_bf16(o[0], o[1]); w.y = cvt_pk_bf16(o[2], o[3]); w.z = cvt_pk_bf16(o[4], o[5]); w.w = cvt_pk_bf16(o[6], o[7]); *(u32x4*)rowp = w; } }
    }
};
struct EpiDN {
    static constexpr bool PERM = true, AFTER_DRAIN = false;
    bf16_t* Y; const float* gate; int npn; float scale;
    __device__ __forceinline__ void operator()(const f32x4 (&acc)[2][2][4][2], const Unit& u, int wr, int wc, int fr, int fq) const {
        const int row0 = u.pm * BM + wr * 64 + fr, col0 = (u.pn % npn) * BM + wc * 32 + 8 * fq;
#pragma unroll
        for (int ai = 0; ai < 2; ++ai)
#pragma unroll
            for (int m = 0; m < 4; ++m) { const int row = row0 + ai * HALF + m * 16; const float gt = gate[row] * scale; bf16_t* rowp = Y + (size_t)row * 1024 + col0;
#pragma unroll
                for (int bj = 0; bj < 2; ++bj) { const f32x4 v0 = acc[ai][bj][m][0] * gt, v1 = acc[ai][bj][m][1] * gt;
#if MK_FP8_Y
                    unsigned w0 = 0u, w1 = 0u;
                    w0 = __builtin_amdgcn_cvt_pk_fp8_f32(__builtin_amdgcn_fmed3f(v0[0], -448.0f, 448.0f), __builtin_amdgcn_fmed3f(v0[1], -448.0f, 448.0f), w0, false);
                    w0 = __builtin_amdgcn_cvt_pk_fp8_f32(__builtin_amdgcn_fmed3f(v0[2], -448.0f, 448.0f), __builtin_amdgcn_fmed3f(v0[3], -448.0f, 448.0f), w0, true);
                    w1 = __builtin_amdgcn_cvt_pk_fp8_f32(__builtin_amdgcn_fmed3f(v1[0], -448.0f, 448.0f), __builtin_amdgcn_fmed3f(v1[1], -448.0f, 448.0f), w1, false);
                    w1 = __builtin_amdgcn_cvt_pk_fp8_f32(__builtin_amdgcn_fmed3f(v1[2], -448.0f, 448.0f), __builtin_amdgcn_fmed3f(v1[3], -448.0f, 448.0f), w1, true);
                    *(u32x2*)((unsigned char*)Y + (size_t)row * 1024 + col0 + bj * HALF) = (u32x2){w0, w1}; } }
#else
                    u32x4 w; w.x = cvt_pk_bf16(v0[0], v0[1]); w.y = cvt_pk_bf16(v0[2], v0[3]); w.z = cvt_pk_bf16(v1[0], v1[1]); w.w = cvt_pk_bf16(v1[2], v1[3]);
                    *(u32x4*)(rowp + bj * HALF) = w; } }
#endif
    }
};
struct EpiVT {
    static constexpr bool PERM = false, AFTER_DRAIN = false;
    bf16_t* VT; int ldc; f32x2* VST; int ntok; float pre = 1.f;
    __device__ __forceinline__ void operator()(const f32x4 (&acc)[2][2][4][2], const Unit& u, int wr, int wc, int fr, int fq) const {
        const int row0 = u.pm * BM + wr * 64 + fr, col0 = u.pn * BM + wc * 32 + 4 * fq;
        f32x4 s1[2][2], s2[2][2];
#pragma unroll
        for (int bj = 0; bj < 2; ++bj)
#pragma unroll
            for (int n = 0; n < 2; ++n) { s1[bj][n] = (f32x4){0.f, 0.f, 0.f, 0.f}; s2[bj][n] = (f32x4){0.f, 0.f, 0.f, 0.f}; }
#pragma unroll
        for (int ai = 0; ai < 2; ++ai)
#pragma unroll
            for (int m = 0; m < 4; ++m) { bf16_t* rowp = VT + (size_t)(row0 + ai * HALF + m * 16) * ldc + col0;
#pragma unroll
                for (int bj = 0; bj < 2; ++bj)
#pragma unroll
                    for (int n = 0; n < 2; ++n) { const f32x4 v = acc[ai][bj][m][n] * pre; const f32x2 a = gelu_pk((f32x2){v[0], v[1]}), b = gelu_pk((f32x2){v[2], v[3]});
                        const f32x4 gl = (f32x4){a.x, a.y, b.x, b.y}; { u32x2 gw; gw.x = cvt_pk_bf16(gl[0], gl[1]); gw.y = cvt_pk_bf16(gl[2], gl[3]); *(u32x2*)(rowp + bj * HALF + n * 16) = gw; } s1[bj][n] += gl; s2[bj][n] += gl * gl; } }
#pragma unroll
        for (int bj = 0; bj < 2; ++bj)
#pragma unroll
            for (int n = 0; n < 2; ++n)
#pragma unroll
                for (int j = 0; j < 4; ++j) { float a = s1[bj][n][j], b = s2[bj][n][j];
#pragma unroll
                    for (int o = 1; o < 16; o <<= 1) { a += __shfl_xor(a, o); b += __shfl_xor(b, o); }
                    s1[bj][n][j] = a; s2[bj][n][j] = b; }
        if (fr == 0) {
            f32x2* dst = VST + (size_t)(u.pm * 2 + wr) * ntok + col0;
#pragma unroll
            for (int bj = 0; bj < 2; ++bj)
#pragma unroll
                for (int n = 0; n < 2; ++n)
#pragma unroll
                    for (int j = 0; j < 4; ++j) dst[bj * HALF + n * 16 + j] = (f32x2){s1[bj][n][j], s2[bj][n][j]};
        }
    }
};
struct MoeOrder {
    int nPM, nPN, G, vcu; int fixed = 0;
    __device__ __forceinline__ bool next(int i, Unit& u) const {
        const int L = i * G + vcu; if (L >= 16 * nPM * nPN) return false;
        const int pm = L % nPM, r = L / nPM, pn = r % nPN, e = r / nPN; u.pm = e * 9 + pm; u.pn = e * nPN + pn;
#if defined(MK_FIXEDUNIT)
        if (fixed) { u.pm = 0; u.pn = 0; }
#endif
        return true;
    }
    __device__ __forceinline__ void a_ready(const Unit&) const {}
    __device__ __forceinline__ void done(const Unit&) const {}
};

template <class Epi, class Sched, bool ALIGN_EPI = false, bool GATHER = false, bool FP8 = false>
__device__ __forceinline__ void gemm_phase(PG8_LAS unsigned char* lds, const Gemm g, const Sched& S, const Epi& E) {
    int tid_ = threadIdx.x; asm volatile("" : "+v"(tid_));
    const int tid = tid_, wid = __builtin_amdgcn_readfirstlane(tid >> 6), lane = tid & 63, wr = wid >> 2, wc = wid & 3, fr = lane & 15, fq = lane >> 4;
    const int K = g.K, nt = K / BK;
    unsigned voffA[2], voffB[2];
#pragma unroll
    for (int i = 0; i < 2; ++i) { int R, C; stage_rc(tid * 16 + i * 8192, R, C); const int Rb = Epi::PERM ? ((R & ~31) + perm32(R & 31)) : R;
        voffA[i] = (unsigned)(R * K + C) * 2u; voffB[i] = (unsigned)(Rb * K + C) * 2u; }
    const size_t kstep = (size_t)(BK * 2);
    const size_t hstep = (size_t)HALF * K * 2;
    const size_t tstep = 2 * hstep;
    const unsigned ldsw = (unsigned)wid * 1024u;
    const int aoff = lds_byte(wr * 64 + fr, fq * 8), boff = lds_byte(wc * 32 + fr, fq * 8);
#define PG8_SA(b, h) (((b) * 2 + (h)) * HTB)
#define PG8_SB(b, h) ((4 + (b) * 2 + (h)) * HTB)
#define PG8_STAGE(bufoff, gbase, voff) do { _Pragma("unroll") for (int _i = 0; _i < 2; ++_i) \
        __builtin_amdgcn_global_load_lds((const unsigned*)((const char*)(gbase) + (voff)[_i]), (PG8_LAS unsigned*)(lds + (bufoff) + ldsw + _i * 8192), 16, 0, 0); } while (0)
#define PG8_STGA(b, h, ubase, koff, gofs) do { if constexpr (GATHER) { PG8_STAGE(PG8_SA(b, h), (const char*)g.A + (koff), gofs[h]); } \
        else { PG8_STAGE(PG8_SA(b, h), (ubase) + (koff) + (size_t)(h) * hstep, voffA); } } while (0)
#define PG8_GLOAD(dst, u) do { if constexpr (GATHER) { _Pragma("unroll") for (int _i = 0; _i < 2; ++_i) { int _R, _C; stage_rc(tid * 16 + _i * 8192, _R, _C); \
        _Pragma("unroll") for (int _h = 0; _h < 2; ++_h) dst[_h][_i] = (unsigned)g.rows[(u).pm * BM + _h * HALF + _R] * (unsigned)(K * 2) + (unsigned)_C * 2u; } } } while (0)
#define PG8_LDA(dst, b, h) do { _Pragma("unroll") for (int m = 0; m < 4; ++m) _Pragma("unroll") for (int k = 0; k < 2; ++k) dst[m][k] = *(const PG8_LAS bf16x8*)(lds + PG8_SA(b, h) + aoff + m * 2048 + k * 1024); } while (0)
#define PG8_LDB(dst, b, h) do { _Pragma("unroll") for (int n = 0; n < 2; ++n) _Pragma("unroll") for (int k = 0; k < 2; ++k) dst[n][k] = *(const PG8_LAS bf16x8*)(lds + PG8_SB(b, h) + boff + n * 2048 + k * 1024); } while (0)
#define PG8_CAT8(x0, x1) __builtin_shufflevector(__builtin_bit_cast(v4i_t, x0), __builtin_bit_cast(v4i_t, x1), 0, 1, 2, 3, 4, 5, 6, 7)
#define PG8_MMA(ai, bj, At, Bt) do { __builtin_amdgcn_s_setprio(1); _Pragma("unroll") for (int m = 0; m < 4; ++m) _Pragma("unroll") for (int n = 0; n < 2; ++n) { \
        if constexpr (FP8) { asm volatile("v_mfma_scale_f32_16x16x128_f8f6f4 %0, %1, %2, %0, %3, %3 op_sel_hi:[0,0,0]" : "+v"(acc[ai][bj][m][n]) : "v"(PG8_CAT8(Bt[n][0], Bt[n][1])), "v"(PG8_CAT8(At[m][0], At[m][1])), "v"(0x7F7F7F7F)); } \
        else { _Pragma("unroll") for (int k = 0; k < 2; ++k) acc[ai][bj][m][n] = __builtin_amdgcn_mfma_f32_16x16x32_bf16(Bt[n][k], At[m][k], acc[ai][bj][m][n], 0, 0, 0); } } \
        __builtin_amdgcn_s_setprio(0); } while (0)
#define PG8_WAIT_V(n) asm volatile("s_waitcnt vmcnt(" #n ")" ::: "memory")
#define PG8_WAIT_L(n) asm volatile("s_waitcnt lgkmcnt(" #n ")" ::: "memory")
#define PG8_BAR __builtin_amdgcn_s_barrier()
#define PG8_SCHED __builtin_amdgcn_sched_barrier(0)
    Unit cur, nxt; int ui = 0;
    if (!S.next(0, cur)) return;
    f32x4 acc[2][2][4][2];
#pragma unroll
    for (int a = 0; a < 2; ++a)
#pragma unroll
        for (int b = 0; b < 2; ++b)
#pragma unroll
            for (int m = 0; m < 4; ++m)
#pragma unroll
                for (int n = 0; n < 2; ++n) acc[a][b][m][n] = (f32x4){0.f, 0.f, 0.f, 0.f};
    bf16x8 At[4][2], B0[2][2], B1[2][2];
    typedef int v8i_t __attribute__((ext_vector_type(8))); typedef int v4i_t __attribute__((ext_vector_type(4)));
    unsigned gc[2][2] = {{0u, 0u}, {0u, 0u}}, gn[2][2] = {{0u, 0u}, {0u, 0u}};
    const char* cA = GATHER ? (const char*)g.A : (const char*)g.A + (size_t)cur.pm * tstep; const char* cB = (const char*)g.Bt + (size_t)cur.pn * tstep;
    S.a_ready(cur);
    PG8_GLOAD(gc, cur);
    PG8_STAGE(PG8_SB(0, 0), cB, voffB); PG8_STAGE(PG8_SB(0, 1), cB + hstep, voffB); PG8_STGA(0, 0, cA, 0, gc); PG8_STGA(0, 1, cA, 0, gc);
    if (wr == 1) PG8_BAR;
    PG8_WAIT_V(2); PG8_BAR;
    PG8_STAGE(PG8_SB(1, 0), cB + kstep, voffB); PG8_STGA(1, 0, cA, kstep, gc); PG8_STAGE(PG8_SB(1, 1), cB + hstep + kstep, voffB);
    PG8_WAIT_V(6); PG8_BAR;
    for (;;) {
        const bool has_next = S.next(ui + 1, nxt);
        const char* nA = GATHER ? (const char*)g.A : (has_next ? (const char*)g.A + (size_t)nxt.pm * tstep : cA); const char* nB = has_next ? (const char*)g.Bt + (size_t)nxt.pn * tstep : cB;
#pragma unroll 1
        for (int t = 0; t < nt; t += 2) {
            const bool last = (t == nt - 2);
            const size_t k1 = (size_t)(t + 1) * kstep;
            const char* b2 = last ? nB : cB + (size_t)(t + 2) * kstep; const char* b3 = b2 + kstep;
            if (last && has_next) S.a_ready(nxt);
            if (last) { if (has_next) { PG8_GLOAD(gn, nxt); } else {
#pragma unroll
                    for (int h = 0; h < 2; ++h)
#pragma unroll
                        for (int i = 0; i < 2; ++i) gn[h][i] = gc[h][i]; } }
            PG8_LDB(B0, 0, 0); PG8_LDB(B1, 0, 1); PG8_SCHED; PG8_LDA(At, 0, 0); PG8_STGA(1, 1, cA, k1, gc);
            PG8_WAIT_V(8); PG8_WAIT_L(0); PG8_BAR; PG8_MMA(0, 0, At, B0); PG8_MMA(0, 1, At, B1); PG8_BAR; PG8_SCHED;
            PG8_LDA(At, 0, 1); PG8_STAGE(PG8_SB(0, 0), b2, voffB); PG8_STAGE(PG8_SB(0, 1), b2 + hstep, voffB);
            if (last) { PG8_STGA(0, 0, nA, 0, gn); } else { PG8_STGA(0, 0, cA, (size_t)(t + 2) * kstep, gc); }
            PG8_WAIT_V(8); PG8_WAIT_L(0); PG8_BAR; PG8_MMA(1, 0, At, B0); PG8_MMA(1, 1, At, B1); PG8_BAR; PG8_SCHED;
            PG8_LDB(B0, 1, 0); PG8_LDB(B1, 1, 1); PG8_SCHED; PG8_LDA(At, 1, 0);
            if (last) { PG8_STGA(0, 1, nA, 0, gn); } else { PG8_STGA(0, 1, cA, (size_t)(t + 2) * kstep, gc); }
            PG8_WAIT_V(8); PG8_WAIT_L(0); PG8_BAR; PG8_MMA(0, 0, At, B0); PG8_MMA(0, 1, At, B1); PG8_BAR; PG8_SCHED;
            PG8_LDA(At, 1, 1); PG8_STAGE(PG8_SB(1, 0), b3, voffB); PG8_STAGE(PG8_SB(1, 1), b3 + hstep, voffB);
            if (last) { PG8_STGA(1, 0, nA, kstep, gn); } else { PG8_STGA(1, 0, cA, (size_t)(t + 3) * kstep, gc); }
            PG8_WAIT_V(8); PG8_WAIT_L(0); PG8_BAR; PG8_MMA(1, 0, At, B0); PG8_MMA(1, 1, At, B1); PG8_BAR; PG8_SCHED;
        }
        if constexpr (ALIGN_EPI) { if (wr == 0) PG8_BAR; }
        if constexpr (FP8) asm volatile("s_nop 15\n\ts_nop 15" ::: "memory");
        if constexpr (!Epi::AFTER_DRAIN) { E(acc, cur, wr, wc, fr, fq); S.done(cur); }
        if (!has_next) break;
#pragma unroll
        for (int a = 0; a < 2; ++a)
#pragma unroll
            for (int b = 0; b < 2; ++b)
#pragma unroll
                for (int m = 0; m < 4; ++m)
#pragma unroll
                    for (int n = 0; n < 2; ++n) acc[a][b][m][n] = (f32x4){0.f, 0.f, 0.f, 0.f};
        if constexpr (FP8) asm volatile("s_nop 7" ::: "memory");
        cur = nxt; cA = nA; cB = nB; ++ui;
#pragma unroll
        for (int h = 0; h < 2; ++h)
#pragma unroll
            for (int i = 0; i < 2; ++i) gc[h][i] = gn[h][i];
        if constexpr (ALIGN_EPI) { if (wr == 1) PG8_BAR; }
    }
    PG8_WAIT_V(0);
    if constexpr (!ALIGN_EPI) { if (wr == 0) PG8_BAR; }
    PG8_BAR;
    if constexpr (Epi::AFTER_DRAIN) { E.fused(acc, cur, wr, wc, fr, fq, lds, wid, lane); S.done(cur); }
#undef PG8_SA
#undef PG8_SB
#undef PG8_STAGE
#undef PG8_STGA
#undef PG8_GLOAD
#undef PG8_LDA
#undef PG8_LDB
#undef PG8_MMA
#undef PG8_CAT8
#undef PG8_WAIT_V
#undef PG8_WAIT_L
#undef PG8_BAR
#undef PG8_SCHED
}
}
constexpr int NB = 4, SEQ = 4096, T = NB * SEQ, LC = 256, TC = NB * LC, TA = T + TC, D = 1024;
constexpr int NE = 16, FF = 2048, ESTR = 2304;
constexpr int LK = LC + SEQ, KVP = 256;
constexpr float ALPHA = 1.6817928305074290f;
constexpr float LN_EPS = 1e-5f, RMS_EPS = 1e-6f;
constexpr float ATT_C2 = 0.125f * 1.4426950408889634f;
constexpr int NWAVES = 8, NTHR = 512;
constexpr size_t MiB = 1u << 20;
constexpr size_t WS_CTL = 0, WS_MOD = 1 * MiB, WS_MODP = 2 * MiB, WS_TW = 6 * MiB;
constexpr size_t WS_WHYIN = 8 * MiB, WS_WHYOUT = 20 * MiB, WS_WQKV = 24 * MiB, WS_WATO = 27 * MiB, WS_WCMIN = 29 * MiB, WS_WCMOUT = 37 * MiB, WS_WCMS = 41 * MiB;
constexpr size_t WS_WGU = 42 * MiB, WS_WDN = 554 * MiB, WS_HF = 810 * MiB;
constexpr size_t WS_XL = 942 * MiB, WS_U = 1010 * MiB, WS_HB = 1078 * MiB, WS_AFF = 1112 * MiB, WS_ROWS = 1114 * MiB, WS_GATE = WS_ROWS + 256 * 1024, WS_INV = 1115 * MiB;
constexpr size_t WS_ACT = 1117 * MiB, WS_Y = 1261 * MiB, WS_SCR = 1405 * MiB, WS_XC = 1677 * MiB, WS_END = 1745 * MiB;
constexpr size_t WS_XG = WS_Y;
constexpr size_t SC_PT = WS_SCR, SC_Z2T = WS_SCR + 204 * MiB, SC_Z2 = WS_SCR + 238 * MiB;
constexpr size_t SC_QKV = WS_SCR, SC_Q = WS_SCR + 102 * MiB, SC_K = WS_SCR + 134 * MiB, SC_V = WS_SCR + 143 * MiB, SC_O = WS_SCR + 152 * MiB;
constexpr size_t SC_UB = WS_SCR, SC_VT = WS_SCR + 64 * MiB, SC_VST = WS_SCR + 192 * MiB, SC_UV = WS_SCR + 194 * MiB;
constexpr size_t HF_SLOT = (size_t)4 * 1024 * 4096 * 4, HF_CTX = 2 * HF_SLOT;
constexpr int LDS_BYTES = 147456;
constexpr int RING_BYTES = 131072, MISC_OFF = LDS_BYTES - 256;

#define GAS __attribute__((address_space(1)))
#define LAS __attribute__((address_space(3)))
typedef unsigned short bf16;
typedef unsigned v4u __attribute__((ext_vector_type(4)));
typedef unsigned v2u __attribute__((ext_vector_type(2)));
typedef float f32x4 __attribute__((ext_vector_type(4)));
typedef float f32x2 __attribute__((ext_vector_type(2)));
#define LDS_WAIT() asm volatile("s_waitcnt lgkmcnt(0)" ::: "memory")
__device__ __forceinline__ unsigned f2bf(float f) { unsigned u = __builtin_bit_cast(unsigned, f); return (u + 0x7fffu + ((u >> 16) & 1u)) >> 16; }
__device__ __forceinline__ unsigned pk2(float lo, float hi) { unsigned r; asm("v_cvt_pk_bf16_f32 %0, %1, %2" : "=v"(r) : "v"(lo), "v"(hi)); return r; }
__device__ __forceinline__ unsigned pk4_e4m3(f32x4 h) { unsigned o8 = 0u;
    o8 = __builtin_amdgcn_cvt_pk_fp8_f32(__builtin_amdgcn_fmed3f(h[0], -448.0f, 448.0f), __builtin_amdgcn_fmed3f(h[1], -448.0f, 448.0f), o8, false);
    o8 = __builtin_amdgcn_cvt_pk_fp8_f32(__builtin_amdgcn_fmed3f(h[2], -448.0f, 448.0f), __builtin_amdgcn_fmed3f(h[3], -448.0f, 448.0f), o8, true); return o8; }
__device__ __forceinline__ f32x4 up4(v2u w) { return (f32x4){__builtin_bit_cast(float, w.x << 16), __builtin_bit_cast(float, w.x & 0xffff0000u), __builtin_bit_cast(float, w.y << 16), __builtin_bit_cast(float, w.y & 0xffff0000u)}; }
__device__ __forceinline__ float bf2f(unsigned short b) { return __builtin_bit_cast(float, (unsigned)b << 16); }
__device__ __forceinline__ float wave_sum(float v) {
#pragma unroll
    for (int o = 1; o < 64; o <<= 1) v += __shfl_xor(v, o);
    return v;
}

#ifndef MK_FP8_HYIN
#define MK_FP8_HYIN 1
#endif
constexpr float WH_SCALE = 64.0f;
#ifndef MK_FP8_CMIN
#define MK_FP8_CMIN 0
#endif
#ifndef MK_FP8_CMV
#define MK_FP8_CMV 0
#endif
constexpr size_t WS_HB8B = 943 * (1ull << 20);
#ifndef MK_FP8_HYOUT
#define MK_FP8_HYOUT 1
#endif
constexpr float Z_SCALE = 8.0f;
#ifndef MK_FP8_AOUT
#define MK_FP8_AOUT 1
#endif
constexpr float O_SCALE = 16.0f;
#ifndef MK_FP8_CMOUT
#define MK_FP8_CMOUT 0
#endif
constexpr float Y_SCALE = 64.0f;
#ifndef MK_FP8_QKV
#define MK_FP8_QKV 1
#endif
#ifndef MK_LNR_WREG
#define MK_LNR_WREG 0
#endif
#ifndef MK_COMB_WIDE
#define MK_COMB_WIDE 1
#endif
#ifndef MK_MERGE_PRO
#define MK_MERGE_PRO 0
#endif
#ifndef MK_FOLLOW_L1INV
#define MK_FOLLOW_L1INV 0
#endif
#ifndef MK_EARLY_WB
#define MK_EARLY_WB 0
#endif
#define XB_TMO      128
#define XB_XCNT(j)  (256  + 64 * (j))
#define XB_XSUB(j)  (1280 + 64 * (j))
#define XB_XGEN(j)  (2304 + 64 * (j))
#define XB_TOP      3328
#define XB_TOPGEN   3392
#define XCD_BAR_WORDS 3456
#define XB_SPIN_CAP (1u << 18)
__device__ __forceinline__ unsigned xb_ld(unsigned* p)              { return __hip_atomic_load(p, __ATOMIC_RELAXED, __HIP_MEMORY_SCOPE_AGENT); }
__device__ __forceinline__ unsigned xb_add(unsigned* p, unsigned v) { return __hip_atomic_fetch_add(p, v, __ATOMIC_RELAXED, __HIP_MEMORY_SCOPE_AGENT); }
__device__ __forceinline__ unsigned xb_xcc_id() { return (unsigned)__builtin_amdgcn_s_getreg((3 << 11) | 20) & 0xFu; }
#define XB_SPIN(cond, bar) do { unsigned _sp = 0; while (cond) { __builtin_amdgcn_s_sleep(1); \
    if ((++_sp & 255u) == 0u) { if (xb_ld(&(bar)[XB_TMO])) break; if (_sp > XB_SPIN_CAP) { atomicAdd(&(bar)[XB_TMO], 1u); break; } } } } while (0)
struct XcdBarrier { unsigned* bar; unsigned x; volatile LAS unsigned* st; };
__device__ __forceinline__ XcdBarrier xcd_barrier_post(unsigned* bar, volatile LAS unsigned* st) {
    XcdBarrier b; b.bar = bar; b.x = xb_xcc_id(); b.st = st;
    if (threadIdx.x == 0) (void)xb_add(&bar[XB_XCNT(b.x)], 1u);
    return b;
}
__device__ __forceinline__ void xcd_barrier_complete(unsigned* bar, unsigned x, unsigned& nloc, unsigned& nx) {
    const unsigned G = gridDim.x * gridDim.y * gridDim.z;
    unsigned sum, cnt, mine, sp = 0u;
    for (;;) {
        sum = 0u; cnt = 0u; mine = 0u;
#pragma unroll
        for (unsigned j = 0; j < 16; ++j) { const unsigned c = xb_ld(&bar[XB_XCNT(j)]); sum += c; cnt += (c > 0u) ? 1u : 0u; mine = (j == x) ? c : mine; }
        if (sum == G) break;
        __builtin_amdgcn_s_sleep(1);
        if ((++sp & 255u) == 0u) { if (xb_ld(&bar[XB_TMO])) break; if (sp > XB_SPIN_CAP) { atomicAdd(&bar[XB_TMO], 1u); break; } }
    }
    nloc = mine > 0u ? mine : 1u; nx = cnt > 0u ? cnt : 1u;
}
__device__ __forceinline__ void xcd_barrier(const XcdBarrier& b) {
    asm volatile("s_waitcnt vmcnt(0)" ::: "memory");
    __syncthreads();
    if (threadIdx.x == 0) {
        unsigned* bar = b.bar; asm volatile("" : "+s"(bar));
        __builtin_amdgcn_s_waitcnt(0);
        unsigned bx_ = b.x; asm volatile("" : "+s"(bx_));
        unsigned nloc = b.st[0], nx = b.st[1];
        if (nloc == 0u) { xcd_barrier_complete(bar, bx_, nloc, nx); b.st[0] = nloc; b.st[1] = nx; }
#if MK_EARLY_WB
        asm volatile("buffer_wbl2 sc1" ::: "memory");
#endif
        const unsigned old = xb_add(&bar[XB_XSUB(bx_)], 1u);
        const unsigned gen = old / nloc;
        if (old + 1u == (gen + 1u) * nloc) {
            __builtin_amdgcn_fence(__ATOMIC_RELEASE, "agent");
            asm volatile("s_waitcnt vmcnt(0)" ::: "memory");
            const unsigned og = xb_add(&bar[XB_TOP], 1u);
            const unsigned tg = og / nx;
            if (og + 1u == (tg + 1u) * nx) xb_add(&bar[XB_TOPGEN], 1u);
            else XB_SPIN(xb_ld(&bar[XB_TOPGEN]) == tg, bar);
            __builtin_amdgcn_fence(__ATOMIC_ACQUIRE, "agent");
            xb_add(&bar[XB_XGEN(bx_)], 1u);
            asm volatile("s_waitcnt vmcnt(0)" ::: "memory");
        } else {
            XB_SPIN(xb_ld(&bar[XB_XGEN(bx_)]) == gen, bar);
#if MK_FOLLOW_L1INV
            asm volatile("buffer_inv sc0" ::: "memory");
#else
            __builtin_amdgcn_fence(__ATOMIC_ACQUIRE, "agent");
#endif
            asm volatile("s_waitcnt vmcnt(0)" ::: "memory");
        }
    }
    __syncthreads();
}

struct Args { const float* in[33]; float* out; unsigned char* ws; int ph_lo, ph_hi; };
enum { I_X = 0, I_C, I_CTX, I_CCTX, I_MODW, I_MODB, I_LNG, I_LNB, I_HYWIN, I_HYCW, I_HYCB, I_FW1, I_FB1, I_FW2, I_FB2, I_FW3, I_FFREQ, I_FBIAS, I_HYWOUT,
       I_WQKV, I_QGAIN, I_KGAIN, I_WATO, I_CMWIN, I_CMLNG, I_CMLNB, I_CMWS, I_CMBS, I_CMWOUT, I_ROUTER, I_WGATE, I_WUP, I_WDOWN };
typedef const __attribute__((address_space(4))) Args* ArgsP;
__device__ __forceinline__ ArgsP get_args() { auto p = __builtin_amdgcn_kernarg_segment_ptr(); asm volatile("" : "+s"(p)); return (ArgsP)p; }
struct Fr { LAS unsigned char* lds; int tid, lane, wave, vcu, G, bx; };
__device__ __forceinline__ Fr mkfr(unsigned char* lds_raw) {
    Fr F; int tid = threadIdx.x; asm volatile("" : "+v"(tid)); int bx = blockIdx.x, G = gridDim.x; asm volatile("" : "+s"(bx), "+s"(G));
    F.lds = (LAS unsigned char*)lds_raw; F.tid = tid; F.lane = tid & 63; F.wave = __builtin_amdgcn_readfirstlane(tid >> 6);
    F.G = G; F.bx = bx; F.vcu = (G % 8 == 0) ? (bx % 8) * (G / 8) + bx / 8 : bx; return F; }
__device__ __forceinline__ void proA_adaln_item(ArgsP a, const Fr& F, int it) {
    LAS float* sc = (LAS float*)F.lds;
    const int i = it / 96, ks = (it / 12) % 8, cc = it % 12;
    __syncthreads();
    for (int u = F.tid; u < 5 * 128; u += NTHR) { const int r = u / 128, k = ks * 128 + (u % 128);
        const float x = r < 4 ? a->in[I_C][r * D + k] : a->in[I_CCTX][k]; sc[u] = x / (1.0f + expf(-x)); }
    __syncthreads();
    const int col = cc * 512 + F.tid;
    const float* w = a->in[I_MODW] + ((size_t)i * D + (size_t)ks * 128) * 6144 + col;
    float acc[5] = {0.f, 0.f, 0.f, 0.f, 0.f};
#pragma unroll 8
    for (int k = 0; k < 128; ++k) { const float wv = w[(size_t)k * 6144];
#pragma unroll
        for (int r = 0; r < 5; ++r) acc[r] += sc[r * 128 + k] * wv; }
    float* mp = (float*)(a->ws + WS_MODP) + (size_t)((i * 8 + ks) * 5) * 6144 + col;
#pragma unroll
    for (int r = 0; r < 5; ++r) {
#if MK_MERGE_PRO
        asm volatile("global_store_dword %0, %1, off sc0 sc1" :: "v"(mp + (size_t)r * 6144), "v"(acc[r]) : "memory");
#else
        mp[(size_t)r * 6144] = acc[r];
#endif
    }
}
__device__ __forceinline__ void proA_filter_item(ArgsP a, const Fr& F, int it) {
    int slot, L, t0; float* HF;
    if (it < 512) { slot = it >> 8; L = SEQ; t0 = (it & 255) * 16; HF = (float*)(a->ws + WS_HF + (size_t)slot * HF_SLOT); }
    else { slot = 0; L = LC; t0 = (it - 512) * 16; HF = (float*)(a->ws + WS_HF + HF_CTX); }
    LAS float* z = (LAS float*)F.lds;
    LAS float* h1 = z + 16 * 33;
    LAS float* h2 = h1 + 16 * 64;
    LAS float* w1s = h2 + 16 * 64;
    LAS float* w2s = w1s + 33 * 64;
    __syncthreads();
    for (int u = F.tid; u < 33 * 64; u += NTHR) w1s[u] = a->in[I_FW1][(size_t)slot * 33 * 64 + u];
    for (int u = F.tid; u < 64 * 64; u += NTHR) w2s[u] = a->in[I_FW2][(size_t)slot * 64 * 64 + u];
    for (int u = F.tid; u < 16 * 33; u += NTHR) { const int tt = u / 33, j = u % 33; const float tf = (float)(t0 + tt);
        float v;
        if (j == 0) v = tf / (float)(L - 1);
        else { const int jj = (j - 1) & 15; const float f = 1e-4f + (float)jj * ((15.0f - 1e-4f) / 15.0f); const float w = (float)(6.283185307179586 / (double)L) * tf;
            v = j <= 16 ? cosf(f * w) : -sinf(f * w); }
        z[u] = v; }
    __syncthreads();
    const LAS float* w1 = w1s; const float* b1 = a->in[I_FB1] + slot * 64;
    const LAS float* w2 = w2s; const float* b2 = a->in[I_FB2] + slot * 64;
    const float* fq = a->in[I_FFREQ] + slot * 128;
    for (int u = F.tid; u < 16 * 64; u += NTHR) { const int tt = u >> 6, j = u & 63; float s = b1[j];
        for (int i = 0; i < 33; ++i) s += z[tt * 33 + i] * w1[i * 64 + j];
        h1[u] = sinf(fq[j] * s); }
    __syncthreads();
    for (int u = F.tid; u < 16 * 64; u += NTHR) { const int tt = u >> 6, j = u & 63; float s = b2[j];
        for (int i = 0; i < 64; ++i) s += h1[tt * 64 + i] * w2[i * 64 + j];
        h2[u] = sinf(fq[64 + j] * s); }
    __syncthreads();
    const float* w3 = a->in[I_FW3] + (size_t)slot * 64 * 4096;
    const float dmin = -3.0701134573253940f, dmax = -15.350567286626973f;
    const int lane = F.lane, lm = lane & 15, lk = lane >> 4;
    float af[16];
#pragma unroll
    for (int s = 0; s < 16; ++s) af[s] = h2[lm * 64 + 4 * s + lk];
    float tl[4];
#pragma unroll
    for (int j = 0; j < 4; ++j) tl[j] = (float)(t0 + 4 * lk + j) / (float)(L - 1);
#define FILT_LOAD(bA, bB, ct_) do { const int c0_ = (F.wave * 32 + (ct_)) * 16 + lm; _Pragma("unroll") for (int s = 0; s < 16; ++s) { bA[s] = w3[(size_t)(4 * s + lk) * 4096 + c0_]; bB[s] = w3[(size_t)(4 * s + lk) * 4096 + c0_ + 16]; } } while (0)
#define FILT_STEP(bA, bB, ct_) do { const int c0 = (F.wave * 32 + (ct_)) * 16 + lm, c1 = c0 + 16; f32x4 acc0 = {0.f, 0.f, 0.f, 0.f}, acc1 = {0.f, 0.f, 0.f, 0.f}; \
        _Pragma("unroll") for (int s = 0; s < 16; ++s) { acc0 = __builtin_amdgcn_mfma_f32_16x16x4f32(af[s], bA[s], acc0, 0, 0, 0); acc1 = __builtin_amdgcn_mfma_f32_16x16x4f32(af[s], bB[s], acc1, 0, 0, 0); } \
        { const float delta = fabsf(dmin + (float)(c0 & 1023) * ((dmax - dmin) / 1023.0f)); f32x4 o; _Pragma("unroll") for (int j = 0; j < 4; ++j) o[j] = acc0[j] * expf(-tl[j] * delta); *(f32x4*)(HF + (size_t)c0 * L + t0 + 4 * lk) = o; } \
        { const float delta = fabsf(dmin + (float)(c1 & 1023) * ((dmax - dmin) / 1023.0f)); f32x4 o; _Pragma("unroll") for (int j = 0; j < 4; ++j) o[j] = acc1[j] * expf(-tl[j] * delta); *(f32x4*)(HF + (size_t)c1 * L + t0 + 4 * lk) = o; } } while (0)
    float p0[16], p1[16], q0[16], q1[16];
    FILT_LOAD(p0, p1, 0);
    for (int ct = 0; ct < 32; ct += 4) {
        FILT_LOAD(q0, q1, ct + 2);
        FILT_STEP(p0, p1, ct);
        if (ct + 4 < 32) FILT_LOAD(p0, p1, ct + 4);
        FILT_STEP(q0, q1, ct + 2);
    }
#undef FILT_LOAD
#undef FILT_STEP
}
__device__ __forceinline__ void conv_tile(const float* W, int K, int N, int k0, int n0, bf16* WT, int drow0, LAS float* scr, int lane) {
    float rv[64];
#pragma unroll
    for (int i = 0; i < 64; ++i) rv[i] = W[(size_t)(k0 + i) * N + n0 + lane];
#pragma unroll
    for (int i = 0; i < 64; ++i) scr[i * 65 + lane] = rv[i];
    LDS_WAIT(); asm volatile("" ::: "memory");
    const int c = lane & 7;
#pragma unroll
    for (int j = 0; j < 8; ++j) { const int n = (lane >> 3) + 8 * j; const LAS float* s = scr + (8 * c) * 65 + n;
        v4u o; o.x = pk2(s[0 * 65], s[1 * 65]); o.y = pk2(s[2 * 65], s[3 * 65]); o.z = pk2(s[4 * 65], s[5 * 65]); o.w = pk2(s[6 * 65], s[7 * 65]);
        *(v4u*)(WT + (size_t)(drow0 + n) * K + k0 + 8 * c) = o; }
    LDS_WAIT(); asm volatile("" ::: "memory");
}
__device__ __forceinline__ void conv_tile8(const float* W, int K, int N, int k0, int n0, unsigned char* WT, int drow0, float scale, LAS float* scr, int lane) {
    float rv[64];
#pragma unroll
    for (int i = 0; i < 64; ++i) rv[i] = W[(size_t)(k0 + i) * N + n0 + lane];
#pragma unroll
    for (int i = 0; i < 64; ++i) scr[i * 65 + lane] = __builtin_amdgcn_fmed3f(rv[i] * scale, -448.0f, 448.0f);
    LDS_WAIT(); asm volatile("" ::: "memory");
    const int c = lane & 3;
#pragma unroll
    for (int j = 0; j < 4; ++j) { const int n = (lane >> 2) + 16 * j; const LAS float* s = scr + (16 * c) * 65 + n;
        unsigned w[4];
#pragma unroll
        for (int q = 0; q < 4; ++q) { unsigned x = 0u; x = __builtin_amdgcn_cvt_pk_fp8_f32(s[(4 * q) * 65], s[(4 * q + 1) * 65], x, false); x = __builtin_amdgcn_cvt_pk_fp8_f32(s[(4 * q + 2) * 65], s[(4 * q + 3) * 65], x, true); w[q] = x; }
        v4u o; o.x = w[0]; o.y = w[1]; o.z = w[2]; o.w = w[3];
        *(v4u*)(WT + (size_t)(drow0 + n) * K + k0 + 16 * c) = o; }
    LDS_WAIT(); asm volatile("" ::: "memory");
}
struct Cv8 { const float* src; unsigned char* dst; int N, K; float scale; };
__device__ __forceinline__ void conv8_load(const Cv8& d, float (&rv)[64], int lane) {
#pragma unroll
    for (int i = 0; i < 64; ++i) rv[i] = d.src[(size_t)i * d.N + lane];
}
__device__ __forceinline__ void conv8_store(const Cv8& d, const float (&rv)[64], LAS float* scr, int lane) {
#pragma unroll
    for (int i = 0; i < 64; ++i) scr[i * 65 + lane] = __builtin_amdgcn_fmed3f(rv[i] * d.scale, -448.0f, 448.0f);
    LDS_WAIT(); asm volatile("" ::: "memory");
    const int c = lane & 3;
#pragma unroll
    for (int j = 0; j < 4; ++j) { const int n = (lane >> 2) + 16 * j; const LAS float* s = scr + (16 * c) * 65 + n;
        unsigned w[4];
#pragma unroll
        for (int q = 0; q < 4; ++q) { unsigned x = 0u; x = __builtin_amdgcn_cvt_pk_fp8_f32(s[(4 * q) * 65], s[(4 * q + 1) * 65], x, false); x = __builtin_amdgcn_cvt_pk_fp8_f32(s[(4 * q + 2) * 65], s[(4 * q + 3) * 65], x, true); w[q] = x; }
        v4u o; o.x = w[0]; o.y = w[1]; o.z = w[2]; o.w = w[3];
        *(v4u*)(d.dst + (size_t)n * d.K + 16 * c) = o; }
    LDS_WAIT(); asm volatile("" ::: "memory");
}
#ifndef MK_CV_CHUNK
#define MK_CV_CHUNK 4
#endif
#ifndef MK_CV_ORDER
#define MK_CV_ORDER 0
#endif
#ifndef MK_CV_PIPE
#define MK_CV_PIPE 0
#endif
#ifndef MK_FP8_DN
#define MK_FP8_DN 1
#endif
constexpr float WGU_SCALE = 64.0f, WDN_SCALE = 128.0f, ACT_SCALE = 2.0f;
constexpr int CV_SMALL = 768 * 2 + 256 * 2 + 384 + 256 + 1024 + 512;
constexpr int CV_MOE = 4 * 16 * 3 * 512;
__device__ __forceinline__ void proA_conv_item(ArgsP a, int it, LAS float* scr, int lane) {
    unsigned char* ws = a->ws;
    if (it < CV_SMALL) {
        int r = it;
        if (r < 1536) { const int s = r / 768, q = r % 768, kb = q / 48, nb = q % 48;
#if MK_FP8_HYIN
            conv_tile8(a->in[I_HYWIN] + (size_t)s * 1024 * 3072, 1024, 3072, kb * 64, nb * 64, (unsigned char*)(ws + WS_WHYIN) + (size_t)s * 3072 * 1024, nb * 64, WH_SCALE, scr, lane); return; } r -= 1536;
#else
            conv_tile(a->in[I_HYWIN] + (size_t)s * 1024 * 3072, 1024, 3072, kb * 64, nb * 64, (bf16*)(ws + WS_WHYIN) + (size_t)s * 3072 * 1024, nb * 64, scr, lane); return; } r -= 1536;
#endif
        if (r < 512) { const int s = r / 256, q = r % 256, kb = q / 16, nb = q % 16;
#if MK_FP8_HYOUT
            conv_tile8(a->in[I_HYWOUT] + (size_t)s * 1024 * 1024, 1024, 1024, kb * 64, nb * 64, (unsigned char*)(ws + WS_WHYOUT) + (size_t)s * 1024 * 1024, nb * 64, WH_SCALE, scr, lane); return; } r -= 512;
#else
            conv_tile(a->in[I_HYWOUT] + (size_t)s * 1024 * 1024, 1024, 1024, kb * 64, nb * 64, (bf16*)(ws + WS_WHYOUT) + (size_t)s * 1024 * 1024, nb * 64, scr, lane); return; } r -= 512;
#endif
        if (r < 384) { const int kb = r / 24, nb = r % 24;
#if MK_FP8_QKV
            conv_tile8(a->in[I_WQKV], 1024, 1536, kb * 64, nb * 64, (unsigned char*)(ws + WS_WQKV), nb * 64, WH_SCALE, scr, lane); return; } r -= 384;
#else
            conv_tile(a->in[I_WQKV], 1024, 1536, kb * 64, nb * 64, (bf16*)(ws + WS_WQKV), nb * 64, scr, lane); return; } r -= 384;
#endif
        if (r < 256) { const int kb = r / 16, nb = r % 16;
#if MK_FP8_AOUT
            conv_tile8(a->in[I_WATO], 1024, 1024, kb * 64, nb * 64, (unsigned char*)(ws + WS_WATO), nb * 64, WH_SCALE, scr, lane); return; } r -= 256;
#else
            conv_tile(a->in[I_WATO], 1024, 1024, kb * 64, nb * 64, (bf16*)(ws + WS_WATO), nb * 64, scr, lane); return; } r -= 256;
#endif
        if (r < 1024) { const int kb = r / 64, nb = r % 64;
#if MK_FP8_CMIN
            conv_tile8(a->in[I_CMWIN], 1024, 4096, kb * 64, nb * 64, (unsigned char*)(ws + WS_WCMIN), nb * 64, WH_SCALE, scr, lane); return; } r -= 1024;
#elif MK_FP8_CMV
            if (nb >= 32) { conv_tile8(a->in[I_CMWIN], 1024, 4096, kb * 64, nb * 64, (unsigned char*)(ws + WS_WCMIN) + (size_t)2048 * 1024 * 2, (nb - 32) * 64, WH_SCALE, scr, lane); return; }
            conv_tile(a->in[I_CMWIN], 1024, 4096, kb * 64, nb * 64, (bf16*)(ws + WS_WCMIN), nb * 64, scr, lane); return; } r -= 1024;
#else
            conv_tile(a->in[I_CMWIN], 1024, 4096, kb * 64, nb * 64, (bf16*)(ws + WS_WCMIN), nb * 64, scr, lane); return; } r -= 1024;
#endif
        { const int kb = r / 16, nb = r % 16;
#if MK_FP8_CMOUT
            conv_tile8(a->in[I_CMWOUT], 2048, 1024, kb * 64, nb * 64, (unsigned char*)(ws + WS_WCMOUT), nb * 64, WH_SCALE, scr, lane); return; }
#else
            conv_tile(a->in[I_CMWOUT], 2048, 1024, kb * 64, nb * 64, (bf16*)(ws + WS_WCMOUT), nb * 64, scr, lane); return; }
#endif
    }
    const int r = it - CV_SMALL, mat = r / 512, q = r % 512, le = mat / 3, which = mat % 3;
    if (which < 2) { const int kb = MK_CV_ORDER ? (q >> 7) * 4 + (q & 3) : q / 32, nb = MK_CV_ORDER ? (q >> 2) & 31 : q % 32, n0 = nb * 64;
        const float* src = a->in[which == 0 ? I_WGATE : I_WUP] + (size_t)le * 1024 * 2048;
        conv_tile8(src, 1024, 2048, kb * 64, n0, (unsigned char*)(ws + WS_WGU) + (size_t)le * 4096 * 1024, (n0 >> 7) * 256 + (n0 & 127) + which * 128, WGU_SCALE, scr, lane); }
    else { const int kb = MK_CV_ORDER ? (q >> 6) * 4 + (q & 3) : q / 16, nb = MK_CV_ORDER ? (q >> 2) & 15 : q % 16;
#if MK_FP8_DN
        conv_tile8(a->in[I_WDOWN] + (size_t)le * 2048 * 1024, 2048, 1024, kb * 64, nb * 64, (unsigned char*)(ws + WS_WDN) + (size_t)le * 1024 * 2048, nb * 64, WDN_SCALE, scr, lane); }
#else
        conv_tile(a->in[I_WDOWN] + (size_t)le * 2048 * 1024, 2048, 1024, kb * 64, nb * 64, (bf16*)(ws + WS_WDN) + (size_t)le * 1024 * 2048, nb * 64, scr, lane); }
#endif
}
#if MK_FP8_DN
__device__ __forceinline__ Cv8 cv8_desc(ArgsP a, int it) {
    unsigned char* ws = a->ws;
    const int r = it - CV_SMALL, mat = r / 512, q = r % 512, le = mat / 3, which = mat % 3;
    Cv8 d;
    if (which < 2) { const int kb = MK_CV_ORDER ? (q >> 7) * 4 + (q & 3) : q / 32, nb = MK_CV_ORDER ? (q >> 2) & 31 : q % 32, n0 = nb * 64;
        d.src = a->in[which == 0 ? I_WGATE : I_WUP] + (size_t)le * 1024 * 2048 + (size_t)(kb * 64) * 2048 + n0; d.N = 2048; d.K = 1024; d.scale = WGU_SCALE;
        d.dst = (unsigned char*)(ws + WS_WGU) + (size_t)le * 4096 * 1024 + (size_t)((n0 >> 7) * 256 + (n0 & 127) + which * 128) * 1024 + kb * 64; }
    else { const int kb = MK_CV_ORDER ? (q >> 6) * 4 + (q & 3) : q / 16, nb = MK_CV_ORDER ? (q >> 2) & 15 : q % 16;
        d.src = a->in[I_WDOWN] + (size_t)le * 2048 * 1024 + (size_t)(kb * 64) * 1024 + nb * 64; d.N = 1024; d.K = 2048; d.scale = WDN_SCALE;
        d.dst = (unsigned char*)(ws + WS_WDN) + (size_t)le * 1024 * 2048 + (size_t)(nb * 64) * 2048 + kb * 64; }
    return d;
}
#endif
constexpr int CV_TOTAL = CV_SMALL + CV_MOE;
constexpr int BG_IDLE[7] = {208, 240, 128, 192, 104, 192, 192};
#ifndef MK_BG_TPW
#define MK_BG_TPW {4, 4, 2, 3, 3, 2, 2}
#endif
constexpr int BG_TPW[7] = MK_BG_TPW;
constexpr int bg_base(int w) { int s = 0; for (int i = 0; i < w; ++i) s += BG_IDLE[i] * 8 * BG_TPW[i]; return s; }
constexpr int CV_DEFER = bg_base(7);
static_assert(CV_DEFER <= 2 * 24576, "the deferred tiles must all belong to layers 2 and 3 (first needed by the layer-2 expert GEMMs; every window runs before that)");
template <int W> __device__ __forceinline__ void bg_convert(ArgsP a, const Fr& F, int rank) {
    if (F.G != 256 || rank < 0 || rank >= BG_IDLE[W]) return;
    LAS float* scr = (LAS float*)(F.lds + F.wave * 16640);
    constexpr int nw = BG_IDLE[W] * 8; const int widx = rank * 8 + F.wave;
#pragma unroll 1
    for (int k = 0; k < BG_TPW[W]; ++k) proA_conv_item(a, CV_TOTAL - CV_DEFER + bg_base(W) + k * nw + widx, scr, F.lane);
}
__device__ __forceinline__ void phase_proB(ArgsP a, const Fr& F);
__device__ __forceinline__ void phase_proA(ArgsP a, const Fr& F) {
    const int gt = F.vcu * NTHR + F.tid, NGT = F.G * NTHR;
    for (int k = gt; k < 8192; k += NGT) { float s, c; sincospif((float)k * (1.0f / 4096.0f), &s, &c); ((f32x2*)(a->ws + WS_TW))[k] = (f32x2){c, s}; }
    for (int k = gt; k < 16 * 128 * 128; k += NGT) ((bf16*)(a->ws + WS_WCMS))[k] = (bf16)f2bf(a->in[I_CMWS][k]);
    const int nbl = F.G >= 2 ? F.G / 2 : 1;
    if (F.vcu < nbl) { for (int it = F.vcu; it < 384 + 528; it += nbl) {
        if (it < 384) { proA_adaln_item(a, F, it);
#if MK_MERGE_PRO
            asm volatile("s_waitcnt vmcnt(0)" ::: "memory"); __syncthreads();
            if (F.tid == 0) (void)xb_add((unsigned*)(a->ws + WS_CTL) + 8256, 1u);
#endif
        } else proA_filter_item(a, F, it - 384); } }
    __syncthreads();
    LAS float* scr = (LAS float*)(F.lds + F.wave * 16640);
    unsigned* q = (unsigned*)(a->ws + WS_CTL) + 8192;
    const unsigned lim = (unsigned)(F.G == 256 ? CV_TOTAL - CV_DEFER : CV_TOTAL);
    for (;;) {
        unsigned i0 = 0u; if (F.lane == 0) i0 = __hip_atomic_fetch_add(q, (unsigned)MK_CV_CHUNK, __ATOMIC_RELAXED, __HIP_MEMORY_SCOPE_AGENT);
        i0 = (unsigned)__builtin_amdgcn_readfirstlane((int)i0);
        if (i0 >= lim) break;
#if MK_FP8_DN && MK_CV_PIPE
        if (MK_CV_CHUNK == 4 && i0 >= (unsigned)CV_SMALL && i0 + 4u <= lim) {
            float rv[64]; Cv8 dn = cv8_desc(a, (int)i0); conv8_load(dn, rv, F.lane);
#pragma unroll 1
            for (int k = 0; k < 4; ++k) { float cur[64]; const Cv8 dc = dn;
#pragma unroll
                for (int i = 0; i < 64; ++i) cur[i] = rv[i];
                if (k < 3) { dn = cv8_desc(a, (int)i0 + k + 1); conv8_load(dn, rv, F.lane); }
                conv8_store(dc, cur, scr, F.lane); }
            continue; }
#endif
        for (unsigned it = i0; it < i0 + (unsigned)MK_CV_CHUNK && it < lim; ++it) proA_conv_item(a, (int)it, scr, F.lane);
    }
#if MK_MERGE_PRO
    __syncthreads();
    if (F.tid == 0) { unsigned* ctl = (unsigned*)(a->ws + WS_CTL); XB_SPIN(xb_ld(ctl + 8256) < 384u, ctl + 4096); }
    __syncthreads();
    __builtin_amdgcn_fence(__ATOMIC_ACQUIRE, "agent");
    phase_proB(a, F);
#endif
}
__device__ __forceinline__ void phase_proB(ArgsP a, const Fr& F) {
    LAS float* m0 = (LAS float*)F.lds;
    const float* mp = (const float*)(a->ws + WS_MODP);
    for (int u = F.tid; u < 5 * 2048; u += NTHR) { const int r = u / 2048, c = u % 2048; float s = a->in[I_MODB][c];
        for (int ks = 0; ks < 8; ++ks) s += mp[(size_t)(ks * 5 + r) * 6144 + c];
        m0[u] = s; }
    __syncthreads();
    const int gw = F.vcu * NWAVES + F.wave, NGW = F.G * NWAVES;
    for (int row = gw; row < TA; row += NGW) {
        const int r = row < T ? (row >> 12) : 4;
        const float* src = row < T ? a->in[I_X] + (size_t)row * D : a->in[I_CTX] + (size_t)(row - T) * D;
        bf16* xl = (bf16*)(a->ws + WS_XC) + (size_t)row * D; const int hrow = row < T ? (row & ~4095) + ((row & 511) << 3) + ((row & 4095) >> 9) : row;
        bf16* hb = (bf16*)(a->ws + WS_HB) + (size_t)hrow * D;
#pragma unroll
        for (int j = 0; j < 4; ++j) { const int c = 4 * F.lane + 256 * j; const f32x4 v = *(const f32x4*)(src + c); { v2u xo; xo.x = pk2(v[0], v[1]); xo.y = pk2(v[2], v[3]); *(v2u*)(xl + c) = xo; }
            const f32x4 sh = *(const LAS f32x4*)(m0 + r * 2048 + c), sc = *(const LAS f32x4*)(m0 + r * 2048 + 1024 + c);
            const f32x4 h = v * (sc + 1.0f) + sh;
#if MK_FP8_HYIN
            *(unsigned*)((unsigned char*)(a->ws + WS_HB) + (size_t)hrow * D + c) = pk4_e4m3(h); }
#else
            v2u o; o.x = pk2(h[0], h[1]); o.y = pk2(h[2], h[3]); *(v2u*)(hb + c) = o; }
#endif
    }
    const int gt = F.vcu * NTHR + F.tid, NGT = F.G * NTHR;
    float* mod = (float*)(a->ws + WS_MOD);
    for (int u = gt; u < 4 * 5 * 6144; u += NGT) { const int i = u / 30720, r = (u / 6144) % 5, c = u % 6144; float s = a->in[I_MODB][i * 6144 + c];
        for (int ks = 0; ks < 8; ++ks) s += mp[(size_t)((i * 8 + ks) * 5 + r) * 6144 + c];
        mod[u] = s; }
}
template <int L>
__device__ __forceinline__ float sconv(const bf16* p, int t, float w0, float w1, float w2, float cb) {
    const float a = t > 0 ? bf2f(p[t - 1]) : 0.f, b = bf2f(p[t]), c = t < L - 1 ? bf2f(p[t + 1]) : 0.f; return w0 * a + w1 * b + w2 * c + cb;
}
template <int L>
__device__ __forceinline__ void hy_direct_item(ArgsP a, const Fr& F, int slot, int d, int tok0, const float* HF) {
    LAS float* kk = (LAS float*)F.lds;
    LAS float* vb = kk + 4 * L;
    LAS float* red = vb + 4 * L;
    const bf16* PT = (const bf16*)(a->ws + SC_PT);
    bf16* Z2T = (bf16*)(a->ws + SC_Z2T);
    __syncthreads();
    for (int o = 0; o < 2; ++o) {
        const float* fw = HF + (size_t)((o * 2 + 0) * 1024 + d) * L; const float* bw = HF + (size_t)((o * 2 + 1) * 1024 + d) * L;
        float s = 0.f;
        for (int t = F.tid; t < L; t += NTHR) { const float f = fw[t], b = bw[t]; kk[o * 2 * L + (L - 1) + t] = f; if (t >= 1) kk[o * 2 * L + (L - 1) - t] = b; s += fabsf(f) + (t >= 1 ? fabsf(b) : 0.f); }
        s = wave_sum(s); if (F.lane == 0) red[o * 8 + F.wave] = s;
    }
    __syncthreads();
    float nrm[2];
#pragma unroll
    for (int o = 0; o < 2; ++o) { float s = 0.f; for (int w = 0; w < 8; ++w) s += red[o * 8 + w]; nrm[o] = 1.0f / (s + 1e-6f); }
    const float* cw = a->in[I_HYCW] + (size_t)slot * 3 * 3072; const float* cbp = a->in[I_HYCB] + (size_t)slot * 3072;
    float w0[3], w1[3], w2[3], cb[3];
#pragma unroll
    for (int g = 0; g < 3; ++g) { const int c = g * 1024 + d; w0[g] = cw[c]; w1[g] = cw[3072 + c]; w2[g] = cw[2 * 3072 + c]; cb[g] = cbp[c]; }
    const float fb0 = a->in[I_FBIAS][(slot * 2 + 0) * 1024 + d], fb1 = a->in[I_FBIAS][(slot * 2 + 1) * 1024 + d];
    for (int u = F.tid; u < 4 * L; u += NTHR) { const int b = u / L, t = u % L; vb[u] = sconv<L>(PT + (size_t)d * TA + tok0 + b * L, t, w0[0], w1[0], w2[0], cb[0]); }
    __syncthreads();
    constexpr int NBLK = 4 * L / 8, PER = (NBLK + NTHR - 1) / NTHR;
    float res[PER][8];
#pragma unroll 1
    for (int o = 0; o < 2; ++o) {
        const LAS float* ko = kk + o * 2 * L;
#pragma unroll
        for (int pi = 0; pi < PER; ++pi) {
            const int q = F.tid + pi * NTHR;
            float acc[8];
#pragma unroll
            for (int j = 0; j < 8; ++j) acc[j] = 0.f;
            if (q < NBLK) {
                const int b = q / (L / 8), t0 = (q % (L / 8)) * 8;
                const LAS float* vv = vb + b * L;
#pragma unroll 1
                for (int s8 = 0; s8 < L; s8 += 8) {
                    const LAS float* kw = ko + (t0 - s8 - 7 + L - 1);
                    float w[15], x[8];
#pragma unroll
                    for (int i = 0; i < 15; ++i) w[i] = kw[i];
#pragma unroll
                    for (int i = 0; i < 8; ++i) x[i] = vv[s8 + i];
#pragma unroll
                    for (int j = 0; j < 8; ++j)
#pragma unroll
                        for (int i = 0; i < 8; ++i) acc[j] += w[j - i + 7] * x[i];
                }
            }
#pragma unroll
            for (int j = 0; j < 8; ++j) res[pi][j] = acc[j];
        }
        __syncthreads();
#pragma unroll
        for (int pi = 0; pi < PER; ++pi) {
            const int q = F.tid + pi * NTHR;
            if (q < NBLK) {
                const int b = q / (L / 8), t0 = (q % (L / 8)) * 8;
                const bf16* pg = PT + (size_t)((o + 1) * 1024 + d) * TA + tok0 + b * L;
#pragma unroll
                for (int j = 0; j < 8; ++j) { const int t = t0 + j; const float vin = vb[b * L + t];
                    const float y = res[pi][j] * nrm[o] + vin * (o == 0 ? fb0 : fb1);
                    const float xg = sconv<L>(pg, t, w0[o + 1], w1[o + 1], w2[o + 1], cb[o + 1]);
                    res[pi][j] = xg * y; }
            }
        }
        __syncthreads();
        if (o == 0) {
#pragma unroll
            for (int pi = 0; pi < PER; ++pi) { const int q = F.tid + pi * NTHR;
                if (q < NBLK) { const int b = q / (L / 8), t0 = (q % (L / 8)) * 8;
#pragma unroll
                    for (int j = 0; j < 8; ++j) vb[b * L + t0 + j] = res[pi][j]; } }
            __syncthreads();
        } else {
#pragma unroll
            for (int pi = 0; pi < PER; ++pi) { const int q = F.tid + pi * NTHR;
                if (q < NBLK) { const int b = q / (L / 8), t0 = (q % (L / 8)) * 8;
                    v4u ov; ov.x = pk2(res[pi][0], res[pi][1]); ov.y = pk2(res[pi][2], res[pi][3]); ov.z = pk2(res[pi][4], res[pi][5]); ov.w = pk2(res[pi][6], res[pi][7]);
                    *(v4u*)(Z2T + (size_t)d * TA + tok0 + b * L + t0) = ov; } }
        }
    }
}
__device__ __forceinline__ void hy_ctx_item(ArgsP a, const Fr& F, int slot, int d) {
    constexpr int L = LC;
    LAS float* kk = (LAS float*)F.lds;
    LAS float* vb = kk + 4 * L;
    LAS float* red = vb + 4 * L;
    LAS float* ps = red + 16;
    const bf16* PT = (const bf16*)(a->ws + SC_PT); bf16* Z2T = (bf16*)(a->ws + SC_Z2T);
    const float* HF = (const float*)(a->ws + WS_HF + HF_CTX); const int tok0 = T;
    __syncthreads();
    for (int o = 0; o < 2; ++o) {
        const float* fw = HF + (size_t)((o * 2 + 0) * 1024 + d) * L; const float* bw = HF + (size_t)((o * 2 + 1) * 1024 + d) * L;
        float s = 0.f;
        for (int t = F.tid; t < L; t += NTHR) { const float f = fw[t], b = bw[t]; kk[o * 2 * L + (L - 1) + t] = f; if (t >= 1) kk[o * 2 * L + (L - 1) - t] = b; s += fabsf(f) + (t >= 1 ? fabsf(b) : 0.f); }
        s = wave_sum(s); if (F.lane == 0) red[o * 8 + F.wave] = s;
    }
    __syncthreads();
    float nrm[2];
#pragma unroll
    for (int o = 0; o < 2; ++o) { float s = 0.f; for (int w = 0; w < 8; ++w) s += red[o * 8 + w]; nrm[o] = 1.0f / (s + 1e-6f); }
    const float* cw = a->in[I_HYCW] + (size_t)slot * 3 * 3072; const float* cbp = a->in[I_HYCB] + (size_t)slot * 3072;
    float w0[3], w1[3], w2[3], cb[3];
#pragma unroll
    for (int g = 0; g < 3; ++g) { const int c = g * 1024 + d; w0[g] = cw[c]; w1[g] = cw[3072 + c]; w2[g] = cw[2 * 3072 + c]; cb[g] = cbp[c]; }
    const float fb0 = a->in[I_FBIAS][(slot * 2 + 0) * 1024 + d], fb1 = a->in[I_FBIAS][(slot * 2 + 1) * 1024 + d];
    for (int u = F.tid; u < 4 * L; u += NTHR) { const int b = u / L, t = u % L; vb[u] = sconv<L>(PT + (size_t)d * TA + tok0 + b * L, t, w0[0], w1[0], w2[0], cb[0]); }
    __syncthreads();
    const int sq = F.tid >> 7, q = F.tid & 127, b = q >> 5, t0 = (q & 31) * 8;
#pragma unroll 1
    for (int o = 0; o < 2; ++o) {
        const LAS float* ko = kk + o * 2 * L; const LAS float* vv = vb + b * L;
        float acc[8];
#pragma unroll
        for (int j = 0; j < 8; ++j) acc[j] = 0.f;
#pragma unroll 1
        for (int s8 = sq * 64; s8 < sq * 64 + 64; s8 += 8) {
            const LAS float* kw = ko + (t0 - s8 - 7 + L - 1);
            float w[15], x[8];
#pragma unroll
            for (int i = 0; i < 15; ++i) w[i] = kw[i];
#pragma unroll
            for (int i = 0; i < 8; ++i) x[i] = vv[s8 + i];
#pragma unroll
            for (int j = 0; j < 8; ++j)
#pragma unroll
                for (int i = 0; i < 8; ++i) acc[j] += w[j - i + 7] * x[i];
        }
#pragma unroll
        for (int j = 0; j < 8; ++j) ps[(sq * 128 + q) * 8 + j] = acc[j];
        __syncthreads();
        float res[8];
        if (F.tid < 128) {
            const bf16* pg = PT + (size_t)((o + 1) * 1024 + d) * TA + tok0 + b * L;
#pragma unroll
            for (int j = 0; j < 8; ++j) { const float cv = ((ps[q * 8 + j] + ps[(128 + q) * 8 + j]) + ps[(256 + q) * 8 + j]) + ps[(384 + q) * 8 + j];
                const int t = t0 + j; const float vin = vb[b * L + t];
                const float y = cv * nrm[o] + vin * (o == 0 ? fb0 : fb1);
                res[j] = sconv<L>(pg, t, w0[o + 1], w1[o + 1], w2[o + 1], cb[o + 1]) * y; }
        }
        __syncthreads();
        if (F.tid < 128) {
            if (o == 0) {
#pragma unroll
                for (int j = 0; j < 8; ++j) vb[b * L + t0 + j] = res[j]; }
            else { v4u ov; ov.x = pk2(res[0], res[1]); ov.y = pk2(res[2], res[3]); ov.z = pk2(res[4], res[5]); ov.w = pk2(res[6], res[7]);
                *(v4u*)(Z2T + (size_t)d * TA + tok0 + b * L + t0) = ov; }
        }
        __syncthreads();
    }
}
__device__ __forceinline__ void phase_hy_tr(ArgsP a, const Fr& F, int ntok) {
    LAS unsigned short* tile = (LAS unsigned short*)(F.lds + F.wave * 9216);
    const bf16* Z2T = (const bf16*)(a->ws + SC_Z2T); bf16* Z2 = (bf16*)(a->ws + SC_Z2);
    const int gw = F.vcu * NWAVES + F.wave, NGW = F.G * NWAVES, ntt = ntok / 64;
    for (int it = gw; it < 16 * ntt; it += NGW) {
        const int c0 = (it / ntt) * 64, t0 = (it % ntt) * 64;
#pragma unroll
        for (int i = 0; i < 8; ++i) { const int ch = i * 8 + (F.lane >> 3), ck = F.lane & 7;
            const v4u v = *(const v4u*)(Z2T + (size_t)(c0 + ch) * TA + t0 + ck * 8); *(LAS v4u*)(tile + ch * 72 + ck * 8) = v; }
        LDS_WAIT(); asm volatile("" ::: "memory");
        int trow = t0 + F.lane;
        if (trow < T) { const int pi = trow & 4095; trow = (trow & ~4095) + (pi >> 3) + 512 * (pi & 7); }
        bf16* dst = Z2 + (size_t)trow * D + c0;
#pragma unroll
        for (int q = 0; q < 8; ++q) { unsigned w[4];
#pragma unroll
            for (int j = 0; j < 4; ++j) { const unsigned lo = tile[(q * 8 + 2 * j) * 72 + F.lane], hi = tile[(q * 8 + 2 * j + 1) * 72 + F.lane]; w[j] = lo | (hi << 16); }
#if MK_FP8_HYOUT
            v2u o8; o8.x = pk4_e4m3((f32x4){__builtin_bit_cast(float, w[0] << 16), __builtin_bit_cast(float, w[0] & 0xffff0000u), __builtin_bit_cast(float, w[1] << 16), __builtin_bit_cast(float, w[1] & 0xffff0000u)} * Z_SCALE);
            o8.y = pk4_e4m3((f32x4){__builtin_bit_cast(float, w[2] << 16), __builtin_bit_cast(float, w[2] & 0xffff0000u), __builtin_bit_cast(float, w[3] << 16), __builtin_bit_cast(float, w[3] & 0xffff0000u)} * Z_SCALE);
            *(v2u*)((unsigned char*)Z2 + (size_t)trow * D + c0 + q * 8) = o8; }
#else
            v4u o; o.x = w[0]; o.y = w[1]; o.z = w[2]; o.w = w[3]; *(v4u*)(dst + q * 8) = o; }
#endif
        LDS_WAIT(); asm volatile("" ::: "memory");
    }
}
__device__ __forceinline__ void phase_hy_conv_direct(ArgsP a, const Fr& F, int layer) {
    const int slot = layer == 0 ? 0 : 1; const int nitems = layer == 0 ? 2048 : 1024;
    for (int it = F.vcu; it < nitems; it += F.G) {
        if (it < 1024) hy_direct_item<SEQ>(a, F, slot, it, 0, (const float*)(a->ws + WS_HF + (size_t)slot * HF_SLOT));
        else hy_direct_item<LC>(a, F, slot, it - 1024, T, (const float*)(a->ws + WS_HF + HF_CTX));
    }
}

__device__ __forceinline__ void lnr_softmax_store(const float (&part)[16], int lane, float* affrow) {
    const bool h5 = (lane & 32) != 0, h4 = (lane & 16) != 0, h3 = (lane & 8) != 0, h2 = (lane & 4) != 0;
    float q8[8], q4[4], q2[2];
#pragma unroll
    for (int k = 0; k < 8; ++k) { const float keep = h5 ? part[8 + k] : part[k], send = h5 ? part[k] : part[8 + k]; q8[k] = keep + __shfl_xor(send, 32); }
#pragma unroll
    for (int k = 0; k < 4; ++k) { const float keep = h4 ? q8[4 + k] : q8[k], send = h4 ? q8[k] : q8[4 + k]; q4[k] = keep + __shfl_xor(send, 16); }
#pragma unroll
    for (int k = 0; k < 2; ++k) { const float keep = h3 ? q4[2 + k] : q4[k], send = h3 ? q4[k] : q4[2 + k]; q2[k] = keep + __shfl_xor(send, 8); }
    float lg; { const float keep = h2 ? q2[1] : q2[0], send = h2 ? q2[0] : q2[1]; lg = keep + __shfl_xor(send, 4); }
    lg += __shfl_xor(lg, 1); lg += __shfl_xor(lg, 2);
    float mx = lg;
#pragma unroll
    for (int o = 4; o < 64; o <<= 1) mx = fmaxf(mx, __shfl_xor(mx, o));
    const float ex = expf(lg - mx); float den = ex;
#pragma unroll
    for (int o = 4; o < 64; o <<= 1) den += __shfl_xor(den, o);
    const int eidx = (h5 ? 8 : 0) + (h4 ? 4 : 0) + (h3 ? 2 : 0) + (h2 ? 1 : 0);
    if ((lane & 3) == 0) affrow[eidx] = ex / den;
}
__device__ __forceinline__ void phase_lnr2(ArgsP a, const Fr& F, int layer, int nrows) {
    LAS float* wr = (LAS float*)F.lds;
    __syncthreads();
    for (int u = F.tid; u < 1024 * 16; u += NTHR) wr[u] = a->in[I_ROUTER][(size_t)layer * 1024 * 16 + (u & 1023) * 16 + (u >> 10)];
    __syncthreads();
    const bf16* U = (const bf16*)(a->ws + WS_U); f32x2* ST = (f32x2*)(a->ws + WS_XL); unsigned char* HB8 = (unsigned char*)(a->ws + WS_HB); float* AFF = (float*)(a->ws + WS_AFF);
    const float* mod = (const float*)(a->ws + WS_MOD) + (size_t)layer * 5 * 6144;
    const float* lg = a->in[I_LNG] + (size_t)(layer * 2 + 0) * D; const float* lb = a->in[I_LNB] + (size_t)(layer * 2 + 0) * D;
    const int gw = F.vcu * NWAVES + F.wave, NGW = F.G * NWAVES, npair = nrows >> 1;
    v2u vn[2][4];
    if (gw < npair) {
#pragma unroll
        for (int q = 0; q < 2; ++q)
#pragma unroll
            for (int j = 0; j < 4; ++j) vn[q][j] = *(const v2u*)(U + (size_t)(2 * gw + q) * D + 4 * F.lane + 256 * j); }
    for (int pi = gw; pi < npair; pi += NGW) {
        int lane = F.lane; asm volatile("" : "+v"(lane));
        const int row = 2 * pi; const int r = row < T ? (row >> 12) : 4;
        f32x4 v[2][4]; float s[2] = {0.f, 0.f};
#pragma unroll
        for (int q = 0; q < 2; ++q)
#pragma unroll
            for (int j = 0; j < 4; ++j) { v[q][j] = up4(vn[q][j]); s[q] += (v[q][j][0] + v[q][j][1]) + (v[q][j][2] + v[q][j][3]); }
        if (pi + NGW < npair) {
#pragma unroll
            for (int q = 0; q < 2; ++q)
#pragma unroll
                for (int j = 0; j < 4; ++j) vn[q][j] = *(const v2u*)(U + (size_t)(2 * (pi + NGW) + q) * D + 4 * lane + 256 * j); }
        float rstd[2];
#pragma unroll
        for (int q = 0; q < 2; ++q) { const float mean = wave_sum(s[q]) * (1.0f / D); float s2 = 0.f;
#pragma unroll
            for (int j = 0; j < 4; ++j) { v[q][j] = v[q][j] - mean; s2 += (v[q][j][0] * v[q][j][0] + v[q][j][1] * v[q][j][1]) + (v[q][j][2] * v[q][j][2] + v[q][j][3] * v[q][j][3]); }
            rstd[q] = 1.0f / sqrtf(wave_sum(s2) * (1.0f / D) + LN_EPS);
            if (lane == 0) ST[row + q] = (f32x2){mean, rstd[q]}; }
        float pa[16], pb[16];
#pragma unroll
        for (int e = 0; e < 16; ++e) { pa[e] = 0.f; pb[e] = 0.f; }
#pragma unroll 1
        for (int j = 0; j < 4; ++j) { const int c = 4 * lane + 256 * j;
            const f32x4 g4 = *(const f32x4*)(lg + c), b4 = *(const f32x4*)(lb + c), sc = *(const f32x4*)(mod + r * 6144 + 4096 + c) + 1.0f, sh = *(const f32x4*)(mod + r * 6144 + 3072 + c);
            f32x4 vA, vB;
            switch (j) { case 0: vA = v[0][0]; vB = v[1][0]; break; case 1: vA = v[0][1]; vB = v[1][1]; break; case 2: vA = v[0][2]; vB = v[1][2]; break; default: vA = v[0][3]; vB = v[1][3]; break; }
            const f32x4 hA = (vA * rstd[0] * g4 + b4) * sc + sh, hB = (vB * rstd[1] * g4 + b4) * sc + sh;
            { unsigned o8 = 0u; o8 = __builtin_amdgcn_cvt_pk_fp8_f32(__builtin_amdgcn_fmed3f(hA[0], -448.0f, 448.0f), __builtin_amdgcn_fmed3f(hA[1], -448.0f, 448.0f), o8, false);
              o8 = __builtin_amdgcn_cvt_pk_fp8_f32(__builtin_amdgcn_fmed3f(hA[2], -448.0f, 448.0f), __builtin_amdgcn_fmed3f(hA[3], -448.0f, 448.0f), o8, true); *(unsigned*)(HB8 + (size_t)row * D + c) = o8; }
            { unsigned o8 = 0u; o8 = __builtin_amdgcn_cvt_pk_fp8_f32(__builtin_amdgcn_fmed3f(hB[0], -448.0f, 448.0f), __builtin_amdgcn_fmed3f(hB[1], -448.0f, 448.0f), o8, false);
              o8 = __builtin_amdgcn_cvt_pk_fp8_f32(__builtin_amdgcn_fmed3f(hB[2], -448.0f, 448.0f), __builtin_amdgcn_fmed3f(hB[3], -448.0f, 448.0f), o8, true); *(unsigned*)(HB8 + (size_t)(row + 1) * D + c) = o8; }
#pragma unroll
            for (int e = 0; e < 16; ++e) { const f32x4 w = *(const LAS f32x4*)(wr + e * 1024 + c);
                pa[e] += (hA[0] * w[0] + hA[1] * w[1]) + (hA[2] * w[2] + hA[3] * w[3]);
                pb[e] += (hB[0] * w[0] + hB[1] * w[1]) + (hB[2] * w[2] + hB[3] * w[3]); }
            asm volatile("" ::: "memory"); }
        lnr_softmax_store(pa, lane, AFF + (size_t)row * 16);
        lnr_softmax_store(pb, lane, AFF + (size_t)(row + 1) * 16);
    }
}
__device__ __forceinline__ void phase_lnr(ArgsP a, const Fr& F, int layer, int nrows) {
    LAS float* wr = (LAS float*)F.lds;
    __syncthreads();
    for (int u = F.tid; u < 1024 * 16; u += NTHR) wr[u] = a->in[I_ROUTER][(size_t)layer * 1024 * 16 + (u & 1023) * 16 + (u >> 10)];
    __syncthreads();
    const bf16* U = (const bf16*)(a->ws + WS_U); f32x2* ST = (f32x2*)(a->ws + WS_XL); unsigned char* HB8 = (unsigned char*)(a->ws + WS_HB); float* AFF = (float*)(a->ws + WS_AFF);
    const float* mod = (const float*)(a->ws + WS_MOD) + (size_t)layer * 5 * 6144;
    const float* lg = a->in[I_LNG] + (size_t)(layer * 2 + 0) * D; const float* lb = a->in[I_LNB] + (size_t)(layer * 2 + 0) * D;
    const int gw = F.vcu * NWAVES + F.wave, NGW = F.G * NWAVES;
    f32x4 wreg[MK_LNR_WREG > 0 ? MK_LNR_WREG : 1][4];
#pragma unroll
    for (int e = 0; e < MK_LNR_WREG; ++e)
#pragma unroll
        for (int j = 0; j < 4; ++j) wreg[e][j] = *(const LAS f32x4*)(wr + e * 1024 + 4 * F.lane + 256 * j);
    v2u vn[4];
    if (gw < nrows) {
#pragma unroll
        for (int j = 0; j < 4; ++j) vn[j] = *(const v2u*)(U + (size_t)gw * D + 4 * F.lane + 256 * j); }
    for (int row = gw; row < nrows; row += NGW) {
        const int r = row < T ? (row >> 12) : 4;
        f32x4 v[4]; float s = 0.f;
#pragma unroll
        for (int j = 0; j < 4; ++j) { v[j] = up4(vn[j]); s += (v[j][0] + v[j][1]) + (v[j][2] + v[j][3]); }
        if (row + NGW < nrows) {
#pragma unroll
            for (int j = 0; j < 4; ++j) vn[j] = *(const v2u*)(U + (size_t)(row + NGW) * D + 4 * F.lane + 256 * j); }
        const float mean = wave_sum(s) * (1.0f / D); float s2 = 0.f;
#pragma unroll
        for (int j = 0; j < 4; ++j) { v[j] = v[j] - mean; s2 += (v[j][0] * v[j][0] + v[j][1] * v[j][1]) + (v[j][2] * v[j][2] + v[j][3] * v[j][3]); }
        const float rstd = 1.0f / sqrtf(wave_sum(s2) * (1.0f / D) + LN_EPS);
        if (F.lane == 0) ST[row] = (f32x2){mean, rstd};
        float part[16];
#pragma unroll
        for (int e = 0; e < 16; ++e) part[e] = 0.f;
#pragma unroll
        for (int j = 0; j < 4; ++j) { const int c = 4 * F.lane + 256 * j;
            const f32x4 x = v[j] * rstd * *(const f32x4*)(lg + c) + *(const f32x4*)(lb + c);
            const f32x4 h = x * (*(const f32x4*)(mod + r * 6144 + 4096 + c) + 1.0f) + *(const f32x4*)(mod + r * 6144 + 3072 + c);
            { unsigned o8 = 0u; const f32x4 hc = {__builtin_amdgcn_fmed3f(h[0], -448.0f, 448.0f), __builtin_amdgcn_fmed3f(h[1], -448.0f, 448.0f), __builtin_amdgcn_fmed3f(h[2], -448.0f, 448.0f), __builtin_amdgcn_fmed3f(h[3], -448.0f, 448.0f)};
              o8 = __builtin_amdgcn_cvt_pk_fp8_f32(hc[0], hc[1], o8, false); o8 = __builtin_amdgcn_cvt_pk_fp8_f32(hc[2], hc[3], o8, true); *(unsigned*)(HB8 + (size_t)row * D + c) = o8; }
#pragma unroll
            for (int e = 0; e < 16; ++e) { const f32x4 w = e < MK_LNR_WREG ? wreg[e < MK_LNR_WREG ? e : 0][j] : *(const LAS f32x4*)(wr + e * 1024 + c);
                part[e] += (h[0] * w[0] + h[1] * w[1]) + (h[2] * w[2] + h[3] * w[3]); }
            asm volatile("" ::: "memory"); }
        const bool h5 = (F.lane & 32) != 0, h4 = (F.lane & 16) != 0, h3 = (F.lane & 8) != 0, h2 = (F.lane & 4) != 0;
        float q8[8], q4[4], q2[2];
#pragma unroll
        for (int k = 0; k < 8; ++k) { const float keep = h5 ? part[8 + k] : part[k], send = h5 ? part[k] : part[8 + k]; q8[k] = keep + __shfl_xor(send, 32); }
#pragma unroll
        for (int k = 0; k < 4; ++k) { const float keep = h4 ? q8[4 + k] : q8[k], send = h4 ? q8[k] : q8[4 + k]; q4[k] = keep + __shfl_xor(send, 16); }
#pragma unroll
        for (int k = 0; k < 2; ++k) { const float keep = h3 ? q4[2 + k] : q4[k], send = h3 ? q4[k] : q4[2 + k]; q2[k] = keep + __shfl_xor(send, 8); }
        float lg; { const float keep = h2 ? q2[1] : q2[0], send = h2 ? q2[0] : q2[1]; lg = keep + __shfl_xor(send, 4); }
        lg += __shfl_xor(lg, 1); lg += __shfl_xor(lg, 2);
        float mx = lg;
#pragma unroll
        for (int o = 4; o < 64; o <<= 1) mx = fmaxf(mx, __shfl_xor(mx, o));
        const float ex = expf(lg - mx); float den = ex;
#pragma unroll
        for (int o = 4; o < 64; o <<= 1) den += __shfl_xor(den, o);
        const int eidx = (h5 ? 8 : 0) + (h4 ? 4 : 0) + (h3 ? 2 : 0) + (h2 ? 1 : 0);
        if ((F.lane & 3) == 0) AFF[(size_t)row * 16 + eidx] = ex / den;
    }
}

template <int N, int CAPN>
__device__ __forceinline__ void topk_item(ArgsP a, const Fr& F, int b, int e, int rowbase, int slotbase, bool pad) {
    LAS unsigned* hist = (LAS unsigned*)F.lds;
    LAS unsigned* sel = hist + 256;
    LAS unsigned* wtot = hist + 264;
    const float* AFF = (const float*)(a->ws + WS_AFF); int* ROWS = (int*)(a->ws + WS_ROWS); float* GATE = (float*)(a->ws + WS_GATE); int* INV = (int*)(a->ws + WS_INV);
    const int tid = F.tid, lane = F.lane; const bool act = tid * 8 < N;
    unsigned key[8];
#pragma unroll
    for (int j = 0; j < 8; ++j) key[j] = act ? __float_as_uint(AFF[(size_t)(rowbase + tid * 8 + j) * 16 + e]) : 0u;
    unsigned prefix = 0u, need = CAPN;
#pragma unroll 1
    for (int pass = 0; pass < 4; ++pass) {
        const int shift = 24 - 8 * pass; const unsigned himask = pass == 0 ? 0u : (0xFFFFFFFFu << (shift + 8));
        __syncthreads();
        if (tid < 256) hist[tid] = 0u;
        __syncthreads();
        if (act) {
#pragma unroll
            for (int j = 0; j < 8; ++j) if ((key[j] & himask) == prefix) __hip_atomic_fetch_add(&hist[(key[j] >> shift) & 255u], 1u, __ATOMIC_RELAXED, __HIP_MEMORY_SCOPE_WORKGROUP);
        }
        __syncthreads();
        if (tid < 64) {
            const unsigned v0 = hist[4 * lane], v1 = hist[4 * lane + 1], v2 = hist[4 * lane + 2], v3 = hist[4 * lane + 3]; const unsigned tot = v0 + v1 + v2 + v3;
            unsigned x = tot;
#pragma unroll
            for (int o = 1; o < 64; o <<= 1) { const unsigned t = __shfl_down(x, o); if (lane + o < 64) x += t; }
            const unsigned a3 = x - tot, a2 = a3 + v3, a1 = a2 + v2, a0 = a1 + v1;
            if (a3 < need && need <= a3 + v3) { sel[0] = 4 * lane + 3; sel[1] = a3; }
            if (a2 < need && need <= a2 + v2) { sel[0] = 4 * lane + 2; sel[1] = a2; }
            if (a1 < need && need <= a1 + v1) { sel[0] = 4 * lane + 1; sel[1] = a1; }
            if (a0 < need && need <= a0 + v0) { sel[0] = 4 * lane + 0; sel[1] = a0; }
        }
        __syncthreads();
        prefix |= sel[0] << shift; need -= sel[1];
    }
    const unsigned tau = prefix;
    unsigned ceq = 0u;
#pragma unroll
    for (int j = 0; j < 8; ++j) ceq += (act && key[j] == tau) ? 1u : 0u;
    unsigned xe = ceq;
#pragma unroll
    for (int o = 1; o < 64; o <<= 1) { const unsigned t = __shfl_up(xe, o); if (lane >= o) xe += t; }
    __syncthreads();
    if (lane == 63) wtot[F.wave * 2] = xe;
    __syncthreads();
    unsigned eqbase = xe - ceq; for (int w = 0; w < F.wave; ++w) eqbase += wtot[w * 2];
    unsigned flags = 0u, csel = 0u;
#pragma unroll
    for (int j = 0; j < 8; ++j) { bool s = false; if (act) { if (key[j] > tau) s = true; else if (key[j] == tau) { s = eqbase < need; ++eqbase; } } if (s) { flags |= 1u << j; ++csel; } }
    unsigned xs = csel;
#pragma unroll
    for (int o = 1; o < 64; o <<= 1) { const unsigned t = __shfl_up(xs, o); if (lane >= o) xs += t; }
    if (lane == 63) wtot[F.wave * 2 + 1] = xs;
    __syncthreads();
    unsigned pos = xs - csel; for (int w = 0; w < F.wave; ++w) pos += wtot[w * 2 + 1];
    if (act) {
#pragma unroll
        for (int j = 0; j < 8; ++j) { const int row = rowbase + tid * 8 + j; int slot = -1;
            if (flags & (1u << j)) { slot = e * ESTR + slotbase + (int)pos; ++pos; ROWS[slot] = row; GATE[slot] = __uint_as_float(key[j]); }
            INV[(size_t)row * 16 + e] = slot; }
    }
    if (pad) for (int p = tid; p < 128; p += NTHR) { ROWS[e * ESTR + 2176 + p] = 0; GATE[e * ESTR + 2176 + p] = 0.f; }
}
__device__ __forceinline__ void phase_topk(ArgsP a, const Fr& F, int layer) {
    const int nitems = layer == 0 ? 128 : 64;
    for (int it = F.vcu; it < nitems; it += F.G) {
        if (it < 64) { const int b = it >> 4, e = it & 15; topk_item<SEQ, 512>(a, F, b, e, b * SEQ, b * 512, false); }
        else { const int b = (it - 64) >> 4, e = it & 15; topk_item<LC, 32>(a, F, b, e, T + b * LC, 2048 + b * 32, b == 0); }
    }
}
__device__ __forceinline__ void phase_gather(ArgsP a, const Fr& F, int layer) {
    const int me = layer == 0 ? 2304 : 2048;
    const int* ROWS = (const int*)(a->ws + WS_ROWS); const bf16* HB = (const bf16*)(a->ws + WS_HB); bf16* XG = (bf16*)(a->ws + WS_XG);
    const int gw = F.vcu * NWAVES + F.wave, NGW = F.G * NWAVES;
    for (int it = gw; it < 16 * me; it += NGW) { const int e = it / me, s = it % me, dr = e * ESTR + s; const int sr = ROWS[dr];
        const v4u* src = (const v4u*)(HB + (size_t)sr * D); v4u* dst = (v4u*)(XG + (size_t)dr * D);
        dst[F.lane] = src[F.lane]; dst[64 + F.lane] = src[64 + F.lane]; }
}
#if MK_FP8_Y
typedef unsigned comb_y_t;
#define COMB_YLOAD(p, off) (*(const unsigned*)((const unsigned char*)(p) + (off)))
#define COMB_YS (1.0f / Y_SCALE)
#define COMB_YROW(s) ((const bf16*)((const unsigned char*)Y + (size_t)(s) * D))
__device__ __forceinline__ f32x4 comb_y_up(unsigned w) { const auto lo = __builtin_amdgcn_cvt_pk_f32_fp8(w, false), hi = __builtin_amdgcn_cvt_pk_f32_fp8(w, true); return (f32x4){lo[0], lo[1], hi[0], hi[1]}; }
#else
typedef v2u comb_y_t;
#define COMB_YLOAD(p, off) (*(const v2u*)((p) + (off)))
#define COMB_YS 1.0f
#define COMB_YROW(s) (Y + (size_t)(s) * D)
__device__ __forceinline__ f32x4 comb_y_up(v2u w) { return up4(w); }
#endif
#if MK_COMB_WIDE && MK_FP8_Y && !MK_FP8_CMV
__device__ __forceinline__ void phase_comb(ArgsP a, const Fr& F, int layer, int nrows) {
    const unsigned char* Y = (const unsigned char*)(a->ws + WS_Y); const bf16* XL = (const bf16*)(a->ws + WS_U); const f32x2* ST = (const f32x2*)(a->ws + WS_XL); bf16* XC = (bf16*)(a->ws + WS_XC); bf16* HB = (bf16*)(a->ws + WS_HB); const int* INV = (const int*)(a->ws + WS_INV);
    const float* lg1 = a->in[I_LNG] + (size_t)(layer * 2 + 0) * D; const float* lb1 = a->in[I_LNB] + (size_t)(layer * 2 + 0) * D;
    const float* mod = (const float*)(a->ws + WS_MOD) + (size_t)layer * 5 * 6144;
    const float* modn = (const float*)(a->ws + WS_MOD) + (size_t)(layer < 3 ? layer + 1 : 3) * 5 * 6144;
    const float* lg = a->in[I_LNG] + (size_t)(layer * 2 + 1) * D; const float* lb = a->in[I_LNB] + (size_t)(layer * 2 + 1) * D;
    const int gw = F.vcu * NWAVES + F.wave, NGW = F.G * NWAVES;
#define COMB_ISSUE(inv_, row_, sl_, rest_, yv_, xl_, st_) do { unsigned mk_ = (unsigned)(__ballot((inv_) >= 0) & 0xFFFFull); \
        _Pragma("unroll") for (int q = 0; q < 4; ++q) { if (mk_) { const int e_ = __builtin_ctz(mk_); mk_ &= mk_ - 1; sl_[q] = __shfl((inv_), e_); } else sl_[q] = -1; } \
        rest_ = mk_; \
        _Pragma("unroll") for (int q = 0; q < 4; ++q) if (sl_[q] >= 0) { const unsigned char* yp_ = Y + (size_t)sl_[q] * D; _Pragma("unroll") for (int jj = 0; jj < 2; ++jj) yv_[q][jj] = *(const v2u*)(yp_ + 8 * F.lane + 512 * jj); } \
        _Pragma("unroll") for (int jj = 0; jj < 2; ++jj) xl_[jj] = *(const v4u*)(XL + (size_t)(row_) * D + 8 * F.lane + 512 * jj); st_ = ST[(row_)]; } while (0)
    int inv_c = gw < nrows ? INV[(size_t)gw * 16 + (F.lane & 15)] : -1;
    int inv_n = gw + NGW < nrows ? INV[(size_t)(gw + NGW) * 16 + (F.lane & 15)] : -1;
    int sl_c[4] = {-1, -1, -1, -1}; unsigned rest_c = 0u; v2u yv_c[4][2]; v4u xl_c[2]; f32x2 st_c = {0.f, 1.f};
    if (gw < nrows) COMB_ISSUE(inv_c, gw, sl_c, rest_c, yv_c, xl_c, st_c);
    for (int row = gw; row < nrows; row += NGW) {
        const int r = row < T ? (row >> 12) : 4;
        const int hrow = (layer == 2 && row < T) ? (row & ~4095) + ((row & 511) << 3) + ((row & 4095) >> 9) : row;
        const int myinv = inv_c;
        int sl_n[4] = {-1, -1, -1, -1}; unsigned rest_n = 0u; v2u yv_n[4][2]; v4u xl_n[2]; f32x2 st_n = {0.f, 1.f};
        const bool has_n = row + NGW < nrows;
        if (has_n) COMB_ISSUE(inv_n, row + NGW, sl_n, rest_n, yv_n, xl_n, st_n);
        const int inv_nn = (row + 2 * NGW < nrows) ? INV[(size_t)(row + 2 * NGW) * 16 + (F.lane & 15)] : -1;
        f32x4 m[4];
#pragma unroll
        for (int k = 0; k < 4; ++k) m[k] = (f32x4){0.f, 0.f, 0.f, 0.f};
#pragma unroll
        for (int q = 0; q < 4; ++q) if (sl_c[q] >= 0) {
#pragma unroll
            for (int jj = 0; jj < 2; ++jj) { m[2 * jj] += comb_y_up(yv_c[q][jj].x); m[2 * jj + 1] += comb_y_up(yv_c[q][jj].y); } }
        unsigned msk = rest_c;
        while (msk) { const int e = __builtin_ctz(msk); msk &= msk - 1; const int slot = __shfl(myinv, e); const unsigned char* yp = Y + (size_t)slot * D;
#pragma unroll
            for (int jj = 0; jj < 2; ++jj) { const v2u w = *(const v2u*)(yp + 8 * F.lane + 512 * jj); m[2 * jj] += comb_y_up(w.x); m[2 * jj + 1] += comb_y_up(w.y); } }
        f32x4 xc[4];
#pragma unroll
        for (int k = 0; k < 4; ++k) { const int c = 8 * F.lane + 512 * (k >> 1) + 4 * (k & 1); const v4u xw = xl_c[k >> 1]; v2u half; half.x = (k & 1) ? xw.z : xw.x; half.y = (k & 1) ? xw.w : xw.y;
            xc[k] = (up4(half) - st_c.x) * st_c.y * *(const f32x4*)(lg1 + c) + *(const f32x4*)(lb1 + c); }
        inv_c = inv_n; inv_n = inv_nn; rest_c = rest_n; st_c = st_n;
#pragma unroll
        for (int q = 0; q < 4; ++q) { sl_c[q] = sl_n[q];
#pragma unroll
            for (int jj = 0; jj < 2; ++jj) yv_c[q][jj] = yv_n[q][jj]; }
#pragma unroll
        for (int jj = 0; jj < 2; ++jj) xl_c[jj] = xl_n[jj];
        f32x4 v[4]; float s = 0.f;
#pragma unroll
        for (int k = 0; k < 4; ++k) { const int c = 8 * F.lane + 512 * (k >> 1) + 4 * (k & 1);
            v[k] = xc[k] * ALPHA + *(const f32x4*)(mod + r * 6144 + 5120 + c) * (m[k] * COMB_YS); s += (v[k][0] + v[k][1]) + (v[k][2] + v[k][3]); }
        const float mean = wave_sum(s) * (1.0f / D); float s2 = 0.f;
#pragma unroll
        for (int k = 0; k < 4; ++k) { v[k] = v[k] - mean; s2 += (v[k][0] * v[k][0] + v[k][1] * v[k][1]) + (v[k][2] * v[k][2] + v[k][3] * v[k][3]); }
        const float rstd = 1.0f / sqrtf(wave_sum(s2) * (1.0f / D) + LN_EPS);
#pragma unroll
        for (int jj = 0; jj < 2; ++jj) { const int c0 = 8 * F.lane + 512 * jj;
            const f32x4 xa = v[2 * jj] * rstd * *(const f32x4*)(lg + c0) + *(const f32x4*)(lb + c0), xb = v[2 * jj + 1] * rstd * *(const f32x4*)(lg + c0 + 4) + *(const f32x4*)(lb + c0 + 4);
            if (layer == 3) { *(f32x4*)(a->out + (size_t)row * D + c0) = xa; *(f32x4*)(a->out + (size_t)row * D + c0 + 4) = xb; }
            else { { v4u xo; xo.x = pk2(xa[0], xa[1]); xo.y = pk2(xa[2], xa[3]); xo.z = pk2(xb[0], xb[1]); xo.w = pk2(xb[2], xb[3]); *(v4u*)(XC + (size_t)row * D + c0) = xo; }
                const f32x4 ha = xa * (*(const f32x4*)(modn + r * 6144 + 1024 + c0) + 1.0f) + *(const f32x4*)(modn + r * 6144 + c0);
                const f32x4 hb = xb * (*(const f32x4*)(modn + r * 6144 + 1024 + c0 + 4) + 1.0f) + *(const f32x4*)(modn + r * 6144 + c0 + 4);
                if ((MK_FP8_HYIN && layer == 2) || (MK_FP8_CMIN && layer == 1) || (MK_FP8_QKV && layer == 0)) { v2u o8; o8.x = pk4_e4m3(ha); o8.y = pk4_e4m3(hb); *(v2u*)((unsigned char*)HB + (size_t)hrow * D + c0) = o8; }
                else { v4u o; o.x = pk2(ha[0], ha[1]); o.y = pk2(ha[2], ha[3]); o.z = pk2(hb[0], hb[1]); o.w = pk2(hb[2], hb[3]); *(v4u*)(HB + (size_t)hrow * D + c0) = o; } } }
    }
#undef COMB_ISSUE
}
#else
__device__ __forceinline__ void phase_comb(ArgsP a, const Fr& F, int layer, int nrows) {
    const bf16* Y = (const bf16*)(a->ws + WS_Y); const bf16* XL = (const bf16*)(a->ws + WS_U); const f32x2* ST = (const f32x2*)(a->ws + WS_XL); bf16* XC = (bf16*)(a->ws + WS_XC); bf16* HB = (bf16*)(a->ws + WS_HB); const int* INV = (const int*)(a->ws + WS_INV);
    const float* lg1 = a->in[I_LNG] + (size_t)(layer * 2 + 0) * D; const float* lb1 = a->in[I_LNB] + (size_t)(layer * 2 + 0) * D;
    const float* mod = (const float*)(a->ws + WS_MOD) + (size_t)layer * 5 * 6144;
    const float* modn = (const float*)(a->ws + WS_MOD) + (size_t)(layer < 3 ? layer + 1 : 3) * 5 * 6144;
    const float* lg = a->in[I_LNG] + (size_t)(layer * 2 + 1) * D; const float* lb = a->in[I_LNB] + (size_t)(layer * 2 + 1) * D;
    const int gw = F.vcu * NWAVES + F.wave, NGW = F.G * NWAVES;
#define COMB_ISSUE(inv_, row_, sl_, rest_, yv_, xl_, st_) do { unsigned mk_ = (unsigned)(__ballot((inv_) >= 0) & 0xFFFFull); \
        _Pragma("unroll") for (int q = 0; q < 4; ++q) { if (mk_) { const int e_ = __builtin_ctz(mk_); mk_ &= mk_ - 1; sl_[q] = __shfl((inv_), e_); } else sl_[q] = -1; } \
        rest_ = mk_; \
        _Pragma("unroll") for (int q = 0; q < 4; ++q) if (sl_[q] >= 0) { const bf16* yp_ = COMB_YROW(sl_[q]); _Pragma("unroll") for (int j = 0; j < 4; ++j) yv_[q][j] = COMB_YLOAD(yp_, 4 * F.lane + 256 * j); } \
        _Pragma("unroll") for (int j = 0; j < 4; ++j) xl_[j] = *(const v2u*)(XL + (size_t)(row_) * D + 4 * F.lane + 256 * j); st_ = ST[(row_)]; } while (0)
    int inv_c = gw < nrows ? INV[(size_t)gw * 16 + (F.lane & 15)] : -1;
    int inv_n = gw + NGW < nrows ? INV[(size_t)(gw + NGW) * 16 + (F.lane & 15)] : -1;
    int sl_c[4] = {-1, -1, -1, -1}; unsigned rest_c = 0u; comb_y_t yv_c[4][4]; v2u xl_c[4]; f32x2 st_c = {0.f, 1.f};
    if (gw < nrows) COMB_ISSUE(inv_c, gw, sl_c, rest_c, yv_c, xl_c, st_c);
    for (int row = gw; row < nrows; row += NGW) {
        const int r = row < T ? (row >> 12) : 4;
        const int hrow = (layer == 2 && row < T) ? (row & ~4095) + ((row & 511) << 3) + ((row & 4095) >> 9) : row;
        const int myinv = inv_c;
        int sl_n[4] = {-1, -1, -1, -1}; unsigned rest_n = 0u; comb_y_t yv_n[4][4]; v2u xl_n[4]; f32x2 st_n = {0.f, 1.f};
        const bool has_n = row + NGW < nrows;
        if (has_n) COMB_ISSUE(inv_n, row + NGW, sl_n, rest_n, yv_n, xl_n, st_n);
        const int inv_nn = (row + 2 * NGW < nrows) ? INV[(size_t)(row + 2 * NGW) * 16 + (F.lane & 15)] : -1;
        f32x4 m[4];
#pragma unroll
        for (int j = 0; j < 4; ++j) m[j] = (f32x4){0.f, 0.f, 0.f, 0.f};
#pragma unroll
        for (int q = 0; q < 4; ++q) if (sl_c[q] >= 0) {
#pragma unroll
            for (int j = 0; j < 4; ++j) m[j] += comb_y_up(yv_c[q][j]); }
        unsigned msk = rest_c;
        while (msk) { const int e = __builtin_ctz(msk); msk &= msk - 1; const int slot = __shfl(myinv, e); const bf16* yp = COMB_YROW(slot);
#pragma unroll
            for (int j = 0; j < 4; ++j) m[j] += comb_y_up(COMB_YLOAD(yp, 4 * F.lane + 256 * j)); }
        f32x4 xc[4];
#pragma unroll
        for (int j = 0; j < 4; ++j) { const int c = 4 * F.lane + 256 * j; xc[j] = (up4(xl_c[j]) - st_c.x) * st_c.y * *(const f32x4*)(lg1 + c) + *(const f32x4*)(lb1 + c); }
        inv_c = inv_n; inv_n = inv_nn; rest_c = rest_n; st_c = st_n;
#pragma unroll
        for (int q = 0; q < 4; ++q) { sl_c[q] = sl_n[q];
#pragma unroll
            for (int j = 0; j < 4; ++j) yv_c[q][j] = yv_n[q][j]; }
#pragma unroll
        for (int j = 0; j < 4; ++j) xl_c[j] = xl_n[j];
        f32x4 v[4]; float s = 0.f;
#pragma unroll
        for (int j = 0; j < 4; ++j) { const int c = 4 * F.lane + 256 * j;
            v[j] = xc[j] * ALPHA + *(const f32x4*)(mod + r * 6144 + 5120 + c) * (m[j] * COMB_YS); s += (v[j][0] + v[j][1]) + (v[j][2] + v[j][3]); }
        const float mean = wave_sum(s) * (1.0f / D); float s2 = 0.f;
#pragma unroll
        for (int j = 0; j < 4; ++j) { v[j] = v[j] - mean; s2 += (v[j][0] * v[j][0] + v[j][1] * v[j][1]) + (v[j][2] * v[j][2] + v[j][3] * v[j][3]); }
        const float rstd = 1.0f / sqrtf(wave_sum(s2) * (1.0f / D) + LN_EPS);
#pragma unroll
        for (int j = 0; j < 4; ++j) { const int c = 4 * F.lane + 256 * j;
            const f32x4 x = v[j] * rstd * *(const f32x4*)(lg + c) + *(const f32x4*)(lb + c);
            if (layer == 3) { *(f32x4*)(a->out + (size_t)row * D + c) = x; }
            else { { v2u xo; xo.x = pk2(x[0], x[1]); xo.y = pk2(x[2], x[3]); *(v2u*)(XC + (size_t)row * D + c) = xo; }
                const f32x4 h = x * (*(const f32x4*)(modn + r * 6144 + 1024 + c) + 1.0f) + *(const f32x4*)(modn + r * 6144 + c);
                if ((MK_FP8_HYIN && layer == 2) || (MK_FP8_CMIN && layer == 1) || (MK_FP8_QKV && layer == 0)) *(unsigned*)((unsigned char*)HB + (size_t)hrow * D + c) = pk4_e4m3(h);
                else { v2u o; o.x = pk2(h[0], h[1]); o.y = pk2(h[2], h[3]); *(v2u*)(HB + (size_t)hrow * D + c) = o;
                    if (MK_FP8_CMV && !MK_FP8_CMIN && layer == 1) *(unsigned*)((unsigned char*)(a->ws + WS_HB8B) + (size_t)row * D + c) = pk4_e4m3(h); } } }
    }
#undef COMB_ISSUE
}
#endif
#ifndef FFT_HD
#define FFT_HD __device__ __forceinline__
#endif
typedef float cf2 __attribute__((ext_vector_type(2)));
FFT_HD cf2 cmul(cf2 a, cf2 b) { return (cf2){a.x * b.x - a.y * b.y, a.x * b.y + a.y * b.x}; }
FFT_HD int fpad(int p) { return p + (p >> 5); }
constexpr int FFT_N = 8192, FFT_BUF = 8192 + 256;
template <bool INV> FFT_HD void dft4(cf2& a, cf2& b, cf2& c, cf2& d) {
    const cf2 s0 = a + c, s1 = a - c, s2 = b + d, s3 = b - d;
    const cf2 js3 = INV ? (cf2){-s3.y, s3.x} : (cf2){s3.y, -s3.x};
    a = s0 + s2; b = s1 + js3; c = s0 - s2; d = s1 - js3;
}
template <bool INV> FFT_HD void dft16(cf2 (&x)[16]) {
#pragma unroll
    for (int n0 = 0; n0 < 4; ++n0) dft4<INV>(x[n0], x[n0 + 4], x[n0 + 8], x[n0 + 12]);
    constexpr float C1 = 0.92387953251128674f, S1 = 0.38268343236508977f, R2 = 0.70710678118654752f;
    const float sg = INV ? 1.f : -1.f;
    const cf2 w1 = {C1, sg * S1}, w2 = {R2, sg * R2}, w3 = {S1, sg * C1}, w4 = {0.f, sg * 1.f}, w6 = {-R2, sg * R2}, w9 = {-C1, -sg * S1};
    x[1 + 4 * 1] = cmul(x[1 + 4 * 1], w1); x[1 + 4 * 2] = cmul(x[1 + 4 * 2], w2); x[1 + 4 * 3] = cmul(x[1 + 4 * 3], w3);
    x[2 + 4 * 1] = cmul(x[2 + 4 * 1], w2); x[2 + 4 * 2] = cmul(x[2 + 4 * 2], w4); x[2 + 4 * 3] = cmul(x[2 + 4 * 3], w6);
    x[3 + 4 * 1] = cmul(x[3 + 4 * 1], w3); x[3 + 4 * 2] = cmul(x[3 + 4 * 2], w6); x[3 + 4 * 3] = cmul(x[3 + 4 * 3], w9);
#pragma unroll
    for (int k0 = 0; k0 < 4; ++k0) dft4<INV>(x[0 + 4 * k0], x[1 + 4 * k0], x[2 + 4 * k0], x[3 + 4 * k0]);
#pragma unroll
    for (int i = 0; i < 4; ++i)
#pragma unroll
        for (int j = i + 1; j < 4; ++j) { const cf2 t = x[i + 4 * j]; x[i + 4 * j] = x[j + 4 * i]; x[j + 4 * i] = t; }
}
FFT_HD cf2 cmulc(cf2 a, cf2 b) { return (cf2){a.x * b.x + a.y * b.y, a.y * b.x - a.x * b.y}; }
template <bool INV, class BP> FFT_HD void stage_r16(BP buf, const cf2 (&tw)[15], int base, int stride) {
    cf2 x[16];
    const int pb = fpad(base), ps = stride + (stride >> 5);
#pragma unroll
    for (int i = 0; i < 16; ++i) x[i] = buf[pb + i * ps];
    if (!INV) { dft16<false>(x);
#pragma unroll
        for (int k = 1; k < 16; ++k) x[k] = cmulc(x[k], tw[k - 1]); }
    else {
#pragma unroll
        for (int k = 1; k < 16; ++k) x[k] = cmul(x[k], tw[k - 1]);
        dft16<true>(x); }
#pragma unroll
    for (int i = 0; i < 16; ++i) buf[pb + i * ps] = x[i];
}
template <class TP> FFT_HD void load_tw(TP TW, int tidx, cf2 (&tw)[15]) {
#pragma unroll
    for (int k = 1; k < 16; ++k) tw[k - 1] = TW[(tidx * k) & (FFT_N - 1)];
}
template <bool INV, class BP> FFT_HD void stage_r16_chain(BP buf, cf2 w, int base, int stride) {
    cf2 tw[15]; tw[0] = w;
#pragma unroll
    for (int k = 1; k < 15; ++k) tw[k] = cmul(tw[k - 1], w);
    stage_r16<INV>(buf, tw, base, stride);
}
template <class BP> FFT_HD void stage1_fwd_regs(BP buf, cf2 (&x)[16], cf2 w, int m) {
    dft16<false>(x);
    cf2 wk = w; const int pb = fpad(m);
    buf[pb] = x[0];
#pragma unroll
    for (int k = 1; k < 16; ++k) { buf[pb + 528 * k] = cmulc(x[k], wk); if (k < 15) wk = cmul(wk, w); }
}
template <class BP> FFT_HD void stage1_inv_regs(BP buf, cf2 (&x)[16], cf2 w, int m) {
    cf2 wk = w; const int pb = fpad(m);
    x[0] = buf[pb];
#pragma unroll
    for (int k = 1; k < 16; ++k) { x[k] = cmul(buf[pb + 528 * k], wk); if (k < 15) wk = cmul(wk, w); }
    dft16<true>(x);
}
template <bool INV, class BP> FFT_HD void stage_r32_load(BP buf, int blk, int r, cf2 (&u)[16]) {
    constexpr float CS[16] = {1.f, 0.98078528040323043f, 0.92387953251128674f, 0.83146961230254524f, 0.70710678118654752f, 0.55557023301960218f, 0.38268343236508977f, 0.19509032201612825f,
                              0.f, -0.19509032201612825f, -0.38268343236508977f, -0.55557023301960218f, -0.70710678118654752f, -0.83146961230254524f, -0.92387953251128674f, -0.98078528040323043f};
    constexpr float SN[16] = {0.f, 0.19509032201612825f, 0.38268343236508977f, 0.55557023301960218f, 0.70710678118654752f, 0.83146961230254524f, 0.92387953251128674f, 0.98078528040323043f,
                              1.f, 0.98078528040323043f, 0.92387953251128674f, 0.83146961230254524f, 0.70710678118654752f, 0.55557023301960218f, 0.38268343236508977f, 0.19509032201612825f};
    const int base = blk * 33;
#pragma unroll
    for (int n = 0; n < 16; ++n) { const cf2 lo = buf[base + n], hi = buf[base + n + 16];
        const cf2 s = lo + hi, d = lo - hi; const cf2 w = {CS[n], INV ? SN[n] : -SN[n]}; const cf2 dw = cmul(d, w);
        u[n] = r ? dw : s; }
    dft16<INV>(u);
}
template <class BP> FFT_HD void stage_r32_store(BP buf, int blk, int r, const cf2 (&u)[16]) {
    const int base = blk * 33;
#pragma unroll
    for (int g = 0; g < 16; ++g) buf[base + 2 * g + r] = u[g];
}
template <class BP> FFT_HD void stage_r32_store_mul(BP buf, BP W, int blk, int r, const cf2 (&u)[16], int o, float scale) {
    const int base = blk * 33; const int f1 = blk >> 4, f2 = blk & 15;
#pragma unroll
    for (int g = 0; g < 16; ++g) { const int f3 = 2 * g + r; const int f = f1 + 16 * f2 + 256 * f3; const int fm = (FFT_N - f) & (FFT_N - 1);
        const int pm = (fm & 15) * 512 + ((fm >> 4) & 15) * 32 + (fm >> 8);
        const cf2 a = W[base + f3], b = W[fpad(pm)];
        const cf2 k = o == 0 ? (cf2){0.5f * (a.x + b.x), 0.5f * (a.y - b.y)} : (cf2){0.5f * (a.y + b.y), 0.5f * (b.x - a.x)};
        buf[base + f3] = cmul(u[g], k) * scale; }
}
template <class BP> FFT_HD void fft_mul(BP Z, BP W, int tid, int o, float scale) {
    const int f2 = tid >> 5, f3 = tid & 31; const int pp = fpad(tid);
#pragma unroll 4
    for (int j = 0; j < 16; ++j) { const int f = j + 16 * f2 + 256 * f3; const int fm = (FFT_N - f) & (FFT_N - 1);
        const int pm = (fm & 15) * 512 + ((fm >> 4) & 15) * 32 + (fm >> 8);
        const cf2 a = W[pp + 528 * j], b = W[fpad(pm)];
        const cf2 k = o == 0 ? (cf2){0.5f * (a.x + b.x), 0.5f * (a.y - b.y)} : (cf2){0.5f * (a.y + b.y), 0.5f * (b.x - a.x)};
        const cf2 z = Z[pp + 528 * j]; Z[pp + 528 * j] = cmul(z, k) * scale; }
}
#ifndef FFT_HOST_ONLY
__device__ __forceinline__ void ld_tw2(const LAS cf2* tw2l, int tid, cf2 (&tw)[15]) {
#pragma unroll
    for (int k = 0; k < 15; ++k) tw[k] = tw2l[(tid & 31) * 15 + k];
}
__device__ __forceinline__ void fft_fwd(LAS cf2* buf, cf2 w1, const LAS cf2* tw2l, int tid) {
    asm volatile("" : "+v"(tid));
    stage_r16_chain<false>(buf, w1, tid, 512); __syncthreads();
    { cf2 tw[15]; ld_tw2(tw2l, tid, tw); stage_r16<false>(buf, tw, (tid >> 5) * 512 + (tid & 31), 32); } __syncthreads();
    { cf2 u[16]; stage_r32_load<false>(buf, tid >> 1, tid & 1, u); stage_r32_store(buf, tid >> 1, tid & 1, u); } __syncthreads();
}
__device__ __forceinline__ void fft_inv(LAS cf2* buf, cf2 w1, const LAS cf2* tw2l, int tid) {
    asm volatile("" : "+v"(tid));
    { cf2 u[16]; stage_r32_load<true>(buf, tid >> 1, tid & 1, u); stage_r32_store(buf, tid >> 1, tid & 1, u); } __syncthreads();
    { cf2 tw[15]; ld_tw2(tw2l, tid, tw); stage_r16<true>(buf, tw, (tid >> 5) * 512 + (tid & 31), 32); } __syncthreads();
    stage_r16_chain<true>(buf, w1, tid, 512); __syncthreads();
}
struct P8 { v4u own, prv, nxt; };
__device__ __forceinline__ P8 p8_load(const bf16* p, int m) { P8 r; r.own = *(const v4u*)(p + 8 * m); r.prv = *(const v4u*)(p + 8 * (m == 0 ? 511 : m - 1)); r.nxt = *(const v4u*)(p + 8 * (m == 511 ? 0 : m + 1)); return r; }
__device__ __forceinline__ void unpk8(const v4u& v, float (&o)[8]) { const unsigned w[4] = {v.x, v.y, v.z, v.w};
#pragma unroll
    for (int j = 0; j < 4; ++j) { o[2 * j] = __builtin_bit_cast(float, w[j] << 16); o[2 * j + 1] = __builtin_bit_cast(float, w[j] & 0xffff0000u); } }
__device__ __forceinline__ void p8_conv(const P8& r, int m, float w0, float w1, float w2, float cb, float (&o)[8]) {
    float a[8], b[8], c[8]; unpk8(r.own, a); unpk8(r.prv, b); unpk8(r.nxt, c);
#pragma unroll
    for (int j = 0; j < 8; ++j) { const float pv = m == 0 ? (j ? b[j - 1] : 0.f) : b[j]; const float nx = m == 511 ? (j < 7 ? c[j + 1] : 0.f) : c[j];
        o[j] = w0 * pv + w1 * a[j] + w2 * nx + cb; }
}
__device__ __forceinline__ void fft_mid_a(LAS cf2* Zb, LAS cf2* Wb, const LAS cf2* tw2l, int tid, int o, float sc) {
    asm volatile("" : "+v"(tid));
    __syncthreads();
    { cf2 tw[15]; ld_tw2(tw2l, tid, tw); stage_r16<false>(Zb, tw, (tid >> 5) * 512 + (tid & 31), 32); } __syncthreads();
    { cf2 u[16]; stage_r32_load<false>(Zb, tid >> 1, tid & 1, u); stage_r32_store_mul(Zb, Wb, tid >> 1, tid & 1, u, o, sc); } __syncthreads();
    { cf2 u[16]; stage_r32_load<true>(Zb, tid >> 1, tid & 1, u); stage_r32_store(Zb, tid >> 1, tid & 1, u); } __syncthreads();
}
__device__ __forceinline__ void fft_mid_b(LAS cf2* Zb, const LAS cf2* tw2l, int tid) {
    asm volatile("" : "+v"(tid));
    { cf2 tw[15]; ld_tw2(tw2l, tid, tw); stage_r16<true>(Zb, tw, (tid >> 5) * 512 + (tid & 31), 32); } __syncthreads();
}
__device__ __forceinline__ void hy_fft_item(ArgsP a, const Fr& F, int slot, int d, cf2 wtw) {
    LAS cf2* Zb = (LAS cf2*)F.lds;
    LAS cf2* Wb = Zb + FFT_BUF;
    LAS float* red = (LAS float*)(Wb + FFT_BUF);
    const LAS cf2* tw2l = (const LAS cf2*)(red + 16);
    const bf16* PT = (const bf16*)(a->ws + SC_PT); bf16* Z2T = (bf16*)(a->ws + SC_Z2T);
    const float* HF = (const float*)(a->ws + WS_HF + (size_t)slot * HF_SLOT);
    const int tid = F.tid;
    __syncthreads();
    { const float* f0 = HF + (size_t)(0 * 1024 + d) * SEQ; const float* b0 = HF + (size_t)(1 * 1024 + d) * SEQ;
      const float* f1 = HF + (size_t)(2 * 1024 + d) * SEQ; const float* b1 = HF + (size_t)(3 * 1024 + d) * SEQ;
      float s0 = 0.f, s1 = 0.f; float fa[8], fb[8], ba[8], bb[8];
#pragma unroll
      for (int j = 0; j < 8; ++j) { const int t = tid + 512 * j; fa[j] = f0[t]; fb[j] = f1[t]; ba[j] = b0[t]; bb[j] = b1[t]; }
#pragma unroll
      for (int j = 0; j < 8; ++j) { const int t = tid + 512 * j; Wb[fpad(t)] = (cf2){fa[j], fb[j]}; s0 += fabsf(fa[j]); s1 += fabsf(fb[j]);
          if (t >= 1) { Wb[fpad(FFT_N - t)] = (cf2){ba[j], bb[j]}; s0 += fabsf(ba[j]); s1 += fabsf(bb[j]); } }
      if (tid == 0) Wb[fpad(SEQ)] = (cf2){0.f, 0.f};
      s0 = wave_sum(s0); s1 = wave_sum(s1); if (F.lane == 0) { red[F.wave] = s0; red[8 + F.wave] = s1; } }
    __syncthreads();
    float nrm0, nrm1; { float s0 = 0.f, s1 = 0.f; for (int w = 0; w < 8; ++w) { s0 += red[w]; s1 += red[8 + w]; } nrm0 = 1.0f / (s0 + 1e-6f); nrm1 = 1.0f / (s1 + 1e-6f); }
    fft_fwd(Wb, wtw, tw2l, tid);
    const float* cw = a->in[I_HYCW] + (size_t)slot * 3 * 3072; const float* cbp = a->in[I_HYCB] + (size_t)slot * 3072;
    float w0[3], w1[3], w2[3], cb[3];
#pragma unroll
    for (int g = 0; g < 3; ++g) { const int c = g * 1024 + d; w0[g] = cw[c]; w1[g] = cw[3072 + c]; w2[g] = cw[2 * 3072 + c]; cb[g] = cbp[c]; }
    const float fb0 = a->in[I_FBIAS][(slot * 2 + 0) * 1024 + d], fb1 = a->in[I_FBIAS][(slot * 2 + 1) * 1024 + d];
    const float sc0 = nrm0 * (1.0f / FFT_N), sc1 = nrm1 * (1.0f / FFT_N);
#pragma unroll 1
    for (int pr = 0; pr < 2; ++pr) {
        int m = tid; asm volatile("" : "+v"(m));
        const bf16* pb = PT + (size_t)d * TA + (2 * pr) * SEQ;
        const P8 rv0 = p8_load(pb, m), rv1 = p8_load(pb + SEQ, m);
        float va[8], vb2[8];
        p8_conv(rv0, m, w0[0], w1[0], w2[0], cb[0], va); p8_conv(rv1, m, w0[0], w1[0], w2[0], cb[0], vb2);
        cf2 vin[8], x[16];
#pragma unroll
        for (int j = 0; j < 8; ++j) { vin[j] = (cf2){va[j], vb2[j]}; x[j] = vin[j]; x[j + 8] = (cf2){0.f, 0.f}; }
        stage1_fwd_regs(Zb, x, wtw, m);
        fft_mid_a(Zb, Wb, tw2l, tid, 0, sc0);
        const P8 rx0 = p8_load(pb + (size_t)1024 * TA, m), rx1 = p8_load(pb + (size_t)1024 * TA + SEQ, m);
        fft_mid_b(Zb, tw2l, tid);
        stage1_inv_regs(Zb, x, wtw, m);
        p8_conv(rx0, m, w0[1], w1[1], w2[1], cb[1], va); p8_conv(rx1, m, w0[1], w1[1], w2[1], cb[1], vb2);
#pragma unroll
        for (int j = 0; j < 8; ++j) { const cf2 xg = {va[j], vb2[j]}; vin[j] = xg * (x[j] + vin[j] * fb0); x[j] = vin[j]; x[j + 8] = (cf2){0.f, 0.f}; }
        stage1_fwd_regs(Zb, x, wtw, m);
        fft_mid_a(Zb, Wb, tw2l, tid, 1, sc1);
        const P8 rz0 = p8_load(pb + (size_t)2048 * TA, m), rz1 = p8_load(pb + (size_t)2048 * TA + SEQ, m);
        fft_mid_b(Zb, tw2l, tid);
        stage1_inv_regs(Zb, x, wtw, m);
        p8_conv(rz0, m, w0[2], w1[2], w2[2], cb[2], va); p8_conv(rz1, m, w0[2], w1[2], w2[2], cb[2], vb2);
        float z0[8], z1[8];
#pragma unroll
        for (int j = 0; j < 8; ++j) { const cf2 xg = {va[j], vb2[j]}; const cf2 z = xg * (x[j] + vin[j] * fb1); z0[j] = z.x; z1[j] = z.y; }
        bf16* o0 = Z2T + (size_t)d * TA + (2 * pr) * SEQ + 8 * m;
        v4u q0, q1; q0.x = pk2(z0[0], z0[1]); q0.y = pk2(z0[2], z0[3]); q0.z = pk2(z0[4], z0[5]); q0.w = pk2(z0[6], z0[7]);
        q1.x = pk2(z1[0], z1[1]); q1.y = pk2(z1[2], z1[3]); q1.z = pk2(z1[4], z1[5]); q1.w = pk2(z1[6], z1[7]);
        *(v4u*)o0 = q0; *(v4u*)(o0 + SEQ) = q1;
    }
}
__device__ __forceinline__ void phase_hy_conv_fft(ArgsP a, const Fr& F, int layer) {
    const int slot = layer == 0 ? 0 : 1; const int nitems = layer == 0 ? 2048 : 1024;
    {   const cf2* TW = (const cf2*)(a->ws + WS_TW);
        LAS cf2* tw2l = (LAS cf2*)((LAS float*)((LAS cf2*)F.lds + 2 * FFT_BUF) + 16);
        __syncthreads();
        if (F.tid < 32 * 15) { const int n3 = F.tid / 15, k = F.tid % 15 + 1; tw2l[F.tid] = TW[(16 * n3 * k) & (FFT_N - 1)]; }
        const cf2 w1 = TW[F.tid];
        __syncthreads();
        for (int it = F.vcu; it < 1024; it += F.G) hy_fft_item(a, F, slot, it, w1);
    }
    for (int it = 1024 + F.vcu; it < nitems; it += F.G) hy_ctx_item(a, F, slot, it - 1024);
}
#endif
#include <hip/hip_bf16.h>
namespace attn_body {
using bf16=__hip_bfloat16;
using bf16x8=__attribute__((ext_vector_type(8)))short;
using s16x4=__attribute__((ext_vector_type(4)))short;
using f32x16=__attribute__((ext_vector_type(16)))float;
using u32x4=__attribute__((ext_vector_type(4)))unsigned;
constexpr int BATCH=4,NHEAD=16,SEQ=4096,D=64,DM=NHEAD*D,KP=256,LKEYS=4352;
constexpr int NW=8,QBLK=32,QB=QBLK*NW,KVBLK=64,NQB=SEQ/QB;
constexpr int ATTN_PITCH=DM, ATTN_UNIT_ROWS=QB;
__device__ __forceinline__ int crow(int r,int hi){return (r&3)+8*(r>>2)+4*hi;}
#define SBAR() __builtin_amdgcn_sched_barrier(0)
__device__ __forceinline__ void cmask(f32x16&p0,f32x16&p1,int jb,int qrel,int hi){
  const float NEG=-INFINITY; int kb=64*jb+4*hi;
  #pragma unroll
  for(int r=0;r<16;++r){int kv=kb+(r&3)+8*(r>>2); if(kv>qrel)p0[r]=NEG; if(kv+32>qrel)p1[r]=NEG;}
}

constexpr int NSLOT=3, SLOTB=8192;
constexpr int LDS_K=0, LDS_V=NSLOT*SLOTB, LDS_WS=2*NSLOT*SLOTB, LDS_OST=LDS_WS+NW*64*4, LDS_BYTES=LDS_OST+NW*4096;
constexpr float C2=0.125f*1.4426950408889634f;
__device__ __forceinline__ void glds16(const void*gsrc,unsigned lds_dst){unsigned keep;
  asm volatile("s_mov_b32 %0, m0\n\ts_mov_b32 m0, %2\n\ts_nop 0\n\tglobal_load_lds_dwordx4 %1, off\n\ts_mov_b32 m0, %0":"=&s"(keep):"v"(gsrc),"s"(lds_dst):"memory");}
__device__ __forceinline__ float max3f(float a,float b,float c){float r;asm("v_max3_f32 %0, %1, %2, %3":"=v"(r):"v"(a),"v"(b),"v"(c));return r;}
__device__ __forceinline__ float max2f(float a,float b){float r;asm("v_max_f32_e32 %0, %1, %2":"=v"(r):"v"(a),"v"(b));return r;}
__device__ __forceinline__ float fadd_s(float a,float b){float r;asm("v_add_f32_e32 %0, %1, %2":"=v"(r):"v"(a),"v"(b));return r;}
__device__ __forceinline__ float fsub_s(float a,float b){float r;asm("v_sub_f32_e32 %0, %1, %2":"=v"(r):"v"(a),"v"(b));return r;}
typedef float f32x2_t __attribute__((ext_vector_type(2))); typedef __bf16 bf16x2_t __attribute__((ext_vector_type(2)));
__device__ __forceinline__ unsigned cvtpk_s(float lo,float hi){f32x2_t v={lo,hi};bf16x2_t b=__builtin_convertvector(v,bf16x2_t);return __builtin_bit_cast(unsigned,b);}
#define WAIT_BAR(N) asm volatile("s_waitcnt vmcnt(" #N ") lgkmcnt(0)\n\ts_barrier":::"memory")

__device__ __forceinline__ void qkt(f32x16&p0,f32x16&p1,const char*Kslot,const bf16x8*qr,const f32x16&negm,int r32,int hi){
  const char*kb=Kslot+hi*1024+r32*16;
  #pragma unroll
  for(int d0=0;d0<4;++d0){
    const bf16x8 b0=*reinterpret_cast<const bf16x8*>(kb+d0*2048);
    const bf16x8 b1=*reinterpret_cast<const bf16x8*>(kb+d0*2048+512);
    if(d0==0){p0=__builtin_amdgcn_mfma_f32_32x32x16_bf16(b0,qr[0],negm,0,0,0);p1=__builtin_amdgcn_mfma_f32_32x32x16_bf16(b1,qr[0],negm,0,0,0);}
    else{p0=__builtin_amdgcn_mfma_f32_32x32x16_bf16(b0,qr[d0],p0,0,0,0);p1=__builtin_amdgcn_mfma_f32_32x32x16_bf16(b1,qr[d0],p1,0,0,0);}}
}
typedef __attribute__((address_space(3))) const char* lds_cptr;
typedef short v4i16_t __attribute__((ext_vector_type(4)));
__device__ __forceinline__ void kload8(bf16x8*kf,lds_cptr kp){
  kf[0]=*(const __attribute__((address_space(3))) bf16x8*)(kp);      kf[1]=*(const __attribute__((address_space(3))) bf16x8*)(kp+512);
  kf[2]=*(const __attribute__((address_space(3))) bf16x8*)(kp+2048); kf[3]=*(const __attribute__((address_space(3))) bf16x8*)(kp+2560);
  kf[4]=*(const __attribute__((address_space(3))) bf16x8*)(kp+4096); kf[5]=*(const __attribute__((address_space(3))) bf16x8*)(kp+4608);
  kf[6]=*(const __attribute__((address_space(3))) bf16x8*)(kp+6144); kf[7]=*(const __attribute__((address_space(3))) bf16x8*)(kp+6656);
}
__device__ __forceinline__ void kload2(bf16x8*kf,lds_cptr kp,int j){ kf[2*j]=*(const __attribute__((address_space(3))) bf16x8*)(kp+j*2048); kf[2*j+1]=*(const __attribute__((address_space(3))) bf16x8*)(kp+j*2048+512); }
__device__ __forceinline__ s16x4 vtr(lds_cptr p){ return __builtin_bit_cast(s16x4,__builtin_amdgcn_ds_read_tr16_b64_v4i16((__attribute__((address_space(3))) v4i16_t*)p)); }
__device__ __forceinline__ float rowmax(const f32x16&p0,const f32x16&p1){
  float a=max3f(p0[0],p0[1],p1[0]),b=max3f(p0[2],p0[3],p1[1]);a=max3f(a,p1[2],p1[3]);
  #pragma unroll
  for(int r=4;r<16;r+=4){a=max3f(a,p0[r],p0[r+1]);b=max3f(b,p0[r+2],p0[r+3]);a=max3f(a,p1[r],p1[r+1]);b=max3f(b,p1[r+2],p1[r+3]);}
  const float m=max2f(a,b);
  auto rr=__builtin_amdgcn_permlane32_swap(__float_as_uint(m),__float_as_uint(m),false,false);
  return max2f(__uint_as_float(rr[0]),__uint_as_float(rr[1]));
}
__device__ __forceinline__ void pv(f32x16*o,int vb,bf16x8 pa0,bf16x8 pa1,bf16x8 pa2,bf16x8 pa3){
  #pragma unroll
  for(int d0=0;d0<2;++d0){s16x4 lo[4],hi[4];
    #pragma unroll
    for(int ks=0;ks<4;++ks){
      asm volatile("ds_read_b64_tr_b16 %0,%1 offset:%c2":"=&v"(lo[ks]):"v"(vb),"i"(d0*4096+ks*1024):"memory");
      asm volatile("ds_read_b64_tr_b16 %0,%1 offset:%c2":"=&v"(hi[ks]):"v"(vb),"i"(d0*4096+ks*1024+512):"memory");}
    asm volatile("s_waitcnt lgkmcnt(0)":::"memory");SBAR();
    #define PK(k) (bf16x8){lo[k][0],lo[k][1],lo[k][2],lo[k][3],hi[k][0],hi[k][1],hi[k][2],hi[k][3]}
    o[d0]=__builtin_amdgcn_mfma_f32_32x32x16_bf16(pa0,PK(0),o[d0],0,0,0);
    o[d0]=__builtin_amdgcn_mfma_f32_32x32x16_bf16(pa1,PK(1),o[d0],0,0,0);
    o[d0]=__builtin_amdgcn_mfma_f32_32x32x16_bf16(pa2,PK(2),o[d0],0,0,0);
    o[d0]=__builtin_amdgcn_mfma_f32_32x32x16_bf16(pa3,PK(3),o[d0],0,0,0);
    #undef PK
  }
}

#ifndef ATTN_STORE16
#if MK_FP8_AOUT
#define ATTN_STORE16(p,v) do { const long off_ = (const bf16*)(p) - (const bf16*)O; const u32x4 v_ = (v); ::v2u o8_; \
    o8_.x = ::pk4_e4m3((::f32x4){__builtin_bit_cast(float, v_.x << 16), __builtin_bit_cast(float, v_.x & 0xffff0000u), __builtin_bit_cast(float, v_.y << 16), __builtin_bit_cast(float, v_.y & 0xffff0000u)} * O_SCALE); \
    o8_.y = ::pk4_e4m3((::f32x4){__builtin_bit_cast(float, v_.z << 16), __builtin_bit_cast(float, v_.z & 0xffff0000u), __builtin_bit_cast(float, v_.w << 16), __builtin_bit_cast(float, v_.w & 0xffff0000u)} * O_SCALE); \
    *(::v2u*)((unsigned char*)O + off_) = o8_; } while (0)
#else
#define ATTN_STORE16(p,v) (*(u32x4*)(p)=(v))
#endif
#endif
template<int THRL> __device__ __forceinline__ void attn_unit(int b,int h,int qb,const bf16*Q,const bf16*__restrict__ K,const bf16*__restrict__ V,bf16*O,char*shm){
  int tid_=threadIdx.x; asm volatile("":"+v"(tid_)); const int tid=tid_,lane=tid&63,r32=lane&31,hi=lane>>5; const int wid=__builtin_amdgcn_readfirstlane(tid>>6);
  const long rowbase=(long)b*SEQ; const int q0=qb*QB;
  const bf16*Qw=Q+(rowbase+q0+wid*QBLK)*DM+h*D;
  const bf16*Kh=K+(long)b*LKEYS*KP+(h>>2)*D,*Vh=V+(long)b*LKEYS*KP+(h>>2)*D;
  const unsigned lds0=(unsigned)(uintptr_t)shm;
  float*wsf=(float*)(shm+LDS_WS)+wid*64;
  const bf16*ksrc=Kh+(long)lane*KP+wid*8;
  const bf16*vsrc=Vh+(long)(16*(wid&3)+(lane>>2))*KP+(wid>>2)*32+(lane&3)*8;
  const unsigned kdst=lds0+LDS_K+wid*1024, vdst=lds0+LDS_V+wid*1024;
  #define DMA_K(t,slot) glds16(ksrc+(long)(t)*KVBLK*KP,(unsigned)__builtin_amdgcn_readfirstlane(kdst+(slot)))
  #define DMA_V(t,slot) glds16(vsrc+(long)(t)*KVBLK*KP,(unsigned)__builtin_amdgcn_readfirstlane(vdst+(slot)))
  const int vb0=(int)(lds0+LDS_V)+((lane>>4)&1)*32+(lane&3)*8+(4*hi+((lane&15)>>2))*64;
  const char*Kbase=shm+LDS_K; bf16x8 kf[8];
  const lds_cptr shm3=(lds_cptr)shm; const lds_cptr kp0=shm3+LDS_K+hi*1024+r32*16; const lds_cptr vp0=shm3+LDS_V+((lane>>4)&1)*32+(lane&3)*8+(4*hi+((lane&15)>>2))*64;
  const int NT=LKEYS/KVBLK;
  DMA_K(0,0);DMA_V(0,0);DMA_K(1,SLOTB);
  bf16x8 qr[4];
  #pragma unroll
  for(int d0=0;d0<4;++d0)qr[d0]=*reinterpret_cast<const bf16x8*>(&Qw[(long)r32*DM+d0*16+hi*8]);
  float mhat=0.f,l_reg=0.f;f32x16 o[2];o[0]=f32x16{};o[1]=f32x16{};f32x16 negm=f32x16{};asm volatile("":"+v"(negm));

  #define CMASK(P0,P1,t) do{}while(0)
  bool resc=false;
  #define START(P0,P1) do{ const float rm=rowmax(P0,P1); resc=false; \
    { const float dl=rm; mhat=fadd_s(mhat,dl); \
      _Pragma("unroll") for(int r=0;r<16;++r){P0[r]=fsub_s(P0[r],dl);P1[r]=fsub_s(P1[r],dl);} \
      _Pragma("unroll") for(int r=0;r<16;++r)negm[r]=-mhat; asm volatile("":"+v"(negm)); } \
    _Pragma("unroll") for(int r=0;r<16;++r)P0[r]=__builtin_amdgcn_exp2f(P0[r]); }while(0)
  #define RESC() do{ if(resc){ asm volatile("s_waitcnt lgkmcnt(0)":::"memory"); \
      _Pragma("unroll") for(int d_=0;d_<2;++d_) _Pragma("unroll") for(int r=0;r<16;++r)o[d_][r]*=wsf[crow(r,hi)]; } }while(0)
  f32x16 pA0,pA1,pB0,pB1;
  int sl_prev=0,sl_cur=0,sl_next=SLOTB;
  #define ROT() do{sl_prev=sl_cur;sl_cur=sl_next;sl_next=(sl_next==(NSLOT-1)*SLOTB)?0:sl_next+SLOTB;}while(0)
  DMA_K(2,2*SLOTB);
  WAIT_BAR(3);
  qkt(pA0,pA1,Kbase,qr,negm,r32,hi);asm volatile("s_nop 15\n\ts_nop 7":"+v"(pA0),"+v"(pA1));CMASK(pA0,pA1,0);
  START(pA0,pA1);
  _Pragma("unroll") for(int r=0;r<16;++r)pA1[r]=__builtin_amdgcn_exp2f(pA1[r]);
  WAIT_BAR(0);
  DMA_K(3,0);DMA_V(1,SLOTB);
  ROT();
  kload8(kf,kp0+sl_cur);
  WAIT_BAR(2);
  s16x4 vlo[8],vhi[8]; u32x4 pw0,pw1,pw2,pw3;
  #define PKW(P,B) cvtpk_s(P[B],P[B+1])
  #define PAF(k) __builtin_bit_cast(bf16x8,pw##k)
  #define VFR(i) (bf16x8){vlo[i][0],vlo[i][1],vlo[i][2],vlo[i][3],vhi[i][0],vhi[i][1],vhi[i][2],vhi[i][3]}
  #define PIN(x) asm volatile("":"+v"(x))
  #define MX3(a,b,c) __builtin_fmaxf(__builtin_fmaxf((a),(b)),(c))
  #define GAPA(MF,A0,A1,A2,A3,W0,W1,PW) do{ MF; sacc+=A0; sacc+=A1; sacc+=A2; sacc+=A3; PIN(sacc); W0; W1; PIN(PW); SBAR(); }while(0)
  #define EX(v) __builtin_amdgcn_exp2f(v)
  #define GAPB(MF,X,B) do{ MF; X[B]=EX(X[B]); X[B+1]=EX(X[B+1]); X[B+2]=EX(X[B+2]); X[B+3]=EX(X[B+3]); PIN(X); SBAR(); }while(0)
  #define VRD(i) do{ vlo[i]=vtr(vp_+(((i)>>2)*4096+((i)&3)*1024)); vhi[i]=vtr(vp_+(((i)>>2)*4096+((i)&3)*1024+512)); }while(0)
  #define KRD(G,j) do{ if(G){ kload2(kf,kp0+sl_next,j); SBAR(); } }while(0)
  #define STEP(C0,C1,P0,P1,t,GK,GV,GL) do{ SBAR(); \
    const lds_cptr vp_=vp0+sl_prev; \
    VRD(0); SBAR(); float sacc=(P0[0]+P0[1]); \
    GAPA(C0=__builtin_amdgcn_mfma_f32_32x32x16_bf16(kf[0],qr[0],negm,0,0,0), P0[2],P0[3],P0[4],P0[5],     pw0[0]=PKW(P0,0), pw0[1]=PKW(P0,2), pw0); \
    VRD(4); SBAR(); GAPA(C1=__builtin_amdgcn_mfma_f32_32x32x16_bf16(kf[1],qr[0],negm,0,0,0), P0[6],P0[7],P0[8],P0[9],     pw0[2]=PKW(P0,4), pw0[3]=PKW(P0,6), pw0); \
    VRD(1); SBAR(); GAPA(C0=__builtin_amdgcn_mfma_f32_32x32x16_bf16(kf[2],qr[1],C0,0,0,0),   P0[10],P0[11],P0[12],P0[13], pw1[0]=PKW(P0,8), pw1[1]=PKW(P0,10), pw1); \
    VRD(5); SBAR(); GAPA(C1=__builtin_amdgcn_mfma_f32_32x32x16_bf16(kf[3],qr[1],C1,0,0,0),   P0[14],P0[15],P1[0],P1[1],   pw1[2]=PKW(P0,12),pw1[3]=PKW(P0,14), pw1); \
    VRD(2); SBAR(); GAPA(C0=__builtin_amdgcn_mfma_f32_32x32x16_bf16(kf[4],qr[2],C0,0,0,0),   P1[2],P1[3],P1[4],P1[5],     pw2[0]=PKW(P1,0), pw2[1]=PKW(P1,2), pw2); \
    VRD(6); SBAR(); GAPA(C1=__builtin_amdgcn_mfma_f32_32x32x16_bf16(kf[5],qr[2],C1,0,0,0),   P1[6],P1[7],P1[8],P1[9],     pw2[2]=PKW(P1,4), pw2[3]=PKW(P1,6), pw2); \
    VRD(3); SBAR(); GAPA(C0=__builtin_amdgcn_mfma_f32_32x32x16_bf16(kf[6],qr[3],C0,0,0,0),   P1[10],P1[11],P1[12],P1[13], pw3[0]=PKW(P1,8), pw3[1]=PKW(P1,10), pw3); \
    VRD(7); SBAR(); GAPA(C1=__builtin_amdgcn_mfma_f32_32x32x16_bf16(kf[7],qr[3],C1,0,0,0),   P1[14],P1[15],0.f,0.f,       pw3[2]=PKW(P1,12),pw3[3]=PKW(P1,14), pw3); \
    l_reg+=sacc; \
    if(GK){DMA_K((t)+3,sl_cur);} if(GV){DMA_V((t)+1,sl_next);} \
    CMASK(C0,C1,t); \
    { float a=MX3(C0[0],C0[1],C1[0]),b=MX3(C0[2],C0[3],C1[1]); a=MX3(a,C1[2],C1[3]); \
      _Pragma("unroll") for(int r=4;r<16;r+=4){a=MX3(a,C0[r],C0[r+1]);b=MX3(b,C0[r+2],C0[r+3]);a=MX3(a,C1[r],C1[r+1]);b=MX3(b,C1[r+2],C1[r+3]);} \
      float rm=__builtin_fmaxf(a,b); { auto rr=__builtin_amdgcn_permlane32_swap(__float_as_uint(rm),__float_as_uint(rm),false,false); rm=__builtin_fmaxf(__uint_as_float(rr[0]),__uint_as_float(rr[1])); } \
      resc=false; \
      if(__builtin_expect(__any(rm>(float)THRL),0)){ const float dl=__builtin_fmaxf(rm,0.f); mhat+=dl; \
        _Pragma("unroll") for(int r=0;r<16;++r){C0[r]-=dl;C1[r]-=dl;} \
        _Pragma("unroll") for(int r=0;r<16;++r)negm[r]=-mhat; asm volatile("":"+v"(negm)); \
        const float f=__builtin_amdgcn_exp2f(-dl); l_reg*=f; if(hi==0)wsf[r32]=f; resc=true; } } \
    SBAR(); \
    GAPB(o[0]=__builtin_amdgcn_mfma_f32_32x32x16_bf16(PAF(0),VFR(0),o[0],0,0,0), C0,0); \
    GAPB(o[1]=__builtin_amdgcn_mfma_f32_32x32x16_bf16(PAF(0),VFR(4),o[1],0,0,0), C0,4); \
    KRD(GL,0); GAPB(o[0]=__builtin_amdgcn_mfma_f32_32x32x16_bf16(PAF(1),VFR(1),o[0],0,0,0), C0,8); \
    KRD(GL,1); GAPB(o[1]=__builtin_amdgcn_mfma_f32_32x32x16_bf16(PAF(1),VFR(5),o[1],0,0,0), C0,12); \
    KRD(GL,2); GAPB(o[0]=__builtin_amdgcn_mfma_f32_32x32x16_bf16(PAF(2),VFR(2),o[0],0,0,0), C1,0); \
    KRD(GL,3); GAPB(o[1]=__builtin_amdgcn_mfma_f32_32x32x16_bf16(PAF(2),VFR(6),o[1],0,0,0), C1,4); \
    GAPB(o[0]=__builtin_amdgcn_mfma_f32_32x32x16_bf16(PAF(3),VFR(3),o[0],0,0,0), C1,8); \
    GAPB(o[1]=__builtin_amdgcn_mfma_f32_32x32x16_bf16(PAF(3),VFR(7),o[1],0,0,0), C1,12); \
    }while(0)
  int t=1;
  #undef CMASK
  #define CMASK(P0,P1,t) do{}while(0)
  for(;t+5<NT;t+=2){
    STEP(pB0,pB1,pA0,pA1,t,true,true,true);     WAIT_BAR(2); RESC(); ROT();
    STEP(pA0,pA1,pB0,pB1,t+1,true,true,true);   WAIT_BAR(2); RESC(); ROT();
  }
  #undef CMASK
  #define CMASK(P0,P1,t) do{}while(0)
  #define ENDW(tt) do{ if((tt)+3<NT){WAIT_BAR(2);} else if((tt)+2<NT){WAIT_BAR(1);} else {WAIT_BAR(0);} }while(0)
  for(;t+1<NT;t+=2){
    STEP(pB0,pB1,pA0,pA1,t,(t+3<NT),(t+1<NT),(t+1<NT));       ENDW(t);   RESC(); ROT();
    STEP(pA0,pA1,pB0,pB1,t+1,(t+4<NT),(t+2<NT),(t+2<NT));     ENDW(t+1); RESC(); ROT();
  }
  STEP(pB0,pB1,pA0,pA1,NT-1,false,false,false); RESC();
  { float sacc=pB0[0]+pB0[1]; _Pragma("unroll") for(int r=2;r<16;++r)sacc+=pB0[r]; _Pragma("unroll") for(int r=0;r<16;++r)sacc+=pB1[r]; l_reg+=sacc;
    pw0=(u32x4){PKW(pB0,0),PKW(pB0,2),PKW(pB0,4),PKW(pB0,6)};pw1=(u32x4){PKW(pB0,8),PKW(pB0,10),PKW(pB0,12),PKW(pB0,14)};pw2=(u32x4){PKW(pB1,0),PKW(pB1,2),PKW(pB1,4),PKW(pB1,6)};pw3=(u32x4){PKW(pB1,8),PKW(pB1,10),PKW(pB1,12),PKW(pB1,14)};
    SBAR(); pv(o,vb0+sl_cur,PAF(0),PAF(1),PAF(2),PAF(3)); }
  #undef PKW
  #undef PAF
  #undef VFR
  #undef PIN
  #undef MX3
  #undef GAPA
  #undef GAPB
  #undef EX
  #undef VRD
  #undef KRD
  #undef STEP
  #undef ENDW
  {auto rr=__builtin_amdgcn_permlane32_swap(__float_as_uint(l_reg),__float_as_uint(l_reg),false,false);l_reg=__uint_as_float(rr[0])+__uint_as_float(rr[1]);}
  if(hi==0)wsf[32+r32]=l_reg;asm volatile("s_waitcnt lgkmcnt(0)":::"memory");
  float rli[16];
  #pragma unroll
  for(int r=0;r<16;++r)rli[r]=__builtin_amdgcn_rcpf(wsf[32+crow(r,hi)]);
  bf16*Ow=O+(rowbase+q0+wid*QBLK)*DM+h*D;
  { bf16*stg=(bf16*)(shm+LDS_OST)+wid*2048;
    #pragma unroll
    for(int r=0;r<16;++r){const int orow=crow(r,hi);
      #pragma unroll
      for(int d0=0;d0<2;++d0)stg[orow*64+d0*32+r32]=__float2bfloat16(o[d0][r]*rli[r]);}
    asm volatile("s_waitcnt lgkmcnt(0)":::"memory");
    #pragma unroll
    for(int i=0;i<4;++i){const int row=i*8+(lane>>3),ch=lane&7; const u32x4 v=*(const u32x4*)(stg+row*64+ch*8); ATTN_STORE16(Ow+(long)row*DM+ch*8,v);} }
  asm volatile("s_waitcnt lgkmcnt(0)\n\ts_barrier":::"memory");
  #undef DMA_K
  #undef DMA_V
  #undef CMASK
  #undef START
  #undef RESC
  #undef ROT
}
constexpr int ATTN_LDS_BYTES=LDS_BYTES;
struct AttnTensors { const bf16* Q; const bf16* K; const bf16* V; bf16* O; };
struct AttnUnit { int bh; int qb; };
struct StaticOrder {
  int vcu, per;
  __device__ __forceinline__ explicit StaticOrder(int grid,int vcu_):vcu(vcu_),per((BATCH*NHEAD*(SEQ/QB)+grid-1)/grid){}
  __device__ __forceinline__ bool next(int i,AttnUnit&u)const{ if(i>=per)return false; const int idx=vcu*per+i; if(idx>=BATCH*NHEAD*(SEQ/QB))return false; u.bh=idx/(SEQ/QB); u.qb=idx%(SEQ/QB); return true; }
  __device__ __forceinline__ void a_ready(const AttnUnit&)const{}
  __device__ __forceinline__ void done(const AttnUnit&)const{}
};
template<class Sched,int THRL=8> __device__ __forceinline__ void attn_phase(char*lds,const AttnTensors&T,const Sched&S){
  AttnUnit u;
  for(int i=0;S.next(i,u);++i){ S.a_ready(u); attn_unit<THRL>(u.bh/NHEAD,u.bh%NHEAD,u.qb,T.Q,T.K,T.V,T.O,lds); S.done(u); }
}
#undef SBAR
#undef WAIT_BAR
}

__device__ __forceinline__ void phase_attn_fast(ArgsP a, const Fr& F) {
    const attn_body::AttnTensors AT{(const attn_body::bf16*)(a->ws + SC_Q), (const attn_body::bf16*)(a->ws + SC_K), (const attn_body::bf16*)(a->ws + SC_V), (attn_body::bf16*)(a->ws + SC_O)};
    const attn_body::StaticOrder S(F.G, F.vcu);
    __syncthreads();
    attn_body::attn_phase<attn_body::StaticOrder>((char*)F.lds, AT, S);
    __syncthreads();
}
__device__ __forceinline__ void phase_sp_fast(ArgsP a, const Fr& F) {
    typedef short bf16x8 __attribute__((ext_vector_type(8)));
    constexpr int PITCH = 136;
    LAS unsigned short* As = (LAS unsigned short*)F.lds;
    LAS unsigned short* Bs = As + 128 * PITCH;
    LAS float* st = (LAS float*)(Bs + 128 * PITCH);
    const bf16* VT = (const bf16*)(a->ws + SC_VT); const f32x2* VST = (const f32x2*)(a->ws + SC_VST); const bf16* UB = (const bf16*)(a->ws + SC_UB); bf16* UV = (bf16*)(a->ws + SC_UV);
    const bf16* WS = (const bf16*)(a->ws + WS_WCMS);
    const float* lng = a->in[I_CMLNG]; const float* lnb = a->in[I_CMLNB]; const float* bs = a->in[I_CMBS];
    const int tid = F.tid, lane = F.lane, wid = F.wave, wr = wid >> 2, wc = wid & 3, fr = lane & 15, fq = lane >> 4;
    const int per = (2048 + F.G - 1) / F.G; int gl = -1;
    const int s4 = (lane & 31) * 4, ch = lane >> 5;
    const int it_lo = F.vcu * per, it_hi = ((F.vcu + 1) * per < 2048) ? (F.vcu + 1) * per : 2048;
#define SP_BAR() asm volatile("s_waitcnt lgkmcnt(0)\n\ts_barrier" ::: "memory")
#define SP_PREFETCH(it_) do { const int g_ = (it_) >> 7, n_ = (it_) & 127; \
        _Pragma("unroll") for (int q = 0; q < 8; ++q) vt_n[q] = *(const v2u*)(VT + (size_t)(g_ * 128 + q * 16 + wid * 2 + ch) * T + n_ * 128 + s4); \
        if (tid < 128) { _Pragma("unroll") for (int p = 0; p < 16; ++p) vst_n[p] = VST[(size_t)p * T + n_ * 128 + tid]; } } while (0)
    v2u vt_n[8]; f32x2 vst_n[16];
#pragma unroll
    for (int p = 0; p < 16; ++p) vst_n[p] = (f32x2){0.f, 0.f};
    if (it_lo < it_hi) SP_PREFETCH(it_lo);
    for (int it = it_lo; it < it_hi; ++it) {
        const int g = it >> 7, n = it & 127;
        v2u vt[8];
#pragma unroll
        for (int q = 0; q < 8; ++q) vt[q] = vt_n[q];
        float s1 = 0.f, s2 = 0.f;
#pragma unroll
        for (int p = 0; p < 16; ++p) { s1 += vst_n[p].x; s2 += vst_n[p].y; }
        v2u ub[4][2];
#pragma unroll
        for (int m = 0; m < 4; ++m)
#pragma unroll
            for (int nn = 0; nn < 2; ++nn) ub[m][nn] = *(const v2u*)(UB + (size_t)(n * 128 + wr * 64 + m * 16 + fr) * 2048 + g * 128 + wc * 32 + nn * 16 + 4 * fq);
        SP_BAR();
        if (g != gl) { gl = g;
#pragma unroll
            for (int q = 0; q < 4; ++q) { const int idx = tid + q * NTHR, t = idx >> 4, ck = idx & 15;
                *(LAS v4u*)(As + t * PITCH + ck * 8) = *(const v4u*)(WS + (size_t)g * 16384 + t * 128 + ck * 8); } }
        if (tid < 128) { const float mean = s1 * (1.0f / 2048.0f); const float var = s2 * (1.0f / 2048.0f) - mean * mean; st[tid * 2] = mean; st[tid * 2 + 1] = 1.0f / sqrtf(var + LN_EPS); }
        if (it + 1 < it_hi) SP_PREFETCH(it + 1);
        SP_BAR();
        { const f32x4 mu = {st[(s4 + 0) * 2], st[(s4 + 1) * 2], st[(s4 + 2) * 2], st[(s4 + 3) * 2]};
          const f32x4 rs = {st[(s4 + 0) * 2 + 1], st[(s4 + 1) * 2 + 1], st[(s4 + 2) * 2 + 1], st[(s4 + 3) * 2 + 1]};
#pragma unroll
          for (int q = 0; q < 8; ++q) { const int c = q * 16 + wid * 2 + ch; const int chn = g * 128 + c;
              const f32x4 v = up4(vt[q]);
              const float lg = lng[chn], lb = lnb[chn];
              const f32x4 y = (v - mu) * rs * lg + lb;
              v2u o; o.x = pk2(y[0], y[1]); o.y = pk2(y[2], y[3]); *(LAS v2u*)(Bs + c * PITCH + s4) = o; } }
        SP_BAR();
        f32x4 acc[4][2];
#pragma unroll
        for (int m = 0; m < 4; ++m)
#pragma unroll
            for (int nn = 0; nn < 2; ++nn) acc[m][nn] = (f32x4){0.f, 0.f, 0.f, 0.f};
#pragma unroll
        for (int k = 0; k < 4; ++k) {
            bf16x8 af[4], bfr[2];
#pragma unroll
            for (int m = 0; m < 4; ++m) af[m] = *(const LAS bf16x8*)(As + (wr * 64 + m * 16 + fr) * PITCH + k * 32 + fq * 8);
#pragma unroll
            for (int nn = 0; nn < 2; ++nn) bfr[nn] = *(const LAS bf16x8*)(Bs + (wc * 32 + nn * 16 + fr) * PITCH + k * 32 + fq * 8);
#pragma unroll
            for (int m = 0; m < 4; ++m)
#pragma unroll
                for (int nn = 0; nn < 2; ++nn) acc[m][nn] = __builtin_amdgcn_mfma_f32_16x16x32_bf16(bfr[nn], af[m], acc[m][nn], 0, 0, 0);
        }
#pragma unroll
        for (int m = 0; m < 4; ++m) { const int t = wr * 64 + m * 16 + fr; const float bt = bs[g * 128 + t];
#pragma unroll
            for (int nn = 0; nn < 2; ++nn) { const size_t idx = (size_t)(n * 128 + t) * 2048 + g * 128 + wc * 32 + nn * 16 + 4 * fq;
                const v2u ubv = ub[m][nn]; const f32x4 o = acc[m][nn] + bt;
#if MK_FP8_CMOUT
                const f32x4 uvv = {__builtin_bit_cast(float, ubv.x << 16) * o[0], __builtin_bit_cast(float, ubv.x & 0xffff0000u) * o[1], __builtin_bit_cast(float, ubv.y << 16) * o[2], __builtin_bit_cast(float, ubv.y & 0xffff0000u) * o[3]};
                *(unsigned*)((unsigned char*)UV + idx) = pk4_e4m3(uvv * O_SCALE); } }
#else
                v2u w; w.x = pk2(__builtin_bit_cast(float, ubv.x << 16) * o[0], __builtin_bit_cast(float, ubv.x & 0xffff0000u) * o[1]);
                w.y = pk2(__builtin_bit_cast(float, ubv.y << 16) * o[2], __builtin_bit_cast(float, ubv.y & 0xffff0000u) * o[3]);
                *(v2u*)(UV + idx) = w; } }
#endif
    }
#undef SP_BAR
#undef SP_PREFETCH
}
__device__ __forceinline__ void phase_rope(ArgsP a, const Fr& F) {
    LAS f32x2* tab = (LAS f32x2*)F.lds;
    __syncthreads();
    for (int u = F.tid; u < 1024; u += NTHR) { const int pos = u >> 4, f = u & 15; const float invf = powf(10000.0f, -(float)f / 16.0f); float sn, cs; sincosf((float)pos * invf, &sn, &cs); tab[u] = (f32x2){cs, sn}; }
    __syncthreads();
    const bf16* QKV = (const bf16*)(a->ws + SC_QKV); bf16* Q = (bf16*)(a->ws + SC_Q); bf16* K = (bf16*)(a->ws + SC_K); bf16* V = (bf16*)(a->ws + SC_V);
    const int gw = F.vcu * NWAVES + F.wave, NGW = F.G * NWAVES;
    const int l8 = F.lane & 7, hl = F.lane >> 3;
    const f32x4 qg0 = *(const f32x4*)(a->in[I_QGAIN] + 4 * l8), qg1 = *(const f32x4*)(a->in[I_QGAIN] + 32 + 4 * l8);
    const f32x4 kg0 = *(const f32x4*)(a->in[I_KGAIN] + 4 * l8), kg1 = *(const f32x4*)(a->in[I_KGAIN] + 32 + 4 * l8);
    for (int row0 = gw; row0 < TA; row0 += 4 * NGW) {
        v2u xa[4][3], xb[4][3];
#pragma unroll
        for (int rr = 0; rr < 4; ++rr) { const int row = row0 + rr * NGW < TA ? row0 + rr * NGW : row0; const bf16* src = QKV + (size_t)row * 1536 + hl * 64 + 4 * l8;
#pragma unroll
            for (int p = 0; p < 3; ++p) { xa[rr][p] = *(const v2u*)(src + p * 512); xb[rr][p] = *(const v2u*)(src + p * 512 + 32); } }
#pragma unroll
        for (int rr = 0; rr < 4; ++rr) { const int row = row0 + rr * NGW; if (row >= TA) break;
            const bool lat = row < T; const int b = lat ? (row >> 12) : ((row - T) >> 8); const int t = lat ? (row & 4095) : ((row - T) & 255);
            f32x4 cs = {1.f, 1.f, 1.f, 1.f}, sn = {0.f, 0.f, 0.f, 0.f};
            if (lat) { const int pos = (l8 < 4) ? (t >> 6) : (t & 63); const LAS f32x4* tp = (const LAS f32x4*)(tab + pos * 16 + 4 * (l8 & 3));
                const f32x4 c01 = tp[0], c23 = tp[1]; cs = (f32x4){c01[0], c01[2], c23[0], c23[2]}; sn = (f32x4){c01[1], c01[3], c23[1], c23[3]}; }
            const size_t krow = (size_t)b * LK + (lat ? LC + t : t);
#pragma unroll
            for (int p = 0; p < 3; ++p) {
                if (p < 2 && !lat) continue;
                if (p == 2 && hl >= 4) { bf16* d = V + krow * KVP + (hl - 4) * 64 + 4 * l8; *(v2u*)d = xa[rr][p]; *(v2u*)(d + 32) = xb[rr][p]; }
                else {
                    const f32x4 x1 = up4(xa[rr][p]), x2 = up4(xb[rr][p]);
                    float ss = ((x1[0] * x1[0] + x1[1] * x1[1]) + (x1[2] * x1[2] + x1[3] * x1[3])) + ((x2[0] * x2[0] + x2[1] * x2[1]) + (x2[2] * x2[2] + x2[3] * x2[3]));
                    ss += __shfl_xor(ss, 1); ss += __shfl_xor(ss, 2); ss += __shfl_xor(ss, 4);
                    const float rs = 1.0f / sqrtf(ss * (1.0f / 64.0f) + RMS_EPS);
                    const bool isq = p < 2;
                    const f32x4 n1 = x1 * rs * (isq ? qg0 : kg0), n2 = x2 * rs * (isq ? qg1 : kg1);
                    f32x4 o1 = n1 * cs - n2 * sn, o2 = n1 * sn + n2 * cs;
                    bf16* d;
                    if (isq) { o1 *= ATT_C2; o2 *= ATT_C2; d = Q + (size_t)row * 1024 + (p * 8 + hl) * 64 + 4 * l8; }
                    else d = K + krow * KVP + hl * 64 + 4 * l8;
                    v2u w1, w2; w1.x = pk2(o1[0], o1[1]); w1.y = pk2(o1[2], o1[3]); w2.x = pk2(o2[0], o2[1]); w2.y = pk2(o2[2], o2[3]);
                    *(v2u*)d = w1; *(v2u*)(d + 32) = w2; }
            }
        }
    }
}
__device__ __forceinline__ void phase_attn_simple(ArgsP a, const Fr& F) {
    const bf16* Q = (const bf16*)(a->ws + SC_Q); const bf16* K = (const bf16*)(a->ws + SC_K); const bf16* V = (const bf16*)(a->ws + SC_V); bf16* O = (bf16*)(a->ws + SC_O);
    for (int it = F.vcu; it < 512; it += F.G) {
        const int b = it >> 7, h = (it >> 3) & 15, q = (it & 7) * 512 + F.tid;
        const bf16* qp = Q + (size_t)(b * SEQ + q) * 1024 + h * 64;
        float qv[64], o[64];
#pragma unroll
        for (int d = 0; d < 64; ++d) { qv[d] = bf2f(qp[d]); o[d] = 0.f; }
        float m = -3.0e38f, l = 0.f;
        const bf16* kb = K + (size_t)b * LK * KVP + (h >> 2) * 64; const bf16* vb = V + (size_t)b * LK * KVP + (h >> 2) * 64;
        for (int s = 0; s < LK; ++s) {
            const v4u* kr = (const v4u*)(kb + (size_t)s * KVP); float sc = 0.f;
#pragma unroll
            for (int c = 0; c < 8; ++c) { const v4u kv = kr[c]; const unsigned w[4] = {kv.x, kv.y, kv.z, kv.w};
#pragma unroll
                for (int j = 0; j < 4; ++j) { sc += qv[c * 8 + 2 * j] * __builtin_bit_cast(float, w[j] << 16) + qv[c * 8 + 2 * j + 1] * __builtin_bit_cast(float, w[j] & 0xffff0000u); } }
            const float mn = fmaxf(m, sc); const float al = exp2f(m - mn), p = exp2f(sc - mn); l = l * al + p; m = mn;
            const v4u* vr = (const v4u*)(vb + (size_t)s * KVP);
#pragma unroll
            for (int c = 0; c < 8; ++c) { const v4u vv = vr[c]; const unsigned w[4] = {vv.x, vv.y, vv.z, vv.w};
#pragma unroll
                for (int j = 0; j < 4; ++j) { o[c * 8 + 2 * j] = o[c * 8 + 2 * j] * al + p * __builtin_bit_cast(float, w[j] << 16); o[c * 8 + 2 * j + 1] = o[c * 8 + 2 * j + 1] * al + p * __builtin_bit_cast(float, w[j] & 0xffff0000u); } }
        }
        const float il = 1.0f / l; bf16* op = O + (size_t)(b * SEQ + q) * 1024 + h * 64;
#pragma unroll
        for (int c = 0; c < 8; ++c) { v4u w; w.x = pk2(o[c * 8] * il, o[c * 8 + 1] * il); w.y = pk2(o[c * 8 + 2] * il, o[c * 8 + 3] * il); w.z = pk2(o[c * 8 + 4] * il, o[c * 8 + 5] * il); w.w = pk2(o[c * 8 + 6] * il, o[c * 8 + 7] * il);
            *(v4u*)(op + c * 8) = w; }
    }
}
__device__ __forceinline__ void phase_sp_simple(ArgsP a, const Fr& F) {
    LAS float* wsL = (LAS float*)F.lds;
    LAS float* vl = wsL + 128 * 128;
    LAS float* st = vl + 128 * 128;
    const float* VT = (const float*)(a->ws + SC_VT); const f32x2* VST = (const f32x2*)(a->ws + SC_VST); const bf16* UB = (const bf16*)(a->ws + SC_UB); bf16* UV = (bf16*)(a->ws + SC_UV);
    const int per = (2048 + F.G - 1) / F.G; int gl = -1;
    for (int it = F.vcu * per; it < (F.vcu + 1) * per && it < 2048; ++it) {
        const int g = it >> 7, n = it & 127;
        __syncthreads();
        if (g != gl) { for (int u = F.tid; u < 128 * 128; u += NTHR) wsL[u] = a->in[I_CMWS][(size_t)g * 16384 + u]; gl = g; }
        if (F.tid < 128) { float s1 = 0.f, s2 = 0.f; for (int p = 0; p < 16; ++p) { const f32x2 v = VST[(size_t)p * T + n * 128 + F.tid]; s1 += v.x; s2 += v.y; }
            const float mean = s1 * (1.0f / 2048.0f); const float var = s2 * (1.0f / 2048.0f) - mean * mean; st[F.tid * 2] = mean; st[F.tid * 2 + 1] = 1.0f / sqrtf(var + LN_EPS); }
        __syncthreads();
        for (int u = F.tid; u < 128 * 128; u += NTHR) { const int c = u >> 7, s = u & 127; const int ch = g * 128 + c;
            const float v = VT[(size_t)ch * T + n * 128 + s]; vl[s * 128 + c] = (v - st[s * 2]) * st[s * 2 + 1] * a->in[I_CMLNG][ch] + a->in[I_CMLNB][ch]; }
        __syncthreads();
        const int c = F.tid & 127, tq = F.tid >> 7;
        for (int jj = 0; jj < 32; ++jj) { const int t = tq + 4 * jj; float acc = 0.f;
            for (int s = 0; s < 128; ++s) acc += wsL[t * 128 + s] * vl[s * 128 + c];
            acc += a->in[I_CMBS][g * 128 + t];
            const size_t idx = (size_t)(n * 128 + t) * 2048 + g * 128 + c;
            UV[idx] = (bf16)f2bf(bf2f(UB[idx]) * acc); }
    }
}
#ifndef MK_FAST_CONV
#define MK_FAST_CONV 0
#endif
#ifndef MK_FAST_ATTN
#define MK_FAST_ATTN 0
#endif
#ifndef MK_FAST_SP
#define MK_FAST_SP 0
#endif
#ifndef MK_GATHER
#define MK_GATHER 0
#endif
constexpr int MOE_PH = MK_GATHER ? 5 : 6;
constexpr int N_PHASES = (MK_MERGE_PRO ? 1 : 2) + (4 + MOE_PH) + (4 + MOE_PH) + (3 + MOE_PH) + (4 + MOE_PH);

#ifndef MK_STAG_GU
#define MK_STAG_GU 0
#endif
#define STAGGER(ticks) do { if ((ticks) > 0 && (F.vcu & 1)) { const unsigned long long t0_ = __builtin_amdgcn_s_memrealtime(); while (__builtin_amdgcn_s_memrealtime() - t0_ < (unsigned long long)(ticks)) __builtin_amdgcn_s_sleep(8); } } while (0)
#ifndef MK_REPMASK
#define MK_REPMASK 0ull
#endif
#ifndef MK_CODEPROBE_N
#define MK_CODEPROBE_N 0
#endif
#if MK_CODEPROBE_N > 0
#define MK_CODEPROBE { _Pragma("unroll 1") for (int cp_ = 0; cp_ < MK_CODEPROBE_N; ++cp_) asm volatile(".rept 2048\n\ts_nop 0\n\t.endr" ::: "memory"); }
#else
#define MK_CODEPROBE
#endif
#ifndef MK_LNR2
#define MK_LNR2 0
#endif
#ifndef MK_XBAR
#define MK_XBAR 0
#endif
#ifndef MK_REPN
#define MK_REPN 3
#endif
#ifndef MK_REPBAR
#define MK_REPBAR 0
#endif
__device__ __forceinline__ bool probe_bar(unsigned char* lds_raw) { ArgsP a__ = get_args(); XcdBarrier bb; bb.bar = (unsigned*)(a__->ws + WS_CTL) + 4096; bb.x = xb_xcc_id();
    bb.st = (volatile LAS unsigned*)((LAS unsigned char*)lds_raw + MISC_OFF) + 8; xcd_barrier(bb); return false; }
#define REPS for (int rep_ = 0; rep_ < (((MK_REPMASK >> p) & 1ull) ? MK_REPN : 1); ++rep_) if (MK_REPBAR && rep_ > 0 && probe_bar(lds_raw)) {} else
#define IN() (get_args()->ph_lo <= p && p < get_args()->ph_hi)
#define PHB ArgsP a = get_args(); unsigned char* ws = a->ws; (void)ws; const Fr F = mkfr(lds_raw);
#define SEAM() do { { ArgsP a__ = get_args(); if (a__->ph_lo <= p && p + 1 < a__->ph_hi) { XcdBarrier bb; bb.bar = (unsigned*)(a__->ws + WS_CTL) + 4096; bb.x = xb_xcc_id(); \
        bb.st = (volatile LAS unsigned*)((LAS unsigned char*)lds_raw + MISC_OFF) + 8; xcd_barrier(bb); for (int xb_ = 0; xb_ < MK_XBAR; ++xb_) xcd_barrier(bb); MK_CODEPROBE } } ++p; } while (0)
template <int layer> __device__ __forceinline__ void layer_body(int& p, unsigned char* lds_raw) {
    PG8_LAS unsigned char* ring = (PG8_LAS unsigned char*)lds_raw;
        constexpr int kind = layer % 3;
        const int nrows = layer == 0 ? TA : T;
#define G1PTR ((const float*)(ws + WS_MOD) + (size_t)layer * 5 * 6144 + 2048)
        if constexpr (kind == 0) {
            const int slot = layer == 0 ? 0 : 1;
#if MK_FP8_HYIN
            REPS if (IN()) { PHB pg8::Gemm g{(const pg8::bf16_t*)(ws + WS_WHYIN + (size_t)slot * 3072 * 1024), (const pg8::bf16_t*)(ws + WS_HB), 3072, nrows, 512, nullptr};
                pg8::StaticOrder S; S.init(3072, nrows, F.G, F.bx); pg8::EpiBf16<0> E{(pg8::bf16_t*)(ws + SC_PT), TA, nullptr, 1 << 30, 0, 1.0f / WH_SCALE};
                pg8::gemm_phase<pg8::EpiBf16<0>, pg8::StaticOrder, true, false, true>(ring, g, S, E);
#else
            REPS if (IN()) { PHB pg8::Gemm g{(const pg8::bf16_t*)(ws + WS_WHYIN) + (size_t)slot * 3072 * 1024, (const pg8::bf16_t*)(ws + WS_HB), 3072, nrows, 1024, nullptr};
                pg8::StaticOrder S; S.init(3072, nrows, F.G, F.bx); pg8::EpiBf16<0> E{(pg8::bf16_t*)(ws + SC_PT), TA, nullptr, 0, 0, 1.f};
                pg8::gemm_phase<pg8::EpiBf16<0>, pg8::StaticOrder, true, false>(ring, g, S, E);
#endif
                if constexpr (layer == 0) { __syncthreads(); bg_convert<0>(a, F, F.bx - (12 * 68) % 256); } }
            SEAM();
            REPS if (IN()) { PHB
#if MK_FAST_CONV
                phase_hy_conv_fft(a, F, layer);
#else
                phase_hy_conv_direct(a, F, layer);
#endif
            }
            SEAM();
            REPS if (IN()) { PHB phase_hy_tr(a, F, nrows); }
            SEAM();
#if MK_FP8_HYOUT
            REPS if (IN()) { PHB pg8::Gemm g{(const pg8::bf16_t*)(ws + SC_Z2), (const pg8::bf16_t*)(ws + WS_WHYOUT + (size_t)slot * 1024 * 1024), nrows, 1024, 512, nullptr};
                pg8::StaticOrder S; S.init(nrows, 1024, F.G, F.bx); pg8::EpiRes E{(const pg8::bf16_t*)(ws + WS_XC), (pg8::bf16_t*)(ws + WS_U), G1PTR, 6144, ALPHA, 1.0f / (WH_SCALE * Z_SCALE)};
                pg8::gemm_phase<pg8::EpiRes, pg8::StaticOrder, true, false, true>(ring, g, S, E);
#else
            REPS if (IN()) { PHB pg8::Gemm g{(const pg8::bf16_t*)(ws + SC_Z2), (const pg8::bf16_t*)(ws + WS_WHYOUT) + (size_t)slot * 1024 * 1024, nrows, 1024, 1024, nullptr};
                pg8::StaticOrder S; S.init(nrows, 1024, F.G, F.bx); pg8::EpiRes E{(const pg8::bf16_t*)(ws + WS_XC), (pg8::bf16_t*)(ws + WS_U), G1PTR, 6144, ALPHA};
                pg8::gemm_phase<pg8::EpiRes, pg8::StaticOrder, true, false>(ring, g, S, E);
#endif
                if constexpr (layer == 0) { __syncthreads(); bg_convert<1>(a, F, F.bx - (68 * 4) % 256); } }
            SEAM();
        } else if constexpr (kind == 1) {
#if MK_FP8_QKV
            REPS if (IN()) { PHB pg8::Gemm g{(const pg8::bf16_t*)(ws + WS_HB), (const pg8::bf16_t*)(ws + WS_WQKV), TA, 1536, 512, nullptr};
                pg8::StaticOrder S; S.init(TA, 1536, F.G, F.bx); pg8::EpiBf16<0> E{(pg8::bf16_t*)(ws + SC_QKV), 1536, nullptr, 0, 0, 1.f, 1.0f / WH_SCALE};
                pg8::gemm_phase<pg8::EpiBf16<0>, pg8::StaticOrder, true, false, true>(ring, g, S, E);
#else
            REPS if (IN()) { PHB pg8::Gemm g{(const pg8::bf16_t*)(ws + WS_HB), (const pg8::bf16_t*)(ws + WS_WQKV), TA, 1536, 1024, nullptr};
                pg8::StaticOrder S; S.init(TA, 1536, F.G, F.bx); pg8::EpiBf16<0> E{(pg8::bf16_t*)(ws + SC_QKV), 1536, nullptr, 0, 0, 1.f};
                pg8::gemm_phase<pg8::EpiBf16<0>, pg8::StaticOrder, true, false>(ring, g, S, E);
#endif
                __syncthreads(); bg_convert<4>(a, F, F.bx - (68 * 6) % 256); }
            SEAM();
            REPS if (IN()) { PHB phase_rope(a, F); }
            SEAM();
            REPS if (IN()) { PHB
#if MK_FAST_ATTN
                phase_attn_fast(a, F);
#else
                phase_attn_simple(a, F);
#endif
            }
            SEAM();
#if MK_FP8_AOUT
            REPS if (IN()) { PHB pg8::Gemm g{(const pg8::bf16_t*)(ws + SC_O), (const pg8::bf16_t*)(ws + WS_WATO), T, 1024, 512, nullptr};
                pg8::StaticOrder S; S.init(T, 1024, F.G, F.bx); pg8::EpiRes E{(const pg8::bf16_t*)(ws + WS_XC), (pg8::bf16_t*)(ws + WS_U), G1PTR, 6144, ALPHA, 1.0f / (WH_SCALE * O_SCALE)};
                pg8::gemm_phase<pg8::EpiRes, pg8::StaticOrder, true, false, true>(ring, g, S, E); }
#else
            REPS if (IN()) { PHB pg8::Gemm g{(const pg8::bf16_t*)(ws + SC_O), (const pg8::bf16_t*)(ws + WS_WATO), T, 1024, 1024, nullptr};
                pg8::StaticOrder S; S.init(T, 1024, F.G, F.bx); pg8::EpiRes E{(const pg8::bf16_t*)(ws + WS_XC), (pg8::bf16_t*)(ws + WS_U), G1PTR, 6144, ALPHA};
                pg8::gemm_phase<pg8::EpiRes, pg8::StaticOrder, true, false>(ring, g, S, E); }
#endif
            SEAM();
        } else {
            REPS if (IN()) {
#if MK_FP8_CMIN
                { PHB pg8::Gemm g{(const pg8::bf16_t*)(ws + WS_HB), (const pg8::bf16_t*)(ws + WS_WCMIN), T, 2048, 512, nullptr};
                  pg8::StaticOrder S; S.init(T, 2048, F.G, F.bx); pg8::EpiBf16<1> E{(pg8::bf16_t*)(ws + SC_UB), 2048, nullptr, 0, 0, 1.f, 1.0f / WH_SCALE};
                  pg8::gemm_phase<pg8::EpiBf16<1>, pg8::StaticOrder, true, false, true>(ring, g, S, E); }
                { PHB pg8::Gemm g{(const pg8::bf16_t*)(ws + WS_WCMIN + (size_t)2048 * 1024), (const pg8::bf16_t*)(ws + WS_HB), 2048, T, 512, nullptr};
                  pg8::StaticOrder S; S.init(2048, T, F.G, F.bx); pg8::EpiVT E{(pg8::bf16_t*)(ws + SC_VT), T, (pg8::f32x2*)(ws + SC_VST), T, 1.0f / WH_SCALE};
                  pg8::gemm_phase<pg8::EpiVT, pg8::StaticOrder, true, false, true>(ring, g, S, E); }
#else
                { PHB pg8::Gemm g{(const pg8::bf16_t*)(ws + WS_HB), (const pg8::bf16_t*)(ws + WS_WCMIN), T, 2048, 1024, nullptr};
                  pg8::StaticOrder S; S.init(T, 2048, F.G, F.bx); pg8::EpiBf16<1> E{(pg8::bf16_t*)(ws + SC_UB), 2048, nullptr, 0, 0, 1.f};
                  pg8::gemm_phase<pg8::EpiBf16<1>, pg8::StaticOrder, true, false>(ring, g, S, E); }
#if MK_FP8_CMV
                { PHB pg8::Gemm g{(const pg8::bf16_t*)(ws + WS_WCMIN + (size_t)2048 * 1024 * 2), (const pg8::bf16_t*)(ws + WS_HB8B), 2048, T, 512, nullptr};
                  pg8::StaticOrder S; S.init(2048, T, F.G, F.bx); pg8::EpiVT E{(pg8::bf16_t*)(ws + SC_VT), T, (pg8::f32x2*)(ws + SC_VST), T, 1.0f / WH_SCALE};
                  pg8::gemm_phase<pg8::EpiVT, pg8::StaticOrder, true, false, true>(ring, g, S, E); }
#else
                { PHB pg8::Gemm g{(const pg8::bf16_t*)(ws + WS_WCMIN) + (size_t)2048 * 1024, (const pg8::bf16_t*)(ws + WS_HB), 2048, T, 1024, nullptr};
                  pg8::StaticOrder S; S.init(2048, T, F.G, F.bx); pg8::EpiVT E{(pg8::bf16_t*)(ws + SC_VT), T, (pg8::f32x2*)(ws + SC_VST), T};
                  pg8::gemm_phase<pg8::EpiVT, pg8::StaticOrder, true, false>(ring, g, S, E); }
#endif
#endif
            }
            SEAM();
            REPS if (IN()) { PHB
#if MK_FAST_SP
                phase_sp_fast(a, F);
#else
                phase_sp_simple(a, F);
#endif
            }
            SEAM();
#if MK_FP8_CMOUT
            REPS if (IN()) { PHB pg8::Gemm g{(const pg8::bf16_t*)(ws + SC_UV), (const pg8::bf16_t*)(ws + WS_WCMOUT), T, 1024, 1024, nullptr};
                pg8::StaticOrder S; S.init(T, 1024, F.G, F.bx); pg8::EpiRes E{(const pg8::bf16_t*)(ws + WS_XC), (pg8::bf16_t*)(ws + WS_U), G1PTR, 6144, ALPHA, 1.0f / (WH_SCALE * O_SCALE)};
                pg8::gemm_phase<pg8::EpiRes, pg8::StaticOrder, true, false, true>(ring, g, S, E); }
#else
            REPS if (IN()) { PHB pg8::Gemm g{(const pg8::bf16_t*)(ws + SC_UV), (const pg8::bf16_t*)(ws + WS_WCMOUT), T, 1024, 2048, nullptr};
                pg8::StaticOrder S; S.init(T, 1024, F.G, F.bx); pg8::EpiRes E{(const pg8::bf16_t*)(ws + WS_XC), (pg8::bf16_t*)(ws + WS_U), G1PTR, 6144, ALPHA};
                pg8::gemm_phase<pg8::EpiRes, pg8::StaticOrder, true, false>(ring, g, S, E); }
#endif
            SEAM();
        }
#if MK_LNR2
        REPS if (IN()) { PHB phase_lnr2(a, F, layer, nrows); }
#else
        REPS if (IN()) { PHB phase_lnr(a, F, layer, nrows); }
#endif
        SEAM();
        REPS if (IN()) { PHB phase_topk(a, F, layer);
            if constexpr (layer == 0) { __syncthreads(); bg_convert<2>(a, F, F.vcu - 128); }
            if constexpr (layer == 1) { __syncthreads(); bg_convert<5>(a, F, F.vcu - 64); }
            if constexpr (layer == 2) { __syncthreads(); bg_convert<6>(a, F, F.vcu - 64); } }
        SEAM();
        const int npm = layer == 0 ? 9 : 8;
#if MK_GATHER
        REPS if (IN()) { PHB pg8::Gemm g{(const pg8::bf16_t*)(ws + WS_HB), (const pg8::bf16_t*)(ws + WS_WGU + (size_t)layer * 16 * 4096 * 1024), 0, 0, 512, (const int*)(ws + WS_ROWS)};
            pg8::MoeOrder S{npm, 16, F.G, F.vcu}; pg8::EpiGU8<MK_FP8_DN != 0> E{(unsigned char*)(ws + WS_ACT), 16, 1.0f / WGU_SCALE, MK_FP8_DN ? ACT_SCALE : 1.0f};
            STAGGER(MK_STAG_GU);
#if defined(MK_NULLEPI)
            if (rep_ > 0) { pg8::MK_NULLEPI EN; pg8::MoeOrder S2 = S; S2.fixed = 1; pg8::gemm_phase<pg8::MK_NULLEPI, pg8::MoeOrder, true, true, true>(ring, g, S2, EN); } else
#endif
            pg8::gemm_phase<pg8::EpiGU8<MK_FP8_DN != 0>, pg8::MoeOrder, true, true, true>(ring, g, S, E); }
        SEAM();
#else
        REPS if (IN()) { PHB phase_gather(a, F, layer); }
        SEAM();
#error "the materialised-gather build (MK_GATHER 0) predates the e4m3 expert GEMMs and is no longer supported"
        SEAM();
#endif
#if MK_FP8_DN
        REPS if (IN()) { PHB pg8::Gemm g{(const pg8::bf16_t*)(ws + WS_ACT), (const pg8::bf16_t*)(ws + WS_WDN + (size_t)layer * 16 * 1024 * 2048), 0, 0, 1024, nullptr};
            pg8::MoeOrder S{npm, 4, F.G, F.vcu}; pg8::EpiDN E{(pg8::bf16_t*)(ws + WS_Y), (const float*)(ws + WS_GATE), 4, (MK_FP8_Y ? Y_SCALE : 1.0f) / (WDN_SCALE * ACT_SCALE)};
            pg8::gemm_phase<pg8::EpiDN, pg8::MoeOrder, true, false, true>(ring, g, S, E);
            if constexpr (layer == 0) { __syncthreads(); bg_convert<3>(a, F, F.vcu - (16 * 9 * 4) % 256); } }
#else
        REPS if (IN()) { PHB pg8::Gemm g{(const pg8::bf16_t*)(ws + WS_ACT), (const pg8::bf16_t*)(ws + WS_WDN) + (size_t)layer * 16 * 1024 * 2048, 0, 0, 2048, nullptr};
            pg8::MoeOrder S{npm, 4, F.G, F.vcu}; pg8::EpiDN E{(pg8::bf16_t*)(ws + WS_Y), (const float*)(ws + WS_GATE), 4, 1.0f};
            pg8::gemm_phase<pg8::EpiDN, pg8::MoeOrder, true, false, false>(ring, g, S, E); }
#endif
        SEAM();
        REPS if (IN()) { PHB phase_comb(a, F, layer, nrows); }
        SEAM();
    }
__global__ void __launch_bounds__(NTHR, 2) mk_fwd(Args a_) {
    extern __shared__ __attribute__((aligned(16))) unsigned char lds_raw[];
    Fr F0 = mkfr(lds_raw);
    volatile LAS unsigned* MISC = (volatile LAS unsigned*)(F0.lds + MISC_OFF);
    if (F0.tid < 32) MISC[F0.tid] = 0u;
    __syncthreads();
    if (a_.ph_hi - a_.ph_lo > 1) (void)xcd_barrier_post((unsigned*)(a_.ws + WS_CTL) + 4096, MISC + 8);
    int p = 0;
    PG8_LAS unsigned char* ring = (PG8_LAS unsigned char*)lds_raw;

    REPS if (IN()) { PHB phase_proA(a, F); }
    SEAM();
#if !MK_MERGE_PRO
    REPS if (IN()) { PHB phase_proB(a, F); }
    SEAM();
#endif
    layer_body<0>(p, lds_raw); layer_body<1>(p, lds_raw); layer_body<2>(p, lds_raw); layer_body<3>(p, lds_raw);
#undef IN
#undef PHB
#undef G1PTR
#undef SEAM
}

#ifndef MK_N_LAUNCHES
#define MK_N_LAUNCHES 0
#endif
extern "C" void kernel_launch(void* const* d_in, const int* in_sizes, int n_in, void* d_out, int out_size, void* d_ws, size_t ws_size, hipStream_t stream) {
    static int grid = 0;
    if (grid == 0) {
        if (n_in != 33 || out_size != T * D || ws_size < WS_END) { fprintf(stderr, "kernel_launch: expected 33 inputs, %d outputs, >= %zu bytes of workspace; got %d, %d, %zu\n", T * D, (size_t)WS_END, n_in, out_size, ws_size); grid = -1; return; }
        int dev = 0, cus = 0, per_cu = 0;
        if (hipGetDevice(&dev) != hipSuccess || hipDeviceGetAttribute(&cus, hipDeviceAttributeMultiprocessorCount, dev) != hipSuccess) { grid = -1; return; }
        if (hipFuncSetAttribute((const void*)mk_fwd, hipFuncAttributeMaxDynamicSharedMemorySize, LDS_BYTES) != hipSuccess) { fprintf(stderr, "kernel_launch: hipFuncSetAttribute failed\n"); grid = -1; return; }
        if (hipOccupancyMaxActiveBlocksPerMultiprocessor(&per_cu, (const void*)mk_fwd, NTHR, LDS_BYTES) != hipSuccess || per_cu < 1)
            fprintf(stderr, "kernel_launch: note: occupancy query reports %d workgroups per CU\n", per_cu);
        (void)hipGetLastError();
        grid = cus;
    }
    if (grid < 0) return;
    (void)hipMemsetAsync((char*)d_ws + WS_CTL, 0, 64 * 1024, stream);
    Args a{};
    for (int i = 0; i < 33; ++i) a.in[i] = (const float*)d_in[i];
    a.out = (float*)d_out; a.ws = (unsigned char*)d_ws;
#if MK_N_LAUNCHES == 1
    a.ph_lo = 0; a.ph_hi = N_PHASES;
    hipLaunchKernelGGL(mk_fwd, dim3(grid), dim3(NTHR), LDS_BYTES, stream, a);
#else
    for (int p = 0; p < N_PHASES; ++p) { a.ph_lo = p; a.ph_hi = p + 1; hipLaunchKernelGGL(mk_fwd, dim3(grid), dim3(NTHR), LDS_BYTES, stream, a); }
#endif
    const hipError_t le = hipPeekAtLastError();
    if (le != hipSuccess) fprintf(stderr, "kernel_launch: launch failed: %s\n", hipGetErrorName(le));
}
```

```cpp
#define MK_N_LAUNCHES 1
#define MK_FAST_ATTN 1
#define MK_FAST_CONV 1
#define MK_GATHER 1
#define MK_FAST_SP 1
#include <hip/hip_runtime.h>
#include <cstdio>
#include <cstdint>
#include <cmath>
namespace pg8 {
#define PG8_LAS __attribute__((address_space(3)))
typedef unsigned short bf16_t;
typedef short bf16x8 __attribute__((ext_vector_type(8)));
typedef float f32x4 __attribute__((ext_vector_type(4)));
typedef unsigned u32x4 __attribute__((ext_vector_type(4)));
typedef unsigned u32x2 __attribute__((ext_vector_type(2)));
constexpr int BM = 256, BK = 64, HALF = 128, HTB = HALF * BK * 2  , STAGE_BYTES = 8 * HTB, NXCD = 8, WGM = 8;

__host__ __device__ __forceinline__ int lds_byte(int r, int c) { const int st = (r >> 4) * 2 + (c >> 5), rr = r & 15, cc = c & 31, ob = rr * 64 + cc * 2; return st * 1024 + (ob ^ (((ob >> 9) & 1) << 5)); }
__host__ __device__ __forceinline__ void stage_rc(int b, int& R, int& C) { const int st = b / 1024, sb = b % 1024, swz = sb ^ (((sb >> 9) & 1) << 5); R = (st >> 1) * 16 + swz / 64; C = (st & 1) * 32 + (swz % 64) / 2; }
__host__ __device__ __forceinline__ int perm32(int rho) { const int n = rho >> 4, i = rho & 15; return 8 * (i >> 2) + 4 * n + (i & 3); }

struct Unit { int pm, pn; };
struct Gemm { const bf16_t* A; const bf16_t* Bt; int M, N, K; const int* rows; };

struct StaticOrder {
    int nM, nN, nwg, G, c;
    __host__ __device__ void init(int M, int N, int G_, int c_) { nM = M / BM; nN = N / BM; nwg = nM * nN; G = G_; c = c_; }
    __host__ __device__ bool next(int i, Unit& u) const {
        const long L = (long)i * G + c; if (L >= nwg) return false;
        int wgid = (int)L; { const int q = nwg / NXCD, r = nwg % NXCD, xcd = wgid % NXCD, off = wgid / NXCD; wgid = (xcd < r ? xcd * (q + 1) : r * (q + 1) + (xcd - r) * q) + off; }
        const int nig = WGM * nN, gid = wgid / nig, fm = gid * WGM, gsz = (nM - fm) < WGM ? (nM - fm) : WGM;
        u.pm = fm + ((wgid % nig) % gsz); u.pn = (wgid % nig) / gsz; return true;
    }
    __device__ __forceinline__ void a_ready(const Unit&) const {}
    __device__ __forceinline__ void done(const Unit&) const {}
};

__device__ __forceinline__ unsigned cvt_pk_bf16(float lo, float hi) { unsigned r; asm volatile("v_cvt_pk_bf16_f32 %0, %1, %2" : "=v"(r) : "v"(lo), "v"(hi)); return r; }
typedef float f32x2 __attribute__((ext_vector_type(2)));
__device__ __forceinline__ f32x2 gelu_pk(f32x2 v) {
    const f32x2 av = __builtin_elementwise_abs(v), d = av * 0.2316418882f + 1.0f;
    f32x2 t; t.x = __builtin_amdgcn_rcpf(d.x); t.y = __builtin_amdgcn_rcpf(d.y);
    f32x2 q = t * 0.5307027145f + (-0.7265760135f); q = q * t + 0.7107068705f; q = q * t + (-0.142248368f); q = q * t + 0.127414796f; q = q * t;
    const f32x2 s = (v * v) * (-0.72134752044f);
    f32x2 e; e.x = __builtin_amdgcn_exp2f(s.x); e.y = __builtin_amdgcn_exp2f(s.y);
    const f32x2 m = v * (q * e), r = v - m;
    f32x2 o; o.x = v.x < 0.f ? m.x : r.x; o.y = v.y < 0.f ? m.y : r.y; return o;
}

template <int ACT  > struct EpiBf16 {
    static constexpr bool PERM = true, AFTER_DRAIN = false; static_assert(ACT == 0 || ACT == 1, "EpiBf16: ACT is 0 (none) or 1 (gelu_pk)");
    bf16_t* O; int ldc; const float* bias; int split_cols; size_t split_stride; float scale0; float pre = 1.f;
    __device__ __forceinline__ void operator()(const f32x4 (&acc)[2][2][4][2], const Unit& u, int wr, int wc, int fr, int fq) const {
        const int row0 = u.pm * BM + wr * 64 + fr; int colt = u.pn * BM; bf16_t* base = O;
        float sc = 1.f; if (split_cols) { const int t = colt / split_cols; base += (size_t)t * split_stride; colt -= t * split_cols; if (t == 0) sc = scale0; }
        const int col0 = colt + wc * 32 + 8 * fq, bcol0 = u.pn * BM + wc * 32 + 8 * fq;
        f32x4 bv[2][2];
#pragma unroll
        for (int bj = 0; bj < 2; ++bj)
#pragma unroll
            for (int n = 0; n < 2; ++n) bv[bj][n] = bias ? *(const f32x4*)(bias + bcol0 + bj * HALF + 4 * n) : (f32x4){0.f, 0.f, 0.f, 0.f};
#pragma unroll
        for (int ai = 0; ai < 2; ++ai)
#pragma unroll
            for (int m = 0; m < 4; ++m) { bf16_t* rowp = base + (size_t)(row0 + ai * HALF + m * 16) * ldc + col0;
#pragma unroll
                for (int bj = 0; bj < 2; ++bj) { f32x4 v0 = acc[ai][bj][m][0] * pre + bv[bj][0], v1 = acc[ai][bj][m][1] * pre + bv[bj][1];
                    if (ACT == 1) { f32x2 a = gelu_pk((f32x2){v0[0], v0[1]}), b = gelu_pk((f32x2){v0[2], v0[3]}), c = gelu_pk((f32x2){v1[0], v1[1]}), d = gelu_pk((f32x2){v1[2], v1[3]});
                        v0 = (f32x4){a.x, a.y, b.x, b.y}; v1 = (f32x4){c.x, c.y, d.x, d.y}; }
                    v0 = v0 * sc; v1 = v1 * sc; u32x4 w; w.x = cvt_pk_bf16(v0[0], v0[1]); w.y = cvt_pk_bf16(v0[2], v0[3]); w.z = cvt_pk_bf16(v1[0], v1[1]); w.w = cvt_pk_bf16(v1[2], v1[3]);
                    *(u32x4*)(rowp + bj * HALF) = w; } }
    }
};

#ifndef MK_FP8_Y
#define MK_FP8_Y 1
#endif
struct EpiF32 {
    static constexpr bool PERM = false, AFTER_DRAIN = false;
    float* C; int ldc;
    __device__ __forceinline__ void operator()(const f32x4 (&acc)[2][2][4][2], const Unit& u, int wr, int wc, int fr, int fq) const {
        const int row0 = u.pm * BM + wr * 64 + fr, col0 = u.pn * BM + wc * 32 + 4 * fq;
#pragma unroll
        for (int ai = 0; ai < 2; ++ai)
#pragma unroll
            for (int m = 0; m < 4; ++m) { float* rowp = C + (size_t)(row0 + ai * HALF + m * 16) * ldc + col0;
#pragma unroll
                for (int bj = 0; bj < 2; ++bj)
#pragma unroll
                    for (int n = 0; n < 2; ++n) *(f32x4*)(rowp + bj * HALF + n * 16) = acc[ai][bj][m][n]; }
    }
};
struct EpiRes {
    static constexpr bool PERM = true, AFTER_DRAIN = false;
    const bf16_t* X; bf16_t* U; const float* g; int gstride; float alpha; float accs = 1.f;
    __device__ __forceinline__ void operator()(const f32x4 (&acc)[2][2][4][2], const Unit& u, int wr, int wc, int fr, int fq) const {
        const int row0 = u.pm * BM + wr * 64 + fr, col0 = u.pn * BM + wc * 32 + 8 * fq;
        const int rb = u.pm * BM; const int bidx = rb < 16384 ? (rb >> 12) : 4;
        const float* gp = g + (size_t)bidx * gstride + col0;
        f32x4 gv[2][2];
#pragma unroll
        for (int bj = 0; bj < 2; ++bj)
#pragma unroll
            for (int n = 0; n < 2; ++n) gv[bj][n] = *(const f32x4*)(gp + bj * HALF + 4 * n) * accs;
#pragma unroll
        for (int ai = 0; ai < 2; ++ai)
#pragma unroll
            for (int m = 0; m < 4; ++m) { const size_t off = (size_t)(row0 + ai * HALF + m * 16) * 1024 + col0;
#pragma unroll
                for (int bj = 0; bj < 2; ++bj) { const u32x4 xw = *(const u32x4*)(X + off + bj * HALF);
                    const f32x4 x0 = (f32x4){__builtin_bit_cast(float, xw.x << 16), __builtin_bit_cast(float, xw.x & 0xffff0000u), __builtin_bit_cast(float, xw.y << 16), __builtin_bit_cast(float, xw.y & 0xffff0000u)};
                    const f32x4 x1 = (f32x4){__builtin_bit_cast(float, xw.z << 16), __builtin_bit_cast(float, xw.z & 0xffff0000u), __builtin_bit_cast(float, xw.w << 16), __builtin_bit_cast(float, xw.w & 0xffff0000u)};
                    const f32x4 u0 = x0 * alpha + gv[bj][0] * acc[ai][bj][m][0], u1 = x1 * alpha + gv[bj][1] * acc[ai][bj][m][1];
                    u32x4 uw; uw.x = cvt_pk_bf16(u0[0], u0[1]); uw.y = cvt_pk_bf16(u0[2], u0[3]); uw.z = cvt_pk_bf16(u1[0], u1[1]); uw.w = cvt_pk_bf16(u1[2], u1[3]);
                    *(u32x4*)(U + off + bj * HALF) = uw; }
                asm volatile("" ::: "memory"); }
    }
};
struct EpiNull {
    static constexpr bool PERM = true, AFTER_DRAIN = false;
    __device__ __forceinline__ void operator()(const f32x4 (&acc)[2][2][4][2], const Unit& u, int wr, int wc, int fr, int fq) const {
        f32x4 s = (f32x4){0.f, 0.f, 0.f, 0.f};
#pragma unroll
        for (int ai = 0; ai < 2; ++ai)
#pragma unroll
            for (int bj = 0; bj < 2; ++bj)
#pragma unroll
                for (int m = 0; m < 4; ++m)
#pragma unroll
                    for (int n = 0; n < 2; ++n) s += acc[ai][bj][m][n];
        asm volatile("" :: "v"(s));
    }
};
struct EpiGUnostore {
    static constexpr bool PERM = true, AFTER_DRAIN = false;
    __device__ __forceinline__ void operator()(const f32x4 (&acc)[2][2][4][2], const Unit& u, int wr, int wc, int fr, int fq) const {
#pragma unroll
        for (int ai = 0; ai < 2; ++ai)
#pragma unroll
            for (int m = 0; m < 4; ++m) { float o[8];
#pragma unroll
                for (int n = 0; n < 2; ++n)
#pragma unroll
                    for (int j = 0; j < 4; ++j) { const float a = acc[ai][0][m][n][j], b = acc[ai][1][m][n][j];
                        const float s = a * __builtin_amdgcn_rcpf(1.0f + __builtin_amdgcn_exp2f(-1.4426950408889634f * a)); o[n * 4 + j] = s * b; }
                u32x4 w; w.x = cvt_pk_bf16(o[0], o[1]); w.y = cvt_pk_bf16(o[2], o[3]); w.z = cvt_pk_bf16(o[4], o[5]); w.w = cvt_pk_bf16(o[6], o[7]);
                asm volatile("" :: "v"(w)); }
    }
};
struct EpiGU {
    static constexpr bool PERM = true, AFTER_DRAIN = false;
    bf16_t* ACT; int npn;
    __device__ __forceinline__ void operator()(const f32x4 (&acc)[2][2][4][2], const Unit& u, int wr, int wc, int fr, int fq) const {
        const int row0 = u.pm * BM + wr * 64 + fr; const int col0 = (u.pn % npn) * 128 + wc * 32 + 8 * fq;
#pragma unroll
        for (int ai = 0; ai < 2; ++ai)
#pragma unroll
            for (int m = 0; m < 4; ++m) { bf16_t* rowp = ACT + (size_t)(row0 + ai * HALF + m * 16) * 2048 + col0;
                float o[8];
#pragma unroll
                for (int n = 0; n < 2; ++n)
#pragma unroll
                    for (int j = 0; j < 4; ++j) { const float a = acc[ai][0][m][n][j], b = acc[ai][1][m][n][j];
                        const float s = a * __builtin_amdgcn_rcpf(1.0f + __builtin_amdgcn_exp2f(-1.4426950408889634f * a)); o[n * 4 + j] = s * b; }
                u32x4 w; w.x = cvt_pk_bf16(o[0], o[1]); w.y = cvt_pk_bf16(o[2], o[3]); w.z = cvt_pk_bf16(o[4], o[5]); w.w = cvt_pk_bf16(o[6], o[7]);
                *(u32x4*)rowp = w; }
    }
};
template <bool OUT8> struct EpiGU8 {
    static constexpr bool PERM = true, AFTER_DRAIN = false;
    unsigned char* ACT; int npn; float inscale, outscale;
    __device__ __forceinline__ void operator()(const f32x4 (&acc)[2][2][4][2], const Unit& u, int wr, int wc, int fr, int fq) const {
        const int row0 = u.pm * BM + wr * 64 + fr; const int col0 = (u.pn % npn) * 128 + wc * 32 + 8 * fq;
        const float ka = -1.4426950408889634f * inscale, kb = inscale * inscale * outscale;
#pragma unroll
        for (int ai = 0; ai < 2; ++ai)
#pragma unroll
            for (int m = 0; m < 4; ++m) { unsigned char* rowp = ACT + ((size_t)(row0 + ai * HALF + m * 16) * 2048 + col0) * (OUT8 ? 1 : 2);
                float o[8];
#pragma unroll
                for (int n = 0; n < 2; ++n)
#pragma unroll
                    for (int j = 0; j < 4; ++j) { const float a = acc[ai][0][m][n][j], b = acc[ai][1][m][n][j];
                        o[n * 4 + j] = a * __builtin_amdgcn_rcpf(1.0f + __builtin_amdgcn_exp2f(ka * a)) * (b * kb); }
                if constexpr (OUT8) {
#pragma unroll
                    for (int q = 0; q < 8; ++q) o[q] = __builtin_amdgcn_fmed3f(o[q], -448.0f, 448.0f);
                    unsigned w0 = 0u, w1 = 0u;
                    w0 = __builtin_amdgcn_cvt_pk_fp8_f32(o[0], o[1], w0, false); w0 = __builtin_amdgcn_cvt_pk_fp8_f32(o[2], o[3], w0, true);
                    w1 = __builtin_amdgcn_cvt_pk_fp8_f32(o[4], o[5], w1, false); w1 = __builtin_amdgcn_cvt_pk_fp8_f32(o[6], o[7], w1, true);
                    typedef unsigned u32x2_ __attribute__((ext_vector_type(2)));
                    *(u32x2_*)rowp = (u32x2_){w0, w1}; }
                else { u32x4 w; w.x = cvt_pk_bf16(o[0], o[1]); w.y = cvt_pk_bf16(o[2], o[3]); w.z = cvt_pk_bf16(o[4], o[5]); w.w = cvt_pk_bf16(o[6], o[7]); *(u32x4*)rowp = w; } }
    }
};
struct EpiDN {
    static constexpr bool PERM = true, AFTER_DRAIN = false;
    bf16_t* Y; const float* gate; int npn; float scale;
    __device__ __forceinline__ void operator()(const f32x4 (&acc)[2][2][4][2], const Unit& u, int wr, int wc, int fr, int fq) const {
        const int row0 = u.pm * BM + wr * 64 + fr, col0 = (u.pn % npn) * BM + wc * 32 + 8 * fq;
#pragma unroll
        for (int ai = 0; ai < 2; ++ai)
#pragma unroll
            for (int m = 0; m < 4; ++m) { const int row = row0 + ai * HALF + m * 16; const float gt = gate[row] * scale; bf16_t* rowp = Y + (size_t)row * 1024 + col0;
#pragma unroll
                for (int bj = 0; bj < 2; ++bj) { const f32x4 v0 = acc[ai][bj][m][0] * gt, v1 = acc[ai][bj][m][1] * gt;
#if MK_FP8_Y
                    unsigned w0 = 0u, w1 = 0u;
                    w0 = __builtin_amdgcn_cvt_pk_fp8_f32(__builtin_amdgcn_fmed3f(v0[0], -448.0f, 448.0f), __builtin_amdgcn_fmed3f(v0[1], -448.0f, 448.0f), w0, false);
                    w0 = __builtin_amdgcn_cvt_pk_fp8_f32(__builtin_amdgcn_fmed3f(v0[2], -448.0f, 448.0f), __builtin_amdgcn_fmed3f(v0[3], -448.0f, 448.0f), w0, true);
                    w1 = __builtin_amdgcn_cvt_pk_fp8_f32(__builtin_amdgcn_fmed3f(v1[0], -448.0f, 448.0f), __builtin_amdgcn_fmed3f(v1[1], -448.0f, 448.0f), w1, false);
                    w1 = __builtin_amdgcn_cvt_pk_fp8_f32(__builtin_amdgcn_fmed3f(v1[2], -448.0f, 448.0f), __builtin_amdgcn_fmed3f(v1[3], -448.0f, 448.0f), w1, true);
                    *(u32x2*)((unsigned char*)Y + (size_t)row * 1024 + col0 + bj * HALF) = (u32x2){w0, w1}; } }
#else
                    u32x4 w; w.x = cvt_pk_bf16(v0[0], v0[1]); w.y = cvt_pk_bf16(v0[2], v0[3]); w.z = cvt_pk_bf16(v1[0], v1[1]); w.w = cvt_pk_bf16(v1[2], v1[3]);
                    *(u32x4*)(rowp + bj * HALF) = w; } }
#endif
    }
};
struct EpiVT {
    static constexpr bool PERM = false, AFTER_DRAIN = false;
    bf16_t* VT; int ldc; f32x2* VST; int ntok; float pre = 1.f;
    __device__ __forceinline__ void operator()(const f32x4 (&acc)[2][2][4][2], const Unit& u, int wr, int wc, int fr, int fq) const {
        const int row0 = u.pm * BM + wr * 64 + fr, col0 = u.pn * BM + wc * 32 + 4 * fq;
        f32x4 s1[2][2], s2[2][2];
#pragma unroll
        for (int bj = 0; bj < 2; ++bj)
#pragma unroll
            for (int n = 0; n < 2; ++n) { s1[bj][n] = (f32x4){0.f, 0.f, 0.f, 0.f}; s2[bj][n] = (f32x4){0.f, 0.f, 0.f, 0.f}; }
#pragma unroll
        for (int ai = 0; ai < 2; ++ai)
#pragma unroll
            for (int m = 0; m < 4; ++m) { bf16_t* rowp = VT + (size_t)(row0 + ai * HALF + m * 16) * ldc + col0;
#pragma unroll
                for (int bj = 0; bj < 2; ++bj)
#pragma unroll
                    for (int n = 0; n < 2; ++n) { const f32x4 v = acc[ai][bj][m][n] * pre; const f32x2 a = gelu_pk((f32x2){v[0], v[1]}), b = gelu_pk((f32x2){v[2], v[3]});
                        const f32x4 gl = (f32x4){a.x, a.y, b.x, b.y}; { u32x2 gw; gw.x = cvt_pk_bf16(gl[0], gl[1]); gw.y = cvt_pk_bf16(gl[2], gl[3]); *(u32x2*)(rowp + bj * HALF + n * 16) = gw; } s1[bj][n] += gl; s2[bj][n] += gl * gl; } }
#pragma unroll
        for (int bj = 0; bj < 2; ++bj)
#pragma unroll
            for (int n = 0; n < 2; ++n)
#pragma unroll
                for (int j = 0; j < 4; ++j) { float a = s1[bj][n][j], b = s2[bj][n][j];
#pragma unroll
                    for (int o = 1; o < 16; o <<= 1) { a += __shfl_xor(a, o); b += __shfl_xor(b, o); }
                    s1[bj][n][j] = a; s2[bj][n][j] = b; }
        if (fr == 0) {
            f32x2* dst = VST + (size_t)(u.pm * 2 + wr) * ntok + col0;
#pragma unroll
            for (int bj = 0; bj < 2; ++bj)
#pragma unroll
                for (int n = 0; n < 2; ++n)
#pragma unroll
                    for (int j = 0; j < 4; ++j) dst[bj * HALF + n * 16 + j] = (f32x2){s1[bj][n][j], s2[bj][n][j]};
        }
    }
};
struct MoeOrder {
    int nPM, nPN, G, vcu; int fixed = 0;
    __device__ __forceinline__ bool next(int i, Unit& u) const {
        const int L = i * G + vcu; if (L >= 16 * nPM * nPN) return false;
        const int pm = L % nPM, r = L / nPM, pn = r % nPN, e = r / nPN; u.pm = e * 9 + pm; u.pn = e * nPN + pn;
#if defined(MK_FIXEDUNIT)
        if (fixed) { u.pm = 0; u.pn = 0; }
#endif
        return true;
    }
    __device__ __forceinline__ void a_ready(const Unit&) const {}
    __device__ __forceinline__ void done(const Unit&) const {}
};

template <class Epi, class Sched, bool ALIGN_EPI = false, bool GATHER = false, bool FP8 = false>
__device__ __forceinline__ void gemm_phase(PG8_LAS unsigned char* lds, const Gemm g, const Sched& S, const Epi& E) {
    int tid_ = threadIdx.x; asm volatile("" : "+v"(tid_));
    const int tid = tid_, wid = __builtin_amdgcn_readfirstlane(tid >> 6), lane = tid & 63, wr = wid >> 2, wc = wid & 3, fr = lane & 15, fq = lane >> 4;
    const int K = g.K, nt = K / BK;
    unsigned voffA[2], voffB[2];
#pragma unroll
    for (int i = 0; i < 2; ++i) { int R, C; stage_rc(tid * 16 + i * 8192, R, C); const int Rb = Epi::PERM ? ((R & ~31) + perm32(R & 31)) : R;
        voffA[i] = (unsigned)(R * K + C) * 2u; voffB[i] = (unsigned)(Rb * K + C) * 2u; }
    const size_t kstep = (size_t)(BK * 2);
    const size_t hstep = (size_t)HALF * K * 2;
    const size_t tstep = 2 * hstep;
    const unsigned ldsw = (unsigned)wid * 1024u;
    const int aoff = lds_byte(wr * 64 + fr, fq * 8), boff = lds_byte(wc * 32 + fr, fq * 8);
#define PG8_SA(b, h) (((b) * 2 + (h)) * HTB)
#define PG8_SB(b, h) ((4 + (b) * 2 + (h)) * HTB)
#define PG8_STAGE(bufoff, gbase, voff) do { _Pragma("unroll") for (int _i = 0; _i < 2; ++_i) \
        __builtin_amdgcn_global_load_lds((const unsigned*)((const char*)(gbase) + (voff)[_i]), (PG8_LAS unsigned*)(lds + (bufoff) + ldsw + _i * 8192), 16, 0, 0); } while (0)
#define PG8_STGA(b, h, ubase, koff, gofs) do { if constexpr (GATHER) { PG8_STAGE(PG8_SA(b, h), (const char*)g.A + (koff), gofs[h]); } \
        else { PG8_STAGE(PG8_SA(b, h), (ubase) + (koff) + (size_t)(h) * hstep, voffA); } } while (0)
#define PG8_GLOAD(dst, u) do { if constexpr (GATHER) { _Pragma("unroll") for (int _i = 0; _i < 2; ++_i) { int _R, _C; stage_rc(tid * 16 + _i * 8192, _R, _C); \
        _Pragma("unroll") for (int _h = 0; _h < 2; ++_h) dst[_h][_i] = (unsigned)g.rows[(u).pm * BM + _h * HALF + _R] * (unsigned)(K * 2) + (unsigned)_C * 2u; } } } while (0)
#define PG8_LDA(dst, b, h) do { _Pragma("unroll") for (int m = 0; m < 4; ++m) _Pragma("unroll") for (int k = 0; k < 2; ++k) dst[m][k] = *(const PG8_LAS bf16x8*)(lds + PG8_SA(b, h) + aoff + m * 2048 + k * 1024); } while (0)
#define PG8_LDB(dst, b, h) do { _Pragma("unroll") for (int n = 0; n < 2; ++n) _Pragma("unroll") for (int k = 0; k < 2; ++k) dst[n][k] = *(const PG8_LAS bf16x8*)(lds + PG8_SB(b, h) + boff + n * 2048 + k * 1024); } while (0)
#define PG8_CAT8(x0, x1) __builtin_shufflevector(__builtin_bit_cast(v4i_t, x0), __builtin_bit_cast(v4i_t, x1), 0, 1, 2, 3, 4, 5, 6, 7)
#define PG8_MMA(ai, bj, At, Bt) do { __builtin_amdgcn_s_setprio(1); _Pragma("unroll") for (int m = 0; m < 4; ++m) _Pragma("unroll") for (int n = 0; n < 2; ++n) { \
        if constexpr (FP8) { asm volatile("v_mfma_scale_f32_16x16x128_f8f6f4 %0, %1, %2, %0, %3, %3 op_sel_hi:[0,0,0]" : "+v"(acc[ai][bj][m][n]) : "v"(PG8_CAT8(Bt[n][0], Bt[n][1])), "v"(PG8_CAT8(At[m][0], At[m][1])), "v"(0x7F7F7F7F)); } \
        else { _Pragma("unroll") for (int k = 0; k < 2; ++k) acc[ai][bj][m][n] = __builtin_amdgcn_mfma_f32_16x16x32_bf16(Bt[n][k], At[m][k], acc[ai][bj][m][n], 0, 0, 0); } } \
        __builtin_amdgcn_s_setprio(0); } while (0)
#define PG8_WAIT_V(n) asm volatile("s_waitcnt vmcnt(" #n ")" ::: "memory")
#define PG8_WAIT_L(n) asm volatile("s_waitcnt lgkmcnt(" #n ")" ::: "memory")
#define PG8_BAR __builtin_amdgcn_s_barrier()
#define PG8_SCHED __builtin_amdgcn_sched_barrier(0)
    Unit cur, nxt; int ui = 0;
    if (!S.next(0, cur)) return;
    f32x4 acc[2][2][4][2];
#pragma unroll
    for (int a = 0; a < 2; ++a)
#pragma unroll
        for (int b = 0; b < 2; ++b)
#pragma unroll
            for (int m = 0; m < 4; ++m)
#pragma unroll
                for (int n = 0; n < 2; ++n) acc[a][b][m][n] = (f32x4){0.f, 0.f, 0.f, 0.f};
    bf16x8 At[4][2], B0[2][2], B1[2][2];
    typedef int v8i_t __attribute__((ext_vector_type(8))); typedef int v4i_t __attribute__((ext_vector_type(4)));
    unsigned gc[2][2] = {{0u, 0u}, {0u, 0u}}, gn[2][2] = {{0u, 0u}, {0u, 0u}};
    const char* cA = GATHER ? (const char*)g.A : (const char*)g.A + (size_t)cur.pm * tstep; const char* cB = (const char*)g.Bt + (size_t)cur.pn * tstep;
    S.a_ready(cur);
    PG8_GLOAD(gc, cur);
    PG8_STAGE(PG8_SB(0, 0), cB, voffB); PG8_STAGE(PG8_SB(0, 1), cB + hstep, voffB); PG8_STGA(0, 0, cA, 0, gc); PG8_STGA(0, 1, cA, 0, gc);
    if (wr == 1) PG8_BAR;
    PG8_WAIT_V(2); PG8_BAR;
    PG8_STAGE(PG8_SB(1, 0), cB + kstep, voffB); PG8_STGA(1, 0, cA, kstep, gc); PG8_STAGE(PG8_SB(1, 1), cB + hstep + kstep, voffB);
    PG8_WAIT_V(6); PG8_BAR;
    for (;;) {
        const bool has_next = S.next(ui + 1, nxt);
        const char* nA = GATHER ? (const char*)g.A : (has_next ? (const char*)g.A + (size_t)nxt.pm * tstep : cA); const char* nB = has_next ? (const char*)g.Bt + (size_t)nxt.pn * tstep : cB;
#pragma unroll 1
        for (int t = 0; t < nt; t += 2) {
            const bool last = (t == nt - 2);
            const size_t k1 = (size_t)(t + 1) * kstep;
            const char* b2 = last ? nB : cB + (size_t)(t + 2) * kstep; const char* b3 = b2 + kstep;
            if (last && has_next) S.a_ready(nxt);
            if (last) { if (has_next) { PG8_GLOAD(gn, nxt); } else {
#pragma unroll
                    for (int h = 0; h < 2; ++h)
#pragma unroll
                        for (int i = 0; i < 2; ++i) gn[h][i] = gc[h][i]; } }
            PG8_LDB(B0, 0, 0); PG8_LDB(B1, 0, 1); PG8_SCHED; PG8_LDA(At, 0, 0); PG8_STGA(1, 1, cA, k1, gc);
            PG8_WAIT_V(8); PG8_WAIT_L(0); PG8_BAR; PG8_MMA(0, 0, At, B0); PG8_MMA(0, 1, At, B1); PG8_BAR; PG8_SCHED;
            PG8_LDA(At, 0, 1); PG8_STAGE(PG8_SB(0, 0), b2, voffB); PG8_STAGE(PG8_SB(0, 1), b2 + hstep, voffB);
            if (last) { PG8_STGA(0, 0, nA, 0, gn); } else { PG8_STGA(0, 0, cA, (size_t)(t + 2) * kstep, gc); }
            PG8_WAIT_V(8); PG8_WAIT_L(0); PG8_BAR; PG8_MMA(1, 0, At, B0); PG8_MMA(1, 1, At, B1); PG8_BAR; PG8_SCHED;
            PG8_LDB(B0, 1, 0); PG8_LDB(B1, 1, 1); PG8_SCHED; PG8_LDA(At, 1, 0);
            if (last) { PG8_STGA(0, 1, nA, 0, gn); } else { PG8_STGA(0, 1, cA, (size_t)(t + 2) * kstep, gc); }
            PG8_WAIT_V(8); PG8_WAIT_L(0); PG8_BAR; PG8_MMA(0, 0, At, B0); PG8_MMA(0, 1, At, B1); PG8_BAR; PG8_SCHED;
            PG8_LDA(At, 1, 1); PG8_STAGE(PG8_SB(1, 0), b3, voffB); PG8_STAGE(PG8_SB(1, 1), b3 + hstep, voffB);
            if (last) { PG8_STGA(1, 0, nA, kstep, gn); } else { PG8_STGA(1, 0, cA, (size_t)(t + 3) * kstep, gc); }
            PG8_WAIT_V(8); PG8_WAIT_L(0); PG8_BAR; PG8_MMA(1, 0, At, B0); PG8_MMA(1, 1, At, B1); PG8_BAR; PG8_SCHED;
        }
        if constexpr (ALIGN_EPI) { if (wr == 0) PG8_BAR; }
        if constexpr (FP8) asm volatile("s_nop 15\n\ts_nop 15" ::: "memory");
        if constexpr (!Epi::AFTER_DRAIN) { E(acc, cur, wr, wc, fr, fq); S.done(cur); }
        if (!has_next) break;
#pragma unroll
        for (int a = 0; a < 2; ++a)
#pragma unroll
            for (int b = 0; b < 2; ++b)
#pragma unroll
                for (int m = 0; m < 4; ++m)
#pragma unroll
                    for (int n = 0; n < 2; ++n) acc[a][b][m][n] = (f32x4){0.f, 0.f, 0.f, 0.f};
        if constexpr (FP8) asm volatile("s_nop 7" ::: "memory");
        cur = nxt; cA = nA; cB = nB; ++ui;
#pragma unroll
        for (int h = 0; h < 2; ++h)
#pragma unroll
            for (int i = 0; i < 2; ++i) gc[h][i] = gn[h][i];
        if constexpr (ALIGN_EPI) { if (wr == 1) PG8_BAR; }
    }
    PG8_WAIT_V(0);
    if constexpr (!ALIGN_EPI) { if (wr == 0) PG8_BAR; }
    PG8_BAR;
    if constexpr (Epi::AFTER_DRAIN) { E.fused(acc, cur, wr, wc, fr, fq, lds, wid, lane); S.done(cur); }
#undef PG8_SA
#undef PG8_SB
#undef PG8_STAGE
#undef PG8_STGA
#undef PG8_GLOAD
#undef PG8_LDA
#undef PG8_LDB
#undef PG8_MMA
#undef PG8_CAT8
#undef PG8_WAIT_V
#undef PG8_WAIT_L
#undef PG8_BAR
#undef PG8_SCHED
}
}
constexpr int NB = 4, SEQ = 4096, T = NB * SEQ, LC = 256, TC = NB * LC, TA = T + TC, D = 1024;
constexpr int NE = 16, FF = 2048, ESTR = 2304;
constexpr int LK = LC + SEQ, KVP = 256;
constexpr float ALPHA = 1.6817928305074290f;
constexpr float LN_EPS = 1e-5f, RMS_EPS = 1e-6f;
constexpr float ATT_C2 = 0.125f * 1.4426950408889634f;
constexpr int NWAVES = 8, NTHR = 512;
constexpr size_t MiB = 1u << 20;
constexpr size_t WS_CTL = 0, WS_MOD = 1 * MiB, WS_MODP = 2 * MiB, WS_TW = 6 * MiB;
constexpr size_t WS_WHYIN = 8 * MiB, WS_WHYOUT = 20 * MiB, WS_WQKV = 24 * MiB, WS_WATO = 27 * MiB, WS_WCMIN = 29 * MiB, WS_WCMOUT = 37 * MiB, WS_WCMS = 41 * MiB;
constexpr size_t WS_WGU = 42 * MiB, WS_WDN = 554 * MiB, WS_HF = 810 * MiB;
constexpr size_t WS_XL = 942 * MiB, WS_U = 1010 * MiB, WS_HB = 1078 * MiB, WS_AFF = 1112 * MiB, WS_ROWS = 1114 * MiB, WS_GATE = WS_ROWS + 256 * 1024, WS_INV = 1115 * MiB;
constexpr size_t WS_ACT = 1117 * MiB, WS_Y = 1261 * MiB, WS_SCR = 1405 * MiB, WS_XC = 1677 * MiB, WS_END = 1745 * MiB;
constexpr size_t WS_XG = WS_Y;
constexpr size_t SC_PT = WS_SCR, SC_Z2T = WS_SCR + 204 * MiB, SC_Z2 = WS_SCR + 238 * MiB;
constexpr size_t SC_QKV = WS_SCR, SC_Q = WS_SCR + 102 * MiB, SC_K = WS_SCR + 134 * MiB, SC_V = WS_SCR + 143 * MiB, SC_O = WS_SCR + 152 * MiB;
constexpr size_t SC_UB = WS_SCR, SC_VT = WS_SCR + 64 * MiB, SC_VST = WS_SCR + 192 * MiB, SC_UV = WS_SCR + 194 * MiB;
constexpr size_t HF_SLOT = (size_t)4 * 1024 * 4096 * 4, HF_CTX = 2 * HF_SLOT;
constexpr int LDS_BYTES = 147456;
constexpr int RING_BYTES = 131072, MISC_OFF = LDS_BYTES - 256;

#define GAS __attribute__((address_space(1)))
#define LAS __attribute__((address_space(3)))
typedef unsigned short bf16;
typedef unsigned v4u __attribute__((ext_vector_type(4)));
typedef unsigned v2u __attribute__((ext_vector_type(2)));
typedef float f32x4 __attribute__((ext_vector_type(4)));
typedef float f32x2 __attribute__((ext_vector_type(2)));
#define LDS_WAIT() asm volatile("s_waitcnt lgkmcnt(0)" ::: "memory")
__device__ __forceinline__ unsigned f2bf(float f) { unsigned u = __builtin_bit_cast(unsigned, f); return (u + 0x7fffu + ((u >> 16) & 1u)) >> 16; }
__device__ __forceinline__ unsigned pk2(float lo, float hi) { unsigned r; asm("v_cvt_pk_bf16_f32 %0, %1, %2" : "=v"(r) : "v"(lo), "v"(hi)); return r; }
__device__ __forceinline__ unsigned pk4_e4m3(f32x4 h) { unsigned o8 = 0u;
    o8 = __builtin_amdgcn_cvt_pk_fp8_f32(__builtin_amdgcn_fmed3f(h[0], -448.0f, 448.0f), __builtin_amdgcn_fmed3f(h[1], -448.0f, 448.0f), o8, false);
    o8 = __builtin_amdgcn_cvt_pk_fp8_f32(__builtin_amdgcn_fmed3f(h[2], -448.0f, 448.0f), __builtin_amdgcn_fmed3f(h[3], -448.0f, 448.0f), o8, true); return o8; }
__device__ __forceinline__ f32x4 up4(v2u w) { return (f32x4){__builtin_bit_cast(float, w.x << 16), __builtin_bit_cast(float, w.x & 0xffff0000u), __builtin_bit_cast(float, w.y << 16), __builtin_bit_cast(float, w.y & 0xffff0000u)}; }
__device__ __forceinline__ float bf2f(unsigned short b) { return __builtin_bit_cast(float, (unsigned)b << 16); }
__device__ __forceinline__ float wave_sum(float v) {
#pragma unroll
    for (int o = 1; o < 64; o <<= 1) v += __shfl_xor(v, o);
    return v;
}

#ifndef MK_FP8_HYIN
#define MK_FP8_HYIN 1
#endif
constexpr float WH_SCALE = 64.0f;
#ifndef MK_FP8_CMIN
#define MK_FP8_CMIN 0
#endif
#ifndef MK_FP8_CMV
#define MK_FP8_CMV 0
#endif
constexpr size_t WS_HB8B = 943 * (1ull << 20);
#ifndef MK_FP8_HYOUT
#define MK_FP8_HYOUT 1
#endif
constexpr float Z_SCALE = 8.0f;
#ifndef MK_FP8_AOUT
#define MK_FP8_AOUT 1
#endif
constexpr float O_SCALE = 16.0f;
#ifndef MK_FP8_CMOUT
#define MK_FP8_CMOUT 0
#endif
constexpr float Y_SCALE = 64.0f;
#ifndef MK_FP8_QKV
#define MK_FP8_QKV 1
#endif
#ifndef MK_LNR_WREG
#define MK_LNR_WREG 0
#endif
#ifndef MK_LNR_WIDE
#define MK_LNR_WIDE 1
#endif
#ifndef MK_COMB_WIDE
#define MK_COMB_WIDE 1
#endif
#ifndef MK_MERGE_PRO
#define MK_MERGE_PRO 0
#endif
#ifndef MK_FOLLOW_L1INV
#define MK_FOLLOW_L1INV 0
#endif
#ifndef MK_EARLY_WB
#define MK_EARLY_WB 0
#endif
#define XB_TMO      128
#define XB_XCNT(j)  (256  + 64 * (j))
#define XB_XSUB(j)  (1280 + 64 * (j))
#define XB_XGEN(j)  (2304 + 64 * (j))
#define XB_TOP      3328
#define XB_TOPGEN   3392
#define XCD_BAR_WORDS 3456
#define XB_SPIN_CAP (1u << 18)
__device__ __forceinline__ unsigned xb_ld(unsigned* p)              { return __hip_atomic_load(p, __ATOMIC_RELAXED, __HIP_MEMORY_SCOPE_AGENT); }
__device__ __forceinline__ unsigned xb_add(unsigned* p, unsigned v) { return __hip_atomic_fetch_add(p, v, __ATOMIC_RELAXED, __HIP_MEMORY_SCOPE_AGENT); }
__device__ __forceinline__ unsigned xb_xcc_id() { return (unsigned)__builtin_amdgcn_s_getreg((3 << 11) | 20) & 0xFu; }
#define XB_SPIN(cond, bar) do { unsigned _sp = 0; while (cond) { __builtin_amdgcn_s_sleep(1); \
    if ((++_sp & 255u) == 0u) { if (xb_ld(&(bar)[XB_TMO])) break; if (_sp > XB_SPIN_CAP) { atomicAdd(&(bar)[XB_TMO], 1u); break; } } } } while (0)
struct XcdBarrier { unsigned* bar; unsigned x; volatile LAS unsigned* st; };
__device__ __forceinline__ XcdBarrier xcd_barrier_post(unsigned* bar, volatile LAS unsigned* st) {
    XcdBarrier b; b.bar = bar; b.x = xb_xcc_id(); b.st = st;
    if (threadIdx.x == 0) (void)xb_add(&bar[XB_XCNT(b.x)], 1u);
    return b;
}
__device__ __forceinline__ void xcd_barrier_complete(unsigned* bar, unsigned x, unsigned& nloc, unsigned& nx) {
    const unsigned G = gridDim.x * gridDim.y * gridDim.z;
    unsigned sum, cnt, mine, sp = 0u;
    for (;;) {
        sum = 0u; cnt = 0u; mine = 0u;
#pragma unroll
        for (unsigned j = 0; j < 16; ++j) { const unsigned c = xb_ld(&bar[XB_XCNT(j)]); sum += c; cnt += (c > 0u) ? 1u : 0u; mine = (j == x) ? c : mine; }
        if (sum == G) break;
        __builtin_amdgcn_s_sleep(1);
        if ((++sp & 255u) == 0u) { if (xb_ld(&bar[XB_TMO])) break; if (sp > XB_SPIN_CAP) { atomicAdd(&bar[XB_TMO], 1u); break; } }
    }
    nloc = mine > 0u ? mine : 1u; nx = cnt > 0u ? cnt : 1u;
}
__device__ __forceinline__ void xcd_barrier(const XcdBarrier& b) {
    asm volatile("s_waitcnt vmcnt(0)" ::: "memory");
    __syncthreads();
    if (threadIdx.x == 0) {
        unsigned* bar = b.bar; asm volatile("" : "+s"(bar));
        __builtin_amdgcn_s_waitcnt(0);
        unsigned bx_ = b.x; asm volatile("" : "+s"(bx_));
        unsigned nloc = b.st[0], nx = b.st[1];
        if (nloc == 0u) { xcd_barrier_complete(bar, bx_, nloc, nx); b.st[0] = nloc; b.st[1] = nx; }
#if MK_EARLY_WB
        asm volatile("buffer_wbl2 sc1" ::: "memory");
#endif
        const unsigned old = xb_add(&bar[XB_XSUB(bx_)], 1u);
        const unsigned gen = old / nloc;
        if (old + 1u == (gen + 1u) * nloc) {
            __builtin_amdgcn_fence(__ATOMIC_RELEASE, "agent");
            asm volatile("s_waitcnt vmcnt(0)" ::: "memory");
            const unsigned og = xb_add(&bar[XB_TOP], 1u);
            const unsigned tg = og / nx;
            if (og + 1u == (tg + 1u) * nx) xb_add(&bar[XB_TOPGEN], 1u);
            else XB_SPIN(xb_ld(&bar[XB_TOPGEN]) == tg, bar);
            __builtin_amdgcn_fence(__ATOMIC_ACQUIRE, "agent");
            xb_add(&bar[XB_XGEN(bx_)], 1u);
            asm volatile("s_waitcnt vmcnt(0)" ::: "memory");
        } else {
            XB_SPIN(xb_ld(&bar[XB_XGEN(bx_)]) == gen, bar);
#if MK_FOLLOW_L1INV
            asm volatile("buffer_inv sc0" ::: "memory");
#else
            __builtin_amdgcn_fence(__ATOMIC_ACQUIRE, "agent");
#endif
            asm volatile("s_waitcnt vmcnt(0)" ::: "memory");
        }
    }
    __syncthreads();
}

struct Args { const float* in[33]; float* out; unsigned char* ws; int ph_lo, ph_hi; };
enum { I_X = 0, I_C, I_CTX, I_CCTX, I_MODW, I_MODB, I_LNG, I_LNB, I_HYWIN, I_HYCW, I_HYCB, I_FW1, I_FB1, I_FW2, I_FB2, I_FW3, I_FFREQ, I_FBIAS, I_HYWOUT,
       I_WQKV, I_QGAIN, I_KGAIN, I_WATO, I_CMWIN, I_CMLNG, I_CMLNB, I_CMWS, I_CMBS, I_CMWOUT, I_ROUTER, I_WGATE, I_WUP, I_WDOWN };
typedef const __attribute__((address_space(4))) Args* ArgsP;
__device__ __forceinline__ ArgsP get_args() { auto p = __builtin_amdgcn_kernarg_segment_ptr(); asm volatile("" : "+s"(p)); return (ArgsP)p; }
struct Fr { LAS unsigned char* lds; int tid, lane, wave, vcu, G, bx; };
__device__ __forceinline__ Fr mkfr(unsigned char* lds_raw) {
    Fr F; int tid = threadIdx.x; asm volatile("" : "+v"(tid)); int bx = blockIdx.x, G = gridDim.x; asm volatile("" : "+s"(bx), "+s"(G));
    F.lds = (LAS unsigned char*)lds_raw; F.tid = tid; F.lane = tid & 63; F.wave = __builtin_amdgcn_readfirstlane(tid >> 6);
    F.G = G; F.bx = bx; F.vcu = (G % 8 == 0) ? (bx % 8) * (G / 8) + bx / 8 : bx; return F; }
__device__ __forceinline__ void proA_adaln_item(ArgsP a, const Fr& F, int it) {
    LAS float* sc = (LAS float*)F.lds;
    const int i = it / 96, ks = (it / 12) % 8, cc = it % 12;
    __syncthreads();
    for (int u = F.tid; u < 5 * 128; u += NTHR) { const int r = u / 128, k = ks * 128 + (u % 128);
        const float x = r < 4 ? a->in[I_C][r * D + k] : a->in[I_CCTX][k]; sc[u] = x / (1.0f + expf(-x)); }
    __syncthreads();
    const int col = cc * 512 + F.tid;
    const float* w = a->in[I_MODW] + ((size_t)i * D + (size_t)ks * 128) * 6144 + col;
    float acc[5] = {0.f, 0.f, 0.f, 0.f, 0.f};
#pragma unroll 8
    for (int k = 0; k < 128; ++k) { const float wv = w[(size_t)k * 6144];
#pragma unroll
        for (int r = 0; r < 5; ++r) acc[r] += sc[r * 128 + k] * wv; }
    float* mp = (float*)(a->ws + WS_MODP) + (size_t)((i * 8 + ks) * 5) * 6144 + col;
#pragma unroll
    for (int r = 0; r < 5; ++r) {
#if MK_MERGE_PRO
        asm volatile("global_store_dword %0, %1, off sc0 sc1" :: "v"(mp + (size_t)r * 6144), "v"(acc[r]) : "memory");
#else
        mp[(size_t)r * 6144] = acc[r];
#endif
    }
}
__device__ __forceinline__ void proA_filter_item(ArgsP a, const Fr& F, int it) {
    int slot, L, t0; float* HF;
    if (it < 512) { slot = it >> 8; L = SEQ; t0 = (it & 255) * 16; HF = (float*)(a->ws + WS_HF + (size_t)slot * HF_SLOT); }
    else { slot = 0; L = LC; t0 = (it - 512) * 16; HF = (float*)(a->ws + WS_HF + HF_CTX); }
    LAS float* z = (LAS float*)F.lds;
    LAS float* h1 = z + 16 * 33;
    LAS float* h2 = h1 + 16 * 64;
    LAS float* w1s = h2 + 16 * 64;
    LAS float* w2s = w1s + 33 * 64;
    __syncthreads();
    for (int u = F.tid; u < 33 * 64; u += NTHR) w1s[u] = a->in[I_FW1][(size_t)slot * 33 * 64 + u];
    for (int u = F.tid; u < 64 * 64; u += NTHR) w2s[u] = a->in[I_FW2][(size_t)slot * 64 * 64 + u];
    for (int u = F.tid; u < 16 * 33; u += NTHR) { const int tt = u / 33, j = u % 33; const float tf = (float)(t0 + tt);
        float v;
        if (j == 0) v = tf / (float)(L - 1);
        else { const int jj = (j - 1) & 15; const float f = 1e-4f + (float)jj * ((15.0f - 1e-4f) / 15.0f); const float w = (float)(6.283185307179586 / (double)L) * tf;
            v = j <= 16 ? cosf(f * w) : -sinf(f * w); }
        z[u] = v; }
    __syncthreads();
    const LAS float* w1 = w1s; const float* b1 = a->in[I_FB1] + slot * 64;
    const LAS float* w2 = w2s; const float* b2 = a->in[I_FB2] + slot * 64;
    const float* fq = a->in[I_FFREQ] + slot * 128;
    for (int u = F.tid; u < 16 * 64; u += NTHR) { const int tt = u >> 6, j = u & 63; float s = b1[j];
        for (int i = 0; i < 33; ++i) s += z[tt * 33 + i] * w1[i * 64 + j];
        h1[u] = sinf(fq[j] * s); }
    __syncthreads();
    for (int u = F.tid; u < 16 * 64; u += NTHR) { const int tt = u >> 6, j = u & 63; float s = b2[j];
        for (int i = 0; i < 64; ++i) s += h1[tt * 64 + i] * w2[i * 64 + j];
        h2[u] = sinf(fq[64 + j] * s); }
    __syncthreads();
    const float* w3 = a->in[I_FW3] + (size_t)slot * 64 * 4096;
    const float dmin = -3.0701134573253940f, dmax = -15.350567286626973f;
    const int lane = F.lane, lm = lane & 15, lk = lane >> 4;
    float af[16];
#pragma unroll
    for (int s = 0; s < 16; ++s) af[s] = h2[lm * 64 + 4 * s + lk];
    float tl[4];
#pragma unroll
    for (int j = 0; j < 4; ++j) tl[j] = (float)(t0 + 4 * lk + j) / (float)(L - 1);
#define FILT_LOAD(bA, bB, ct_) do { const int c0_ = (F.wave * 32 + (ct_)) * 16 + lm; _Pragma("unroll") for (int s = 0; s < 16; ++s) { bA[s] = w3[(size_t)(4 * s + lk) * 4096 + c0_]; bB[s] = w3[(size_t)(4 * s + lk) * 4096 + c0_ + 16]; } } while (0)
#define FILT_STEP(bA, bB, ct_) do { const int c0 = (F.wave * 32 + (ct_)) * 16 + lm, c1 = c0 + 16; f32x4 acc0 = {0.f, 0.f, 0.f, 0.f}, acc1 = {0.f, 0.f, 0.f, 0.f}; \
        _Pragma("unroll") for (int s = 0; s < 16; ++s) { acc0 = __builtin_amdgcn_mfma_f32_16x16x4f32(af[s], bA[s], acc0, 0, 0, 0); acc1 = __builtin_amdgcn_mfma_f32_16x16x4f32(af[s], bB[s], acc1, 0, 0, 0); } \
        { const float delta = fabsf(dmin + (float)(c0 & 1023) * ((dmax - dmin) / 1023.0f)); f32x4 o; _Pragma("unroll") for (int j = 0; j < 4; ++j) o[j] = acc0[j] * expf(-tl[j] * delta); *(f32x4*)(HF + (size_t)c0 * L + t0 + 4 * lk) = o; } \
        { const float delta = fabsf(dmin + (float)(c1 & 1023) * ((dmax - dmin) / 1023.0f)); f32x4 o; _Pragma("unroll") for (int j = 0; j < 4; ++j) o[j] = acc1[j] * expf(-tl[j] * delta); *(f32x4*)(HF + (size_t)c1 * L + t0 + 4 * lk) = o; } } while (0)
    float p0[16], p1[16], q0[16], q1[16];
    FILT_LOAD(p0, p1, 0);
    for (int ct = 0; ct < 32; ct += 4) {
        FILT_LOAD(q0, q1, ct + 2);
        FILT_STEP(p0, p1, ct);
        if (ct + 4 < 32) FILT_LOAD(p0, p1, ct + 4);
        FILT_STEP(q0, q1, ct + 2);
    }
#undef FILT_LOAD
#undef FILT_STEP
}
__device__ __forceinline__ void conv_tile(const float* W, int K, int N, int k0, int n0, bf16* WT, int drow0, LAS float* scr, int lane) {
    float rv[64];
#pragma unroll
    for (int i = 0; i < 64; ++i) rv[i] = W[(size_t)(k0 + i) * N + n0 + lane];
#pragma unroll
    for (int i = 0; i < 64; ++i) scr[i * 65 + lane] = rv[i];
    LDS_WAIT(); asm volatile("" ::: "memory");
    const int c = lane & 7;
#pragma unroll
    for (int j = 0; j < 8; ++j) { const int n = (lane >> 3) + 8 * j; const LAS float* s = scr + (8 * c) * 65 + n;
        v4u o; o.x = pk2(s[0 * 65], s[1 * 65]); o.y = pk2(s[2 * 65], s[3 * 65]); o.z = pk2(s[4 * 65], s[5 * 65]); o.w = pk2(s[6 * 65], s[7 * 65]);
        *(v4u*)(WT + (size_t)(drow0 + n) * K + k0 + 8 * c) = o; }
    LDS_WAIT(); asm volatile("" ::: "memory");
}
__device__ __forceinline__ void conv_tile8(const float* W, int K, int N, int k0, int n0, unsigned char* WT, int drow0, float scale, LAS float* scr, int lane) {
    float rv[64];
#pragma unroll
    for (int i = 0; i < 64; ++i) rv[i] = W[(size_t)(k0 + i) * N + n0 + lane];
#pragma unroll
    for (int i = 0; i < 64; ++i) scr[i * 65 + lane] = __builtin_amdgcn_fmed3f(rv[i] * scale, -448.0f, 448.0f);
    LDS_WAIT(); asm volatile("" ::: "memory");
    const int c = lane & 3;
#pragma unroll
    for (int j = 0; j < 4; ++j) { const int n = (lane >> 2) + 16 * j; const LAS float* s = scr + (16 * c) * 65 + n;
        unsigned w[4];
#pragma unroll
        for (int q = 0; q < 4; ++q) { unsigned x = 0u; x = __builtin_amdgcn_cvt_pk_fp8_f32(s[(4 * q) * 65], s[(4 * q + 1) * 65], x, false); x = __builtin_amdgcn_cvt_pk_fp8_f32(s[(4 * q + 2) * 65], s[(4 * q + 3) * 65], x, true); w[q] = x; }
        v4u o; o.x = w[0]; o.y = w[1]; o.z = w[2]; o.w = w[3];
        *(v4u*)(WT + (size_t)(drow0 + n) * K + k0 + 16 * c) = o; }
    LDS_WAIT(); asm volatile("" ::: "memory");
}
struct Cv8 { const float* src; unsigned char* dst; int N, K; float scale; };
__device__ __forceinline__ void conv8_load(const Cv8& d, float (&rv)[64], int lane) {
#pragma unroll
    for (int i = 0; i < 64; ++i) rv[i] = d.src[(size_t)i * d.N + lane];
}
__device__ __forceinline__ void conv8_store(const Cv8& d, const float (&rv)[64], LAS float* scr, int lane) {
#pragma unroll
    for (int i = 0; i < 64; ++i) scr[i * 65 + lane] = __builtin_amdgcn_fmed3f(rv[i] * d.scale, -448.0f, 448.0f);
    LDS_WAIT(); asm volatile("" ::: "memory");
    const int c = lane & 3;
#pragma unroll
    for (int j = 0; j < 4; ++j) { const int n = (lane >> 2) + 16 * j; const LAS float* s = scr + (16 * c) * 65 + n;
        unsigned w[4];
#pragma unroll
        for (int q = 0; q < 4; ++q) { unsigned x = 0u; x = __builtin_amdgcn_cvt_pk_fp8_f32(s[(4 * q) * 65], s[(4 * q + 1) * 65], x, false); x = __builtin_amdgcn_cvt_pk_fp8_f32(s[(4 * q + 2) * 65], s[(4 * q + 3) * 65], x, true); w[q] = x; }
        v4u o; o.x = w[0]; o.y = w[1]; o.z = w[2]; o.w = w[3];
        *(v4u*)(d.dst + (size_t)n * d.K + 16 * c) = o; }
    LDS_WAIT(); asm volatile("" ::: "memory");
}
#ifndef MK_CV_CHUNK
#define MK_CV_CHUNK 4
#endif
#ifndef MK_CV_ORDER
#define MK_CV_ORDER 0
#endif
#ifndef MK_CV_PIPE
#define MK_CV_PIPE 0
#endif
#ifndef MK_FP8_DN
#define MK_FP8_DN 1
#endif
constexpr float WGU_SCALE = 64.0f, WDN_SCALE = 128.0f, ACT_SCALE = 2.0f;
constexpr int CV_SMALL = 768 * 2 + 256 * 2 + 384 + 256 + 1024 + 512;
constexpr int CV_MOE = 4 * 16 * 3 * 512;
__device__ __forceinline__ void proA_conv_item(ArgsP a, int it, LAS float* scr, int lane) {
    unsigned char* ws = a->ws;
    if (it < CV_SMALL) {
        int r = it;
        if (r < 1536) { const int s = r / 768, q = r % 768, kb = q / 48, nb = q % 48;
#if MK_FP8_HYIN
            conv_tile8(a->in[I_HYWIN] + (size_t)s * 1024 * 3072, 1024, 3072, kb * 64, nb * 64, (unsigned char*)(ws + WS_WHYIN) + (size_t)s * 3072 * 1024, nb * 64, WH_SCALE, scr, lane); return; } r -= 1536;
#else
            conv_tile(a->in[I_HYWIN] + (size_t)s * 1024 * 3072, 1024, 3072, kb * 64, nb * 64, (bf16*)(ws + WS_WHYIN) + (size_t)s * 3072 * 1024, nb * 64, scr, lane); return; } r -= 1536;
#endif
        if (r < 512) { const int s = r / 256, q = r % 256, kb = q / 16, nb = q % 16;
#if MK_FP8_HYOUT
            conv_tile8(a->in[I_HYWOUT] + (size_t)s * 1024 * 1024, 1024, 1024, kb * 64, nb * 64, (unsigned char*)(ws + WS_WHYOUT) + (size_t)s * 1024 * 1024, nb * 64, WH_SCALE, scr, lane); return; } r -= 512;
#else
            conv_tile(a->in[I_HYWOUT] + (size_t)s * 1024 * 1024, 1024, 1024, kb * 64, nb * 64, (bf16*)(ws + WS_WHYOUT) + (size_t)s * 1024 * 1024, nb * 64, scr, lane); return; } r -= 512;
#endif
        if (r < 384) { const int kb = r / 24, nb = r % 24;
#if MK_FP8_QKV
            conv_tile8(a->in[I_WQKV], 1024, 1536, kb * 64, nb * 64, (unsigned char*)(ws + WS_WQKV), nb * 64, WH_SCALE, scr, lane); return; } r -= 384;
#else
            conv_tile(a->in[I_WQKV], 1024, 1536, kb * 64, nb * 64, (bf16*)(ws + WS_WQKV), nb * 64, scr, lane); return; } r -= 384;
#endif
        if (r < 256) { const int kb = r / 16, nb = r % 16;
#if MK_FP8_AOUT
            conv_tile8(a->in[I_WATO], 1024, 1024, kb * 64, nb * 64, (unsigned char*)(ws + WS_WATO), nb * 64, WH_SCALE, scr, lane); return; } r -= 256;
#else
            conv_tile(a->in[I_WATO], 1024, 1024, kb * 64, nb * 64, (bf16*)(ws + WS_WATO), nb * 64, scr, lane); return; } r -= 256;
#endif
        if (r < 1024) { const int kb = r / 64, nb = r % 64;
#if MK_FP8_CMIN
            conv_tile8(a->in[I_CMWIN], 1024, 4096, kb * 64, nb * 64, (unsigned char*)(ws + WS_WCMIN), nb * 64, WH_SCALE, scr, lane); return; } r -= 1024;
#elif MK_FP8_CMV
            if (nb >= 32) { conv_tile8(a->in[I_CMWIN], 1024, 4096, kb * 64, nb * 64, (unsigned char*)(ws + WS_WCMIN) + (size_t)2048 * 1024 * 2, (nb - 32) * 64, WH_SCALE, scr, lane); return; }
            conv_tile(a->in[I_CMWIN], 1024, 4096, kb * 64, nb * 64, (bf16*)(ws + WS_WCMIN), nb * 64, scr, lane); return; } r -= 1024;
#else
            conv_tile(a->in[I_CMWIN], 1024, 4096, kb * 64, nb * 64, (bf16*)(ws + WS_WCMIN), nb * 64, scr, lane); return; } r -= 1024;
#endif
        { const int kb = r / 16, nb = r % 16;
#if MK_FP8_CMOUT
            conv_tile8(a->in[I_CMWOUT], 2048, 1024, kb * 64, nb * 64, (unsigned char*)(ws + WS_WCMOUT), nb * 64, WH_SCALE, scr, lane); return; }
#else
            conv_tile(a->in[I_CMWOUT], 2048, 1024, kb * 64, nb * 64, (bf16*)(ws + WS_WCMOUT), nb * 64, scr, lane); return; }
#endif
    }
    const int r = it - CV_SMALL, mat = r / 512, q = r % 512, le = mat / 3, which = mat % 3;
    if (which < 2) { const int kb = MK_CV_ORDER ? (q >> 7) * 4 + (q & 3) : q / 32, nb = MK_CV_ORDER ? (q >> 2) & 31 : q % 32, n0 = nb * 64;
        const float* src = a->in[which == 0 ? I_WGATE : I_WUP] + (size_t)le * 1024 * 2048;
        conv_tile8(src, 1024, 2048, kb * 64, n0, (unsigned char*)(ws + WS_WGU) + (size_t)le * 4096 * 1024, (n0 >> 7) * 256 + (n0 & 127) + which * 128, WGU_SCALE, scr, lane); }
    else { const int kb = MK_CV_ORDER ? (q >> 6) * 4 + (q & 3) : q / 16, nb = MK_CV_ORDER ? (q >> 2) & 15 : q % 16;
#if MK_FP8_DN
        conv_tile8(a->in[I_WDOWN] + (size_t)le * 2048 * 1024, 2048, 1024, kb * 64, nb * 64, (unsigned char*)(ws + WS_WDN) + (size_t)le * 1024 * 2048, nb * 64, WDN_SCALE, scr, lane); }
#else
        conv_tile(a->in[I_WDOWN] + (size_t)le * 2048 * 1024, 2048, 1024, kb * 64, nb * 64, (bf16*)(ws + WS_WDN) + (size_t)le * 1024 * 2048, nb * 64, scr, lane); }
#endif
}
#if MK_FP8_DN
__device__ __forceinline__ Cv8 cv8_desc(ArgsP a, int it) {
    unsigned char* ws = a->ws;
    const int r = it - CV_SMALL, mat = r / 512, q = r % 512, le = mat / 3, which = mat % 3;
    Cv8 d;
    if (which < 2) { const int kb = MK_CV_ORDER ? (q >> 7) * 4 + (q & 3) : q / 32, nb = MK_CV_ORDER ? (q >> 2) & 31 : q % 32, n0 = nb * 64;
        d.src = a->in[which == 0 ? I_WGATE : I_WUP] + (size_t)le * 1024 * 2048 + (size_t)(kb * 64) * 2048 + n0; d.N = 2048; d.K = 1024; d.scale = WGU_SCALE;
        d.dst = (unsigned char*)(ws + WS_WGU) + (size_t)le * 4096 * 1024 + (size_t)((n0 >> 7) * 256 + (n0 & 127) + which * 128) * 1024 + kb * 64; }
    else { const int kb = MK_CV_ORDER ? (q >> 6) * 4 + (q & 3) : q / 16, nb = MK_CV_ORDER ? (q >> 2) & 15 : q % 16;
        d.src = a->in[I_WDOWN] + (size_t)le * 2048 * 1024 + (size_t)(kb * 64) * 1024 + nb * 64; d.N = 1024; d.K = 2048; d.scale = WDN_SCALE;
        d.dst = (unsigned char*)(ws + WS_WDN) + (size_t)le * 1024 * 2048 + (size_t)(nb * 64) * 2048 + kb * 64; }
    return d;
}
#endif
constexpr int CV_TOTAL = CV_SMALL + CV_MOE;
constexpr int BG_IDLE[7] = {208, 240, 128, 192, 104, 192, 192};
#ifndef MK_BG_TPW
#define MK_BG_TPW {4, 4, 2, 3, 3, 2, 2}
#endif
constexpr int BG_TPW[7] = MK_BG_TPW;
constexpr int bg_base(int w) { int s = 0; for (int i = 0; i < w; ++i) s += BG_IDLE[i] * 8 * BG_TPW[i]; return s; }
constexpr int CV_DEFER = bg_base(7);
static_assert(CV_DEFER <= 2 * 24576, "the deferred tiles must all belong to layers 2 and 3 (first needed by the layer-2 expert GEMMs; every window runs before that)");
template <int W> __device__ __forceinline__ void bg_convert(ArgsP a, const Fr& F, int rank) {
    if (F.G != 256 || rank < 0 || rank >= BG_IDLE[W]) return;
    LAS float* scr = (LAS float*)(F.lds + F.wave * 16640);
    constexpr int nw = BG_IDLE[W] * 8; const int widx = rank * 8 + F.wave;
#pragma unroll 1
    for (int k = 0; k < BG_TPW[W]; ++k) proA_conv_item(a, CV_TOTAL - CV_DEFER + bg_base(W) + k * nw + widx, scr, F.lane);
}
__device__ __forceinline__ void phase_proB(ArgsP a, const Fr& F);
__device__ __forceinline__ void phase_proA(ArgsP a, const Fr& F) {
    const int gt = F.vcu * NTHR + F.tid, NGT = F.G * NTHR;
    for (int k = gt; k < 8192; k += NGT) { float s, c; sincospif((float)k * (1.0f / 4096.0f), &s, &c); ((f32x2*)(a->ws + WS_TW))[k] = (f32x2){c, s}; }
    for (int k = gt; k < 16 * 128 * 128; k += NGT) ((bf16*)(a->ws + WS_WCMS))[k] = (bf16)f2bf(a->in[I_CMWS][k]);
    const int nbl = F.G >= 2 ? F.G / 2 : 1;
    if (F.vcu < nbl) { for (int it = F.vcu; it < 384 + 528; it += nbl) {
        if (it < 384) { proA_adaln_item(a, F, it);
#if MK_MERGE_PRO
            asm volatile("s_waitcnt vmcnt(0)" ::: "memory"); __syncthreads();
            if (F.tid == 0) (void)xb_add((unsigned*)(a->ws + WS_CTL) + 8256, 1u);
#endif
        } else proA_filter_item(a, F, it - 384); } }
    __syncthreads();
    LAS float* scr = (LAS float*)(F.lds + F.wave * 16640);
    unsigned* q = (unsigned*)(a->ws + WS_CTL) + 8192;
    const unsigned lim = (unsigned)(F.G == 256 ? CV_TOTAL - CV_DEFER : CV_TOTAL);
    for (;;) {
        unsigned i0 = 0u; if (F.lane == 0) i0 = __hip_atomic_fetch_add(q, (unsigned)MK_CV_CHUNK, __ATOMIC_RELAXED, __HIP_MEMORY_SCOPE_AGENT);
        i0 = (unsigned)__builtin_amdgcn_readfirstlane((int)i0);
        if (i0 >= lim) break;
#if MK_FP8_DN && MK_CV_PIPE
        if (MK_CV_CHUNK == 4 && i0 >= (unsigned)CV_SMALL && i0 + 4u <= lim) {
            float rv[64]; Cv8 dn = cv8_desc(a, (int)i0); conv8_load(dn, rv, F.lane);
#pragma unroll 1
            for (int k = 0; k < 4; ++k) { float cur[64]; const Cv8 dc = dn;
#pragma unroll
                for (int i = 0; i < 64; ++i) cur[i] = rv[i];
                if (k < 3) { dn = cv8_desc(a, (int)i0 + k + 1); conv8_load(dn, rv, F.lane); }
                conv8_store(dc, cur, scr, F.lane); }
            continue; }
#endif
        for (unsigned it = i0; it < i0 + (unsigned)MK_CV_CHUNK && it < lim; ++it) proA_conv_item(a, (int)it, scr, F.lane);
    }
#if MK_MERGE_PRO
    __syncthreads();
    if (F.tid == 0) { unsigned* ctl = (unsigned*)(a->ws + WS_CTL); XB_SPIN(xb_ld(ctl + 8256) < 384u, ctl + 4096); }
    __syncthreads();
    __builtin_amdgcn_fence(__ATOMIC_ACQUIRE, "agent");
    phase_proB(a, F);
#endif
}
__device__ __forceinline__ void phase_proB(ArgsP a, const Fr& F) {
    LAS float* m0 = (LAS float*)F.lds;
    const float* mp = (const float*)(a->ws + WS_MODP);
    for (int u = F.tid; u < 5 * 2048; u += NTHR) { const int r = u / 2048, c = u % 2048; float s = a->in[I_MODB][c];
        for (int ks = 0; ks < 8; ++ks) s += mp[(size_t)(ks * 5 + r) * 6144 + c];
        m0[u] = s; }
    __syncthreads();
    const int gw = F.vcu * NWAVES + F.wave, NGW = F.G * NWAVES;
    for (int row = gw; row < TA; row += NGW) {
        const int r = row < T ? (row >> 12) : 4;
        const float* src = row < T ? a->in[I_X] + (size_t)row * D : a->in[I_CTX] + (size_t)(row - T) * D;
        bf16* xl = (bf16*)(a->ws + WS_XC) + (size_t)row * D; const int hrow = row < T ? (row & ~4095) + ((row & 511) << 3) + ((row & 4095) >> 9) : row;
        bf16* hb = (bf16*)(a->ws + WS_HB) + (size_t)hrow * D;
#pragma unroll
        for (int j = 0; j < 4; ++j) { const int c = 4 * F.lane + 256 * j; const f32x4 v = *(const f32x4*)(src + c); { v2u xo; xo.x = pk2(v[0], v[1]); xo.y = pk2(v[2], v[3]); *(v2u*)(xl + c) = xo; }
            const f32x4 sh = *(const LAS f32x4*)(m0 + r * 2048 + c), sc = *(const LAS f32x4*)(m0 + r * 2048 + 1024 + c);
            const f32x4 h = v * (sc + 1.0f) + sh;
#if MK_FP8_HYIN
            *(unsigned*)((unsigned char*)(a->ws + WS_HB) + (size_t)hrow * D + c) = pk4_e4m3(h); }
#else
            v2u o; o.x = pk2(h[0], h[1]); o.y = pk2(h[2], h[3]); *(v2u*)(hb + c) = o; }
#endif
    }
    const int gt = F.vcu * NTHR + F.tid, NGT = F.G * NTHR;
    float* mod = (float*)(a->ws + WS_MOD);
    for (int u = gt; u < 4 * 5 * 6144; u += NGT) { const int i = u / 30720, r = (u / 6144) % 5, c = u % 6144; float s = a->in[I_MODB][i * 6144 + c];
        for (int ks = 0; ks < 8; ++ks) s += mp[(size_t)((i * 8 + ks) * 5 + r) * 6144 + c];
        mod[u] = s; }
}
template <int L>
__device__ __forceinline__ float sconv(const bf16* p, int t, float w0, float w1, float w2, float cb) {
    const float a = t > 0 ? bf2f(p[t - 1]) : 0.f, b = bf2f(p[t]), c = t < L - 1 ? bf2f(p[t + 1]) : 0.f; return w0 * a + w1 * b + w2 * c + cb;
}
template <int L>
__device__ __forceinline__ void hy_direct_item(ArgsP a, const Fr& F, int slot, int d, int tok0, const float* HF) {
    LAS float* kk = (LAS float*)F.lds;
    LAS float* vb = kk + 4 * L;
    LAS float* red = vb + 4 * L;
    const bf16* PT = (const bf16*)(a->ws + SC_PT);
    bf16* Z2T = (bf16*)(a->ws + SC_Z2T);
    __syncthreads();
    for (int o = 0; o < 2; ++o) {
        const float* fw = HF + (size_t)((o * 2 + 0) * 1024 + d) * L; const float* bw = HF + (size_t)((o * 2 + 1) * 1024 + d) * L;
        float s = 0.f;
        for (int t = F.tid; t < L; t += NTHR) { const float f = fw[t], b = bw[t]; kk[o * 2 * L + (L - 1) + t] = f; if (t >= 1) kk[o * 2 * L + (L - 1) - t] = b; s += fabsf(f) + (t >= 1 ? fabsf(b) : 0.f); }
        s = wave_sum(s); if (F.lane == 0) red[o * 8 + F.wave] = s;
    }
    __syncthreads();
    float nrm[2];
#pragma unroll
    for (int o = 0; o < 2; ++o) { float s = 0.f; for (int w = 0; w < 8; ++w) s += red[o * 8 + w]; nrm[o] = 1.0f / (s + 1e-6f); }
    const float* cw = a->in[I_HYCW] + (size_t)slot * 3 * 3072; const float* cbp = a->in[I_HYCB] + (size_t)slot * 3072;
    float w0[3], w1[3], w2[3], cb[3];
#pragma unroll
    for (int g = 0; g < 3; ++g) { const int c = g * 1024 + d; w0[g] = cw[c]; w1[g] = cw[3072 + c]; w2[g] = cw[2 * 3072 + c]; cb[g] = cbp[c]; }
    const float fb0 = a->in[I_FBIAS][(slot * 2 + 0) * 1024 + d], fb1 = a->in[I_FBIAS][(slot * 2 + 1) * 1024 + d];
    for (int u = F.tid; u < 4 * L; u += NTHR) { const int b = u / L, t = u % L; vb[u] = sconv<L>(PT + (size_t)d * TA + tok0 + b * L, t, w0[0], w1[0], w2[0], cb[0]); }
    __syncthreads();
    constexpr int NBLK = 4 * L / 8, PER = (NBLK + NTHR - 1) / NTHR;
    float res[PER][8];
#pragma unroll 1
    for (int o = 0; o < 2; ++o) {
        const LAS float* ko = kk + o * 2 * L;
#pragma unroll
        for (int pi = 0; pi < PER; ++pi) {
            const int q = F.tid + pi * NTHR;
            float acc[8];
#pragma unroll
            for (int j = 0; j < 8; ++j) acc[j] = 0.f;
            if (q < NBLK) {
                const int b = q / (L / 8), t0 = (q % (L / 8)) * 8;
                const LAS float* vv = vb + b * L;
#pragma unroll 1
                for (int s8 = 0; s8 < L; s8 += 8) {
                    const LAS float* kw = ko + (t0 - s8 - 7 + L - 1);
                    float w[15], x[8];
#pragma unroll
                    for (int i = 0; i < 15; ++i) w[i] = kw[i];
#pragma unroll
                    for (int i = 0; i < 8; ++i) x[i] = vv[s8 + i];
#pragma unroll
                    for (int j = 0; j < 8; ++j)
#pragma unroll
                        for (int i = 0; i < 8; ++i) acc[j] += w[j - i + 7] * x[i];
                }
            }
#pragma unroll
            for (int j = 0; j < 8; ++j) res[pi][j] = acc[j];
        }
        __syncthreads();
#pragma unroll
        for (int pi = 0; pi < PER; ++pi) {
            const int q = F.tid + pi * NTHR;
            if (q < NBLK) {
                const int b = q / (L / 8), t0 = (q % (L / 8)) * 8;
                const bf16* pg = PT + (size_t)((o + 1) * 1024 + d) * TA + tok0 + b * L;
#pragma unroll
                for (int j = 0; j < 8; ++j) { const int t = t0 + j; const float vin = vb[b * L + t];
                    const float y = res[pi][j] * nrm[o] + vin * (o == 0 ? fb0 : fb1);
                    const float xg = sconv<L>(pg, t, w0[o + 1], w1[o + 1], w2[o + 1], cb[o + 1]);
                    res[pi][j] = xg * y; }
            }
        }
        __syncthreads();
        if (o == 0) {
#pragma unroll
            for (int pi = 0; pi < PER; ++pi) { const int q = F.tid + pi * NTHR;
                if (q < NBLK) { const int b = q / (L / 8), t0 = (q % (L / 8)) * 8;
#pragma unroll
                    for (int j = 0; j < 8; ++j) vb[b * L + t0 + j] = res[pi][j]; } }
            __syncthreads();
        } else {
#pragma unroll
            for (int pi = 0; pi < PER; ++pi) { const int q = F.tid + pi * NTHR;
                if (q < NBLK) { const int b = q / (L / 8), t0 = (q % (L / 8)) * 8;
                    v4u ov; ov.x = pk2(res[pi][0], res[pi][1]); ov.y = pk2(res[pi][2], res[pi][3]); ov.z = pk2(res[pi][4], res[pi][5]); ov.w = pk2(res[pi][6], res[pi][7]);
                    *(v4u*)(Z2T + (size_t)d * TA + tok0 + b * L + t0) = ov; } }
        }
    }
}
__device__ __forceinline__ void hy_ctx_item(ArgsP a, const Fr& F, int slot, int d) {
    constexpr int L = LC;
    LAS float* kk = (LAS float*)F.lds;
    LAS float* vb = kk + 4 * L;
    LAS float* red = vb + 4 * L;
    LAS float* ps = red + 16;
    const bf16* PT = (const bf16*)(a->ws + SC_PT); bf16* Z2T = (bf16*)(a->ws + SC_Z2T);
    const float* HF = (const float*)(a->ws + WS_HF + HF_CTX); const int tok0 = T;
    __syncthreads();
    for (int o = 0; o < 2; ++o) {
        const float* fw = HF + (size_t)((o * 2 + 0) * 1024 + d) * L; const float* bw = HF + (size_t)((o * 2 + 1) * 1024 + d) * L;
        float s = 0.f;
        for (int t = F.tid; t < L; t += NTHR) { const float f = fw[t], b = bw[t]; kk[o * 2 * L + (L - 1) + t] = f; if (t >= 1) kk[o * 2 * L + (L - 1) - t] = b; s += fabsf(f) + (t >= 1 ? fabsf(b) : 0.f); }
        s = wave_sum(s); if (F.lane == 0) red[o * 8 + F.wave] = s;
    }
    __syncthreads();
    float nrm[2];
#pragma unroll
    for (int o = 0; o < 2; ++o) { float s = 0.f; for (int w = 0; w < 8; ++w) s += red[o * 8 + w]; nrm[o] = 1.0f / (s + 1e-6f); }
    const float* cw = a->in[I_HYCW] + (size_t)slot * 3 * 3072; const float* cbp = a->in[I_HYCB] + (size_t)slot * 3072;
    float w0[3], w1[3], w2[3], cb[3];
#pragma unroll
    for (int g = 0; g < 3; ++g) { const int c = g * 1024 + d; w0[g] = cw[c]; w1[g] = cw[3072 + c]; w2[g] = cw[2 * 3072 + c]; cb[g] = cbp[c]; }
    const float fb0 = a->in[I_FBIAS][(slot * 2 + 0) * 1024 + d], fb1 = a->in[I_FBIAS][(slot * 2 + 1) * 1024 + d];
    for (int u = F.tid; u < 4 * L; u += NTHR) { const int b = u / L, t = u % L; vb[u] = sconv<L>(PT + (size_t)d * TA + tok0 + b * L, t, w0[0], w1[0], w2[0], cb[0]); }
    __syncthreads();
    const int sq = F.tid >> 7, q = F.tid & 127, b = q >> 5, t0 = (q & 31) * 8;
#pragma unroll 1
    for (int o = 0; o < 2; ++o) {
        const LAS float* ko = kk + o * 2 * L; const LAS float* vv = vb + b * L;
        float acc[8];
#pragma unroll
        for (int j = 0; j < 8; ++j) acc[j] = 0.f;
#pragma unroll 1
        for (int s8 = sq * 64; s8 < sq * 64 + 64; s8 += 8) {
            const LAS float* kw = ko + (t0 - s8 - 7 + L - 1);
            float w[15], x[8];
#pragma unroll
            for (int i = 0; i < 15; ++i) w[i] = kw[i];
#pragma unroll
            for (int i = 0; i < 8; ++i) x[i] = vv[s8 + i];
#pragma unroll
            for (int j = 0; j < 8; ++j)
#pragma unroll
                for (int i = 0; i < 8; ++i) acc[j] += w[j - i + 7] * x[i];
        }
#pragma unroll
        for (int j = 0; j < 8; ++j) ps[(sq * 128 + q) * 8 + j] = acc[j];
        __syncthreads();
        float res[8];
        if (F.tid < 128) {
            const bf16* pg = PT + (size_t)((o + 1) * 1024 + d) * TA + tok0 + b * L;
#pragma unroll
            for (int j = 0; j < 8; ++j) { const float cv = ((ps[q * 8 + j] + ps[(128 + q) * 8 + j]) + ps[(256 + q) * 8 + j]) + ps[(384 + q) * 8 + j];
                const int t = t0 + j; const float vin = vb[b * L + t];
                const float y = cv * nrm[o] + vin * (o == 0 ? fb0 : fb1);
                res[j] = sconv<L>(pg, t, w0[o + 1], w1[o + 1], w2[o + 1], cb[o + 1]) * y; }
        }
        __syncthreads();
        if (F.tid < 128) {
            if (o == 0) {
#pragma unroll
                for (int j = 0; j < 8; ++j) vb[b * L + t0 + j] = res[j]; }
            else { v4u ov; ov.x = pk2(res[0], res[1]); ov.y = pk2(res[2], res[3]); ov.z = pk2(res[4], res[5]); ov.w = pk2(res[6], res[7]);
                *(v4u*)(Z2T + (size_t)d * TA + tok0 + b * L + t0) = ov; }
        }
        __syncthreads();
    }
}
__device__ __forceinline__ void phase_hy_tr(ArgsP a, const Fr& F, int ntok) {
    LAS unsigned short* tile = (LAS unsigned short*)(F.lds + F.wave * 9216);
    const bf16* Z2T = (const bf16*)(a->ws + SC_Z2T); bf16* Z2 = (bf16*)(a->ws + SC_Z2);
    const int gw = F.vcu * NWAVES + F.wave, NGW = F.G * NWAVES, ntt = ntok / 64;
    for (int it = gw; it < 16 * ntt; it += NGW) {
        const int c0 = (it / ntt) * 64, t0 = (it % ntt) * 64;
#pragma unroll
        for (int i = 0; i < 8; ++i) { const int ch = i * 8 + (F.lane >> 3), ck = F.lane & 7;
            const v4u v = *(const v4u*)(Z2T + (size_t)(c0 + ch) * TA + t0 + ck * 8); *(LAS v4u*)(tile + ch * 72 + ck * 8) = v; }
        LDS_WAIT(); asm volatile("" ::: "memory");
        int trow = t0 + F.lane;
        if (trow < T) { const int pi = trow & 4095; trow = (trow & ~4095) + (pi >> 3) + 512 * (pi & 7); }
        bf16* dst = Z2 + (size_t)trow * D + c0;
#pragma unroll
        for (int q = 0; q < 8; ++q) { unsigned w[4];
#pragma unroll
            for (int j = 0; j < 4; ++j) { const unsigned lo = tile[(q * 8 + 2 * j) * 72 + F.lane], hi = tile[(q * 8 + 2 * j + 1) * 72 + F.lane]; w[j] = lo | (hi << 16); }
#if MK_FP8_HYOUT
            v2u o8; o8.x = pk4_e4m3((f32x4){__builtin_bit_cast(float, w[0] << 16), __builtin_bit_cast(float, w[0] & 0xffff0000u), __builtin_bit_cast(float, w[1] << 16), __builtin_bit_cast(float, w[1] & 0xffff0000u)} * Z_SCALE);
            o8.y = pk4_e4m3((f32x4){__builtin_bit_cast(float, w[2] << 16), __builtin_bit_cast(float, w[2] & 0xffff0000u), __builtin_bit_cast(float, w[3] << 16), __builtin_bit_cast(float, w[3] & 0xffff0000u)} * Z_SCALE);
            *(v2u*)((unsigned char*)Z2 + (size_t)trow * D + c0 + q * 8) = o8; }
#else
            v4u o; o.x = w[0]; o.y = w[1]; o.z = w[2]; o.w = w[3]; *(v4u*)(dst + q * 8) = o; }
#endif
        LDS_WAIT(); asm volatile("" ::: "memory");
    }
}
__device__ __forceinline__ void phase_hy_conv_direct(ArgsP a, const Fr& F, int layer) {
    const int slot = layer == 0 ? 0 : 1; const int nitems = layer == 0 ? 2048 : 1024;
    for (int it = F.vcu; it < nitems; it += F.G) {
        if (it < 1024) hy_direct_item<SEQ>(a, F, slot, it, 0, (const float*)(a->ws + WS_HF + (size_t)slot * HF_SLOT));
        else hy_direct_item<LC>(a, F, slot, it - 1024, T, (const float*)(a->ws + WS_HF + HF_CTX));
    }
}

__device__ __forceinline__ void lnr_softmax_store(const float (&part)[16], int lane, float* affrow) {
    const bool h5 = (lane & 32) != 0, h4 = (lane & 16) != 0, h3 = (lane & 8) != 0, h2 = (lane & 4) != 0;
    float q8[8], q4[4], q2[2];
#pragma unroll
    for (int k = 0; k < 8; ++k) { const float keep = h5 ? part[8 + k] : part[k], send = h5 ? part[k] : part[8 + k]; q8[k] = keep + __shfl_xor(send, 32); }
#pragma unroll
    for (int k = 0; k < 4; ++k) { const float keep = h4 ? q8[4 + k] : q8[k], send = h4 ? q8[k] : q8[4 + k]; q4[k] = keep + __shfl_xor(send, 16); }
#pragma unroll
    for (int k = 0; k < 2; ++k) { const float keep = h3 ? q4[2 + k] : q4[k], send = h3 ? q4[k] : q4[2 + k]; q2[k] = keep + __shfl_xor(send, 8); }
    float lg; { const float keep = h2 ? q2[1] : q2[0], send = h2 ? q2[0] : q2[1]; lg = keep + __shfl_xor(send, 4); }
    lg += __shfl_xor(lg, 1); lg += __shfl_xor(lg, 2);
    float mx = lg;
#pragma unroll
    for (int o = 4; o < 64; o <<= 1) mx = fmaxf(mx, __shfl_xor(mx, o));
    const float ex = expf(lg - mx); float den = ex;
#pragma unroll
    for (int o = 4; o < 64; o <<= 1) den += __shfl_xor(den, o);
    const int eidx = (h5 ? 8 : 0) + (h4 ? 4 : 0) + (h3 ? 2 : 0) + (h2 ? 1 : 0);
    if ((lane & 3) == 0) affrow[eidx] = ex / den;
}
__device__ __forceinline__ void phase_lnr2(ArgsP a, const Fr& F, int layer, int nrows) {
    LAS float* wr = (LAS float*)F.lds;
    __syncthreads();
    for (int u = F.tid; u < 1024 * 16; u += NTHR) wr[u] = a->in[I_ROUTER][(size_t)layer * 1024 * 16 + (u & 1023) * 16 + (u >> 10)];
    __syncthreads();
    const bf16* U = (const bf16*)(a->ws + WS_U); f32x2* ST = (f32x2*)(a->ws + WS_XL); unsigned char* HB8 = (unsigned char*)(a->ws + WS_HB); float* AFF = (float*)(a->ws + WS_AFF);
    const float* mod = (const float*)(a->ws + WS_MOD) + (size_t)layer * 5 * 6144;
    const float* lg = a->in[I_LNG] + (size_t)(layer * 2 + 0) * D; const float* lb = a->in[I_LNB] + (size_t)(layer * 2 + 0) * D;
    const int gw = F.vcu * NWAVES + F.wave, NGW = F.G * NWAVES, npair = nrows >> 1;
    v2u vn[2][4];
    if (gw < npair) {
#pragma unroll
        for (int q = 0; q < 2; ++q)
#pragma unroll
            for (int j = 0; j < 4; ++j) vn[q][j] = *(const v2u*)(U + (size_t)(2 * gw + q) * D + 4 * F.lane + 256 * j); }
    for (int pi = gw; pi < npair; pi += NGW) {
        int lane = F.lane; asm volatile("" : "+v"(lane));
        const int row = 2 * pi; const int r = row < T ? (row >> 12) : 4;
        f32x4 v[2][4]; float s[2] = {0.f, 0.f};
#pragma unroll
        for (int q = 0; q < 2; ++q)
#pragma unroll
            for (int j = 0; j < 4; ++j) { v[q][j] = up4(vn[q][j]); s[q] += (v[q][j][0] + v[q][j][1]) + (v[q][j][2] + v[q][j][3]); }
        if (pi + NGW < npair) {
#pragma unroll
            for (int q = 0; q < 2; ++q)
#pragma unroll
                for (int j = 0; j < 4; ++j) vn[q][j] = *(const v2u*)(U + (size_t)(2 * (pi + NGW) + q) * D + 4 * lane + 256 * j); }
        float rstd[2];
#pragma unroll
        for (int q = 0; q < 2; ++q) { const float mean = wave_sum(s[q]) * (1.0f / D); float s2 = 0.f;
#pragma unroll
            for (int j = 0; j < 4; ++j) { v[q][j] = v[q][j] - mean; s2 += (v[q][j][0] * v[q][j][0] + v[q][j][1] * v[q][j][1]) + (v[q][j][2] * v[q][j][2] + v[q][j][3] * v[q][j][3]); }
            rstd[q] = 1.0f / sqrtf(wave_sum(s2) * (1.0f / D) + LN_EPS);
            if (lane == 0) ST[row + q] = (f32x2){mean, rstd[q]}; }
        float pa[16], pb[16];
#pragma unroll
        for (int e = 0; e < 16; ++e) { pa[e] = 0.f; pb[e] = 0.f; }
#pragma unroll 1
        for (int j = 0; j < 4; ++j) { const int c = 4 * lane + 256 * j;
            const f32x4 g4 = *(const f32x4*)(lg + c), b4 = *(const f32x4*)(lb + c), sc = *(const f32x4*)(mod + r * 6144 + 4096 + c) + 1.0f, sh = *(const f32x4*)(mod + r * 6144 + 3072 + c);
            f32x4 vA, vB;
            switch (j) { case 0: vA = v[0][0]; vB = v[1][0]; break; case 1: vA = v[0][1]; vB = v[1][1]; break; case 2: vA = v[0][2]; vB = v[1][2]; break; default: vA = v[0][3]; vB = v[1][3]; break; }
            const f32x4 hA = (vA * rstd[0] * g4 + b4) * sc + sh, hB = (vB * rstd[1] * g4 + b4) * sc + sh;
            { unsigned o8 = 0u; o8 = __builtin_amdgcn_cvt_pk_fp8_f32(__builtin_amdgcn_fmed3f(hA[0], -448.0f, 448.0f), __builtin_amdgcn_fmed3f(hA[1], -448.0f, 448.0f), o8, false);
              o8 = __builtin_amdgcn_cvt_pk_fp8_f32(__builtin_amdgcn_fmed3f(hA[2], -448.0f, 448.0f), __builtin_amdgcn_fmed3f(hA[3], -448.0f, 448.0f), o8, true); *(unsigned*)(HB8 + (size_t)row * D + c) = o8; }
            { unsigned o8 = 0u; o8 = __builtin_amdgcn_cvt_pk_fp8_f32(__builtin_amdgcn_fmed3f(hB[0], -448.0f, 448.0f), __builtin_amdgcn_fmed3f(hB[1], -448.0f, 448.0f), o8, false);
              o8 = __builtin_amdgcn_cvt_pk_fp8_f32(__builtin_amdgcn_fmed3f(hB[2], -448.0f, 448.0f), __builtin_amdgcn_fmed3f(hB[3], -448.0f, 448.0f), o8, true); *(unsigned*)(HB8 + (size_t)(row + 1) * D + c) = o8; }
#pragma unroll
            for (int e = 0; e < 16; ++e) { const f32x4 w = *(const LAS f32x4*)(wr + e * 1024 + c);
                pa[e] += (hA[0] * w[0] + hA[1] * w[1]) + (hA[2] * w[2] + hA[3] * w[3]);
                pb[e] += (hB[0] * w[0] + hB[1] * w[1]) + (hB[2] * w[2] + hB[3] * w[3]); }
            asm volatile("" ::: "memory"); }
        lnr_softmax_store(pa, lane, AFF + (size_t)row * 16);
        lnr_softmax_store(pb, lane, AFF + (size_t)(row + 1) * 16);
    }
}
__device__ __forceinline__ void phase_lnr(ArgsP a, const Fr& F, int layer, int nrows) {
    LAS float* wr = (LAS float*)F.lds;
    __syncthreads();
    for (int u = F.tid; u < 1024 * 16; u += NTHR) { const int p = u & 1023; const int col = MK_LNR_WIDE ? 8 * ((p & 255) >> 2) + 512 * (p >> 9) + 4 * ((p >> 8) & 1) + (p & 3) : p;
        wr[u] = a->in[I_ROUTER][(size_t)layer * 1024 * 16 + col * 16 + (u >> 10)]; }
    __syncthreads();
    const bf16* U = (const bf16*)(a->ws + WS_U); f32x2* ST = (f32x2*)(a->ws + WS_XL); unsigned char* HB8 = (unsigned char*)(a->ws + WS_HB); float* AFF = (float*)(a->ws + WS_AFF);
    const float* mod = (const float*)(a->ws + WS_MOD) + (size_t)layer * 5 * 6144;
    const float* lg = a->in[I_LNG] + (size_t)(layer * 2 + 0) * D; const float* lb = a->in[I_LNB] + (size_t)(layer * 2 + 0) * D;
    const int gw = F.vcu * NWAVES + F.wave, NGW = F.G * NWAVES;
    f32x4 wreg[MK_LNR_WREG > 0 ? MK_LNR_WREG : 1][4];
#pragma unroll
    for (int e = 0; e < MK_LNR_WREG; ++e)
#pragma unroll
        for (int j = 0; j < 4; ++j) wreg[e][j] = *(const LAS f32x4*)(wr + e * 1024 + 4 * F.lane + 256 * j);
#if MK_LNR_WIDE
    v4u vw[2];
    if (gw < nrows) {
#pragma unroll
        for (int jj = 0; jj < 2; ++jj) vw[jj] = *(const v4u*)(U + (size_t)gw * D + 8 * F.lane + 512 * jj); }
#else
    v2u vn[4];
    if (gw < nrows) {
#pragma unroll
        for (int j = 0; j < 4; ++j) vn[j] = *(const v2u*)(U + (size_t)gw * D + 4 * F.lane + 256 * j); }
#endif
    for (int row = gw; row < nrows; row += NGW) {
        const int r = row < T ? (row >> 12) : 4;
        f32x4 v[4]; float s = 0.f;
#pragma unroll
#if MK_LNR_WIDE
        for (int j = 0; j < 4; ++j) { v2u hf; hf.x = (j & 1) ? vw[j >> 1].z : vw[j >> 1].x; hf.y = (j & 1) ? vw[j >> 1].w : vw[j >> 1].y; v[j] = up4(hf); s += (v[j][0] + v[j][1]) + (v[j][2] + v[j][3]); }
        if (row + NGW < nrows) {
#pragma unroll
            for (int jj = 0; jj < 2; ++jj) vw[jj] = *(const v4u*)(U + (size_t)(row + NGW) * D + 8 * F.lane + 512 * jj); }
#else
        for (int j = 0; j < 4; ++j) { v[j] = up4(vn[j]); s += (v[j][0] + v[j][1]) + (v[j][2] + v[j][3]); }
        if (row + NGW < nrows) {
#pragma unroll
            for (int j = 0; j < 4; ++j) vn[j] = *(const v2u*)(U + (size_t)(row + NGW) * D + 4 * F.lane + 256 * j); }
#endif
        const float mean = wave_sum(s) * (1.0f / D); float s2 = 0.f;
#pragma unroll
        for (int j = 0; j < 4; ++j) { v[j] = v[j] - mean; s2 += (v[j][0] * v[j][0] + v[j][1] * v[j][1]) + (v[j][2] * v[j][2] + v[j][3] * v[j][3]); }
        const float rstd = 1.0f / sqrtf(wave_sum(s2) * (1.0f / D) + LN_EPS);
        if (F.lane == 0) ST[row] = (f32x2){mean, rstd};
        float part[16];
#pragma unroll
        for (int e = 0; e < 16; ++e) part[e] = 0.f;
        unsigned o8prev = 0u; (void)o8prev;
#pragma unroll
        for (int j = 0; j < 4; ++j) { const int cl = 4 * F.lane + 256 * j;
            const int c = MK_LNR_WIDE ? 8 * F.lane + 512 * (j >> 1) + 4 * (j & 1) : cl;
            const f32x4 x = v[j] * rstd * *(const f32x4*)(lg + c) + *(const f32x4*)(lb + c);
            const f32x4 h = x * (*(const f32x4*)(mod + r * 6144 + 4096 + c) + 1.0f) + *(const f32x4*)(mod + r * 6144 + 3072 + c);
            { unsigned o8 = 0u; const f32x4 hc = {__builtin_amdgcn_fmed3f(h[0], -448.0f, 448.0f), __builtin_amdgcn_fmed3f(h[1], -448.0f, 448.0f), __builtin_amdgcn_fmed3f(h[2], -448.0f, 448.0f), __builtin_amdgcn_fmed3f(h[3], -448.0f, 448.0f)};
              o8 = __builtin_amdgcn_cvt_pk_fp8_f32(hc[0], hc[1], o8, false); o8 = __builtin_amdgcn_cvt_pk_fp8_f32(hc[2], hc[3], o8, true);
              if (MK_LNR_WIDE) { if (j & 1) { v2u o2; o2.x = o8prev; o2.y = o8; *(v2u*)(HB8 + (size_t)row * D + c - 4) = o2; } else o8prev = o8; }
              else *(unsigned*)(HB8 + (size_t)row * D + c) = o8; }
#pragma unroll
            for (int e = 0; e < 16; ++e) { const f32x4 w = e < MK_LNR_WREG ? wreg[e < MK_LNR_WREG ? e : 0][j] : *(const LAS f32x4*)(wr + e * 1024 + cl);
                part[e] += (h[0] * w[0] + h[1] * w[1]) + (h[2] * w[2] + h[3] * w[3]); }
            asm volatile("" ::: "memory"); }
        const bool h5 = (F.lane & 32) != 0, h4 = (F.lane & 16) != 0, h3 = (F.lane & 8) != 0, h2 = (F.lane & 4) != 0;
        float q8[8], q4[4], q2[2];
#pragma unroll
        for (int k = 0; k < 8; ++k) { const float keep = h5 ? part[8 + k] : part[k], send = h5 ? part[k] : part[8 + k]; q8[k] = keep + __shfl_xor(send, 32); }
#pragma unroll
        for (int k = 0; k < 4; ++k) { const float keep = h4 ? q8[4 + k] : q8[k], send = h4 ? q8[k] : q8[4 + k]; q4[k] = keep + __shfl_xor(send, 16); }
#pragma unroll
        for (int k = 0; k < 2; ++k) { const float keep = h3 ? q4[2 + k] : q4[k], send = h3 ? q4[k] : q4[2 + k]; q2[k] = keep + __shfl_xor(send, 8); }
        float lg; { const float keep = h2 ? q2[1] : q2[0], send = h2 ? q2[0] : q2[1]; lg = keep + __shfl_xor(send, 4); }
        lg += __shfl_xor(lg, 1); lg += __shfl_xor(lg, 2);
        float mx = lg;
#pragma unroll
        for (int o = 4; o < 64; o <<= 1) mx = fmaxf(mx, __shfl_xor(mx, o));
        const float ex = expf(lg - mx); float den = ex;
#pragma unroll
        for (int o = 4; o < 64; o <<= 1) den += __shfl_xor(den, o);
        const int eidx = (h5 ? 8 : 0) + (h4 ? 4 : 0) + (h3 ? 2 : 0) + (h2 ? 1 : 0);
        if ((F.lane & 3) == 0) AFF[(size_t)row * 16 + eidx] = ex / den;
    }
}

template <int N, int CAPN>
__device__ __forceinline__ void topk_item(ArgsP a, const Fr& F, int b, int e, int rowbase, int slotbase, bool pad) {
    LAS unsigned* hist = (LAS unsigned*)F.lds;
    LAS unsigned* sel = hist + 256;
    LAS unsigned* wtot = hist + 264;
    const float* AFF = (const float*)(a->ws + WS_AFF); int* ROWS = (int*)(a->ws + WS_ROWS); float* GATE = (float*)(a->ws + WS_GATE); int* INV = (int*)(a->ws + WS_INV);
    const int tid = F.tid, lane = F.lane; const bool act = tid * 8 < N;
    unsigned key[8];
#pragma unroll
    for (int j = 0; j < 8; ++j) key[j] = act ? __float_as_uint(AFF[(size_t)(rowbase + tid * 8 + j) * 16 + e]) : 0u;
    unsigned prefix = 0u, need = CAPN;
#pragma unroll 1
    for (int pass = 0; pass < 4; ++pass) {
        const int shift = 24 - 8 * pass; const unsigned himask = pass == 0 ? 0u : (0xFFFFFFFFu << (shift + 8));
        __syncthreads();
        if (tid < 256) hist[tid] = 0u;
        __syncthreads();
        if (act) {
#pragma unroll
            for (int j = 0; j < 8; ++j) if ((key[j] & himask) == prefix) __hip_atomic_fetch_add(&hist[(key[j] >> shift) & 255u], 1u, __ATOMIC_RELAXED, __HIP_MEMORY_SCOPE_WORKGROUP);
        }
        __syncthreads();
        if (tid < 64) {
            const unsigned v0 = hist[4 * lane], v1 = hist[4 * lane + 1], v2 = hist[4 * lane + 2], v3 = hist[4 * lane + 3]; const unsigned tot = v0 + v1 + v2 + v3;
            unsigned x = tot;
#pragma unroll
            for (int o = 1; o < 64; o <<= 1) { const unsigned t = __shfl_down(x, o); if (lane + o < 64) x += t; }
            const unsigned a3 = x - tot, a2 = a3 + v3, a1 = a2 + v2, a0 = a1 + v1;
            if (a3 < need && need <= a3 + v3) { sel[0] = 4 * lane + 3; sel[1] = a3; }
            if (a2 < need && need <= a2 + v2) { sel[0] = 4 * lane + 2; sel[1] = a2; }
            if (a1 < need && need <= a1 + v1) { sel[0] = 4 * lane + 1; sel[1] = a1; }
            if (a0 < need && need <= a0 + v0) { sel[0] = 4 * lane + 0; sel[1] = a0; }
        }
        __syncthreads();
        prefix |= sel[0] << shift; need -= sel[1];
    }
    const unsigned tau = prefix;
    unsigned ceq = 0u;
#pragma unroll
    for (int j = 0; j < 8; ++j) ceq += (act && key[j] == tau) ? 1u : 0u;
    unsigned xe = ceq;
#pragma unroll
    for (int o = 1; o < 64; o <<= 1) { const unsigned t = __shfl_up(xe, o); if (lane >= o) xe += t; }
    __syncthreads();
    if (lane == 63) wtot[F.wave * 2] = xe;
    __syncthreads();
    unsigned eqbase = xe - ceq; for (int w = 0; w < F.wave; ++w) eqbase += wtot[w * 2];
    unsigned flags = 0u, csel = 0u;
#pragma unroll
    for (int j = 0; j < 8; ++j) { bool s = false; if (act) { if (key[j] > tau) s = true; else if (key[j] == tau) { s = eqbase < need; ++eqbase; } } if (s) { flags |= 1u << j; ++csel; } }
    unsigned xs = csel;
#pragma unroll
    for (int o = 1; o < 64; o <<= 1) { const unsigned t = __shfl_up(xs, o); if (lane >= o) xs += t; }
    if (lane == 63) wtot[F.wave * 2 + 1] = xs;
    __syncthreads();
    unsigned pos = xs - csel; for (int w = 0; w < F.wave; ++w) pos += wtot[w * 2 + 1];
    if (act) {
#pragma unroll
        for (int j = 0; j < 8; ++j) { const int row = rowbase + tid * 8 + j; int slot = -1;
            if (flags & (1u << j)) { slot = e * ESTR + slotbase + (int)pos; ++pos; ROWS[slot] = row; GATE[slot] = __uint_as_float(key[j]); }
            INV[(size_t)row * 16 + e] = slot; }
    }
    if (pad) for (int p = tid; p < 128; p += NTHR) { ROWS[e * ESTR + 2176 + p] = 0; GATE[e * ESTR + 2176 + p] = 0.f; }
}
__device__ __forceinline__ void phase_topk(ArgsP a, const Fr& F, int layer) {
    const int nitems = layer == 0 ? 128 : 64;
    for (int it = F.vcu; it < nitems; it += F.G) {
        if (it < 64) { const int b = it >> 4, e = it & 15; topk_item<SEQ, 512>(a, F, b, e, b * SEQ, b * 512, false); }
        else { const int b = (it - 64) >> 4, e = it & 15; topk_item<LC, 32>(a, F, b, e, T + b * LC, 2048 + b * 32, b == 0); }
    }
}
__device__ __forceinline__ void phase_gather(ArgsP a, const Fr& F, int layer) {
    const int me = layer == 0 ? 2304 : 2048;
    const int* ROWS = (const int*)(a->ws + WS_ROWS); const bf16* HB = (const bf16*)(a->ws + WS_HB); bf16* XG = (bf16*)(a->ws + WS_XG);
    const int gw = F.vcu * NWAVES + F.wave, NGW = F.G * NWAVES;
    for (int it = gw; it < 16 * me; it += NGW) { const int e = it / me, s = it % me, dr = e * ESTR + s; const int sr = ROWS[dr];
        const v4u* src = (const v4u*)(HB + (size_t)sr * D); v4u* dst = (v4u*)(XG + (size_t)dr * D);
        dst[F.lane] = src[F.lane]; dst[64 + F.lane] = src[64 + F.lane]; }
}
#if MK_FP8_Y
typedef unsigned comb_y_t;
#define COMB_YLOAD(p, off) (*(const unsigned*)((const unsigned char*)(p) + (off)))
#define COMB_YS (1.0f / Y_SCALE)
#define COMB_YROW(s) ((const bf16*)((const unsigned char*)Y + (size_t)(s) * D))
__device__ __forceinline__ f32x4 comb_y_up(unsigned w) { const auto lo = __builtin_amdgcn_cvt_pk_f32_fp8(w, false), hi = __builtin_amdgcn_cvt_pk_f32_fp8(w, true); return (f32x4){lo[0], lo[1], hi[0], hi[1]}; }
#else
typedef v2u comb_y_t;
#define COMB_YLOAD(p, off) (*(const v2u*)((p) + (off)))
#define COMB_YS 1.0f
#define COMB_YROW(s) (Y + (size_t)(s) * D)
__device__ __forceinline__ f32x4 comb_y_up(v2u w) { return up4(w); }
#endif
#if MK_COMB_WIDE && MK_FP8_Y && !MK_FP8_CMV
__device__ __forceinline__ void phase_comb(ArgsP a, const Fr& F, int layer, int nrows) {
    const unsigned char* Y = (const unsigned char*)(a->ws + WS_Y); const bf16* XL = (const bf16*)(a->ws + WS_U); const f32x2* ST = (const f32x2*)(a->ws + WS_XL); bf16* XC = (bf16*)(a->ws + WS_XC); bf16* HB = (bf16*)(a->ws + WS_HB); const int* INV = (const int*)(a->ws + WS_INV);
    const float* lg1 = a->in[I_LNG] + (size_t)(layer * 2 + 0) * D; const float* lb1 = a->in[I_LNB] + (size_t)(layer * 2 + 0) * D;
    const float* mod = (const float*)(a->ws + WS_MOD) + (size_t)layer * 5 * 6144;
    const float* modn = (const float*)(a->ws + WS_MOD) + (size_t)(layer < 3 ? layer + 1 : 3) * 5 * 6144;
    const float* lg = a->in[I_LNG] + (size_t)(layer * 2 + 1) * D; const float* lb = a->in[I_LNB] + (size_t)(layer * 2 + 1) * D;
    const int gw = F.vcu * NWAVES + F.wave, NGW = F.G * NWAVES;
#define COMB_ISSUE(inv_, row_, sl_, rest_, yv_, xl_, st_) do { unsigned mk_ = (unsigned)(__ballot((inv_) >= 0) & 0xFFFFull); \
        _Pragma("unroll") for (int q = 0; q < 4; ++q) { if (mk_) { const int e_ = __builtin_ctz(mk_); mk_ &= mk_ - 1; sl_[q] = __shfl((inv_), e_); } else sl_[q] = -1; } \
        rest_ = mk_; \
        _Pragma("unroll") for (int q = 0; q < 4; ++q) if (sl_[q] >= 0) { const unsigned char* yp_ = Y + (size_t)sl_[q] * D; _Pragma("unroll") for (int jj = 0; jj < 2; ++jj) yv_[q][jj] = *(const v2u*)(yp_ + 8 * F.lane + 512 * jj); } \
        _Pragma("unroll") for (int jj = 0; jj < 2; ++jj) xl_[jj] = *(const v4u*)(XL + (size_t)(row_) * D + 8 * F.lane + 512 * jj); st_ = ST[(row_)]; } while (0)
    int inv_c = gw < nrows ? INV[(size_t)gw * 16 + (F.lane & 15)] : -1;
    int inv_n = gw + NGW < nrows ? INV[(size_t)(gw + NGW) * 16 + (F.lane & 15)] : -1;
    int sl_c[4] = {-1, -1, -1, -1}; unsigned rest_c = 0u; v2u yv_c[4][2]; v4u xl_c[2]; f32x2 st_c = {0.f, 1.f};
    if (gw < nrows) COMB_ISSUE(inv_c, gw, sl_c, rest_c, yv_c, xl_c, st_c);
    for (int row = gw; row < nrows; row += NGW) {
        const int r = row < T ? (row >> 12) : 4;
        const int hrow = (layer == 2 && row < T) ? (row & ~4095) + ((row & 511) << 3) + ((row & 4095) >> 9) : row;
        const int myinv = inv_c;
        int sl_n[4] = {-1, -1, -1, -1}; unsigned rest_n = 0u; v2u yv_n[4][2]; v4u xl_n[2]; f32x2 st_n = {0.f, 1.f};
        const bool has_n = row + NGW < nrows;
        if (has_n) COMB_ISSUE(inv_n, row + NGW, sl_n, rest_n, yv_n, xl_n, st_n);
        const int inv_nn = (row + 2 * NGW < nrows) ? INV[(size_t)(row + 2 * NGW) * 16 + (F.lane & 15)] : -1;
        f32x4 m[4];
#pragma unroll
        for (int k = 0; k < 4; ++k) m[k] = (f32x4){0.f, 0.f, 0.f, 0.f};
#pragma unroll
        for (int q = 0; q < 4; ++q) if (sl_c[q] >= 0) {
#pragma unroll
            for (int jj = 0; jj < 2; ++jj) { m[2 * jj] += comb_y_up(yv_c[q][jj].x); m[2 * jj + 1] += comb_y_up(yv_c[q][jj].y); } }
        unsigned msk = rest_c;
        while (msk) { const int e = __builtin_ctz(msk); msk &= msk - 1; const int slot = __shfl(myinv, e); const unsigned char* yp = Y + (size_t)slot * D;
#pragma unroll
            for (int jj = 0; jj < 2; ++jj) { const v2u w = *(const v2u*)(yp + 8 * F.lane + 512 * jj); m[2 * jj] += comb_y_up(w.x); m[2 * jj + 1] += comb_y_up(w.y); } }
        f32x4 xc[4];
#pragma unroll
        for (int k = 0; k < 4; ++k) { const int c = 8 * F.lane + 512 * (k >> 1) + 4 * (k & 1); const v4u xw = xl_c[k >> 1]; v2u half; half.x = (k & 1) ? xw.z : xw.x; half.y = (k & 1) ? xw.w : xw.y;
            xc[k] = (up4(half) - st_c.x) * st_c.y * *(const f32x4*)(lg1 + c) + *(const f32x4*)(lb1 + c); }
        inv_c = inv_n; inv_n = inv_nn; rest_c = rest_n; st_c = st_n;
#pragma unroll
        for (int q = 0; q < 4; ++q) { sl_c[q] = sl_n[q];
#pragma unroll
            for (int jj = 0; jj < 2; ++jj) yv_c[q][jj] = yv_n[q][jj]; }
#pragma unroll
        for (int jj = 0; jj < 2; ++jj) xl_c[jj] = xl_n[jj];
        f32x4 v[4]; float s = 0.f;
#pragma unroll
        for (int k = 0; k < 4; ++k) { const int c = 8 * F.lane + 512 * (k >> 1) + 4 * (k & 1);
            v[k] = xc[k] * ALPHA + *(const f32x4*)(mod + r * 6144 + 5120 + c) * (m[k] * COMB_YS); s += (v[k][0] + v[k][1]) + (v[k][2] + v[k][3]); }
        const float mean = wave_sum(s) * (1.0f / D); float s2 = 0.f;
#pragma unroll
        for (int k = 0; k < 4; ++k) { v[k] = v[k] - mean; s2 += (v[k][0] * v[k][0] + v[k][1] * v[k][1]) + (v[k][2] * v[k][2] + v[k][3] * v[k][3]); }
        const float rstd = 1.0f / sqrtf(wave_sum(s2) * (1.0f / D) + LN_EPS);
#pragma unroll
        for (int jj = 0; jj < 2; ++jj) { const int c0 = 8 * F.lane + 512 * jj;
            const f32x4 xa = v[2 * jj] * rstd * *(const f32x4*)(lg + c0) + *(const f32x4*)(lb + c0), xb = v[2 * jj + 1] * rstd * *(const f32x4*)(lg + c0 + 4) + *(const f32x4*)(lb + c0 + 4);
            if (layer == 3) { *(f32x4*)(a->out + (size_t)row * D + c0) = xa; *(f32x4*)(a->out + (size_t)row * D + c0 + 4) = xb; }
            else { { v4u xo; xo.x = pk2(xa[0], xa[1]); xo.y = pk2(xa[2], xa[3]); xo.z = pk2(xb[0], xb[1]); xo.w = pk2(xb[2], xb[3]); *(v4u*)(XC + (size_t)row * D + c0) = xo; }
                const f32x4 ha = xa * (*(const f32x4*)(modn + r * 6144 + 1024 + c0) + 1.0f) + *(const f32x4*)(modn + r * 6144 + c0);
                const f32x4 hb = xb * (*(const f32x4*)(modn + r * 6144 + 1024 + c0 + 4) + 1.0f) + *(const f32x4*)(modn + r * 6144 + c0 + 4);
                if ((MK_FP8_HYIN && layer == 2) || (MK_FP8_CMIN && layer == 1) || (MK_FP8_QKV && layer == 0)) { v2u o8; o8.x = pk4_e4m3(ha); o8.y = pk4_e4m3(hb); *(v2u*)((unsigned char*)HB + (size_t)hrow * D + c0) = o8; }
                else { v4u o; o.x = pk2(ha[0], ha[1]); o.y = pk2(ha[2], ha[3]); o.z = pk2(hb[0], hb[1]); o.w = pk2(hb[2], hb[3]); *(v4u*)(HB + (size_t)hrow * D + c0) = o; } } }
    }
#undef COMB_ISSUE
}
#else
__device__ __forceinline__ void phase_comb(ArgsP a, const Fr& F, int layer, int nrows) {
    const bf16* Y = (const bf16*)(a->ws + WS_Y); const bf16* XL = (const bf16*)(a->ws + WS_U); const f32x2* ST = (const f32x2*)(a->ws + WS_XL); bf16* XC = (bf16*)(a->ws + WS_XC); bf16* HB = (bf16*)(a->ws + WS_HB); const int* INV = (const int*)(a->ws + WS_INV);
    const float* lg1 = a->in[I_LNG] + (size_t)(layer * 2 + 0) * D; const float* lb1 = a->in[I_LNB] + (size_t)(layer * 2 + 0) * D;
    const float* mod = (const float*)(a->ws + WS_MOD) + (size_t)layer * 5 * 6144;
    const float* modn = (const float*)(a->ws + WS_MOD) + (size_t)(layer < 3 ? layer + 1 : 3) * 5 * 6144;
    const float* lg = a->in[I_LNG] + (size_t)(layer * 2 + 1) * D; const float* lb = a->in[I_LNB] + (size_t)(layer * 2 + 1) * D;
    const int gw = F.vcu * NWAVES + F.wave, NGW = F.G * NWAVES;
#define COMB_ISSUE(inv_, row_, sl_, rest_, yv_, xl_, st_) do { unsigned mk_ = (unsigned)(__ballot((inv_) >= 0) & 0xFFFFull); \
        _Pragma("unroll") for (int q = 0; q < 4; ++q) { if (mk_) { const int e_ = __builtin_ctz(mk_); mk_ &= mk_ - 1; sl_[q] = __shfl((inv_), e_); } else sl_[q] = -1; } \
        rest_ = mk_; \
        _Pragma("unroll") for (int q = 0; q < 4; ++q) if (sl_[q] >= 0) { const bf16* yp_ = COMB_YROW(sl_[q]); _Pragma("unroll") for (int j = 0; j < 4; ++j) yv_[q][j] = COMB_YLOAD(yp_, 4 * F.lane + 256 * j); } \
        _Pragma("unroll") for (int j = 0; j < 4; ++j) xl_[j] = *(const v2u*)(XL + (size_t)(row_) * D + 4 * F.lane + 256 * j); st_ = ST[(row_)]; } while (0)
    int inv_c = gw < nrows ? INV[(size_t)gw * 16 + (F.lane & 15)] : -1;
    int inv_n = gw + NGW < nrows ? INV[(size_t)(gw + NGW) * 16 + (F.lane & 15)] : -1;
    int sl_c[4] = {-1, -1, -1, -1}; unsigned rest_c = 0u; comb_y_t yv_c[4][4]; v2u xl_c[4]; f32x2 st_c = {0.f, 1.f};
    if (gw < nrows) COMB_ISSUE(inv_c, gw, sl_c, rest_c, yv_c, xl_c, st_c);
    for (int row = gw; row < nrows; row += NGW) {
        const int r = row < T ? (row >> 12) : 4;
        const int hrow = (layer == 2 && row < T) ? (row & ~4095) + ((row & 511) << 3) + ((row & 4095) >> 9) : row;
        const int myinv = inv_c;
        int sl_n[4] = {-1, -1, -1, -1}; unsigned rest_n = 0u; comb_y_t yv_n[4][4]; v2u xl_n[4]; f32x2 st_n = {0.f, 1.f};
        const bool has_n = row + NGW < nrows;
        if (has_n) COMB_ISSUE(inv_n, row + NGW, sl_n, rest_n, yv_n, xl_n, st_n);
        const int inv_nn = (row + 2 * NGW < nrows) ? INV[(size_t)(row + 2 * NGW) * 16 + (F.lane & 15)] : -1;
        f32x4 m[4];
#pragma unroll
        for (int j = 0; j < 4; ++j) m[j] = (f32x4){0.f, 0.f, 0.f, 0.f};
#pragma unroll
        for (int q = 0; q < 4; ++q) if (sl_c[q] >= 0) {
#pragma unroll
            for (int j = 0; j < 4; ++j) m[j] += comb_y_up(yv_c[q][j]); }
        unsigned msk = rest_c;
        while (msk) { const int e = __builtin_ctz(msk); msk &= msk - 1; const int slot = __shfl(myinv, e); const bf16* yp = COMB_YROW(slot);
#pragma unroll
            for (int j = 0; j < 4; ++j) m[j] += comb_y_up(COMB_YLOAD(yp, 4 * F.lane + 256 * j)); }
        f32x4 xc[4];
#pragma unroll
        for (int j = 0; j < 4; ++j) { const int c = 4 * F.lane + 256 * j; xc[j] = (up4(xl_c[j]) - st_c.x) * st_c.y * *(const f32x4*)(lg1 + c) + *(const f32x4*)(lb1 + c); }
        inv_c = inv_n; inv_n = inv_nn; rest_c = rest_n; st_c = st_n;
#pragma unroll
        for (int q = 0; q < 4; ++q) { sl_c[q] = sl_n[q];
#pragma unroll
            for (int j = 0; j < 4; ++j) yv_c[q][j] = yv_n[q][j]; }
#pragma unroll
        for (int j = 0; j < 4; ++j) xl_c[j] = xl_n[j];
        f32x4 v[4]; float s = 0.f;
#pragma unroll
        for (int j = 0; j < 4; ++j) { const int c = 4 * F.lane + 256 * j;
            v[j] = xc[j] * ALPHA + *(const f32x4*)(mod + r * 6144 + 5120 + c) * (m[j] * COMB_YS); s += (v[j][0] + v[j][1]) + (v[j][2] + v[j][3]); }
        const float mean = wave_sum(s) * (1.0f / D); float s2 = 0.f;
#pragma unroll
        for (int j = 0; j < 4; ++j) { v[j] = v[j] - mean; s2 += (v[j][0] * v[j][0] + v[j][1] * v[j][1]) + (v[j][2] * v[j][2] + v[j][3] * v[j][3]); }
        const float rstd = 1.0f / sqrtf(wave_sum(s2) * (1.0f / D) + LN_EPS);
#pragma unroll
        for (int j = 0; j < 4; ++j) { const int c = 4 * F.lane + 256 * j;
            const f32x4 x = v[j] * rstd * *(const f32x4*)(lg + c) + *(const f32x4*)(lb + c);
            if (layer == 3) { *(f32x4*)(a->out + (size_t)row * D + c) = x; }
            else { { v2u xo; xo.x = pk2(x[0], x[1]); xo.y = pk2(x[2], x[3]); *(v2u*)(XC + (size_t)row * D + c) = xo; }
                const f32x4 h = x * (*(const f32x4*)(modn + r * 6144 + 1024 + c) + 1.0f) + *(const f32x4*)(modn + r * 6144 + c);
                if ((MK_FP8_HYIN && layer == 2) || (MK_FP8_CMIN && layer == 1) || (MK_FP8_QKV && layer == 0)) *(unsigned*)((unsigned char*)HB + (size_t)hrow * D + c) = pk4_e4m3(h);
                else { v2u o; o.x = pk2(h[0], h[1]); o.y = pk2(h[2], h[3]); *(v2u*)(HB + (size_t)hrow * D + c) = o;
                    if (MK_FP8_CMV && !MK_FP8_CMIN && layer == 1) *(unsigned*)((unsigned char*)(a->ws + WS_HB8B) + (size_t)row * D + c) = pk4_e4m3(h); } } }
    }
#undef COMB_ISSUE
}
#endif
#ifndef FFT_HD
#define FFT_HD __device__ __forceinline__
#endif
typedef float cf2 __attribute__((ext_vector_type(2)));
FFT_HD cf2 cmul(cf2 a, cf2 b) { return (cf2){a.x * b.x - a.y * b.y, a.x * b.y + a.y * b.x}; }
FFT_HD int fpad(int p) { return p + (p >> 5); }
constexpr int FFT_N = 8192, FFT_BUF = 8192 + 256;
template <bool INV> FFT_HD void dft4(cf2& a, cf2& b, cf2& c, cf2& d) {
    const cf2 s0 = a + c, s1 = a - c, s2 = b + d, s3 = b - d;
    const cf2 js3 = INV ? (cf2){-s3.y, s3.x} : (cf2){s3.y, -s3.x};
    a = s0 + s2; b = s1 + js3; c = s0 - s2; d = s1 - js3;
}
template <bool INV> FFT_HD void dft16(cf2 (&x)[16]) {
#pragma unroll
    for (int n0 = 0; n0 < 4; ++n0) dft4<INV>(x[n0], x[n0 + 4], x[n0 + 8], x[n0 + 12]);
    constexpr float C1 = 0.92387953251128674f, S1 = 0.38268343236508977f, R2 = 0.70710678118654752f;
    const float sg = INV ? 1.f : -1.f;
    const cf2 w1 = {C1, sg * S1}, w2 = {R2, sg * R2}, w3 = {S1, sg * C1}, w4 = {0.f, sg * 1.f}, w6 = {-R2, sg * R2}, w9 = {-C1, -sg * S1};
    x[1 + 4 * 1] = cmul(x[1 + 4 * 1], w1); x[1 + 4 * 2] = cmul(x[1 + 4 * 2], w2); x[1 + 4 * 3] = cmul(x[1 + 4 * 3], w3);
    x[2 + 4 * 1] = cmul(x[2 + 4 * 1], w2); x[2 + 4 * 2] = cmul(x[2 + 4 * 2], w4); x[2 + 4 * 3] = cmul(x[2 + 4 * 3], w6);
    x[3 + 4 * 1] = cmul(x[3 + 4 * 1], w3); x[3 + 4 * 2] = cmul(x[3 + 4 * 2], w6); x[3 + 4 * 3] = cmul(x[3 + 4 * 3], w9);
#pragma unroll
    for (int k0 = 0; k0 < 4; ++k0) dft4<INV>(x[0 + 4 * k0], x[1 + 4 * k0], x[2 + 4 * k0], x[3 + 4 * k0]);
#pragma unroll
    for (int i = 0; i < 4; ++i)
#pragma unroll
        for (int j = i + 1; j < 4; ++j) { const cf2 t = x[i + 4 * j]; x[i + 4 * j] = x[j + 4 * i]; x[j + 4 * i] = t; }
}
FFT_HD cf2 cmulc(cf2 a, cf2 b) { return (cf2){a.x * b.x + a.y * b.y, a.y * b.x - a.x * b.y}; }
template <bool INV, class BP> FFT_HD void stage_r16(BP buf, const cf2 (&tw)[15], int base, int stride) {
    cf2 x[16];
    const int pb = fpad(base), ps = stride + (stride >> 5);
#pragma unroll
    for (int i = 0; i < 16; ++i) x[i] = buf[pb + i * ps];
    if (!INV) { dft16<false>(x);
#pragma unroll
        for (int k = 1; k < 16; ++k) x[k] = cmulc(x[k], tw[k - 1]); }
    else {
#pragma unroll
        for (int k = 1; k < 16; ++k) x[k] = cmul(x[k], tw[k - 1]);
        dft16<true>(x); }
#pragma unroll
    for (int i = 0; i < 16; ++i) buf[pb + i * ps] = x[i];
}
template <class TP> FFT_HD void load_tw(TP TW, int tidx, cf2 (&tw)[15]) {
#pragma unroll
    for (int k = 1; k < 16; ++k) tw[k - 1] = TW[(tidx * k) & (FFT_N - 1)];
}
template <bool INV, class BP> FFT_HD void stage_r16_chain(BP buf, cf2 w, int base, int stride) {
    cf2 tw[15]; tw[0] = w;
#pragma unroll
    for (int k = 1; k < 15; ++k) tw[k] = cmul(tw[k - 1], w);
    stage_r16<INV>(buf, tw, base, stride);
}
template <class BP> FFT_HD void stage1_fwd_regs(BP buf, cf2 (&x)[16], cf2 w, int m) {
    dft16<false>(x);
    cf2 wk = w; const int pb = fpad(m);
    buf[pb] = x[0];
#pragma unroll
    for (int k = 1; k < 16; ++k) { buf[pb + 528 * k] = cmulc(x[k], wk); if (k < 15) wk = cmul(wk, w); }
}
template <class BP> FFT_HD void stage1_inv_regs(BP buf, cf2 (&x)[16], cf2 w, int m) {
    cf2 wk = w; const int pb = fpad(m);
    x[0] = buf[pb];
#pragma unroll
    for (int k = 1; k < 16; ++k) { x[k] = cmul(buf[pb + 528 * k], wk); if (k < 15) wk = cmul(wk, w); }
    dft16<true>(x);
}
template <bool INV, class BP> FFT_HD void stage_r32_load(BP buf, int blk, int r, cf2 (&u)[16]) {
    constexpr float CS[16] = {1.f, 0.98078528040323043f, 0.92387953251128674f, 0.83146961230254524f, 0.70710678118654752f, 0.55557023301960218f, 0.38268343236508977f, 0.19509032201612825f,
                              0.f, -0.19509032201612825f, -0.38268343236508977f, -0.55557023301960218f, -0.70710678118654752f, -0.83146961230254524f, -0.92387953251128674f, -0.98078528040323043f};
    constexpr float SN[16] = {0.f, 0.19509032201612825f, 0.38268343236508977f, 0.55557023301960218f, 0.70710678118654752f, 0.83146961230254524f, 0.92387953251128674f, 0.98078528040323043f,
                              1.f, 0.98078528040323043f, 0.92387953251128674f, 0.83146961230254524f, 0.70710678118654752f, 0.55557023301960218f, 0.38268343236508977f, 0.19509032201612825f};
    const int base = blk * 33;
#pragma unroll
    for (int n = 0; n < 16; ++n) { const cf2 lo = buf[base + n], hi = buf[base + n + 16];
        const cf2 s = lo + hi, d = lo - hi; const cf2 w = {CS[n], INV ? SN[n] : -SN[n]}; const cf2 dw = cmul(d, w);
        u[n] = r ? dw : s; }
    dft16<INV>(u);
}
template <class BP> FFT_HD void stage_r32_store(BP buf, int blk, int r, const cf2 (&u)[16]) {
    const int base = blk * 33;
#pragma unroll
    for (int g = 0; g < 16; ++g) buf[base + 2 * g + r] = u[g];
}
template <class BP> FFT_HD void stage_r32_store_mul(BP buf, BP W, int blk, int r, const cf2 (&u)[16], int o, float scale) {
    const int base = blk * 33; const int f1 = blk >> 4, f2 = blk & 15;
#pragma unroll
    for (int g = 0; g < 16; ++g) { const int f3 = 2 * g + r; const int f = f1 + 16 * f2 + 256 * f3; const int fm = (FFT_N - f) & (FFT_N - 1);
        const int pm = (fm & 15) * 512 + ((fm >> 4) & 15) * 32 + (fm >> 8);
        const cf2 a = W[base + f3], b = W[fpad(pm)];
        const cf2 k = o == 0 ? (cf2){0.5f * (a.x + b.x), 0.5f * (a.y - b.y)} : (cf2){0.5f * (a.y + b.y), 0.5f * (b.x - a.x)};
        buf[base + f3] = cmul(u[g], k) * scale; }
}
template <class BP> FFT_HD void fft_mul(BP Z, BP W, int tid, int o, float scale) {
    const int f2 = tid >> 5, f3 = tid & 31; const int pp = fpad(tid);
#pragma unroll 4
    for (int j = 0; j < 16; ++j) { const int f = j + 16 * f2 + 256 * f3; const int fm = (FFT_N - f) & (FFT_N - 1);
        const int pm = (fm & 15) * 512 + ((fm >> 4) & 15) * 32 + (fm >> 8);
        const cf2 a = W[pp + 528 * j], b = W[fpad(pm)];
        const cf2 k = o == 0 ? (cf2){0.5f * (a.x + b.x), 0.5f * (a.y - b.y)} : (cf2){0.5f * (a.y + b.y), 0.5f * (b.x - a.x)};
        const cf2 z = Z[pp + 528 * j]; Z[pp + 528 * j] = cmul(z, k) * scale; }
}
#ifndef FFT_HOST_ONLY
__device__ __forceinline__ void ld_tw2(const LAS cf2* tw2l, int tid, cf2 (&tw)[15]) {
#pragma unroll
    for (int k = 0; k < 15; ++k) tw[k] = tw2l[(tid & 31) * 15 + k];
}
__device__ __forceinline__ void fft_fwd(LAS cf2* buf, cf2 w1, const LAS cf2* tw2l, int tid) {
    asm volatile("" : "+v"(tid));
    stage_r16_chain<false>(buf, w1, tid, 512); __syncthreads();
    { cf2 tw[15]; ld_tw2(tw2l, tid, tw); stage_r16<false>(buf, tw, (tid >> 5) * 512 + (tid & 31), 32); } __syncthreads();
    { cf2 u[16]; stage_r32_load<false>(buf, tid >> 1, tid & 1, u); stage_r32_store(buf, tid >> 1, tid & 1, u); } __syncthreads();
}
__device__ __forceinline__ void fft_inv(LAS cf2* buf, cf2 w1, const LAS cf2* tw2l, int tid) {
    asm volatile("" : "+v"(tid));
    { cf2 u[16]; stage_r32_load<true>(buf, tid >> 1, tid & 1, u); stage_r32_store(buf, tid >> 1, tid & 1, u); } __syncthreads();
    { cf2 tw[15]; ld_tw2(tw2l, tid, tw); stage_r16<true>(buf, tw, (tid >> 5) * 512 + (tid & 31), 32); } __syncthreads();
    stage_r16_chain<true>(buf, w1, tid, 512); __syncthreads();
}
struct P8 { v4u own, prv, nxt; };
__device__ __forceinline__ P8 p8_load(const bf16* p, int m) { P8 r; r.own = *(const v4u*)(p + 8 * m); r.prv = *(const v4u*)(p + 8 * (m == 0 ? 511 : m - 1)); r.nxt = *(const v4u*)(p + 8 * (m == 511 ? 0 : m + 1)); return r; }
__device__ __forceinline__ void unpk8(const v4u& v, float (&o)[8]) { const unsigned w[4] = {v.x, v.y, v.z, v.w};
#pragma unroll
    for (int j = 0; j < 4; ++j) { o[2 * j] = __builtin_bit_cast(float, w[j] << 16); o[2 * j + 1] = __builtin_bit_cast(float, w[j] & 0xffff0000u); } }
__device__ __forceinline__ void p8_conv(const P8& r, int m, float w0, float w1, float w2, float cb, float (&o)[8]) {
    float a[8], b[8], c[8]; unpk8(r.own, a); unpk8(r.prv, b); unpk8(r.nxt, c);
#pragma unroll
    for (int j = 0; j < 8; ++j) { const float pv = m == 0 ? (j ? b[j - 1] : 0.f) : b[j]; const float nx = m == 511 ? (j < 7 ? c[j + 1] : 0.f) : c[j];
        o[j] = w0 * pv + w1 * a[j] + w2 * nx + cb; }
}
__device__ __forceinline__ void fft_mid_a(LAS cf2* Zb, LAS cf2* Wb, const LAS cf2* tw2l, int tid, int o, float sc) {
    asm volatile("" : "+v"(tid));
    __syncthreads();
    { cf2 tw[15]; ld_tw2(tw2l, tid, tw); stage_r16<false>(Zb, tw, (tid >> 5) * 512 + (tid & 31), 32); } __syncthreads();
    { cf2 u[16]; stage_r32_load<false>(Zb, tid >> 1, tid & 1, u); stage_r32_store_mul(Zb, Wb, tid >> 1, tid & 1, u, o, sc); } __syncthreads();
    { cf2 u[16]; stage_r32_load<true>(Zb, tid >> 1, tid & 1, u); stage_r32_store(Zb, tid >> 1, tid & 1, u); } __syncthreads();
}
__device__ __forceinline__ void fft_mid_b(LAS cf2* Zb, const LAS cf2* tw2l, int tid) {
    asm volatile("" : "+v"(tid));
    { cf2 tw[15]; ld_tw2(tw2l, tid, tw); stage_r16<true>(Zb, tw, (tid >> 5) * 512 + (tid & 31), 32); } __syncthreads();
}
__device__ __forceinline__ void hy_fft_item(ArgsP a, const Fr& F, int slot, int d, cf2 wtw) {
    LAS cf2* Zb = (LAS cf2*)F.lds;
    LAS cf2* Wb = Zb + FFT_BUF;
    LAS float* red = (LAS float*)(Wb + FFT_BUF);
    const LAS cf2* tw2l = (const LAS cf2*)(red + 16);
    const bf16* PT = (const bf16*)(a->ws + SC_PT); bf16* Z2T = (bf16*)(a->ws + SC_Z2T);
    const float* HF = (const float*)(a->ws + WS_HF + (size_t)slot * HF_SLOT);
    const int tid = F.tid;
    __syncthreads();
    { const float* f0 = HF + (size_t)(0 * 1024 + d) * SEQ; const float* b0 = HF + (size_t)(1 * 1024 + d) * SEQ;
      const float* f1 = HF + (size_t)(2 * 1024 + d) * SEQ; const float* b1 = HF + (size_t)(3 * 1024 + d) * SEQ;
      float s0 = 0.f, s1 = 0.f; float fa[8], fb[8], ba[8], bb[8];
#pragma unroll
      for (int j = 0; j < 8; ++j) { const int t = tid + 512 * j; fa[j] = f0[t]; fb[j] = f1[t]; ba[j] = b0[t]; bb[j] = b1[t]; }
#pragma unroll
      for (int j = 0; j < 8; ++j) { const int t = tid + 512 * j; Wb[fpad(t)] = (cf2){fa[j], fb[j]}; s0 += fabsf(fa[j]); s1 += fabsf(fb[j]);
          if (t >= 1) { Wb[fpad(FFT_N - t)] = (cf2){ba[j], bb[j]}; s0 += fabsf(ba[j]); s1 += fabsf(bb[j]); } }
      if (tid == 0) Wb[fpad(SEQ)] = (cf2){0.f, 0.f};
      s0 = wave_sum(s0); s1 = wave_sum(s1); if (F.lane == 0) { red[F.wave] = s0; red[8 + F.wave] = s1; } }
    __syncthreads();
    float nrm0, nrm1; { float s0 = 0.f, s1 = 0.f; for (int w = 0; w < 8; ++w) { s0 += red[w]; s1 += red[8 + w]; } nrm0 = 1.0f / (s0 + 1e-6f); nrm1 = 1.0f / (s1 + 1e-6f); }
    fft_fwd(Wb, wtw, tw2l, tid);
    const float* cw = a->in[I_HYCW] + (size_t)slot * 3 * 3072; const float* cbp = a->in[I_HYCB] + (size_t)slot * 3072;
    float w0[3], w1[3], w2[3], cb[3];
#pragma unroll
    for (int g = 0; g < 3; ++g) { const int c = g * 1024 + d; w0[g] = cw[c]; w1[g] = cw[3072 + c]; w2[g] = cw[2 * 3072 + c]; cb[g] = cbp[c]; }
    const float fb0 = a->in[I_FBIAS][(slot * 2 + 0) * 1024 + d], fb1 = a->in[I_FBIAS][(slot * 2 + 1) * 1024 + d];
    const float sc0 = nrm0 * (1.0f / FFT_N), sc1 = nrm1 * (1.0f / FFT_N);
#pragma unroll 1
    for (int pr = 0; pr < 2; ++pr) {
        int m = tid; asm volatile("" : "+v"(m));
        const bf16* pb = PT + (size_t)d * TA + (2 * pr) * SEQ;
        const P8 rv0 = p8_load(pb, m), rv1 = p8_load(pb + SEQ, m);
        float va[8], vb2[8];
        p8_conv(rv0, m, w0[0], w1[0], w2[0], cb[0], va); p8_conv(rv1, m, w0[0], w1[0], w2[0], cb[0], vb2);
        cf2 vin[8], x[16];
#pragma unroll
        for (int j = 0; j < 8; ++j) { vin[j] = (cf2){va[j], vb2[j]}; x[j] = vin[j]; x[j + 8] = (cf2){0.f, 0.f}; }
        stage1_fwd_regs(Zb, x, wtw, m);
        fft_mid_a(Zb, Wb, tw2l, tid, 0, sc0);
        const P8 rx0 = p8_load(pb + (size_t)1024 * TA, m), rx1 = p8_load(pb + (size_t)1024 * TA + SEQ, m);
        fft_mid_b(Zb, tw2l, tid);
        stage1_inv_regs(Zb, x, wtw, m);
        p8_conv(rx0, m, w0[1], w1[1], w2[1], cb[1], va); p8_conv(rx1, m, w0[1], w1[1], w2[1], cb[1], vb2);
#pragma unroll
        for (int j = 0; j < 8; ++j) { const cf2 xg = {va[j], vb2[j]}; vin[j] = xg * (x[j] + vin[j] * fb0); x[j] = vin[j]; x[j + 8] = (cf2){0.f, 0.f}; }
        stage1_fwd_regs(Zb, x, wtw, m);
        fft_mid_a(Zb, Wb, tw2l, tid, 1, sc1);
        const P8 rz0 = p8_load(pb + (size_t)2048 * TA, m), rz1 = p8_load(pb + (size_t)2048 * TA + SEQ, m);
        fft_mid_b(Zb, tw2l, tid);
        stage1_inv_regs(Zb, x, wtw, m);
        p8_conv(rz0, m, w0[2], w1[2], w2[2], cb[2], va); p8_conv(rz1, m, w0[2], w1[2], w2[2], cb[2], vb2);
        float z0[8], z1[8];
#pragma unroll
        for (int j = 0; j < 8; ++j) { const cf2 xg = {va[j], vb2[j]}; const cf2 z = xg * (x[j] + vin[j] * fb1); z0[j] = z.x; z1[j] = z.y; }
        bf16* o0 = Z2T + (size_t)d * TA + (2 * pr) * SEQ + 8 * m;
        v4u q0, q1; q0.x = pk2(z0[0], z0[1]); q0.y = pk2(z0[2], z0[3]); q0.z = pk2(z0[4], z0[5]); q0.w = pk2(z0[6], z0[7]);
        q1.x = pk2(z1[0], z1[1]); q1.y = pk2(z1[2], z1[3]); q1.z = pk2(z1[4], z1[5]); q1.w = pk2(z1[6], z1[7]);
        *(v4u*)o0 = q0; *(v4u*)(o0 + SEQ) = q1;
    }
}
__device__ __forceinline__ void phase_hy_conv_fft(ArgsP a, const Fr& F, int layer) {
    const int slot = layer == 0 ? 0 : 1; const int nitems = layer == 0 ? 2048 : 1024;
    {   const cf2* TW = (const cf2*)(a->ws + WS_TW);
        LAS cf2* tw2l = (LAS cf2*)((LAS float*)((LAS cf2*)F.lds + 2 * FFT_BUF) + 16);
        __syncthreads();
        if (F.tid < 32 * 15) { const int n3 = F.tid / 15, k = F.tid % 15 + 1; tw2l[F.tid] = TW[(16 * n3 * k) & (FFT_N - 1)]; }
        const cf2 w1 = TW[F.tid];
        __syncthreads();
        for (int it = F.vcu; it < 1024; it += F.G) hy_fft_item(a, F, slot, it, w1);
    }
    for (int it = 1024 + F.vcu; it < nitems; it += F.G) hy_ctx_item(a, F, slot, it - 1024);
}
#endif
#include <hip/hip_bf16.h>
namespace attn_body {
using bf16=__hip_bfloat16;
using bf16x8=__attribute__((ext_vector_type(8)))short;
using s16x4=__attribute__((ext_vector_type(4)))short;
using f32x16=__attribute__((ext_vector_type(16)))float;
using u32x4=__attribute__((ext_vector_type(4)))unsigned;
constexpr int BATCH=4,NHEAD=16,SEQ=4096,D=64,DM=NHEAD*D,KP=256,LKEYS=4352;
constexpr int NW=8,QBLK=32,QB=QBLK*NW,KVBLK=64,NQB=SEQ/QB;
constexpr int ATTN_PITCH=DM, ATTN_UNIT_ROWS=QB;
__device__ __forceinline__ int crow(int r,int hi){return (r&3)+8*(r>>2)+4*hi;}
#define SBAR() __builtin_amdgcn_sched_barrier(0)
__device__ __forceinline__ void cmask(f32x16&p0,f32x16&p1,int jb,int qrel,int hi){
  const float NEG=-INFINITY; int kb=64*jb+4*hi;
  #pragma unroll
  for(int r=0;r<16;++r){int kv=kb+(r&3)+8*(r>>2); if(kv>qrel)p0[r]=NEG; if(kv+32>qrel)p1[r]=NEG;}
}

constexpr int NSLOT=3, SLOTB=8192;
constexpr int LDS_K=0, LDS_V=NSLOT*SLOTB, LDS_WS=2*NSLOT*SLOTB, LDS_OST=LDS_WS+NW*64*4, LDS_BYTES=LDS_OST+NW*4096;
constexpr float C2=0.125f*1.4426950408889634f;
__device__ __forceinline__ void glds16(const void*gsrc,unsigned lds_dst){unsigned keep;
  asm volatile("s_mov_b32 %0, m0\n\ts_mov_b32 m0, %2\n\ts_nop 0\n\tglobal_load_lds_dwordx4 %1, off\n\ts_mov_b32 m0, %0":"=&s"(keep):"v"(gsrc),"s"(lds_dst):"memory");}
__device__ __forceinline__ float max3f(float a,float b,float c){float r;asm("v_max3_f32 %0, %1, %2, %3":"=v"(r):"v"(a),"v"(b),"v"(c));return r;}
__device__ __forceinline__ float max2f(float a,float b){float r;asm("v_max_f32_e32 %0, %1, %2":"=v"(r):"v"(a),"v"(b));return r;}
__device__ __forceinline__ float fadd_s(float a,float b){float r;asm("v_add_f32_e32 %0, %1, %2":"=v"(r):"v"(a),"v"(b));return r;}
__device__ __forceinline__ float fsub_s(float a,float b){float r;asm("v_sub_f32_e32 %0, %1, %2":"=v"(r):"v"(a),"v"(b));return r;}
typedef float f32x2_t __attribute__((ext_vector_type(2))); typedef __bf16 bf16x2_t __attribute__((ext_vector_type(2)));
__device__ __forceinline__ unsigned cvtpk_s(float lo,float hi){f32x2_t v={lo,hi};bf16x2_t b=__builtin_convertvector(v,bf16x2_t);return __builtin_bit_cast(unsigned,b);}
#define WAIT_BAR(N) asm volatile("s_waitcnt vmcnt(" #N ") lgkmcnt(0)\n\ts_barrier":::"memory")

__device__ __forceinline__ void qkt(f32x16&p0,f32x16&p1,const char*Kslot,const bf16x8*qr,const f32x16&negm,int r32,int hi){
  const char*kb=Kslot+hi*1024+r32*16;
  #pragma unroll
  for(int d0=0;d0<4;++d0){
    const bf16x8 b0=*reinterpret_cast<const bf16x8*>(kb+d0*2048);
    const bf16x8 b1=*reinterpret_cast<const bf16x8*>(kb+d0*2048+512);
    if(d0==0){p0=__builtin_amdgcn_mfma_f32_32x32x16_bf16(b0,qr[0],negm,0,0,0);p1=__builtin_amdgcn_mfma_f32_32x32x16_bf16(b1,qr[0],negm,0,0,0);}
    else{p0=__builtin_amdgcn_mfma_f32_32x32x16_bf16(b0,qr[d0],p0,0,0,0);p1=__builtin_amdgcn_mfma_f32_32x32x16_bf16(b1,qr[d0],p1,0,0,0);}}
}
typedef __attribute__((address_space(3))) const char* lds_cptr;
typedef short v4i16_t __attribute__((ext_vector_type(4)));
__device__ __forceinline__ void kload8(bf16x8*kf,lds_cptr kp){
  kf[0]=*(const __attribute__((address_space(3))) bf16x8*)(kp);      kf[1]=*(const __attribute__((address_space(3))) bf16x8*)(kp+512);
  kf[2]=*(const __attribute__((address_space(3))) bf16x8*)(kp+2048); kf[3]=*(const __attribute__((address_space(3))) bf16x8*)(kp+2560);
  kf[4]=*(const __attribute__((address_space(3))) bf16x8*)(kp+4096); kf[5]=*(const __attribute__((address_space(3))) bf16x8*)(kp+4608);
  kf[6]=*(const __attribute__((address_space(3))) bf16x8*)(kp+6144); kf[7]=*(const __attribute__((address_space(3))) bf16x8*)(kp+6656);
}
__device__ __forceinline__ void kload2(bf16x8*kf,lds_cptr kp,int j){ kf[2*j]=*(const __attribute__((address_space(3))) bf16x8*)(kp+j*2048); kf[2*j+1]=*(const __attribute__((address_space(3))) bf16x8*)(kp+j*2048+512); }
__device__ __forceinline__ s16x4 vtr(lds_cptr p){ return __builtin_bit_cast(s16x4,__builtin_amdgcn_ds_read_tr16_b64_v4i16((__attribute__((address_space(3))) v4i16_t*)p)); }
__device__ __forceinline__ float rowmax(const f32x16&p0,const f32x16&p1){
  float a=max3f(p0[0],p0[1],p1[0]),b=max3f(p0[2],p0[3],p1[1]);a=max3f(a,p1[2],p1[3]);
  #pragma unroll
  for(int r=4;r<16;r+=4){a=max3f(a,p0[r],p0[r+1]);b=max3f(b,p0[r+2],p0[r+3]);a=max3f(a,p1[r],p1[r+1]);b=max3f(b,p1[r+2],p1[r+3]);}
  const float m=max2f(a,b);
  auto rr=__builtin_amdgcn_permlane32_swap(__float_as_uint(m),__float_as_uint(m),false,false);
  return max2f(__uint_as_float(rr[0]),__uint_as_float(rr[1]));
}
__device__ __forceinline__ void pv(f32x16*o,int vb,bf16x8 pa0,bf16x8 pa1,bf16x8 pa2,bf16x8 pa3){
  #pragma unroll
  for(int d0=0;d0<2;++d0){s16x4 lo[4],hi[4];
    #pragma unroll
    for(int ks=0;ks<4;++ks){
      asm volatile("ds_read_b64_tr_b16 %0,%1 offset:%c2":"=&v"(lo[ks]):"v"(vb),"i"(d0*4096+ks*1024):"memory");
      asm volatile("ds_read_b64_tr_b16 %0,%1 offset:%c2":"=&v"(hi[ks]):"v"(vb),"i"(d0*4096+ks*1024+512):"memory");}
    asm volatile("s_waitcnt lgkmcnt(0)":::"memory");SBAR();
    #define PK(k) (bf16x8){lo[k][0],lo[k][1],lo[k][2],lo[k][3],hi[k][0],hi[k][1],hi[k][2],hi[k][3]}
    o[d0]=__builtin_amdgcn_mfma_f32_32x32x16_bf16(pa0,PK(0),o[d0],0,0,0);
    o[d0]=__builtin_amdgcn_mfma_f32_32x32x16_bf16(pa1,PK(1),o[d0],0,0,0);
    o[d0]=__builtin_amdgcn_mfma_f32_32x32x16_bf16(pa2,PK(2),o[d0],0,0,0);
    o[d0]=__builtin_amdgcn_mfma_f32_32x32x16_bf16(pa3,PK(3),o[d0],0,0,0);
    #undef PK
  }
}

#ifndef ATTN_STORE16
#if MK_FP8_AOUT
#define ATTN_STORE16(p,v) do { const long off_ = (const bf16*)(p) - (const bf16*)O; const u32x4 v_ = (v); ::v2u o8_; \
    o8_.x = ::pk4_e4m3((::f32x4){__builtin_bit_cast(float, v_.x << 16), __builtin_bit_cast(float, v_.x & 0xffff0000u), __builtin_bit_cast(float, v_.y << 16), __builtin_bit_cast(float, v_.y & 0xffff0000u)} * O_SCALE); \
    o8_.y = ::pk4_e4m3((::f32x4){__builtin_bit_cast(float, v_.z << 16), __builtin_bit_cast(float, v_.z & 0xffff0000u), __builtin_bit_cast(float, v_.w << 16), __builtin_bit_cast(float, v_.w & 0xffff0000u)} * O_SCALE); \
    *(::v2u*)((unsigned char*)O + off_) = o8_; } while (0)
#else
#define ATTN_STORE16(p,v) (*(u32x4*)(p)=(v))
#endif
#endif
template<int THRL> __device__ __forceinline__ void attn_unit(int b,int h,int qb,const bf16*Q,const bf16*__restrict__ K,const bf16*__restrict__ V,bf16*O,char*shm){
  int tid_=threadIdx.x; asm volatile("":"+v"(tid_)); const int tid=tid_,lane=tid&63,r32=lane&31,hi=lane>>5; const int wid=__builtin_amdgcn_readfirstlane(tid>>6);
  const long rowbase=(long)b*SEQ; const int q0=qb*QB;
  const bf16*Qw=Q+(rowbase+q0+wid*QBLK)*DM+h*D;
  const bf16*Kh=K+(long)b*LKEYS*KP+(h>>2)*D,*Vh=V+(long)b*LKEYS*KP+(h>>2)*D;
  const unsigned lds0=(unsigned)(uintptr_t)shm;
  float*wsf=(float*)(shm+LDS_WS)+wid*64;
  const bf16*ksrc=Kh+(long)lane*KP+wid*8;
  const bf16*vsrc=Vh+(long)(16*(wid&3)+(lane>>2))*KP+(wid>>2)*32+(lane&3)*8;
  const unsigned kdst=lds0+LDS_K+wid*1024, vdst=lds0+LDS_V+wid*1024;
  #define DMA_K(t,slot) glds16(ksrc+(long)(t)*KVBLK*KP,(unsigned)__builtin_amdgcn_readfirstlane(kdst+(slot)))
  #define DMA_V(t,slot) glds16(vsrc+(long)(t)*KVBLK*KP,(unsigned)__builtin_amdgcn_readfirstlane(vdst+(slot)))
  const int vb0=(int)(lds0+LDS_V)+((lane>>4)&1)*32+(lane&3)*8+(4*hi+((lane&15)>>2))*64;
  const char*Kbase=shm+LDS_K; bf16x8 kf[8];
  const lds_cptr shm3=(lds_cptr)shm; const lds_cptr kp0=shm3+LDS_K+hi*1024+r32*16; const lds_cptr vp0=shm3+LDS_V+((lane>>4)&1)*32+(lane&3)*8+(4*hi+((lane&15)>>2))*64;
  const int NT=LKEYS/KVBLK;
  DMA_K(0,0);DMA_V(0,0);DMA_K(1,SLOTB);
  bf16x8 qr[4];
  #pragma unroll
  for(int d0=0;d0<4;++d0)qr[d0]=*reinterpret_cast<const bf16x8*>(&Qw[(long)r32*DM+d0*16+hi*8]);
  float mhat=0.f,l_reg=0.f;f32x16 o[2];o[0]=f32x16{};o[1]=f32x16{};f32x16 negm=f32x16{};asm volatile("":"+v"(negm));

  #define CMASK(P0,P1,t) do{}while(0)
  bool resc=false;
  #define START(P0,P1) do{ const float rm=rowmax(P0,P1); resc=false; \
    { const float dl=rm; mhat=fadd_s(mhat,dl); \
      _Pragma("unroll") for(int r=0;r<16;++r){P0[r]=fsub_s(P0[r],dl);P1[r]=fsub_s(P1[r],dl);} \
      _Pragma("unroll") for(int r=0;r<16;++r)negm[r]=-mhat; asm volatile("":"+v"(negm)); } \
    _Pragma("unroll") for(int r=0;r<16;++r)P0[r]=__builtin_amdgcn_exp2f(P0[r]); }while(0)
  #define RESC() do{ if(resc){ asm volatile("s_waitcnt lgkmcnt(0)":::"memory"); \
      _Pragma("unroll") for(int d_=0;d_<2;++d_) _Pragma("unroll") for(int r=0;r<16;++r)o[d_][r]*=wsf[crow(r,hi)]; } }while(0)
  f32x16 pA0,pA1,pB0,pB1;
  int sl_prev=0,sl_cur=0,sl_next=SLOTB;
  #define ROT() do{sl_prev=sl_cur;sl_cur=sl_next;sl_next=(sl_next==(NSLOT-1)*SLOTB)?0:sl_next+SLOTB;}while(0)
  DMA_K(2,2*SLOTB);
  WAIT_BAR(3);
  qkt(pA0,pA1,Kbase,qr,negm,r32,hi);asm volatile("s_nop 15\n\ts_nop 7":"+v"(pA0),"+v"(pA1));CMASK(pA0,pA1,0);
  START(pA0,pA1);
  _Pragma("unroll") for(int r=0;r<16;++r)pA1[r]=__builtin_amdgcn_exp2f(pA1[r]);
  WAIT_BAR(0);
  DMA_K(3,0);DMA_V(1,SLOTB);
  ROT();
  kload8(kf,kp0+sl_cur);
  WAIT_BAR(2);
  s16x4 vlo[8],vhi[8]; u32x4 pw0,pw1,pw2,pw3;
  #define PKW(P,B) cvtpk_s(P[B],P[B+1])
  #define PAF(k) __builtin_bit_cast(bf16x8,pw##k)
  #define VFR(i) (bf16x8){vlo[i][0],vlo[i][1],vlo[i][2],vlo[i][3],vhi[i][0],vhi[i][1],vhi[i][2],vhi[i][3]}
  #define PIN(x) asm volatile("":"+v"(x))
  #define MX3(a,b,c) __builtin_fmaxf(__builtin_fmaxf((a),(b)),(c))
  #define GAPA(MF,A0,A1,A2,A3,W0,W1,PW) do{ MF; sacc+=A0; sacc+=A1; sacc+=A2; sacc+=A3; PIN(sacc); W0; W1; PIN(PW); SBAR(); }while(0)
  #define EX(v) __builtin_amdgcn_exp2f(v)
  #define GAPB(MF,X,B) do{ MF; X[B]=EX(X[B]); X[B+1]=EX(X[B+1]); X[B+2]=EX(X[B+2]); X[B+3]=EX(X[B+3]); PIN(X); SBAR(); }while(0)
  #define VRD(i) do{ vlo[i]=vtr(vp_+(((i)>>2)*4096+((i)&3)*1024)); vhi[i]=vtr(vp_+(((i)>>2)*4096+((i)&3)*1024+512)); }while(0)
  #define KRD(G,j) do{ if(G){ kload2(kf,kp0+sl_next,j); SBAR(); } }while(0)
  #define STEP(C0,C1,P0,P1,t,GK,GV,GL) do{ SBAR(); \
    const lds_cptr vp_=vp0+sl_prev; \
    VRD(0); SBAR(); float sacc=(P0[0]+P0[1]); \
    GAPA(C0=__builtin_amdgcn_mfma_f32_32x32x16_bf16(kf[0],qr[0],negm,0,0,0), P0[2],P0[3],P0[4],P0[5],     pw0[0]=PKW(P0,0), pw0[1]=PKW(P0,2), pw0); \
    VRD(4); SBAR(); GAPA(C1=__builtin_amdgcn_mfma_f32_32x32x16_bf16(kf[1],qr[0],negm,0,0,0), P0[6],P0[7],P0[8],P0[9],     pw0[2]=PKW(P0,4), pw0[3]=PKW(P0,6), pw0); \
    VRD(1); SBAR(); GAPA(C0=__builtin_amdgcn_mfma_f32_32x32x16_bf16(kf[2],qr[1],C0,0,0,0),   P0[10],P0[11],P0[12],P0[13], pw1[0]=PKW(P0,8), pw1[1]=PKW(P0,10), pw1); \
    VRD(5); SBAR(); GAPA(C1=__builtin_amdgcn_mfma_f32_32x32x16_bf16(kf[3],qr[1],C1,0,0,0),   P0[14],P0[15],P1[0],P1[1],   pw1[2]=PKW(P0,12),pw1[3]=PKW(P0,14), pw1); \
    VRD(2); SBAR(); GAPA(C0=__builtin_amdgcn_mfma_f32_32x32x16_bf16(kf[4],qr[2],C0,0,0,0),   P1[2],P1[3],P1[4],P1[5],     pw2[0]=PKW(P1,0), pw2[1]=PKW(P1,2), pw2); \
    VRD(6); SBAR(); GAPA(C1=__builtin_amdgcn_mfma_f32_32x32x16_bf16(kf[5],qr[2],C1,0,0,0),   P1[6],P1[7],P1[8],P1[9],     pw2[2]=PKW(P1,4), pw2[3]=PKW(P1,6), pw2); \
    VRD(3); SBAR(); GAPA(C0=__builtin_amdgcn_mfma_f32_32x32x16_bf16(kf[6],qr[3],C0,0,0,0),   P1[10],P1[11],P1[12],P1[13], pw3[0]=PKW(P1,8), pw3[1]=PKW(P1,10), pw3); \
    VRD(7); SBAR(); GAPA(C1=__builtin_amdgcn_mfma_f32_32x32x16_bf16(kf[7],qr[3],C1,0,0,0),   P1[14],P1[15],0.f,0.f,       pw3[2]=PKW(P1,12),pw3[3]=PKW(P1,14), pw3); \
    l_reg+=sacc; \
    if(GK){DMA_K((t)+3,sl_cur);} if(GV){DMA_V((t)+1,sl_next);} \
    CMASK(C0,C1,t); \
    { float a=MX3(C0[0],C0[1],C1[0]),b=MX3(C0[2],C0[3],C1[1]); a=MX3(a,C1[2],C1[3]); \
      _Pragma("unroll") for(int r=4;r<16;r+=4){a=MX3(a,C0[r],C0[r+1]);b=MX3(b,C0[r+2],C0[r+3]);a=MX3(a,C1[r],C1[r+1]);b=MX3(b,C1[r+2],C1[r+3]);} \
      float rm=__builtin_fmaxf(a,b); { auto rr=__builtin_amdgcn_permlane32_swap(__float_as_uint(rm),__float_as_uint(rm),false,false); rm=__builtin_fmaxf(__uint_as_float(rr[0]),__uint_as_float(rr[1])); } \
      resc=false; \
      if(__builtin_expect(__any(rm>(float)THRL),0)){ const float dl=__builtin_fmaxf(rm,0.f); mhat+=dl; \
        _Pragma("unroll") for(int r=0;r<16;++r){C0[r]-=dl;C1[r]-=dl;} \
        _Pragma("unroll") for(int r=0;r<16;++r)negm[r]=-mhat; asm volatile("":"+v"(negm)); \
        const float f=__builtin_amdgcn_exp2f(-dl); l_reg*=f; if(hi==0)wsf[r32]=f; resc=true; } } \
    SBAR(); \
    GAPB(o[0]=__builtin_amdgcn_mfma_f32_32x32x16_bf16(PAF(0),VFR(0),o[0],0,0,0), C0,0); \
    GAPB(o[1]=__builtin_amdgcn_mfma_f32_32x32x16_bf16(PAF(0),VFR(4),o[1],0,0,0), C0,4); \
    KRD(GL,0); GAPB(o[0]=__builtin_amdgcn_mfma_f32_32x32x16_bf16(PAF(1),VFR(1),o[0],0,0,0), C0,8); \
    KRD(GL,1); GAPB(o[1]=__builtin_amdgcn_mfma_f32_32x32x16_bf16(PAF(1),VFR(5),o[1],0,0,0), C0,12); \
    KRD(GL,2); GAPB(o[0]=__builtin_amdgcn_mfma_f32_32x32x16_bf16(PAF(2),VFR(2),o[0],0,0,0), C1,0); \
    KRD(GL,3); GAPB(o[1]=__builtin_amdgcn_mfma_f32_32x32x16_bf16(PAF(2),VFR(6),o[1],0,0,0), C1,4); \
    GAPB(o[0]=__builtin_amdgcn_mfma_f32_32x32x16_bf16(PAF(3),VFR(3),o[0],0,0,0), C1,8); \
    GAPB(o[1]=__builtin_amdgcn_mfma_f32_32x32x16_bf16(PAF(3),VFR(7),o[1],0,0,0), C1,12); \
    }while(0)
  int t=1;
  #undef CMASK
  #define CMASK(P0,P1,t) do{}while(0)
  for(;t+5<NT;t+=2){
    STEP(pB0,pB1,pA0,pA1,t,true,true,true);     WAIT_BAR(2); RESC(); ROT();
    STEP(pA0,pA1,pB0,pB1,t+1,true,true,true);   WAIT_BAR(2); RESC(); ROT();
  }
  #undef CMASK
  #define CMASK(P0,P1,t) do{}while(0)
  #define ENDW(tt) do{ if((tt)+3<NT){WAIT_BAR(2);} else if((tt)+2<NT){WAIT_BAR(1);} else {WAIT_BAR(0);} }while(0)
  for(;t+1<NT;t+=2){
    STEP(pB0,pB1,pA0,pA1,t,(t+3<NT),(t+1<NT),(t+1<NT));       ENDW(t);   RESC(); ROT();
    STEP(pA0,pA1,pB0,pB1,t+1,(t+4<NT),(t+2<NT),(t+2<NT));     ENDW(t+1); RESC(); ROT();
  }
  STEP(pB0,pB1,pA0,pA1,NT-1,false,false,false); RESC();
  { float sacc=pB0[0]+pB0[1]; _Pragma("unroll") for(int r=2;r<16;++r)sacc+=pB0[r]; _Pragma("unroll") for(int r=0;r<16;++r)sacc+=pB1[r]; l_reg+=sacc;
    pw0=(u32x4){PKW(pB0,0),PKW(pB0,2),PKW(pB0,4),PKW(pB0,6)};pw1=(u32x4){PKW(pB0,8),PKW(pB0,10),PKW(pB0,12),PKW(pB0,14)};pw2=(u32x4){PKW(pB1,0),PKW(pB1,2),PKW(pB1,4),PKW(pB1,6)};pw3=(u32x4){PKW(pB1,8),PKW(pB1,10),PKW(pB1,12),PKW(pB1,14)};
    SBAR(); pv(o,vb0+sl_cur,PAF(0),PAF(1),PAF(2),PAF(3)); }
  #undef PKW
  #undef PAF
  #undef VFR
  #undef PIN
  #undef MX3
  #undef GAPA
  #undef GAPB
  #undef EX
  #undef VRD
  #undef KRD
  #undef STEP
  #undef ENDW
  {auto rr=__builtin_amdgcn_permlane32_swap(__float_as_uint(l_reg),__float_as_uint(l_reg),false,false);l_reg=__uint_as_float(rr[0])+__uint_as_float(rr[1]);}
  if(hi==0)wsf[32+r32]=l_reg;asm volatile("s_waitcnt lgkmcnt(0)":::"memory");
  float rli[16];
  #pragma unroll
  for(int r=0;r<16;++r)rli[r]=__builtin_amdgcn_rcpf(wsf[32+crow(r,hi)]);
  bf16*Ow=O+(rowbase+q0+wid*QBLK)*DM+h*D;
  { bf16*stg=(bf16*)(shm+LDS_OST)+wid*2048;
    #pragma unroll
    for(int r=0;r<16;++r){const int orow=crow(r,hi);
      #pragma unroll
      for(int d0=0;d0<2;++d0)stg[orow*64+d0*32+r32]=__float2bfloat16(o[d0][r]*rli[r]);}
    asm volatile("s_waitcnt lgkmcnt(0)":::"memory");
    #pragma unroll
    for(int i=0;i<4;++i){const int row=i*8+(lane>>3),ch=lane&7; const u32x4 v=*(const u32x4*)(stg+row*64+ch*8); ATTN_STORE16(Ow+(long)row*DM+ch*8,v);} }
  asm volatile("s_waitcnt lgkmcnt(0)\n\ts_barrier":::"memory");
  #undef DMA_K
  #undef DMA_V
  #undef CMASK
  #undef START
  #undef RESC
  #undef ROT
}
constexpr int ATTN_LDS_BYTES=LDS_BYTES;
struct AttnTensors { const bf16* Q; const bf16* K; const bf16* V; bf16* O; };
struct AttnUnit { int bh; int qb; };
struct StaticOrder {
  int vcu, per;
  __device__ __forceinline__ explicit StaticOrder(int grid,int vcu_):vcu(vcu_),per((BATCH*NHEAD*(SEQ/QB)+grid-1)/grid){}
  __device__ __forceinline__ bool next(int i,AttnUnit&u)const{ if(i>=per)return false; const int idx=vcu*per+i; if(idx>=BATCH*NHEAD*(SEQ/QB))return false; u.bh=idx/(SEQ/QB); u.qb=idx%(SEQ/QB); return true; }
  __device__ __forceinline__ void a_ready(const AttnUnit&)const{}
  __device__ __forceinline__ void done(const AttnUnit&)const{}
};
template<class Sched,int THRL=8> __device__ __forceinline__ void attn_phase(char*lds,const AttnTensors&T,const Sched&S){
  AttnUnit u;
  for(int i=0;S.next(i,u);++i){ S.a_ready(u); attn_unit<THRL>(u.bh/NHEAD,u.bh%NHEAD,u.qb,T.Q,T.K,T.V,T.O,lds); S.done(u); }
}
#undef SBAR
#undef WAIT_BAR
}

__device__ __forceinline__ void phase_attn_fast(ArgsP a, const Fr& F) {
    const attn_body::AttnTensors AT{(const attn_body::bf16*)(a->ws + SC_Q), (const attn_body::bf16*)(a->ws + SC_K), (const attn_body::bf16*)(a->ws + SC_V), (attn_body::bf16*)(a->ws + SC_O)};
    const attn_body::StaticOrder S(F.G, F.vcu);
    __syncthreads();
    attn_body::attn_phase<attn_body::StaticOrder>((char*)F.lds, AT, S);
    __syncthreads();
}
__device__ __forceinline__ void phase_sp_fast(ArgsP a, const Fr& F) {
    typedef short bf16x8 __attribute__((ext_vector_type(8)));
    constexpr int PITCH = 136;
    LAS unsigned short* As = (LAS unsigned short*)F.lds;
    LAS unsigned short* Bs = As + 128 * PITCH;
    LAS float* st = (LAS float*)(Bs + 128 * PITCH);
    const bf16* VT = (const bf16*)(a->ws + SC_VT); const f32x2* VST = (const f32x2*)(a->ws + SC_VST); const bf16* UB = (const bf16*)(a->ws + SC_UB); bf16* UV = (bf16*)(a->ws + SC_UV);
    const bf16* WS = (const bf16*)(a->ws + WS_WCMS);
    const float* lng = a->in[I_CMLNG]; const float* lnb = a->in[I_CMLNB]; const float* bs = a->in[I_CMBS];
    const int tid = F.tid, lane = F.lane, wid = F.wave, wr = wid >> 2, wc = wid & 3, fr = lane & 15, fq = lane >> 4;
    const int per = (2048 + F.G - 1) / F.G; int gl = -1;
    const int s4 = (lane & 31) * 4, ch = lane >> 5;
    const int it_lo = F.vcu * per, it_hi = ((F.vcu + 1) * per < 2048) ? (F.vcu + 1) * per : 2048;
#define SP_BAR() asm volatile("s_waitcnt lgkmcnt(0)\n\ts_barrier" ::: "memory")
#define SP_PREFETCH(it_) do { const int g_ = (it_) >> 7, n_ = (it_) & 127; \
        _Pragma("unroll") for (int q = 0; q < 8; ++q) vt_n[q] = *(const v2u*)(VT + (size_t)(g_ * 128 + q * 16 + wid * 2 + ch) * T + n_ * 128 + s4); \
        if (tid < 128) { _Pragma("unroll") for (int p = 0; p < 16; ++p) vst_n[p] = VST[(size_t)p * T + n_ * 128 + tid]; } } while (0)
    v2u vt_n[8]; f32x2 vst_n[16];
#pragma unroll
    for (int p = 0; p < 16; ++p) vst_n[p] = (f32x2){0.f, 0.f};
    if (it_lo < it_hi) SP_PREFETCH(it_lo);
    for (int it = it_lo; it < it_hi; ++it) {
        const int g = it >> 7, n = it & 127;
        v2u vt[8];
#pragma unroll
        for (int q = 0; q < 8; ++q) vt[q] = vt_n[q];
        float s1 = 0.f, s2 = 0.f;
#pragma unroll
        for (int p = 0; p < 16; ++p) { s1 += vst_n[p].x; s2 += vst_n[p].y; }
        v2u ub[4][2];
#pragma unroll
        for (int m = 0; m < 4; ++m)
#pragma unroll
            for (int nn = 0; nn < 2; ++nn) ub[m][nn] = *(const v2u*)(UB + (size_t)(n * 128 + wr * 64 + m * 16 + fr) * 2048 + g * 128 + wc * 32 + nn * 16 + 4 * fq);
        SP_BAR();
        if (g != gl) { gl = g;
#pragma unroll
            for (int q = 0; q < 4; ++q) { const int idx = tid + q * NTHR, t = idx >> 4, ck = idx & 15;
                *(LAS v4u*)(As + t * PITCH + ck * 8) = *(const v4u*)(WS + (size_t)g * 16384 + t * 128 + ck * 8); } }
        if (tid < 128) { const float mean = s1 * (1.0f / 2048.0f); const float var = s2 * (1.0f / 2048.0f) - mean * mean; st[tid * 2] = mean; st[tid * 2 + 1] = 1.0f / sqrtf(var + LN_EPS); }
        if (it + 1 < it_hi) SP_PREFETCH(it + 1);
        SP_BAR();
        { const f32x4 mu = {st[(s4 + 0) * 2], st[(s4 + 1) * 2], st[(s4 + 2) * 2], st[(s4 + 3) * 2]};
          const f32x4 rs = {st[(s4 + 0) * 2 + 1], st[(s4 + 1) * 2 + 1], st[(s4 + 2) * 2 + 1], st[(s4 + 3) * 2 + 1]};
#pragma unroll
          for (int q = 0; q < 8; ++q) { const int c = q * 16 + wid * 2 + ch; const int chn = g * 128 + c;
              const f32x4 v = up4(vt[q]);
              const float lg = lng[chn], lb = lnb[chn];
              const f32x4 y = (v - mu) * rs * lg + lb;
              v2u o; o.x = pk2(y[0], y[1]); o.y = pk2(y[2], y[3]); *(LAS v2u*)(Bs + c * PITCH + s4) = o; } }
        SP_BAR();
        f32x4 acc[4][2];
#pragma unroll
        for (int m = 0; m < 4; ++m)
#pragma unroll
            for (int nn = 0; nn < 2; ++nn) acc[m][nn] = (f32x4){0.f, 0.f, 0.f, 0.f};
#pragma unroll
        for (int k = 0; k < 4; ++k) {
            bf16x8 af[4], bfr[2];
#pragma unroll
            for (int m = 0; m < 4; ++m) af[m] = *(const LAS bf16x8*)(As + (wr * 64 + m * 16 + fr) * PITCH + k * 32 + fq * 8);
#pragma unroll
            for (int nn = 0; nn < 2; ++nn) bfr[nn] = *(const LAS bf16x8*)(Bs + (wc * 32 + nn * 16 + fr) * PITCH + k * 32 + fq * 8);
#pragma unroll
            for (int m = 0; m < 4; ++m)
#pragma unroll
                for (int nn = 0; nn < 2; ++nn) acc[m][nn] = __builtin_amdgcn_mfma_f32_16x16x32_bf16(bfr[nn], af[m], acc[m][nn], 0, 0, 0);
        }
#pragma unroll
        for (int m = 0; m < 4; ++m) { const int t = wr * 64 + m * 16 + fr; const float bt = bs[g * 128 + t];
#pragma unroll
            for (int nn = 0; nn < 2; ++nn) { const size_t idx = (size_t)(n * 128 + t) * 2048 + g * 128 + wc * 32 + nn * 16 + 4 * fq;
                const v2u ubv = ub[m][nn]; const f32x4 o = acc[m][nn] + bt;
#if MK_FP8_CMOUT
                const f32x4 uvv = {__builtin_bit_cast(float, ubv.x << 16) * o[0], __builtin_bit_cast(float, ubv.x & 0xffff0000u) * o[1], __builtin_bit_cast(float, ubv.y << 16) * o[2], __builtin_bit_cast(float, ubv.y & 0xffff0000u) * o[3]};
                *(unsigned*)((unsigned char*)UV + idx) = pk4_e4m3(uvv * O_SCALE); } }
#else
                v2u w; w.x = pk2(__builtin_bit_cast(float, ubv.x << 16) * o[0], __builtin_bit_cast(float, ubv.x & 0xffff0000u) * o[1]);
                w.y = pk2(__builtin_bit_cast(float, ubv.y << 16) * o[2], __builtin_bit_cast(float, ubv.y & 0xffff0000u) * o[3]);
                *(v2u*)(UV + idx) = w; } }
#endif
    }
#undef SP_BAR
#undef SP_PREFETCH
}
__device__ __forceinline__ void phase_rope(ArgsP a, const Fr& F) {
    LAS f32x2* tab = (LAS f32x2*)F.lds;
    __syncthreads();
    for (int u = F.tid; u < 1024; u += NTHR) { const int pos = u >> 4, f = u & 15; const float invf = powf(10000.0f, -(float)f / 16.0f); float sn, cs; sincosf((float)pos * invf, &sn, &cs); tab[u] = (f32x2){cs, sn}; }
    __syncthreads();
    const bf16* QKV = (const bf16*)(a->ws + SC_QKV); bf16* Q = (bf16*)(a->ws + SC_Q); bf16* K = (bf16*)(a->ws + SC_K); bf16* V = (bf16*)(a->ws + SC_V);
    const int gw = F.vcu * NWAVES + F.wave, NGW = F.G * NWAVES;
    const int l8 = F.lane & 7, hl = F.lane >> 3;
    const f32x4 qg0 = *(const f32x4*)(a->in[I_QGAIN] + 4 * l8), qg1 = *(const f32x4*)(a->in[I_QGAIN] + 32 + 4 * l8);
    const f32x4 kg0 = *(const f32x4*)(a->in[I_KGAIN] + 4 * l8), kg1 = *(const f32x4*)(a->in[I_KGAIN] + 32 + 4 * l8);
    for (int row0 = gw; row0 < TA; row0 += 4 * NGW) {
        v2u xa[4][3], xb[4][3];
#pragma unroll
        for (int rr = 0; rr < 4; ++rr) { const int row = row0 + rr * NGW < TA ? row0 + rr * NGW : row0; const bf16* src = QKV + (size_t)row * 1536 + hl * 64 + 4 * l8;
#pragma unroll
            for (int p = 0; p < 3; ++p) { xa[rr][p] = *(const v2u*)(src + p * 512); xb[rr][p] = *(const v2u*)(src + p * 512 + 32); } }
#pragma unroll
        for (int rr = 0; rr < 4; ++rr) { const int row = row0 + rr * NGW; if (row >= TA) break;
            const bool lat = row < T; const int b = lat ? (row >> 12) : ((row - T) >> 8); const int t = lat ? (row & 4095) : ((row - T) & 255);
            f32x4 cs = {1.f, 1.f, 1.f, 1.f}, sn = {0.f, 0.f, 0.f, 0.f};
            if (lat) { const int pos = (l8 < 4) ? (t >> 6) : (t & 63); const LAS f32x4* tp = (const LAS f32x4*)(tab + pos * 16 + 4 * (l8 & 3));
                const f32x4 c01 = tp[0], c23 = tp[1]; cs = (f32x4){c01[0], c01[2], c23[0], c23[2]}; sn = (f32x4){c01[1], c01[3], c23[1], c23[3]}; }
            const size_t krow = (size_t)b * LK + (lat ? LC + t : t);
#pragma unroll
            for (int p = 0; p < 3; ++p) {
                if (p < 2 && !lat) continue;
                if (p == 2 && hl >= 4) { bf16* d = V + krow * KVP + (hl - 4) * 64 + 4 * l8; *(v2u*)d = xa[rr][p]; *(v2u*)(d + 32) = xb[rr][p]; }
                else {
                    const f32x4 x1 = up4(xa[rr][p]), x2 = up4(xb[rr][p]);
                    float ss = ((x1[0] * x1[0] + x1[1] * x1[1]) + (x1[2] * x1[2] + x1[3] * x1[3])) + ((x2[0] * x2[0] + x2[1] * x2[1]) + (x2[2] * x2[2] + x2[3] * x2[3]));
                    ss += __shfl_xor(ss, 1); ss += __shfl_xor(ss, 2); ss += __shfl_xor(ss, 4);
                    const float rs = 1.0f / sqrtf(ss * (1.0f / 64.0f) + RMS_EPS);
                    const bool isq = p < 2;
                    const f32x4 n1 = x1 * rs * (isq ? qg0 : kg0), n2 = x2 * rs * (isq ? qg1 : kg1);
                    f32x4 o1 = n1 * cs - n2 * sn, o2 = n1 * sn + n2 * cs;
                    bf16* d;
                    if (isq) { o1 *= ATT_C2; o2 *= ATT_C2; d = Q + (size_t)row * 1024 + (p * 8 + hl) * 64 + 4 * l8; }
                    else d = K + krow * KVP + hl * 64 + 4 * l8;
                    v2u w1, w2; w1.x = pk2(o1[0], o1[1]); w1.y = pk2(o1[2], o1[3]); w2.x = pk2(o2[0], o2[1]); w2.y = pk2(o2[2], o2[3]);
                    *(v2u*)d = w1; *(v2u*)(d + 32) = w2; }
            }
        }
    }
}
__device__ __forceinline__ void phase_attn_simple(ArgsP a, const Fr& F) {
    const bf16* Q = (const bf16*)(a->ws + SC_Q); const bf16* K = (const bf16*)(a->ws + SC_K); const bf16* V = (const bf16*)(a->ws + SC_V); bf16* O = (bf16*)(a->ws + SC_O);
    for (int it = F.vcu; it < 512; it += F.G) {
        const int b = it >> 7, h = (it >> 3) & 15, q = (it & 7) * 512 + F.tid;
        const bf16* qp = Q + (size_t)(b * SEQ + q) * 1024 + h * 64;
        float qv[64], o[64];
#pragma unroll
        for (int d = 0; d < 64; ++d) { qv[d] = bf2f(qp[d]); o[d] = 0.f; }
        float m = -3.0e38f, l = 0.f;
        const bf16* kb = K + (size_t)b * LK * KVP + (h >> 2) * 64; const bf16* vb = V + (size_t)b * LK * KVP + (h >> 2) * 64;
        for (int s = 0; s < LK; ++s) {
            const v4u* kr = (const v4u*)(kb + (size_t)s * KVP); float sc = 0.f;
#pragma unroll
            for (int c = 0; c < 8; ++c) { const v4u kv = kr[c]; const unsigned w[4] = {kv.x, kv.y, kv.z, kv.w};
#pragma unroll
                for (int j = 0; j < 4; ++j) { sc += qv[c * 8 + 2 * j] * __builtin_bit_cast(float, w[j] << 16) + qv[c * 8 + 2 * j + 1] * __builtin_bit_cast(float, w[j] & 0xffff0000u); } }
            const float mn = fmaxf(m, sc); const float al = exp2f(m - mn), p = exp2f(sc - mn); l = l * al + p; m = mn;
            const v4u* vr = (const v4u*)(vb + (size_t)s * KVP);
#pragma unroll
            for (int c = 0; c < 8; ++c) { const v4u vv = vr[c]; const unsigned w[4] = {vv.x, vv.y, vv.z, vv.w};
#pragma unroll
                for (int j = 0; j < 4; ++j) { o[c * 8 + 2 * j] = o[c * 8 + 2 * j] * al + p * __builtin_bit_cast(float, w[j] << 16); o[c * 8 + 2 * j + 1] = o[c * 8 + 2 * j + 1] * al + p * __builtin_bit_cast(float, w[j] & 0xffff0000u); } }
        }
        const float il = 1.0f / l; bf16* op = O + (size_t)(b * SEQ + q) * 1024 + h * 64;
#pragma unroll
        for (int c = 0; c < 8; ++c) { v4u w; w.x = pk2(o[c * 8] * il, o[c * 8 + 1] * il); w.y = pk2(o[c * 8 + 2] * il, o[c * 8 + 3] * il); w.z = pk2(o[c * 8 + 4] * il, o[c * 8 + 5] * il); w.w = pk2(o[c * 8 + 6] * il, o[c * 8 + 7] * il);
            *(v4u*)(op + c * 8) = w; }
    }
}
__device__ __forceinline__ void phase_sp_simple(ArgsP a, const Fr& F) {
    LAS float* wsL = (LAS float*)F.lds;
    LAS float* vl = wsL + 128 * 128;
    LAS float* st = vl + 128 * 128;
    const float* VT = (const float*)(a->ws + SC_VT); const f32x2* VST = (const f32x2*)(a->ws + SC_VST); const bf16* UB = (const bf16*)(a->ws + SC_UB); bf16* UV = (bf16*)(a->ws + SC_UV);
    const int per = (2048 + F.G - 1) / F.G; int gl = -1;
    for (int it = F.vcu * per; it < (F.vcu + 1) * per && it < 2048; ++it) {
        const int g = it >> 7, n = it & 127;
        __syncthreads();
        if (g != gl) { for (int u = F.tid; u < 128 * 128; u += NTHR) wsL[u] = a->in[I_CMWS][(size_t)g * 16384 + u]; gl = g; }
        if (F.tid < 128) { float s1 = 0.f, s2 = 0.f; for (int p = 0; p < 16; ++p) { const f32x2 v = VST[(size_t)p * T + n * 128 + F.tid]; s1 += v.x; s2 += v.y; }
            const float mean = s1 * (1.0f / 2048.0f); const float var = s2 * (1.0f / 2048.0f) - mean * mean; st[F.tid * 2] = mean; st[F.tid * 2 + 1] = 1.0f / sqrtf(var + LN_EPS); }
        __syncthreads();
        for (int u = F.tid; u < 128 * 128; u += NTHR) { const int c = u >> 7, s = u & 127; const int ch = g * 128 + c;
            const float v = VT[(size_t)ch * T + n * 128 + s]; vl[s * 128 + c] = (v - st[s * 2]) * st[s * 2 + 1] * a->in[I_CMLNG][ch] + a->in[I_CMLNB][ch]; }
        __syncthreads();
        const int c = F.tid & 127, tq = F.tid >> 7;
        for (int jj = 0; jj < 32; ++jj) { const int t = tq + 4 * jj; float acc = 0.f;
            for (int s = 0; s < 128; ++s) acc += wsL[t * 128 + s] * vl[s * 128 + c];
            acc += a->in[I_CMBS][g * 128 + t];
            const size_t idx = (size_t)(n * 128 + t) * 2048 + g * 128 + c;
            UV[idx] = (bf16)f2bf(bf2f(UB[idx]) * acc); }
    }
}
#ifndef MK_FAST_CONV
#define MK_FAST_CONV 0
#endif
#ifndef MK_FAST_ATTN
#define MK_FAST_ATTN 0
#endif
#ifndef MK_FAST_SP
#define MK_FAST_SP 0
#endif
#ifndef MK_GATHER
#define MK_GATHER 0
#endif
constexpr int MOE_PH = MK_GATHER ? 5 : 6;
constexpr int N_PHASES = (MK_MERGE_PRO ? 1 : 2) + (4 + MOE_PH) + (4 + MOE_PH) + (3 + MOE_PH) + (4 + MOE_PH);

#ifndef MK_STAG_GU
#define MK_STAG_GU 0
#endif
#define STAGGER(ticks) do { if ((ticks) > 0 && (F.vcu & 1)) { const unsigned long long t0_ = __builtin_amdgcn_s_memrealtime(); while (__builtin_amdgcn_s_memrealtime() - t0_ < (unsigned long long)(ticks)) __builtin_amdgcn_s_sleep(8); } } while (0)
#ifndef MK_REPMASK
#define MK_REPMASK 0ull
#endif
#ifndef MK_CODEPROBE_N
#define MK_CODEPROBE_N 0
#endif
#if MK_CODEPROBE_N > 0
#define MK_CODEPROBE { _Pragma("unroll 1") for (int cp_ = 0; cp_ < MK_CODEPROBE_N; ++cp_) asm volatile(".rept 2048\n\ts_nop 0\n\t.endr" ::: "memory"); }
#else
#define MK_CODEPROBE
#endif
#ifndef MK_LNR2
#define MK_LNR2 0
#endif
#ifndef MK_XBAR
#define MK_XBAR 0
#endif
#ifndef MK_REPN
#define MK_REPN 3
#endif
#ifndef MK_REPBAR
#define MK_REPBAR 0
#endif
__device__ __forceinline__ bool probe_bar(unsigned char* lds_raw) { ArgsP a__ = get_args(); XcdBarrier bb; bb.bar = (unsigned*)(a__->ws + WS_CTL) + 4096; bb.x = xb_xcc_id();
    bb.st = (volatile LAS unsigned*)((LAS unsigned char*)lds_raw + MISC_OFF) + 8; xcd_barrier(bb); return false; }
#define REPS for (int rep_ = 0; rep_ < (((MK_REPMASK >> p) & 1ull) ? MK_REPN : 1); ++rep_) if (MK_REPBAR && rep_ > 0 && probe_bar(lds_raw)) {} else
#define IN() (get_args()->ph_lo <= p && p < get_args()->ph_hi)
#define PHB ArgsP a = get_args(); unsigned char* ws = a->ws; (void)ws; const Fr F = mkfr(lds_raw);
#define SEAM() do { { ArgsP a__ = get_args(); if (a__->ph_lo <= p && p + 1 < a__->ph_hi) { XcdBarrier bb; bb.bar = (unsigned*)(a__->ws + WS_CTL) + 4096; bb.x = xb_xcc_id(); \
        bb.st = (volatile LAS unsigned*)((LAS unsigned char*)lds_raw + MISC_OFF) + 8; xcd_barrier(bb); for (int xb_ = 0; xb_ < MK_XBAR; ++xb_) xcd_barrier(bb); MK_CODEPROBE } } ++p; } while (0)
template <int layer> __device__ __forceinline__ void layer_body(int& p, unsigned char* lds_raw) {
    PG8_LAS unsigned char* ring = (PG8_LAS unsigned char*)lds_raw;
        constexpr int kind = layer % 3;
        const int nrows = layer == 0 ? TA : T;
#define G1PTR ((const float*)(ws + WS_MOD) + (size_t)layer * 5 * 6144 + 2048)
        if constexpr (kind == 0) {
            const int slot = layer == 0 ? 0 : 1;
#if MK_FP8_HYIN
            REPS if (IN()) { PHB pg8::Gemm g{(const pg8::bf16_t*)(ws + WS_WHYIN + (size_t)slot * 3072 * 1024), (const pg8::bf16_t*)(ws + WS_HB), 3072, nrows, 512, nullptr};
                pg8::StaticOrder S; S.init(3072, nrows, F.G, F.bx); pg8::EpiBf16<0> E{(pg8::bf16_t*)(ws + SC_PT), TA, nullptr, 1 << 30, 0, 1.0f / WH_SCALE};
                pg8::gemm_phase<pg8::EpiBf16<0>, pg8::StaticOrder, true, false, true>(ring, g, S, E);
#else
            REPS if (IN()) { PHB pg8::Gemm g{(const pg8::bf16_t*)(ws + WS_WHYIN) + (size_t)slot * 3072 * 1024, (const pg8::bf16_t*)(ws + WS_HB), 3072, nrows, 1024, nullptr};
                pg8::StaticOrder S; S.init(3072, nrows, F.G, F.bx); pg8::EpiBf16<0> E{(pg8::bf16_t*)(ws + SC_PT), TA, nullptr, 0, 0, 1.f};
                pg8::gemm_phase<pg8::EpiBf16<0>, pg8::StaticOrder, true, false>(ring, g, S, E);
#endif
                if constexpr (layer == 0) { __syncthreads(); bg_convert<0>(a, F, F.bx - (12 * 68) % 256); } }
            SEAM();
            REPS if (IN()) { PHB
#if MK_FAST_CONV
                phase_hy_conv_fft(a, F, layer);
#else
                phase_hy_conv_direct(a, F, layer);
#endif
            }
            SEAM();
            REPS if (IN()) { PHB phase_hy_tr(a, F, nrows); }
            SEAM();
#if MK_FP8_HYOUT
            REPS if (IN()) { PHB pg8::Gemm g{(const pg8::bf16_t*)(ws + SC_Z2), (const pg8::bf16_t*)(ws + WS_WHYOUT + (size_t)slot * 1024 * 1024), nrows, 1024, 512, nullptr};
                pg8::StaticOrder S; S.init(nrows, 1024, F.G, F.bx); pg8::EpiRes E{(const pg8::bf16_t*)(ws + WS_XC), (pg8::bf16_t*)(ws + WS_U), G1PTR, 6144, ALPHA, 1.0f / (WH_SCALE * Z_SCALE)};
                pg8::gemm_phase<pg8::EpiRes, pg8::StaticOrder, true, false, true>(ring, g, S, E);
#else
            REPS if (IN()) { PHB pg8::Gemm g{(const pg8::bf16_t*)(ws + SC_Z2), (const pg8::bf16_t*)(ws + WS_WHYOUT) + (size_t)slot * 1024 * 1024, nrows, 1024, 1024, nullptr};
                pg8::StaticOrder S; S.init(nrows, 1024, F.G, F.bx); pg8::EpiRes E{(const pg8::bf16_t*)(ws + WS_XC), (pg8::bf16_t*)(ws + WS_U), G1PTR, 6144, ALPHA};
                pg8::gemm_phase<pg8::EpiRes, pg8::StaticOrder, true, false>(ring, g, S, E);
#endif
                if constexpr (layer == 0) { __syncthreads(); bg_convert<1>(a, F, F.bx - (68 * 4) % 256); } }
            SEAM();
        } else if constexpr (kind == 1) {
#if MK_FP8_QKV
            REPS if (IN()) { PHB pg8::Gemm g{(const pg8::bf16_t*)(ws + WS_HB), (const pg8::bf16_t*)(ws + WS_WQKV), TA, 1536, 512, nullptr};
                pg8::StaticOrder S; S.init(TA, 1536, F.G, F.bx); pg8::EpiBf16<0> E{(pg8::bf16_t*)(ws + SC_QKV), 1536, nullptr, 0, 0, 1.f, 1.0f / WH_SCALE};
                pg8::gemm_phase<pg8::EpiBf16<0>, pg8::StaticOrder, true, false, true>(ring, g, S, E);
#else
            REPS if (IN()) { PHB pg8::Gemm g{(const pg8::bf16_t*)(ws + WS_HB), (const pg8::bf16_t*)(ws + WS_WQKV), TA, 1536, 1024, nullptr};
                pg8::StaticOrder S; S.init(TA, 1536, F.G, F.bx); pg8::EpiBf16<0> E{(pg8::bf16_t*)(ws + SC_QKV), 1536, nullptr, 0, 0, 1.f};
                pg8::gemm_phase<pg8::EpiBf16<0>, pg8::StaticOrder, true, false>(ring, g, S, E);
#endif
                __syncthreads(); bg_convert<4>(a, F, F.bx - (68 * 6) % 256); }
            SEAM();
            REPS if (IN()) { PHB phase_rope(a, F); }
            SEAM();
            REPS if (IN()) { PHB
#if MK_FAST_ATTN
                phase_attn_fast(a, F);
#else
                phase_attn_simple(a, F);
#endif
            }
            SEAM();
#if MK_FP8_AOUT
            REPS if (IN()) { PHB pg8::Gemm g{(const pg8::bf16_t*)(ws + SC_O), (const pg8::bf16_t*)(ws + WS_WATO), T, 1024, 512, nullptr};
                pg8::StaticOrder S; S.init(T, 1024, F.G, F.bx); pg8::EpiRes E{(const pg8::bf16_t*)(ws + WS_XC), (pg8::bf16_t*)(ws + WS_U), G1PTR, 6144, ALPHA, 1.0f / (WH_SCALE * O_SCALE)};
                pg8::gemm_phase<pg8::EpiRes, pg8::StaticOrder, true, false, true>(ring, g, S, E); }
#else
            REPS if (IN()) { PHB pg8::Gemm g{(const pg8::bf16_t*)(ws + SC_O), (const pg8::bf16_t*)(ws + WS_WATO), T, 1024, 1024, nullptr};
                pg8::StaticOrder S; S.init(T, 1024, F.G, F.bx); pg8::EpiRes E{(const pg8::bf16_t*)(ws + WS_XC), (pg8::bf16_t*)(ws + WS_U), G1PTR, 6144, ALPHA};
                pg8::gemm_phase<pg8::EpiRes, pg8::StaticOrder, true, false>(ring, g, S, E); }
#endif
            SEAM();
        } else {
            REPS if (IN()) {
#if MK_FP8_CMIN
                { PHB pg8::Gemm g{(const pg8::bf16_t*)(ws + WS_HB), (const pg8::bf16_t*)(ws + WS_WCMIN), T, 2048, 512, nullptr};
                  pg8::StaticOrder S; S.init(T, 2048, F.G, F.bx); pg8::EpiBf16<1> E{(pg8::bf16_t*)(ws + SC_UB), 2048, nullptr, 0, 0, 1.f, 1.0f / WH_SCALE};
                  pg8::gemm_phase<pg8::EpiBf16<1>, pg8::StaticOrder, true, false, true>(ring, g, S, E); }
                { PHB pg8::Gemm g{(const pg8::bf16_t*)(ws + WS_WCMIN + (size_t)2048 * 1024), (const pg8::bf16_t*)(ws + WS_HB), 2048, T, 512, nullptr};
                  pg8::StaticOrder S; S.init(2048, T, F.G, F.bx); pg8::EpiVT E{(pg8::bf16_t*)(ws + SC_VT), T, (pg8::f32x2*)(ws + SC_VST), T, 1.0f / WH_SCALE};
                  pg8::gemm_phase<pg8::EpiVT, pg8::StaticOrder, true, false, true>(ring, g, S, E); }
#else
                { PHB pg8::Gemm g{(const pg8::bf16_t*)(ws + WS_HB), (const pg8::bf16_t*)(ws + WS_WCMIN), T, 2048, 1024, nullptr};
                  pg8::StaticOrder S; S.init(T, 2048, F.G, F.bx); pg8::EpiBf16<1> E{(pg8::bf16_t*)(ws + SC_UB), 2048, nullptr, 0, 0, 1.f};
                  pg8::gemm_phase<pg8::EpiBf16<1>, pg8::StaticOrder, true, false>(ring, g, S, E); }
#if MK_FP8_CMV
                { PHB pg8::Gemm g{(const pg8::bf16_t*)(ws + WS_WCMIN + (size_t)2048 * 1024 * 2), (const pg8::bf16_t*)(ws + WS_HB8B), 2048, T, 512, nullptr};
                  pg8::StaticOrder S; S.init(2048, T, F.G, F.bx); pg8::EpiVT E{(pg8::bf16_t*)(ws + SC_VT), T, (pg8::f32x2*)(ws + SC_VST), T, 1.0f / WH_SCALE};
                  pg8::gemm_phase<pg8::EpiVT, pg8::StaticOrder, true, false, true>(ring, g, S, E); }
#else
                { PHB pg8::Gemm g{(const pg8::bf16_t*)(ws + WS_WCMIN) + (size_t)2048 * 1024, (const pg8::bf16_t*)(ws + WS_HB), 2048, T, 1024, nullptr};
                  pg8::StaticOrder S; S.init(2048, T, F.G, F.bx); pg8::EpiVT E{(pg8::bf16_t*)(ws + SC_VT), T, (pg8::f32x2*)(ws + SC_VST), T};
                  pg8::gemm_phase<pg8::EpiVT, pg8::StaticOrder, true, false>(ring, g, S, E); }
#endif
#endif
            }
            SEAM();
            REPS if (IN()) { PHB
#if MK_FAST_SP
                phase_sp_fast(a, F);
#else
                phase_sp_simple(a, F);
#endif
            }
            SEAM();
#if MK_FP8_CMOUT
            REPS if (IN()) { PHB pg8::Gemm g{(const pg8::bf16_t*)(ws + SC_UV), (const pg8::bf16_t*)(ws + WS_WCMOUT), T, 1024, 1024, nullptr};
                pg8::StaticOrder S; S.init(T, 1024, F.G, F.bx); pg8::EpiRes E{(const pg8::bf16_t*)(ws + WS_XC), (pg8::bf16_t*)(ws + WS_U), G1PTR, 6144, ALPHA, 1.0f / (WH_SCALE * O_SCALE)};
                pg8::gemm_phase<pg8::EpiRes, pg8::StaticOrder, true, false, true>(ring, g, S, E); }
#else
            REPS if (IN()) { PHB pg8::Gemm g{(const pg8::bf16_t*)(ws + SC_UV), (const pg8::bf16_t*)(ws + WS_WCMOUT), T, 1024, 2048, nullptr};
                pg8::StaticOrder S; S.init(T, 1024, F.G, F.bx); pg8::EpiRes E{(const pg8::bf16_t*)(ws + WS_XC), (pg8::bf16_t*)(ws + WS_U), G1PTR, 6144, ALPHA};
                pg8::gemm_phase<pg8::EpiRes, pg8::StaticOrder, true, false>(ring, g, S, E); }
#endif
            SEAM();
        }
#if MK_LNR2
        REPS if (IN()) { PHB phase_lnr2(a, F, layer, nrows); }
#else
        REPS if (IN()) { PHB phase_lnr(a, F, layer, nrows); }
#endif
        SEAM();
        REPS if (IN()) { PHB phase_topk(a, F, layer);
            if constexpr (layer == 0) { __syncthreads(); bg_convert<2>(a, F, F.vcu - 128); }
            if constexpr (layer == 1) { __syncthreads(); bg_convert<5>(a, F, F.vcu - 64); }
            if constexpr (layer == 2) { __syncthreads(); bg_convert<6>(a, F, F.vcu - 64); } }
        SEAM();
        const int npm = layer == 0 ? 9 : 8;
#if MK_GATHER
        REPS if (IN()) { PHB pg8::Gemm g{(const pg8::bf16_t*)(ws + WS_HB), (const pg8::bf16_t*)(ws + WS_WGU + (size_t)layer * 16 * 4096 * 1024), 0, 0, 512, (const int*)(ws + WS_ROWS)};
            pg8::MoeOrder S{npm, 16, F.G, F.vcu}; pg8::EpiGU8<MK_FP8_DN != 0> E{(unsigned char*)(ws + WS_ACT), 16, 1.0f / WGU_SCALE, MK_FP8_DN ? ACT_SCALE : 1.0f};
            STAGGER(MK_STAG_GU);
#if defined(MK_NULLEPI)
            if (rep_ > 0) { pg8::MK_NULLEPI EN; pg8::MoeOrder S2 = S; S2.fixed = 1; pg8::gemm_phase<pg8::MK_NULLEPI, pg8::MoeOrder, true, true, true>(ring, g, S2, EN); } else
#endif
            pg8::gemm_phase<pg8::EpiGU8<MK_FP8_DN != 0>, pg8::MoeOrder, true, true, true>(ring, g, S, E); }
        SEAM();
#else
        REPS if (IN()) { PHB phase_gather(a, F, layer); }
        SEAM();
#error "the materialised-gather build (MK_GATHER 0) predates the e4m3 expert GEMMs and is no longer supported"
        SEAM();
#endif
#if MK_FP8_DN
        REPS if (IN()) { PHB pg8::Gemm g{(const pg8::bf16_t*)(ws + WS_ACT), (const pg8::bf16_t*)(ws + WS_WDN + (size_t)layer * 16 * 1024 * 2048), 0, 0, 1024, nullptr};
            pg8::MoeOrder S{npm, 4, F.G, F.vcu}; pg8::EpiDN E{(pg8::bf16_t*)(ws + WS_Y), (const float*)(ws + WS_GATE), 4, (MK_FP8_Y ? Y_SCALE : 1.0f) / (WDN_SCALE * ACT_SCALE)};
            pg8::gemm_phase<pg8::EpiDN, pg8::MoeOrder, true, false, true>(ring, g, S, E);
            if constexpr (layer == 0) { __syncthreads(); bg_convert<3>(a, F, F.vcu - (16 * 9 * 4) % 256); } }
#else
        REPS if (IN()) { PHB pg8::Gemm g{(const pg8::bf16_t*)(ws + WS_ACT), (const pg8::bf16_t*)(ws + WS_WDN) + (size_t)layer * 16 * 1024 * 2048, 0, 0, 2048, nullptr};
            pg8::MoeOrder S{npm, 4, F.G, F.vcu}; pg8::EpiDN E{(pg8::bf16_t*)(ws + WS_Y), (const float*)(ws + WS_GATE), 4, 1.0f};
            pg8::gemm_phase<pg8::EpiDN, pg8::MoeOrder, true, false, false>(ring, g, S, E); }
#endif
        SEAM();
        REPS if (IN()) { PHB phase_comb(a, F, layer, nrows); }
        SEAM();
    }
__global__ void __launch_bounds__(NTHR, 2) mk_fwd(Args a_) {
    extern __shared__ __attribute__((aligned(16))) unsigned char lds_raw[];
    Fr F0 = mkfr(lds_raw);
    volatile LAS unsigned* MISC = (volatile LAS unsigned*)(F0.lds + MISC_OFF);
    if (F0.tid < 32) MISC[F0.tid] = 0u;
    __syncthreads();
    if (a_.ph_hi - a_.ph_lo > 1) (void)xcd_barrier_post((unsigned*)(a_.ws + WS_CTL) + 4096, MISC + 8);
    int p = 0;
    PG8_LAS unsigned char* ring = (PG8_LAS unsigned char*)lds_raw;

    REPS if (IN()) { PHB phase_proA(a, F); }
    SEAM();
#if !MK_MERGE_PRO
    REPS if (IN()) { PHB phase_proB(a, F); }
    SEAM();
#endif
    layer_body<0>(p, lds_raw); layer_body<1>(p, lds_raw); layer_body<2>(p, lds_raw); layer_body<3>(p, lds_raw);
#undef IN
#undef PHB
#undef G1PTR
#undef SEAM
}

#ifndef MK_N_LAUNCHES
#define MK_N_LAUNCHES 0
#endif
extern "C" void kernel_launch(void* const* d_in, const int* in_sizes, int n_in, void* d_out, int out_size, void* d_ws, size_t ws_size, hipStream_t stream) {
    static int grid = 0;
    if (grid == 0) {
        if (n_in != 33 || out_size != T * D || ws_size < WS_END) { fprintf(stderr, "kernel_launch: expected 33 inputs, %d outputs, >= %zu bytes of workspace; got %d, %d, %zu\n", T * D, (size_t)WS_END, n_in, out_size, ws_size); grid = -1; return; }
        int dev = 0, cus = 0, per_cu = 0;
        if (hipGetDevice(&dev) != hipSuccess || hipDeviceGetAttribute(&cus, hipDeviceAttributeMultiprocessorCount, dev) != hipSuccess) { grid = -1; return; }
        if (hipFuncSetAttribute((const void*)mk_fwd, hipFuncAttributeMaxDynamicSharedMemorySize, LDS_BYTES) != hipSuccess) { fprintf(stderr, "kernel_launch: hipFuncSetAttribute failed\n"); grid = -1; return; }
        if (hipOccupancyMaxActiveBlocksPerMultiprocessor(&per_cu, (const void*)mk_fwd, NTHR, LDS_BYTES) != hipSuccess || per_cu < 1)
            fprintf(stderr, "kernel_launch: note: occupancy query reports %d workgroups per CU\n", per_cu);
        (void)hipGetLastError();
        grid = cus;
    }
    if (grid < 0) return;
    (void)hipMemsetAsync((char*)d_ws + WS_CTL, 0, 64 * 1024, stream);
    Args a{};
    for (int i = 0; i < 33; ++i) a.in[i] = (const float*)d_in[i];
    a.out = (float*)d_out; a.ws = (unsigned char*)d_ws;
#if MK_N_LAUNCHES == 1
    a.ph_lo = 0; a.ph_hi = N_PHASES;
    hipLaunchKernelGGL(mk_fwd, dim3(grid), dim3(NTHR), LDS_BYTES, stream, a);
#else
    for (int p = 0; p < N_PHASES; ++p) { a.ph_lo = p; a.ph_hi = p + 1; hipLaunchKernelGGL(mk_fwd, dim3(grid), dim3(NTHR), LDS_BYTES, stream, a); }
#endif
    const hipError_t le = hipPeekAtLastError();
    if (le != hipSuccess) fprintf(stderr, "kernel_launch: launch failed: %s\n", hipGetErrorName(le));
}
```

```cpp
#define MK_N_LAUNCHES 1
#define MK_FAST_ATTN 1
#define MK_FAST_CONV 1
#define MK_GATHER 1
#define MK_FAST_SP 1
#include <hip/hip_runtime.h>
#include <cstdio>
#include <cstdint>
#include <cmath>
namespace pg8 {
#define PG8_LAS __attribute__((address_space(3)))
typedef unsigned short bf16_t;
typedef short bf16x8 __attribute__((ext_vector_type(8)));
typedef float f32x4 __attribute__((ext_vector_type(4)));
typedef unsigned u32x4 __attribute__((ext_vector_type(4)));
typedef unsigned u32x2 __attribute__((ext_vector_type(2)));
constexpr int BM = 256, BK = 64, HALF = 128, HTB = HALF * BK * 2  , STAGE_BYTES = 8 * HTB, NXCD = 8, WGM = 8;

__host__ __device__ __forceinline__ int lds_byte(int r, int c) { const int st = (r >> 4) * 2 + (c >> 5), rr = r & 15, cc = c & 31, ob = rr * 64 + cc * 2; return st * 1024 + (ob ^ (((ob >> 9) & 1) << 5)); }
__host__ __device__ __forceinline__ void stage_rc(int b, int& R, int& C) { const int st = b / 1024, sb = b % 1024, swz = sb ^ (((sb >> 9) & 1) << 5); R = (st >> 1) * 16 + swz / 64; C = (st & 1) * 32 + (swz % 64) / 2; }
__host__ __device__ __forceinline__ int perm32(int rho) { const int n = rho >> 4, i = rho & 15; return 8 * (i >> 2) + 4 * n + (i & 3); }

struct Unit { int pm, pn; };
struct Gemm { const bf16_t* A; const bf16_t* Bt; int M, N, K; const int* rows; };

struct StaticOrder {
    int nM, nN, nwg, G, c;
    __host__ __device__ void init(int M, int N, int G_, int c_) { nM = M / BM; nN = N / BM; nwg = nM * nN; G = G_; c = c_; }
    __host__ __device__ bool next(int i, Unit& u) const {
        const long L = (long)i * G + c; if (L >= nwg) return false;
        int wgid = (int)L; { const int q = nwg / NXCD, r = nwg % NXCD, xcd = wgid % NXCD, off = wgid / NXCD; wgid = (xcd < r ? xcd * (q + 1) : r * (q + 1) + (xcd - r) * q) + off; }
        const int nig = WGM * nN, gid = wgid / nig, fm = gid * WGM, gsz = (nM - fm) < WGM ? (nM - fm) : WGM;
        u.pm = fm + ((wgid % nig) % gsz); u.pn = (wgid % nig) / gsz; return true;
    }
    __device__ __forceinline__ void a_ready(const Unit&) const {}
    __device__ __forceinline__ void done(const Unit&) const {}
};

__device__ __forceinline__ unsigned cvt_pk_bf16(float lo, float hi) { unsigned r; asm volatile("v_cvt_pk_bf16_f32 %0, %1, %2" : "=v"(r) : "v"(lo), "v"(hi)); return r; }
typedef float f32x2 __attribute__((ext_vector_type(2)));
__device__ __forceinline__ f32x2 gelu_pk(f32x2 v) {
    const f32x2 av = __builtin_elementwise_abs(v), d = av * 0.2316418882f + 1.0f;
    f32x2 t; t.x = __builtin_amdgcn_rcpf(d.x); t.y = __builtin_amdgcn_rcpf(d.y);
    f32x2 q = t * 0.5307027145f + (-0.7265760135f); q = q * t + 0.7107068705f; q = q * t + (-0.142248368f); q = q * t + 0.127414796f; q = q * t;
    const f32x2 s = (v * v) * (-0.72134752044f);
    f32x2 e; e.x = __builtin_amdgcn_exp2f(s.x); e.y = __builtin_amdgcn_exp2f(s.y);
    const f32x2 m = v * (q * e), r = v - m;
    f32x2 o; o.x = v.x < 0.f ? m.x : r.x; o.y = v.y < 0.f ? m.y : r.y; return o;
}

template <int ACT  > struct EpiBf16 {
    static constexpr bool PERM = true, AFTER_DRAIN = false; static_assert(ACT == 0 || ACT == 1, "EpiBf16: ACT is 0 (none) or 1 (gelu_pk)");
    bf16_t* O; int ldc; const float* bias; int split_cols; size_t split_stride; float scale0; float pre = 1.f;
    __device__ __forceinline__ void operator()(const f32x4 (&acc)[2][2][4][2], const Unit& u, int wr, int wc, int fr, int fq) const {
        const int row0 = u.pm * BM + wr * 64 + fr; int colt = u.pn * BM; bf16_t* base = O;
        float sc = 1.f; if (split_cols) { const int t = colt / split_cols; base += (size_t)t * split_stride; colt -= t * split_cols; if (t == 0) sc = scale0; }
        const int col0 = colt + wc * 32 + 8 * fq, bcol0 = u.pn * BM + wc * 32 + 8 * fq;
        f32x4 bv[2][2];
#pragma unroll
        for (int bj = 0; bj < 2; ++bj)
#pragma unroll
            for (int n = 0; n < 2; ++n) bv[bj][n] = bias ? *(const f32x4*)(bias + bcol0 + bj * HALF + 4 * n) : (f32x4){0.f, 0.f, 0.f, 0.f};
#pragma unroll
        for (int ai = 0; ai < 2; ++ai)
#pragma unroll
            for (int m = 0; m < 4; ++m) { bf16_t* rowp = base + (size_t)(row0 + ai * HALF + m * 16) * ldc + col0;
#pragma unroll
                for (int bj = 0; bj < 2; ++bj) { f32x4 v0 = acc[ai][bj][m][0] * pre + bv[bj][0], v1 = acc[ai][bj][m][1] * pre + bv[bj][1];
                    if (ACT == 1) { f32x2 a = gelu_pk((f32x2){v0[0], v0[1]}), b = gelu_pk((f32x2){v0[2], v0[3]}), c = gelu_pk((f32x2){v1[0], v1[1]}), d = gelu_pk((f32x2){v1[2], v1[3]});
                        v0 = (f32x4){a.x, a.y, b.x, b.y}; v1 = (f32x4){c.x, c.y, d.x, d.y}; }
                    v0 = v0 * sc; v1 = v1 * sc; u32x4 w; w.x = cvt_pk_bf16(v0[0], v0[1]); w.y = cvt_pk_bf16(v0[2], v0[3]); w.z = cvt_pk_bf16(v1[0], v1[1]); w.w = cvt_pk_bf16(v1[2], v1[3]);
                    *(u32x4*)(rowp + bj * HALF) = w; } }
    }
};

#ifndef MK_FP8_Y
#define MK_FP8_Y 1
#endif
struct EpiF32 {
    static constexpr bool PERM = false, AFTER_DRAIN = false;
    float* C; int ldc;
    __device__ __forceinline__ void operator()(const f32x4 (&acc)[2][2][4][2], const Unit& u, int wr, int wc, int fr, int fq) const {
        const int row0 = u.pm * BM + wr * 64 + fr, col0 = u.pn * BM + wc * 32 + 4 * fq;
#pragma unroll
        for (int ai = 0; ai < 2; ++ai)
#pragma unroll
            for (int m = 0; m < 4; ++m) { float* rowp = C + (size_t)(row0 + ai * HALF + m * 16) * ldc + col0;
#pragma unroll
                for (int bj = 0; bj < 2; ++bj)
#pragma unroll
                    for (int n = 0; n < 2; ++n) *(f32x4*)(rowp + bj * HALF + n * 16) = acc[ai][bj][m][n]; }
    }
};
struct EpiRes {
    static constexpr bool PERM = true, AFTER_DRAIN = false;
    const bf16_t* X; bf16_t* U; const float* g; int gstride; float alpha; float accs = 1.f;
    __device__ __forceinline__ void operator()(const f32x4 (&acc)[2][2][4][2], const Unit& u, int wr, int wc, int fr, int fq) const {
        const int row0 = u.pm * BM + wr * 64 + fr, col0 = u.pn * BM + wc * 32 + 8 * fq;
        const int rb = u.pm * BM; const int bidx = rb < 16384 ? (rb >> 12) : 4;
        const float* gp = g + (size_t)bidx * gstride + col0;
        f32x4 gv[2][2];
#pragma unroll
        for (int bj = 0; bj < 2; ++bj)
#pragma unroll
            for (int n = 0; n < 2; ++n) gv[bj][n] = *(const f32x4*)(gp + bj * HALF + 4 * n) * accs;
#pragma unroll
        for (int ai = 0; ai < 2; ++ai)
#pragma unroll
            for (int m = 0; m < 4; ++m) { const size_t off = (size_t)(row0 + ai * HALF + m * 16) * 1024 + col0;
#pragma unroll
                for (int bj = 0; bj < 2; ++bj) { const u32x4 xw = *(const u32x4*)(X + off + bj * HALF);
                    const f32x4 x0 = (f32x4){__builtin_bit_cast(float, xw.x << 16), __builtin_bit_cast(float, xw.x & 0xffff0000u), __builtin_bit_cast(float, xw.y << 16), __builtin_bit_cast(float, xw.y & 0xffff0000u)};
                    const f32x4 x1 = (f32x4){__builtin_bit_cast(float, xw.z << 16), __builtin_bit_cast(float, xw.z & 0xffff0000u), __builtin_bit_cast(float, xw.w << 16), __builtin_bit_cast(float, xw.w & 0xffff0000u)};
                    const f32x4 u0 = x0 * alpha + gv[bj][0] * acc[ai][bj][m][0], u1 = x1 * alpha + gv[bj][1] * acc[ai][bj][m][1];
                    u32x4 uw; uw.x = cvt_pk_bf16(u0[0], u0[1]); uw.y = cvt_pk_bf16(u0[2], u0[3]); uw.z = cvt_pk_bf16(u1[0], u1[1]); uw.w = cvt_pk_bf16(u1[2], u1[3]);
                    *(u32x4*)(U + off + bj * HALF) = uw; }
                asm volatile("" ::: "memory"); }
    }
};
struct EpiNull {
    static constexpr bool PERM = true, AFTER_DRAIN = false;
    __device__ __forceinline__ void operator()(const f32x4 (&acc)[2][2][4][2], const Unit& u, int wr, int wc, int fr, int fq) const {
        f32x4 s = (f32x4){0.f, 0.f, 0.f, 0.f};
#pragma unroll
        for (int ai = 0; ai < 2; ++ai)
#pragma unroll
            for (int bj = 0; bj < 2; ++bj)
#pragma unroll
                for (int m = 0; m < 4; ++m)
#pragma unroll
                    for (int n = 0; n < 2; ++n) s += acc[ai][bj][m][n];
        asm volatile("" :: "v"(s));
    }
};
struct EpiGUnostore {
    static constexpr bool PERM = true, AFTER_DRAIN = false;
    __device__ __forceinline__ void operator()(const f32x4 (&acc)[2][2][4][2], const Unit& u, int wr, int wc, int fr, int fq) const {
#pragma unroll
        for (int ai = 0; ai < 2; ++ai)
#pragma unroll
            for (int m = 0; m < 4; ++m) { float o[8];
#pragma unroll
                for (int n = 0; n < 2; ++n)
#pragma unroll
                    for (int j = 0; j < 4; ++j) { const float a = acc[ai][0][m][n][j], b = acc[ai][1][m][n][j];
                        const float s = a * __builtin_amdgcn_rcpf(1.0f + __builtin_amdgcn_exp2f(-1.4426950408889634f * a)); o[n * 4 + j] = s * b; }
                u32x4 w; w.x = cvt_pk_bf16(o[0], o[1]); w.y = cvt_pk_bf16(o[2], o[3]); w.z = cvt_pk_bf16(o[4], o[5]); w.w = cvt_pk_bf16(o[6], o[7]);
                asm volatile("" :: "v"(w)); }
    }
};
struct EpiGU {
    static constexpr bool PERM = true, AFTER_DRAIN = false;
    bf16_t* ACT; int npn;
    __device__ __forceinline__ void operator()(const f32x4 (&acc)[2][2][4][2], const Unit& u, int wr, int wc, int fr, int fq) const {
        const int row0 = u.pm * BM + wr * 64 + fr; const int col0 = (u.pn % npn) * 128 + wc * 32 + 8 * fq;
#pragma unroll
        for (int ai = 0; ai < 2; ++ai)
#pragma unroll
            for (int m = 0; m < 4; ++m) { bf16_t* rowp = ACT + (size_t)(row0 + ai * HALF + m * 16) * 2048 + col0;
                float o[8];
#pragma unroll
                for (int n = 0; n < 2; ++n)
#pragma unroll
                    for (int j = 0; j < 4; ++j) { const float a = acc[ai][0][m][n][j], b = acc[ai][1][m][n][j];
                        const float s = a * __builtin_amdgcn_rcpf(1.0f + __builtin_amdgcn_exp2f(-1.4426950408889634f * a)); o[n * 4 + j] = s * b; }
                u32x4 w; w.x = cvt_pk_bf16(o[0], o[1]); w.y = cvt_pk_bf16(o[2], o[3]); w.z = cvt_pk_bf16(o[4], o[5]); w.w = cvt_pk_bf16(o[6], o[7]);
                *(u32x4*)rowp = w; }
    }
};
template <bool OUT8> struct EpiGU8 {
    static constexpr bool PERM = true, AFTER_DRAIN = false;
    unsigned char* ACT; int npn; float inscale, outscale;
    __device__ __forceinline__ void operator()(const f32x4 (&acc)[2][2][4][2], const Unit& u, int wr, int wc, int fr, int fq) const {
        const int row0 = u.pm * BM + wr * 64 + fr; const int col0 = (u.pn % npn) * 128 + wc * 32 + 8 * fq;
        const float ka = -1.4426950408889634f * inscale, kb = inscale * inscale * outscale;
#pragma unroll
        for (int ai = 0; ai < 2; ++ai)
#pragma unroll
            for (int m = 0; m < 4; ++m) { unsigned char* rowp = ACT + ((size_t)(row0 + ai * HALF + m * 16) * 2048 + col0) * (OUT8 ? 1 : 2);
                float o[8];
#pragma unroll
                for (int n = 0; n < 2; ++n)
#pragma unroll
                    for (int j = 0; j < 4; ++j) { const float a = acc[ai][0][m][n][j], b = acc[ai][1][m][n][j];
                        o[n * 4 + j] = a * __builtin_amdgcn_rcpf(1.0f + __builtin_amdgcn_exp2f(ka * a)) * (b * kb); }
                if constexpr (OUT8) {
#pragma unroll
                    for (int q = 0; q < 8; ++q) o[q] = __builtin_amdgcn_fmed3f(o[q], -448.0f, 448.0f);
                    unsigned w0 = 0u, w1 = 0u;
                    w0 = __builtin_amdgcn_cvt_pk_fp8_f32(o[0], o[1], w0, false); w0 = __builtin_amdgcn_cvt_pk_fp8_f32(o[2], o[3], w0, true);
                    w1 = __builtin_amdgcn_cvt_pk_fp8_f32(o[4], o[5], w1, false); w1 = __builtin_amdgcn_cvt_pk_fp8_f32(o[6], o[7], w1, true);
                    typedef unsigned u32x2_ __attribute__((ext_vector_type(2)));
                    *(u32x2_*)rowp = (u32x2_){w0, w1}; }
                else { u32x4 w; w.x = cvt_pk_bf16(o[0], o[1]); w.y = cvt_pk_bf16(o[2], o[3]); w.z = cvt_pk_bf16(o[4], o[5]); w.w = cvt_pk_bf16(o[6], o[7]); *(u32x4*)rowp = w; } }
    }
};
struct EpiDN {
    static constexpr bool PERM = true, AFTER_DRAIN = false;
    bf16_t* Y; const float* gate; int npn; float scale;
    __device__ __forceinline__ void operator()(const f32x4 (&acc)[2][2][4][2], const Unit& u, int wr, int wc, int fr, int fq) const {
        const int row0 = u.pm * BM + wr * 64 + fr, col0 = (u.pn % npn) * BM + wc * 32 + 8 * fq;
#pragma unroll
        for (int ai = 0; ai < 2; ++ai)
#pragma unroll
            for (int m = 0; m < 4; ++m) { const int row = row0 + ai * HALF + m * 16; const float gt = gate[row] * scale; bf16_t* rowp = Y + (size_t)row * 1024 + col0;
#pragma unroll
                for (int bj = 0; bj < 2; ++bj) { const f32x4 v0 = acc[ai][bj][m][0] * gt, v1 = acc[ai][bj][m][1] * gt;
#if MK_FP8_Y
                    unsigned w0 = 0u, w1 = 0u;
                    w0 = __builtin_amdgcn_cvt_pk_fp8_f32(__builtin_amdgcn_fmed3f(v0[0], -448.0f, 448.0f), __builtin_amdgcn_fmed3f(v0[1], -448.0f, 448.0f), w0, false);
                    w0 = __builtin_amdgcn_cvt_pk_fp8_f32(__builtin_amdgcn_fmed3f(v0[2], -448.0f, 448.0f), __builtin_amdgcn_fmed3f(v0[3], -448.0f, 448.0f), w0, true);
                    w1 = __builtin_amdgcn_cvt_pk_fp8_f32(__builtin_amdgcn_fmed3f(v1[0], -448.0f, 448.0f), __builtin_amdgcn_fmed3f(v1[1], -448.0f, 448.0f), w1, false);
                    w1 = __builtin_amdgcn_cvt_pk_fp8_f32(__builtin_amdgcn_fmed3f(v1[2], -448.0f, 448.0f), __builtin_amdgcn_fmed3f(v1[3], -448.0f, 448.0f), w1, true);
                    *(u32x2*)((unsigned char*)Y + (size_t)row * 1024 + col0 + bj * HALF) = (u32x2){w0, w1}; } }
#else
                    u32x4 w; w.x = cvt_pk_bf16(v0[0], v0[1]); w.y = cvt_pk_bf16(v0[2], v0[3]); w.z = cvt_pk_bf16(v1[0], v1[1]); w.w = cvt_pk_bf16(v1[2], v1[3]);
                    *(u32x4*)(rowp + bj * HALF) = w; } }
#endif
    }
};
struct EpiVT {
    static constexpr bool PERM = true, AFTER_DRAIN = false;
    bf16_t* VT; int ldc; f32x2* VST; int ntok; float pre = 1.f;
    __device__ __forceinline__ void operator()(const f32x4 (&acc)[2][2][4][2], const Unit& u, int wr, int wc, int fr, int fq) const {
        const int row0 = u.pm * BM + wr * 64 + fr, col0 = u.pn * BM + wc * 32 + 8 * fq;
        f32x4 s1[2][2], s2[2][2];
#pragma unroll
        for (int bj = 0; bj < 2; ++bj)
#pragma unroll
            for (int n = 0; n < 2; ++n) { s1[bj][n] = (f32x4){0.f, 0.f, 0.f, 0.f}; s2[bj][n] = (f32x4){0.f, 0.f, 0.f, 0.f}; }
#pragma unroll
        for (int ai = 0; ai < 2; ++ai)
#pragma unroll
            for (int m = 0; m < 4; ++m) { bf16_t* rowp = VT + (size_t)(row0 + ai * HALF + m * 16) * ldc + col0;
#pragma unroll
                for (int bj = 0; bj < 2; ++bj) { u32x4 gw;
#pragma unroll
                    for (int n = 0; n < 2; ++n) { const f32x4 v = acc[ai][bj][m][n] * pre; const f32x2 a = gelu_pk((f32x2){v[0], v[1]}), b = gelu_pk((f32x2){v[2], v[3]});
                        const f32x4 gl = (f32x4){a.x, a.y, b.x, b.y}; if (n == 0) { gw.x = cvt_pk_bf16(gl[0], gl[1]); gw.y = cvt_pk_bf16(gl[2], gl[3]); } else { gw.z = cvt_pk_bf16(gl[0], gl[1]); gw.w = cvt_pk_bf16(gl[2], gl[3]); }
                        s1[bj][n] += gl; s2[bj][n] += gl * gl; }
                    *(u32x4*)(rowp + bj * HALF) = gw; } }
#pragma unroll
        for (int bj = 0; bj < 2; ++bj)
#pragma unroll
            for (int n = 0; n < 2; ++n)
#pragma unroll
                for (int j = 0; j < 4; ++j) { float a = s1[bj][n][j], b = s2[bj][n][j];
#pragma unroll
                    for (int o = 1; o < 16; o <<= 1) { a += __shfl_xor(a, o); b += __shfl_xor(b, o); }
                    s1[bj][n][j] = a; s2[bj][n][j] = b; }
        if (fr == 0) {
            f32x2* dst = VST + (size_t)(u.pm * 2 + wr) * ntok + col0;
#pragma unroll
            for (int bj = 0; bj < 2; ++bj)
#pragma unroll
                for (int n = 0; n < 2; ++n)
#pragma unroll
                    for (int j = 0; j < 4; ++j) dst[bj * HALF + 4 * n + j] = (f32x2){s1[bj][n][j], s2[bj][n][j]};
        }
    }
};
struct MoeOrder {
    int nPM, nPN, G, vcu; int fixed = 0;
    __device__ __forceinline__ bool next(int i, Unit& u) const {
        const int L = i * G + vcu; if (L >= 16 * nPM * nPN) return false;
        const int pm = L % nPM, r = L / nPM, pn = r % nPN, e = r / nPN; u.pm = e * 9 + pm; u.pn = e * nPN + pn;
#if defined(MK_FIXEDUNIT)
        if (fixed) { u.pm = 0; u.pn = 0; }
#endif
        return true;
    }
    __device__ __forceinline__ void a_ready(const Unit&) const {}
    __device__ __forceinline__ void done(const Unit&) const {}
};

template <class Epi, class Sched, bool ALIGN_EPI = false, bool GATHER = false, bool FP8 = false>
__device__ __forceinline__ void gemm_phase(PG8_LAS unsigned char* lds, const Gemm g, const Sched& S, const Epi& E) {
    int tid_ = threadIdx.x; asm volatile("" : "+v"(tid_));
    const int tid = tid_, wid = __builtin_amdgcn_readfirstlane(tid >> 6), lane = tid & 63, wr = wid >> 2, wc = wid & 3, fr = lane & 15, fq = lane >> 4;
    const int K = g.K, nt = K / BK;
    unsigned voffA[2], voffB[2];
#pragma unroll
    for (int i = 0; i < 2; ++i) { int R, C; stage_rc(tid * 16 + i * 8192, R, C); const int Rb = Epi::PERM ? ((R & ~31) + perm32(R & 31)) : R;
        voffA[i] = (unsigned)(R * K + C) * 2u; voffB[i] = (unsigned)(Rb * K + C) * 2u; }
    const size_t kstep = (size_t)(BK * 2);
    const size_t hstep = (size_t)HALF * K * 2;
    const size_t tstep = 2 * hstep;
    const unsigned ldsw = (unsigned)wid * 1024u;
    const int aoff = lds_byte(wr * 64 + fr, fq * 8), boff = lds_byte(wc * 32 + fr, fq * 8);
#define PG8_SA(b, h) (((b) * 2 + (h)) * HTB)
#define PG8_SB(b, h) ((4 + (b) * 2 + (h)) * HTB)
#define PG8_STAGE(bufoff, gbase, voff) do { _Pragma("unroll") for (int _i = 0; _i < 2; ++_i) \
        __builtin_amdgcn_global_load_lds((const unsigned*)((const char*)(gbase) + (voff)[_i]), (PG8_LAS unsigned*)(lds + (bufoff) + ldsw + _i * 8192), 16, 0, 0); } while (0)
#define PG8_STGA(b, h, ubase, koff, gofs) do { if constexpr (GATHER) { PG8_STAGE(PG8_SA(b, h), (const char*)g.A + (koff), gofs[h]); } \
        else { PG8_STAGE(PG8_SA(b, h), (ubase) + (koff) + (size_t)(h) * hstep, voffA); } } while (0)
#define PG8_GLOAD(dst, u) do { if constexpr (GATHER) { _Pragma("unroll") for (int _i = 0; _i < 2; ++_i) { int _R, _C; stage_rc(tid * 16 + _i * 8192, _R, _C); \
        _Pragma("unroll") for (int _h = 0; _h < 2; ++_h) dst[_h][_i] = (unsigned)g.rows[(u).pm * BM + _h * HALF + _R] * (unsigned)(K * 2) + (unsigned)_C * 2u; } } } while (0)
#define PG8_LDA(dst, b, h) do { _Pragma("unroll") for (int m = 0; m < 4; ++m) _Pragma("unroll") for (int k = 0; k < 2; ++k) dst[m][k] = *(const PG8_LAS bf16x8*)(lds + PG8_SA(b, h) + aoff + m * 2048 + k * 1024); } while (0)
#define PG8_LDB(dst, b, h) do { _Pragma("unroll") for (int n = 0; n < 2; ++n) _Pragma("unroll") for (int k = 0; k < 2; ++k) dst[n][k] = *(const PG8_LAS bf16x8*)(lds + PG8_SB(b, h) + boff + n * 2048 + k * 1024); } while (0)
#define PG8_CAT8(x0, x1) __builtin_shufflevector(__builtin_bit_cast(v4i_t, x0), __builtin_bit_cast(v4i_t, x1), 0, 1, 2, 3, 4, 5, 6, 7)
#define PG8_MMA(ai, bj, At, Bt) do { __builtin_amdgcn_s_setprio(1); _Pragma("unroll") for (int m = 0; m < 4; ++m) _Pragma("unroll") for (int n = 0; n < 2; ++n) { \
        if constexpr (FP8) { asm volatile("v_mfma_scale_f32_16x16x128_f8f6f4 %0, %1, %2, %0, %3, %3 op_sel_hi:[0,0,0]" : "+v"(acc[ai][bj][m][n]) : "v"(PG8_CAT8(Bt[n][0], Bt[n][1])), "v"(PG8_CAT8(At[m][0], At[m][1])), "v"(0x7F7F7F7F)); } \
        else { _Pragma("unroll") for (int k = 0; k < 2; ++k) acc[ai][bj][m][n] = __builtin_amdgcn_mfma_f32_16x16x32_bf16(Bt[n][k], At[m][k], acc[ai][bj][m][n], 0, 0, 0); } } \
        __builtin_amdgcn_s_setprio(0); } while (0)
#define PG8_WAIT_V(n) asm volatile("s_waitcnt vmcnt(" #n ")" ::: "memory")
#define PG8_WAIT_L(n) asm volatile("s_waitcnt lgkmcnt(" #n ")" ::: "memory")
#define PG8_BAR __builtin_amdgcn_s_barrier()
#define PG8_SCHED __builtin_amdgcn_sched_barrier(0)
    Unit cur, nxt; int ui = 0;
    if (!S.next(0, cur)) return;
    f32x4 acc[2][2][4][2];
#pragma unroll
    for (int a = 0; a < 2; ++a)
#pragma unroll
        for (int b = 0; b < 2; ++b)
#pragma unroll
            for (int m = 0; m < 4; ++m)
#pragma unroll
                for (int n = 0; n < 2; ++n) acc[a][b][m][n] = (f32x4){0.f, 0.f, 0.f, 0.f};
    bf16x8 At[4][2], B0[2][2], B1[2][2];
    typedef int v8i_t __attribute__((ext_vector_type(8))); typedef int v4i_t __attribute__((ext_vector_type(4)));
    unsigned gc[2][2] = {{0u, 0u}, {0u, 0u}}, gn[2][2] = {{0u, 0u}, {0u, 0u}};
    const char* cA = GATHER ? (const char*)g.A : (const char*)g.A + (size_t)cur.pm * tstep; const char* cB = (const char*)g.Bt + (size_t)cur.pn * tstep;
    S.a_ready(cur);
    PG8_GLOAD(gc, cur);
    PG8_STAGE(PG8_SB(0, 0), cB, voffB); PG8_STAGE(PG8_SB(0, 1), cB + hstep, voffB); PG8_STGA(0, 0, cA, 0, gc); PG8_STGA(0, 1, cA, 0, gc);
    if (wr == 1) PG8_BAR;
    PG8_WAIT_V(2); PG8_BAR;
    PG8_STAGE(PG8_SB(1, 0), cB + kstep, voffB); PG8_STGA(1, 0, cA, kstep, gc); PG8_STAGE(PG8_SB(1, 1), cB + hstep + kstep, voffB);
    PG8_WAIT_V(6); PG8_BAR;
    for (;;) {
        const bool has_next = S.next(ui + 1, nxt);
        const char* nA = GATHER ? (const char*)g.A : (has_next ? (const char*)g.A + (size_t)nxt.pm * tstep : cA); const char* nB = has_next ? (const char*)g.Bt + (size_t)nxt.pn * tstep : cB;
#pragma unroll 1
        for (int t = 0; t < nt; t += 2) {
            const bool last = (t == nt - 2);
            const size_t k1 = (size_t)(t + 1) * kstep;
            const char* b2 = last ? nB : cB + (size_t)(t + 2) * kstep; const char* b3 = b2 + kstep;
            if (last && has_next) S.a_ready(nxt);
            if (last) { if (has_next) { PG8_GLOAD(gn, nxt); } else {
#pragma unroll
                    for (int h = 0; h < 2; ++h)
#pragma unroll
                        for (int i = 0; i < 2; ++i) gn[h][i] = gc[h][i]; } }
            PG8_LDB(B0, 0, 0); PG8_LDB(B1, 0, 1); PG8_SCHED; PG8_LDA(At, 0, 0); PG8_STGA(1, 1, cA, k1, gc);
            PG8_WAIT_V(8); PG8_WAIT_L(0); PG8_BAR; PG8_MMA(0, 0, At, B0); PG8_MMA(0, 1, At, B1); PG8_BAR; PG8_SCHED;
            PG8_LDA(At, 0, 1); PG8_STAGE(PG8_SB(0, 0), b2, voffB); PG8_STAGE(PG8_SB(0, 1), b2 + hstep, voffB);
            if (last) { PG8_STGA(0, 0, nA, 0, gn); } else { PG8_STGA(0, 0, cA, (size_t)(t + 2) * kstep, gc); }
            PG8_WAIT_V(8); PG8_WAIT_L(0); PG8_BAR; PG8_MMA(1, 0, At, B0); PG8_MMA(1, 1, At, B1); PG8_BAR; PG8_SCHED;
            PG8_LDB(B0, 1, 0); PG8_LDB(B1, 1, 1); PG8_SCHED; PG8_LDA(At, 1, 0);
            if (last) { PG8_STGA(0, 1, nA, 0, gn); } else { PG8_STGA(0, 1, cA, (size_t)(t + 2) * kstep, gc); }
            PG8_WAIT_V(8); PG8_WAIT_L(0); PG8_BAR; PG8_MMA(0, 0, At, B0); PG8_MMA(0, 1, At, B1); PG8_BAR; PG8_SCHED;
            PG8_LDA(At, 1, 1); PG8_STAGE(PG8_SB(1, 0), b3, voffB); PG8_STAGE(PG8_SB(1, 1), b3 + hstep, voffB);
            if (last) { PG8_STGA(1, 0, nA, kstep, gn); } else { PG8_STGA(1, 0, cA, (size_t)(t + 3) * kstep, gc); }
            PG8_WAIT_V(8); PG8_WAIT_L(0); PG8_BAR; PG8_MMA(1, 0, At, B0); PG8_MMA(1, 1, At, B1); PG8_BAR; PG8_SCHED;
        }
        if constexpr (ALIGN_EPI) { if (wr == 0) PG8_BAR; }
        if constexpr (FP8) asm volatile("s_nop 15\n\ts_nop 15" ::: "memory");
        if constexpr (!Epi::AFTER_DRAIN) { E(acc, cur, wr, wc, fr, fq); S.done(cur); }
        if (!has_next) break;
#pragma unroll
        for (int a = 0; a < 2; ++a)
#pragma unroll
            for (int b = 0; b < 2; ++b)
#pragma unroll
                for (int m = 0; m < 4; ++m)
#pragma unroll
                    for (int n = 0; n < 2; ++n) acc[a][b][m][n] = (f32x4){0.f, 0.f, 0.f, 0.f};
        if constexpr (FP8) asm volatile("s_nop 7" ::: "memory");
        cur = nxt; cA = nA; cB = nB; ++ui;
#pragma unroll
        for (int h = 0; h < 2; ++h)
#pragma unroll
            for (int i = 0; i < 2; ++i) gc[h][i] = gn[h][i];
        if constexpr (ALIGN_EPI) { if (wr == 1) PG8_BAR; }
    }
    PG8_WAIT_V(0);
    if constexpr (!ALIGN_EPI) { if (wr == 0) PG8_BAR; }
    PG8_BAR;
    if constexpr (Epi::AFTER_DRAIN) { E.fused(acc, cur, wr, wc, fr, fq, lds, wid, lane); S.done(cur); }
#undef PG8_SA
#undef PG8_SB
#undef PG8_STAGE
#undef PG8_STGA
#undef PG8_GLOAD
#undef PG8_LDA
#undef PG8_LDB
#undef PG8_MMA
#undef PG8_CAT8
#undef PG8_WAIT_V
#undef PG8_WAIT_L
#undef PG8_BAR
#undef PG8_SCHED
}
}
constexpr int NB = 4, SEQ = 4096, T = NB * SEQ, LC = 256, TC = NB * LC, TA = T + TC, D = 1024;
constexpr int NE = 16, FF = 2048, ESTR = 2304;
constexpr int LK = LC + SEQ, KVP = 256;
constexpr float ALPHA = 1.6817928305074290f;
constexpr float LN_EPS = 1e-5f, RMS_EPS = 1e-6f;
constexpr float ATT_C2 = 0.125f * 1.4426950408889634f;
constexpr int NWAVES = 8, NTHR = 512;
constexpr size_t MiB = 1u << 20;
constexpr size_t WS_CTL = 0, WS_MOD = 1 * MiB, WS_MODP = 2 * MiB, WS_TW = 6 * MiB;
constexpr size_t WS_WHYIN = 8 * MiB, WS_WHYOUT = 20 * MiB, WS_WQKV = 24 * MiB, WS_WATO = 27 * MiB, WS_WCMIN = 29 * MiB, WS_WCMOUT = 37 * MiB, WS_WCMS = 41 * MiB;
constexpr size_t WS_WGU = 42 * MiB, WS_WDN = 554 * MiB, WS_HF = 810 * MiB;
constexpr size_t WS_XL = 942 * MiB, WS_U = 1010 * MiB, WS_HB = 1078 * MiB, WS_AFF = 1112 * MiB, WS_ROWS = 1114 * MiB, WS_GATE = WS_ROWS + 256 * 1024, WS_INV = 1115 * MiB;
constexpr size_t WS_ACT = 1117 * MiB, WS_Y = 1261 * MiB, WS_SCR = 1405 * MiB, WS_XC = 1677 * MiB, WS_END = 1745 * MiB;
constexpr size_t WS_XG = WS_Y;
constexpr size_t SC_PT = WS_SCR, SC_Z2T = WS_SCR + 204 * MiB, SC_Z2 = WS_SCR + 238 * MiB;
constexpr size_t SC_QKV = WS_SCR, SC_Q = WS_SCR + 102 * MiB, SC_K = WS_SCR + 134 * MiB, SC_V = WS_SCR + 143 * MiB, SC_O = WS_SCR + 152 * MiB;
constexpr size_t SC_UB = WS_SCR, SC_VT = WS_SCR + 64 * MiB, SC_VST = WS_SCR + 192 * MiB, SC_UV = WS_SCR + 194 * MiB;
constexpr size_t HF_SLOT = (size_t)4 * 1024 * 4096 * 4, HF_CTX = 2 * HF_SLOT;
constexpr int LDS_BYTES = 147456;
constexpr int RING_BYTES = 131072, MISC_OFF = LDS_BYTES - 256;

#define GAS __attribute__((address_space(1)))
#define LAS __attribute__((address_space(3)))
typedef unsigned short bf16;
typedef unsigned v4u __attribute__((ext_vector_type(4)));
typedef unsigned v2u __attribute__((ext_vector_type(2)));
typedef float f32x4 __attribute__((ext_vector_type(4)));
typedef float f32x2 __attribute__((ext_vector_type(2)));
#define LDS_WAIT() asm volatile("s_waitcnt lgkmcnt(0)" ::: "memory")
__device__ __forceinline__ unsigned f2bf(float f) { unsigned u = __builtin_bit_cast(unsigned, f); return (u + 0x7fffu + ((u >> 16) & 1u)) >> 16; }
__device__ __forceinline__ unsigned pk2(float lo, float hi) { unsigned r; asm("v_cvt_pk_bf16_f32 %0, %1, %2" : "=v"(r) : "v"(lo), "v"(hi)); return r; }
__device__ __forceinline__ unsigned pk4_e4m3(f32x4 h) { unsigned o8 = 0u;
    o8 = __builtin_amdgcn_cvt_pk_fp8_f32(__builtin_amdgcn_fmed3f(h[0], -448.0f, 448.0f), __builtin_amdgcn_fmed3f(h[1], -448.0f, 448.0f), o8, false);
    o8 = __builtin_amdgcn_cvt_pk_fp8_f32(__builtin_amdgcn_fmed3f(h[2], -448.0f, 448.0f), __builtin_amdgcn_fmed3f(h[3], -448.0f, 448.0f), o8, true); return o8; }
__device__ __forceinline__ f32x4 up4(v2u w) { return (f32x4){__builtin_bit_cast(float, w.x << 16), __builtin_bit_cast(float, w.x & 0xffff0000u), __builtin_bit_cast(float, w.y << 16), __builtin_bit_cast(float, w.y & 0xffff0000u)}; }
__device__ __forceinline__ float bf2f(unsigned short b) { return __builtin_bit_cast(float, (unsigned)b << 16); }
__device__ __forceinline__ float wave_sum(float v) {
#pragma unroll
    for (int o = 1; o < 64; o <<= 1) v += __shfl_xor(v, o);
    return v;
}

#ifndef MK_FP8_HYIN
#define MK_FP8_HYIN 1
#endif
constexpr float WH_SCALE = 64.0f;
#ifndef MK_FP8_CMIN
#define MK_FP8_CMIN 0
#endif
#ifndef MK_FP8_CMV
#define MK_FP8_CMV 0
#endif
constexpr size_t WS_HB8B = 943 * (1ull << 20);
#ifndef MK_FP8_HYOUT
#define MK_FP8_HYOUT 1
#endif
constexpr float Z_SCALE = 8.0f;
#ifndef MK_FP8_AOUT
#define MK_FP8_AOUT 1
#endif
constexpr float O_SCALE = 16.0f;
#ifndef MK_FP8_CMOUT
#define MK_FP8_CMOUT 0
#endif
constexpr float Y_SCALE = 64.0f;
#ifndef MK_FP8_QKV
#define MK_FP8_QKV 1
#endif
#ifndef MK_LNR_WREG
#define MK_LNR_WREG 0
#endif
#ifndef MK_LNR_WIDE
#define MK_LNR_WIDE 1
#endif
#ifndef MK_COMB_WIDE
#define MK_COMB_WIDE 1
#endif
#ifndef MK_MERGE_PRO
#define MK_MERGE_PRO 0
#endif
#ifndef MK_FOLLOW_L1INV
#define MK_FOLLOW_L1INV 0
#endif
#ifndef MK_EARLY_WB
#define MK_EARLY_WB 0
#endif
#define XB_TMO      128
#define XB_XCNT(j)  (256  + 64 * (j))
#define XB_XSUB(j)  (1280 + 64 * (j))
#define XB_XGEN(j)  (2304 + 64 * (j))
#define XB_TOP      3328
#define XB_TOPGEN   3392
#define XCD_BAR_WORDS 3456
#define XB_SPIN_CAP (1u << 18)
__device__ __forceinline__ unsigned xb_ld(unsigned* p)              { return __hip_atomic_load(p, __ATOMIC_RELAXED, __HIP_MEMORY_SCOPE_AGENT); }
__device__ __forceinline__ unsigned xb_add(unsigned* p, unsigned v) { return __hip_atomic_fetch_add(p, v, __ATOMIC_RELAXED, __HIP_MEMORY_SCOPE_AGENT); }
__device__ __forceinline__ unsigned xb_xcc_id() { return (unsigned)__builtin_amdgcn_s_getreg((3 << 11) | 20) & 0xFu; }
#define XB_SPIN(cond, bar) do { unsigned _sp = 0; while (cond) { __builtin_amdgcn_s_sleep(1); \
    if ((++_sp & 255u) == 0u) { if (xb_ld(&(bar)[XB_TMO])) break; if (_sp > XB_SPIN_CAP) { atomicAdd(&(bar)[XB_TMO], 1u); break; } } } } while (0)
struct XcdBarrier { unsigned* bar; unsigned x; volatile LAS unsigned* st; };
__device__ __forceinline__ XcdBarrier xcd_barrier_post(unsigned* bar, volatile LAS unsigned* st) {
    XcdBarrier b; b.bar = bar; b.x = xb_xcc_id(); b.st = st;
    if (threadIdx.x == 0) (void)xb_add(&bar[XB_XCNT(b.x)], 1u);
    return b;
}
__device__ __forceinline__ void xcd_barrier_complete(unsigned* bar, unsigned x, unsigned& nloc, unsigned& nx) {
    const unsigned G = gridDim.x * gridDim.y * gridDim.z;
    unsigned sum, cnt, mine, sp = 0u;
    for (;;) {
        sum = 0u; cnt = 0u; mine = 0u;
#pragma unroll
        for (unsigned j = 0; j < 16; ++j) { const unsigned c = xb_ld(&bar[XB_XCNT(j)]); sum += c; cnt += (c > 0u) ? 1u : 0u; mine = (j == x) ? c : mine; }
        if (sum == G) break;
        __builtin_amdgcn_s_sleep(1);
        if ((++sp & 255u) == 0u) { if (xb_ld(&bar[XB_TMO])) break; if (sp > XB_SPIN_CAP) { atomicAdd(&bar[XB_TMO], 1u); break; } }
    }
    nloc = mine > 0u ? mine : 1u; nx = cnt > 0u ? cnt : 1u;
}
__device__ __forceinline__ void xcd_barrier(const XcdBarrier& b) {
    asm volatile("s_waitcnt vmcnt(0)" ::: "memory");
    __syncthreads();
    if (threadIdx.x == 0) {
        unsigned* bar = b.bar; asm volatile("" : "+s"(bar));
        __builtin_amdgcn_s_waitcnt(0);
        unsigned bx_ = b.x; asm volatile("" : "+s"(bx_));
        unsigned nloc = b.st[0], nx = b.st[1];
        if (nloc == 0u) { xcd_barrier_complete(bar, bx_, nloc, nx); b.st[0] = nloc; b.st[1] = nx; }
#if MK_EARLY_WB
        asm volatile("buffer_wbl2 sc1" ::: "memory");
#endif
        const unsigned old = xb_add(&bar[XB_XSUB(bx_)], 1u);
        const unsigned gen = old / nloc;
        if (old + 1u == (gen + 1u) * nloc) {
            __builtin_amdgcn_fence(__ATOMIC_RELEASE, "agent");
            asm volatile("s_waitcnt vmcnt(0)" ::: "memory");
            const unsigned og = xb_add(&bar[XB_TOP], 1u);
            const unsigned tg = og / nx;
            if (og + 1u == (tg + 1u) * nx) xb_add(&bar[XB_TOPGEN], 1u);
            else XB_SPIN(xb_ld(&bar[XB_TOPGEN]) == tg, bar);
            __builtin_amdgcn_fence(__ATOMIC_ACQUIRE, "agent");
            xb_add(&bar[XB_XGEN(bx_)], 1u);
            asm volatile("s_waitcnt vmcnt(0)" ::: "memory");
        } else {
            XB_SPIN(xb_ld(&bar[XB_XGEN(bx_)]) == gen, bar);
#if MK_FOLLOW_L1INV
            asm volatile("buffer_inv sc0" ::: "memory");
#else
            __builtin_amdgcn_fence(__ATOMIC_ACQUIRE, "agent");
#endif
            asm volatile("s_waitcnt vmcnt(0)" ::: "memory");
        }
    }
    __syncthreads();
}

struct Args { const float* in[33]; float* out; unsigned char* ws; int ph_lo, ph_hi; };
enum { I_X = 0, I_C, I_CTX, I_CCTX, I_MODW, I_MODB, I_LNG, I_LNB, I_HYWIN, I_HYCW, I_HYCB, I_FW1, I_FB1, I_FW2, I_FB2, I_FW3, I_FFREQ, I_FBIAS, I_HYWOUT,
       I_WQKV, I_QGAIN, I_KGAIN, I_WATO, I_CMWIN, I_CMLNG, I_CMLNB, I_CMWS, I_CMBS, I_CMWOUT, I_ROUTER, I_WGATE, I_WUP, I_WDOWN };
typedef const __attribute__((address_space(4))) Args* ArgsP;
__device__ __forceinline__ ArgsP get_args() { auto p = __builtin_amdgcn_kernarg_segment_ptr(); asm volatile("" : "+s"(p)); return (ArgsP)p; }
struct Fr { LAS unsigned char* lds; int tid, lane, wave, vcu, G, bx; };
__device__ __forceinline__ Fr mkfr(unsigned char* lds_raw) {
    Fr F; int tid = threadIdx.x; asm volatile("" : "+v"(tid)); int bx = blockIdx.x, G = gridDim.x; asm volatile("" : "+s"(bx), "+s"(G));
    F.lds = (LAS unsigned char*)lds_raw; F.tid = tid; F.lane = tid & 63; F.wave = __builtin_amdgcn_readfirstlane(tid >> 6);
    F.G = G; F.bx = bx; F.vcu = (G % 8 == 0) ? (bx % 8) * (G / 8) + bx / 8 : bx; return F; }
__device__ __forceinline__ void proA_adaln_item(ArgsP a, const Fr& F, int it) {
    LAS float* sc = (LAS float*)F.lds;
    const int i = it / 96, ks = (it / 12) % 8, cc = it % 12;
    __syncthreads();
    for (int u = F.tid; u < 5 * 128; u += NTHR) { const int r = u / 128, k = ks * 128 + (u % 128);
        const float x = r < 4 ? a->in[I_C][r * D + k] : a->in[I_CCTX][k]; sc[u] = x / (1.0f + expf(-x)); }
    __syncthreads();
    const int col = cc * 512 + F.tid;
    const float* w = a->in[I_MODW] + ((size_t)i * D + (size_t)ks * 128) * 6144 + col;
    float acc[5] = {0.f, 0.f, 0.f, 0.f, 0.f};
#pragma unroll 8
    for (int k = 0; k < 128; ++k) { const float wv = w[(size_t)k * 6144];
#pragma unroll
        for (int r = 0; r < 5; ++r) acc[r] += sc[r * 128 + k] * wv; }
    float* mp = (float*)(a->ws + WS_MODP) + (size_t)((i * 8 + ks) * 5) * 6144 + col;
#pragma unroll
    for (int r = 0; r < 5; ++r) {
#if MK_MERGE_PRO
        asm volatile("global_store_dword %0, %1, off sc0 sc1" :: "v"(mp + (size_t)r * 6144), "v"(acc[r]) : "memory");
#else
        mp[(size_t)r * 6144] = acc[r];
#endif
    }
}
__device__ __forceinline__ void proA_filter_item(ArgsP a, const Fr& F, int it) {
    int slot, L, t0; float* HF;
    if (it < 512) { slot = it >> 8; L = SEQ; t0 = (it & 255) * 16; HF = (float*)(a->ws + WS_HF + (size_t)slot * HF_SLOT); }
    else { slot = 0; L = LC; t0 = (it - 512) * 16; HF = (float*)(a->ws + WS_HF + HF_CTX); }
    LAS float* z = (LAS float*)F.lds;
    LAS float* h1 = z + 16 * 33;
    LAS float* h2 = h1 + 16 * 64;
    LAS float* w1s = h2 + 16 * 64;
    LAS float* w2s = w1s + 33 * 64;
    __syncthreads();
    for (int u = F.tid; u < 33 * 64; u += NTHR) w1s[u] = a->in[I_FW1][(size_t)slot * 33 * 64 + u];
    for (int u = F.tid; u < 64 * 64; u += NTHR) w2s[u] = a->in[I_FW2][(size_t)slot * 64 * 64 + u];
    for (int u = F.tid; u < 16 * 33; u += NTHR) { const int tt = u / 33, j = u % 33; const float tf = (float)(t0 + tt);
        float v;
        if (j == 0) v = tf / (float)(L - 1);
        else { const int jj = (j - 1) & 15; const float f = 1e-4f + (float)jj * ((15.0f - 1e-4f) / 15.0f); const float w = (float)(6.283185307179586 / (double)L) * tf;
            v = j <= 16 ? cosf(f * w) : -sinf(f * w); }
        z[u] = v; }
    __syncthreads();
    const LAS float* w1 = w1s; const float* b1 = a->in[I_FB1] + slot * 64;
    const LAS float* w2 = w2s; const float* b2 = a->in[I_FB2] + slot * 64;
    const float* fq = a->in[I_FFREQ] + slot * 128;
    for (int u = F.tid; u < 16 * 64; u += NTHR) { const int tt = u >> 6, j = u & 63; float s = b1[j];
        for (int i = 0; i < 33; ++i) s += z[tt * 33 + i] * w1[i * 64 + j];
        h1[u] = sinf(fq[j] * s); }
    __syncthreads();
    for (int u = F.tid; u < 16 * 64; u += NTHR) { const int tt = u >> 6, j = u & 63; float s = b2[j];
        for (int i = 0; i < 64; ++i) s += h1[tt * 64 + i] * w2[i * 64 + j];
        h2[u] = sinf(fq[64 + j] * s); }
    __syncthreads();
    const float* w3 = a->in[I_FW3] + (size_t)slot * 64 * 4096;
    const float dmin = -3.0701134573253940f, dmax = -15.350567286626973f;
    const int lane = F.lane, lm = lane & 15, lk = lane >> 4;
    float af[16];
#pragma unroll
    for (int s = 0; s < 16; ++s) af[s] = h2[lm * 64 + 4 * s + lk];
    float tl[4];
#pragma unroll
    for (int j = 0; j < 4; ++j) tl[j] = (float)(t0 + 4 * lk + j) / (float)(L - 1);
#define FILT_LOAD(bA, bB, ct_) do { const int c0_ = (F.wave * 32 + (ct_)) * 16 + lm; _Pragma("unroll") for (int s = 0; s < 16; ++s) { bA[s] = w3[(size_t)(4 * s + lk) * 4096 + c0_]; bB[s] = w3[(size_t)(4 * s + lk) * 4096 + c0_ + 16]; } } while (0)
#define FILT_STEP(bA, bB, ct_) do { const int c0 = (F.wave * 32 + (ct_)) * 16 + lm, c1 = c0 + 16; f32x4 acc0 = {0.f, 0.f, 0.f, 0.f}, acc1 = {0.f, 0.f, 0.f, 0.f}; \
        _Pragma("unroll") for (int s = 0; s < 16; ++s) { acc0 = __builtin_amdgcn_mfma_f32_16x16x4f32(af[s], bA[s], acc0, 0, 0, 0); acc1 = __builtin_amdgcn_mfma_f32_16x16x4f32(af[s], bB[s], acc1, 0, 0, 0); } \
        { const float delta = fabsf(dmin + (float)(c0 & 1023) * ((dmax - dmin) / 1023.0f)); f32x4 o; _Pragma("unroll") for (int j = 0; j < 4; ++j) o[j] = acc0[j] * expf(-tl[j] * delta); *(f32x4*)(HF + (size_t)c0 * L + t0 + 4 * lk) = o; } \
        { const float delta = fabsf(dmin + (float)(c1 & 1023) * ((dmax - dmin) / 1023.0f)); f32x4 o; _Pragma("unroll") for (int j = 0; j < 4; ++j) o[j] = acc1[j] * expf(-tl[j] * delta); *(f32x4*)(HF + (size_t)c1 * L + t0 + 4 * lk) = o; } } while (0)
    float p0[16], p1[16], q0[16], q1[16];
    FILT_LOAD(p0, p1, 0);
    for (int ct = 0; ct < 32; ct += 4) {
        FILT_LOAD(q0, q1, ct + 2);
        FILT_STEP(p0, p1, ct);
        if (ct + 4 < 32) FILT_LOAD(p0, p1, ct + 4);
        FILT_STEP(q0, q1, ct + 2);
    }
#undef FILT_LOAD
#undef FILT_STEP
}
__device__ __forceinline__ void conv_tile(const float* W, int K, int N, int k0, int n0, bf16* WT, int drow0, LAS float* scr, int lane) {
    float rv[64];
#pragma unroll
    for (int i = 0; i < 64; ++i) rv[i] = W[(size_t)(k0 + i) * N + n0 + lane];
#pragma unroll
    for (int i = 0; i < 64; ++i) scr[i * 65 + lane] = rv[i];
    LDS_WAIT(); asm volatile("" ::: "memory");
    const int c = lane & 7;
#pragma unroll
    for (int j = 0; j < 8; ++j) { const int n = (lane >> 3) + 8 * j; const LAS float* s = scr + (8 * c) * 65 + n;
        v4u o; o.x = pk2(s[0 * 65], s[1 * 65]); o.y = pk2(s[2 * 65], s[3 * 65]); o.z = pk2(s[4 * 65], s[5 * 65]); o.w = pk2(s[6 * 65], s[7 * 65]);
        *(v4u*)(WT + (size_t)(drow0 + n) * K + k0 + 8 * c) = o; }
    LDS_WAIT(); asm volatile("" ::: "memory");
}
__device__ __forceinline__ void conv_tile8(const float* W, int K, int N, int k0, int n0, unsigned char* WT, int drow0, float scale, LAS float* scr, int lane) {
    float rv[64];
#pragma unroll
    for (int i = 0; i < 64; ++i) rv[i] = W[(size_t)(k0 + i) * N + n0 + lane];
#pragma unroll
    for (int i = 0; i < 64; ++i) scr[i * 65 + lane] = __builtin_amdgcn_fmed3f(rv[i] * scale, -448.0f, 448.0f);
    LDS_WAIT(); asm volatile("" ::: "memory");
    const int c = lane & 3;
#pragma unroll
    for (int j = 0; j < 4; ++j) { const int n = (lane >> 2) + 16 * j; const LAS float* s = scr + (16 * c) * 65 + n;
        unsigned w[4];
#pragma unroll
        for (int q = 0; q < 4; ++q) { unsigned x = 0u; x = __builtin_amdgcn_cvt_pk_fp8_f32(s[(4 * q) * 65], s[(4 * q + 1) * 65], x, false); x = __builtin_amdgcn_cvt_pk_fp8_f32(s[(4 * q + 2) * 65], s[(4 * q + 3) * 65], x, true); w[q] = x; }
        v4u o; o.x = w[0]; o.y = w[1]; o.z = w[2]; o.w = w[3];
        *(v4u*)(WT + (size_t)(drow0 + n) * K + k0 + 16 * c) = o; }
    LDS_WAIT(); asm volatile("" ::: "memory");
}
struct Cv8 { const float* src; unsigned char* dst; int N, K; float scale; };
__device__ __forceinline__ void conv8_load(const Cv8& d, float (&rv)[64], int lane) {
#pragma unroll
    for (int i = 0; i < 64; ++i) rv[i] = d.src[(size_t)i * d.N + lane];
}
__device__ __forceinline__ void conv8_store(const Cv8& d, const float (&rv)[64], LAS float* scr, int lane) {
#pragma unroll
    for (int i = 0; i < 64; ++i) scr[i * 65 + lane] = __builtin_amdgcn_fmed3f(rv[i] * d.scale, -448.0f, 448.0f);
    LDS_WAIT(); asm volatile("" ::: "memory");
    const int c = lane & 3;
#pragma unroll
    for (int j = 0; j < 4; ++j) { const int n = (lane >> 2) + 16 * j; const LAS float* s = scr + (16 * c) * 65 + n;
        unsigned w[4];
#pragma unroll
        for (int q = 0; q < 4; ++q) { unsigned x = 0u; x = __builtin_amdgcn_cvt_pk_fp8_f32(s[(4 * q) * 65], s[(4 * q + 1) * 65], x, false); x = __builtin_amdgcn_cvt_pk_fp8_f32(s[(4 * q + 2) * 65], s[(4 * q + 3) * 65], x, true); w[q] = x; }
        v4u o; o.x = w[0]; o.y = w[1]; o.z = w[2]; o.w = w[3];
        *(v4u*)(d.dst + (size_t)n * d.K + 16 * c) = o; }
    LDS_WAIT(); asm volatile("" ::: "memory");
}
#ifndef MK_CV_CHUNK
#define MK_CV_CHUNK 4
#endif
#ifndef MK_CV_ORDER
#define MK_CV_ORDER 0
#endif
#ifndef MK_CV_PIPE
#define MK_CV_PIPE 0
#endif
#ifndef MK_FP8_DN
#define MK_FP8_DN 1
#endif
constexpr float WGU_SCALE = 64.0f, WDN_SCALE = 128.0f, ACT_SCALE = 2.0f;
constexpr int CV_SMALL = 768 * 2 + 256 * 2 + 384 + 256 + 1024 + 512;
constexpr int CV_MOE = 4 * 16 * 3 * 512;
__device__ __forceinline__ void proA_conv_item(ArgsP a, int it, LAS float* scr, int lane) {
    unsigned char* ws = a->ws;
    if (it < CV_SMALL) {
        int r = it;
        if (r < 1536) { const int s = r / 768, q = r % 768, kb = q / 48, nb = q % 48;
#if MK_FP8_HYIN
            conv_tile8(a->in[I_HYWIN] + (size_t)s * 1024 * 3072, 1024, 3072, kb * 64, nb * 64, (unsigned char*)(ws + WS_WHYIN) + (size_t)s * 3072 * 1024, nb * 64, WH_SCALE, scr, lane); return; } r -= 1536;
#else
            conv_tile(a->in[I_HYWIN] + (size_t)s * 1024 * 3072, 1024, 3072, kb * 64, nb * 64, (bf16*)(ws + WS_WHYIN) + (size_t)s * 3072 * 1024, nb * 64, scr, lane); return; } r -= 1536;
#endif
        if (r < 512) { const int s = r / 256, q = r % 256, kb = q / 16, nb = q % 16;
#if MK_FP8_HYOUT
            conv_tile8(a->in[I_HYWOUT] + (size_t)s * 1024 * 1024, 1024, 1024, kb * 64, nb * 64, (unsigned char*)(ws + WS_WHYOUT) + (size_t)s * 1024 * 1024, nb * 64, WH_SCALE, scr, lane); return; } r -= 512;
#else
            conv_tile(a->in[I_HYWOUT] + (size_t)s * 1024 * 1024, 1024, 1024, kb * 64, nb * 64, (bf16*)(ws + WS_WHYOUT) + (size_t)s * 1024 * 1024, nb * 64, scr, lane); return; } r -= 512;
#endif
        if (r < 384) { const int kb = r / 24, nb = r % 24;
#if MK_FP8_QKV
            conv_tile8(a->in[I_WQKV], 1024, 1536, kb * 64, nb * 64, (unsigned char*)(ws + WS_WQKV), nb * 64, WH_SCALE, scr, lane); return; } r -= 384;
#else
            conv_tile(a->in[I_WQKV], 1024, 1536, kb * 64, nb * 64, (bf16*)(ws + WS_WQKV), nb * 64, scr, lane); return; } r -= 384;
#endif
        if (r < 256) { const int kb = r / 16, nb = r % 16;
#if MK_FP8_AOUT
            conv_tile8(a->in[I_WATO], 1024, 1024, kb * 64, nb * 64, (unsigned char*)(ws + WS_WATO), nb * 64, WH_SCALE, scr, lane); return; } r -= 256;
#else
            conv_tile(a->in[I_WATO], 1024, 1024, kb * 64, nb * 64, (bf16*)(ws + WS_WATO), nb * 64, scr, lane); return; } r -= 256;
#endif
        if (r < 1024) { const int kb = r / 64, nb = r % 64;
#if MK_FP8_CMIN
            conv_tile8(a->in[I_CMWIN], 1024, 4096, kb * 64, nb * 64, (unsigned char*)(ws + WS_WCMIN), nb * 64, WH_SCALE, scr, lane); return; } r -= 1024;
#elif MK_FP8_CMV
            if (nb >= 32) { conv_tile8(a->in[I_CMWIN], 1024, 4096, kb * 64, nb * 64, (unsigned char*)(ws + WS_WCMIN) + (size_t)2048 * 1024 * 2, (nb - 32) * 64, WH_SCALE, scr, lane); return; }
            conv_tile(a->in[I_CMWIN], 1024, 4096, kb * 64, nb * 64, (bf16*)(ws + WS_WCMIN), nb * 64, scr, lane); return; } r -= 1024;
#else
            conv_tile(a->in[I_CMWIN], 1024, 4096, kb * 64, nb * 64, (bf16*)(ws + WS_WCMIN), nb * 64, scr, lane); return; } r -= 1024;
#endif
        { const int kb = r / 16, nb = r % 16;
#if MK_FP8_CMOUT
            conv_tile8(a->in[I_CMWOUT], 2048, 1024, kb * 64, nb * 64, (unsigned char*)(ws + WS_WCMOUT), nb * 64, WH_SCALE, scr, lane); return; }
#else
            conv_tile(a->in[I_CMWOUT], 2048, 1024, kb * 64, nb * 64, (bf16*)(ws + WS_WCMOUT), nb * 64, scr, lane); return; }
#endif
    }
    const int r = it - CV_SMALL, mat = r / 512, q = r % 512, le = mat / 3, which = mat % 3;
    if (which < 2) { const int kb = MK_CV_ORDER ? (q >> 7) * 4 + (q & 3) : q / 32, nb = MK_CV_ORDER ? (q >> 2) & 31 : q % 32, n0 = nb * 64;
        const float* src = a->in[which == 0 ? I_WGATE : I_WUP] + (size_t)le * 1024 * 2048;
        conv_tile8(src, 1024, 2048, kb * 64, n0, (unsigned char*)(ws + WS_WGU) + (size_t)le * 4096 * 1024, (n0 >> 7) * 256 + (n0 & 127) + which * 128, WGU_SCALE, scr, lane); }
    else { const int kb = MK_CV_ORDER ? (q >> 6) * 4 + (q & 3) : q / 16, nb = MK_CV_ORDER ? (q >> 2) & 15 : q % 16;
#if MK_FP8_DN
        conv_tile8(a->in[I_WDOWN] + (size_t)le * 2048 * 1024, 2048, 1024, kb * 64, nb * 64, (unsigned char*)(ws + WS_WDN) + (size_t)le * 1024 * 2048, nb * 64, WDN_SCALE, scr, lane); }
#else
        conv_tile(a->in[I_WDOWN] + (size_t)le * 2048 * 1024, 2048, 1024, kb * 64, nb * 64, (bf16*)(ws + WS_WDN) + (size_t)le * 1024 * 2048, nb * 64, scr, lane); }
#endif
}
#if MK_FP8_DN
__device__ __forceinline__ Cv8 cv8_desc(ArgsP a, int it) {
    unsigned char* ws = a->ws;
    const int r = it - CV_SMALL, mat = r / 512, q = r % 512, le = mat / 3, which = mat % 3;
    Cv8 d;
    if (which < 2) { const int kb = MK_CV_ORDER ? (q >> 7) * 4 + (q & 3) : q / 32, nb = MK_CV_ORDER ? (q >> 2) & 31 : q % 32, n0 = nb * 64;
        d.src = a->in[which == 0 ? I_WGATE : I_WUP] + (size_t)le * 1024 * 2048 + (size_t)(kb * 64) * 2048 + n0; d.N = 2048; d.K = 1024; d.scale = WGU_SCALE;
        d.dst = (unsigned char*)(ws + WS_WGU) + (size_t)le * 4096 * 1024 + (size_t)((n0 >> 7) * 256 + (n0 & 127) + which * 128) * 1024 + kb * 64; }
    else { const int kb = MK_CV_ORDER ? (q >> 6) * 4 + (q & 3) : q / 16, nb = MK_CV_ORDER ? (q >> 2) & 15 : q % 16;
        d.src = a->in[I_WDOWN] + (size_t)le * 2048 * 1024 + (size_t)(kb * 64) * 1024 + nb * 64; d.N = 1024; d.K = 2048; d.scale = WDN_SCALE;
        d.dst = (unsigned char*)(ws + WS_WDN) + (size_t)le * 1024 * 2048 + (size_t)(nb * 64) * 2048 + kb * 64; }
    return d;
}
#endif
constexpr int CV_TOTAL = CV_SMALL + CV_MOE;
constexpr int BG_IDLE[7] = {208, 240, 128, 192, 104, 192, 192};
#ifndef MK_BG_TPW
#define MK_BG_TPW {4, 4, 2, 3, 3, 2, 2}
#endif
constexpr int BG_TPW[7] = MK_BG_TPW;
constexpr int bg_base(int w) { int s = 0; for (int i = 0; i < w; ++i) s += BG_IDLE[i] * 8 * BG_TPW[i]; return s; }
constexpr int CV_DEFER = bg_base(7);
static_assert(CV_DEFER <= 2 * 24576, "the deferred tiles must all belong to layers 2 and 3 (first needed by the layer-2 expert GEMMs; every window runs before that)");
template <int W> __device__ __forceinline__ void bg_convert(ArgsP a, const Fr& F, int rank) {
    if (F.G != 256 || rank < 0 || rank >= BG_IDLE[W]) return;
    LAS float* scr = (LAS float*)(F.lds + F.wave * 16640);
    constexpr int nw = BG_IDLE[W] * 8; const int widx = rank * 8 + F.wave;
#pragma unroll 1
    for (int k = 0; k < BG_TPW[W]; ++k) proA_conv_item(a, CV_TOTAL - CV_DEFER + bg_base(W) + k * nw + widx, scr, F.lane);
}
__device__ __forceinline__ void phase_proB(ArgsP a, const Fr& F);
__device__ __forceinline__ void phase_proA(ArgsP a, const Fr& F) {
    const int gt = F.vcu * NTHR + F.tid, NGT = F.G * NTHR;
    for (int k = gt; k < 8192; k += NGT) { float s, c; sincospif((float)k * (1.0f / 4096.0f), &s, &c); ((f32x2*)(a->ws + WS_TW))[k] = (f32x2){c, s}; }
    for (int k = gt; k < 16 * 128 * 128; k += NGT) ((bf16*)(a->ws + WS_WCMS))[k] = (bf16)f2bf(a->in[I_CMWS][k]);
    const int nbl = F.G >= 2 ? F.G / 2 : 1;
    if (F.vcu < nbl) { for (int it = F.vcu; it < 384 + 528; it += nbl) {
        if (it < 384) { proA_adaln_item(a, F, it);
#if MK_MERGE_PRO
            asm volatile("s_waitcnt vmcnt(0)" ::: "memory"); __syncthreads();
            if (F.tid == 0) (void)xb_add((unsigned*)(a->ws + WS_CTL) + 8256, 1u);
#endif
        } else proA_filter_item(a, F, it - 384); } }
    __syncthreads();
    LAS float* scr = (LAS float*)(F.lds + F.wave * 16640);
    unsigned* q = (unsigned*)(a->ws + WS_CTL) + 8192;
    const unsigned lim = (unsigned)(F.G == 256 ? CV_TOTAL - CV_DEFER : CV_TOTAL);
    for (;;) {
        unsigned i0 = 0u; if (F.lane == 0) i0 = __hip_atomic_fetch_add(q, (unsigned)MK_CV_CHUNK, __ATOMIC_RELAXED, __HIP_MEMORY_SCOPE_AGENT);
        i0 = (unsigned)__builtin_amdgcn_readfirstlane((int)i0);
        if (i0 >= lim) break;
#if MK_FP8_DN && MK_CV_PIPE
        if (MK_CV_CHUNK == 4 && i0 >= (unsigned)CV_SMALL && i0 + 4u <= lim) {
            float rv[64]; Cv8 dn = cv8_desc(a, (int)i0); conv8_load(dn, rv, F.lane);
#pragma unroll 1
            for (int k = 0; k < 4; ++k) { float cur[64]; const Cv8 dc = dn;
#pragma unroll
                for (int i = 0; i < 64; ++i) cur[i] = rv[i];
                if (k < 3) { dn = cv8_desc(a, (int)i0 + k + 1); conv8_load(dn, rv, F.lane); }
                conv8_store(dc, cur, scr, F.lane); }
            continue; }
#endif
        for (unsigned it = i0; it < i0 + (unsigned)MK_CV_CHUNK && it < lim; ++it) proA_conv_item(a, (int)it, scr, F.lane);
    }
#if MK_MERGE_PRO
    __syncthreads();
    if (F.tid == 0) { unsigned* ctl = (unsigned*)(a->ws + WS_CTL); XB_SPIN(xb_ld(ctl + 8256) < 384u, ctl + 4096); }
    __syncthreads();
    __builtin_amdgcn_fence(__ATOMIC_ACQUIRE, "agent");
    phase_proB(a, F);
#endif
}
__device__ __forceinline__ void phase_proB(ArgsP a, const Fr& F) {
    LAS float* m0 = (LAS float*)F.lds;
    const float* mp = (const float*)(a->ws + WS_MODP);
    for (int u = F.tid; u < 5 * 2048; u += NTHR) { const int r = u / 2048, c = u % 2048; float s = a->in[I_MODB][c];
        for (int ks = 0; ks < 8; ++ks) s += mp[(size_t)(ks * 5 + r) * 6144 + c];
        m0[u] = s; }
    __syncthreads();
    const int gw = F.vcu * NWAVES + F.wave, NGW = F.G * NWAVES;
    for (int row = gw; row < TA; row += NGW) {
        const int r = row < T ? (row >> 12) : 4;
        const float* src = row < T ? a->in[I_X] + (size_t)row * D : a->in[I_CTX] + (size_t)(row - T) * D;
        bf16* xl = (bf16*)(a->ws + WS_XC) + (size_t)row * D; const int hrow = row < T ? (row & ~4095) + ((row & 511) << 3) + ((row & 4095) >> 9) : row;
        bf16* hb = (bf16*)(a->ws + WS_HB) + (size_t)hrow * D;
#pragma unroll
        for (int j = 0; j < 4; ++j) { const int c = 4 * F.lane + 256 * j; const f32x4 v = *(const f32x4*)(src + c); { v2u xo; xo.x = pk2(v[0], v[1]); xo.y = pk2(v[2], v[3]); *(v2u*)(xl + c) = xo; }
            const f32x4 sh = *(const LAS f32x4*)(m0 + r * 2048 + c), sc = *(const LAS f32x4*)(m0 + r * 2048 + 1024 + c);
            const f32x4 h = v * (sc + 1.0f) + sh;
#if MK_FP8_HYIN
            *(unsigned*)((unsigned char*)(a->ws + WS_HB) + (size_t)hrow * D + c) = pk4_e4m3(h); }
#else
            v2u o; o.x = pk2(h[0], h[1]); o.y = pk2(h[2], h[3]); *(v2u*)(hb + c) = o; }
#endif
    }
    const int gt = F.vcu * NTHR + F.tid, NGT = F.G * NTHR;
    float* mod = (float*)(a->ws + WS_MOD);
    for (int u = gt; u < 4 * 5 * 6144; u += NGT) { const int i = u / 30720, r = (u / 6144) % 5, c = u % 6144; float s = a->in[I_MODB][i * 6144 + c];
        for (int ks = 0; ks < 8; ++ks) s += mp[(size_t)((i * 8 + ks) * 5 + r) * 6144 + c];
        mod[u] = s; }
}
template <int L>
__device__ __forceinline__ float sconv(const bf16* p, int t, float w0, float w1, float w2, float cb) {
    const float a = t > 0 ? bf2f(p[t - 1]) : 0.f, b = bf2f(p[t]), c = t < L - 1 ? bf2f(p[t + 1]) : 0.f; return w0 * a + w1 * b + w2 * c + cb;
}
template <int L>
__device__ __forceinline__ void hy_direct_item(ArgsP a, const Fr& F, int slot, int d, int tok0, const float* HF) {
    LAS float* kk = (LAS float*)F.lds;
    LAS float* vb = kk + 4 * L;
    LAS float* red = vb + 4 * L;
    const bf16* PT = (const bf16*)(a->ws + SC_PT);
    bf16* Z2T = (bf16*)(a->ws + SC_Z2T);
    __syncthreads();
    for (int o = 0; o < 2; ++o) {
        const float* fw = HF + (size_t)((o * 2 + 0) * 1024 + d) * L; const float* bw = HF + (size_t)((o * 2 + 1) * 1024 + d) * L;
        float s = 0.f;
        for (int t = F.tid; t < L; t += NTHR) { const float f = fw[t], b = bw[t]; kk[o * 2 * L + (L - 1) + t] = f; if (t >= 1) kk[o * 2 * L + (L - 1) - t] = b; s += fabsf(f) + (t >= 1 ? fabsf(b) : 0.f); }
        s = wave_sum(s); if (F.lane == 0) red[o * 8 + F.wave] = s;
    }
    __syncthreads();
    float nrm[2];
#pragma unroll
    for (int o = 0; o < 2; ++o) { float s = 0.f; for (int w = 0; w < 8; ++w) s += red[o * 8 + w]; nrm[o] = 1.0f / (s + 1e-6f); }
    const float* cw = a->in[I_HYCW] + (size_t)slot * 3 * 3072; const float* cbp = a->in[I_HYCB] + (size_t)slot * 3072;
    float w0[3], w1[3], w2[3], cb[3];
#pragma unroll
    for (int g = 0; g < 3; ++g) { const int c = g * 1024 + d; w0[g] = cw[c]; w1[g] = cw[3072 + c]; w2[g] = cw[2 * 3072 + c]; cb[g] = cbp[c]; }
    const float fb0 = a->in[I_FBIAS][(slot * 2 + 0) * 1024 + d], fb1 = a->in[I_FBIAS][(slot * 2 + 1) * 1024 + d];
    for (int u = F.tid; u < 4 * L; u += NTHR) { const int b = u / L, t = u % L; vb[u] = sconv<L>(PT + (size_t)d * TA + tok0 + b * L, t, w0[0], w1[0], w2[0], cb[0]); }
    __syncthreads();
    constexpr int NBLK = 4 * L / 8, PER = (NBLK + NTHR - 1) / NTHR;
    float res[PER][8];
#pragma unroll 1
    for (int o = 0; o < 2; ++o) {
        const LAS float* ko = kk + o * 2 * L;
#pragma unroll
        for (int pi = 0; pi < PER; ++pi) {
            const int q = F.tid + pi * NTHR;
            float acc[8];
#pragma unroll
            for (int j = 0; j < 8; ++j) acc[j] = 0.f;
            if (q < NBLK) {
                const int b = q / (L / 8), t0 = (q % (L / 8)) * 8;
                const LAS float* vv = vb + b * L;
#pragma unroll 1
                for (int s8 = 0; s8 < L; s8 += 8) {
                    const LAS float* kw = ko + (t0 - s8 - 7 + L - 1);
                    float w[15], x[8];
#pragma unroll
                    for (int i = 0; i < 15; ++i) w[i] = kw[i];
#pragma unroll
                    for (int i = 0; i < 8; ++i) x[i] = vv[s8 + i];
#pragma unroll
                    for (int j = 0; j < 8; ++j)
#pragma unroll
                        for (int i = 0; i < 8; ++i) acc[j] += w[j - i + 7] * x[i];
                }
            }
#pragma unroll
            for (int j = 0; j < 8; ++j) res[pi][j] = acc[j];
        }
        __syncthreads();
#pragma unroll
        for (int pi = 0; pi < PER; ++pi) {
            const int q = F.tid + pi * NTHR;
            if (q < NBLK) {
                const int b = q / (L / 8), t0 = (q % (L / 8)) * 8;
                const bf16* pg = PT + (size_t)((o + 1) * 1024 + d) * TA + tok0 + b * L;
#pragma unroll
                for (int j = 0; j < 8; ++j) { const int t = t0 + j; const float vin = vb[b * L + t];
                    const float y = res[pi][j] * nrm[o] + vin * (o == 0 ? fb0 : fb1);
                    const float xg = sconv<L>(pg, t, w0[o + 1], w1[o + 1], w2[o + 1], cb[o + 1]);
                    res[pi][j] = xg * y; }
            }
        }
        __syncthreads();
        if (o == 0) {
#pragma unroll
            for (int pi = 0; pi < PER; ++pi) { const int q = F.tid + pi * NTHR;
                if (q < NBLK) { const int b = q / (L / 8), t0 = (q % (L / 8)) * 8;
#pragma unroll
                    for (int j = 0; j < 8; ++j) vb[b * L + t0 + j] = res[pi][j]; } }
            __syncthreads();
        } else {
#pragma unroll
            for (int pi = 0; pi < PER; ++pi) { const int q = F.tid + pi * NTHR;
                if (q < NBLK) { const int b = q / (L / 8), t0 = (q % (L / 8)) * 8;
                    v4u ov; ov.x = pk2(res[pi][0], res[pi][1]); ov.y = pk2(res[pi][2], res[pi][3]); ov.z = pk2(res[pi][4], res[pi][5]); ov.w = pk2(res[pi][6], res[pi][7]);
                    *(v4u*)(Z2T + (size_t)d * TA + tok0 + b * L + t0) = ov; } }
        }
    }
}
__device__ __forceinline__ void hy_ctx_item(ArgsP a, const Fr& F, int slot, int d) {
    constexpr int L = LC;
    LAS float* kk = (LAS float*)F.lds;
    LAS float* vb = kk + 4 * L;
    LAS float* red = vb + 4 * L;
    LAS float* ps = red + 16;
    const bf16* PT = (const bf16*)(a->ws + SC_PT); bf16* Z2T = (bf16*)(a->ws + SC_Z2T);
    const float* HF = (const float*)(a->ws + WS_HF + HF_CTX); const int tok0 = T;
    __syncthreads();
    for (int o = 0; o < 2; ++o) {
        const float* fw = HF + (size_t)((o * 2 + 0) * 1024 + d) * L; const float* bw = HF + (size_t)((o * 2 + 1) * 1024 + d) * L;
        float s = 0.f;
        for (int t = F.tid; t < L; t += NTHR) { const float f = fw[t], b = bw[t]; kk[o * 2 * L + (L - 1) + t] = f; if (t >= 1) kk[o * 2 * L + (L - 1) - t] = b; s += fabsf(f) + (t >= 1 ? fabsf(b) : 0.f); }
        s = wave_sum(s); if (F.lane == 0) red[o * 8 + F.wave] = s;
    }
    __syncthreads();
    float nrm[2];
#pragma unroll
    for (int o = 0; o < 2; ++o) { float s = 0.f; for (int w = 0; w < 8; ++w) s += red[o * 8 + w]; nrm[o] = 1.0f / (s + 1e-6f); }
    const float* cw = a->in[I_HYCW] + (size_t)slot * 3 * 3072; const float* cbp = a->in[I_HYCB] + (size_t)slot * 3072;
    float w0[3], w1[3], w2[3], cb[3];
#pragma unroll
    for (int g = 0; g < 3; ++g) { const int c = g * 1024 + d; w0[g] = cw[c]; w1[g] = cw[3072 + c]; w2[g] = cw[2 * 3072 + c]; cb[g] = cbp[c]; }
    const float fb0 = a->in[I_FBIAS][(slot * 2 + 0) * 1024 + d], fb1 = a->in[I_FBIAS][(slot * 2 + 1) * 1024 + d];
    for (int u = F.tid; u < 4 * L; u += NTHR) { const int b = u / L, t = u % L; vb[u] = sconv<L>(PT + (size_t)d * TA + tok0 + b * L, t, w0[0], w1[0], w2[0], cb[0]); }
    __syncthreads();
    const int sq = F.tid >> 7, q = F.tid & 127, b = q >> 5, t0 = (q & 31) * 8;
#pragma unroll 1
    for (int o = 0; o < 2; ++o) {
        const LAS float* ko = kk + o * 2 * L; const LAS float* vv = vb + b * L;
        float acc[8];
#pragma unroll
        for (int j = 0; j < 8; ++j) acc[j] = 0.f;
#pragma unroll 1
        for (int s8 = sq * 64; s8 < sq * 64 + 64; s8 += 8) {
            const LAS float* kw = ko + (t0 - s8 - 7 + L - 1);
            float w[15], x[8];
#pragma unroll
            for (int i = 0; i < 15; ++i) w[i] = kw[i];
#pragma unroll
            for (int i = 0; i < 8; ++i) x[i] = vv[s8 + i];
#pragma unroll
            for (int j = 0; j < 8; ++j)
#pragma unroll
                for (int i = 0; i < 8; ++i) acc[j] += w[j - i + 7] * x[i];
        }
#pragma unroll
        for (int j = 0; j < 8; ++j) ps[(sq * 128 + q) * 8 + j] = acc[j];
        __syncthreads();
        float res[8];
        if (F.tid < 128) {
            const bf16* pg = PT + (size_t)((o + 1) * 1024 + d) * TA + tok0 + b * L;
#pragma unroll
            for (int j = 0; j < 8; ++j) { const float cv = ((ps[q * 8 + j] + ps[(128 + q) * 8 + j]) + ps[(256 + q) * 8 + j]) + ps[(384 + q) * 8 + j];
                const int t = t0 + j; const float vin = vb[b * L + t];
                const float y = cv * nrm[o] + vin * (o == 0 ? fb0 : fb1);
                res[j] = sconv<L>(pg, t, w0[o + 1], w1[o + 1], w2[o + 1], cb[o + 1]) * y; }
        }
        __syncthreads();
        if (F.tid < 128) {
            if (o == 0) {
#pragma unroll
                for (int j = 0; j < 8; ++j) vb[b * L + t0 + j] = res[j]; }
            else { v4u ov; ov.x = pk2(res[0], res[1]); ov.y = pk2(res[2], res[3]); ov.z = pk2(res[4], res[5]); ov.w = pk2(res[6], res[7]);
                *(v4u*)(Z2T + (size_t)d * TA + tok0 + b * L + t0) = ov; }
        }
        __syncthreads();
    }
}
__device__ __forceinline__ void phase_hy_tr(ArgsP a, const Fr& F, int ntok) {
    LAS unsigned short* tile = (LAS unsigned short*)(F.lds + F.wave * 9216);
    const bf16* Z2T = (const bf16*)(a->ws + SC_Z2T); bf16* Z2 = (bf16*)(a->ws + SC_Z2);
    const int gw = F.vcu * NWAVES + F.wave, NGW = F.G * NWAVES, ntt = ntok / 64;
    for (int it = gw; it < 16 * ntt; it += NGW) {
        const int c0 = (it / ntt) * 64, t0 = (it % ntt) * 64;
#pragma unroll
        for (int i = 0; i < 8; ++i) { const int ch = i * 8 + (F.lane >> 3), ck = F.lane & 7;
            const v4u v = *(const v4u*)(Z2T + (size_t)(c0 + ch) * TA + t0 + ck * 8); *(LAS v4u*)(tile + ch * 72 + ck * 8) = v; }
        LDS_WAIT(); asm volatile("" ::: "memory");
        int trow = t0 + F.lane;
        if (trow < T) { const int pi = trow & 4095; trow = (trow & ~4095) + (pi >> 3) + 512 * (pi & 7); }
        bf16* dst = Z2 + (size_t)trow * D + c0;
#pragma unroll
        for (int q = 0; q < 8; ++q) { unsigned w[4];
#pragma unroll
            for (int j = 0; j < 4; ++j) { const unsigned lo = tile[(q * 8 + 2 * j) * 72 + F.lane], hi = tile[(q * 8 + 2 * j + 1) * 72 + F.lane]; w[j] = lo | (hi << 16); }
#if MK_FP8_HYOUT
            v2u o8; o8.x = pk4_e4m3((f32x4){__builtin_bit_cast(float, w[0] << 16), __builtin_bit_cast(float, w[0] & 0xffff0000u), __builtin_bit_cast(float, w[1] << 16), __builtin_bit_cast(float, w[1] & 0xffff0000u)} * Z_SCALE);
            o8.y = pk4_e4m3((f32x4){__builtin_bit_cast(float, w[2] << 16), __builtin_bit_cast(float, w[2] & 0xffff0000u), __builtin_bit_cast(float, w[3] << 16), __builtin_bit_cast(float, w[3] & 0xffff0000u)} * Z_SCALE);
            *(v2u*)((unsigned char*)Z2 + (size_t)trow * D + c0 + q * 8) = o8; }
#else
            v4u o; o.x = w[0]; o.y = w[1]; o.z = w[2]; o.w = w[3]; *(v4u*)(dst + q * 8) = o; }
#endif
        LDS_WAIT(); asm volatile("" ::: "memory");
    }
}
__device__ __forceinline__ void phase_hy_conv_direct(ArgsP a, const Fr& F, int layer) {
    const int slot = layer == 0 ? 0 : 1; const int nitems = layer == 0 ? 2048 : 1024;
    for (int it = F.vcu; it < nitems; it += F.G) {
        if (it < 1024) hy_direct_item<SEQ>(a, F, slot, it, 0, (const float*)(a->ws + WS_HF + (size_t)slot * HF_SLOT));
        else hy_direct_item<LC>(a, F, slot, it - 1024, T, (const float*)(a->ws + WS_HF + HF_CTX));
    }
}

__device__ __forceinline__ void lnr_softmax_store(const float (&part)[16], int lane, float* affrow) {
    const bool h5 = (lane & 32) != 0, h4 = (lane & 16) != 0, h3 = (lane & 8) != 0, h2 = (lane & 4) != 0;
    float q8[8], q4[4], q2[2];
#pragma unroll
    for (int k = 0; k < 8; ++k) { const float keep = h5 ? part[8 + k] : part[k], send = h5 ? part[k] : part[8 + k]; q8[k] = keep + __shfl_xor(send, 32); }
#pragma unroll
    for (int k = 0; k < 4; ++k) { const float keep = h4 ? q8[4 + k] : q8[k], send = h4 ? q8[k] : q8[4 + k]; q4[k] = keep + __shfl_xor(send, 16); }
#pragma unroll
    for (int k = 0; k < 2; ++k) { const float keep = h3 ? q4[2 + k] : q4[k], send = h3 ? q4[k] : q4[2 + k]; q2[k] = keep + __shfl_xor(send, 8); }
    float lg; { const float keep = h2 ? q2[1] : q2[0], send = h2 ? q2[0] : q2[1]; lg = keep + __shfl_xor(send, 4); }
    lg += __shfl_xor(lg, 1); lg += __shfl_xor(lg, 2);
    float mx = lg;
#pragma unroll
    for (int o = 4; o < 64; o <<= 1) mx = fmaxf(mx, __shfl_xor(mx, o));
    const float ex = expf(lg - mx); float den = ex;
#pragma unroll
    for (int o = 4; o < 64; o <<= 1) den += __shfl_xor(den, o);
    const int eidx = (h5 ? 8 : 0) + (h4 ? 4 : 0) + (h3 ? 2 : 0) + (h2 ? 1 : 0);
    if ((lane & 3) == 0) affrow[eidx] = ex / den;
}
__device__ __forceinline__ void phase_lnr2(ArgsP a, const Fr& F, int layer, int nrows) {
    LAS float* wr = (LAS float*)F.lds;
    __syncthreads();
    for (int u = F.tid; u < 1024 * 16; u += NTHR) wr[u] = a->in[I_ROUTER][(size_t)layer * 1024 * 16 + (u & 1023) * 16 + (u >> 10)];
    __syncthreads();
    const bf16* U = (const bf16*)(a->ws + WS_U); f32x2* ST = (f32x2*)(a->ws + WS_XL); unsigned char* HB8 = (unsigned char*)(a->ws + WS_HB); float* AFF = (float*)(a->ws + WS_AFF);
    const float* mod = (const float*)(a->ws + WS_MOD) + (size_t)layer * 5 * 6144;
    const float* lg = a->in[I_LNG] + (size_t)(layer * 2 + 0) * D; const float* lb = a->in[I_LNB] + (size_t)(layer * 2 + 0) * D;
    const int gw = F.vcu * NWAVES + F.wave, NGW = F.G * NWAVES, npair = nrows >> 1;
    v2u vn[2][4];
    if (gw < npair) {
#pragma unroll
        for (int q = 0; q < 2; ++q)
#pragma unroll
            for (int j = 0; j < 4; ++j) vn[q][j] = *(const v2u*)(U + (size_t)(2 * gw + q) * D + 4 * F.lane + 256 * j); }
    for (int pi = gw; pi < npair; pi += NGW) {
        int lane = F.lane; asm volatile("" : "+v"(lane));
        const int row = 2 * pi; const int r = row < T ? (row >> 12) : 4;
        f32x4 v[2][4]; float s[2] = {0.f, 0.f};
#pragma unroll
        for (int q = 0; q < 2; ++q)
#pragma unroll
            for (int j = 0; j < 4; ++j) { v[q][j] = up4(vn[q][j]); s[q] += (v[q][j][0] + v[q][j][1]) + (v[q][j][2] + v[q][j][3]); }
        if (pi + NGW < npair) {
#pragma unroll
            for (int q = 0; q < 2; ++q)
#pragma unroll
                for (int j = 0; j < 4; ++j) vn[q][j] = *(const v2u*)(U + (size_t)(2 * (pi + NGW) + q) * D + 4 * lane + 256 * j); }
        float rstd[2];
#pragma unroll
        for (int q = 0; q < 2; ++q) { const float mean = wave_sum(s[q]) * (1.0f / D); float s2 = 0.f;
#pragma unroll
            for (int j = 0; j < 4; ++j) { v[q][j] = v[q][j] - mean; s2 += (v[q][j][0] * v[q][j][0] + v[q][j][1] * v[q][j][1]) + (v[q][j][2] * v[q][j][2] + v[q][j][3] * v[q][j][3]); }
            rstd[q] = 1.0f / sqrtf(wave_sum(s2) * (1.0f / D) + LN_EPS);
            if (lane == 0) ST[row + q] = (f32x2){mean, rstd[q]}; }
        float pa[16], pb[16];
#pragma unroll
        for (int e = 0; e < 16; ++e) { pa[e] = 0.f; pb[e] = 0.f; }
#pragma unroll 1
        for (int j = 0; j < 4; ++j) { const int c = 4 * lane + 256 * j;
            const f32x4 g4 = *(const f32x4*)(lg + c), b4 = *(const f32x4*)(lb + c), sc = *(const f32x4*)(mod + r * 6144 + 4096 + c) + 1.0f, sh = *(const f32x4*)(mod + r * 6144 + 3072 + c);
            f32x4 vA, vB;
            switch (j) { case 0: vA = v[0][0]; vB = v[1][0]; break; case 1: vA = v[0][1]; vB = v[1][1]; break; case 2: vA = v[0][2]; vB = v[1][2]; break; default: vA = v[0][3]; vB = v[1][3]; break; }
            const f32x4 hA = (vA * rstd[0] * g4 + b4) * sc + sh, hB = (vB * rstd[1] * g4 + b4) * sc + sh;
            { unsigned o8 = 0u; o8 = __builtin_amdgcn_cvt_pk_fp8_f32(__builtin_amdgcn_fmed3f(hA[0], -448.0f, 448.0f), __builtin_amdgcn_fmed3f(hA[1], -448.0f, 448.0f), o8, false);
              o8 = __builtin_amdgcn_cvt_pk_fp8_f32(__builtin_amdgcn_fmed3f(hA[2], -448.0f, 448.0f), __builtin_amdgcn_fmed3f(hA[3], -448.0f, 448.0f), o8, true); *(unsigned*)(HB8 + (size_t)row * D + c) = o8; }
            { unsigned o8 = 0u; o8 = __builtin_amdgcn_cvt_pk_fp8_f32(__builtin_amdgcn_fmed3f(hB[0], -448.0f, 448.0f), __builtin_amdgcn_fmed3f(hB[1], -448.0f, 448.0f), o8, false);
              o8 = __builtin_amdgcn_cvt_pk_fp8_f32(__builtin_amdgcn_fmed3f(hB[2], -448.0f, 448.0f), __builtin_amdgcn_fmed3f(hB[3], -448.0f, 448.0f), o8, true); *(unsigned*)(HB8 + (size_t)(row + 1) * D + c) = o8; }
#pragma unroll
            for (int e = 0; e < 16; ++e) { const f32x4 w = *(const LAS f32x4*)(wr + e * 1024 + c);
                pa[e] += (hA[0] * w[0] + hA[1] * w[1]) + (hA[2] * w[2] + hA[3] * w[3]);
                pb[e] += (hB[0] * w[0] + hB[1] * w[1]) + (hB[2] * w[2] + hB[3] * w[3]); }
            asm volatile("" ::: "memory"); }
        lnr_softmax_store(pa, lane, AFF + (size_t)row * 16);
        lnr_softmax_store(pb, lane, AFF + (size_t)(row + 1) * 16);
    }
}
__device__ __forceinline__ void phase_lnr(ArgsP a, const Fr& F, int layer, int nrows) {
    LAS float* wr = (LAS float*)F.lds;
    __syncthreads();
    for (int u = F.tid; u < 1024 * 16; u += NTHR) { const int p = u & 1023; const int col = MK_LNR_WIDE ? 8 * ((p & 255) >> 2) + 512 * (p >> 9) + 4 * ((p >> 8) & 1) + (p & 3) : p;
        wr[u] = a->in[I_ROUTER][(size_t)layer * 1024 * 16 + col * 16 + (u >> 10)]; }
    __syncthreads();
    const bf16* U = (const bf16*)(a->ws + WS_U); f32x2* ST = (f32x2*)(a->ws + WS_XL); unsigned char* HB8 = (unsigned char*)(a->ws + WS_HB); float* AFF = (float*)(a->ws + WS_AFF);
    const float* mod = (const float*)(a->ws + WS_MOD) + (size_t)layer * 5 * 6144;
    const float* lg = a->in[I_LNG] + (size_t)(layer * 2 + 0) * D; const float* lb = a->in[I_LNB] + (size_t)(layer * 2 + 0) * D;
    const int gw = F.vcu * NWAVES + F.wave, NGW = F.G * NWAVES;
    f32x4 wreg[MK_LNR_WREG > 0 ? MK_LNR_WREG : 1][4];
#pragma unroll
    for (int e = 0; e < MK_LNR_WREG; ++e)
#pragma unroll
        for (int j = 0; j < 4; ++j) wreg[e][j] = *(const LAS f32x4*)(wr + e * 1024 + 4 * F.lane + 256 * j);
#if MK_LNR_WIDE
    v4u vw[2];
    if (gw < nrows) {
#pragma unroll
        for (int jj = 0; jj < 2; ++jj) vw[jj] = *(const v4u*)(U + (size_t)gw * D + 8 * F.lane + 512 * jj); }
#else
    v2u vn[4];
    if (gw < nrows) {
#pragma unroll
        for (int j = 0; j < 4; ++j) vn[j] = *(const v2u*)(U + (size_t)gw * D + 4 * F.lane + 256 * j); }
#endif
    for (int row = gw; row < nrows; row += NGW) {
        const int r = row < T ? (row >> 12) : 4;
        f32x4 v[4]; float s = 0.f;
#pragma unroll
#if MK_LNR_WIDE
        for (int j = 0; j < 4; ++j) { v2u hf; hf.x = (j & 1) ? vw[j >> 1].z : vw[j >> 1].x; hf.y = (j & 1) ? vw[j >> 1].w : vw[j >> 1].y; v[j] = up4(hf); s += (v[j][0] + v[j][1]) + (v[j][2] + v[j][3]); }
        if (row + NGW < nrows) {
#pragma unroll
            for (int jj = 0; jj < 2; ++jj) vw[jj] = *(const v4u*)(U + (size_t)(row + NGW) * D + 8 * F.lane + 512 * jj); }
#else
        for (int j = 0; j < 4; ++j) { v[j] = up4(vn[j]); s += (v[j][0] + v[j][1]) + (v[j][2] + v[j][3]); }
        if (row + NGW < nrows) {
#pragma unroll
            for (int j = 0; j < 4; ++j) vn[j] = *(const v2u*)(U + (size_t)(row + NGW) * D + 4 * F.lane + 256 * j); }
#endif
        const float mean = wave_sum(s) * (1.0f / D); float s2 = 0.f;
#pragma unroll
        for (int j = 0; j < 4; ++j) { v[j] = v[j] - mean; s2 += (v[j][0] * v[j][0] + v[j][1] * v[j][1]) + (v[j][2] * v[j][2] + v[j][3] * v[j][3]); }
        const float rstd = 1.0f / sqrtf(wave_sum(s2) * (1.0f / D) + LN_EPS);
        if (F.lane == 0) ST[row] = (f32x2){mean, rstd};
        float part[16];
#pragma unroll
        for (int e = 0; e < 16; ++e) part[e] = 0.f;
        unsigned o8prev = 0u; (void)o8prev;
#pragma unroll
        for (int j = 0; j < 4; ++j) { const int cl = 4 * F.lane + 256 * j;
            const int c = MK_LNR_WIDE ? 8 * F.lane + 512 * (j >> 1) + 4 * (j & 1) : cl;
            const f32x4 x = v[j] * rstd * *(const f32x4*)(lg + c) + *(const f32x4*)(lb + c);
            const f32x4 h = x * (*(const f32x4*)(mod + r * 6144 + 4096 + c) + 1.0f) + *(const f32x4*)(mod + r * 6144 + 3072 + c);
            { unsigned o8 = 0u; const f32x4 hc = {__builtin_amdgcn_fmed3f(h[0], -448.0f, 448.0f), __builtin_amdgcn_fmed3f(h[1], -448.0f, 448.0f), __builtin_amdgcn_fmed3f(h[2], -448.0f, 448.0f), __builtin_amdgcn_fmed3f(h[3], -448.0f, 448.0f)};
              o8 = __builtin_amdgcn_cvt_pk_fp8_f32(hc[0], hc[1], o8, false); o8 = __builtin_amdgcn_cvt_pk_fp8_f32(hc[2], hc[3], o8, true);
              if (MK_LNR_WIDE) { if (j & 1) { v2u o2; o2.x = o8prev; o2.y = o8; *(v2u*)(HB8 + (size_t)row * D + c - 4) = o2; } else o8prev = o8; }
              else *(unsigned*)(HB8 + (size_t)row * D + c) = o8; }
#pragma unroll
            for (int e = 0; e < 16; ++e) { const f32x4 w = e < MK_LNR_WREG ? wreg[e < MK_LNR_WREG ? e : 0][j] : *(const LAS f32x4*)(wr + e * 1024 + cl);
                part[e] += (h[0] * w[0] + h[1] * w[1]) + (h[2] * w[2] + h[3] * w[3]); }
            asm volatile("" ::: "memory"); }
        const bool h5 = (F.lane & 32) != 0, h4 = (F.lane & 16) != 0, h3 = (F.lane & 8) != 0, h2 = (F.lane & 4) != 0;
        float q8[8], q4[4], q2[2];
#pragma unroll
        for (int k = 0; k < 8; ++k) { const float keep = h5 ? part[8 + k] : part[k], send = h5 ? part[k] : part[8 + k]; q8[k] = keep + __shfl_xor(send, 32); }
#pragma unroll
        for (int k = 0; k < 4; ++k) { const float keep = h4 ? q8[4 + k] : q8[k], send = h4 ? q8[k] : q8[4 + k]; q4[k] = keep + __shfl_xor(send, 16); }
#pragma unroll
        for (int k = 0; k < 2; ++k) { const float keep = h3 ? q4[2 + k] : q4[k], send = h3 ? q4[k] : q4[2 + k]; q2[k] = keep + __shfl_xor(send, 8); }
        float lg; { const float keep = h2 ? q2[1] : q2[0], send = h2 ? q2[0] : q2[1]; lg = keep + __shfl_xor(send, 4); }
        lg += __shfl_xor(lg, 1); lg += __shfl_xor(lg, 2);
        float mx = lg;
#pragma unroll
        for (int o = 4; o < 64; o <<= 1) mx = fmaxf(mx, __shfl_xor(mx, o));
        const float ex = expf(lg - mx); float den = ex;
#pragma unroll
        for (int o = 4; o < 64; o <<= 1) den += __shfl_xor(den, o);
        const int eidx = (h5 ? 8 : 0) + (h4 ? 4 : 0) + (h3 ? 2 : 0) + (h2 ? 1 : 0);
        if ((F.lane & 3) == 0) AFF[(size_t)row * 16 + eidx] = ex / den;
    }
}

template <int N, int CAPN>
__device__ __forceinline__ void topk_item(ArgsP a, const Fr& F, int b, int e, int rowbase, int slotbase, bool pad) {
    LAS unsigned* hist = (LAS unsigned*)F.lds;
    LAS unsigned* sel = hist + 256;
    LAS unsigned* wtot = hist + 264;
    const float* AFF = (const float*)(a->ws + WS_AFF); int* ROWS = (int*)(a->ws + WS_ROWS); float* GATE = (float*)(a->ws + WS_GATE); int* INV = (int*)(a->ws + WS_INV);
    const int tid = F.tid, lane = F.lane; const bool act = tid * 8 < N;
    unsigned key[8];
#pragma unroll
    for (int j = 0; j < 8; ++j) key[j] = act ? __float_as_uint(AFF[(size_t)(rowbase + tid * 8 + j) * 16 + e]) : 0u;
    unsigned prefix = 0u, need = CAPN;
#pragma unroll 1
    for (int pass = 0; pass < 4; ++pass) {
        const int shift = 24 - 8 * pass; const unsigned himask = pass == 0 ? 0u : (0xFFFFFFFFu << (shift + 8));
        __syncthreads();
        if (tid < 256) hist[tid] = 0u;
        __syncthreads();
        if (act) {
#pragma unroll
            for (int j = 0; j < 8; ++j) if ((key[j] & himask) == prefix) __hip_atomic_fetch_add(&hist[(key[j] >> shift) & 255u], 1u, __ATOMIC_RELAXED, __HIP_MEMORY_SCOPE_WORKGROUP);
        }
        __syncthreads();
        if (tid < 64) {
            const unsigned v0 = hist[4 * lane], v1 = hist[4 * lane + 1], v2 = hist[4 * lane + 2], v3 = hist[4 * lane + 3]; const unsigned tot = v0 + v1 + v2 + v3;
            unsigned x = tot;
#pragma unroll
            for (int o = 1; o < 64; o <<= 1) { const unsigned t = __shfl_down(x, o); if (lane + o < 64) x += t; }
            const unsigned a3 = x - tot, a2 = a3 + v3, a1 = a2 + v2, a0 = a1 + v1;
            if (a3 < need && need <= a3 + v3) { sel[0] = 4 * lane + 3; sel[1] = a3; }
            if (a2 < need && need <= a2 + v2) { sel[0] = 4 * lane + 2; sel[1] = a2; }
            if (a1 < need && need <= a1 + v1) { sel[0] = 4 * lane + 1; sel[1] = a1; }
            if (a0 < need && need <= a0 + v0) { sel[0] = 4 * lane + 0; sel[1] = a0; }
        }
        __syncthreads();
        prefix |= sel[0] << shift; need -= sel[1];
    }
    const unsigned tau = prefix;
    unsigned ceq = 0u;
#pragma unroll
    for (int j = 0; j < 8; ++j) ceq += (act && key[j] == tau) ? 1u : 0u;
    unsigned xe = ceq;
#pragma unroll
    for (int o = 1; o < 64; o <<= 1) { const unsigned t = __shfl_up(xe, o); if (lane >= o) xe += t; }
    __syncthreads();
    if (lane == 63) wtot[F.wave * 2] = xe;
    __syncthreads();
    unsigned eqbase = xe - ceq; for (int w = 0; w < F.wave; ++w) eqbase += wtot[w * 2];
    unsigned flags = 0u, csel = 0u;
#pragma unroll
    for (int j = 0; j < 8; ++j) { bool s = false; if (act) { if (key[j] > tau) s = true; else if (key[j] == tau) { s = eqbase < need; ++eqbase; } } if (s) { flags |= 1u << j; ++csel; } }
    unsigned xs = csel;
#pragma unroll
    for (int o = 1; o < 64; o <<= 1) { const unsigned t = __shfl_up(xs, o); if (lane >= o) xs += t; }
    if (lane == 63) wtot[F.wave * 2 + 1] = xs;
    __syncthreads();
    unsigned pos = xs - csel; for (int w = 0; w < F.wave; ++w) pos += wtot[w * 2 + 1];
    if (act) {
#pragma unroll
        for (int j = 0; j < 8; ++j) { const int row = rowbase + tid * 8 + j; int slot = -1;
            if (flags & (1u << j)) { slot = e * ESTR + slotbase + (int)pos; ++pos; ROWS[slot] = row; GATE[slot] = __uint_as_float(key[j]); }
            INV[(size_t)row * 16 + e] = slot; }
    }
    if (pad) for (int p = tid; p < 128; p += NTHR) { ROWS[e * ESTR + 2176 + p] = 0; GATE[e * ESTR + 2176 + p] = 0.f; }
}
__device__ __forceinline__ void phase_topk(ArgsP a, const Fr& F, int layer) {
    const int nitems = layer == 0 ? 128 : 64;
    for (int it = F.vcu; it < nitems; it += F.G) {
        if (it < 64) { const int b = it >> 4, e = it & 15; topk_item<SEQ, 512>(a, F, b, e, b * SEQ, b * 512, false); }
        else { const int b = (it - 64) >> 4, e = it & 15; topk_item<LC, 32>(a, F, b, e, T + b * LC, 2048 + b * 32, b == 0); }
    }
}
__device__ __forceinline__ void phase_gather(ArgsP a, const Fr& F, int layer) {
    const int me = layer == 0 ? 2304 : 2048;
    const int* ROWS = (const int*)(a->ws + WS_ROWS); const bf16* HB = (const bf16*)(a->ws + WS_HB); bf16* XG = (bf16*)(a->ws + WS_XG);
    const int gw = F.vcu * NWAVES + F.wave, NGW = F.G * NWAVES;
    for (int it = gw; it < 16 * me; it += NGW) { const int e = it / me, s = it % me, dr = e * ESTR + s; const int sr = ROWS[dr];
        const v4u* src = (const v4u*)(HB + (size_t)sr * D); v4u* dst = (v4u*)(XG + (size_t)dr * D);
        dst[F.lane] = src[F.lane]; dst[64 + F.lane] = src[64 + F.lane]; }
}
#if MK_FP8_Y
typedef unsigned comb_y_t;
#define COMB_YLOAD(p, off) (*(const unsigned*)((const unsigned char*)(p) + (off)))
#define COMB_YS (1.0f / Y_SCALE)
#define COMB_YROW(s) ((const bf16*)((const unsigned char*)Y + (size_t)(s) * D))
__device__ __forceinline__ f32x4 comb_y_up(unsigned w) { const auto lo = __builtin_amdgcn_cvt_pk_f32_fp8(w, false), hi = __builtin_amdgcn_cvt_pk_f32_fp8(w, true); return (f32x4){lo[0], lo[1], hi[0], hi[1]}; }
#else
typedef v2u comb_y_t;
#define COMB_YLOAD(p, off) (*(const v2u*)((p) + (off)))
#define COMB_YS 1.0f
#define COMB_YROW(s) (Y + (size_t)(s) * D)
__device__ __forceinline__ f32x4 comb_y_up(v2u w) { return up4(w); }
#endif
#if MK_COMB_WIDE && MK_FP8_Y && !MK_FP8_CMV
__device__ __forceinline__ void phase_comb(ArgsP a, const Fr& F, int layer, int nrows) {
    const unsigned char* Y = (const unsigned char*)(a->ws + WS_Y); const bf16* XL = (const bf16*)(a->ws + WS_U); const f32x2* ST = (const f32x2*)(a->ws + WS_XL); bf16* XC = (bf16*)(a->ws + WS_XC); bf16* HB = (bf16*)(a->ws + WS_HB); const int* INV = (const int*)(a->ws + WS_INV);
    const float* lg1 = a->in[I_LNG] + (size_t)(layer * 2 + 0) * D; const float* lb1 = a->in[I_LNB] + (size_t)(layer * 2 + 0) * D;
    const float* mod = (const float*)(a->ws + WS_MOD) + (size_t)layer * 5 * 6144;
    const float* modn = (const float*)(a->ws + WS_MOD) + (size_t)(layer < 3 ? layer + 1 : 3) * 5 * 6144;
    const float* lg = a->in[I_LNG] + (size_t)(layer * 2 + 1) * D; const float* lb = a->in[I_LNB] + (size_t)(layer * 2 + 1) * D;
    const int gw = F.vcu * NWAVES + F.wave, NGW = F.G * NWAVES;
#define COMB_ISSUE(inv_, row_, sl_, rest_, yv_, xl_, st_) do { unsigned mk_ = (unsigned)(__ballot((inv_) >= 0) & 0xFFFFull); \
        _Pragma("unroll") for (int q = 0; q < 4; ++q) { if (mk_) { const int e_ = __builtin_ctz(mk_); mk_ &= mk_ - 1; sl_[q] = __shfl((inv_), e_); } else sl_[q] = -1; } \
        rest_ = mk_; \
        _Pragma("unroll") for (int q = 0; q < 4; ++q) if (sl_[q] >= 0) { const unsigned char* yp_ = Y + (size_t)sl_[q] * D; _Pragma("unroll") for (int jj = 0; jj < 2; ++jj) yv_[q][jj] = *(const v2u*)(yp_ + 8 * F.lane + 512 * jj); } \
        _Pragma("unroll") for (int jj = 0; jj < 2; ++jj) xl_[jj] = *(const v4u*)(XL + (size_t)(row_) * D + 8 * F.lane + 512 * jj); st_ = ST[(row_)]; } while (0)
    int inv_c = gw < nrows ? INV[(size_t)gw * 16 + (F.lane & 15)] : -1;
    int inv_n = gw + NGW < nrows ? INV[(size_t)(gw + NGW) * 16 + (F.lane & 15)] : -1;
    int sl_c[4] = {-1, -1, -1, -1}; unsigned rest_c = 0u; v2u yv_c[4][2]; v4u xl_c[2]; f32x2 st_c = {0.f, 1.f};
    if (gw < nrows) COMB_ISSUE(inv_c, gw, sl_c, rest_c, yv_c, xl_c, st_c);
    for (int row = gw; row < nrows; row += NGW) {
        const int r = row < T ? (row >> 12) : 4;
        const int hrow = (layer == 2 && row < T) ? (row & ~4095) + ((row & 511) << 3) + ((row & 4095) >> 9) : row;
        const int myinv = inv_c;
        int sl_n[4] = {-1, -1, -1, -1}; unsigned rest_n = 0u; v2u yv_n[4][2]; v4u xl_n[2]; f32x2 st_n = {0.f, 1.f};
        const bool has_n = row + NGW < nrows;
        if (has_n) COMB_ISSUE(inv_n, row + NGW, sl_n, rest_n, yv_n, xl_n, st_n);
        const int inv_nn = (row + 2 * NGW < nrows) ? INV[(size_t)(row + 2 * NGW) * 16 + (F.lane & 15)] : -1;
        f32x4 m[4];
#pragma unroll
        for (int k = 0; k < 4; ++k) m[k] = (f32x4){0.f, 0.f, 0.f, 0.f};
#pragma unroll
        for (int q = 0; q < 4; ++q) if (sl_c[q] >= 0) {
#pragma unroll
            for (int jj = 0; jj < 2; ++jj) { m[2 * jj] += comb_y_up(yv_c[q][jj].x); m[2 * jj + 1] += comb_y_up(yv_c[q][jj].y); } }
        unsigned msk = rest_c;
        while (msk) { const int e = __builtin_ctz(msk); msk &= msk - 1; const int slot = __shfl(myinv, e); const unsigned char* yp = Y + (size_t)slot * D;
#pragma unroll
            for (int jj = 0; jj < 2; ++jj) { const v2u w = *(const v2u*)(yp + 8 * F.lane + 512 * jj); m[2 * jj] += comb_y_up(w.x); m[2 * jj + 1] += comb_y_up(w.y); } }
        f32x4 xc[4];
#pragma unroll
        for (int k = 0; k < 4; ++k) { const int c = 8 * F.lane + 512 * (k >> 1) + 4 * (k & 1); const v4u xw = xl_c[k >> 1]; v2u half; half.x = (k & 1) ? xw.z : xw.x; half.y = (k & 1) ? xw.w : xw.y;
            xc[k] = (up4(half) - st_c.x) * st_c.y * *(const f32x4*)(lg1 + c) + *(const f32x4*)(lb1 + c); }
        inv_c = inv_n; inv_n = inv_nn; rest_c = rest_n; st_c = st_n;
#pragma unroll
        for (int q = 0; q < 4; ++q) { sl_c[q] = sl_n[q];
#pragma unroll
            for (int jj = 0; jj < 2; ++jj) yv_c[q][jj] = yv_n[q][jj]; }
#pragma unroll
        for (int jj = 0; jj < 2; ++jj) xl_c[jj] = xl_n[jj];
        f32x4 v[4]; float s = 0.f;
#pragma unroll
        for (int k = 0; k < 4; ++k) { const int c = 8 * F.lane + 512 * (k >> 1) + 4 * (k & 1);
            v[k] = xc[k] * ALPHA + *(const f32x4*)(mod + r * 6144 + 5120 + c) * (m[k] * COMB_YS); s += (v[k][0] + v[k][1]) + (v[k][2] + v[k][3]); }
        const float mean = wave_sum(s) * (1.0f / D); float s2 = 0.f;
#pragma unroll
        for (int k = 0; k < 4; ++k) { v[k] = v[k] - mean; s2 += (v[k][0] * v[k][0] + v[k][1] * v[k][1]) + (v[k][2] * v[k][2] + v[k][3] * v[k][3]); }
        const float rstd = 1.0f / sqrtf(wave_sum(s2) * (1.0f / D) + LN_EPS);
#pragma unroll
        for (int jj = 0; jj < 2; ++jj) { const int c0 = 8 * F.lane + 512 * jj;
            const f32x4 xa = v[2 * jj] * rstd * *(const f32x4*)(lg + c0) + *(const f32x4*)(lb + c0), xb = v[2 * jj + 1] * rstd * *(const f32x4*)(lg + c0 + 4) + *(const f32x4*)(lb + c0 + 4);
            if (layer == 3) { *(f32x4*)(a->out + (size_t)row * D + c0) = xa; *(f32x4*)(a->out + (size_t)row * D + c0 + 4) = xb; }
            else { { v4u xo; xo.x = pk2(xa[0], xa[1]); xo.y = pk2(xa[2], xa[3]); xo.z = pk2(xb[0], xb[1]); xo.w = pk2(xb[2], xb[3]); *(v4u*)(XC + (size_t)row * D + c0) = xo; }
                const f32x4 ha = xa * (*(const f32x4*)(modn + r * 6144 + 1024 + c0) + 1.0f) + *(const f32x4*)(modn + r * 6144 + c0);
                const f32x4 hb = xb * (*(const f32x4*)(modn + r * 6144 + 1024 + c0 + 4) + 1.0f) + *(const f32x4*)(modn + r * 6144 + c0 + 4);
                if ((MK_FP8_HYIN && layer == 2) || (MK_FP8_CMIN && layer == 1) || (MK_FP8_QKV && layer == 0)) { v2u o8; o8.x = pk4_e4m3(ha); o8.y = pk4_e4m3(hb); *(v2u*)((unsigned char*)HB + (size_t)hrow * D + c0) = o8; }
                else { v4u o; o.x = pk2(ha[0], ha[1]); o.y = pk2(ha[2], ha[3]); o.z = pk2(hb[0], hb[1]); o.w = pk2(hb[2], hb[3]); *(v4u*)(HB + (size_t)hrow * D + c0) = o; } } }
    }
#undef COMB_ISSUE
}
#else
__device__ __forceinline__ void phase_comb(ArgsP a, const Fr& F, int layer, int nrows) {
    const bf16* Y = (const bf16*)(a->ws + WS_Y); const bf16* XL = (const bf16*)(a->ws + WS_U); const f32x2* ST = (const f32x2*)(a->ws + WS_XL); bf16* XC = (bf16*)(a->ws + WS_XC); bf16* HB = (bf16*)(a->ws + WS_HB); const int* INV = (const int*)(a->ws + WS_INV);
    const float* lg1 = a->in[I_LNG] + (size_t)(layer * 2 + 0) * D; const float* lb1 = a->in[I_LNB] + (size_t)(layer * 2 + 0) * D;
    const float* mod = (const float*)(a->ws + WS_MOD) + (size_t)layer * 5 * 6144;
    const float* modn = (const float*)(a->ws + WS_MOD) + (size_t)(layer < 3 ? layer + 1 : 3) * 5 * 6144;
    const float* lg = a->in[I_LNG] + (size_t)(layer * 2 + 1) * D; const float* lb = a->in[I_LNB] + (size_t)(layer * 2 + 1) * D;
    const int gw = F.vcu * NWAVES + F.wave, NGW = F.G * NWAVES;
#define COMB_ISSUE(inv_, row_, sl_, rest_, yv_, xl_, st_) do { unsigned mk_ = (unsigned)(__ballot((inv_) >= 0) & 0xFFFFull); \
        _Pragma("unroll") for (int q = 0; q < 4; ++q) { if (mk_) { const int e_ = __builtin_ctz(mk_); mk_ &= mk_ - 1; sl_[q] = __shfl((inv_), e_); } else sl_[q] = -1; } \
        rest_ = mk_; \
        _Pragma("unroll") for (int q = 0; q < 4; ++q) if (sl_[q] >= 0) { const bf16* yp_ = COMB_YROW(sl_[q]); _Pragma("unroll") for (int j = 0; j < 4; ++j) yv_[q][j] = COMB_YLOAD(yp_, 4 * F.lane + 256 * j); } \
        _Pragma("unroll") for (int j = 0; j < 4; ++j) xl_[j] = *(const v2u*)(XL + (size_t)(row_) * D + 4 * F.lane + 256 * j); st_ = ST[(row_)]; } while (0)
    int inv_c = gw < nrows ? INV[(size_t)gw * 16 + (F.lane & 15)] : -1;
    int inv_n = gw + NGW < nrows ? INV[(size_t)(gw + NGW) * 16 + (F.lane & 15)] : -1;
    int sl_c[4] = {-1, -1, -1, -1}; unsigned rest_c = 0u; comb_y_t yv_c[4][4]; v2u xl_c[4]; f32x2 st_c = {0.f, 1.f};
    if (gw < nrows) COMB_ISSUE(inv_c, gw, sl_c, rest_c, yv_c, xl_c, st_c);
    for (int row = gw; row < nrows; row += NGW) {
        const int r = row < T ? (row >> 12) : 4;
        const int hrow = (layer == 2 && row < T) ? (row & ~4095) + ((row & 511) << 3) + ((row & 4095) >> 9) : row;
        const int myinv = inv_c;
        int sl_n[4] = {-1, -1, -1, -1}; unsigned rest_n = 0u; comb_y_t yv_n[4][4]; v2u xl_n[4]; f32x2 st_n = {0.f, 1.f};
        const bool has_n = row + NGW < nrows;
        if (has_n) COMB_ISSUE(inv_n, row + NGW, sl_n, rest_n, yv_n, xl_n, st_n);
        const int inv_nn = (row + 2 * NGW < nrows) ? INV[(size_t)(row + 2 * NGW) * 16 + (F.lane & 15)] : -1;
        f32x4 m[4];
#pragma unroll
        for (int j = 0; j < 4; ++j) m[j] = (f32x4){0.f, 0.f, 0.f, 0.f};
#pragma unroll
        for (int q = 0; q < 4; ++q) if (sl_c[q] >= 0) {
#pragma unroll
            for (int j = 0; j < 4; ++j) m[j] += comb_y_up(yv_c[q][j]); }
        unsigned msk = rest_c;
        while (msk) { const int e = __builtin_ctz(msk); msk &= msk - 1; const int slot = __shfl(myinv, e); const bf16* yp = COMB_YROW(slot);
#pragma unroll
            for (int j = 0; j < 4; ++j) m[j] += comb_y_up(COMB_YLOAD(yp, 4 * F.lane + 256 * j)); }
        f32x4 xc[4];
#pragma unroll
        for (int j = 0; j < 4; ++j) { const int c = 4 * F.lane + 256 * j; xc[j] = (up4(xl_c[j]) - st_c.x) * st_c.y * *(const f32x4*)(lg1 + c) + *(const f32x4*)(lb1 + c); }
        inv_c = inv_n; inv_n = inv_nn; rest_c = rest_n; st_c = st_n;
#pragma unroll
        for (int q = 0; q < 4; ++q) { sl_c[q] = sl_n[q];
#pragma unroll
            for (int j = 0; j < 4; ++j) yv_c[q][j] = yv_n[q][j]; }
#pragma unroll
        for (int j = 0; j < 4; ++j) xl_c[j] = xl_n[j];
        f32x4 v[4]; float s = 0.f;
#pragma unroll
        for (int j = 0; j < 4; ++j) { const int c = 4 * F.lane + 256 * j;
            v[j] = xc[j] * ALPHA + *(const f32x4*)(mod + r * 6144 + 5120 + c) * (m[j] * COMB_YS); s += (v[j][0] + v[j][1]) + (v[j][2] + v[j][3]); }
        const float mean = wave_sum(s) * (1.0f / D); float s2 = 0.f;
#pragma unroll
        for (int j = 0; j < 4; ++j) { v[j] = v[j] - mean; s2 += (v[j][0] * v[j][0] + v[j][1] * v[j][1]) + (v[j][2] * v[j][2] + v[j][3] * v[j][3]); }
        const float rstd = 1.0f / sqrtf(wave_sum(s2) * (1.0f / D) + LN_EPS);
#pragma unroll
        for (int j = 0; j < 4; ++j) { const int c = 4 * F.lane + 256 * j;
            const f32x4 x = v[j] * rstd * *(const f32x4*)(lg + c) + *(const f32x4*)(lb + c);
            if (layer == 3) { *(f32x4*)(a->out + (size_t)row * D + c) = x; }
            else { { v2u xo; xo.x = pk2(x[0], x[1]); xo.y = pk2(x[2], x[3]); *(v2u*)(XC + (size_t)row * D + c) = xo; }
                const f32x4 h = x * (*(const f32x4*)(modn + r * 6144 + 1024 + c) + 1.0f) + *(const f32x4*)(modn + r * 6144 + c);
                if ((MK_FP8_HYIN && layer == 2) || (MK_FP8_CMIN && layer == 1) || (MK_FP8_QKV && layer == 0)) *(unsigned*)((unsigned char*)HB + (size_t)hrow * D + c) = pk4_e4m3(h);
                else { v2u o; o.x = pk2(h[0], h[1]); o.y = pk2(h[2], h[3]); *(v2u*)(HB + (size_t)hrow * D + c) = o;
                    if (MK_FP8_CMV && !MK_FP8_CMIN && layer == 1) *(unsigned*)((unsigned char*)(a->ws + WS_HB8B) + (size_t)row * D + c) = pk4_e4m3(h); } } }
    }
#undef COMB_ISSUE
}
#endif
#ifndef FFT_HD
#define FFT_HD __device__ __forceinline__
#endif
typedef float cf2 __attribute__((ext_vector_type(2)));
FFT_HD cf2 cmul(cf2 a, cf2 b) { return (cf2){a.x * b.x - a.y * b.y, a.x * b.y + a.y * b.x}; }
FFT_HD int fpad(int p) { return p + (p >> 5); }
constexpr int FFT_N = 8192, FFT_BUF = 8192 + 256;
template <bool INV> FFT_HD void dft4(cf2& a, cf2& b, cf2& c, cf2& d) {
    const cf2 s0 = a + c, s1 = a - c, s2 = b + d, s3 = b - d;
    const cf2 js3 = INV ? (cf2){-s3.y, s3.x} : (cf2){s3.y, -s3.x};
    a = s0 + s2; b = s1 + js3; c = s0 - s2; d = s1 - js3;
}
template <bool INV> FFT_HD void dft16(cf2 (&x)[16]) {
#pragma unroll
    for (int n0 = 0; n0 < 4; ++n0) dft4<INV>(x[n0], x[n0 + 4], x[n0 + 8], x[n0 + 12]);
    constexpr float C1 = 0.92387953251128674f, S1 = 0.38268343236508977f, R2 = 0.70710678118654752f;
    const float sg = INV ? 1.f : -1.f;
    const cf2 w1 = {C1, sg * S1}, w2 = {R2, sg * R2}, w3 = {S1, sg * C1}, w4 = {0.f, sg * 1.f}, w6 = {-R2, sg * R2}, w9 = {-C1, -sg * S1};
    x[1 + 4 * 1] = cmul(x[1 + 4 * 1], w1); x[1 + 4 * 2] = cmul(x[1 + 4 * 2], w2); x[1 + 4 * 3] = cmul(x[1 + 4 * 3], w3);
    x[2 + 4 * 1] = cmul(x[2 + 4 * 1], w2); x[2 + 4 * 2] = cmul(x[2 + 4 * 2], w4); x[2 + 4 * 3] = cmul(x[2 + 4 * 3], w6);
    x[3 + 4 * 1] = cmul(x[3 + 4 * 1], w3); x[3 + 4 * 2] = cmul(x[3 + 4 * 2], w6); x[3 + 4 * 3] = cmul(x[3 + 4 * 3], w9);
#pragma unroll
    for (int k0 = 0; k0 < 4; ++k0) dft4<INV>(x[0 + 4 * k0], x[1 + 4 * k0], x[2 + 4 * k0], x[3 + 4 * k0]);
#pragma unroll
    for (int i = 0; i < 4; ++i)
#pragma unroll
        for (int j = i + 1; j < 4; ++j) { const cf2 t = x[i + 4 * j]; x[i + 4 * j] = x[j + 4 * i]; x[j + 4 * i] = t; }
}
FFT_HD cf2 cmulc(cf2 a, cf2 b) { return (cf2){a.x * b.x + a.y * b.y, a.y * b.x - a.x * b.y}; }
template <bool INV, class BP> FFT_HD void stage_r16(BP buf, const cf2 (&tw)[15], int base, int stride) {
    cf2 x[16];
    const int pb = fpad(base), ps = stride + (stride >> 5);
#pragma unroll
    for (int i = 0; i < 16; ++i) x[i] = buf[pb + i * ps];
    if (!INV) { dft16<false>(x);
#pragma unroll
        for (int k = 1; k < 16; ++k) x[k] = cmulc(x[k], tw[k - 1]); }
    else {
#pragma unroll
        for (int k = 1; k < 16; ++k) x[k] = cmul(x[k], tw[k - 1]);
        dft16<true>(x); }
#pragma unroll
    for (int i = 0; i < 16; ++i) buf[pb + i * ps] = x[i];
}
template <class TP> FFT_HD void load_tw(TP TW, int tidx, cf2 (&tw)[15]) {
#pragma unroll
    for (int k = 1; k < 16; ++k) tw[k - 1] = TW[(tidx * k) & (FFT_N - 1)];
}
template <bool INV, class BP> FFT_HD void stage_r16_chain(BP buf, cf2 w, int base, int stride) {
    cf2 tw[15]; tw[0] = w;
#pragma unroll
    for (int k = 1; k < 15; ++k) tw[k] = cmul(tw[k - 1], w);
    stage_r16<INV>(buf, tw, base, stride);
}
template <class BP> FFT_HD void stage1_fwd_regs(BP buf, cf2 (&x)[16], cf2 w, int m) {
    dft16<false>(x);
    cf2 wk = w; const int pb = fpad(m);
    buf[pb] = x[0];
#pragma unroll
    for (int k = 1; k < 16; ++k) { buf[pb + 528 * k] = cmulc(x[k], wk); if (k < 15) wk = cmul(wk, w); }
}
template <class BP> FFT_HD void stage1_inv_regs(BP buf, cf2 (&x)[16], cf2 w, int m) {
    cf2 wk = w; const int pb = fpad(m);
    x[0] = buf[pb];
#pragma unroll
    for (int k = 1; k < 16; ++k) { x[k] = cmul(buf[pb + 528 * k], wk); if (k < 15) wk = cmul(wk, w); }
    dft16<true>(x);
}
template <bool INV, class BP> FFT_HD void stage_r32_load(BP buf, int blk, int r, cf2 (&u)[16]) {
    constexpr float CS[16] = {1.f, 0.98078528040323043f, 0.92387953251128674f, 0.83146961230254524f, 0.70710678118654752f, 0.55557023301960218f, 0.38268343236508977f, 0.19509032201612825f,
                              0.f, -0.19509032201612825f, -0.38268343236508977f, -0.55557023301960218f, -0.70710678118654752f, -0.83146961230254524f, -0.92387953251128674f, -0.98078528040323043f};
    constexpr float SN[16] = {0.f, 0.19509032201612825f, 0.38268343236508977f, 0.55557023301960218f, 0.70710678118654752f, 0.83146961230254524f, 0.92387953251128674f, 0.98078528040323043f,
                              1.f, 0.98078528040323043f, 0.92387953251128674f, 0.83146961230254524f, 0.70710678118654752f, 0.55557023301960218f, 0.38268343236508977f, 0.19509032201612825f};
    const int base = blk * 33;
#pragma unroll
    for (int n = 0; n < 16; ++n) { const cf2 lo = buf[base + n], hi = buf[base + n + 16];
        const cf2 s = lo + hi, d = lo - hi; const cf2 w = {CS[n], INV ? SN[n] : -SN[n]}; const cf2 dw = cmul(d, w);
        u[n] = r ? dw : s; }
    dft16<INV>(u);
}
template <class BP> FFT_HD void stage_r32_store(BP buf, int blk, int r, const cf2 (&u)[16]) {
    const int base = blk * 33;
#pragma unroll
    for (int g = 0; g < 16; ++g) buf[base + 2 * g + r] = u[g];
}
template <class BP> FFT_HD void stage_r32_store_mul(BP buf, BP W, int blk, int r, const cf2 (&u)[16], int o, float scale) {
    const int base = blk * 33; const int f1 = blk >> 4, f2 = blk & 15;
#pragma unroll
    for (int g = 0; g < 16; ++g) { const int f3 = 2 * g + r; const int f = f1 + 16 * f2 + 256 * f3; const int fm = (FFT_N - f) & (FFT_N - 1);
        const int pm = (fm & 15) * 512 + ((fm >> 4) & 15) * 32 + (fm >> 8);
        const cf2 a = W[base + f3], b = W[fpad(pm)];
        const cf2 k = o == 0 ? (cf2){0.5f * (a.x + b.x), 0.5f * (a.y - b.y)} : (cf2){0.5f * (a.y + b.y), 0.5f * (b.x - a.x)};
        buf[base + f3] = cmul(u[g], k) * scale; }
}
template <class BP> FFT_HD void fft_mul(BP Z, BP W, int tid, int o, float scale) {
    const int f2 = tid >> 5, f3 = tid & 31; const int pp = fpad(tid);
#pragma unroll 4
    for (int j = 0; j < 16; ++j) { const int f = j + 16 * f2 + 256 * f3; const int fm = (FFT_N - f) & (FFT_N - 1);
        const int pm = (fm & 15) * 512 + ((fm >> 4) & 15) * 32 + (fm >> 8);
        const cf2 a = W[pp + 528 * j], b = W[fpad(pm)];
        const cf2 k = o == 0 ? (cf2){0.5f * (a.x + b.x), 0.5f * (a.y - b.y)} : (cf2){0.5f * (a.y + b.y), 0.5f * (b.x - a.x)};
        const cf2 z = Z[pp + 528 * j]; Z[pp + 528 * j] = cmul(z, k) * scale; }
}
#ifndef FFT_HOST_ONLY
__device__ __forceinline__ void ld_tw2(const LAS cf2* tw2l, int tid, cf2 (&tw)[15]) {
#pragma unroll
    for (int k = 0; k < 15; ++k) tw[k] = tw2l[(tid & 31) * 15 + k];
}
__device__ __forceinline__ void fft_fwd(LAS cf2* buf, cf2 w1, const LAS cf2* tw2l, int tid) {
    asm volatile("" : "+v"(tid));
    stage_r16_chain<false>(buf, w1, tid, 512); __syncthreads();
    { cf2 tw[15]; ld_tw2(tw2l, tid, tw); stage_r16<false>(buf, tw, (tid >> 5) * 512 + (tid & 31), 32); } __syncthreads();
    { cf2 u[16]; stage_r32_load<false>(buf, tid >> 1, tid & 1, u); stage_r32_store(buf, tid >> 1, tid & 1, u); } __syncthreads();
}
__device__ __forceinline__ void fft_inv(LAS cf2* buf, cf2 w1, const LAS cf2* tw2l, int tid) {
    asm volatile("" : "+v"(tid));
    { cf2 u[16]; stage_r32_load<true>(buf, tid >> 1, tid & 1, u); stage_r32_store(buf, tid >> 1, tid & 1, u); } __syncthreads();
    { cf2 tw[15]; ld_tw2(tw2l, tid, tw); stage_r16<true>(buf, tw, (tid >> 5) * 512 + (tid & 31), 32); } __syncthreads();
    stage_r16_chain<true>(buf, w1, tid, 512); __syncthreads();
}
struct P8 { v4u own, prv, nxt; };
__device__ __forceinline__ P8 p8_load(const bf16* p, int m) { P8 r; r.own = *(const v4u*)(p + 8 * m); r.prv = *(const v4u*)(p + 8 * (m == 0 ? 511 : m - 1)); r.nxt = *(const v4u*)(p + 8 * (m == 511 ? 0 : m + 1)); return r; }
__device__ __forceinline__ void unpk8(const v4u& v, float (&o)[8]) { const unsigned w[4] = {v.x, v.y, v.z, v.w};
#pragma unroll
    for (int j = 0; j < 4; ++j) { o[2 * j] = __builtin_bit_cast(float, w[j] << 16); o[2 * j + 1] = __builtin_bit_cast(float, w[j] & 0xffff0000u); } }
__device__ __forceinline__ void p8_conv(const P8& r, int m, float w0, float w1, float w2, float cb, float (&o)[8]) {
    float a[8], b[8], c[8]; unpk8(r.own, a); unpk8(r.prv, b); unpk8(r.nxt, c);
#pragma unroll
    for (int j = 0; j < 8; ++j) { const float pv = m == 0 ? (j ? b[j - 1] : 0.f) : b[j]; const float nx = m == 511 ? (j < 7 ? c[j + 1] : 0.f) : c[j];
        o[j] = w0 * pv + w1 * a[j] + w2 * nx + cb; }
}
__device__ __forceinline__ void fft_mid_a(LAS cf2* Zb, LAS cf2* Wb, const LAS cf2* tw2l, int tid, int o, float sc) {
    asm volatile("" : "+v"(tid));
    __syncthreads();
    { cf2 tw[15]; ld_tw2(tw2l, tid, tw); stage_r16<false>(Zb, tw, (tid >> 5) * 512 + (tid & 31), 32); } __syncthreads();
    { cf2 u[16]; stage_r32_load<false>(Zb, tid >> 1, tid & 1, u); stage_r32_store_mul(Zb, Wb, tid >> 1, tid & 1, u, o, sc); } __syncthreads();
    { cf2 u[16]; stage_r32_load<true>(Zb, tid >> 1, tid & 1, u); stage_r32_store(Zb, tid >> 1, tid & 1, u); } __syncthreads();
}
__device__ __forceinline__ void fft_mid_b(LAS cf2* Zb, const LAS cf2* tw2l, int tid) {
    asm volatile("" : "+v"(tid));
    { cf2 tw[15]; ld_tw2(tw2l, tid, tw); stage_r16<true>(Zb, tw, (tid >> 5) * 512 + (tid & 31), 32); } __syncthreads();
}
__device__ __forceinline__ void hy_fft_item(ArgsP a, const Fr& F, int slot, int d, cf2 wtw) {
    LAS cf2* Zb = (LAS cf2*)F.lds;
    LAS cf2* Wb = Zb + FFT_BUF;
    LAS float* red = (LAS float*)(Wb + FFT_BUF);
    const LAS cf2* tw2l = (const LAS cf2*)(red + 16);
    const bf16* PT = (const bf16*)(a->ws + SC_PT); bf16* Z2T = (bf16*)(a->ws + SC_Z2T);
    const float* HF = (const float*)(a->ws + WS_HF + (size_t)slot * HF_SLOT);
    const int tid = F.tid;
    __syncthreads();
    { const float* f0 = HF + (size_t)(0 * 1024 + d) * SEQ; const float* b0 = HF + (size_t)(1 * 1024 + d) * SEQ;
      const float* f1 = HF + (size_t)(2 * 1024 + d) * SEQ; const float* b1 = HF + (size_t)(3 * 1024 + d) * SEQ;
      float s0 = 0.f, s1 = 0.f; float fa[8], fb[8], ba[8], bb[8];
#pragma unroll
      for (int j = 0; j < 8; ++j) { const int t = tid + 512 * j; fa[j] = f0[t]; fb[j] = f1[t]; ba[j] = b0[t]; bb[j] = b1[t]; }
#pragma unroll
      for (int j = 0; j < 8; ++j) { const int t = tid + 512 * j; Wb[fpad(t)] = (cf2){fa[j], fb[j]}; s0 += fabsf(fa[j]); s1 += fabsf(fb[j]);
          if (t >= 1) { Wb[fpad(FFT_N - t)] = (cf2){ba[j], bb[j]}; s0 += fabsf(ba[j]); s1 += fabsf(bb[j]); } }
      if (tid == 0) Wb[fpad(SEQ)] = (cf2){0.f, 0.f};
      s0 = wave_sum(s0); s1 = wave_sum(s1); if (F.lane == 0) { red[F.wave] = s0; red[8 + F.wave] = s1; } }
    __syncthreads();
    float nrm0, nrm1; { float s0 = 0.f, s1 = 0.f; for (int w = 0; w < 8; ++w) { s0 += red[w]; s1 += red[8 + w]; } nrm0 = 1.0f / (s0 + 1e-6f); nrm1 = 1.0f / (s1 + 1e-6f); }
    fft_fwd(Wb, wtw, tw2l, tid);
    const float* cw = a->in[I_HYCW] + (size_t)slot * 3 * 3072; const float* cbp = a->in[I_HYCB] + (size_t)slot * 3072;
    float w0[3], w1[3], w2[3], cb[3];
#pragma unroll
    for (int g = 0; g < 3; ++g) { const int c = g * 1024 + d; w0[g] = cw[c]; w1[g] = cw[3072 + c]; w2[g] = cw[2 * 3072 + c]; cb[g] = cbp[c]; }
    const float fb0 = a->in[I_FBIAS][(slot * 2 + 0) * 1024 + d], fb1 = a->in[I_FBIAS][(slot * 2 + 1) * 1024 + d];
    const float sc0 = nrm0 * (1.0f / FFT_N), sc1 = nrm1 * (1.0f / FFT_N);
#pragma unroll 1
    for (int pr = 0; pr < 2; ++pr) {
        int m = tid; asm volatile("" : "+v"(m));
        const bf16* pb = PT + (size_t)d * TA + (2 * pr) * SEQ;
        const P8 rv0 = p8_load(pb, m), rv1 = p8_load(pb + SEQ, m);
        float va[8], vb2[8];
        p8_conv(rv0, m, w0[0], w1[0], w2[0], cb[0], va); p8_conv(rv1, m, w0[0], w1[0], w2[0], cb[0], vb2);
        cf2 vin[8], x[16];
#pragma unroll
        for (int j = 0; j < 8; ++j) { vin[j] = (cf2){va[j], vb2[j]}; x[j] = vin[j]; x[j + 8] = (cf2){0.f, 0.f}; }
        stage1_fwd_regs(Zb, x, wtw, m);
        fft_mid_a(Zb, Wb, tw2l, tid, 0, sc0);
        const P8 rx0 = p8_load(pb + (size_t)1024 * TA, m), rx1 = p8_load(pb + (size_t)1024 * TA + SEQ, m);
        fft_mid_b(Zb, tw2l, tid);
        stage1_inv_regs(Zb, x, wtw, m);
        p8_conv(rx0, m, w0[1], w1[1], w2[1], cb[1], va); p8_conv(rx1, m, w0[1], w1[1], w2[1], cb[1], vb2);
#pragma unroll
        for (int j = 0; j < 8; ++j) { const cf2 xg = {va[j], vb2[j]}; vin[j] = xg * (x[j] + vin[j] * fb0); x[j] = vin[j]; x[j + 8] = (cf2){0.f, 0.f}; }
        stage1_fwd_regs(Zb, x, wtw, m);
        fft_mid_a(Zb, Wb, tw2l, tid, 1, sc1);
        const P8 rz0 = p8_load(pb + (size_t)2048 * TA, m), rz1 = p8_load(pb + (size_t)2048 * TA + SEQ, m);
        fft_mid_b(Zb, tw2l, tid);
        stage1_inv_regs(Zb, x, wtw, m);
        p8_conv(rz0, m, w0[2], w1[2], w2[2], cb[2], va); p8_conv(rz1, m, w0[2], w1[2], w2[2], cb[2], vb2);
        float z0[8], z1[8];
#pragma unroll
        for (int j = 0; j < 8; ++j) { const cf2 xg = {va[j], vb2[j]}; const cf2 z = xg * (x[j] + vin[j] * fb1); z0[j] = z.x; z1[j] = z.y; }
        bf16* o0 = Z2T + (size_t)d * TA + (2 * pr) * SEQ + 8 * m;
        v4u q0, q1; q0.x = pk2(z0[0], z0[1]); q0.y = pk2(z0[2], z0[3]); q0.z = pk2(z0[4], z0[5]); q0.w = pk2(z0[6], z0[7]);
        q1.x = pk2(z1[0], z1[1]); q1.y = pk2(z1[2], z1[3]); q1.z = pk2(z1[4], z1[5]); q1.w = pk2(z1[6], z1[7]);
        *(v4u*)o0 = q0; *(v4u*)(o0 + SEQ) = q1;
    }
}
__device__ __forceinline__ void phase_hy_conv_fft(ArgsP a, const Fr& F, int layer) {
    const int slot = layer == 0 ? 0 : 1; const int nitems = layer == 0 ? 2048 : 1024;
    {   const cf2* TW = (const cf2*)(a->ws + WS_TW);
        LAS cf2* tw2l = (LAS cf2*)((LAS float*)((LAS cf2*)F.lds + 2 * FFT_BUF) + 16);
        __syncthreads();
        if (F.tid < 32 * 15) { const int n3 = F.tid / 15, k = F.tid % 15 + 1; tw2l[F.tid] = TW[(16 * n3 * k) & (FFT_N - 1)]; }
        const cf2 w1 = TW[F.tid];
        __syncthreads();
        for (int it = F.vcu; it < 1024; it += F.G) hy_fft_item(a, F, slot, it, w1);
    }
    for (int it = 1024 + F.vcu; it < nitems; it += F.G) hy_ctx_item(a, F, slot, it - 1024);
}
#endif
#include <hip/hip_bf16.h>
namespace attn_body {
using bf16=__hip_bfloat16;
using bf16x8=__attribute__((ext_vector_type(8)))short;
using s16x4=__attribute__((ext_vector_type(4)))short;
using f32x16=__attribute__((ext_vector_type(16)))float;
using u32x4=__attribute__((ext_vector_type(4)))unsigned;
constexpr int BATCH=4,NHEAD=16,SEQ=4096,D=64,DM=NHEAD*D,KP=256,LKEYS=4352;
constexpr int NW=8,QBLK=32,QB=QBLK*NW,KVBLK=64,NQB=SEQ/QB;
constexpr int ATTN_PITCH=DM, ATTN_UNIT_ROWS=QB;
__device__ __forceinline__ int crow(int r,int hi){return (r&3)+8*(r>>2)+4*hi;}
#define SBAR() __builtin_amdgcn_sched_barrier(0)
__device__ __forceinline__ void cmask(f32x16&p0,f32x16&p1,int jb,int qrel,int hi){
  const float NEG=-INFINITY; int kb=64*jb+4*hi;
  #pragma unroll
  for(int r=0;r<16;++r){int kv=kb+(r&3)+8*(r>>2); if(kv>qrel)p0[r]=NEG; if(kv+32>qrel)p1[r]=NEG;}
}

constexpr int NSLOT=3, SLOTB=8192;
constexpr int LDS_K=0, LDS_V=NSLOT*SLOTB, LDS_WS=2*NSLOT*SLOTB, LDS_OST=LDS_WS+NW*64*4, LDS_BYTES=LDS_OST+NW*4096;
constexpr float C2=0.125f*1.4426950408889634f;
__device__ __forceinline__ void glds16(const void*gsrc,unsigned lds_dst){unsigned keep;
  asm volatile("s_mov_b32 %0, m0\n\ts_mov_b32 m0, %2\n\ts_nop 0\n\tglobal_load_lds_dwordx4 %1, off\n\ts_mov_b32 m0, %0":"=&s"(keep):"v"(gsrc),"s"(lds_dst):"memory");}
__device__ __forceinline__ float max3f(float a,float b,float c){float r;asm("v_max3_f32 %0, %1, %2, %3":"=v"(r):"v"(a),"v"(b),"v"(c));return r;}
__device__ __forceinline__ float max2f(float a,float b){float r;asm("v_max_f32_e32 %0, %1, %2":"=v"(r):"v"(a),"v"(b));return r;}
__device__ __forceinline__ float fadd_s(float a,float b){float r;asm("v_add_f32_e32 %0, %1, %2":"=v"(r):"v"(a),"v"(b));return r;}
__device__ __forceinline__ float fsub_s(float a,float b){float r;asm("v_sub_f32_e32 %0, %1, %2":"=v"(r):"v"(a),"v"(b));return r;}
typedef float f32x2_t __attribute__((ext_vector_type(2))); typedef __bf16 bf16x2_t __attribute__((ext_vector_type(2)));
__device__ __forceinline__ unsigned cvtpk_s(float lo,float hi){f32x2_t v={lo,hi};bf16x2_t b=__builtin_convertvector(v,bf16x2_t);return __builtin_bit_cast(unsigned,b);}
#define WAIT_BAR(N) asm volatile("s_waitcnt vmcnt(" #N ") lgkmcnt(0)\n\ts_barrier":::"memory")

__device__ __forceinline__ void qkt(f32x16&p0,f32x16&p1,const char*Kslot,const bf16x8*qr,const f32x16&negm,int r32,int hi){
  const char*kb=Kslot+hi*1024+r32*16;
  #pragma unroll
  for(int d0=0;d0<4;++d0){
    const bf16x8 b0=*reinterpret_cast<const bf16x8*>(kb+d0*2048);
    const bf16x8 b1=*reinterpret_cast<const bf16x8*>(kb+d0*2048+512);
    if(d0==0){p0=__builtin_amdgcn_mfma_f32_32x32x16_bf16(b0,qr[0],negm,0,0,0);p1=__builtin_amdgcn_mfma_f32_32x32x16_bf16(b1,qr[0],negm,0,0,0);}
    else{p0=__builtin_amdgcn_mfma_f32_32x32x16_bf16(b0,qr[d0],p0,0,0,0);p1=__builtin_amdgcn_mfma_f32_32x32x16_bf16(b1,qr[d0],p1,0,0,0);}}
}
typedef __attribute__((address_space(3))) const char* lds_cptr;
typedef short v4i16_t __attribute__((ext_vector_type(4)));
__device__ __forceinline__ void kload8(bf16x8*kf,lds_cptr kp){
  kf[0]=*(const __attribute__((address_space(3))) bf16x8*)(kp);      kf[1]=*(const __attribute__((address_space(3))) bf16x8*)(kp+512);
  kf[2]=*(const __attribute__((address_space(3))) bf16x8*)(kp+2048); kf[3]=*(const __attribute__((address_space(3))) bf16x8*)(kp+2560);
  kf[4]=*(const __attribute__((address_space(3))) bf16x8*)(kp+4096); kf[5]=*(const __attribute__((address_space(3))) bf16x8*)(kp+4608);
  kf[6]=*(const __attribute__((address_space(3))) bf16x8*)(kp+6144); kf[7]=*(const __attribute__((address_space(3))) bf16x8*)(kp+6656);
}
__device__ __forceinline__ void kload2(bf16x8*kf,lds_cptr kp,int j){ kf[2*j]=*(const __attribute__((address_space(3))) bf16x8*)(kp+j*2048); kf[2*j+1]=*(const __attribute__((address_space(3))) bf16x8*)(kp+j*2048+512); }
__device__ __forceinline__ s16x4 vtr(lds_cptr p){ return __builtin_bit_cast(s16x4,__builtin_amdgcn_ds_read_tr16_b64_v4i16((__attribute__((address_space(3))) v4i16_t*)p)); }
__device__ __forceinline__ float rowmax(const f32x16&p0,const f32x16&p1){
  float a=max3f(p0[0],p0[1],p1[0]),b=max3f(p0[2],p0[3],p1[1]);a=max3f(a,p1[2],p1[3]);
  #pragma unroll
  for(int r=4;r<16;r+=4){a=max3f(a,p0[r],p0[r+1]);b=max3f(b,p0[r+2],p0[r+3]);a=max3f(a,p1[r],p1[r+1]);b=max3f(b,p1[r+2],p1[r+3]);}
  const float m=max2f(a,b);
  auto rr=__builtin_amdgcn_permlane32_swap(__float_as_uint(m),__float_as_uint(m),false,false);
  return max2f(__uint_as_float(rr[0]),__uint_as_float(rr[1]));
}
__device__ __forceinline__ void pv(f32x16*o,int vb,bf16x8 pa0,bf16x8 pa1,bf16x8 pa2,bf16x8 pa3){
  #pragma unroll
  for(int d0=0;d0<2;++d0){s16x4 lo[4],hi[4];
    #pragma unroll
    for(int ks=0;ks<4;++ks){
      asm volatile("ds_read_b64_tr_b16 %0,%1 offset:%c2":"=&v"(lo[ks]):"v"(vb),"i"(d0*4096+ks*1024):"memory");
      asm volatile("ds_read_b64_tr_b16 %0,%1 offset:%c2":"=&v"(hi[ks]):"v"(vb),"i"(d0*4096+ks*1024+512):"memory");}
    asm volatile("s_waitcnt lgkmcnt(0)":::"memory");SBAR();
    #define PK(k) (bf16x8){lo[k][0],lo[k][1],lo[k][2],lo[k][3],hi[k][0],hi[k][1],hi[k][2],hi[k][3]}
    o[d0]=__builtin_amdgcn_mfma_f32_32x32x16_bf16(pa0,PK(0),o[d0],0,0,0);
    o[d0]=__builtin_amdgcn_mfma_f32_32x32x16_bf16(pa1,PK(1),o[d0],0,0,0);
    o[d0]=__builtin_amdgcn_mfma_f32_32x32x16_bf16(pa2,PK(2),o[d0],0,0,0);
    o[d0]=__builtin_amdgcn_mfma_f32_32x32x16_bf16(pa3,PK(3),o[d0],0,0,0);
    #undef PK
  }
}

#ifndef ATTN_STORE16
#if MK_FP8_AOUT
#define ATTN_STORE16(p,v) do { const long off_ = (const bf16*)(p) - (const bf16*)O; const u32x4 v_ = (v); ::v2u o8_; \
    o8_.x = ::pk4_e4m3((::f32x4){__builtin_bit_cast(float, v_.x << 16), __builtin_bit_cast(float, v_.x & 0xffff0000u), __builtin_bit_cast(float, v_.y << 16), __builtin_bit_cast(float, v_.y & 0xffff0000u)} * O_SCALE); \
    o8_.y = ::pk4_e4m3((::f32x4){__builtin_bit_cast(float, v_.z << 16), __builtin_bit_cast(float, v_.z & 0xffff0000u), __builtin_bit_cast(float, v_.w << 16), __builtin_bit_cast(float, v_.w & 0xffff0000u)} * O_SCALE); \
    *(::v2u*)((unsigned char*)O + off_) = o8_; } while (0)
#else
#define ATTN_STORE16(p,v) (*(u32x4*)(p)=(v))
#endif
#endif
template<int THRL> __device__ __forceinline__ void attn_unit(int b,int h,int qb,const bf16*Q,const bf16*__restrict__ K,const bf16*__restrict__ V,bf16*O,char*shm){
  int tid_=threadIdx.x; asm volatile("":"+v"(tid_)); const int tid=tid_,lane=tid&63,r32=lane&31,hi=lane>>5; const int wid=__builtin_amdgcn_readfirstlane(tid>>6);
  const long rowbase=(long)b*SEQ; const int q0=qb*QB;
  const bf16*Qw=Q+(rowbase+q0+wid*QBLK)*DM+h*D;
  const bf16*Kh=K+(long)b*LKEYS*KP+(h>>2)*D,*Vh=V+(long)b*LKEYS*KP+(h>>2)*D;
  const unsigned lds0=(unsigned)(uintptr_t)shm;
  float*wsf=(float*)(shm+LDS_WS)+wid*64;
  const bf16*ksrc=Kh+(long)lane*KP+wid*8;
  const bf16*vsrc=Vh+(long)(16*(wid&3)+(lane>>2))*KP+(wid>>2)*32+(lane&3)*8;
  const unsigned kdst=lds0+LDS_K+wid*1024, vdst=lds0+LDS_V+wid*1024;
  #define DMA_K(t,slot) glds16(ksrc+(long)(t)*KVBLK*KP,(unsigned)__builtin_amdgcn_readfirstlane(kdst+(slot)))
  #define DMA_V(t,slot) glds16(vsrc+(long)(t)*KVBLK*KP,(unsigned)__builtin_amdgcn_readfirstlane(vdst+(slot)))
  const int vb0=(int)(lds0+LDS_V)+((lane>>4)&1)*32+(lane&3)*8+(4*hi+((lane&15)>>2))*64;
  const char*Kbase=shm+LDS_K; bf16x8 kf[8];
  const lds_cptr shm3=(lds_cptr)shm; const lds_cptr kp0=shm3+LDS_K+hi*1024+r32*16; const lds_cptr vp0=shm3+LDS_V+((lane>>4)&1)*32+(lane&3)*8+(4*hi+((lane&15)>>2))*64;
  const int NT=LKEYS/KVBLK;
  DMA_K(0,0);DMA_V(0,0);DMA_K(1,SLOTB);
  bf16x8 qr[4];
  #pragma unroll
  for(int d0=0;d0<4;++d0)qr[d0]=*reinterpret_cast<const bf16x8*>(&Qw[(long)r32*DM+d0*16+hi*8]);
  float mhat=0.f,l_reg=0.f;f32x16 o[2];o[0]=f32x16{};o[1]=f32x16{};f32x16 negm=f32x16{};asm volatile("":"+v"(negm));

  #define CMASK(P0,P1,t) do{}while(0)
  bool resc=false;
  #define START(P0,P1) do{ const float rm=rowmax(P0,P1); resc=false; \
    { const float dl=rm; mhat=fadd_s(mhat,dl); \
      _Pragma("unroll") for(int r=0;r<16;++r){P0[r]=fsub_s(P0[r],dl);P1[r]=fsub_s(P1[r],dl);} \
      _Pragma("unroll") for(int r=0;r<16;++r)negm[r]=-mhat; asm volatile("":"+v"(negm)); } \
    _Pragma("unroll") for(int r=0;r<16;++r)P0[r]=__builtin_amdgcn_exp2f(P0[r]); }while(0)
  #define RESC() do{ if(resc){ asm volatile("s_waitcnt lgkmcnt(0)":::"memory"); \
      _Pragma("unroll") for(int d_=0;d_<2;++d_) _Pragma("unroll") for(int r=0;r<16;++r)o[d_][r]*=wsf[crow(r,hi)]; } }while(0)
  f32x16 pA0,pA1,pB0,pB1;
  int sl_prev=0,sl_cur=0,sl_next=SLOTB;
  #define ROT() do{sl_prev=sl_cur;sl_cur=sl_next;sl_next=(sl_next==(NSLOT-1)*SLOTB)?0:sl_next+SLOTB;}while(0)
  DMA_K(2,2*SLOTB);
  WAIT_BAR(3);
  qkt(pA0,pA1,Kbase,qr,negm,r32,hi);asm volatile("s_nop 15\n\ts_nop 7":"+v"(pA0),"+v"(pA1));CMASK(pA0,pA1,0);
  START(pA0,pA1);
  _Pragma("unroll") for(int r=0;r<16;++r)pA1[r]=__builtin_amdgcn_exp2f(pA1[r]);
  WAIT_BAR(0);
  DMA_K(3,0);DMA_V(1,SLOTB);
  ROT();
  kload8(kf,kp0+sl_cur);
  WAIT_BAR(2);
  s16x4 vlo[8],vhi[8]; u32x4 pw0,pw1,pw2,pw3;
  #define PKW(P,B) cvtpk_s(P[B],P[B+1])
  #define PAF(k) __builtin_bit_cast(bf16x8,pw##k)
  #define VFR(i) (bf16x8){vlo[i][0],vlo[i][1],vlo[i][2],vlo[i][3],vhi[i][0],vhi[i][1],vhi[i][2],vhi[i][3]}
  #define PIN(x) asm volatile("":"+v"(x))
  #define MX3(a,b,c) __builtin_fmaxf(__builtin_fmaxf((a),(b)),(c))
  #define GAPA(MF,A0,A1,A2,A3,W0,W1,PW) do{ MF; sacc+=A0; sacc+=A1; sacc+=A2; sacc+=A3; PIN(sacc); W0; W1; PIN(PW); SBAR(); }while(0)
  #define EX(v) __builtin_amdgcn_exp2f(v)
  #define GAPB(MF,X,B) do{ MF; X[B]=EX(X[B]); X[B+1]=EX(X[B+1]); X[B+2]=EX(X[B+2]); X[B+3]=EX(X[B+3]); PIN(X); SBAR(); }while(0)
  #define VRD(i) do{ vlo[i]=vtr(vp_+(((i)>>2)*4096+((i)&3)*1024)); vhi[i]=vtr(vp_+(((i)>>2)*4096+((i)&3)*1024+512)); }while(0)
  #define KRD(G,j) do{ if(G){ kload2(kf,kp0+sl_next,j); SBAR(); } }while(0)
  #define STEP(C0,C1,P0,P1,t,GK,GV,GL) do{ SBAR(); \
    const lds_cptr vp_=vp0+sl_prev; \
    VRD(0); SBAR(); float sacc=(P0[0]+P0[1]); \
    GAPA(C0=__builtin_amdgcn_mfma_f32_32x32x16_bf16(kf[0],qr[0],negm,0,0,0), P0[2],P0[3],P0[4],P0[5],     pw0[0]=PKW(P0,0), pw0[1]=PKW(P0,2), pw0); \
    VRD(4); SBAR(); GAPA(C1=__builtin_amdgcn_mfma_f32_32x32x16_bf16(kf[1],qr[0],negm,0,0,0), P0[6],P0[7],P0[8],P0[9],     pw0[2]=PKW(P0,4), pw0[3]=PKW(P0,6), pw0); \
    VRD(1); SBAR(); GAPA(C0=__builtin_amdgcn_mfma_f32_32x32x16_bf16(kf[2],qr[1],C0,0,0,0),   P0[10],P0[11],P0[12],P0[13], pw1[0]=PKW(P0,8), pw1[1]=PKW(P0,10), pw1); \
    VRD(5); SBAR(); GAPA(C1=__builtin_amdgcn_mfma_f32_32x32x16_bf16(kf[3],qr[1],C1,0,0,0),   P0[14],P0[15],P1[0],P1[1],   pw1[2]=PKW(P0,12),pw1[3]=PKW(P0,14), pw1); \
    VRD(2); SBAR(); GAPA(C0=__builtin_amdgcn_mfma_f32_32x32x16_bf16(kf[4],qr[2],C0,0,0,0),   P1[2],P1[3],P1[4],P1[5],     pw2[0]=PKW(P1,0), pw2[1]=PKW(P1,2), pw2); \
    VRD(6); SBAR(); GAPA(C1=__builtin_amdgcn_mfma_f32_32x32x16_bf16(kf[5],qr[2],C1,0,0,0),   P1[6],P1[7],P1[8],P1[9],     pw2[2]=PKW(P1,4), pw2[3]=PKW(P1,6), pw2); \
    VRD(3); SBAR(); GAPA(C0=__builtin_amdgcn_mfma_f32_32x32x16_bf16(kf[6],qr[3],C0,0,0,0),   P1[10],P1[11],P1[12],P1[13], pw3[0]=PKW(P1,8), pw3[1]=PKW(P1,10), pw3); \
    VRD(7); SBAR(); GAPA(C1=__builtin_amdgcn_mfma_f32_32x32x16_bf16(kf[7],qr[3],C1,0,0,0),   P1[14],P1[15],0.f,0.f,       pw3[2]=PKW(P1,12),pw3[3]=PKW(P1,14), pw3); \
    l_reg+=sacc; \
    if(GK){DMA_K((t)+3,sl_cur);} if(GV){DMA_V((t)+1,sl_next);} \
    CMASK(C0,C1,t); \
    { float a=MX3(C0[0],C0[1],C1[0]),b=MX3(C0[2],C0[3],C1[1]); a=MX3(a,C1[2],C1[3]); \
      _Pragma("unroll") for(int r=4;r<16;r+=4){a=MX3(a,C0[r],C0[r+1]);b=MX3(b,C0[r+2],C0[r+3]);a=MX3(a,C1[r],C1[r+1]);b=MX3(b,C1[r+2],C1[r+3]);} \
      float rm=__builtin_fmaxf(a,b); { auto rr=__builtin_amdgcn_permlane32_swap(__float_as_uint(rm),__float_as_uint(rm),false,false); rm=__builtin_fmaxf(__uint_as_float(rr[0]),__uint_as_float(rr[1])); } \
      resc=false; \
      if(__builtin_expect(__any(rm>(float)THRL),0)){ const float dl=__builtin_fmaxf(rm,0.f); mhat+=dl; \
        _Pragma("unroll") for(int r=0;r<16;++r){C0[r]-=dl;C1[r]-=dl;} \
        _Pragma("unroll") for(int r=0;r<16;++r)negm[r]=-mhat; asm volatile("":"+v"(negm)); \
        const float f=__builtin_amdgcn_exp2f(-dl); l_reg*=f; if(hi==0)wsf[r32]=f; resc=true; } } \
    SBAR(); \
    GAPB(o[0]=__builtin_amdgcn_mfma_f32_32x32x16_bf16(PAF(0),VFR(0),o[0],0,0,0), C0,0); \
    GAPB(o[1]=__builtin_amdgcn_mfma_f32_32x32x16_bf16(PAF(0),VFR(4),o[1],0,0,0), C0,4); \
    KRD(GL,0); GAPB(o[0]=__builtin_amdgcn_mfma_f32_32x32x16_bf16(PAF(1),VFR(1),o[0],0,0,0), C0,8); \
    KRD(GL,1); GAPB(o[1]=__builtin_amdgcn_mfma_f32_32x32x16_bf16(PAF(1),VFR(5),o[1],0,0,0), C0,12); \
    KRD(GL,2); GAPB(o[0]=__builtin_amdgcn_mfma_f32_32x32x16_bf16(PAF(2),VFR(2),o[0],0,0,0), C1,0); \
    KRD(GL,3); GAPB(o[1]=__builtin_amdgcn_mfma_f32_32x32x16_bf16(PAF(2),VFR(6),o[1],0,0,0), C1,4); \
    GAPB(o[0]=__builtin_amdgcn_mfma_f32_32x32x16_bf16(PAF(3),VFR(3),o[0],0,0,0), C1,8); \
    GAPB(o[1]=__builtin_amdgcn_mfma_f32_32x32x16_bf16(PAF(3),VFR(7),o[1],0,0,0), C1,12); \
    }while(0)
  int t=1;
  #undef CMASK
  #define CMASK(P0,P1,t) do{}while(0)
  for(;t+5<NT;t+=2){
    STEP(pB0,pB1,pA0,pA1,t,true,true,true);     WAIT_BAR(2); RESC(); ROT();
    STEP(pA0,pA1,pB0,pB1,t+1,true,true,true);   WAIT_BAR(2); RESC(); ROT();
  }
  #undef CMASK
  #define CMASK(P0,P1,t) do{}while(0)
  #define ENDW(tt) do{ if((tt)+3<NT){WAIT_BAR(2);} else if((tt)+2<NT){WAIT_BAR(1);} else {WAIT_BAR(0);} }while(0)
  for(;t+1<NT;t+=2){
    STEP(pB0,pB1,pA0,pA1,t,(t+3<NT),(t+1<NT),(t+1<NT));       ENDW(t);   RESC(); ROT();
    STEP(pA0,pA1,pB0,pB1,t+1,(t+4<NT),(t+2<NT),(t+2<NT));     ENDW(t+1); RESC(); ROT();
  }
  STEP(pB0,pB1,pA0,pA1,NT-1,false,false,false); RESC();
  { float sacc=pB0[0]+pB0[1]; _Pragma("unroll") for(int r=2;r<16;++r)sacc+=pB0[r]; _Pragma("unroll") for(int r=0;r<16;++r)sacc+=pB1[r]; l_reg+=sacc;
    pw0=(u32x4){PKW(pB0,0),PKW(pB0,2),PKW(pB0,4),PKW(pB0,6)};pw1=(u32x4){PKW(pB0,8),PKW(pB0,10),PKW(pB0,12),PKW(pB0,14)};pw2=(u32x4){PKW(pB1,0),PKW(pB1,2),PKW(pB1,4),PKW(pB1,6)};pw3=(u32x4){PKW(pB1,8),PKW(pB1,10),PKW(pB1,12),PKW(pB1,14)};
    SBAR(); pv(o,vb0+sl_cur,PAF(0),PAF(1),PAF(2),PAF(3)); }
  #undef PKW
  #undef PAF
  #undef VFR
  #undef PIN
  #undef MX3
  #undef GAPA
  #undef GAPB
  #undef EX
  #undef VRD
  #undef KRD
  #undef STEP
  #undef ENDW
  {auto rr=__builtin_amdgcn_permlane32_swap(__float_as_uint(l_reg),__float_as_uint(l_reg),false,false);l_reg=__uint_as_float(rr[0])+__uint_as_float(rr[1]);}
  if(hi==0)wsf[32+r32]=l_reg;asm volatile("s_waitcnt lgkmcnt(0)":::"memory");
  float rli[16];
  #pragma unroll
  for(int r=0;r<16;++r)rli[r]=__builtin_amdgcn_rcpf(wsf[32+crow(r,hi)]);
  bf16*Ow=O+(rowbase+q0+wid*QBLK)*DM+h*D;
  { bf16*stg=(bf16*)(shm+LDS_OST)+wid*2048;
    #pragma unroll
    for(int r=0;r<16;++r){const int orow=crow(r,hi);
      #pragma unroll
      for(int d0=0;d0<2;++d0)stg[orow*64+d0*32+r32]=__float2bfloat16(o[d0][r]*rli[r]);}
    asm volatile("s_waitcnt lgkmcnt(0)":::"memory");
    #pragma unroll
    for(int i=0;i<4;++i){const int row=i*8+(lane>>3),ch=lane&7; const u32x4 v=*(const u32x4*)(stg+row*64+ch*8); ATTN_STORE16(Ow+(long)row*DM+ch*8,v);} }
  asm volatile("s_waitcnt lgkmcnt(0)\n\ts_barrier":::"memory");
  #undef DMA_K
  #undef DMA_V
  #undef CMASK
  #undef START
  #undef RESC
  #undef ROT
}
constexpr int ATTN_LDS_BYTES=LDS_BYTES;
struct AttnTensors { const bf16* Q; const bf16* K; const bf16* V; bf16* O; };
struct AttnUnit { int bh; int qb; };
struct StaticOrder {
  int vcu, per;
  __device__ __forceinline__ explicit StaticOrder(int grid,int vcu_):vcu(vcu_),per((BATCH*NHEAD*(SEQ/QB)+grid-1)/grid){}
  __device__ __forceinline__ bool next(int i,AttnUnit&u)const{ if(i>=per)return false; const int idx=vcu*per+i; if(idx>=BATCH*NHEAD*(SEQ/QB))return false; u.bh=idx/(SEQ/QB); u.qb=idx%(SEQ/QB); return true; }
  __device__ __forceinline__ void a_ready(const AttnUnit&)const{}
  __device__ __forceinline__ void done(const AttnUnit&)const{}
};
template<class Sched,int THRL=8> __device__ __forceinline__ void attn_phase(char*lds,const AttnTensors&T,const Sched&S){
  AttnUnit u;
  for(int i=0;S.next(i,u);++i){ S.a_ready(u); attn_unit<THRL>(u.bh/NHEAD,u.bh%NHEAD,u.qb,T.Q,T.K,T.V,T.O,lds); S.done(u); }
}
#undef SBAR
#undef WAIT_BAR
}

__device__ __forceinline__ void phase_attn_fast(ArgsP a, const Fr& F) {
    const attn_body::AttnTensors AT{(const attn_body::bf16*)(a->ws + SC_Q), (const attn_body::bf16*)(a->ws + SC_K), (const attn_body::bf16*)(a->ws + SC_V), (attn_body::bf16*)(a->ws + SC_O)};
    const attn_body::StaticOrder S(F.G, F.vcu);
    __syncthreads();
    attn_body::attn_phase<attn_body::StaticOrder>((char*)F.lds, AT, S);
    __syncthreads();
}
__device__ __forceinline__ void phase_sp_fast(ArgsP a, const Fr& F) {
    typedef short bf16x8 __attribute__((ext_vector_type(8)));
    constexpr int PITCH = 136;
    LAS unsigned short* As = (LAS unsigned short*)F.lds;
    LAS unsigned short* Bs = As + 128 * PITCH;
    LAS float* st = (LAS float*)(Bs + 128 * PITCH);
    const bf16* VT = (const bf16*)(a->ws + SC_VT); const f32x2* VST = (const f32x2*)(a->ws + SC_VST); const bf16* UB = (const bf16*)(a->ws + SC_UB); bf16* UV = (bf16*)(a->ws + SC_UV);
    const bf16* WS = (const bf16*)(a->ws + WS_WCMS);
    const float* lng = a->in[I_CMLNG]; const float* lnb = a->in[I_CMLNB]; const float* bs = a->in[I_CMBS];
    const int tid = F.tid, lane = F.lane, wid = F.wave, wr = wid >> 2, wc = wid & 3, fr = lane & 15, fq = lane >> 4;
    const int per = (2048 + F.G - 1) / F.G; int gl = -1;
    const int s4 = (lane & 31) * 4, ch = lane >> 5;
    const int it_lo = F.vcu * per, it_hi = ((F.vcu + 1) * per < 2048) ? (F.vcu + 1) * per : 2048;
#define SP_BAR() asm volatile("s_waitcnt lgkmcnt(0)\n\ts_barrier" ::: "memory")
#define SP_PREFETCH(it_) do { const int g_ = (it_) >> 7, n_ = (it_) & 127; \
        _Pragma("unroll") for (int q = 0; q < 8; ++q) vt_n[q] = *(const v2u*)(VT + (size_t)(g_ * 128 + q * 16 + wid * 2 + ch) * T + n_ * 128 + s4); \
        if (tid < 128) { _Pragma("unroll") for (int p = 0; p < 16; ++p) vst_n[p] = VST[(size_t)p * T + n_ * 128 + tid]; } } while (0)
    v2u vt_n[8]; f32x2 vst_n[16];
#pragma unroll
    for (int p = 0; p < 16; ++p) vst_n[p] = (f32x2){0.f, 0.f};
    if (it_lo < it_hi) SP_PREFETCH(it_lo);
    for (int it = it_lo; it < it_hi; ++it) {
        const int g = it >> 7, n = it & 127;
        v2u vt[8];
#pragma unroll
        for (int q = 0; q < 8; ++q) vt[q] = vt_n[q];
        float s1 = 0.f, s2 = 0.f;
#pragma unroll
        for (int p = 0; p < 16; ++p) { s1 += vst_n[p].x; s2 += vst_n[p].y; }
        v2u ub[4][2];
#pragma unroll
        for (int m = 0; m < 4; ++m)
#pragma unroll
            for (int nn = 0; nn < 2; ++nn) ub[m][nn] = *(const v2u*)(UB + (size_t)(n * 128 + wr * 64 + m * 16 + fr) * 2048 + g * 128 + wc * 32 + nn * 16 + 4 * fq);
        SP_BAR();
        if (g != gl) { gl = g;
#pragma unroll
            for (int q = 0; q < 4; ++q) { const int idx = tid + q * NTHR, t = idx >> 4, ck = idx & 15;
                *(LAS v4u*)(As + t * PITCH + ck * 8) = *(const v4u*)(WS + (size_t)g * 16384 + t * 128 + ck * 8); } }
        if (tid < 128) { const float mean = s1 * (1.0f / 2048.0f); const float var = s2 * (1.0f / 2048.0f) - mean * mean; st[tid * 2] = mean; st[tid * 2 + 1] = 1.0f / sqrtf(var + LN_EPS); }
        if (it + 1 < it_hi) SP_PREFETCH(it + 1);
        SP_BAR();
        { const f32x4 mu = {st[(s4 + 0) * 2], st[(s4 + 1) * 2], st[(s4 + 2) * 2], st[(s4 + 3) * 2]};
          const f32x4 rs = {st[(s4 + 0) * 2 + 1], st[(s4 + 1) * 2 + 1], st[(s4 + 2) * 2 + 1], st[(s4 + 3) * 2 + 1]};
#pragma unroll
          for (int q = 0; q < 8; ++q) { const int c = q * 16 + wid * 2 + ch; const int chn = g * 128 + c;
              const f32x4 v = up4(vt[q]);
              const float lg = lng[chn], lb = lnb[chn];
              const f32x4 y = (v - mu) * rs * lg + lb;
              v2u o; o.x = pk2(y[0], y[1]); o.y = pk2(y[2], y[3]); *(LAS v2u*)(Bs + c * PITCH + s4) = o; } }
        SP_BAR();
        f32x4 acc[4][2];
#pragma unroll
        for (int m = 0; m < 4; ++m)
#pragma unroll
            for (int nn = 0; nn < 2; ++nn) acc[m][nn] = (f32x4){0.f, 0.f, 0.f, 0.f};
#pragma unroll
        for (int k = 0; k < 4; ++k) {
            bf16x8 af[4], bfr[2];
#pragma unroll
            for (int m = 0; m < 4; ++m) af[m] = *(const LAS bf16x8*)(As + (wr * 64 + m * 16 + fr) * PITCH + k * 32 + fq * 8);
#pragma unroll
            for (int nn = 0; nn < 2; ++nn) bfr[nn] = *(const LAS bf16x8*)(Bs + (wc * 32 + nn * 16 + fr) * PITCH + k * 32 + fq * 8);
#pragma unroll
            for (int m = 0; m < 4; ++m)
#pragma unroll
                for (int nn = 0; nn < 2; ++nn) acc[m][nn] = __builtin_amdgcn_mfma_f32_16x16x32_bf16(bfr[nn], af[m], acc[m][nn], 0, 0, 0);
        }
#pragma unroll
        for (int m = 0; m < 4; ++m) { const int t = wr * 64 + m * 16 + fr; const float bt = bs[g * 128 + t];
#pragma unroll
            for (int nn = 0; nn < 2; ++nn) { const size_t idx = (size_t)(n * 128 + t) * 2048 + g * 128 + wc * 32 + nn * 16 + 4 * fq;
                const v2u ubv = ub[m][nn]; const f32x4 o = acc[m][nn] + bt;
#if MK_FP8_CMOUT
                const f32x4 uvv = {__builtin_bit_cast(float, ubv.x << 16) * o[0], __builtin_bit_cast(float, ubv.x & 0xffff0000u) * o[1], __builtin_bit_cast(float, ubv.y << 16) * o[2], __builtin_bit_cast(float, ubv.y & 0xffff0000u) * o[3]};
                *(unsigned*)((unsigned char*)UV + idx) = pk4_e4m3(uvv * O_SCALE); } }
#else
                v2u w; w.x = pk2(__builtin_bit_cast(float, ubv.x << 16) * o[0], __builtin_bit_cast(float, ubv.x & 0xffff0000u) * o[1]);
                w.y = pk2(__builtin_bit_cast(float, ubv.y << 16) * o[2], __builtin_bit_cast(float, ubv.y & 0xffff0000u) * o[3]);
                *(v2u*)(UV + idx) = w; } }
#endif
    }
#undef SP_BAR
#undef SP_PREFETCH
}
__device__ __forceinline__ void phase_rope(ArgsP a, const Fr& F) {
    LAS f32x2* tab = (LAS f32x2*)F.lds;
    __syncthreads();
    for (int u = F.tid; u < 1024; u += NTHR) { const int pos = u >> 4, f = u & 15; const float invf = powf(10000.0f, -(float)f / 16.0f); float sn, cs; sincosf((float)pos * invf, &sn, &cs); tab[u] = (f32x2){cs, sn}; }
    __syncthreads();
    const bf16* QKV = (const bf16*)(a->ws + SC_QKV); bf16* Q = (bf16*)(a->ws + SC_Q); bf16* K = (bf16*)(a->ws + SC_K); bf16* V = (bf16*)(a->ws + SC_V);
    const int gw = F.vcu * NWAVES + F.wave, NGW = F.G * NWAVES;
    const int l8 = F.lane & 7, hl = F.lane >> 3;
    const f32x4 qg0 = *(const f32x4*)(a->in[I_QGAIN] + 4 * l8), qg1 = *(const f32x4*)(a->in[I_QGAIN] + 32 + 4 * l8);
    const f32x4 kg0 = *(const f32x4*)(a->in[I_KGAIN] + 4 * l8), kg1 = *(const f32x4*)(a->in[I_KGAIN] + 32 + 4 * l8);
    for (int row0 = gw; row0 < TA; row0 += 4 * NGW) {
        v2u xa[4][3], xb[4][3];
#pragma unroll
        for (int rr = 0; rr < 4; ++rr) { const int row = row0 + rr * NGW < TA ? row0 + rr * NGW : row0; const bf16* src = QKV + (size_t)row * 1536 + hl * 64 + 4 * l8;
#pragma unroll
            for (int p = 0; p < 3; ++p) { xa[rr][p] = *(const v2u*)(src + p * 512); xb[rr][p] = *(const v2u*)(src + p * 512 + 32); } }
#pragma unroll
        for (int rr = 0; rr < 4; ++rr) { const int row = row0 + rr * NGW; if (row >= TA) break;
            const bool lat = row < T; const int b = lat ? (row >> 12) : ((row - T) >> 8); const int t = lat ? (row & 4095) : ((row - T) & 255);
            f32x4 cs = {1.f, 1.f, 1.f, 1.f}, sn = {0.f, 0.f, 0.f, 0.f};
            if (lat) { const int pos = (l8 < 4) ? (t >> 6) : (t & 63); const LAS f32x4* tp = (const LAS f32x4*)(tab + pos * 16 + 4 * (l8 & 3));
                const f32x4 c01 = tp[0], c23 = tp[1]; cs = (f32x4){c01[0], c01[2], c23[0], c23[2]}; sn = (f32x4){c01[1], c01[3], c23[1], c23[3]}; }
            const size_t krow = (size_t)b * LK + (lat ? LC + t : t);
#pragma unroll
            for (int p = 0; p < 3; ++p) {
                if (p < 2 && !lat) continue;
                if (p == 2 && hl >= 4) { bf16* d = V + krow * KVP + (hl - 4) * 64 + 4 * l8; *(v2u*)d = xa[rr][p]; *(v2u*)(d + 32) = xb[rr][p]; }
                else {
                    const f32x4 x1 = up4(xa[rr][p]), x2 = up4(xb[rr][p]);
                    float ss = ((x1[0] * x1[0] + x1[1] * x1[1]) + (x1[2] * x1[2] + x1[3] * x1[3])) + ((x2[0] * x2[0] + x2[1] * x2[1]) + (x2[2] * x2[2] + x2[3] * x2[3]));
                    ss += __shfl_xor(ss, 1); ss += __shfl_xor(ss, 2); ss += __shfl_xor(ss, 4);
                    const float rs = 1.0f / sqrtf(ss * (1.0f / 64.0f) + RMS_EPS);
                    const bool isq = p < 2;
                    const f32x4 n1 = x1 * rs * (isq ? qg0 : kg0), n2 = x2 * rs * (isq ? qg1 : kg1);
                    f32x4 o1 = n1 * cs - n2 * sn, o2 = n1 * sn + n2 * cs;
                    bf16* d;
                    if (isq) { o1 *= ATT_C2; o2 *= ATT_C2; d = Q + (size_t)row * 1024 + (p * 8 + hl) * 64 + 4 * l8; }
                    else d = K + krow * KVP + hl * 64 + 4 * l8;
                    v2u w1, w2; w1.x = pk2(o1[0], o1[1]); w1.y = pk2(o1[2], o1[3]); w2.x = pk2(o2[0], o2[1]); w2.y = pk2(o2[2], o2[3]);
                    *(v2u*)d = w1; *(v2u*)(d + 32) = w2; }
            }
        }
    }
}
__device__ __forceinline__ void phase_attn_simple(ArgsP a, const Fr& F) {
    const bf16* Q = (const bf16*)(a->ws + SC_Q); const bf16* K = (const bf16*)(a->ws + SC_K); const bf16* V = (const bf16*)(a->ws + SC_V); bf16* O = (bf16*)(a->ws + SC_O);
    for (int it = F.vcu; it < 512; it += F.G) {
        const int b = it >> 7, h = (it >> 3) & 15, q = (it & 7) * 512 + F.tid;
        const bf16* qp = Q + (size_t)(b * SEQ + q) * 1024 + h * 64;
        float qv[64], o[64];
#pragma unroll
        for (int d = 0; d < 64; ++d) { qv[d] = bf2f(qp[d]); o[d] = 0.f; }
        float m = -3.0e38f, l = 0.f;
        const bf16* kb = K + (size_t)b * LK * KVP + (h >> 2) * 64; const bf16* vb = V + (size_t)b * LK * KVP + (h >> 2) * 64;
        for (int s = 0; s < LK; ++s) {
            const v4u* kr = (const v4u*)(kb + (size_t)s * KVP); float sc = 0.f;
#pragma unroll
            for (int c = 0; c < 8; ++c) { const v4u kv = kr[c]; const unsigned w[4] = {kv.x, kv.y, kv.z, kv.w};
#pragma unroll
                for (int j = 0; j < 4; ++j) { sc += qv[c * 8 + 2 * j] * __builtin_bit_cast(float, w[j] << 16) + qv[c * 8 + 2 * j + 1] * __builtin_bit_cast(float, w[j] & 0xffff0000u); } }
            const float mn = fmaxf(m, sc); const float al = exp2f(m - mn), p = exp2f(sc - mn); l = l * al + p; m = mn;
            const v4u* vr = (const v4u*)(vb + (size_t)s * KVP);
#pragma unroll
            for (int c = 0; c < 8; ++c) { const v4u vv = vr[c]; const unsigned w[4] = {vv.x, vv.y, vv.z, vv.w};
#pragma unroll
                for (int j = 0; j < 4; ++j) { o[c * 8 + 2 * j] = o[c * 8 + 2 * j] * al + p * __builtin_bit_cast(float, w[j] << 16); o[c * 8 + 2 * j + 1] = o[c * 8 + 2 * j + 1] * al + p * __builtin_bit_cast(float, w[j] & 0xffff0000u); } }
        }
        const float il = 1.0f / l; bf16* op = O + (size_t)(b * SEQ + q) * 1024 + h * 64;
#pragma unroll
        for (int c = 0; c < 8; ++c) { v4u w; w.x = pk2(o[c * 8] * il, o[c * 8 + 1] * il); w.y = pk2(o[c * 8 + 2] * il, o[c * 8 + 3] * il); w.z = pk2(o[c * 8 + 4] * il, o[c * 8 + 5] * il); w.w = pk2(o[c * 8 + 6] * il, o[c * 8 + 7] * il);
            *(v4u*)(op + c * 8) = w; }
    }
}
__device__ __forceinline__ void phase_sp_simple(ArgsP a, const Fr& F) {
    LAS float* wsL = (LAS float*)F.lds;
    LAS float* vl = wsL + 128 * 128;
    LAS float* st = vl + 128 * 128;
    const float* VT = (const float*)(a->ws + SC_VT); const f32x2* VST = (const f32x2*)(a->ws + SC_VST); const bf16* UB = (const bf16*)(a->ws + SC_UB); bf16* UV = (bf16*)(a->ws + SC_UV);
    const int per = (2048 + F.G - 1) / F.G; int gl = -1;
    for (int it = F.vcu * per; it < (F.vcu + 1) * per && it < 2048; ++it) {
        const int g = it >> 7, n = it & 127;
        __syncthreads();
        if (g != gl) { for (int u = F.tid; u < 128 * 128; u += NTHR) wsL[u] = a->in[I_CMWS][(size_t)g * 16384 + u]; gl = g; }
        if (F.tid < 128) { float s1 = 0.f, s2 = 0.f; for (int p = 0; p < 16; ++p) { const f32x2 v = VST[(size_t)p * T + n * 128 + F.tid]; s1 += v.x; s2 += v.y; }
            const float mean = s1 * (1.0f / 2048.0f); const float var = s2 * (1.0f / 2048.0f) - mean * mean; st[F.tid * 2] = mean; st[F.tid * 2 + 1] = 1.0f / sqrtf(var + LN_EPS); }
        __syncthreads();
        for (int u = F.tid; u < 128 * 128; u += NTHR) { const int c = u >> 7, s = u & 127; const int ch = g * 128 + c;
            const float v = VT[(size_t)ch * T + n * 128 + s]; vl[s * 128 + c] = (v - st[s * 2]) * st[s * 2 + 1] * a->in[I_CMLNG][ch] + a->in[I_CMLNB][ch]; }
        __syncthreads();
        const int c = F.tid & 127, tq = F.tid >> 7;
        for (int jj = 0; jj < 32; ++jj) { const int t = tq + 4 * jj; float acc = 0.f;
            for (int s = 0; s < 128; ++s) acc += wsL[t * 128 + s] * vl[s * 128 + c];
            acc += a->in[I_CMBS][g * 128 + t];
            const size_t idx = (size_t)(n * 128 + t) * 2048 + g * 128 + c;
            UV[idx] = (bf16)f2bf(bf2f(UB[idx]) * acc); }
    }
}
#ifndef MK_FAST_CONV
#define MK_FAST_CONV 0
#endif
#ifndef MK_FAST_ATTN
#define MK_FAST_ATTN 0
#endif
#ifndef MK_FAST_SP
#define MK_FAST_SP 0
#endif
#ifndef MK_GATHER
#define MK_GATHER 0
#endif
constexpr int MOE_PH = MK_GATHER ? 5 : 6;
constexpr int N_PHASES = (MK_MERGE_PRO ? 1 : 2) + (4 + MOE_PH) + (4 + MOE_PH) + (3 + MOE_PH) + (4 + MOE_PH);

#ifndef MK_STAG_GU
#define MK_STAG_GU 0
#endif
#define STAGGER(ticks) do { if ((ticks) > 0 && (F.vcu & 1)) { const unsigned long long t0_ = __builtin_amdgcn_s_memrealtime(); while (__builtin_amdgcn_s_memrealtime() - t0_ < (unsigned long long)(ticks)) __builtin_amdgcn_s_sleep(8); } } while (0)
#ifndef MK_REPMASK
#define MK_REPMASK 0ull
#endif
#ifndef MK_CODEPROBE_N
#define MK_CODEPROBE_N 0
#endif
#if MK_CODEPROBE_N > 0
#define MK_CODEPROBE { _Pragma("unroll 1") for (int cp_ = 0; cp_ < MK_CODEPROBE_N; ++cp_) asm volatile(".rept 2048\n\ts_nop 0\n\t.endr" ::: "memory"); }
#else
#define MK_CODEPROBE
#endif
#ifndef MK_LNR2
#define MK_LNR2 0
#endif
#ifndef MK_XBAR
#define MK_XBAR 0
#endif
#ifndef MK_REPN
#define MK_REPN 3
#endif
#ifndef MK_REPBAR
#define MK_REPBAR 0
#endif
__device__ __forceinline__ bool probe_bar(unsigned char* lds_raw) { ArgsP a__ = get_args(); XcdBarrier bb; bb.bar = (unsigned*)(a__->ws + WS_CTL) + 4096; bb.x = xb_xcc_id();
    bb.st = (volatile LAS unsigned*)((LAS unsigned char*)lds_raw + MISC_OFF) + 8; xcd_barrier(bb); return false; }
#define REPS for (int rep_ = 0; rep_ < (((MK_REPMASK >> p) & 1ull) ? MK_REPN : 1); ++rep_) if (MK_REPBAR && rep_ > 0 && probe_bar(lds_raw)) {} else
#define IN() (get_args()->ph_lo <= p && p < get_args()->ph_hi)
#define PHB ArgsP a = get_args(); unsigned char* ws = a->ws; (void)ws; const Fr F = mkfr(lds_raw);
#define SEAM() do { { ArgsP a__ = get_args(); if (a__->ph_lo <= p && p + 1 < a__->ph_hi) { XcdBarrier bb; bb.bar = (unsigned*)(a__->ws + WS_CTL) + 4096; bb.x = xb_xcc_id(); \
        bb.st = (volatile LAS unsigned*)((LAS unsigned char*)lds_raw + MISC_OFF) + 8; xcd_barrier(bb); for (int xb_ = 0; xb_ < MK_XBAR; ++xb_) xcd_barrier(bb); MK_CODEPROBE } } ++p; } while (0)
template <int layer> __device__ __forceinline__ void layer_body(int& p, unsigned char* lds_raw) {
    PG8_LAS unsigned char* ring = (PG8_LAS unsigned char*)lds_raw;
        constexpr int kind = layer % 3;
        const int nrows = layer == 0 ? TA : T;
#define G1PTR ((const float*)(ws + WS_MOD) + (size_t)layer * 5 * 6144 + 2048)
        if constexpr (kind == 0) {
            const int slot = layer == 0 ? 0 : 1;
#if MK_FP8_HYIN
            REPS if (IN()) { PHB pg8::Gemm g{(const pg8::bf16_t*)(ws + WS_WHYIN + (size_t)slot * 3072 * 1024), (const pg8::bf16_t*)(ws + WS_HB), 3072, nrows, 512, nullptr};
                pg8::StaticOrder S; S.init(3072, nrows, F.G, F.bx); pg8::EpiBf16<0> E{(pg8::bf16_t*)(ws + SC_PT), TA, nullptr, 1 << 30, 0, 1.0f / WH_SCALE};
                pg8::gemm_phase<pg8::EpiBf16<0>, pg8::StaticOrder, true, false, true>(ring, g, S, E);
#else
            REPS if (IN()) { PHB pg8::Gemm g{(const pg8::bf16_t*)(ws + WS_WHYIN) + (size_t)slot * 3072 * 1024, (const pg8::bf16_t*)(ws + WS_HB), 3072, nrows, 1024, nullptr};
                pg8::StaticOrder S; S.init(3072, nrows, F.G, F.bx); pg8::EpiBf16<0> E{(pg8::bf16_t*)(ws + SC_PT), TA, nullptr, 0, 0, 1.f};
                pg8::gemm_phase<pg8::EpiBf16<0>, pg8::StaticOrder, true, false>(ring, g, S, E);
#endif
                if constexpr (layer == 0) { __syncthreads(); bg_convert<0>(a, F, F.bx - (12 * 68) % 256); } }
            SEAM();
            REPS if (IN()) { PHB
#if MK_FAST_CONV
                phase_hy_conv_fft(a, F, layer);
#else
                phase_hy_conv_direct(a, F, layer);
#endif
            }
            SEAM();
            REPS if (IN()) { PHB phase_hy_tr(a, F, nrows); }
            SEAM();
#if MK_FP8_HYOUT
            REPS if (IN()) { PHB pg8::Gemm g{(const pg8::bf16_t*)(ws + SC_Z2), (const pg8::bf16_t*)(ws + WS_WHYOUT + (size_t)slot * 1024 * 1024), nrows, 1024, 512, nullptr};
                pg8::StaticOrder S; S.init(nrows, 1024, F.G, F.bx); pg8::EpiRes E{(const pg8::bf16_t*)(ws + WS_XC), (pg8::bf16_t*)(ws + WS_U), G1PTR, 6144, ALPHA, 1.0f / (WH_SCALE * Z_SCALE)};
                pg8::gemm_phase<pg8::EpiRes, pg8::StaticOrder, true, false, true>(ring, g, S, E);
#else
            REPS if (IN()) { PHB pg8::Gemm g{(const pg8::bf16_t*)(ws + SC_Z2), (const pg8::bf16_t*)(ws + WS_WHYOUT) + (size_t)slot * 1024 * 1024, nrows, 1024, 1024, nullptr};
                pg8::StaticOrder S; S.init(nrows, 1024, F.G, F.bx); pg8::EpiRes E{(const pg8::bf16_t*)(ws + WS_XC), (pg8::bf16_t*)(ws + WS_U), G1PTR, 6144, ALPHA};
                pg8::gemm_phase<pg8::EpiRes, pg8::StaticOrder, true, false>(ring, g, S, E);
#endif
                if constexpr (layer == 0) { __syncthreads(); bg_convert<1>(a, F, F.bx - (68 * 4) % 256); } }
            SEAM();
        } else if constexpr (kind == 1) {
#if MK_FP8_QKV
            REPS if (IN()) { PHB pg8::Gemm g{(const pg8::bf16_t*)(ws + WS_HB), (const pg8::bf16_t*)(ws + WS_WQKV), TA, 1536, 512, nullptr};
                pg8::StaticOrder S; S.init(TA, 1536, F.G, F.bx); pg8::EpiBf16<0> E{(pg8::bf16_t*)(ws + SC_QKV), 1536, nullptr, 0, 0, 1.f, 1.0f / WH_SCALE};
                pg8::gemm_phase<pg8::EpiBf16<0>, pg8::StaticOrder, true, false, true>(ring, g, S, E);
#else
            REPS if (IN()) { PHB pg8::Gemm g{(const pg8::bf16_t*)(ws + WS_HB), (const pg8::bf16_t*)(ws + WS_WQKV), TA, 1536, 1024, nullptr};
                pg8::StaticOrder S; S.init(TA, 1536, F.G, F.bx); pg8::EpiBf16<0> E{(pg8::bf16_t*)(ws + SC_QKV), 1536, nullptr, 0, 0, 1.f};
                pg8::gemm_phase<pg8::EpiBf16<0>, pg8::StaticOrder, true, false>(ring, g, S, E);
#endif
                __syncthreads(); bg_convert<4>(a, F, F.bx - (68 * 6) % 256); }
            SEAM();
            REPS if (IN()) { PHB phase_rope(a, F); }
            SEAM();
            REPS if (IN()) { PHB
#if MK_FAST_ATTN
                phase_attn_fast(a, F);
#else
                phase_attn_simple(a, F);
#endif
            }
            SEAM();
#if MK_FP8_AOUT
            REPS if (IN()) { PHB pg8::Gemm g{(const pg8::bf16_t*)(ws + SC_O), (const pg8::bf16_t*)(ws + WS_WATO), T, 1024, 512, nullptr};
                pg8::StaticOrder S; S.init(T, 1024, F.G, F.bx); pg8::EpiRes E{(const pg8::bf16_t*)(ws + WS_XC), (pg8::bf16_t*)(ws + WS_U), G1PTR, 6144, ALPHA, 1.0f / (WH_SCALE * O_SCALE)};
                pg8::gemm_phase<pg8::EpiRes, pg8::StaticOrder, true, false, true>(ring, g, S, E); }
#else
            REPS if (IN()) { PHB pg8::Gemm g{(const pg8::bf16_t*)(ws + SC_O), (const pg8::bf16_t*)(ws + WS_WATO), T, 1024, 1024, nullptr};
                pg8::StaticOrder S; S.init(T, 1024, F.G, F.bx); pg8::EpiRes E{(const pg8::bf16_t*)(ws + WS_XC), (pg8::bf16_t*)(ws + WS_U), G1PTR, 6144, ALPHA};
                pg8::gemm_phase<pg8::EpiRes, pg8::StaticOrder, true, false>(ring, g, S, E); }
#endif
            SEAM();
        } else {
            REPS if (IN()) {
#if MK_FP8_CMIN
                { PHB pg8::Gemm g{(const pg8::bf16_t*)(ws + WS_HB), (const pg8::bf16_t*)(ws + WS_WCMIN), T, 2048, 512, nullptr};
                  pg8::StaticOrder S; S.init(T, 2048, F.G, F.bx); pg8::EpiBf16<1> E{(pg8::bf16_t*)(ws + SC_UB), 2048, nullptr, 0, 0, 1.f, 1.0f / WH_SCALE};
                  pg8::gemm_phase<pg8::EpiBf16<1>, pg8::StaticOrder, true, false, true>(ring, g, S, E); }
                { PHB pg8::Gemm g{(const pg8::bf16_t*)(ws + WS_WCMIN + (size_t)2048 * 1024), (const pg8::bf16_t*)(ws + WS_HB), 2048, T, 512, nullptr};
                  pg8::StaticOrder S; S.init(2048, T, F.G, F.bx); pg8::EpiVT E{(pg8::bf16_t*)(ws + SC_VT), T, (pg8::f32x2*)(ws + SC_VST), T, 1.0f / WH_SCALE};
                  pg8::gemm_phase<pg8::EpiVT, pg8::StaticOrder, true, false, true>(ring, g, S, E); }
#else
                { PHB pg8::Gemm g{(const pg8::bf16_t*)(ws + WS_HB), (const pg8::bf16_t*)(ws + WS_WCMIN), T, 2048, 1024, nullptr};
                  pg8::StaticOrder S; S.init(T, 2048, F.G, F.bx); pg8::EpiBf16<1> E{(pg8::bf16_t*)(ws + SC_UB), 2048, nullptr, 0, 0, 1.f};
                  pg8::gemm_phase<pg8::EpiBf16<1>, pg8::StaticOrder, true, false>(ring, g, S, E); }
#if MK_FP8_CMV
                { PHB pg8::Gemm g{(const pg8::bf16_t*)(ws + WS_WCMIN + (size_t)2048 * 1024 * 2), (const pg8::bf16_t*)(ws + WS_HB8B), 2048, T, 512, nullptr};
                  pg8::StaticOrder S; S.init(2048, T, F.G, F.bx); pg8::EpiVT E{(pg8::bf16_t*)(ws + SC_VT), T, (pg8::f32x2*)(ws + SC_VST), T, 1.0f / WH_SCALE};
                  pg8::gemm_phase<pg8::EpiVT, pg8::StaticOrder, true, false, true>(ring, g, S, E); }
#else
                { PHB pg8::Gemm g{(const pg8::bf16_t*)(ws + WS_WCMIN) + (size_t)2048 * 1024, (const pg8::bf16_t*)(ws + WS_HB), 2048, T, 1024, nullptr};
                  pg8::StaticOrder S; S.init(2048, T, F.G, F.bx); pg8::EpiVT E{(pg8::bf16_t*)(ws + SC_VT), T, (pg8::f32x2*)(ws + SC_VST), T};
                  pg8::gemm_phase<pg8::EpiVT, pg8::StaticOrder, true, false>(ring, g, S, E); }
#endif
#endif
            }
            SEAM();
            REPS if (IN()) { PHB
#if MK_FAST_SP
                phase_sp_fast(a, F);
#else
                phase_sp_simple(a, F);
#endif
            }
            SEAM();
#if MK_FP8_CMOUT
            REPS if (IN()) { PHB pg8::Gemm g{(const pg8::bf16_t*)(ws + SC_UV), (const pg8::bf16_t*)(ws + WS_WCMOUT), T, 1024, 1024, nullptr};
                pg8::StaticOrder S; S.init(T, 1024, F.G, F.bx); pg8::EpiRes E{(const pg8::bf16_t*)(ws + WS_XC), (pg8::bf16_t*)(ws + WS_U), G1PTR, 6144, ALPHA, 1.0f / (WH_SCALE * O_SCALE)};
                pg8::gemm_phase<pg8::EpiRes, pg8::StaticOrder, true, false, true>(ring, g, S, E); }
#else
            REPS if (IN()) { PHB pg8::Gemm g{(const pg8::bf16_t*)(ws + SC_UV), (const pg8::bf16_t*)(ws + WS_WCMOUT), T, 1024, 2048, nullptr};
                pg8::StaticOrder S; S.init(T, 1024, F.G, F.bx); pg8::EpiRes E{(const pg8::bf16_t*)(ws + WS_XC), (pg8::bf16_t*)(ws + WS_U), G1PTR, 6144, ALPHA};
                pg8::gemm_phase<pg8::EpiRes, pg8::StaticOrder, true, false>(ring, g, S, E); }
#endif
            SEAM();
        }
#if MK_LNR2
        REPS if (IN()) { PHB phase_lnr2(a, F, layer, nrows); }
#else
        REPS if (IN()) { PHB phase_lnr(a, F, layer, nrows); }
#endif
        SEAM();
        REPS if (IN()) { PHB phase_topk(a, F, layer);
            if constexpr (layer == 0) { __syncthreads(); bg_convert<2>(a, F, F.vcu - 128); }
            if constexpr (layer == 1) { __syncthreads(); bg_convert<5>(a, F, F.vcu - 64); }
            if constexpr (layer == 2) { __syncthreads(); bg_convert<6>(a, F, F.vcu - 64); } }
        SEAM();
        const int npm = layer == 0 ? 9 : 8;
#if MK_GATHER
        REPS if (IN()) { PHB pg8::Gemm g{(const pg8::bf16_t*)(ws + WS_HB), (const pg8::bf16_t*)(ws + WS_WGU + (size_t)layer * 16 * 4096 * 1024), 0, 0, 512, (const int*)(ws + WS_ROWS)};
            pg8::MoeOrder S{npm, 16, F.G, F.vcu}; pg8::EpiGU8<MK_FP8_DN != 0> E{(unsigned char*)(ws + WS_ACT), 16, 1.0f / WGU_SCALE, MK_FP8_DN ? ACT_SCALE : 1.0f};
            STAGGER(MK_STAG_GU);
#if defined(MK_NULLEPI)
            if (rep_ > 0) { pg8::MK_NULLEPI EN; pg8::MoeOrder S2 = S; S2.fixed = 1; pg8::gemm_phase<pg8::MK_NULLEPI, pg8::MoeOrder, true, true, true>(ring, g, S2, EN); } else
#endif
            pg8::gemm_phase<pg8::EpiGU8<MK_FP8_DN != 0>, pg8::MoeOrder, true, true, true>(ring, g, S, E); }
        SEAM();
#else
        REPS if (IN()) { PHB phase_gather(a, F, layer); }
        SEAM();
#error "the materialised-gather build (MK_GATHER 0) predates the e4m3 expert GEMMs and is no longer supported"
        SEAM();
#endif
#if MK_FP8_DN
        REPS if (IN()) { PHB pg8::Gemm g{(const pg8::bf16_t*)(ws + WS_ACT), (const pg8::bf16_t*)(ws + WS_WDN + (size_t)layer * 16 * 1024 * 2048), 0, 0, 1024, nullptr};
            pg8::MoeOrder S{npm, 4, F.G, F.vcu}; pg8::EpiDN E{(pg8::bf16_t*)(ws + WS_Y), (const float*)(ws + WS_GATE), 4, (MK_FP8_Y ? Y_SCALE : 1.0f) / (WDN_SCALE * ACT_SCALE)};
            pg8::gemm_phase<pg8::EpiDN, pg8::MoeOrder, true, false, true>(ring, g, S, E);
            if constexpr (layer == 0) { __syncthreads(); bg_convert<3>(a, F, F.vcu - (16 * 9 * 4) % 256); } }
#else
        REPS if (IN()) { PHB pg8::Gemm g{(const pg8::bf16_t*)(ws + WS_ACT), (const pg8::bf16_t*)(ws + WS_WDN) + (size_t)layer * 16 * 1024 * 2048, 0, 0, 2048, nullptr};
            pg8::MoeOrder S{npm, 4, F.G, F.vcu}; pg8::EpiDN E{(pg8::bf16_t*)(ws + WS_Y), (const float*)(ws + WS_GATE), 4, 1.0f};
            pg8::gemm_phase<pg8::EpiDN, pg8::MoeOrder, true, false, false>(ring, g, S, E); }
#endif
        SEAM();
        REPS if (IN()) { PHB phase_comb(a, F, layer, nrows); }
        SEAM();
    }
__global__ void __launch_bounds__(NTHR, 2) mk_fwd(Args a_) {
    extern __shared__ __attribute__((aligned(16))) unsigned char lds_raw[];
    Fr F0 = mkfr(lds_raw);
    volatile LAS unsigned* MISC = (volatile LAS unsigned*)(F0.lds + MISC_OFF);
    if (F0.tid < 32) MISC[F0.tid] = 0u;
    __syncthreads();
    if (a_.ph_hi - a_.ph_lo > 1) (void)xcd_barrier_post((unsigned*)(a_.ws + WS_CTL) + 4096, MISC + 8);
    int p = 0;
    PG8_LAS unsigned char* ring = (PG8_LAS unsigned char*)lds_raw;

    REPS if (IN()) { PHB phase_proA(a, F); }
    SEAM();
#if !MK_MERGE_PRO
    REPS if (IN()) { PHB phase_proB(a, F); }
    SEAM();
#endif
    layer_body<0>(p, lds_raw); layer_body<1>(p, lds_raw); layer_body<2>(p, lds_raw); layer_body<3>(p, lds_raw);
#undef IN
#undef PHB
#undef G1PTR
#undef SEAM
}

#ifndef MK_N_LAUNCHES
#define MK_N_LAUNCHES 0
#endif
extern "C" void kernel_launch(void* const* d_in, const int* in_sizes, int n_in, void* d_out, int out_size, void* d_ws, size_t ws_size, hipStream_t stream) {
    static int grid = 0;
    if (grid == 0) {
        if (n_in != 33 || out_size != T * D || ws_size < WS_END) { fprintf(stderr, "kernel_launch: expected 33 inputs, %d outputs, >= %zu bytes of workspace; got %d, %d, %zu\n", T * D, (size_t)WS_END, n_in, out_size, ws_size); grid = -1; return; }
        int dev = 0, cus = 0, per_cu = 0;
        if (hipGetDevice(&dev) != hipSuccess || hipDeviceGetAttribute(&cus, hipDeviceAttributeMultiprocessorCount, dev) != hipSuccess) { grid = -1; return; }
        if (hipFuncSetAttribute((const void*)mk_fwd, hipFuncAttributeMaxDynamicSharedMemorySize, LDS_BYTES) != hipSuccess) { fprintf(stderr, "kernel_launch: hipFuncSetAttribute failed\n"); grid = -1; return; }
        if (hipOccupancyMaxActiveBlocksPerMultiprocessor(&per_cu, (const void*)mk_fwd, NTHR, LDS_BYTES) != hipSuccess || per_cu < 1)
            fprintf(stderr, "kernel_launch: note: occupancy query reports %d workgroups per CU\n", per_cu);
        (void)hipGetLastError();
        grid = cus;
    }
    if (grid < 0) return;
    (void)hipMemsetAsync((char*)d_ws + WS_CTL, 0, 64 * 1024, stream);
    Args a{};
    for (int i = 0; i < 33; ++i) a.in[i] = (const float*)d_in[i];
    a.out = (float*)d_out; a.ws = (unsigned char*)d_ws;
#if MK_N_LAUNCHES == 1
    a.ph_lo = 0; a.ph_hi = N_PHASES;
    hipLaunchKernelGGL(mk_fwd, dim3(grid), dim3(NTHR), LDS_BYTES, stream, a);
#else
    for (int p = 0; p < N_PHASES; ++p) { a.ph_lo = p; a.ph_hi = p + 1; hipLaunchKernelGGL(mk_fwd, dim3(grid), dim3(NTHR), LDS_BYTES, stream, a); }
#endif
    const hipError_t le = hipPeekAtLastError();
    if (le != hipSuccess) fprintf(stderr, "kernel_launch: launch failed: %s\n", hipGetErrorName(le));
}
```
